# Optimizing an MI355X kernel written in HIP

```python
import math
import jax, jax.numpy as jnp
from jax import lax
import numpy as np

D_MODEL = 1024
BATCH = 8
SEQ = 2048
DEPTH = 4

ROPE_THETA = 10000.0
EPS = 1e-6
LN_EPS = 1e-5
MLA_H = 8
MLA_NOPE = 64
MLA_ROPE = 32
MLA_V = 64
Q_LORA = 256
KV_LORA = 128
ATTN_BLOCK = 128
GDN_H = 4
GDN_DK = 128
GDN_DV = 128
CONV_W = 4
GDN_CHUNK = 64
ML_H = 4
ML_DK = 64
ML_DV = 128
ML_CHUNK = 64
SWA_H = 8
SWA_KV = 2
SWA_D = 64
WINDOW = 128
N_EXPERTS = 64
N_GROUPS = 8
TOPK_GROUPS = 4
TOP_K = 8
D_EXPERT = 256
D_SHARED = 256
ROUTED_SCALE = 2.5
DISPATCH_BLOCK = 128
DN_ALPHA = (2 * DEPTH) ** 0.25
DN_BETA = (8 * DEPTH) ** -0.25

EV_SIZES = (Q_LORA, KV_LORA + MLA_ROPE, GDN_H * GDN_DK, GDN_H * GDN_DK, GDN_H * GDN_DV, GDN_H, GDN_H, GDN_H * GDN_DV)
OD_SIZES = (ML_H * ML_DK, ML_H * ML_DK, ML_H * ML_DV, ML_H, ML_H, ML_H * ML_DV, SWA_H * SWA_D, SWA_KV * SWA_D, SWA_KV * SWA_D)
EV_IN = sum(EV_SIZES)
OD_IN = sum(OD_SIZES)
EV_MIX = MLA_H * MLA_V + GDN_H * GDN_DV
OD_MIX = ML_H * ML_DV + SWA_H * SWA_D

kernel_name = "hybrid_mla_gdn_mlstm_swa_moe_deepnorm"


def split_cols(t, sizes):
    return jnp.split(t, np.cumsum(sizes)[:-1].tolist(), axis=-1)


def rms_norm(t, g):
    tf = t.astype(jnp.float32)
    y = tf * lax.rsqrt(jnp.mean(tf * tf, -1, keepdims=True) + EPS)
    return (y * g.astype(jnp.float32)).astype(t.dtype)


def layer_norm(t, g, b):
    tf = t.astype(jnp.float32)
    mu = jnp.mean(tf, -1, keepdims=True)
    var = jnp.mean(jnp.square(tf - mu), -1, keepdims=True)
    y = (tf - mu) * lax.rsqrt(var + LN_EPS) * g.astype(jnp.float32) + b.astype(jnp.float32)
    return y.astype(t.dtype)


def l2_normalize(t):
    tf = t.astype(jnp.float32)
    return tf * lax.rsqrt(jnp.sum(tf * tf, -1, keepdims=True) + EPS)


def rope_tables(positions, dim):
    inv_freq = ROPE_THETA ** (-(jnp.arange(0, dim, 2, dtype=jnp.float32) / dim))
    ang = positions.astype(jnp.float32)[..., None] * inv_freq
    return jnp.cos(ang), jnp.sin(ang)


def apply_rope(t, cos, sin):
    shape = cos.shape[:2] + (1,) * (t.ndim - 3) + cos.shape[2:]
    c, s = cos.reshape(shape), sin.reshape(shape)
    tf = t.astype(jnp.float32)
    half = t.shape[-1] // 2
    t1, t2 = tf[..., :half], tf[..., half:]
    return jnp.concatenate([t1 * c - t2 * s, t2 * c + t1 * s], -1).astype(t.dtype)


def causal_dwconv(t, w):
    width, ch = w.shape
    return lax.conv_general_dilated(t, w[:, None, :].astype(t.dtype), window_strides=(1,),
                                    padding=[(width - 1, 0)], dimension_numbers=('NWC', 'WIO', 'NWC'),
                                    feature_group_count=ch)


def to_chunks(t, c):
    b, s, h = t.shape[:3]
    t = t.astype(jnp.float32).reshape((b, s // c, c, h) + t.shape[3:])
    return jnp.moveaxis(t, (1, 3), (0, 2))


def from_chunks(o):
    n, b, h, c, d = o.shape
    return jnp.moveaxis(o, (0, 2), (1, 3)).reshape(b, n * c, h, d)


def mla_attention(q_nope, q_rope, k_nope, k_rope, v):
    b, s, h, _ = q_nope.shape
    nb = s // ATTN_BLOCK
    scale = (MLA_NOPE + MLA_ROPE) ** -0.5
    kpos = jnp.arange(s)

    def blocks(t):
        return jnp.moveaxis(t.reshape((b, nb, ATTN_BLOCK) + t.shape[2:]), 1, 0)

    def one_block(args):
        qn, qr, n = args
        sc = jnp.einsum('bqhd,bkhd->bhqk', qn, k_nope) + jnp.einsum('bqhd,bkd->bhqk', qr, k_rope)
        sc = sc.astype(jnp.float32) * scale
        qpos = n * ATTN_BLOCK + jnp.arange(ATTN_BLOCK)
        sc = jnp.where(qpos[:, None] >= kpos[None, :], sc, -jnp.inf)
        p = jax.nn.softmax(sc, -1).astype(v.dtype)
        return jnp.einsum('bhqk,bkhd->bqhd', p, v)

    o = lax.map(one_block, (blocks(q_nope), blocks(q_rope), jnp.arange(nb)))
    return jnp.moveaxis(o, 0, 1).reshape(b, s, h * MLA_V)


def gated_delta_rule(q, k, v, beta, g):
    b, s, h, dk = q.shape
    dv = v.shape[-1]
    c = GDN_CHUNK
    q = to_chunks(q, c) * dk ** -0.5
    k, v, beta = to_chunks(k, c), to_chunks(v, c), to_chunks(beta, c)
    g = jnp.cumsum(to_chunks(g, c), -1)
    incl = jnp.tril(jnp.ones((c, c), bool))
    strict = jnp.tril(jnp.ones((c, c), bool), -1)
    decay = jnp.exp(jnp.where(incl, g[..., :, None] - g[..., None, :], -jnp.inf))
    kb = k * beta[..., None]
    lower = jnp.where(strict, jnp.einsum('nbhcd,nbhsd->nbhcs', kb, k) * decay, 0.0)
    eye = jnp.eye(c, dtype=jnp.float32)
    a = eye + lower
    t_inv = lax.linalg.triangular_solve(a, jnp.broadcast_to(eye, a.shape), left_side=True,
                                        lower=True, unit_diagonal=True)
    u = t_inv @ (v * beta[..., None])
    w = t_inv @ (kb * jnp.exp(g)[..., None])
    attn = jnp.einsum('nbhcd,nbhsd->nbhcs', q, k) * decay
    qg = q * jnp.exp(g)[..., None]
    kg = k * jnp.exp(g[..., -1:] - g)[..., None]
    glast = jnp.exp(g[..., -1])

    def step(state, inp):
        qg_c, kg_c, u_c, w_c, a_c, gl = inp
        v_new = u_c - w_c @ state
        o = qg_c @ state + a_c @ v_new
        state = state * gl[..., None, None] + jnp.einsum('bhcd,bhce->bhde', kg_c, v_new)
        return state, o

    _, o = lax.scan(step, jnp.zeros((b, h, dk, dv), jnp.float32), (qg, kg, u, w, attn, glast))
    return from_chunks(o)


def mlstm_chunked(q, k, v, i_pre, logf):
    b, s, h, dk = q.shape
    dv = v.shape[-1]
    c = ML_CHUNK
    incl = jnp.tril(jnp.ones((c, c), bool))
    xs = (to_chunks(q, c), to_chunks(k, c), to_chunks(v, c), to_chunks(i_pre, c), to_chunks(logf, c))

    def step(carry, inp):
        c_st, n_st, m_st = carry
        q_c, k_c, v_c, i_c, lf_c = inp
        bcum = jnp.cumsum(lf_c, -1)
        d = jnp.where(incl, bcum[..., :, None] - bcum[..., None, :] + i_c[..., None, :], -jnp.inf)
        inter = bcum + m_st[..., None]
        m_t = jnp.maximum(inter, jnp.max(d, -1))
        w_inter = jnp.exp(inter - m_t)
        p = jnp.exp(d - m_t[..., None]) * jnp.einsum('bhtd,bhsd->bhts', q_c, k_c)
        num = w_inter[..., None] * jnp.einsum('bhtd,bhde->bhte', q_c, c_st) + p @ v_c
        den = w_inter * jnp.einsum('bhtd,bhd->bht', q_c, n_st) + jnp.sum(p, -1)
        h_c = num / jnp.maximum(jnp.abs(den), jnp.exp(-m_t))[..., None]
        b_end = bcum[..., -1]
        a = b_end[..., None] - bcum + i_c
        m_new = jnp.maximum(b_end + m_st, jnp.max(a, -1))
        s_a = jnp.exp(a - m_new[..., None])
        keep = jnp.exp(b_end + m_st - m_new)
        c_st = keep[..., None, None] * c_st + jnp.einsum('bhsd,bhse->bhde', k_c * s_a[..., None], v_c)
        n_st = keep[..., None] * n_st + jnp.einsum('bhsd,bhs->bhd', k_c, s_a)
        return (c_st, n_st, m_new), h_c

    init = (jnp.zeros((b, h, dk, dv), jnp.float32), jnp.zeros((b, h, dk), jnp.float32),
            jnp.zeros((b, h), jnp.float32))
    _, o = lax.scan(step, init, xs)
    return from_chunks(o)


def swa_with_sinks(q, k, v, sinks):
    b, s, hq, d = q.shape
    grp = hq // SWA_KV
    nb = s // WINDOW
    qb = q.reshape(b, nb, WINDOW, SWA_KV, grp, d)

    def band(t):
        tb = t.reshape(b, nb, WINDOW, SWA_KV, d)
        prev = jnp.pad(tb, ((0, 0), (1, 0), (0, 0), (0, 0), (0, 0)))[:, :-1]
        return jnp.concatenate([prev, tb], axis=2)

    kb, vb = band(k), band(v)
    sc = jnp.einsum('bnqhgd,bnkhd->bnhgqk', qb, kb).astype(jnp.float32) * d ** -0.5
    qi = jnp.arange(WINDOW)[:, None]
    kj = jnp.arange(2 * WINDOW)[None, :]
    rel = qi + WINDOW - kj
    in_band = (rel >= 0) & (rel < WINDOW)
    exists = (jnp.arange(nb)[:, None, None] > 0) | (kj >= WINDOW)[None]
    mask = in_band[None] & exists
    sc = jnp.where(mask[None, :, None, None], sc, -jnp.inf)
    sink = jnp.broadcast_to(sinks.astype(jnp.float32).reshape(1, 1, SWA_KV, grp, 1, 1), sc.shape[:-1] + (1,))
    p = jax.nn.softmax(jnp.concatenate([sc, sink], -1), -1)[..., :-1].astype(v.dtype)
    o = jnp.einsum('bnhgqk,bnkhd->bnqhgd', p, vb)
    return o.reshape(b, s, hq * d)


def even_mixer(x, cos_m, sin_m, w_in, q_norm, w_qb, kv_norm, w_kvb, conv_w, a_log, dt_bias, o_norm, w_out):
    b, s, _ = x.shape
    c_q, kv_a, gq, gk, gv, g_beta, g_decay, z = split_cols(x @ w_in, EV_SIZES)
    q = (rms_norm(c_q, q_norm) @ w_qb).reshape(b, s, MLA_H, MLA_NOPE + MLA_ROPE)
    q_nope, q_rope = q[..., :MLA_NOPE], apply_rope(q[..., MLA_NOPE:], cos_m, sin_m)
    c_kv, k_rope = kv_a[..., :KV_LORA], apply_rope(kv_a[..., KV_LORA:], cos_m, sin_m)
    kv = (rms_norm(c_kv, kv_norm) @ w_kvb).reshape(b, s, MLA_H, MLA_NOPE + MLA_V)
    o_a = mla_attention(q_nope, q_rope, kv[..., :MLA_NOPE], k_rope, kv[..., MLA_NOPE:])
    qkv = jax.nn.silu(causal_dwconv(jnp.concatenate([gq, gk, gv], -1), conv_w))
    gq, gk, gv = split_cols(qkv, (GDN_H * GDN_DK, GDN_H * GDN_DK, GDN_H * GDN_DV))
    gq = l2_normalize(gq.reshape(b, s, GDN_H, GDN_DK))
    gk = l2_normalize(gk.reshape(b, s, GDN_H, GDN_DK))
    gv = gv.reshape(b, s, GDN_H, GDN_DV)
    beta = jax.nn.sigmoid(g_beta.astype(jnp.float32))
    g = -jnp.exp(a_log.astype(jnp.float32)) * jax.nn.softplus(g_decay.astype(jnp.float32) + dt_bias.astype(jnp.float32))
    o_b = gated_delta_rule(gq, gk, gv, beta, g)
    o_b = rms_norm(o_b, o_norm) * jax.nn.silu(z.reshape(b, s, GDN_H, GDN_DV).astype(jnp.float32))
    o_b = o_b.reshape(b, s, GDN_H * GDN_DV).astype(x.dtype)
    return jnp.concatenate([o_a, o_b], -1) @ w_out


def odd_mixer(x, cos_s, sin_s, w_in, b_i, b_f, ml_norm, sinks, w_out):
    b, s, _ = x.shape
    mq, mk, mv, mi, mf, mo, sq, sk, sv = split_cols(x @ w_in, OD_SIZES)
    i_pre = mi.astype(jnp.float32) + b_i.astype(jnp.float32)
    logf = jax.nn.log_sigmoid(mf.astype(jnp.float32) + b_f.astype(jnp.float32))
    h = mlstm_chunked(mq.reshape(b, s, ML_H, ML_DK), mk.reshape(b, s, ML_H, ML_DK) * ML_DK ** -0.5,
                      mv.reshape(b, s, ML_H, ML_DV), i_pre, logf)
    h = rms_norm(h, ml_norm.reshape(ML_H, ML_DV)) * jax.nn.sigmoid(mo.reshape(b, s, ML_H, ML_DV).astype(jnp.float32))
    o_c = h.reshape(b, s, ML_H * ML_DV).astype(x.dtype)
    q = apply_rope(sq.reshape(b, s, SWA_H, SWA_D), cos_s, sin_s)
    k = apply_rope(sk.reshape(b, s, SWA_KV, SWA_D), cos_s, sin_s)
    o_d = swa_with_sinks(q, k, sv.reshape(b, s, SWA_KV, SWA_D), sinks)
    return jnp.concatenate([o_c, o_d], -1) @ w_out


def moe_ffn(x, router_w, router_b, w_gate, w_up, w_down, s_gate, s_up, s_down):
    t, d = x.shape
    scores = jax.nn.sigmoid((x @ router_w).astype(jnp.float32))
    grouped = (scores + router_b.astype(jnp.float32)).reshape(t, N_GROUPS, N_EXPERTS // N_GROUPS)
    group_score = jnp.sum(lax.top_k(grouped, 2)[0], -1)
    _, top_groups = lax.top_k(group_score, TOPK_GROUPS)
    group_mask = jnp.any(top_groups[..., None] == jnp.arange(N_GROUPS), axis=1)
    masked = jnp.where(group_mask[..., None], grouped, -jnp.inf).reshape(t, N_EXPERTS)
    _, idx = lax.top_k(masked, TOP_K)
    gate = jnp.take_along_axis(scores, idx, -1)
    gate = gate / jnp.sum(gate, -1, keepdims=True) * ROUTED_SCALE
    n_assign = t * TOP_K
    flat_e = idx.reshape(-1)
    order = jnp.argsort(flat_e)
    e_sorted = flat_e[order]
    tok_sorted = (order // TOP_K).astype(jnp.int32)
    w_sorted = gate.reshape(-1)[order].astype(x.dtype)
    counts = jnp.bincount(flat_e, length=N_EXPERTS)
    padded = (counts + DISPATCH_BLOCK - 1) // DISPATCH_BLOCK * DISPATCH_BLOCK
    pad_end = jnp.cumsum(padded)
    pad_start = pad_end - padded
    start = jnp.cumsum(counts) - counts
    dest = pad_start[e_sorted] + jnp.arange(n_assign) - start[e_sorted]
    n_blocks = -(-n_assign // DISPATCH_BLOCK) + N_EXPERTS
    rows = n_blocks * DISPATCH_BLOCK
    row_tok = jnp.zeros((rows,), jnp.int32).at[dest].set(tok_sorted)
    row_w = jnp.zeros((rows,), x.dtype).at[dest].set(w_sorted)
    block_e = jnp.minimum(jnp.searchsorted(pad_end, jnp.arange(n_blocks) * DISPATCH_BLOCK, side='right'), N_EXPERTS - 1)

    def body(y, blk):
        tok, wt, e = blk
        xb = x[tok]
        hb = jax.nn.silu(xb @ w_gate[e]) * (xb @ w_up[e])
        return y.at[tok].add((hb @ w_down[e]) * wt[:, None]), None

    y, _ = lax.scan(body, jnp.zeros_like(x), (row_tok.reshape(n_blocks, DISPATCH_BLOCK),
                                              row_w.reshape(n_blocks, DISPATCH_BLOCK), block_e))
    shared = (jax.nn.silu(x @ s_gate) * (x @ s_up)) @ s_down
    return y + shared


def setup_inputs(seed: int = 0) -> dict:
    key = jax.random.key(seed)
    keys = iter(jax.random.split(key, 40))
    ne, no = (DEPTH + 1) // 2, DEPTH // 2

    def nrm(shape, scale):
        return jax.random.normal(next(keys), shape, jnp.float32) * scale

    def gain(shape):
        return 1.0 + nrm(shape, 0.02)

    x = nrm((BATCH, SEQ, D_MODEL), 1.0)
    positions = jax.random.randint(next(keys), (BATCH, 1), 0, 4096, dtype=jnp.int32) + jnp.arange(SEQ, dtype=jnp.int32)[None, :]
    u = jax.random.uniform(next(keys), (ne, GDN_H), jnp.float32)
    dt = jnp.exp(u * (math.log(0.1) - math.log(0.001)) + math.log(0.001))
    return {
        'x': x,
        'positions': positions,
        'ev_w_in': nrm((ne, D_MODEL, EV_IN), D_MODEL ** -0.5),
        'mla_q_norm': gain((ne, Q_LORA)),
        'mla_w_qb': nrm((ne, Q_LORA, MLA_H * (MLA_NOPE + MLA_ROPE)), Q_LORA ** -0.5),
        'mla_kv_norm': gain((ne, KV_LORA)),
        'mla_w_kvb': nrm((ne, KV_LORA, MLA_H * (MLA_NOPE + MLA_V)), KV_LORA ** -0.5),
        'gdn_conv': nrm((ne, CONV_W, GDN_H * (2 * GDN_DK + GDN_DV)), CONV_W ** -0.5),
        'gdn_a_log': jnp.log(jax.random.uniform(next(keys), (ne, GDN_H), jnp.float32, 1.0, 16.0)),
        'gdn_dt_bias': dt + jnp.log(-jnp.expm1(-dt)),
        'gdn_norm': gain((ne, GDN_DV)),
        'ev_w_out': nrm((ne, EV_MIX, D_MODEL), EV_MIX ** -0.5 * DN_BETA),
        'od_w_in': nrm((no, D_MODEL, OD_IN), D_MODEL ** -0.5),
        'mlstm_b_i': nrm((no, ML_H), 0.1) - 1.0,
        'mlstm_b_f': jnp.linspace(3.0, 6.0, ML_H, dtype=jnp.float32)[None, :] + nrm((no, ML_H), 0.1),
        'mlstm_norm': gain((no, ML_H * ML_DV)),
        'swa_sinks': nrm((no, SWA_H), 0.5),
        'od_w_out': nrm((no, OD_MIX, D_MODEL), OD_MIX ** -0.5 * DN_BETA),
        'ln1_g': gain((DEPTH, D_MODEL)),
        'ln1_b': nrm((DEPTH, D_MODEL), 0.02),
        'router_w': nrm((DEPTH, D_MODEL, N_EXPERTS), D_MODEL ** -0.5),
        'router_b': nrm((DEPTH, N_EXPERTS), 0.01),
        'moe_w_gate': nrm((DEPTH, N_EXPERTS, D_MODEL, D_EXPERT), D_MODEL ** -0.5),
        'moe_w_up': nrm((DEPTH, N_EXPERTS, D_MODEL, D_EXPERT), D_MODEL ** -0.5),
        'moe_w_down': nrm((DEPTH, N_EXPERTS, D_EXPERT, D_MODEL), D_EXPERT ** -0.5 * DN_BETA),
        'shared_w_gate': nrm((DEPTH, D_MODEL, D_SHARED), D_MODEL ** -0.5),
        'shared_w_up': nrm((DEPTH, D_MODEL, D_SHARED), D_MODEL ** -0.5),
        'shared_w_down': nrm((DEPTH, D_SHARED, D_MODEL), D_SHARED ** -0.5 * DN_BETA),
        'ln2_g': gain((DEPTH, D_MODEL)),
        'ln2_b': nrm((DEPTH, D_MODEL), 0.02),
    }


def reference(x, positions, ev_w_in, mla_q_norm, mla_w_qb, mla_kv_norm, mla_w_kvb, gdn_conv, gdn_a_log,
              gdn_dt_bias, gdn_norm, ev_w_out, od_w_in, mlstm_b_i, mlstm_b_f, mlstm_norm, swa_sinks, od_w_out,
              ln1_g, ln1_b, router_w, router_b, moe_w_gate, moe_w_up, moe_w_down, shared_w_gate, shared_w_up,
              shared_w_down, ln2_g, ln2_b):
    b, s, d = x.shape
    cos_m, sin_m = rope_tables(positions, MLA_ROPE)
    cos_s, sin_s = rope_tables(positions, SWA_D)
    for layer in range(DEPTH):
        j = layer // 2
        if layer % 2 == 0:
            mix = even_mixer(x, cos_m, sin_m, ev_w_in[j], mla_q_norm[j], mla_w_qb[j], mla_kv_norm[j], mla_w_kvb[j],
                             gdn_conv[j], gdn_a_log[j], gdn_dt_bias[j], gdn_norm[j], ev_w_out[j])
        else:
            mix = odd_mixer(x, cos_s, sin_s, od_w_in[j], mlstm_b_i[j], mlstm_b_f[j], mlstm_norm[j], swa_sinks[j], od_w_out[j])
        x = layer_norm(DN_ALPHA * x + mix, ln1_g[layer], ln1_b[layer])
        ff = moe_ffn(x.reshape(b * s, d), router_w[layer], router_b[layer], moe_w_gate[layer], moe_w_up[layer],
                     moe_w_down[layer], shared_w_gate[layer], shared_w_up[layer], shared_w_down[layer])
        x = layer_norm(DN_ALPHA * x + ff.reshape(b, s, d), ln2_g[layer], ln2_b[layer])
    return x
```

```cpp
#include <hip/hip_runtime.h>
#include <stdint.h>
#include <stdio.h>

#ifndef ONE_LAUNCH
#define ONE_LAUNCH 1
#endif

typedef unsigned short bf16_t;
typedef short bf16x8 __attribute__((ext_vector_type(8)));
typedef float f32x4 __attribute__((ext_vector_type(4)));
typedef unsigned u32x4 __attribute__((ext_vector_type(4)));
typedef unsigned u32x2 __attribute__((ext_vector_type(2)));
#define LAS __attribute__((address_space(3)))
#define GAS __attribute__((address_space(1)))

constexpr int T = 16384, SEQ = 2048;
constexpr int NPAD = 2560;
constexpr int CAP = 16384;
constexpr int MAXRB = 1024 + 64 + 128;
constexpr int MAXROWS = MAXRB * 128;
constexpr float ALPHA = 1.681792830507429f;
constexpr int PPL = 11;
constexpr int NPH = 1 + 4 * PPL;
constexpr int DYN_LDS = 65536 + 64;

constexpr size_t cmax(size_t a, size_t b) { return a > b ? a : b; }
constexpr size_t WS_CTL = 0;
constexpr size_t CTL_BYTES = 65536;
constexpr size_t WS_WIN = WS_CTL + CTL_BYTES;
constexpr size_t WIN_ELEMS = (size_t)NPAD * 1024;
constexpr size_t WS_WQB = WS_WIN + 4 * WIN_ELEMS * 2;
constexpr size_t WQB_ELEMS = 768 * 256;
constexpr size_t WS_WKVB = WS_WQB + 2 * WQB_ELEMS * 2;
constexpr size_t WKVB_ELEMS = 1024 * 128;
constexpr size_t WS_WOUT = WS_WKVB + 2 * WKVB_ELEMS * 2;
constexpr size_t WOUT_ELEMS = 1024 * 1024;
constexpr size_t WS_WRT = WS_WOUT + 4 * WOUT_ELEMS * 2;
constexpr size_t WRT_ELEMS = 128 * 1024;
constexpr size_t WS_WGU = WS_WRT + 4 * WRT_ELEMS * 2;
constexpr size_t WGU_ELEMS = 512 * 1024;
constexpr size_t WS_WDN = WS_WGU + 4 * 65 * WGU_ELEMS * 2;
constexpr size_t WDN_ELEMS = 1024 * 256;
constexpr size_t WS_ROPEM = WS_WDN + 4 * 65 * WDN_ELEMS * 2;
constexpr size_t WS_ROPES = WS_ROPEM + (size_t)T * 16 * 2 * 4;
constexpr size_t WS_X1 = WS_ROPES + (size_t)T * 32 * 2 * 4;
constexpr size_t WS_XBF = WS_X1 + (size_t)T * 1024 * 4;
constexpr size_t WS_HBUF = WS_XBF + (size_t)T * 1024 * 2;
constexpr size_t WS_LOG = WS_HBUF + (size_t)MAXROWS * 256 * 2;
constexpr size_t WS_ASG = WS_LOG + (size_t)T * 64 * 4;
constexpr size_t WS_LTOK = WS_ASG + (size_t)T * 8 * 4;
constexpr size_t WS_LW = WS_LTOK + (size_t)65 * CAP * 4;
constexpr size_t WS_U = WS_LW + (size_t)65 * CAP * 4;
constexpr size_t U_Y = WS_U;
constexpr size_t U_PROJ = WS_U;
constexpr size_t U_GATES = U_PROJ + (size_t)T * NPAD * 2;
constexpr size_t U_CQ = U_GATES + (size_t)T * 8 * 4;
constexpr size_t U_CKV = U_CQ + (size_t)T * 256 * 2;
constexpr size_t U_KROPE = U_CKV + (size_t)T * 128 * 2;
constexpr size_t U_QF = U_KROPE + (size_t)T * 32 * 2;
constexpr size_t U_KN = U_QF + (size_t)T * 768 * 2;
constexpr size_t U_VV = U_KN + (size_t)T * 512 * 2;
constexpr size_t U_GQ = U_VV + (size_t)T * 512 * 2;
constexpr size_t U_GK = U_GQ + (size_t)T * 512 * 2;
constexpr size_t U_GV = U_GK + (size_t)T * 512 * 2;
constexpr size_t U_BETA = U_GV + (size_t)T * 512 * 2;
constexpr size_t U_GLOG = U_BETA + (size_t)T * 4 * 4;
constexpr size_t U_MIXO = U_GLOG + (size_t)T * 4 * 4;
constexpr size_t U_YBUF = U_MIXO + (size_t)T * 1024 * 2;
constexpr size_t U_END1 = U_YBUF + (size_t)T * 1024 * 4;
constexpr size_t WS_END = WS_U + cmax((size_t)MAXROWS * 1024 * 2, U_END1 - WS_U);

constexpr int CW_CNT = 4096;
constexpr int CW_WORK = 8192;

#define XB_TMO      128
#define XB_XCNT(j)  (256  + 64 * (j))
#define XB_XSUB(j)  (1280 + 64 * (j))
#define XB_XGEN(j)  (2304 + 64 * (j))
#define XB_TOP      3328
#define XB_TOPGEN   3392
#define XCD_BAR_WORDS 3456
#define XB_SPIN_CAP (1u << 18)

__device__ __forceinline__ unsigned xb_ld(unsigned* p)              { return __hip_atomic_load(p, __ATOMIC_RELAXED, __HIP_MEMORY_SCOPE_AGENT); }
__device__ __forceinline__ unsigned xb_add(unsigned* p, unsigned v) { return __hip_atomic_fetch_add(p, v, __ATOMIC_RELAXED, __HIP_MEMORY_SCOPE_AGENT); }
__device__ __forceinline__ unsigned xb_xcc_id() { return (unsigned)__builtin_amdgcn_s_getreg((3 << 11) | 20) & 0xFu; }
#define XB_SPIN(cond, bar) do { unsigned _sp = 0; while (cond) { __builtin_amdgcn_s_sleep(1); \
    if ((++_sp & 255u) == 0u) { if (xb_ld(&(bar)[XB_TMO])) break; if (_sp > XB_SPIN_CAP) { atomicAdd(&(bar)[XB_TMO], 1u); break; } } } } while (0)

struct XcdBarrier { unsigned* bar; unsigned x; volatile LAS unsigned* st; };

__device__ __forceinline__ XcdBarrier xcd_barrier_post(unsigned* bar, volatile LAS unsigned* st) {
    XcdBarrier b; b.bar = bar; b.x = xb_xcc_id(); b.st = st;
    if (threadIdx.x == 0) (void)xb_add(&bar[XB_XCNT(b.x)], 1u);
    return b;
}
__device__ __forceinline__ void xcd_barrier_complete(unsigned* bar, unsigned x, unsigned& nloc, unsigned& nx) {
    const unsigned G = gridDim.x * gridDim.y * gridDim.z;
    unsigned sum, cnt, mine, sp = 0u;
    for (;;) {
        sum = 0u; cnt = 0u; mine = 0u;
#pragma unroll
        for (unsigned j = 0; j < 16; ++j) { const unsigned c = xb_ld(&bar[XB_XCNT(j)]); sum += c; cnt += (c > 0u) ? 1u : 0u; mine = (j == x) ? c : mine; }
        if (sum == G) break;
        __builtin_amdgcn_s_sleep(1);
        if ((++sp & 255u) == 0u) { if (xb_ld(&bar[XB_TMO])) break; if (sp > XB_SPIN_CAP) { atomicAdd(&bar[XB_TMO], 1u); break; } }
    }
    nloc = mine > 0u ? mine : 1u; nx = cnt > 0u ? cnt : 1u;
}
__device__ __forceinline__ void xcd_barrier(const XcdBarrier& b) {
    asm volatile("s_waitcnt vmcnt(0)" ::: "memory");
    __syncthreads();
    if (threadIdx.x == 0) {
        unsigned* bar = b.bar;
        __builtin_amdgcn_s_waitcnt(0);
        unsigned nloc = b.st[0], nx = b.st[1];
        if (nloc == 0u) { xcd_barrier_complete(bar, b.x, nloc, nx); b.st[0] = nloc; b.st[1] = nx; }
        const unsigned old = xb_add(&bar[XB_XSUB(b.x)], 1u);
        const unsigned gen = old / nloc;
        if (old + 1u == (gen + 1u) * nloc) {
            __builtin_amdgcn_fence(__ATOMIC_RELEASE, "agent");
            asm volatile("s_waitcnt vmcnt(0)" ::: "memory");
            const unsigned og = xb_add(&bar[XB_TOP], 1u);
            const unsigned tg = og / nx;
            if (og + 1u == (tg + 1u) * nx) xb_add(&bar[XB_TOPGEN], 1u);
            else XB_SPIN(xb_ld(&bar[XB_TOPGEN]) == tg, bar);
            __builtin_amdgcn_fence(__ATOMIC_ACQUIRE, "agent");
            xb_add(&bar[XB_XGEN(b.x)], 1u);
            asm volatile("s_waitcnt vmcnt(0)" ::: "memory");
        } else {
            XB_SPIN(xb_ld(&bar[XB_XGEN(b.x)]) == gen, bar);
            __builtin_amdgcn_fence(__ATOMIC_ACQUIRE, "agent");
            asm volatile("s_waitcnt vmcnt(0)" ::: "memory");
        }
    }
    __syncthreads();
}

__device__ __forceinline__ float bf2f(unsigned v) { return __uint_as_float(v << 16); }
__device__ __forceinline__ float bflo(unsigned w) { return __uint_as_float(w << 16); }
__device__ __forceinline__ float bfhi(unsigned w) { return __uint_as_float(w & 0xffff0000u); }
__device__ __forceinline__ unsigned f2bf(float f) { unsigned u = __float_as_uint(f); u += 0x7fffu + ((u >> 16) & 1u); return u >> 16; }
__device__ __forceinline__ unsigned pk2(float lo, float hi) { return f2bf(lo) | (f2bf(hi) << 16); }
__device__ __forceinline__ float wave_sum(float v) {
#pragma unroll
    for (int o = 32; o > 0; o >>= 1) v += __shfl_xor(v, o);
    return v;
}
__device__ __forceinline__ float sigmoidf_(float x) { return 1.f / (1.f + expf(-x)); }
__device__ __forceinline__ float siluf_(float x) { return x / (1.f + expf(-x)); }
__device__ __forceinline__ float softplusf_(float x) { return x > 20.f ? x : log1pf(expf(x)); }
__device__ __forceinline__ void glds16(const void* g, void* l) {
    __builtin_amdgcn_global_load_lds((const GAS unsigned*)g, (LAS unsigned*)l, 16, 0, 0);
}
__device__ __forceinline__ void unpack8(const u32x4 r, float (&f)[8]) {
    f[0] = bflo(r.x); f[1] = bfhi(r.x); f[2] = bflo(r.y); f[3] = bfhi(r.y);
    f[4] = bflo(r.z); f[5] = bfhi(r.z); f[6] = bflo(r.w); f[7] = bfhi(r.w);
}

struct Args {
    const void* in[30];
    float* out;
    unsigned char* ws;
    int ph_lo, ph_hi, use_bar, pad;
};

struct Ctx { int tid, lane, wid, wr, wc, fr, fq, bid, nblk; unsigned char* smem; };

__device__ __forceinline__ void gemm_tile(const bf16_t* a0, const bf16_t* a1, const bf16_t* b0, const bf16_t* b1,
                                          int nk, f32x4 (&acc)[4][4], const Ctx& c) {
#pragma unroll
    for (int m = 0; m < 4; ++m)
#pragma unroll
        for (int n = 0; n < 4; ++n) acc[m][n] = (f32x4){0.f, 0.f, 0.f, 0.f};
    unsigned char* smem = c.smem;
    const int sb = c.tid * 16;
    {
        glds16(a0, smem + sb); glds16(a1, smem + 4096 + sb);
        glds16(b0, smem + 16384 + sb); glds16(b1, smem + 16384 + 4096 + sb);
    }
    for (int kt = 0; kt < nk; ++kt) {
        const int cur = kt & 1;
        asm volatile("s_waitcnt vmcnt(0)" ::: "memory");
        __syncthreads();
        if (kt + 1 < nk) {
            unsigned char* sa = smem + (cur ^ 1) * 8192; unsigned char* sbb = smem + 16384 + (cur ^ 1) * 8192;
            const int ko = (kt + 1) * 32;
            glds16(a0 + ko, sa + sb); glds16(a1 + ko, sa + 4096 + sb);
            glds16(b0 + ko, sbb + sb); glds16(b1 + ko, sbb + 4096 + sb);
        }
        const unsigned char* sa = smem + cur * 8192; const unsigned char* sbb = smem + 16384 + cur * 8192;
        bf16x8 af[4], bfr[4];
#pragma unroll
        for (int m = 0; m < 4; ++m) af[m] = *(const bf16x8*)(sa + (c.wr * 64 + m * 16 + c.fr) * 64 + c.fq * 16);
#pragma unroll
        for (int n = 0; n < 4; ++n) bfr[n] = *(const bf16x8*)(sbb + (c.wc * 64 + n * 16 + c.fr) * 64 + c.fq * 16);
#pragma unroll
        for (int m = 0; m < 4; ++m)
#pragma unroll
            for (int n = 0; n < 4; ++n) acc[m][n] = __builtin_amdgcn_mfma_f32_16x16x32_bf16(bfr[n], af[m], acc[m][n], 0, 0, 0);
    }
    __syncthreads();
}

__device__ void conv_family(const float* src, int nmat, size_t src_stride, int K, int N, int Nout,
                            bf16_t* dst, size_t dst_stride, int grp, int kind, const Ctx& c) {
    float* lds = (float*)c.smem;
    const int tk = K / 64, tn = Nout / 64, per = tk * tn, total = nmat * per;
    for (int u = c.bid; u < total; u += c.nblk) {
        const int mat = u / per, r = u % per, kt = r / tn, nt = r % tn;
        const int dmat = grp ? (mat / grp) * (grp + 1) + (mat % grp) : mat;
        const float* s = src + (size_t)mat * src_stride;
        bf16_t* d = dst + (size_t)dmat * dst_stride;
        const int k0 = kt * 64, n0 = nt * 64;
        const int tx = c.tid & 63, ty = c.tid >> 6;
#pragma unroll 4
        for (int i = 0; i < 16; ++i) {
            const int k = i * 4 + ty, n = n0 + tx;
            lds[k * 65 + tx] = (n < N) ? s[(size_t)(k0 + k) * N + n] : 0.f;
        }
        __syncthreads();
        const int nl = c.tid >> 2, kq = (c.tid & 3) * 16;
        unsigned w[8];
#pragma unroll
        for (int j = 0; j < 8; ++j) w[j] = pk2(lds[(kq + 2 * j) * 65 + nl], lds[(kq + 2 * j + 1) * 65 + nl]);
        const int n = n0 + nl;
        const int drow = (kind == 0) ? n : ((n >> 5) * 64 + (n & 31) + (kind == 2 ? 32 : 0));
        u32x4* dp = (u32x4*)(d + (size_t)drow * K + k0 + kq);
        dp[0] = (u32x4){w[0], w[1], w[2], w[3]};
        dp[1] = (u32x4){w[4], w[5], w[6], w[7]};
        __syncthreads();
    }
}

__device__ void phase_prologue(const Args& a, const Ctx& c) {
    unsigned char* ws = a.ws;
    bf16_t* WIN = (bf16_t*)(ws + WS_WIN);
    conv_family((const float*)a.in[2], 2, (size_t)1024 * 2472, 1024, 2472, NPAD, WIN, 2 * WIN_ELEMS, 0, 0, c);
    conv_family((const float*)a.in[12], 2, (size_t)1024 * 2312, 1024, 2312, NPAD, WIN + WIN_ELEMS, 2 * WIN_ELEMS, 0, 0, c);
    conv_family((const float*)a.in[4], 2, (size_t)256 * 768, 256, 768, 768, (bf16_t*)(ws + WS_WQB), WQB_ELEMS, 0, 0, c);
    conv_family((const float*)a.in[6], 2, (size_t)128 * 1024, 128, 1024, 1024, (bf16_t*)(ws + WS_WKVB), WKVB_ELEMS, 0, 0, c);
    bf16_t* WOUT = (bf16_t*)(ws + WS_WOUT);
    conv_family((const float*)a.in[11], 2, (size_t)1024 * 1024, 1024, 1024, 1024, WOUT, 2 * WOUT_ELEMS, 0, 0, c);
    conv_family((const float*)a.in[17], 2, (size_t)1024 * 1024, 1024, 1024, 1024, WOUT + WOUT_ELEMS, 2 * WOUT_ELEMS, 0, 0, c);
    conv_family((const float*)a.in[20], 4, (size_t)1024 * 64, 1024, 64, 128, (bf16_t*)(ws + WS_WRT), WRT_ELEMS, 0, 0, c);
    bf16_t* WGU = (bf16_t*)(ws + WS_WGU);
    conv_family((const float*)a.in[22], 256, (size_t)1024 * 256, 1024, 256, 256, WGU, WGU_ELEMS, 64, 1, c);
    conv_family((const float*)a.in[23], 256, (size_t)1024 * 256, 1024, 256, 256, WGU, WGU_ELEMS, 64, 2, c);
    conv_family((const float*)a.in[25], 4, (size_t)1024 * 256, 1024, 256, 256, WGU + 64 * WGU_ELEMS, 65 * WGU_ELEMS, 0, 1, c);
    conv_family((const float*)a.in[26], 4, (size_t)1024 * 256, 1024, 256, 256, WGU + 64 * WGU_ELEMS, 65 * WGU_ELEMS, 0, 2, c);
    bf16_t* WDN = (bf16_t*)(ws + WS_WDN);
    conv_family((const float*)a.in[24], 256, (size_t)256 * 1024, 256, 1024, 1024, WDN, WDN_ELEMS, 64, 0, c);
    conv_family((const float*)a.in[27], 4, (size_t)256 * 1024, 256, 1024, 1024, WDN + 64 * WDN_ELEMS, 65 * WDN_ELEMS, 0, 0, c);
    {
        const float* x = (const float*)a.in[0]; bf16_t* xb = (bf16_t*)(ws + WS_XBF);
        const size_t n8 = (size_t)T * 1024 / 8;
        for (size_t i = (size_t)c.bid * 256 + c.tid; i < n8; i += (size_t)c.nblk * 256) {
            const f32x4 v0 = *(const f32x4*)(x + i * 8), v1 = *(const f32x4*)(x + i * 8 + 4);
            *(u32x4*)(xb + i * 8) = (u32x4){pk2(v0[0], v0[1]), pk2(v0[2], v0[3]), pk2(v1[0], v1[1]), pk2(v1[2], v1[3])};
        }
    }
    {
        const int* pos = (const int*)a.in[1];
        float* rm = (float*)(ws + WS_ROPEM); float* rs = (float*)(ws + WS_ROPES);
        const float ln_theta = 9.210340371976184f;
        for (int i = c.bid * 256 + c.tid; i < T * 16; i += c.nblk * 256) {
            const int t = i >> 4, f = i & 15;
            const float inv = expf(-((float)(2 * f) / 32.f) * ln_theta);
            const float ang = (float)pos[t] * inv;
            rm[i * 2] = cosf(ang); rm[i * 2 + 1] = sinf(ang);
        }
        for (int i = c.bid * 256 + c.tid; i < T * 32; i += c.nblk * 256) {
            const int t = i >> 5, f = i & 31;
            const float inv = expf(-((float)(2 * f) / 64.f) * ln_theta);
            const float ang = (float)pos[t] * inv;
            rs[i * 2] = cosf(ang); rs[i * 2 + 1] = sinf(ang);
        }
    }
}

__device__ void phase_inproj(const bf16_t* XBF, const bf16_t* W, bf16_t* PROJ, float* GATES, int gbase, const Ctx& c) {
    const int ntn = NPAD / 128, total = (T / 128) * ntn;
    for (int u = c.bid; u < total; u += c.nblk) {
        const int mt = u / ntn, nt = u % ntn;
        const bf16_t* a0 = XBF + (size_t)(mt * 128 + (c.tid >> 2)) * 1024 + (c.tid & 3) * 8;
        const bf16_t* b0 = W + (size_t)(nt * 128 + (c.tid >> 2)) * 1024 + (c.tid & 3) * 8;
        f32x4 acc[4][4];
        gemm_tile(a0, a0 + 64 * 1024, b0, b0 + 64 * 1024, 32, acc, c);
#pragma unroll
        for (int m = 0; m < 4; ++m) {
            const int row = mt * 128 + c.wr * 64 + m * 16 + c.fr;
#pragma unroll
            for (int n = 0; n < 4; ++n) {
                const int col = nt * 128 + c.wc * 64 + n * 16 + c.fq * 4;
                const f32x4 v = acc[m][n];
                *(u32x2*)(PROJ + (size_t)row * NPAD + col) = (u32x2){pk2(v[0], v[1]), pk2(v[2], v[3])};
                if (col >= gbase && col < gbase + 8) *(f32x4*)(GATES + (size_t)row * 8 + (col - gbase)) = v;
            }
        }
    }
}

__device__ void phase_mla_up(const bf16_t* CQ, const bf16_t* WQB, const bf16_t* CKV, const bf16_t* WKVB,
                             const float* ROPEM, bf16_t* QF, bf16_t* KN, bf16_t* VV, const Ctx& c) {
    const int tq = (T / 128) * 6, tkv = (T / 128) * 8;
    const float qscale = 0.10206207261596577f;
    for (int u = c.bid; u < tq + tkv; u += c.nblk) {
        f32x4 acc[4][4];
        if (u < tq) {
            const int mt = u / 6, nt = u % 6;
            const bf16_t* a0 = CQ + (size_t)(mt * 128 + (c.tid >> 2)) * 256 + (c.tid & 3) * 8;
            const bf16_t* b0 = WQB + (size_t)(nt * 128 + (c.tid >> 2)) * 256 + (c.tid & 3) * 8;
            gemm_tile(a0, a0 + 64 * 256, b0, b0 + 64 * 256, 8, acc, c);
#pragma unroll
            for (int m = 0; m < 4; ++m) {
                const int row = mt * 128 + c.wr * 64 + m * 16 + c.fr;
#pragma unroll
                for (int np = 0; np < 2; ++np) {
                    const int cg = nt * 128 + c.wc * 64 + np * 32;
                    f32x4 v0 = acc[m][2 * np], v1 = acc[m][2 * np + 1];
                    if (((cg >> 5) % 3) == 2) {
#pragma unroll
                        for (int j = 0; j < 4; ++j) {
                            const int i = c.fq * 4 + j;
                            const float cs = ROPEM[((size_t)row * 16 + i) * 2], sn = ROPEM[((size_t)row * 16 + i) * 2 + 1];
                            const float x1 = v0[j], x2 = v1[j];
                            v0[j] = x1 * cs - x2 * sn; v1[j] = x2 * cs + x1 * sn;
                        }
                    }
                    v0 *= qscale; v1 *= qscale;
                    *(u32x2*)(QF + (size_t)row * 768 + cg + c.fq * 4) = (u32x2){pk2(v0[0], v0[1]), pk2(v0[2], v0[3])};
                    *(u32x2*)(QF + (size_t)row * 768 + cg + 16 + c.fq * 4) = (u32x2){pk2(v1[0], v1[1]), pk2(v1[2], v1[3])};
                }
            }
        } else {
            const int v = u - tq, mt = v / 8, nt = v % 8;
            const bf16_t* a0 = CKV + (size_t)(mt * 128 + (c.tid >> 2)) * 128 + (c.tid & 3) * 8;
            const bf16_t* b0 = WKVB + (size_t)(nt * 128 + (c.tid >> 2)) * 128 + (c.tid & 3) * 8;
            gemm_tile(a0, a0 + 64 * 128, b0, b0 + 64 * 128, 4, acc, c);
            bf16_t* dst = (c.wc == 0) ? KN : VV;
#pragma unroll
            for (int m = 0; m < 4; ++m) {
                const int row = mt * 128 + c.wr * 64 + m * 16 + c.fr;
#pragma unroll
                for (int n = 0; n < 4; ++n) {
                    const f32x4 x = acc[m][n];
                    *(u32x2*)(dst + (size_t)row * 512 + nt * 64 + n * 16 + c.fq * 4) = (u32x2){pk2(x[0], x[1]), pk2(x[2], x[3])};
                }
            }
        }
    }
}

__device__ void phase_outproj(const bf16_t* MIXO, const bf16_t* W, const float* xres, float* YBUF, const Ctx& c) {
    const int total = (T / 128) * 8;
    for (int u = c.bid; u < total; u += c.nblk) {
        const int mt = u / 8, nt = u % 8;
        const bf16_t* a0 = MIXO + (size_t)(mt * 128 + (c.tid >> 2)) * 1024 + (c.tid & 3) * 8;
        const bf16_t* b0 = W + (size_t)(nt * 128 + (c.tid >> 2)) * 1024 + (c.tid & 3) * 8;
        f32x4 acc[4][4];
        gemm_tile(a0, a0 + 64 * 1024, b0, b0 + 64 * 1024, 32, acc, c);
#pragma unroll
        for (int m = 0; m < 4; ++m) {
            const int row = mt * 128 + c.wr * 64 + m * 16 + c.fr;
#pragma unroll
            for (int n = 0; n < 4; ++n) {
                const int col = nt * 128 + c.wc * 64 + n * 16 + c.fq * 4;
                const f32x4 xr = *(const f32x4*)(xres + (size_t)row * 1024 + col);
                *(f32x4*)(YBUF + (size_t)row * 1024 + col) = xr * ALPHA + acc[m][n];
            }
        }
    }
}

__device__ void phase_router(const bf16_t* XBF, const bf16_t* W, float* LOG, const Ctx& c) {
    for (int mt = c.bid; mt < T / 128; mt += c.nblk) {
        const bf16_t* a0 = XBF + (size_t)(mt * 128 + (c.tid >> 2)) * 1024 + (c.tid & 3) * 8;
        const bf16_t* b0 = W + (size_t)(c.tid >> 2) * 1024 + (c.tid & 3) * 8;
        f32x4 acc[4][4];
        gemm_tile(a0, a0 + 64 * 1024, b0, b0 + 64 * 1024, 32, acc, c);
        if (c.wc == 0) {
#pragma unroll
            for (int m = 0; m < 4; ++m) {
                const int row = mt * 128 + c.wr * 64 + m * 16 + c.fr;
#pragma unroll
                for (int n = 0; n < 4; ++n) *(f32x4*)(LOG + (size_t)row * 64 + n * 16 + c.fq * 4) = acc[m][n];
            }
        }
    }
}

__device__ __forceinline__ void build_block_table(const unsigned* CNT, int* bst, const Ctx& c) {
    __syncthreads();
    if (c.tid == 0) {
        int s = 0;
        for (int e = 0; e < 65; ++e) {
            const int cnt = (e < 64) ? (int)__hip_atomic_load(CNT + e, __ATOMIC_RELAXED, __HIP_MEMORY_SCOPE_AGENT) : T;
            bst[e] = s; bst[66 + e] = cnt; s += (cnt + 127) >> 7;
        }
        bst[65] = s;
    }
    __syncthreads();
}
__device__ __forceinline__ int find_expert(const int* bst, int rb) {
    int e = 0;
    for (int i = 1; i < 65; ++i) e += (bst[i] <= rb) ? 1 : 0;
    return e;
}

__device__ void phase_moe1(const bf16_t* XBF, const bf16_t* WGU, const unsigned* CNT, const int* LTOK, bf16_t* HBUF, const Ctx& c) {
    int* bst = (int*)(c.smem + 32768);
    build_block_table(CNT, bst, c);
    const int total = bst[65] * 4;
    for (int u = c.bid; u < total; u += c.nblk) {
        const int rb = u >> 2, nt = u & 3;
        const int e = find_expert(bst, rb);
        const int lb = rb - bst[e], cnt = bst[66 + e];
        const int p0 = lb * 128 + (c.tid >> 2), p1 = p0 + 64;
        const int t0 = (p0 < cnt) ? LTOK[(size_t)e * CAP + p0] : 0;
        const int t1 = (p1 < cnt) ? LTOK[(size_t)e * CAP + p1] : 0;
        const bf16_t* a0 = XBF + (size_t)t0 * 1024 + (c.tid & 3) * 8;
        const bf16_t* a1 = XBF + (size_t)t1 * 1024 + (c.tid & 3) * 8;
        const bf16_t* b0 = WGU + (size_t)e * WGU_ELEMS + (size_t)(nt * 128 + (c.tid >> 2)) * 1024 + (c.tid & 3) * 8;
        f32x4 acc[4][4];
        gemm_tile(a0, a1, b0, b0 + 64 * 1024, 32, acc, c);
#pragma unroll
        for (int m = 0; m < 4; ++m) {
            const size_t crow = (size_t)rb * 128 + c.wr * 64 + m * 16 + c.fr;
#pragma unroll
            for (int n = 0; n < 2; ++n) {
                const f32x4 g = acc[m][n], up = acc[m][n + 2];
                float h[4];
#pragma unroll
                for (int j = 0; j < 4; ++j) h[j] = siluf_(g[j]) * up[j];
                *(u32x2*)(HBUF + crow * 256 + nt * 64 + c.wc * 32 + n * 16 + c.fq * 4) = (u32x2){pk2(h[0], h[1]), pk2(h[2], h[3])};
            }
        }
    }
}

__device__ void phase_moe2(const bf16_t* HBUF, const bf16_t* WDN, const unsigned* CNT, const float* LW, bf16_t* Y, const Ctx& c) {
    int* bst = (int*)(c.smem + 32768);
    build_block_table(CNT, bst, c);
    const int total = bst[65] * 8;
    for (int u = c.bid; u < total; u += c.nblk) {
        const int rb = u >> 3, nt = u & 7;
        const int e = find_expert(bst, rb);
        const int lb = rb - bst[e], cnt = bst[66 + e];
        const bf16_t* a0 = HBUF + ((size_t)rb * 128 + (c.tid >> 2)) * 256 + (c.tid & 3) * 8;
        const bf16_t* b0 = WDN + (size_t)e * WDN_ELEMS + (size_t)(nt * 128 + (c.tid >> 2)) * 256 + (c.tid & 3) * 8;
        f32x4 acc[4][4];
        gemm_tile(a0, a0 + 64 * 256, b0, b0 + 64 * 256, 8, acc, c);
#pragma unroll
        for (int m = 0; m < 4; ++m) {
            const int lr = c.wr * 64 + m * 16 + c.fr;
            const int p = lb * 128 + lr;
            const float w = (p < cnt) ? LW[(size_t)e * CAP + p] : 0.f;
            const size_t crow = (size_t)rb * 128 + lr;
#pragma unroll
            for (int n = 0; n < 4; ++n) {
                const f32x4 v = acc[m][n] * w;
                *(u32x2*)(Y + crow * 1024 + nt * 128 + c.wc * 64 + n * 16 + c.fq * 4) = (u32x2){pk2(v[0], v[1]), pk2(v[2], v[3])};
            }
        }
    }
}

__device__ __forceinline__ void ln_row_store(float (&v)[16], const float* g, const float* b, float* of32, bf16_t* obf, int lane) {
    float s = 0.f;
#pragma unroll
    for (int i = 0; i < 16; ++i) s += v[i];
    const float mean = wave_sum(s) * (1.f / 1024.f);
    float q = 0.f;
#pragma unroll
    for (int i = 0; i < 16; ++i) { v[i] -= mean; q += v[i] * v[i]; }
    const float rstd = rsqrtf(wave_sum(q) * (1.f / 1024.f) + 1e-5f);
#pragma unroll
    for (int hf = 0; hf < 2; ++hf) {
        const int col = hf * 512 + lane * 8;
        const f32x4 g0 = *(const f32x4*)(g + col), g1 = *(const f32x4*)(g + col + 4);
        const f32x4 b0 = *(const f32x4*)(b + col), b1 = *(const f32x4*)(b + col + 4);
        f32x4 y0, y1;
#pragma unroll
        for (int j = 0; j < 4; ++j) { y0[j] = v[hf * 8 + j] * rstd * g0[j] + b0[j]; y1[j] = v[hf * 8 + 4 + j] * rstd * g1[j] + b1[j]; }
        *(f32x4*)(of32 + col) = y0; *(f32x4*)(of32 + col + 4) = y1;
        *(u32x4*)(obf + col) = (u32x4){pk2(y0[0], y0[1]), pk2(y0[2], y0[3]), pk2(y1[0], y1[1]), pk2(y1[2], y1[3])};
    }
}

__device__ void phase_ln1(const float* YBUF, const float* g, const float* b, float* X1, bf16_t* XBF, const Ctx& c) {
    for (int t = c.bid * 4 + c.wid; t < T; t += c.nblk * 4) {
        float v[16];
#pragma unroll
        for (int hf = 0; hf < 2; ++hf) {
            const float* p = YBUF + (size_t)t * 1024 + hf * 512 + c.lane * 8;
            const f32x4 a0 = *(const f32x4*)p, a1 = *(const f32x4*)(p + 4);
#pragma unroll
            for (int j = 0; j < 4; ++j) { v[hf * 8 + j] = a0[j]; v[hf * 8 + 4 + j] = a1[j]; }
        }
        ln_row_store(v, g, b, X1 + (size_t)t * 1024, XBF + (size_t)t * 1024, c.lane);
    }
}

__device__ void phase_combine(const float* X1, const bf16_t* Y, const int* ASG, const unsigned* CNT, const float* g, const float* b,
                              float* XOUT, bf16_t* XBF, const Ctx& c) {
    int* bst = (int*)(c.smem + 32768);
    build_block_table(CNT, bst, c);
    for (int t = c.bid * 4 + c.wid; t < T; t += c.nblk * 4) {
        float v[16];
#pragma unroll
        for (int hf = 0; hf < 2; ++hf) {
            const float* p = X1 + (size_t)t * 1024 + hf * 512 + c.lane * 8;
            const f32x4 a0 = *(const f32x4*)p, a1 = *(const f32x4*)(p + 4);
#pragma unroll
            for (int j = 0; j < 4; ++j) { v[hf * 8 + j] = a0[j] * ALPHA; v[hf * 8 + 4 + j] = a1[j] * ALPHA; }
        }
#pragma unroll
        for (int k = 0; k < 9; ++k) {
            size_t crow;
            if (k < 8) { const int asg = ASG[(size_t)t * 8 + k]; crow = (size_t)bst[asg >> 16] * 128 + (asg & 0xffff); }
            else crow = (size_t)bst[64] * 128 + t;
#pragma unroll
            for (int hf = 0; hf < 2; ++hf) {
                const u32x4 r = *(const u32x4*)(Y + crow * 1024 + hf * 512 + c.lane * 8);
                float f[8]; unpack8(r, f);
#pragma unroll
                for (int j = 0; j < 8; ++j) v[hf * 8 + j] += f[j];
            }
        }
        ln_row_store(v, g, b, XOUT + (size_t)t * 1024, XBF + (size_t)t * 1024, c.lane);
    }
}

__device__ void phase_route(const float* LOG, const float* rb, unsigned* CNT, int* LTOK, float* LW, int* ASG, const Ctx& c) {
    int* lcnt = (int*)c.smem;
    int* lbase = lcnt + 64;
    int* sel_e = lbase + 64;
    int* sel_p = sel_e + 256;
    float* sel_w = (float*)(sel_p + 256);
    const float rbias = rb[c.lane];
    for (int ch = c.bid; ch < T / 32; ch += c.nblk) {
        __syncthreads();
        if (c.tid < 64) lcnt[c.tid] = 0;
        __syncthreads();
        for (int tl = c.wid; tl < 32; tl += 4) {
            const int t = ch * 32 + tl;
            const float lg = LOG[(size_t)t * 64 + c.lane];
            const float sc = 1.f / (1.f + expf(-lg));
            const float v = sc + rbias;
            float m1 = v;
            m1 = fmaxf(m1, __shfl_xor(m1, 1)); m1 = fmaxf(m1, __shfl_xor(m1, 2)); m1 = fmaxf(m1, __shfl_xor(m1, 4));
            int cand = (v == m1) ? c.lane : 999;
            cand = min(cand, __shfl_xor(cand, 1)); cand = min(cand, __shfl_xor(cand, 2)); cand = min(cand, __shfl_xor(cand, 4));
            float m2 = (c.lane == cand) ? -INFINITY : v;
            m2 = fmaxf(m2, __shfl_xor(m2, 1)); m2 = fmaxf(m2, __shfl_xor(m2, 2)); m2 = fmaxf(m2, __shfl_xor(m2, 4));
            const float gs = m1 + m2;
            const int g = c.lane >> 3;
            int grank = 0;
#pragma unroll
            for (int gg = 0; gg < 8; ++gg) { const float o = __shfl(gs, gg * 8); grank += ((o > gs) || (o == gs && gg < g)) ? 1 : 0; }
            const bool gsel = grank < 4;
            const float mv = gsel ? v : -INFINITY;
            int rank = 0;
#pragma unroll 8
            for (int jj = 0; jj < 64; ++jj) { const float o = __shfl(mv, jj); rank += ((o > mv) || (o == mv && jj < c.lane)) ? 1 : 0; }
            const bool sel = gsel && rank < 8;
            const float ssum = wave_sum(sel ? sc : 0.f);
            const float w = sc / ssum * 2.5f;
            const unsigned long long bal = __ballot(sel);
            const int slot = __popcll(bal & ((1ull << c.lane) - 1ull));
            if (sel) {
                const int p = atomicAdd(&lcnt[c.lane], 1);
                sel_e[tl * 8 + slot] = c.lane; sel_p[tl * 8 + slot] = p; sel_w[tl * 8 + slot] = w;
            }
        }
        __syncthreads();
        if (c.tid < 64) { const int n = lcnt[c.tid]; lbase[c.tid] = n ? (int)atomicAdd(CNT + c.tid, (unsigned)n) : 0; }
        __syncthreads();
        {
            const int tl = c.tid >> 3, t = ch * 32 + tl;
            const int e = sel_e[c.tid], pos = lbase[e] + sel_p[c.tid];
            LTOK[(size_t)e * CAP + pos] = t; LW[(size_t)e * CAP + pos] = sel_w[c.tid];
            ASG[(size_t)t * 8 + (c.tid & 7)] = (e << 16) | pos;
            if (c.tid < 32) { const int ts = ch * 32 + c.tid; LTOK[(size_t)64 * CAP + ts] = ts; LW[(size_t)64 * CAP + ts] = 1.f; }
        }
    }
}

__device__ void phase_prep_even(const bf16_t* PROJ, const float* GATES, const float* qn, const float* kvn, const float* cw,
                                const float* a_log, const float* dt_bias, const float* ROPEM,
                                bf16_t* CQ, bf16_t* CKV, bf16_t* KROPE, bf16_t* GQ, bf16_t* GK, bf16_t* GV, float* BETA, float* GLOG, const Ctx& c) {
    const int lane = c.lane;
    for (int t = c.bid * 4 + c.wid; t < T; t += c.nblk * 4) {
        const bf16_t* pr = PROJ + (size_t)t * NPAD;
        {
            const u32x2 r = *(const u32x2*)(pr + lane * 4);
            float v[4] = {bflo(r.x), bfhi(r.x), bflo(r.y), bfhi(r.y)};
            const float ss = wave_sum(v[0] * v[0] + v[1] * v[1] + v[2] * v[2] + v[3] * v[3]);
            const float rr = rsqrtf(ss * (1.f / 256.f) + 1e-6f);
            const f32x4 gq = *(const f32x4*)(qn + lane * 4);
            *(u32x2*)(CQ + (size_t)t * 256 + lane * 4) = (u32x2){pk2(v[0] * rr * gq[0], v[1] * rr * gq[1]), pk2(v[2] * rr * gq[2], v[3] * rr * gq[3])};
        }
        {
            const unsigned r = *(const unsigned*)(pr + 256 + lane * 2);
            const float v0 = bflo(r), v1 = bfhi(r);
            const float ss = wave_sum(v0 * v0 + v1 * v1);
            const float rr = rsqrtf(ss * (1.f / 128.f) + 1e-6f);
            *(unsigned*)(CKV + (size_t)t * 128 + lane * 2) = pk2(v0 * rr * kvn[lane * 2], v1 * rr * kvn[lane * 2 + 1]);
        }
        if (lane < 16) {
            const float x1 = bf2f(pr[384 + lane]), x2 = bf2f(pr[400 + lane]);
            const float cs = ROPEM[((size_t)t * 16 + lane) * 2], sn = ROPEM[((size_t)t * 16 + lane) * 2 + 1];
            KROPE[(size_t)t * 32 + lane] = (bf16_t)f2bf(x1 * cs - x2 * sn);
            KROPE[(size_t)t * 32 + 16 + lane] = (bf16_t)f2bf(x2 * cs + x1 * sn);
        }
        const int s = t & (SEQ - 1);
#pragma unroll 1
        for (int hg = 0; hg < 12; ++hg) {
            const int chn = hg * 128 + lane * 2;
            float a0 = 0.f, a1 = 0.f;
#pragma unroll
            for (int w = 0; w < 4; ++w) {
                if (s - 3 + w >= 0) {
                    const unsigned r = *(const unsigned*)(PROJ + (size_t)(t - 3 + w) * NPAD + 416 + chn);
                    a0 += cw[w * 1536 + chn] * bflo(r); a1 += cw[w * 1536 + chn + 1] * bfhi(r);
                }
            }
            float y0 = siluf_(a0), y1 = siluf_(a1);
            if (hg < 8) {
                const float ss = wave_sum(y0 * y0 + y1 * y1);
                float rr = rsqrtf(ss + 1e-6f);
                if (hg < 4) rr *= 0.08838834764831845f;
                y0 *= rr; y1 *= rr;
            }
            bf16_t* dst = (hg < 4) ? GQ : (hg < 8) ? GK : GV;
            *(unsigned*)(dst + (size_t)t * 512 + (hg & 3) * 128 + lane * 2) = pk2(y0, y1);
        }
        if (lane < 4) BETA[(size_t)t * 4 + lane] = sigmoidf_(GATES[(size_t)t * 8 + lane]);
        else if (lane < 8) { const int h = lane - 4; GLOG[(size_t)t * 4 + h] = -expf(a_log[h]) * softplusf_(GATES[(size_t)t * 8 + lane] + dt_bias[h]); }
    }
}

__device__ void phase_prep_odd(const bf16_t* PROJ, const float* ROPES, bf16_t* SQ, bf16_t* SK, const Ctx& c) {
    const int lane = c.lane;
    for (int t = c.bid * 4 + c.wid; t < T; t += c.nblk * 4) {
        const bf16_t* pr = PROJ + (size_t)t * NPAD;
        const int i = lane & 31;
        const float cs = ROPES[((size_t)t * 32 + i) * 2], sn = ROPES[((size_t)t * 32 + i) * 2 + 1];
#pragma unroll
        for (int r = 0; r < 4; ++r) {
            const int h = (lane >> 5) + 2 * r;
            const float x1 = bf2f(pr[1544 + h * 64 + i]), x2 = bf2f(pr[1544 + h * 64 + 32 + i]);
            SQ[(size_t)t * 512 + h * 64 + i] = (bf16_t)f2bf((x1 * cs - x2 * sn) * 0.125f);
            SQ[(size_t)t * 512 + h * 64 + 32 + i] = (bf16_t)f2bf((x2 * cs + x1 * sn) * 0.125f);
        }
        {
            const int h = lane >> 5;
            const float x1 = bf2f(pr[2056 + h * 64 + i]), x2 = bf2f(pr[2056 + h * 64 + 32 + i]);
            SK[(size_t)t * 128 + h * 64 + i] = (bf16_t)f2bf(x1 * cs - x2 * sn);
            SK[(size_t)t * 128 + h * 64 + 32 + i] = (bf16_t)f2bf(x2 * cs + x1 * sn);
        }
    }
}

__device__ __forceinline__ int next_unit(unsigned* ctr, const Ctx& c) {
    volatile int* su = (volatile int*)(c.smem + 65536 + 16);
    __syncthreads();
    if (c.tid == 0) *su = (int)atomicAdd(ctr, 1u);
    __syncthreads();
    return *su;
}

__device__ void mla_unit(int u, const bf16_t* QF, const bf16_t* KN, const bf16_t* KROPE, const bf16_t* VV, bf16_t* MIXO, const Ctx& c) {
    const int qb = 7 - (u >> 6), bh = u & 63, b = bh >> 3, h = bh & 7;
    const int s = qb * 256 + c.tid;
    const size_t t = (size_t)b * SEQ + s;
    float* tile = (float*)c.smem;
    float q[96], o[64];
#pragma unroll
    for (int i = 0; i < 12; ++i) {
        const u32x4 r = *(const u32x4*)(QF + t * 768 + h * 96 + i * 8);
        float f[8]; unpack8(r, f);
#pragma unroll
        for (int j = 0; j < 8; ++j) q[i * 8 + j] = f[j];
    }
#pragma unroll
    for (int i = 0; i < 64; ++i) o[i] = 0.f;
    float m = -1e30f, l = 0.f;
    const int nkt = (qb + 1) * 8;
    for (int kt = 0; kt < nkt; ++kt) {
        __syncthreads();
        for (int idx = c.tid; idx < 640; idx += 256) {
            const int key = idx / 20, chk = idx % 20;
            const size_t tk = (size_t)b * SEQ + kt * 32 + key;
            const bf16_t* src = (chk < 8) ? (KN + tk * 512 + h * 64 + chk * 8) : (chk < 12) ? (KROPE + tk * 32 + (chk - 8) * 8) : (VV + tk * 512 + h * 64 + (chk - 12) * 8);
            const u32x4 r = *(const u32x4*)src;
            float f[8]; unpack8(r, f);
            float* d = tile + key * 160 + chk * 8;
            *(f32x4*)d = (f32x4){f[0], f[1], f[2], f[3]}; *(f32x4*)(d + 4) = (f32x4){f[4], f[5], f[6], f[7]};
        }
        __syncthreads();
#pragma unroll 1
        for (int j = 0; j < 32; ++j) {
            const int key = kt * 32 + j;
            if (key <= s) {
                const float* kr = tile + j * 160;
                float sc = 0.f;
#pragma unroll
                for (int i = 0; i < 96; ++i) sc += q[i] * kr[i];
                const float mn = fmaxf(m, sc);
                const float al = __expf(m - mn), p = __expf(sc - mn);
                l = l * al + p;
#pragma unroll
                for (int i = 0; i < 64; ++i) o[i] = o[i] * al + p * kr[96 + i];
                m = mn;
            }
        }
    }
    const float inv = 1.f / l;
#pragma unroll
    for (int i = 0; i < 8; ++i)
        *(u32x4*)(MIXO + t * 1024 + h * 64 + i * 8) = (u32x4){pk2(o[i * 8] * inv, o[i * 8 + 1] * inv), pk2(o[i * 8 + 2] * inv, o[i * 8 + 3] * inv),
                                                             pk2(o[i * 8 + 4] * inv, o[i * 8 + 5] * inv), pk2(o[i * 8 + 6] * inv, o[i * 8 + 7] * inv)};
}

__device__ void gdn_unit(int u, const bf16_t* GQ, const bf16_t* GK, const bf16_t* GV, const float* BETA, const float* GLOG,
                         const bf16_t* PROJ, const float* gnorm, bf16_t* MIXO, const Ctx& c) {
    const int b = u >> 2, h = u & 3;
    float* kf = (float*)c.smem; float* qf = kf + 16 * 128; float* vf = qf + 16 * 128; float* ob = vf + 16 * 128;
    float* bt = ob + 16 * 128; float* av = bt + 16;
    float S[64];
#pragma unroll
    for (int i = 0; i < 64; ++i) S[i] = 0.f;
    const int j = c.wid * 32 + (c.lane & 31), half = c.lane >> 5;
    for (int c0 = 0; c0 < SEQ; c0 += 16) {
        const size_t t0 = (size_t)b * SEQ + c0;
        __syncthreads();
#pragma unroll
        for (int i = 0; i < 3; ++i) {
            const int idx = c.tid + 256 * i, arr = idx >> 8, r = idx & 255, tok = r >> 4, chk = r & 15;
            const bf16_t* src = ((arr == 0) ? GK : (arr == 1) ? GQ : GV) + (t0 + tok) * 512 + h * 128 + chk * 8;
            const u32x4 rr = *(const u32x4*)src;
            float f[8]; unpack8(rr, f);
            float* d = kf + arr * 2048 + tok * 128 + chk * 8;
            *(f32x4*)d = (f32x4){f[0], f[1], f[2], f[3]}; *(f32x4*)(d + 4) = (f32x4){f[4], f[5], f[6], f[7]};
        }
        if (c.tid < 16) { bt[c.tid] = BETA[(t0 + c.tid) * 4 + h]; av[c.tid] = expf(GLOG[(t0 + c.tid) * 4 + h]); }
        __syncthreads();
#pragma unroll 1
        for (int tt = 0; tt < 16; ++tt) {
            const float* kr = kf + tt * 128 + half * 64; const float* qr = qf + tt * 128 + half * 64;
            const float a = av[tt];
            float kS = 0.f;
#pragma unroll
            for (int i = 0; i < 64; ++i) kS += kr[i] * S[i];
            kS += __shfl_xor(kS, 32);
            const float vn = bt[tt] * (vf[tt * 128 + j] - a * kS);
            float o = 0.f;
#pragma unroll
            for (int i = 0; i < 64; ++i) { S[i] = a * S[i] + kr[i] * vn; o += qr[i] * S[i]; }
            o += __shfl_xor(o, 32);
            if (half == 0) ob[tt * 128 + j] = o;
        }
        __syncthreads();
#pragma unroll
        for (int k = 0; k < 4; ++k) {
            const int tt = c.wid * 4 + k;
            const float o0 = ob[tt * 128 + c.lane * 2], o1 = ob[tt * 128 + c.lane * 2 + 1];
            const float rr = rsqrtf(wave_sum(o0 * o0 + o1 * o1) * (1.f / 128.f) + 1e-6f);
            const unsigned zr = *(const unsigned*)(PROJ + (t0 + tt) * NPAD + 1960 + h * 128 + c.lane * 2);
            const float y0 = o0 * rr * gnorm[c.lane * 2] * siluf_(bflo(zr)), y1 = o1 * rr * gnorm[c.lane * 2 + 1] * siluf_(bfhi(zr));
            *(unsigned*)(MIXO + (t0 + tt) * 1024 + 512 + h * 128 + c.lane * 2) = pk2(y0, y1);
        }
    }
}

__device__ void mlstm_unit(int u, const bf16_t* PROJ, const float* GATES, const float* b_i, const float* b_f, const float* mnorm, bf16_t* MIXO, const Ctx& c) {
    const int b = u >> 2, h = u & 3;
    float* kf = (float*)c.smem; float* qf = kf + 16 * 64; float* vf = qf + 16 * 64; float* ob = vf + 16 * 128;
    float* ip = ob + 16 * 128; float* lf = ip + 16;
    float C[32], nn[32];
#pragma unroll
    for (int i = 0; i < 32; ++i) { C[i] = 0.f; nn[i] = 0.f; }
    float mst = 0.f;
    const int j = c.wid * 32 + (c.lane & 31), half = c.lane >> 5;
    const float bi = b_i[h], bfv = b_f[h];
    for (int c0 = 0; c0 < SEQ; c0 += 16) {
        const size_t t0 = (size_t)b * SEQ + c0;
        __syncthreads();
        {
            const int idx = c.tid;
            if (idx < 128) { const int tok = idx >> 3, chk = idx & 7;
                const u32x4 rr = *(const u32x4*)(PROJ + (t0 + tok) * NPAD + 256 + h * 64 + chk * 8); float f[8]; unpack8(rr, f);
                float* d = kf + tok * 64 + chk * 8; *(f32x4*)d = (f32x4){f[0], f[1], f[2], f[3]}; *(f32x4*)(d + 4) = (f32x4){f[4], f[5], f[6], f[7]}; }
            else { const int i2 = idx - 128, tok = i2 >> 3, chk = i2 & 7;
                const u32x4 rr = *(const u32x4*)(PROJ + (t0 + tok) * NPAD + h * 64 + chk * 8); float f[8]; unpack8(rr, f);
                float* d = qf + tok * 64 + chk * 8; *(f32x4*)d = (f32x4){f[0], f[1], f[2], f[3]}; *(f32x4*)(d + 4) = (f32x4){f[4], f[5], f[6], f[7]}; }
            { const int tok = idx >> 4, chk = idx & 15;
                const u32x4 rr = *(const u32x4*)(PROJ + (t0 + tok) * NPAD + 512 + h * 128 + chk * 8); float f[8]; unpack8(rr, f);
                float* d = vf + tok * 128 + chk * 8; *(f32x4*)d = (f32x4){f[0], f[1], f[2], f[3]}; *(f32x4*)(d + 4) = (f32x4){f[4], f[5], f[6], f[7]}; }
            if (idx < 16) { ip[idx] = GATES[(t0 + idx) * 8 + h] + bi; lf[idx] = -softplusf_(-(GATES[(t0 + idx) * 8 + 4 + h] + bfv)); }
        }
        __syncthreads();
#pragma unroll 1
        for (int tt = 0; tt < 16; ++tt) {
            const float* kr = kf + tt * 64 + half * 32; const float* qr = qf + tt * 64 + half * 32;
            const float mn = fmaxf(lf[tt] + mst, ip[tt]);
            const float fs = expf(lf[tt] + mst - mn), is = expf(ip[tt] - mn) * 0.125f;
            mst = mn;
            const float vj = vf[tt * 128 + j] * is;
            float num = 0.f, den = 0.f;
#pragma unroll
            for (int i = 0; i < 32; ++i) {
                C[i] = fs * C[i] + kr[i] * vj; nn[i] = fs * nn[i] + kr[i] * is;
                num += qr[i] * C[i]; den += qr[i] * nn[i];
            }
            num += __shfl_xor(num, 32); den += __shfl_xor(den, 32);
            if (half == 0) ob[tt * 128 + j] = num / fmaxf(fabsf(den), expf(-mn));
        }
        __syncthreads();
#pragma unroll
        for (int k = 0; k < 4; ++k) {
            const int tt = c.wid * 4 + k;
            const float o0 = ob[tt * 128 + c.lane * 2], o1 = ob[tt * 128 + c.lane * 2 + 1];
            const float rr = rsqrtf(wave_sum(o0 * o0 + o1 * o1) * (1.f / 128.f) + 1e-6f);
            const unsigned zr = *(const unsigned*)(PROJ + (t0 + tt) * NPAD + 1032 + h * 128 + c.lane * 2);
            const float y0 = o0 * rr * mnorm[h * 128 + c.lane * 2] * sigmoidf_(bflo(zr)), y1 = o1 * rr * mnorm[h * 128 + c.lane * 2 + 1] * sigmoidf_(bfhi(zr));
            *(unsigned*)(MIXO + (t0 + tt) * 1024 + h * 128 + c.lane * 2) = pk2(y0, y1);
        }
    }
}

__device__ void swa_unit(int u, const bf16_t* SQ, const bf16_t* SK, const bf16_t* PROJ, const float* sinks, bf16_t* MIXO, const Ctx& c) {
    const int half = u & 1, n = (u >> 1) & 15, kvh = (u >> 5) & 1, b = u >> 6;
    bf16_t* Kb = (bf16_t*)c.smem; bf16_t* Vb = Kb + 256 * 64;
    const int kstart = (n - 1) * 128;
    __syncthreads();
    for (int idx = c.tid; idx < 4096; idx += 256) {
        const int arr = idx >> 11, r = idx & 2047, kj = r >> 3, chk = r & 7;
        const int kpos = kstart + kj;
        u32x4 v = (u32x4){0u, 0u, 0u, 0u};
        if (kpos >= 0) {
            const size_t tk = (size_t)b * SEQ + kpos;
            v = arr ? *(const u32x4*)(PROJ + tk * NPAD + 2184 + kvh * 64 + chk * 8) : *(const u32x4*)(SK + tk * 128 + kvh * 64 + chk * 8);
        }
        *(u32x4*)((arr ? Vb : Kb) + kj * 64 + chk * 8) = v;
    }
    __syncthreads();
    const int qi = c.tid & 127, g = half * 2 + (c.tid >> 7), hq = kvh * 4 + g;
    const size_t t = (size_t)b * SEQ + n * 128 + qi;
    float q[64], o[64];
#pragma unroll
    for (int i = 0; i < 8; ++i) {
        const u32x4 r = *(const u32x4*)(SQ + t * 512 + hq * 64 + i * 8);
        float f[8]; unpack8(r, f);
#pragma unroll
        for (int jj = 0; jj < 8; ++jj) q[i * 8 + jj] = f[jj];
    }
#pragma unroll
    for (int i = 0; i < 64; ++i) o[i] = 0.f;
    float m = sinks[hq], l = 1.f;
#pragma unroll 1
    for (int kj = (n == 0) ? 128 : 0; kj < 256; ++kj) {
        const int rel = qi + 128 - kj;
        if (rel >= 0 && rel < 128) {
            float sc = 0.f;
#pragma unroll
            for (int i = 0; i < 8; ++i) {
                const u32x4 r = *(const u32x4*)(Kb + kj * 64 + i * 8);
                float f[8]; unpack8(r, f);
#pragma unroll
                for (int jj = 0; jj < 8; ++jj) sc += q[i * 8 + jj] * f[jj];
            }
            const float mn = fmaxf(m, sc);
            const float al = __expf(m - mn), p = __expf(sc - mn);
            l = l * al + p; m = mn;
#pragma unroll
            for (int i = 0; i < 8; ++i) {
                const u32x4 r = *(const u32x4*)(Vb + kj * 64 + i * 8);
                float f[8]; unpack8(r, f);
#pragma unroll
                for (int jj = 0; jj < 8; ++jj) o[i * 8 + jj] = o[i * 8 + jj] * al + p * f[jj];
            }
        }
    }
    const float inv = 1.f / l;
#pragma unroll
    for (int i = 0; i < 8; ++i)
        *(u32x4*)(MIXO + t * 1024 + 512 + hq * 64 + i * 8) = (u32x4){pk2(o[i * 8] * inv, o[i * 8 + 1] * inv), pk2(o[i * 8 + 2] * inv, o[i * 8 + 3] * inv),
                                                                   pk2(o[i * 8 + 4] * inv, o[i * 8 + 5] * inv), pk2(o[i * 8 + 6] * inv, o[i * 8 + 7] * inv)};
}

__global__ void __launch_bounds__(256, 2) fwd(Args a) {
    extern __shared__ __attribute__((aligned(16))) unsigned char smem[];
    Ctx c;
    c.tid = threadIdx.x; c.lane = c.tid & 63; c.wid = c.tid >> 6; c.wr = c.wid >> 1; c.wc = c.wid & 1; c.fr = c.lane & 15; c.fq = c.lane >> 4;
    c.bid = blockIdx.x; c.nblk = gridDim.x; c.smem = smem;
#define PH_CTX() do { int t_ = threadIdx.x; asm volatile("" : "+v"(t_)); c.tid = t_; c.lane = t_ & 63; c.wid = t_ >> 6; c.wr = c.wid >> 1; c.wc = c.wid & 1; c.fr = c.lane & 15; c.fq = c.lane >> 4; } while (0)
    unsigned char* ws = a.ws;
    unsigned* ctl = (unsigned*)(ws + WS_CTL);
    volatile LAS unsigned* xbw = (volatile LAS unsigned*)(smem + 65536);
    if (c.tid < 8) xbw[c.tid] = 0u;
    __syncthreads();
    XcdBarrier bar; bar.bar = ctl; bar.x = 0; bar.st = xbw;
    if (a.use_bar) bar = xcd_barrier_post(ctl, xbw);
    const int lo = a.ph_lo, hi = a.ph_hi;
#define IN(k) (lo <= (k) && (k) < hi)
#define PH(k) if (IN(k)) { PH_CTX();
#define SEAM(k) do { if ((k) + 1 < hi) xcd_barrier(bar); } while (0)

    bf16_t* XBF = (bf16_t*)(ws + WS_XBF);
    float* X1 = (float*)(ws + WS_X1);
    bf16_t* PROJ = (bf16_t*)(ws + U_PROJ);
    float* GATES = (float*)(ws + U_GATES);
    bf16_t* MIXO = (bf16_t*)(ws + U_MIXO);
    float* YBUF = (float*)(ws + U_YBUF);
    const float* ROPEM = (const float*)(ws + WS_ROPEM);
    const float* ROPES = (const float*)(ws + WS_ROPES);

    PH(0) phase_prologue(a, c); SEAM(0); }

    for (int layer = 0; layer < 4; ++layer) {
        const int pb = 1 + layer * PPL;
        if (pb >= hi || pb + PPL <= lo) continue;
        const int jj = layer >> 1;
        const bool odd = (layer & 1) != 0;
        const float* xres = (layer == 0) ? (const float*)a.in[0] : (const float*)a.out;
        unsigned* CNT = ctl + CW_CNT + layer * 128;
        const bf16_t* WIN = (const bf16_t*)(ws + WS_WIN) + (size_t)layer * WIN_ELEMS;
        const bf16_t* WOUT = (const bf16_t*)(ws + WS_WOUT) + (size_t)layer * WOUT_ELEMS;

        PH(pb + 0) phase_inproj(XBF, WIN, PROJ, GATES, odd ? 1024 : 1952, c); SEAM(pb + 0); }
        PH(pb + 1)
            if (!odd) phase_prep_even(PROJ, GATES, (const float*)a.in[3] + jj * 256, (const float*)a.in[5] + jj * 128, (const float*)a.in[7] + jj * 4 * 1536,
                                      (const float*)a.in[8] + jj * 4, (const float*)a.in[9] + jj * 4, ROPEM,
                                      (bf16_t*)(ws + U_CQ), (bf16_t*)(ws + U_CKV), (bf16_t*)(ws + U_KROPE), (bf16_t*)(ws + U_GQ), (bf16_t*)(ws + U_GK), (bf16_t*)(ws + U_GV),
                                      (float*)(ws + U_BETA), (float*)(ws + U_GLOG), c);
            else phase_prep_odd(PROJ, ROPES, (bf16_t*)(ws + U_QF), (bf16_t*)(ws + U_KN), c);
            SEAM(pb + 1);
        }
        PH(pb + 2)
            if (!odd) phase_mla_up((const bf16_t*)(ws + U_CQ), (const bf16_t*)(ws + WS_WQB) + (size_t)jj * WQB_ELEMS, (const bf16_t*)(ws + U_CKV),
                                   (const bf16_t*)(ws + WS_WKVB) + (size_t)jj * WKVB_ELEMS, ROPEM, (bf16_t*)(ws + U_QF), (bf16_t*)(ws + U_KN), (bf16_t*)(ws + U_VV), c);
            SEAM(pb + 2);
        }
        PH(pb + 3)
            unsigned* ctr = ctl + CW_WORK + pb + 3;
            if (!odd) {
                for (;;) {
                    const int u = next_unit(ctr, c);
                    if (u >= 32 + 512) break;
                    if (u < 32) gdn_unit(u, (const bf16_t*)(ws + U_GQ), (const bf16_t*)(ws + U_GK), (const bf16_t*)(ws + U_GV), (const float*)(ws + U_BETA),
                                         (const float*)(ws + U_GLOG), PROJ, (const float*)a.in[10] + jj * 128, MIXO, c);
                    else mla_unit(u - 32, (const bf16_t*)(ws + U_QF), (const bf16_t*)(ws + U_KN), (const bf16_t*)(ws + U_KROPE), (const bf16_t*)(ws + U_VV), MIXO, c);
                }
            } else {
                for (;;) {
                    const int u = next_unit(ctr, c);
                    if (u >= 32 + 512) break;
                    if (u < 32) mlstm_unit(u, PROJ, GATES, (const float*)a.in[13] + jj * 4, (const float*)a.in[14] + jj * 4, (const float*)a.in[15] + jj * 512, MIXO, c);
                    else swa_unit(u - 32, (const bf16_t*)(ws + U_QF), (const bf16_t*)(ws + U_KN), PROJ, (const float*)a.in[16] + jj * 8, MIXO, c);
                }
            }
            SEAM(pb + 3);
        }
        PH(pb + 4) phase_outproj(MIXO, WOUT, xres, YBUF, c); SEAM(pb + 4); }
        PH(pb + 5) phase_ln1(YBUF, (const float*)a.in[18] + layer * 1024, (const float*)a.in[19] + layer * 1024, X1, XBF, c); SEAM(pb + 5); }
        PH(pb + 6) phase_router(XBF, (const bf16_t*)(ws + WS_WRT) + (size_t)layer * WRT_ELEMS, (float*)(ws + WS_LOG), c); SEAM(pb + 6); }
        PH(pb + 7) phase_route((const float*)(ws + WS_LOG), (const float*)a.in[21] + layer * 64, CNT, (int*)(ws + WS_LTOK), (float*)(ws + WS_LW), (int*)(ws + WS_ASG), c); SEAM(pb + 7); }
        PH(pb + 8) phase_moe1(XBF, (const bf16_t*)(ws + WS_WGU) + (size_t)layer * 65 * WGU_ELEMS, CNT, (const int*)(ws + WS_LTOK), (bf16_t*)(ws + WS_HBUF), c); SEAM(pb + 8); }
        PH(pb + 9) phase_moe2((const bf16_t*)(ws + WS_HBUF), (const bf16_t*)(ws + WS_WDN) + (size_t)layer * 65 * WDN_ELEMS, CNT, (const float*)(ws + WS_LW), (bf16_t*)(ws + U_Y), c); SEAM(pb + 9); }
        PH(pb + 10) phase_combine(X1, (const bf16_t*)(ws + U_Y), (const int*)(ws + WS_ASG), CNT, (const float*)a.in[28] + layer * 1024, (const float*)a.in[29] + layer * 1024,
                                         a.out, XBF, c); SEAM(pb + 10); }
    }
#undef IN
#undef PH
#undef PH_CTX
#undef SEAM
}

extern "C" void kernel_launch(void* const* d_in, const int* in_sizes, int n_in, void* d_out, int out_size, void* d_ws, size_t ws_size, hipStream_t stream) {
    static int grid = 0;
    if (grid == 0) {
        if (n_in != 30 || out_size != T * 1024 || ws_size < WS_END) {
            fprintf(stderr, "kernel_launch: unexpected shapes (n_in %d, out %d, ws %zu < %zu)\n", n_in, out_size, ws_size, (size_t)WS_END);
            grid = -1; return;
        }
        int dev = 0, cus = 0, per_cu = 0;
        hipGetDevice(&dev);
        hipDeviceGetAttribute(&cus, hipDeviceAttributeMultiprocessorCount, dev);
        hipFuncSetAttribute((const void*)fwd, hipFuncAttributeMaxDynamicSharedMemorySize, DYN_LDS);
        hipOccupancyMaxActiveBlocksPerMultiprocessor(&per_cu, (const void*)fwd, 256, DYN_LDS);
        (void)hipGetLastError();
        if (per_cu < 1) per_cu = 1;
        grid = cus * (per_cu < 2 ? per_cu : 2);
    }
    if (grid < 0) return;
    hipMemsetAsync((char*)d_ws + WS_CTL, 0, CTL_BYTES, stream);
    Args a{};
    for (int i = 0; i < 30; ++i) a.in[i] = d_in[i];
    a.out = (float*)d_out; a.ws = (unsigned char*)d_ws; a.pad = 0;
#if ONE_LAUNCH
    a.ph_lo = 0; a.ph_hi = NPH; a.use_bar = 1;
    hipLaunchKernelGGL(fwd, dim3(grid), dim3(256), DYN_LDS, stream, a);
#else
    for (int p = 0; p < NPH; ++p) {
        a.ph_lo = p; a.ph_hi = p + 1; a.use_bar = 0;
        hipLaunchKernelGGL(fwd, dim3(grid), dim3(256), DYN_LDS, stream, a);
    }
#endif
}
```

```cpp
#include <hip/hip_runtime.h>
#include <stdint.h>
#include <stdio.h>

#define REP_GEMM 1
#define REP_PRO 1
#define REP_TOK 1
#ifndef ONE_LAUNCH
#define ONE_LAUNCH 1
#endif

typedef unsigned short bf16_t;
typedef short bf16x8 __attribute__((ext_vector_type(8)));
typedef float f32x4 __attribute__((ext_vector_type(4)));
typedef unsigned u32x4 __attribute__((ext_vector_type(4)));
typedef unsigned u32x2 __attribute__((ext_vector_type(2)));
#define LAS __attribute__((address_space(3)))
#define GAS __attribute__((address_space(1)))

constexpr int T = 16384, SEQ = 2048;
constexpr int NPAD = 2560;
constexpr int CAP = 16384;
constexpr int MAXRB = 1024 + 64 + 128;
constexpr int MAXROWS = MAXRB * 128;
constexpr float ALPHA = 1.681792830507429f;
constexpr int PPL = 12;
constexpr int NPH = 1 + 4 * PPL;
constexpr int DYN_LDS = 65536 + 64;

constexpr size_t cmax(size_t a, size_t b) { return a > b ? a : b; }
constexpr size_t WS_CTL = 0;
constexpr size_t CTL_BYTES = 65536;
constexpr size_t WS_WIN = WS_CTL + CTL_BYTES;
constexpr size_t WIN_ELEMS = (size_t)NPAD * 1024;
constexpr size_t WS_WQB = WS_WIN + 4 * WIN_ELEMS * 2;
constexpr size_t WQB_ELEMS = 768 * 256;
constexpr size_t WS_WKVB = WS_WQB + 2 * WQB_ELEMS * 2;
constexpr size_t WKVB_ELEMS = 1024 * 128;
constexpr size_t WS_WOUT = WS_WKVB + 2 * WKVB_ELEMS * 2;
constexpr size_t WOUT_ELEMS = 1024 * 1024;
constexpr size_t WS_WRT = WS_WOUT + 4 * WOUT_ELEMS * 2;
constexpr size_t WRT_ELEMS = 128 * 1024;
constexpr size_t WS_WGU = WS_WRT + 4 * WRT_ELEMS * 2;
constexpr size_t WGU_ELEMS = 512 * 1024;
constexpr size_t WS_WDN = WS_WGU + 4 * 65 * WGU_ELEMS * 2;
constexpr size_t WDN_ELEMS = 1024 * 256;
constexpr size_t WS_ROPEM = WS_WDN + 4 * 65 * WDN_ELEMS * 2;
constexpr size_t WS_ROPES = WS_ROPEM + (size_t)T * 16 * 2 * 4;
constexpr size_t WS_X1 = WS_ROPES + (size_t)T * 32 * 2 * 4;
constexpr size_t WS_XBF = WS_X1 + (size_t)T * 1024 * 4;
constexpr size_t WS_HBUF = WS_XBF + (size_t)T * 1024 * 2;
constexpr size_t WS_LOG = WS_HBUF + (size_t)MAXROWS * 256 * 2;
constexpr size_t WS_ASG = WS_LOG + (size_t)T * 64 * 4;
constexpr size_t WS_LTOK = WS_ASG + (size_t)T * 8 * 4;
constexpr size_t WS_LW = WS_LTOK + (size_t)65 * CAP * 4;
constexpr size_t WS_U = WS_LW + (size_t)65 * CAP * 4;
constexpr size_t U_Y = WS_U;
constexpr size_t U_PROJ = WS_U;
constexpr size_t U_GATES = U_PROJ + (size_t)T * NPAD * 2;
constexpr size_t U_CQ = U_GATES + (size_t)T * 8 * 4;
constexpr size_t U_CKV = U_CQ + (size_t)T * 256 * 2;
constexpr size_t U_KROPE = U_CKV + (size_t)T * 128 * 2;
constexpr size_t U_QF = U_KROPE + (size_t)T * 32 * 2;
constexpr size_t U_KN = U_QF + (size_t)T * 768 * 2;
constexpr size_t U_VV = U_KN + (size_t)T * 512 * 2;
constexpr size_t U_GQ = U_VV + (size_t)T * 512 * 2;
constexpr size_t U_GK = U_GQ + (size_t)T * 512 * 2;
constexpr size_t U_GV = U_GK + (size_t)T * 512 * 2;
constexpr size_t U_BETA = U_GV + (size_t)T * 512 * 2;
constexpr size_t U_GLOG = U_BETA + (size_t)T * 4 * 4;
constexpr size_t U_MIXO = U_GLOG + (size_t)T * 4 * 4;
constexpr size_t U_YBUF = U_MIXO + (size_t)T * 1024 * 2;
constexpr size_t U_END1 = U_YBUF + (size_t)T * 1024 * 4;
constexpr size_t WS_END = WS_U + cmax((size_t)MAXROWS * 1024 * 2, U_END1 - WS_U);

constexpr int CW_CNT = 4096;
constexpr int CW_WORK = 8192;

#define XB_TMO      128
#define XB_XCNT(j)  (256  + 64 * (j))
#define XB_XSUB(j)  (1280 + 64 * (j))
#define XB_XGEN(j)  (2304 + 64 * (j))
#define XB_TOP      3328
#define XB_TOPGEN   3392
#define XCD_BAR_WORDS 3456
#define XB_SPIN_CAP (1u << 18)

__device__ __forceinline__ unsigned xb_ld(unsigned* p)              { return __hip_atomic_load(p, __ATOMIC_RELAXED, __HIP_MEMORY_SCOPE_AGENT); }
__device__ __forceinline__ unsigned xb_add(unsigned* p, unsigned v) { return __hip_atomic_fetch_add(p, v, __ATOMIC_RELAXED, __HIP_MEMORY_SCOPE_AGENT); }
__device__ __forceinline__ unsigned xb_xcc_id() { return (unsigned)__builtin_amdgcn_s_getreg((3 << 11) | 20) & 0xFu; }
#define XB_SPIN(cond, bar) do { unsigned _sp = 0; while (cond) { __builtin_amdgcn_s_sleep(1); \
    if ((++_sp & 255u) == 0u) { if (xb_ld(&(bar)[XB_TMO])) break; if (_sp > XB_SPIN_CAP) { atomicAdd(&(bar)[XB_TMO], 1u); break; } } } } while (0)

struct XcdBarrier { unsigned* bar; unsigned x; volatile LAS unsigned* st; };

__device__ __forceinline__ XcdBarrier xcd_barrier_post(unsigned* bar, volatile LAS unsigned* st) {
    XcdBarrier b; b.bar = bar; b.x = xb_xcc_id(); b.st = st;
    if (threadIdx.x == 0) (void)xb_add(&bar[XB_XCNT(b.x)], 1u);
    return b;
}
__device__ __forceinline__ void xcd_barrier_complete(unsigned* bar, unsigned x, unsigned& nloc, unsigned& nx) {
    const unsigned G = gridDim.x * gridDim.y * gridDim.z;
    unsigned sum, cnt, mine, sp = 0u;
    for (;;) {
        sum = 0u; cnt = 0u; mine = 0u;
#pragma unroll
        for (unsigned j = 0; j < 16; ++j) { const unsigned c = xb_ld(&bar[XB_XCNT(j)]); sum += c; cnt += (c > 0u) ? 1u : 0u; mine = (j == x) ? c : mine; }
        if (sum == G) break;
        __builtin_amdgcn_s_sleep(1);
        if ((++sp & 255u) == 0u) { if (xb_ld(&bar[XB_TMO])) break; if (sp > XB_SPIN_CAP) { atomicAdd(&bar[XB_TMO], 1u); break; } }
    }
    nloc = mine > 0u ? mine : 1u; nx = cnt > 0u ? cnt : 1u;
}
__device__ __forceinline__ void xcd_barrier(const XcdBarrier& b) {
    asm volatile("s_waitcnt vmcnt(0)" ::: "memory");
    __syncthreads();
    if (threadIdx.x == 0) {
        unsigned* bar = b.bar;
        __builtin_amdgcn_s_waitcnt(0);
        unsigned nloc = b.st[0], nx = b.st[1];
        if (nloc == 0u) { xcd_barrier_complete(bar, b.x, nloc, nx); b.st[0] = nloc; b.st[1] = nx; }
        const unsigned old = xb_add(&bar[XB_XSUB(b.x)], 1u);
        const unsigned gen = old / nloc;
        if (old + 1u == (gen + 1u) * nloc) {
            __builtin_amdgcn_fence(__ATOMIC_RELEASE, "agent");
            asm volatile("s_waitcnt vmcnt(0)" ::: "memory");
            const unsigned og = xb_add(&bar[XB_TOP], 1u);
            const unsigned tg = og / nx;
            if (og + 1u == (tg + 1u) * nx) xb_add(&bar[XB_TOPGEN], 1u);
            else XB_SPIN(xb_ld(&bar[XB_TOPGEN]) == tg, bar);
            __builtin_amdgcn_fence(__ATOMIC_ACQUIRE, "agent");
            xb_add(&bar[XB_XGEN(b.x)], 1u);
            asm volatile("s_waitcnt vmcnt(0)" ::: "memory");
        } else {
            XB_SPIN(xb_ld(&bar[XB_XGEN(b.x)]) == gen, bar);
            __builtin_amdgcn_fence(__ATOMIC_ACQUIRE, "agent");
            asm volatile("s_waitcnt vmcnt(0)" ::: "memory");
        }
    }
    __syncthreads();
}

__device__ __forceinline__ float bf2f(unsigned v) { return __uint_as_float(v << 16); }
__device__ __forceinline__ float bflo(unsigned w) { return __uint_as_float(w << 16); }
__device__ __forceinline__ float bfhi(unsigned w) { return __uint_as_float(w & 0xffff0000u); }
__device__ __forceinline__ unsigned f2bf(float f) { unsigned u = __float_as_uint(f); u += 0x7fffu + ((u >> 16) & 1u); return u >> 16; }
__device__ __forceinline__ unsigned pk2(float lo, float hi) { return f2bf(lo) | (f2bf(hi) << 16); }
__device__ __forceinline__ float wave_sum(float v) {
#pragma unroll
    for (int o = 32; o > 0; o >>= 1) v += __shfl_xor(v, o);
    return v;
}
__device__ __forceinline__ float sigmoidf_(float x) { return 1.f / (1.f + expf(-x)); }
__device__ __forceinline__ float siluf_(float x) { return x / (1.f + expf(-x)); }
__device__ __forceinline__ float softplusf_(float x) { return x > 20.f ? x : log1pf(expf(x)); }
__device__ __forceinline__ void glds16(const void* g, void* l) {
    __builtin_amdgcn_global_load_lds((const GAS unsigned*)g, (LAS unsigned*)l, 16, 0, 0);
}
__device__ __forceinline__ void unpack8(const u32x4 r, float (&f)[8]) {
    f[0] = bflo(r.x); f[1] = bfhi(r.x); f[2] = bflo(r.y); f[3] = bfhi(r.y);
    f[4] = bflo(r.z); f[5] = bfhi(r.z); f[6] = bflo(r.w); f[7] = bfhi(r.w);
}

struct Args {
    const void* in[30];
    float* out;
    unsigned char* ws;
    int ph_lo, ph_hi, use_bar, pad;
};

struct Ctx { int tid, lane, wid, wr, wc, fr, fq, bid, nblk; unsigned char* smem; };

__device__ __forceinline__ void gemm_tile(const bf16_t* a0, const bf16_t* a1, const bf16_t* b0, const bf16_t* b1,
                                          int nk, f32x4 (&acc)[4][4], const Ctx& c) {
#pragma unroll
    for (int m = 0; m < 4; ++m)
#pragma unroll
        for (int n = 0; n < 4; ++n) acc[m][n] = (f32x4){0.f, 0.f, 0.f, 0.f};
    unsigned char* smem = c.smem;
    const int sb = c.tid * 16;
    {
        glds16(a0, smem + sb); glds16(a1, smem + 4096 + sb);
        glds16(b0, smem + 16384 + sb); glds16(b1, smem + 16384 + 4096 + sb);
    }
    for (int kt = 0; kt < nk; ++kt) {
        const int cur = kt & 1;
        asm volatile("s_waitcnt vmcnt(0)" ::: "memory");
        __syncthreads();
        if (kt + 1 < nk) {
            unsigned char* sa = smem + (cur ^ 1) * 8192; unsigned char* sbb = smem + 16384 + (cur ^ 1) * 8192;
            const int ko = (kt + 1) * 32;
            glds16(a0 + ko, sa + sb); glds16(a1 + ko, sa + 4096 + sb);
            glds16(b0 + ko, sbb + sb); glds16(b1 + ko, sbb + 4096 + sb);
        }
        const unsigned char* sa = smem + cur * 8192; const unsigned char* sbb = smem + 16384 + cur * 8192;
        bf16x8 af[4], bfr[4];
#pragma unroll
        for (int m = 0; m < 4; ++m) af[m] = *(const bf16x8*)(sa + (c.wr * 64 + m * 16 + c.fr) * 64 + c.fq * 16);
#pragma unroll
        for (int n = 0; n < 4; ++n) bfr[n] = *(const bf16x8*)(sbb + (c.wc * 64 + n * 16 + c.fr) * 64 + c.fq * 16);
#pragma unroll
        for (int m = 0; m < 4; ++m)
#pragma unroll
            for (int n = 0; n < 4; ++n) acc[m][n] = __builtin_amdgcn_mfma_f32_16x16x32_bf16(bfr[n], af[m], acc[m][n], 0, 0, 0);
    }
    __syncthreads();
}

__device__ void conv_family(const float* src, int nmat, size_t src_stride, int K, int N, int Nout,
                            bf16_t* dst, size_t dst_stride, int grp, int kind, const Ctx& c) {
    float* lds = (float*)c.smem;
    const int tk = K / 64, tn = Nout / 64, per = tk * tn, total = nmat * per;
    for (int u = c.bid; u < total; u += c.nblk) {
        const int mat = u / per, r = u % per, kt = r / tn, nt = r % tn;
        const int dmat = grp ? (mat / grp) * (grp + 1) + (mat % grp) : mat;
        const float* s = src + (size_t)mat * src_stride;
        bf16_t* d = dst + (size_t)dmat * dst_stride;
        const int k0 = kt * 64, n0 = nt * 64;
        const int tx = c.tid & 63, ty = c.tid >> 6;
#pragma unroll 4
        for (int i = 0; i < 16; ++i) {
            const int k = i * 4 + ty, n = n0 + tx;
            lds[k * 65 + tx] = (n < N) ? s[(size_t)(k0 + k) * N + n] : 0.f;
        }
        __syncthreads();
        const int nl = c.tid >> 2, kq = (c.tid & 3) * 16;
        unsigned w[8];
#pragma unroll
        for (int j = 0; j < 8; ++j) w[j] = pk2(lds[(kq + 2 * j) * 65 + nl], lds[(kq + 2 * j + 1) * 65 + nl]);
        const int n = n0 + nl;
        const int drow = (kind == 0) ? n : ((n >> 5) * 64 + (n & 31) + (kind == 2 ? 32 : 0));
        u32x4* dp = (u32x4*)(d + (size_t)drow * K + k0 + kq);
        dp[0] = (u32x4){w[0], w[1], w[2], w[3]};
        dp[1] = (u32x4){w[4], w[5], w[6], w[7]};
        __syncthreads();
    }
}

__device__ void phase_prologue(const Args& a, const Ctx& c) {
    unsigned char* ws = a.ws;
    bf16_t* WIN = (bf16_t*)(ws + WS_WIN);
    conv_family((const float*)a.in[2], 2, (size_t)1024 * 2472, 1024, 2472, NPAD, WIN, 2 * WIN_ELEMS, 0, 0, c);
    conv_family((const float*)a.in[12], 2, (size_t)1024 * 2312, 1024, 2312, NPAD, WIN + WIN_ELEMS, 2 * WIN_ELEMS, 0, 0, c);
    conv_family((const float*)a.in[4], 2, (size_t)256 * 768, 256, 768, 768, (bf16_t*)(ws + WS_WQB), WQB_ELEMS, 0, 0, c);
    conv_family((const float*)a.in[6], 2, (size_t)128 * 1024, 128, 1024, 1024, (bf16_t*)(ws + WS_WKVB), WKVB_ELEMS, 0, 0, c);
    bf16_t* WOUT = (bf16_t*)(ws + WS_WOUT);
    conv_family((const float*)a.in[11], 2, (size_t)1024 * 1024, 1024, 1024, 1024, WOUT, 2 * WOUT_ELEMS, 0, 0, c);
    conv_family((const float*)a.in[17], 2, (size_t)1024 * 1024, 1024, 1024, 1024, WOUT + WOUT_ELEMS, 2 * WOUT_ELEMS, 0, 0, c);
    conv_family((const float*)a.in[20], 4, (size_t)1024 * 64, 1024, 64, 128, (bf16_t*)(ws + WS_WRT), WRT_ELEMS, 0, 0, c);
    bf16_t* WGU = (bf16_t*)(ws + WS_WGU);
    conv_family((const float*)a.in[22], 256, (size_t)1024 * 256, 1024, 256, 256, WGU, WGU_ELEMS, 64, 1, c);
    conv_family((const float*)a.in[23], 256, (size_t)1024 * 256, 1024, 256, 256, WGU, WGU_ELEMS, 64, 2, c);
    conv_family((const float*)a.in[25], 4, (size_t)1024 * 256, 1024, 256, 256, WGU + 64 * WGU_ELEMS, 65 * WGU_ELEMS, 0, 1, c);
    conv_family((const float*)a.in[26], 4, (size_t)1024 * 256, 1024, 256, 256, WGU + 64 * WGU_ELEMS, 65 * WGU_ELEMS, 0, 2, c);
    bf16_t* WDN = (bf16_t*)(ws + WS_WDN);
    conv_family((const float*)a.in[24], 256, (size_t)256 * 1024, 256, 1024, 1024, WDN, WDN_ELEMS, 64, 0, c);
    conv_family((const float*)a.in[27], 4, (size_t)256 * 1024, 256, 1024, 1024, WDN + 64 * WDN_ELEMS, 65 * WDN_ELEMS, 0, 0, c);
    {
        const float* x = (const float*)a.in[0]; bf16_t* xb = (bf16_t*)(ws + WS_XBF);
        const size_t n8 = (size_t)T * 1024 / 8;
        for (size_t i = (size_t)c.bid * 256 + c.tid; i < n8; i += (size_t)c.nblk * 256) {
            const f32x4 v0 = *(const f32x4*)(x + i * 8), v1 = *(const f32x4*)(x + i * 8 + 4);
            *(u32x4*)(xb + i * 8) = (u32x4){pk2(v0[0], v0[1]), pk2(v0[2], v0[3]), pk2(v1[0], v1[1]), pk2(v1[2], v1[3])};
        }
    }
    {
        const int* pos = (const int*)a.in[1];
        float* rm = (float*)(ws + WS_ROPEM); float* rs = (float*)(ws + WS_ROPES);
        const float ln_theta = 9.210340371976184f;
        for (int i = c.bid * 256 + c.tid; i < T * 16; i += c.nblk * 256) {
            const int t = i >> 4, f = i & 15;
            const float inv = expf(-((float)(2 * f) / 32.f) * ln_theta);
            const float ang = (float)pos[t] * inv;
            rm[i * 2] = cosf(ang); rm[i * 2 + 1] = sinf(ang);
        }
        for (int i = c.bid * 256 + c.tid; i < T * 32; i += c.nblk * 256) {
            const int t = i >> 5, f = i & 31;
            const float inv = expf(-((float)(2 * f) / 64.f) * ln_theta);
            const float ang = (float)pos[t] * inv;
            rs[i * 2] = cosf(ang); rs[i * 2 + 1] = sinf(ang);
        }
    }
}

__device__ void phase_inproj(const bf16_t* XBF, const bf16_t* W, bf16_t* PROJ, float* GATES, int gbase, const Ctx& c) {
    const int ntn = NPAD / 128, total = (T / 128) * ntn;
    for (int u = c.bid; u < total; u += c.nblk) {
        const int mt = u / ntn, nt = u % ntn;
        const bf16_t* a0 = XBF + (size_t)(mt * 128 + (c.tid >> 2)) * 1024 + (c.tid & 3) * 8;
        const bf16_t* b0 = W + (size_t)(nt * 128 + (c.tid >> 2)) * 1024 + (c.tid & 3) * 8;
        f32x4 acc[4][4];
        gemm_tile(a0, a0 + 64 * 1024, b0, b0 + 64 * 1024, 32, acc, c);
#pragma unroll
        for (int m = 0; m < 4; ++m) {
            const int row = mt * 128 + c.wr * 64 + m * 16 + c.fr;
#pragma unroll
            for (int n = 0; n < 4; ++n) {
                const int col = nt * 128 + c.wc * 64 + n * 16 + c.fq * 4;
                const f32x4 v = acc[m][n];
                *(u32x2*)(PROJ + (size_t)row * NPAD + col) = (u32x2){pk2(v[0], v[1]), pk2(v[2], v[3])};
                if (col >= gbase && col < gbase + 8) *(f32x4*)(GATES + (size_t)row * 8 + (col - gbase)) = v;
            }
        }
    }
}

__device__ void phase_mla_up(const bf16_t* CQ, const bf16_t* WQB, const bf16_t* CKV, const bf16_t* WKVB,
                             const float* ROPEM, bf16_t* QF, bf16_t* KN, bf16_t* VV, const Ctx& c) {
    const int tq = (T / 128) * 6, tkv = (T / 128) * 8;
    const float qscale = 0.10206207261596577f;
    for (int u = c.bid; u < tq + tkv; u += c.nblk) {
        f32x4 acc[4][4];
        if (u < tq) {
            const int mt = u / 6, nt = u % 6;
            const bf16_t* a0 = CQ + (size_t)(mt * 128 + (c.tid >> 2)) * 256 + (c.tid & 3) * 8;
            const bf16_t* b0 = WQB + (size_t)(nt * 128 + (c.tid >> 2)) * 256 + (c.tid & 3) * 8;
            gemm_tile(a0, a0 + 64 * 256, b0, b0 + 64 * 256, 8, acc, c);
#pragma unroll
            for (int m = 0; m < 4; ++m) {
                const int row = mt * 128 + c.wr * 64 + m * 16 + c.fr;
#pragma unroll
                for (int np = 0; np < 2; ++np) {
                    const int cg = nt * 128 + c.wc * 64 + np * 32;
                    f32x4 v0 = acc[m][2 * np], v1 = acc[m][2 * np + 1];
                    if (((cg >> 5) % 3) == 2) {
#pragma unroll
                        for (int j = 0; j < 4; ++j) {
                            const int i = c.fq * 4 + j;
                            const float cs = ROPEM[((size_t)row * 16 + i) * 2], sn = ROPEM[((size_t)row * 16 + i) * 2 + 1];
                            const float x1 = v0[j], x2 = v1[j];
                            v0[j] = x1 * cs - x2 * sn; v1[j] = x2 * cs + x1 * sn;
                        }
                    }
                    v0 *= qscale; v1 *= qscale;
                    *(u32x2*)(QF + (size_t)row * 768 + cg + c.fq * 4) = (u32x2){pk2(v0[0], v0[1]), pk2(v0[2], v0[3])};
                    *(u32x2*)(QF + (size_t)row * 768 + cg + 16 + c.fq * 4) = (u32x2){pk2(v1[0], v1[1]), pk2(v1[2], v1[3])};
                }
            }
        } else {
            const int v = u - tq, mt = v / 8, nt = v % 8;
            const bf16_t* a0 = CKV + (size_t)(mt * 128 + (c.tid >> 2)) * 128 + (c.tid & 3) * 8;
            const bf16_t* b0 = WKVB + (size_t)(nt * 128 + (c.tid >> 2)) * 128 + (c.tid & 3) * 8;
            gemm_tile(a0, a0 + 64 * 128, b0, b0 + 64 * 128, 4, acc, c);
            bf16_t* dst = (c.wc == 0) ? KN : VV;
#pragma unroll
            for (int m = 0; m < 4; ++m) {
                const int row = mt * 128 + c.wr * 64 + m * 16 + c.fr;
#pragma unroll
                for (int n = 0; n < 4; ++n) {
                    const f32x4 x = acc[m][n];
                    *(u32x2*)(dst + (size_t)row * 512 + nt * 64 + n * 16 + c.fq * 4) = (u32x2){pk2(x[0], x[1]), pk2(x[2], x[3])};
                }
            }
        }
    }
}

__device__ void phase_outproj(const bf16_t* MIXO, const bf16_t* W, const float* xres, float* YBUF, const Ctx& c) {
    const int total = (T / 128) * 8;
    for (int u = c.bid; u < total; u += c.nblk) {
        const int mt = u / 8, nt = u % 8;
        const bf16_t* a0 = MIXO + (size_t)(mt * 128 + (c.tid >> 2)) * 1024 + (c.tid & 3) * 8;
        const bf16_t* b0 = W + (size_t)(nt * 128 + (c.tid >> 2)) * 1024 + (c.tid & 3) * 8;
        f32x4 acc[4][4];
        gemm_tile(a0, a0 + 64 * 1024, b0, b0 + 64 * 1024, 32, acc, c);
#pragma unroll
        for (int m = 0; m < 4; ++m) {
            const int row = mt * 128 + c.wr * 64 + m * 16 + c.fr;
#pragma unroll
            for (int n = 0; n < 4; ++n) {
                const int col = nt * 128 + c.wc * 64 + n * 16 + c.fq * 4;
                const f32x4 xr = *(const f32x4*)(xres + (size_t)row * 1024 + col);
                *(f32x4*)(YBUF + (size_t)row * 1024 + col) = xr * ALPHA + acc[m][n];
            }
        }
    }
}

__device__ void phase_router(const bf16_t* XBF, const bf16_t* W, float* LOG, const Ctx& c) {
    for (int mt = c.bid; mt < T / 128; mt += c.nblk) {
        const bf16_t* a0 = XBF + (size_t)(mt * 128 + (c.tid >> 2)) * 1024 + (c.tid & 3) * 8;
        const bf16_t* b0 = W + (size_t)(c.tid >> 2) * 1024 + (c.tid & 3) * 8;
        f32x4 acc[4][4];
        gemm_tile(a0, a0 + 64 * 1024, b0, b0 + 64 * 1024, 32, acc, c);
        if (c.wc == 0) {
#pragma unroll
            for (int m = 0; m < 4; ++m) {
                const int row = mt * 128 + c.wr * 64 + m * 16 + c.fr;
#pragma unroll
                for (int n = 0; n < 4; ++n) *(f32x4*)(LOG + (size_t)row * 64 + n * 16 + c.fq * 4) = acc[m][n];
            }
        }
    }
}

__device__ __forceinline__ void build_block_table(const unsigned* CNT, int* bst, const Ctx& c) {
    __syncthreads();
    if (c.tid == 0) {
        int s = 0;
        for (int e = 0; e < 65; ++e) {
            const int cnt = (e < 64) ? (int)__hip_atomic_load(CNT + e, __ATOMIC_RELAXED, __HIP_MEMORY_SCOPE_AGENT) : T;
            bst[e] = s; bst[66 + e] = cnt; s += (cnt + 127) >> 7;
        }
        bst[65] = s;
    }
    __syncthreads();
}
__device__ __forceinline__ int find_expert(const int* bst, int rb) {
    int e = 0;
    for (int i = 1; i < 65; ++i) e += (bst[i] <= rb) ? 1 : 0;
    return e;
}

__device__ void phase_moe1(const bf16_t* XBF, const bf16_t* WGU, const unsigned* CNT, const int* LTOK, bf16_t* HBUF, const Ctx& c) {
    int* bst = (int*)(c.smem + 32768);
    build_block_table(CNT, bst, c);
    const int total = bst[65] * 4;
    for (int u = c.bid; u < total; u += c.nblk) {
        const int rb = u >> 2, nt = u & 3;
        const int e = find_expert(bst, rb);
        const int lb = rb - bst[e], cnt = bst[66 + e];
        const int p0 = lb * 128 + (c.tid >> 2), p1 = p0 + 64;
        const int t0 = (p0 < cnt) ? LTOK[(size_t)e * CAP + p0] : 0;
        const int t1 = (p1 < cnt) ? LTOK[(size_t)e * CAP + p1] : 0;
        const bf16_t* a0 = XBF + (size_t)t0 * 1024 + (c.tid & 3) * 8;
        const bf16_t* a1 = XBF + (size_t)t1 * 1024 + (c.tid & 3) * 8;
        const bf16_t* b0 = WGU + (size_t)e * WGU_ELEMS + (size_t)(nt * 128 + (c.tid >> 2)) * 1024 + (c.tid & 3) * 8;
        f32x4 acc[4][4];
        gemm_tile(a0, a1, b0, b0 + 64 * 1024, 32, acc, c);
#pragma unroll
        for (int m = 0; m < 4; ++m) {
            const size_t crow = (size_t)rb * 128 + c.wr * 64 + m * 16 + c.fr;
#pragma unroll
            for (int n = 0; n < 2; ++n) {
                const f32x4 g = acc[m][n], up = acc[m][n + 2];
                float h[4];
#pragma unroll
                for (int j = 0; j < 4; ++j) h[j] = siluf_(g[j]) * up[j];
                *(u32x2*)(HBUF + crow * 256 + nt * 64 + c.wc * 32 + n * 16 + c.fq * 4) = (u32x2){pk2(h[0], h[1]), pk2(h[2], h[3])};
            }
        }
    }
}

__device__ void phase_moe2(const bf16_t* HBUF, const bf16_t* WDN, const unsigned* CNT, const float* LW, bf16_t* Y, const Ctx& c) {
    int* bst = (int*)(c.smem + 32768);
    build_block_table(CNT, bst, c);
    const int total = bst[65] * 8;
    for (int u = c.bid; u < total; u += c.nblk) {
        const int rb = u >> 3, nt = u & 7;
        const int e = find_expert(bst, rb);
        const int lb = rb - bst[e], cnt = bst[66 + e];
        const bf16_t* a0 = HBUF + ((size_t)rb * 128 + (c.tid >> 2)) * 256 + (c.tid & 3) * 8;
        const bf16_t* b0 = WDN + (size_t)e * WDN_ELEMS + (size_t)(nt * 128 + (c.tid >> 2)) * 256 + (c.tid & 3) * 8;
        f32x4 acc[4][4];
        gemm_tile(a0, a0 + 64 * 256, b0, b0 + 64 * 256, 8, acc, c);
#pragma unroll
        for (int m = 0; m < 4; ++m) {
            const int lr = c.wr * 64 + m * 16 + c.fr;
            const int p = lb * 128 + lr;
            const float w = (p < cnt) ? LW[(size_t)e * CAP + p] : 0.f;
            const size_t crow = (size_t)rb * 128 + lr;
#pragma unroll
            for (int n = 0; n < 4; ++n) {
                const f32x4 v = acc[m][n] * w;
                *(u32x2*)(Y + crow * 1024 + nt * 128 + c.wc * 64 + n * 16 + c.fq * 4) = (u32x2){pk2(v[0], v[1]), pk2(v[2], v[3])};
            }
        }
    }
}

__device__ __forceinline__ void ln_row_store(float (&v)[16], const float* g, const float* b, float* of32, bf16_t* obf, int lane) {
    float s = 0.f;
#pragma unroll
    for (int i = 0; i < 16; ++i) s += v[i];
    const float mean = wave_sum(s) * (1.f / 1024.f);
    float q = 0.f;
#pragma unroll
    for (int i = 0; i < 16; ++i) { v[i] -= mean; q += v[i] * v[i]; }
    const float rstd = rsqrtf(wave_sum(q) * (1.f / 1024.f) + 1e-5f);
#pragma unroll
    for (int hf = 0; hf < 2; ++hf) {
        const int col = hf * 512 + lane * 8;
        const f32x4 g0 = *(const f32x4*)(g + col), g1 = *(const f32x4*)(g + col + 4);
        const f32x4 b0 = *(const f32x4*)(b + col), b1 = *(const f32x4*)(b + col + 4);
        f32x4 y0, y1;
#pragma unroll
        for (int j = 0; j < 4; ++j) { y0[j] = v[hf * 8 + j] * rstd * g0[j] + b0[j]; y1[j] = v[hf * 8 + 4 + j] * rstd * g1[j] + b1[j]; }
        *(f32x4*)(of32 + col) = y0; *(f32x4*)(of32 + col + 4) = y1;
        *(u32x4*)(obf + col) = (u32x4){pk2(y0[0], y0[1]), pk2(y0[2], y0[3]), pk2(y1[0], y1[1]), pk2(y1[2], y1[3])};
    }
}

__device__ void phase_ln1(const float* YBUF, const float* g, const float* b, float* X1, bf16_t* XBF, const Ctx& c) {
    for (int t = c.bid * 4 + c.wid; t < T; t += c.nblk * 4) {
        float v[16];
#pragma unroll
        for (int hf = 0; hf < 2; ++hf) {
            const float* p = YBUF + (size_t)t * 1024 + hf * 512 + c.lane * 8;
            const f32x4 a0 = *(const f32x4*)p, a1 = *(const f32x4*)(p + 4);
#pragma unroll
            for (int j = 0; j < 4; ++j) { v[hf * 8 + j] = a0[j]; v[hf * 8 + 4 + j] = a1[j]; }
        }
        ln_row_store(v, g, b, X1 + (size_t)t * 1024, XBF + (size_t)t * 1024, c.lane);
    }
}

__device__ void phase_combine(const float* X1, const bf16_t* Y, const int* ASG, const unsigned* CNT, const float* g, const float* b,
                              float* XOUT, bf16_t* XBF, const Ctx& c) {
    int* bst = (int*)(c.smem + 32768);
    build_block_table(CNT, bst, c);
    for (int t = c.bid * 4 + c.wid; t < T; t += c.nblk * 4) {
        float v[16];
#pragma unroll
        for (int hf = 0; hf < 2; ++hf) {
            const float* p = X1 + (size_t)t * 1024 + hf * 512 + c.lane * 8;
            const f32x4 a0 = *(const f32x4*)p, a1 = *(const f32x4*)(p + 4);
#pragma unroll
            for (int j = 0; j < 4; ++j) { v[hf * 8 + j] = a0[j] * ALPHA; v[hf * 8 + 4 + j] = a1[j] * ALPHA; }
        }
#pragma unroll
        for (int k = 0; k < 9; ++k) {
            size_t crow;
            if (k < 8) { const int asg = ASG[(size_t)t * 8 + k]; crow = (size_t)bst[asg >> 16] * 128 + (asg & 0xffff); }
            else crow = (size_t)bst[64] * 128 + t;
#pragma unroll
            for (int hf = 0; hf < 2; ++hf) {
                const u32x4 r = *(const u32x4*)(Y + crow * 1024 + hf * 512 + c.lane * 8);
                float f[8]; unpack8(r, f);
#pragma unroll
                for (int j = 0; j < 8; ++j) v[hf * 8 + j] += f[j];
            }
        }
        ln_row_store(v, g, b, XOUT + (size_t)t * 1024, XBF + (size_t)t * 1024, c.lane);
    }
}

__device__ void phase_route(const float* LOG, const float* rb, unsigned* CNT, int* LTOK, float* LW, int* ASG, const Ctx& c) {
    int* lcnt = (int*)c.smem;
    int* lbase = lcnt + 64;
    int* sel_e = lbase + 64;
    int* sel_p = sel_e + 256;
    float* sel_w = (float*)(sel_p + 256);
    const float rbias = rb[c.lane];
    for (int ch = c.bid; ch < T / 32; ch += c.nblk) {
        __syncthreads();
        if (c.tid < 64) lcnt[c.tid] = 0;
        __syncthreads();
        for (int tl = c.wid; tl < 32; tl += 4) {
            const int t = ch * 32 + tl;
            const float lg = LOG[(size_t)t * 64 + c.lane];
            const float sc = 1.f / (1.f + expf(-lg));
            const float v = sc + rbias;
            float m1 = v;
            m1 = fmaxf(m1, __shfl_xor(m1, 1)); m1 = fmaxf(m1, __shfl_xor(m1, 2)); m1 = fmaxf(m1, __shfl_xor(m1, 4));
            int cand = (v == m1) ? c.lane : 999;
            cand = min(cand, __shfl_xor(cand, 1)); cand = min(cand, __shfl_xor(cand, 2)); cand = min(cand, __shfl_xor(cand, 4));
            float m2 = (c.lane == cand) ? -INFINITY : v;
            m2 = fmaxf(m2, __shfl_xor(m2, 1)); m2 = fmaxf(m2, __shfl_xor(m2, 2)); m2 = fmaxf(m2, __shfl_xor(m2, 4));
            const float gs = m1 + m2;
            const int g = c.lane >> 3;
            int grank = 0;
#pragma unroll
            for (int gg = 0; gg < 8; ++gg) { const float o = __shfl(gs, gg * 8); grank += ((o > gs) || (o == gs && gg < g)) ? 1 : 0; }
            const bool gsel = grank < 4;
            const float mv = gsel ? v : -INFINITY;
            int rank = 0;
#pragma unroll 8
            for (int jj = 0; jj < 64; ++jj) { const float o = __shfl(mv, jj); rank += ((o > mv) || (o == mv && jj < c.lane)) ? 1 : 0; }
            const bool sel = gsel && rank < 8;
            const float ssum = wave_sum(sel ? sc : 0.f);
            const float w = sc / ssum * 2.5f;
            const unsigned long long bal = __ballot(sel);
            const int slot = __popcll(bal & ((1ull << c.lane) - 1ull));
            if (sel) {
                const int p = atomicAdd(&lcnt[c.lane], 1);
                sel_e[tl * 8 + slot] = c.lane; sel_p[tl * 8 + slot] = p; sel_w[tl * 8 + slot] = w;
            }
        }
        __syncthreads();
        if (c.tid < 64) { const int n = lcnt[c.tid]; lbase[c.tid] = n ? (int)atomicAdd(CNT + c.tid, (unsigned)n) : 0; }
        __syncthreads();
        {
            const int tl = c.tid >> 3, t = ch * 32 + tl;
            const int e = sel_e[c.tid], pos = lbase[e] + sel_p[c.tid];
            LTOK[(size_t)e * CAP + pos] = t; LW[(size_t)e * CAP + pos] = sel_w[c.tid];
            ASG[(size_t)t * 8 + (c.tid & 7)] = (e << 16) | pos;
            if (c.tid < 32) { const int ts = ch * 32 + c.tid; LTOK[(size_t)64 * CAP + ts] = ts; LW[(size_t)64 * CAP + ts] = 1.f; }
        }
    }
}

__device__ void phase_prep_even(const bf16_t* PROJ, const float* GATES, const float* qn, const float* kvn, const float* cw,
                                const float* a_log, const float* dt_bias, const float* ROPEM,
                                bf16_t* CQ, bf16_t* CKV, bf16_t* KROPE, bf16_t* GQ, bf16_t* GK, bf16_t* GV, float* BETA, float* GLOG, const Ctx& c) {
    const int lane = c.lane;
    for (int t = c.bid * 4 + c.wid; t < T; t += c.nblk * 4) {
        const bf16_t* pr = PROJ + (size_t)t * NPAD;
        {
            const u32x2 r = *(const u32x2*)(pr + lane * 4);
            float v[4] = {bflo(r.x), bfhi(r.x), bflo(r.y), bfhi(r.y)};
            const float ss = wave_sum(v[0] * v[0] + v[1] * v[1] + v[2] * v[2] + v[3] * v[3]);
            const float rr = rsqrtf(ss * (1.f / 256.f) + 1e-6f);
            const f32x4 gq = *(const f32x4*)(qn + lane * 4);
            *(u32x2*)(CQ + (size_t)t * 256 + lane * 4) = (u32x2){pk2(v[0] * rr * gq[0], v[1] * rr * gq[1]), pk2(v[2] * rr * gq[2], v[3] * rr * gq[3])};
        }
        {
            const unsigned r = *(const unsigned*)(pr + 256 + lane * 2);
            const float v0 = bflo(r), v1 = bfhi(r);
            const float ss = wave_sum(v0 * v0 + v1 * v1);
            const float rr = rsqrtf(ss * (1.f / 128.f) + 1e-6f);
            *(unsigned*)(CKV + (size_t)t * 128 + lane * 2) = pk2(v0 * rr * kvn[lane * 2], v1 * rr * kvn[lane * 2 + 1]);
        }
        if (lane < 16) {
            const float x1 = bf2f(pr[384 + lane]), x2 = bf2f(pr[400 + lane]);
            const float cs = ROPEM[((size_t)t * 16 + lane) * 2], sn = ROPEM[((size_t)t * 16 + lane) * 2 + 1];
            KROPE[(size_t)t * 32 + lane] = (bf16_t)f2bf(x1 * cs - x2 * sn);
            KROPE[(size_t)t * 32 + 16 + lane] = (bf16_t)f2bf(x2 * cs + x1 * sn);
        }
        const int s = t & (SEQ - 1);
#pragma unroll 1
        for (int hg = 0; hg < 12; ++hg) {
            const int chn = hg * 128 + lane * 2;
            float a0 = 0.f, a1 = 0.f;
#pragma unroll
            for (int w = 0; w < 4; ++w) {
                if (s - 3 + w >= 0) {
                    const unsigned r = *(const unsigned*)(PROJ + (size_t)(t - 3 + w) * NPAD + 416 + chn);
                    a0 += cw[w * 1536 + chn] * bflo(r); a1 += cw[w * 1536 + chn + 1] * bfhi(r);
                }
            }
            float y0 = siluf_(a0), y1 = siluf_(a1);
            if (hg < 8) {
                const float ss = wave_sum(y0 * y0 + y1 * y1);
                float rr = rsqrtf(ss + 1e-6f);
                if (hg < 4) rr *= 0.08838834764831845f;
                y0 *= rr; y1 *= rr;
            }
            bf16_t* dst = (hg < 4) ? GQ : (hg < 8) ? GK : GV;
            *(unsigned*)(dst + (size_t)t * 512 + (hg & 3) * 128 + lane * 2) = pk2(y0, y1);
        }
        if (lane < 4) BETA[(size_t)t * 4 + lane] = sigmoidf_(GATES[(size_t)t * 8 + lane]);
        else if (lane < 8) { const int h = lane - 4; GLOG[(size_t)t * 4 + h] = -expf(a_log[h]) * softplusf_(GATES[(size_t)t * 8 + lane] + dt_bias[h]); }
    }
}

__device__ void phase_prep_odd(const bf16_t* PROJ, const float* ROPES, bf16_t* SQ, bf16_t* SK, const Ctx& c) {
    const int lane = c.lane;
    for (int t = c.bid * 4 + c.wid; t < T; t += c.nblk * 4) {
        const bf16_t* pr = PROJ + (size_t)t * NPAD;
        const int i = lane & 31;
        const float cs = ROPES[((size_t)t * 32 + i) * 2], sn = ROPES[((size_t)t * 32 + i) * 2 + 1];
#pragma unroll
        for (int r = 0; r < 4; ++r) {
            const int h = (lane >> 5) + 2 * r;
            const float x1 = bf2f(pr[1544 + h * 64 + i]), x2 = bf2f(pr[1544 + h * 64 + 32 + i]);
            SQ[(size_t)t * 512 + h * 64 + i] = (bf16_t)f2bf((x1 * cs - x2 * sn) * 0.125f);
            SQ[(size_t)t * 512 + h * 64 + 32 + i] = (bf16_t)f2bf((x2 * cs + x1 * sn) * 0.125f);
        }
        {
            const int h = lane >> 5;
            const float x1 = bf2f(pr[2056 + h * 64 + i]), x2 = bf2f(pr[2056 + h * 64 + 32 + i]);
            SK[(size_t)t * 128 + h * 64 + i] = (bf16_t)f2bf(x1 * cs - x2 * sn);
            SK[(size_t)t * 128 + h * 64 + 32 + i] = (bf16_t)f2bf(x2 * cs + x1 * sn);
        }
    }
}

__device__ __forceinline__ int next_unit(unsigned* ctr, const Ctx& c) {
    volatile int* su = (volatile int*)(c.smem + 65536 + 16);
    __syncthreads();
    if (c.tid == 0) *su = (int)atomicAdd(ctr, 1u);
    __syncthreads();
    return *su;
}

__device__ void mla_unit(int u, const bf16_t* QF, const bf16_t* KN, const bf16_t* KROPE, const bf16_t* VV, bf16_t* MIXO, const Ctx& c) {
    const int qb = 7 - (u >> 6), bh = u & 63, b = bh >> 3, h = bh & 7;
    const int s = qb * 256 + c.tid;
    const size_t t = (size_t)b * SEQ + s;
    float* tile = (float*)c.smem;
    float q[96], o[64];
#pragma unroll
    for (int i = 0; i < 12; ++i) {
        const u32x4 r = *(const u32x4*)(QF + t * 768 + h * 96 + i * 8);
        float f[8]; unpack8(r, f);
#pragma unroll
        for (int j = 0; j < 8; ++j) q[i * 8 + j] = f[j];
    }
#pragma unroll
    for (int i = 0; i < 64; ++i) o[i] = 0.f;
    float m = -1e30f, l = 0.f;
    const int nkt = (qb + 1) * 8;
    for (int kt = 0; kt < nkt; ++kt) {
        __syncthreads();
        for (int idx = c.tid; idx < 640; idx += 256) {
            const int key = idx / 20, chk = idx % 20;
            const size_t tk = (size_t)b * SEQ + kt * 32 + key;
            const bf16_t* src = (chk < 8) ? (KN + tk * 512 + h * 64 + chk * 8) : (chk < 12) ? (KROPE + tk * 32 + (chk - 8) * 8) : (VV + tk * 512 + h * 64 + (chk - 12) * 8);
            const u32x4 r = *(const u32x4*)src;
            float f[8]; unpack8(r, f);
            float* d = tile + key * 160 + chk * 8;
            *(f32x4*)d = (f32x4){f[0], f[1], f[2], f[3]}; *(f32x4*)(d + 4) = (f32x4){f[4], f[5], f[6], f[7]};
        }
        __syncthreads();
#pragma unroll 1
        for (int j = 0; j < 32; ++j) {
            const int key = kt * 32 + j;
            if (key <= s) {
                const float* kr = tile + j * 160;
                float sc = 0.f;
#pragma unroll
                for (int i = 0; i < 96; ++i) sc += q[i] * kr[i];
                const float mn = fmaxf(m, sc);
                const float al = __expf(m - mn), p = __expf(sc - mn);
                l = l * al + p;
#pragma unroll
                for (int i = 0; i < 64; ++i) o[i] = o[i] * al + p * kr[96 + i];
                m = mn;
            }
        }
    }
    const float inv = 1.f / l;
#pragma unroll
    for (int i = 0; i < 8; ++i)
        *(u32x4*)(MIXO + t * 1024 + h * 64 + i * 8) = (u32x4){pk2(o[i * 8] * inv, o[i * 8 + 1] * inv), pk2(o[i * 8 + 2] * inv, o[i * 8 + 3] * inv),
                                                             pk2(o[i * 8 + 4] * inv, o[i * 8 + 5] * inv), pk2(o[i * 8 + 6] * inv, o[i * 8 + 7] * inv)};
}

__device__ void gdn_unit(int u, const bf16_t* GQ, const bf16_t* GK, const bf16_t* GV, const float* BETA, const float* GLOG,
                         const bf16_t* PROJ, const float* gnorm, bf16_t* MIXO, const Ctx& c) {
    const int b = u >> 2, h = u & 3;
    float* kf = (float*)c.smem; float* qf = kf + 16 * 128; float* vf = qf + 16 * 128; float* ob = vf + 16 * 128;
    float* bt = ob + 16 * 128; float* av = bt + 16;
    float S[64];
#pragma unroll
    for (int i = 0; i < 64; ++i) S[i] = 0.f;
    const int j = c.wid * 32 + (c.lane & 31), half = c.lane >> 5;
    for (int c0 = 0; c0 < SEQ; c0 += 16) {
        const size_t t0 = (size_t)b * SEQ + c0;
        __syncthreads();
#pragma unroll
        for (int i = 0; i < 3; ++i) {
            const int idx = c.tid + 256 * i, arr = idx >> 8, r = idx & 255, tok = r >> 4, chk = r & 15;
            const bf16_t* src = ((arr == 0) ? GK : (arr == 1) ? GQ : GV) + (t0 + tok) * 512 + h * 128 + chk * 8;
            const u32x4 rr = *(const u32x4*)src;
            float f[8]; unpack8(rr, f);
            float* d = kf + arr * 2048 + tok * 128 + chk * 8;
            *(f32x4*)d = (f32x4){f[0], f[1], f[2], f[3]}; *(f32x4*)(d + 4) = (f32x4){f[4], f[5], f[6], f[7]};
        }
        if (c.tid < 16) { bt[c.tid] = BETA[(t0 + c.tid) * 4 + h]; av[c.tid] = expf(GLOG[(t0 + c.tid) * 4 + h]); }
        __syncthreads();
#pragma unroll 1
        for (int tt = 0; tt < 16; ++tt) {
            const float* kr = kf + tt * 128 + half * 64; const float* qr = qf + tt * 128 + half * 64;
            const float a = av[tt];
            float kS = 0.f;
#pragma unroll
            for (int i = 0; i < 64; ++i) kS += kr[i] * S[i];
            kS += __shfl_xor(kS, 32);
            const float vn = bt[tt] * (vf[tt * 128 + j] - a * kS);
            float o = 0.f;
#pragma unroll
            for (int i = 0; i < 64; ++i) { S[i] = a * S[i] + kr[i] * vn; o += qr[i] * S[i]; }
            o += __shfl_xor(o, 32);
            if (half == 0) ob[tt * 128 + j] = o;
        }
        __syncthreads();
#pragma unroll
        for (int k = 0; k < 4; ++k) {
            const int tt = c.wid * 4 + k;
            const float o0 = ob[tt * 128 + c.lane * 2], o1 = ob[tt * 128 + c.lane * 2 + 1];
            const float rr = rsqrtf(wave_sum(o0 * o0 + o1 * o1) * (1.f / 128.f) + 1e-6f);
            const unsigned zr = *(const unsigned*)(PROJ + (t0 + tt) * NPAD + 1960 + h * 128 + c.lane * 2);
            const float y0 = o0 * rr * gnorm[c.lane * 2] * siluf_(bflo(zr)), y1 = o1 * rr * gnorm[c.lane * 2 + 1] * siluf_(bfhi(zr));
            *(unsigned*)(MIXO + (t0 + tt) * 1024 + 512 + h * 128 + c.lane * 2) = pk2(y0, y1);
        }
    }
}

__device__ void mlstm_unit(int u, const bf16_t* PROJ, const float* GATES, const float* b_i, const float* b_f, const float* mnorm, bf16_t* MIXO, const Ctx& c) {
    const int b = u >> 2, h = u & 3;
    float* kf = (float*)c.smem; float* qf = kf + 16 * 64; float* vf = qf + 16 * 64; float* ob = vf + 16 * 128;
    float* ip = ob + 16 * 128; float* lf = ip + 16;
    float C[32], nn[32];
#pragma unroll
    for (int i = 0; i < 32; ++i) { C[i] = 0.f; nn[i] = 0.f; }
    float mst = 0.f;
    const int j = c.wid * 32 + (c.lane & 31), half = c.lane >> 5;
    const float bi = b_i[h], bfv = b_f[h];
    for (int c0 = 0; c0 < SEQ; c0 += 16) {
        const size_t t0 = (size_t)b * SEQ + c0;
        __syncthreads();
        {
            const int idx = c.tid;
            if (idx < 128) { const int tok = idx >> 3, chk = idx & 7;
                const u32x4 rr = *(const u32x4*)(PROJ + (t0 + tok) * NPAD + 256 + h * 64 + chk * 8); float f[8]; unpack8(rr, f);
                float* d = kf + tok * 64 + chk * 8; *(f32x4*)d = (f32x4){f[0], f[1], f[2], f[3]}; *(f32x4*)(d + 4) = (f32x4){f[4], f[5], f[6], f[7]}; }
            else { const int i2 = idx - 128, tok = i2 >> 3, chk = i2 & 7;
                const u32x4 rr = *(const u32x4*)(PROJ + (t0 + tok) * NPAD + h * 64 + chk * 8); float f[8]; unpack8(rr, f);
                float* d = qf + tok * 64 + chk * 8; *(f32x4*)d = (f32x4){f[0], f[1], f[2], f[3]}; *(f32x4*)(d + 4) = (f32x4){f[4], f[5], f[6], f[7]}; }
            { const int tok = idx >> 4, chk = idx & 15;
                const u32x4 rr = *(const u32x4*)(PROJ + (t0 + tok) * NPAD + 512 + h * 128 + chk * 8); float f[8]; unpack8(rr, f);
                float* d = vf + tok * 128 + chk * 8; *(f32x4*)d = (f32x4){f[0], f[1], f[2], f[3]}; *(f32x4*)(d + 4) = (f32x4){f[4], f[5], f[6], f[7]}; }
            if (idx < 16) { ip[idx] = GATES[(t0 + idx) * 8 + h] + bi; lf[idx] = -softplusf_(-(GATES[(t0 + idx) * 8 + 4 + h] + bfv)); }
        }
        __syncthreads();
#pragma unroll 1
        for (int tt = 0; tt < 16; ++tt) {
            const float* kr = kf + tt * 64 + half * 32; const float* qr = qf + tt * 64 + half * 32;
            const float mn = fmaxf(lf[tt] + mst, ip[tt]);
            const float fs = expf(lf[tt] + mst - mn), is = expf(ip[tt] - mn) * 0.125f;
            mst = mn;
            const float vj = vf[tt * 128 + j] * is;
            float num = 0.f, den = 0.f;
#pragma unroll
            for (int i = 0; i < 32; ++i) {
                C[i] = fs * C[i] + kr[i] * vj; nn[i] = fs * nn[i] + kr[i] * is;
                num += qr[i] * C[i]; den += qr[i] * nn[i];
            }
            num += __shfl_xor(num, 32); den += __shfl_xor(den, 32);
            if (half == 0) ob[tt * 128 + j] = num / fmaxf(fabsf(den), expf(-mn));
        }
        __syncthreads();
#pragma unroll
        for (int k = 0; k < 4; ++k) {
            const int tt = c.wid * 4 + k;
            const float o0 = ob[tt * 128 + c.lane * 2], o1 = ob[tt * 128 + c.lane * 2 + 1];
            const float rr = rsqrtf(wave_sum(o0 * o0 + o1 * o1) * (1.f / 128.f) + 1e-6f);
            const unsigned zr = *(const unsigned*)(PROJ + (t0 + tt) * NPAD + 1032 + h * 128 + c.lane * 2);
            const float y0 = o0 * rr * mnorm[h * 128 + c.lane * 2] * sigmoidf_(bflo(zr)), y1 = o1 * rr * mnorm[h * 128 + c.lane * 2 + 1] * sigmoidf_(bfhi(zr));
            *(unsigned*)(MIXO + (t0 + tt) * 1024 + h * 128 + c.lane * 2) = pk2(y0, y1);
        }
    }
}

__device__ void swa_unit(int u, const bf16_t* SQ, const bf16_t* SK, const bf16_t* PROJ, const float* sinks, bf16_t* MIXO, const Ctx& c) {
    const int half = u & 1, n = (u >> 1) & 15, kvh = (u >> 5) & 1, b = u >> 6;
    bf16_t* Kb = (bf16_t*)c.smem; bf16_t* Vb = Kb + 256 * 64;
    const int kstart = (n - 1) * 128;
    __syncthreads();
    for (int idx = c.tid; idx < 4096; idx += 256) {
        const int arr = idx >> 11, r = idx & 2047, kj = r >> 3, chk = r & 7;
        const int kpos = kstart + kj;
        u32x4 v = (u32x4){0u, 0u, 0u, 0u};
        if (kpos >= 0) {
            const size_t tk = (size_t)b * SEQ + kpos;
            v = arr ? *(const u32x4*)(PROJ + tk * NPAD + 2184 + kvh * 64 + chk * 8) : *(const u32x4*)(SK + tk * 128 + kvh * 64 + chk * 8);
        }
        *(u32x4*)((arr ? Vb : Kb) + kj * 64 + chk * 8) = v;
    }
    __syncthreads();
    const int qi = c.tid & 127, g = half * 2 + (c.tid >> 7), hq = kvh * 4 + g;
    const size_t t = (size_t)b * SEQ + n * 128 + qi;
    float q[64], o[64];
#pragma unroll
    for (int i = 0; i < 8; ++i) {
        const u32x4 r = *(const u32x4*)(SQ + t * 512 + hq * 64 + i * 8);
        float f[8]; unpack8(r, f);
#pragma unroll
        for (int jj = 0; jj < 8; ++jj) q[i * 8 + jj] = f[jj];
    }
#pragma unroll
    for (int i = 0; i < 64; ++i) o[i] = 0.f;
    float m = sinks[hq], l = 1.f;
#pragma unroll 1
    for (int kj = (n == 0) ? 128 : 0; kj < 256; ++kj) {
        const int rel = qi + 128 - kj;
        if (rel >= 0 && rel < 128) {
            float sc = 0.f;
#pragma unroll
            for (int i = 0; i < 8; ++i) {
                const u32x4 r = *(const u32x4*)(Kb + kj * 64 + i * 8);
                float f[8]; unpack8(r, f);
#pragma unroll
                for (int jj = 0; jj < 8; ++jj) sc += q[i * 8 + jj] * f[jj];
            }
            const float mn = fmaxf(m, sc);
            const float al = __expf(m - mn), p = __expf(sc - mn);
            l = l * al + p; m = mn;
#pragma unroll
            for (int i = 0; i < 8; ++i) {
                const u32x4 r = *(const u32x4*)(Vb + kj * 64 + i * 8);
                float f[8]; unpack8(r, f);
#pragma unroll
                for (int jj = 0; jj < 8; ++jj) o[i * 8 + jj] = o[i * 8 + jj] * al + p * f[jj];
            }
        }
    }
    const float inv = 1.f / l;
#pragma unroll
    for (int i = 0; i < 8; ++i)
        *(u32x4*)(MIXO + t * 1024 + 512 + hq * 64 + i * 8) = (u32x4){pk2(o[i * 8] * inv, o[i * 8 + 1] * inv), pk2(o[i * 8 + 2] * inv, o[i * 8 + 3] * inv),
                                                                   pk2(o[i * 8 + 4] * inv, o[i * 8 + 5] * inv), pk2(o[i * 8 + 6] * inv, o[i * 8 + 7] * inv)};
}

__device__ __forceinline__ float dppf(float v, int ctrl_sel) {
    int x = __builtin_bit_cast(int, v), r;
    if (ctrl_sel == 0) r = __builtin_amdgcn_update_dpp(0, x, 0xB1, 0xF, 0xF, true);
    else if (ctrl_sel == 1) r = __builtin_amdgcn_update_dpp(0, x, 0x4E, 0xF, 0xF, true);
    else if (ctrl_sel == 2) r = __builtin_amdgcn_update_dpp(0, x, 0x141, 0xF, 0xF, true);
    else r = __builtin_amdgcn_update_dpp(0, x, 0x140, 0xF, 0xF, true);
    return __builtin_bit_cast(float, r);
}
__device__ __forceinline__ float red16(float v) { v += dppf(v, 0); v += dppf(v, 1); v += dppf(v, 2); v += dppf(v, 3); return v; }

__device__ void gdn_unit2(int u, const bf16_t* GQ, const bf16_t* GK, const bf16_t* GV, const float* BETA, const float* GLOG, float* OG, const Ctx& c) {
    const int sl = u & 7, bh = u >> 3, b = bh >> 2, h = bh & 3;
    const int col = c.tid >> 4, rc = c.tid & 15;
    float* kf = (float*)c.smem; float* qf = kf + 32 * 128; float* vf = qf + 32 * 128; float* bt = vf + 32 * 16; float* av = bt + 32;
    float S[8];
#pragma unroll
    for (int i = 0; i < 8; ++i) S[i] = 0.f;
    const size_t tb = (size_t)b * SEQ;
    u32x4 rk[2], rq[2], rv; float rg = 0.f;
    const int tok0 = c.tid >> 4, chk = c.tid & 15;
#define GDN_LOAD(c0) do { \
        _Pragma("unroll") for (int i = 0; i < 2; ++i) { const size_t t = tb + (c0) + tok0 + 16 * i; \
            rk[i] = *(const u32x4*)(GK + t * 512 + h * 128 + chk * 8); rq[i] = *(const u32x4*)(GQ + t * 512 + h * 128 + chk * 8); } \
        if (c.tid < 64) rv = *(const u32x4*)(GV + (tb + (c0) + (c.tid >> 1)) * 512 + h * 128 + sl * 16 + (c.tid & 1) * 8); \
        if (c.tid < 32) rg = BETA[(tb + (c0) + c.tid) * 4 + h]; else if (c.tid < 64) rg = GLOG[(tb + (c0) + c.tid - 32) * 4 + h]; } while (0)
    GDN_LOAD(0);
    for (int c0 = 0; c0 < SEQ; c0 += 32) {
        __syncthreads();
#pragma unroll
        for (int i = 0; i < 2; ++i) {
            float f[8]; unpack8(rk[i], f);
            float* d = kf + (tok0 + 16 * i) * 128 + chk * 8;
            *(f32x4*)d = (f32x4){f[0], f[1], f[2], f[3]}; *(f32x4*)(d + 4) = (f32x4){f[4], f[5], f[6], f[7]};
            unpack8(rq[i], f);
            d = qf + (tok0 + 16 * i) * 128 + chk * 8;
            *(f32x4*)d = (f32x4){f[0], f[1], f[2], f[3]}; *(f32x4*)(d + 4) = (f32x4){f[4], f[5], f[6], f[7]};
        }
        if (c.tid < 64) { float f[8]; unpack8(rv, f); float* d = vf + (c.tid >> 1) * 16 + (c.tid & 1) * 8;
            *(f32x4*)d = (f32x4){f[0], f[1], f[2], f[3]}; *(f32x4*)(d + 4) = (f32x4){f[4], f[5], f[6], f[7]}; }
        if (c.tid < 32) bt[c.tid] = rg; else if (c.tid < 64) av[c.tid - 32] = expf(rg);
        if (c0 + 32 < SEQ) GDN_LOAD(c0 + 32);
        __syncthreads();
#pragma unroll 2
        for (int tt = 0; tt < 32; ++tt) {
            const f32x4 k0 = *(const f32x4*)(kf + tt * 128 + rc * 8), k1 = *(const f32x4*)(kf + tt * 128 + rc * 8 + 4);
            const f32x4 q0 = *(const f32x4*)(qf + tt * 128 + rc * 8), q1 = *(const f32x4*)(qf + tt * 128 + rc * 8 + 4);
            const float a = av[tt];
            float part = (k0[0] * S[0] + k0[1] * S[1]) + (k0[2] * S[2] + k0[3] * S[3]) + (k1[0] * S[4] + k1[1] * S[5]) + (k1[2] * S[6] + k1[3] * S[7]);
            const float kS = red16(part);
            const float vn = bt[tt] * (vf[tt * 16 + col] - a * kS);
#pragma unroll
            for (int i = 0; i < 4; ++i) { S[i] = a * S[i] + k0[i] * vn; S[4 + i] = a * S[4 + i] + k1[i] * vn; }
            float po = (q0[0] * S[0] + q0[1] * S[1]) + (q0[2] * S[2] + q0[3] * S[3]) + (q1[0] * S[4] + q1[1] * S[5]) + (q1[2] * S[6] + q1[3] * S[7]);
            po = red16(po);
            if (rc == 0) OG[(tb + c0 + tt) * 512 + h * 128 + sl * 16 + col] = po;
        }
    }
#undef GDN_LOAD
}

__device__ void mlstm_unit2(int u, const bf16_t* PROJ, const float* GATES, const float* b_i, const float* b_f, float* OG, const Ctx& c) {
    const int sl = u & 7, bh = u >> 3, b = bh >> 2, h = bh & 3;
    const int col = c.tid >> 4, rc = c.tid & 15;
    float* kf = (float*)c.smem; float* qf = kf + 32 * 64; float* vf = qf + 32 * 64; float* ip = vf + 32 * 16; float* lf = ip + 32;
    float C[4], nn[4];
#pragma unroll
    for (int i = 0; i < 4; ++i) { C[i] = 0.f; nn[i] = 0.f; }
    float mst = 0.f;
    const size_t tb = (size_t)b * SEQ;
    const float bi = b_i[h], bfv = b_f[h];
    u32x4 rk, rq, rv; float rg = 0.f;
    const int tok0 = c.tid >> 3, chk = c.tid & 7;
#define ML_LOAD(c0) do { const size_t t = tb + (c0) + tok0; \
        rk = *(const u32x4*)(PROJ + t * NPAD + 256 + h * 64 + chk * 8); rq = *(const u32x4*)(PROJ + t * NPAD + h * 64 + chk * 8); \
        if (c.tid < 64) rv = *(const u32x4*)(PROJ + (tb + (c0) + (c.tid >> 1)) * NPAD + 512 + h * 128 + sl * 16 + (c.tid & 1) * 8); \
        if (c.tid < 32) rg = GATES[(tb + (c0) + c.tid) * 8 + h]; else if (c.tid < 64) rg = GATES[(tb + (c0) + c.tid - 32) * 8 + 4 + h]; } while (0)
    ML_LOAD(0);
    for (int c0 = 0; c0 < SEQ; c0 += 32) {
        __syncthreads();
        {
            float f[8]; unpack8(rk, f);
            float* d = kf + tok0 * 64 + chk * 8;
            *(f32x4*)d = (f32x4){f[0], f[1], f[2], f[3]}; *(f32x4*)(d + 4) = (f32x4){f[4], f[5], f[6], f[7]};
            unpack8(rq, f);
            d = qf + tok0 * 64 + chk * 8;
            *(f32x4*)d = (f32x4){f[0], f[1], f[2], f[3]}; *(f32x4*)(d + 4) = (f32x4){f[4], f[5], f[6], f[7]};
        }
        if (c.tid < 64) { float f[8]; unpack8(rv, f); float* d = vf + (c.tid >> 1) * 16 + (c.tid & 1) * 8;
            *(f32x4*)d = (f32x4){f[0], f[1], f[2], f[3]}; *(f32x4*)(d + 4) = (f32x4){f[4], f[5], f[6], f[7]}; }
        if (c.tid < 32) ip[c.tid] = rg + bi; else if (c.tid < 64) lf[c.tid - 32] = -softplusf_(-(rg + bfv));
        if (c0 + 32 < SEQ) ML_LOAD(c0 + 32);
        __syncthreads();
#pragma unroll 2
        for (int tt = 0; tt < 32; ++tt) {
            const f32x4 k4 = *(const f32x4*)(kf + tt * 64 + rc * 4), q4 = *(const f32x4*)(qf + tt * 64 + rc * 4);
            const float lft = lf[tt], ipt = ip[tt];
            const float mn = fmaxf(lft + mst, ipt);
            const float fs = __expf(lft + mst - mn), is = __expf(ipt - mn) * 0.125f;
            mst = mn;
            const float vj = vf[tt * 16 + col] * is;
            float pn = 0.f, pd = 0.f;
#pragma unroll
            for (int i = 0; i < 4; ++i) { C[i] = fs * C[i] + k4[i] * vj; nn[i] = fs * nn[i] + k4[i] * is; pn += q4[i] * C[i]; pd += q4[i] * nn[i]; }
            pn = red16(pn); pd = red16(pd);
            if (rc == 0) OG[(tb + c0 + tt) * 512 + h * 128 + sl * 16 + col] = pn / fmaxf(fabsf(pd), __expf(-mn));
        }
    }
#undef ML_LOAD
}

__device__ void phase_post(const float* OG, const bf16_t* PROJ, const float* gain, bool odd, bf16_t* MIXO, const Ctx& c) {
    const int lane = c.lane;
    const int gcol = odd ? 1032 : 1960, ocol = odd ? 0 : 512;
    for (int t = c.bid * 4 + c.wid; t < T; t += c.nblk * 4) {
        const f32x4 a0 = *(const f32x4*)(OG + (size_t)t * 512 + lane * 8), a1 = *(const f32x4*)(OG + (size_t)t * 512 + lane * 8 + 4);
        float ss = (a0[0] * a0[0] + a0[1] * a0[1]) + (a0[2] * a0[2] + a0[3] * a0[3]) + (a1[0] * a1[0] + a1[1] * a1[1]) + (a1[2] * a1[2] + a1[3] * a1[3]);
        ss = red16(ss);
        const float rr = rsqrtf(ss * (1.f / 128.f) + 1e-6f);
        const u32x4 zr = *(const u32x4*)(PROJ + (size_t)t * NPAD + gcol + lane * 8);
        float z[8]; unpack8(zr, z);
        const int gi = odd ? lane * 8 : (lane & 15) * 8;
        const f32x4 g0 = *(const f32x4*)(gain + gi), g1 = *(const f32x4*)(gain + gi + 4);
        float y[8];
#pragma unroll
        for (int j = 0; j < 4; ++j) {
            const float ga = odd ? sigmoidf_(z[j]) : siluf_(z[j]), gb = odd ? sigmoidf_(z[4 + j]) : siluf_(z[4 + j]);
            y[j] = a0[j] * rr * g0[j] * ga; y[4 + j] = a1[j] * rr * g1[j] * gb;
        }
        *(u32x4*)(MIXO + (size_t)t * 1024 + ocol + lane * 8) = (u32x4){pk2(y[0], y[1]), pk2(y[2], y[3]), pk2(y[4], y[5]), pk2(y[6], y[7])};
    }
}

__global__ void __launch_bounds__(256, 2) fwd(Args a) {
    extern __shared__ __attribute__((aligned(16))) unsigned char smem[];
    Ctx c;
    c.tid = threadIdx.x; c.lane = c.tid & 63; c.wid = c.tid >> 6; c.wr = c.wid >> 1; c.wc = c.wid & 1; c.fr = c.lane & 15; c.fq = c.lane >> 4;
    c.bid = blockIdx.x; c.nblk = gridDim.x; c.smem = smem;
#define PH_CTX() do { int t_ = threadIdx.x; asm volatile("" : "+v"(t_)); c.tid = t_; c.lane = t_ & 63; c.wid = t_ >> 6; c.wr = c.wid >> 1; c.wc = c.wid & 1; c.fr = c.lane & 15; c.fq = c.lane >> 4; } while (0)
    unsigned char* ws = a.ws;
    unsigned* ctl = (unsigned*)(ws + WS_CTL);
    volatile LAS unsigned* xbw = (volatile LAS unsigned*)(smem + 65536);
    if (c.tid < 8) xbw[c.tid] = 0u;
    __syncthreads();
    XcdBarrier bar; bar.bar = ctl; bar.x = 0; bar.st = xbw;
    if (a.use_bar) bar = xcd_barrier_post(ctl, xbw);
    const int lo = a.ph_lo, hi = a.ph_hi;
#define IN(k) (lo <= (k) && (k) < hi)
#define PH(k) if (IN(k)) { PH_CTX();
#define SEAM(k) do { if ((k) + 1 < hi) xcd_barrier(bar); } while (0)

    bf16_t* XBF = (bf16_t*)(ws + WS_XBF);
    float* X1 = (float*)(ws + WS_X1);
    bf16_t* PROJ = (bf16_t*)(ws + U_PROJ);
    float* GATES = (float*)(ws + U_GATES);
    bf16_t* MIXO = (bf16_t*)(ws + U_MIXO);
    float* YBUF = (float*)(ws + U_YBUF);
    const float* ROPEM = (const float*)(ws + WS_ROPEM);
    const float* ROPES = (const float*)(ws + WS_ROPES);

    PH(0) for (int rep = 0; rep < REP_PRO; ++rep) phase_prologue(a, c); SEAM(0); }

    for (int layer = 0; layer < 4; ++layer) {
        const int pb = 1 + layer * PPL;
        if (pb >= hi || pb + PPL <= lo) continue;
        const int jj = layer >> 1;
        const bool odd = (layer & 1) != 0;
        const float* xres = (layer == 0) ? (const float*)a.in[0] : (const float*)a.out;
        unsigned* CNT = ctl + CW_CNT + layer * 128;
        const bf16_t* WIN = (const bf16_t*)(ws + WS_WIN) + (size_t)layer * WIN_ELEMS;
        const bf16_t* WOUT = (const bf16_t*)(ws + WS_WOUT) + (size_t)layer * WOUT_ELEMS;

        PH(pb + 0) for (int rep = 0; rep < REP_GEMM; ++rep) phase_inproj(XBF, WIN, PROJ, GATES, odd ? 1024 : 1952, c); SEAM(pb + 0); }
        PH(pb + 1)
            for (int rep = 0; rep < REP_TOK; ++rep) if (!odd) phase_prep_even(PROJ, GATES, (const float*)a.in[3] + jj * 256, (const float*)a.in[5] + jj * 128, (const float*)a.in[7] + jj * 4 * 1536,
                                      (const float*)a.in[8] + jj * 4, (const float*)a.in[9] + jj * 4, ROPEM,
                                      (bf16_t*)(ws + U_CQ), (bf16_t*)(ws + U_CKV), (bf16_t*)(ws + U_KROPE), (bf16_t*)(ws + U_GQ), (bf16_t*)(ws + U_GK), (bf16_t*)(ws + U_GV),
                                      (float*)(ws + U_BETA), (float*)(ws + U_GLOG), c);
            else phase_prep_odd(PROJ, ROPES, (bf16_t*)(ws + U_QF), (bf16_t*)(ws + U_KN), c);
            SEAM(pb + 1);
        }
        PH(pb + 2)
            if (!odd) for (int rep = 0; rep < REP_GEMM; ++rep) phase_mla_up((const bf16_t*)(ws + U_CQ), (const bf16_t*)(ws + WS_WQB) + (size_t)jj * WQB_ELEMS, (const bf16_t*)(ws + U_CKV),
                                   (const bf16_t*)(ws + WS_WKVB) + (size_t)jj * WKVB_ELEMS, ROPEM, (bf16_t*)(ws + U_QF), (bf16_t*)(ws + U_KN), (bf16_t*)(ws + U_VV), c);
            SEAM(pb + 2);
        }
        PH(pb + 3)
            unsigned* ctr = ctl + CW_WORK + pb + 3;
            float* OG = YBUF;
            if (!odd) {
                for (;;) {
                    const int u = next_unit(ctr, c);
                    if (u >= 256 + 512) break;
                    if (u < 256) gdn_unit2(u, (const bf16_t*)(ws + U_GQ), (const bf16_t*)(ws + U_GK), (const bf16_t*)(ws + U_GV), (const float*)(ws + U_BETA),
                                           (const float*)(ws + U_GLOG), OG, c);
                    else mla_unit(u - 256, (const bf16_t*)(ws + U_QF), (const bf16_t*)(ws + U_KN), (const bf16_t*)(ws + U_KROPE), (const bf16_t*)(ws + U_VV), MIXO, c);
                }
            } else {
                for (;;) {
                    const int u = next_unit(ctr, c);
                    if (u >= 256 + 512) break;
                    if (u < 256) mlstm_unit2(u, PROJ, GATES, (const float*)a.in[13] + jj * 4, (const float*)a.in[14] + jj * 4, OG, c);
                    else swa_unit(u - 256, (const bf16_t*)(ws + U_QF), (const bf16_t*)(ws + U_KN), PROJ, (const float*)a.in[16] + jj * 8, MIXO, c);
                }
            }
            SEAM(pb + 3);
        }
        PH(pb + 4) phase_post(YBUF, PROJ, odd ? (const float*)a.in[15] + jj * 512 : (const float*)a.in[10] + jj * 128, odd, MIXO, c); SEAM(pb + 4); }
        PH(pb + 5) for (int rep = 0; rep < REP_GEMM; ++rep) phase_outproj(MIXO, WOUT, xres, YBUF, c); SEAM(pb + 5); }
        PH(pb + 6) for (int rep = 0; rep < REP_TOK; ++rep) phase_ln1(YBUF, (const float*)a.in[18] + layer * 1024, (const float*)a.in[19] + layer * 1024, X1, XBF, c); SEAM(pb + 6); }
        PH(pb + 7) for (int rep = 0; rep < REP_GEMM; ++rep) phase_router(XBF, (const bf16_t*)(ws + WS_WRT) + (size_t)layer * WRT_ELEMS, (float*)(ws + WS_LOG), c); SEAM(pb + 7); }
        PH(pb + 8) phase_route((const float*)(ws + WS_LOG), (const float*)a.in[21] + layer * 64, CNT, (int*)(ws + WS_LTOK), (float*)(ws + WS_LW), (int*)(ws + WS_ASG), c); SEAM(pb + 8); }
        PH(pb + 9) for (int rep = 0; rep < REP_GEMM; ++rep) phase_moe1(XBF, (const bf16_t*)(ws + WS_WGU) + (size_t)layer * 65 * WGU_ELEMS, CNT, (const int*)(ws + WS_LTOK), (bf16_t*)(ws + WS_HBUF), c); SEAM(pb + 9); }
        PH(pb + 10) for (int rep = 0; rep < REP_GEMM; ++rep) phase_moe2((const bf16_t*)(ws + WS_HBUF), (const bf16_t*)(ws + WS_WDN) + (size_t)layer * 65 * WDN_ELEMS, CNT, (const float*)(ws + WS_LW), (bf16_t*)(ws + U_Y), c); SEAM(pb + 10); }
        PH(pb + 11) phase_combine(X1, (const bf16_t*)(ws + U_Y), (const int*)(ws + WS_ASG), CNT, (const float*)a.in[28] + layer * 1024, (const float*)a.in[29] + layer * 1024,
                                         a.out, XBF, c); SEAM(pb + 11); }
    }
#undef IN
#undef PH
#undef PH_CTX
#undef SEAM
}

extern "C" void kernel_launch(void* const* d_in, const int* in_sizes, int n_in, void* d_out, int out_size, void* d_ws, size_t ws_size, hipStream_t stream) {
    static int grid = 0;
    if (grid == 0) {
        if (n_in != 30 || out_size != T * 1024 || ws_size < WS_END) {
            fprintf(stderr, "kernel_launch: unexpected shapes (n_in %d, out %d, ws %zu < %zu)\n", n_in, out_size, ws_size, (size_t)WS_END);
            grid = -1; return;
        }
        int dev = 0, cus = 0, per_cu = 0;
        (void)hipGetDevice(&dev);
        (void)hipDeviceGetAttribute(&cus, hipDeviceAttributeMultiprocessorCount, dev);
        (void)hipFuncSetAttribute((const void*)fwd, hipFuncAttributeMaxDynamicSharedMemorySize, DYN_LDS);
        (void)hipOccupancyMaxActiveBlocksPerMultiprocessor(&per_cu, (const void*)fwd, 256, DYN_LDS);
        (void)hipGetLastError();
        if (per_cu < 1) per_cu = 1;
        grid = cus * (per_cu < 2 ? per_cu : 2);
    }
    if (grid < 0) return;
    (void)hipMemsetAsync((char*)d_ws + WS_CTL, 0, CTL_BYTES, stream);
    Args a{};
    for (int i = 0; i < 30; ++i) a.in[i] = d_in[i];
    a.out = (float*)d_out; a.ws = (unsigned char*)d_ws; a.pad = 0;
#if ONE_LAUNCH
    a.ph_lo = 0; a.ph_hi = NPH; a.use_bar = 1;
    hipLaunchKernelGGL(fwd, dim3(grid), dim3(256), DYN_LDS, stream, a);
#else
    for (int p = 0; p < NPH; ++p) {
        a.ph_lo = p; a.ph_hi = p + 1; a.use_bar = 0;
        hipLaunchKernelGGL(fwd, dim3(grid), dim3(256), DYN_LDS, stream, a);
    }
#endif
}
```

```cpp
#include <hip/hip_runtime.h>
#include <stdint.h>
#include <stdio.h>

#define REP_GEMM 1
#define REP_PRO 1
#define REP_TOK 1
#ifndef ONE_LAUNCH
#define ONE_LAUNCH 1
#endif

typedef unsigned short bf16_t;
typedef short bf16x8 __attribute__((ext_vector_type(8)));
typedef float f32x4 __attribute__((ext_vector_type(4)));
typedef unsigned u32x4 __attribute__((ext_vector_type(4)));
typedef unsigned u32x2 __attribute__((ext_vector_type(2)));
#define LAS __attribute__((address_space(3)))
#define GAS __attribute__((address_space(1)))

constexpr int T = 16384, SEQ = 2048;
constexpr int NPAD = 2560;
constexpr int CAP = 16384;
constexpr int MAXRB = 1024 + 64 + 128;
constexpr int MAXROWS = MAXRB * 128;
constexpr float ALPHA = 1.681792830507429f;
constexpr int PPL = 12;
constexpr int NPH = 1 + 4 * PPL;
constexpr int DYN_LDS = 65536 + 64;

constexpr size_t cmax(size_t a, size_t b) { return a > b ? a : b; }
constexpr size_t WS_CTL = 0;
constexpr size_t CTL_BYTES = 65536;
constexpr size_t WS_WIN = WS_CTL + CTL_BYTES;
constexpr size_t WIN_ELEMS = (size_t)NPAD * 1024;
constexpr size_t WS_WQB = WS_WIN + 4 * WIN_ELEMS * 2;
constexpr size_t WQB_ELEMS = 768 * 256;
constexpr size_t WS_WKVB = WS_WQB + 2 * WQB_ELEMS * 2;
constexpr size_t WKVB_ELEMS = 1024 * 128;
constexpr size_t WS_WOUT = WS_WKVB + 2 * WKVB_ELEMS * 2;
constexpr size_t WOUT_ELEMS = 1024 * 1024;
constexpr size_t WS_WRT = WS_WOUT + 4 * WOUT_ELEMS * 2;
constexpr size_t WRT_ELEMS = 128 * 1024;
constexpr size_t WS_WGU = WS_WRT + 4 * WRT_ELEMS * 2;
constexpr size_t WGU_ELEMS = 512 * 1024;
constexpr size_t WS_WDN = WS_WGU + 4 * 65 * WGU_ELEMS * 2;
constexpr size_t WDN_ELEMS = 1024 * 256;
constexpr size_t WS_ROPEM = WS_WDN + 4 * 65 * WDN_ELEMS * 2;
constexpr size_t WS_ROPES = WS_ROPEM + (size_t)T * 16 * 2 * 4;
constexpr size_t WS_X1 = WS_ROPES + (size_t)T * 32 * 2 * 4;
constexpr size_t WS_XBF = WS_X1 + (size_t)T * 1024 * 4;
constexpr size_t WS_HBUF = WS_XBF + (size_t)T * 1024 * 2;
constexpr size_t WS_LOG = WS_HBUF + (size_t)MAXROWS * 256 * 2;
constexpr size_t WS_ASG = WS_LOG + (size_t)T * 64 * 4;
constexpr size_t WS_LTOK = WS_ASG + (size_t)T * 8 * 4;
constexpr size_t WS_LW = WS_LTOK + (size_t)65 * CAP * 4;
constexpr size_t WS_U = WS_LW + (size_t)65 * CAP * 4;
constexpr size_t U_Y = WS_U;
constexpr size_t U_PROJ = WS_U;
constexpr size_t U_GATES = U_PROJ + (size_t)T * NPAD * 2;
constexpr size_t U_CQ = U_GATES + (size_t)T * 8 * 4;
constexpr size_t U_CKV = U_CQ + (size_t)T * 256 * 2;
constexpr size_t U_KROPE = U_CKV + (size_t)T * 128 * 2;
constexpr size_t U_QF = U_KROPE + (size_t)T * 32 * 2;
constexpr size_t U_KN = U_QF + (size_t)T * 768 * 2;
constexpr size_t U_VV = U_KN + (size_t)T * 512 * 2;
constexpr size_t U_GQ = U_VV + (size_t)T * 512 * 2;
constexpr size_t U_GK = U_GQ + (size_t)T * 512 * 2;
constexpr size_t U_GV = U_GK + (size_t)T * 512 * 2;
constexpr size_t U_BETA = U_GV + (size_t)T * 512 * 2;
constexpr size_t U_GLOG = U_BETA + (size_t)T * 4 * 4;
constexpr size_t U_MIXO = U_GLOG + (size_t)T * 4 * 4;
constexpr size_t U_YBUF = U_MIXO + (size_t)T * 1024 * 2;
constexpr size_t U_END1 = U_YBUF + (size_t)T * 1024 * 4;
constexpr size_t WS_END = WS_U + cmax((size_t)MAXROWS * 1024 * 2, U_END1 - WS_U);

constexpr int CW_CNT = 4096;
constexpr int CW_WORK = 8192;

#define XB_TMO      128
#define XB_XCNT(j)  (256  + 64 * (j))
#define XB_XSUB(j)  (1280 + 64 * (j))
#define XB_XGEN(j)  (2304 + 64 * (j))
#define XB_TOP      3328
#define XB_TOPGEN   3392
#define XCD_BAR_WORDS 3456
#define XB_SPIN_CAP (1u << 18)

__device__ __forceinline__ unsigned xb_ld(unsigned* p)              { return __hip_atomic_load(p, __ATOMIC_RELAXED, __HIP_MEMORY_SCOPE_AGENT); }
__device__ __forceinline__ unsigned xb_add(unsigned* p, unsigned v) { return __hip_atomic_fetch_add(p, v, __ATOMIC_RELAXED, __HIP_MEMORY_SCOPE_AGENT); }
__device__ __forceinline__ unsigned xb_xcc_id() { return (unsigned)__builtin_amdgcn_s_getreg((3 << 11) | 20) & 0xFu; }
#define XB_SPIN(cond, bar) do { unsigned _sp = 0; while (cond) { __builtin_amdgcn_s_sleep(1); \
    if ((++_sp & 255u) == 0u) { if (xb_ld(&(bar)[XB_TMO])) break; if (_sp > XB_SPIN_CAP) { atomicAdd(&(bar)[XB_TMO], 1u); break; } } } } while (0)

struct XcdBarrier { unsigned* bar; unsigned x; volatile LAS unsigned* st; };

__device__ __forceinline__ XcdBarrier xcd_barrier_post(unsigned* bar, volatile LAS unsigned* st) {
    XcdBarrier b; b.bar = bar; b.x = xb_xcc_id(); b.st = st;
    if (threadIdx.x == 0) (void)xb_add(&bar[XB_XCNT(b.x)], 1u);
    return b;
}
__device__ __forceinline__ void xcd_barrier_complete(unsigned* bar, unsigned x, unsigned& nloc, unsigned& nx) {
    const unsigned G = gridDim.x * gridDim.y * gridDim.z;
    unsigned sum, cnt, mine, sp = 0u;
    for (;;) {
        sum = 0u; cnt = 0u; mine = 0u;
#pragma unroll
        for (unsigned j = 0; j < 16; ++j) { const unsigned c = xb_ld(&bar[XB_XCNT(j)]); sum += c; cnt += (c > 0u) ? 1u : 0u; mine = (j == x) ? c : mine; }
        if (sum == G) break;
        __builtin_amdgcn_s_sleep(1);
        if ((++sp & 255u) == 0u) { if (xb_ld(&bar[XB_TMO])) break; if (sp > XB_SPIN_CAP) { atomicAdd(&bar[XB_TMO], 1u); break; } }
    }
    nloc = mine > 0u ? mine : 1u; nx = cnt > 0u ? cnt : 1u;
}
__device__ __forceinline__ void xcd_barrier(const XcdBarrier& b) {
    asm volatile("s_waitcnt vmcnt(0)" ::: "memory");
    __syncthreads();
    if (threadIdx.x == 0) {
        unsigned* bar = b.bar;
        __builtin_amdgcn_s_waitcnt(0);
        unsigned nloc = b.st[0], nx = b.st[1];
        if (nloc == 0u) { xcd_barrier_complete(bar, b.x, nloc, nx); b.st[0] = nloc; b.st[1] = nx; }
        const unsigned old = xb_add(&bar[XB_XSUB(b.x)], 1u);
        const unsigned gen = old / nloc;
        if (old + 1u == (gen + 1u) * nloc) {
            __builtin_amdgcn_fence(__ATOMIC_RELEASE, "agent");
            asm volatile("s_waitcnt vmcnt(0)" ::: "memory");
            const unsigned og = xb_add(&bar[XB_TOP], 1u);
            const unsigned tg = og / nx;
            if (og + 1u == (tg + 1u) * nx) xb_add(&bar[XB_TOPGEN], 1u);
            else XB_SPIN(xb_ld(&bar[XB_TOPGEN]) == tg, bar);
            __builtin_amdgcn_fence(__ATOMIC_ACQUIRE, "agent");
            xb_add(&bar[XB_XGEN(b.x)], 1u);
            asm volatile("s_waitcnt vmcnt(0)" ::: "memory");
        } else {
            XB_SPIN(xb_ld(&bar[XB_XGEN(b.x)]) == gen, bar);
            __builtin_amdgcn_fence(__ATOMIC_ACQUIRE, "agent");
            asm volatile("s_waitcnt vmcnt(0)" ::: "memory");
        }
    }
    __syncthreads();
}

__device__ __forceinline__ float bf2f(unsigned v) { return __uint_as_float(v << 16); }
__device__ __forceinline__ float bflo(unsigned w) { return __uint_as_float(w << 16); }
__device__ __forceinline__ float bfhi(unsigned w) { return __uint_as_float(w & 0xffff0000u); }
__device__ __forceinline__ unsigned f2bf(float f) { unsigned u = __float_as_uint(f); u += 0x7fffu + ((u >> 16) & 1u); return u >> 16; }
__device__ __forceinline__ unsigned pk2(float lo, float hi) { return f2bf(lo) | (f2bf(hi) << 16); }
__device__ __forceinline__ float wave_sum(float v) {
#pragma unroll
    for (int o = 32; o > 0; o >>= 1) v += __shfl_xor(v, o);
    return v;
}
__device__ __forceinline__ float sigmoidf_(float x) { return 1.f / (1.f + expf(-x)); }
__device__ __forceinline__ float siluf_(float x) { return x / (1.f + expf(-x)); }
__device__ __forceinline__ float softplusf_(float x) { return x > 20.f ? x : log1pf(expf(x)); }
__device__ __forceinline__ void glds16(const void* g, void* l) {
    __builtin_amdgcn_global_load_lds((const GAS unsigned*)g, (LAS unsigned*)l, 16, 0, 0);
}
__device__ __forceinline__ void unpack8(const u32x4 r, float (&f)[8]) {
    f[0] = bflo(r.x); f[1] = bfhi(r.x); f[2] = bflo(r.y); f[3] = bfhi(r.y);
    f[4] = bflo(r.z); f[5] = bfhi(r.z); f[6] = bflo(r.w); f[7] = bfhi(r.w);
}

struct Args {
    const void* in[30];
    float* out;
    unsigned char* ws;
    int ph_lo, ph_hi, use_bar, pad;
};

struct Ctx { int tid, lane, wid, wr, wc, fr, fq, bid, nblk; unsigned char* smem; };

__device__ __forceinline__ void gemm_tile(const bf16_t* a0, const bf16_t* a1, const bf16_t* b0, const bf16_t* b1,
                                          int nk, f32x4 (&acc)[4][4], const Ctx& c) {
#pragma unroll
    for (int m = 0; m < 4; ++m)
#pragma unroll
        for (int n = 0; n < 4; ++n) acc[m][n] = (f32x4){0.f, 0.f, 0.f, 0.f};
    unsigned char* smem = c.smem;
    const int sb = c.tid * 16;
    {
        glds16(a0, smem + sb); glds16(a1, smem + 4096 + sb);
        glds16(b0, smem + 16384 + sb); glds16(b1, smem + 16384 + 4096 + sb);
    }
    for (int kt = 0; kt < nk; ++kt) {
        const int cur = kt & 1;
        asm volatile("s_waitcnt vmcnt(0)" ::: "memory");
        __syncthreads();
        if (kt + 1 < nk) {
            unsigned char* sa = smem + (cur ^ 1) * 8192; unsigned char* sbb = smem + 16384 + (cur ^ 1) * 8192;
            const int ko = (kt + 1) * 32;
            glds16(a0 + ko, sa + sb); glds16(a1 + ko, sa + 4096 + sb);
            glds16(b0 + ko, sbb + sb); glds16(b1 + ko, sbb + 4096 + sb);
        }
        const unsigned char* sa = smem + cur * 8192; const unsigned char* sbb = smem + 16384 + cur * 8192;
        bf16x8 af[4], bfr[4];
#pragma unroll
        for (int m = 0; m < 4; ++m) af[m] = *(const bf16x8*)(sa + (c.wr * 64 + m * 16 + c.fr) * 64 + c.fq * 16);
#pragma unroll
        for (int n = 0; n < 4; ++n) bfr[n] = *(const bf16x8*)(sbb + (c.wc * 64 + n * 16 + c.fr) * 64 + c.fq * 16);
#pragma unroll
        for (int m = 0; m < 4; ++m)
#pragma unroll
            for (int n = 0; n < 4; ++n) acc[m][n] = __builtin_amdgcn_mfma_f32_16x16x32_bf16(bfr[n], af[m], acc[m][n], 0, 0, 0);
    }
    __syncthreads();
}

__device__ void conv_family(const float* src, int nmat, size_t src_stride, int K, int N, int Nout,
                            bf16_t* dst, size_t dst_stride, int grp, int kind, const Ctx& c) {
    float* lds = (float*)c.smem;
    const int tk = K / 64, tn = Nout / 64, per = tk * tn, total = nmat * per;
    for (int u = c.bid; u < total; u += c.nblk) {
        const int mat = u / per, r = u % per, kt = r / tn, nt = r % tn;
        const int dmat = grp ? (mat / grp) * (grp + 1) + (mat % grp) : mat;
        const float* s = src + (size_t)mat * src_stride;
        bf16_t* d = dst + (size_t)dmat * dst_stride;
        const int k0 = kt * 64, n0 = nt * 64;
        const int tx = c.tid & 63, ty = c.tid >> 6;
#pragma unroll 4
        for (int i = 0; i < 16; ++i) {
            const int k = i * 4 + ty, n = n0 + tx;
            lds[k * 65 + tx] = (n < N) ? s[(size_t)(k0 + k) * N + n] : 0.f;
        }
        __syncthreads();
        const int nl = c.tid >> 2, kq = (c.tid & 3) * 16;
        unsigned w[8];
#pragma unroll
        for (int j = 0; j < 8; ++j) w[j] = pk2(lds[(kq + 2 * j) * 65 + nl], lds[(kq + 2 * j + 1) * 65 + nl]);
        const int n = n0 + nl;
        const int drow = (kind == 0) ? n : ((n >> 5) * 64 + (n & 31) + (kind == 2 ? 32 : 0));
        u32x4* dp = (u32x4*)(d + (size_t)drow * K + k0 + kq);
        dp[0] = (u32x4){w[0], w[1], w[2], w[3]};
        dp[1] = (u32x4){w[4], w[5], w[6], w[7]};
        __syncthreads();
    }
}

__device__ void phase_prologue(const Args& a, const Ctx& c) {
    unsigned char* ws = a.ws;
    bf16_t* WIN = (bf16_t*)(ws + WS_WIN);
    conv_family((const float*)a.in[2], 2, (size_t)1024 * 2472, 1024, 2472, NPAD, WIN, 2 * WIN_ELEMS, 0, 0, c);
    conv_family((const float*)a.in[12], 2, (size_t)1024 * 2312, 1024, 2312, NPAD, WIN + WIN_ELEMS, 2 * WIN_ELEMS, 0, 0, c);
    conv_family((const float*)a.in[4], 2, (size_t)256 * 768, 256, 768, 768, (bf16_t*)(ws + WS_WQB), WQB_ELEMS, 0, 0, c);
    conv_family((const float*)a.in[6], 2, (size_t)128 * 1024, 128, 1024, 1024, (bf16_t*)(ws + WS_WKVB), WKVB_ELEMS, 0, 0, c);
    bf16_t* WOUT = (bf16_t*)(ws + WS_WOUT);
    conv_family((const float*)a.in[11], 2, (size_t)1024 * 1024, 1024, 1024, 1024, WOUT, 2 * WOUT_ELEMS, 0, 0, c);
    conv_family((const float*)a.in[17], 2, (size_t)1024 * 1024, 1024, 1024, 1024, WOUT + WOUT_ELEMS, 2 * WOUT_ELEMS, 0, 0, c);
    conv_family((const float*)a.in[20], 4, (size_t)1024 * 64, 1024, 64, 128, (bf16_t*)(ws + WS_WRT), WRT_ELEMS, 0, 0, c);
    bf16_t* WGU = (bf16_t*)(ws + WS_WGU);
    conv_family((const float*)a.in[22], 256, (size_t)1024 * 256, 1024, 256, 256, WGU, WGU_ELEMS, 64, 1, c);
    conv_family((const float*)a.in[23], 256, (size_t)1024 * 256, 1024, 256, 256, WGU, WGU_ELEMS, 64, 2, c);
    conv_family((const float*)a.in[25], 4, (size_t)1024 * 256, 1024, 256, 256, WGU + 64 * WGU_ELEMS, 65 * WGU_ELEMS, 0, 1, c);
    conv_family((const float*)a.in[26], 4, (size_t)1024 * 256, 1024, 256, 256, WGU + 64 * WGU_ELEMS, 65 * WGU_ELEMS, 0, 2, c);
    bf16_t* WDN = (bf16_t*)(ws + WS_WDN);
    conv_family((const float*)a.in[24], 256, (size_t)256 * 1024, 256, 1024, 1024, WDN, WDN_ELEMS, 64, 0, c);
    conv_family((const float*)a.in[27], 4, (size_t)256 * 1024, 256, 1024, 1024, WDN + 64 * WDN_ELEMS, 65 * WDN_ELEMS, 0, 0, c);
    {
        const float* x = (const float*)a.in[0]; bf16_t* xb = (bf16_t*)(ws + WS_XBF);
        const size_t n8 = (size_t)T * 1024 / 8;
        for (size_t i = (size_t)c.bid * 256 + c.tid; i < n8; i += (size_t)c.nblk * 256) {
            const f32x4 v0 = *(const f32x4*)(x + i * 8), v1 = *(const f32x4*)(x + i * 8 + 4);
            *(u32x4*)(xb + i * 8) = (u32x4){pk2(v0[0], v0[1]), pk2(v0[2], v0[3]), pk2(v1[0], v1[1]), pk2(v1[2], v1[3])};
        }
    }
    {
        const int* pos = (const int*)a.in[1];
        float* rm = (float*)(ws + WS_ROPEM); float* rs = (float*)(ws + WS_ROPES);
        const float ln_theta = 9.210340371976184f;
        for (int i = c.bid * 256 + c.tid; i < T * 16; i += c.nblk * 256) {
            const int t = i >> 4, f = i & 15;
            const float inv = expf(-((float)(2 * f) / 32.f) * ln_theta);
            const float ang = (float)pos[t] * inv;
            rm[i * 2] = cosf(ang); rm[i * 2 + 1] = sinf(ang);
        }
        for (int i = c.bid * 256 + c.tid; i < T * 32; i += c.nblk * 256) {
            const int t = i >> 5, f = i & 31;
            const float inv = expf(-((float)(2 * f) / 64.f) * ln_theta);
            const float ang = (float)pos[t] * inv;
            rs[i * 2] = cosf(ang); rs[i * 2 + 1] = sinf(ang);
        }
    }
}

__device__ void phase_inproj(const bf16_t* XBF, const bf16_t* W, bf16_t* PROJ, float* GATES, int gbase, const Ctx& c) {
    const int ntn = NPAD / 128, total = (T / 128) * ntn;
    for (int u = c.bid; u < total; u += c.nblk) {
        const int mt = u / ntn, nt = u % ntn;
        const bf16_t* a0 = XBF + (size_t)(mt * 128 + (c.tid >> 2)) * 1024 + (c.tid & 3) * 8;
        const bf16_t* b0 = W + (size_t)(nt * 128 + (c.tid >> 2)) * 1024 + (c.tid & 3) * 8;
        f32x4 acc[4][4];
        gemm_tile(a0, a0 + 64 * 1024, b0, b0 + 64 * 1024, 32, acc, c);
#pragma unroll
        for (int m = 0; m < 4; ++m) {
            const int row = mt * 128 + c.wr * 64 + m * 16 + c.fr;
#pragma unroll
            for (int n = 0; n < 4; ++n) {
                const int col = nt * 128 + c.wc * 64 + n * 16 + c.fq * 4;
                const f32x4 v = acc[m][n];
                *(u32x2*)(PROJ + (size_t)row * NPAD + col) = (u32x2){pk2(v[0], v[1]), pk2(v[2], v[3])};
                if (col >= gbase && col < gbase + 8) *(f32x4*)(GATES + (size_t)row * 8 + (col - gbase)) = v;
            }
        }
    }
}

__device__ void phase_mla_up(const bf16_t* CQ, const bf16_t* WQB, const bf16_t* CKV, const bf16_t* WKVB,
                             const float* ROPEM, bf16_t* QF, bf16_t* KN, bf16_t* VV, const Ctx& c) {
    const int tq = (T / 128) * 6, tkv = (T / 128) * 8;
    const float qscale = 0.10206207261596577f * 1.4426950408889634f;
    for (int u = c.bid; u < tq + tkv; u += c.nblk) {
        f32x4 acc[4][4];
        if (u < tq) {
            const int mt = u / 6, nt = u % 6;
            const bf16_t* a0 = CQ + (size_t)(mt * 128 + (c.tid >> 2)) * 256 + (c.tid & 3) * 8;
            const bf16_t* b0 = WQB + (size_t)(nt * 128 + (c.tid >> 2)) * 256 + (c.tid & 3) * 8;
            gemm_tile(a0, a0 + 64 * 256, b0, b0 + 64 * 256, 8, acc, c);
#pragma unroll
            for (int m = 0; m < 4; ++m) {
                const int row = mt * 128 + c.wr * 64 + m * 16 + c.fr;
#pragma unroll
                for (int np = 0; np < 2; ++np) {
                    const int cg = nt * 128 + c.wc * 64 + np * 32;
                    f32x4 v0 = acc[m][2 * np], v1 = acc[m][2 * np + 1];
                    if (((cg >> 5) % 3) == 2) {
#pragma unroll
                        for (int j = 0; j < 4; ++j) {
                            const int i = c.fq * 4 + j;
                            const float cs = ROPEM[((size_t)row * 16 + i) * 2], sn = ROPEM[((size_t)row * 16 + i) * 2 + 1];
                            const float x1 = v0[j], x2 = v1[j];
                            v0[j] = x1 * cs - x2 * sn; v1[j] = x2 * cs + x1 * sn;
                        }
                    }
                    v0 *= qscale; v1 *= qscale;
                    *(u32x2*)(QF + (size_t)row * 768 + cg + c.fq * 4) = (u32x2){pk2(v0[0], v0[1]), pk2(v0[2], v0[3])};
                    *(u32x2*)(QF + (size_t)row * 768 + cg + 16 + c.fq * 4) = (u32x2){pk2(v1[0], v1[1]), pk2(v1[2], v1[3])};
                }
            }
        } else {
            const int v = u - tq, mt = v / 8, nt = v % 8;
            const bf16_t* a0 = CKV + (size_t)(mt * 128 + (c.tid >> 2)) * 128 + (c.tid & 3) * 8;
            const bf16_t* b0 = WKVB + (size_t)(nt * 128 + (c.tid >> 2)) * 128 + (c.tid & 3) * 8;
            gemm_tile(a0, a0 + 64 * 128, b0, b0 + 64 * 128, 4, acc, c);
            bf16_t* dst = (c.wc == 0) ? KN : VV;
#pragma unroll
            for (int m = 0; m < 4; ++m) {
                const int row = mt * 128 + c.wr * 64 + m * 16 + c.fr;
#pragma unroll
                for (int n = 0; n < 4; ++n) {
                    const f32x4 x = acc[m][n];
                    *(u32x2*)(dst + (size_t)row * 512 + nt * 64 + n * 16 + c.fq * 4) = (u32x2){pk2(x[0], x[1]), pk2(x[2], x[3])};
                }
            }
        }
    }
}

__device__ void phase_outproj(const bf16_t* MIXO, const bf16_t* W, const float* xres, float* YBUF, const Ctx& c) {
    const int total = (T / 128) * 8;
    for (int u = c.bid; u < total; u += c.nblk) {
        const int mt = u / 8, nt = u % 8;
        const bf16_t* a0 = MIXO + (size_t)(mt * 128 + (c.tid >> 2)) * 1024 + (c.tid & 3) * 8;
        const bf16_t* b0 = W + (size_t)(nt * 128 + (c.tid >> 2)) * 1024 + (c.tid & 3) * 8;
        f32x4 acc[4][4];
        gemm_tile(a0, a0 + 64 * 1024, b0, b0 + 64 * 1024, 32, acc, c);
#pragma unroll
        for (int m = 0; m < 4; ++m) {
            const int row = mt * 128 + c.wr * 64 + m * 16 + c.fr;
#pragma unroll
            for (int n = 0; n < 4; ++n) {
                const int col = nt * 128 + c.wc * 64 + n * 16 + c.fq * 4;
                const f32x4 xr = *(const f32x4*)(xres + (size_t)row * 1024 + col);
                *(f32x4*)(YBUF + (size_t)row * 1024 + col) = xr * ALPHA + acc[m][n];
            }
        }
    }
}

__device__ void phase_router(const bf16_t* XBF, const bf16_t* W, float* LOG, const Ctx& c) {
    for (int mt = c.bid; mt < T / 128; mt += c.nblk) {
        const bf16_t* a0 = XBF + (size_t)(mt * 128 + (c.tid >> 2)) * 1024 + (c.tid & 3) * 8;
        const bf16_t* b0 = W + (size_t)(c.tid >> 2) * 1024 + (c.tid & 3) * 8;
        f32x4 acc[4][4];
        gemm_tile(a0, a0 + 64 * 1024, b0, b0 + 64 * 1024, 32, acc, c);
        if (c.wc == 0) {
#pragma unroll
            for (int m = 0; m < 4; ++m) {
                const int row = mt * 128 + c.wr * 64 + m * 16 + c.fr;
#pragma unroll
                for (int n = 0; n < 4; ++n) *(f32x4*)(LOG + (size_t)row * 64 + n * 16 + c.fq * 4) = acc[m][n];
            }
        }
    }
}

__device__ __forceinline__ void build_block_table(const unsigned* CNT, int* bst, const Ctx& c) {
    __syncthreads();
    if (c.tid == 0) {
        int s = 0;
        for (int e = 0; e < 65; ++e) {
            const int cnt = (e < 64) ? (int)__hip_atomic_load(CNT + e, __ATOMIC_RELAXED, __HIP_MEMORY_SCOPE_AGENT) : T;
            bst[e] = s; bst[66 + e] = cnt; s += (cnt + 127) >> 7;
        }
        bst[65] = s;
    }
    __syncthreads();
}
__device__ __forceinline__ int find_expert(const int* bst, int rb) {
    int e = 0;
    for (int i = 1; i < 65; ++i) e += (bst[i] <= rb) ? 1 : 0;
    return e;
}

__device__ void phase_moe1(const bf16_t* XBF, const bf16_t* WGU, const unsigned* CNT, const int* LTOK, bf16_t* HBUF, const Ctx& c) {
    int* bst = (int*)(c.smem + 32768);
    build_block_table(CNT, bst, c);
    const int total = bst[65] * 4;
    for (int u = c.bid; u < total; u += c.nblk) {
        const int rb = u >> 2, nt = u & 3;
        const int e = find_expert(bst, rb);
        const int lb = rb - bst[e], cnt = bst[66 + e];
        const int p0 = lb * 128 + (c.tid >> 2), p1 = p0 + 64;
        const int t0 = (p0 < cnt) ? LTOK[(size_t)e * CAP + p0] : 0;
        const int t1 = (p1 < cnt) ? LTOK[(size_t)e * CAP + p1] : 0;
        const bf16_t* a0 = XBF + (size_t)t0 * 1024 + (c.tid & 3) * 8;
        const bf16_t* a1 = XBF + (size_t)t1 * 1024 + (c.tid & 3) * 8;
        const bf16_t* b0 = WGU + (size_t)e * WGU_ELEMS + (size_t)(nt * 128 + (c.tid >> 2)) * 1024 + (c.tid & 3) * 8;
        f32x4 acc[4][4];
        gemm_tile(a0, a1, b0, b0 + 64 * 1024, 32, acc, c);
#pragma unroll
        for (int m = 0; m < 4; ++m) {
            const size_t crow = (size_t)rb * 128 + c.wr * 64 + m * 16 + c.fr;
#pragma unroll
            for (int n = 0; n < 2; ++n) {
                const f32x4 g = acc[m][n], up = acc[m][n + 2];
                float h[4];
#pragma unroll
                for (int j = 0; j < 4; ++j) h[j] = siluf_(g[j]) * up[j];
                *(u32x2*)(HBUF + crow * 256 + nt * 64 + c.wc * 32 + n * 16 + c.fq * 4) = (u32x2){pk2(h[0], h[1]), pk2(h[2], h[3])};
            }
        }
    }
}

__device__ void phase_moe2(const bf16_t* HBUF, const bf16_t* WDN, const unsigned* CNT, const float* LW, bf16_t* Y, const Ctx& c) {
    int* bst = (int*)(c.smem + 32768);
    build_block_table(CNT, bst, c);
    const int total = bst[65] * 8;
    for (int u = c.bid; u < total; u += c.nblk) {
        const int rb = u >> 3, nt = u & 7;
        const int e = find_expert(bst, rb);
        const int lb = rb - bst[e], cnt = bst[66 + e];
        const bf16_t* a0 = HBUF + ((size_t)rb * 128 + (c.tid >> 2)) * 256 + (c.tid & 3) * 8;
        const bf16_t* b0 = WDN + (size_t)e * WDN_ELEMS + (size_t)(nt * 128 + (c.tid >> 2)) * 256 + (c.tid & 3) * 8;
        f32x4 acc[4][4];
        gemm_tile(a0, a0 + 64 * 256, b0, b0 + 64 * 256, 8, acc, c);
#pragma unroll
        for (int m = 0; m < 4; ++m) {
            const int lr = c.wr * 64 + m * 16 + c.fr;
            const int p = lb * 128 + lr;
            const float w = (p < cnt) ? LW[(size_t)e * CAP + p] : 0.f;
            const size_t crow = (size_t)rb * 128 + lr;
#pragma unroll
            for (int n = 0; n < 4; ++n) {
                const f32x4 v = acc[m][n] * w;
                *(u32x2*)(Y + crow * 1024 + nt * 128 + c.wc * 64 + n * 16 + c.fq * 4) = (u32x2){pk2(v[0], v[1]), pk2(v[2], v[3])};
            }
        }
    }
}

__device__ __forceinline__ void ln_row_store(float (&v)[16], const float* g, const float* b, float* of32, bf16_t* obf, int lane) {
    float s = 0.f;
#pragma unroll
    for (int i = 0; i < 16; ++i) s += v[i];
    const float mean = wave_sum(s) * (1.f / 1024.f);
    float q = 0.f;
#pragma unroll
    for (int i = 0; i < 16; ++i) { v[i] -= mean; q += v[i] * v[i]; }
    const float rstd = rsqrtf(wave_sum(q) * (1.f / 1024.f) + 1e-5f);
#pragma unroll
    for (int hf = 0; hf < 2; ++hf) {
        const int col = hf * 512 + lane * 8;
        const f32x4 g0 = *(const f32x4*)(g + col), g1 = *(const f32x4*)(g + col + 4);
        const f32x4 b0 = *(const f32x4*)(b + col), b1 = *(const f32x4*)(b + col + 4);
        f32x4 y0, y1;
#pragma unroll
        for (int j = 0; j < 4; ++j) { y0[j] = v[hf * 8 + j] * rstd * g0[j] + b0[j]; y1[j] = v[hf * 8 + 4 + j] * rstd * g1[j] + b1[j]; }
        *(f32x4*)(of32 + col) = y0; *(f32x4*)(of32 + col + 4) = y1;
        *(u32x4*)(obf + col) = (u32x4){pk2(y0[0], y0[1]), pk2(y0[2], y0[3]), pk2(y1[0], y1[1]), pk2(y1[2], y1[3])};
    }
}

__device__ void phase_ln1(const float* YBUF, const float* g, const float* b, float* X1, bf16_t* XBF, const Ctx& c) {
    for (int t = c.bid * 4 + c.wid; t < T; t += c.nblk * 4) {
        float v[16];
#pragma unroll
        for (int hf = 0; hf < 2; ++hf) {
            const float* p = YBUF + (size_t)t * 1024 + hf * 512 + c.lane * 8;
            const f32x4 a0 = *(const f32x4*)p, a1 = *(const f32x4*)(p + 4);
#pragma unroll
            for (int j = 0; j < 4; ++j) { v[hf * 8 + j] = a0[j]; v[hf * 8 + 4 + j] = a1[j]; }
        }
        ln_row_store(v, g, b, X1 + (size_t)t * 1024, XBF + (size_t)t * 1024, c.lane);
    }
}

__device__ void phase_combine(const float* X1, const bf16_t* Y, const int* ASG, const unsigned* CNT, const float* g, const float* b,
                              float* XOUT, bf16_t* XBF, const Ctx& c) {
    int* bst = (int*)(c.smem + 32768);
    build_block_table(CNT, bst, c);
    for (int t = c.bid * 4 + c.wid; t < T; t += c.nblk * 4) {
        float v[16];
#pragma unroll
        for (int hf = 0; hf < 2; ++hf) {
            const float* p = X1 + (size_t)t * 1024 + hf * 512 + c.lane * 8;
            const f32x4 a0 = *(const f32x4*)p, a1 = *(const f32x4*)(p + 4);
#pragma unroll
            for (int j = 0; j < 4; ++j) { v[hf * 8 + j] = a0[j] * ALPHA; v[hf * 8 + 4 + j] = a1[j] * ALPHA; }
        }
#pragma unroll
        for (int k = 0; k < 9; ++k) {
            size_t crow;
            if (k < 8) { const int asg = ASG[(size_t)t * 8 + k]; crow = (size_t)bst[asg >> 16] * 128 + (asg & 0xffff); }
            else crow = (size_t)bst[64] * 128 + t;
#pragma unroll
            for (int hf = 0; hf < 2; ++hf) {
                const u32x4 r = *(const u32x4*)(Y + crow * 1024 + hf * 512 + c.lane * 8);
                float f[8]; unpack8(r, f);
#pragma unroll
                for (int j = 0; j < 8; ++j) v[hf * 8 + j] += f[j];
            }
        }
        ln_row_store(v, g, b, XOUT + (size_t)t * 1024, XBF + (size_t)t * 1024, c.lane);
    }
}

__device__ void phase_route(const float* LOG, const float* rb, unsigned* CNT, int* LTOK, float* LW, int* ASG, const Ctx& c) {
    int* lcnt = (int*)c.smem;
    int* lbase = lcnt + 64;
    int* sel_e = lbase + 64;
    int* sel_p = sel_e + 256;
    float* sel_w = (float*)(sel_p + 256);
    const float rbias = rb[c.lane];
    for (int ch = c.bid; ch < T / 32; ch += c.nblk) {
        __syncthreads();
        if (c.tid < 64) lcnt[c.tid] = 0;
        __syncthreads();
        for (int tl = c.wid; tl < 32; tl += 4) {
            const int t = ch * 32 + tl;
            const float lg = LOG[(size_t)t * 64 + c.lane];
            const float sc = 1.f / (1.f + expf(-lg));
            const float v = sc + rbias;
            float m1 = v;
            m1 = fmaxf(m1, __shfl_xor(m1, 1)); m1 = fmaxf(m1, __shfl_xor(m1, 2)); m1 = fmaxf(m1, __shfl_xor(m1, 4));
            int cand = (v == m1) ? c.lane : 999;
            cand = min(cand, __shfl_xor(cand, 1)); cand = min(cand, __shfl_xor(cand, 2)); cand = min(cand, __shfl_xor(cand, 4));
            float m2 = (c.lane == cand) ? -INFINITY : v;
            m2 = fmaxf(m2, __shfl_xor(m2, 1)); m2 = fmaxf(m2, __shfl_xor(m2, 2)); m2 = fmaxf(m2, __shfl_xor(m2, 4));
            const float gs = m1 + m2;
            const int g = c.lane >> 3;
            int grank = 0;
#pragma unroll
            for (int gg = 0; gg < 8; ++gg) { const float o = __shfl(gs, gg * 8); grank += ((o > gs) || (o == gs && gg < g)) ? 1 : 0; }
            const bool gsel = grank < 4;
            const float mv = gsel ? v : -INFINITY;
            int rank = 0;
#pragma unroll 8
            for (int jj = 0; jj < 64; ++jj) { const float o = __shfl(mv, jj); rank += ((o > mv) || (o == mv && jj < c.lane)) ? 1 : 0; }
            const bool sel = gsel && rank < 8;
            const float ssum = wave_sum(sel ? sc : 0.f);
            const float w = sc / ssum * 2.5f;
            const unsigned long long bal = __ballot(sel);
            const int slot = __popcll(bal & ((1ull << c.lane) - 1ull));
            if (sel) {
                const int p = atomicAdd(&lcnt[c.lane], 1);
                sel_e[tl * 8 + slot] = c.lane; sel_p[tl * 8 + slot] = p; sel_w[tl * 8 + slot] = w;
            }
        }
        __syncthreads();
        if (c.tid < 64) { const int n = lcnt[c.tid]; lbase[c.tid] = n ? (int)atomicAdd(CNT + c.tid, (unsigned)n) : 0; }
        __syncthreads();
        {
            const int tl = c.tid >> 3, t = ch * 32 + tl;
            const int e = sel_e[c.tid], pos = lbase[e] + sel_p[c.tid];
            LTOK[(size_t)e * CAP + pos] = t; LW[(size_t)e * CAP + pos] = sel_w[c.tid];
            ASG[(size_t)t * 8 + (c.tid & 7)] = (e << 16) | pos;
            if (c.tid < 32) { const int ts = ch * 32 + c.tid; LTOK[(size_t)64 * CAP + ts] = ts; LW[(size_t)64 * CAP + ts] = 1.f; }
        }
    }
}

__device__ void phase_prep_even(const bf16_t* PROJ, const float* GATES, const float* qn, const float* kvn, const float* cw,
                                const float* a_log, const float* dt_bias, const float* ROPEM,
                                bf16_t* CQ, bf16_t* CKV, bf16_t* KROPE, bf16_t* GQ, bf16_t* GK, bf16_t* GV, float* BETA, float* GLOG, const Ctx& c) {
    const int lane = c.lane;
    for (int t = c.bid * 4 + c.wid; t < T; t += c.nblk * 4) {
        const bf16_t* pr = PROJ + (size_t)t * NPAD;
        {
            const u32x2 r = *(const u32x2*)(pr + lane * 4);
            float v[4] = {bflo(r.x), bfhi(r.x), bflo(r.y), bfhi(r.y)};
            const float ss = wave_sum(v[0] * v[0] + v[1] * v[1] + v[2] * v[2] + v[3] * v[3]);
            const float rr = rsqrtf(ss * (1.f / 256.f) + 1e-6f);
            const f32x4 gq = *(const f32x4*)(qn + lane * 4);
            *(u32x2*)(CQ + (size_t)t * 256 + lane * 4) = (u32x2){pk2(v[0] * rr * gq[0], v[1] * rr * gq[1]), pk2(v[2] * rr * gq[2], v[3] * rr * gq[3])};
        }
        {
            const unsigned r = *(const unsigned*)(pr + 256 + lane * 2);
            const float v0 = bflo(r), v1 = bfhi(r);
            const float ss = wave_sum(v0 * v0 + v1 * v1);
            const float rr = rsqrtf(ss * (1.f / 128.f) + 1e-6f);
            *(unsigned*)(CKV + (size_t)t * 128 + lane * 2) = pk2(v0 * rr * kvn[lane * 2], v1 * rr * kvn[lane * 2 + 1]);
        }
        if (lane < 16) {
            const float x1 = bf2f(pr[384 + lane]), x2 = bf2f(pr[400 + lane]);
            const float cs = ROPEM[((size_t)t * 16 + lane) * 2], sn = ROPEM[((size_t)t * 16 + lane) * 2 + 1];
            KROPE[(size_t)t * 32 + lane] = (bf16_t)f2bf(x1 * cs - x2 * sn);
            KROPE[(size_t)t * 32 + 16 + lane] = (bf16_t)f2bf(x2 * cs + x1 * sn);
        }
        const int s = t & (SEQ - 1);
#pragma unroll 1
        for (int hg = 0; hg < 12; ++hg) {
            const int chn = hg * 128 + lane * 2;
            float a0 = 0.f, a1 = 0.f;
#pragma unroll
            for (int w = 0; w < 4; ++w) {
                if (s - 3 + w >= 0) {
                    const unsigned r = *(const unsigned*)(PROJ + (size_t)(t - 3 + w) * NPAD + 416 + chn);
                    a0 += cw[w * 1536 + chn] * bflo(r); a1 += cw[w * 1536 + chn + 1] * bfhi(r);
                }
            }
            float y0 = siluf_(a0), y1 = siluf_(a1);
            if (hg < 8) {
                const float ss = wave_sum(y0 * y0 + y1 * y1);
                float rr = rsqrtf(ss + 1e-6f);
                if (hg < 4) rr *= 0.08838834764831845f;
                y0 *= rr; y1 *= rr;
            }
            bf16_t* dst = (hg < 4) ? GQ : (hg < 8) ? GK : GV;
            *(unsigned*)(dst + (size_t)t * 512 + (hg & 3) * 128 + lane * 2) = pk2(y0, y1);
        }
        if (lane < 4) BETA[(size_t)t * 4 + lane] = sigmoidf_(GATES[(size_t)t * 8 + lane]);
        else if (lane < 8) { const int h = lane - 4; GLOG[(size_t)t * 4 + h] = -expf(a_log[h]) * softplusf_(GATES[(size_t)t * 8 + lane] + dt_bias[h]); }
    }
}

__device__ void phase_prep_odd(const bf16_t* PROJ, const float* ROPES, bf16_t* SQ, bf16_t* SK, const Ctx& c) {
    const int lane = c.lane;
    for (int t = c.bid * 4 + c.wid; t < T; t += c.nblk * 4) {
        const bf16_t* pr = PROJ + (size_t)t * NPAD;
        const int i = lane & 31;
        const float cs = ROPES[((size_t)t * 32 + i) * 2], sn = ROPES[((size_t)t * 32 + i) * 2 + 1];
#pragma unroll
        for (int r = 0; r < 4; ++r) {
            const int h = (lane >> 5) + 2 * r;
            const float x1 = bf2f(pr[1544 + h * 64 + i]), x2 = bf2f(pr[1544 + h * 64 + 32 + i]);
            SQ[(size_t)t * 512 + h * 64 + i] = (bf16_t)f2bf((x1 * cs - x2 * sn) * 0.18033688011112042f);
            SQ[(size_t)t * 512 + h * 64 + 32 + i] = (bf16_t)f2bf((x2 * cs + x1 * sn) * 0.18033688011112042f);
        }
        {
            const int h = lane >> 5;
            const float x1 = bf2f(pr[2056 + h * 64 + i]), x2 = bf2f(pr[2056 + h * 64 + 32 + i]);
            SK[(size_t)t * 128 + h * 64 + i] = (bf16_t)f2bf(x1 * cs - x2 * sn);
            SK[(size_t)t * 128 + h * 64 + 32 + i] = (bf16_t)f2bf(x2 * cs + x1 * sn);
        }
    }
}

__device__ __forceinline__ int next_unit(unsigned* ctr, const Ctx& c) {
    volatile int* su = (volatile int*)(c.smem + 65536 + 16);
    __syncthreads();
    if (c.tid == 0) *su = (int)atomicAdd(ctr, 1u);
    __syncthreads();
    return *su;
}

__device__ void mla_unit(int u, const bf16_t* QF, const bf16_t* KN, const bf16_t* KROPE, const bf16_t* VV, bf16_t* MIXO, const Ctx& c) {
    const int qb = 7 - (u >> 6), bh = u & 63, b = bh >> 3, h = bh & 7;
    const int s = qb * 256 + c.tid;
    const size_t t = (size_t)b * SEQ + s;
    float* tile = (float*)c.smem;
    float q[96], o[64];
#pragma unroll
    for (int i = 0; i < 12; ++i) {
        const u32x4 r = *(const u32x4*)(QF + t * 768 + h * 96 + i * 8);
        float f[8]; unpack8(r, f);
#pragma unroll
        for (int j = 0; j < 8; ++j) q[i * 8 + j] = f[j];
    }
#pragma unroll
    for (int i = 0; i < 64; ++i) o[i] = 0.f;
    float m = -1e30f, l = 0.f;
    const int nkt = (qb + 1) * 8;
    for (int kt = 0; kt < nkt; ++kt) {
        __syncthreads();
        for (int idx = c.tid; idx < 640; idx += 256) {
            const int key = idx / 20, chk = idx % 20;
            const size_t tk = (size_t)b * SEQ + kt * 32 + key;
            const bf16_t* src = (chk < 8) ? (KN + tk * 512 + h * 64 + chk * 8) : (chk < 12) ? (KROPE + tk * 32 + (chk - 8) * 8) : (VV + tk * 512 + h * 64 + (chk - 12) * 8);
            const u32x4 r = *(const u32x4*)src;
            float f[8]; unpack8(r, f);
            float* d = tile + key * 160 + chk * 8;
            *(f32x4*)d = (f32x4){f[0], f[1], f[2], f[3]}; *(f32x4*)(d + 4) = (f32x4){f[4], f[5], f[6], f[7]};
        }
        __syncthreads();
#pragma unroll 1
        for (int j = 0; j < 32; ++j) {
            const int key = kt * 32 + j;
            if (key <= s) {
                const float* kr = tile + j * 160;
                float sc = 0.f;
#pragma unroll
                for (int i = 0; i < 96; ++i) sc += q[i] * kr[i];
                const float mn = fmaxf(m, sc);
                const float al = __expf(m - mn), p = __expf(sc - mn);
                l = l * al + p;
#pragma unroll
                for (int i = 0; i < 64; ++i) o[i] = o[i] * al + p * kr[96 + i];
                m = mn;
            }
        }
    }
    const float inv = 1.f / l;
#pragma unroll
    for (int i = 0; i < 8; ++i)
        *(u32x4*)(MIXO + t * 1024 + h * 64 + i * 8) = (u32x4){pk2(o[i * 8] * inv, o[i * 8 + 1] * inv), pk2(o[i * 8 + 2] * inv, o[i * 8 + 3] * inv),
                                                             pk2(o[i * 8 + 4] * inv, o[i * 8 + 5] * inv), pk2(o[i * 8 + 6] * inv, o[i * 8 + 7] * inv)};
}

__device__ void gdn_unit(int u, const bf16_t* GQ, const bf16_t* GK, const bf16_t* GV, const float* BETA, const float* GLOG,
                         const bf16_t* PROJ, const float* gnorm, bf16_t* MIXO, const Ctx& c) {
    const int b = u >> 2, h = u & 3;
    float* kf = (float*)c.smem; float* qf = kf + 16 * 128; float* vf = qf + 16 * 128; float* ob = vf + 16 * 128;
    float* bt = ob + 16 * 128; float* av = bt + 16;
    float S[64];
#pragma unroll
    for (int i = 0; i < 64; ++i) S[i] = 0.f;
    const int j = c.wid * 32 + (c.lane & 31), half = c.lane >> 5;
    for (int c0 = 0; c0 < SEQ; c0 += 16) {
        const size_t t0 = (size_t)b * SEQ + c0;
        __syncthreads();
#pragma unroll
        for (int i = 0; i < 3; ++i) {
            const int idx = c.tid + 256 * i, arr = idx >> 8, r = idx & 255, tok = r >> 4, chk = r & 15;
            const bf16_t* src = ((arr == 0) ? GK : (arr == 1) ? GQ : GV) + (t0 + tok) * 512 + h * 128 + chk * 8;
            const u32x4 rr = *(const u32x4*)src;
            float f[8]; unpack8(rr, f);
            float* d = kf + arr * 2048 + tok * 128 + chk * 8;
            *(f32x4*)d = (f32x4){f[0], f[1], f[2], f[3]}; *(f32x4*)(d + 4) = (f32x4){f[4], f[5], f[6], f[7]};
        }
        if (c.tid < 16) { bt[c.tid] = BETA[(t0 + c.tid) * 4 + h]; av[c.tid] = expf(GLOG[(t0 + c.tid) * 4 + h]); }
        __syncthreads();
#pragma unroll 1
        for (int tt = 0; tt < 16; ++tt) {
            const float* kr = kf + tt * 128 + half * 64; const float* qr = qf + tt * 128 + half * 64;
            const float a = av[tt];
            float kS = 0.f;
#pragma unroll
            for (int i = 0; i < 64; ++i) kS += kr[i] * S[i];
            kS += __shfl_xor(kS, 32);
            const float vn = bt[tt] * (vf[tt * 128 + j] - a * kS);
            float o = 0.f;
#pragma unroll
            for (int i = 0; i < 64; ++i) { S[i] = a * S[i] + kr[i] * vn; o += qr[i] * S[i]; }
            o += __shfl_xor(o, 32);
            if (half == 0) ob[tt * 128 + j] = o;
        }
        __syncthreads();
#pragma unroll
        for (int k = 0; k < 4; ++k) {
            const int tt = c.wid * 4 + k;
            const float o0 = ob[tt * 128 + c.lane * 2], o1 = ob[tt * 128 + c.lane * 2 + 1];
            const float rr = rsqrtf(wave_sum(o0 * o0 + o1 * o1) * (1.f / 128.f) + 1e-6f);
            const unsigned zr = *(const unsigned*)(PROJ + (t0 + tt) * NPAD + 1960 + h * 128 + c.lane * 2);
            const float y0 = o0 * rr * gnorm[c.lane * 2] * siluf_(bflo(zr)), y1 = o1 * rr * gnorm[c.lane * 2 + 1] * siluf_(bfhi(zr));
            *(unsigned*)(MIXO + (t0 + tt) * 1024 + 512 + h * 128 + c.lane * 2) = pk2(y0, y1);
        }
    }
}

__device__ void mlstm_unit(int u, const bf16_t* PROJ, const float* GATES, const float* b_i, const float* b_f, const float* mnorm, bf16_t* MIXO, const Ctx& c) {
    const int b = u >> 2, h = u & 3;
    float* kf = (float*)c.smem; float* qf = kf + 16 * 64; float* vf = qf + 16 * 64; float* ob = vf + 16 * 128;
    float* ip = ob + 16 * 128; float* lf = ip + 16;
    float C[32], nn[32];
#pragma unroll
    for (int i = 0; i < 32; ++i) { C[i] = 0.f; nn[i] = 0.f; }
    float mst = 0.f;
    const int j = c.wid * 32 + (c.lane & 31), half = c.lane >> 5;
    const float bi = b_i[h], bfv = b_f[h];
    for (int c0 = 0; c0 < SEQ; c0 += 16) {
        const size_t t0 = (size_t)b * SEQ + c0;
        __syncthreads();
        {
            const int idx = c.tid;
            if (idx < 128) { const int tok = idx >> 3, chk = idx & 7;
                const u32x4 rr = *(const u32x4*)(PROJ + (t0 + tok) * NPAD + 256 + h * 64 + chk * 8); float f[8]; unpack8(rr, f);
                float* d = kf + tok * 64 + chk * 8; *(f32x4*)d = (f32x4){f[0], f[1], f[2], f[3]}; *(f32x4*)(d + 4) = (f32x4){f[4], f[5], f[6], f[7]}; }
            else { const int i2 = idx - 128, tok = i2 >> 3, chk = i2 & 7;
                const u32x4 rr = *(const u32x4*)(PROJ + (t0 + tok) * NPAD + h * 64 + chk * 8); float f[8]; unpack8(rr, f);
                float* d = qf + tok * 64 + chk * 8; *(f32x4*)d = (f32x4){f[0], f[1], f[2], f[3]}; *(f32x4*)(d + 4) = (f32x4){f[4], f[5], f[6], f[7]}; }
            { const int tok = idx >> 4, chk = idx & 15;
                const u32x4 rr = *(const u32x4*)(PROJ + (t0 + tok) * NPAD + 512 + h * 128 + chk * 8); float f[8]; unpack8(rr, f);
                float* d = vf + tok * 128 + chk * 8; *(f32x4*)d = (f32x4){f[0], f[1], f[2], f[3]}; *(f32x4*)(d + 4) = (f32x4){f[4], f[5], f[6], f[7]}; }
            if (idx < 16) { ip[idx] = GATES[(t0 + idx) * 8 + h] + bi; lf[idx] = -softplusf_(-(GATES[(t0 + idx) * 8 + 4 + h] + bfv)); }
        }
        __syncthreads();
#pragma unroll 1
        for (int tt = 0; tt < 16; ++tt) {
            const float* kr = kf + tt * 64 + half * 32; const float* qr = qf + tt * 64 + half * 32;
            const float mn = fmaxf(lf[tt] + mst, ip[tt]);
            const float fs = expf(lf[tt] + mst - mn), is = expf(ip[tt] - mn) * 0.125f;
            mst = mn;
            const float vj = vf[tt * 128 + j] * is;
            float num = 0.f, den = 0.f;
#pragma unroll
            for (int i = 0; i < 32; ++i) {
                C[i] = fs * C[i] + kr[i] * vj; nn[i] = fs * nn[i] + kr[i] * is;
                num += qr[i] * C[i]; den += qr[i] * nn[i];
            }
            num += __shfl_xor(num, 32); den += __shfl_xor(den, 32);
            if (half == 0) ob[tt * 128 + j] = num / fmaxf(fabsf(den), expf(-mn));
        }
        __syncthreads();
#pragma unroll
        for (int k = 0; k < 4; ++k) {
            const int tt = c.wid * 4 + k;
            const float o0 = ob[tt * 128 + c.lane * 2], o1 = ob[tt * 128 + c.lane * 2 + 1];
            const float rr = rsqrtf(wave_sum(o0 * o0 + o1 * o1) * (1.f / 128.f) + 1e-6f);
            const unsigned zr = *(const unsigned*)(PROJ + (t0 + tt) * NPAD + 1032 + h * 128 + c.lane * 2);
            const float y0 = o0 * rr * mnorm[h * 128 + c.lane * 2] * sigmoidf_(bflo(zr)), y1 = o1 * rr * mnorm[h * 128 + c.lane * 2 + 1] * sigmoidf_(bfhi(zr));
            *(unsigned*)(MIXO + (t0 + tt) * 1024 + h * 128 + c.lane * 2) = pk2(y0, y1);
        }
    }
}

__device__ void swa_unit(int u, const bf16_t* SQ, const bf16_t* SK, const bf16_t* PROJ, const float* sinks, bf16_t* MIXO, const Ctx& c) {
    const int half = u & 1, n = (u >> 1) & 15, kvh = (u >> 5) & 1, b = u >> 6;
    bf16_t* Kb = (bf16_t*)c.smem; bf16_t* Vb = Kb + 256 * 64;
    const int kstart = (n - 1) * 128;
    __syncthreads();
    for (int idx = c.tid; idx < 4096; idx += 256) {
        const int arr = idx >> 11, r = idx & 2047, kj = r >> 3, chk = r & 7;
        const int kpos = kstart + kj;
        u32x4 v = (u32x4){0u, 0u, 0u, 0u};
        if (kpos >= 0) {
            const size_t tk = (size_t)b * SEQ + kpos;
            v = arr ? *(const u32x4*)(PROJ + tk * NPAD + 2184 + kvh * 64 + chk * 8) : *(const u32x4*)(SK + tk * 128 + kvh * 64 + chk * 8);
        }
        *(u32x4*)((arr ? Vb : Kb) + kj * 64 + chk * 8) = v;
    }
    __syncthreads();
    const int qi = c.tid & 127, g = half * 2 + (c.tid >> 7), hq = kvh * 4 + g;
    const size_t t = (size_t)b * SEQ + n * 128 + qi;
    float q[64], o[64];
#pragma unroll
    for (int i = 0; i < 8; ++i) {
        const u32x4 r = *(const u32x4*)(SQ + t * 512 + hq * 64 + i * 8);
        float f[8]; unpack8(r, f);
#pragma unroll
        for (int jj = 0; jj < 8; ++jj) q[i * 8 + jj] = f[jj];
    }
#pragma unroll
    for (int i = 0; i < 64; ++i) o[i] = 0.f;
    float m = sinks[hq], l = 1.f;
#pragma unroll 1
    for (int kj = (n == 0) ? 128 : 0; kj < 256; ++kj) {
        const int rel = qi + 128 - kj;
        if (rel >= 0 && rel < 128) {
            float sc = 0.f;
#pragma unroll
            for (int i = 0; i < 8; ++i) {
                const u32x4 r = *(const u32x4*)(Kb + kj * 64 + i * 8);
                float f[8]; unpack8(r, f);
#pragma unroll
                for (int jj = 0; jj < 8; ++jj) sc += q[i * 8 + jj] * f[jj];
            }
            const float mn = fmaxf(m, sc);
            const float al = __expf(m - mn), p = __expf(sc - mn);
            l = l * al + p; m = mn;
#pragma unroll
            for (int i = 0; i < 8; ++i) {
                const u32x4 r = *(const u32x4*)(Vb + kj * 64 + i * 8);
                float f[8]; unpack8(r, f);
#pragma unroll
                for (int jj = 0; jj < 8; ++jj) o[i * 8 + jj] = o[i * 8 + jj] * al + p * f[jj];
            }
        }
    }
    const float inv = 1.f / l;
#pragma unroll
    for (int i = 0; i < 8; ++i)
        *(u32x4*)(MIXO + t * 1024 + 512 + hq * 64 + i * 8) = (u32x4){pk2(o[i * 8] * inv, o[i * 8 + 1] * inv), pk2(o[i * 8 + 2] * inv, o[i * 8 + 3] * inv),
                                                                   pk2(o[i * 8 + 4] * inv, o[i * 8 + 5] * inv), pk2(o[i * 8 + 6] * inv, o[i * 8 + 7] * inv)};
}

typedef float f32x16 __attribute__((ext_vector_type(16)));
typedef short s16x4 __attribute__((ext_vector_type(4)));
#define MFMA32(a, b, c) __builtin_amdgcn_mfma_f32_32x32x16_bf16((a), (b), (c), 0, 0, 0)
template <int S_> __device__ __forceinline__ bf16x8 pack_step(const f32x16& x) {
    u32x4 p;
    asm volatile("v_cvt_pk_bf16_f32 %0, %4, %5\n\tv_cvt_pk_bf16_f32 %1, %6, %7\n\tv_cvt_pk_bf16_f32 %2, %8, %9\n\tv_cvt_pk_bf16_f32 %3, %10, %11\n\ts_nop 1"
                 : "=&v"(p[0]), "=&v"(p[1]), "=&v"(p[2]), "=&v"(p[3])
                 : "v"(x[8 * S_]), "v"(x[8 * S_ + 1]), "v"(x[8 * S_ + 2]), "v"(x[8 * S_ + 3]), "v"(x[8 * S_ + 4]), "v"(x[8 * S_ + 5]), "v"(x[8 * S_ + 6]), "v"(x[8 * S_ + 7]));
    return __builtin_bit_cast(bf16x8, p);
}
constexpr int ATT_VB = 64 * 128;

template <int NKS, bool WIN>
__device__ void attn_unit(const bf16_t* Qp, int q_ld, const bf16_t* K1, int k1_ld, const bf16_t* K2, int k2_ld, const bf16_t* Vp, int v_ld,
                          bf16_t* Op, int o_ld, int Q0, float sink_l2, const Ctx& c) {
    constexpr int KB = NKS * 2 * 1024, BUF = KB + ATT_VB;
    const int lane = c.lane, r = lane & 31, h = lane >> 5;
    const int wid = __builtin_amdgcn_readfirstlane(c.wid);
    const int q0w = Q0 + wid * 32;
    unsigned char* smem = c.smem;
    bf16x8 qf[NKS];
#pragma unroll
    for (int ks = 0; ks < NKS; ++ks) qf[ks] = *(const bf16x8*)(Qp + (size_t)(q0w + r) * q_ld + ks * 16 + h * 8);
    f32x16 o0, o1;
#pragma unroll
    for (int i = 0; i < 16; ++i) { o0[i] = 0.f; o1[i] = 0.f; }
    float m = WIN ? sink_l2 : -1e30f, l = (WIN && h == 0) ? 1.f : 0.f;
    const int kt_lo = WIN ? ((Q0 >> 6) - 2 < 0 ? 0 : (Q0 >> 6) - 2) : 0, kt_hi = (Q0 >> 6) + 1;
#define ATT_STAGE(kt_, buf_) do { unsigned char* bp = smem + (buf_) * BUF; const size_t kb = (size_t)(kt_) * 64; \
        _Pragma("unroll") for (int i = 0; i < (NKS * 2) / 4; ++i) { const int ch = wid + 4 * i; \
            const bf16_t* sp = (ch < 8) ? (K1 + (kb + lane) * k1_ld + ch * 8) : (K2 + (kb + lane) * k2_ld + (ch - 8) * 8); \
            glds16(sp, bp + ch * 1024 + lane * 16); } \
        _Pragma("unroll") for (int i = 0; i < 2; ++i) { const int j = wid + 4 * i; \
            glds16(Vp + (kb + 8 * j + (lane >> 3)) * v_ld + (lane & 7) * 8, bp + KB + j * 1024 + lane * 16); } } while (0)
    ATT_STAGE(kt_lo, 0);
    const int i16 = lane & 15;
    const unsigned vlane = (unsigned)((4 * h + (i16 >> 2)) * 128 + 32 * ((lane >> 4) & 1) + 8 * (i16 & 3));
    for (int kt = kt_lo; kt <= kt_hi; ++kt) {
        const int cur = (kt - kt_lo) & 1;
        asm volatile("s_waitcnt vmcnt(0)" ::: "memory");
        __syncthreads();
        if (kt < kt_hi) ATT_STAGE(kt + 1, cur ^ 1);
        const int k0 = kt * 64;
        const bool active = (k0 <= q0w + 31) && (!WIN || (k0 + 63 > q0w - 128));
        if (active) {
            const unsigned char* Kt = smem + cur * BUF;
            f32x16 x0, x1;
#pragma unroll
            for (int i = 0; i < 16; ++i) { x0[i] = 0.f; x1[i] = 0.f; }
#pragma unroll
            for (int ks = 0; ks < NKS; ++ks) {
                const bf16x8 kf0 = *(const bf16x8*)(Kt + (ks * 2 + h) * 1024 + r * 16);
                const bf16x8 kf1 = *(const bf16x8*)(Kt + (ks * 2 + h) * 1024 + (32 + r) * 16);
                x0 = MFMA32(kf0, qf[ks], x0); x1 = MFMA32(kf1, qf[ks], x1);
            }
            const bool need_mask = (k0 + 63 > q0w) || (WIN && (k0 <= q0w + 31 - 128));
            if (need_mask) {
                const int q = q0w + r;
#pragma unroll
                for (int i = 0; i < 16; ++i) {
                    const int key = k0 + (i & 3) + 8 * (i >> 2) + 4 * h;
                    const bool v0 = (key <= q) && (!WIN || key > q - 128);
                    const bool v1 = (key + 32 <= q) && (!WIN || key + 32 > q - 128);
                    x0[i] = v0 ? x0[i] : -INFINITY; x1[i] = v1 ? x1[i] : -INFINITY;
                }
            }
            float mx = fmaxf(x0[0], x1[0]);
#pragma unroll
            for (int i = 1; i < 16; ++i) mx = fmaxf(mx, fmaxf(x0[i], x1[i]));
            mx = fmaxf(mx, __shfl_xor(mx, 32));
            const float mn = fmaxf(m, mx);
            const float alpha = __builtin_amdgcn_exp2f(m - mn);
            m = mn;
            float ps = 0.f;
#pragma unroll
            for (int i = 0; i < 16; ++i) { x0[i] = __builtin_amdgcn_exp2f(x0[i] - mn); x1[i] = __builtin_amdgcn_exp2f(x1[i] - mn); ps += x0[i] + x1[i]; }
            l = l * alpha + ps;
            o0 *= alpha; o1 *= alpha;
            const unsigned vbase = (unsigned)(size_t)(smem + cur * BUF + KB) + vlane;
#pragma unroll
            for (int t = 0; t < 2; ++t) {
                s16x4 l00, h00, l01, h01, l10, h10, l11, h11;
                const unsigned va = vbase + t * 4096;
                asm volatile("ds_read_b64_tr_b16 %0, %8\n\t"
                             "ds_read_b64_tr_b16 %1, %8 offset:1024\n\t"
                             "ds_read_b64_tr_b16 %2, %8 offset:64\n\t"
                             "ds_read_b64_tr_b16 %3, %8 offset:1088\n\t"
                             "ds_read_b64_tr_b16 %4, %8 offset:2048\n\t"
                             "ds_read_b64_tr_b16 %5, %8 offset:3072\n\t"
                             "ds_read_b64_tr_b16 %6, %8 offset:2112\n\t"
                             "ds_read_b64_tr_b16 %7, %8 offset:3136\n\t"
                             "s_waitcnt lgkmcnt(0)"
                             : "=&v"(l00), "=&v"(h00), "=&v"(l01), "=&v"(h01), "=&v"(l10), "=&v"(h10), "=&v"(l11), "=&v"(h11) : "v"(va) : "memory");
                const bf16x8 v00 = __builtin_shufflevector(l00, h00, 0, 1, 2, 3, 4, 5, 6, 7), v01 = __builtin_shufflevector(l01, h01, 0, 1, 2, 3, 4, 5, 6, 7);
                const bf16x8 v10 = __builtin_shufflevector(l10, h10, 0, 1, 2, 3, 4, 5, 6, 7), v11 = __builtin_shufflevector(l11, h11, 0, 1, 2, 3, 4, 5, 6, 7);
                const bf16x8 pb0 = (t == 0) ? pack_step<0>(x0) : pack_step<0>(x1);
                const bf16x8 pb1 = (t == 0) ? pack_step<1>(x0) : pack_step<1>(x1);
                o0 = MFMA32(v00, pb0, o0); o1 = MFMA32(v01, pb0, o1);
                o0 = MFMA32(v10, pb1, o0); o1 = MFMA32(v11, pb1, o1);
            }
        }
    }
#undef ATT_STAGE
    l += __shfl_xor(l, 32);
    const float inv = 1.f / l;
    bf16_t* orow = Op + (size_t)(q0w + r) * o_ld + 4 * h;
#pragma unroll
    for (int g = 0; g < 4; ++g) {
        *(u32x2*)(orow + 8 * g) = (u32x2){pk2(o0[4 * g] * inv, o0[4 * g + 1] * inv), pk2(o0[4 * g + 2] * inv, o0[4 * g + 3] * inv)};
        *(u32x2*)(orow + 32 + 8 * g) = (u32x2){pk2(o1[4 * g] * inv, o1[4 * g + 1] * inv), pk2(o1[4 * g + 2] * inv, o1[4 * g + 3] * inv)};
    }
}

__device__ __forceinline__ float dppf(float v, int ctrl_sel) {
    int x = __builtin_bit_cast(int, v), r;
    if (ctrl_sel == 0) r = __builtin_amdgcn_update_dpp(0, x, 0xB1, 0xF, 0xF, true);
    else if (ctrl_sel == 1) r = __builtin_amdgcn_update_dpp(0, x, 0x4E, 0xF, 0xF, true);
    else if (ctrl_sel == 2) r = __builtin_amdgcn_update_dpp(0, x, 0x141, 0xF, 0xF, true);
    else r = __builtin_amdgcn_update_dpp(0, x, 0x140, 0xF, 0xF, true);
    return __builtin_bit_cast(float, r);
}
__device__ __forceinline__ float red16(float v) { v += dppf(v, 0); v += dppf(v, 1); v += dppf(v, 2); v += dppf(v, 3); return v; }

__device__ void gdn_unit2(int u, const bf16_t* GQ, const bf16_t* GK, const bf16_t* GV, const float* BETA, const float* GLOG, float* OG, const Ctx& c) {
    const int sl = u & 7, bh = u >> 3, b = bh >> 2, h = bh & 3;
    const int col = c.tid >> 4, rc = c.tid & 15;
    float* kf = (float*)c.smem; float* qf = kf + 32 * 128; float* vf = qf + 32 * 128; float* bt = vf + 32 * 16; float* av = bt + 32;
    float S[8];
#pragma unroll
    for (int i = 0; i < 8; ++i) S[i] = 0.f;
    const size_t tb = (size_t)b * SEQ;
    u32x4 rk[2], rq[2], rv; float rg = 0.f;
    const int tok0 = c.tid >> 4, chk = c.tid & 15;
#define GDN_LOAD(c0) do { \
        _Pragma("unroll") for (int i = 0; i < 2; ++i) { const size_t t = tb + (c0) + tok0 + 16 * i; \
            rk[i] = *(const u32x4*)(GK + t * 512 + h * 128 + chk * 8); rq[i] = *(const u32x4*)(GQ + t * 512 + h * 128 + chk * 8); } \
        if (c.tid < 64) rv = *(const u32x4*)(GV + (tb + (c0) + (c.tid >> 1)) * 512 + h * 128 + sl * 16 + (c.tid & 1) * 8); \
        if (c.tid < 32) rg = BETA[(tb + (c0) + c.tid) * 4 + h]; else if (c.tid < 64) rg = GLOG[(tb + (c0) + c.tid - 32) * 4 + h]; } while (0)
    GDN_LOAD(0);
    for (int c0 = 0; c0 < SEQ; c0 += 32) {
        __syncthreads();
#pragma unroll
        for (int i = 0; i < 2; ++i) {
            float f[8]; unpack8(rk[i], f);
            float* d = kf + (tok0 + 16 * i) * 128 + chk * 8;
            *(f32x4*)d = (f32x4){f[0], f[1], f[2], f[3]}; *(f32x4*)(d + 4) = (f32x4){f[4], f[5], f[6], f[7]};
            unpack8(rq[i], f);
            d = qf + (tok0 + 16 * i) * 128 + chk * 8;
            *(f32x4*)d = (f32x4){f[0], f[1], f[2], f[3]}; *(f32x4*)(d + 4) = (f32x4){f[4], f[5], f[6], f[7]};
        }
        if (c.tid < 64) { float f[8]; unpack8(rv, f); float* d = vf + (c.tid >> 1) * 16 + (c.tid & 1) * 8;
            *(f32x4*)d = (f32x4){f[0], f[1], f[2], f[3]}; *(f32x4*)(d + 4) = (f32x4){f[4], f[5], f[6], f[7]}; }
        if (c.tid < 32) bt[c.tid] = rg; else if (c.tid < 64) av[c.tid - 32] = expf(rg);
        if (c0 + 32 < SEQ) GDN_LOAD(c0 + 32);
        __syncthreads();
#pragma unroll 2
        for (int tt = 0; tt < 32; ++tt) {
            const f32x4 k0 = *(const f32x4*)(kf + tt * 128 + rc * 8), k1 = *(const f32x4*)(kf + tt * 128 + rc * 8 + 4);
            const f32x4 q0 = *(const f32x4*)(qf + tt * 128 + rc * 8), q1 = *(const f32x4*)(qf + tt * 128 + rc * 8 + 4);
            const float a = av[tt];
            float part = (k0[0] * S[0] + k0[1] * S[1]) + (k0[2] * S[2] + k0[3] * S[3]) + (k1[0] * S[4] + k1[1] * S[5]) + (k1[2] * S[6] + k1[3] * S[7]);
            const float kS = red16(part);
            const float vn = bt[tt] * (vf[tt * 16 + col] - a * kS);
#pragma unroll
            for (int i = 0; i < 4; ++i) { S[i] = a * S[i] + k0[i] * vn; S[4 + i] = a * S[4 + i] + k1[i] * vn; }
            float po = (q0[0] * S[0] + q0[1] * S[1]) + (q0[2] * S[2] + q0[3] * S[3]) + (q1[0] * S[4] + q1[1] * S[5]) + (q1[2] * S[6] + q1[3] * S[7]);
            po = red16(po);
            if (rc == 0) OG[(tb + c0 + tt) * 512 + h * 128 + sl * 16 + col] = po;
        }
    }
#undef GDN_LOAD
}

__device__ void mlstm_unit2(int u, const bf16_t* PROJ, const float* GATES, const float* b_i, const float* b_f, float* OG, const Ctx& c) {
    const int sl = u & 7, bh = u >> 3, b = bh >> 2, h = bh & 3;
    const int col = c.tid >> 4, rc = c.tid & 15;
    float* kf = (float*)c.smem; float* qf = kf + 32 * 64; float* vf = qf + 32 * 64; float* ip = vf + 32 * 16; float* lf = ip + 32;
    float C[4], nn[4];
#pragma unroll
    for (int i = 0; i < 4; ++i) { C[i] = 0.f; nn[i] = 0.f; }
    float mst = 0.f;
    const size_t tb = (size_t)b * SEQ;
    const float bi = b_i[h], bfv = b_f[h];
    u32x4 rk, rq, rv; float rg = 0.f;
    const int tok0 = c.tid >> 3, chk = c.tid & 7;
#define ML_LOAD(c0) do { const size_t t = tb + (c0) + tok0; \
        rk = *(const u32x4*)(PROJ + t * NPAD + 256 + h * 64 + chk * 8); rq = *(const u32x4*)(PROJ + t * NPAD + h * 64 + chk * 8); \
        if (c.tid < 64) rv = *(const u32x4*)(PROJ + (tb + (c0) + (c.tid >> 1)) * NPAD + 512 + h * 128 + sl * 16 + (c.tid & 1) * 8); \
        if (c.tid < 32) rg = GATES[(tb + (c0) + c.tid) * 8 + h]; else if (c.tid < 64) rg = GATES[(tb + (c0) + c.tid - 32) * 8 + 4 + h]; } while (0)
    ML_LOAD(0);
    for (int c0 = 0; c0 < SEQ; c0 += 32) {
        __syncthreads();
        {
            float f[8]; unpack8(rk, f);
            float* d = kf + tok0 * 64 + chk * 8;
            *(f32x4*)d = (f32x4){f[0], f[1], f[2], f[3]}; *(f32x4*)(d + 4) = (f32x4){f[4], f[5], f[6], f[7]};
            unpack8(rq, f);
            d = qf + tok0 * 64 + chk * 8;
            *(f32x4*)d = (f32x4){f[0], f[1], f[2], f[3]}; *(f32x4*)(d + 4) = (f32x4){f[4], f[5], f[6], f[7]};
        }
        if (c.tid < 64) { float f[8]; unpack8(rv, f); float* d = vf + (c.tid >> 1) * 16 + (c.tid & 1) * 8;
            *(f32x4*)d = (f32x4){f[0], f[1], f[2], f[3]}; *(f32x4*)(d + 4) = (f32x4){f[4], f[5], f[6], f[7]}; }
        if (c.tid < 32) ip[c.tid] = rg + bi; else if (c.tid < 64) lf[c.tid - 32] = -softplusf_(-(rg + bfv));
        if (c0 + 32 < SEQ) ML_LOAD(c0 + 32);
        __syncthreads();
#pragma unroll 2
        for (int tt = 0; tt < 32; ++tt) {
            const f32x4 k4 = *(const f32x4*)(kf + tt * 64 + rc * 4), q4 = *(const f32x4*)(qf + tt * 64 + rc * 4);
            const float lft = lf[tt], ipt = ip[tt];
            const float mn = fmaxf(lft + mst, ipt);
            const float fs = __expf(lft + mst - mn), is = __expf(ipt - mn) * 0.125f;
            mst = mn;
            const float vj = vf[tt * 16 + col] * is;
            float pn = 0.f, pd = 0.f;
#pragma unroll
            for (int i = 0; i < 4; ++i) { C[i] = fs * C[i] + k4[i] * vj; nn[i] = fs * nn[i] + k4[i] * is; pn += q4[i] * C[i]; pd += q4[i] * nn[i]; }
            pn = red16(pn); pd = red16(pd);
            if (rc == 0) OG[(tb + c0 + tt) * 512 + h * 128 + sl * 16 + col] = pn / fmaxf(fabsf(pd), __expf(-mn));
        }
    }
#undef ML_LOAD
}

__device__ void phase_post(const float* OG, const bf16_t* PROJ, const float* gain, bool odd, bf16_t* MIXO, const Ctx& c) {
    const int lane = c.lane;
    const int gcol = odd ? 1032 : 1960, ocol = odd ? 0 : 512;
    for (int t = c.bid * 4 + c.wid; t < T; t += c.nblk * 4) {
        const f32x4 a0 = *(const f32x4*)(OG + (size_t)t * 512 + lane * 8), a1 = *(const f32x4*)(OG + (size_t)t * 512 + lane * 8 + 4);
        float ss = (a0[0] * a0[0] + a0[1] * a0[1]) + (a0[2] * a0[2] + a0[3] * a0[3]) + (a1[0] * a1[0] + a1[1] * a1[1]) + (a1[2] * a1[2] + a1[3] * a1[3]);
        ss = red16(ss);
        const float rr = rsqrtf(ss * (1.f / 128.f) + 1e-6f);
        const u32x4 zr = *(const u32x4*)(PROJ + (size_t)t * NPAD + gcol + lane * 8);
        float z[8]; unpack8(zr, z);
        const int gi = odd ? lane * 8 : (lane & 15) * 8;
        const f32x4 g0 = *(const f32x4*)(gain + gi), g1 = *(const f32x4*)(gain + gi + 4);
        float y[8];
#pragma unroll
        for (int j = 0; j < 4; ++j) {
            const float ga = odd ? sigmoidf_(z[j]) : siluf_(z[j]), gb = odd ? sigmoidf_(z[4 + j]) : siluf_(z[4 + j]);
            y[j] = a0[j] * rr * g0[j] * ga; y[4 + j] = a1[j] * rr * g1[j] * gb;
        }
        *(u32x4*)(MIXO + (size_t)t * 1024 + ocol + lane * 8) = (u32x4){pk2(y[0], y[1]), pk2(y[2], y[3]), pk2(y[4], y[5]), pk2(y[6], y[7])};
    }
}

__global__ void __launch_bounds__(256, 2) fwd(Args a) {
    extern __shared__ __attribute__((aligned(16))) unsigned char smem[];
    Ctx c;
    c.tid = threadIdx.x; c.lane = c.tid & 63; c.wid = c.tid >> 6; c.wr = c.wid >> 1; c.wc = c.wid & 1; c.fr = c.lane & 15; c.fq = c.lane >> 4;
    c.bid = blockIdx.x; c.nblk = gridDim.x; c.smem = smem;
#define PH_CTX() do { int t_ = threadIdx.x; asm volatile("" : "+v"(t_)); c.tid = t_; c.lane = t_ & 63; c.wid = t_ >> 6; c.wr = c.wid >> 1; c.wc = c.wid & 1; c.fr = c.lane & 15; c.fq = c.lane >> 4; } while (0)
    unsigned char* ws = a.ws;
    unsigned* ctl = (unsigned*)(ws + WS_CTL);
    volatile LAS unsigned* xbw = (volatile LAS unsigned*)(smem + 65536);
    if (c.tid < 8) xbw[c.tid] = 0u;
    __syncthreads();
    XcdBarrier bar; bar.bar = ctl; bar.x = 0; bar.st = xbw;
    if (a.use_bar) bar = xcd_barrier_post(ctl, xbw);
    const int lo = a.ph_lo, hi = a.ph_hi;
#define IN(k) (lo <= (k) && (k) < hi)
#define PH(k) if (IN(k)) { PH_CTX();
#define SEAM(k) do { if ((k) + 1 < hi) xcd_barrier(bar); } while (0)

    bf16_t* XBF = (bf16_t*)(ws + WS_XBF);
    float* X1 = (float*)(ws + WS_X1);
    bf16_t* PROJ = (bf16_t*)(ws + U_PROJ);
    float* GATES = (float*)(ws + U_GATES);
    bf16_t* MIXO = (bf16_t*)(ws + U_MIXO);
    float* YBUF = (float*)(ws + U_YBUF);
    const float* ROPEM = (const float*)(ws + WS_ROPEM);
    const float* ROPES = (const float*)(ws + WS_ROPES);

    PH(0) for (int rep = 0; rep < REP_PRO; ++rep) phase_prologue(a, c); SEAM(0); }

    for (int layer = 0; layer < 4; ++layer) {
        const int pb = 1 + layer * PPL;
        if (pb >= hi || pb + PPL <= lo) continue;
        const int jj = layer >> 1;
        const bool odd = (layer & 1) != 0;
        const float* xres = (layer == 0) ? (const float*)a.in[0] : (const float*)a.out;
        unsigned* CNT = ctl + CW_CNT + layer * 128;
        const bf16_t* WIN = (const bf16_t*)(ws + WS_WIN) + (size_t)layer * WIN_ELEMS;
        const bf16_t* WOUT = (const bf16_t*)(ws + WS_WOUT) + (size_t)layer * WOUT_ELEMS;

        PH(pb + 0) for (int rep = 0; rep < REP_GEMM; ++rep) phase_inproj(XBF, WIN, PROJ, GATES, odd ? 1024 : 1952, c); SEAM(pb + 0); }
        PH(pb + 1)
            for (int rep = 0; rep < REP_TOK; ++rep) if (!odd) phase_prep_even(PROJ, GATES, (const float*)a.in[3] + jj * 256, (const float*)a.in[5] + jj * 128, (const float*)a.in[7] + jj * 4 * 1536,
                                      (const float*)a.in[8] + jj * 4, (const float*)a.in[9] + jj * 4, ROPEM,
                                      (bf16_t*)(ws + U_CQ), (bf16_t*)(ws + U_CKV), (bf16_t*)(ws + U_KROPE), (bf16_t*)(ws + U_GQ), (bf16_t*)(ws + U_GK), (bf16_t*)(ws + U_GV),
                                      (float*)(ws + U_BETA), (float*)(ws + U_GLOG), c);
            else phase_prep_odd(PROJ, ROPES, (bf16_t*)(ws + U_QF), (bf16_t*)(ws + U_KN), c);
            SEAM(pb + 1);
        }
        PH(pb + 2)
            if (!odd) for (int rep = 0; rep < REP_GEMM; ++rep) phase_mla_up((const bf16_t*)(ws + U_CQ), (const bf16_t*)(ws + WS_WQB) + (size_t)jj * WQB_ELEMS, (const bf16_t*)(ws + U_CKV),
                                   (const bf16_t*)(ws + WS_WKVB) + (size_t)jj * WKVB_ELEMS, ROPEM, (bf16_t*)(ws + U_QF), (bf16_t*)(ws + U_KN), (bf16_t*)(ws + U_VV), c);
            SEAM(pb + 2);
        }
        PH(pb + 3)
            unsigned* ctr = ctl + CW_WORK + pb + 3;
            float* OG = YBUF;
            if (!odd) {
                for (;;) {
                    const int u = next_unit(ctr, c);
                    if (u >= 256 + 1024) break;
                    if (u < 256) gdn_unit2(u, (const bf16_t*)(ws + U_GQ), (const bf16_t*)(ws + U_GK), (const bf16_t*)(ws + U_GV), (const float*)(ws + U_BETA),
                                           (const float*)(ws + U_GLOG), OG, c);
                    else {
                        const int v = u - 256, qb = 15 - (v >> 6), bh = v & 63, b = bh >> 3, hh = bh & 7;
                        const size_t tb = (size_t)b * SEQ;
                        attn_unit<6, false>((const bf16_t*)(ws + U_QF) + tb * 768 + hh * 96, 768, (const bf16_t*)(ws + U_KN) + tb * 512 + hh * 64, 512,
                                            (const bf16_t*)(ws + U_KROPE) + tb * 32, 32, (const bf16_t*)(ws + U_VV) + tb * 512 + hh * 64, 512,
                                            MIXO + tb * 1024 + hh * 64, 1024, qb * 128, 0.f, c);
                    }
                }
            } else {
                for (;;) {
                    const int u = next_unit(ctr, c);
                    if (u >= 256 + 1024) break;
                    if (u < 256) mlstm_unit2(u, PROJ, GATES, (const float*)a.in[13] + jj * 4, (const float*)a.in[14] + jj * 4, OG, c);
                    else {
                        const int v = u - 256, n = v & 15, hq = (v >> 4) & 7, b = v >> 7, kvh = hq >> 2;
                        const size_t tb = (size_t)b * SEQ;
                        attn_unit<4, true>((const bf16_t*)(ws + U_QF) + tb * 512 + hq * 64, 512, (const bf16_t*)(ws + U_KN) + tb * 128 + kvh * 64, 128,
                                           (const bf16_t*)(ws + U_KN), 0, PROJ + tb * NPAD + 2184 + kvh * 64, NPAD,
                                           MIXO + tb * 1024 + 512 + hq * 64, 1024, n * 128, ((const float*)a.in[16])[jj * 8 + hq] * 1.4426950408889634f, c);
                    }
                }
            }
            SEAM(pb + 3);
        }
        PH(pb + 4) phase_post(YBUF, PROJ, odd ? (const float*)a.in[15] + jj * 512 : (const float*)a.in[10] + jj * 128, odd, MIXO, c); SEAM(pb + 4); }
        PH(pb + 5) for (int rep = 0; rep < REP_GEMM; ++rep) phase_outproj(MIXO, WOUT, xres, YBUF, c); SEAM(pb + 5); }
        PH(pb + 6) for (int rep = 0; rep < REP_TOK; ++rep) phase_ln1(YBUF, (const float*)a.in[18] + layer * 1024, (const float*)a.in[19] + layer * 1024, X1, XBF, c); SEAM(pb + 6); }
        PH(pb + 7) for (int rep = 0; rep < REP_GEMM; ++rep) phase_router(XBF, (const bf16_t*)(ws + WS_WRT) + (size_t)layer * WRT_ELEMS, (float*)(ws + WS_LOG), c); SEAM(pb + 7); }
        PH(pb + 8) phase_route((const float*)(ws + WS_LOG), (const float*)a.in[21] + layer * 64, CNT, (int*)(ws + WS_LTOK), (float*)(ws + WS_LW), (int*)(ws + WS_ASG), c); SEAM(pb + 8); }
        PH(pb + 9) for (int rep = 0; rep < REP_GEMM; ++rep) phase_moe1(XBF, (const bf16_t*)(ws + WS_WGU) + (size_t)layer * 65 * WGU_ELEMS, CNT, (const int*)(ws + WS_LTOK), (bf16_t*)(ws + WS_HBUF), c); SEAM(pb + 9); }
        PH(pb + 10) for (int rep = 0; rep < REP_GEMM; ++rep) phase_moe2((const bf16_t*)(ws + WS_HBUF), (const bf16_t*)(ws + WS_WDN) + (size_t)layer * 65 * WDN_ELEMS, CNT, (const float*)(ws + WS_LW), (bf16_t*)(ws + U_Y), c); SEAM(pb + 10); }
        PH(pb + 11) phase_combine(X1, (const bf16_t*)(ws + U_Y), (const int*)(ws + WS_ASG), CNT, (const float*)a.in[28] + layer * 1024, (const float*)a.in[29] + layer * 1024,
                                         a.out, XBF, c); SEAM(pb + 11); }
    }
#undef IN
#undef PH
#undef PH_CTX
#undef SEAM
}

extern "C" void kernel_launch(void* const* d_in, const int* in_sizes, int n_in, void* d_out, int out_size, void* d_ws, size_t ws_size, hipStream_t stream) {
    static int grid = 0;
    if (grid == 0) {
        if (n_in != 30 || out_size != T * 1024 || ws_size < WS_END) {
            fprintf(stderr, "kernel_launch: unexpected shapes (n_in %d, out %d, ws %zu < %zu)\n", n_in, out_size, ws_size, (size_t)WS_END);
            grid = -1; return;
        }
        int dev = 0, cus = 0, per_cu = 0;
        (void)hipGetDevice(&dev);
        (void)hipDeviceGetAttribute(&cus, hipDeviceAttributeMultiprocessorCount, dev);
        (void)hipFuncSetAttribute((const void*)fwd, hipFuncAttributeMaxDynamicSharedMemorySize, DYN_LDS);
        (void)hipOccupancyMaxActiveBlocksPerMultiprocessor(&per_cu, (const void*)fwd, 256, DYN_LDS);
        (void)hipGetLastError();
        if (per_cu < 1) per_cu = 1;
        grid = cus * (per_cu < 2 ? per_cu : 2);
    }
    if (grid < 0) return;
    (void)hipMemsetAsync((char*)d_ws + WS_CTL, 0, CTL_BYTES, stream);
    Args a{};
    for (int i = 0; i < 30; ++i) a.in[i] = d_in[i];
    a.out = (float*)d_out; a.ws = (unsigned char*)d_ws; a.pad = 0;
#if ONE_LAUNCH
    a.ph_lo = 0; a.ph_hi = NPH; a.use_bar = 1;
    hipLaunchKernelGGL(fwd, dim3(grid), dim3(256), DYN_LDS, stream, a);
#else
    for (int p = 0; p < NPH; ++p) {
        a.ph_lo = p; a.ph_hi = p + 1; a.use_bar = 0;
        hipLaunchKernelGGL(fwd, dim3(grid), dim3(256), DYN_LDS, stream, a);
    }
#endif
}
```

```cpp
#include <hip/hip_runtime.h>
#include <stdint.h>
#include <stdio.h>

#define REP_GEMM 1
#define REP_G0 1
#define REP_G1 1
#define REP_G2 1
#define REP_G3 1
#define REP_MIX 1
#define REP_ONLY 0
#define REP_CMB 1
#define REP_PRO 1
#define REP_TOK 1
#ifndef ONE_LAUNCH
#define ONE_LAUNCH 1
#endif

typedef unsigned short bf16_t;
typedef short bf16x8 __attribute__((ext_vector_type(8)));
typedef float f32x4 __attribute__((ext_vector_type(4)));
typedef unsigned u32x4 __attribute__((ext_vector_type(4)));
typedef unsigned u32x2 __attribute__((ext_vector_type(2)));
#define LAS __attribute__((address_space(3)))
#define GAS __attribute__((address_space(1)))

constexpr int T = 16384, SEQ = 2048;
constexpr int NPAD = 2560;
constexpr int CAP = 16384;
constexpr int MAXRB = 1024 + 64 + 128;
constexpr int MAXROWS = MAXRB * 128;
constexpr float ALPHA = 1.681792830507429f;
constexpr int PPL = 12;
constexpr int NPH = 1 + 4 * PPL;
constexpr int DYN_LDS = 65536 + 64 + 1024;

constexpr size_t cmax(size_t a, size_t b) { return a > b ? a : b; }
constexpr size_t WS_CTL = 0;
constexpr size_t CTL_BYTES = 65536;
constexpr size_t WS_WIN = WS_CTL + CTL_BYTES;
constexpr size_t WIN_ELEMS = (size_t)NPAD * 1024;
constexpr size_t WS_WQB = WS_WIN + 4 * WIN_ELEMS * 2;
constexpr size_t WQB_ELEMS = 768 * 256;
constexpr size_t WS_WKVB = WS_WQB + 2 * WQB_ELEMS * 2;
constexpr size_t WKVB_ELEMS = 1024 * 128;
constexpr size_t WS_WOUT = WS_WKVB + 2 * WKVB_ELEMS * 2;
constexpr size_t WOUT_ELEMS = 1024 * 1024;
constexpr size_t WS_WRT = WS_WOUT + 4 * WOUT_ELEMS * 2;
constexpr size_t WRT_ELEMS = 128 * 1024;
constexpr size_t WS_WGU = WS_WRT + 4 * WRT_ELEMS * 2;
constexpr size_t WGU_ELEMS = 512 * 1024;
constexpr size_t WS_WDN = WS_WGU + 4 * 65 * WGU_ELEMS * 2;
constexpr size_t WDN_ELEMS = 1024 * 256;
constexpr size_t WS_ROPEM = WS_WDN + 4 * 65 * WDN_ELEMS * 2;
constexpr size_t WS_ROPES = WS_ROPEM + (size_t)T * 16 * 2 * 4;
constexpr size_t WS_X1 = WS_ROPES + (size_t)T * 32 * 2 * 4;
constexpr size_t WS_XBF = WS_X1 + (size_t)T * 1024 * 4;
constexpr size_t WS_HBUF = WS_XBF + (size_t)T * 1024 * 2;
constexpr size_t WS_LOG = WS_HBUF + (size_t)MAXROWS * 256 * 2;
constexpr size_t WS_ASG = WS_LOG + (size_t)T * 64 * 4;
constexpr size_t WS_LTOK = WS_ASG + (size_t)T * 8 * 4;
constexpr size_t WS_LW = WS_LTOK + (size_t)65 * CAP * 4;
constexpr size_t WS_U = WS_LW + (size_t)65 * CAP * 4;
constexpr size_t U_Y = WS_U;
constexpr size_t U_PROJ = WS_U;
constexpr size_t U_GATES = U_PROJ + (size_t)T * NPAD * 2;
constexpr size_t U_CQ = U_GATES + (size_t)T * 8 * 4;
constexpr size_t U_CKV = U_CQ + (size_t)T * 256 * 2;
constexpr size_t U_KROPE = U_CKV + (size_t)T * 128 * 2;
constexpr size_t U_QF = U_KROPE + (size_t)T * 32 * 2;
constexpr size_t U_KN = U_QF + (size_t)T * 768 * 2;
constexpr size_t U_VV = U_KN + (size_t)T * 512 * 2;
constexpr size_t U_GQ = U_VV + (size_t)T * 512 * 2;
constexpr size_t U_GK = U_GQ + (size_t)T * 512 * 2;
constexpr size_t U_GV = U_GK + (size_t)T * 512 * 2;
constexpr size_t U_BETA = U_GV + (size_t)T * 512 * 2;
constexpr size_t U_GLOG = U_BETA + (size_t)T * 4 * 4;
constexpr size_t U_MIXO = U_GLOG + (size_t)T * 4 * 4;
constexpr size_t U_YBUF = U_MIXO + (size_t)T * 1024 * 2;
constexpr size_t U_END1 = U_YBUF + (size_t)T * 1024 * 4;
constexpr size_t WS_END = WS_U + cmax((size_t)MAXROWS * 1024 * 2, U_END1 - WS_U);

constexpr int CW_CNT = 4096;
constexpr int CW_WORK = 8192;

#define XB_TMO      128
#define XB_XCNT(j)  (256  + 64 * (j))
#define XB_XSUB(j)  (1280 + 64 * (j))
#define XB_XGEN(j)  (2304 + 64 * (j))
#define XB_TOP      3328
#define XB_TOPGEN   3392
#define XCD_BAR_WORDS 3456
#define XB_SPIN_CAP (1u << 18)

__device__ __forceinline__ unsigned xb_ld(unsigned* p)              { return __hip_atomic_load(p, __ATOMIC_RELAXED, __HIP_MEMORY_SCOPE_AGENT); }
__device__ __forceinline__ unsigned xb_add(unsigned* p, unsigned v) { return __hip_atomic_fetch_add(p, v, __ATOMIC_RELAXED, __HIP_MEMORY_SCOPE_AGENT); }
__device__ __forceinline__ unsigned xb_xcc_id() { return (unsigned)__builtin_amdgcn_s_getreg((3 << 11) | 20) & 0xFu; }
#define XB_SPIN(cond, bar) do { unsigned _sp = 0; while (cond) { __builtin_amdgcn_s_sleep(1); \
    if ((++_sp & 255u) == 0u) { if (xb_ld(&(bar)[XB_TMO])) break; if (_sp > XB_SPIN_CAP) { atomicAdd(&(bar)[XB_TMO], 1u); break; } } } } while (0)

struct XcdBarrier { unsigned* bar; unsigned x; volatile LAS unsigned* st; };

__device__ __forceinline__ XcdBarrier xcd_barrier_post(unsigned* bar, volatile LAS unsigned* st) {
    XcdBarrier b; b.bar = bar; b.x = xb_xcc_id(); b.st = st;
    if (threadIdx.x == 0) (void)xb_add(&bar[XB_XCNT(b.x)], 1u);
    return b;
}
__device__ __forceinline__ void xcd_barrier_complete(unsigned* bar, unsigned x, unsigned& nloc, unsigned& nx) {
    const unsigned G = gridDim.x * gridDim.y * gridDim.z;
    unsigned sum, cnt, mine, sp = 0u;
    for (;;) {
        sum = 0u; cnt = 0u; mine = 0u;
#pragma unroll
        for (unsigned j = 0; j < 16; ++j) { const unsigned c = xb_ld(&bar[XB_XCNT(j)]); sum += c; cnt += (c > 0u) ? 1u : 0u; mine = (j == x) ? c : mine; }
        if (sum == G) break;
        __builtin_amdgcn_s_sleep(1);
        if ((++sp & 255u) == 0u) { if (xb_ld(&bar[XB_TMO])) break; if (sp > XB_SPIN_CAP) { atomicAdd(&bar[XB_TMO], 1u); break; } }
    }
    nloc = mine > 0u ? mine : 1u; nx = cnt > 0u ? cnt : 1u;
}
__device__ __forceinline__ void xcd_barrier(const XcdBarrier& b) {
    asm volatile("s_waitcnt vmcnt(0)" ::: "memory");
    __syncthreads();
    if (threadIdx.x == 0) {
        unsigned* bar = b.bar;
        __builtin_amdgcn_s_waitcnt(0);
        unsigned nloc = b.st[0], nx = b.st[1];
        if (nloc == 0u) { xcd_barrier_complete(bar, b.x, nloc, nx); b.st[0] = nloc; b.st[1] = nx; }
        const unsigned old = xb_add(&bar[XB_XSUB(b.x)], 1u);
        const unsigned gen = old / nloc;
        if (old + 1u == (gen + 1u) * nloc) {
            __builtin_amdgcn_fence(__ATOMIC_RELEASE, "agent");
            asm volatile("s_waitcnt vmcnt(0)" ::: "memory");
            const unsigned og = xb_add(&bar[XB_TOP], 1u);
            const unsigned tg = og / nx;
            if (og + 1u == (tg + 1u) * nx) xb_add(&bar[XB_TOPGEN], 1u);
            else XB_SPIN(xb_ld(&bar[XB_TOPGEN]) == tg, bar);
            __builtin_amdgcn_fence(__ATOMIC_ACQUIRE, "agent");
            xb_add(&bar[XB_XGEN(b.x)], 1u);
            asm volatile("s_waitcnt vmcnt(0)" ::: "memory");
        } else {
            XB_SPIN(xb_ld(&bar[XB_XGEN(b.x)]) == gen, bar);
            __builtin_amdgcn_fence(__ATOMIC_ACQUIRE, "agent");
            asm volatile("s_waitcnt vmcnt(0)" ::: "memory");
        }
    }
    __syncthreads();
}

__device__ __forceinline__ float bf2f(unsigned v) { return __uint_as_float(v << 16); }
__device__ __forceinline__ float bflo(unsigned w) { return __uint_as_float(w << 16); }
__device__ __forceinline__ float bfhi(unsigned w) { return __uint_as_float(w & 0xffff0000u); }
__device__ __forceinline__ unsigned f2bf(float f) { unsigned u = __float_as_uint(f); u += 0x7fffu + ((u >> 16) & 1u); return u >> 16; }
__device__ __forceinline__ unsigned pk2(float lo, float hi) { return f2bf(lo) | (f2bf(hi) << 16); }
__device__ __forceinline__ float wave_sum(float v) {
#pragma unroll
    for (int o = 32; o > 0; o >>= 1) v += __shfl_xor(v, o);
    return v;
}
__device__ __forceinline__ float sigmoidf_(float x) { return 1.f / (1.f + expf(-x)); }
__device__ __forceinline__ float siluf_(float x) { return x / (1.f + expf(-x)); }
__device__ __forceinline__ float softplusf_(float x) { return x > 20.f ? x : log1pf(expf(x)); }
__device__ __forceinline__ void glds16(const void* g, void* l) {
    __builtin_amdgcn_global_load_lds((const GAS unsigned*)g, (LAS unsigned*)l, 16, 0, 0);
}
__device__ __forceinline__ void unpack8(const u32x4 r, float (&f)[8]) {
    f[0] = bflo(r.x); f[1] = bfhi(r.x); f[2] = bflo(r.y); f[3] = bfhi(r.y);
    f[4] = bflo(r.z); f[5] = bfhi(r.z); f[6] = bflo(r.w); f[7] = bfhi(r.w);
}

struct Args {
    const void* in[30];
    float* out;
    unsigned char* ws;
    int ph_lo, ph_hi, use_bar, pad;
};

struct Ctx { int tid, lane, wid, wr, wc, fr, fq, bid, nblk; unsigned char* smem; };

#define WAIT_V(n) asm volatile("s_waitcnt vmcnt(" #n ")" ::: "memory")
__device__ __forceinline__ void gemm_tile(const bf16_t* a0, const bf16_t* a1, const bf16_t* b0, const bf16_t* b1,
                                          int nk, f32x4 (&acc)[4][4], const Ctx& c) {
#pragma unroll
    for (int m = 0; m < 4; ++m)
#pragma unroll
        for (int n = 0; n < 4; ++n) acc[m][n] = (f32x4){0.f, 0.f, 0.f, 0.f};
    unsigned char* smem = c.smem;
    const int sb = c.tid * 16;
    const int kofs = ((c.tid & 3) ^ ((c.tid >> 4) & 3)) * 8;
    a0 += kofs; a1 += kofs; b0 += kofs; b1 += kofs;
#define G_STAGE(kt_) do { unsigned char* sp_ = smem + ((kt_) & 3) * 16384 + sb; const int ko_ = (kt_) * 32; \
        glds16(a0 + ko_, sp_); glds16(a1 + ko_, sp_ + 4096); glds16(b0 + ko_, sp_ + 8192); glds16(b1 + ko_, sp_ + 12288); } while (0)
    WAIT_V(0);
    G_STAGE(0);
    if (nk > 1) G_STAGE(1);
    if (nk > 2) G_STAGE(2);
    const int roff = (c.fr * 64) + ((c.fq ^ ((c.fr >> 2) & 3)) * 16);
    for (int kt = 0; kt < nk; ++kt) {
        if (kt + 2 < nk) WAIT_V(8); else if (kt + 1 < nk) WAIT_V(4); else WAIT_V(0);
        asm volatile("" ::: "memory"); __builtin_amdgcn_s_barrier(); asm volatile("" ::: "memory");
        if (kt + 3 < nk) G_STAGE(kt + 3);
        const unsigned char* sa = smem + (kt & 3) * 16384 + c.wr * 4096 + roff; const unsigned char* sbb = smem + (kt & 3) * 16384 + 8192 + c.wc * 4096 + roff;
        bf16x8 af[4], bfr[4];
#pragma unroll
        for (int m = 0; m < 4; ++m) af[m] = *(const bf16x8*)(sa + m * 1024);
#pragma unroll
        for (int n = 0; n < 4; ++n) bfr[n] = *(const bf16x8*)(sbb + n * 1024);
        __builtin_amdgcn_s_setprio(1);
#pragma unroll
        for (int m = 0; m < 4; ++m)
#pragma unroll
            for (int n = 0; n < 4; ++n) acc[m][n] = __builtin_amdgcn_mfma_f32_16x16x32_bf16(bfr[n], af[m], acc[m][n], 0, 0, 0);
        __builtin_amdgcn_s_setprio(0);
    }
#undef G_STAGE
    __syncthreads();
}

__device__ __forceinline__ bool tile_map(int i, const Ctx& c, int ntm, int ntn, int& mt, int& nt) {
    const int vb = ((c.nblk & 7) == 0) ? (c.bid & 7) * (c.nblk >> 3) + (c.bid >> 3) : c.bid;
    const int L = i * c.nblk + vb;
    if (L >= ntm * ntn) return false;
    const int g = L / (8 * ntn), rem = L - g * 8 * ntn;
    const int gsz = (ntm - g * 8) < 8 ? (ntm - g * 8) : 8;
    mt = g * 8 + rem % gsz; nt = rem / gsz;
    return true;
}

constexpr int TS_RS = 272;
__device__ __forceinline__ void tile_put(const Ctx& c, int row_l, int col_l, const u32x2 v) { *(u32x2*)(c.smem + row_l * TS_RS + col_l * 2) = v; }
template <int NCOL>
__device__ __forceinline__ void tile_flush(const Ctx& c, bf16_t* out, size_t ld) {
    __syncthreads();
    constexpr int CPR = NCOL / 8, PER = (128 * CPR) / 256;
#pragma unroll
    for (int i = 0; i < PER; ++i) {
        const int idx = c.tid + 256 * i, row = idx / CPR, ch = idx % CPR;
        const u32x4 v = *(const u32x4*)(c.smem + row * TS_RS + ch * 16);
        *(u32x4*)(out + (size_t)row * ld + ch * 8) = v;
    }
    __syncthreads();
}

__device__ __forceinline__ void conv_family(const float* src, int nmat, size_t src_stride, int K, int N, int Nout,
                            bf16_t* dst, size_t dst_stride, int grp, int kind, const Ctx& c) {
    float* lds = (float*)c.smem;
    const int tk = K / 128, tn = Nout / 64, per = tk * tn, total = nmat * per;
    const int tx = c.tid & 15, ty = c.tid >> 4;
    f32x4 r[8];
#define CV_LOAD(u_) do { const int mat_ = (u_) / per, r_ = (u_) - mat_ * per, kt_ = r_ / tn, nt_ = r_ - kt_ * tn; \
        const float* s_ = src + (size_t)mat_ * src_stride + (size_t)(kt_ * 128 + ty) * N + nt_ * 64 + tx * 4; const bool in_ = (nt_ * 64 + tx * 4) < N; \
        _Pragma("unroll") for (int i = 0; i < 8; ++i) r[i] = in_ ? *(const f32x4*)(s_ + (size_t)(16 * i) * N) : (f32x4){0.f, 0.f, 0.f, 0.f}; } while (0)
    int u = c.bid;
    if (u < total) CV_LOAD(u);
    for (; u < total; u += c.nblk) {
#pragma unroll
        for (int i = 0; i < 8; ++i) *(f32x4*)(lds + (ty + 16 * i) * 68 + tx * 4) = r[i];
        if (u + c.nblk < total) CV_LOAD(u + c.nblk);
        __syncthreads();
        const int mat = u / per, rr = u - mat * per, kt = rr / tn, nt = rr - kt * tn;
        const int dmat = grp ? (mat / grp) * (grp + 1) + (mat % grp) : mat;
        bf16_t* d = dst + (size_t)dmat * dst_stride;
        const int nl = c.tid & 63, kq = (c.tid >> 6) * 32;
        unsigned w[16];
#pragma unroll
        for (int j = 0; j < 16; ++j) w[j] = pk2(lds[(kq + 2 * j) * 68 + nl], lds[(kq + 2 * j + 1) * 68 + nl]);
        const int n = nt * 64 + nl;
        const int drow = (kind == 0) ? n : ((n >> 5) * 64 + (n & 31) + (kind == 2 ? 32 : 0));
        u32x4* dp = (u32x4*)(d + (size_t)drow * K + kt * 128 + kq);
        dp[0] = (u32x4){w[0], w[1], w[2], w[3]}; dp[1] = (u32x4){w[4], w[5], w[6], w[7]};
        dp[2] = (u32x4){w[8], w[9], w[10], w[11]}; dp[3] = (u32x4){w[12], w[13], w[14], w[15]};
        __syncthreads();
    }
#undef CV_LOAD
}

__device__ __forceinline__ void phase_prologue(const Args& a, const Ctx& c) {
    unsigned char* ws = a.ws;
    bf16_t* WIN = (bf16_t*)(ws + WS_WIN);
    conv_family((const float*)a.in[2], 2, (size_t)1024 * 2472, 1024, 2472, NPAD, WIN, 2 * WIN_ELEMS, 0, 0, c);
    conv_family((const float*)a.in[12], 2, (size_t)1024 * 2312, 1024, 2312, NPAD, WIN + WIN_ELEMS, 2 * WIN_ELEMS, 0, 0, c);
    conv_family((const float*)a.in[4], 2, (size_t)256 * 768, 256, 768, 768, (bf16_t*)(ws + WS_WQB), WQB_ELEMS, 0, 0, c);
    conv_family((const float*)a.in[6], 2, (size_t)128 * 1024, 128, 1024, 1024, (bf16_t*)(ws + WS_WKVB), WKVB_ELEMS, 0, 0, c);
    bf16_t* WOUT = (bf16_t*)(ws + WS_WOUT);
    conv_family((const float*)a.in[11], 2, (size_t)1024 * 1024, 1024, 1024, 1024, WOUT, 2 * WOUT_ELEMS, 0, 0, c);
    conv_family((const float*)a.in[17], 2, (size_t)1024 * 1024, 1024, 1024, 1024, WOUT + WOUT_ELEMS, 2 * WOUT_ELEMS, 0, 0, c);
    conv_family((const float*)a.in[20], 4, (size_t)1024 * 64, 1024, 64, 128, (bf16_t*)(ws + WS_WRT), WRT_ELEMS, 0, 0, c);
    bf16_t* WGU = (bf16_t*)(ws + WS_WGU);
    conv_family((const float*)a.in[22], 256, (size_t)1024 * 256, 1024, 256, 256, WGU, WGU_ELEMS, 64, 1, c);
    conv_family((const float*)a.in[23], 256, (size_t)1024 * 256, 1024, 256, 256, WGU, WGU_ELEMS, 64, 2, c);
    conv_family((const float*)a.in[25], 4, (size_t)1024 * 256, 1024, 256, 256, WGU + 64 * WGU_ELEMS, 65 * WGU_ELEMS, 0, 1, c);
    conv_family((const float*)a.in[26], 4, (size_t)1024 * 256, 1024, 256, 256, WGU + 64 * WGU_ELEMS, 65 * WGU_ELEMS, 0, 2, c);
    bf16_t* WDN = (bf16_t*)(ws + WS_WDN);
    conv_family((const float*)a.in[24], 256, (size_t)256 * 1024, 256, 1024, 1024, WDN, WDN_ELEMS, 64, 0, c);
    conv_family((const float*)a.in[27], 4, (size_t)256 * 1024, 256, 1024, 1024, WDN + 64 * WDN_ELEMS, 65 * WDN_ELEMS, 0, 0, c);
    {
        const float* x = (const float*)a.in[0]; bf16_t* xb = (bf16_t*)(ws + WS_XBF);
        const size_t n8 = (size_t)T * 1024 / 8;
        for (size_t i = (size_t)c.bid * 256 + c.tid; i < n8; i += (size_t)c.nblk * 256) {
            const f32x4 v0 = *(const f32x4*)(x + i * 8), v1 = *(const f32x4*)(x + i * 8 + 4);
            *(u32x4*)(xb + i * 8) = (u32x4){pk2(v0[0], v0[1]), pk2(v0[2], v0[3]), pk2(v1[0], v1[1]), pk2(v1[2], v1[3])};
        }
    }
    {
        const int* pos = (const int*)a.in[1];
        float* rm = (float*)(ws + WS_ROPEM); float* rs = (float*)(ws + WS_ROPES);
        const float ln_theta = 9.210340371976184f;
        for (int i = c.bid * 256 + c.tid; i < T * 16; i += c.nblk * 256) {
            const int t = i >> 4, f = i & 15;
            const float inv = expf(-((float)(2 * f) / 32.f) * ln_theta);
            const float ang = (float)pos[t] * inv;
            rm[i * 2] = cosf(ang); rm[i * 2 + 1] = sinf(ang);
        }
        for (int i = c.bid * 256 + c.tid; i < T * 32; i += c.nblk * 256) {
            const int t = i >> 5, f = i & 31;
            const float inv = expf(-((float)(2 * f) / 64.f) * ln_theta);
            const float ang = (float)pos[t] * inv;
            rs[i * 2] = cosf(ang); rs[i * 2 + 1] = sinf(ang);
        }
    }
}

__device__ __forceinline__ void phase_inproj(const bf16_t* XBF, const bf16_t* W, bf16_t* PROJ, float* GATES, int gbase, const Ctx& c) {
    const int ntn = NPAD / 128;
    for (int i = 0;; ++i) {
        int mt, nt; if (!tile_map(i, c, T / 128, ntn, mt, nt)) break;
        const bf16_t* a0 = XBF + (size_t)(mt * 128 + (c.tid >> 2)) * 1024;
        const bf16_t* b0 = W + (size_t)(nt * 128 + (c.tid >> 2)) * 1024;
        f32x4 acc[4][4];
        gemm_tile(a0, a0 + 64 * 1024, b0, b0 + 64 * 1024, 32, acc, c);
#pragma unroll
        for (int m = 0; m < 4; ++m) {
            const int rl = c.wr * 64 + m * 16 + c.fr, row = mt * 128 + rl;
#pragma unroll
            for (int n = 0; n < 4; ++n) {
                const int cl = c.wc * 64 + n * 16 + c.fq * 4, col = nt * 128 + cl;
                const f32x4 v = acc[m][n];
                tile_put(c, rl, cl, (u32x2){pk2(v[0], v[1]), pk2(v[2], v[3])});
                if (col >= gbase && col < gbase + 8) *(f32x4*)(GATES + (size_t)row * 8 + (col - gbase)) = v;
            }
        }
        tile_flush<128>(c, PROJ + (size_t)mt * 128 * NPAD + nt * 128, NPAD);
    }
}

__device__ __forceinline__ void phase_mla_up(const bf16_t* CQ, const bf16_t* WQB, const bf16_t* CKV, const bf16_t* WKVB,
                             const float* ROPEM, bf16_t* QF, bf16_t* KN, bf16_t* VV, const Ctx& c) {
    const int tq = (T / 128) * 6, tkv = (T / 128) * 8;
    const float qscale = 0.10206207261596577f * 1.4426950408889634f;
    for (int u = c.bid; u < tq + tkv; u += c.nblk) {
        f32x4 acc[4][4];
        if (u < tq) {
            const int mt = u / 6, nt = u % 6;
            const bf16_t* a0 = CQ + (size_t)(mt * 128 + (c.tid >> 2)) * 256;
            const bf16_t* b0 = WQB + (size_t)(nt * 128 + (c.tid >> 2)) * 256;
            gemm_tile(a0, a0 + 64 * 256, b0, b0 + 64 * 256, 8, acc, c);
#pragma unroll
            for (int m = 0; m < 4; ++m) {
                const int row = mt * 128 + c.wr * 64 + m * 16 + c.fr;
#pragma unroll
                for (int np = 0; np < 2; ++np) {
                    const int cg = nt * 128 + c.wc * 64 + np * 32;
                    f32x4 v0 = acc[m][2 * np], v1 = acc[m][2 * np + 1];
                    if (((cg >> 5) % 3) == 2) {
#pragma unroll
                        for (int j = 0; j < 4; ++j) {
                            const int i = c.fq * 4 + j;
                            const float cs = ROPEM[((size_t)row * 16 + i) * 2], sn = ROPEM[((size_t)row * 16 + i) * 2 + 1];
                            const float x1 = v0[j], x2 = v1[j];
                            v0[j] = x1 * cs - x2 * sn; v1[j] = x2 * cs + x1 * sn;
                        }
                    }
                    v0 *= qscale; v1 *= qscale;
                    *(u32x2*)(QF + (size_t)row * 768 + cg + c.fq * 4) = (u32x2){pk2(v0[0], v0[1]), pk2(v0[2], v0[3])};
                    *(u32x2*)(QF + (size_t)row * 768 + cg + 16 + c.fq * 4) = (u32x2){pk2(v1[0], v1[1]), pk2(v1[2], v1[3])};
                }
            }
        } else {
            const int v = u - tq, mt = v / 8, nt = v % 8;
            const bf16_t* a0 = CKV + (size_t)(mt * 128 + (c.tid >> 2)) * 128;
            const bf16_t* b0 = WKVB + (size_t)(nt * 128 + (c.tid >> 2)) * 128;
            gemm_tile(a0, a0 + 64 * 128, b0, b0 + 64 * 128, 4, acc, c);
            bf16_t* dst = (c.wc == 0) ? KN : VV;
#pragma unroll
            for (int m = 0; m < 4; ++m) {
                const int row = mt * 128 + c.wr * 64 + m * 16 + c.fr;
#pragma unroll
                for (int n = 0; n < 4; ++n) {
                    const f32x4 x = acc[m][n];
                    *(u32x2*)(dst + (size_t)row * 512 + nt * 64 + n * 16 + c.fq * 4) = (u32x2){pk2(x[0], x[1]), pk2(x[2], x[3])};
                }
            }
        }
    }
}

__device__ __forceinline__ void phase_outproj(const bf16_t* MIXO, const bf16_t* W, const float* xres, float* YBUF, const Ctx& c) {
    for (int i = 0;; ++i) {
        int mt, nt; if (!tile_map(i, c, T / 128, 8, mt, nt)) break;
        const bf16_t* a0 = MIXO + (size_t)(mt * 128 + (c.tid >> 2)) * 1024;
        const bf16_t* b0 = W + (size_t)(nt * 128 + (c.tid >> 2)) * 1024;
        f32x4 acc[4][4];
        gemm_tile(a0, a0 + 64 * 1024, b0, b0 + 64 * 1024, 32, acc, c);
#pragma unroll
        for (int m = 0; m < 4; ++m) {
            const int row = mt * 128 + c.wr * 64 + m * 16 + c.fr;
#pragma unroll
            for (int n = 0; n < 4; ++n) {
                const int col = nt * 128 + c.wc * 64 + n * 16 + c.fq * 4;
                const f32x4 xr = *(const f32x4*)(xres + (size_t)row * 1024 + col);
                *(f32x4*)(YBUF + (size_t)row * 1024 + col) = xr * ALPHA + acc[m][n];
            }
        }
    }
}

__device__ __forceinline__ void phase_router(const bf16_t* XBF, const bf16_t* W, float* LOG, const Ctx& c) {
    for (int mt = c.bid; mt < T / 128; mt += c.nblk) {
        const bf16_t* a0 = XBF + (size_t)(mt * 128 + (c.tid >> 2)) * 1024;
        const bf16_t* b0 = W + (size_t)(c.tid >> 2) * 1024;
        f32x4 acc[4][4];
        gemm_tile(a0, a0 + 64 * 1024, b0, b0 + 64 * 1024, 32, acc, c);
        if (c.wc == 0) {
#pragma unroll
            for (int m = 0; m < 4; ++m) {
                const int row = mt * 128 + c.wr * 64 + m * 16 + c.fr;
#pragma unroll
                for (int n = 0; n < 4; ++n) *(f32x4*)(LOG + (size_t)row * 64 + n * 16 + c.fq * 4) = acc[m][n];
            }
        }
    }
}

__device__ __forceinline__ void build_block_table(const unsigned* CNT, int* bst, const Ctx& c) {
    __syncthreads();
    if (c.wid == 0) {
        const int cnt = (int)__hip_atomic_load(CNT + c.lane, __ATOMIC_RELAXED, __HIP_MEMORY_SCOPE_AGENT);
        const int nb = (cnt + 127) >> 7;
        int inc = nb;
#pragma unroll
        for (int o = 1; o < 64; o <<= 1) { const int x = __shfl_up(inc, o); if (c.lane >= o) inc += x; }
        bst[c.lane] = inc - nb; bst[66 + c.lane] = cnt;
        if (c.lane == 63) { bst[64] = inc; bst[65] = inc + T / 128; bst[66 + 64] = T; }
    }
    __syncthreads();
}
__device__ __forceinline__ int find_expert(const int* bst, int rb, const Ctx& c) {
    return __popcll(__ballot(bst[1 + c.lane] <= rb));
}

__device__ __forceinline__ void phase_moe1(const bf16_t* XBF, const bf16_t* WGU, const unsigned* CNT, const int* LTOK, bf16_t* HBUF, const Ctx& c) {
    int* bst = (int*)(c.smem + 65536 + 64);
    build_block_table(CNT, bst, c);
    const int nrb = bst[65];
    for (int i = 0;; ++i) {
        int rb, nt; if (!tile_map(i, c, nrb, 4, rb, nt)) break;
        const int e = find_expert(bst, rb, c);
        const int lb = rb - bst[e], cnt = bst[66 + e];
        const int p0 = lb * 128 + (c.tid >> 2), p1 = p0 + 64;
        const int t0 = (p0 < cnt) ? LTOK[(size_t)e * CAP + p0] : 0;
        const int t1 = (p1 < cnt) ? LTOK[(size_t)e * CAP + p1] : 0;
        const bf16_t* a0 = XBF + (size_t)t0 * 1024;
        const bf16_t* a1 = XBF + (size_t)t1 * 1024;
        const bf16_t* b0 = WGU + (size_t)e * WGU_ELEMS + (size_t)(nt * 128 + (c.tid >> 2)) * 1024;
        f32x4 acc[4][4];
        gemm_tile(a0, a1, b0, b0 + 64 * 1024, 32, acc, c);
#pragma unroll
        for (int m = 0; m < 4; ++m) {
            const int rl = c.wr * 64 + m * 16 + c.fr;
#pragma unroll
            for (int n = 0; n < 2; ++n) {
                const f32x4 g = acc[m][n], up = acc[m][n + 2];
                float h[4];
#pragma unroll
                for (int j = 0; j < 4; ++j) h[j] = siluf_(g[j]) * up[j];
                tile_put(c, rl, c.wc * 32 + n * 16 + c.fq * 4, (u32x2){pk2(h[0], h[1]), pk2(h[2], h[3])});
            }
        }
        tile_flush<64>(c, HBUF + (size_t)rb * 128 * 256 + nt * 64, 256);
    }
}

__device__ __forceinline__ void phase_moe2(const bf16_t* HBUF, const bf16_t* WDN, const unsigned* CNT, const float* LW, bf16_t* Y, const Ctx& c) {
    int* bst = (int*)(c.smem + 65536 + 64);
    build_block_table(CNT, bst, c);
    const int nrb = bst[65];
    for (int i = 0;; ++i) {
        int rb, nt; if (!tile_map(i, c, nrb, 8, rb, nt)) break;
        const int e = find_expert(bst, rb, c);
        const int lb = rb - bst[e], cnt = bst[66 + e];
        const bf16_t* a0 = HBUF + ((size_t)rb * 128 + (c.tid >> 2)) * 256;
        const bf16_t* b0 = WDN + (size_t)e * WDN_ELEMS + (size_t)(nt * 128 + (c.tid >> 2)) * 256;
        f32x4 acc[4][4];
        gemm_tile(a0, a0 + 64 * 256, b0, b0 + 64 * 256, 8, acc, c);
#pragma unroll
        for (int m = 0; m < 4; ++m) {
            const int lr = c.wr * 64 + m * 16 + c.fr;
            const int p = lb * 128 + lr;
            const float w = (p < cnt) ? LW[(size_t)e * CAP + p] : 0.f;
#pragma unroll
            for (int n = 0; n < 4; ++n) {
                const f32x4 v = acc[m][n] * w;
                tile_put(c, lr, c.wc * 64 + n * 16 + c.fq * 4, (u32x2){pk2(v[0], v[1]), pk2(v[2], v[3])});
            }
        }
        tile_flush<128>(c, Y + (size_t)rb * 128 * 1024 + nt * 128, 1024);
    }
}

__device__ __forceinline__ void ln_row_store(float (&v)[16], const float* g, const float* b, float* of32, bf16_t* obf, int lane) {
    float s = 0.f;
#pragma unroll
    for (int i = 0; i < 16; ++i) s += v[i];
    const float mean = wave_sum(s) * (1.f / 1024.f);
    float q = 0.f;
#pragma unroll
    for (int i = 0; i < 16; ++i) { v[i] -= mean; q += v[i] * v[i]; }
    const float rstd = rsqrtf(wave_sum(q) * (1.f / 1024.f) + 1e-5f);
#pragma unroll
    for (int hf = 0; hf < 2; ++hf) {
        const int col = hf * 512 + lane * 8;
        const f32x4 g0 = *(const f32x4*)(g + col), g1 = *(const f32x4*)(g + col + 4);
        const f32x4 b0 = *(const f32x4*)(b + col), b1 = *(const f32x4*)(b + col + 4);
        f32x4 y0, y1;
#pragma unroll
        for (int j = 0; j < 4; ++j) { y0[j] = v[hf * 8 + j] * rstd * g0[j] + b0[j]; y1[j] = v[hf * 8 + 4 + j] * rstd * g1[j] + b1[j]; }
        *(f32x4*)(of32 + col) = y0; *(f32x4*)(of32 + col + 4) = y1;
        *(u32x4*)(obf + col) = (u32x4){pk2(y0[0], y0[1]), pk2(y0[2], y0[3]), pk2(y1[0], y1[1]), pk2(y1[2], y1[3])};
    }
}

__device__ __forceinline__ void phase_ln1(const float* YBUF, const float* g, const float* b, float* X1, bf16_t* XBF, const Ctx& c) {
    for (int t = c.bid * 4 + c.wid; t < T; t += c.nblk * 4) {
        float v[16];
#pragma unroll
        for (int hf = 0; hf < 2; ++hf) {
            const float* p = YBUF + (size_t)t * 1024 + hf * 512 + c.lane * 8;
            const f32x4 a0 = *(const f32x4*)p, a1 = *(const f32x4*)(p + 4);
#pragma unroll
            for (int j = 0; j < 4; ++j) { v[hf * 8 + j] = a0[j]; v[hf * 8 + 4 + j] = a1[j]; }
        }
        ln_row_store(v, g, b, X1 + (size_t)t * 1024, XBF + (size_t)t * 1024, c.lane);
    }
}

__device__ __forceinline__ void phase_combine(const float* X1, const bf16_t* Y, const int* ASG, const unsigned* CNT, const float* g, const float* b,
                              float* XOUT, bf16_t* XBF, const Ctx& c) {
    int* bst = (int*)(c.smem + 65536 + 64);
    build_block_table(CNT, bst, c);
    for (int t = c.bid * 4 + c.wid; t < T; t += c.nblk * 4) {
        float v[16];
#pragma unroll
        for (int hf = 0; hf < 2; ++hf) {
            const float* p = X1 + (size_t)t * 1024 + hf * 512 + c.lane * 8;
            const f32x4 a0 = *(const f32x4*)p, a1 = *(const f32x4*)(p + 4);
#pragma unroll
            for (int j = 0; j < 4; ++j) { v[hf * 8 + j] = a0[j] * ALPHA; v[hf * 8 + 4 + j] = a1[j] * ALPHA; }
        }
#pragma unroll
        for (int k = 0; k < 9; ++k) {
            size_t crow;
            if (k < 8) { const int asg = ASG[(size_t)t * 8 + k]; crow = (size_t)bst[asg >> 16] * 128 + (asg & 0xffff); }
            else crow = (size_t)bst[64] * 128 + t;
#pragma unroll
            for (int hf = 0; hf < 2; ++hf) {
                const u32x4 r = *(const u32x4*)(Y + crow * 1024 + hf * 512 + c.lane * 8);
                float f[8]; unpack8(r, f);
#pragma unroll
                for (int j = 0; j < 8; ++j) v[hf * 8 + j] += f[j];
            }
        }
        ln_row_store(v, g, b, XOUT + (size_t)t * 1024, XBF + (size_t)t * 1024, c.lane);
    }
}

__device__ __forceinline__ void phase_route(const float* LOG, const float* rb, unsigned* CNT, int* LTOK, float* LW, int* ASG, const Ctx& c) {
    int* lcnt = (int*)c.smem;
    int* lbase = lcnt + 64;
    int* sel_e = lbase + 64;
    int* sel_p = sel_e + 256;
    float* sel_w = (float*)(sel_p + 256);
    const float rbias = rb[c.lane];
    for (int ch = c.bid; ch < T / 32; ch += c.nblk) {
        __syncthreads();
        if (c.tid < 64) lcnt[c.tid] = 0;
        __syncthreads();
        for (int tl = c.wid; tl < 32; tl += 4) {
            const int t = ch * 32 + tl;
            const float lg = LOG[(size_t)t * 64 + c.lane];
            const float sc = 1.f / (1.f + expf(-lg));
            const float v = sc + rbias;
            float m1 = v;
            m1 = fmaxf(m1, __shfl_xor(m1, 1)); m1 = fmaxf(m1, __shfl_xor(m1, 2)); m1 = fmaxf(m1, __shfl_xor(m1, 4));
            int cand = (v == m1) ? c.lane : 999;
            cand = min(cand, __shfl_xor(cand, 1)); cand = min(cand, __shfl_xor(cand, 2)); cand = min(cand, __shfl_xor(cand, 4));
            float m2 = (c.lane == cand) ? -INFINITY : v;
            m2 = fmaxf(m2, __shfl_xor(m2, 1)); m2 = fmaxf(m2, __shfl_xor(m2, 2)); m2 = fmaxf(m2, __shfl_xor(m2, 4));
            const float gs = m1 + m2;
            const int g = c.lane >> 3;
            int grank = 0;
#pragma unroll
            for (int gg = 0; gg < 8; ++gg) { const float o = __shfl(gs, gg * 8); grank += ((o > gs) || (o == gs && gg < g)) ? 1 : 0; }
            const bool gsel = grank < 4;
            const float mv = gsel ? v : -INFINITY;
            int rank = 0;
#pragma unroll 8
            for (int jj = 0; jj < 64; ++jj) { const float o = __shfl(mv, jj); rank += ((o > mv) || (o == mv && jj < c.lane)) ? 1 : 0; }
            const bool sel = gsel && rank < 8;
            const float ssum = wave_sum(sel ? sc : 0.f);
            const float w = sc / ssum * 2.5f;
            const unsigned long long bal = __ballot(sel);
            const int slot = __popcll(bal & ((1ull << c.lane) - 1ull));
            if (sel) {
                const int p = atomicAdd(&lcnt[c.lane], 1);
                sel_e[tl * 8 + slot] = c.lane; sel_p[tl * 8 + slot] = p; sel_w[tl * 8 + slot] = w;
            }
        }
        __syncthreads();
        if (c.tid < 64) { const int n = lcnt[c.tid]; lbase[c.tid] = n ? (int)atomicAdd(CNT + c.tid, (unsigned)n) : 0; }
        __syncthreads();
        {
            const int tl = c.tid >> 3, t = ch * 32 + tl;
            const int e = sel_e[c.tid], pos = lbase[e] + sel_p[c.tid];
            LTOK[(size_t)e * CAP + pos] = t; LW[(size_t)e * CAP + pos] = sel_w[c.tid];
            ASG[(size_t)t * 8 + (c.tid & 7)] = (e << 16) | pos;
            if (c.tid < 32) { const int ts = ch * 32 + c.tid; LTOK[(size_t)64 * CAP + ts] = ts; LW[(size_t)64 * CAP + ts] = 1.f; }
        }
    }
}

__device__ __forceinline__ void phase_prep_even(const bf16_t* PROJ, const float* GATES, const float* qn, const float* kvn, const float* cw,
                                const float* a_log, const float* dt_bias, const float* ROPEM,
                                bf16_t* CQ, bf16_t* CKV, bf16_t* KROPE, bf16_t* GQ, bf16_t* GK, bf16_t* GV, float* BETA, float* GLOG, const Ctx& c) {
    const int lane = c.lane;
    for (int t = c.bid * 4 + c.wid; t < T; t += c.nblk * 4) {
        const bf16_t* pr = PROJ + (size_t)t * NPAD;
        {
            const u32x2 r = *(const u32x2*)(pr + lane * 4);
            float v[4] = {bflo(r.x), bfhi(r.x), bflo(r.y), bfhi(r.y)};
            const float ss = wave_sum(v[0] * v[0] + v[1] * v[1] + v[2] * v[2] + v[3] * v[3]);
            const float rr = rsqrtf(ss * (1.f / 256.f) + 1e-6f);
            const f32x4 gq = *(const f32x4*)(qn + lane * 4);
            *(u32x2*)(CQ + (size_t)t * 256 + lane * 4) = (u32x2){pk2(v[0] * rr * gq[0], v[1] * rr * gq[1]), pk2(v[2] * rr * gq[2], v[3] * rr * gq[3])};
        }
        {
            const unsigned r = *(const unsigned*)(pr + 256 + lane * 2);
            const float v0 = bflo(r), v1 = bfhi(r);
            const float ss = wave_sum(v0 * v0 + v1 * v1);
            const float rr = rsqrtf(ss * (1.f / 128.f) + 1e-6f);
            *(unsigned*)(CKV + (size_t)t * 128 + lane * 2) = pk2(v0 * rr * kvn[lane * 2], v1 * rr * kvn[lane * 2 + 1]);
        }
        if (lane < 16) {
            const float x1 = bf2f(pr[384 + lane]), x2 = bf2f(pr[400 + lane]);
            const float cs = ROPEM[((size_t)t * 16 + lane) * 2], sn = ROPEM[((size_t)t * 16 + lane) * 2 + 1];
            KROPE[(size_t)t * 32 + lane] = (bf16_t)f2bf(x1 * cs - x2 * sn);
            KROPE[(size_t)t * 32 + 16 + lane] = (bf16_t)f2bf(x2 * cs + x1 * sn);
        }
        const int s = t & (SEQ - 1);
#pragma unroll 1
        for (int hg = 0; hg < 12; ++hg) {
            const int chn = hg * 128 + lane * 2;
            float a0 = 0.f, a1 = 0.f;
#pragma unroll
            for (int w = 0; w < 4; ++w) {
                if (s - 3 + w >= 0) {
                    const unsigned r = *(const unsigned*)(PROJ + (size_t)(t - 3 + w) * NPAD + 416 + chn);
                    a0 += cw[w * 1536 + chn] * bflo(r); a1 += cw[w * 1536 + chn + 1] * bfhi(r);
                }
            }
            float y0 = siluf_(a0), y1 = siluf_(a1);
            if (hg < 8) {
                const float ss = wave_sum(y0 * y0 + y1 * y1);
                float rr = rsqrtf(ss + 1e-6f);
                if (hg < 4) rr *= 0.08838834764831845f;
                y0 *= rr; y1 *= rr;
            }
            bf16_t* dst = (hg < 4) ? GQ : (hg < 8) ? GK : GV;
            *(unsigned*)(dst + (size_t)t * 512 + (hg & 3) * 128 + lane * 2) = pk2(y0, y1);
        }
        if (lane < 4) BETA[(size_t)t * 4 + lane] = sigmoidf_(GATES[(size_t)t * 8 + lane]);
        else if (lane < 8) { const int h = lane - 4; GLOG[(size_t)t * 4 + h] = -expf(a_log[h]) * softplusf_(GATES[(size_t)t * 8 + lane] + dt_bias[h]); }
    }
}

__device__ __forceinline__ void phase_prep_odd(const bf16_t* PROJ, const float* ROPES, bf16_t* SQ, bf16_t* SK, const Ctx& c) {
    const int lane = c.lane;
    for (int t = c.bid * 4 + c.wid; t < T; t += c.nblk * 4) {
        const bf16_t* pr = PROJ + (size_t)t * NPAD;
        const int i = lane & 31;
        const float cs = ROPES[((size_t)t * 32 + i) * 2], sn = ROPES[((size_t)t * 32 + i) * 2 + 1];
#pragma unroll
        for (int r = 0; r < 4; ++r) {
            const int h = (lane >> 5) + 2 * r;
            const float x1 = bf2f(pr[1544 + h * 64 + i]), x2 = bf2f(pr[1544 + h * 64 + 32 + i]);
            SQ[(size_t)t * 512 + h * 64 + i] = (bf16_t)f2bf((x1 * cs - x2 * sn) * 0.18033688011112042f);
            SQ[(size_t)t * 512 + h * 64 + 32 + i] = (bf16_t)f2bf((x2 * cs + x1 * sn) * 0.18033688011112042f);
        }
        {
            const int h = lane >> 5;
            const float x1 = bf2f(pr[2056 + h * 64 + i]), x2 = bf2f(pr[2056 + h * 64 + 32 + i]);
            SK[(size_t)t * 128 + h * 64 + i] = (bf16_t)f2bf(x1 * cs - x2 * sn);
            SK[(size_t)t * 128 + h * 64 + 32 + i] = (bf16_t)f2bf(x2 * cs + x1 * sn);
        }
    }
}

__device__ __forceinline__ int next_unit(unsigned* ctr, const Ctx& c) {
    volatile int* su = (volatile int*)(c.smem + 65536 + 16);
    __syncthreads();
    if (c.tid == 0) *su = (int)atomicAdd(ctr, 1u);
    __syncthreads();
    return *su;
}

__device__ __forceinline__ void mla_unit(int u, const bf16_t* QF, const bf16_t* KN, const bf16_t* KROPE, const bf16_t* VV, bf16_t* MIXO, const Ctx& c) {
    const int qb = 7 - (u >> 6), bh = u & 63, b = bh >> 3, h = bh & 7;
    const int s = qb * 256 + c.tid;
    const size_t t = (size_t)b * SEQ + s;
    float* tile = (float*)c.smem;
    float q[96], o[64];
#pragma unroll
    for (int i = 0; i < 12; ++i) {
        const u32x4 r = *(const u32x4*)(QF + t * 768 + h * 96 + i * 8);
        float f[8]; unpack8(r, f);
#pragma unroll
        for (int j = 0; j < 8; ++j) q[i * 8 + j] = f[j];
    }
#pragma unroll
    for (int i = 0; i < 64; ++i) o[i] = 0.f;
    float m = -1e30f, l = 0.f;
    const int nkt = (qb + 1) * 8;
    for (int kt = 0; kt < nkt; ++kt) {
        __syncthreads();
        for (int idx = c.tid; idx < 640; idx += 256) {
            const int key = idx / 20, chk = idx % 20;
            const size_t tk = (size_t)b * SEQ + kt * 32 + key;
            const bf16_t* src = (chk < 8) ? (KN + tk * 512 + h * 64 + chk * 8) : (chk < 12) ? (KROPE + tk * 32 + (chk - 8) * 8) : (VV + tk * 512 + h * 64 + (chk - 12) * 8);
            const u32x4 r = *(const u32x4*)src;
            float f[8]; unpack8(r, f);
            float* d = tile + key * 160 + chk * 8;
            *(f32x4*)d = (f32x4){f[0], f[1], f[2], f[3]}; *(f32x4*)(d + 4) = (f32x4){f[4], f[5], f[6], f[7]};
        }
        __syncthreads();
#pragma unroll 1
        for (int j = 0; j < 32; ++j) {
            const int key = kt * 32 + j;
            if (key <= s) {
                const float* kr = tile + j * 160;
                float sc = 0.f;
#pragma unroll
                for (int i = 0; i < 96; ++i) sc += q[i] * kr[i];
                const float mn = fmaxf(m, sc);
                const float al = __expf(m - mn), p = __expf(sc - mn);
                l = l * al + p;
#pragma unroll
                for (int i = 0; i < 64; ++i) o[i] = o[i] * al + p * kr[96 + i];
                m = mn;
            }
        }
    }
    const float inv = 1.f / l;
#pragma unroll
    for (int i = 0; i < 8; ++i)
        *(u32x4*)(MIXO + t * 1024 + h * 64 + i * 8) = (u32x4){pk2(o[i * 8] * inv, o[i * 8 + 1] * inv), pk2(o[i * 8 + 2] * inv, o[i * 8 + 3] * inv),
                                                             pk2(o[i * 8 + 4] * inv, o[i * 8 + 5] * inv), pk2(o[i * 8 + 6] * inv, o[i * 8 + 7] * inv)};
}

__device__ __forceinline__ void gdn_unit(int u, const bf16_t* GQ, const bf16_t* GK, const bf16_t* GV, const float* BETA, const float* GLOG,
                         const bf16_t* PROJ, const float* gnorm, bf16_t* MIXO, const Ctx& c) {
    const int b = u >> 2, h = u & 3;
    float* kf = (float*)c.smem; float* qf = kf + 16 * 128; float* vf = qf + 16 * 128; float* ob = vf + 16 * 128;
    float* bt = ob + 16 * 128; float* av = bt + 16;
    float S[64];
#pragma unroll
    for (int i = 0; i < 64; ++i) S[i] = 0.f;
    const int j = c.wid * 32 + (c.lane & 31), half = c.lane >> 5;
    for (int c0 = 0; c0 < SEQ; c0 += 16) {
        const size_t t0 = (size_t)b * SEQ + c0;
        __syncthreads();
#pragma unroll
        for (int i = 0; i < 3; ++i) {
            const int idx = c.tid + 256 * i, arr = idx >> 8, r = idx & 255, tok = r >> 4, chk = r & 15;
            const bf16_t* src = ((arr == 0) ? GK : (arr == 1) ? GQ : GV) + (t0 + tok) * 512 + h * 128 + chk * 8;
            const u32x4 rr = *(const u32x4*)src;
            float f[8]; unpack8(rr, f);
            float* d = kf + arr * 2048 + tok * 128 + chk * 8;
            *(f32x4*)d = (f32x4){f[0], f[1], f[2], f[3]}; *(f32x4*)(d + 4) = (f32x4){f[4], f[5], f[6], f[7]};
        }
        if (c.tid < 16) { bt[c.tid] = BETA[(t0 + c.tid) * 4 + h]; av[c.tid] = expf(GLOG[(t0 + c.tid) * 4 + h]); }
        __syncthreads();
#pragma unroll 1
        for (int tt = 0; tt < 16; ++tt) {
            const float* kr = kf + tt * 128 + half * 64; const float* qr = qf + tt * 128 + half * 64;
            const float a = av[tt];
            float kS = 0.f;
#pragma unroll
            for (int i = 0; i < 64; ++i) kS += kr[i] * S[i];
            kS += __shfl_xor(kS, 32);
            const float vn = bt[tt] * (vf[tt * 128 + j] - a * kS);
            float o = 0.f;
#pragma unroll
            for (int i = 0; i < 64; ++i) { S[i] = a * S[i] + kr[i] * vn; o += qr[i] * S[i]; }
            o += __shfl_xor(o, 32);
            if (half == 0) ob[tt * 128 + j] = o;
        }
        __syncthreads();
#pragma unroll
        for (int k = 0; k < 4; ++k) {
            const int tt = c.wid * 4 + k;
            const float o0 = ob[tt * 128 + c.lane * 2], o1 = ob[tt * 128 + c.lane * 2 + 1];
            const float rr = rsqrtf(wave_sum(o0 * o0 + o1 * o1) * (1.f / 128.f) + 1e-6f);
            const unsigned zr = *(const unsigned*)(PROJ + (t0 + tt) * NPAD + 1960 + h * 128 + c.lane * 2);
            const float y0 = o0 * rr * gnorm[c.lane * 2] * siluf_(bflo(zr)), y1 = o1 * rr * gnorm[c.lane * 2 + 1] * siluf_(bfhi(zr));
            *(unsigned*)(MIXO + (t0 + tt) * 1024 + 512 + h * 128 + c.lane * 2) = pk2(y0, y1);
        }
    }
}

__device__ __forceinline__ void mlstm_unit(int u, const bf16_t* PROJ, const float* GATES, const float* b_i, const float* b_f, const float* mnorm, bf16_t* MIXO, const Ctx& c) {
    const int b = u >> 2, h = u & 3;
    float* kf = (float*)c.smem; float* qf = kf + 16 * 64; float* vf = qf + 16 * 64; float* ob = vf + 16 * 128;
    float* ip = ob + 16 * 128; float* lf = ip + 16;
    float C[32], nn[32];
#pragma unroll
    for (int i = 0; i < 32; ++i) { C[i] = 0.f; nn[i] = 0.f; }
    float mst = 0.f;
    const int j = c.wid * 32 + (c.lane & 31), half = c.lane >> 5;
    const float bi = b_i[h], bfv = b_f[h];
    for (int c0 = 0; c0 < SEQ; c0 += 16) {
        const size_t t0 = (size_t)b * SEQ + c0;
        __syncthreads();
        {
            const int idx = c.tid;
            if (idx < 128) { const int tok = idx >> 3, chk = idx & 7;
                const u32x4 rr = *(const u32x4*)(PROJ + (t0 + tok) * NPAD + 256 + h * 64 + chk * 8); float f[8]; unpack8(rr, f);
                float* d = kf + tok * 64 + chk * 8; *(f32x4*)d = (f32x4){f[0], f[1], f[2], f[3]}; *(f32x4*)(d + 4) = (f32x4){f[4], f[5], f[6], f[7]}; }
            else { const int i2 = idx - 128, tok = i2 >> 3, chk = i2 & 7;
                const u32x4 rr = *(const u32x4*)(PROJ + (t0 + tok) * NPAD + h * 64 + chk * 8); float f[8]; unpack8(rr, f);
                float* d = qf + tok * 64 + chk * 8; *(f32x4*)d = (f32x4){f[0], f[1], f[2], f[3]}; *(f32x4*)(d + 4) = (f32x4){f[4], f[5], f[6], f[7]}; }
            { const int tok = idx >> 4, chk = idx & 15;
                const u32x4 rr = *(const u32x4*)(PROJ + (t0 + tok) * NPAD + 512 + h * 128 + chk * 8); float f[8]; unpack8(rr, f);
                float* d = vf + tok * 128 + chk * 8; *(f32x4*)d = (f32x4){f[0], f[1], f[2], f[3]}; *(f32x4*)(d + 4) = (f32x4){f[4], f[5], f[6], f[7]}; }
            if (idx < 16) { ip[idx] = GATES[(t0 + idx) * 8 + h] + bi; lf[idx] = -softplusf_(-(GATES[(t0 + idx) * 8 + 4 + h] + bfv)); }
        }
        __syncthreads();
#pragma unroll 1
        for (int tt = 0; tt < 16; ++tt) {
            const float* kr = kf + tt * 64 + half * 32; const float* qr = qf + tt * 64 + half * 32;
            const float mn = fmaxf(lf[tt] + mst, ip[tt]);
            const float fs = expf(lf[tt] + mst - mn), is = expf(ip[tt] - mn) * 0.125f;
            mst = mn;
            const float vj = vf[tt * 128 + j] * is;
            float num = 0.f, den = 0.f;
#pragma unroll
            for (int i = 0; i < 32; ++i) {
                C[i] = fs * C[i] + kr[i] * vj; nn[i] = fs * nn[i] + kr[i] * is;
                num += qr[i] * C[i]; den += qr[i] * nn[i];
            }
            num += __shfl_xor(num, 32); den += __shfl_xor(den, 32);
            if (half == 0) ob[tt * 128 + j] = num / fmaxf(fabsf(den), expf(-mn));
        }
        __syncthreads();
#pragma unroll
        for (int k = 0; k < 4; ++k) {
            const int tt = c.wid * 4 + k;
            const float o0 = ob[tt * 128 + c.lane * 2], o1 = ob[tt * 128 + c.lane * 2 + 1];
            const float rr = rsqrtf(wave_sum(o0 * o0 + o1 * o1) * (1.f / 128.f) + 1e-6f);
            const unsigned zr = *(const unsigned*)(PROJ + (t0 + tt) * NPAD + 1032 + h * 128 + c.lane * 2);
            const float y0 = o0 * rr * mnorm[h * 128 + c.lane * 2] * sigmoidf_(bflo(zr)), y1 = o1 * rr * mnorm[h * 128 + c.lane * 2 + 1] * sigmoidf_(bfhi(zr));
            *(unsigned*)(MIXO + (t0 + tt) * 1024 + h * 128 + c.lane * 2) = pk2(y0, y1);
        }
    }
}

__device__ __forceinline__ void swa_unit(int u, const bf16_t* SQ, const bf16_t* SK, const bf16_t* PROJ, const float* sinks, bf16_t* MIXO, const Ctx& c) {
    const int half = u & 1, n = (u >> 1) & 15, kvh = (u >> 5) & 1, b = u >> 6;
    bf16_t* Kb = (bf16_t*)c.smem; bf16_t* Vb = Kb + 256 * 64;
    const int kstart = (n - 1) * 128;
    __syncthreads();
    for (int idx = c.tid; idx < 4096; idx += 256) {
        const int arr = idx >> 11, r = idx & 2047, kj = r >> 3, chk = r & 7;
        const int kpos = kstart + kj;
        u32x4 v = (u32x4){0u, 0u, 0u, 0u};
        if (kpos >= 0) {
            const size_t tk = (size_t)b * SEQ + kpos;
            v = arr ? *(const u32x4*)(PROJ + tk * NPAD + 2184 + kvh * 64 + chk * 8) : *(const u32x4*)(SK + tk * 128 + kvh * 64 + chk * 8);
        }
        *(u32x4*)((arr ? Vb : Kb) + kj * 64 + chk * 8) = v;
    }
    __syncthreads();
    const int qi = c.tid & 127, g = half * 2 + (c.tid >> 7), hq = kvh * 4 + g;
    const size_t t = (size_t)b * SEQ + n * 128 + qi;
    float q[64], o[64];
#pragma unroll
    for (int i = 0; i < 8; ++i) {
        const u32x4 r = *(const u32x4*)(SQ + t * 512 + hq * 64 + i * 8);
        float f[8]; unpack8(r, f);
#pragma unroll
        for (int jj = 0; jj < 8; ++jj) q[i * 8 + jj] = f[jj];
    }
#pragma unroll
    for (int i = 0; i < 64; ++i) o[i] = 0.f;
    float m = sinks[hq], l = 1.f;
#pragma unroll 1
    for (int kj = (n == 0) ? 128 : 0; kj < 256; ++kj) {
        const int rel = qi + 128 - kj;
        if (rel >= 0 && rel < 128) {
            float sc = 0.f;
#pragma unroll
            for (int i = 0; i < 8; ++i) {
                const u32x4 r = *(const u32x4*)(Kb + kj * 64 + i * 8);
                float f[8]; unpack8(r, f);
#pragma unroll
                for (int jj = 0; jj < 8; ++jj) sc += q[i * 8 + jj] * f[jj];
            }
            const float mn = fmaxf(m, sc);
            const float al = __expf(m - mn), p = __expf(sc - mn);
            l = l * al + p; m = mn;
#pragma unroll
            for (int i = 0; i < 8; ++i) {
                const u32x4 r = *(const u32x4*)(Vb + kj * 64 + i * 8);
                float f[8]; unpack8(r, f);
#pragma unroll
                for (int jj = 0; jj < 8; ++jj) o[i * 8 + jj] = o[i * 8 + jj] * al + p * f[jj];
            }
        }
    }
    const float inv = 1.f / l;
#pragma unroll
    for (int i = 0; i < 8; ++i)
        *(u32x4*)(MIXO + t * 1024 + 512 + hq * 64 + i * 8) = (u32x4){pk2(o[i * 8] * inv, o[i * 8 + 1] * inv), pk2(o[i * 8 + 2] * inv, o[i * 8 + 3] * inv),
                                                                   pk2(o[i * 8 + 4] * inv, o[i * 8 + 5] * inv), pk2(o[i * 8 + 6] * inv, o[i * 8 + 7] * inv)};
}

typedef float f32x16 __attribute__((ext_vector_type(16)));
typedef short s16x4 __attribute__((ext_vector_type(4)));
#define MFMA32(a, b, c) __builtin_amdgcn_mfma_f32_32x32x16_bf16((a), (b), (c), 0, 0, 0)
template <int S_> __device__ __forceinline__ bf16x8 pack_step(const f32x16& x) {
    u32x4 p;
    asm volatile("v_cvt_pk_bf16_f32 %0, %4, %5\n\tv_cvt_pk_bf16_f32 %1, %6, %7\n\tv_cvt_pk_bf16_f32 %2, %8, %9\n\tv_cvt_pk_bf16_f32 %3, %10, %11\n\ts_nop 1"
                 : "=&v"(p[0]), "=&v"(p[1]), "=&v"(p[2]), "=&v"(p[3])
                 : "v"(x[8 * S_]), "v"(x[8 * S_ + 1]), "v"(x[8 * S_ + 2]), "v"(x[8 * S_ + 3]), "v"(x[8 * S_ + 4]), "v"(x[8 * S_ + 5]), "v"(x[8 * S_ + 6]), "v"(x[8 * S_ + 7]));
    return __builtin_bit_cast(bf16x8, p);
}
constexpr int ATT_VB = 64 * 128;

template <int NKS, bool WIN>
__device__ __forceinline__ void attn_unit(const bf16_t* Qp, int q_ld, const bf16_t* K1, int k1_ld, const bf16_t* K2, int k2_ld, const bf16_t* Vp, int v_ld,
                          bf16_t* Op, int o_ld, int Q0, float sink_l2, const Ctx& c) {
    constexpr int KB = NKS * 2 * 1024, BUF = KB + ATT_VB;
    const int lane = c.lane, r = lane & 31, h = lane >> 5;
    const int wid = __builtin_amdgcn_readfirstlane(c.wid);
    const int q0w = Q0 + wid * 32;
    unsigned char* smem = c.smem;
    bf16x8 qf[NKS];
#pragma unroll
    for (int ks = 0; ks < NKS; ++ks) qf[ks] = *(const bf16x8*)(Qp + (size_t)(q0w + r) * q_ld + ks * 16 + h * 8);
    f32x16 o0, o1;
#pragma unroll
    for (int i = 0; i < 16; ++i) { o0[i] = 0.f; o1[i] = 0.f; }
    float m = WIN ? sink_l2 : -1e30f, l = (WIN && h == 0) ? 1.f : 0.f;
    const int kt_lo = WIN ? ((Q0 >> 6) - 2 < 0 ? 0 : (Q0 >> 6) - 2) : 0, kt_hi = (Q0 >> 6) + 1;
#define ATT_STAGE(kt_, buf_) do { unsigned char* bp = smem + (buf_) * BUF; const size_t kb = (size_t)(kt_) * 64; \
        _Pragma("unroll") for (int i = 0; i < (NKS * 2) / 4; ++i) { const int ch = wid + 4 * i; \
            const bf16_t* sp = (ch < 8) ? (K1 + (kb + lane) * k1_ld + ch * 8) : (K2 + (kb + lane) * k2_ld + (ch - 8) * 8); \
            glds16(sp, bp + ch * 1024 + lane * 16); } \
        _Pragma("unroll") for (int i = 0; i < 2; ++i) { const int j = wid + 4 * i; \
            glds16(Vp + (kb + 8 * j + (lane >> 3)) * v_ld + (lane & 7) * 8, bp + KB + j * 1024 + lane * 16); } } while (0)
    ATT_STAGE(kt_lo, 0);
    const int i16 = lane & 15;
    const unsigned vlane = (unsigned)((4 * h + (i16 >> 2)) * 128 + 32 * ((lane >> 4) & 1) + 8 * (i16 & 3));
    for (int kt = kt_lo; kt <= kt_hi; ++kt) {
        const int cur = (kt - kt_lo) & 1;
        asm volatile("s_waitcnt vmcnt(0)" ::: "memory");
        __syncthreads();
        if (kt < kt_hi) ATT_STAGE(kt + 1, cur ^ 1);
        const int k0 = kt * 64;
        const bool active = (k0 <= q0w + 31) && (!WIN || (k0 + 63 > q0w - 128));
        if (active) {
            const unsigned char* Kt = smem + cur * BUF;
            f32x16 x0, x1;
#pragma unroll
            for (int i = 0; i < 16; ++i) { x0[i] = 0.f; x1[i] = 0.f; }
#pragma unroll
            for (int ks = 0; ks < NKS; ++ks) {
                const bf16x8 kf0 = *(const bf16x8*)(Kt + (ks * 2 + h) * 1024 + r * 16);
                const bf16x8 kf1 = *(const bf16x8*)(Kt + (ks * 2 + h) * 1024 + (32 + r) * 16);
                x0 = MFMA32(kf0, qf[ks], x0); x1 = MFMA32(kf1, qf[ks], x1);
            }
            const bool need_mask = (k0 + 63 > q0w) || (WIN && (k0 <= q0w + 31 - 128));
            if (need_mask) {
                const int q = q0w + r;
#pragma unroll
                for (int i = 0; i < 16; ++i) {
                    const int key = k0 + (i & 3) + 8 * (i >> 2) + 4 * h;
                    const bool v0 = (key <= q) && (!WIN || key > q - 128);
                    const bool v1 = (key + 32 <= q) && (!WIN || key + 32 > q - 128);
                    x0[i] = v0 ? x0[i] : -INFINITY; x1[i] = v1 ? x1[i] : -INFINITY;
                }
            }
            float mx = fmaxf(x0[0], x1[0]);
#pragma unroll
            for (int i = 1; i < 16; ++i) mx = fmaxf(mx, fmaxf(x0[i], x1[i]));
            mx = fmaxf(mx, __shfl_xor(mx, 32));
            const float mn = fmaxf(m, mx);
            const float alpha = __builtin_amdgcn_exp2f(m - mn);
            m = mn;
            float ps = 0.f;
#pragma unroll
            for (int i = 0; i < 16; ++i) { x0[i] = __builtin_amdgcn_exp2f(x0[i] - mn); x1[i] = __builtin_amdgcn_exp2f(x1[i] - mn); ps += x0[i] + x1[i]; }
            l = l * alpha + ps;
            o0 *= alpha; o1 *= alpha;
            const unsigned vbase = (unsigned)(size_t)(smem + cur * BUF + KB) + vlane;
#pragma unroll
            for (int t = 0; t < 2; ++t) {
                s16x4 l00, h00, l01, h01, l10, h10, l11, h11;
                const unsigned va = vbase + t * 4096;
                asm volatile("ds_read_b64_tr_b16 %0, %8\n\t"
                             "ds_read_b64_tr_b16 %1, %8 offset:1024\n\t"
                             "ds_read_b64_tr_b16 %2, %8 offset:64\n\t"
                             "ds_read_b64_tr_b16 %3, %8 offset:1088\n\t"
                             "ds_read_b64_tr_b16 %4, %8 offset:2048\n\t"
                             "ds_read_b64_tr_b16 %5, %8 offset:3072\n\t"
                             "ds_read_b64_tr_b16 %6, %8 offset:2112\n\t"
                             "ds_read_b64_tr_b16 %7, %8 offset:3136\n\t"
                             "s_waitcnt lgkmcnt(0)"
                             : "=&v"(l00), "=&v"(h00), "=&v"(l01), "=&v"(h01), "=&v"(l10), "=&v"(h10), "=&v"(l11), "=&v"(h11) : "v"(va) : "memory");
                const bf16x8 v00 = __builtin_shufflevector(l00, h00, 0, 1, 2, 3, 4, 5, 6, 7), v01 = __builtin_shufflevector(l01, h01, 0, 1, 2, 3, 4, 5, 6, 7);
                const bf16x8 v10 = __builtin_shufflevector(l10, h10, 0, 1, 2, 3, 4, 5, 6, 7), v11 = __builtin_shufflevector(l11, h11, 0, 1, 2, 3, 4, 5, 6, 7);
                const bf16x8 pb0 = (t == 0) ? pack_step<0>(x0) : pack_step<0>(x1);
                const bf16x8 pb1 = (t == 0) ? pack_step<1>(x0) : pack_step<1>(x1);
                o0 = MFMA32(v00, pb0, o0); o1 = MFMA32(v01, pb0, o1);
                o0 = MFMA32(v10, pb1, o0); o1 = MFMA32(v11, pb1, o1);
            }
        }
    }
#undef ATT_STAGE
    l += __shfl_xor(l, 32);
    const float inv = 1.f / l;
    bf16_t* orow = Op + (size_t)(q0w + r) * o_ld + 4 * h;
#pragma unroll
    for (int g = 0; g < 4; ++g) {
        *(u32x2*)(orow + 8 * g) = (u32x2){pk2(o0[4 * g] * inv, o0[4 * g + 1] * inv), pk2(o0[4 * g + 2] * inv, o0[4 * g + 3] * inv)};
        *(u32x2*)(orow + 32 + 8 * g) = (u32x2){pk2(o1[4 * g] * inv, o1[4 * g + 1] * inv), pk2(o1[4 * g + 2] * inv, o1[4 * g + 3] * inv)};
    }
}

__device__ __forceinline__ float dppf(float v, int ctrl_sel) {
    int x = __builtin_bit_cast(int, v), r;
    if (ctrl_sel == 0) r = __builtin_amdgcn_update_dpp(0, x, 0xB1, 0xF, 0xF, true);
    else if (ctrl_sel == 1) r = __builtin_amdgcn_update_dpp(0, x, 0x4E, 0xF, 0xF, true);
    else if (ctrl_sel == 2) r = __builtin_amdgcn_update_dpp(0, x, 0x141, 0xF, 0xF, true);
    else r = __builtin_amdgcn_update_dpp(0, x, 0x140, 0xF, 0xF, true);
    return __builtin_bit_cast(float, r);
}
__device__ __forceinline__ float red16(float v) { v += dppf(v, 0); v += dppf(v, 1); v += dppf(v, 2); v += dppf(v, 3); return v; }

__device__ __forceinline__ float red32(float v) {
    v = red16(v);
    float a = v, b = v;
    asm volatile("s_nop 1\n\tv_permlane32_swap_b32 %0, %1\n\ts_nop 1" : "+v"(a), "+v"(b));
    return a + b;
}

__device__ __forceinline__ void gdn_unit2(int u, const bf16_t* GQ, const bf16_t* GK, const bf16_t* GV, const float* BETA, const float* GLOG, float* OG, const Ctx& c) {
    const int sl = u & 15, bh = u >> 4, b = bh >> 2, h = bh & 3;
    const int col = c.wid * 2 + ((c.lane >> 4) & 1), rcx = (c.lane >> 5) * 16 + (c.lane & 15);
    float* kf = (float*)c.smem; float* qf = kf + 32 * 128; float* bvf = qf + 32 * 128; float* baf = bvf + 32 * 8; float* af = baf + 32;
    float S[4];
#pragma unroll
    for (int i = 0; i < 4; ++i) S[i] = 0.f;
    const size_t tb = (size_t)b * SEQ;
    u32x4 rk[2], rq[2], rv; float rbeta = 0.f, rglog = 0.f;
    const int tok0 = c.tid >> 4, chk = c.tid & 15;
#define GDN_LOAD(c0) do { \
        _Pragma("unroll") for (int i = 0; i < 2; ++i) { const size_t t = tb + (c0) + tok0 + 16 * i; \
            rk[i] = *(const u32x4*)(GK + t * 512 + h * 128 + chk * 8); rq[i] = *(const u32x4*)(GQ + t * 512 + h * 128 + chk * 8); } \
        if (c.tid < 32) { const size_t t = tb + (c0) + c.tid; rv = *(const u32x4*)(GV + t * 512 + h * 128 + sl * 8); \
            rbeta = BETA[t * 4 + h]; rglog = GLOG[t * 4 + h]; } } while (0)
    GDN_LOAD(0);
    for (int c0 = 0; c0 < SEQ; c0 += 32) {
        __syncthreads();
#pragma unroll
        for (int i = 0; i < 2; ++i) {
            float f[8]; unpack8(rk[i], f);
            float* d = kf + (tok0 + 16 * i) * 128 + chk * 8;
            *(f32x4*)d = (f32x4){f[0], f[1], f[2], f[3]}; *(f32x4*)(d + 4) = (f32x4){f[4], f[5], f[6], f[7]};
            unpack8(rq[i], f);
            d = qf + (tok0 + 16 * i) * 128 + chk * 8;
            *(f32x4*)d = (f32x4){f[0], f[1], f[2], f[3]}; *(f32x4*)(d + 4) = (f32x4){f[4], f[5], f[6], f[7]};
        }
        if (c.tid < 32) { float f[8]; unpack8(rv, f); float* d = bvf + c.tid * 8;
            *(f32x4*)d = (f32x4){f[0] * rbeta, f[1] * rbeta, f[2] * rbeta, f[3] * rbeta}; *(f32x4*)(d + 4) = (f32x4){f[4] * rbeta, f[5] * rbeta, f[6] * rbeta, f[7] * rbeta};
            const float av = expf(rglog); af[c.tid] = av; baf[c.tid] = av * rbeta; }
        if (c0 + 32 < SEQ) GDN_LOAD(c0 + 32);
        __syncthreads();
        float keep = 0.f;
        f32x4 ka, qa, kb, qb; float aa, baa, bva, ab, bab, bvb;
#define GDN_LD(tt_, K4, Q4, A_, BA_, BV_) do { const int t_ = (tt_) < 32 ? (tt_) : 31; \
            K4 = *(const f32x4*)(kf + t_ * 128 + rcx * 4); Q4 = *(const f32x4*)(qf + t_ * 128 + rcx * 4); \
            A_ = af[t_]; BA_ = baf[t_]; BV_ = bvf[t_ * 8 + col]; } while (0)
#define GDN_STEP(tt_, K4, Q4, A_, BA_, BV_) do { \
            const float part = (K4[0] * S[0] + K4[1] * S[1]) + (K4[2] * S[2] + K4[3] * S[3]); \
            float aS[4]; _Pragma("unroll") for (int i = 0; i < 4; ++i) aS[i] = A_ * S[i]; \
            const float kS = red32(part); const float vn = BV_ - BA_ * kS; \
            _Pragma("unroll") for (int i = 0; i < 4; ++i) S[i] = aS[i] + K4[i] * vn; \
            float po = (Q4[0] * S[0] + Q4[1] * S[1]) + (Q4[2] * S[2] + Q4[3] * S[3]); \
            po = red32(po); keep = (rcx == (tt_)) ? po : keep; } while (0)
        GDN_LD(0, ka, qa, aa, baa, bva);
#pragma unroll 2
        for (int t2 = 0; t2 < 16; ++t2) {
            GDN_LD(2 * t2 + 1, kb, qb, ab, bab, bvb);
            GDN_STEP(2 * t2, ka, qa, aa, baa, bva);
            GDN_LD(2 * t2 + 2, ka, qa, aa, baa, bva);
            GDN_STEP(2 * t2 + 1, kb, qb, ab, bab, bvb);
        }
#undef GDN_LD
#undef GDN_STEP
        OG[(tb + c0 + rcx) * 512 + h * 128 + sl * 8 + col] = keep;
    }
#undef GDN_LOAD
}

__device__ __forceinline__ void mlstm_unit2(int u, const bf16_t* PROJ, const float* GATES, const float* b_i, const float* b_f, float* OG, const Ctx& c) {
    typedef float f32x2 __attribute__((ext_vector_type(2)));
    const int sl = u & 15, bh = u >> 4, b = bh >> 2, h = bh & 3;
    const int col = c.wid * 2 + ((c.lane >> 4) & 1), rcx = (c.lane >> 5) * 16 + (c.lane & 15);
    float* kf = (float*)c.smem; float* qf = kf + 32 * 64; float* vf = qf + 32 * 64; float* fsA = vf + 32 * 8; float* isA = fsA + 32; float* emA = isA + 32;
    float C[2], nn[2];
#pragma unroll
    for (int i = 0; i < 2; ++i) { C[i] = 0.f; nn[i] = 0.f; }
    float mprev = 0.f;
    const size_t tb = (size_t)b * SEQ;
    const float bi = b_i[h], bfv = b_f[h];
    u32x4 rk, rq, rv; float rgi = 0.f, rgf = 0.f;
    const int tok0 = c.tid >> 3, chk = c.tid & 7;
#define ML_LOAD(c0) do { const size_t t = tb + (c0) + tok0; \
        rk = *(const u32x4*)(PROJ + t * NPAD + 256 + h * 64 + chk * 8); rq = *(const u32x4*)(PROJ + t * NPAD + h * 64 + chk * 8); \
        if (c.tid < 64) { const size_t tg = tb + (c0) + (c.tid & 31); rv = *(const u32x4*)(PROJ + tg * NPAD + 512 + h * 128 + sl * 8); \
            rgi = GATES[tg * 8 + h]; rgf = GATES[tg * 8 + 4 + h]; } } while (0)
    ML_LOAD(0);
    for (int c0 = 0; c0 < SEQ; c0 += 32) {
        __syncthreads();
        {
            float f[8]; unpack8(rk, f);
            float* d = kf + tok0 * 64 + chk * 8;
            *(f32x4*)d = (f32x4){f[0], f[1], f[2], f[3]}; *(f32x4*)(d + 4) = (f32x4){f[4], f[5], f[6], f[7]};
            unpack8(rq, f);
            d = qf + tok0 * 64 + chk * 8;
            *(f32x4*)d = (f32x4){f[0], f[1], f[2], f[3]}; *(f32x4*)(d + 4) = (f32x4){f[4], f[5], f[6], f[7]};
        }
        if (c.tid < 64) {
            const int l5 = c.lane & 31;
            const float ipt = rgi + bi, lft = -softplusf_(-(rgf + bfv));
            float F = lft;
#pragma unroll
            for (int o = 1; o < 32; o <<= 1) { const float x = __shfl_up(F, o, 32); if (l5 >= o) F += x; }
            float P = ipt - F;
#pragma unroll
            for (int o = 1; o < 32; o <<= 1) { const float x = __shfl_up(P, o, 32); if (l5 >= o) P = fmaxf(P, x); }
            const float mt = F + fmaxf(mprev, P);
            float mtm1 = __shfl_up(mt, 1, 32); if (l5 == 0) mtm1 = mprev;
            mprev = __shfl(mt, 31, 32);
            if (c.tid < 32) {
                const float isv = expf(ipt - mt) * 0.125f;
                fsA[l5] = expf(lft + mtm1 - mt); isA[l5] = isv; emA[l5] = expf(-mt);
                float f[8]; unpack8(rv, f); float* d = vf + c.tid * 8;
                *(f32x4*)d = (f32x4){f[0] * isv, f[1] * isv, f[2] * isv, f[3] * isv}; *(f32x4*)(d + 4) = (f32x4){f[4] * isv, f[5] * isv, f[6] * isv, f[7] * isv};
            }
        }
        if (c0 + 32 < SEQ) ML_LOAD(c0 + 32);
        __syncthreads();
        float keep = 0.f;
        f32x2 k2a, q2a, k2b, q2b; float fsa, isa, ema, va, fsb, isb, emb, vb;
#define ML_LD(tt_, K2, Q2, FS_, IS_, EM_, V_) do { const int t_ = (tt_) < 32 ? (tt_) : 31; \
            K2 = *(const f32x2*)(kf + t_ * 64 + rcx * 2); Q2 = *(const f32x2*)(qf + t_ * 64 + rcx * 2); \
            FS_ = fsA[t_]; IS_ = isA[t_]; EM_ = emA[t_]; V_ = vf[t_ * 8 + col]; } while (0)
#define ML_STEP(tt_, K2, Q2, FS_, IS_, EM_, V_) do { float pn = 0.f, pd = 0.f; \
            _Pragma("unroll") for (int i = 0; i < 2; ++i) { C[i] = FS_ * C[i] + K2[i] * V_; nn[i] = FS_ * nn[i] + K2[i] * IS_; pn += Q2[i] * C[i]; pd += Q2[i] * nn[i]; } \
            pn = red32(pn); pd = red32(pd); \
            const float hv = pn * __builtin_amdgcn_rcpf(fmaxf(fabsf(pd), EM_)); \
            keep = (rcx == (tt_)) ? hv : keep; } while (0)
        ML_LD(0, k2a, q2a, fsa, isa, ema, va);
#pragma unroll 2
        for (int t2 = 0; t2 < 16; ++t2) {
            ML_LD(2 * t2 + 1, k2b, q2b, fsb, isb, emb, vb);
            ML_STEP(2 * t2, k2a, q2a, fsa, isa, ema, va);
            ML_LD(2 * t2 + 2, k2a, q2a, fsa, isa, ema, va);
            ML_STEP(2 * t2 + 1, k2b, q2b, fsb, isb, emb, vb);
        }
#undef ML_LD
#undef ML_STEP
        OG[(tb + c0 + rcx) * 512 + h * 128 + sl * 8 + col] = keep;
    }
#undef ML_LOAD
}

__device__ __forceinline__ void phase_post(const float* OG, const bf16_t* PROJ, const float* gain, bool odd, bf16_t* MIXO, const Ctx& c) {
    const int lane = c.lane;
    const int gcol = odd ? 1032 : 1960, ocol = odd ? 0 : 512;
    for (int t = c.bid * 4 + c.wid; t < T; t += c.nblk * 4) {
        const f32x4 a0 = *(const f32x4*)(OG + (size_t)t * 512 + lane * 8), a1 = *(const f32x4*)(OG + (size_t)t * 512 + lane * 8 + 4);
        float ss = (a0[0] * a0[0] + a0[1] * a0[1]) + (a0[2] * a0[2] + a0[3] * a0[3]) + (a1[0] * a1[0] + a1[1] * a1[1]) + (a1[2] * a1[2] + a1[3] * a1[3]);
        ss = red16(ss);
        const float rr = rsqrtf(ss * (1.f / 128.f) + 1e-6f);
        const u32x4 zr = *(const u32x4*)(PROJ + (size_t)t * NPAD + gcol + lane * 8);
        float z[8]; unpack8(zr, z);
        const int gi = odd ? lane * 8 : (lane & 15) * 8;
        const f32x4 g0 = *(const f32x4*)(gain + gi), g1 = *(const f32x4*)(gain + gi + 4);
        float y[8];
#pragma unroll
        for (int j = 0; j < 4; ++j) {
            const float ga = odd ? sigmoidf_(z[j]) : siluf_(z[j]), gb = odd ? sigmoidf_(z[4 + j]) : siluf_(z[4 + j]);
            y[j] = a0[j] * rr * g0[j] * ga; y[4 + j] = a1[j] * rr * g1[j] * gb;
        }
        *(u32x4*)(MIXO + (size_t)t * 1024 + ocol + lane * 8) = (u32x4){pk2(y[0], y[1]), pk2(y[2], y[3]), pk2(y[4], y[5]), pk2(y[6], y[7])};
    }
}

__global__ void __launch_bounds__(256, 2) fwd(Args a) {
    extern __shared__ __attribute__((aligned(16))) unsigned char smem[];
    Ctx c;
    c.tid = threadIdx.x; c.lane = c.tid & 63; c.wid = c.tid >> 6; c.wr = c.wid >> 1; c.wc = c.wid & 1; c.fr = c.lane & 15; c.fq = c.lane >> 4;
    c.bid = blockIdx.x; c.nblk = gridDim.x; c.smem = smem;
#define PH_CTX() do { int t_ = threadIdx.x; asm volatile("" : "+v"(t_)); c.tid = t_; c.lane = t_ & 63; c.wid = t_ >> 6; c.wr = c.wid >> 1; c.wc = c.wid & 1; c.fr = c.lane & 15; c.fq = c.lane >> 4; } while (0)
    unsigned char* ws = a.ws;
    unsigned* ctl = (unsigned*)(ws + WS_CTL);
    volatile LAS unsigned* xbw = (volatile LAS unsigned*)(smem + 65536);
    if (c.tid < 8) xbw[c.tid] = 0u;
    __syncthreads();
    XcdBarrier bar; bar.bar = ctl; bar.x = 0; bar.st = xbw;
    if (a.use_bar) bar = xcd_barrier_post(ctl, xbw);
    const int lo = a.ph_lo, hi = a.ph_hi;
#define IN(k) (lo <= (k) && (k) < hi)
#define PH(k) if (IN(k)) { PH_CTX();
#define SEAM(k) do { if ((k) + 1 < hi) xcd_barrier(bar); } while (0)

    bf16_t* XBF = (bf16_t*)(ws + WS_XBF);
    float* X1 = (float*)(ws + WS_X1);
    bf16_t* PROJ = (bf16_t*)(ws + U_PROJ);
    float* GATES = (float*)(ws + U_GATES);
    bf16_t* MIXO = (bf16_t*)(ws + U_MIXO);
    float* YBUF = (float*)(ws + U_YBUF);
    const float* ROPEM = (const float*)(ws + WS_ROPEM);
    const float* ROPES = (const float*)(ws + WS_ROPES);

    PH(0) for (int rep = 0; rep < REP_PRO; ++rep) phase_prologue(a, c); SEAM(0); }

    for (int layer = 0; layer < 4; ++layer) {
        const int pb = 1 + layer * PPL;
        if (pb >= hi || pb + PPL <= lo) continue;
        const int jj = layer >> 1;
        const bool odd = (layer & 1) != 0;
        const float* xres = (layer == 0) ? (const float*)a.in[0] : (const float*)a.out;
        unsigned* CNT = ctl + CW_CNT + layer * 128;
        const bf16_t* WIN = (const bf16_t*)(ws + WS_WIN) + (size_t)layer * WIN_ELEMS;
        const bf16_t* WOUT = (const bf16_t*)(ws + WS_WOUT) + (size_t)layer * WOUT_ELEMS;

        PH(pb + 0) for (int rep = 0; rep < REP_GEMM * REP_G0; ++rep) phase_inproj(XBF, WIN, PROJ, GATES, odd ? 1024 : 1952, c); SEAM(pb + 0); }
        PH(pb + 1)
            for (int rep = 0; rep < REP_TOK; ++rep) if (!odd) phase_prep_even(PROJ, GATES, (const float*)a.in[3] + jj * 256, (const float*)a.in[5] + jj * 128, (const float*)a.in[7] + jj * 4 * 1536,
                                      (const float*)a.in[8] + jj * 4, (const float*)a.in[9] + jj * 4, ROPEM,
                                      (bf16_t*)(ws + U_CQ), (bf16_t*)(ws + U_CKV), (bf16_t*)(ws + U_KROPE), (bf16_t*)(ws + U_GQ), (bf16_t*)(ws + U_GK), (bf16_t*)(ws + U_GV),
                                      (float*)(ws + U_BETA), (float*)(ws + U_GLOG), c);
            else phase_prep_odd(PROJ, ROPES, (bf16_t*)(ws + U_QF), (bf16_t*)(ws + U_KN), c);
            SEAM(pb + 1);
        }
        PH(pb + 2)
            if (!odd) for (int rep = 0; rep < REP_GEMM; ++rep) phase_mla_up((const bf16_t*)(ws + U_CQ), (const bf16_t*)(ws + WS_WQB) + (size_t)jj * WQB_ELEMS, (const bf16_t*)(ws + U_CKV),
                                   (const bf16_t*)(ws + WS_WKVB) + (size_t)jj * WKVB_ELEMS, ROPEM, (bf16_t*)(ws + U_QF), (bf16_t*)(ws + U_KN), (bf16_t*)(ws + U_VV), c);
            SEAM(pb + 2);
        }
        PH(pb + 3)
            for (int rep = 0; rep < REP_MIX; ++rep) {
            unsigned* ctr = ctl + CW_WORK + pb + 3 + 64 * rep;
            float* OG = YBUF;
            if (!odd) {
                for (;;) {
                    const int u = next_unit(ctr, c);
                    if (u >= 512 + 1024) break;
                    if (rep > 0 && ((REP_ONLY == 1 && u >= 512) || (REP_ONLY == 2 && u < 512))) continue;
                    if (u < 512) gdn_unit2(u, (const bf16_t*)(ws + U_GQ), (const bf16_t*)(ws + U_GK), (const bf16_t*)(ws + U_GV), (const float*)(ws + U_BETA),
                                           (const float*)(ws + U_GLOG), OG, c);
                    else {
                        const int v = u - 512, qb = 15 - (v >> 6), bh = v & 63, b = bh >> 3, hh = bh & 7;
                        const size_t tb = (size_t)b * SEQ;
                        attn_unit<6, false>((const bf16_t*)(ws + U_QF) + tb * 768 + hh * 96, 768, (const bf16_t*)(ws + U_KN) + tb * 512 + hh * 64, 512,
                                            (const bf16_t*)(ws + U_KROPE) + tb * 32, 32, (const bf16_t*)(ws + U_VV) + tb * 512 + hh * 64, 512,
                                            MIXO + tb * 1024 + hh * 64, 1024, qb * 128, 0.f, c);
                    }
                }
            } else {
                for (;;) {
                    const int u = next_unit(ctr, c);
                    if (u >= 512 + 1024) break;
                    if (rep > 0 && ((REP_ONLY == 1 && u >= 512) || (REP_ONLY == 2 && u < 512))) continue;
                    if (u < 512) mlstm_unit2(u, PROJ, GATES, (const float*)a.in[13] + jj * 4, (const float*)a.in[14] + jj * 4, OG, c);
                    else {
                        const int v = u - 512, n = v & 15, hq = (v >> 4) & 7, b = v >> 7, kvh = hq >> 2;
                        const size_t tb = (size_t)b * SEQ;
                        attn_unit<4, true>((const bf16_t*)(ws + U_QF) + tb * 512 + hq * 64, 512, (const bf16_t*)(ws + U_KN) + tb * 128 + kvh * 64, 128,
                                           (const bf16_t*)(ws + U_KN), 0, PROJ + tb * NPAD + 2184 + kvh * 64, NPAD,
                                           MIXO + tb * 1024 + 512 + hq * 64, 1024, n * 128, ((const float*)a.in[16])[jj * 8 + hq] * 1.4426950408889634f, c);
                    }
                }
            }
            if (rep + 1 < REP_MIX) xcd_barrier(bar);
            }
            SEAM(pb + 3);
        }
        PH(pb + 4) phase_post(YBUF, PROJ, odd ? (const float*)a.in[15] + jj * 512 : (const float*)a.in[10] + jj * 128, odd, MIXO, c); SEAM(pb + 4); }
        PH(pb + 5) for (int rep = 0; rep < REP_GEMM * REP_G1; ++rep) phase_outproj(MIXO, WOUT, xres, YBUF, c); SEAM(pb + 5); }
        PH(pb + 6) for (int rep = 0; rep < REP_TOK; ++rep) phase_ln1(YBUF, (const float*)a.in[18] + layer * 1024, (const float*)a.in[19] + layer * 1024, X1, XBF, c); SEAM(pb + 6); }
        PH(pb + 7) for (int rep = 0; rep < REP_GEMM; ++rep) phase_router(XBF, (const bf16_t*)(ws + WS_WRT) + (size_t)layer * WRT_ELEMS, (float*)(ws + WS_LOG), c); SEAM(pb + 7); }
        PH(pb + 8) phase_route((const float*)(ws + WS_LOG), (const float*)a.in[21] + layer * 64, CNT, (int*)(ws + WS_LTOK), (float*)(ws + WS_LW), (int*)(ws + WS_ASG), c); SEAM(pb + 8); }
        PH(pb + 9) for (int rep = 0; rep < REP_GEMM * REP_G2; ++rep) phase_moe1(XBF, (const bf16_t*)(ws + WS_WGU) + (size_t)layer * 65 * WGU_ELEMS, CNT, (const int*)(ws + WS_LTOK), (bf16_t*)(ws + WS_HBUF), c); SEAM(pb + 9); }
        PH(pb + 10) for (int rep = 0; rep < REP_GEMM * REP_G3; ++rep) phase_moe2((const bf16_t*)(ws + WS_HBUF), (const bf16_t*)(ws + WS_WDN) + (size_t)layer * 65 * WDN_ELEMS, CNT, (const float*)(ws + WS_LW), (bf16_t*)(ws + U_Y), c); SEAM(pb + 10); }
        PH(pb + 11) for (int rep = 0; rep < REP_CMB; ++rep) phase_combine(X1, (const bf16_t*)(ws + U_Y), (const int*)(ws + WS_ASG), CNT, (const float*)a.in[28] + layer * 1024, (const float*)a.in[29] + layer * 1024,
                                         a.out, XBF, c); SEAM(pb + 11); }
    }
#undef IN
#undef PH
#undef PH_CTX
#undef SEAM
}

extern "C" void kernel_launch(void* const* d_in, const int* in_sizes, int n_in, void* d_out, int out_size, void* d_ws, size_t ws_size, hipStream_t stream) {
    static int grid = 0;
    if (grid == 0) {
        if (n_in != 30 || out_size != T * 1024 || ws_size < WS_END) {
            fprintf(stderr, "kernel_launch: unexpected shapes (n_in %d, out %d, ws %zu < %zu)\n", n_in, out_size, ws_size, (size_t)WS_END);
            grid = -1; return;
        }
        int dev = 0, cus = 0, per_cu = 0;
        (void)hipGetDevice(&dev);
        (void)hipDeviceGetAttribute(&cus, hipDeviceAttributeMultiprocessorCount, dev);
        (void)hipFuncSetAttribute((const void*)fwd, hipFuncAttributeMaxDynamicSharedMemorySize, DYN_LDS);
        (void)hipOccupancyMaxActiveBlocksPerMultiprocessor(&per_cu, (const void*)fwd, 256, DYN_LDS);
        (void)hipGetLastError();
        if (per_cu < 1) per_cu = 1;
        grid = cus * (per_cu < 2 ? per_cu : 2);
    }
    if (grid < 0) return;
    (void)hipMemsetAsync((char*)d_ws + WS_CTL, 0, CTL_BYTES, stream);
    Args a{};
    for (int i = 0; i < 30; ++i) a.in[i] = d_in[i];
    a.out = (float*)d_out; a.ws = (unsigned char*)d_ws; a.pad = 0;
#if ONE_LAUNCH
    a.ph_lo = 0; a.ph_hi = NPH; a.use_bar = 1;
    hipLaunchKernelGGL(fwd, dim3(grid), dim3(256), DYN_LDS, stream, a);
#else
    for (int p = 0; p < NPH; ++p) {
        a.ph_lo = p; a.ph_hi = p + 1; a.use_bar = 0;
        hipLaunchKernelGGL(fwd, dim3(grid), dim3(256), DYN_LDS, stream, a);
    }
#endif
}
```

```cpp
#include <hip/hip_runtime.h>
#include <stdint.h>
#include <stdio.h>

#define REP_GEMM 1
#define REP_G0 1
#define REP_G1 1
#define REP_G2 1
#define REP_G3 1
#define REP_MIX 1
#define REP_ONLY 0
#define REP_CMB 1
#define REP_PRO 1
#define REP_TOK 1
#ifndef ONE_LAUNCH
#define ONE_LAUNCH 1
#endif

typedef unsigned short bf16_t;
typedef short bf16x8 __attribute__((ext_vector_type(8)));
typedef float f32x4 __attribute__((ext_vector_type(4)));
typedef unsigned u32x4 __attribute__((ext_vector_type(4)));
typedef unsigned u32x2 __attribute__((ext_vector_type(2)));
#define LAS __attribute__((address_space(3)))
#define GAS __attribute__((address_space(1)))

constexpr int T = 16384, SEQ = 2048;
constexpr int NPAD = 2560;
constexpr int CAP = 16384;
constexpr int MAXRB = 1024 + 64 + 128;
constexpr int MAXROWS = MAXRB * 128;
constexpr float ALPHA = 1.681792830507429f;
constexpr int PPL = 13;
constexpr int NPH = 1 + 4 * PPL;
constexpr int DYN_LDS = 65536 + 64 + 1024;

constexpr size_t cmax(size_t a, size_t b) { return a > b ? a : b; }
constexpr size_t WS_CTL = 0;
constexpr size_t CTL_BYTES = 65536;
constexpr size_t WS_WIN = WS_CTL + CTL_BYTES;
constexpr size_t WIN_ELEMS = (size_t)NPAD * 1024;
constexpr size_t WS_WQB = WS_WIN + 4 * WIN_ELEMS * 2;
constexpr size_t WQB_ELEMS = 768 * 256;
constexpr size_t WS_WKVB = WS_WQB + 2 * WQB_ELEMS * 2;
constexpr size_t WKVB_ELEMS = 1024 * 128;
constexpr size_t WS_WOUT = WS_WKVB + 2 * WKVB_ELEMS * 2;
constexpr size_t WOUT_ELEMS = 1024 * 1024;
constexpr size_t WS_WRT = WS_WOUT + 4 * WOUT_ELEMS * 2;
constexpr size_t WRT_ELEMS = 128 * 1024;
constexpr size_t WS_WGU = WS_WRT + 4 * WRT_ELEMS * 2;
constexpr size_t WGU_ELEMS = 512 * 1024;
constexpr size_t WS_WDN = WS_WGU + 4 * 65 * WGU_ELEMS * 2;
constexpr size_t WDN_ELEMS = 1024 * 256;
constexpr size_t WS_ROPEM = WS_WDN + 4 * 65 * WDN_ELEMS * 2;
constexpr size_t WS_ROPES = WS_ROPEM + (size_t)T * 16 * 2 * 4;
constexpr size_t WS_X1 = WS_ROPES + (size_t)T * 32 * 2 * 4;
constexpr size_t WS_XBF = WS_X1 + (size_t)T * 1024 * 4;
constexpr size_t WS_HBUF = WS_XBF + (size_t)T * 1024 * 2;
constexpr size_t WS_LOG = WS_HBUF + (size_t)MAXROWS * 256 * 2;
constexpr size_t WS_ASG = WS_LOG + (size_t)T * 64 * 4;
constexpr size_t WS_LTOK = WS_ASG + (size_t)T * 8 * 4;
constexpr size_t WS_LW = WS_LTOK + (size_t)65 * CAP * 4;
constexpr size_t WS_U = WS_LW + (size_t)65 * CAP * 4;
constexpr size_t U_Y = WS_U;
constexpr size_t U_PROJ = WS_U;
constexpr size_t U_GATES = U_PROJ + (size_t)T * NPAD * 2;
constexpr size_t U_CQ = U_GATES + (size_t)T * 8 * 4;
constexpr size_t U_CKV = U_CQ + (size_t)T * 256 * 2;
constexpr size_t U_KROPE = U_CKV + (size_t)T * 128 * 2;
constexpr size_t U_QF = U_KROPE + (size_t)T * 32 * 2;
constexpr size_t U_KN = U_QF + (size_t)T * 768 * 2;
constexpr size_t U_VV = U_KN + (size_t)T * 512 * 2;
constexpr size_t U_GQ = U_VV + (size_t)T * 512 * 2;
constexpr size_t U_GK = U_GQ + (size_t)T * 512 * 2;
constexpr size_t U_GV = U_GK + (size_t)T * 512 * 2;
constexpr size_t U_BETA = U_GV + (size_t)T * 512 * 2;
constexpr size_t U_GLOG = U_BETA + (size_t)T * 4 * 4;
constexpr size_t U_MIXO = U_GLOG + (size_t)T * 4 * 4;
constexpr size_t U_YBUF = U_MIXO + (size_t)T * 1024 * 2;
constexpr size_t U_END1 = U_YBUF + (size_t)T * 1024 * 4;
constexpr size_t WS_END = WS_U + cmax((size_t)MAXROWS * 1024 * 2, U_END1 - WS_U);

constexpr int CW_CNT = 4096;
constexpr int CW_WORK = 8192;

#define XB_TMO      128
#define XB_XCNT(j)  (256  + 64 * (j))
#define XB_XSUB(j)  (1280 + 64 * (j))
#define XB_XGEN(j)  (2304 + 64 * (j))
#define XB_TOP      3328
#define XB_TOPGEN   3392
#define XCD_BAR_WORDS 3456
#define XB_SPIN_CAP (1u << 18)

__device__ __forceinline__ unsigned xb_ld(unsigned* p)              { return __hip_atomic_load(p, __ATOMIC_RELAXED, __HIP_MEMORY_SCOPE_AGENT); }
__device__ __forceinline__ unsigned xb_add(unsigned* p, unsigned v) { return __hip_atomic_fetch_add(p, v, __ATOMIC_RELAXED, __HIP_MEMORY_SCOPE_AGENT); }
__device__ __forceinline__ unsigned xb_xcc_id() { return (unsigned)__builtin_amdgcn_s_getreg((3 << 11) | 20) & 0xFu; }
#define XB_SPIN(cond, bar) do { unsigned _sp = 0; while (cond) { __builtin_amdgcn_s_sleep(1); \
    if ((++_sp & 255u) == 0u) { if (xb_ld(&(bar)[XB_TMO])) break; if (_sp > XB_SPIN_CAP) { atomicAdd(&(bar)[XB_TMO], 1u); break; } } } } while (0)

struct XcdBarrier { unsigned* bar; unsigned x; volatile LAS unsigned* st; };

__device__ __forceinline__ XcdBarrier xcd_barrier_post(unsigned* bar, volatile LAS unsigned* st) {
    XcdBarrier b; b.bar = bar; b.x = xb_xcc_id(); b.st = st;
    if (threadIdx.x == 0) (void)xb_add(&bar[XB_XCNT(b.x)], 1u);
    return b;
}
__device__ __forceinline__ void xcd_barrier_complete(unsigned* bar, unsigned x, unsigned& nloc, unsigned& nx) {
    const unsigned G = gridDim.x * gridDim.y * gridDim.z;
    unsigned sum, cnt, mine, sp = 0u;
    for (;;) {
        sum = 0u; cnt = 0u; mine = 0u;
#pragma unroll
        for (unsigned j = 0; j < 16; ++j) { const unsigned c = xb_ld(&bar[XB_XCNT(j)]); sum += c; cnt += (c > 0u) ? 1u : 0u; mine = (j == x) ? c : mine; }
        if (sum == G) break;
        __builtin_amdgcn_s_sleep(1);
        if ((++sp & 255u) == 0u) { if (xb_ld(&bar[XB_TMO])) break; if (sp > XB_SPIN_CAP) { atomicAdd(&bar[XB_TMO], 1u); break; } }
    }
    nloc = mine > 0u ? mine : 1u; nx = cnt > 0u ? cnt : 1u;
}
__device__ __forceinline__ void xcd_barrier(const XcdBarrier& b) {
    asm volatile("s_waitcnt vmcnt(0)" ::: "memory");
    __syncthreads();
    if (threadIdx.x == 0) {
        unsigned* bar = b.bar;
        __builtin_amdgcn_s_waitcnt(0);
        unsigned nloc = b.st[0], nx = b.st[1];
        if (nloc == 0u) { xcd_barrier_complete(bar, b.x, nloc, nx); b.st[0] = nloc; b.st[1] = nx; }
        const unsigned old = xb_add(&bar[XB_XSUB(b.x)], 1u);
        const unsigned gen = old / nloc;
        if (old + 1u == (gen + 1u) * nloc) {
            __builtin_amdgcn_fence(__ATOMIC_RELEASE, "agent");
            asm volatile("s_waitcnt vmcnt(0)" ::: "memory");
            const unsigned og = xb_add(&bar[XB_TOP], 1u);
            const unsigned tg = og / nx;
            if (og + 1u == (tg + 1u) * nx) xb_add(&bar[XB_TOPGEN], 1u);
            else XB_SPIN(xb_ld(&bar[XB_TOPGEN]) == tg, bar);
            __builtin_amdgcn_fence(__ATOMIC_ACQUIRE, "agent");
            xb_add(&bar[XB_XGEN(b.x)], 1u);
            asm volatile("s_waitcnt vmcnt(0)" ::: "memory");
        } else {
            XB_SPIN(xb_ld(&bar[XB_XGEN(b.x)]) == gen, bar);
            __builtin_amdgcn_fence(__ATOMIC_ACQUIRE, "agent");
            asm volatile("s_waitcnt vmcnt(0)" ::: "memory");
        }
    }
    __syncthreads();
}

__device__ __forceinline__ float bf2f(unsigned v) { return __uint_as_float(v << 16); }
__device__ __forceinline__ float bflo(unsigned w) { return __uint_as_float(w << 16); }
__device__ __forceinline__ float bfhi(unsigned w) { return __uint_as_float(w & 0xffff0000u); }
__device__ __forceinline__ unsigned f2bf(float f) { unsigned u = __float_as_uint(f); u += 0x7fffu + ((u >> 16) & 1u); return u >> 16; }
__device__ __forceinline__ unsigned pk2(float lo, float hi) { return f2bf(lo) | (f2bf(hi) << 16); }
__device__ __forceinline__ float wave_sum(float v) {
#pragma unroll
    for (int o = 32; o > 0; o >>= 1) v += __shfl_xor(v, o);
    return v;
}
__device__ __forceinline__ float sigmoidf_(float x) { return 1.f / (1.f + expf(-x)); }
__device__ __forceinline__ float siluf_(float x) { return x / (1.f + expf(-x)); }
__device__ __forceinline__ float softplusf_(float x) { return x > 20.f ? x : log1pf(expf(x)); }
__device__ __forceinline__ void glds16(const void* g, void* l) {
    __builtin_amdgcn_global_load_lds((const GAS unsigned*)g, (LAS unsigned*)l, 16, 0, 0);
}
__device__ __forceinline__ void unpack8(const u32x4 r, float (&f)[8]) {
    f[0] = bflo(r.x); f[1] = bfhi(r.x); f[2] = bflo(r.y); f[3] = bfhi(r.y);
    f[4] = bflo(r.z); f[5] = bfhi(r.z); f[6] = bflo(r.w); f[7] = bfhi(r.w);
}

struct Args {
    const void* in[30];
    float* out;
    unsigned char* ws;
    int ph_lo, ph_hi, use_bar, pad;
};

struct Ctx { int tid, lane, wid, wr, wc, fr, fq, bid, nblk; unsigned char* smem; };

#define WAIT_V(n) asm volatile("s_waitcnt vmcnt(" #n ")" ::: "memory")
__device__ __forceinline__ void gemm_tile(const bf16_t* a0, const bf16_t* a1, const bf16_t* b0, const bf16_t* b1,
                                          int nk, f32x4 (&acc)[4][4], const Ctx& c) {
#pragma unroll
    for (int m = 0; m < 4; ++m)
#pragma unroll
        for (int n = 0; n < 4; ++n) acc[m][n] = (f32x4){0.f, 0.f, 0.f, 0.f};
    unsigned char* smem = c.smem;
    const int sb = c.tid * 16;
    const int kofs = ((c.tid & 3) ^ ((c.tid >> 4) & 3)) * 8;
    a0 += kofs; a1 += kofs; b0 += kofs; b1 += kofs;
#define G_STAGE(kt_) do { unsigned char* sp_ = smem + ((kt_) & 3) * 16384 + sb; const int ko_ = (kt_) * 32; \
        glds16(a0 + ko_, sp_); glds16(a1 + ko_, sp_ + 4096); glds16(b0 + ko_, sp_ + 8192); glds16(b1 + ko_, sp_ + 12288); } while (0)
    WAIT_V(0);
    G_STAGE(0);
    if (nk > 1) G_STAGE(1);
    if (nk > 2) G_STAGE(2);
    const int roff = (c.fr * 64) + ((c.fq ^ ((c.fr >> 2) & 3)) * 16);
    for (int kt = 0; kt < nk; ++kt) {
        if (kt + 2 < nk) WAIT_V(8); else if (kt + 1 < nk) WAIT_V(4); else WAIT_V(0);
        asm volatile("" ::: "memory"); __builtin_amdgcn_s_barrier(); asm volatile("" ::: "memory");
        if (kt + 3 < nk) G_STAGE(kt + 3);
        const unsigned char* sa = smem + (kt & 3) * 16384 + c.wr * 4096 + roff; const unsigned char* sbb = smem + (kt & 3) * 16384 + 8192 + c.wc * 4096 + roff;
        bf16x8 af[4], bfr[4];
#pragma unroll
        for (int m = 0; m < 4; ++m) af[m] = *(const bf16x8*)(sa + m * 1024);
#pragma unroll
        for (int n = 0; n < 4; ++n) bfr[n] = *(const bf16x8*)(sbb + n * 1024);
        __builtin_amdgcn_s_setprio(1);
#pragma unroll
        for (int m = 0; m < 4; ++m)
#pragma unroll
            for (int n = 0; n < 4; ++n) acc[m][n] = __builtin_amdgcn_mfma_f32_16x16x32_bf16(bfr[n], af[m], acc[m][n], 0, 0, 0);
        __builtin_amdgcn_s_setprio(0);
    }
#undef G_STAGE
    __syncthreads();
}

__device__ __forceinline__ bool tile_map(int i, const Ctx& c, int ntm, int ntn, int& mt, int& nt) {
    const int vb = ((c.nblk & 7) == 0) ? (c.bid & 7) * (c.nblk >> 3) + (c.bid >> 3) : c.bid;
    const int L = i * c.nblk + vb;
    if (L >= ntm * ntn) return false;
    const int g = L / (8 * ntn), rem = L - g * 8 * ntn;
    const int gsz = (ntm - g * 8) < 8 ? (ntm - g * 8) : 8;
    mt = g * 8 + rem % gsz; nt = rem / gsz;
    return true;
}

constexpr int TS_RS = 272;
__device__ __forceinline__ void tile_put(const Ctx& c, int row_l, int col_l, const u32x2 v) { *(u32x2*)(c.smem + row_l * TS_RS + col_l * 2) = v; }
template <int NCOL>
__device__ __forceinline__ void tile_flush(const Ctx& c, bf16_t* out, size_t ld) {
    __syncthreads();
    constexpr int CPR = NCOL / 8, PER = (128 * CPR) / 256;
#pragma unroll
    for (int i = 0; i < PER; ++i) {
        const int idx = c.tid + 256 * i, row = idx / CPR, ch = idx % CPR;
        const u32x4 v = *(const u32x4*)(c.smem + row * TS_RS + ch * 16);
        *(u32x4*)(out + (size_t)row * ld + ch * 8) = v;
    }
    __syncthreads();
}

__device__ __forceinline__ void conv_family(const float* src, int nmat, size_t src_stride, int K, int N, int Nout,
                            bf16_t* dst, size_t dst_stride, int grp, int kind, const Ctx& c) {
    float* lds = (float*)c.smem;
    const int tk = K / 128, tn = Nout / 64, per = tk * tn, total = nmat * per;
    const int tx = c.tid & 15, ty = c.tid >> 4;
    f32x4 r[8];
#define CV_LOAD(u_) do { const int mat_ = (u_) / per, r_ = (u_) - mat_ * per, kt_ = r_ / tn, nt_ = r_ - kt_ * tn; \
        const float* s_ = src + (size_t)mat_ * src_stride + (size_t)(kt_ * 128 + ty) * N + nt_ * 64 + tx * 4; const bool in_ = (nt_ * 64 + tx * 4) < N; \
        _Pragma("unroll") for (int i = 0; i < 8; ++i) r[i] = in_ ? *(const f32x4*)(s_ + (size_t)(16 * i) * N) : (f32x4){0.f, 0.f, 0.f, 0.f}; } while (0)
    int u = c.bid;
    if (u < total) CV_LOAD(u);
    for (; u < total; u += c.nblk) {
#pragma unroll
        for (int i = 0; i < 8; ++i) *(f32x4*)(lds + (ty + 16 * i) * 68 + tx * 4) = r[i];
        if (u + c.nblk < total) CV_LOAD(u + c.nblk);
        __syncthreads();
        const int mat = u / per, rr = u - mat * per, kt = rr / tn, nt = rr - kt * tn;
        const int dmat = grp ? (mat / grp) * (grp + 1) + (mat % grp) : mat;
        bf16_t* d = dst + (size_t)dmat * dst_stride;
        const int nl = c.tid & 63, kq = (c.tid >> 6) * 32;
        unsigned w[16];
#pragma unroll
        for (int j = 0; j < 16; ++j) w[j] = pk2(lds[(kq + 2 * j) * 68 + nl], lds[(kq + 2 * j + 1) * 68 + nl]);
        const int n = nt * 64 + nl;
        const int drow = (kind == 0) ? n : ((n >> 5) * 64 + (n & 31) + (kind == 2 ? 32 : 0));
        u32x4* dp = (u32x4*)(d + (size_t)drow * K + kt * 128 + kq);
        dp[0] = (u32x4){w[0], w[1], w[2], w[3]}; dp[1] = (u32x4){w[4], w[5], w[6], w[7]};
        dp[2] = (u32x4){w[8], w[9], w[10], w[11]}; dp[3] = (u32x4){w[12], w[13], w[14], w[15]};
        __syncthreads();
    }
#undef CV_LOAD
}

__device__ __forceinline__ void phase_prologue(const Args& a, const Ctx& c) {
    unsigned char* ws = a.ws;
    bf16_t* WIN = (bf16_t*)(ws + WS_WIN);
    conv_family((const float*)a.in[2], 2, (size_t)1024 * 2472, 1024, 2472, NPAD, WIN, 2 * WIN_ELEMS, 0, 0, c);
    conv_family((const float*)a.in[12], 2, (size_t)1024 * 2312, 1024, 2312, NPAD, WIN + WIN_ELEMS, 2 * WIN_ELEMS, 0, 0, c);
    conv_family((const float*)a.in[4], 2, (size_t)256 * 768, 256, 768, 768, (bf16_t*)(ws + WS_WQB), WQB_ELEMS, 0, 0, c);
    conv_family((const float*)a.in[6], 2, (size_t)128 * 1024, 128, 1024, 1024, (bf16_t*)(ws + WS_WKVB), WKVB_ELEMS, 0, 0, c);
    bf16_t* WOUT = (bf16_t*)(ws + WS_WOUT);
    conv_family((const float*)a.in[11], 2, (size_t)1024 * 1024, 1024, 1024, 1024, WOUT, 2 * WOUT_ELEMS, 0, 0, c);
    conv_family((const float*)a.in[17], 2, (size_t)1024 * 1024, 1024, 1024, 1024, WOUT + WOUT_ELEMS, 2 * WOUT_ELEMS, 0, 0, c);
    conv_family((const float*)a.in[20], 4, (size_t)1024 * 64, 1024, 64, 128, (bf16_t*)(ws + WS_WRT), WRT_ELEMS, 0, 0, c);
    bf16_t* WGU = (bf16_t*)(ws + WS_WGU);
    conv_family((const float*)a.in[22], 256, (size_t)1024 * 256, 1024, 256, 256, WGU, WGU_ELEMS, 64, 1, c);
    conv_family((const float*)a.in[23], 256, (size_t)1024 * 256, 1024, 256, 256, WGU, WGU_ELEMS, 64, 2, c);
    conv_family((const float*)a.in[25], 4, (size_t)1024 * 256, 1024, 256, 256, WGU + 64 * WGU_ELEMS, 65 * WGU_ELEMS, 0, 1, c);
    conv_family((const float*)a.in[26], 4, (size_t)1024 * 256, 1024, 256, 256, WGU + 64 * WGU_ELEMS, 65 * WGU_ELEMS, 0, 2, c);
    bf16_t* WDN = (bf16_t*)(ws + WS_WDN);
    conv_family((const float*)a.in[24], 256, (size_t)256 * 1024, 256, 1024, 1024, WDN, WDN_ELEMS, 64, 0, c);
    conv_family((const float*)a.in[27], 4, (size_t)256 * 1024, 256, 1024, 1024, WDN + 64 * WDN_ELEMS, 65 * WDN_ELEMS, 0, 0, c);
    {
        const float* x = (const float*)a.in[0]; bf16_t* xb = (bf16_t*)(ws + WS_XBF);
        const size_t n8 = (size_t)T * 1024 / 8;
        for (size_t i = (size_t)c.bid * 256 + c.tid; i < n8; i += (size_t)c.nblk * 256) {
            const f32x4 v0 = *(const f32x4*)(x + i * 8), v1 = *(const f32x4*)(x + i * 8 + 4);
            *(u32x4*)(xb + i * 8) = (u32x4){pk2(v0[0], v0[1]), pk2(v0[2], v0[3]), pk2(v1[0], v1[1]), pk2(v1[2], v1[3])};
        }
    }
    {
        const int* pos = (const int*)a.in[1];
        float* rm = (float*)(ws + WS_ROPEM); float* rs = (float*)(ws + WS_ROPES);
        const float ln_theta = 9.210340371976184f;
        for (int i = c.bid * 256 + c.tid; i < T * 16; i += c.nblk * 256) {
            const int t = i >> 4, f = i & 15;
            const float inv = expf(-((float)(2 * f) / 32.f) * ln_theta);
            const float ang = (float)pos[t] * inv;
            rm[i * 2] = cosf(ang); rm[i * 2 + 1] = sinf(ang);
        }
        for (int i = c.bid * 256 + c.tid; i < T * 32; i += c.nblk * 256) {
            const int t = i >> 5, f = i & 31;
            const float inv = expf(-((float)(2 * f) / 64.f) * ln_theta);
            const float ang = (float)pos[t] * inv;
            rs[i * 2] = cosf(ang); rs[i * 2 + 1] = sinf(ang);
        }
    }
}

__device__ __forceinline__ void phase_inproj(const bf16_t* XBF, const bf16_t* W, bf16_t* PROJ, float* GATES, int gbase, const Ctx& c) {
    const int ntn = NPAD / 128;
    for (int i = 0;; ++i) {
        int mt, nt; if (!tile_map(i, c, T / 128, ntn, mt, nt)) break;
        const bf16_t* a0 = XBF + (size_t)(mt * 128 + (c.tid >> 2)) * 1024;
        const bf16_t* b0 = W + (size_t)(nt * 128 + (c.tid >> 2)) * 1024;
        f32x4 acc[4][4];
        gemm_tile(a0, a0 + 64 * 1024, b0, b0 + 64 * 1024, 32, acc, c);
#pragma unroll
        for (int m = 0; m < 4; ++m) {
            const int rl = c.wr * 64 + m * 16 + c.fr, row = mt * 128 + rl;
#pragma unroll
            for (int n = 0; n < 4; ++n) {
                const int cl = c.wc * 64 + n * 16 + c.fq * 4, col = nt * 128 + cl;
                const f32x4 v = acc[m][n];
                tile_put(c, rl, cl, (u32x2){pk2(v[0], v[1]), pk2(v[2], v[3])});
                if (col >= gbase && col < gbase + 8) *(f32x4*)(GATES + (size_t)row * 8 + (col - gbase)) = v;
            }
        }
        tile_flush<128>(c, PROJ + (size_t)mt * 128 * NPAD + nt * 128, NPAD);
    }
}

__device__ __forceinline__ void phase_mla_up(const bf16_t* CQ, const bf16_t* WQB, const bf16_t* CKV, const bf16_t* WKVB,
                             const float* ROPEM, bf16_t* QF, bf16_t* KN, bf16_t* VV, const Ctx& c) {
    const int tq = (T / 128) * 6, tkv = (T / 128) * 8;
    const float qscale = 0.10206207261596577f * 1.4426950408889634f;
    for (int u = c.bid; u < tq + tkv; u += c.nblk) {
        f32x4 acc[4][4];
        if (u < tq) {
            const int mt = u / 6, nt = u % 6;
            const bf16_t* a0 = CQ + (size_t)(mt * 128 + (c.tid >> 2)) * 256;
            const bf16_t* b0 = WQB + (size_t)(nt * 128 + (c.tid >> 2)) * 256;
            gemm_tile(a0, a0 + 64 * 256, b0, b0 + 64 * 256, 8, acc, c);
#pragma unroll
            for (int m = 0; m < 4; ++m) {
                const int row = mt * 128 + c.wr * 64 + m * 16 + c.fr;
#pragma unroll
                for (int np = 0; np < 2; ++np) {
                    const int cg = nt * 128 + c.wc * 64 + np * 32;
                    f32x4 v0 = acc[m][2 * np], v1 = acc[m][2 * np + 1];
                    if (((cg >> 5) % 3) == 2) {
#pragma unroll
                        for (int j = 0; j < 4; ++j) {
                            const int i = c.fq * 4 + j;
                            const float cs = ROPEM[((size_t)row * 16 + i) * 2], sn = ROPEM[((size_t)row * 16 + i) * 2 + 1];
                            const float x1 = v0[j], x2 = v1[j];
                            v0[j] = x1 * cs - x2 * sn; v1[j] = x2 * cs + x1 * sn;
                        }
                    }
                    v0 *= qscale; v1 *= qscale;
                    *(u32x2*)(QF + (size_t)row * 768 + cg + c.fq * 4) = (u32x2){pk2(v0[0], v0[1]), pk2(v0[2], v0[3])};
                    *(u32x2*)(QF + (size_t)row * 768 + cg + 16 + c.fq * 4) = (u32x2){pk2(v1[0], v1[1]), pk2(v1[2], v1[3])};
                }
            }
        } else {
            const int v = u - tq, mt = v / 8, nt = v % 8;
            const bf16_t* a0 = CKV + (size_t)(mt * 128 + (c.tid >> 2)) * 128;
            const bf16_t* b0 = WKVB + (size_t)(nt * 128 + (c.tid >> 2)) * 128;
            gemm_tile(a0, a0 + 64 * 128, b0, b0 + 64 * 128, 4, acc, c);
            bf16_t* dst = (c.wc == 0) ? KN : VV;
#pragma unroll
            for (int m = 0; m < 4; ++m) {
                const int row = mt * 128 + c.wr * 64 + m * 16 + c.fr;
#pragma unroll
                for (int n = 0; n < 4; ++n) {
                    const f32x4 x = acc[m][n];
                    *(u32x2*)(dst + (size_t)row * 512 + nt * 64 + n * 16 + c.fq * 4) = (u32x2){pk2(x[0], x[1]), pk2(x[2], x[3])};
                }
            }
        }
    }
}

__device__ __forceinline__ void phase_outproj(const bf16_t* MIXO, const bf16_t* W, const float* xres, float* YBUF, const Ctx& c) {
    for (int i = 0;; ++i) {
        int mt, nt; if (!tile_map(i, c, T / 128, 8, mt, nt)) break;
        const bf16_t* a0 = MIXO + (size_t)(mt * 128 + (c.tid >> 2)) * 1024;
        const bf16_t* b0 = W + (size_t)(nt * 128 + (c.tid >> 2)) * 1024;
        f32x4 acc[4][4];
        gemm_tile(a0, a0 + 64 * 1024, b0, b0 + 64 * 1024, 32, acc, c);
#pragma unroll
        for (int m = 0; m < 4; ++m) {
            const int row = mt * 128 + c.wr * 64 + m * 16 + c.fr;
#pragma unroll
            for (int n = 0; n < 4; ++n) {
                const int col = nt * 128 + c.wc * 64 + n * 16 + c.fq * 4;
                const f32x4 xr = *(const f32x4*)(xres + (size_t)row * 1024 + col);
                *(f32x4*)(YBUF + (size_t)row * 1024 + col) = xr * ALPHA + acc[m][n];
            }
        }
    }
}

__device__ __forceinline__ void phase_router(const bf16_t* XBF, const bf16_t* W, float* LOG, const Ctx& c) {
    for (int mt = c.bid; mt < T / 128; mt += c.nblk) {
        const bf16_t* a0 = XBF + (size_t)(mt * 128 + (c.tid >> 2)) * 1024;
        const bf16_t* b0 = W + (size_t)(c.tid >> 2) * 1024;
        f32x4 acc[4][4];
        gemm_tile(a0, a0 + 64 * 1024, b0, b0 + 64 * 1024, 32, acc, c);
        if (c.wc == 0) {
#pragma unroll
            for (int m = 0; m < 4; ++m) {
                const int row = mt * 128 + c.wr * 64 + m * 16 + c.fr;
#pragma unroll
                for (int n = 0; n < 4; ++n) *(f32x4*)(LOG + (size_t)row * 64 + n * 16 + c.fq * 4) = acc[m][n];
            }
        }
    }
}

__device__ __forceinline__ void build_block_table(const unsigned* CNT, int* bst, const Ctx& c) {
    __syncthreads();
    if (c.wid == 0) {
        const int cnt = (int)__hip_atomic_load(CNT + c.lane, __ATOMIC_RELAXED, __HIP_MEMORY_SCOPE_AGENT);
        const int nb = (cnt + 127) >> 7;
        int inc = nb;
#pragma unroll
        for (int o = 1; o < 64; o <<= 1) { const int x = __shfl_up(inc, o); if (c.lane >= o) inc += x; }
        bst[c.lane] = inc - nb; bst[66 + c.lane] = cnt;
        if (c.lane == 63) { bst[64] = inc; bst[65] = inc + T / 128; bst[66 + 64] = T; }
    }
    __syncthreads();
}
__device__ __forceinline__ int find_expert(const int* bst, int rb, const Ctx& c) {
    return __popcll(__ballot(bst[1 + c.lane] <= rb));
}

__device__ __forceinline__ void phase_moe1(const bf16_t* XBF, const bf16_t* WGU, const unsigned* CNT, const int* LTOK, bf16_t* HBUF, const Ctx& c) {
    int* bst = (int*)(c.smem + 65536 + 64);
    build_block_table(CNT, bst, c);
    const int nrb = bst[65];
    for (int i = 0;; ++i) {
        int rb, nt; if (!tile_map(i, c, nrb, 4, rb, nt)) break;
        const int e = find_expert(bst, rb, c);
        const int lb = rb - bst[e], cnt = bst[66 + e];
        const int p0 = lb * 128 + (c.tid >> 2), p1 = p0 + 64;
        const int t0 = (p0 < cnt) ? LTOK[(size_t)e * CAP + p0] : 0;
        const int t1 = (p1 < cnt) ? LTOK[(size_t)e * CAP + p1] : 0;
        const bf16_t* a0 = XBF + (size_t)t0 * 1024;
        const bf16_t* a1 = XBF + (size_t)t1 * 1024;
        const bf16_t* b0 = WGU + (size_t)e * WGU_ELEMS + (size_t)(nt * 128 + (c.tid >> 2)) * 1024;
        f32x4 acc[4][4];
        gemm_tile(a0, a1, b0, b0 + 64 * 1024, 32, acc, c);
#pragma unroll
        for (int m = 0; m < 4; ++m) {
            const int rl = c.wr * 64 + m * 16 + c.fr;
#pragma unroll
            for (int n = 0; n < 2; ++n) {
                const f32x4 g = acc[m][n], up = acc[m][n + 2];
                float h[4];
#pragma unroll
                for (int j = 0; j < 4; ++j) h[j] = siluf_(g[j]) * up[j];
                tile_put(c, rl, c.wc * 32 + n * 16 + c.fq * 4, (u32x2){pk2(h[0], h[1]), pk2(h[2], h[3])});
            }
        }
        tile_flush<64>(c, HBUF + (size_t)rb * 128 * 256 + nt * 64, 256);
    }
}

__device__ __forceinline__ void phase_moe2(const bf16_t* HBUF, const bf16_t* WDN, const unsigned* CNT, const float* LW, bf16_t* Y, const Ctx& c) {
    int* bst = (int*)(c.smem + 65536 + 64);
    build_block_table(CNT, bst, c);
    const int nrb = bst[65];
    for (int i = 0;; ++i) {
        int rb, nt; if (!tile_map(i, c, nrb, 8, rb, nt)) break;
        const int e = find_expert(bst, rb, c);
        const int lb = rb - bst[e], cnt = bst[66 + e];
        const bf16_t* a0 = HBUF + ((size_t)rb * 128 + (c.tid >> 2)) * 256;
        const bf16_t* b0 = WDN + (size_t)e * WDN_ELEMS + (size_t)(nt * 128 + (c.tid >> 2)) * 256;
        f32x4 acc[4][4];
        gemm_tile(a0, a0 + 64 * 256, b0, b0 + 64 * 256, 8, acc, c);
#pragma unroll
        for (int m = 0; m < 4; ++m) {
            const int lr = c.wr * 64 + m * 16 + c.fr;
            const int p = lb * 128 + lr;
            const float w = (p < cnt) ? LW[(size_t)e * CAP + p] : 0.f;
#pragma unroll
            for (int n = 0; n < 4; ++n) {
                const f32x4 v = acc[m][n] * w;
                tile_put(c, lr, c.wc * 64 + n * 16 + c.fq * 4, (u32x2){pk2(v[0], v[1]), pk2(v[2], v[3])});
            }
        }
        tile_flush<128>(c, Y + (size_t)rb * 128 * 1024 + nt * 128, 1024);
    }
}

__device__ __forceinline__ void ln_row_store(float (&v)[16], const float* g, const float* b, float* of32, bf16_t* obf, int lane) {
    float s = 0.f;
#pragma unroll
    for (int i = 0; i < 16; ++i) s += v[i];
    const float mean = wave_sum(s) * (1.f / 1024.f);
    float q = 0.f;
#pragma unroll
    for (int i = 0; i < 16; ++i) { v[i] -= mean; q += v[i] * v[i]; }
    const float rstd = rsqrtf(wave_sum(q) * (1.f / 1024.f) + 1e-5f);
#pragma unroll
    for (int hf = 0; hf < 2; ++hf) {
        const int col = hf * 512 + lane * 8;
        const f32x4 g0 = *(const f32x4*)(g + col), g1 = *(const f32x4*)(g + col + 4);
        const f32x4 b0 = *(const f32x4*)(b + col), b1 = *(const f32x4*)(b + col + 4);
        f32x4 y0, y1;
#pragma unroll
        for (int j = 0; j < 4; ++j) { y0[j] = v[hf * 8 + j] * rstd * g0[j] + b0[j]; y1[j] = v[hf * 8 + 4 + j] * rstd * g1[j] + b1[j]; }
        *(f32x4*)(of32 + col) = y0; *(f32x4*)(of32 + col + 4) = y1;
        *(u32x4*)(obf + col) = (u32x4){pk2(y0[0], y0[1]), pk2(y0[2], y0[3]), pk2(y1[0], y1[1]), pk2(y1[2], y1[3])};
    }
}

__device__ __forceinline__ void phase_ln1(const float* YBUF, const float* g, const float* b, float* X1, bf16_t* XBF, const Ctx& c) {
    for (int t = c.bid * 4 + c.wid; t < T; t += c.nblk * 4) {
        float v[16];
#pragma unroll
        for (int hf = 0; hf < 2; ++hf) {
            const float* p = YBUF + (size_t)t * 1024 + hf * 512 + c.lane * 8;
            const f32x4 a0 = *(const f32x4*)p, a1 = *(const f32x4*)(p + 4);
#pragma unroll
            for (int j = 0; j < 4; ++j) { v[hf * 8 + j] = a0[j]; v[hf * 8 + 4 + j] = a1[j]; }
        }
        ln_row_store(v, g, b, X1 + (size_t)t * 1024, XBF + (size_t)t * 1024, c.lane);
    }
}

__device__ __forceinline__ void phase_combine(const float* X1, const bf16_t* Y, const int* ASG, const unsigned* CNT, const float* g, const float* b,
                              float* XOUT, bf16_t* XBF, const Ctx& c) {
    int* bst = (int*)(c.smem + 65536 + 64);
    build_block_table(CNT, bst, c);
    for (int t = c.bid * 4 + c.wid; t < T; t += c.nblk * 4) {
        float v[16];
#pragma unroll
        for (int hf = 0; hf < 2; ++hf) {
            const float* p = X1 + (size_t)t * 1024 + hf * 512 + c.lane * 8;
            const f32x4 a0 = *(const f32x4*)p, a1 = *(const f32x4*)(p + 4);
#pragma unroll
            for (int j = 0; j < 4; ++j) { v[hf * 8 + j] = a0[j] * ALPHA; v[hf * 8 + 4 + j] = a1[j] * ALPHA; }
        }
#pragma unroll
        for (int k = 0; k < 9; ++k) {
            size_t crow;
            if (k < 8) { const int asg = ASG[(size_t)t * 8 + k]; crow = (size_t)bst[asg >> 16] * 128 + (asg & 0xffff); }
            else crow = (size_t)bst[64] * 128 + t;
#pragma unroll
            for (int hf = 0; hf < 2; ++hf) {
                const u32x4 r = *(const u32x4*)(Y + crow * 1024 + hf * 512 + c.lane * 8);
                float f[8]; unpack8(r, f);
#pragma unroll
                for (int j = 0; j < 8; ++j) v[hf * 8 + j] += f[j];
            }
        }
        ln_row_store(v, g, b, XOUT + (size_t)t * 1024, XBF + (size_t)t * 1024, c.lane);
    }
}

__device__ __forceinline__ void phase_route(const float* LOG, const float* rb, unsigned* CNT, int* LTOK, float* LW, int* ASG, const Ctx& c) {
    int* lcnt = (int*)c.smem;
    int* lbase = lcnt + 64;
    int* sel_e = lbase + 64;
    int* sel_p = sel_e + 256;
    float* sel_w = (float*)(sel_p + 256);
    const float rbias = rb[c.lane];
    for (int ch = c.bid; ch < T / 32; ch += c.nblk) {
        __syncthreads();
        if (c.tid < 64) lcnt[c.tid] = 0;
        __syncthreads();
        for (int tl = c.wid; tl < 32; tl += 4) {
            const int t = ch * 32 + tl;
            const float lg = LOG[(size_t)t * 64 + c.lane];
            const float sc = 1.f / (1.f + expf(-lg));
            const float v = sc + rbias;
            float m1 = v;
            m1 = fmaxf(m1, __shfl_xor(m1, 1)); m1 = fmaxf(m1, __shfl_xor(m1, 2)); m1 = fmaxf(m1, __shfl_xor(m1, 4));
            int cand = (v == m1) ? c.lane : 999;
            cand = min(cand, __shfl_xor(cand, 1)); cand = min(cand, __shfl_xor(cand, 2)); cand = min(cand, __shfl_xor(cand, 4));
            float m2 = (c.lane == cand) ? -INFINITY : v;
            m2 = fmaxf(m2, __shfl_xor(m2, 1)); m2 = fmaxf(m2, __shfl_xor(m2, 2)); m2 = fmaxf(m2, __shfl_xor(m2, 4));
            const float gs = m1 + m2;
            const int g = c.lane >> 3;
            int grank = 0;
#pragma unroll
            for (int gg = 0; gg < 8; ++gg) { const float o = __shfl(gs, gg * 8); grank += ((o > gs) || (o == gs && gg < g)) ? 1 : 0; }
            const bool gsel = grank < 4;
            const float mv = gsel ? v : -INFINITY;
            int rank = 0;
#pragma unroll 8
            for (int jj = 0; jj < 64; ++jj) { const float o = __shfl(mv, jj); rank += ((o > mv) || (o == mv && jj < c.lane)) ? 1 : 0; }
            const bool sel = gsel && rank < 8;
            const float ssum = wave_sum(sel ? sc : 0.f);
            const float w = sc / ssum * 2.5f;
            const unsigned long long bal = __ballot(sel);
            const int slot = __popcll(bal & ((1ull << c.lane) - 1ull));
            if (sel) {
                const int p = atomicAdd(&lcnt[c.lane], 1);
                sel_e[tl * 8 + slot] = c.lane; sel_p[tl * 8 + slot] = p; sel_w[tl * 8 + slot] = w;
            }
        }
        __syncthreads();
        if (c.tid < 64) { const int n = lcnt[c.tid]; lbase[c.tid] = n ? (int)atomicAdd(CNT + c.tid, (unsigned)n) : 0; }
        __syncthreads();
        {
            const int tl = c.tid >> 3, t = ch * 32 + tl;
            const int e = sel_e[c.tid], pos = lbase[e] + sel_p[c.tid];
            LTOK[(size_t)e * CAP + pos] = t; LW[(size_t)e * CAP + pos] = sel_w[c.tid];
            ASG[(size_t)t * 8 + (c.tid & 7)] = (e << 16) | pos;
            if (c.tid < 32) { const int ts = ch * 32 + c.tid; LTOK[(size_t)64 * CAP + ts] = ts; LW[(size_t)64 * CAP + ts] = 1.f; }
        }
    }
}

__device__ __forceinline__ void phase_prep_even(const bf16_t* PROJ, const float* GATES, const float* qn, const float* kvn, const float* cw,
                                const float* a_log, const float* dt_bias, const float* ROPEM,
                                bf16_t* CQ, bf16_t* CKV, bf16_t* KROPE, bf16_t* GQ, bf16_t* GK, bf16_t* GV, float* BETA, float* GLOG, const Ctx& c) {
    const int lane = c.lane;
    for (int t = c.bid * 4 + c.wid; t < T; t += c.nblk * 4) {
        const bf16_t* pr = PROJ + (size_t)t * NPAD;
        {
            const u32x2 r = *(const u32x2*)(pr + lane * 4);
            float v[4] = {bflo(r.x), bfhi(r.x), bflo(r.y), bfhi(r.y)};
            const float ss = wave_sum(v[0] * v[0] + v[1] * v[1] + v[2] * v[2] + v[3] * v[3]);
            const float rr = rsqrtf(ss * (1.f / 256.f) + 1e-6f);
            const f32x4 gq = *(const f32x4*)(qn + lane * 4);
            *(u32x2*)(CQ + (size_t)t * 256 + lane * 4) = (u32x2){pk2(v[0] * rr * gq[0], v[1] * rr * gq[1]), pk2(v[2] * rr * gq[2], v[3] * rr * gq[3])};
        }
        {
            const unsigned r = *(const unsigned*)(pr + 256 + lane * 2);
            const float v0 = bflo(r), v1 = bfhi(r);
            const float ss = wave_sum(v0 * v0 + v1 * v1);
            const float rr = rsqrtf(ss * (1.f / 128.f) + 1e-6f);
            *(unsigned*)(CKV + (size_t)t * 128 + lane * 2) = pk2(v0 * rr * kvn[lane * 2], v1 * rr * kvn[lane * 2 + 1]);
        }
        if (lane < 16) {
            const float x1 = bf2f(pr[384 + lane]), x2 = bf2f(pr[400 + lane]);
            const float cs = ROPEM[((size_t)t * 16 + lane) * 2], sn = ROPEM[((size_t)t * 16 + lane) * 2 + 1];
            KROPE[(size_t)t * 32 + lane] = (bf16_t)f2bf(x1 * cs - x2 * sn);
            KROPE[(size_t)t * 32 + 16 + lane] = (bf16_t)f2bf(x2 * cs + x1 * sn);
        }
        const int s = t & (SEQ - 1);
#pragma unroll 1
        for (int hg = 0; hg < 12; ++hg) {
            const int chn = hg * 128 + lane * 2;
            float a0 = 0.f, a1 = 0.f;
#pragma unroll
            for (int w = 0; w < 4; ++w) {
                if (s - 3 + w >= 0) {
                    const unsigned r = *(const unsigned*)(PROJ + (size_t)(t - 3 + w) * NPAD + 416 + chn);
                    a0 += cw[w * 1536 + chn] * bflo(r); a1 += cw[w * 1536 + chn + 1] * bfhi(r);
                }
            }
            float y0 = siluf_(a0), y1 = siluf_(a1);
            if (hg < 8) {
                const float ss = wave_sum(y0 * y0 + y1 * y1);
                float rr = rsqrtf(ss + 1e-6f);
                if (hg < 4) rr *= 0.08838834764831845f;
                y0 *= rr; y1 *= rr;
            }
            bf16_t* dst = (hg < 4) ? GQ : (hg < 8) ? GK : GV;
            *(unsigned*)(dst + (size_t)t * 512 + (hg & 3) * 128 + lane * 2) = pk2(y0, y1);
        }
        if (lane < 4) BETA[(size_t)t * 4 + lane] = sigmoidf_(GATES[(size_t)t * 8 + lane]);
        else if (lane < 8) { const int h = lane - 4; GLOG[(size_t)t * 4 + h] = -expf(a_log[h]) * softplusf_(GATES[(size_t)t * 8 + lane] + dt_bias[h]); }
    }
}

__device__ __forceinline__ void phase_prep_odd(const bf16_t* PROJ, const float* ROPES, bf16_t* SQ, bf16_t* SK, const Ctx& c) {
    const int lane = c.lane;
    for (int t = c.bid * 4 + c.wid; t < T; t += c.nblk * 4) {
        const bf16_t* pr = PROJ + (size_t)t * NPAD;
        const int i = lane & 31;
        const float cs = ROPES[((size_t)t * 32 + i) * 2], sn = ROPES[((size_t)t * 32 + i) * 2 + 1];
#pragma unroll
        for (int r = 0; r < 4; ++r) {
            const int h = (lane >> 5) + 2 * r;
            const float x1 = bf2f(pr[1544 + h * 64 + i]), x2 = bf2f(pr[1544 + h * 64 + 32 + i]);
            SQ[(size_t)t * 512 + h * 64 + i] = (bf16_t)f2bf((x1 * cs - x2 * sn) * 0.18033688011112042f);
            SQ[(size_t)t * 512 + h * 64 + 32 + i] = (bf16_t)f2bf((x2 * cs + x1 * sn) * 0.18033688011112042f);
        }
        {
            const int h = lane >> 5;
            const float x1 = bf2f(pr[2056 + h * 64 + i]), x2 = bf2f(pr[2056 + h * 64 + 32 + i]);
            SK[(size_t)t * 128 + h * 64 + i] = (bf16_t)f2bf(x1 * cs - x2 * sn);
            SK[(size_t)t * 128 + h * 64 + 32 + i] = (bf16_t)f2bf(x2 * cs + x1 * sn);
        }
    }
}

__device__ __forceinline__ int next_unit(unsigned* ctr, const Ctx& c) {
    volatile int* su = (volatile int*)(c.smem + 65536 + 16);
    __syncthreads();
    if (c.tid == 0) *su = (int)atomicAdd(ctr, 1u);
    __syncthreads();
    return *su;
}

__device__ __forceinline__ void mla_unit(int u, const bf16_t* QF, const bf16_t* KN, const bf16_t* KROPE, const bf16_t* VV, bf16_t* MIXO, const Ctx& c) {
    const int qb = 7 - (u >> 6), bh = u & 63, b = bh >> 3, h = bh & 7;
    const int s = qb * 256 + c.tid;
    const size_t t = (size_t)b * SEQ + s;
    float* tile = (float*)c.smem;
    float q[96], o[64];
#pragma unroll
    for (int i = 0; i < 12; ++i) {
        const u32x4 r = *(const u32x4*)(QF + t * 768 + h * 96 + i * 8);
        float f[8]; unpack8(r, f);
#pragma unroll
        for (int j = 0; j < 8; ++j) q[i * 8 + j] = f[j];
    }
#pragma unroll
    for (int i = 0; i < 64; ++i) o[i] = 0.f;
    float m = -1e30f, l = 0.f;
    const int nkt = (qb + 1) * 8;
    for (int kt = 0; kt < nkt; ++kt) {
        __syncthreads();
        for (int idx = c.tid; idx < 640; idx += 256) {
            const int key = idx / 20, chk = idx % 20;
            const size_t tk = (size_t)b * SEQ + kt * 32 + key;
            const bf16_t* src = (chk < 8) ? (KN + tk * 512 + h * 64 + chk * 8) : (chk < 12) ? (KROPE + tk * 32 + (chk - 8) * 8) : (VV + tk * 512 + h * 64 + (chk - 12) * 8);
            const u32x4 r = *(const u32x4*)src;
            float f[8]; unpack8(r, f);
            float* d = tile + key * 160 + chk * 8;
            *(f32x4*)d = (f32x4){f[0], f[1], f[2], f[3]}; *(f32x4*)(d + 4) = (f32x4){f[4], f[5], f[6], f[7]};
        }
        __syncthreads();
#pragma unroll 1
        for (int j = 0; j < 32; ++j) {
            const int key = kt * 32 + j;
            if (key <= s) {
                const float* kr = tile + j * 160;
                float sc = 0.f;
#pragma unroll
                for (int i = 0; i < 96; ++i) sc += q[i] * kr[i];
                const float mn = fmaxf(m, sc);
                const float al = __expf(m - mn), p = __expf(sc - mn);
                l = l * al + p;
#pragma unroll
                for (int i = 0; i < 64; ++i) o[i] = o[i] * al + p * kr[96 + i];
                m = mn;
            }
        }
    }
    const float inv = 1.f / l;
#pragma unroll
    for (int i = 0; i < 8; ++i)
        *(u32x4*)(MIXO + t * 1024 + h * 64 + i * 8) = (u32x4){pk2(o[i * 8] * inv, o[i * 8 + 1] * inv), pk2(o[i * 8 + 2] * inv, o[i * 8 + 3] * inv),
                                                             pk2(o[i * 8 + 4] * inv, o[i * 8 + 5] * inv), pk2(o[i * 8 + 6] * inv, o[i * 8 + 7] * inv)};
}

__device__ __forceinline__ void gdn_unit(int u, const bf16_t* GQ, const bf16_t* GK, const bf16_t* GV, const float* BETA, const float* GLOG,
                         const bf16_t* PROJ, const float* gnorm, bf16_t* MIXO, const Ctx& c) {
    const int b = u >> 2, h = u & 3;
    float* kf = (float*)c.smem; float* qf = kf + 16 * 128; float* vf = qf + 16 * 128; float* ob = vf + 16 * 128;
    float* bt = ob + 16 * 128; float* av = bt + 16;
    float S[64];
#pragma unroll
    for (int i = 0; i < 64; ++i) S[i] = 0.f;
    const int j = c.wid * 32 + (c.lane & 31), half = c.lane >> 5;
    for (int c0 = 0; c0 < SEQ; c0 += 16) {
        const size_t t0 = (size_t)b * SEQ + c0;
        __syncthreads();
#pragma unroll
        for (int i = 0; i < 3; ++i) {
            const int idx = c.tid + 256 * i, arr = idx >> 8, r = idx & 255, tok = r >> 4, chk = r & 15;
            const bf16_t* src = ((arr == 0) ? GK : (arr == 1) ? GQ : GV) + (t0 + tok) * 512 + h * 128 + chk * 8;
            const u32x4 rr = *(const u32x4*)src;
            float f[8]; unpack8(rr, f);
            float* d = kf + arr * 2048 + tok * 128 + chk * 8;
            *(f32x4*)d = (f32x4){f[0], f[1], f[2], f[3]}; *(f32x4*)(d + 4) = (f32x4){f[4], f[5], f[6], f[7]};
        }
        if (c.tid < 16) { bt[c.tid] = BETA[(t0 + c.tid) * 4 + h]; av[c.tid] = expf(GLOG[(t0 + c.tid) * 4 + h]); }
        __syncthreads();
#pragma unroll 1
        for (int tt = 0; tt < 16; ++tt) {
            const float* kr = kf + tt * 128 + half * 64; const float* qr = qf + tt * 128 + half * 64;
            const float a = av[tt];
            float kS = 0.f;
#pragma unroll
            for (int i = 0; i < 64; ++i) kS += kr[i] * S[i];
            kS += __shfl_xor(kS, 32);
            const float vn = bt[tt] * (vf[tt * 128 + j] - a * kS);
            float o = 0.f;
#pragma unroll
            for (int i = 0; i < 64; ++i) { S[i] = a * S[i] + kr[i] * vn; o += qr[i] * S[i]; }
            o += __shfl_xor(o, 32);
            if (half == 0) ob[tt * 128 + j] = o;
        }
        __syncthreads();
#pragma unroll
        for (int k = 0; k < 4; ++k) {
            const int tt = c.wid * 4 + k;
            const float o0 = ob[tt * 128 + c.lane * 2], o1 = ob[tt * 128 + c.lane * 2 + 1];
            const float rr = rsqrtf(wave_sum(o0 * o0 + o1 * o1) * (1.f / 128.f) + 1e-6f);
            const unsigned zr = *(const unsigned*)(PROJ + (t0 + tt) * NPAD + 1960 + h * 128 + c.lane * 2);
            const float y0 = o0 * rr * gnorm[c.lane * 2] * siluf_(bflo(zr)), y1 = o1 * rr * gnorm[c.lane * 2 + 1] * siluf_(bfhi(zr));
            *(unsigned*)(MIXO + (t0 + tt) * 1024 + 512 + h * 128 + c.lane * 2) = pk2(y0, y1);
        }
    }
}

__device__ __forceinline__ void mlstm_unit(int u, const bf16_t* PROJ, const float* GATES, const float* b_i, const float* b_f, const float* mnorm, bf16_t* MIXO, const Ctx& c) {
    const int b = u >> 2, h = u & 3;
    float* kf = (float*)c.smem; float* qf = kf + 16 * 64; float* vf = qf + 16 * 64; float* ob = vf + 16 * 128;
    float* ip = ob + 16 * 128; float* lf = ip + 16;
    float C[32], nn[32];
#pragma unroll
    for (int i = 0; i < 32; ++i) { C[i] = 0.f; nn[i] = 0.f; }
    float mst = 0.f;
    const int j = c.wid * 32 + (c.lane & 31), half = c.lane >> 5;
    const float bi = b_i[h], bfv = b_f[h];
    for (int c0 = 0; c0 < SEQ; c0 += 16) {
        const size_t t0 = (size_t)b * SEQ + c0;
        __syncthreads();
        {
            const int idx = c.tid;
            if (idx < 128) { const int tok = idx >> 3, chk = idx & 7;
                const u32x4 rr = *(const u32x4*)(PROJ + (t0 + tok) * NPAD + 256 + h * 64 + chk * 8); float f[8]; unpack8(rr, f);
                float* d = kf + tok * 64 + chk * 8; *(f32x4*)d = (f32x4){f[0], f[1], f[2], f[3]}; *(f32x4*)(d + 4) = (f32x4){f[4], f[5], f[6], f[7]}; }
            else { const int i2 = idx - 128, tok = i2 >> 3, chk = i2 & 7;
                const u32x4 rr = *(const u32x4*)(PROJ + (t0 + tok) * NPAD + h * 64 + chk * 8); float f[8]; unpack8(rr, f);
                float* d = qf + tok * 64 + chk * 8; *(f32x4*)d = (f32x4){f[0], f[1], f[2], f[3]}; *(f32x4*)(d + 4) = (f32x4){f[4], f[5], f[6], f[7]}; }
            { const int tok = idx >> 4, chk = idx & 15;
                const u32x4 rr = *(const u32x4*)(PROJ + (t0 + tok) * NPAD + 512 + h * 128 + chk * 8); float f[8]; unpack8(rr, f);
                float* d = vf + tok * 128 + chk * 8; *(f32x4*)d = (f32x4){f[0], f[1], f[2], f[3]}; *(f32x4*)(d + 4) = (f32x4){f[4], f[5], f[6], f[7]}; }
            if (idx < 16) { ip[idx] = GATES[(t0 + idx) * 8 + h] + bi; lf[idx] = -softplusf_(-(GATES[(t0 + idx) * 8 + 4 + h] + bfv)); }
        }
        __syncthreads();
#pragma unroll 1
        for (int tt = 0; tt < 16; ++tt) {
            const float* kr = kf + tt * 64 + half * 32; const float* qr = qf + tt * 64 + half * 32;
            const float mn = fmaxf(lf[tt] + mst, ip[tt]);
            const float fs = expf(lf[tt] + mst - mn), is = expf(ip[tt] - mn) * 0.125f;
            mst = mn;
            const float vj = vf[tt * 128 + j] * is;
            float num = 0.f, den = 0.f;
#pragma unroll
            for (int i = 0; i < 32; ++i) {
                C[i] = fs * C[i] + kr[i] * vj; nn[i] = fs * nn[i] + kr[i] * is;
                num += qr[i] * C[i]; den += qr[i] * nn[i];
            }
            num += __shfl_xor(num, 32); den += __shfl_xor(den, 32);
            if (half == 0) ob[tt * 128 + j] = num / fmaxf(fabsf(den), expf(-mn));
        }
        __syncthreads();
#pragma unroll
        for (int k = 0; k < 4; ++k) {
            const int tt = c.wid * 4 + k;
            const float o0 = ob[tt * 128 + c.lane * 2], o1 = ob[tt * 128 + c.lane * 2 + 1];
            const float rr = rsqrtf(wave_sum(o0 * o0 + o1 * o1) * (1.f / 128.f) + 1e-6f);
            const unsigned zr = *(const unsigned*)(PROJ + (t0 + tt) * NPAD + 1032 + h * 128 + c.lane * 2);
            const float y0 = o0 * rr * mnorm[h * 128 + c.lane * 2] * sigmoidf_(bflo(zr)), y1 = o1 * rr * mnorm[h * 128 + c.lane * 2 + 1] * sigmoidf_(bfhi(zr));
            *(unsigned*)(MIXO + (t0 + tt) * 1024 + h * 128 + c.lane * 2) = pk2(y0, y1);
        }
    }
}

__device__ __forceinline__ void swa_unit(int u, const bf16_t* SQ, const bf16_t* SK, const bf16_t* PROJ, const float* sinks, bf16_t* MIXO, const Ctx& c) {
    const int half = u & 1, n = (u >> 1) & 15, kvh = (u >> 5) & 1, b = u >> 6;
    bf16_t* Kb = (bf16_t*)c.smem; bf16_t* Vb = Kb + 256 * 64;
    const int kstart = (n - 1) * 128;
    __syncthreads();
    for (int idx = c.tid; idx < 4096; idx += 256) {
        const int arr = idx >> 11, r = idx & 2047, kj = r >> 3, chk = r & 7;
        const int kpos = kstart + kj;
        u32x4 v = (u32x4){0u, 0u, 0u, 0u};
        if (kpos >= 0) {
            const size_t tk = (size_t)b * SEQ + kpos;
            v = arr ? *(const u32x4*)(PROJ + tk * NPAD + 2184 + kvh * 64 + chk * 8) : *(const u32x4*)(SK + tk * 128 + kvh * 64 + chk * 8);
        }
        *(u32x4*)((arr ? Vb : Kb) + kj * 64 + chk * 8) = v;
    }
    __syncthreads();
    const int qi = c.tid & 127, g = half * 2 + (c.tid >> 7), hq = kvh * 4 + g;
    const size_t t = (size_t)b * SEQ + n * 128 + qi;
    float q[64], o[64];
#pragma unroll
    for (int i = 0; i < 8; ++i) {
        const u32x4 r = *(const u32x4*)(SQ + t * 512 + hq * 64 + i * 8);
        float f[8]; unpack8(r, f);
#pragma unroll
        for (int jj = 0; jj < 8; ++jj) q[i * 8 + jj] = f[jj];
    }
#pragma unroll
    for (int i = 0; i < 64; ++i) o[i] = 0.f;
    float m = sinks[hq], l = 1.f;
#pragma unroll 1
    for (int kj = (n == 0) ? 128 : 0; kj < 256; ++kj) {
        const int rel = qi + 128 - kj;
        if (rel >= 0 && rel < 128) {
            float sc = 0.f;
#pragma unroll
            for (int i = 0; i < 8; ++i) {
                const u32x4 r = *(const u32x4*)(Kb + kj * 64 + i * 8);
                float f[8]; unpack8(r, f);
#pragma unroll
                for (int jj = 0; jj < 8; ++jj) sc += q[i * 8 + jj] * f[jj];
            }
            const float mn = fmaxf(m, sc);
            const float al = __expf(m - mn), p = __expf(sc - mn);
            l = l * al + p; m = mn;
#pragma unroll
            for (int i = 0; i < 8; ++i) {
                const u32x4 r = *(const u32x4*)(Vb + kj * 64 + i * 8);
                float f[8]; unpack8(r, f);
#pragma unroll
                for (int jj = 0; jj < 8; ++jj) o[i * 8 + jj] = o[i * 8 + jj] * al + p * f[jj];
            }
        }
    }
    const float inv = 1.f / l;
#pragma unroll
    for (int i = 0; i < 8; ++i)
        *(u32x4*)(MIXO + t * 1024 + 512 + hq * 64 + i * 8) = (u32x4){pk2(o[i * 8] * inv, o[i * 8 + 1] * inv), pk2(o[i * 8 + 2] * inv, o[i * 8 + 3] * inv),
                                                                   pk2(o[i * 8 + 4] * inv, o[i * 8 + 5] * inv), pk2(o[i * 8 + 6] * inv, o[i * 8 + 7] * inv)};
}

typedef float f32x16 __attribute__((ext_vector_type(16)));
typedef short s16x4 __attribute__((ext_vector_type(4)));
#define MFMA32(a, b, c) __builtin_amdgcn_mfma_f32_32x32x16_bf16((a), (b), (c), 0, 0, 0)
template <int S_> __device__ __forceinline__ bf16x8 pack_step(const f32x16& x) {
    u32x4 p;
    asm volatile("v_cvt_pk_bf16_f32 %0, %4, %5\n\tv_cvt_pk_bf16_f32 %1, %6, %7\n\tv_cvt_pk_bf16_f32 %2, %8, %9\n\tv_cvt_pk_bf16_f32 %3, %10, %11\n\ts_nop 1"
                 : "=&v"(p[0]), "=&v"(p[1]), "=&v"(p[2]), "=&v"(p[3])
                 : "v"(x[8 * S_]), "v"(x[8 * S_ + 1]), "v"(x[8 * S_ + 2]), "v"(x[8 * S_ + 3]), "v"(x[8 * S_ + 4]), "v"(x[8 * S_ + 5]), "v"(x[8 * S_ + 6]), "v"(x[8 * S_ + 7]));
    return __builtin_bit_cast(bf16x8, p);
}
constexpr int ATT_VB = 64 * 128;

template <int NKS, bool WIN>
__device__ __forceinline__ void attn_unit(const bf16_t* Qp, int q_ld, const bf16_t* K1, int k1_ld, const bf16_t* K2, int k2_ld, const bf16_t* Vp, int v_ld,
                          bf16_t* Op, int o_ld, int Q0, float sink_l2, const Ctx& c) {
    constexpr int KB = NKS * 2 * 1024, BUF = KB + ATT_VB;
    const int lane = c.lane, r = lane & 31, h = lane >> 5;
    const int wid = __builtin_amdgcn_readfirstlane(c.wid);
    const int q0w = Q0 + wid * 32;
    unsigned char* smem = c.smem;
    bf16x8 qf[NKS];
#pragma unroll
    for (int ks = 0; ks < NKS; ++ks) qf[ks] = *(const bf16x8*)(Qp + (size_t)(q0w + r) * q_ld + ks * 16 + h * 8);
    f32x16 o0, o1;
#pragma unroll
    for (int i = 0; i < 16; ++i) { o0[i] = 0.f; o1[i] = 0.f; }
    float m = WIN ? sink_l2 : -1e30f, l = (WIN && h == 0) ? 1.f : 0.f;
    const int kt_lo = WIN ? ((Q0 >> 6) - 2 < 0 ? 0 : (Q0 >> 6) - 2) : 0, kt_hi = (Q0 >> 6) + 1;
#define ATT_STAGE(kt_, buf_) do { unsigned char* bp = smem + (buf_) * BUF; const size_t kb = (size_t)(kt_) * 64; \
        _Pragma("unroll") for (int i = 0; i < (NKS * 2) / 4; ++i) { const int ch = wid + 4 * i; \
            const bf16_t* sp = (ch < 8) ? (K1 + (kb + lane) * k1_ld + ch * 8) : (K2 + (kb + lane) * k2_ld + (ch - 8) * 8); \
            glds16(sp, bp + ch * 1024 + lane * 16); } \
        _Pragma("unroll") for (int i = 0; i < 2; ++i) { const int j = wid + 4 * i; \
            glds16(Vp + (kb + 8 * j + (lane >> 3)) * v_ld + (lane & 7) * 8, bp + KB + j * 1024 + lane * 16); } } while (0)
    ATT_STAGE(kt_lo, 0);
    const int i16 = lane & 15;
    const unsigned vlane = (unsigned)((4 * h + (i16 >> 2)) * 128 + 32 * ((lane >> 4) & 1) + 8 * (i16 & 3));
    for (int kt = kt_lo; kt <= kt_hi; ++kt) {
        const int cur = (kt - kt_lo) & 1;
        asm volatile("s_waitcnt vmcnt(0)" ::: "memory");
        __syncthreads();
        if (kt < kt_hi) ATT_STAGE(kt + 1, cur ^ 1);
        const int k0 = kt * 64;
        const bool active = (k0 <= q0w + 31) && (!WIN || (k0 + 63 > q0w - 128));
        if (active) {
            const unsigned char* Kt = smem + cur * BUF;
            f32x16 x0, x1;
#pragma unroll
            for (int i = 0; i < 16; ++i) { x0[i] = 0.f; x1[i] = 0.f; }
#pragma unroll
            for (int ks = 0; ks < NKS; ++ks) {
                const bf16x8 kf0 = *(const bf16x8*)(Kt + (ks * 2 + h) * 1024 + r * 16);
                const bf16x8 kf1 = *(const bf16x8*)(Kt + (ks * 2 + h) * 1024 + (32 + r) * 16);
                x0 = MFMA32(kf0, qf[ks], x0); x1 = MFMA32(kf1, qf[ks], x1);
            }
            const bool need_mask = (k0 + 63 > q0w) || (WIN && (k0 <= q0w + 31 - 128));
            if (need_mask) {
                const int q = q0w + r;
#pragma unroll
                for (int i = 0; i < 16; ++i) {
                    const int key = k0 + (i & 3) + 8 * (i >> 2) + 4 * h;
                    const bool v0 = (key <= q) && (!WIN || key > q - 128);
                    const bool v1 = (key + 32 <= q) && (!WIN || key + 32 > q - 128);
                    x0[i] = v0 ? x0[i] : -INFINITY; x1[i] = v1 ? x1[i] : -INFINITY;
                }
            }
            float mx = fmaxf(x0[0], x1[0]);
#pragma unroll
            for (int i = 1; i < 16; ++i) mx = fmaxf(mx, fmaxf(x0[i], x1[i]));
            mx = fmaxf(mx, __shfl_xor(mx, 32));
            const float mn = fmaxf(m, mx);
            const float alpha = __builtin_amdgcn_exp2f(m - mn);
            m = mn;
            float ps = 0.f;
#pragma unroll
            for (int i = 0; i < 16; ++i) { x0[i] = __builtin_amdgcn_exp2f(x0[i] - mn); x1[i] = __builtin_amdgcn_exp2f(x1[i] - mn); ps += x0[i] + x1[i]; }
            l = l * alpha + ps;
            o0 *= alpha; o1 *= alpha;
            const unsigned vbase = (unsigned)(size_t)(smem + cur * BUF + KB) + vlane;
#pragma unroll
            for (int t = 0; t < 2; ++t) {
                s16x4 l00, h00, l01, h01, l10, h10, l11, h11;
                const unsigned va = vbase + t * 4096;
                asm volatile("ds_read_b64_tr_b16 %0, %8\n\t"
                             "ds_read_b64_tr_b16 %1, %8 offset:1024\n\t"
                             "ds_read_b64_tr_b16 %2, %8 offset:64\n\t"
                             "ds_read_b64_tr_b16 %3, %8 offset:1088\n\t"
                             "ds_read_b64_tr_b16 %4, %8 offset:2048\n\t"
                             "ds_read_b64_tr_b16 %5, %8 offset:3072\n\t"
                             "ds_read_b64_tr_b16 %6, %8 offset:2112\n\t"
                             "ds_read_b64_tr_b16 %7, %8 offset:3136\n\t"
                             "s_waitcnt lgkmcnt(0)"
                             : "=&v"(l00), "=&v"(h00), "=&v"(l01), "=&v"(h01), "=&v"(l10), "=&v"(h10), "=&v"(l11), "=&v"(h11) : "v"(va) : "memory");
                const bf16x8 v00 = __builtin_shufflevector(l00, h00, 0, 1, 2, 3, 4, 5, 6, 7), v01 = __builtin_shufflevector(l01, h01, 0, 1, 2, 3, 4, 5, 6, 7);
                const bf16x8 v10 = __builtin_shufflevector(l10, h10, 0, 1, 2, 3, 4, 5, 6, 7), v11 = __builtin_shufflevector(l11, h11, 0, 1, 2, 3, 4, 5, 6, 7);
                const bf16x8 pb0 = (t == 0) ? pack_step<0>(x0) : pack_step<0>(x1);
                const bf16x8 pb1 = (t == 0) ? pack_step<1>(x0) : pack_step<1>(x1);
                o0 = MFMA32(v00, pb0, o0); o1 = MFMA32(v01, pb0, o1);
                o0 = MFMA32(v10, pb1, o0); o1 = MFMA32(v11, pb1, o1);
            }
        }
    }
#undef ATT_STAGE
    l += __shfl_xor(l, 32);
    const float inv = 1.f / l;
    bf16_t* orow = Op + (size_t)(q0w + r) * o_ld + 4 * h;
#pragma unroll
    for (int g = 0; g < 4; ++g) {
        *(u32x2*)(orow + 8 * g) = (u32x2){pk2(o0[4 * g] * inv, o0[4 * g + 1] * inv), pk2(o0[4 * g + 2] * inv, o0[4 * g + 3] * inv)};
        *(u32x2*)(orow + 32 + 8 * g) = (u32x2){pk2(o1[4 * g] * inv, o1[4 * g + 1] * inv), pk2(o1[4 * g + 2] * inv, o1[4 * g + 3] * inv)};
    }
}

__device__ __forceinline__ float dppf(float v, int ctrl_sel) {
    int x = __builtin_bit_cast(int, v), r;
    if (ctrl_sel == 0) r = __builtin_amdgcn_update_dpp(0, x, 0xB1, 0xF, 0xF, true);
    else if (ctrl_sel == 1) r = __builtin_amdgcn_update_dpp(0, x, 0x4E, 0xF, 0xF, true);
    else if (ctrl_sel == 2) r = __builtin_amdgcn_update_dpp(0, x, 0x141, 0xF, 0xF, true);
    else r = __builtin_amdgcn_update_dpp(0, x, 0x140, 0xF, 0xF, true);
    return __builtin_bit_cast(float, r);
}
__device__ __forceinline__ float red16(float v) { v += dppf(v, 0); v += dppf(v, 1); v += dppf(v, 2); v += dppf(v, 3); return v; }

__device__ __forceinline__ float red32(float v) {
    v = red16(v);
    float a = v, b = v;
    asm volatile("s_nop 1\n\tv_permlane32_swap_b32 %0, %1\n\ts_nop 1" : "+v"(a), "+v"(b));
    return a + b;
}

__device__ __forceinline__ void gdn_unit2(int u, const bf16_t* GQ, const bf16_t* GK, const bf16_t* GV, const float* BETA, const float* GLOG, float* OG, const Ctx& c) {
    const int sl = u & 15, bh = u >> 4, b = bh >> 2, h = bh & 3;
    const int col = c.wid * 2 + ((c.lane >> 4) & 1), rcx = (c.lane >> 5) * 16 + (c.lane & 15);
    float* kf = (float*)c.smem; float* qf = kf + 32 * 128; float* bvf = qf + 32 * 128; float* baf = bvf + 32 * 8; float* af = baf + 32;
    float S[4];
#pragma unroll
    for (int i = 0; i < 4; ++i) S[i] = 0.f;
    const size_t tb = (size_t)b * SEQ;
    u32x4 rk[2], rq[2], rv; float rbeta = 0.f, rglog = 0.f;
    const int tok0 = c.tid >> 4, chk = c.tid & 15;
#define GDN_LOAD(c0) do { \
        _Pragma("unroll") for (int i = 0; i < 2; ++i) { const size_t t = tb + (c0) + tok0 + 16 * i; \
            rk[i] = *(const u32x4*)(GK + t * 512 + h * 128 + chk * 8); rq[i] = *(const u32x4*)(GQ + t * 512 + h * 128 + chk * 8); } \
        if (c.tid < 32) { const size_t t = tb + (c0) + c.tid; rv = *(const u32x4*)(GV + t * 512 + h * 128 + sl * 8); \
            rbeta = BETA[t * 4 + h]; rglog = GLOG[t * 4 + h]; } } while (0)
    GDN_LOAD(0);
    for (int c0 = 0; c0 < SEQ; c0 += 32) {
        __syncthreads();
#pragma unroll
        for (int i = 0; i < 2; ++i) {
            float f[8]; unpack8(rk[i], f);
            float* d = kf + (tok0 + 16 * i) * 128 + chk * 8;
            *(f32x4*)d = (f32x4){f[0], f[1], f[2], f[3]}; *(f32x4*)(d + 4) = (f32x4){f[4], f[5], f[6], f[7]};
            unpack8(rq[i], f);
            d = qf + (tok0 + 16 * i) * 128 + chk * 8;
            *(f32x4*)d = (f32x4){f[0], f[1], f[2], f[3]}; *(f32x4*)(d + 4) = (f32x4){f[4], f[5], f[6], f[7]};
        }
        if (c.tid < 32) { float f[8]; unpack8(rv, f); float* d = bvf + c.tid * 8;
            *(f32x4*)d = (f32x4){f[0] * rbeta, f[1] * rbeta, f[2] * rbeta, f[3] * rbeta}; *(f32x4*)(d + 4) = (f32x4){f[4] * rbeta, f[5] * rbeta, f[6] * rbeta, f[7] * rbeta};
            const float av = expf(rglog); af[c.tid] = av; baf[c.tid] = av * rbeta; }
        if (c0 + 32 < SEQ) GDN_LOAD(c0 + 32);
        __syncthreads();
        float keep = 0.f;
        f32x4 ka, qa, kb, qb; float aa, baa, bva, ab, bab, bvb;
#define GDN_LD(tt_, K4, Q4, A_, BA_, BV_) do { const int t_ = (tt_) < 32 ? (tt_) : 31; \
            K4 = *(const f32x4*)(kf + t_ * 128 + rcx * 4); Q4 = *(const f32x4*)(qf + t_ * 128 + rcx * 4); \
            A_ = af[t_]; BA_ = baf[t_]; BV_ = bvf[t_ * 8 + col]; } while (0)
#define GDN_STEP(tt_, K4, Q4, A_, BA_, BV_) do { \
            const float part = (K4[0] * S[0] + K4[1] * S[1]) + (K4[2] * S[2] + K4[3] * S[3]); \
            float aS[4]; _Pragma("unroll") for (int i = 0; i < 4; ++i) aS[i] = A_ * S[i]; \
            const float kS = red32(part); const float vn = BV_ - BA_ * kS; \
            _Pragma("unroll") for (int i = 0; i < 4; ++i) S[i] = aS[i] + K4[i] * vn; \
            float po = (Q4[0] * S[0] + Q4[1] * S[1]) + (Q4[2] * S[2] + Q4[3] * S[3]); \
            po = red32(po); keep = (rcx == (tt_)) ? po : keep; } while (0)
        GDN_LD(0, ka, qa, aa, baa, bva);
#pragma unroll 2
        for (int t2 = 0; t2 < 16; ++t2) {
            GDN_LD(2 * t2 + 1, kb, qb, ab, bab, bvb);
            GDN_STEP(2 * t2, ka, qa, aa, baa, bva);
            GDN_LD(2 * t2 + 2, ka, qa, aa, baa, bva);
            GDN_STEP(2 * t2 + 1, kb, qb, ab, bab, bvb);
        }
#undef GDN_LD
#undef GDN_STEP
        OG[(tb + c0 + rcx) * 512 + h * 128 + sl * 8 + col] = keep;
    }
#undef GDN_LOAD
}

__device__ __forceinline__ void mlstm_unit2(int u, const bf16_t* PROJ, const float* GATES, const float* b_i, const float* b_f, float* OG, const Ctx& c) {
    typedef float f32x2 __attribute__((ext_vector_type(2)));
    const int sl = u & 15, bh = u >> 4, b = bh >> 2, h = bh & 3;
    const int col = c.wid * 2 + ((c.lane >> 4) & 1), rcx = (c.lane >> 5) * 16 + (c.lane & 15);
    float* kf = (float*)c.smem; float* qf = kf + 32 * 64; float* vf = qf + 32 * 64; float* fsA = vf + 32 * 8; float* isA = fsA + 32; float* emA = isA + 32;
    float C[2], nn[2];
#pragma unroll
    for (int i = 0; i < 2; ++i) { C[i] = 0.f; nn[i] = 0.f; }
    float mprev = 0.f;
    const size_t tb = (size_t)b * SEQ;
    const float bi = b_i[h], bfv = b_f[h];
    u32x4 rk, rq, rv; float rgi = 0.f, rgf = 0.f;
    const int tok0 = c.tid >> 3, chk = c.tid & 7;
#define ML_LOAD(c0) do { const size_t t = tb + (c0) + tok0; \
        rk = *(const u32x4*)(PROJ + t * NPAD + 256 + h * 64 + chk * 8); rq = *(const u32x4*)(PROJ + t * NPAD + h * 64 + chk * 8); \
        if (c.tid < 64) { const size_t tg = tb + (c0) + (c.tid & 31); rv = *(const u32x4*)(PROJ + tg * NPAD + 512 + h * 128 + sl * 8); \
            rgi = GATES[tg * 8 + h]; rgf = GATES[tg * 8 + 4 + h]; } } while (0)
    ML_LOAD(0);
    for (int c0 = 0; c0 < SEQ; c0 += 32) {
        __syncthreads();
        {
            float f[8]; unpack8(rk, f);
            float* d = kf + tok0 * 64 + chk * 8;
            *(f32x4*)d = (f32x4){f[0], f[1], f[2], f[3]}; *(f32x4*)(d + 4) = (f32x4){f[4], f[5], f[6], f[7]};
            unpack8(rq, f);
            d = qf + tok0 * 64 + chk * 8;
            *(f32x4*)d = (f32x4){f[0], f[1], f[2], f[3]}; *(f32x4*)(d + 4) = (f32x4){f[4], f[5], f[6], f[7]};
        }
        if (c.tid < 64) {
            const int l5 = c.lane & 31;
            const float ipt = rgi + bi, lft = -softplusf_(-(rgf + bfv));
            float F = lft;
#pragma unroll
            for (int o = 1; o < 32; o <<= 1) { const float x = __shfl_up(F, o, 32); if (l5 >= o) F += x; }
            float P = ipt - F;
#pragma unroll
            for (int o = 1; o < 32; o <<= 1) { const float x = __shfl_up(P, o, 32); if (l5 >= o) P = fmaxf(P, x); }
            const float mt = F + fmaxf(mprev, P);
            float mtm1 = __shfl_up(mt, 1, 32); if (l5 == 0) mtm1 = mprev;
            mprev = __shfl(mt, 31, 32);
            if (c.tid < 32) {
                const float isv = expf(ipt - mt) * 0.125f;
                fsA[l5] = expf(lft + mtm1 - mt); isA[l5] = isv; emA[l5] = expf(-mt);
                float f[8]; unpack8(rv, f); float* d = vf + c.tid * 8;
                *(f32x4*)d = (f32x4){f[0] * isv, f[1] * isv, f[2] * isv, f[3] * isv}; *(f32x4*)(d + 4) = (f32x4){f[4] * isv, f[5] * isv, f[6] * isv, f[7] * isv};
            }
        }
        if (c0 + 32 < SEQ) ML_LOAD(c0 + 32);
        __syncthreads();
        float keep = 0.f;
        f32x2 k2a, q2a, k2b, q2b; float fsa, isa, ema, va, fsb, isb, emb, vb;
#define ML_LD(tt_, K2, Q2, FS_, IS_, EM_, V_) do { const int t_ = (tt_) < 32 ? (tt_) : 31; \
            K2 = *(const f32x2*)(kf + t_ * 64 + rcx * 2); Q2 = *(const f32x2*)(qf + t_ * 64 + rcx * 2); \
            FS_ = fsA[t_]; IS_ = isA[t_]; EM_ = emA[t_]; V_ = vf[t_ * 8 + col]; } while (0)
#define ML_STEP(tt_, K2, Q2, FS_, IS_, EM_, V_) do { float pn = 0.f, pd = 0.f; \
            _Pragma("unroll") for (int i = 0; i < 2; ++i) { C[i] = FS_ * C[i] + K2[i] * V_; nn[i] = FS_ * nn[i] + K2[i] * IS_; pn += Q2[i] * C[i]; pd += Q2[i] * nn[i]; } \
            pn = red32(pn); pd = red32(pd); \
            const float hv = pn * __builtin_amdgcn_rcpf(fmaxf(fabsf(pd), EM_)); \
            keep = (rcx == (tt_)) ? hv : keep; } while (0)
        ML_LD(0, k2a, q2a, fsa, isa, ema, va);
#pragma unroll 2
        for (int t2 = 0; t2 < 16; ++t2) {
            ML_LD(2 * t2 + 1, k2b, q2b, fsb, isb, emb, vb);
            ML_STEP(2 * t2, k2a, q2a, fsa, isa, ema, va);
            ML_LD(2 * t2 + 2, k2a, q2a, fsa, isa, ema, va);
            ML_STEP(2 * t2 + 1, k2b, q2b, fsb, isb, emb, vb);
        }
#undef ML_LD
#undef ML_STEP
        OG[(tb + c0 + rcx) * 512 + h * 128 + sl * 8 + col] = keep;
    }
#undef ML_LOAD
}

constexpr size_t MLC_DC = 0, MLC_CS = 33554432, MLC_DN = MLC_CS + 16777216, MLC_NS = MLC_DN + 262144, MLC_ML = MLC_NS + 262144, MLC_BE = MLC_ML + 4096, MLC_MS = MLC_BE + 4096;

__device__ __forceinline__ float scan_add64(float v, int lane) {
#pragma unroll
    for (int o = 1; o < 64; o <<= 1) { const float x = __shfl_up(v, o); if (lane >= o) v += x; }
    return v;
}
__device__ __forceinline__ float scan_max64(float v, int lane) {
#pragma unroll
    for (int o = 1; o < 64; o <<= 1) { const float x = __shfl_up(v, o); if (lane >= o) v = fmaxf(v, x); }
    return v;
}
__device__ __forceinline__ float wave_max(float v) {
#pragma unroll
    for (int o = 32; o > 0; o >>= 1) v = fmaxf(v, __shfl_xor(v, o));
    return v;
}

__device__ __forceinline__ void mlc_passA(int u, const bf16_t* PROJ, const float* GATES, const float* b_i, const float* b_f, unsigned char* YB, const Ctx& c) {
    const int bh = u >> 5, b = bh >> 2, h = bh & 3;
    const size_t t0 = (size_t)b * SEQ + (u & 31) * 64;
    unsigned char* smem = c.smem;
    float* saL = (float*)(smem + 24576);
    const int lane = c.lane, wid = __builtin_amdgcn_readfirstlane(c.wid);
#pragma unroll
    for (int i = 0; i < 4; ++i) { const int j = wid * 4 + i;
        glds16(PROJ + (t0 + 4 * j + (lane >> 4)) * NPAD + 512 + h * 128 + (lane & 15) * 8, smem + 8192 + j * 1024 + lane * 16); }
    if (wid == 0) {
        const float ip = GATES[(t0 + lane) * 8 + h] + b_i[h], lf = -softplusf_(-(GATES[(t0 + lane) * 8 + 4 + h] + b_f[h]));
        const float bc = scan_add64(lf, lane), bend = __shfl(bc, 63);
        const float a = bend - bc + ip, mloc = wave_max(a);
        saL[lane] = expf(a - mloc) * 0.125f;
        if (lane == 0) { ((float*)(YB + MLC_ML))[u] = mloc; ((float*)(YB + MLC_BE))[u] = bend; }
    }
    __syncthreads();
#pragma unroll
    for (int i = 0; i < 2; ++i) {
        const int idx = c.tid + 256 * i, row = idx >> 3, chk = idx & 7;
        const u32x4 r = *(const u32x4*)(PROJ + (t0 + row) * NPAD + 256 + h * 64 + chk * 8);
        float f[8]; unpack8(r, f);
        const float s = saL[row];
        *(u32x4*)(smem + row * 128 + chk * 16) = (u32x4){pk2(f[0] * s, f[1] * s), pk2(f[2] * s, f[3] * s), pk2(f[4] * s, f[5] * s), pk2(f[6] * s, f[7] * s)};
    }
    asm volatile("s_waitcnt vmcnt(0)" ::: "memory");
    __syncthreads();
    const int h5 = lane >> 5, r = lane & 31, i16 = lane & 15, q4 = i16 >> 2, p = i16 & 3, blk = (lane >> 4) & 1;
    const int dkt = wid & 1, dvp = wid >> 1;
    const unsigned kaddr = (unsigned)(size_t)smem + (unsigned)((8 * h5 + q4) * 128 + dkt * 64 + 32 * blk + 8 * p);
    const unsigned vaddr = (unsigned)(size_t)smem + 8192u + (unsigned)((8 * h5 + q4) * 256 + dvp * 128 + 32 * blk + 8 * p);
    f32x16 a0, a1;
#pragma unroll
    for (int i = 0; i < 16; ++i) { a0[i] = 0.f; a1[i] = 0.f; }
#pragma unroll
    for (int st = 0; st < 4; ++st) {
        s16x4 kl, kh, v0l, v0h, v1l, v1h;
        const unsigned ka = kaddr + st * 2048, va = vaddr + st * 4096;
        asm volatile("ds_read_b64_tr_b16 %0, %6\n\t"
                     "ds_read_b64_tr_b16 %1, %6 offset:512\n\t"
                     "ds_read_b64_tr_b16 %2, %7\n\t"
                     "ds_read_b64_tr_b16 %3, %7 offset:1024\n\t"
                     "ds_read_b64_tr_b16 %4, %7 offset:64\n\t"
                     "ds_read_b64_tr_b16 %5, %7 offset:1088\n\t"
                     "s_waitcnt lgkmcnt(0)"
                     : "=&v"(kl), "=&v"(kh), "=&v"(v0l), "=&v"(v0h), "=&v"(v1l), "=&v"(v1h) : "v"(ka), "v"(va) : "memory");
        const bf16x8 kf = __builtin_shufflevector(kl, kh, 0, 1, 2, 3, 4, 5, 6, 7);
        const bf16x8 vf0 = __builtin_shufflevector(v0l, v0h, 0, 1, 2, 3, 4, 5, 6, 7), vf1 = __builtin_shufflevector(v1l, v1h, 0, 1, 2, 3, 4, 5, 6, 7);
        a0 = MFMA32(kf, vf0, a0); a1 = MFMA32(kf, vf1, a1);
    }
    float* DC = (float*)(YB + MLC_DC) + (size_t)u * 8192;
#pragma unroll
    for (int i = 0; i < 16; ++i) {
        const int dk = dkt * 32 + (i & 3) + 8 * (i >> 2) + 4 * h5;
        DC[dk * 128 + dvp * 64 + r] = a0[i]; DC[dk * 128 + dvp * 64 + 32 + r] = a1[i];
    }
    if (c.tid < 64) {
        float s = 0.f;
#pragma unroll 8
        for (int t = 0; t < 64; ++t) s += bf2f(((const bf16_t*)smem)[t * 64 + c.tid]);
        ((float*)(YB + MLC_DN))[(size_t)u * 64 + c.tid] = s;
    }
}

__device__ __forceinline__ void mlc_passB(int u, unsigned char* YB, const Ctx& c) {
    const int bh = u >> 3, sl = u & 7;
    const float* ML = (const float*)(YB + MLC_ML) + bh * 32; const float* BE = (const float*)(YB + MLC_BE) + bh * 32;
    const float* DC = (const float*)(YB + MLC_DC) + (size_t)bh * 32 * 8192 + sl * 1024 + c.tid * 4;
    bf16_t* CS = (bf16_t*)(YB + MLC_CS) + (size_t)bh * 32 * 8192 + sl * 1024 + c.tid * 4;
    const float* DN = (const float*)(YB + MLC_DN) + (size_t)bh * 32 * 64; float* NS = (float*)(YB + MLC_NS) + (size_t)bh * 32 * 64; float* MS = (float*)(YB + MLC_MS) + bh * 32;
    f32x4 C4 = (f32x4){0.f, 0.f, 0.f, 0.f}; float nv = 0.f, m = 0.f;
    const bool do_n = (sl == 0) && (c.tid < 64);
#pragma unroll 4
    for (int n = 0; n < 32; ++n) {
        *(u32x2*)(CS + (size_t)n * 8192) = (u32x2){pk2(C4[0], C4[1]), pk2(C4[2], C4[3])};
        if (do_n) NS[n * 64 + c.tid] = nv;
        if (sl == 0 && c.tid == 0) MS[n] = m;
        const float be = BE[n], ml = ML[n];
        const float mn = fmaxf(be + m, ml), keep = expf(be + m - mn), g = expf(ml - mn);
        m = mn;
        const f32x4 d = *(const f32x4*)(DC + (size_t)n * 8192);
        C4 = C4 * keep + d * g;
        if (do_n) nv = nv * keep + DN[n * 64 + c.tid] * g;
    }
}

__device__ __forceinline__ void mlc_passC(int u, const bf16_t* PROJ, const float* GATES, const float* b_i, const float* b_f, const unsigned char* YB,
                                          const float* gain  , bf16_t* MIXO, const Ctx& c) {
    const int bh = u >> 5, b = bh >> 2, h = bh & 3;
    const size_t t0 = (size_t)b * SEQ + (u & 31) * 64;
    unsigned char* smem = c.smem;
    float* csL = (float*)(smem + 32768); float* pmL = (float*)(smem + 33024); float* bcL = (float*)(smem + 33280); float* nnL = (float*)(smem + 33536); float* sqL = (float*)(smem + 33792);
    const int lane = c.lane, wid = __builtin_amdgcn_readfirstlane(c.wid);
    const bf16_t* CS = (const bf16_t*)(YB + MLC_CS) + (size_t)u * 8192;
#pragma unroll
    for (int i = 0; i < 4; ++i) { const int j = wid * 4 + i;
        glds16(PROJ + (t0 + 4 * j + (lane >> 4)) * NPAD + 512 + h * 128 + (lane & 15) * 8, smem + j * 1024 + lane * 16);
        glds16(CS + (4 * j + (lane >> 4)) * 128 + (lane & 15) * 8, smem + 16384 + j * 1024 + lane * 16); }
    float bcl = 0.f;
    if (wid == 0) {
        const float ip = GATES[(t0 + lane) * 8 + h] + b_i[h], lf = -softplusf_(-(GATES[(t0 + lane) * 8 + 4 + h] + b_f[h]));
        bcl = scan_add64(lf, lane);
        const float cs = ip - bcl;
        csL[lane] = cs; pmL[lane] = scan_max64(cs, lane);
        nnL[lane] = ((const float*)(YB + MLC_NS))[(size_t)u * 64 + lane];
        bcL[lane] = bcl;
    }
    asm volatile("s_waitcnt vmcnt(0)" ::: "memory");
    __syncthreads();
    const int h5 = lane >> 5, r = lane & 31, i16 = lane & 15, q4 = i16 >> 2, p = i16 & 3, blk = (lane >> 4) & 1;
    const int th = wid & 1, dvh = wid >> 1;
    const int t = th * 32 + r;
    const float m_n = ((const float*)(YB + MLC_MS))[u];
    const float Mt = fmaxf(m_n, pmL[t]), w_inter = __expf(m_n - Mt), em = __expf(-(bcL[t] + Mt));
    bf16x8 qf[4];
#pragma unroll
    for (int ks = 0; ks < 4; ++ks) qf[ks] = *(const bf16x8*)(PROJ + (t0 + t) * NPAD + h * 64 + ks * 16 + h5 * 8);
    float qn = 0.f; bf16x8 qw[4];
#pragma unroll
    for (int ks = 0; ks < 4; ++ks) {
        const u32x4 raw = __builtin_bit_cast(u32x4, qf[ks]); float f[8]; unpack8(raw, f);
#pragma unroll
        for (int j = 0; j < 8; ++j) qn += f[j] * nnL[ks * 16 + h5 * 8 + j];
        qw[ks] = __builtin_bit_cast(bf16x8, (u32x4){pk2(f[0] * w_inter, f[1] * w_inter), pk2(f[2] * w_inter, f[3] * w_inter), pk2(f[4] * w_inter, f[5] * w_inter), pk2(f[6] * w_inter, f[7] * w_inter)});
    }
    qn += __shfl_xor(qn, 32);
    f32x16 x0, x1;
#pragma unroll
    for (int i = 0; i < 16; ++i) { x0[i] = 0.f; x1[i] = 0.f; }
#pragma unroll
    for (int ks = 0; ks < 4; ++ks) {
        const bf16x8 kf0 = *(const bf16x8*)(PROJ + (t0 + r) * NPAD + 256 + h * 64 + ks * 16 + h5 * 8);
        x0 = MFMA32(kf0, qf[ks], x0);
        if (th) { const bf16x8 kf1 = *(const bf16x8*)(PROJ + (t0 + 32 + r) * NPAD + 256 + h * 64 + ks * 16 + h5 * 8); x1 = MFMA32(kf1, qf[ks], x1); }
    }
    float ps = 0.f;
#pragma unroll
    for (int i = 0; i < 16; ++i) {
        const int s = (i & 3) + 8 * (i >> 2) + 4 * h5;
        const float w0 = (s <= t) ? __expf(csL[s] - Mt) * 0.125f : 0.f;
        x0[i] *= w0; ps += x0[i];
        if (th) { const float w1 = (s <= r) ? __expf(csL[32 + s] - Mt) * 0.125f : 0.f; x1[i] *= w1; ps += x1[i]; }
    }
    ps += __shfl_xor(ps, 32);
    const float den = w_inter * qn + ps;
    f32x16 o0, o1;
#pragma unroll
    for (int i = 0; i < 16; ++i) { o0[i] = 0.f; o1[i] = 0.f; }
    {
        const unsigned vb = (unsigned)(size_t)smem + (unsigned)((4 * h5 + q4) * 256 + dvh * 128 + 32 * blk + 8 * p);
#pragma unroll
        for (int st = 0; st < 2; ++st) {
            if (st == 0 || th) {
                s16x4 l00, h00, l01, h01, l10, h10, l11, h11;
                const unsigned va = vb + st * 8192;
                asm volatile("ds_read_b64_tr_b16 %0, %8\n\t"
                             "ds_read_b64_tr_b16 %1, %8 offset:2048\n\t"
                             "ds_read_b64_tr_b16 %2, %8 offset:64\n\t"
                             "ds_read_b64_tr_b16 %3, %8 offset:2112\n\t"
                             "ds_read_b64_tr_b16 %4, %8 offset:4096\n\t"
                             "ds_read_b64_tr_b16 %5, %8 offset:6144\n\t"
                             "ds_read_b64_tr_b16 %6, %8 offset:4160\n\t"
                             "ds_read_b64_tr_b16 %7, %8 offset:6208\n\t"
                             "s_waitcnt lgkmcnt(0)"
                             : "=&v"(l00), "=&v"(h00), "=&v"(l01), "=&v"(h01), "=&v"(l10), "=&v"(h10), "=&v"(l11), "=&v"(h11) : "v"(va) : "memory");
                const bf16x8 v00 = __builtin_shufflevector(l00, h00, 0, 1, 2, 3, 4, 5, 6, 7), v01 = __builtin_shufflevector(l01, h01, 0, 1, 2, 3, 4, 5, 6, 7);
                const bf16x8 v10 = __builtin_shufflevector(l10, h10, 0, 1, 2, 3, 4, 5, 6, 7), v11 = __builtin_shufflevector(l11, h11, 0, 1, 2, 3, 4, 5, 6, 7);
                const bf16x8 pb0 = (st == 0) ? pack_step<0>(x0) : pack_step<0>(x1);
                const bf16x8 pb1 = (st == 0) ? pack_step<1>(x0) : pack_step<1>(x1);
                o0 = MFMA32(v00, pb0, o0); o1 = MFMA32(v01, pb0, o1);
                o0 = MFMA32(v10, pb1, o0); o1 = MFMA32(v11, pb1, o1);
            }
        }
    }
    {
        const unsigned cb = (unsigned)(size_t)smem + 16384u + (unsigned)((8 * h5 + q4) * 256 + dvh * 128 + 32 * blk + 8 * p);
#pragma unroll
        for (int kp = 0; kp < 2; ++kp) {
            s16x4 l00, h00, l01, h01, l10, h10, l11, h11;
            const unsigned ca = cb + kp * 8192;
            asm volatile("ds_read_b64_tr_b16 %0, %8\n\t"
                         "ds_read_b64_tr_b16 %1, %8 offset:1024\n\t"
                         "ds_read_b64_tr_b16 %2, %8 offset:64\n\t"
                         "ds_read_b64_tr_b16 %3, %8 offset:1088\n\t"
                         "ds_read_b64_tr_b16 %4, %8 offset:4096\n\t"
                         "ds_read_b64_tr_b16 %5, %8 offset:5120\n\t"
                         "ds_read_b64_tr_b16 %6, %8 offset:4160\n\t"
                         "ds_read_b64_tr_b16 %7, %8 offset:5184\n\t"
                         "s_waitcnt lgkmcnt(0)"
                         : "=&v"(l00), "=&v"(h00), "=&v"(l01), "=&v"(h01), "=&v"(l10), "=&v"(h10), "=&v"(l11), "=&v"(h11) : "v"(ca) : "memory");
            const bf16x8 c00 = __builtin_shufflevector(l00, h00, 0, 1, 2, 3, 4, 5, 6, 7), c01 = __builtin_shufflevector(l01, h01, 0, 1, 2, 3, 4, 5, 6, 7);
            const bf16x8 c10 = __builtin_shufflevector(l10, h10, 0, 1, 2, 3, 4, 5, 6, 7), c11 = __builtin_shufflevector(l11, h11, 0, 1, 2, 3, 4, 5, 6, 7);
            o0 = MFMA32(c00, qw[2 * kp], o0); o1 = MFMA32(c01, qw[2 * kp], o1);
            o0 = MFMA32(c10, qw[2 * kp + 1], o0); o1 = MFMA32(c11, qw[2 * kp + 1], o1);
        }
    }
    const float inv = __builtin_amdgcn_rcpf(fmaxf(fabsf(den), em));
    float ss = 0.f;
#pragma unroll
    for (int i = 0; i < 16; ++i) { o0[i] *= inv; o1[i] *= inv; ss += o0[i] * o0[i] + o1[i] * o1[i]; }
    ss += __shfl_xor(ss, 32);
    if (h5 == 0) sqL[wid * 32 + r] = ss;
    __syncthreads();
    const float rr = rsqrtf((sqL[th * 32 + r] + sqL[(th + 2) * 32 + r]) * (1.f / 128.f) + 1e-6f);
    const bf16_t* grow = PROJ + (t0 + t) * NPAD + 1032 + h * 128 + dvh * 64 + 4 * h5;
    const float* gn = gain + h * 128 + dvh * 64 + 4 * h5;
    bf16_t* orow = MIXO + (t0 + t) * 1024 + h * 128 + dvh * 64 + 4 * h5;
#pragma unroll
    for (int d = 0; d < 2; ++d)
#pragma unroll
        for (int g = 0; g < 4; ++g) {
            const u32x2 zr = *(const u32x2*)(grow + d * 32 + 8 * g);
            const f32x4 gv = *(const f32x4*)(gn + d * 32 + 8 * g);
            const float z0 = bflo(zr.x), z1 = bfhi(zr.x), z2 = bflo(zr.y), z3 = bfhi(zr.y);
            const float y0 = (d ? o1[4 * g] : o0[4 * g]) * rr * gv[0] * sigmoidf_(z0), y1 = (d ? o1[4 * g + 1] : o0[4 * g + 1]) * rr * gv[1] * sigmoidf_(z1);
            const float y2 = (d ? o1[4 * g + 2] : o0[4 * g + 2]) * rr * gv[2] * sigmoidf_(z2), y3 = (d ? o1[4 * g + 3] : o0[4 * g + 3]) * rr * gv[3] * sigmoidf_(z3);
            *(u32x2*)(orow + d * 32 + 8 * g) = (u32x2){pk2(y0, y1), pk2(y2, y3)};
        }
}

__device__ __forceinline__ void phase_post(const float* OG, const bf16_t* PROJ, const float* gain, bool odd, bf16_t* MIXO, const Ctx& c) {
    const int lane = c.lane;
    const int gcol = odd ? 1032 : 1960, ocol = odd ? 0 : 512;
    for (int t = c.bid * 4 + c.wid; t < T; t += c.nblk * 4) {
        const f32x4 a0 = *(const f32x4*)(OG + (size_t)t * 512 + lane * 8), a1 = *(const f32x4*)(OG + (size_t)t * 512 + lane * 8 + 4);
        float ss = (a0[0] * a0[0] + a0[1] * a0[1]) + (a0[2] * a0[2] + a0[3] * a0[3]) + (a1[0] * a1[0] + a1[1] * a1[1]) + (a1[2] * a1[2] + a1[3] * a1[3]);
        ss = red16(ss);
        const float rr = rsqrtf(ss * (1.f / 128.f) + 1e-6f);
        const u32x4 zr = *(const u32x4*)(PROJ + (size_t)t * NPAD + gcol + lane * 8);
        float z[8]; unpack8(zr, z);
        const int gi = odd ? lane * 8 : (lane & 15) * 8;
        const f32x4 g0 = *(const f32x4*)(gain + gi), g1 = *(const f32x4*)(gain + gi + 4);
        float y[8];
#pragma unroll
        for (int j = 0; j < 4; ++j) {
            const float ga = odd ? sigmoidf_(z[j]) : siluf_(z[j]), gb = odd ? sigmoidf_(z[4 + j]) : siluf_(z[4 + j]);
            y[j] = a0[j] * rr * g0[j] * ga; y[4 + j] = a1[j] * rr * g1[j] * gb;
        }
        *(u32x4*)(MIXO + (size_t)t * 1024 + ocol + lane * 8) = (u32x4){pk2(y[0], y[1]), pk2(y[2], y[3]), pk2(y[4], y[5]), pk2(y[6], y[7])};
    }
}

__global__ void __launch_bounds__(256, 2) fwd(Args a) {
    extern __shared__ __attribute__((aligned(16))) unsigned char smem[];
    Ctx c;
    c.tid = threadIdx.x; c.lane = c.tid & 63; c.wid = c.tid >> 6; c.wr = c.wid >> 1; c.wc = c.wid & 1; c.fr = c.lane & 15; c.fq = c.lane >> 4;
    c.bid = blockIdx.x; c.nblk = gridDim.x; c.smem = smem;
#define PH_CTX() do { int t_ = threadIdx.x; asm volatile("" : "+v"(t_)); c.tid = t_; c.lane = t_ & 63; c.wid = t_ >> 6; c.wr = c.wid >> 1; c.wc = c.wid & 1; c.fr = c.lane & 15; c.fq = c.lane >> 4; } while (0)
    unsigned char* ws = a.ws;
    unsigned* ctl = (unsigned*)(ws + WS_CTL);
    volatile LAS unsigned* xbw = (volatile LAS unsigned*)(smem + 65536);
    if (c.tid < 8) xbw[c.tid] = 0u;
    __syncthreads();
    XcdBarrier bar; bar.bar = ctl; bar.x = 0; bar.st = xbw;
    if (a.use_bar) bar = xcd_barrier_post(ctl, xbw);
    const int lo = a.ph_lo, hi = a.ph_hi;
#define IN(k) (lo <= (k) && (k) < hi)
#define PH(k) if (IN(k)) { PH_CTX();
#define SEAM(k) do { if ((k) + 1 < hi) xcd_barrier(bar); } while (0)

    bf16_t* XBF = (bf16_t*)(ws + WS_XBF);
    float* X1 = (float*)(ws + WS_X1);
    bf16_t* PROJ = (bf16_t*)(ws + U_PROJ);
    float* GATES = (float*)(ws + U_GATES);
    bf16_t* MIXO = (bf16_t*)(ws + U_MIXO);
    float* YBUF = (float*)(ws + U_YBUF);
    const float* ROPEM = (const float*)(ws + WS_ROPEM);
    const float* ROPES = (const float*)(ws + WS_ROPES);

    PH(0) for (int rep = 0; rep < REP_PRO; ++rep) phase_prologue(a, c); SEAM(0); }

    for (int layer = 0; layer < 4; ++layer) {
        const int pb = 1 + layer * PPL;
        if (pb >= hi || pb + PPL <= lo) continue;
        const int jj = layer >> 1;
        const bool odd = (layer & 1) != 0;
        const float* xres = (layer == 0) ? (const float*)a.in[0] : (const float*)a.out;
        unsigned* CNT = ctl + CW_CNT + layer * 128;
        const bf16_t* WIN = (const bf16_t*)(ws + WS_WIN) + (size_t)layer * WIN_ELEMS;
        const bf16_t* WOUT = (const bf16_t*)(ws + WS_WOUT) + (size_t)layer * WOUT_ELEMS;

        PH(pb + 0) for (int rep = 0; rep < REP_GEMM * REP_G0; ++rep) phase_inproj(XBF, WIN, PROJ, GATES, odd ? 1024 : 1952, c); SEAM(pb + 0); }
        PH(pb + 1)
            for (int rep = 0; rep < REP_TOK; ++rep) if (!odd) phase_prep_even(PROJ, GATES, (const float*)a.in[3] + jj * 256, (const float*)a.in[5] + jj * 128, (const float*)a.in[7] + jj * 4 * 1536,
                                      (const float*)a.in[8] + jj * 4, (const float*)a.in[9] + jj * 4, ROPEM,
                                      (bf16_t*)(ws + U_CQ), (bf16_t*)(ws + U_CKV), (bf16_t*)(ws + U_KROPE), (bf16_t*)(ws + U_GQ), (bf16_t*)(ws + U_GK), (bf16_t*)(ws + U_GV),
                                      (float*)(ws + U_BETA), (float*)(ws + U_GLOG), c);
            else phase_prep_odd(PROJ, ROPES, (bf16_t*)(ws + U_QF), (bf16_t*)(ws + U_KN), c);
            SEAM(pb + 1);
        }
        PH(pb + 2)
            if (!odd) for (int rep = 0; rep < REP_GEMM; ++rep) phase_mla_up((const bf16_t*)(ws + U_CQ), (const bf16_t*)(ws + WS_WQB) + (size_t)jj * WQB_ELEMS, (const bf16_t*)(ws + U_CKV),
                                   (const bf16_t*)(ws + WS_WKVB) + (size_t)jj * WKVB_ELEMS, ROPEM, (bf16_t*)(ws + U_QF), (bf16_t*)(ws + U_KN), (bf16_t*)(ws + U_VV), c);
            SEAM(pb + 2);
        }
        PH(pb + 3)
            unsigned* ctr = ctl + CW_WORK + pb + 3;
            float* OG = YBUF;
            if (!odd) {
                for (;;) {
                    const int u = next_unit(ctr, c);
                    if (u >= 512 + 1024) break;
                    if (u < 512) gdn_unit2(u, (const bf16_t*)(ws + U_GQ), (const bf16_t*)(ws + U_GK), (const bf16_t*)(ws + U_GV), (const float*)(ws + U_BETA),
                                           (const float*)(ws + U_GLOG), OG, c);
                    else {
                        const int v = u - 512, qb = 15 - (v >> 6), bh = v & 63, b = bh >> 3, hh = bh & 7;
                        const size_t tb = (size_t)b * SEQ;
                        attn_unit<6, false>((const bf16_t*)(ws + U_QF) + tb * 768 + hh * 96, 768, (const bf16_t*)(ws + U_KN) + tb * 512 + hh * 64, 512,
                                            (const bf16_t*)(ws + U_KROPE) + tb * 32, 32, (const bf16_t*)(ws + U_VV) + tb * 512 + hh * 64, 512,
                                            MIXO + tb * 1024 + hh * 64, 1024, qb * 128, 0.f, c);
                    }
                }
            } else {
                for (;;) {
                    const int u = next_unit(ctr, c);
                    if (u >= 1024 + 1024) break;
                    if (u < 1024) mlc_passA(u, PROJ, GATES, (const float*)a.in[13] + jj * 4, (const float*)a.in[14] + jj * 4, (unsigned char*)YBUF, c);
                    else {
                        const int v = u - 1024, n = v & 15, hq = (v >> 4) & 7, b = v >> 7, kvh = hq >> 2;
                        const size_t tb = (size_t)b * SEQ;
                        attn_unit<4, true>((const bf16_t*)(ws + U_QF) + tb * 512 + hq * 64, 512, (const bf16_t*)(ws + U_KN) + tb * 128 + kvh * 64, 128,
                                           (const bf16_t*)(ws + U_KN), 0, PROJ + tb * NPAD + 2184 + kvh * 64, NPAD,
                                           MIXO + tb * 1024 + 512 + hq * 64, 1024, n * 128, ((const float*)a.in[16])[jj * 8 + hq] * 1.4426950408889634f, c);
                    }
                }
            }
            SEAM(pb + 3);
        }
        PH(pb + 4)
            if (!odd) phase_post(YBUF, PROJ, (const float*)a.in[10] + jj * 128, false, MIXO, c);
            else { for (int u = c.bid; u < 256; u += c.nblk) mlc_passB(u, (unsigned char*)YBUF, c); }
            SEAM(pb + 4);
        }
        PH(pb + 5)
            if (odd) {
                unsigned* ctr = ctl + CW_WORK + pb + 5;
                for (;;) {
                    const int u = next_unit(ctr, c);
                    if (u >= 1024) break;
                    mlc_passC(u, PROJ, GATES, (const float*)a.in[13] + jj * 4, (const float*)a.in[14] + jj * 4, (const unsigned char*)YBUF, (const float*)a.in[15] + jj * 512, MIXO, c);
                }
                SEAM(pb + 5);
            }
        }
        PH(pb + 6) for (int rep = 0; rep < REP_GEMM * REP_G1; ++rep) phase_outproj(MIXO, WOUT, xres, YBUF, c); SEAM(pb + 6); }
        PH(pb + 7) for (int rep = 0; rep < REP_TOK; ++rep) phase_ln1(YBUF, (const float*)a.in[18] + layer * 1024, (const float*)a.in[19] + layer * 1024, X1, XBF, c); SEAM(pb + 7); }
        PH(pb + 8) for (int rep = 0; rep < REP_GEMM; ++rep) phase_router(XBF, (const bf16_t*)(ws + WS_WRT) + (size_t)layer * WRT_ELEMS, (float*)(ws + WS_LOG), c); SEAM(pb + 8); }
        PH(pb + 9) phase_route((const float*)(ws + WS_LOG), (const float*)a.in[21] + layer * 64, CNT, (int*)(ws + WS_LTOK), (float*)(ws + WS_LW), (int*)(ws + WS_ASG), c); SEAM(pb + 9); }
        PH(pb + 10) for (int rep = 0; rep < REP_GEMM * REP_G2; ++rep) phase_moe1(XBF, (const bf16_t*)(ws + WS_WGU) + (size_t)layer * 65 * WGU_ELEMS, CNT, (const int*)(ws + WS_LTOK), (bf16_t*)(ws + WS_HBUF), c); SEAM(pb + 10); }
        PH(pb + 11) for (int rep = 0; rep < REP_GEMM * REP_G3; ++rep) phase_moe2((const bf16_t*)(ws + WS_HBUF), (const bf16_t*)(ws + WS_WDN) + (size_t)layer * 65 * WDN_ELEMS, CNT, (const float*)(ws + WS_LW), (bf16_t*)(ws + U_Y), c); SEAM(pb + 11); }
        PH(pb + 12) for (int rep = 0; rep < REP_CMB; ++rep) phase_combine(X1, (const bf16_t*)(ws + U_Y), (const int*)(ws + WS_ASG), CNT, (const float*)a.in[28] + layer * 1024, (const float*)a.in[29] + layer * 1024,
                                         a.out, XBF, c); SEAM(pb + 12); }
    }
#undef IN
#undef PH
#undef PH_CTX
#undef SEAM
}

extern "C" void kernel_launch(void* const* d_in, const int* in_sizes, int n_in, void* d_out, int out_size, void* d_ws, size_t ws_size, hipStream_t stream) {
    static int grid = 0;
    if (grid == 0) {
        if (n_in != 30 || out_size != T * 1024 || ws_size < WS_END) {
            fprintf(stderr, "kernel_launch: unexpected shapes (n_in %d, out %d, ws %zu < %zu)\n", n_in, out_size, ws_size, (size_t)WS_END);
            grid = -1; return;
        }
        int dev = 0, cus = 0, per_cu = 0;
        (void)hipGetDevice(&dev);
        (void)hipDeviceGetAttribute(&cus, hipDeviceAttributeMultiprocessorCount, dev);
        (void)hipFuncSetAttribute((const void*)fwd, hipFuncAttributeMaxDynamicSharedMemorySize, DYN_LDS);
        (void)hipOccupancyMaxActiveBlocksPerMultiprocessor(&per_cu, (const void*)fwd, 256, DYN_LDS);
        (void)hipGetLastError();
        if (per_cu < 1) per_cu = 1;
        grid = cus * (per_cu < 2 ? per_cu : 2);
    }
    if (grid < 0) return;
    (void)hipMemsetAsync((char*)d_ws + WS_CTL, 0, CTL_BYTES, stream);
    Args a{};
    for (int i = 0; i < 30; ++i) a.in[i] = d_in[i];
    a.out = (float*)d_out; a.ws = (unsigned char*)d_ws; a.pad = 0;
#if ONE_LAUNCH
    a.ph_lo = 0; a.ph_hi = NPH; a.use_bar = 1;
    hipLaunchKernelGGL(fwd, dim3(grid), dim3(256), DYN_LDS, stream, a);
#else
    for (int p = 0; p < NPH; ++p) {
        a.ph_lo = p; a.ph_hi = p + 1; a.use_bar = 0;
        hipLaunchKernelGGL(fwd, dim3(grid), dim3(256), DYN_LDS, stream, a);
    }
#endif
}
```

```cpp
#include <hip/hip_runtime.h>
#include <stdint.h>
#include <stdio.h>

#define REP_GEMM 1
#define REP_G0 1
#define REP_G1 1
#define REP_G2 1
#define REP_G3 1
#define REP_MIX 1
#define REP_ONLY 0
#define REP_CMB 1
#define REP_PRO 1
#define REP_TOK 1
#ifndef ONE_LAUNCH
#define ONE_LAUNCH 1
#endif

typedef unsigned short bf16_t;
typedef short bf16x8 __attribute__((ext_vector_type(8)));
typedef float f32x4 __attribute__((ext_vector_type(4)));
typedef unsigned u32x4 __attribute__((ext_vector_type(4)));
typedef unsigned u32x2 __attribute__((ext_vector_type(2)));
#define LAS __attribute__((address_space(3)))
#define GAS __attribute__((address_space(1)))

constexpr int T = 16384, SEQ = 2048;
constexpr int NPAD = 2560;
constexpr int CAP = 16384;
constexpr int MAXRB = 1024 + 64 + 128;
constexpr int MAXROWS = MAXRB * 128;
constexpr float ALPHA = 1.681792830507429f;
constexpr int PPL = 13;
constexpr int NPH = 1 + 4 * PPL;
constexpr int DYN_LDS = 65536 + 64 + 1024;

constexpr size_t cmax(size_t a, size_t b) { return a > b ? a : b; }
constexpr size_t WS_CTL = 0;
constexpr size_t CTL_BYTES = 65536;
constexpr size_t WS_WIN = WS_CTL + CTL_BYTES;
constexpr size_t WIN_ELEMS = (size_t)NPAD * 1024;
constexpr size_t WS_WQB = WS_WIN + 4 * WIN_ELEMS * 2;
constexpr size_t WQB_ELEMS = 768 * 256;
constexpr size_t WS_WKVB = WS_WQB + 2 * WQB_ELEMS * 2;
constexpr size_t WKVB_ELEMS = 1024 * 128;
constexpr size_t WS_WOUT = WS_WKVB + 2 * WKVB_ELEMS * 2;
constexpr size_t WOUT_ELEMS = 1024 * 1024;
constexpr size_t WS_WRT = WS_WOUT + 4 * WOUT_ELEMS * 2;
constexpr size_t WRT_ELEMS = 128 * 1024;
constexpr size_t WS_WGU = WS_WRT + 4 * WRT_ELEMS * 2;
constexpr size_t WGU_ELEMS = 512 * 1024;
constexpr size_t WS_WDN = WS_WGU + 4 * 65 * WGU_ELEMS * 2;
constexpr size_t WDN_ELEMS = 1024 * 256;
constexpr size_t WS_ROPEM = WS_WDN + 4 * 65 * WDN_ELEMS * 2;
constexpr size_t WS_ROPES = WS_ROPEM + (size_t)T * 16 * 2 * 4;
constexpr size_t WS_X1 = WS_ROPES + (size_t)T * 32 * 2 * 4;
constexpr size_t WS_XBF = WS_X1 + (size_t)T * 1024 * 4;
constexpr size_t WS_HBUF = WS_XBF + (size_t)T * 1024 * 2;
constexpr size_t WS_LOG = WS_HBUF + (size_t)MAXROWS * 256 * 2;
constexpr size_t WS_ASG = WS_LOG + (size_t)T * 64 * 4;
constexpr size_t WS_LTOK = WS_ASG + (size_t)T * 8 * 4;
constexpr size_t WS_LW = WS_LTOK + (size_t)65 * CAP * 4;
constexpr size_t WS_U = WS_LW + (size_t)65 * CAP * 4;
constexpr size_t U_Y = WS_U;
constexpr size_t U_PROJ = WS_U;
constexpr size_t U_GATES = U_PROJ + (size_t)T * NPAD * 2;
constexpr size_t U_CQ = U_GATES + (size_t)T * 8 * 4;
constexpr size_t U_CKV = U_CQ + (size_t)T * 256 * 2;
constexpr size_t U_KROPE = U_CKV + (size_t)T * 128 * 2;
constexpr size_t U_QF = U_KROPE + (size_t)T * 32 * 2;
constexpr size_t U_KN = U_QF + (size_t)T * 768 * 2;
constexpr size_t U_VV = U_KN + (size_t)T * 512 * 2;
constexpr size_t U_GQ = U_VV + (size_t)T * 512 * 2;
constexpr size_t U_GK = U_GQ + (size_t)T * 512 * 2;
constexpr size_t U_GV = U_GK + (size_t)T * 512 * 2;
constexpr size_t U_BETA = U_GV + (size_t)T * 512 * 2;
constexpr size_t U_GLOG = U_BETA + (size_t)T * 4 * 4;
constexpr size_t U_MIXO = U_GLOG + (size_t)T * 4 * 4;
constexpr size_t U_YBUF = U_MIXO + (size_t)T * 1024 * 2;
constexpr size_t U_END1 = U_YBUF + (size_t)T * 1024 * 4;
constexpr size_t WS_END = WS_U + cmax((size_t)MAXROWS * 1024 * 2, U_END1 - WS_U);

constexpr int CW_CNT = 4096;
constexpr int CW_WORK = 8192;

#define XB_TMO      128
#define XB_XCNT(j)  (256  + 64 * (j))
#define XB_XSUB(j)  (1280 + 64 * (j))
#define XB_XGEN(j)  (2304 + 64 * (j))
#define XB_TOP      3328
#define XB_TOPGEN   3392
#define XCD_BAR_WORDS 3456
#define XB_SPIN_CAP (1u << 18)

__device__ __forceinline__ unsigned xb_ld(unsigned* p)              { return __hip_atomic_load(p, __ATOMIC_RELAXED, __HIP_MEMORY_SCOPE_AGENT); }
__device__ __forceinline__ unsigned xb_add(unsigned* p, unsigned v) { return __hip_atomic_fetch_add(p, v, __ATOMIC_RELAXED, __HIP_MEMORY_SCOPE_AGENT); }
__device__ __forceinline__ unsigned xb_xcc_id() { return (unsigned)__builtin_amdgcn_s_getreg((3 << 11) | 20) & 0xFu; }
#define XB_SPIN(cond, bar) do { unsigned _sp = 0; while (cond) { __builtin_amdgcn_s_sleep(1); \
    if ((++_sp & 255u) == 0u) { if (xb_ld(&(bar)[XB_TMO])) break; if (_sp > XB_SPIN_CAP) { atomicAdd(&(bar)[XB_TMO], 1u); break; } } } } while (0)

struct XcdBarrier { unsigned* bar; unsigned x; volatile LAS unsigned* st; };

__device__ __forceinline__ XcdBarrier xcd_barrier_post(unsigned* bar, volatile LAS unsigned* st) {
    XcdBarrier b; b.bar = bar; b.x = xb_xcc_id(); b.st = st;
    if (threadIdx.x == 0) (void)xb_add(&bar[XB_XCNT(b.x)], 1u);
    return b;
}
__device__ __forceinline__ void xcd_barrier_complete(unsigned* bar, unsigned x, unsigned& nloc, unsigned& nx) {
    const unsigned G = gridDim.x * gridDim.y * gridDim.z;
    unsigned sum, cnt, mine, sp = 0u;
    for (;;) {
        sum = 0u; cnt = 0u; mine = 0u;
#pragma unroll
        for (unsigned j = 0; j < 16; ++j) { const unsigned c = xb_ld(&bar[XB_XCNT(j)]); sum += c; cnt += (c > 0u) ? 1u : 0u; mine = (j == x) ? c : mine; }
        if (sum == G) break;
        __builtin_amdgcn_s_sleep(1);
        if ((++sp & 255u) == 0u) { if (xb_ld(&bar[XB_TMO])) break; if (sp > XB_SPIN_CAP) { atomicAdd(&bar[XB_TMO], 1u); break; } }
    }
    nloc = mine > 0u ? mine : 1u; nx = cnt > 0u ? cnt : 1u;
}
__device__ __forceinline__ void xcd_barrier(const XcdBarrier& b) {
    asm volatile("s_waitcnt vmcnt(0)" ::: "memory");
    __syncthreads();
    if (threadIdx.x == 0) {
        unsigned* bar = b.bar;
        __builtin_amdgcn_s_waitcnt(0);
        unsigned nloc = b.st[0], nx = b.st[1];
        if (nloc == 0u) { xcd_barrier_complete(bar, b.x, nloc, nx); b.st[0] = nloc; b.st[1] = nx; }
        const unsigned old = xb_add(&bar[XB_XSUB(b.x)], 1u);
        const unsigned gen = old / nloc;
        if (old + 1u == (gen + 1u) * nloc) {
            __builtin_amdgcn_fence(__ATOMIC_RELEASE, "agent");
            asm volatile("s_waitcnt vmcnt(0)" ::: "memory");
            const unsigned og = xb_add(&bar[XB_TOP], 1u);
            const unsigned tg = og / nx;
            if (og + 1u == (tg + 1u) * nx) xb_add(&bar[XB_TOPGEN], 1u);
            else XB_SPIN(xb_ld(&bar[XB_TOPGEN]) == tg, bar);
            __builtin_amdgcn_fence(__ATOMIC_ACQUIRE, "agent");
            xb_add(&bar[XB_XGEN(b.x)], 1u);
            asm volatile("s_waitcnt vmcnt(0)" ::: "memory");
        } else {
            XB_SPIN(xb_ld(&bar[XB_XGEN(b.x)]) == gen, bar);
            __builtin_amdgcn_fence(__ATOMIC_ACQUIRE, "agent");
            asm volatile("s_waitcnt vmcnt(0)" ::: "memory");
        }
    }
    __syncthreads();
}

__device__ __forceinline__ float bf2f(unsigned v) { return __uint_as_float(v << 16); }
__device__ __forceinline__ float bflo(unsigned w) { return __uint_as_float(w << 16); }
__device__ __forceinline__ float bfhi(unsigned w) { return __uint_as_float(w & 0xffff0000u); }
__device__ __forceinline__ unsigned f2bf(float f) { unsigned u = __float_as_uint(f); u += 0x7fffu + ((u >> 16) & 1u); return u >> 16; }
__device__ __forceinline__ unsigned pk2(float lo, float hi) { return f2bf(lo) | (f2bf(hi) << 16); }
__device__ __forceinline__ float wave_sum(float v) {
#pragma unroll
    for (int o = 32; o > 0; o >>= 1) v += __shfl_xor(v, o);
    return v;
}
__device__ __forceinline__ float sigmoidf_(float x) { return 1.f / (1.f + expf(-x)); }
__device__ __forceinline__ float siluf_(float x) { return x / (1.f + expf(-x)); }
__device__ __forceinline__ float softplusf_(float x) { return x > 20.f ? x : log1pf(expf(x)); }
__device__ __forceinline__ void glds16(const void* g, void* l) {
    __builtin_amdgcn_global_load_lds((const GAS unsigned*)g, (LAS unsigned*)l, 16, 0, 0);
}
__device__ __forceinline__ void unpack8(const u32x4 r, float (&f)[8]) {
    f[0] = bflo(r.x); f[1] = bfhi(r.x); f[2] = bflo(r.y); f[3] = bfhi(r.y);
    f[4] = bflo(r.z); f[5] = bfhi(r.z); f[6] = bflo(r.w); f[7] = bfhi(r.w);
}

struct Args {
    const void* in[30];
    float* out;
    unsigned char* ws;
    int ph_lo, ph_hi, use_bar, pad;
};

struct Ctx { int tid, lane, wid, wr, wc, fr, fq, bid, nblk; unsigned char* smem; };

#define WAIT_V(n) asm volatile("s_waitcnt vmcnt(" #n ")" ::: "memory")
__device__ __forceinline__ void gemm_tile(const bf16_t* a0, const bf16_t* a1, const bf16_t* b0, const bf16_t* b1,
                                          int nk, f32x4 (&acc)[4][4], const Ctx& c) {
#pragma unroll
    for (int m = 0; m < 4; ++m)
#pragma unroll
        for (int n = 0; n < 4; ++n) acc[m][n] = (f32x4){0.f, 0.f, 0.f, 0.f};
    unsigned char* smem = c.smem;
    const int sb = c.tid * 16;
    const int kofs = ((c.tid & 3) ^ ((c.tid >> 4) & 3)) * 8;
    a0 += kofs; a1 += kofs; b0 += kofs; b1 += kofs;
#define G_STAGE(kt_) do { unsigned char* sp_ = smem + ((kt_) & 3) * 16384 + sb; const int ko_ = (kt_) * 32; \
        glds16(a0 + ko_, sp_); glds16(a1 + ko_, sp_ + 4096); glds16(b0 + ko_, sp_ + 8192); glds16(b1 + ko_, sp_ + 12288); } while (0)
    WAIT_V(0);
    G_STAGE(0);
    if (nk > 1) G_STAGE(1);
    if (nk > 2) G_STAGE(2);
    const int roff = (c.fr * 64) + ((c.fq ^ ((c.fr >> 2) & 3)) * 16);
    for (int kt = 0; kt < nk; ++kt) {
        if (kt + 2 < nk) WAIT_V(8); else if (kt + 1 < nk) WAIT_V(4); else WAIT_V(0);
        asm volatile("" ::: "memory"); __builtin_amdgcn_s_barrier(); asm volatile("" ::: "memory");
        if (kt + 3 < nk) G_STAGE(kt + 3);
        const unsigned char* sa = smem + (kt & 3) * 16384 + c.wr * 4096 + roff; const unsigned char* sbb = smem + (kt & 3) * 16384 + 8192 + c.wc * 4096 + roff;
        bf16x8 af[4], bfr[4];
#pragma unroll
        for (int m = 0; m < 4; ++m) af[m] = *(const bf16x8*)(sa + m * 1024);
#pragma unroll
        for (int n = 0; n < 4; ++n) bfr[n] = *(const bf16x8*)(sbb + n * 1024);
        __builtin_amdgcn_s_setprio(1);
#pragma unroll
        for (int m = 0; m < 4; ++m)
#pragma unroll
            for (int n = 0; n < 4; ++n) acc[m][n] = __builtin_amdgcn_mfma_f32_16x16x32_bf16(bfr[n], af[m], acc[m][n], 0, 0, 0);
        __builtin_amdgcn_s_setprio(0);
    }
#undef G_STAGE
    __syncthreads();
}

__device__ __forceinline__ bool tile_map(int i, const Ctx& c, int ntm, int ntn, int& mt, int& nt) {
    const int vb = ((c.nblk & 7) == 0) ? (c.bid & 7) * (c.nblk >> 3) + (c.bid >> 3) : c.bid;
    const int L = i * c.nblk + vb;
    if (L >= ntm * ntn) return false;
    const int g = L / (8 * ntn), rem = L - g * 8 * ntn;
    const int gsz = (ntm - g * 8) < 8 ? (ntm - g * 8) : 8;
    mt = g * 8 + rem % gsz; nt = rem / gsz;
    return true;
}

constexpr int TS_RS = 272;
__device__ __forceinline__ void tile_put(const Ctx& c, int row_l, int col_l, const u32x2 v) { *(u32x2*)(c.smem + row_l * TS_RS + col_l * 2) = v; }
template <int NCOL>
__device__ __forceinline__ void tile_flush(const Ctx& c, bf16_t* out, size_t ld) {
    __syncthreads();
    constexpr int CPR = NCOL / 8, PER = (128 * CPR) / 256;
#pragma unroll
    for (int i = 0; i < PER; ++i) {
        const int idx = c.tid + 256 * i, row = idx / CPR, ch = idx % CPR;
        const u32x4 v = *(const u32x4*)(c.smem + row * TS_RS + ch * 16);
        *(u32x4*)(out + (size_t)row * ld + ch * 8) = v;
    }
    __syncthreads();
}

__device__ __forceinline__ void conv_family(const float* src, int nmat, size_t src_stride, int K, int N, int Nout,
                            bf16_t* dst, size_t dst_stride, int grp, int kind, const Ctx& c) {
    float* lds = (float*)c.smem;
    const int tk = K / 128, tn = Nout / 64, per = tk * tn, total = nmat * per;
    const int tx = c.tid & 15, ty = c.tid >> 4;
    f32x4 r[8];
#define CV_LOAD(u_) do { const int mat_ = (u_) / per, r_ = (u_) - mat_ * per, kt_ = r_ / tn, nt_ = r_ - kt_ * tn; \
        const float* s_ = src + (size_t)mat_ * src_stride + (size_t)(kt_ * 128 + ty) * N + nt_ * 64 + tx * 4; const bool in_ = (nt_ * 64 + tx * 4) < N; \
        _Pragma("unroll") for (int i = 0; i < 8; ++i) r[i] = in_ ? *(const f32x4*)(s_ + (size_t)(16 * i) * N) : (f32x4){0.f, 0.f, 0.f, 0.f}; } while (0)
    int u = c.bid;
    if (u < total) CV_LOAD(u);
    for (; u < total; u += c.nblk) {
#pragma unroll
        for (int i = 0; i < 8; ++i) *(f32x4*)(lds + (ty + 16 * i) * 68 + tx * 4) = r[i];
        if (u + c.nblk < total) CV_LOAD(u + c.nblk);
        __syncthreads();
        const int mat = u / per, rr = u - mat * per, kt = rr / tn, nt = rr - kt * tn;
        const int dmat = grp ? (mat / grp) * (grp + 1) + (mat % grp) : mat;
        bf16_t* d = dst + (size_t)dmat * dst_stride;
        const int nl = c.tid & 63, kq = (c.tid >> 6) * 32;
        unsigned w[16];
#pragma unroll
        for (int j = 0; j < 16; ++j) w[j] = pk2(lds[(kq + 2 * j) * 68 + nl], lds[(kq + 2 * j + 1) * 68 + nl]);
        const int n = nt * 64 + nl;
        const int drow = (kind == 0) ? n : ((n >> 5) * 64 + (n & 31) + (kind == 2 ? 32 : 0));
        u32x4* dp = (u32x4*)(d + (size_t)drow * K + kt * 128 + kq);
        dp[0] = (u32x4){w[0], w[1], w[2], w[3]}; dp[1] = (u32x4){w[4], w[5], w[6], w[7]};
        dp[2] = (u32x4){w[8], w[9], w[10], w[11]}; dp[3] = (u32x4){w[12], w[13], w[14], w[15]};
        __syncthreads();
    }
#undef CV_LOAD
}

__device__ __forceinline__ void phase_prologue(const Args& a, const Ctx& c) {
    unsigned char* ws = a.ws;
    bf16_t* WIN = (bf16_t*)(ws + WS_WIN);
    conv_family((const float*)a.in[2], 2, (size_t)1024 * 2472, 1024, 2472, NPAD, WIN, 2 * WIN_ELEMS, 0, 0, c);
    conv_family((const float*)a.in[12], 2, (size_t)1024 * 2312, 1024, 2312, NPAD, WIN + WIN_ELEMS, 2 * WIN_ELEMS, 0, 0, c);
    conv_family((const float*)a.in[4], 2, (size_t)256 * 768, 256, 768, 768, (bf16_t*)(ws + WS_WQB), WQB_ELEMS, 0, 0, c);
    conv_family((const float*)a.in[6], 2, (size_t)128 * 1024, 128, 1024, 1024, (bf16_t*)(ws + WS_WKVB), WKVB_ELEMS, 0, 0, c);
    bf16_t* WOUT = (bf16_t*)(ws + WS_WOUT);
    conv_family((const float*)a.in[11], 2, (size_t)1024 * 1024, 1024, 1024, 1024, WOUT, 2 * WOUT_ELEMS, 0, 0, c);
    conv_family((const float*)a.in[17], 2, (size_t)1024 * 1024, 1024, 1024, 1024, WOUT + WOUT_ELEMS, 2 * WOUT_ELEMS, 0, 0, c);
    conv_family((const float*)a.in[20], 4, (size_t)1024 * 64, 1024, 64, 128, (bf16_t*)(ws + WS_WRT), WRT_ELEMS, 0, 0, c);
    bf16_t* WGU = (bf16_t*)(ws + WS_WGU);
    conv_family((const float*)a.in[22], 256, (size_t)1024 * 256, 1024, 256, 256, WGU, WGU_ELEMS, 64, 1, c);
    conv_family((const float*)a.in[23], 256, (size_t)1024 * 256, 1024, 256, 256, WGU, WGU_ELEMS, 64, 2, c);
    conv_family((const float*)a.in[25], 4, (size_t)1024 * 256, 1024, 256, 256, WGU + 64 * WGU_ELEMS, 65 * WGU_ELEMS, 0, 1, c);
    conv_family((const float*)a.in[26], 4, (size_t)1024 * 256, 1024, 256, 256, WGU + 64 * WGU_ELEMS, 65 * WGU_ELEMS, 0, 2, c);
    bf16_t* WDN = (bf16_t*)(ws + WS_WDN);
    conv_family((const float*)a.in[24], 256, (size_t)256 * 1024, 256, 1024, 1024, WDN, WDN_ELEMS, 64, 0, c);
    conv_family((const float*)a.in[27], 4, (size_t)256 * 1024, 256, 1024, 1024, WDN + 64 * WDN_ELEMS, 65 * WDN_ELEMS, 0, 0, c);
    {
        const float* x = (const float*)a.in[0]; bf16_t* xb = (bf16_t*)(ws + WS_XBF);
        const size_t n8 = (size_t)T * 1024 / 8;
        for (size_t i = (size_t)c.bid * 256 + c.tid; i < n8; i += (size_t)c.nblk * 256) {
            const f32x4 v0 = *(const f32x4*)(x + i * 8), v1 = *(const f32x4*)(x + i * 8 + 4);
            *(u32x4*)(xb + i * 8) = (u32x4){pk2(v0[0], v0[1]), pk2(v0[2], v0[3]), pk2(v1[0], v1[1]), pk2(v1[2], v1[3])};
        }
    }
    {
        const int* pos = (const int*)a.in[1];
        float* rm = (float*)(ws + WS_ROPEM); float* rs = (float*)(ws + WS_ROPES);
        const float ln_theta = 9.210340371976184f;
        for (int i = c.bid * 256 + c.tid; i < T * 16; i += c.nblk * 256) {
            const int t = i >> 4, f = i & 15;
            const float inv = expf(-((float)(2 * f) / 32.f) * ln_theta);
            const float ang = (float)pos[t] * inv;
            rm[i * 2] = cosf(ang); rm[i * 2 + 1] = sinf(ang);
        }
        for (int i = c.bid * 256 + c.tid; i < T * 32; i += c.nblk * 256) {
            const int t = i >> 5, f = i & 31;
            const float inv = expf(-((float)(2 * f) / 64.f) * ln_theta);
            const float ang = (float)pos[t] * inv;
            rs[i * 2] = cosf(ang); rs[i * 2 + 1] = sinf(ang);
        }
    }
}

__device__ __forceinline__ void phase_inproj(const bf16_t* XBF, const bf16_t* W, bf16_t* PROJ, float* GATES, int gbase, const Ctx& c) {
    const int ntn = NPAD / 128;
    for (int i = 0;; ++i) {
        int mt, nt; if (!tile_map(i, c, T / 128, ntn, mt, nt)) break;
        const bf16_t* a0 = XBF + (size_t)(mt * 128 + (c.tid >> 2)) * 1024;
        const bf16_t* b0 = W + (size_t)(nt * 128 + (c.tid >> 2)) * 1024;
        f32x4 acc[4][4];
        gemm_tile(a0, a0 + 64 * 1024, b0, b0 + 64 * 1024, 32, acc, c);
#pragma unroll
        for (int m = 0; m < 4; ++m) {
            const int rl = c.wr * 64 + m * 16 + c.fr, row = mt * 128 + rl;
#pragma unroll
            for (int n = 0; n < 4; ++n) {
                const int cl = c.wc * 64 + n * 16 + c.fq * 4, col = nt * 128 + cl;
                const f32x4 v = acc[m][n];
                tile_put(c, rl, cl, (u32x2){pk2(v[0], v[1]), pk2(v[2], v[3])});
                if (col >= gbase && col < gbase + 8) *(f32x4*)(GATES + (size_t)row * 8 + (col - gbase)) = v;
            }
        }
        tile_flush<128>(c, PROJ + (size_t)mt * 128 * NPAD + nt * 128, NPAD);
    }
}

__device__ __forceinline__ void phase_mla_up(const bf16_t* CQ, const bf16_t* WQB, const bf16_t* CKV, const bf16_t* WKVB,
                             const float* ROPEM, bf16_t* QF, bf16_t* KN, bf16_t* VV, const Ctx& c) {
    const int tq = (T / 128) * 6, tkv = (T / 128) * 8;
    const float qscale = 0.10206207261596577f * 1.4426950408889634f;
    for (int u = c.bid; u < tq + tkv; u += c.nblk) {
        f32x4 acc[4][4];
        if (u < tq) {
            const int mt = u / 6, nt = u % 6;
            const bf16_t* a0 = CQ + (size_t)(mt * 128 + (c.tid >> 2)) * 256;
            const bf16_t* b0 = WQB + (size_t)(nt * 128 + (c.tid >> 2)) * 256;
            gemm_tile(a0, a0 + 64 * 256, b0, b0 + 64 * 256, 8, acc, c);
#pragma unroll
            for (int m = 0; m < 4; ++m) {
                const int row = mt * 128 + c.wr * 64 + m * 16 + c.fr;
#pragma unroll
                for (int np = 0; np < 2; ++np) {
                    const int cg = nt * 128 + c.wc * 64 + np * 32;
                    f32x4 v0 = acc[m][2 * np], v1 = acc[m][2 * np + 1];
                    if (((cg >> 5) % 3) == 2) {
#pragma unroll
                        for (int j = 0; j < 4; ++j) {
                            const int i = c.fq * 4 + j;
                            const float cs = ROPEM[((size_t)row * 16 + i) * 2], sn = ROPEM[((size_t)row * 16 + i) * 2 + 1];
                            const float x1 = v0[j], x2 = v1[j];
                            v0[j] = x1 * cs - x2 * sn; v1[j] = x2 * cs + x1 * sn;
                        }
                    }
                    v0 *= qscale; v1 *= qscale;
                    *(u32x2*)(QF + (size_t)row * 768 + cg + c.fq * 4) = (u32x2){pk2(v0[0], v0[1]), pk2(v0[2], v0[3])};
                    *(u32x2*)(QF + (size_t)row * 768 + cg + 16 + c.fq * 4) = (u32x2){pk2(v1[0], v1[1]), pk2(v1[2], v1[3])};
                }
            }
        } else {
            const int v = u - tq, mt = v / 8, nt = v % 8;
            const bf16_t* a0 = CKV + (size_t)(mt * 128 + (c.tid >> 2)) * 128;
            const bf16_t* b0 = WKVB + (size_t)(nt * 128 + (c.tid >> 2)) * 128;
            gemm_tile(a0, a0 + 64 * 128, b0, b0 + 64 * 128, 4, acc, c);
            bf16_t* dst = (c.wc == 0) ? KN : VV;
#pragma unroll
            for (int m = 0; m < 4; ++m) {
                const int row = mt * 128 + c.wr * 64 + m * 16 + c.fr;
#pragma unroll
                for (int n = 0; n < 4; ++n) {
                    const f32x4 x = acc[m][n];
                    *(u32x2*)(dst + (size_t)row * 512 + nt * 64 + n * 16 + c.fq * 4) = (u32x2){pk2(x[0], x[1]), pk2(x[2], x[3])};
                }
            }
        }
    }
}

__device__ __forceinline__ void phase_outproj(const bf16_t* MIXO, const bf16_t* W, const float* xres, float* YBUF, const Ctx& c) {
    for (int i = 0;; ++i) {
        int mt, nt; if (!tile_map(i, c, T / 128, 8, mt, nt)) break;
        const bf16_t* a0 = MIXO + (size_t)(mt * 128 + (c.tid >> 2)) * 1024;
        const bf16_t* b0 = W + (size_t)(nt * 128 + (c.tid >> 2)) * 1024;
        f32x4 acc[4][4];
        gemm_tile(a0, a0 + 64 * 1024, b0, b0 + 64 * 1024, 32, acc, c);
#pragma unroll
        for (int m = 0; m < 4; ++m) {
            const int row = mt * 128 + c.wr * 64 + m * 16 + c.fr;
#pragma unroll
            for (int n = 0; n < 4; ++n) {
                const int col = nt * 128 + c.wc * 64 + n * 16 + c.fq * 4;
                const f32x4 xr = *(const f32x4*)(xres + (size_t)row * 1024 + col);
                *(f32x4*)(YBUF + (size_t)row * 1024 + col) = xr * ALPHA + acc[m][n];
            }
        }
    }
}

__device__ __forceinline__ void phase_router(const bf16_t* XBF, const bf16_t* W, float* LOG, const Ctx& c) {
    for (int mt = c.bid; mt < T / 128; mt += c.nblk) {
        const bf16_t* a0 = XBF + (size_t)(mt * 128 + (c.tid >> 2)) * 1024;
        const bf16_t* b0 = W + (size_t)(c.tid >> 2) * 1024;
        f32x4 acc[4][4];
        gemm_tile(a0, a0 + 64 * 1024, b0, b0 + 64 * 1024, 32, acc, c);
        if (c.wc == 0) {
#pragma unroll
            for (int m = 0; m < 4; ++m) {
                const int row = mt * 128 + c.wr * 64 + m * 16 + c.fr;
#pragma unroll
                for (int n = 0; n < 4; ++n) *(f32x4*)(LOG + (size_t)row * 64 + n * 16 + c.fq * 4) = acc[m][n];
            }
        }
    }
}

__device__ __forceinline__ void build_block_table(const unsigned* CNT, int* bst, const Ctx& c) {
    __syncthreads();
    if (c.wid == 0) {
        const int cnt = (int)__hip_atomic_load(CNT + c.lane, __ATOMIC_RELAXED, __HIP_MEMORY_SCOPE_AGENT);
        const int nb = (cnt + 127) >> 7;
        int inc = nb;
#pragma unroll
        for (int o = 1; o < 64; o <<= 1) { const int x = __shfl_up(inc, o); if (c.lane >= o) inc += x; }
        bst[c.lane] = inc - nb; bst[66 + c.lane] = cnt;
        if (c.lane == 63) { bst[64] = inc; bst[65] = inc + T / 128; bst[66 + 64] = T; }
    }
    __syncthreads();
}
__device__ __forceinline__ int find_expert(const int* bst, int rb, const Ctx& c) {
    return __popcll(__ballot(bst[1 + c.lane] <= rb));
}

__device__ __forceinline__ void phase_moe1(const bf16_t* XBF, const bf16_t* WGU, const unsigned* CNT, const int* LTOK, bf16_t* HBUF, const Ctx& c) {
    int* bst = (int*)(c.smem + 65536 + 64);
    build_block_table(CNT, bst, c);
    const int nrb = bst[65];
    for (int i = 0;; ++i) {
        int rb, nt; if (!tile_map(i, c, nrb, 4, rb, nt)) break;
        const int e = find_expert(bst, rb, c);
        const int lb = rb - bst[e], cnt = bst[66 + e];
        const int p0 = lb * 128 + (c.tid >> 2), p1 = p0 + 64;
        const int t0 = (p0 < cnt) ? LTOK[(size_t)e * CAP + p0] : 0;
        const int t1 = (p1 < cnt) ? LTOK[(size_t)e * CAP + p1] : 0;
        const bf16_t* a0 = XBF + (size_t)t0 * 1024;
        const bf16_t* a1 = XBF + (size_t)t1 * 1024;
        const bf16_t* b0 = WGU + (size_t)e * WGU_ELEMS + (size_t)(nt * 128 + (c.tid >> 2)) * 1024;
        f32x4 acc[4][4];
        gemm_tile(a0, a1, b0, b0 + 64 * 1024, 32, acc, c);
#pragma unroll
        for (int m = 0; m < 4; ++m) {
            const int rl = c.wr * 64 + m * 16 + c.fr;
#pragma unroll
            for (int n = 0; n < 2; ++n) {
                const f32x4 g = acc[m][n], up = acc[m][n + 2];
                float h[4];
#pragma unroll
                for (int j = 0; j < 4; ++j) h[j] = siluf_(g[j]) * up[j];
                tile_put(c, rl, c.wc * 32 + n * 16 + c.fq * 4, (u32x2){pk2(h[0], h[1]), pk2(h[2], h[3])});
            }
        }
        tile_flush<64>(c, HBUF + (size_t)rb * 128 * 256 + nt * 64, 256);
    }
}

__device__ __forceinline__ void phase_moe2(const bf16_t* HBUF, const bf16_t* WDN, const unsigned* CNT, const float* LW, bf16_t* Y, const Ctx& c) {
    int* bst = (int*)(c.smem + 65536 + 64);
    build_block_table(CNT, bst, c);
    const int nrb = bst[65];
    for (int i = 0;; ++i) {
        int rb, nt; if (!tile_map(i, c, nrb, 8, rb, nt)) break;
        const int e = find_expert(bst, rb, c);
        const int lb = rb - bst[e], cnt = bst[66 + e];
        const bf16_t* a0 = HBUF + ((size_t)rb * 128 + (c.tid >> 2)) * 256;
        const bf16_t* b0 = WDN + (size_t)e * WDN_ELEMS + (size_t)(nt * 128 + (c.tid >> 2)) * 256;
        f32x4 acc[4][4];
        gemm_tile(a0, a0 + 64 * 256, b0, b0 + 64 * 256, 8, acc, c);
#pragma unroll
        for (int m = 0; m < 4; ++m) {
            const int lr = c.wr * 64 + m * 16 + c.fr;
            const int p = lb * 128 + lr;
            const float w = (p < cnt) ? LW[(size_t)e * CAP + p] : 0.f;
#pragma unroll
            for (int n = 0; n < 4; ++n) {
                const f32x4 v = acc[m][n] * w;
                tile_put(c, lr, c.wc * 64 + n * 16 + c.fq * 4, (u32x2){pk2(v[0], v[1]), pk2(v[2], v[3])});
            }
        }
        tile_flush<128>(c, Y + (size_t)rb * 128 * 1024 + nt * 128, 1024);
    }
}

__device__ __forceinline__ void ln_row_store(float (&v)[16], const float* g, const float* b, float* of32, bf16_t* obf, int lane) {
    float s = 0.f;
#pragma unroll
    for (int i = 0; i < 16; ++i) s += v[i];
    const float mean = wave_sum(s) * (1.f / 1024.f);
    float q = 0.f;
#pragma unroll
    for (int i = 0; i < 16; ++i) { v[i] -= mean; q += v[i] * v[i]; }
    const float rstd = rsqrtf(wave_sum(q) * (1.f / 1024.f) + 1e-5f);
#pragma unroll
    for (int hf = 0; hf < 2; ++hf) {
        const int col = hf * 512 + lane * 8;
        const f32x4 g0 = *(const f32x4*)(g + col), g1 = *(const f32x4*)(g + col + 4);
        const f32x4 b0 = *(const f32x4*)(b + col), b1 = *(const f32x4*)(b + col + 4);
        f32x4 y0, y1;
#pragma unroll
        for (int j = 0; j < 4; ++j) { y0[j] = v[hf * 8 + j] * rstd * g0[j] + b0[j]; y1[j] = v[hf * 8 + 4 + j] * rstd * g1[j] + b1[j]; }
        *(f32x4*)(of32 + col) = y0; *(f32x4*)(of32 + col + 4) = y1;
        *(u32x4*)(obf + col) = (u32x4){pk2(y0[0], y0[1]), pk2(y0[2], y0[3]), pk2(y1[0], y1[1]), pk2(y1[2], y1[3])};
    }
}

__device__ __forceinline__ void phase_ln1(const float* YBUF, const float* g, const float* b, float* X1, bf16_t* XBF, const Ctx& c) {
    for (int t = c.bid * 4 + c.wid; t < T; t += c.nblk * 4) {
        float v[16];
#pragma unroll
        for (int hf = 0; hf < 2; ++hf) {
            const float* p = YBUF + (size_t)t * 1024 + hf * 512 + c.lane * 8;
            const f32x4 a0 = *(const f32x4*)p, a1 = *(const f32x4*)(p + 4);
#pragma unroll
            for (int j = 0; j < 4; ++j) { v[hf * 8 + j] = a0[j]; v[hf * 8 + 4 + j] = a1[j]; }
        }
        ln_row_store(v, g, b, X1 + (size_t)t * 1024, XBF + (size_t)t * 1024, c.lane);
    }
}

__device__ __forceinline__ void phase_combine(const float* X1, const bf16_t* Y, const int* ASG, const unsigned* CNT, const float* g, const float* b,
                              float* XOUT, bf16_t* XBF, const Ctx& c) {
    int* bst = (int*)(c.smem + 65536 + 64);
    build_block_table(CNT, bst, c);
    for (int t = c.bid * 4 + c.wid; t < T; t += c.nblk * 4) {
        float v[16];
#pragma unroll
        for (int hf = 0; hf < 2; ++hf) {
            const float* p = X1 + (size_t)t * 1024 + hf * 512 + c.lane * 8;
            const f32x4 a0 = *(const f32x4*)p, a1 = *(const f32x4*)(p + 4);
#pragma unroll
            for (int j = 0; j < 4; ++j) { v[hf * 8 + j] = a0[j] * ALPHA; v[hf * 8 + 4 + j] = a1[j] * ALPHA; }
        }
#pragma unroll
        for (int k = 0; k < 9; ++k) {
            size_t crow;
            if (k < 8) { const int asg = ASG[(size_t)t * 8 + k]; crow = (size_t)bst[asg >> 16] * 128 + (asg & 0xffff); }
            else crow = (size_t)bst[64] * 128 + t;
#pragma unroll
            for (int hf = 0; hf < 2; ++hf) {
                const u32x4 r = *(const u32x4*)(Y + crow * 1024 + hf * 512 + c.lane * 8);
                float f[8]; unpack8(r, f);
#pragma unroll
                for (int j = 0; j < 8; ++j) v[hf * 8 + j] += f[j];
            }
        }
        ln_row_store(v, g, b, XOUT + (size_t)t * 1024, XBF + (size_t)t * 1024, c.lane);
    }
}

__device__ __forceinline__ void phase_route(const float* LOG, const float* rb, unsigned* CNT, int* LTOK, float* LW, int* ASG, const Ctx& c) {
    int* lcnt = (int*)c.smem;
    int* lbase = lcnt + 64;
    int* sel_e = lbase + 64;
    int* sel_p = sel_e + 256;
    float* sel_w = (float*)(sel_p + 256);
    const float rbias = rb[c.lane];
    for (int ch = c.bid; ch < T / 32; ch += c.nblk) {
        __syncthreads();
        if (c.tid < 64) lcnt[c.tid] = 0;
        __syncthreads();
        for (int tl = c.wid; tl < 32; tl += 4) {
            const int t = ch * 32 + tl;
            const float lg = LOG[(size_t)t * 64 + c.lane];
            const float sc = 1.f / (1.f + expf(-lg));
            const float v = sc + rbias;
            float m1 = v;
            m1 = fmaxf(m1, __shfl_xor(m1, 1)); m1 = fmaxf(m1, __shfl_xor(m1, 2)); m1 = fmaxf(m1, __shfl_xor(m1, 4));
            int cand = (v == m1) ? c.lane : 999;
            cand = min(cand, __shfl_xor(cand, 1)); cand = min(cand, __shfl_xor(cand, 2)); cand = min(cand, __shfl_xor(cand, 4));
            float m2 = (c.lane == cand) ? -INFINITY : v;
            m2 = fmaxf(m2, __shfl_xor(m2, 1)); m2 = fmaxf(m2, __shfl_xor(m2, 2)); m2 = fmaxf(m2, __shfl_xor(m2, 4));
            const float gs = m1 + m2;
            const int g = c.lane >> 3;
            int grank = 0;
#pragma unroll
            for (int gg = 0; gg < 8; ++gg) { const float o = __shfl(gs, gg * 8); grank += ((o > gs) || (o == gs && gg < g)) ? 1 : 0; }
            const bool gsel = grank < 4;
            const float mv = gsel ? v : -INFINITY;
            int rank = 0;
#pragma unroll 8
            for (int jj = 0; jj < 64; ++jj) { const float o = __shfl(mv, jj); rank += ((o > mv) || (o == mv && jj < c.lane)) ? 1 : 0; }
            const bool sel = gsel && rank < 8;
            const float ssum = wave_sum(sel ? sc : 0.f);
            const float w = sc / ssum * 2.5f;
            const unsigned long long bal = __ballot(sel);
            const int slot = __popcll(bal & ((1ull << c.lane) - 1ull));
            if (sel) {
                const int p = atomicAdd(&lcnt[c.lane], 1);
                sel_e[tl * 8 + slot] = c.lane; sel_p[tl * 8 + slot] = p; sel_w[tl * 8 + slot] = w;
            }
        }
        __syncthreads();
        if (c.tid < 64) { const int n = lcnt[c.tid]; lbase[c.tid] = n ? (int)atomicAdd(CNT + c.tid, (unsigned)n) : 0; }
        __syncthreads();
        {
            const int tl = c.tid >> 3, t = ch * 32 + tl;
            const int e = sel_e[c.tid], pos = lbase[e] + sel_p[c.tid];
            LTOK[(size_t)e * CAP + pos] = t; LW[(size_t)e * CAP + pos] = sel_w[c.tid];
            ASG[(size_t)t * 8 + (c.tid & 7)] = (e << 16) | pos;
            if (c.tid < 32) { const int ts = ch * 32 + c.tid; LTOK[(size_t)64 * CAP + ts] = ts; LW[(size_t)64 * CAP + ts] = 1.f; }
        }
    }
}

__device__ __forceinline__ void phase_prep_even(const bf16_t* PROJ, const float* GATES, const float* qn, const float* kvn, const float* cw,
                                const float* a_log, const float* dt_bias, const float* ROPEM,
                                bf16_t* CQ, bf16_t* CKV, bf16_t* KROPE, bf16_t* GQ, bf16_t* GK, bf16_t* GV, float* BETA, float* GLOG, const Ctx& c) {
    const int lane = c.lane;
    for (int t = c.bid * 4 + c.wid; t < T; t += c.nblk * 4) {
        const bf16_t* pr = PROJ + (size_t)t * NPAD;
        {
            const u32x2 r = *(const u32x2*)(pr + lane * 4);
            float v[4] = {bflo(r.x), bfhi(r.x), bflo(r.y), bfhi(r.y)};
            const float ss = wave_sum(v[0] * v[0] + v[1] * v[1] + v[2] * v[2] + v[3] * v[3]);
            const float rr = rsqrtf(ss * (1.f / 256.f) + 1e-6f);
            const f32x4 gq = *(const f32x4*)(qn + lane * 4);
            *(u32x2*)(CQ + (size_t)t * 256 + lane * 4) = (u32x2){pk2(v[0] * rr * gq[0], v[1] * rr * gq[1]), pk2(v[2] * rr * gq[2], v[3] * rr * gq[3])};
        }
        {
            const unsigned r = *(const unsigned*)(pr + 256 + lane * 2);
            const float v0 = bflo(r), v1 = bfhi(r);
            const float ss = wave_sum(v0 * v0 + v1 * v1);
            const float rr = rsqrtf(ss * (1.f / 128.f) + 1e-6f);
            *(unsigned*)(CKV + (size_t)t * 128 + lane * 2) = pk2(v0 * rr * kvn[lane * 2], v1 * rr * kvn[lane * 2 + 1]);
        }
        if (lane < 16) {
            const float x1 = bf2f(pr[384 + lane]), x2 = bf2f(pr[400 + lane]);
            const float cs = ROPEM[((size_t)t * 16 + lane) * 2], sn = ROPEM[((size_t)t * 16 + lane) * 2 + 1];
            KROPE[(size_t)t * 32 + lane] = (bf16_t)f2bf(x1 * cs - x2 * sn);
            KROPE[(size_t)t * 32 + 16 + lane] = (bf16_t)f2bf(x2 * cs + x1 * sn);
        }
        const int s = t & (SEQ - 1);
#pragma unroll 1
        for (int hg = 0; hg < 12; ++hg) {
            const int chn = hg * 128 + lane * 2;
            float a0 = 0.f, a1 = 0.f;
#pragma unroll
            for (int w = 0; w < 4; ++w) {
                if (s - 3 + w >= 0) {
                    const unsigned r = *(const unsigned*)(PROJ + (size_t)(t - 3 + w) * NPAD + 416 + chn);
                    a0 += cw[w * 1536 + chn] * bflo(r); a1 += cw[w * 1536 + chn + 1] * bfhi(r);
                }
            }
            float y0 = siluf_(a0), y1 = siluf_(a1);
            if (hg < 8) {
                const float ss = wave_sum(y0 * y0 + y1 * y1);
                float rr = rsqrtf(ss + 1e-6f);
                if (hg < 4) rr *= 0.08838834764831845f;
                y0 *= rr; y1 *= rr;
            }
            bf16_t* dst = (hg < 4) ? GQ : (hg < 8) ? GK : GV;
            *(unsigned*)(dst + (size_t)t * 512 + (hg & 3) * 128 + lane * 2) = pk2(y0, y1);
        }
        if (lane < 4) BETA[(size_t)t * 4 + lane] = sigmoidf_(GATES[(size_t)t * 8 + lane]);
        else if (lane < 8) { const int h = lane - 4; GLOG[(size_t)t * 4 + h] = -expf(a_log[h]) * softplusf_(GATES[(size_t)t * 8 + lane] + dt_bias[h]); }
    }
}

__device__ __forceinline__ void phase_prep_odd(const bf16_t* PROJ, const float* ROPES, bf16_t* SQ, bf16_t* SK, const Ctx& c) {
    const int lane = c.lane;
    for (int t = c.bid * 4 + c.wid; t < T; t += c.nblk * 4) {
        const bf16_t* pr = PROJ + (size_t)t * NPAD;
        const int i = lane & 31;
        const float cs = ROPES[((size_t)t * 32 + i) * 2], sn = ROPES[((size_t)t * 32 + i) * 2 + 1];
#pragma unroll
        for (int r = 0; r < 4; ++r) {
            const int h = (lane >> 5) + 2 * r;
            const float x1 = bf2f(pr[1544 + h * 64 + i]), x2 = bf2f(pr[1544 + h * 64 + 32 + i]);
            SQ[(size_t)t * 512 + h * 64 + i] = (bf16_t)f2bf((x1 * cs - x2 * sn) * 0.18033688011112042f);
            SQ[(size_t)t * 512 + h * 64 + 32 + i] = (bf16_t)f2bf((x2 * cs + x1 * sn) * 0.18033688011112042f);
        }
        {
            const int h = lane >> 5;
            const float x1 = bf2f(pr[2056 + h * 64 + i]), x2 = bf2f(pr[2056 + h * 64 + 32 + i]);
            SK[(size_t)t * 128 + h * 64 + i] = (bf16_t)f2bf(x1 * cs - x2 * sn);
            SK[(size_t)t * 128 + h * 64 + 32 + i] = (bf16_t)f2bf(x2 * cs + x1 * sn);
        }
    }
}

__device__ __forceinline__ int next_unit(unsigned* ctr, const Ctx& c) {
    volatile int* su = (volatile int*)(c.smem + 65536 + 16);
    __syncthreads();
    if (c.tid == 0) *su = (int)atomicAdd(ctr, 1u);
    __syncthreads();
    return *su;
}

__device__ __forceinline__ void mla_unit(int u, const bf16_t* QF, const bf16_t* KN, const bf16_t* KROPE, const bf16_t* VV, bf16_t* MIXO, const Ctx& c) {
    const int qb = 7 - (u >> 6), bh = u & 63, b = bh >> 3, h = bh & 7;
    const int s = qb * 256 + c.tid;
    const size_t t = (size_t)b * SEQ + s;
    float* tile = (float*)c.smem;
    float q[96], o[64];
#pragma unroll
    for (int i = 0; i < 12; ++i) {
        const u32x4 r = *(const u32x4*)(QF + t * 768 + h * 96 + i * 8);
        float f[8]; unpack8(r, f);
#pragma unroll
        for (int j = 0; j < 8; ++j) q[i * 8 + j] = f[j];
    }
#pragma unroll
    for (int i = 0; i < 64; ++i) o[i] = 0.f;
    float m = -1e30f, l = 0.f;
    const int nkt = (qb + 1) * 8;
    for (int kt = 0; kt < nkt; ++kt) {
        __syncthreads();
        for (int idx = c.tid; idx < 640; idx += 256) {
            const int key = idx / 20, chk = idx % 20;
            const size_t tk = (size_t)b * SEQ + kt * 32 + key;
            const bf16_t* src = (chk < 8) ? (KN + tk * 512 + h * 64 + chk * 8) : (chk < 12) ? (KROPE + tk * 32 + (chk - 8) * 8) : (VV + tk * 512 + h * 64 + (chk - 12) * 8);
            const u32x4 r = *(const u32x4*)src;
            float f[8]; unpack8(r, f);
            float* d = tile + key * 160 + chk * 8;
            *(f32x4*)d = (f32x4){f[0], f[1], f[2], f[3]}; *(f32x4*)(d + 4) = (f32x4){f[4], f[5], f[6], f[7]};
        }
        __syncthreads();
#pragma unroll 1
        for (int j = 0; j < 32; ++j) {
            const int key = kt * 32 + j;
            if (key <= s) {
                const float* kr = tile + j * 160;
                float sc = 0.f;
#pragma unroll
                for (int i = 0; i < 96; ++i) sc += q[i] * kr[i];
                const float mn = fmaxf(m, sc);
                const float al = __expf(m - mn), p = __expf(sc - mn);
                l = l * al + p;
#pragma unroll
                for (int i = 0; i < 64; ++i) o[i] = o[i] * al + p * kr[96 + i];
                m = mn;
            }
        }
    }
    const float inv = 1.f / l;
#pragma unroll
    for (int i = 0; i < 8; ++i)
        *(u32x4*)(MIXO + t * 1024 + h * 64 + i * 8) = (u32x4){pk2(o[i * 8] * inv, o[i * 8 + 1] * inv), pk2(o[i * 8 + 2] * inv, o[i * 8 + 3] * inv),
                                                             pk2(o[i * 8 + 4] * inv, o[i * 8 + 5] * inv), pk2(o[i * 8 + 6] * inv, o[i * 8 + 7] * inv)};
}

__device__ __forceinline__ void gdn_unit(int u, const bf16_t* GQ, const bf16_t* GK, const bf16_t* GV, const float* BETA, const float* GLOG,
                         const bf16_t* PROJ, const float* gnorm, bf16_t* MIXO, const Ctx& c) {
    const int b = u >> 2, h = u & 3;
    float* kf = (float*)c.smem; float* qf = kf + 16 * 128; float* vf = qf + 16 * 128; float* ob = vf + 16 * 128;
    float* bt = ob + 16 * 128; float* av = bt + 16;
    float S[64];
#pragma unroll
    for (int i = 0; i < 64; ++i) S[i] = 0.f;
    const int j = c.wid * 32 + (c.lane & 31), half = c.lane >> 5;
    for (int c0 = 0; c0 < SEQ; c0 += 16) {
        const size_t t0 = (size_t)b * SEQ + c0;
        __syncthreads();
#pragma unroll
        for (int i = 0; i < 3; ++i) {
            const int idx = c.tid + 256 * i, arr = idx >> 8, r = idx & 255, tok = r >> 4, chk = r & 15;
            const bf16_t* src = ((arr == 0) ? GK : (arr == 1) ? GQ : GV) + (t0 + tok) * 512 + h * 128 + chk * 8;
            const u32x4 rr = *(const u32x4*)src;
            float f[8]; unpack8(rr, f);
            float* d = kf + arr * 2048 + tok * 128 + chk * 8;
            *(f32x4*)d = (f32x4){f[0], f[1], f[2], f[3]}; *(f32x4*)(d + 4) = (f32x4){f[4], f[5], f[6], f[7]};
        }
        if (c.tid < 16) { bt[c.tid] = BETA[(t0 + c.tid) * 4 + h]; av[c.tid] = expf(GLOG[(t0 + c.tid) * 4 + h]); }
        __syncthreads();
#pragma unroll 1
        for (int tt = 0; tt < 16; ++tt) {
            const float* kr = kf + tt * 128 + half * 64; const float* qr = qf + tt * 128 + half * 64;
            const float a = av[tt];
            float kS = 0.f;
#pragma unroll
            for (int i = 0; i < 64; ++i) kS += kr[i] * S[i];
            kS += __shfl_xor(kS, 32);
            const float vn = bt[tt] * (vf[tt * 128 + j] - a * kS);
            float o = 0.f;
#pragma unroll
            for (int i = 0; i < 64; ++i) { S[i] = a * S[i] + kr[i] * vn; o += qr[i] * S[i]; }
            o += __shfl_xor(o, 32);
            if (half == 0) ob[tt * 128 + j] = o;
        }
        __syncthreads();
#pragma unroll
        for (int k = 0; k < 4; ++k) {
            const int tt = c.wid * 4 + k;
            const float o0 = ob[tt * 128 + c.lane * 2], o1 = ob[tt * 128 + c.lane * 2 + 1];
            const float rr = rsqrtf(wave_sum(o0 * o0 + o1 * o1) * (1.f / 128.f) + 1e-6f);
            const unsigned zr = *(const unsigned*)(PROJ + (t0 + tt) * NPAD + 1960 + h * 128 + c.lane * 2);
            const float y0 = o0 * rr * gnorm[c.lane * 2] * siluf_(bflo(zr)), y1 = o1 * rr * gnorm[c.lane * 2 + 1] * siluf_(bfhi(zr));
            *(unsigned*)(MIXO + (t0 + tt) * 1024 + 512 + h * 128 + c.lane * 2) = pk2(y0, y1);
        }
    }
}

__device__ __forceinline__ void mlstm_unit(int u, const bf16_t* PROJ, const float* GATES, const float* b_i, const float* b_f, const float* mnorm, bf16_t* MIXO, const Ctx& c) {
    const int b = u >> 2, h = u & 3;
    float* kf = (float*)c.smem; float* qf = kf + 16 * 64; float* vf = qf + 16 * 64; float* ob = vf + 16 * 128;
    float* ip = ob + 16 * 128; float* lf = ip + 16;
    float C[32], nn[32];
#pragma unroll
    for (int i = 0; i < 32; ++i) { C[i] = 0.f; nn[i] = 0.f; }
    float mst = 0.f;
    const int j = c.wid * 32 + (c.lane & 31), half = c.lane >> 5;
    const float bi = b_i[h], bfv = b_f[h];
    for (int c0 = 0; c0 < SEQ; c0 += 16) {
        const size_t t0 = (size_t)b * SEQ + c0;
        __syncthreads();
        {
            const int idx = c.tid;
            if (idx < 128) { const int tok = idx >> 3, chk = idx & 7;
                const u32x4 rr = *(const u32x4*)(PROJ + (t0 + tok) * NPAD + 256 + h * 64 + chk * 8); float f[8]; unpack8(rr, f);
                float* d = kf + tok * 64 + chk * 8; *(f32x4*)d = (f32x4){f[0], f[1], f[2], f[3]}; *(f32x4*)(d + 4) = (f32x4){f[4], f[5], f[6], f[7]}; }
            else { const int i2 = idx - 128, tok = i2 >> 3, chk = i2 & 7;
                const u32x4 rr = *(const u32x4*)(PROJ + (t0 + tok) * NPAD + h * 64 + chk * 8); float f[8]; unpack8(rr, f);
                float* d = qf + tok * 64 + chk * 8; *(f32x4*)d = (f32x4){f[0], f[1], f[2], f[3]}; *(f32x4*)(d + 4) = (f32x4){f[4], f[5], f[6], f[7]}; }
            { const int tok = idx >> 4, chk = idx & 15;
                const u32x4 rr = *(const u32x4*)(PROJ + (t0 + tok) * NPAD + 512 + h * 128 + chk * 8); float f[8]; unpack8(rr, f);
                float* d = vf + tok * 128 + chk * 8; *(f32x4*)d = (f32x4){f[0], f[1], f[2], f[3]}; *(f32x4*)(d + 4) = (f32x4){f[4], f[5], f[6], f[7]}; }
            if (idx < 16) { ip[idx] = GATES[(t0 + idx) * 8 + h] + bi; lf[idx] = -softplusf_(-(GATES[(t0 + idx) * 8 + 4 + h] + bfv)); }
        }
        __syncthreads();
#pragma unroll 1
        for (int tt = 0; tt < 16; ++tt) {
            const float* kr = kf + tt * 64 + half * 32; const float* qr = qf + tt * 64 + half * 32;
            const float mn = fmaxf(lf[tt] + mst, ip[tt]);
            const float fs = expf(lf[tt] + mst - mn), is = expf(ip[tt] - mn) * 0.125f;
            mst = mn;
            const float vj = vf[tt * 128 + j] * is;
            float num = 0.f, den = 0.f;
#pragma unroll
            for (int i = 0; i < 32; ++i) {
                C[i] = fs * C[i] + kr[i] * vj; nn[i] = fs * nn[i] + kr[i] * is;
                num += qr[i] * C[i]; den += qr[i] * nn[i];
            }
            num += __shfl_xor(num, 32); den += __shfl_xor(den, 32);
            if (half == 0) ob[tt * 128 + j] = num / fmaxf(fabsf(den), expf(-mn));
        }
        __syncthreads();
#pragma unroll
        for (int k = 0; k < 4; ++k) {
            const int tt = c.wid * 4 + k;
            const float o0 = ob[tt * 128 + c.lane * 2], o1 = ob[tt * 128 + c.lane * 2 + 1];
            const float rr = rsqrtf(wave_sum(o0 * o0 + o1 * o1) * (1.f / 128.f) + 1e-6f);
            const unsigned zr = *(const unsigned*)(PROJ + (t0 + tt) * NPAD + 1032 + h * 128 + c.lane * 2);
            const float y0 = o0 * rr * mnorm[h * 128 + c.lane * 2] * sigmoidf_(bflo(zr)), y1 = o1 * rr * mnorm[h * 128 + c.lane * 2 + 1] * sigmoidf_(bfhi(zr));
            *(unsigned*)(MIXO + (t0 + tt) * 1024 + h * 128 + c.lane * 2) = pk2(y0, y1);
        }
    }
}

__device__ __forceinline__ void swa_unit(int u, const bf16_t* SQ, const bf16_t* SK, const bf16_t* PROJ, const float* sinks, bf16_t* MIXO, const Ctx& c) {
    const int half = u & 1, n = (u >> 1) & 15, kvh = (u >> 5) & 1, b = u >> 6;
    bf16_t* Kb = (bf16_t*)c.smem; bf16_t* Vb = Kb + 256 * 64;
    const int kstart = (n - 1) * 128;
    __syncthreads();
    for (int idx = c.tid; idx < 4096; idx += 256) {
        const int arr = idx >> 11, r = idx & 2047, kj = r >> 3, chk = r & 7;
        const int kpos = kstart + kj;
        u32x4 v = (u32x4){0u, 0u, 0u, 0u};
        if (kpos >= 0) {
            const size_t tk = (size_t)b * SEQ + kpos;
            v = arr ? *(const u32x4*)(PROJ + tk * NPAD + 2184 + kvh * 64 + chk * 8) : *(const u32x4*)(SK + tk * 128 + kvh * 64 + chk * 8);
        }
        *(u32x4*)((arr ? Vb : Kb) + kj * 64 + chk * 8) = v;
    }
    __syncthreads();
    const int qi = c.tid & 127, g = half * 2 + (c.tid >> 7), hq = kvh * 4 + g;
    const size_t t = (size_t)b * SEQ + n * 128 + qi;
    float q[64], o[64];
#pragma unroll
    for (int i = 0; i < 8; ++i) {
        const u32x4 r = *(const u32x4*)(SQ + t * 512 + hq * 64 + i * 8);
        float f[8]; unpack8(r, f);
#pragma unroll
        for (int jj = 0; jj < 8; ++jj) q[i * 8 + jj] = f[jj];
    }
#pragma unroll
    for (int i = 0; i < 64; ++i) o[i] = 0.f;
    float m = sinks[hq], l = 1.f;
#pragma unroll 1
    for (int kj = (n == 0) ? 128 : 0; kj < 256; ++kj) {
        const int rel = qi + 128 - kj;
        if (rel >= 0 && rel < 128) {
            float sc = 0.f;
#pragma unroll
            for (int i = 0; i < 8; ++i) {
                const u32x4 r = *(const u32x4*)(Kb + kj * 64 + i * 8);
                float f[8]; unpack8(r, f);
#pragma unroll
                for (int jj = 0; jj < 8; ++jj) sc += q[i * 8 + jj] * f[jj];
            }
            const float mn = fmaxf(m, sc);
            const float al = __expf(m - mn), p = __expf(sc - mn);
            l = l * al + p; m = mn;
#pragma unroll
            for (int i = 0; i < 8; ++i) {
                const u32x4 r = *(const u32x4*)(Vb + kj * 64 + i * 8);
                float f[8]; unpack8(r, f);
#pragma unroll
                for (int jj = 0; jj < 8; ++jj) o[i * 8 + jj] = o[i * 8 + jj] * al + p * f[jj];
            }
        }
    }
    const float inv = 1.f / l;
#pragma unroll
    for (int i = 0; i < 8; ++i)
        *(u32x4*)(MIXO + t * 1024 + 512 + hq * 64 + i * 8) = (u32x4){pk2(o[i * 8] * inv, o[i * 8 + 1] * inv), pk2(o[i * 8 + 2] * inv, o[i * 8 + 3] * inv),
                                                                   pk2(o[i * 8 + 4] * inv, o[i * 8 + 5] * inv), pk2(o[i * 8 + 6] * inv, o[i * 8 + 7] * inv)};
}

typedef float f32x16 __attribute__((ext_vector_type(16)));
typedef short s16x4 __attribute__((ext_vector_type(4)));
#define MFMA32(a, b, c) __builtin_amdgcn_mfma_f32_32x32x16_bf16((a), (b), (c), 0, 0, 0)
template <int S_> __device__ __forceinline__ bf16x8 pack_step(const f32x16& x) {
    u32x4 p;
    asm volatile("v_cvt_pk_bf16_f32 %0, %4, %5\n\tv_cvt_pk_bf16_f32 %1, %6, %7\n\tv_cvt_pk_bf16_f32 %2, %8, %9\n\tv_cvt_pk_bf16_f32 %3, %10, %11\n\ts_nop 1"
                 : "=&v"(p[0]), "=&v"(p[1]), "=&v"(p[2]), "=&v"(p[3])
                 : "v"(x[8 * S_]), "v"(x[8 * S_ + 1]), "v"(x[8 * S_ + 2]), "v"(x[8 * S_ + 3]), "v"(x[8 * S_ + 4]), "v"(x[8 * S_ + 5]), "v"(x[8 * S_ + 6]), "v"(x[8 * S_ + 7]));
    return __builtin_bit_cast(bf16x8, p);
}
template <int S_> __device__ __forceinline__ bf16x8 pack_step_m(const f32x16& x) {
    u32x4 p;
    asm volatile("s_nop 15\n\tv_cvt_pk_bf16_f32 %0, %4, %5\n\tv_cvt_pk_bf16_f32 %1, %6, %7\n\tv_cvt_pk_bf16_f32 %2, %8, %9\n\tv_cvt_pk_bf16_f32 %3, %10, %11\n\ts_nop 1"
                 : "=&v"(p[0]), "=&v"(p[1]), "=&v"(p[2]), "=&v"(p[3])
                 : "v"(x[8 * S_]), "v"(x[8 * S_ + 1]), "v"(x[8 * S_ + 2]), "v"(x[8 * S_ + 3]), "v"(x[8 * S_ + 4]), "v"(x[8 * S_ + 5]), "v"(x[8 * S_ + 6]), "v"(x[8 * S_ + 7]));
    return __builtin_bit_cast(bf16x8, p);
}
constexpr int ATT_VB = 64 * 128;

template <int NKS, bool WIN>
__device__ __forceinline__ void attn_unit(const bf16_t* Qp, int q_ld, const bf16_t* K1, int k1_ld, const bf16_t* K2, int k2_ld, const bf16_t* Vp, int v_ld,
                          bf16_t* Op, int o_ld, int Q0, float sink_l2, const Ctx& c) {
    constexpr int KB = NKS * 2 * 1024, BUF = KB + ATT_VB;
    const int lane = c.lane, r = lane & 31, h = lane >> 5;
    const int wid = __builtin_amdgcn_readfirstlane(c.wid);
    const int q0w = Q0 + wid * 32;
    unsigned char* smem = c.smem;
    bf16x8 qf[NKS];
#pragma unroll
    for (int ks = 0; ks < NKS; ++ks) qf[ks] = *(const bf16x8*)(Qp + (size_t)(q0w + r) * q_ld + ks * 16 + h * 8);
    f32x16 o0, o1;
#pragma unroll
    for (int i = 0; i < 16; ++i) { o0[i] = 0.f; o1[i] = 0.f; }
    float m = WIN ? sink_l2 : -1e30f, l = (WIN && h == 0) ? 1.f : 0.f;
    const int kt_lo = WIN ? ((Q0 >> 6) - 2 < 0 ? 0 : (Q0 >> 6) - 2) : 0, kt_hi = (Q0 >> 6) + 1;
#define ATT_STAGE(kt_, buf_) do { unsigned char* bp = smem + (buf_) * BUF; const size_t kb = (size_t)(kt_) * 64; \
        _Pragma("unroll") for (int i = 0; i < (NKS * 2) / 4; ++i) { const int ch = wid + 4 * i; \
            const bf16_t* sp = (ch < 8) ? (K1 + (kb + lane) * k1_ld + ch * 8) : (K2 + (kb + lane) * k2_ld + (ch - 8) * 8); \
            glds16(sp, bp + ch * 1024 + lane * 16); } \
        _Pragma("unroll") for (int i = 0; i < 2; ++i) { const int j = wid + 4 * i; \
            glds16(Vp + (kb + 8 * j + (lane >> 3)) * v_ld + (lane & 7) * 8, bp + KB + j * 1024 + lane * 16); } } while (0)
    ATT_STAGE(kt_lo, 0);
    const int i16 = lane & 15;
    const unsigned vlane = (unsigned)((4 * h + (i16 >> 2)) * 128 + 32 * ((lane >> 4) & 1) + 8 * (i16 & 3));
    for (int kt = kt_lo; kt <= kt_hi; ++kt) {
        const int cur = (kt - kt_lo) & 1;
        asm volatile("s_waitcnt vmcnt(0)" ::: "memory");
        __syncthreads();
        if (kt < kt_hi) ATT_STAGE(kt + 1, cur ^ 1);
        const int k0 = kt * 64;
        const bool active = (k0 <= q0w + 31) && (!WIN || (k0 + 63 > q0w - 128));
        if (active) {
            const unsigned char* Kt = smem + cur * BUF;
            f32x16 x0, x1;
#pragma unroll
            for (int i = 0; i < 16; ++i) { x0[i] = 0.f; x1[i] = 0.f; }
#pragma unroll
            for (int ks = 0; ks < NKS; ++ks) {
                const bf16x8 kf0 = *(const bf16x8*)(Kt + (ks * 2 + h) * 1024 + r * 16);
                const bf16x8 kf1 = *(const bf16x8*)(Kt + (ks * 2 + h) * 1024 + (32 + r) * 16);
                x0 = MFMA32(kf0, qf[ks], x0); x1 = MFMA32(kf1, qf[ks], x1);
            }
            const bool need_mask = (k0 + 63 > q0w) || (WIN && (k0 <= q0w + 31 - 128));
            if (need_mask) {
                const int q = q0w + r;
#pragma unroll
                for (int i = 0; i < 16; ++i) {
                    const int key = k0 + (i & 3) + 8 * (i >> 2) + 4 * h;
                    const bool v0 = (key <= q) && (!WIN || key > q - 128);
                    const bool v1 = (key + 32 <= q) && (!WIN || key + 32 > q - 128);
                    x0[i] = v0 ? x0[i] : -INFINITY; x1[i] = v1 ? x1[i] : -INFINITY;
                }
            }
            float mx = fmaxf(x0[0], x1[0]);
#pragma unroll
            for (int i = 1; i < 16; ++i) mx = fmaxf(mx, fmaxf(x0[i], x1[i]));
            mx = fmaxf(mx, __shfl_xor(mx, 32));
            const float mn = fmaxf(m, mx);
            const float alpha = __builtin_amdgcn_exp2f(m - mn);
            m = mn;
            float ps = 0.f;
#pragma unroll
            for (int i = 0; i < 16; ++i) { x0[i] = __builtin_amdgcn_exp2f(x0[i] - mn); x1[i] = __builtin_amdgcn_exp2f(x1[i] - mn); ps += x0[i] + x1[i]; }
            l = l * alpha + ps;
            o0 *= alpha; o1 *= alpha;
            const unsigned vbase = (unsigned)(size_t)(smem + cur * BUF + KB) + vlane;
#pragma unroll
            for (int t = 0; t < 2; ++t) {
                s16x4 l00, h00, l01, h01, l10, h10, l11, h11;
                const unsigned va = vbase + t * 4096;
                asm volatile("ds_read_b64_tr_b16 %0, %8\n\t"
                             "ds_read_b64_tr_b16 %1, %8 offset:1024\n\t"
                             "ds_read_b64_tr_b16 %2, %8 offset:64\n\t"
                             "ds_read_b64_tr_b16 %3, %8 offset:1088\n\t"
                             "ds_read_b64_tr_b16 %4, %8 offset:2048\n\t"
                             "ds_read_b64_tr_b16 %5, %8 offset:3072\n\t"
                             "ds_read_b64_tr_b16 %6, %8 offset:2112\n\t"
                             "ds_read_b64_tr_b16 %7, %8 offset:3136\n\t"
                             "s_waitcnt lgkmcnt(0)"
                             : "=&v"(l00), "=&v"(h00), "=&v"(l01), "=&v"(h01), "=&v"(l10), "=&v"(h10), "=&v"(l11), "=&v"(h11) : "v"(va) : "memory");
                const bf16x8 v00 = __builtin_shufflevector(l00, h00, 0, 1, 2, 3, 4, 5, 6, 7), v01 = __builtin_shufflevector(l01, h01, 0, 1, 2, 3, 4, 5, 6, 7);
                const bf16x8 v10 = __builtin_shufflevector(l10, h10, 0, 1, 2, 3, 4, 5, 6, 7), v11 = __builtin_shufflevector(l11, h11, 0, 1, 2, 3, 4, 5, 6, 7);
                const bf16x8 pb0 = (t == 0) ? pack_step<0>(x0) : pack_step<0>(x1);
                const bf16x8 pb1 = (t == 0) ? pack_step<1>(x0) : pack_step<1>(x1);
                o0 = MFMA32(v00, pb0, o0); o1 = MFMA32(v01, pb0, o1);
                o0 = MFMA32(v10, pb1, o0); o1 = MFMA32(v11, pb1, o1);
            }
        }
    }
#undef ATT_STAGE
    l += __shfl_xor(l, 32);
    const float inv = 1.f / l;
    bf16_t* orow = Op + (size_t)(q0w + r) * o_ld + 4 * h;
#pragma unroll
    for (int g = 0; g < 4; ++g) {
        *(u32x2*)(orow + 8 * g) = (u32x2){pk2(o0[4 * g] * inv, o0[4 * g + 1] * inv), pk2(o0[4 * g + 2] * inv, o0[4 * g + 3] * inv)};
        *(u32x2*)(orow + 32 + 8 * g) = (u32x2){pk2(o1[4 * g] * inv, o1[4 * g + 1] * inv), pk2(o1[4 * g + 2] * inv, o1[4 * g + 3] * inv)};
    }
}

__device__ __forceinline__ float dppf(float v, int ctrl_sel) {
    int x = __builtin_bit_cast(int, v), r;
    if (ctrl_sel == 0) r = __builtin_amdgcn_update_dpp(0, x, 0xB1, 0xF, 0xF, true);
    else if (ctrl_sel == 1) r = __builtin_amdgcn_update_dpp(0, x, 0x4E, 0xF, 0xF, true);
    else if (ctrl_sel == 2) r = __builtin_amdgcn_update_dpp(0, x, 0x141, 0xF, 0xF, true);
    else r = __builtin_amdgcn_update_dpp(0, x, 0x140, 0xF, 0xF, true);
    return __builtin_bit_cast(float, r);
}
__device__ __forceinline__ float red16(float v) { v += dppf(v, 0); v += dppf(v, 1); v += dppf(v, 2); v += dppf(v, 3); return v; }

__device__ __forceinline__ float red32(float v) {
    v = red16(v);
    float a = v, b = v;
    asm volatile("s_nop 1\n\tv_permlane32_swap_b32 %0, %1\n\ts_nop 1" : "+v"(a), "+v"(b));
    return a + b;
}

__device__ __forceinline__ void gdn_unit2(int u, const bf16_t* GQ, const bf16_t* GK, const bf16_t* GV, const float* BETA, const float* GLOG, float* OG, const Ctx& c) {
    const int sl = u & 15, bh = u >> 4, b = bh >> 2, h = bh & 3;
    const int col = c.wid * 2 + ((c.lane >> 4) & 1), rcx = (c.lane >> 5) * 16 + (c.lane & 15);
    float* kf = (float*)c.smem; float* qf = kf + 32 * 128; float* bvf = qf + 32 * 128; float* baf = bvf + 32 * 8; float* af = baf + 32;
    float S[4];
#pragma unroll
    for (int i = 0; i < 4; ++i) S[i] = 0.f;
    const size_t tb = (size_t)b * SEQ;
    u32x4 rk[2], rq[2], rv; float rbeta = 0.f, rglog = 0.f;
    const int tok0 = c.tid >> 4, chk = c.tid & 15;
#define GDN_LOAD(c0) do { \
        _Pragma("unroll") for (int i = 0; i < 2; ++i) { const size_t t = tb + (c0) + tok0 + 16 * i; \
            rk[i] = *(const u32x4*)(GK + t * 512 + h * 128 + chk * 8); rq[i] = *(const u32x4*)(GQ + t * 512 + h * 128 + chk * 8); } \
        if (c.tid < 32) { const size_t t = tb + (c0) + c.tid; rv = *(const u32x4*)(GV + t * 512 + h * 128 + sl * 8); \
            rbeta = BETA[t * 4 + h]; rglog = GLOG[t * 4 + h]; } } while (0)
    GDN_LOAD(0);
    for (int c0 = 0; c0 < SEQ; c0 += 32) {
        __syncthreads();
#pragma unroll
        for (int i = 0; i < 2; ++i) {
            float f[8]; unpack8(rk[i], f);
            float* d = kf + (tok0 + 16 * i) * 128 + chk * 8;
            *(f32x4*)d = (f32x4){f[0], f[1], f[2], f[3]}; *(f32x4*)(d + 4) = (f32x4){f[4], f[5], f[6], f[7]};
            unpack8(rq[i], f);
            d = qf + (tok0 + 16 * i) * 128 + chk * 8;
            *(f32x4*)d = (f32x4){f[0], f[1], f[2], f[3]}; *(f32x4*)(d + 4) = (f32x4){f[4], f[5], f[6], f[7]};
        }
        if (c.tid < 32) { float f[8]; unpack8(rv, f); float* d = bvf + c.tid * 8;
            *(f32x4*)d = (f32x4){f[0] * rbeta, f[1] * rbeta, f[2] * rbeta, f[3] * rbeta}; *(f32x4*)(d + 4) = (f32x4){f[4] * rbeta, f[5] * rbeta, f[6] * rbeta, f[7] * rbeta};
            const float av = expf(rglog); af[c.tid] = av; baf[c.tid] = av * rbeta; }
        if (c0 + 32 < SEQ) GDN_LOAD(c0 + 32);
        __syncthreads();
        float keep = 0.f;
        f32x4 ka, qa, kb, qb; float aa, baa, bva, ab, bab, bvb;
#define GDN_LD(tt_, K4, Q4, A_, BA_, BV_) do { const int t_ = (tt_) < 32 ? (tt_) : 31; \
            K4 = *(const f32x4*)(kf + t_ * 128 + rcx * 4); Q4 = *(const f32x4*)(qf + t_ * 128 + rcx * 4); \
            A_ = af[t_]; BA_ = baf[t_]; BV_ = bvf[t_ * 8 + col]; } while (0)
#define GDN_STEP(tt_, K4, Q4, A_, BA_, BV_) do { \
            const float part = (K4[0] * S[0] + K4[1] * S[1]) + (K4[2] * S[2] + K4[3] * S[3]); \
            float aS[4]; _Pragma("unroll") for (int i = 0; i < 4; ++i) aS[i] = A_ * S[i]; \
            const float kS = red32(part); const float vn = BV_ - BA_ * kS; \
            _Pragma("unroll") for (int i = 0; i < 4; ++i) S[i] = aS[i] + K4[i] * vn; \
            float po = (Q4[0] * S[0] + Q4[1] * S[1]) + (Q4[2] * S[2] + Q4[3] * S[3]); \
            po = red32(po); keep = (rcx == (tt_)) ? po : keep; } while (0)
        GDN_LD(0, ka, qa, aa, baa, bva);
#pragma unroll 2
        for (int t2 = 0; t2 < 16; ++t2) {
            GDN_LD(2 * t2 + 1, kb, qb, ab, bab, bvb);
            GDN_STEP(2 * t2, ka, qa, aa, baa, bva);
            GDN_LD(2 * t2 + 2, ka, qa, aa, baa, bva);
            GDN_STEP(2 * t2 + 1, kb, qb, ab, bab, bvb);
        }
#undef GDN_LD
#undef GDN_STEP
        OG[(tb + c0 + rcx) * 512 + h * 128 + sl * 8 + col] = keep;
    }
#undef GDN_LOAD
}

__device__ __forceinline__ void mlstm_unit2(int u, const bf16_t* PROJ, const float* GATES, const float* b_i, const float* b_f, float* OG, const Ctx& c) {
    typedef float f32x2 __attribute__((ext_vector_type(2)));
    const int sl = u & 15, bh = u >> 4, b = bh >> 2, h = bh & 3;
    const int col = c.wid * 2 + ((c.lane >> 4) & 1), rcx = (c.lane >> 5) * 16 + (c.lane & 15);
    float* kf = (float*)c.smem; float* qf = kf + 32 * 64; float* vf = qf + 32 * 64; float* fsA = vf + 32 * 8; float* isA = fsA + 32; float* emA = isA + 32;
    float C[2], nn[2];
#pragma unroll
    for (int i = 0; i < 2; ++i) { C[i] = 0.f; nn[i] = 0.f; }
    float mprev = 0.f;
    const size_t tb = (size_t)b * SEQ;
    const float bi = b_i[h], bfv = b_f[h];
    u32x4 rk, rq, rv; float rgi = 0.f, rgf = 0.f;
    const int tok0 = c.tid >> 3, chk = c.tid & 7;
#define ML_LOAD(c0) do { const size_t t = tb + (c0) + tok0; \
        rk = *(const u32x4*)(PROJ + t * NPAD + 256 + h * 64 + chk * 8); rq = *(const u32x4*)(PROJ + t * NPAD + h * 64 + chk * 8); \
        if (c.tid < 64) { const size_t tg = tb + (c0) + (c.tid & 31); rv = *(const u32x4*)(PROJ + tg * NPAD + 512 + h * 128 + sl * 8); \
            rgi = GATES[tg * 8 + h]; rgf = GATES[tg * 8 + 4 + h]; } } while (0)
    ML_LOAD(0);
    for (int c0 = 0; c0 < SEQ; c0 += 32) {
        __syncthreads();
        {
            float f[8]; unpack8(rk, f);
            float* d = kf + tok0 * 64 + chk * 8;
            *(f32x4*)d = (f32x4){f[0], f[1], f[2], f[3]}; *(f32x4*)(d + 4) = (f32x4){f[4], f[5], f[6], f[7]};
            unpack8(rq, f);
            d = qf + tok0 * 64 + chk * 8;
            *(f32x4*)d = (f32x4){f[0], f[1], f[2], f[3]}; *(f32x4*)(d + 4) = (f32x4){f[4], f[5], f[6], f[7]};
        }
        if (c.tid < 64) {
            const int l5 = c.lane & 31;
            const float ipt = rgi + bi, lft = -softplusf_(-(rgf + bfv));
            float F = lft;
#pragma unroll
            for (int o = 1; o < 32; o <<= 1) { const float x = __shfl_up(F, o, 32); if (l5 >= o) F += x; }
            float P = ipt - F;
#pragma unroll
            for (int o = 1; o < 32; o <<= 1) { const float x = __shfl_up(P, o, 32); if (l5 >= o) P = fmaxf(P, x); }
            const float mt = F + fmaxf(mprev, P);
            float mtm1 = __shfl_up(mt, 1, 32); if (l5 == 0) mtm1 = mprev;
            mprev = __shfl(mt, 31, 32);
            if (c.tid < 32) {
                const float isv = expf(ipt - mt) * 0.125f;
                fsA[l5] = expf(lft + mtm1 - mt); isA[l5] = isv; emA[l5] = expf(-mt);
                float f[8]; unpack8(rv, f); float* d = vf + c.tid * 8;
                *(f32x4*)d = (f32x4){f[0] * isv, f[1] * isv, f[2] * isv, f[3] * isv}; *(f32x4*)(d + 4) = (f32x4){f[4] * isv, f[5] * isv, f[6] * isv, f[7] * isv};
            }
        }
        if (c0 + 32 < SEQ) ML_LOAD(c0 + 32);
        __syncthreads();
        float keep = 0.f;
        f32x2 k2a, q2a, k2b, q2b; float fsa, isa, ema, va, fsb, isb, emb, vb;
#define ML_LD(tt_, K2, Q2, FS_, IS_, EM_, V_) do { const int t_ = (tt_) < 32 ? (tt_) : 31; \
            K2 = *(const f32x2*)(kf + t_ * 64 + rcx * 2); Q2 = *(const f32x2*)(qf + t_ * 64 + rcx * 2); \
            FS_ = fsA[t_]; IS_ = isA[t_]; EM_ = emA[t_]; V_ = vf[t_ * 8 + col]; } while (0)
#define ML_STEP(tt_, K2, Q2, FS_, IS_, EM_, V_) do { float pn = 0.f, pd = 0.f; \
            _Pragma("unroll") for (int i = 0; i < 2; ++i) { C[i] = FS_ * C[i] + K2[i] * V_; nn[i] = FS_ * nn[i] + K2[i] * IS_; pn += Q2[i] * C[i]; pd += Q2[i] * nn[i]; } \
            pn = red32(pn); pd = red32(pd); \
            const float hv = pn * __builtin_amdgcn_rcpf(fmaxf(fabsf(pd), EM_)); \
            keep = (rcx == (tt_)) ? hv : keep; } while (0)
        ML_LD(0, k2a, q2a, fsa, isa, ema, va);
#pragma unroll 2
        for (int t2 = 0; t2 < 16; ++t2) {
            ML_LD(2 * t2 + 1, k2b, q2b, fsb, isb, emb, vb);
            ML_STEP(2 * t2, k2a, q2a, fsa, isa, ema, va);
            ML_LD(2 * t2 + 2, k2a, q2a, fsa, isa, ema, va);
            ML_STEP(2 * t2 + 1, k2b, q2b, fsb, isb, emb, vb);
        }
#undef ML_LD
#undef ML_STEP
        OG[(tb + c0 + rcx) * 512 + h * 128 + sl * 8 + col] = keep;
    }
#undef ML_LOAD
}

constexpr size_t MLC_DC = 0, MLC_CS = 33554432, MLC_DN = MLC_CS + 16777216, MLC_NS = MLC_DN + 262144, MLC_ML = MLC_NS + 262144, MLC_BE = MLC_ML + 4096, MLC_MS = MLC_BE + 4096;

__device__ __forceinline__ float scan_add64(float v, int lane) {
#pragma unroll
    for (int o = 1; o < 64; o <<= 1) { const float x = __shfl_up(v, o); if (lane >= o) v += x; }
    return v;
}
__device__ __forceinline__ float scan_max64(float v, int lane) {
#pragma unroll
    for (int o = 1; o < 64; o <<= 1) { const float x = __shfl_up(v, o); if (lane >= o) v = fmaxf(v, x); }
    return v;
}
__device__ __forceinline__ float wave_max(float v) {
#pragma unroll
    for (int o = 32; o > 0; o >>= 1) v = fmaxf(v, __shfl_xor(v, o));
    return v;
}

__device__ __forceinline__ void mlc_passA(int u, const bf16_t* PROJ, const float* GATES, const float* b_i, const float* b_f, unsigned char* YB, const Ctx& c) {
    const int bh = u >> 5, b = bh >> 2, h = bh & 3;
    const size_t t0 = (size_t)b * SEQ + (u & 31) * 64;
    unsigned char* smem = c.smem;
    float* saL = (float*)(smem + 24576);
    const int lane = c.lane, wid = __builtin_amdgcn_readfirstlane(c.wid);
#pragma unroll
    for (int i = 0; i < 4; ++i) { const int j = wid * 4 + i;
        glds16(PROJ + (t0 + 4 * j + (lane >> 4)) * NPAD + 512 + h * 128 + (lane & 15) * 8, smem + 8192 + j * 1024 + lane * 16); }
    if (wid == 0) {
        const float ip = GATES[(t0 + lane) * 8 + h] + b_i[h], lf = -softplusf_(-(GATES[(t0 + lane) * 8 + 4 + h] + b_f[h]));
        const float bc = scan_add64(lf, lane), bend = __shfl(bc, 63);
        const float a = bend - bc + ip, mloc = wave_max(a);
        saL[lane] = expf(a - mloc) * 0.125f;
        if (lane == 0) { ((float*)(YB + MLC_ML))[u] = mloc; ((float*)(YB + MLC_BE))[u] = bend; }
    }
    __syncthreads();
#pragma unroll
    for (int i = 0; i < 2; ++i) {
        const int idx = c.tid + 256 * i, row = idx >> 3, chk = idx & 7;
        const u32x4 r = *(const u32x4*)(PROJ + (t0 + row) * NPAD + 256 + h * 64 + chk * 8);
        float f[8]; unpack8(r, f);
        const float s = saL[row];
        *(u32x4*)(smem + row * 128 + chk * 16) = (u32x4){pk2(f[0] * s, f[1] * s), pk2(f[2] * s, f[3] * s), pk2(f[4] * s, f[5] * s), pk2(f[6] * s, f[7] * s)};
    }
    asm volatile("s_waitcnt vmcnt(0)" ::: "memory");
    __syncthreads();
    const int h5 = lane >> 5, r = lane & 31, i16 = lane & 15, q4 = i16 >> 2, p = i16 & 3, blk = (lane >> 4) & 1;
    const int dkt = wid & 1, dvp = wid >> 1;
    const unsigned kaddr = (unsigned)(size_t)smem + (unsigned)((8 * h5 + q4) * 128 + dkt * 64 + 32 * blk + 8 * p);
    const unsigned vaddr = (unsigned)(size_t)smem + 8192u + (unsigned)((8 * h5 + q4) * 256 + dvp * 128 + 32 * blk + 8 * p);
    f32x16 a0, a1;
#pragma unroll
    for (int i = 0; i < 16; ++i) { a0[i] = 0.f; a1[i] = 0.f; }
#pragma unroll
    for (int st = 0; st < 4; ++st) {
        s16x4 kl, kh, v0l, v0h, v1l, v1h;
        const unsigned ka = kaddr + st * 2048, va = vaddr + st * 4096;
        asm volatile("ds_read_b64_tr_b16 %0, %6\n\t"
                     "ds_read_b64_tr_b16 %1, %6 offset:512\n\t"
                     "ds_read_b64_tr_b16 %2, %7\n\t"
                     "ds_read_b64_tr_b16 %3, %7 offset:1024\n\t"
                     "ds_read_b64_tr_b16 %4, %7 offset:64\n\t"
                     "ds_read_b64_tr_b16 %5, %7 offset:1088\n\t"
                     "s_waitcnt lgkmcnt(0)"
                     : "=&v"(kl), "=&v"(kh), "=&v"(v0l), "=&v"(v0h), "=&v"(v1l), "=&v"(v1h) : "v"(ka), "v"(va) : "memory");
        const bf16x8 kf = __builtin_shufflevector(kl, kh, 0, 1, 2, 3, 4, 5, 6, 7);
        const bf16x8 vf0 = __builtin_shufflevector(v0l, v0h, 0, 1, 2, 3, 4, 5, 6, 7), vf1 = __builtin_shufflevector(v1l, v1h, 0, 1, 2, 3, 4, 5, 6, 7);
        a0 = MFMA32(kf, vf0, a0); a1 = MFMA32(kf, vf1, a1);
    }
    float* DC = (float*)(YB + MLC_DC) + (size_t)u * 8192;
#pragma unroll
    for (int i = 0; i < 16; ++i) {
        const int dk = dkt * 32 + (i & 3) + 8 * (i >> 2) + 4 * h5;
        DC[dk * 128 + dvp * 64 + r] = a0[i]; DC[dk * 128 + dvp * 64 + 32 + r] = a1[i];
    }
    if (c.tid < 64) {
        float s = 0.f;
#pragma unroll 8
        for (int t = 0; t < 64; ++t) s += bf2f(((const bf16_t*)smem)[t * 64 + c.tid]);
        ((float*)(YB + MLC_DN))[(size_t)u * 64 + c.tid] = s;
    }
}

__device__ __forceinline__ void mlc_passB(int u, unsigned char* YB, const Ctx& c) {
    const int bh = u >> 3, sl = u & 7;
    const float* ML = (const float*)(YB + MLC_ML) + bh * 32; const float* BE = (const float*)(YB + MLC_BE) + bh * 32;
    const float* DC = (const float*)(YB + MLC_DC) + (size_t)bh * 32 * 8192 + sl * 1024 + c.tid * 4;
    bf16_t* CS = (bf16_t*)(YB + MLC_CS) + (size_t)bh * 32 * 8192 + sl * 1024 + c.tid * 4;
    const float* DN = (const float*)(YB + MLC_DN) + (size_t)bh * 32 * 64; float* NS = (float*)(YB + MLC_NS) + (size_t)bh * 32 * 64; float* MS = (float*)(YB + MLC_MS) + bh * 32;
    f32x4 C4 = (f32x4){0.f, 0.f, 0.f, 0.f}; float nv = 0.f, m = 0.f;
    const bool do_n = (sl == 0) && (c.tid < 64);
#pragma unroll 4
    for (int n = 0; n < 32; ++n) {
        *(u32x2*)(CS + (size_t)n * 8192) = (u32x2){pk2(C4[0], C4[1]), pk2(C4[2], C4[3])};
        if (do_n) NS[n * 64 + c.tid] = nv;
        if (sl == 0 && c.tid == 0) MS[n] = m;
        const float be = BE[n], ml = ML[n];
        const float mn = fmaxf(be + m, ml), keep = expf(be + m - mn), g = expf(ml - mn);
        m = mn;
        const f32x4 d = *(const f32x4*)(DC + (size_t)n * 8192);
        C4 = C4 * keep + d * g;
        if (do_n) nv = nv * keep + DN[n * 64 + c.tid] * g;
    }
}

__device__ __forceinline__ void mlc_passC(int u, const bf16_t* PROJ, const float* GATES, const float* b_i, const float* b_f, const unsigned char* YB,
                                          const float* gain  , bf16_t* MIXO, const Ctx& c) {
    const int bh = u >> 5, b = bh >> 2, h = bh & 3;
    const size_t t0 = (size_t)b * SEQ + (u & 31) * 64;
    unsigned char* smem = c.smem;
    float* csL = (float*)(smem + 32768); float* pmL = (float*)(smem + 33024); float* bcL = (float*)(smem + 33280); float* nnL = (float*)(smem + 33536); float* sqL = (float*)(smem + 33792);
    const int lane = c.lane, wid = __builtin_amdgcn_readfirstlane(c.wid);
    const bf16_t* CS = (const bf16_t*)(YB + MLC_CS) + (size_t)u * 8192;
#pragma unroll
    for (int i = 0; i < 4; ++i) { const int j = wid * 4 + i;
        glds16(PROJ + (t0 + 4 * j + (lane >> 4)) * NPAD + 512 + h * 128 + (lane & 15) * 8, smem + j * 1024 + lane * 16);
        glds16(CS + (4 * j + (lane >> 4)) * 128 + (lane & 15) * 8, smem + 16384 + j * 1024 + lane * 16); }
    float bcl = 0.f;
    if (wid == 0) {
        const float ip = GATES[(t0 + lane) * 8 + h] + b_i[h], lf = -softplusf_(-(GATES[(t0 + lane) * 8 + 4 + h] + b_f[h]));
        bcl = scan_add64(lf, lane);
        const float cs = ip - bcl;
        csL[lane] = cs; pmL[lane] = scan_max64(cs, lane);
        nnL[lane] = ((const float*)(YB + MLC_NS))[(size_t)u * 64 + lane];
        bcL[lane] = bcl;
    }
    asm volatile("s_waitcnt vmcnt(0)" ::: "memory");
    __syncthreads();
    const int h5 = lane >> 5, r = lane & 31, i16 = lane & 15, q4 = i16 >> 2, p = i16 & 3, blk = (lane >> 4) & 1;
    const int th = wid & 1, dvh = wid >> 1;
    const int t = th * 32 + r;
    const float m_n = ((const float*)(YB + MLC_MS))[u];
    const float Mt = fmaxf(m_n, pmL[t]), w_inter = __expf(m_n - Mt), em = __expf(-(bcL[t] + Mt));
    bf16x8 qf[4];
#pragma unroll
    for (int ks = 0; ks < 4; ++ks) qf[ks] = *(const bf16x8*)(PROJ + (t0 + t) * NPAD + h * 64 + ks * 16 + h5 * 8);
    float qn = 0.f; bf16x8 qw[4];
#pragma unroll
    for (int ks = 0; ks < 4; ++ks) {
        const u32x4 raw = __builtin_bit_cast(u32x4, qf[ks]); float f[8]; unpack8(raw, f);
#pragma unroll
        for (int j = 0; j < 8; ++j) qn += f[j] * nnL[ks * 16 + h5 * 8 + j];
        qw[ks] = __builtin_bit_cast(bf16x8, (u32x4){pk2(f[0] * w_inter, f[1] * w_inter), pk2(f[2] * w_inter, f[3] * w_inter), pk2(f[4] * w_inter, f[5] * w_inter), pk2(f[6] * w_inter, f[7] * w_inter)});
    }
    qn += __shfl_xor(qn, 32);
    f32x16 x0, x1;
#pragma unroll
    for (int i = 0; i < 16; ++i) { x0[i] = 0.f; x1[i] = 0.f; }
#pragma unroll
    for (int ks = 0; ks < 4; ++ks) {
        const bf16x8 kf0 = *(const bf16x8*)(PROJ + (t0 + r) * NPAD + 256 + h * 64 + ks * 16 + h5 * 8);
        x0 = MFMA32(kf0, qf[ks], x0);
        if (th) { const bf16x8 kf1 = *(const bf16x8*)(PROJ + (t0 + 32 + r) * NPAD + 256 + h * 64 + ks * 16 + h5 * 8); x1 = MFMA32(kf1, qf[ks], x1); }
    }
    float ps = 0.f;
#pragma unroll
    for (int i = 0; i < 16; ++i) {
        const int s = (i & 3) + 8 * (i >> 2) + 4 * h5;
        const float w0 = (s <= t) ? __expf(csL[s] - Mt) * 0.125f : 0.f;
        x0[i] *= w0; ps += x0[i];
        if (th) { const float w1 = (s <= r) ? __expf(csL[32 + s] - Mt) * 0.125f : 0.f; x1[i] *= w1; ps += x1[i]; }
    }
    ps += __shfl_xor(ps, 32);
    const float den = w_inter * qn + ps;
    f32x16 o0, o1;
#pragma unroll
    for (int i = 0; i < 16; ++i) { o0[i] = 0.f; o1[i] = 0.f; }
    {
        const unsigned vb = (unsigned)(size_t)smem + (unsigned)((4 * h5 + q4) * 256 + dvh * 128 + 32 * blk + 8 * p);
#pragma unroll
        for (int st = 0; st < 2; ++st) {
            if (st == 0 || th) {
                s16x4 l00, h00, l01, h01, l10, h10, l11, h11;
                const unsigned va = vb + st * 8192;
                asm volatile("ds_read_b64_tr_b16 %0, %8\n\t"
                             "ds_read_b64_tr_b16 %1, %8 offset:2048\n\t"
                             "ds_read_b64_tr_b16 %2, %8 offset:64\n\t"
                             "ds_read_b64_tr_b16 %3, %8 offset:2112\n\t"
                             "ds_read_b64_tr_b16 %4, %8 offset:4096\n\t"
                             "ds_read_b64_tr_b16 %5, %8 offset:6144\n\t"
                             "ds_read_b64_tr_b16 %6, %8 offset:4160\n\t"
                             "ds_read_b64_tr_b16 %7, %8 offset:6208\n\t"
                             "s_waitcnt lgkmcnt(0)"
                             : "=&v"(l00), "=&v"(h00), "=&v"(l01), "=&v"(h01), "=&v"(l10), "=&v"(h10), "=&v"(l11), "=&v"(h11) : "v"(va) : "memory");
                const bf16x8 v00 = __builtin_shufflevector(l00, h00, 0, 1, 2, 3, 4, 5, 6, 7), v01 = __builtin_shufflevector(l01, h01, 0, 1, 2, 3, 4, 5, 6, 7);
                const bf16x8 v10 = __builtin_shufflevector(l10, h10, 0, 1, 2, 3, 4, 5, 6, 7), v11 = __builtin_shufflevector(l11, h11, 0, 1, 2, 3, 4, 5, 6, 7);
                const bf16x8 pb0 = (st == 0) ? pack_step<0>(x0) : pack_step<0>(x1);
                const bf16x8 pb1 = (st == 0) ? pack_step<1>(x0) : pack_step<1>(x1);
                o0 = MFMA32(v00, pb0, o0); o1 = MFMA32(v01, pb0, o1);
                o0 = MFMA32(v10, pb1, o0); o1 = MFMA32(v11, pb1, o1);
            }
        }
    }
    {
        const unsigned cb = (unsigned)(size_t)smem + 16384u + (unsigned)((8 * h5 + q4) * 256 + dvh * 128 + 32 * blk + 8 * p);
#pragma unroll
        for (int kp = 0; kp < 2; ++kp) {
            s16x4 l00, h00, l01, h01, l10, h10, l11, h11;
            const unsigned ca = cb + kp * 8192;
            asm volatile("ds_read_b64_tr_b16 %0, %8\n\t"
                         "ds_read_b64_tr_b16 %1, %8 offset:1024\n\t"
                         "ds_read_b64_tr_b16 %2, %8 offset:64\n\t"
                         "ds_read_b64_tr_b16 %3, %8 offset:1088\n\t"
                         "ds_read_b64_tr_b16 %4, %8 offset:4096\n\t"
                         "ds_read_b64_tr_b16 %5, %8 offset:5120\n\t"
                         "ds_read_b64_tr_b16 %6, %8 offset:4160\n\t"
                         "ds_read_b64_tr_b16 %7, %8 offset:5184\n\t"
                         "s_waitcnt lgkmcnt(0)"
                         : "=&v"(l00), "=&v"(h00), "=&v"(l01), "=&v"(h01), "=&v"(l10), "=&v"(h10), "=&v"(l11), "=&v"(h11) : "v"(ca) : "memory");
            const bf16x8 c00 = __builtin_shufflevector(l00, h00, 0, 1, 2, 3, 4, 5, 6, 7), c01 = __builtin_shufflevector(l01, h01, 0, 1, 2, 3, 4, 5, 6, 7);
            const bf16x8 c10 = __builtin_shufflevector(l10, h10, 0, 1, 2, 3, 4, 5, 6, 7), c11 = __builtin_shufflevector(l11, h11, 0, 1, 2, 3, 4, 5, 6, 7);
            o0 = MFMA32(c00, qw[2 * kp], o0); o1 = MFMA32(c01, qw[2 * kp], o1);
            o0 = MFMA32(c10, qw[2 * kp + 1], o0); o1 = MFMA32(c11, qw[2 * kp + 1], o1);
        }
    }
    const float inv = __builtin_amdgcn_rcpf(fmaxf(fabsf(den), em));
    float ss = 0.f;
#pragma unroll
    for (int i = 0; i < 16; ++i) { o0[i] *= inv; o1[i] *= inv; ss += o0[i] * o0[i] + o1[i] * o1[i]; }
    ss += __shfl_xor(ss, 32);
    if (h5 == 0) sqL[wid * 32 + r] = ss;
    __syncthreads();
    const float rr = rsqrtf((sqL[th * 32 + r] + sqL[(th + 2) * 32 + r]) * (1.f / 128.f) + 1e-6f);
    const bf16_t* grow = PROJ + (t0 + t) * NPAD + 1032 + h * 128 + dvh * 64 + 4 * h5;
    const float* gn = gain + h * 128 + dvh * 64 + 4 * h5;
    bf16_t* orow = MIXO + (t0 + t) * 1024 + h * 128 + dvh * 64 + 4 * h5;
#pragma unroll
    for (int d = 0; d < 2; ++d)
#pragma unroll
        for (int g = 0; g < 4; ++g) {
            const u32x2 zr = *(const u32x2*)(grow + d * 32 + 8 * g);
            const f32x4 gv = *(const f32x4*)(gn + d * 32 + 8 * g);
            const float z0 = bflo(zr.x), z1 = bfhi(zr.x), z2 = bflo(zr.y), z3 = bfhi(zr.y);
            const float y0 = (d ? o1[4 * g] : o0[4 * g]) * rr * gv[0] * sigmoidf_(z0), y1 = (d ? o1[4 * g + 1] : o0[4 * g + 1]) * rr * gv[1] * sigmoidf_(z1);
            const float y2 = (d ? o1[4 * g + 2] : o0[4 * g + 2]) * rr * gv[2] * sigmoidf_(z2), y3 = (d ? o1[4 * g + 3] : o0[4 * g + 3]) * rr * gv[3] * sigmoidf_(z3);
            *(u32x2*)(orow + d * 32 + 8 * g) = (u32x2){pk2(y0, y1), pk2(y2, y3)};
        }
}

constexpr size_t GD_WN = 0, GD_UU = GD_WN + (size_t)1024 * 16384, GD_KGT = GD_UU + (size_t)1024 * 16384, GD_QG = GD_KGT + (size_t)1024 * 16384,
                 GD_AT = GD_QG + (size_t)1024 * 16384, GD_GL = GD_AT + (size_t)1024 * 8192, GD_END = GD_GL + 4096;
static_assert(GD_END <= (size_t)MAXROWS * 256 * 2, "GDN chunk records must fit the HBUF region");

__device__ __forceinline__ void gdc_passA(int u, const bf16_t* GQ, const bf16_t* GK, const bf16_t* GV, const float* BETA, const float* GLOG, unsigned char* HB, const Ctx& c) {
    const int bh = u >> 5, b = bh >> 2, h = bh & 3;
    const size_t t0 = (size_t)b * SEQ + (u & 31) * 64;
    unsigned char* smem = c.smem;
    float* Lm = (float*)(smem + 49152);
    float* GA = (float*)(smem + 65536 + 64); float* BT = GA + 64; float* EG = BT + 64; float* EK = EG + 64;
    const int lane = c.lane, wid = __builtin_amdgcn_readfirstlane(c.wid);
    const int h5 = lane >> 5, r = lane & 31;
    if (wid == 0) {
        const float g = GLOG[(t0 + lane) * 4 + h];
        const float G = scan_add64(g, lane), Gl = __shfl(G, 63);
        GA[lane] = G; BT[lane] = BETA[(t0 + lane) * 4 + h]; EG[lane] = expf(G); EK[lane] = expf(Gl - G);
        if (lane == 0) ((float*)(HB + GD_GL))[u] = expf(Gl);
    }
    __syncthreads();
    if (wid < 3) {
        const int it = (wid + 1) >> 1, jt = wid >> 1;
        f32x16 dl, da;
#pragma unroll
        for (int i = 0; i < 16; ++i) { dl[i] = 0.f; da[i] = 0.f; }
#pragma unroll
        for (int ks = 0; ks < 8; ++ks) {
            const bf16x8 ki = *(const bf16x8*)(GK + (t0 + 32 * it + r) * 512 + h * 128 + ks * 16 + h5 * 8);
            const bf16x8 kj = *(const bf16x8*)(GK + (t0 + 32 * jt + r) * 512 + h * 128 + ks * 16 + h5 * 8);
            const bf16x8 qi = *(const bf16x8*)(GQ + (t0 + 32 * it + r) * 512 + h * 128 + ks * 16 + h5 * 8);
            dl = MFMA32(ki, kj, dl); da = MFMA32(qi, kj, da);
        }
        const int j = 32 * jt + r; const float Gj = GA[j];
        bf16_t* AT = (bf16_t*)(HB + GD_AT) + (size_t)u * 4096;
#pragma unroll
        for (int i = 0; i < 16; ++i) {
            const int ii = 32 * it + (i & 3) + 8 * (i >> 2) + 4 * h5;
            const float dec = __expf(GA[ii] - Gj);
            Lm[ii * 64 + j] = (j < ii) ? dl[i] * BT[ii] * dec : 0.f;
            AT[ii * 64 + j] = (bf16_t)f2bf((j <= ii) ? da[i] * dec : 0.f);
        }
        if (wid == 0) {
#pragma unroll
            for (int i = 0; i < 16; ++i) { const int ii = (i & 3) + 8 * (i >> 2) + 4 * h5; Lm[ii * 64 + 32 + r] = 0.f; AT[ii * 64 + 32 + r] = 0; }
        }
    }
    __syncthreads();
    if (wid == 0) {
        float Tc[64];
#pragma unroll
        for (int i = 0; i < 64; ++i) {
            float s = (i == lane) ? 1.f : 0.f;
#pragma unroll
            for (int k = 0; k < i; ++k) s -= Lm[i * 64 + k] * Tc[k];
            Tc[i] = s;
        }
        bf16_t* Tm = (bf16_t*)Lm;
#pragma unroll
        for (int i = 0; i < 64; ++i) Tm[i * 64 + lane] = (bf16_t)f2bf(Tc[i]);
    } else {
        const int t3 = c.tid - 64;
        for (int idx = t3; idx < 4096; idx += 192) {
            const int arr = idx >> 10, rem = idx & 1023, row = rem >> 4, chk = rem & 15;
            const bf16_t* sp = ((arr == 1) ? GV : (arr == 3) ? GQ : GK) + (t0 + row) * 512 + h * 128 + chk * 8;
            const u32x4 raw = *(const u32x4*)sp; float f[8]; unpack8(raw, f);
            const float sc = (arr == 0) ? BT[row] * EG[row] : (arr == 1) ? BT[row] : (arr == 2) ? EK[row] : EG[row];
            const u32x4 o = (u32x4){pk2(f[0] * sc, f[1] * sc), pk2(f[2] * sc, f[3] * sc), pk2(f[4] * sc, f[5] * sc), pk2(f[6] * sc, f[7] * sc)};
            if (arr < 3) *(u32x4*)(smem + arr * 16384 + row * 256 + chk * 16) = o;
            else *(u32x4*)((bf16_t*)(HB + GD_QG) + (size_t)u * 8192 + row * 128 + chk * 8) = o;
        }
    }
    __syncthreads();
    {
        const int i16 = lane & 15, q4 = i16 >> 2, p = i16 & 3, blk = (lane >> 4) & 1;
        const unsigned char* Tm = smem + 49152;
        f32x16 u0, u1, w0, w1;
#pragma unroll
        for (int i = 0; i < 16; ++i) { u0[i] = 0.f; u1[i] = 0.f; w0[i] = 0.f; w1[i] = 0.f; }
        const unsigned ib = (unsigned)(size_t)smem + (unsigned)((8 * h5 + q4) * 256 + wid * 64 + 32 * blk + 8 * p);
#pragma unroll
        for (int ks = 0; ks < 4; ++ks) {
            s16x4 kl, kh, vl, vh;
            const unsigned ia = ib + ks * 4096;
            asm volatile("ds_read_b64_tr_b16 %0, %4\n\t"
                         "ds_read_b64_tr_b16 %1, %4 offset:1024\n\t"
                         "ds_read_b64_tr_b16 %2, %4 offset:16384\n\t"
                         "ds_read_b64_tr_b16 %3, %4 offset:17408\n\t"
                         "s_waitcnt lgkmcnt(0)"
                         : "=&v"(kl), "=&v"(kh), "=&v"(vl), "=&v"(vh) : "v"(ia) : "memory");
            const bf16x8 kb = __builtin_shufflevector(kl, kh, 0, 1, 2, 3, 4, 5, 6, 7), vb = __builtin_shufflevector(vl, vh, 0, 1, 2, 3, 4, 5, 6, 7);
            const bf16x8 t1 = *(const bf16x8*)(Tm + (32 + r) * 128 + ks * 32 + h5 * 16);
            w1 = MFMA32(t1, kb, w1); u1 = MFMA32(t1, vb, u1);
            if (ks < 2) { const bf16x8 tt0 = *(const bf16x8*)(Tm + r * 128 + ks * 32 + h5 * 16); w0 = MFMA32(tt0, kb, w0); u0 = MFMA32(tt0, vb, u0); }
        }
        bf16_t* WN = (bf16_t*)(HB + GD_WN) + (size_t)u * 8192; bf16_t* UU = (bf16_t*)(HB + GD_UU) + (size_t)u * 8192;
#pragma unroll
        for (int i = 0; i < 16; ++i) {
            const int s = (i & 3) + 8 * (i >> 2) + 4 * h5;
            WN[s * 128 + wid * 32 + r] = (bf16_t)f2bf(-w0[i]); WN[(32 + s) * 128 + wid * 32 + r] = (bf16_t)f2bf(-w1[i]);
        }
        {
            u32x4* up = (u32x4*)(UU + (size_t)(wid * 64 + lane) * 32);
            up[0] = (u32x4){pk2(u0[0], u0[1]), pk2(u0[2], u0[3]), pk2(u0[4], u0[5]), pk2(u0[6], u0[7])};
            up[1] = (u32x4){pk2(u0[8], u0[9]), pk2(u0[10], u0[11]), pk2(u0[12], u0[13]), pk2(u0[14], u0[15])};
            up[2] = (u32x4){pk2(u1[0], u1[1]), pk2(u1[2], u1[3]), pk2(u1[4], u1[5]), pk2(u1[6], u1[7])};
            up[3] = (u32x4){pk2(u1[8], u1[9]), pk2(u1[10], u1[11]), pk2(u1[12], u1[13]), pk2(u1[14], u1[15])};
        }
        bf16_t* KGT = (bf16_t*)(HB + GD_KGT) + (size_t)u * 8192;
        const int gq = lane >> 4;
        const unsigned kb0 = (unsigned)(size_t)smem + 32768u + (unsigned)(q4 * 256 + gq * 32 + 8 * p);
#pragma unroll
        for (int it2 = 0; it2 < 8; ++it2) {
            const int job = wid * 8 + it2, s0 = (job & 15) * 4, dkb = (job >> 4) * 64;
            s16x4 v;
            const unsigned ad = kb0 + s0 * 256 + dkb * 2;
            asm volatile("ds_read_b64_tr_b16 %0, %1\n\ts_waitcnt lgkmcnt(0)" : "=&v"(v) : "v"(ad) : "memory");
            *(s16x4*)(KGT + (size_t)(dkb + gq * 16 + i16) * 64 + s0) = v;
        }
    }
}

__device__ __forceinline__ void gdc_passB(int bh, const unsigned char* HB, float* OG, const Ctx& c) {
    const int b = bh >> 2, h = bh & 3;
    const int lane = c.lane, wid = __builtin_amdgcn_readfirstlane(c.wid);
    const int h5 = lane >> 5, r = lane & 31;
    unsigned char* smem = c.smem;
    f32x16 S0, S1, S2, S3;
#pragma unroll
    for (int i = 0; i < 16; ++i) { S0[i] = 0.f; S1[i] = 0.f; S2[i] = 0.f; S3[i] = 0.f; }
    const size_t u0 = (size_t)bh * 32;
#define GB_STAGE0(n_) do { const bf16_t* wn_ = (const bf16_t*)(HB + GD_WN) + (u0 + (n_)) * 8192; const bf16_t* qg_ = (const bf16_t*)(HB + GD_QG) + (u0 + (n_)) * 8192; \
        _Pragma("unroll") for (int i = 0; i < 8; ++i) { const int j = wid * 8 + i, jj = j & 15, row = 4 * jj + (lane >> 4), ch = (lane & 15) ^ (row & 15); \
            glds16(((j >> 4) ? qg_ : wn_) + row * 128 + ch * 8, smem + (j >> 4) * 16384 + jj * 1024 + lane * 16); } } while (0)
#define GB_STAGE1(n_) do { const bf16_t* kg_ = (const bf16_t*)(HB + GD_KGT) + (u0 + (n_)) * 8192; const bf16_t* at_ = (const bf16_t*)(HB + GD_AT) + (u0 + (n_)) * 4096; \
        _Pragma("unroll") for (int i = 0; i < 6; ++i) { const int j = wid * 6 + i, isat = (j >= 16), jj = isat ? j - 16 : j, row = 8 * jj + (lane >> 3), ch = (lane & 7) ^ ((row >> 1) & 7); \
            glds16((isat ? at_ : kg_) + row * 64 + ch * 8, smem + 32768 + isat * 16384 + jj * 1024 + lane * 16); } } while (0)
#define LD128(base_, R_, ks_) __builtin_shufflevector(*(const s16x4*)((base_) + (R_) * 256 + (((2 * (ks_)) ^ (rl & 15)) << 4) + 8 * hl), \
                                                      *(const s16x4*)((base_) + (R_) * 256 + (((2 * (ks_) + 1) ^ (rl & 15)) << 4) + 8 * hl), 0, 1, 2, 3, 4, 5, 6, 7)
#define LD64(base_, R_, k2_) __builtin_shufflevector(*(const s16x4*)((base_) + (R_) * 128 + (((2 * (k2_)) ^ ((rl >> 1) & 7)) << 4) + 8 * hl), \
                                                     *(const s16x4*)((base_) + (R_) * 128 + (((2 * (k2_) + 1) ^ ((rl >> 1) & 7)) << 4) + 8 * hl), 0, 1, 2, 3, 4, 5, 6, 7)
    u32x4 uu[4];
#define GB_LOADU(n_) do { const u32x4* up_ = (const u32x4*)((const bf16_t*)(HB + GD_UU) + (u0 + (n_)) * 8192 + (size_t)(wid * 64 + lane) * 32); \
        uu[0] = up_[0]; uu[1] = up_[1]; uu[2] = up_[2]; uu[3] = up_[3]; } while (0)
    __syncthreads();
    GB_STAGE0(0);
    GB_LOADU(0);
#pragma unroll 1
    for (int n = 0; n < 32; ++n) {
        const float gl = ((const float*)(HB + GD_GL))[u0 + n];
        const size_t t0 = (size_t)b * SEQ + n * 64;
        asm volatile("s_waitcnt vmcnt(0)" ::: "memory");
        __syncthreads();
        GB_STAGE1(n);
        int rl = r, hl = h5; asm volatile("" : "+v"(rl), "+v"(hl));
        f32x16 v0, v1;
#pragma unroll
        for (int q = 0; q < 2; ++q) {
            const u32x4 a = uu[q], bq = uu[2 + q];
            v0[8 * q + 0] = bflo(a.x); v0[8 * q + 1] = bfhi(a.x); v0[8 * q + 2] = bflo(a.y); v0[8 * q + 3] = bfhi(a.y);
            v0[8 * q + 4] = bflo(a.z); v0[8 * q + 5] = bfhi(a.z); v0[8 * q + 6] = bflo(a.w); v0[8 * q + 7] = bfhi(a.w);
            v1[8 * q + 0] = bflo(bq.x); v1[8 * q + 1] = bfhi(bq.x); v1[8 * q + 2] = bflo(bq.y); v1[8 * q + 3] = bfhi(bq.y);
            v1[8 * q + 4] = bflo(bq.z); v1[8 * q + 5] = bfhi(bq.z); v1[8 * q + 6] = bflo(bq.w); v1[8 * q + 7] = bfhi(bq.w);
        }
#define KS_V(SX, HF, ks_) do { const bf16x8 sbk = pack_step<HF>(SX); \
            v0 = MFMA32(LD128(smem, rl, ks_), sbk, v0); v1 = MFMA32(LD128(smem, 32 + rl, ks_), sbk, v1); } while (0)
        KS_V(S0, 0, 0); KS_V(S0, 1, 1); asm volatile("" ::: "memory"); KS_V(S1, 0, 2); KS_V(S1, 1, 3); asm volatile("" ::: "memory");
        KS_V(S2, 0, 4); KS_V(S2, 1, 5); asm volatile("" ::: "memory"); KS_V(S3, 0, 6); KS_V(S3, 1, 7);
#undef KS_V
        const bf16x8 vb0 = pack_step_m<0>(v0), vb1 = pack_step_m<1>(v0), vb2 = pack_step_m<0>(v1), vb3 = pack_step_m<1>(v1);
        asm volatile("" ::: "memory"); asm volatile("" : "+v"(rl), "+v"(hl));
        f32x16 o0, o1;
#pragma unroll
        for (int i = 0; i < 16; ++i) { o0[i] = 0.f; o1[i] = 0.f; }
#define KS_O(SX, HF, ks_) do { const bf16x8 sbk = pack_step<HF>(SX); \
            o0 = MFMA32(LD128(smem + 16384, rl, ks_), sbk, o0); o1 = MFMA32(LD128(smem + 16384, 32 + rl, ks_), sbk, o1); } while (0)
        KS_O(S0, 0, 0); KS_O(S0, 1, 1); asm volatile("" ::: "memory"); KS_O(S1, 0, 2); KS_O(S1, 1, 3); asm volatile("" ::: "memory");
        KS_O(S2, 0, 4); KS_O(S2, 1, 5); asm volatile("" ::: "memory"); KS_O(S3, 0, 6); KS_O(S3, 1, 7);
#undef KS_O
        asm volatile("s_waitcnt vmcnt(0)" ::: "memory");
        __syncthreads();
        if (n + 1 < 32) { GB_STAGE0(n + 1); GB_LOADU(n + 1); }
        asm volatile("" : "+v"(rl), "+v"(hl));
        o0 = MFMA32(LD64(smem + 49152, rl, 0), vb0, o0); o0 = MFMA32(LD64(smem + 49152, rl, 1), vb1, o0);
        o1 = MFMA32(LD64(smem + 49152, 32 + rl, 0), vb0, o1); o1 = MFMA32(LD64(smem + 49152, 32 + rl, 1), vb1, o1);
        o1 = MFMA32(LD64(smem + 49152, 32 + rl, 2), vb2, o1); o1 = MFMA32(LD64(smem + 49152, 32 + rl, 3), vb3, o1);
#pragma unroll
        for (int i = 0; i < 16; ++i) {
            const int t = (i & 3) + 8 * (i >> 2) + 4 * h5;
            OG[(t0 + t) * 512 + h * 128 + wid * 32 + r] = o0[i]; OG[(t0 + 32 + t) * 512 + h * 128 + wid * 32 + r] = o1[i];
        }
        asm volatile("" : "+v"(rl), "+v"(hl));
        S0 *= gl; S1 *= gl; S2 *= gl; S3 *= gl;
#define SUPD(SX, dt_) do { SX = MFMA32(LD64(smem + 32768, (dt_) * 32 + rl, 0), vb0, SX); SX = MFMA32(LD64(smem + 32768, (dt_) * 32 + rl, 1), vb1, SX); \
            SX = MFMA32(LD64(smem + 32768, (dt_) * 32 + rl, 2), vb2, SX); SX = MFMA32(LD64(smem + 32768, (dt_) * 32 + rl, 3), vb3, SX); } while (0)
        SUPD(S0, 0); asm volatile("" ::: "memory"); SUPD(S1, 1); asm volatile("" ::: "memory"); SUPD(S2, 2); asm volatile("" ::: "memory"); SUPD(S3, 3);
#undef SUPD
    }
#undef GB_STAGE0
#undef GB_STAGE1
#undef LD128
#undef LD64
#undef GB_LOADU
}

__device__ __forceinline__ void phase_post(const float* OG, const bf16_t* PROJ, const float* gain, bool odd, bf16_t* MIXO, const Ctx& c) {
    const int lane = c.lane;
    const int gcol = odd ? 1032 : 1960, ocol = odd ? 0 : 512;
    for (int t = c.bid * 4 + c.wid; t < T; t += c.nblk * 4) {
        const f32x4 a0 = *(const f32x4*)(OG + (size_t)t * 512 + lane * 8), a1 = *(const f32x4*)(OG + (size_t)t * 512 + lane * 8 + 4);
        float ss = (a0[0] * a0[0] + a0[1] * a0[1]) + (a0[2] * a0[2] + a0[3] * a0[3]) + (a1[0] * a1[0] + a1[1] * a1[1]) + (a1[2] * a1[2] + a1[3] * a1[3]);
        ss = red16(ss);
        const float rr = rsqrtf(ss * (1.f / 128.f) + 1e-6f);
        const u32x4 zr = *(const u32x4*)(PROJ + (size_t)t * NPAD + gcol + lane * 8);
        float z[8]; unpack8(zr, z);
        const int gi = odd ? lane * 8 : (lane & 15) * 8;
        const f32x4 g0 = *(const f32x4*)(gain + gi), g1 = *(const f32x4*)(gain + gi + 4);
        float y[8];
#pragma unroll
        for (int j = 0; j < 4; ++j) {
            const float ga = odd ? sigmoidf_(z[j]) : siluf_(z[j]), gb = odd ? sigmoidf_(z[4 + j]) : siluf_(z[4 + j]);
            y[j] = a0[j] * rr * g0[j] * ga; y[4 + j] = a1[j] * rr * g1[j] * gb;
        }
        *(u32x4*)(MIXO + (size_t)t * 1024 + ocol + lane * 8) = (u32x4){pk2(y[0], y[1]), pk2(y[2], y[3]), pk2(y[4], y[5]), pk2(y[6], y[7])};
    }
}

__global__ void __launch_bounds__(256, 2) fwd(Args a) {
    extern __shared__ __attribute__((aligned(16))) unsigned char smem[];
    Ctx c;
    c.tid = threadIdx.x; c.lane = c.tid & 63; c.wid = c.tid >> 6; c.wr = c.wid >> 1; c.wc = c.wid & 1; c.fr = c.lane & 15; c.fq = c.lane >> 4;
    c.bid = blockIdx.x; c.nblk = gridDim.x; c.smem = smem;
#define PH_CTX() do { int t_ = threadIdx.x; asm volatile("" : "+v"(t_)); c.tid = t_; c.lane = t_ & 63; c.wid = t_ >> 6; c.wr = c.wid >> 1; c.wc = c.wid & 1; c.fr = c.lane & 15; c.fq = c.lane >> 4; } while (0)
    unsigned char* ws = a.ws;
    unsigned* ctl = (unsigned*)(ws + WS_CTL);
    volatile LAS unsigned* xbw = (volatile LAS unsigned*)(smem + 65536);
    if (c.tid < 8) xbw[c.tid] = 0u;
    __syncthreads();
    XcdBarrier bar; bar.bar = ctl; bar.x = 0; bar.st = xbw;
    if (a.use_bar) bar = xcd_barrier_post(ctl, xbw);
    const int lo = a.ph_lo, hi = a.ph_hi;
#define IN(k) (lo <= (k) && (k) < hi)
#define PH(k) if (IN(k)) { PH_CTX();
#define UNIT_CTX() Ctx cu = c; do { int t_ = c.tid; asm volatile("" : "+v"(t_)); cu.tid = t_; cu.lane = t_ & 63; cu.wid = t_ >> 6; cu.wr = cu.wid >> 1; cu.wc = cu.wid & 1; cu.fr = cu.lane & 15; cu.fq = cu.lane >> 4; } while (0)
#define SEAM(k) do { if ((k) + 1 < hi) xcd_barrier(bar); } while (0)

    bf16_t* XBF = (bf16_t*)(ws + WS_XBF);
    float* X1 = (float*)(ws + WS_X1);
    bf16_t* PROJ = (bf16_t*)(ws + U_PROJ);
    float* GATES = (float*)(ws + U_GATES);
    bf16_t* MIXO = (bf16_t*)(ws + U_MIXO);
    float* YBUF = (float*)(ws + U_YBUF);
    const float* ROPEM = (const float*)(ws + WS_ROPEM);
    const float* ROPES = (const float*)(ws + WS_ROPES);

    PH(0) for (int rep = 0; rep < REP_PRO; ++rep) phase_prologue(a, c); SEAM(0); }

    for (int layer = 0; layer < 4; ++layer) {
        const int pb = 1 + layer * PPL;
        if (pb >= hi || pb + PPL <= lo) continue;
        const int jj = layer >> 1;
        const bool odd = (layer & 1) != 0;
        const float* xres = (layer == 0) ? (const float*)a.in[0] : (const float*)a.out;
        unsigned* CNT = ctl + CW_CNT + layer * 128;
        const bf16_t* WIN = (const bf16_t*)(ws + WS_WIN) + (size_t)layer * WIN_ELEMS;
        const bf16_t* WOUT = (const bf16_t*)(ws + WS_WOUT) + (size_t)layer * WOUT_ELEMS;

        PH(pb + 0) for (int rep = 0; rep < REP_GEMM * REP_G0; ++rep) phase_inproj(XBF, WIN, PROJ, GATES, odd ? 1024 : 1952, c); SEAM(pb + 0); }
        PH(pb + 1)
            for (int rep = 0; rep < REP_TOK; ++rep) if (!odd) phase_prep_even(PROJ, GATES, (const float*)a.in[3] + jj * 256, (const float*)a.in[5] + jj * 128, (const float*)a.in[7] + jj * 4 * 1536,
                                      (const float*)a.in[8] + jj * 4, (const float*)a.in[9] + jj * 4, ROPEM,
                                      (bf16_t*)(ws + U_CQ), (bf16_t*)(ws + U_CKV), (bf16_t*)(ws + U_KROPE), (bf16_t*)(ws + U_GQ), (bf16_t*)(ws + U_GK), (bf16_t*)(ws + U_GV),
                                      (float*)(ws + U_BETA), (float*)(ws + U_GLOG), c);
            else phase_prep_odd(PROJ, ROPES, (bf16_t*)(ws + U_QF), (bf16_t*)(ws + U_KN), c);
            SEAM(pb + 1);
        }
        PH(pb + 2)
            if (!odd) for (int rep = 0; rep < REP_GEMM; ++rep) phase_mla_up((const bf16_t*)(ws + U_CQ), (const bf16_t*)(ws + WS_WQB) + (size_t)jj * WQB_ELEMS, (const bf16_t*)(ws + U_CKV),
                                   (const bf16_t*)(ws + WS_WKVB) + (size_t)jj * WKVB_ELEMS, ROPEM, (bf16_t*)(ws + U_QF), (bf16_t*)(ws + U_KN), (bf16_t*)(ws + U_VV), c);
            SEAM(pb + 2);
        }
        PH(pb + 3)
            unsigned* ctr = ctl + CW_WORK + pb + 3;
            float* OG = YBUF;
            if (!odd) {
                for (;;) {
                    const int u = next_unit(ctr, c); UNIT_CTX();
                    if (u >= 1024) break;
                    gdc_passA(u, (const bf16_t*)(ws + U_GQ), (const bf16_t*)(ws + U_GK), (const bf16_t*)(ws + U_GV), (const float*)(ws + U_BETA),
                              (const float*)(ws + U_GLOG), ws + WS_HBUF, cu);
                }
            } else {
                for (;;) {
                    const int u = next_unit(ctr, c); UNIT_CTX();
                    if (u >= 1024 + 1024) break;
                    if (u < 1024) mlc_passA(u, PROJ, GATES, (const float*)a.in[13] + jj * 4, (const float*)a.in[14] + jj * 4, (unsigned char*)YBUF, cu);
                    else {
                        const int v = u - 1024, n = v & 15, hq = (v >> 4) & 7, b = v >> 7, kvh = hq >> 2;
                        const size_t tb = (size_t)b * SEQ;
                        attn_unit<4, true>((const bf16_t*)(ws + U_QF) + tb * 512 + hq * 64, 512, (const bf16_t*)(ws + U_KN) + tb * 128 + kvh * 64, 128,
                                           (const bf16_t*)(ws + U_KN), 0, PROJ + tb * NPAD + 2184 + kvh * 64, NPAD,
                                           MIXO + tb * 1024 + 512 + hq * 64, 1024, n * 128, ((const float*)a.in[16])[jj * 8 + hq] * 1.4426950408889634f, cu);
                    }
                }
            }
            SEAM(pb + 3);
        }
        PH(pb + 4)
            if (!odd) {
                unsigned* ctr = ctl + CW_WORK + pb + 4;
                for (;;) {
                    const int u = next_unit(ctr, c); UNIT_CTX();
                    if (u >= 32 + 1024) break;
                    if (u < 32) gdc_passB(u, ws + WS_HBUF, YBUF, cu);
                    else {
                        const int v = u - 32, qb = 15 - (v >> 6), bh = v & 63, b = bh >> 3, hh = bh & 7;
                        const size_t tb = (size_t)b * SEQ;
                        attn_unit<6, false>((const bf16_t*)(ws + U_QF) + tb * 768 + hh * 96, 768, (const bf16_t*)(ws + U_KN) + tb * 512 + hh * 64, 512,
                                            (const bf16_t*)(ws + U_KROPE) + tb * 32, 32, (const bf16_t*)(ws + U_VV) + tb * 512 + hh * 64, 512,
                                            MIXO + tb * 1024 + hh * 64, 1024, qb * 128, 0.f, cu);
                    }
                }
            } else { for (int u = c.bid; u < 256; u += c.nblk) mlc_passB(u, (unsigned char*)YBUF, c); }
            SEAM(pb + 4);
        }
        PH(pb + 5)
            if (!odd) { phase_post(YBUF, PROJ, (const float*)a.in[10] + jj * 128, false, MIXO, c); SEAM(pb + 5); }
            if (odd) {
                unsigned* ctr = ctl + CW_WORK + pb + 5;
                for (;;) {
                    const int u = next_unit(ctr, c); UNIT_CTX();
                    if (u >= 1024) break;
                    mlc_passC(u, PROJ, GATES, (const float*)a.in[13] + jj * 4, (const float*)a.in[14] + jj * 4, (const unsigned char*)YBUF, (const float*)a.in[15] + jj * 512, MIXO, cu);
                }
                SEAM(pb + 5);
            }
        }
        PH(pb + 6) for (int rep = 0; rep < REP_GEMM * REP_G1; ++rep) phase_outproj(MIXO, WOUT, xres, YBUF, c); SEAM(pb + 6); }
        PH(pb + 7) for (int rep = 0; rep < REP_TOK; ++rep) phase_ln1(YBUF, (const float*)a.in[18] + layer * 1024, (const float*)a.in[19] + layer * 1024, X1, XBF, c); SEAM(pb + 7); }
        PH(pb + 8) for (int rep = 0; rep < REP_GEMM; ++rep) phase_router(XBF, (const bf16_t*)(ws + WS_WRT) + (size_t)layer * WRT_ELEMS, (float*)(ws + WS_LOG), c); SEAM(pb + 8); }
        PH(pb + 9) phase_route((const float*)(ws + WS_LOG), (const float*)a.in[21] + layer * 64, CNT, (int*)(ws + WS_LTOK), (float*)(ws + WS_LW), (int*)(ws + WS_ASG), c); SEAM(pb + 9); }
        PH(pb + 10) for (int rep = 0; rep < REP_GEMM * REP_G2; ++rep) phase_moe1(XBF, (const bf16_t*)(ws + WS_WGU) + (size_t)layer * 65 * WGU_ELEMS, CNT, (const int*)(ws + WS_LTOK), (bf16_t*)(ws + WS_HBUF), c); SEAM(pb + 10); }
        PH(pb + 11) for (int rep = 0; rep < REP_GEMM * REP_G3; ++rep) phase_moe2((const bf16_t*)(ws + WS_HBUF), (const bf16_t*)(ws + WS_WDN) + (size_t)layer * 65 * WDN_ELEMS, CNT, (const float*)(ws + WS_LW), (bf16_t*)(ws + U_Y), c); SEAM(pb + 11); }
        PH(pb + 12) for (int rep = 0; rep < REP_CMB; ++rep) phase_combine(X1, (const bf16_t*)(ws + U_Y), (const int*)(ws + WS_ASG), CNT, (const float*)a.in[28] + layer * 1024, (const float*)a.in[29] + layer * 1024,
                                         a.out, XBF, c); SEAM(pb + 12); }
    }
#undef IN
#undef PH
#undef PH_CTX
#undef UNIT_CTX
#undef SEAM
}

extern "C" void kernel_launch(void* const* d_in, const int* in_sizes, int n_in, void* d_out, int out_size, void* d_ws, size_t ws_size, hipStream_t stream) {
    static int grid = 0;
    if (grid == 0) {
        if (n_in != 30 || out_size != T * 1024 || ws_size < WS_END) {
            fprintf(stderr, "kernel_launch: unexpected shapes (n_in %d, out %d, ws %zu < %zu)\n", n_in, out_size, ws_size, (size_t)WS_END);
            grid = -1; return;
        }
        int dev = 0, cus = 0, per_cu = 0;
        (void)hipGetDevice(&dev);
        (void)hipDeviceGetAttribute(&cus, hipDeviceAttributeMultiprocessorCount, dev);
        (void)hipFuncSetAttribute((const void*)fwd, hipFuncAttributeMaxDynamicSharedMemorySize, DYN_LDS);
        (void)hipOccupancyMaxActiveBlocksPerMultiprocessor(&per_cu, (const void*)fwd, 256, DYN_LDS);
        (void)hipGetLastError();
        if (per_cu < 1) per_cu = 1;
        grid = cus * (per_cu < 2 ? per_cu : 2);
    }
    if (grid < 0) return;
    (void)hipMemsetAsync((char*)d_ws + WS_CTL, 0, CTL_BYTES, stream);
    Args a{};
    for (int i = 0; i < 30; ++i) a.in[i] = d_in[i];
    a.out = (float*)d_out; a.ws = (unsigned char*)d_ws; a.pad = 0;
#if ONE_LAUNCH
    a.ph_lo = 0; a.ph_hi = NPH; a.use_bar = 1;
    hipLaunchKernelGGL(fwd, dim3(grid), dim3(256), DYN_LDS, stream, a);
#else
    for (int p = 0; p < NPH; ++p) {
        a.ph_lo = p; a.ph_hi = p + 1; a.use_bar = 0;
        hipLaunchKernelGGL(fwd, dim3(grid), dim3(256), DYN_LDS, stream, a);
    }
#endif
}
```

```cpp
#include <hip/hip_runtime.h>
#include <stdint.h>
#include <stdio.h>

#define REP_GEMM 1
#define REP_PHASE 0
#define REP_G0 1
#define REP_G1 1
#define REP_G2 1
#define REP_G3 1
#define REP_MIX 1
#define REP_ONLY 0
#define REP_CMB 1
#define REP_PRO 1
#define REP_TOK 1
#define MOE2_G8 1
#ifndef ONE_LAUNCH
#define ONE_LAUNCH 1
#endif

typedef unsigned short bf16_t;
typedef short bf16x8 __attribute__((ext_vector_type(8)));
typedef float f32x4 __attribute__((ext_vector_type(4)));
typedef unsigned u32x4 __attribute__((ext_vector_type(4)));
typedef unsigned u32x2 __attribute__((ext_vector_type(2)));
#define LAS __attribute__((address_space(3)))
#define GAS __attribute__((address_space(1)))

constexpr int T = 16384, SEQ = 2048;
constexpr int NPAD = 2560;
constexpr int CAP = 16384;
constexpr int RBR = 256;
constexpr int MAXRB = 512 + 64 + 64;
constexpr int MAXROWS = MAXRB * RBR;
constexpr float ALPHA = 1.681792830507429f;
constexpr int PPL = 12;
constexpr int NPH = 1 + 4 * PPL;
constexpr int NT = 512, NW = 8;
constexpr int HALF_LDS = 65536 + 64 + 1024;
constexpr int LDS_BLK = 2 * HALF_LDS;
constexpr int DYN_LDS = LDS_BLK + 64 + 1024 + 2560;

constexpr size_t cmax(size_t a, size_t b) { return a > b ? a : b; }
constexpr size_t WS_CTL = 0;
constexpr size_t CTL_BYTES = 65536;
constexpr size_t WS_WIN = WS_CTL + CTL_BYTES;
constexpr size_t WIN_ELEMS = (size_t)NPAD * 1024;
constexpr size_t WS_WQB = WS_WIN + 4 * WIN_ELEMS * 2;
constexpr size_t WQB_ELEMS = 768 * 256;
constexpr size_t WS_WKVB = WS_WQB + 2 * WQB_ELEMS * 2;
constexpr size_t WKVB_ELEMS = 1024 * 128;
constexpr size_t WS_WOUT = WS_WKVB + 2 * WKVB_ELEMS * 2;
constexpr size_t WOUT_ELEMS = 1024 * 1024;
constexpr size_t WS_WRT = WS_WOUT + 4 * WOUT_ELEMS * 2;
constexpr size_t WRT_ELEMS = 128 * 1024;
constexpr size_t WS_WGU = WS_WRT + 4 * WRT_ELEMS * 2;
constexpr size_t WGU_ELEMS = 512 * 1024;
constexpr size_t WS_WDN = WS_WGU + 4 * 65 * WGU_ELEMS * 2;
constexpr size_t WDN_ELEMS = 1024 * 256;
constexpr size_t WS_ROPEM = WS_WDN + 4 * 65 * WDN_ELEMS * 2;
constexpr size_t WS_ROPES = WS_ROPEM + (size_t)T * 16 * 2 * 4;
constexpr size_t WS_X1 = WS_ROPES + (size_t)T * 32 * 2 * 4;
constexpr size_t WS_XBF = WS_X1 + (size_t)T * 1024 * 4;
constexpr size_t WS_HBUF = WS_XBF + (size_t)T * 1024 * 2;
constexpr size_t WS_LOG = WS_HBUF + (size_t)MAXROWS * 256 * 2;
constexpr size_t WS_ASG = WS_LOG + (size_t)T * 64 * 4;
constexpr size_t WS_LTOK = WS_ASG + (size_t)T * 8 * 4;
constexpr size_t WS_LW = WS_LTOK + (size_t)65 * CAP * 4;
constexpr size_t WS_U = WS_LW + (size_t)65 * CAP * 4;
constexpr size_t U_Y = WS_U;
constexpr size_t U_PROJ = WS_U;
constexpr size_t U_GATES = U_PROJ + (size_t)T * NPAD * 2;
constexpr size_t U_CQ = U_GATES + (size_t)T * 8 * 4;
constexpr size_t U_CKV = U_CQ + (size_t)T * 256 * 2;
constexpr size_t U_KROPE = U_CKV + (size_t)T * 128 * 2;
constexpr size_t U_QF = U_KROPE + (size_t)T * 32 * 2;
constexpr size_t U_KN = U_QF + (size_t)T * 768 * 2;
constexpr size_t U_VV = U_KN + (size_t)T * 512 * 2;
constexpr size_t U_GQ = U_VV + (size_t)T * 512 * 2;
constexpr size_t U_GK = U_GQ + (size_t)T * 512 * 2;
constexpr size_t U_GV = U_GK + (size_t)T * 512 * 2;
constexpr size_t U_BETA = U_GV + (size_t)T * 512 * 2;
constexpr size_t U_GLOG = U_BETA + (size_t)T * 4 * 4;
constexpr size_t U_MIXO = U_GLOG + (size_t)T * 4 * 4;
constexpr size_t U_YBUF = U_MIXO + (size_t)T * 1024 * 2;
constexpr size_t U_END1 = U_YBUF + (size_t)T * 1024 * 4;
constexpr size_t WS_END = WS_U + cmax((size_t)MAXROWS * 1024 * 2, U_END1 - WS_U);

constexpr int CW_CNT = 4096;
constexpr int CW_WORK = 8192;

#define XB_TMO      128
#define XB_XCNT(j)  (256  + 64 * (j))
#define XB_XSUB(j)  (1280 + 64 * (j))
#define XB_XGEN(j)  (2304 + 64 * (j))
#define XB_TOP      3328
#define XB_TOPGEN   3392
#define XCD_BAR_WORDS 3456
#define XB_SPIN_CAP (1u << 18)

__device__ __forceinline__ unsigned xb_ld(unsigned* p)              { return __hip_atomic_load(p, __ATOMIC_RELAXED, __HIP_MEMORY_SCOPE_AGENT); }
__device__ __forceinline__ unsigned xb_add(unsigned* p, unsigned v) { return __hip_atomic_fetch_add(p, v, __ATOMIC_RELAXED, __HIP_MEMORY_SCOPE_AGENT); }
__device__ __forceinline__ unsigned xb_xcc_id() { return (unsigned)__builtin_amdgcn_s_getreg((3 << 11) | 20) & 0xFu; }
#define XB_SPIN(cond, bar) do { unsigned _sp = 0; while (cond) { __builtin_amdgcn_s_sleep(1); \
    if ((++_sp & 255u) == 0u) { if (xb_ld(&(bar)[XB_TMO])) break; if (_sp > XB_SPIN_CAP) { atomicAdd(&(bar)[XB_TMO], 1u); break; } } } } while (0)

struct XcdBarrier { unsigned* bar; unsigned x; volatile LAS unsigned* st; };

__device__ __forceinline__ XcdBarrier xcd_barrier_post(unsigned* bar, volatile LAS unsigned* st) {
    XcdBarrier b; b.bar = bar; b.x = xb_xcc_id(); b.st = st;
    if (threadIdx.x == 0) (void)xb_add(&bar[XB_XCNT(b.x)], 1u);
    return b;
}
__device__ __forceinline__ void xcd_barrier_complete(unsigned* bar, unsigned x, unsigned& nloc, unsigned& nx) {
    const unsigned G = gridDim.x * gridDim.y * gridDim.z;
    unsigned sum, cnt, mine, sp = 0u;
    for (;;) {
        sum = 0u; cnt = 0u; mine = 0u;
#pragma unroll
        for (unsigned j = 0; j < 16; ++j) { const unsigned c = xb_ld(&bar[XB_XCNT(j)]); sum += c; cnt += (c > 0u) ? 1u : 0u; mine = (j == x) ? c : mine; }
        if (sum == G) break;
        __builtin_amdgcn_s_sleep(1);
        if ((++sp & 255u) == 0u) { if (xb_ld(&bar[XB_TMO])) break; if (sp > XB_SPIN_CAP) { atomicAdd(&bar[XB_TMO], 1u); break; } }
    }
    nloc = mine > 0u ? mine : 1u; nx = cnt > 0u ? cnt : 1u;
}
__device__ __forceinline__ void xcd_barrier(const XcdBarrier& b) {
    asm volatile("s_waitcnt vmcnt(0)" ::: "memory");
    __syncthreads();
    if (threadIdx.x == 0) {
        unsigned* bar = b.bar;
        __builtin_amdgcn_s_waitcnt(0);
        unsigned nloc = b.st[0], nx = b.st[1];
        if (nloc == 0u) { xcd_barrier_complete(bar, b.x, nloc, nx); b.st[0] = nloc; b.st[1] = nx; }
        const unsigned old = xb_add(&bar[XB_XSUB(b.x)], 1u);
        const unsigned gen = old / nloc;
        if (old + 1u == (gen + 1u) * nloc) {
            __builtin_amdgcn_fence(__ATOMIC_RELEASE, "agent");
            asm volatile("s_waitcnt vmcnt(0)" ::: "memory");
            const unsigned og = xb_add(&bar[XB_TOP], 1u);
            const unsigned tg = og / nx;
            if (og + 1u == (tg + 1u) * nx) xb_add(&bar[XB_TOPGEN], 1u);
            else XB_SPIN(xb_ld(&bar[XB_TOPGEN]) == tg, bar);
            __builtin_amdgcn_fence(__ATOMIC_ACQUIRE, "agent");
            xb_add(&bar[XB_XGEN(b.x)], 1u);
            asm volatile("s_waitcnt vmcnt(0)" ::: "memory");
        } else {
            XB_SPIN(xb_ld(&bar[XB_XGEN(b.x)]) == gen, bar);
            __builtin_amdgcn_fence(__ATOMIC_ACQUIRE, "agent");
            asm volatile("s_waitcnt vmcnt(0)" ::: "memory");
        }
    }
    __syncthreads();
}

__device__ __forceinline__ float bf2f(unsigned v) { return __uint_as_float(v << 16); }
__device__ __forceinline__ float bflo(unsigned w) { return __uint_as_float(w << 16); }
__device__ __forceinline__ float bfhi(unsigned w) { return __uint_as_float(w & 0xffff0000u); }
__device__ __forceinline__ unsigned f2bf(float f) { unsigned u = __float_as_uint(f); u += 0x7fffu + ((u >> 16) & 1u); return u >> 16; }
__device__ __forceinline__ unsigned pk2(float lo, float hi) { return f2bf(lo) | (f2bf(hi) << 16); }
__device__ __forceinline__ unsigned cvt_pk(float lo, float hi) { unsigned r; asm volatile("v_cvt_pk_bf16_f32 %0, %1, %2" : "=v"(r) : "v"(lo), "v"(hi)); return r; }
__device__ __forceinline__ float wave_sum(float v) {
#pragma unroll
    for (int o = 32; o > 0; o >>= 1) v += __shfl_xor(v, o);
    return v;
}
__device__ __forceinline__ float sigmoidf_(float x) { return 1.f / (1.f + expf(-x)); }
__device__ __forceinline__ float siluf_(float x) { return x / (1.f + expf(-x)); }
__device__ __forceinline__ float softplusf_(float x) { return x > 20.f ? x : log1pf(expf(x)); }
__device__ __forceinline__ void glds16(const void* g, void* l) {
    __builtin_amdgcn_global_load_lds((const GAS unsigned*)g, (LAS unsigned*)l, 16, 0, 0);
}
__device__ __forceinline__ void unpack8(const u32x4 r, float (&f)[8]) {
    f[0] = bflo(r.x); f[1] = bfhi(r.x); f[2] = bflo(r.y); f[3] = bfhi(r.y);
    f[4] = bflo(r.z); f[5] = bfhi(r.z); f[6] = bflo(r.w); f[7] = bfhi(r.w);
}

struct Args {
    const void* in[30];
    float* out;
    unsigned char* ws;
    int ph_lo, ph_hi, use_bar, pad;
};

struct Ctx { int tid, lane, wid, wr, wc, fr, fq, bid, nblk; unsigned char* smem; int half, tid0; unsigned char* smem0; };

#define WAIT_V(n) asm volatile("s_waitcnt vmcnt(" #n ")" ::: "memory")
__device__ __forceinline__ void gemm_tile(const bf16_t* a0, const bf16_t* a1, const bf16_t* b0, const bf16_t* b1,
                                          int nk, f32x4 (&acc)[4][4], const Ctx& c) {
#pragma unroll
    for (int m = 0; m < 4; ++m)
#pragma unroll
        for (int n = 0; n < 4; ++n) acc[m][n] = (f32x4){0.f, 0.f, 0.f, 0.f};
    unsigned char* smem = c.smem;
    const int sb = c.tid * 16;
    const int kofs = ((c.tid & 3) ^ ((c.tid >> 4) & 3)) * 8;
    a0 += kofs; a1 += kofs; b0 += kofs; b1 += kofs;
#define G_STAGE(kt_) do { unsigned char* sp_ = smem + ((kt_) & 3) * 16384 + sb; const int ko_ = (kt_) * 32; \
        glds16(a0 + ko_, sp_); glds16(a1 + ko_, sp_ + 4096); glds16(b0 + ko_, sp_ + 8192); glds16(b1 + ko_, sp_ + 12288); } while (0)
#define G_READ(kt_, AF, BF) do { const unsigned char* sa_ = smem + ((kt_) & 3) * 16384 + c.wr * 4096 + roff; const unsigned char* sb_ = smem + ((kt_) & 3) * 16384 + 8192 + c.wc * 4096 + roff; \
        _Pragma("unroll") for (int m = 0; m < 4; ++m) AF[m] = *(const bf16x8*)(sa_ + m * 1024); \
        _Pragma("unroll") for (int n = 0; n < 4; ++n) BF[n] = *(const bf16x8*)(sb_ + n * 1024); } while (0)
#define G_MMA(AF, BF) do { __builtin_amdgcn_s_setprio(1); \
        _Pragma("unroll") for (int m = 0; m < 4; ++m) _Pragma("unroll") for (int n = 0; n < 4; ++n) acc[m][n] = __builtin_amdgcn_mfma_f32_16x16x32_bf16(BF[n], AF[m], acc[m][n], 0, 0, 0); \
        __builtin_amdgcn_s_setprio(0); } while (0)
#define G_BAR() do { asm volatile("" ::: "memory"); __builtin_amdgcn_s_barrier(); asm volatile("" ::: "memory"); } while (0)
    const int roff = (c.fr * 64) + ((c.fq ^ ((c.fr >> 2) & 3)) * 16);
    WAIT_V(0);
    G_STAGE(0); G_STAGE(1); G_STAGE(2); G_STAGE(3);
    bf16x8 fa0[4], fb0[4], fa1[4], fb1[4];
    WAIT_V(12); G_BAR();
    G_READ(0, fa0, fb0);
#define G_LGK0() asm volatile("s_waitcnt lgkmcnt(0)" ::: "memory")
    int kt = 0;
    for (; kt < nk - 4; kt += 4) {
        G_LGK0(); WAIT_V(8); G_BAR(); G_STAGE(kt + 4); G_READ(1, fa1, fb1); G_MMA(fa0, fb0);
        G_LGK0(); WAIT_V(8); G_BAR(); G_STAGE(kt + 5); G_READ(2, fa0, fb0); G_MMA(fa1, fb1);
        G_LGK0(); WAIT_V(8); G_BAR(); G_STAGE(kt + 6); G_READ(3, fa1, fb1); G_MMA(fa0, fb0);
        G_LGK0(); WAIT_V(8); G_BAR(); G_STAGE(kt + 7); G_READ(0, fa0, fb0); G_MMA(fa1, fb1);
    }
    G_LGK0(); WAIT_V(8); G_BAR(); G_READ(1, fa1, fb1); G_MMA(fa0, fb0);
    G_LGK0(); WAIT_V(4); G_BAR(); G_READ(2, fa0, fb0); G_MMA(fa1, fb1);
    G_LGK0(); WAIT_V(0); G_BAR(); G_READ(3, fa1, fb1); G_MMA(fa0, fb0);
    G_MMA(fa1, fb1);
#undef G_LGK0
#undef G_STAGE
#undef G_READ
#undef G_MMA
#undef G_BAR
    __syncthreads();
}

namespace g8 {
constexpr int BM = 256, BK = 64, HALF = 128, HTB = HALF * BK * 2, STAGE_BYTES = 8 * HTB;
__device__ __forceinline__ int lds_byte(int r, int c) { const int st = (r >> 4) * 2 + (c >> 5), rr = r & 15, cc = c & 31, ob = rr * 64 + cc * 2; return st * 1024 + (ob ^ (((ob >> 9) & 1) << 5)); }
__device__ __forceinline__ void stage_rc(int b, int& R, int& C) { const int st = b / 1024, sb = b % 1024, swz = sb ^ (((sb >> 9) & 1) << 5); R = (st >> 1) * 16 + swz / 64; C = (st & 1) * 32 + (swz % 64) / 2; }
__device__ __forceinline__ int perm32(int rho) { const int n = rho >> 4, i = rho & 15; return 8 * (i >> 2) + 4 * n + (i & 3); }
struct Unit { int pm, pn, bt; };

template <bool PERM, class Sched, class Epi>
__device__ __forceinline__ void phase(unsigned char* ldsp, const char* Abase, const char* Bbase, int K, const Sched& S, const Epi& E) {
    LAS unsigned char* lds = (LAS unsigned char*)ldsp;
    int tid = threadIdx.x; asm volatile("" : "+v"(tid));
    const int wid = __builtin_amdgcn_readfirstlane(tid >> 6), lane = tid & 63, wr = wid >> 2, wc = wid & 3, fr = lane & 15, fq = lane >> 4;
    const int nt = K / BK;
    unsigned voffA[2], voffB[2];
#pragma unroll
    for (int i = 0; i < 2; ++i) { int R, C; stage_rc(tid * 16 + i * 8192, R, C); const int Rb = PERM ? ((R & ~31) + perm32(R & 31)) : R;
        voffA[i] = (unsigned)(R * K + C) * 2u; voffB[i] = (unsigned)(Rb * K + C) * 2u; }
    const size_t kstep = (size_t)(BK * 2);
    const size_t hstep = (size_t)HALF * K * 2, tstep = 2 * hstep;
    const unsigned ldsw = (unsigned)wid * 1024u;
    const int aoff = lds_byte(wr * 64 + fr, fq * 8), boff = lds_byte(wc * 32 + fr, fq * 8);
#define G8_SA(b, h) (((b) * 2 + (h)) * HTB)
#define G8_SB(b, h) ((4 + (b) * 2 + (h)) * HTB)
#define G8_STAGE(bufoff, gbase, voff) do { _Pragma("unroll") for (int _i = 0; _i < 2; ++_i) \
        __builtin_amdgcn_global_load_lds((const GAS unsigned*)((const char*)(gbase) + (voff)[_i]), (LAS unsigned*)(lds + (bufoff) + ldsw + _i * 8192), 16, 0, 0); } while (0)
#define G8_LDA(dst, b, h) do { _Pragma("unroll") for (int m = 0; m < 4; ++m) _Pragma("unroll") for (int k = 0; k < 2; ++k) dst[m][k] = *(const LAS bf16x8*)(lds + G8_SA(b, h) + aoff + m * 2048 + k * 1024); } while (0)
#define G8_LDB(dst, b, h) do { _Pragma("unroll") for (int n = 0; n < 2; ++n) _Pragma("unroll") for (int k = 0; k < 2; ++k) dst[n][k] = *(const LAS bf16x8*)(lds + G8_SB(b, h) + boff + n * 2048 + k * 1024); } while (0)
#define G8_MMA(ai, bj, At, Bt) do { __builtin_amdgcn_s_setprio(1); _Pragma("unroll") for (int m = 0; m < 4; ++m) _Pragma("unroll") for (int n = 0; n < 2; ++n) _Pragma("unroll") for (int k = 0; k < 2; ++k) \
        acc[ai][bj][m][n] = __builtin_amdgcn_mfma_f32_16x16x32_bf16(Bt[n][k], At[m][k], acc[ai][bj][m][n], 0, 0, 0); __builtin_amdgcn_s_setprio(0); } while (0)
#define G8_WAIT_V(n) asm volatile("s_waitcnt vmcnt(" #n ")" ::: "memory")
#define G8_WAIT_L(n) asm volatile("s_waitcnt lgkmcnt(" #n ")" ::: "memory")
#define G8_BAR __builtin_amdgcn_s_barrier()
#define G8_SCHED __builtin_amdgcn_sched_barrier(0)
    Unit cur, nxt; int ui = 0;
    if (!S.next(0, cur)) return;
    f32x4 acc[2][2][4][2];
#pragma unroll
    for (int a = 0; a < 2; ++a)
#pragma unroll
        for (int b = 0; b < 2; ++b)
#pragma unroll
            for (int m = 0; m < 4; ++m)
#pragma unroll
                for (int n = 0; n < 2; ++n) acc[a][b][m][n] = (f32x4){0.f, 0.f, 0.f, 0.f};
    bf16x8 At[4][2], B0[2][2], B1[2][2];
    const char* cA = Abase + (size_t)cur.pm * tstep; const char* cB = Bbase + (size_t)cur.bt * tstep;
    asm volatile("s_waitcnt vmcnt(0)" ::: "memory");
    G8_STAGE(G8_SB(0, 0), cB, voffB); G8_STAGE(G8_SA(0, 0), cA, voffA); G8_STAGE(G8_SB(0, 1), cB + hstep, voffB); G8_STAGE(G8_SA(0, 1), cA + hstep, voffA);
    if (wr == 1) G8_BAR;
    G8_WAIT_V(4); G8_BAR;
    G8_STAGE(G8_SB(1, 0), cB + kstep, voffB); G8_STAGE(G8_SA(1, 0), cA + kstep, voffA); G8_STAGE(G8_SB(1, 1), cB + hstep + kstep, voffB);
    G8_WAIT_V(6); G8_BAR;
    for (;;) {
        const bool has_next = S.next(ui + 1, nxt);
        const char* nA = has_next ? Abase + (size_t)nxt.pm * tstep : cA; const char* nB = has_next ? Bbase + (size_t)nxt.bt * tstep : cB;
        for (int t = 0; t < nt; t += 2) {
            const bool last = (t == nt - 2);
            const char* a1 = cA + (size_t)(t + 1) * kstep;
            const char* a2 = last ? nA : cA + (size_t)(t + 2) * kstep; const char* b2 = last ? nB : cB + (size_t)(t + 2) * kstep;
            const char* a3 = a2 + kstep; const char* b3 = b2 + kstep;
            G8_LDB(B0, 0, 0); G8_SCHED; G8_LDA(At, 0, 0); G8_STAGE(G8_SA(1, 1), a1 + hstep, voffA);
            G8_WAIT_L(8); G8_BAR; G8_WAIT_L(0); G8_MMA(0, 0, At, B0); G8_BAR; G8_SCHED;
            G8_LDB(B1, 0, 1); G8_STAGE(G8_SB(0, 0), b2, voffB);
            G8_BAR; G8_WAIT_L(0); G8_MMA(0, 1, At, B1); G8_BAR;
            G8_LDA(At, 0, 1); G8_STAGE(G8_SA(0, 0), a2, voffA);
            G8_BAR; G8_WAIT_L(0); G8_MMA(1, 0, At, B0); G8_BAR; G8_SCHED;
            G8_STAGE(G8_SB(0, 1), b2 + hstep, voffB);
            G8_WAIT_V(6); G8_BAR; G8_MMA(1, 1, At, B1); G8_BAR;
            G8_LDB(B0, 1, 0); G8_SCHED; G8_LDA(At, 1, 0); G8_STAGE(G8_SA(0, 1), a2 + hstep, voffA);
            G8_WAIT_L(8); G8_BAR; G8_WAIT_L(0); G8_MMA(0, 0, At, B0); G8_BAR; G8_SCHED;
            G8_LDB(B1, 1, 1); G8_STAGE(G8_SB(1, 0), b3, voffB);
            G8_BAR; G8_WAIT_L(0); G8_MMA(0, 1, At, B1); G8_BAR;
            G8_LDA(At, 1, 1); G8_STAGE(G8_SA(1, 0), a3, voffA);
            G8_BAR; G8_WAIT_L(0); G8_MMA(1, 0, At, B0); G8_BAR; G8_SCHED;
            G8_STAGE(G8_SB(1, 1), b3 + hstep, voffB);
            G8_WAIT_V(6); G8_BAR; G8_MMA(1, 1, At, B1); G8_BAR;
        }
        E(acc, cur, wr, wc, fr, fq);
        if (!has_next) break;
#pragma unroll
        for (int a = 0; a < 2; ++a)
#pragma unroll
            for (int b = 0; b < 2; ++b)
#pragma unroll
                for (int m = 0; m < 4; ++m)
#pragma unroll
                    for (int n = 0; n < 2; ++n) acc[a][b][m][n] = (f32x4){0.f, 0.f, 0.f, 0.f};
        cur = nxt; cA = nA; cB = nB; ++ui;
    }
    G8_WAIT_V(0);
    if (wr == 0) G8_BAR;
    G8_BAR;
#undef G8_SA
#undef G8_SB
#undef G8_STAGE
#undef G8_LDA
#undef G8_LDB
#undef G8_MMA
#undef G8_WAIT_V
#undef G8_WAIT_L
#undef G8_BAR
#undef G8_SCHED
}
}

__device__ __forceinline__ bool tile_map(int i, const Ctx& c, int ntm, int ntn, int& mt, int& nt) {
    const int vb = ((c.nblk & 15) == 0) ? ((c.bid >> 1) & 7) * (c.nblk >> 3) + (((c.bid >> 4) << 1) | (c.bid & 1)) : c.bid;
    const int L = i * c.nblk + vb;
    if (L >= ntm * ntn) return false;
    const int g = L / (8 * ntn), rem = L - g * 8 * ntn;
    const int gsz = (ntm - g * 8) < 8 ? (ntm - g * 8) : 8;
    mt = g * 8 + rem % gsz; nt = rem / gsz;
    return true;
}

__device__ __forceinline__ bool tile_map2(int i, const Ctx& c, int ntm, int ntn, int& mt, int& nt, bool& valid) {
    Ctx o = c; o.bid = c.bid ^ 1;
    int mo, no; const bool oko = tile_map(i, o, ntm, ntn, mo, no);
    valid = tile_map(i, c, ntm, ntn, mt, nt);
    if (!valid) { mt = 0; nt = 0; }
    return valid || oko;
}

struct DenseSched {
    int ntm, ntn, K, bid, nblk;
    __device__ __forceinline__ bool next(int i, g8::Unit& u) const {
        const int vb = ((nblk & 7) == 0) ? (bid & 7) * (nblk >> 3) + (bid >> 3) : bid;
        const int L = i * nblk + vb;
        if (L >= ntm * ntn) return false;
        const int g = L / (8 * ntn), rem = L - g * 8 * ntn;
        const int gsz = (ntm - g * 8) < 8 ? (ntm - g * 8) : 8;
        u.pm = g * 8 + rem % gsz; u.pn = rem / gsz; u.bt = u.pn;
        return true;
    }
};
struct MoeSched {
    int nrb, ntn, bid, nblk; const int* eb;
    __device__ __forceinline__ bool next(int i, g8::Unit& u) const {
        const int vb = ((nblk & 7) == 0) ? (bid & 7) * (nblk >> 3) + (bid >> 3) : bid;
        const int L = i * nblk + vb;
        if (L >= nrb * ntn) return false;
        const int g = L / (8 * ntn), rem = L - g * 8 * ntn;
        const int gsz = (nrb - g * 8) < 8 ? (nrb - g * 8) : 8;
        u.pm = g * 8 + rem % gsz; u.pn = rem / gsz;
        u.bt = eb[u.pm] * ntn + u.pn;
        return true;
    }
};
struct EpiIn {
    bf16_t* P; float* G; int gbase;
    __device__ __forceinline__ void operator()(const f32x4 (&acc)[2][2][4][2], const g8::Unit& u, int wr, int wc, int fr, int fq) const {
#pragma unroll
        for (int ai = 0; ai < 2; ++ai)
#pragma unroll
            for (int m = 0; m < 4; ++m) {
                const size_t row = (size_t)u.pm * 256 + ai * 128 + wr * 64 + m * 16 + fr;
#pragma unroll
                for (int bj = 0; bj < 2; ++bj) {
                    const int col = u.pn * 256 + bj * 128 + wc * 32 + fq * 8;
                    const f32x4 v0 = acc[ai][bj][m][0], v1 = acc[ai][bj][m][1];
                    *(u32x4*)(P + row * NPAD + col) = (u32x4){cvt_pk(v0[0], v0[1]), cvt_pk(v0[2], v0[3]), cvt_pk(v1[0], v1[1]), cvt_pk(v1[2], v1[3])};
                    if (col == gbase) { *(f32x4*)(G + row * 8) = v0; *(f32x4*)(G + row * 8 + 4) = v1; }
                }
            }
    }
};
struct EpiMoe2 {
    bf16_t* Y;
    __device__ __forceinline__ void operator()(const f32x4 (&acc)[2][2][4][2], const g8::Unit& u, int wr, int wc, int fr, int fq) const {
#pragma unroll
        for (int ai = 0; ai < 2; ++ai)
#pragma unroll
            for (int m = 0; m < 4; ++m) {
                const size_t row = (size_t)u.pm * RBR + ai * 128 + wr * 64 + m * 16 + fr;
#pragma unroll
                for (int bj = 0; bj < 2; ++bj) {
                    const int col = u.pn * 256 + bj * 128 + wc * 32 + fq * 8;
                    const f32x4 v0 = acc[ai][bj][m][0], v1 = acc[ai][bj][m][1];
                    *(u32x4*)(Y + row * 1024 + col) = (u32x4){cvt_pk(v0[0], v0[1]), cvt_pk(v0[2], v0[3]), cvt_pk(v1[0], v1[1]), cvt_pk(v1[2], v1[3])};
                }
            }
    }
};
struct EpiOut {
    const float* xres; float* Y;
    __device__ __forceinline__ void operator()(const f32x4 (&acc)[2][2][4][2], const g8::Unit& u, int wr, int wc, int fr, int fq) const {
#pragma unroll
        for (int ai = 0; ai < 2; ++ai)
#pragma unroll
            for (int m = 0; m < 4; ++m) {
                const size_t row = (size_t)u.pm * 256 + ai * 128 + wr * 64 + m * 16 + fr;
#pragma unroll
                for (int bj = 0; bj < 2; ++bj)
#pragma unroll
                    for (int n = 0; n < 2; ++n) {
                        const int col = u.pn * 256 + bj * 128 + wc * 32 + n * 16 + fq * 4;
                        const f32x4 xr = *(const f32x4*)(xres + row * 1024 + col);
                        *(f32x4*)(Y + row * 1024 + col) = xr * ALPHA + acc[ai][bj][m][n];
                    }
                asm volatile("" ::: "memory");
            }
    }
};

constexpr int TS_RS = 272;
__device__ __forceinline__ void tile_put(const Ctx& c, int row_l, int col_l, const u32x2 v) { *(u32x2*)(c.smem + row_l * TS_RS + col_l * 2) = v; }
template <int NCOL>
__device__ __forceinline__ void tile_flush(const Ctx& c, bf16_t* out, size_t ld, bool valid) {
    __syncthreads();
    constexpr int CPR = NCOL / 8, PER = (128 * CPR) / 256;
#pragma unroll
    for (int i = 0; i < PER; ++i) {
        const int idx = c.tid + 256 * i, row = idx / CPR, ch = idx % CPR;
        const u32x4 v = *(const u32x4*)(c.smem + row * TS_RS + ch * 16);
        if (valid) *(u32x4*)(out + (size_t)row * ld + ch * 8) = v;
    }
    __syncthreads();
}

__device__ __forceinline__ void conv_family(const float* src, int nmat, size_t src_stride, int K, int N, int Nout,
                            bf16_t* dst, size_t dst_stride, int grp, int kind, const Ctx& c) {
    float* lds = (float*)c.smem;
    const int tk = K / 128, tn = Nout / 64, per = tk * tn, total = nmat * per;
    const int tx = c.tid & 15, ty = c.tid >> 4;
    f32x4 r[8];
#define CV_LOAD(u_) do { const int mat_ = (u_) / per, r_ = (u_) - mat_ * per, kt_ = r_ / tn, nt_ = r_ - kt_ * tn; \
        const float* s_ = src + (size_t)mat_ * src_stride + (size_t)(kt_ * 128 + ty) * N + nt_ * 64 + tx * 4; const bool in_ = (nt_ * 64 + tx * 4) < N; \
        _Pragma("unroll") for (int i = 0; i < 8; ++i) r[i] = in_ ? *(const f32x4*)(s_ + (size_t)(16 * i) * N) : (f32x4){0.f, 0.f, 0.f, 0.f}; } while (0)
    if (c.bid < total) CV_LOAD(c.bid);
    for (int base = 0; base < total; base += c.nblk) {
        const int u = base + c.bid; const bool valid = u < total;
#pragma unroll
        for (int i = 0; i < 8; ++i) *(f32x4*)(lds + (ty + 16 * i) * 68 + tx * 4) = r[i];
        if (u + c.nblk < total) CV_LOAD(u + c.nblk);
        __syncthreads();
        if (valid) {
        const int mat = u / per, rr = u - mat * per, kt = rr / tn, nt = rr - kt * tn;
        const int dmat = grp ? (mat / grp) * (grp + 1) + (mat % grp) : mat;
        bf16_t* d = dst + (size_t)dmat * dst_stride;
        const int nl = c.tid & 63, kq = (c.tid >> 6) * 32;
        unsigned w[16];
#pragma unroll
        for (int j = 0; j < 16; ++j) w[j] = pk2(lds[(kq + 2 * j) * 68 + nl], lds[(kq + 2 * j + 1) * 68 + nl]);
        const int n = nt * 64 + nl;
        const int drow = (kind == 0) ? n : ((n >> 5) * 64 + (n & 31) + (kind == 2 ? 32 : 0));
        u32x4* dp = (u32x4*)(d + (size_t)drow * K + kt * 128 + kq);
        dp[0] = (u32x4){w[0], w[1], w[2], w[3]}; dp[1] = (u32x4){w[4], w[5], w[6], w[7]};
        dp[2] = (u32x4){w[8], w[9], w[10], w[11]}; dp[3] = (u32x4){w[12], w[13], w[14], w[15]};
        }
        __syncthreads();
    }
#undef CV_LOAD
}

__device__ __forceinline__ void phase_prologue(const Args& a, const Ctx& c) {
    unsigned char* ws = a.ws;
    bf16_t* WIN = (bf16_t*)(ws + WS_WIN);
    conv_family((const float*)a.in[2], 2, (size_t)1024 * 2472, 1024, 2472, NPAD, WIN, 2 * WIN_ELEMS, 0, 0, c);
    conv_family((const float*)a.in[12], 2, (size_t)1024 * 2312, 1024, 2312, NPAD, WIN + WIN_ELEMS, 2 * WIN_ELEMS, 0, 0, c);
    conv_family((const float*)a.in[4], 2, (size_t)256 * 768, 256, 768, 768, (bf16_t*)(ws + WS_WQB), WQB_ELEMS, 0, 0, c);
    conv_family((const float*)a.in[6], 2, (size_t)128 * 1024, 128, 1024, 1024, (bf16_t*)(ws + WS_WKVB), WKVB_ELEMS, 0, 0, c);
    bf16_t* WOUT = (bf16_t*)(ws + WS_WOUT);
    conv_family((const float*)a.in[11], 2, (size_t)1024 * 1024, 1024, 1024, 1024, WOUT, 2 * WOUT_ELEMS, 0, 0, c);
    conv_family((const float*)a.in[17], 2, (size_t)1024 * 1024, 1024, 1024, 1024, WOUT + WOUT_ELEMS, 2 * WOUT_ELEMS, 0, 0, c);
    conv_family((const float*)a.in[20], 4, (size_t)1024 * 64, 1024, 64, 128, (bf16_t*)(ws + WS_WRT), WRT_ELEMS, 0, 0, c);
    bf16_t* WGU = (bf16_t*)(ws + WS_WGU);
    conv_family((const float*)a.in[22], 256, (size_t)1024 * 256, 1024, 256, 256, WGU, WGU_ELEMS, 64, 1, c);
    conv_family((const float*)a.in[23], 256, (size_t)1024 * 256, 1024, 256, 256, WGU, WGU_ELEMS, 64, 2, c);
    conv_family((const float*)a.in[25], 4, (size_t)1024 * 256, 1024, 256, 256, WGU + 64 * WGU_ELEMS, 65 * WGU_ELEMS, 0, 1, c);
    conv_family((const float*)a.in[26], 4, (size_t)1024 * 256, 1024, 256, 256, WGU + 64 * WGU_ELEMS, 65 * WGU_ELEMS, 0, 2, c);
    bf16_t* WDN = (bf16_t*)(ws + WS_WDN);
    conv_family((const float*)a.in[24], 256, (size_t)256 * 1024, 256, 1024, 1024, WDN, WDN_ELEMS, 64, 0, c);
    conv_family((const float*)a.in[27], 4, (size_t)256 * 1024, 256, 1024, 1024, WDN + 64 * WDN_ELEMS, 65 * WDN_ELEMS, 0, 0, c);
    {
        const float* x = (const float*)a.in[0]; bf16_t* xb = (bf16_t*)(ws + WS_XBF);
        const size_t n8 = (size_t)T * 1024 / 8;
        for (size_t i = (size_t)c.bid * 256 + c.tid; i < n8; i += (size_t)c.nblk * 256) {
            const f32x4 v0 = *(const f32x4*)(x + i * 8), v1 = *(const f32x4*)(x + i * 8 + 4);
            *(u32x4*)(xb + i * 8) = (u32x4){pk2(v0[0], v0[1]), pk2(v0[2], v0[3]), pk2(v1[0], v1[1]), pk2(v1[2], v1[3])};
        }
    }
    {
        const int* pos = (const int*)a.in[1];
        float* rm = (float*)(ws + WS_ROPEM); float* rs = (float*)(ws + WS_ROPES);
        const float ln_theta = 9.210340371976184f;
        for (int i = c.bid * 256 + c.tid; i < T * 16; i += c.nblk * 256) {
            const int t = i >> 4, f = i & 15;
            const float inv = expf(-((float)(2 * f) / 32.f) * ln_theta);
            const float ang = (float)pos[t] * inv;
            rm[i * 2] = cosf(ang); rm[i * 2 + 1] = sinf(ang);
        }
        for (int i = c.bid * 256 + c.tid; i < T * 32; i += c.nblk * 256) {
            const int t = i >> 5, f = i & 31;
            const float inv = expf(-((float)(2 * f) / 64.f) * ln_theta);
            const float ang = (float)pos[t] * inv;
            rs[i * 2] = cosf(ang); rs[i * 2 + 1] = sinf(ang);
        }
    }
}

__device__ __forceinline__ void phase_inproj(const bf16_t* XBF, const bf16_t* W, bf16_t* PROJ, float* GATES, int gbase, const Ctx& c) {
    const int ntn = NPAD / 128;
    for (int i = 0;; ++i) {
        int mt, nt; bool valid; if (!tile_map2(i, c, T / 128, ntn, mt, nt, valid)) break;
        const bf16_t* a0 = XBF + (size_t)(mt * 128 + (c.tid >> 2)) * 1024;
        const bf16_t* b0 = W + (size_t)(nt * 128 + (c.tid >> 2)) * 1024;
        f32x4 acc[4][4];
        gemm_tile(a0, a0 + 64 * 1024, b0, b0 + 64 * 1024, 32, acc, c);
#pragma unroll
        for (int m = 0; m < 4; ++m) {
            const int rl = c.wr * 64 + m * 16 + c.fr, row = mt * 128 + rl;
#pragma unroll
            for (int n = 0; n < 4; ++n) {
                const int cl = c.wc * 64 + n * 16 + c.fq * 4, col = nt * 128 + cl;
                const f32x4 v = acc[m][n];
                tile_put(c, rl, cl, (u32x2){pk2(v[0], v[1]), pk2(v[2], v[3])});
                if (valid && col >= gbase && col < gbase + 8) *(f32x4*)(GATES + (size_t)row * 8 + (col - gbase)) = v;
            }
        }
        tile_flush<128>(c, PROJ + (size_t)mt * 128 * NPAD + nt * 128, NPAD, valid);
    }
}

constexpr int MLAUP_TILES = (T / 128) * 6 + (T / 128) * 8;
__device__ __forceinline__ void mla_up_tile(int u, const bf16_t* CQ, const bf16_t* WQB, const bf16_t* CKV, const bf16_t* WKVB,
                             const float* ROPEM, bf16_t* QF, bf16_t* KN, bf16_t* VV, const Ctx& c) {
    const int tq = (T / 128) * 6;
    const float qscale = 0.10206207261596577f * 1.4426950408889634f;
    {
        f32x4 acc[4][4];
        if (u < tq) {
            const int mt = u / 6, nt = u % 6;
            const bf16_t* a0 = CQ + (size_t)(mt * 128 + (c.tid >> 2)) * 256;
            const bf16_t* b0 = WQB + (size_t)(nt * 128 + (c.tid >> 2)) * 256;
            gemm_tile(a0, a0 + 64 * 256, b0, b0 + 64 * 256, 8, acc, c);
#pragma unroll
            for (int m = 0; m < 4; ++m) {
                const int row = mt * 128 + c.wr * 64 + m * 16 + c.fr;
#pragma unroll
                for (int np = 0; np < 2; ++np) {
                    const int cg = nt * 128 + c.wc * 64 + np * 32;
                    f32x4 v0 = acc[m][2 * np], v1 = acc[m][2 * np + 1];
                    if (((cg >> 5) % 3) == 2) {
#pragma unroll
                        for (int j = 0; j < 4; ++j) {
                            const int i = c.fq * 4 + j;
                            const float cs = ROPEM[((size_t)row * 16 + i) * 2], sn = ROPEM[((size_t)row * 16 + i) * 2 + 1];
                            const float x1 = v0[j], x2 = v1[j];
                            v0[j] = x1 * cs - x2 * sn; v1[j] = x2 * cs + x1 * sn;
                        }
                    }
                    v0 *= qscale; v1 *= qscale;
                    *(u32x2*)(QF + (size_t)row * 768 + cg + c.fq * 4) = (u32x2){pk2(v0[0], v0[1]), pk2(v0[2], v0[3])};
                    *(u32x2*)(QF + (size_t)row * 768 + cg + 16 + c.fq * 4) = (u32x2){pk2(v1[0], v1[1]), pk2(v1[2], v1[3])};
                }
            }
        } else {
            const int v = u - tq, mt = v / 8, nt = v % 8;
            const bf16_t* a0 = CKV + (size_t)(mt * 128 + (c.tid >> 2)) * 128;
            const bf16_t* b0 = WKVB + (size_t)(nt * 128 + (c.tid >> 2)) * 128;
            gemm_tile(a0, a0 + 64 * 128, b0, b0 + 64 * 128, 4, acc, c);
            bf16_t* dst = (c.wc == 0) ? KN : VV;
#pragma unroll
            for (int m = 0; m < 4; ++m) {
                const int row = mt * 128 + c.wr * 64 + m * 16 + c.fr;
#pragma unroll
                for (int n = 0; n < 4; ++n) {
                    const f32x4 x = acc[m][n];
                    *(u32x2*)(dst + (size_t)row * 512 + nt * 64 + n * 16 + c.fq * 4) = (u32x2){pk2(x[0], x[1]), pk2(x[2], x[3])};
                }
            }
        }
    }
}

__device__ __forceinline__ void phase_outproj(const bf16_t* MIXO, const bf16_t* W, const float* xres, float* YBUF, const Ctx& c) {
    for (int i = 0;; ++i) {
        int mt, nt; bool valid; if (!tile_map2(i, c, T / 128, 8, mt, nt, valid)) break;
        const bf16_t* a0 = MIXO + (size_t)(mt * 128 + (c.tid >> 2)) * 1024;
        const bf16_t* b0 = W + (size_t)(nt * 128 + (c.tid >> 2)) * 1024;
        f32x4 acc[4][4];
        gemm_tile(a0, a0 + 64 * 1024, b0, b0 + 64 * 1024, 32, acc, c);
#pragma unroll
        for (int m = 0; m < 4; ++m) {
            const int row = mt * 128 + c.wr * 64 + m * 16 + c.fr;
#pragma unroll
            for (int n = 0; n < 4; ++n) {
                const int col = nt * 128 + c.wc * 64 + n * 16 + c.fq * 4;
                const f32x4 xr = *(const f32x4*)(xres + (size_t)row * 1024 + col);
                if (valid) *(f32x4*)(YBUF + (size_t)row * 1024 + col) = xr * ALPHA + acc[m][n];
            }
        }
    }
}

__device__ __forceinline__ void phase_router(const bf16_t* XBF, const bf16_t* W, float* LOG, const Ctx& c) {
    for (int base = 0; base < T / 128; base += c.nblk) {
        const bool valid = (base + c.bid) < T / 128; const int mt = valid ? base + c.bid : 0;
        const bf16_t* a0 = XBF + (size_t)(mt * 128 + (c.tid >> 2)) * 1024;
        const bf16_t* b0 = W + (size_t)(c.tid >> 2) * 1024;
        f32x4 acc[4][4];
        gemm_tile(a0, a0 + 64 * 1024, b0, b0 + 64 * 1024, 32, acc, c);
        if (c.wc == 0 && valid) {
#pragma unroll
            for (int m = 0; m < 4; ++m) {
                const int row = mt * 128 + c.wr * 64 + m * 16 + c.fr;
#pragma unroll
                for (int n = 0; n < 4; ++n) *(f32x4*)(LOG + (size_t)row * 64 + n * 16 + c.fq * 4) = acc[m][n];
            }
        }
    }
}

__device__ __forceinline__ void build_block_table(const unsigned* CNT, int* bst, const Ctx& c) {
    __syncthreads();
    if (c.wid == 0) {
        const int cnt = (int)__hip_atomic_load(CNT + c.lane, __ATOMIC_RELAXED, __HIP_MEMORY_SCOPE_AGENT);
        const int nb = (cnt + RBR - 1) / RBR;
        int inc = nb;
#pragma unroll
        for (int o = 1; o < 64; o <<= 1) { const int x = __shfl_up(inc, o); if (c.lane >= o) inc += x; }
        bst[c.lane] = inc - nb; bst[66 + c.lane] = cnt;
        if (c.lane == 63) { bst[64] = inc; bst[65] = inc + T / RBR; bst[66 + 64] = T; }
    }
    __syncthreads();
}
__device__ __forceinline__ int find_expert(const int* bst, int rb, const Ctx& c) {
    return __popcll(__ballot(bst[1 + c.lane] <= rb));
}

__device__ __forceinline__ void phase_moe1(const bf16_t* XBF, const bf16_t* WGU, const unsigned* CNT, const int* LTOK, const float* LW, bf16_t* HBUF, const Ctx& c) {
    int* bst = (int*)(c.smem + 65536 + 64);
    build_block_table(CNT, bst, c);
    const int nsb = bst[65] * 2;
    for (int i = 0;; ++i) {
        int sbk, nt; bool valid; if (!tile_map2(i, c, nsb, 4, sbk, nt, valid)) break;
        const int rb = sbk >> 1, hb = sbk & 1;
        const int e = find_expert(bst, rb, c);
        const int lb = rb - bst[e], cnt = bst[66 + e];
        const int p0 = lb * RBR + hb * 128 + (c.tid >> 2), p1 = p0 + 64;
        const int t0 = (p0 < cnt) ? LTOK[(size_t)e * CAP + p0] : 0;
        const int t1 = (p1 < cnt) ? LTOK[(size_t)e * CAP + p1] : 0;
        const bf16_t* a0 = XBF + (size_t)t0 * 1024;
        const bf16_t* a1 = XBF + (size_t)t1 * 1024;
        const bf16_t* b0 = WGU + (size_t)e * WGU_ELEMS + (size_t)(nt * 128 + (c.tid >> 2)) * 1024;
        f32x4 acc[4][4];
        gemm_tile(a0, a1, b0, b0 + 64 * 1024, 32, acc, c);
#pragma unroll
        for (int m = 0; m < 4; ++m) {
            const int rl = c.wr * 64 + m * 16 + c.fr;
            const int pw = lb * RBR + hb * 128 + rl;
            const float wrow = (pw < cnt) ? LW[(size_t)e * CAP + pw] : 0.f;
#pragma unroll
            for (int n = 0; n < 2; ++n) {
                const f32x4 g = acc[m][n], up = acc[m][n + 2];
                float h[4];
#pragma unroll
                for (int j = 0; j < 4; ++j) h[j] = siluf_(g[j]) * up[j] * wrow;
                tile_put(c, rl, c.wc * 32 + n * 16 + c.fq * 4, (u32x2){pk2(h[0], h[1]), pk2(h[2], h[3])});
            }
        }
        tile_flush<64>(c, HBUF + ((size_t)rb * RBR + hb * 128) * 256 + nt * 64, 256, valid);
    }
}

__device__ __forceinline__ void phase_moe2(const bf16_t* HBUF, const bf16_t* WDN, const unsigned* CNT, bf16_t* Y, const Ctx& c) {
    int* bst = (int*)(c.smem + 65536 + 64);
    build_block_table(CNT, bst, c);
    const int nsb = bst[65] * 2;
    for (int i = 0;; ++i) {
        int sbk, nt; bool valid; if (!tile_map2(i, c, nsb, 8, sbk, nt, valid)) break;
        const int rb = sbk >> 1;
        const int e = find_expert(bst, rb, c);
        const bf16_t* a0 = HBUF + ((size_t)sbk * 128 + (c.tid >> 2)) * 256;
        const bf16_t* b0 = WDN + (size_t)e * WDN_ELEMS + (size_t)(nt * 128 + (c.tid >> 2)) * 256;
        f32x4 acc[4][4];
        gemm_tile(a0, a0 + 64 * 256, b0, b0 + 64 * 256, 8, acc, c);
#pragma unroll
        for (int m = 0; m < 4; ++m) {
            const int lr = c.wr * 64 + m * 16 + c.fr;
#pragma unroll
            for (int n = 0; n < 4; ++n) {
                const f32x4 v = acc[m][n];
                tile_put(c, lr, c.wc * 64 + n * 16 + c.fq * 4, (u32x2){pk2(v[0], v[1]), pk2(v[2], v[3])});
            }
        }
        tile_flush<128>(c, Y + (size_t)sbk * 128 * 1024 + nt * 128, 1024, valid);
    }
}

__device__ __forceinline__ float dppf(float v, int ctrl_sel) {
    int x = __builtin_bit_cast(int, v), r;
    if (ctrl_sel == 0) r = __builtin_amdgcn_update_dpp(0, x, 0xB1, 0xF, 0xF, true);
    else if (ctrl_sel == 1) r = __builtin_amdgcn_update_dpp(0, x, 0x4E, 0xF, 0xF, true);
    else if (ctrl_sel == 2) r = __builtin_amdgcn_update_dpp(0, x, 0x141, 0xF, 0xF, true);
    else r = __builtin_amdgcn_update_dpp(0, x, 0x140, 0xF, 0xF, true);
    return __builtin_bit_cast(float, r);
}
__device__ __forceinline__ float red16(float v) { v += dppf(v, 0); v += dppf(v, 1); v += dppf(v, 2); v += dppf(v, 3); return v; }

__device__ __forceinline__ void ln_row_store(float (&v)[16], const float* g, const float* b, float* of32, bf16_t* obf, int lane) {
    float s = 0.f;
#pragma unroll
    for (int i = 0; i < 16; ++i) s += v[i];
    const float mean = wave_sum(s) * (1.f / 1024.f);
    float q = 0.f;
#pragma unroll
    for (int i = 0; i < 16; ++i) { v[i] -= mean; q += v[i] * v[i]; }
    const float rstd = rsqrtf(wave_sum(q) * (1.f / 1024.f) + 1e-5f);
#pragma unroll
    for (int hf = 0; hf < 2; ++hf) {
        const int col = hf * 512 + lane * 8;
        const f32x4 g0 = *(const f32x4*)(g + col), g1 = *(const f32x4*)(g + col + 4);
        const f32x4 b0 = *(const f32x4*)(b + col), b1 = *(const f32x4*)(b + col + 4);
        f32x4 y0, y1;
#pragma unroll
        for (int j = 0; j < 4; ++j) { y0[j] = v[hf * 8 + j] * rstd * g0[j] + b0[j]; y1[j] = v[hf * 8 + 4 + j] * rstd * g1[j] + b1[j]; }
        *(f32x4*)(of32 + col) = y0; *(f32x4*)(of32 + col + 4) = y1;
        *(u32x4*)(obf + col) = (u32x4){pk2(y0[0], y0[1]), pk2(y0[2], y0[3]), pk2(y1[0], y1[1]), pk2(y1[2], y1[3])};
    }
}

__device__ __forceinline__ void phase_ln1(const float* YBUF, const float* g, const float* b, float* X1, bf16_t* XBF, const Ctx& c) {
    for (int t = c.bid * 4 + c.wid; t < T; t += c.nblk * 4) {
        float v[16];
#pragma unroll
        for (int hf = 0; hf < 2; ++hf) {
            const float* p = YBUF + (size_t)t * 1024 + hf * 512 + c.lane * 8;
            const f32x4 a0 = *(const f32x4*)p, a1 = *(const f32x4*)(p + 4);
#pragma unroll
            for (int j = 0; j < 4; ++j) { v[hf * 8 + j] = a0[j]; v[hf * 8 + 4 + j] = a1[j]; }
        }
        ln_row_store(v, g, b, X1 + (size_t)t * 1024, XBF + (size_t)t * 1024, c.lane);
    }
}

__device__ __forceinline__ void phase_combine(const float* X1, const bf16_t* Y, const int* ASG, const unsigned* CNT, const float* g, const float* b,
                              float* XOUT, bf16_t* XBF, const Ctx& c) {
    int* bst = (int*)(c.smem + 65536 + 64);
    build_block_table(CNT, bst, c);
    for (int t = c.bid * 4 + c.wid; t < T; t += c.nblk * 4) {
        float v[16];
#pragma unroll
        for (int hf = 0; hf < 2; ++hf) {
            const float* p = X1 + (size_t)t * 1024 + hf * 512 + c.lane * 8;
            const f32x4 a0 = *(const f32x4*)p, a1 = *(const f32x4*)(p + 4);
#pragma unroll
            for (int j = 0; j < 4; ++j) { v[hf * 8 + j] = a0[j] * ALPHA; v[hf * 8 + 4 + j] = a1[j] * ALPHA; }
        }
#pragma unroll
        for (int k = 0; k < 9; ++k) {
            size_t crow;
            if (k < 8) { const int asg = ASG[(size_t)t * 8 + k]; crow = (size_t)bst[asg >> 16] * RBR + (asg & 0xffff); }
            else crow = (size_t)bst[64] * RBR + t;
#pragma unroll
            for (int hf = 0; hf < 2; ++hf) {
                const u32x4 r = *(const u32x4*)(Y + crow * 1024 + hf * 512 + c.lane * 8);
                float f[8]; unpack8(r, f);
#pragma unroll
                for (int j = 0; j < 8; ++j) v[hf * 8 + j] += f[j];
            }
        }
        ln_row_store(v, g, b, XOUT + (size_t)t * 1024, XBF + (size_t)t * 1024, c.lane);
    }
}

__device__ __forceinline__ void phase_route(const float* LOG, const float* rb, unsigned* CNT, int* LTOK, float* LW, int* ASG, const Ctx& c) {
    int* lcnt = (int*)c.smem;
    int* lbase = lcnt + 64;
    int* sel_e = lbase + 64;
    int* sel_p = sel_e + 256;
    float* sel_w = (float*)(sel_p + 256);
    const float rbias = rb[c.lane];
    for (int base = 0; base < T / 32; base += c.nblk) {
        const int ch = base + c.bid; const bool valid = ch < T / 32;
        __syncthreads();
        if (c.tid < 64) lcnt[c.tid] = 0;
        __syncthreads();
        if (valid) for (int tl = c.wid; tl < 32; tl += 4) {
            const int t = ch * 32 + tl;
            const float lg = LOG[(size_t)t * 64 + c.lane];
            const float sc = 1.f / (1.f + expf(-lg));
            const float v = sc + rbias;
            float m1 = v;
            m1 = fmaxf(m1, __shfl_xor(m1, 1)); m1 = fmaxf(m1, __shfl_xor(m1, 2)); m1 = fmaxf(m1, __shfl_xor(m1, 4));
            int cand = (v == m1) ? c.lane : 999;
            cand = min(cand, __shfl_xor(cand, 1)); cand = min(cand, __shfl_xor(cand, 2)); cand = min(cand, __shfl_xor(cand, 4));
            float m2 = (c.lane == cand) ? -INFINITY : v;
            m2 = fmaxf(m2, __shfl_xor(m2, 1)); m2 = fmaxf(m2, __shfl_xor(m2, 2)); m2 = fmaxf(m2, __shfl_xor(m2, 4));
            const float gs = m1 + m2;
            const int g = c.lane >> 3;
            int grank = 0;
#pragma unroll
            for (int gg = 0; gg < 8; ++gg) { const float o = __shfl(gs, gg * 8); grank += ((o > gs) || (o == gs && gg < g)) ? 1 : 0; }
            const bool gsel = grank < 4;
            const float mv = gsel ? v : -INFINITY;
            int rank = 0;
#pragma unroll 8
            for (int jj = 0; jj < 64; ++jj) { const float o = __shfl(mv, jj); rank += ((o > mv) || (o == mv && jj < c.lane)) ? 1 : 0; }
            const bool sel = gsel && rank < 8;
            const float ssum = wave_sum(sel ? sc : 0.f);
            const float w = sc / ssum * 2.5f;
            const unsigned long long bal = __ballot(sel);
            const int slot = __popcll(bal & ((1ull << c.lane) - 1ull));
            if (sel) {
                const int p = atomicAdd(&lcnt[c.lane], 1);
                sel_e[tl * 8 + slot] = c.lane; sel_p[tl * 8 + slot] = p; sel_w[tl * 8 + slot] = w;
            }
        }
        __syncthreads();
        if (valid && c.tid < 64) { const int n = lcnt[c.tid]; lbase[c.tid] = n ? (int)atomicAdd(CNT + c.tid, (unsigned)n) : 0; }
        __syncthreads();
        if (valid) {
            const int tl = c.tid >> 3, t = ch * 32 + tl;
            const int e = sel_e[c.tid], pos = lbase[e] + sel_p[c.tid];
            LTOK[(size_t)e * CAP + pos] = t; LW[(size_t)e * CAP + pos] = sel_w[c.tid];
            ASG[(size_t)t * 8 + (c.tid & 7)] = (e << 16) | pos;
            if (c.tid < 32) { const int ts = ch * 32 + c.tid; LTOK[(size_t)64 * CAP + ts] = ts; LW[(size_t)64 * CAP + ts] = 1.f; }
        }
    }
}

__device__ __forceinline__ void phase_prep_even(const bf16_t* PROJ, const float* GATES, const float* qn, const float* kvn, const float* cw,
                                const float* a_log, const float* dt_bias, const float* ROPEM,
                                bf16_t* CQ, bf16_t* CKV, bf16_t* KROPE, bf16_t* GQ, bf16_t* GK, bf16_t* GV, float* BETA, float* GLOG, const Ctx& c) {
    const int lane = c.lane;
    float* cwL = (float*)c.smem;
    __syncthreads();
    for (int i = c.tid; i < 4 * 1536 / 4; i += 256) *(f32x4*)(cwL + i * 4) = *(const f32x4*)(cw + i * 4);
    __syncthreads();
    for (int t = c.bid * 4 + c.wid; t < T; t += c.nblk * 4) {
        const bf16_t* pr = PROJ + (size_t)t * NPAD;
        {
            const u32x2 r = *(const u32x2*)(pr + lane * 4);
            float v[4] = {bflo(r.x), bfhi(r.x), bflo(r.y), bfhi(r.y)};
            const float ss = wave_sum(v[0] * v[0] + v[1] * v[1] + v[2] * v[2] + v[3] * v[3]);
            const float rr = rsqrtf(ss * (1.f / 256.f) + 1e-6f);
            const f32x4 gq = *(const f32x4*)(qn + lane * 4);
            *(u32x2*)(CQ + (size_t)t * 256 + lane * 4) = (u32x2){pk2(v[0] * rr * gq[0], v[1] * rr * gq[1]), pk2(v[2] * rr * gq[2], v[3] * rr * gq[3])};
        }
        {
            const unsigned r = *(const unsigned*)(pr + 256 + lane * 2);
            const float v0 = bflo(r), v1 = bfhi(r);
            const float ss = wave_sum(v0 * v0 + v1 * v1);
            const float rr = rsqrtf(ss * (1.f / 128.f) + 1e-6f);
            *(unsigned*)(CKV + (size_t)t * 128 + lane * 2) = pk2(v0 * rr * kvn[lane * 2], v1 * rr * kvn[lane * 2 + 1]);
        }
        if (lane < 16) {
            const float x1 = bf2f(pr[384 + lane]), x2 = bf2f(pr[400 + lane]);
            const float cs = ROPEM[((size_t)t * 16 + lane) * 2], sn = ROPEM[((size_t)t * 16 + lane) * 2 + 1];
            KROPE[(size_t)t * 32 + lane] = (bf16_t)f2bf(x1 * cs - x2 * sn);
            KROPE[(size_t)t * 32 + 16 + lane] = (bf16_t)f2bf(x2 * cs + x1 * sn);
        }
        const int s = t & (SEQ - 1);
        u32x4 xr[3][4];
#pragma unroll
        for (int arr = 0; arr < 3; ++arr)
#pragma unroll
            for (int w = 0; w < 4; ++w)
                xr[arr][w] = (s - 3 + w >= 0) ? *(const u32x4*)(PROJ + (size_t)(t - 3 + w) * NPAD + 416 + arr * 512 + lane * 8) : (u32x4){0u, 0u, 0u, 0u};
#pragma unroll
        for (int arr = 0; arr < 3; ++arr) {
            float y[8];
#pragma unroll
            for (int j = 0; j < 8; ++j) y[j] = 0.f;
#pragma unroll
            for (int w = 0; w < 4; ++w) {
                float f[8]; unpack8(xr[arr][w], f);
                const f32x4 c0 = *(const f32x4*)(cwL + w * 1536 + arr * 512 + lane * 8), c1 = *(const f32x4*)(cwL + w * 1536 + arr * 512 + lane * 8 + 4);
#pragma unroll
                for (int j = 0; j < 4; ++j) { y[j] += c0[j] * f[j]; y[4 + j] += c1[j] * f[4 + j]; }
            }
            float ss = 0.f;
#pragma unroll
            for (int j = 0; j < 8; ++j) { y[j] = siluf_(y[j]); ss += y[j] * y[j]; }
            if (arr < 2) {
                float rr = rsqrtf(red16(ss) + 1e-6f);
                if (arr == 0) rr *= 0.08838834764831845f;
#pragma unroll
                for (int j = 0; j < 8; ++j) y[j] *= rr;
            }
            bf16_t* dst = (arr == 0) ? GQ : (arr == 1) ? GK : GV;
            *(u32x4*)(dst + (size_t)t * 512 + lane * 8) = (u32x4){pk2(y[0], y[1]), pk2(y[2], y[3]), pk2(y[4], y[5]), pk2(y[6], y[7])};
        }
        if (lane < 4) BETA[(size_t)t * 4 + lane] = sigmoidf_(GATES[(size_t)t * 8 + lane]);
        else if (lane < 8) { const int h = lane - 4; GLOG[(size_t)t * 4 + h] = -expf(a_log[h]) * softplusf_(GATES[(size_t)t * 8 + lane] + dt_bias[h]); }
    }
}

__device__ __forceinline__ void phase_prep_odd(const bf16_t* PROJ, const float* ROPES, bf16_t* SQ, bf16_t* SK, const Ctx& c) {
    const int lane = c.lane;
    for (int t = c.bid * 4 + c.wid; t < T; t += c.nblk * 4) {
        const bf16_t* pr = PROJ + (size_t)t * NPAD;
        const int i = lane & 31;
        const float cs = ROPES[((size_t)t * 32 + i) * 2], sn = ROPES[((size_t)t * 32 + i) * 2 + 1];
#pragma unroll
        for (int r = 0; r < 4; ++r) {
            const int h = (lane >> 5) + 2 * r;
            const float x1 = bf2f(pr[1544 + h * 64 + i]), x2 = bf2f(pr[1544 + h * 64 + 32 + i]);
            SQ[(size_t)t * 512 + h * 64 + i] = (bf16_t)f2bf((x1 * cs - x2 * sn) * 0.18033688011112042f);
            SQ[(size_t)t * 512 + h * 64 + 32 + i] = (bf16_t)f2bf((x2 * cs + x1 * sn) * 0.18033688011112042f);
        }
        {
            const int h = lane >> 5;
            const float x1 = bf2f(pr[2056 + h * 64 + i]), x2 = bf2f(pr[2056 + h * 64 + 32 + i]);
            SK[(size_t)t * 128 + h * 64 + i] = (bf16_t)f2bf(x1 * cs - x2 * sn);
            SK[(size_t)t * 128 + h * 64 + 32 + i] = (bf16_t)f2bf(x2 * cs + x1 * sn);
        }
    }
}

__device__ __forceinline__ int next_unit(unsigned* ctr, const Ctx& c) {
    volatile int* su = (volatile int*)(c.smem0 + LDS_BLK + 16);
    __syncthreads();
    if (c.tid0 == 0) *su = (int)atomicAdd(ctr, 1u);
    __syncthreads();
    return *su * 2 + c.half;
}

typedef float f32x16 __attribute__((ext_vector_type(16)));
typedef short s16x4 __attribute__((ext_vector_type(4)));
#define MFMA32(a, b, c) __builtin_amdgcn_mfma_f32_32x32x16_bf16((a), (b), (c), 0, 0, 0)
template <int S_> __device__ __forceinline__ bf16x8 pack_step(const f32x16& x) {
    u32x4 p;
    asm volatile("v_cvt_pk_bf16_f32 %0, %4, %5\n\tv_cvt_pk_bf16_f32 %1, %6, %7\n\tv_cvt_pk_bf16_f32 %2, %8, %9\n\tv_cvt_pk_bf16_f32 %3, %10, %11\n\ts_nop 1"
                 : "=&v"(p[0]), "=&v"(p[1]), "=&v"(p[2]), "=&v"(p[3])
                 : "v"(x[8 * S_]), "v"(x[8 * S_ + 1]), "v"(x[8 * S_ + 2]), "v"(x[8 * S_ + 3]), "v"(x[8 * S_ + 4]), "v"(x[8 * S_ + 5]), "v"(x[8 * S_ + 6]), "v"(x[8 * S_ + 7]));
    return __builtin_bit_cast(bf16x8, p);
}
template <int S_> __device__ __forceinline__ bf16x8 pack_step_m(const f32x16& x) {
    u32x4 p;
    asm volatile("s_nop 15\n\tv_cvt_pk_bf16_f32 %0, %4, %5\n\tv_cvt_pk_bf16_f32 %1, %6, %7\n\tv_cvt_pk_bf16_f32 %2, %8, %9\n\tv_cvt_pk_bf16_f32 %3, %10, %11\n\ts_nop 1"
                 : "=&v"(p[0]), "=&v"(p[1]), "=&v"(p[2]), "=&v"(p[3])
                 : "v"(x[8 * S_]), "v"(x[8 * S_ + 1]), "v"(x[8 * S_ + 2]), "v"(x[8 * S_ + 3]), "v"(x[8 * S_ + 4]), "v"(x[8 * S_ + 5]), "v"(x[8 * S_ + 6]), "v"(x[8 * S_ + 7]));
    return __builtin_bit_cast(bf16x8, p);
}
constexpr int ATT_VB = 64 * 128;

template <int NKS, bool WIN>
__device__ __forceinline__ void attn_unit(const bf16_t* Qp, int q_ld, const bf16_t* K1, int k1_ld, const bf16_t* K2, int k2_ld, const bf16_t* Vp, int v_ld,
                          bf16_t* Op, int o_ld, int Q0, float sink_l2, const Ctx& c) {
    constexpr int KB = NKS * 2 * 1024, BUF = KB + ATT_VB;
    const int lane = c.lane, r = lane & 31, h = lane >> 5;
    const int wid = __builtin_amdgcn_readfirstlane(c.wid);
    const int q0w = Q0 + wid * 32;
    unsigned char* smem = c.smem;
    bf16x8 qf[NKS];
#pragma unroll
    for (int ks = 0; ks < NKS; ++ks) qf[ks] = *(const bf16x8*)(Qp + (size_t)(q0w + r) * q_ld + ks * 16 + h * 8);
    f32x16 o0, o1;
#pragma unroll
    for (int i = 0; i < 16; ++i) { o0[i] = 0.f; o1[i] = 0.f; }
    float m = WIN ? sink_l2 : -1e30f, l = (WIN && h == 0) ? 1.f : 0.f;
    const int kt_lo = WIN ? ((Q0 >> 6) - 2 < 0 ? 0 : (Q0 >> 6) - 2) : 0, kt_hi = (Q0 >> 6) + 1;
#define ATT_STAGE(kt_, buf_) do { unsigned char* bp = smem + (buf_) * BUF; const size_t kb = (size_t)(kt_) * 64; \
        _Pragma("unroll") for (int i = 0; i < (NKS * 2) / 4; ++i) { const int ch = wid + 4 * i; \
            const bf16_t* sp = (ch < 8) ? (K1 + (kb + lane) * k1_ld + ch * 8) : (K2 + (kb + lane) * k2_ld + (ch - 8) * 8); \
            glds16(sp, bp + ch * 1024 + lane * 16); } \
        _Pragma("unroll") for (int i = 0; i < 2; ++i) { const int j = wid + 4 * i; \
            glds16(Vp + (kb + 8 * j + (lane >> 3)) * v_ld + (lane & 7) * 8, bp + KB + j * 1024 + lane * 16); } } while (0)
    ATT_STAGE(kt_lo, 0);
    const int i16 = lane & 15;
    const unsigned vlane = (unsigned)((4 * h + (i16 >> 2)) * 128 + 32 * ((lane >> 4) & 1) + 8 * (i16 & 3));
    for (int kt = kt_lo; kt <= kt_hi; ++kt) {
        const int cur = (kt - kt_lo) & 1;
        asm volatile("s_waitcnt vmcnt(0)" ::: "memory");
        __syncthreads();
        if (kt < kt_hi) ATT_STAGE(kt + 1, cur ^ 1);
        const int k0 = kt * 64;
        const bool active = (k0 <= q0w + 31) && (!WIN || (k0 + 63 > q0w - 128));
        if (active) {
            const unsigned char* Kt = smem + cur * BUF;
            f32x16 x0, x1;
#pragma unroll
            for (int i = 0; i < 16; ++i) { x0[i] = 0.f; x1[i] = 0.f; }
#pragma unroll
            for (int ks = 0; ks < NKS; ++ks) {
                const bf16x8 kf0 = *(const bf16x8*)(Kt + (ks * 2 + h) * 1024 + r * 16);
                const bf16x8 kf1 = *(const bf16x8*)(Kt + (ks * 2 + h) * 1024 + (32 + r) * 16);
                x0 = MFMA32(kf0, qf[ks], x0); x1 = MFMA32(kf1, qf[ks], x1);
            }
            const bool need_mask = (k0 + 63 > q0w) || (WIN && (k0 <= q0w + 31 - 128));
            if (need_mask) {
                const int q = q0w + r;
#pragma unroll
                for (int i = 0; i < 16; ++i) {
                    const int key = k0 + (i & 3) + 8 * (i >> 2) + 4 * h;
                    const bool v0 = (key <= q) && (!WIN || key > q - 128);
                    const bool v1 = (key + 32 <= q) && (!WIN || key + 32 > q - 128);
                    x0[i] = v0 ? x0[i] : -INFINITY; x1[i] = v1 ? x1[i] : -INFINITY;
                }
            }
            float mx = fmaxf(x0[0], x1[0]);
#pragma unroll
            for (int i = 1; i < 16; ++i) mx = fmaxf(mx, fmaxf(x0[i], x1[i]));
            mx = fmaxf(mx, __shfl_xor(mx, 32));
            const float mn = fmaxf(m, mx);
            const float alpha = __builtin_amdgcn_exp2f(m - mn);
            m = mn;
            float ps = 0.f;
#pragma unroll
            for (int i = 0; i < 16; ++i) { x0[i] = __builtin_amdgcn_exp2f(x0[i] - mn); x1[i] = __builtin_amdgcn_exp2f(x1[i] - mn); ps += x0[i] + x1[i]; }
            l = l * alpha + ps;
            o0 *= alpha; o1 *= alpha;
            const unsigned vbase = (unsigned)(size_t)(smem + cur * BUF + KB) + vlane;
#pragma unroll
            for (int t = 0; t < 2; ++t) {
                s16x4 l00, h00, l01, h01, l10, h10, l11, h11;
                const unsigned va = vbase + t * 4096;
                asm volatile("ds_read_b64_tr_b16 %0, %8\n\t"
                             "ds_read_b64_tr_b16 %1, %8 offset:1024\n\t"
                             "ds_read_b64_tr_b16 %2, %8 offset:64\n\t"
                             "ds_read_b64_tr_b16 %3, %8 offset:1088\n\t"
                             "ds_read_b64_tr_b16 %4, %8 offset:2048\n\t"
                             "ds_read_b64_tr_b16 %5, %8 offset:3072\n\t"
                             "ds_read_b64_tr_b16 %6, %8 offset:2112\n\t"
                             "ds_read_b64_tr_b16 %7, %8 offset:3136\n\t"
                             "s_waitcnt lgkmcnt(0)"
                             : "=&v"(l00), "=&v"(h00), "=&v"(l01), "=&v"(h01), "=&v"(l10), "=&v"(h10), "=&v"(l11), "=&v"(h11) : "v"(va) : "memory");
                const bf16x8 v00 = __builtin_shufflevector(l00, h00, 0, 1, 2, 3, 4, 5, 6, 7), v01 = __builtin_shufflevector(l01, h01, 0, 1, 2, 3, 4, 5, 6, 7);
                const bf16x8 v10 = __builtin_shufflevector(l10, h10, 0, 1, 2, 3, 4, 5, 6, 7), v11 = __builtin_shufflevector(l11, h11, 0, 1, 2, 3, 4, 5, 6, 7);
                const bf16x8 pb0 = (t == 0) ? pack_step<0>(x0) : pack_step<0>(x1);
                const bf16x8 pb1 = (t == 0) ? pack_step<1>(x0) : pack_step<1>(x1);
                o0 = MFMA32(v00, pb0, o0); o1 = MFMA32(v01, pb0, o1);
                o0 = MFMA32(v10, pb1, o0); o1 = MFMA32(v11, pb1, o1);
            }
        }
    }
#undef ATT_STAGE
    l += __shfl_xor(l, 32);
    const float inv = 1.f / l;
    bf16_t* orow = Op + (size_t)(q0w + r) * o_ld + 4 * h;
#pragma unroll
    for (int g = 0; g < 4; ++g) {
        *(u32x2*)(orow + 8 * g) = (u32x2){pk2(o0[4 * g] * inv, o0[4 * g + 1] * inv), pk2(o0[4 * g + 2] * inv, o0[4 * g + 3] * inv)};
        *(u32x2*)(orow + 32 + 8 * g) = (u32x2){pk2(o1[4 * g] * inv, o1[4 * g + 1] * inv), pk2(o1[4 * g + 2] * inv, o1[4 * g + 3] * inv)};
    }
}

constexpr size_t MLC_DC = 0, MLC_CS = 33554432, MLC_DN = MLC_CS + 16777216, MLC_NS = MLC_DN + 262144, MLC_ML = MLC_NS + 262144, MLC_BE = MLC_ML + 4096, MLC_MS = MLC_BE + 4096;

__device__ __forceinline__ float scan_add64(float v, int lane) {
#pragma unroll
    for (int o = 1; o < 64; o <<= 1) { const float x = __shfl_up(v, o); if (lane >= o) v += x; }
    return v;
}
__device__ __forceinline__ float scan_max64(float v, int lane) {
#pragma unroll
    for (int o = 1; o < 64; o <<= 1) { const float x = __shfl_up(v, o); if (lane >= o) v = fmaxf(v, x); }
    return v;
}
__device__ __forceinline__ float wave_max(float v) {
#pragma unroll
    for (int o = 32; o > 0; o >>= 1) v = fmaxf(v, __shfl_xor(v, o));
    return v;
}

__device__ __forceinline__ void mlc_passA(int u, const bf16_t* PROJ, const float* GATES, const float* b_i, const float* b_f, unsigned char* YB, const Ctx& c) {
    const int bh = u >> 5, b = bh >> 2, h = bh & 3;
    const size_t t0 = (size_t)b * SEQ + (u & 31) * 64;
    unsigned char* smem = c.smem;
    float* saL = (float*)(smem + 24576);
    const int lane = c.lane, wid = __builtin_amdgcn_readfirstlane(c.wid);
#pragma unroll
    for (int i = 0; i < 4; ++i) { const int j = wid * 4 + i;
        glds16(PROJ + (t0 + 4 * j + (lane >> 4)) * NPAD + 512 + h * 128 + (lane & 15) * 8, smem + 8192 + j * 1024 + lane * 16); }
    if (wid == 0) {
        const float ip = GATES[(t0 + lane) * 8 + h] + b_i[h], lf = -softplusf_(-(GATES[(t0 + lane) * 8 + 4 + h] + b_f[h]));
        const float bc = scan_add64(lf, lane), bend = __shfl(bc, 63);
        const float a = bend - bc + ip, mloc = wave_max(a);
        saL[lane] = expf(a - mloc) * 0.125f;
        if (lane == 0) { ((float*)(YB + MLC_ML))[u] = mloc; ((float*)(YB + MLC_BE))[u] = bend; }
    }
    __syncthreads();
#pragma unroll
    for (int i = 0; i < 2; ++i) {
        const int idx = c.tid + 256 * i, row = idx >> 3, chk = idx & 7;
        const u32x4 r = *(const u32x4*)(PROJ + (t0 + row) * NPAD + 256 + h * 64 + chk * 8);
        float f[8]; unpack8(r, f);
        const float s = saL[row];
        *(u32x4*)(smem + row * 128 + chk * 16) = (u32x4){pk2(f[0] * s, f[1] * s), pk2(f[2] * s, f[3] * s), pk2(f[4] * s, f[5] * s), pk2(f[6] * s, f[7] * s)};
    }
    asm volatile("s_waitcnt vmcnt(0)" ::: "memory");
    __syncthreads();
    const int h5 = lane >> 5, r = lane & 31, i16 = lane & 15, q4 = i16 >> 2, p = i16 & 3, blk = (lane >> 4) & 1;
    const int dkt = wid & 1, dvp = wid >> 1;
    const unsigned kaddr = (unsigned)(size_t)smem + (unsigned)((8 * h5 + q4) * 128 + dkt * 64 + 32 * blk + 8 * p);
    const unsigned vaddr = (unsigned)(size_t)smem + 8192u + (unsigned)((8 * h5 + q4) * 256 + dvp * 128 + 32 * blk + 8 * p);
    f32x16 a0, a1;
#pragma unroll
    for (int i = 0; i < 16; ++i) { a0[i] = 0.f; a1[i] = 0.f; }
#pragma unroll
    for (int st = 0; st < 4; ++st) {
        s16x4 kl, kh, v0l, v0h, v1l, v1h;
        const unsigned ka = kaddr + st * 2048, va = vaddr + st * 4096;
        asm volatile("ds_read_b64_tr_b16 %0, %6\n\t"
                     "ds_read_b64_tr_b16 %1, %6 offset:512\n\t"
                     "ds_read_b64_tr_b16 %2, %7\n\t"
                     "ds_read_b64_tr_b16 %3, %7 offset:1024\n\t"
                     "ds_read_b64_tr_b16 %4, %7 offset:64\n\t"
                     "ds_read_b64_tr_b16 %5, %7 offset:1088\n\t"
                     "s_waitcnt lgkmcnt(0)"
                     : "=&v"(kl), "=&v"(kh), "=&v"(v0l), "=&v"(v0h), "=&v"(v1l), "=&v"(v1h) : "v"(ka), "v"(va) : "memory");
        const bf16x8 kf = __builtin_shufflevector(kl, kh, 0, 1, 2, 3, 4, 5, 6, 7);
        const bf16x8 vf0 = __builtin_shufflevector(v0l, v0h, 0, 1, 2, 3, 4, 5, 6, 7), vf1 = __builtin_shufflevector(v1l, v1h, 0, 1, 2, 3, 4, 5, 6, 7);
        a0 = MFMA32(kf, vf0, a0); a1 = MFMA32(kf, vf1, a1);
    }
    float* DC = (float*)(YB + MLC_DC) + (size_t)u * 8192;
#pragma unroll
    for (int i = 0; i < 16; ++i) {
        const int dk = dkt * 32 + (i & 3) + 8 * (i >> 2) + 4 * h5;
        DC[dk * 128 + dvp * 64 + r] = a0[i]; DC[dk * 128 + dvp * 64 + 32 + r] = a1[i];
    }
    if (c.tid < 64) {
        float s = 0.f;
#pragma unroll 8
        for (int t = 0; t < 64; ++t) s += bf2f(((const bf16_t*)smem)[t * 64 + c.tid]);
        ((float*)(YB + MLC_DN))[(size_t)u * 64 + c.tid] = s;
    }
}

__device__ __forceinline__ void mlc_passB(int u, unsigned char* YB, const Ctx& c) {
    const int bh = u >> 3, sl = u & 7;
    const float* ML = (const float*)(YB + MLC_ML) + bh * 32; const float* BE = (const float*)(YB + MLC_BE) + bh * 32;
    const float* DC = (const float*)(YB + MLC_DC) + (size_t)bh * 32 * 8192 + sl * 1024 + c.tid * 4;
    bf16_t* CS = (bf16_t*)(YB + MLC_CS) + (size_t)bh * 32 * 8192 + sl * 1024 + c.tid * 4;
    const float* DN = (const float*)(YB + MLC_DN) + (size_t)bh * 32 * 64; float* NS = (float*)(YB + MLC_NS) + (size_t)bh * 32 * 64; float* MS = (float*)(YB + MLC_MS) + bh * 32;
    f32x4 C4 = (f32x4){0.f, 0.f, 0.f, 0.f}; float nv = 0.f, m = 0.f;
    const bool do_n = (sl == 0) && (c.tid < 64);
#pragma unroll 4
    for (int n = 0; n < 32; ++n) {
        *(u32x2*)(CS + (size_t)n * 8192) = (u32x2){pk2(C4[0], C4[1]), pk2(C4[2], C4[3])};
        if (do_n) NS[n * 64 + c.tid] = nv;
        if (sl == 0 && c.tid == 0) MS[n] = m;
        const float be = BE[n], ml = ML[n];
        const float mn = fmaxf(be + m, ml), keep = expf(be + m - mn), g = expf(ml - mn);
        m = mn;
        const f32x4 d = *(const f32x4*)(DC + (size_t)n * 8192);
        C4 = C4 * keep + d * g;
        if (do_n) nv = nv * keep + DN[n * 64 + c.tid] * g;
    }
}

__device__ __forceinline__ void mlc_passC(int u, const bf16_t* PROJ, const float* GATES, const float* b_i, const float* b_f, const unsigned char* YB,
                                          const float* gain  , bf16_t* MIXO, const Ctx& c) {
    const int bh = u >> 5, b = bh >> 2, h = bh & 3;
    const size_t t0 = (size_t)b * SEQ + (u & 31) * 64;
    unsigned char* smem = c.smem;
    float* csL = (float*)(smem + 32768); float* pmL = (float*)(smem + 33024); float* bcL = (float*)(smem + 33280); float* nnL = (float*)(smem + 33536); float* sqL = (float*)(smem + 33792);
    const int lane = c.lane, wid = __builtin_amdgcn_readfirstlane(c.wid);
    const bf16_t* CS = (const bf16_t*)(YB + MLC_CS) + (size_t)u * 8192;
#pragma unroll
    for (int i = 0; i < 4; ++i) { const int j = wid * 4 + i;
        glds16(PROJ + (t0 + 4 * j + (lane >> 4)) * NPAD + 512 + h * 128 + (lane & 15) * 8, smem + j * 1024 + lane * 16);
        glds16(CS + (4 * j + (lane >> 4)) * 128 + (lane & 15) * 8, smem + 16384 + j * 1024 + lane * 16); }
    float bcl = 0.f;
    if (wid == 0) {
        const float ip = GATES[(t0 + lane) * 8 + h] + b_i[h], lf = -softplusf_(-(GATES[(t0 + lane) * 8 + 4 + h] + b_f[h]));
        bcl = scan_add64(lf, lane);
        const float cs = ip - bcl;
        csL[lane] = cs; pmL[lane] = scan_max64(cs, lane);
        nnL[lane] = ((const float*)(YB + MLC_NS))[(size_t)u * 64 + lane];
        bcL[lane] = bcl;
    }
    asm volatile("s_waitcnt vmcnt(0)" ::: "memory");
    __syncthreads();
    const int h5 = lane >> 5, r = lane & 31, i16 = lane & 15, q4 = i16 >> 2, p = i16 & 3, blk = (lane >> 4) & 1;
    const int th = wid & 1, dvh = wid >> 1;
    const int t = th * 32 + r;
    const float m_n = ((const float*)(YB + MLC_MS))[u];
    const float Mt = fmaxf(m_n, pmL[t]), w_inter = __expf(m_n - Mt), em = __expf(-(bcL[t] + Mt));
    bf16x8 qf[4];
#pragma unroll
    for (int ks = 0; ks < 4; ++ks) qf[ks] = *(const bf16x8*)(PROJ + (t0 + t) * NPAD + h * 64 + ks * 16 + h5 * 8);
    float qn = 0.f; bf16x8 qw[4];
#pragma unroll
    for (int ks = 0; ks < 4; ++ks) {
        const u32x4 raw = __builtin_bit_cast(u32x4, qf[ks]); float f[8]; unpack8(raw, f);
#pragma unroll
        for (int j = 0; j < 8; ++j) qn += f[j] * nnL[ks * 16 + h5 * 8 + j];
        qw[ks] = __builtin_bit_cast(bf16x8, (u32x4){pk2(f[0] * w_inter, f[1] * w_inter), pk2(f[2] * w_inter, f[3] * w_inter), pk2(f[4] * w_inter, f[5] * w_inter), pk2(f[6] * w_inter, f[7] * w_inter)});
    }
    qn += __shfl_xor(qn, 32);
    f32x16 x0, x1;
#pragma unroll
    for (int i = 0; i < 16; ++i) { x0[i] = 0.f; x1[i] = 0.f; }
#pragma unroll
    for (int ks = 0; ks < 4; ++ks) {
        const bf16x8 kf0 = *(const bf16x8*)(PROJ + (t0 + r) * NPAD + 256 + h * 64 + ks * 16 + h5 * 8);
        x0 = MFMA32(kf0, qf[ks], x0);
        if (th) { const bf16x8 kf1 = *(const bf16x8*)(PROJ + (t0 + 32 + r) * NPAD + 256 + h * 64 + ks * 16 + h5 * 8); x1 = MFMA32(kf1, qf[ks], x1); }
    }
    float ps = 0.f;
#pragma unroll
    for (int i = 0; i < 16; ++i) {
        const int s = (i & 3) + 8 * (i >> 2) + 4 * h5;
        const float w0 = (s <= t) ? __expf(csL[s] - Mt) * 0.125f : 0.f;
        x0[i] *= w0; ps += x0[i];
        if (th) { const float w1 = (s <= r) ? __expf(csL[32 + s] - Mt) * 0.125f : 0.f; x1[i] *= w1; ps += x1[i]; }
    }
    ps += __shfl_xor(ps, 32);
    const float den = w_inter * qn + ps;
    f32x16 o0, o1;
#pragma unroll
    for (int i = 0; i < 16; ++i) { o0[i] = 0.f; o1[i] = 0.f; }
    {
        const unsigned vb = (unsigned)(size_t)smem + (unsigned)((4 * h5 + q4) * 256 + dvh * 128 + 32 * blk + 8 * p);
#pragma unroll
        for (int st = 0; st < 2; ++st) {
            if (st == 0 || th) {
                s16x4 l00, h00, l01, h01, l10, h10, l11, h11;
                const unsigned va = vb + st * 8192;
                asm volatile("ds_read_b64_tr_b16 %0, %8\n\t"
                             "ds_read_b64_tr_b16 %1, %8 offset:2048\n\t"
                             "ds_read_b64_tr_b16 %2, %8 offset:64\n\t"
                             "ds_read_b64_tr_b16 %3, %8 offset:2112\n\t"
                             "ds_read_b64_tr_b16 %4, %8 offset:4096\n\t"
                             "ds_read_b64_tr_b16 %5, %8 offset:6144\n\t"
                             "ds_read_b64_tr_b16 %6, %8 offset:4160\n\t"
                             "ds_read_b64_tr_b16 %7, %8 offset:6208\n\t"
                             "s_waitcnt lgkmcnt(0)"
                             : "=&v"(l00), "=&v"(h00), "=&v"(l01), "=&v"(h01), "=&v"(l10), "=&v"(h10), "=&v"(l11), "=&v"(h11) : "v"(va) : "memory");
                const bf16x8 v00 = __builtin_shufflevector(l00, h00, 0, 1, 2, 3, 4, 5, 6, 7), v01 = __builtin_shufflevector(l01, h01, 0, 1, 2, 3, 4, 5, 6, 7);
                const bf16x8 v10 = __builtin_shufflevector(l10, h10, 0, 1, 2, 3, 4, 5, 6, 7), v11 = __builtin_shufflevector(l11, h11, 0, 1, 2, 3, 4, 5, 6, 7);
                const bf16x8 pb0 = (st == 0) ? pack_step<0>(x0) : pack_step<0>(x1);
                const bf16x8 pb1 = (st == 0) ? pack_step<1>(x0) : pack_step<1>(x1);
                o0 = MFMA32(v00, pb0, o0); o1 = MFMA32(v01, pb0, o1);
                o0 = MFMA32(v10, pb1, o0); o1 = MFMA32(v11, pb1, o1);
            }
        }
    }
    {
        const unsigned cb = (unsigned)(size_t)smem + 16384u + (unsigned)((8 * h5 + q4) * 256 + dvh * 128 + 32 * blk + 8 * p);
#pragma unroll
        for (int kp = 0; kp < 2; ++kp) {
            s16x4 l00, h00, l01, h01, l10, h10, l11, h11;
            const unsigned ca = cb + kp * 8192;
            asm volatile("ds_read_b64_tr_b16 %0, %8\n\t"
                         "ds_read_b64_tr_b16 %1, %8 offset:1024\n\t"
                         "ds_read_b64_tr_b16 %2, %8 offset:64\n\t"
                         "ds_read_b64_tr_b16 %3, %8 offset:1088\n\t"
                         "ds_read_b64_tr_b16 %4, %8 offset:4096\n\t"
                         "ds_read_b64_tr_b16 %5, %8 offset:5120\n\t"
                         "ds_read_b64_tr_b16 %6, %8 offset:4160\n\t"
                         "ds_read_b64_tr_b16 %7, %8 offset:5184\n\t"
                         "s_waitcnt lgkmcnt(0)"
                         : "=&v"(l00), "=&v"(h00), "=&v"(l01), "=&v"(h01), "=&v"(l10), "=&v"(h10), "=&v"(l11), "=&v"(h11) : "v"(ca) : "memory");
            const bf16x8 c00 = __builtin_shufflevector(l00, h00, 0, 1, 2, 3, 4, 5, 6, 7), c01 = __builtin_shufflevector(l01, h01, 0, 1, 2, 3, 4, 5, 6, 7);
            const bf16x8 c10 = __builtin_shufflevector(l10, h10, 0, 1, 2, 3, 4, 5, 6, 7), c11 = __builtin_shufflevector(l11, h11, 0, 1, 2, 3, 4, 5, 6, 7);
            o0 = MFMA32(c00, qw[2 * kp], o0); o1 = MFMA32(c01, qw[2 * kp], o1);
            o0 = MFMA32(c10, qw[2 * kp + 1], o0); o1 = MFMA32(c11, qw[2 * kp + 1], o1);
        }
    }
    const float inv = __builtin_amdgcn_rcpf(fmaxf(fabsf(den), em));
    float ss = 0.f;
#pragma unroll
    for (int i = 0; i < 16; ++i) { o0[i] *= inv; o1[i] *= inv; ss += o0[i] * o0[i] + o1[i] * o1[i]; }
    ss += __shfl_xor(ss, 32);
    if (h5 == 0) sqL[wid * 32 + r] = ss;
    __syncthreads();
    const float rr = rsqrtf((sqL[th * 32 + r] + sqL[(th + 2) * 32 + r]) * (1.f / 128.f) + 1e-6f);
    const bf16_t* grow = PROJ + (t0 + t) * NPAD + 1032 + h * 128 + dvh * 64 + 4 * h5;
    const float* gn = gain + h * 128 + dvh * 64 + 4 * h5;
    bf16_t* orow = MIXO + (t0 + t) * 1024 + h * 128 + dvh * 64 + 4 * h5;
#pragma unroll
    for (int d = 0; d < 2; ++d)
#pragma unroll
        for (int g = 0; g < 4; ++g) {
            const u32x2 zr = *(const u32x2*)(grow + d * 32 + 8 * g);
            const f32x4 gv = *(const f32x4*)(gn + d * 32 + 8 * g);
            const float z0 = bflo(zr.x), z1 = bfhi(zr.x), z2 = bflo(zr.y), z3 = bfhi(zr.y);
            const float y0 = (d ? o1[4 * g] : o0[4 * g]) * rr * gv[0] * sigmoidf_(z0), y1 = (d ? o1[4 * g + 1] : o0[4 * g + 1]) * rr * gv[1] * sigmoidf_(z1);
            const float y2 = (d ? o1[4 * g + 2] : o0[4 * g + 2]) * rr * gv[2] * sigmoidf_(z2), y3 = (d ? o1[4 * g + 3] : o0[4 * g + 3]) * rr * gv[3] * sigmoidf_(z3);
            *(u32x2*)(orow + d * 32 + 8 * g) = (u32x2){pk2(y0, y1), pk2(y2, y3)};
        }
}

constexpr size_t GD_WN = 0, GD_UU = GD_WN + (size_t)1024 * 16384, GD_KGT = GD_UU + (size_t)1024 * 16384, GD_QG = GD_KGT + (size_t)1024 * 16384,
                 GD_AT = GD_QG + (size_t)1024 * 16384, GD_GL = GD_AT + (size_t)1024 * 8192, GD_END = GD_GL + 4096;
static_assert(GD_END <= (size_t)MAXROWS * 256 * 2, "GDN chunk records must fit the HBUF region");

__device__ __forceinline__ void gdc_passA(int u, const bf16_t* GQ, const bf16_t* GK, const bf16_t* GV, const float* BETA, const float* GLOG, unsigned char* HB, const Ctx& c) {
    const int bh = u >> 5, b = bh >> 2, h = bh & 3;
    const size_t t0 = (size_t)b * SEQ + (u & 31) * 64;
    unsigned char* smem = c.smem;
    float* Lm = (float*)(smem + 49152);
    float* GA = (float*)(smem + 65536 + 64); float* BT = GA + 64; float* EG = BT + 64; float* EK = EG + 64;
    const int lane = c.lane, wid = __builtin_amdgcn_readfirstlane(c.wid);
    const int h5 = lane >> 5, r = lane & 31;
    if (wid == 0) {
        const float g = GLOG[(t0 + lane) * 4 + h];
        const float G = scan_add64(g, lane), Gl = __shfl(G, 63);
        GA[lane] = G; BT[lane] = BETA[(t0 + lane) * 4 + h]; EG[lane] = expf(G); EK[lane] = expf(Gl - G);
        if (lane == 0) ((float*)(HB + GD_GL))[u] = expf(Gl);
    }
    __syncthreads();
    if (wid < 3) {
        const int it = (wid + 1) >> 1, jt = wid >> 1;
        f32x16 dl, da;
#pragma unroll
        for (int i = 0; i < 16; ++i) { dl[i] = 0.f; da[i] = 0.f; }
#pragma unroll
        for (int ks = 0; ks < 8; ++ks) {
            const bf16x8 ki = *(const bf16x8*)(GK + (t0 + 32 * it + r) * 512 + h * 128 + ks * 16 + h5 * 8);
            const bf16x8 kj = *(const bf16x8*)(GK + (t0 + 32 * jt + r) * 512 + h * 128 + ks * 16 + h5 * 8);
            const bf16x8 qi = *(const bf16x8*)(GQ + (t0 + 32 * it + r) * 512 + h * 128 + ks * 16 + h5 * 8);
            dl = MFMA32(ki, kj, dl); da = MFMA32(qi, kj, da);
        }
        const int j = 32 * jt + r; const float Gj = GA[j];
        bf16_t* AT = (bf16_t*)(HB + GD_AT) + (size_t)u * 4096;
#pragma unroll
        for (int i = 0; i < 16; ++i) {
            const int ii = 32 * it + (i & 3) + 8 * (i >> 2) + 4 * h5;
            const float dec = __expf(GA[ii] - Gj);
            Lm[ii * 64 + j] = (j < ii) ? dl[i] * BT[ii] * dec : 0.f;
            AT[ii * 64 + j] = (bf16_t)f2bf((j <= ii) ? da[i] * dec : 0.f);
        }
        if (wid == 0) {
#pragma unroll
            for (int i = 0; i < 16; ++i) { const int ii = (i & 3) + 8 * (i >> 2) + 4 * h5; Lm[ii * 64 + 32 + r] = 0.f; AT[ii * 64 + 32 + r] = 0; }
        }
    }
    __syncthreads();
    if (wid == 0) {
        float Tc[64];
#pragma unroll
        for (int i = 0; i < 64; ++i) {
            float s = (i == lane) ? 1.f : 0.f;
#pragma unroll
            for (int k = 0; k < i; ++k) s -= Lm[i * 64 + k] * Tc[k];
            Tc[i] = s;
        }
        bf16_t* Tm = (bf16_t*)Lm;
#pragma unroll
        for (int i = 0; i < 64; ++i) Tm[i * 64 + lane] = (bf16_t)f2bf(Tc[i]);
    } else {
        const int t3 = c.tid - 64;
        for (int idx = t3; idx < 4096; idx += 192) {
            const int arr = idx >> 10, rem = idx & 1023, row = rem >> 4, chk = rem & 15;
            const bf16_t* sp = ((arr == 1) ? GV : (arr == 3) ? GQ : GK) + (t0 + row) * 512 + h * 128 + chk * 8;
            const u32x4 raw = *(const u32x4*)sp; float f[8]; unpack8(raw, f);
            const float sc = (arr == 0) ? BT[row] * EG[row] : (arr == 1) ? BT[row] : (arr == 2) ? EK[row] : EG[row];
            const u32x4 o = (u32x4){pk2(f[0] * sc, f[1] * sc), pk2(f[2] * sc, f[3] * sc), pk2(f[4] * sc, f[5] * sc), pk2(f[6] * sc, f[7] * sc)};
            if (arr < 3) *(u32x4*)(smem + arr * 16384 + row * 256 + chk * 16) = o;
            else *(u32x4*)((bf16_t*)(HB + GD_QG) + (size_t)u * 8192 + row * 128 + chk * 8) = o;
        }
    }
    __syncthreads();
    {
        const int i16 = lane & 15, q4 = i16 >> 2, p = i16 & 3, blk = (lane >> 4) & 1;
        const unsigned char* Tm = smem + 49152;
        f32x16 u0, u1, w0, w1;
#pragma unroll
        for (int i = 0; i < 16; ++i) { u0[i] = 0.f; u1[i] = 0.f; w0[i] = 0.f; w1[i] = 0.f; }
        const unsigned ib = (unsigned)(size_t)smem + (unsigned)((8 * h5 + q4) * 256 + wid * 64 + 32 * blk + 8 * p);
#pragma unroll
        for (int ks = 0; ks < 4; ++ks) {
            s16x4 kl, kh, vl, vh;
            const unsigned ia = ib + ks * 4096;
            asm volatile("ds_read_b64_tr_b16 %0, %4\n\t"
                         "ds_read_b64_tr_b16 %1, %4 offset:1024\n\t"
                         "ds_read_b64_tr_b16 %2, %4 offset:16384\n\t"
                         "ds_read_b64_tr_b16 %3, %4 offset:17408\n\t"
                         "s_waitcnt lgkmcnt(0)"
                         : "=&v"(kl), "=&v"(kh), "=&v"(vl), "=&v"(vh) : "v"(ia) : "memory");
            const bf16x8 kb = __builtin_shufflevector(kl, kh, 0, 1, 2, 3, 4, 5, 6, 7), vb = __builtin_shufflevector(vl, vh, 0, 1, 2, 3, 4, 5, 6, 7);
            const bf16x8 t1 = *(const bf16x8*)(Tm + (32 + r) * 128 + ks * 32 + h5 * 16);
            w1 = MFMA32(t1, kb, w1); u1 = MFMA32(t1, vb, u1);
            if (ks < 2) { const bf16x8 tt0 = *(const bf16x8*)(Tm + r * 128 + ks * 32 + h5 * 16); w0 = MFMA32(tt0, kb, w0); u0 = MFMA32(tt0, vb, u0); }
        }
        bf16_t* WN = (bf16_t*)(HB + GD_WN) + (size_t)u * 8192; bf16_t* UU = (bf16_t*)(HB + GD_UU) + (size_t)u * 8192;
#pragma unroll
        for (int i = 0; i < 16; ++i) {
            const int s = (i & 3) + 8 * (i >> 2) + 4 * h5;
            WN[s * 128 + wid * 32 + r] = (bf16_t)f2bf(-w0[i]); WN[(32 + s) * 128 + wid * 32 + r] = (bf16_t)f2bf(-w1[i]);
        }
        {
            u32x4* up = (u32x4*)(UU + (size_t)(wid * 64 + lane) * 32);
            up[0] = (u32x4){pk2(u0[0], u0[1]), pk2(u0[2], u0[3]), pk2(u0[4], u0[5]), pk2(u0[6], u0[7])};
            up[1] = (u32x4){pk2(u0[8], u0[9]), pk2(u0[10], u0[11]), pk2(u0[12], u0[13]), pk2(u0[14], u0[15])};
            up[2] = (u32x4){pk2(u1[0], u1[1]), pk2(u1[2], u1[3]), pk2(u1[4], u1[5]), pk2(u1[6], u1[7])};
            up[3] = (u32x4){pk2(u1[8], u1[9]), pk2(u1[10], u1[11]), pk2(u1[12], u1[13]), pk2(u1[14], u1[15])};
        }
        bf16_t* KGT = (bf16_t*)(HB + GD_KGT) + (size_t)u * 8192;
        const int gq = lane >> 4;
        const unsigned kb0 = (unsigned)(size_t)smem + 32768u + (unsigned)(q4 * 256 + gq * 32 + 8 * p);
#pragma unroll
        for (int it2 = 0; it2 < 8; ++it2) {
            const int job = wid * 8 + it2, s0 = (job & 15) * 4, dkb = (job >> 4) * 64;
            s16x4 v;
            const unsigned ad = kb0 + s0 * 256 + dkb * 2;
            asm volatile("ds_read_b64_tr_b16 %0, %1\n\ts_waitcnt lgkmcnt(0)" : "=&v"(v) : "v"(ad) : "memory");
            *(s16x4*)(KGT + (size_t)(dkb + gq * 16 + i16) * 64 + s0) = v;
        }
    }
}

__device__ __forceinline__ void gdc_passB(int bh, const unsigned char* HB, float* OG, const Ctx& c) {
    const int b = bh >> 2, h = bh & 3;
    const int lane = c.lane, wid = __builtin_amdgcn_readfirstlane(c.wid);
    const int h5 = lane >> 5, r = lane & 31;
    unsigned char* smem = c.smem;
    f32x16 S0, S1, S2, S3;
#pragma unroll
    for (int i = 0; i < 16; ++i) { S0[i] = 0.f; S1[i] = 0.f; S2[i] = 0.f; S3[i] = 0.f; }
    const size_t u0 = (size_t)bh * 32;
#define GB_STAGE0(n_) do { const bf16_t* wn_ = (const bf16_t*)(HB + GD_WN) + (u0 + (n_)) * 8192; const bf16_t* qg_ = (const bf16_t*)(HB + GD_QG) + (u0 + (n_)) * 8192; \
        _Pragma("unroll") for (int i = 0; i < 8; ++i) { const int j = wid * 8 + i, jj = j & 15, row = 4 * jj + (lane >> 4), ch = (lane & 15) ^ (row & 15); \
            glds16(((j >> 4) ? qg_ : wn_) + row * 128 + ch * 8, smem + (j >> 4) * 16384 + jj * 1024 + lane * 16); } } while (0)
#define GB_STAGE1(n_) do { const bf16_t* kg_ = (const bf16_t*)(HB + GD_KGT) + (u0 + (n_)) * 8192; const bf16_t* at_ = (const bf16_t*)(HB + GD_AT) + (u0 + (n_)) * 4096; \
        _Pragma("unroll") for (int i = 0; i < 6; ++i) { const int j = wid * 6 + i, isat = (j >= 16), jj = isat ? j - 16 : j, row = 8 * jj + (lane >> 3), ch = (lane & 7) ^ ((row >> 1) & 7); \
            glds16((isat ? at_ : kg_) + row * 64 + ch * 8, smem + 32768 + isat * 16384 + jj * 1024 + lane * 16); } } while (0)
#define LD128(base_, R_, ks_) __builtin_shufflevector(*(const s16x4*)((base_) + (R_) * 256 + (((2 * (ks_)) ^ (rl & 15)) << 4) + 8 * hl), \
                                                      *(const s16x4*)((base_) + (R_) * 256 + (((2 * (ks_) + 1) ^ (rl & 15)) << 4) + 8 * hl), 0, 1, 2, 3, 4, 5, 6, 7)
#define LD64(base_, R_, k2_) __builtin_shufflevector(*(const s16x4*)((base_) + (R_) * 128 + (((2 * (k2_)) ^ ((rl >> 1) & 7)) << 4) + 8 * hl), \
                                                     *(const s16x4*)((base_) + (R_) * 128 + (((2 * (k2_) + 1) ^ ((rl >> 1) & 7)) << 4) + 8 * hl), 0, 1, 2, 3, 4, 5, 6, 7)
    u32x4 uu[4];
#define GB_LOADU(n_) do { const u32x4* up_ = (const u32x4*)((const bf16_t*)(HB + GD_UU) + (u0 + (n_)) * 8192 + (size_t)(wid * 64 + lane) * 32); \
        uu[0] = up_[0]; uu[1] = up_[1]; uu[2] = up_[2]; uu[3] = up_[3]; } while (0)
    __syncthreads();
    GB_STAGE0(0);
    GB_LOADU(0);
#pragma unroll 1
    for (int n = 0; n < 32; ++n) {
        const float gl = ((const float*)(HB + GD_GL))[u0 + n];
        const size_t t0 = (size_t)b * SEQ + n * 64;
        asm volatile("s_waitcnt vmcnt(0)" ::: "memory");
        __syncthreads();
        GB_STAGE1(n);
        int rl = r, hl = h5; asm volatile("" : "+v"(rl), "+v"(hl));
        f32x16 v0, v1;
#pragma unroll
        for (int q = 0; q < 2; ++q) {
            const u32x4 a = uu[q], bq = uu[2 + q];
            v0[8 * q + 0] = bflo(a.x); v0[8 * q + 1] = bfhi(a.x); v0[8 * q + 2] = bflo(a.y); v0[8 * q + 3] = bfhi(a.y);
            v0[8 * q + 4] = bflo(a.z); v0[8 * q + 5] = bfhi(a.z); v0[8 * q + 6] = bflo(a.w); v0[8 * q + 7] = bfhi(a.w);
            v1[8 * q + 0] = bflo(bq.x); v1[8 * q + 1] = bfhi(bq.x); v1[8 * q + 2] = bflo(bq.y); v1[8 * q + 3] = bfhi(bq.y);
            v1[8 * q + 4] = bflo(bq.z); v1[8 * q + 5] = bfhi(bq.z); v1[8 * q + 6] = bflo(bq.w); v1[8 * q + 7] = bfhi(bq.w);
        }
#define KS_V(SX, HF, ks_) do { const bf16x8 sbk = pack_step<HF>(SX); \
            v0 = MFMA32(LD128(smem, rl, ks_), sbk, v0); v1 = MFMA32(LD128(smem, 32 + rl, ks_), sbk, v1); } while (0)
        KS_V(S0, 0, 0); KS_V(S0, 1, 1); asm volatile("" ::: "memory"); KS_V(S1, 0, 2); KS_V(S1, 1, 3); asm volatile("" ::: "memory");
        KS_V(S2, 0, 4); KS_V(S2, 1, 5); asm volatile("" ::: "memory"); KS_V(S3, 0, 6); KS_V(S3, 1, 7);
#undef KS_V
        const bf16x8 vb0 = pack_step_m<0>(v0), vb1 = pack_step_m<1>(v0), vb2 = pack_step_m<0>(v1), vb3 = pack_step_m<1>(v1);
        asm volatile("" ::: "memory"); asm volatile("" : "+v"(rl), "+v"(hl));
        f32x16 o0, o1;
#pragma unroll
        for (int i = 0; i < 16; ++i) { o0[i] = 0.f; o1[i] = 0.f; }
#define KS_O(SX, HF, ks_) do { const bf16x8 sbk = pack_step<HF>(SX); \
            o0 = MFMA32(LD128(smem + 16384, rl, ks_), sbk, o0); o1 = MFMA32(LD128(smem + 16384, 32 + rl, ks_), sbk, o1); } while (0)
        KS_O(S0, 0, 0); KS_O(S0, 1, 1); asm volatile("" ::: "memory"); KS_O(S1, 0, 2); KS_O(S1, 1, 3); asm volatile("" ::: "memory");
        KS_O(S2, 0, 4); KS_O(S2, 1, 5); asm volatile("" ::: "memory"); KS_O(S3, 0, 6); KS_O(S3, 1, 7);
#undef KS_O
        asm volatile("s_waitcnt vmcnt(0)" ::: "memory");
        __syncthreads();
        if (n + 1 < 32) { GB_STAGE0(n + 1); GB_LOADU(n + 1); }
        asm volatile("" : "+v"(rl), "+v"(hl));
        o0 = MFMA32(LD64(smem + 49152, rl, 0), vb0, o0); o0 = MFMA32(LD64(smem + 49152, rl, 1), vb1, o0);
        o1 = MFMA32(LD64(smem + 49152, 32 + rl, 0), vb0, o1); o1 = MFMA32(LD64(smem + 49152, 32 + rl, 1), vb1, o1);
        o1 = MFMA32(LD64(smem + 49152, 32 + rl, 2), vb2, o1); o1 = MFMA32(LD64(smem + 49152, 32 + rl, 3), vb3, o1);
#pragma unroll
        for (int i = 0; i < 16; ++i) {
            const int t = (i & 3) + 8 * (i >> 2) + 4 * h5;
            OG[(t0 + t) * 512 + h * 128 + wid * 32 + r] = o0[i]; OG[(t0 + 32 + t) * 512 + h * 128 + wid * 32 + r] = o1[i];
        }
        asm volatile("" : "+v"(rl), "+v"(hl));
        S0 *= gl; S1 *= gl; S2 *= gl; S3 *= gl;
#define SUPD(SX, dt_) do { SX = MFMA32(LD64(smem + 32768, (dt_) * 32 + rl, 0), vb0, SX); SX = MFMA32(LD64(smem + 32768, (dt_) * 32 + rl, 1), vb1, SX); \
            SX = MFMA32(LD64(smem + 32768, (dt_) * 32 + rl, 2), vb2, SX); SX = MFMA32(LD64(smem + 32768, (dt_) * 32 + rl, 3), vb3, SX); } while (0)
        SUPD(S0, 0); asm volatile("" ::: "memory"); SUPD(S1, 1); asm volatile("" ::: "memory"); SUPD(S2, 2); asm volatile("" ::: "memory"); SUPD(S3, 3);
#undef SUPD
    }
#undef GB_STAGE0
#undef GB_STAGE1
#undef LD128
#undef LD64
#undef GB_LOADU
}

__device__ __forceinline__ void phase_post(const float* OG, const bf16_t* PROJ, const float* gain, bool odd, bf16_t* MIXO, const Ctx& c) {
    const int lane = c.lane;
    const int gcol = odd ? 1032 : 1960, ocol = odd ? 0 : 512;
    for (int t = c.bid * 4 + c.wid; t < T; t += c.nblk * 4) {
        const f32x4 a0 = *(const f32x4*)(OG + (size_t)t * 512 + lane * 8), a1 = *(const f32x4*)(OG + (size_t)t * 512 + lane * 8 + 4);
        float ss = (a0[0] * a0[0] + a0[1] * a0[1]) + (a0[2] * a0[2] + a0[3] * a0[3]) + (a1[0] * a1[0] + a1[1] * a1[1]) + (a1[2] * a1[2] + a1[3] * a1[3]);
        ss = red16(ss);
        const float rr = rsqrtf(ss * (1.f / 128.f) + 1e-6f);
        const u32x4 zr = *(const u32x4*)(PROJ + (size_t)t * NPAD + gcol + lane * 8);
        float z[8]; unpack8(zr, z);
        const int gi = odd ? lane * 8 : (lane & 15) * 8;
        const f32x4 g0 = *(const f32x4*)(gain + gi), g1 = *(const f32x4*)(gain + gi + 4);
        float y[8];
#pragma unroll
        for (int j = 0; j < 4; ++j) {
            const float ga = odd ? sigmoidf_(z[j]) : siluf_(z[j]), gb = odd ? sigmoidf_(z[4 + j]) : siluf_(z[4 + j]);
            y[j] = a0[j] * rr * g0[j] * ga; y[4 + j] = a1[j] * rr * g1[j] * gb;
        }
        *(u32x4*)(MIXO + (size_t)t * 1024 + ocol + lane * 8) = (u32x4){pk2(y[0], y[1]), pk2(y[2], y[3]), pk2(y[4], y[5]), pk2(y[6], y[7])};
    }
}

__global__ void __launch_bounds__(512, 2) fwd(Args a) {
    extern __shared__ __attribute__((aligned(16))) unsigned char smem[];
    Ctx c;
#define SET_CTX(cx) do { int t_ = threadIdx.x; asm volatile("" : "+v"(t_)); cx.tid0 = t_; cx.half = t_ >> 8; cx.tid = t_ & 255; cx.lane = t_ & 63; cx.wid = (t_ >> 6) & 3; \
        cx.wr = cx.wid >> 1; cx.wc = cx.wid & 1; cx.fr = cx.lane & 15; cx.fq = cx.lane >> 4; cx.bid = blockIdx.x * 2 + cx.half; cx.nblk = gridDim.x * 2; \
        cx.smem0 = smem; cx.smem = smem + cx.half * HALF_LDS; } while (0)
    SET_CTX(c);
#define PH_CTX() SET_CTX(c)
    unsigned char* const ws_base = a.ws;
    const void* const* const ain_base = (const void* const*)__builtin_amdgcn_kernarg_segment_ptr();
    unsigned* ctl = (unsigned*)(ws_base + WS_CTL);
    volatile LAS unsigned* xbw = (volatile LAS unsigned*)(smem + LDS_BLK);
    if (c.tid0 < 8) xbw[c.tid0] = 0u;
    __syncthreads();
    XcdBarrier bar; bar.bar = ctl; bar.x = 0; bar.st = xbw;
    if (a.use_bar) bar = xcd_barrier_post(ctl, xbw);
    const int lo = a.ph_lo, hi = a.ph_hi;
#define IN(k) (lo <= (k) && (k) < hi)
#define PH(k) if (IN(k)) { PH_CTX(); unsigned char* ws = ws_base; const void* const* ain = ain_base; asm volatile("" : "+s"(ws), "+s"(ain));
#define UNIT_CTX() Ctx cu; SET_CTX(cu)
#define SEAM(k) do { if ((k) + 1 < hi) xcd_barrier(bar); } while (0)

#define XBF ((bf16_t*)(ws + WS_XBF))
#define X1 ((float*)(ws + WS_X1))
#define PROJ ((bf16_t*)(ws + U_PROJ))
#define GATES ((float*)(ws + U_GATES))
#define MIXO ((bf16_t*)(ws + U_MIXO))
#define YBUF ((float*)(ws + U_YBUF))
#define ROPEM ((const float*)(ws + WS_ROPEM))
#define ROPES ((const float*)(ws + WS_ROPES))
#define XRES ((layer == 0) ? (const float*)ain[0] : (const float*)a.out)
#define CNT (ctl + CW_CNT + layer * 128)
#define WIN ((const bf16_t*)(ws + WS_WIN) + (size_t)layer * WIN_ELEMS)
#define WOUT ((const bf16_t*)(ws + WS_WOUT) + (size_t)layer * WOUT_ELEMS)

    PH(0) for (int rep = 0; rep < REP_PRO; ++rep) phase_prologue(a, c); SEAM(0); }

    for (int layer = 0; layer < 4; ++layer) {
        const int pb = 1 + layer * PPL;
        if (pb >= hi || pb + PPL <= lo) continue;
        const int jj = layer >> 1;
        const bool odd = (layer & 1) != 0;

        PH(pb + 0) {
                DenseSched S{T / 256, NPAD / 256, 1024, (int)blockIdx.x, (int)gridDim.x};
                EpiIn E{PROJ, GATES, odd ? 1024 : 1952};
                g8::phase<true>(smem, (const char*)XBF, (const char*)WIN, 1024, S, E);
            }
            SEAM(pb + 0); }
        PH(pb + 1) for (int rp = 0; rp < ((REP_PHASE == 1) ? 2 : 1); ++rp) { if (rp) xcd_barrier(bar);
            if (!odd) phase_prep_even(PROJ, GATES, (const float*)ain[3] + jj * 256, (const float*)ain[5] + jj * 128, (const float*)ain[7] + jj * 4 * 1536,
                                      (const float*)ain[8] + jj * 4, (const float*)ain[9] + jj * 4, ROPEM,
                                      (bf16_t*)(ws + U_CQ), (bf16_t*)(ws + U_CKV), (bf16_t*)(ws + U_KROPE), (bf16_t*)(ws + U_GQ), (bf16_t*)(ws + U_GK), (bf16_t*)(ws + U_GV),
                                      (float*)(ws + U_BETA), (float*)(ws + U_GLOG), c);
            else {
                phase_prep_odd(PROJ, ROPES, (bf16_t*)(ws + U_QF), (bf16_t*)(ws + U_KN), c);
                unsigned* ctr = ctl + CW_WORK + pb + 1 + 64 * rp;
                for (;;) {
                    const int u = next_unit(ctr, c); UNIT_CTX();
                    if (u >= 1024) break;
                    mlc_passA(u, PROJ, GATES, (const float*)ain[13] + jj * 4, (const float*)ain[14] + jj * 4, (unsigned char*)YBUF, cu);
                }
            }
            }
            SEAM(pb + 1);
        }
        PH(pb + 2) for (int rp = 0; rp < ((REP_PHASE == 2) ? 2 : 1); ++rp) { if (rp) xcd_barrier(bar);
            unsigned* ctr = ctl + CW_WORK + pb + 2 + 64 * rp;
            if (!odd) {
                for (;;) {
                    const int u = next_unit(ctr, c); UNIT_CTX();
                    if (u >= 1024 + MLAUP_TILES) break;
                    if (u < 1024) gdc_passA(u, (const bf16_t*)(ws + U_GQ), (const bf16_t*)(ws + U_GK), (const bf16_t*)(ws + U_GV), (const float*)(ws + U_BETA),
                                            (const float*)(ws + U_GLOG), ws + WS_HBUF, cu);
                    else mla_up_tile(u - 1024, (const bf16_t*)(ws + U_CQ), (const bf16_t*)(ws + WS_WQB) + (size_t)jj * WQB_ELEMS, (const bf16_t*)(ws + U_CKV),
                                     (const bf16_t*)(ws + WS_WKVB) + (size_t)jj * WKVB_ELEMS, ROPEM, (bf16_t*)(ws + U_QF), (bf16_t*)(ws + U_KN), (bf16_t*)(ws + U_VV), cu);
                }
            } else {
                for (;;) {
                    const int u = next_unit(ctr, c); UNIT_CTX();
                    if (u >= 256 + 1024) break;
                    if (u < 256) mlc_passB(u, (unsigned char*)YBUF, cu);
                    else {
                        const int v = u - 256, hq = v & 7, n = (v >> 3) & 15, b = v >> 7, kvh = hq >> 2;
                        const size_t tb = (size_t)b * SEQ;
                        attn_unit<4, true>((const bf16_t*)(ws + U_QF) + tb * 512 + hq * 64, 512, (const bf16_t*)(ws + U_KN) + tb * 128 + kvh * 64, 128,
                                           (const bf16_t*)(ws + U_KN), 0, PROJ + tb * NPAD + 2184 + kvh * 64, NPAD,
                                           MIXO + tb * 1024 + 512 + hq * 64, 1024, n * 128, ((const float*)ain[16])[jj * 8 + hq] * 1.4426950408889634f, cu);
                    }
                }
            }
            }
            SEAM(pb + 2);
        }
        PH(pb + 3) for (int rp = 0; rp < ((REP_PHASE == 3) ? 2 : 1); ++rp) { if (rp) xcd_barrier(bar);
            unsigned* ctr = ctl + CW_WORK + pb + 3 + 64 * rp;
            if (!odd) {
                for (;;) {
                    const int u = next_unit(ctr, c); UNIT_CTX();
                    if (u >= 32 + 1024) break;
                    if (u < 32) gdc_passB(u, ws + WS_HBUF, YBUF, cu);
                    else {
                        const int v = u - 32, qb = 15 - (v >> 6), bh = v & 63, b = bh >> 3, hh = bh & 7;
                        const size_t tb = (size_t)b * SEQ;
                        attn_unit<6, false>((const bf16_t*)(ws + U_QF) + tb * 768 + hh * 96, 768, (const bf16_t*)(ws + U_KN) + tb * 512 + hh * 64, 512,
                                            (const bf16_t*)(ws + U_KROPE) + tb * 32, 32, (const bf16_t*)(ws + U_VV) + tb * 512 + hh * 64, 512,
                                            MIXO + tb * 1024 + hh * 64, 1024, qb * 128, 0.f, cu);
                    }
                }
            } else {
                for (;;) {
                    const int u = next_unit(ctr, c); UNIT_CTX();
                    if (u >= 1024) break;
                    mlc_passC(u, PROJ, GATES, (const float*)ain[13] + jj * 4, (const float*)ain[14] + jj * 4, (const unsigned char*)YBUF, (const float*)ain[15] + jj * 512, MIXO, cu);
                }
            }
            }
            SEAM(pb + 3);
        }
        PH(pb + 4) for (int rp = 0; rp < ((REP_PHASE == 4) ? 2 : 1); ++rp) { if (rp) xcd_barrier(bar);
            if (!odd) { phase_post(YBUF, PROJ, (const float*)ain[10] + jj * 128, false, MIXO, c); }
            }
            if (!odd) SEAM(pb + 4);
        }
        PH(pb + 5) {
                DenseSched S{T / 256, 4, 1024, (int)blockIdx.x, (int)gridDim.x};
                EpiOut E{XRES, YBUF};
                g8::phase<false>(smem, (const char*)MIXO, (const char*)WOUT, 1024, S, E);
            }
            SEAM(pb + 5); }
        PH(pb + 6) for (int rep = 0; rep < REP_TOK; ++rep) phase_ln1(YBUF, (const float*)ain[18] + layer * 1024, (const float*)ain[19] + layer * 1024, X1, XBF, c); SEAM(pb + 6); }
        PH(pb + 7) for (int rep = 0; rep < REP_GEMM; ++rep) phase_router(XBF, (const bf16_t*)(ws + WS_WRT) + (size_t)layer * WRT_ELEMS, (float*)(ws + WS_LOG), c); SEAM(pb + 7); }
        PH(pb + 8) phase_route((const float*)(ws + WS_LOG), (const float*)ain[21] + layer * 64, CNT, (int*)(ws + WS_LTOK), (float*)(ws + WS_LW), (int*)(ws + WS_ASG), c); SEAM(pb + 8); }
        PH(pb + 9) for (int rep = 0; rep < REP_GEMM * REP_G2; ++rep) phase_moe1(XBF, (const bf16_t*)(ws + WS_WGU) + (size_t)layer * 65 * WGU_ELEMS, CNT, (const int*)(ws + WS_LTOK), (const float*)(ws + WS_LW), (bf16_t*)(ws + WS_HBUF), c); SEAM(pb + 9); }
        PH(pb + 10)
#if MOE2_G8
            {
                int* bst8 = (int*)(smem + LDS_BLK + 64); int* eb8 = bst8 + 256;
                build_block_table(CNT, bst8, c);
                for (int rb = c.tid0; rb < bst8[65]; rb += NT) { int e = 0; for (int q = 1; q < 65; ++q) e += (bst8[q] <= rb) ? 1 : 0; eb8[rb] = e; }
                __syncthreads();
                MoeSched S{bst8[65], 4, (int)blockIdx.x, (int)gridDim.x, eb8};
                EpiMoe2 E{(bf16_t*)(ws + U_Y)};
                g8::phase<true>(smem, (const char*)(ws + WS_HBUF), (const char*)((const bf16_t*)(ws + WS_WDN) + (size_t)layer * 65 * WDN_ELEMS), 256, S, E);
            }
#else
            phase_moe2((const bf16_t*)(ws + WS_HBUF), (const bf16_t*)(ws + WS_WDN) + (size_t)layer * 65 * WDN_ELEMS, CNT, (bf16_t*)(ws + U_Y), c);
#endif
            SEAM(pb + 10); }
        PH(pb + 11) for (int rep = 0; rep < REP_CMB; ++rep) phase_combine(X1, (const bf16_t*)(ws + U_Y), (const int*)(ws + WS_ASG), CNT, (const float*)ain[28] + layer * 1024, (const float*)ain[29] + layer * 1024,
                                         a.out, XBF, c); SEAM(pb + 11); }
    }
#undef IN
#undef XBF
#undef X1
#undef PROJ
#undef GATES
#undef MIXO
#undef YBUF
#undef ROPEM
#undef ROPES
#undef XRES
#undef CNT
#undef WIN
#undef WOUT
#undef PH
#undef PH_CTX
#undef UNIT_CTX
#undef SEAM
}

extern "C" void kernel_launch(void* const* d_in, const int* in_sizes, int n_in, void* d_out, int out_size, void* d_ws, size_t ws_size, hipStream_t stream) {
    static int grid = 0;
    if (grid == 0) {
        if (n_in != 30 || out_size != T * 1024 || ws_size < WS_END) {
            fprintf(stderr, "kernel_launch: unexpected shapes (n_in %d, out %d, ws %zu < %zu)\n", n_in, out_size, ws_size, (size_t)WS_END);
            grid = -1; return;
        }
        int dev = 0, cus = 0, per_cu = 0;
        (void)hipGetDevice(&dev);
        (void)hipDeviceGetAttribute(&cus, hipDeviceAttributeMultiprocessorCount, dev);
        (void)hipFuncSetAttribute((const void*)fwd, hipFuncAttributeMaxDynamicSharedMemorySize, DYN_LDS);
        (void)hipOccupancyMaxActiveBlocksPerMultiprocessor(&per_cu, (const void*)fwd, NT, DYN_LDS);
        (void)hipGetLastError();
        if (per_cu < 1) per_cu = 1;
        grid = cus;
    }
    if (grid < 0) return;
    (void)hipMemsetAsync((char*)d_ws + WS_CTL, 0, CTL_BYTES, stream);
    Args a{};
    for (int i = 0; i < 30; ++i) a.in[i] = d_in[i];
    a.out = (float*)d_out; a.ws = (unsigned char*)d_ws; a.pad = 0;
#if ONE_LAUNCH
    a.ph_lo = 0; a.ph_hi = NPH; a.use_bar = 1;
    hipLaunchKernelGGL(fwd, dim3(grid), dim3(NT), DYN_LDS, stream, a);
#else
    for (int p = 0; p < NPH; ++p) {
        a.ph_lo = p; a.ph_hi = p + 1; a.use_bar = 0;
        hipLaunchKernelGGL(fwd, dim3(grid), dim3(NT), DYN_LDS, stream, a);
    }
#endif
}
```

```cpp
#include <hip/hip_runtime.h>
#include <stdint.h>
#include <stdio.h>

#define REP_GEMM 1
#define REP_PHASE 0
#define REP_G0 1
#define REP_G1 1
#define REP_G2 1
#define REP_G3 1
#define REP_MIX 1
#define REP_ONLY 0
#define REP_CMB 1
#define REP_PRO 1
#define REP_TOK 1
#define MOE2_G8 1
#ifndef ONE_LAUNCH
#define ONE_LAUNCH 1
#endif

typedef unsigned short bf16_t;
typedef short bf16x8 __attribute__((ext_vector_type(8)));
typedef float f32x4 __attribute__((ext_vector_type(4)));
typedef unsigned u32x4 __attribute__((ext_vector_type(4)));
typedef unsigned u32x2 __attribute__((ext_vector_type(2)));
#define LAS __attribute__((address_space(3)))
#define GAS __attribute__((address_space(1)))

constexpr int T = 16384, SEQ = 2048;
constexpr int NPAD = 2560;
constexpr int CAP = 16384;
constexpr int RBR = 256;
constexpr int MAXRB = 512 + 64 + 64;
constexpr int MAXROWS = MAXRB * RBR;
constexpr float ALPHA = 1.681792830507429f;
constexpr int PPL = 12;
constexpr int NPH = 1 + 4 * PPL;
constexpr int NT = 512, NW = 8;
constexpr int HALF_LDS = 65536 + 64 + 1024;
constexpr int LDS_BLK = 2 * HALF_LDS;
constexpr int DYN_LDS = LDS_BLK + 64 + 1024 + 2560;

constexpr size_t cmax(size_t a, size_t b) { return a > b ? a : b; }
constexpr size_t WS_CTL = 0;
constexpr size_t CTL_BYTES = 65536;
constexpr size_t WS_WIN = WS_CTL + CTL_BYTES;
constexpr size_t WIN_ELEMS = (size_t)NPAD * 1024;
constexpr size_t WS_WQB = WS_WIN + 4 * WIN_ELEMS * 2;
constexpr size_t WQB_ELEMS = 768 * 256;
constexpr size_t WS_WKVB = WS_WQB + 2 * WQB_ELEMS * 2;
constexpr size_t WKVB_ELEMS = 1024 * 128;
constexpr size_t WS_WOUT = WS_WKVB + 2 * WKVB_ELEMS * 2;
constexpr size_t WOUT_ELEMS = 1024 * 1024;
constexpr size_t WS_WRT = WS_WOUT + 4 * WOUT_ELEMS * 2;
constexpr size_t WRT_ELEMS = 128 * 1024;
constexpr size_t WS_WGU = WS_WRT + 4 * WRT_ELEMS * 2;
constexpr size_t WGU_ELEMS = 512 * 1024;
constexpr size_t WS_WDN = WS_WGU + 4 * 65 * WGU_ELEMS * 2;
constexpr size_t WDN_ELEMS = 1024 * 256;
constexpr size_t WS_ROPEM = WS_WDN + 4 * 65 * WDN_ELEMS * 2;
constexpr size_t WS_ROPES = WS_ROPEM + (size_t)T * 16 * 2 * 4;
constexpr size_t WS_X1 = WS_ROPES + (size_t)T * 32 * 2 * 4;
constexpr size_t WS_XBF = WS_X1 + (size_t)T * 1024 * 4;
constexpr size_t WS_HBUF = WS_XBF + (size_t)T * 1024 * 2;
constexpr size_t WS_LOG = WS_HBUF + (size_t)MAXROWS * 256 * 2;
constexpr size_t WS_ASG = WS_LOG + (size_t)T * 64 * 4;
constexpr size_t WS_ASGW = WS_ASG + (size_t)T * 8 * 4;
constexpr size_t WS_LTOK = WS_ASGW + (size_t)T * 8 * 4;
constexpr size_t WS_LW = WS_LTOK + (size_t)65 * CAP * 4;
constexpr size_t WS_U = WS_LW + (size_t)65 * CAP * 4;
constexpr size_t U_Y = WS_U;
constexpr size_t U_PROJ = WS_U;
constexpr size_t U_GATES = U_PROJ + (size_t)T * NPAD * 2;
constexpr size_t U_CQ = U_GATES + (size_t)T * 8 * 4;
constexpr size_t U_CKV = U_CQ + (size_t)T * 256 * 2;
constexpr size_t U_KROPE = U_CKV + (size_t)T * 128 * 2;
constexpr size_t U_QF = U_KROPE + (size_t)T * 32 * 2;
constexpr size_t U_KN = U_QF + (size_t)T * 768 * 2;
constexpr size_t U_VV = U_KN + (size_t)T * 512 * 2;
constexpr size_t U_GQ = U_VV + (size_t)T * 512 * 2;
constexpr size_t U_GK = U_GQ + (size_t)T * 512 * 2;
constexpr size_t U_GV = U_GK + (size_t)T * 512 * 2;
constexpr size_t U_BETA = U_GV + (size_t)T * 512 * 2;
constexpr size_t U_GLOG = U_BETA + (size_t)T * 4 * 4;
constexpr size_t U_MIXO = U_GLOG + (size_t)T * 4 * 4;
constexpr size_t U_YBUF = U_MIXO + (size_t)T * 1024 * 2;
constexpr size_t U_END1 = U_YBUF + (size_t)T * 1024 * 4;
constexpr size_t WS_END = WS_U + cmax((size_t)MAXROWS * 1024 * 2, U_END1 - WS_U);

constexpr int CW_CNT = 4096;
constexpr int CW_WORK = 8192;

#define XB_TMO      128
#define XB_XCNT(j)  (256  + 64 * (j))
#define XB_XSUB(j)  (1280 + 64 * (j))
#define XB_XGEN(j)  (2304 + 64 * (j))
#define XB_TOP      3328
#define XB_TOPGEN   3392
#define XCD_BAR_WORDS 3456
#define XB_SPIN_CAP (1u << 18)

__device__ __forceinline__ unsigned xb_ld(unsigned* p)              { return __hip_atomic_load(p, __ATOMIC_RELAXED, __HIP_MEMORY_SCOPE_AGENT); }
__device__ __forceinline__ unsigned xb_add(unsigned* p, unsigned v) { return __hip_atomic_fetch_add(p, v, __ATOMIC_RELAXED, __HIP_MEMORY_SCOPE_AGENT); }
__device__ __forceinline__ unsigned xb_xcc_id() { return (unsigned)__builtin_amdgcn_s_getreg((3 << 11) | 20) & 0xFu; }
#define XB_SPIN(cond, bar) do { unsigned _sp = 0; while (cond) { __builtin_amdgcn_s_sleep(1); \
    if ((++_sp & 255u) == 0u) { if (xb_ld(&(bar)[XB_TMO])) break; if (_sp > XB_SPIN_CAP) { atomicAdd(&(bar)[XB_TMO], 1u); break; } } } } while (0)

struct XcdBarrier { unsigned* bar; unsigned x; volatile LAS unsigned* st; };

__device__ __forceinline__ XcdBarrier xcd_barrier_post(unsigned* bar, volatile LAS unsigned* st) {
    XcdBarrier b; b.bar = bar; b.x = xb_xcc_id(); b.st = st;
    if (threadIdx.x == 0) (void)xb_add(&bar[XB_XCNT(b.x)], 1u);
    return b;
}
__device__ __forceinline__ void xcd_barrier_complete(unsigned* bar, unsigned x, unsigned& nloc, unsigned& nx) {
    const unsigned G = gridDim.x * gridDim.y * gridDim.z;
    unsigned sum, cnt, mine, sp = 0u;
    for (;;) {
        sum = 0u; cnt = 0u; mine = 0u;
#pragma unroll
        for (unsigned j = 0; j < 16; ++j) { const unsigned c = xb_ld(&bar[XB_XCNT(j)]); sum += c; cnt += (c > 0u) ? 1u : 0u; mine = (j == x) ? c : mine; }
        if (sum == G) break;
        __builtin_amdgcn_s_sleep(1);
        if ((++sp & 255u) == 0u) { if (xb_ld(&bar[XB_TMO])) break; if (sp > XB_SPIN_CAP) { atomicAdd(&bar[XB_TMO], 1u); break; } }
    }
    nloc = mine > 0u ? mine : 1u; nx = cnt > 0u ? cnt : 1u;
}
__device__ __forceinline__ void xcd_barrier(const XcdBarrier& b) {
    asm volatile("s_waitcnt vmcnt(0)" ::: "memory");
    __syncthreads();
    if (threadIdx.x == 0) {
        unsigned* bar = b.bar;
        __builtin_amdgcn_s_waitcnt(0);
        unsigned nloc = b.st[0], nx = b.st[1];
        if (nloc == 0u) { xcd_barrier_complete(bar, b.x, nloc, nx); b.st[0] = nloc; b.st[1] = nx; }
        const unsigned old = xb_add(&bar[XB_XSUB(b.x)], 1u);
        const unsigned gen = old / nloc;
        if (old + 1u == (gen + 1u) * nloc) {
            __builtin_amdgcn_fence(__ATOMIC_RELEASE, "agent");
            asm volatile("s_waitcnt vmcnt(0)" ::: "memory");
            const unsigned og = xb_add(&bar[XB_TOP], 1u);
            const unsigned tg = og / nx;
            if (og + 1u == (tg + 1u) * nx) xb_add(&bar[XB_TOPGEN], 1u);
            else XB_SPIN(xb_ld(&bar[XB_TOPGEN]) == tg, bar);
            __builtin_amdgcn_fence(__ATOMIC_ACQUIRE, "agent");
            xb_add(&bar[XB_XGEN(b.x)], 1u);
            asm volatile("s_waitcnt vmcnt(0)" ::: "memory");
        } else {
            XB_SPIN(xb_ld(&bar[XB_XGEN(b.x)]) == gen, bar);
            __builtin_amdgcn_fence(__ATOMIC_ACQUIRE, "agent");
            asm volatile("s_waitcnt vmcnt(0)" ::: "memory");
        }
    }
    __syncthreads();
}

__device__ __forceinline__ float bf2f(unsigned v) { return __uint_as_float(v << 16); }
__device__ __forceinline__ float bflo(unsigned w) { return __uint_as_float(w << 16); }
__device__ __forceinline__ float bfhi(unsigned w) { return __uint_as_float(w & 0xffff0000u); }
__device__ __forceinline__ unsigned f2bf(float f) { unsigned u = __float_as_uint(f); u += 0x7fffu + ((u >> 16) & 1u); return u >> 16; }
__device__ __forceinline__ unsigned pk2(float lo, float hi) { return f2bf(lo) | (f2bf(hi) << 16); }
__device__ __forceinline__ unsigned cvt_pk(float lo, float hi) { unsigned r; asm volatile("v_cvt_pk_bf16_f32 %0, %1, %2" : "=v"(r) : "v"(lo), "v"(hi)); return r; }
__device__ __forceinline__ float wave_sum(float v) {
#pragma unroll
    for (int o = 32; o > 0; o >>= 1) v += __shfl_xor(v, o);
    return v;
}
__device__ __forceinline__ float sigmoidf_(float x) { return 1.f / (1.f + expf(-x)); }
__device__ __forceinline__ float siluf_(float x) { return x / (1.f + expf(-x)); }
__device__ __forceinline__ float softplusf_(float x) { return x > 20.f ? x : log1pf(expf(x)); }
__device__ __forceinline__ void glds16(const void* g, void* l) {
    __builtin_amdgcn_global_load_lds((const GAS unsigned*)g, (LAS unsigned*)l, 16, 0, 0);
}
__device__ __forceinline__ void unpack8(const u32x4 r, float (&f)[8]) {
    f[0] = bflo(r.x); f[1] = bfhi(r.x); f[2] = bflo(r.y); f[3] = bfhi(r.y);
    f[4] = bflo(r.z); f[5] = bfhi(r.z); f[6] = bflo(r.w); f[7] = bfhi(r.w);
}

struct Args {
    const void* in[30];
    float* out;
    unsigned char* ws;
    int ph_lo, ph_hi, use_bar, pad;
};

struct Ctx { int tid, lane, wid, wr, wc, fr, fq, bid, nblk; unsigned char* smem; int half, tid0; unsigned char* smem0; };

#define WAIT_V(n) asm volatile("s_waitcnt vmcnt(" #n ")" ::: "memory")
__device__ __forceinline__ void gemm_tile(const bf16_t* a0, const bf16_t* a1, const bf16_t* b0, const bf16_t* b1,
                                          int nk, f32x4 (&acc)[4][4], const Ctx& c) {
#pragma unroll
    for (int m = 0; m < 4; ++m)
#pragma unroll
        for (int n = 0; n < 4; ++n) acc[m][n] = (f32x4){0.f, 0.f, 0.f, 0.f};
    unsigned char* smem = c.smem;
    const int sb = c.tid * 16;
    const int kofs = ((c.tid & 3) ^ ((c.tid >> 4) & 3)) * 8;
    a0 += kofs; a1 += kofs; b0 += kofs; b1 += kofs;
#define G_STAGE(kt_) do { unsigned char* sp_ = smem + ((kt_) & 3) * 16384 + sb; const int ko_ = (kt_) * 32; \
        glds16(a0 + ko_, sp_); glds16(a1 + ko_, sp_ + 4096); glds16(b0 + ko_, sp_ + 8192); glds16(b1 + ko_, sp_ + 12288); } while (0)
#define G_READ(kt_, AF, BF) do { const unsigned char* sa_ = smem + ((kt_) & 3) * 16384 + c.wr * 4096 + roff; const unsigned char* sb_ = smem + ((kt_) & 3) * 16384 + 8192 + c.wc * 4096 + roff; \
        _Pragma("unroll") for (int m = 0; m < 4; ++m) AF[m] = *(const bf16x8*)(sa_ + m * 1024); \
        _Pragma("unroll") for (int n = 0; n < 4; ++n) BF[n] = *(const bf16x8*)(sb_ + n * 1024); } while (0)
#define G_MMA(AF, BF) do { __builtin_amdgcn_s_setprio(1); \
        _Pragma("unroll") for (int m = 0; m < 4; ++m) _Pragma("unroll") for (int n = 0; n < 4; ++n) acc[m][n] = __builtin_amdgcn_mfma_f32_16x16x32_bf16(BF[n], AF[m], acc[m][n], 0, 0, 0); \
        __builtin_amdgcn_s_setprio(0); } while (0)
#define G_BAR() do { asm volatile("" ::: "memory"); __builtin_amdgcn_s_barrier(); asm volatile("" ::: "memory"); } while (0)
    const int roff = (c.fr * 64) + ((c.fq ^ ((c.fr >> 2) & 3)) * 16);
    WAIT_V(0);
    G_STAGE(0); G_STAGE(1); G_STAGE(2); G_STAGE(3);
    bf16x8 fa0[4], fb0[4], fa1[4], fb1[4];
    WAIT_V(12); G_BAR();
    G_READ(0, fa0, fb0);
#define G_LGK0() asm volatile("s_waitcnt lgkmcnt(0)" ::: "memory")
    int kt = 0;
    for (; kt < nk - 4; kt += 4) {
        G_LGK0(); WAIT_V(8); G_BAR(); G_STAGE(kt + 4); G_READ(1, fa1, fb1); G_MMA(fa0, fb0);
        G_LGK0(); WAIT_V(8); G_BAR(); G_STAGE(kt + 5); G_READ(2, fa0, fb0); G_MMA(fa1, fb1);
        G_LGK0(); WAIT_V(8); G_BAR(); G_STAGE(kt + 6); G_READ(3, fa1, fb1); G_MMA(fa0, fb0);
        G_LGK0(); WAIT_V(8); G_BAR(); G_STAGE(kt + 7); G_READ(0, fa0, fb0); G_MMA(fa1, fb1);
    }
    G_LGK0(); WAIT_V(8); G_BAR(); G_READ(1, fa1, fb1); G_MMA(fa0, fb0);
    G_LGK0(); WAIT_V(4); G_BAR(); G_READ(2, fa0, fb0); G_MMA(fa1, fb1);
    G_LGK0(); WAIT_V(0); G_BAR(); G_READ(3, fa1, fb1); G_MMA(fa0, fb0);
    G_MMA(fa1, fb1);
#undef G_LGK0
#undef G_STAGE
#undef G_READ
#undef G_MMA
#undef G_BAR
    __syncthreads();
}

namespace g8 {
constexpr int BM = 256, BK = 64, HALF = 128, HTB = HALF * BK * 2, STAGE_BYTES = 8 * HTB;
__device__ __forceinline__ int lds_byte(int r, int c) { const int st = (r >> 4) * 2 + (c >> 5), rr = r & 15, cc = c & 31, ob = rr * 64 + cc * 2; return st * 1024 + (ob ^ (((ob >> 9) & 1) << 5)); }
__device__ __forceinline__ void stage_rc(int b, int& R, int& C) { const int st = b / 1024, sb = b % 1024, swz = sb ^ (((sb >> 9) & 1) << 5); R = (st >> 1) * 16 + swz / 64; C = (st & 1) * 32 + (swz % 64) / 2; }
__device__ __forceinline__ int perm32(int rho) { const int n = rho >> 4, i = rho & 15; return 8 * (i >> 2) + 4 * n + (i & 3); }
struct Unit { int pm, pn, bt; };

template <bool PERM, bool GATHER, class Sched, class Epi>
__device__ __forceinline__ void phase(unsigned char* ldsp, const char* Abase, const char* Bbase, int K, const Sched& S, const Epi& E) {
    LAS unsigned char* lds = (LAS unsigned char*)ldsp;
    int tid = threadIdx.x; asm volatile("" : "+v"(tid));
    const int wid = __builtin_amdgcn_readfirstlane(tid >> 6), lane = tid & 63, wr = wid >> 2, wc = wid & 3, fr = lane & 15, fq = lane >> 4;
    const int nt = K / BK;
    unsigned voffA[2], voffB[2];
#pragma unroll
    for (int i = 0; i < 2; ++i) { int R, C; stage_rc(tid * 16 + i * 8192, R, C); const int Rb = PERM ? ((R & ~31) + perm32(R & 31)) : R;
        voffA[i] = (unsigned)(R * K + C) * 2u; voffB[i] = (unsigned)(Rb * K + C) * 2u; }
    const size_t kstep = (size_t)(BK * 2);
    const size_t hstep = (size_t)HALF * K * 2, tstep = 2 * hstep;
    const unsigned ldsw = (unsigned)wid * 1024u;
    const int aoff = lds_byte(wr * 64 + fr, fq * 8), boff = lds_byte(wc * 32 + fr, fq * 8);
#define G8_SA(b, h) (((b) * 2 + (h)) * HTB)
#define G8_SB(b, h) ((4 + (b) * 2 + (h)) * HTB)
#define G8_STAGE(bufoff, gbase, voff) do { _Pragma("unroll") for (int _i = 0; _i < 2; ++_i) \
        __builtin_amdgcn_global_load_lds((const GAS unsigned*)((const char*)(gbase) + (voff)[_i]), (LAS unsigned*)(lds + (bufoff) + ldsw + _i * 8192), 16, 0, 0); } while (0)
#define G8_STAGEA(bufoff, gbase, h, kb) do { if constexpr (GATHER) { _Pragma("unroll") for (int _i = 0; _i < 2; ++_i) \
        __builtin_amdgcn_global_load_lds((const GAS unsigned*)(Abase + (kb) + vA[2 * (h) + _i]), (LAS unsigned*)(lds + (bufoff) + ldsw + _i * 8192), 16, 0, 0); } \
        else G8_STAGE(bufoff, (gbase) + (size_t)(h) * hstep + (kb), voffA); } while (0)
#define G8_LDA(dst, b, h) do { _Pragma("unroll") for (int m = 0; m < 4; ++m) _Pragma("unroll") for (int k = 0; k < 2; ++k) dst[m][k] = *(const LAS bf16x8*)(lds + G8_SA(b, h) + aoff + m * 2048 + k * 1024); } while (0)
#define G8_LDB(dst, b, h) do { _Pragma("unroll") for (int n = 0; n < 2; ++n) _Pragma("unroll") for (int k = 0; k < 2; ++k) dst[n][k] = *(const LAS bf16x8*)(lds + G8_SB(b, h) + boff + n * 2048 + k * 1024); } while (0)
#define G8_MMA(ai, bj, At, Bt) do { __builtin_amdgcn_s_setprio(1); _Pragma("unroll") for (int m = 0; m < 4; ++m) _Pragma("unroll") for (int n = 0; n < 2; ++n) _Pragma("unroll") for (int k = 0; k < 2; ++k) \
        acc[ai][bj][m][n] = __builtin_amdgcn_mfma_f32_16x16x32_bf16(Bt[n][k], At[m][k], acc[ai][bj][m][n], 0, 0, 0); __builtin_amdgcn_s_setprio(0); } while (0)
#define G8_WAIT_V(n) asm volatile("s_waitcnt vmcnt(" #n ")" ::: "memory")
#define G8_WAIT_L(n) asm volatile("s_waitcnt lgkmcnt(" #n ")" ::: "memory")
#define G8_BAR __builtin_amdgcn_s_barrier()
#define G8_SCHED __builtin_amdgcn_sched_barrier(0)
    Unit cur, nxt; int ui = 0;
    if (!S.next(0, cur)) return;
    f32x4 acc[2][2][4][2];
#pragma unroll
    for (int a = 0; a < 2; ++a)
#pragma unroll
        for (int b = 0; b < 2; ++b)
#pragma unroll
            for (int m = 0; m < 4; ++m)
#pragma unroll
                for (int n = 0; n < 2; ++n) acc[a][b][m][n] = (f32x4){0.f, 0.f, 0.f, 0.f};
    bf16x8 At[4][2], B0[2][2], B1[2][2];
    const char* cA = Abase + (size_t)cur.pm * tstep; const char* cB = Bbase + (size_t)cur.bt * tstep;
    unsigned vA[4] = {0u, 0u, 0u, 0u};
    if constexpr (GATHER) S.aoff(cur, tid, vA);
    asm volatile("s_waitcnt vmcnt(0)" ::: "memory");
    G8_STAGE(G8_SB(0, 0), cB, voffB); G8_STAGEA(G8_SA(0, 0), cA, 0, 0); G8_STAGE(G8_SB(0, 1), cB + hstep, voffB); G8_STAGEA(G8_SA(0, 1), cA, 1, 0);
    if (wr == 1) G8_BAR;
    G8_WAIT_V(4); G8_BAR;
    G8_STAGE(G8_SB(1, 0), cB + kstep, voffB); G8_STAGEA(G8_SA(1, 0), cA, 0, kstep); G8_STAGE(G8_SB(1, 1), cB + hstep + kstep, voffB);
    G8_WAIT_V(6); G8_BAR;
    for (;;) {
        const bool has_next = S.next(ui + 1, nxt);
        const char* nA = has_next ? Abase + (size_t)nxt.pm * tstep : cA; const char* nB = has_next ? Bbase + (size_t)nxt.bt * tstep : cB;
        for (int t = 0; t < nt; t += 2) {
            const bool last = (t == nt - 2);
            const size_t k1 = (size_t)(t + 1) * kstep, k2 = last ? 0 : (size_t)(t + 2) * kstep, k3 = k2 + kstep;
            const char* a2 = last ? nA : cA; const char* b2 = last ? nB : cB + (size_t)(t + 2) * kstep;
            const char* b3 = b2 + kstep;
            G8_LDB(B0, 0, 0); G8_SCHED; G8_LDA(At, 0, 0); G8_STAGEA(G8_SA(1, 1), cA, 1, k1);
            if constexpr (GATHER) { if (last && has_next) S.aoff(nxt, tid, vA); }
            G8_WAIT_L(8); G8_BAR; G8_WAIT_L(0); G8_MMA(0, 0, At, B0); G8_BAR; G8_SCHED;
            G8_LDB(B1, 0, 1); G8_STAGE(G8_SB(0, 0), b2, voffB);
            G8_BAR; G8_WAIT_L(0); G8_MMA(0, 1, At, B1); G8_BAR;
            G8_LDA(At, 0, 1); G8_STAGEA(G8_SA(0, 0), a2, 0, k2);
            G8_BAR; G8_WAIT_L(0); G8_MMA(1, 0, At, B0); G8_BAR; G8_SCHED;
            G8_STAGE(G8_SB(0, 1), b2 + hstep, voffB);
            G8_WAIT_V(6); G8_BAR; G8_MMA(1, 1, At, B1); G8_BAR;
            G8_LDB(B0, 1, 0); G8_SCHED; G8_LDA(At, 1, 0); G8_STAGEA(G8_SA(0, 1), a2, 1, k2);
            G8_WAIT_L(8); G8_BAR; G8_WAIT_L(0); G8_MMA(0, 0, At, B0); G8_BAR; G8_SCHED;
            G8_LDB(B1, 1, 1); G8_STAGE(G8_SB(1, 0), b3, voffB);
            G8_BAR; G8_WAIT_L(0); G8_MMA(0, 1, At, B1); G8_BAR;
            G8_LDA(At, 1, 1); G8_STAGEA(G8_SA(1, 0), a2, 0, k3);
            G8_BAR; G8_WAIT_L(0); G8_MMA(1, 0, At, B0); G8_BAR; G8_SCHED;
            G8_STAGE(G8_SB(1, 1), b3 + hstep, voffB);
            G8_WAIT_V(6); G8_BAR; G8_MMA(1, 1, At, B1); G8_BAR;
        }
        E(acc, cur, wr, wc, fr, fq);
        if (!has_next) break;
#pragma unroll
        for (int a = 0; a < 2; ++a)
#pragma unroll
            for (int b = 0; b < 2; ++b)
#pragma unroll
                for (int m = 0; m < 4; ++m)
#pragma unroll
                    for (int n = 0; n < 2; ++n) acc[a][b][m][n] = (f32x4){0.f, 0.f, 0.f, 0.f};
        cur = nxt; cA = nA; cB = nB; ++ui;
    }
    G8_WAIT_V(0);
    if (wr == 0) G8_BAR;
    G8_BAR;
#undef G8_SA
#undef G8_SB
#undef G8_STAGE
#undef G8_STAGEA
#undef G8_LDA
#undef G8_LDB
#undef G8_MMA
#undef G8_WAIT_V
#undef G8_WAIT_L
#undef G8_BAR
#undef G8_SCHED
}
}

__device__ __forceinline__ bool tile_map(int i, const Ctx& c, int ntm, int ntn, int& mt, int& nt) {
    const int vb = ((c.nblk & 15) == 0) ? ((c.bid >> 1) & 7) * (c.nblk >> 3) + (((c.bid >> 4) << 1) | (c.bid & 1)) : c.bid;
    const int L = i * c.nblk + vb;
    if (L >= ntm * ntn) return false;
    const int g = L / (8 * ntn), rem = L - g * 8 * ntn;
    const int gsz = (ntm - g * 8) < 8 ? (ntm - g * 8) : 8;
    mt = g * 8 + rem % gsz; nt = rem / gsz;
    return true;
}

__device__ __forceinline__ bool tile_map2(int i, const Ctx& c, int ntm, int ntn, int& mt, int& nt, bool& valid) {
    Ctx o = c; o.bid = c.bid ^ 1;
    int mo, no; const bool oko = tile_map(i, o, ntm, ntn, mo, no);
    valid = tile_map(i, c, ntm, ntn, mt, nt);
    if (!valid) { mt = 0; nt = 0; }
    return valid || oko;
}

struct DenseSched {
    int ntm, ntn, K, bid, nblk;
    __device__ __forceinline__ bool next(int i, g8::Unit& u) const {
        const int vb = ((nblk & 7) == 0) ? (bid & 7) * (nblk >> 3) + (bid >> 3) : bid;
        const int L = i * nblk + vb;
        if (L >= ntm * ntn) return false;
        const int g = L / (8 * ntn), rem = L - g * 8 * ntn;
        const int gsz = (ntm - g * 8) < 8 ? (ntm - g * 8) : 8;
        u.pm = g * 8 + rem % gsz; u.pn = rem / gsz; u.bt = u.pn;
        return true;
    }
};
struct MoeSched {
    int nrb, ntn, bid, nblk; const int* eb;
    __device__ __forceinline__ bool next(int i, g8::Unit& u) const {
        const int vb = ((nblk & 7) == 0) ? (bid & 7) * (nblk >> 3) + (bid >> 3) : bid;
        const int L = i * nblk + vb;
        if (L >= nrb * ntn) return false;
        const int g = L / (8 * ntn), rem = L - g * 8 * ntn;
        const int gsz = (nrb - g * 8) < 8 ? (nrb - g * 8) : 8;
        u.pm = g * 8 + rem % gsz; u.pn = rem / gsz;
        u.bt = eb[u.pm] * ntn + u.pn;
        return true;
    }
};
struct MoeSchedG {
    int nrb, bid, nblk; const int* eb; const int* bst; const int* LTOK;
    __device__ __forceinline__ bool next(int i, g8::Unit& u) const {
        const int vb = ((nblk & 7) == 0) ? (bid & 7) * (nblk >> 3) + (bid >> 3) : bid;
        const int L = i * nblk + vb;
        if (L >= nrb * 2) return false;
        const int g = L >> 4, rem = L & 15;
        const int gsz = (nrb - g * 8) < 8 ? (nrb - g * 8) : 8;
        u.pm = g * 8 + rem % gsz; u.pn = rem / gsz;
        u.bt = eb[u.pm] * 2 + u.pn;
        return true;
    }
    __device__ __forceinline__ void aoff(const g8::Unit& u, int tid, unsigned (&o)[4]) const {
        const int e = eb[u.pm], lb = u.pm - bst[e], cnt = bst[66 + e];
        int R0, C0, R1, C1; g8::stage_rc(tid * 16, R0, C0); g8::stage_rc(tid * 16 + 8192, R1, C1);
        const int* lt = LTOK + (size_t)e * CAP + lb * RBR;
        const int p00 = R0, p01 = R1, p10 = 128 + R0, p11 = 128 + R1;
        const int t00 = (lb * RBR + p00 < cnt) ? lt[p00] : 0, t01 = (lb * RBR + p01 < cnt) ? lt[p01] : 0;
        const int t10 = (lb * RBR + p10 < cnt) ? lt[p10] : 0, t11 = (lb * RBR + p11 < cnt) ? lt[p11] : 0;
        o[0] = (unsigned)t00 * 2048u + (unsigned)C0 * 2u; o[1] = (unsigned)t01 * 2048u + (unsigned)C1 * 2u;
        o[2] = (unsigned)t10 * 2048u + (unsigned)C0 * 2u; o[3] = (unsigned)t11 * 2048u + (unsigned)C1 * 2u;
    }
};
struct EpiMoe1 {
    bf16_t* H;
    __device__ __forceinline__ void operator()(const f32x4 (&acc)[2][2][4][2], const g8::Unit& u, int wr, int wc, int fr, int fq) const {
#pragma unroll
        for (int ai = 0; ai < 2; ++ai)
#pragma unroll
            for (int m = 0; m < 4; ++m) {
                const size_t row = (size_t)u.pm * RBR + ai * 128 + wr * 64 + m * 16 + fr;
#pragma unroll
                for (int bj = 0; bj < 2; ++bj) {
                    const int hc = (u.pn * 8 + bj * 4 + wc) * 16 + fq * 4;
                    const f32x4 g = acc[ai][bj][m][0], up = acc[ai][bj][m][1];
                    float h[4];
#pragma unroll
                    for (int j = 0; j < 4; ++j) h[j] = g[j] * __builtin_amdgcn_rcpf(1.f + __expf(-g[j])) * up[j];
                    *(u32x2*)(H + row * 256 + hc) = (u32x2){cvt_pk(h[0], h[1]), cvt_pk(h[2], h[3])};
                }
            }
    }
};
struct EpiIn {
    bf16_t* P; float* G; int gbase;
    __device__ __forceinline__ void operator()(const f32x4 (&acc)[2][2][4][2], const g8::Unit& u, int wr, int wc, int fr, int fq) const {
#pragma unroll
        for (int ai = 0; ai < 2; ++ai)
#pragma unroll
            for (int m = 0; m < 4; ++m) {
                const size_t row = (size_t)u.pm * 256 + ai * 128 + wr * 64 + m * 16 + fr;
#pragma unroll
                for (int bj = 0; bj < 2; ++bj) {
                    const int col = u.pn * 256 + bj * 128 + wc * 32 + fq * 8;
                    const f32x4 v0 = acc[ai][bj][m][0], v1 = acc[ai][bj][m][1];
                    *(u32x4*)(P + row * NPAD + col) = (u32x4){cvt_pk(v0[0], v0[1]), cvt_pk(v0[2], v0[3]), cvt_pk(v1[0], v1[1]), cvt_pk(v1[2], v1[3])};
                    if (col == gbase) { *(f32x4*)(G + row * 8) = v0; *(f32x4*)(G + row * 8 + 4) = v1; }
                }
            }
    }
};
struct EpiMoe2 {
    bf16_t* Y;
    __device__ __forceinline__ void operator()(const f32x4 (&acc)[2][2][4][2], const g8::Unit& u, int wr, int wc, int fr, int fq) const {
#pragma unroll
        for (int ai = 0; ai < 2; ++ai)
#pragma unroll
            for (int m = 0; m < 4; ++m) {
                const size_t row = (size_t)u.pm * RBR + ai * 128 + wr * 64 + m * 16 + fr;
#pragma unroll
                for (int bj = 0; bj < 2; ++bj) {
                    const int col = u.pn * 256 + bj * 128 + wc * 32 + fq * 8;
                    const f32x4 v0 = acc[ai][bj][m][0], v1 = acc[ai][bj][m][1];
                    *(u32x4*)(Y + row * 1024 + col) = (u32x4){cvt_pk(v0[0], v0[1]), cvt_pk(v0[2], v0[3]), cvt_pk(v1[0], v1[1]), cvt_pk(v1[2], v1[3])};
                }
            }
    }
};
struct EpiOut {
    const float* xres; float* Y;
    __device__ __forceinline__ void operator()(const f32x4 (&acc)[2][2][4][2], const g8::Unit& u, int wr, int wc, int fr, int fq) const {
#pragma unroll
        for (int ai = 0; ai < 2; ++ai)
#pragma unroll
            for (int m = 0; m < 4; ++m) {
                const size_t row = (size_t)u.pm * 256 + ai * 128 + wr * 64 + m * 16 + fr;
#pragma unroll
                for (int bj = 0; bj < 2; ++bj)
#pragma unroll
                    for (int n = 0; n < 2; ++n) {
                        const int col = u.pn * 256 + bj * 128 + wc * 32 + n * 16 + fq * 4;
                        const f32x4 xr = *(const f32x4*)(xres + row * 1024 + col);
                        *(f32x4*)(Y + row * 1024 + col) = xr * ALPHA + acc[ai][bj][m][n];
                    }
                asm volatile("" ::: "memory");
            }
    }
};

constexpr int TS_RS = 272;
__device__ __forceinline__ void tile_put(const Ctx& c, int row_l, int col_l, const u32x2 v) { *(u32x2*)(c.smem + row_l * TS_RS + col_l * 2) = v; }
template <int NCOL>
__device__ __forceinline__ void tile_flush(const Ctx& c, bf16_t* out, size_t ld, bool valid) {
    __syncthreads();
    constexpr int CPR = NCOL / 8, PER = (128 * CPR) / 256;
#pragma unroll
    for (int i = 0; i < PER; ++i) {
        const int idx = c.tid + 256 * i, row = idx / CPR, ch = idx % CPR;
        const u32x4 v = *(const u32x4*)(c.smem + row * TS_RS + ch * 16);
        if (valid) *(u32x4*)(out + (size_t)row * ld + ch * 8) = v;
    }
    __syncthreads();
}

__device__ __forceinline__ void conv_family(const float* src, int nmat, size_t src_stride, int K, int N, int Nout,
                            bf16_t* dst, size_t dst_stride, int grp, int kind, const Ctx& c) {
    float* lds = (float*)c.smem;
    const int tk = K / 128, tn = Nout / 64, per = tk * tn, total = nmat * per;
    const int tx = c.tid & 15, ty = c.tid >> 4;
    f32x4 r[8];
#define CV_LOAD(u_) do { const int mat_ = (u_) / per, r_ = (u_) - mat_ * per, kt_ = r_ / tn, nt_ = r_ - kt_ * tn; \
        const float* s_ = src + (size_t)mat_ * src_stride + (size_t)(kt_ * 128 + ty) * N + nt_ * 64 + tx * 4; const bool in_ = (nt_ * 64 + tx * 4) < N; \
        _Pragma("unroll") for (int i = 0; i < 8; ++i) r[i] = in_ ? *(const f32x4*)(s_ + (size_t)(16 * i) * N) : (f32x4){0.f, 0.f, 0.f, 0.f}; } while (0)
    if (c.bid < total) CV_LOAD(c.bid);
    for (int base = 0; base < total; base += c.nblk) {
        const int u = base + c.bid; const bool valid = u < total;
#pragma unroll
        for (int i = 0; i < 8; ++i) *(f32x4*)(lds + (ty + 16 * i) * 68 + tx * 4) = r[i];
        if (u + c.nblk < total) CV_LOAD(u + c.nblk);
        __syncthreads();
        if (valid) {
        const int mat = u / per, rr = u - mat * per, kt = rr / tn, nt = rr - kt * tn;
        const int dmat = grp ? (mat / grp) * (grp + 1) + (mat % grp) : mat;
        bf16_t* d = dst + (size_t)dmat * dst_stride;
        const int nl = c.tid & 63, kq = (c.tid >> 6) * 32;
        unsigned w[16];
#pragma unroll
        for (int j = 0; j < 16; ++j) w[j] = pk2(lds[(kq + 2 * j) * 68 + nl], lds[(kq + 2 * j + 1) * 68 + nl]);
        const int n = nt * 64 + nl;
        const int drow = (kind == 0) ? n : ((n >> 4) * 32 + (n & 15) + (kind == 2 ? 16 : 0));
        u32x4* dp = (u32x4*)(d + (size_t)drow * K + kt * 128 + kq);
        dp[0] = (u32x4){w[0], w[1], w[2], w[3]}; dp[1] = (u32x4){w[4], w[5], w[6], w[7]};
        dp[2] = (u32x4){w[8], w[9], w[10], w[11]}; dp[3] = (u32x4){w[12], w[13], w[14], w[15]};
        }
        __syncthreads();
    }
#undef CV_LOAD
}

__device__ __forceinline__ void phase_prologue(const Args& a, const Ctx& c) {
    unsigned char* ws = a.ws;
    bf16_t* WIN = (bf16_t*)(ws + WS_WIN);
    conv_family((const float*)a.in[2], 2, (size_t)1024 * 2472, 1024, 2472, NPAD, WIN, 2 * WIN_ELEMS, 0, 0, c);
    conv_family((const float*)a.in[12], 2, (size_t)1024 * 2312, 1024, 2312, NPAD, WIN + WIN_ELEMS, 2 * WIN_ELEMS, 0, 0, c);
    conv_family((const float*)a.in[4], 2, (size_t)256 * 768, 256, 768, 768, (bf16_t*)(ws + WS_WQB), WQB_ELEMS, 0, 0, c);
    conv_family((const float*)a.in[6], 2, (size_t)128 * 1024, 128, 1024, 1024, (bf16_t*)(ws + WS_WKVB), WKVB_ELEMS, 0, 0, c);
    bf16_t* WOUT = (bf16_t*)(ws + WS_WOUT);
    conv_family((const float*)a.in[11], 2, (size_t)1024 * 1024, 1024, 1024, 1024, WOUT, 2 * WOUT_ELEMS, 0, 0, c);
    conv_family((const float*)a.in[17], 2, (size_t)1024 * 1024, 1024, 1024, 1024, WOUT + WOUT_ELEMS, 2 * WOUT_ELEMS, 0, 0, c);
    conv_family((const float*)a.in[20], 4, (size_t)1024 * 64, 1024, 64, 128, (bf16_t*)(ws + WS_WRT), WRT_ELEMS, 0, 0, c);
    bf16_t* WGU = (bf16_t*)(ws + WS_WGU);
    conv_family((const float*)a.in[22], 256, (size_t)1024 * 256, 1024, 256, 256, WGU, WGU_ELEMS, 64, 1, c);
    conv_family((const float*)a.in[23], 256, (size_t)1024 * 256, 1024, 256, 256, WGU, WGU_ELEMS, 64, 2, c);
    conv_family((const float*)a.in[25], 4, (size_t)1024 * 256, 1024, 256, 256, WGU + 64 * WGU_ELEMS, 65 * WGU_ELEMS, 0, 1, c);
    conv_family((const float*)a.in[26], 4, (size_t)1024 * 256, 1024, 256, 256, WGU + 64 * WGU_ELEMS, 65 * WGU_ELEMS, 0, 2, c);
    bf16_t* WDN = (bf16_t*)(ws + WS_WDN);
    conv_family((const float*)a.in[24], 256, (size_t)256 * 1024, 256, 1024, 1024, WDN, WDN_ELEMS, 64, 0, c);
    conv_family((const float*)a.in[27], 4, (size_t)256 * 1024, 256, 1024, 1024, WDN + 64 * WDN_ELEMS, 65 * WDN_ELEMS, 0, 0, c);
    {
        const float* x = (const float*)a.in[0]; bf16_t* xb = (bf16_t*)(ws + WS_XBF);
        const size_t n8 = (size_t)T * 1024 / 8;
        for (size_t i = (size_t)c.bid * 256 + c.tid; i < n8; i += (size_t)c.nblk * 256) {
            const f32x4 v0 = *(const f32x4*)(x + i * 8), v1 = *(const f32x4*)(x + i * 8 + 4);
            *(u32x4*)(xb + i * 8) = (u32x4){pk2(v0[0], v0[1]), pk2(v0[2], v0[3]), pk2(v1[0], v1[1]), pk2(v1[2], v1[3])};
        }
    }
    {
        const int* pos = (const int*)a.in[1];
        float* rm = (float*)(ws + WS_ROPEM); float* rs = (float*)(ws + WS_ROPES);
        const float ln_theta = 9.210340371976184f;
        for (int i = c.bid * 256 + c.tid; i < T * 16; i += c.nblk * 256) {
            const int t = i >> 4, f = i & 15;
            const float inv = expf(-((float)(2 * f) / 32.f) * ln_theta);
            const float ang = (float)pos[t] * inv;
            rm[i * 2] = cosf(ang); rm[i * 2 + 1] = sinf(ang);
        }
        for (int i = c.bid * 256 + c.tid; i < T * 32; i += c.nblk * 256) {
            const int t = i >> 5, f = i & 31;
            const float inv = expf(-((float)(2 * f) / 64.f) * ln_theta);
            const float ang = (float)pos[t] * inv;
            rs[i * 2] = cosf(ang); rs[i * 2 + 1] = sinf(ang);
        }
    }
}

__device__ __forceinline__ void phase_inproj(const bf16_t* XBF, const bf16_t* W, bf16_t* PROJ, float* GATES, int gbase, const Ctx& c) {
    const int ntn = NPAD / 128;
    for (int i = 0;; ++i) {
        int mt, nt; bool valid; if (!tile_map2(i, c, T / 128, ntn, mt, nt, valid)) break;
        const bf16_t* a0 = XBF + (size_t)(mt * 128 + (c.tid >> 2)) * 1024;
        const bf16_t* b0 = W + (size_t)(nt * 128 + (c.tid >> 2)) * 1024;
        f32x4 acc[4][4];
        gemm_tile(a0, a0 + 64 * 1024, b0, b0 + 64 * 1024, 32, acc, c);
#pragma unroll
        for (int m = 0; m < 4; ++m) {
            const int rl = c.wr * 64 + m * 16 + c.fr, row = mt * 128 + rl;
#pragma unroll
            for (int n = 0; n < 4; ++n) {
                const int cl = c.wc * 64 + n * 16 + c.fq * 4, col = nt * 128 + cl;
                const f32x4 v = acc[m][n];
                tile_put(c, rl, cl, (u32x2){pk2(v[0], v[1]), pk2(v[2], v[3])});
                if (valid && col >= gbase && col < gbase + 8) *(f32x4*)(GATES + (size_t)row * 8 + (col - gbase)) = v;
            }
        }
        tile_flush<128>(c, PROJ + (size_t)mt * 128 * NPAD + nt * 128, NPAD, valid);
    }
}

constexpr int MLAUP_TILES = (T / 128) * 6 + (T / 128) * 8;
__device__ __forceinline__ void mla_up_tile(int u, const bf16_t* CQ, const bf16_t* WQB, const bf16_t* CKV, const bf16_t* WKVB,
                             const float* ROPEM, bf16_t* QF, bf16_t* KN, bf16_t* VV, const Ctx& c) {
    const int tq = (T / 128) * 6;
    const float qscale = 0.10206207261596577f * 1.4426950408889634f;
    {
        f32x4 acc[4][4];
        if (u < tq) {
            const int mt = u / 6, nt = u % 6;
            const bf16_t* a0 = CQ + (size_t)(mt * 128 + (c.tid >> 2)) * 256;
            const bf16_t* b0 = WQB + (size_t)(nt * 128 + (c.tid >> 2)) * 256;
            gemm_tile(a0, a0 + 64 * 256, b0, b0 + 64 * 256, 8, acc, c);
#pragma unroll
            for (int m = 0; m < 4; ++m) {
                const int row = mt * 128 + c.wr * 64 + m * 16 + c.fr;
#pragma unroll
                for (int np = 0; np < 2; ++np) {
                    const int cg = nt * 128 + c.wc * 64 + np * 32;
                    f32x4 v0 = acc[m][2 * np], v1 = acc[m][2 * np + 1];
                    if (((cg >> 5) % 3) == 2) {
#pragma unroll
                        for (int j = 0; j < 4; ++j) {
                            const int i = c.fq * 4 + j;
                            const float cs = ROPEM[((size_t)row * 16 + i) * 2], sn = ROPEM[((size_t)row * 16 + i) * 2 + 1];
                            const float x1 = v0[j], x2 = v1[j];
                            v0[j] = x1 * cs - x2 * sn; v1[j] = x2 * cs + x1 * sn;
                        }
                    }
                    v0 *= qscale; v1 *= qscale;
                    *(u32x2*)(QF + (size_t)row * 768 + cg + c.fq * 4) = (u32x2){pk2(v0[0], v0[1]), pk2(v0[2], v0[3])};
                    *(u32x2*)(QF + (size_t)row * 768 + cg + 16 + c.fq * 4) = (u32x2){pk2(v1[0], v1[1]), pk2(v1[2], v1[3])};
                }
            }
        } else {
            const int v = u - tq, mt = v / 8, nt = v % 8;
            const bf16_t* a0 = CKV + (size_t)(mt * 128 + (c.tid >> 2)) * 128;
            const bf16_t* b0 = WKVB + (size_t)(nt * 128 + (c.tid >> 2)) * 128;
            gemm_tile(a0, a0 + 64 * 128, b0, b0 + 64 * 128, 4, acc, c);
            bf16_t* dst = (c.wc == 0) ? KN : VV;
#pragma unroll
            for (int m = 0; m < 4; ++m) {
                const int row = mt * 128 + c.wr * 64 + m * 16 + c.fr;
#pragma unroll
                for (int n = 0; n < 4; ++n) {
                    const f32x4 x = acc[m][n];
                    *(u32x2*)(dst + (size_t)row * 512 + nt * 64 + n * 16 + c.fq * 4) = (u32x2){pk2(x[0], x[1]), pk2(x[2], x[3])};
                }
            }
        }
    }
}

__device__ __forceinline__ void phase_outproj(const bf16_t* MIXO, const bf16_t* W, const float* xres, float* YBUF, const Ctx& c) {
    for (int i = 0;; ++i) {
        int mt, nt; bool valid; if (!tile_map2(i, c, T / 128, 8, mt, nt, valid)) break;
        const bf16_t* a0 = MIXO + (size_t)(mt * 128 + (c.tid >> 2)) * 1024;
        const bf16_t* b0 = W + (size_t)(nt * 128 + (c.tid >> 2)) * 1024;
        f32x4 acc[4][4];
        gemm_tile(a0, a0 + 64 * 1024, b0, b0 + 64 * 1024, 32, acc, c);
#pragma unroll
        for (int m = 0; m < 4; ++m) {
            const int row = mt * 128 + c.wr * 64 + m * 16 + c.fr;
#pragma unroll
            for (int n = 0; n < 4; ++n) {
                const int col = nt * 128 + c.wc * 64 + n * 16 + c.fq * 4;
                const f32x4 xr = *(const f32x4*)(xres + (size_t)row * 1024 + col);
                if (valid) *(f32x4*)(YBUF + (size_t)row * 1024 + col) = xr * ALPHA + acc[m][n];
            }
        }
    }
}

__device__ __forceinline__ void phase_router(const bf16_t* XBF, const bf16_t* W, float* LOG, const Ctx& c) {
    for (int base = 0; base < T / 128; base += c.nblk) {
        const bool valid = (base + c.bid) < T / 128; const int mt = valid ? base + c.bid : 0;
        const bf16_t* a0 = XBF + (size_t)(mt * 128 + (c.tid >> 2)) * 1024;
        const bf16_t* b0 = W + (size_t)(c.tid >> 2) * 1024;
        f32x4 acc[4][4];
        gemm_tile(a0, a0 + 64 * 1024, b0, b0 + 64 * 1024, 32, acc, c);
        if (c.wc == 0 && valid) {
#pragma unroll
            for (int m = 0; m < 4; ++m) {
                const int row = mt * 128 + c.wr * 64 + m * 16 + c.fr;
#pragma unroll
                for (int n = 0; n < 4; ++n) *(f32x4*)(LOG + (size_t)row * 64 + n * 16 + c.fq * 4) = acc[m][n];
            }
        }
    }
}

__device__ __forceinline__ void build_block_table(const unsigned* CNT, int* bst, const Ctx& c) {
    __syncthreads();
    if (c.wid == 0) {
        const int cnt = (int)__hip_atomic_load(CNT + c.lane, __ATOMIC_RELAXED, __HIP_MEMORY_SCOPE_AGENT);
        const int nb = (cnt + RBR - 1) / RBR;
        int inc = nb;
#pragma unroll
        for (int o = 1; o < 64; o <<= 1) { const int x = __shfl_up(inc, o); if (c.lane >= o) inc += x; }
        bst[c.lane] = inc - nb; bst[66 + c.lane] = cnt;
        if (c.lane == 63) { bst[64] = inc; bst[65] = inc + T / RBR; bst[66 + 64] = T; }
    }
    __syncthreads();
}
__device__ __forceinline__ int find_expert(const int* bst, int rb, const Ctx& c) {
    return __popcll(__ballot(bst[1 + c.lane] <= rb));
}

__device__ __forceinline__ void phase_moe1(const bf16_t* XBF, const bf16_t* WGU, const unsigned* CNT, const int* LTOK, const float* LW, bf16_t* HBUF, const Ctx& c) {
    int* bst = (int*)(c.smem + 65536 + 64);
    build_block_table(CNT, bst, c);
    const int nsb = bst[65] * 2;
    for (int i = 0;; ++i) {
        int sbk, nt; bool valid; if (!tile_map2(i, c, nsb, 4, sbk, nt, valid)) break;
        const int rb = sbk >> 1, hb = sbk & 1;
        const int e = find_expert(bst, rb, c);
        const int lb = rb - bst[e], cnt = bst[66 + e];
        const int p0 = lb * RBR + hb * 128 + (c.tid >> 2), p1 = p0 + 64;
        const int t0 = (p0 < cnt) ? LTOK[(size_t)e * CAP + p0] : 0;
        const int t1 = (p1 < cnt) ? LTOK[(size_t)e * CAP + p1] : 0;
        const bf16_t* a0 = XBF + (size_t)t0 * 1024;
        const bf16_t* a1 = XBF + (size_t)t1 * 1024;
        const bf16_t* b0 = WGU + (size_t)e * WGU_ELEMS + (size_t)(nt * 128 + (c.tid >> 2)) * 1024;
        f32x4 acc[4][4];
        gemm_tile(a0, a1, b0, b0 + 64 * 1024, 32, acc, c);
#pragma unroll
        for (int m = 0; m < 4; ++m) {
            const int rl = c.wr * 64 + m * 16 + c.fr;
            const int pw = lb * RBR + hb * 128 + rl;
            const float wrow = (pw < cnt) ? LW[(size_t)e * CAP + pw] : 0.f;
#pragma unroll
            for (int n = 0; n < 2; ++n) {
                const f32x4 g = acc[m][n], up = acc[m][n + 2];
                float h[4];
#pragma unroll
                for (int j = 0; j < 4; ++j) h[j] = siluf_(g[j]) * up[j] * wrow;
                tile_put(c, rl, c.wc * 32 + n * 16 + c.fq * 4, (u32x2){pk2(h[0], h[1]), pk2(h[2], h[3])});
            }
        }
        tile_flush<64>(c, HBUF + ((size_t)rb * RBR + hb * 128) * 256 + nt * 64, 256, valid);
    }
}

__device__ __forceinline__ void phase_moe2(const bf16_t* HBUF, const bf16_t* WDN, const unsigned* CNT, bf16_t* Y, const Ctx& c) {
    int* bst = (int*)(c.smem + 65536 + 64);
    build_block_table(CNT, bst, c);
    const int nsb = bst[65] * 2;
    for (int i = 0;; ++i) {
        int sbk, nt; bool valid; if (!tile_map2(i, c, nsb, 8, sbk, nt, valid)) break;
        const int rb = sbk >> 1;
        const int e = find_expert(bst, rb, c);
        const bf16_t* a0 = HBUF + ((size_t)sbk * 128 + (c.tid >> 2)) * 256;
        const bf16_t* b0 = WDN + (size_t)e * WDN_ELEMS + (size_t)(nt * 128 + (c.tid >> 2)) * 256;
        f32x4 acc[4][4];
        gemm_tile(a0, a0 + 64 * 256, b0, b0 + 64 * 256, 8, acc, c);
#pragma unroll
        for (int m = 0; m < 4; ++m) {
            const int lr = c.wr * 64 + m * 16 + c.fr;
#pragma unroll
            for (int n = 0; n < 4; ++n) {
                const f32x4 v = acc[m][n];
                tile_put(c, lr, c.wc * 64 + n * 16 + c.fq * 4, (u32x2){pk2(v[0], v[1]), pk2(v[2], v[3])});
            }
        }
        tile_flush<128>(c, Y + (size_t)sbk * 128 * 1024 + nt * 128, 1024, valid);
    }
}

__device__ __forceinline__ float dppf(float v, int ctrl_sel) {
    int x = __builtin_bit_cast(int, v), r;
    if (ctrl_sel == 0) r = __builtin_amdgcn_update_dpp(0, x, 0xB1, 0xF, 0xF, true);
    else if (ctrl_sel == 1) r = __builtin_amdgcn_update_dpp(0, x, 0x4E, 0xF, 0xF, true);
    else if (ctrl_sel == 2) r = __builtin_amdgcn_update_dpp(0, x, 0x141, 0xF, 0xF, true);
    else r = __builtin_amdgcn_update_dpp(0, x, 0x140, 0xF, 0xF, true);
    return __builtin_bit_cast(float, r);
}
__device__ __forceinline__ float red16(float v) { v += dppf(v, 0); v += dppf(v, 1); v += dppf(v, 2); v += dppf(v, 3); return v; }

__device__ __forceinline__ void ln_row_store(float (&v)[16], const float* g, const float* b, float* of32, bf16_t* obf, int lane) {
    float s = 0.f;
#pragma unroll
    for (int i = 0; i < 16; ++i) s += v[i];
    const float mean = wave_sum(s) * (1.f / 1024.f);
    float q = 0.f;
#pragma unroll
    for (int i = 0; i < 16; ++i) { v[i] -= mean; q += v[i] * v[i]; }
    const float rstd = rsqrtf(wave_sum(q) * (1.f / 1024.f) + 1e-5f);
#pragma unroll
    for (int hf = 0; hf < 2; ++hf) {
        const int col = hf * 512 + lane * 8;
        const f32x4 g0 = *(const f32x4*)(g + col), g1 = *(const f32x4*)(g + col + 4);
        const f32x4 b0 = *(const f32x4*)(b + col), b1 = *(const f32x4*)(b + col + 4);
        f32x4 y0, y1;
#pragma unroll
        for (int j = 0; j < 4; ++j) { y0[j] = v[hf * 8 + j] * rstd * g0[j] + b0[j]; y1[j] = v[hf * 8 + 4 + j] * rstd * g1[j] + b1[j]; }
        *(f32x4*)(of32 + col) = y0; *(f32x4*)(of32 + col + 4) = y1;
        *(u32x4*)(obf + col) = (u32x4){pk2(y0[0], y0[1]), pk2(y0[2], y0[3]), pk2(y1[0], y1[1]), pk2(y1[2], y1[3])};
    }
}

__device__ __forceinline__ void phase_ln1(const float* YBUF, const float* g, const float* b, float* X1, bf16_t* XBF, const Ctx& c) {
    for (int t = c.bid * 4 + c.wid; t < T; t += c.nblk * 4) {
        float v[16];
#pragma unroll
        for (int hf = 0; hf < 2; ++hf) {
            const float* p = YBUF + (size_t)t * 1024 + hf * 512 + c.lane * 8;
            const f32x4 a0 = *(const f32x4*)p, a1 = *(const f32x4*)(p + 4);
#pragma unroll
            for (int j = 0; j < 4; ++j) { v[hf * 8 + j] = a0[j]; v[hf * 8 + 4 + j] = a1[j]; }
        }
        ln_row_store(v, g, b, X1 + (size_t)t * 1024, XBF + (size_t)t * 1024, c.lane);
    }
}

__device__ __forceinline__ void phase_combine(const float* X1, const bf16_t* Y, const int* ASG, const float* ASGW, const unsigned* CNT, const float* g, const float* b,
                              float* XOUT, bf16_t* XBF, const Ctx& c) {
    int* bst = (int*)(c.smem + 65536 + 64);
    build_block_table(CNT, bst, c);
    for (int t = c.bid * 4 + c.wid; t < T; t += c.nblk * 4) {
        float v[16];
#pragma unroll
        for (int hf = 0; hf < 2; ++hf) {
            const float* p = X1 + (size_t)t * 1024 + hf * 512 + c.lane * 8;
            const f32x4 a0 = *(const f32x4*)p, a1 = *(const f32x4*)(p + 4);
#pragma unroll
            for (int j = 0; j < 4; ++j) { v[hf * 8 + j] = a0[j] * ALPHA; v[hf * 8 + 4 + j] = a1[j] * ALPHA; }
        }
#pragma unroll
        for (int k = 0; k < 9; ++k) {
            size_t crow; float wk = 1.f;
            if (k < 8) { const int asg = ASG[(size_t)t * 8 + k]; crow = (size_t)bst[asg >> 16] * RBR + (asg & 0xffff); wk = ASGW[(size_t)t * 8 + k]; }
            else crow = (size_t)bst[64] * RBR + t;
#pragma unroll
            for (int hf = 0; hf < 2; ++hf) {
                const u32x4 r = *(const u32x4*)(Y + crow * 1024 + hf * 512 + c.lane * 8);
                float f[8]; unpack8(r, f);
#pragma unroll
                for (int j = 0; j < 8; ++j) v[hf * 8 + j] += f[j] * wk;
            }
        }
        ln_row_store(v, g, b, XOUT + (size_t)t * 1024, XBF + (size_t)t * 1024, c.lane);
    }
}

__device__ __forceinline__ void phase_route(const float* LOG, const float* rb, unsigned* CNT, int* LTOK, float* LW, int* ASG, float* ASGW, const Ctx& c) {
    int* lcnt = (int*)c.smem;
    int* lbase = lcnt + 64;
    int* sel_e = lbase + 64;
    int* sel_p = sel_e + 256;
    float* sel_w = (float*)(sel_p + 256);
    const float rbias = rb[c.lane];
    for (int base = 0; base < T / 32; base += c.nblk) {
        const int ch = base + c.bid; const bool valid = ch < T / 32;
        __syncthreads();
        if (c.tid < 64) lcnt[c.tid] = 0;
        __syncthreads();
        if (valid) for (int tl = c.wid; tl < 32; tl += 4) {
            const int t = ch * 32 + tl;
            const float lg = LOG[(size_t)t * 64 + c.lane];
            const float sc = 1.f / (1.f + expf(-lg));
            const float v = sc + rbias;
            float m1 = v;
            m1 = fmaxf(m1, __shfl_xor(m1, 1)); m1 = fmaxf(m1, __shfl_xor(m1, 2)); m1 = fmaxf(m1, __shfl_xor(m1, 4));
            int cand = (v == m1) ? c.lane : 999;
            cand = min(cand, __shfl_xor(cand, 1)); cand = min(cand, __shfl_xor(cand, 2)); cand = min(cand, __shfl_xor(cand, 4));
            float m2 = (c.lane == cand) ? -INFINITY : v;
            m2 = fmaxf(m2, __shfl_xor(m2, 1)); m2 = fmaxf(m2, __shfl_xor(m2, 2)); m2 = fmaxf(m2, __shfl_xor(m2, 4));
            const float gs = m1 + m2;
            const int g = c.lane >> 3;
            int grank = 0;
#pragma unroll
            for (int gg = 0; gg < 8; ++gg) { const float o = __shfl(gs, gg * 8); grank += ((o > gs) || (o == gs && gg < g)) ? 1 : 0; }
            const bool gsel = grank < 4;
            const float mv = gsel ? v : -INFINITY;
            int rank = 0;
#pragma unroll 8
            for (int jj = 0; jj < 64; ++jj) { const float o = __shfl(mv, jj); rank += ((o > mv) || (o == mv && jj < c.lane)) ? 1 : 0; }
            const bool sel = gsel && rank < 8;
            const float ssum = wave_sum(sel ? sc : 0.f);
            const float w = sc / ssum * 2.5f;
            const unsigned long long bal = __ballot(sel);
            const int slot = __popcll(bal & ((1ull << c.lane) - 1ull));
            if (sel) {
                const int p = atomicAdd(&lcnt[c.lane], 1);
                sel_e[tl * 8 + slot] = c.lane; sel_p[tl * 8 + slot] = p; sel_w[tl * 8 + slot] = w;
            }
        }
        __syncthreads();
        if (valid && c.tid < 64) { const int n = lcnt[c.tid]; lbase[c.tid] = n ? (int)atomicAdd(CNT + c.tid, (unsigned)n) : 0; }
        __syncthreads();
        if (valid) {
            const int tl = c.tid >> 3, t = ch * 32 + tl;
            const int e = sel_e[c.tid], pos = lbase[e] + sel_p[c.tid];
            LTOK[(size_t)e * CAP + pos] = t; LW[(size_t)e * CAP + pos] = sel_w[c.tid];
            ASG[(size_t)t * 8 + (c.tid & 7)] = (e << 16) | pos; ASGW[(size_t)t * 8 + (c.tid & 7)] = sel_w[c.tid];
            if (c.tid < 32) { const int ts = ch * 32 + c.tid; LTOK[(size_t)64 * CAP + ts] = ts; LW[(size_t)64 * CAP + ts] = 1.f; }
        }
    }
}

__device__ __forceinline__ void phase_prep_even(const bf16_t* PROJ, const float* GATES, const float* qn, const float* kvn, const float* cw,
                                const float* a_log, const float* dt_bias, const float* ROPEM,
                                bf16_t* CQ, bf16_t* CKV, bf16_t* KROPE, bf16_t* GQ, bf16_t* GK, bf16_t* GV, float* BETA, float* GLOG, const Ctx& c) {
    const int lane = c.lane;
    float* cwL = (float*)c.smem;
    __syncthreads();
    for (int i = c.tid; i < 4 * 1536 / 4; i += 256) *(f32x4*)(cwL + i * 4) = *(const f32x4*)(cw + i * 4);
    __syncthreads();
    for (int t = c.bid * 4 + c.wid; t < T; t += c.nblk * 4) {
        const bf16_t* pr = PROJ + (size_t)t * NPAD;
        {
            const u32x2 r = *(const u32x2*)(pr + lane * 4);
            float v[4] = {bflo(r.x), bfhi(r.x), bflo(r.y), bfhi(r.y)};
            const float ss = wave_sum(v[0] * v[0] + v[1] * v[1] + v[2] * v[2] + v[3] * v[3]);
            const float rr = rsqrtf(ss * (1.f / 256.f) + 1e-6f);
            const f32x4 gq = *(const f32x4*)(qn + lane * 4);
            *(u32x2*)(CQ + (size_t)t * 256 + lane * 4) = (u32x2){pk2(v[0] * rr * gq[0], v[1] * rr * gq[1]), pk2(v[2] * rr * gq[2], v[3] * rr * gq[3])};
        }
        {
            const unsigned r = *(const unsigned*)(pr + 256 + lane * 2);
            const float v0 = bflo(r), v1 = bfhi(r);
            const float ss = wave_sum(v0 * v0 + v1 * v1);
            const float rr = rsqrtf(ss * (1.f / 128.f) + 1e-6f);
            *(unsigned*)(CKV + (size_t)t * 128 + lane * 2) = pk2(v0 * rr * kvn[lane * 2], v1 * rr * kvn[lane * 2 + 1]);
        }
        if (lane < 16) {
            const float x1 = bf2f(pr[384 + lane]), x2 = bf2f(pr[400 + lane]);
            const float cs = ROPEM[((size_t)t * 16 + lane) * 2], sn = ROPEM[((size_t)t * 16 + lane) * 2 + 1];
            KROPE[(size_t)t * 32 + lane] = (bf16_t)f2bf(x1 * cs - x2 * sn);
            KROPE[(size_t)t * 32 + 16 + lane] = (bf16_t)f2bf(x2 * cs + x1 * sn);
        }
        const int s = t & (SEQ - 1);
        u32x4 xr[3][4];
#pragma unroll
        for (int arr = 0; arr < 3; ++arr)
#pragma unroll
            for (int w = 0; w < 4; ++w)
                xr[arr][w] = (s - 3 + w >= 0) ? *(const u32x4*)(PROJ + (size_t)(t - 3 + w) * NPAD + 416 + arr * 512 + lane * 8) : (u32x4){0u, 0u, 0u, 0u};
#pragma unroll
        for (int arr = 0; arr < 3; ++arr) {
            float y[8];
#pragma unroll
            for (int j = 0; j < 8; ++j) y[j] = 0.f;
#pragma unroll
            for (int w = 0; w < 4; ++w) {
                float f[8]; unpack8(xr[arr][w], f);
                const f32x4 c0 = *(const f32x4*)(cwL + w * 1536 + arr * 512 + lane * 8), c1 = *(const f32x4*)(cwL + w * 1536 + arr * 512 + lane * 8 + 4);
#pragma unroll
                for (int j = 0; j < 4; ++j) { y[j] += c0[j] * f[j]; y[4 + j] += c1[j] * f[4 + j]; }
            }
            float ss = 0.f;
#pragma unroll
            for (int j = 0; j < 8; ++j) { y[j] = siluf_(y[j]); ss += y[j] * y[j]; }
            if (arr < 2) {
                float rr = rsqrtf(red16(ss) + 1e-6f);
                if (arr == 0) rr *= 0.08838834764831845f;
#pragma unroll
                for (int j = 0; j < 8; ++j) y[j] *= rr;
            }
            bf16_t* dst = (arr == 0) ? GQ : (arr == 1) ? GK : GV;
            *(u32x4*)(dst + (size_t)t * 512 + lane * 8) = (u32x4){pk2(y[0], y[1]), pk2(y[2], y[3]), pk2(y[4], y[5]), pk2(y[6], y[7])};
        }
        if (lane < 4) BETA[(size_t)t * 4 + lane] = sigmoidf_(GATES[(size_t)t * 8 + lane]);
        else if (lane < 8) { const int h = lane - 4; GLOG[(size_t)t * 4 + h] = -expf(a_log[h]) * softplusf_(GATES[(size_t)t * 8 + lane] + dt_bias[h]); }
    }
}

__device__ __forceinline__ void phase_prep_odd(const bf16_t* PROJ, const float* ROPES, bf16_t* SQ, bf16_t* SK, const Ctx& c) {
    const int lane = c.lane;
    for (int t = c.bid * 4 + c.wid; t < T; t += c.nblk * 4) {
        const bf16_t* pr = PROJ + (size_t)t * NPAD;
        const int i = lane & 31;
        const float cs = ROPES[((size_t)t * 32 + i) * 2], sn = ROPES[((size_t)t * 32 + i) * 2 + 1];
#pragma unroll
        for (int r = 0; r < 4; ++r) {
            const int h = (lane >> 5) + 2 * r;
            const float x1 = bf2f(pr[1544 + h * 64 + i]), x2 = bf2f(pr[1544 + h * 64 + 32 + i]);
            SQ[(size_t)t * 512 + h * 64 + i] = (bf16_t)f2bf((x1 * cs - x2 * sn) * 0.18033688011112042f);
            SQ[(size_t)t * 512 + h * 64 + 32 + i] = (bf16_t)f2bf((x2 * cs + x1 * sn) * 0.18033688011112042f);
        }
        {
            const int h = lane >> 5;
            const float x1 = bf2f(pr[2056 + h * 64 + i]), x2 = bf2f(pr[2056 + h * 64 + 32 + i]);
            SK[(size_t)t * 128 + h * 64 + i] = (bf16_t)f2bf(x1 * cs - x2 * sn);
            SK[(size_t)t * 128 + h * 64 + 32 + i] = (bf16_t)f2bf(x2 * cs + x1 * sn);
        }
    }
}

__device__ __forceinline__ int next_unit(unsigned* ctr, const Ctx& c) {
    volatile int* su = (volatile int*)(c.smem0 + LDS_BLK + 16);
    __syncthreads();
    if (c.tid0 == 0) *su = (int)atomicAdd(ctr, 1u);
    __syncthreads();
    return *su * 2 + c.half;
}

typedef float f32x16 __attribute__((ext_vector_type(16)));
typedef short s16x4 __attribute__((ext_vector_type(4)));
#define MFMA32(a, b, c) __builtin_amdgcn_mfma_f32_32x32x16_bf16((a), (b), (c), 0, 0, 0)
template <int S_> __device__ __forceinline__ bf16x8 pack_step(const f32x16& x) {
    u32x4 p;
    asm volatile("v_cvt_pk_bf16_f32 %0, %4, %5\n\tv_cvt_pk_bf16_f32 %1, %6, %7\n\tv_cvt_pk_bf16_f32 %2, %8, %9\n\tv_cvt_pk_bf16_f32 %3, %10, %11\n\ts_nop 1"
                 : "=&v"(p[0]), "=&v"(p[1]), "=&v"(p[2]), "=&v"(p[3])
                 : "v"(x[8 * S_]), "v"(x[8 * S_ + 1]), "v"(x[8 * S_ + 2]), "v"(x[8 * S_ + 3]), "v"(x[8 * S_ + 4]), "v"(x[8 * S_ + 5]), "v"(x[8 * S_ + 6]), "v"(x[8 * S_ + 7]));
    return __builtin_bit_cast(bf16x8, p);
}
template <int S_> __device__ __forceinline__ bf16x8 pack_step_m(const f32x16& x) {
    u32x4 p;
    asm volatile("s_nop 15\n\tv_cvt_pk_bf16_f32 %0, %4, %5\n\tv_cvt_pk_bf16_f32 %1, %6, %7\n\tv_cvt_pk_bf16_f32 %2, %8, %9\n\tv_cvt_pk_bf16_f32 %3, %10, %11\n\ts_nop 1"
                 : "=&v"(p[0]), "=&v"(p[1]), "=&v"(p[2]), "=&v"(p[3])
                 : "v"(x[8 * S_]), "v"(x[8 * S_ + 1]), "v"(x[8 * S_ + 2]), "v"(x[8 * S_ + 3]), "v"(x[8 * S_ + 4]), "v"(x[8 * S_ + 5]), "v"(x[8 * S_ + 6]), "v"(x[8 * S_ + 7]));
    return __builtin_bit_cast(bf16x8, p);
}
constexpr int ATT_VB = 64 * 128;

template <int NKS, bool WIN>
__device__ __forceinline__ void attn_unit(const bf16_t* Qp, int q_ld, const bf16_t* K1, int k1_ld, const bf16_t* K2, int k2_ld, const bf16_t* Vp, int v_ld,
                          bf16_t* Op, int o_ld, int Q0, float sink_l2, const Ctx& c) {
    constexpr int KB = NKS * 2 * 1024, BUF = KB + ATT_VB;
    const int lane = c.lane, r = lane & 31, h = lane >> 5;
    const int wid = __builtin_amdgcn_readfirstlane(c.wid);
    const int q0w = Q0 + wid * 32;
    unsigned char* smem = c.smem;
    bf16x8 qf[NKS];
#pragma unroll
    for (int ks = 0; ks < NKS; ++ks) qf[ks] = *(const bf16x8*)(Qp + (size_t)(q0w + r) * q_ld + ks * 16 + h * 8);
    f32x16 o0, o1;
#pragma unroll
    for (int i = 0; i < 16; ++i) { o0[i] = 0.f; o1[i] = 0.f; }
    float m = WIN ? sink_l2 : -1e30f, l = (WIN && h == 0) ? 1.f : 0.f;
    const int kt_lo = WIN ? ((Q0 >> 6) - 2 < 0 ? 0 : (Q0 >> 6) - 2) : 0, kt_hi = (Q0 >> 6) + 1;
#define ATT_STAGE(kt_, buf_) do { unsigned char* bp = smem + (buf_) * BUF; const size_t kb = (size_t)(kt_) * 64; \
        _Pragma("unroll") for (int i = 0; i < (NKS * 2) / 4; ++i) { const int ch = wid + 4 * i; \
            const bf16_t* sp = (ch < 8) ? (K1 + (kb + lane) * k1_ld + ch * 8) : (K2 + (kb + lane) * k2_ld + (ch - 8) * 8); \
            glds16(sp, bp + ch * 1024 + lane * 16); } \
        _Pragma("unroll") for (int i = 0; i < 2; ++i) { const int j = wid + 4 * i; \
            glds16(Vp + (kb + 8 * j + (lane >> 3)) * v_ld + (lane & 7) * 8, bp + KB + j * 1024 + lane * 16); } } while (0)
    ATT_STAGE(kt_lo, 0);
    const int i16 = lane & 15;
    const unsigned vlane = (unsigned)((4 * h + (i16 >> 2)) * 128 + 32 * ((lane >> 4) & 1) + 8 * (i16 & 3));
    for (int kt = kt_lo; kt <= kt_hi; ++kt) {
        const int cur = (kt - kt_lo) & 1;
        asm volatile("s_waitcnt vmcnt(0)" ::: "memory");
        __syncthreads();
        if (kt < kt_hi) ATT_STAGE(kt + 1, cur ^ 1);
        const int k0 = kt * 64;
        const bool active = (k0 <= q0w + 31) && (!WIN || (k0 + 63 > q0w - 128));
        if (active) {
            const unsigned char* Kt = smem + cur * BUF;
            f32x16 x0, x1;
#pragma unroll
            for (int i = 0; i < 16; ++i) { x0[i] = 0.f; x1[i] = 0.f; }
#pragma unroll
            for (int ks = 0; ks < NKS; ++ks) {
                const bf16x8 kf0 = *(const bf16x8*)(Kt + (ks * 2 + h) * 1024 + r * 16);
                const bf16x8 kf1 = *(const bf16x8*)(Kt + (ks * 2 + h) * 1024 + (32 + r) * 16);
                x0 = MFMA32(kf0, qf[ks], x0); x1 = MFMA32(kf1, qf[ks], x1);
            }
            const bool need_mask = (k0 + 63 > q0w) || (WIN && (k0 <= q0w + 31 - 128));
            if (need_mask) {
                const int q = q0w + r;
#pragma unroll
                for (int i = 0; i < 16; ++i) {
                    const int key = k0 + (i & 3) + 8 * (i >> 2) + 4 * h;
                    const bool v0 = (key <= q) && (!WIN || key > q - 128);
                    const bool v1 = (key + 32 <= q) && (!WIN || key + 32 > q - 128);
                    x0[i] = v0 ? x0[i] : -INFINITY; x1[i] = v1 ? x1[i] : -INFINITY;
                }
            }
            float mx = fmaxf(x0[0], x1[0]);
#pragma unroll
            for (int i = 1; i < 16; ++i) mx = fmaxf(mx, fmaxf(x0[i], x1[i]));
            mx = fmaxf(mx, __shfl_xor(mx, 32));
            const float mn = fmaxf(m, mx);
            const float alpha = __builtin_amdgcn_exp2f(m - mn);
            m = mn;
            float ps = 0.f;
#pragma unroll
            for (int i = 0; i < 16; ++i) { x0[i] = __builtin_amdgcn_exp2f(x0[i] - mn); x1[i] = __builtin_amdgcn_exp2f(x1[i] - mn); ps += x0[i] + x1[i]; }
            l = l * alpha + ps;
            o0 *= alpha; o1 *= alpha;
            const unsigned vbase = (unsigned)(size_t)(smem + cur * BUF + KB) + vlane;
#pragma unroll
            for (int t = 0; t < 2; ++t) {
                s16x4 l00, h00, l01, h01, l10, h10, l11, h11;
                const unsigned va = vbase + t * 4096;
                asm volatile("ds_read_b64_tr_b16 %0, %8\n\t"
                             "ds_read_b64_tr_b16 %1, %8 offset:1024\n\t"
                             "ds_read_b64_tr_b16 %2, %8 offset:64\n\t"
                             "ds_read_b64_tr_b16 %3, %8 offset:1088\n\t"
                             "ds_read_b64_tr_b16 %4, %8 offset:2048\n\t"
                             "ds_read_b64_tr_b16 %5, %8 offset:3072\n\t"
                             "ds_read_b64_tr_b16 %6, %8 offset:2112\n\t"
                             "ds_read_b64_tr_b16 %7, %8 offset:3136\n\t"
                             "s_waitcnt lgkmcnt(0)"
                             : "=&v"(l00), "=&v"(h00), "=&v"(l01), "=&v"(h01), "=&v"(l10), "=&v"(h10), "=&v"(l11), "=&v"(h11) : "v"(va) : "memory");
                const bf16x8 v00 = __builtin_shufflevector(l00, h00, 0, 1, 2, 3, 4, 5, 6, 7), v01 = __builtin_shufflevector(l01, h01, 0, 1, 2, 3, 4, 5, 6, 7);
                const bf16x8 v10 = __builtin_shufflevector(l10, h10, 0, 1, 2, 3, 4, 5, 6, 7), v11 = __builtin_shufflevector(l11, h11, 0, 1, 2, 3, 4, 5, 6, 7);
                const bf16x8 pb0 = (t == 0) ? pack_step<0>(x0) : pack_step<0>(x1);
                const bf16x8 pb1 = (t == 0) ? pack_step<1>(x0) : pack_step<1>(x1);
                o0 = MFMA32(v00, pb0, o0); o1 = MFMA32(v01, pb0, o1);
                o0 = MFMA32(v10, pb1, o0); o1 = MFMA32(v11, pb1, o1);
            }
        }
    }
#undef ATT_STAGE
    l += __shfl_xor(l, 32);
    const float inv = 1.f / l;
    bf16_t* orow = Op + (size_t)(q0w + r) * o_ld + 4 * h;
#pragma unroll
    for (int g = 0; g < 4; ++g) {
        *(u32x2*)(orow + 8 * g) = (u32x2){pk2(o0[4 * g] * inv, o0[4 * g + 1] * inv), pk2(o0[4 * g + 2] * inv, o0[4 * g + 3] * inv)};
        *(u32x2*)(orow + 32 + 8 * g) = (u32x2){pk2(o1[4 * g] * inv, o1[4 * g + 1] * inv), pk2(o1[4 * g + 2] * inv, o1[4 * g + 3] * inv)};
    }
}

constexpr size_t MLC_DC = 0, MLC_CS = 33554432, MLC_DN = MLC_CS + 16777216, MLC_NS = MLC_DN + 262144, MLC_ML = MLC_NS + 262144, MLC_BE = MLC_ML + 4096, MLC_MS = MLC_BE + 4096;

__device__ __forceinline__ float scan_add64(float v, int lane) {
#pragma unroll
    for (int o = 1; o < 64; o <<= 1) { const float x = __shfl_up(v, o); if (lane >= o) v += x; }
    return v;
}
__device__ __forceinline__ float scan_max64(float v, int lane) {
#pragma unroll
    for (int o = 1; o < 64; o <<= 1) { const float x = __shfl_up(v, o); if (lane >= o) v = fmaxf(v, x); }
    return v;
}
__device__ __forceinline__ float wave_max(float v) {
#pragma unroll
    for (int o = 32; o > 0; o >>= 1) v = fmaxf(v, __shfl_xor(v, o));
    return v;
}

__device__ __forceinline__ void mlc_passA(int u, const bf16_t* PROJ, const float* GATES, const float* b_i, const float* b_f, unsigned char* YB, const Ctx& c) {
    const int bh = u >> 5, b = bh >> 2, h = bh & 3;
    const size_t t0 = (size_t)b * SEQ + (u & 31) * 64;
    unsigned char* smem = c.smem;
    float* saL = (float*)(smem + 24576);
    const int lane = c.lane, wid = __builtin_amdgcn_readfirstlane(c.wid);
#pragma unroll
    for (int i = 0; i < 4; ++i) { const int j = wid * 4 + i;
        glds16(PROJ + (t0 + 4 * j + (lane >> 4)) * NPAD + 512 + h * 128 + (lane & 15) * 8, smem + 8192 + j * 1024 + lane * 16); }
    if (wid == 0) {
        const float ip = GATES[(t0 + lane) * 8 + h] + b_i[h], lf = -softplusf_(-(GATES[(t0 + lane) * 8 + 4 + h] + b_f[h]));
        const float bc = scan_add64(lf, lane), bend = __shfl(bc, 63);
        const float a = bend - bc + ip, mloc = wave_max(a);
        saL[lane] = expf(a - mloc) * 0.125f;
        if (lane == 0) { ((float*)(YB + MLC_ML))[u] = mloc; ((float*)(YB + MLC_BE))[u] = bend; }
    }
    __syncthreads();
#pragma unroll
    for (int i = 0; i < 2; ++i) {
        const int idx = c.tid + 256 * i, row = idx >> 3, chk = idx & 7;
        const u32x4 r = *(const u32x4*)(PROJ + (t0 + row) * NPAD + 256 + h * 64 + chk * 8);
        float f[8]; unpack8(r, f);
        const float s = saL[row];
        *(u32x4*)(smem + row * 128 + chk * 16) = (u32x4){pk2(f[0] * s, f[1] * s), pk2(f[2] * s, f[3] * s), pk2(f[4] * s, f[5] * s), pk2(f[6] * s, f[7] * s)};
    }
    asm volatile("s_waitcnt vmcnt(0)" ::: "memory");
    __syncthreads();
    const int h5 = lane >> 5, r = lane & 31, i16 = lane & 15, q4 = i16 >> 2, p = i16 & 3, blk = (lane >> 4) & 1;
    const int dkt = wid & 1, dvp = wid >> 1;
    const unsigned kaddr = (unsigned)(size_t)smem + (unsigned)((8 * h5 + q4) * 128 + dkt * 64 + 32 * blk + 8 * p);
    const unsigned vaddr = (unsigned)(size_t)smem + 8192u + (unsigned)((8 * h5 + q4) * 256 + dvp * 128 + 32 * blk + 8 * p);
    f32x16 a0, a1;
#pragma unroll
    for (int i = 0; i < 16; ++i) { a0[i] = 0.f; a1[i] = 0.f; }
#pragma unroll
    for (int st = 0; st < 4; ++st) {
        s16x4 kl, kh, v0l, v0h, v1l, v1h;
        const unsigned ka = kaddr + st * 2048, va = vaddr + st * 4096;
        asm volatile("ds_read_b64_tr_b16 %0, %6\n\t"
                     "ds_read_b64_tr_b16 %1, %6 offset:512\n\t"
                     "ds_read_b64_tr_b16 %2, %7\n\t"
                     "ds_read_b64_tr_b16 %3, %7 offset:1024\n\t"
                     "ds_read_b64_tr_b16 %4, %7 offset:64\n\t"
                     "ds_read_b64_tr_b16 %5, %7 offset:1088\n\t"
                     "s_waitcnt lgkmcnt(0)"
                     : "=&v"(kl), "=&v"(kh), "=&v"(v0l), "=&v"(v0h), "=&v"(v1l), "=&v"(v1h) : "v"(ka), "v"(va) : "memory");
        const bf16x8 kf = __builtin_shufflevector(kl, kh, 0, 1, 2, 3, 4, 5, 6, 7);
        const bf16x8 vf0 = __builtin_shufflevector(v0l, v0h, 0, 1, 2, 3, 4, 5, 6, 7), vf1 = __builtin_shufflevector(v1l, v1h, 0, 1, 2, 3, 4, 5, 6, 7);
        a0 = MFMA32(kf, vf0, a0); a1 = MFMA32(kf, vf1, a1);
    }
    float* DC = (float*)(YB + MLC_DC) + (size_t)u * 8192;
#pragma unroll
    for (int i = 0; i < 16; ++i) {
        const int dk = dkt * 32 + (i & 3) + 8 * (i >> 2) + 4 * h5;
        DC[dk * 128 + dvp * 64 + r] = a0[i]; DC[dk * 128 + dvp * 64 + 32 + r] = a1[i];
    }
    if (c.tid < 64) {
        float s = 0.f;
#pragma unroll 8
        for (int t = 0; t < 64; ++t) s += bf2f(((const bf16_t*)smem)[t * 64 + c.tid]);
        ((float*)(YB + MLC_DN))[(size_t)u * 64 + c.tid] = s;
    }
}

__device__ __forceinline__ void mlc_passB(int u, unsigned char* YB, const Ctx& c) {
    const int bh = u >> 3, sl = u & 7;
    const float* ML = (const float*)(YB + MLC_ML) + bh * 32; const float* BE = (const float*)(YB + MLC_BE) + bh * 32;
    const float* DC = (const float*)(YB + MLC_DC) + (size_t)bh * 32 * 8192 + sl * 1024 + c.tid * 4;
    bf16_t* CS = (bf16_t*)(YB + MLC_CS) + (size_t)bh * 32 * 8192 + sl * 1024 + c.tid * 4;
    const float* DN = (const float*)(YB + MLC_DN) + (size_t)bh * 32 * 64; float* NS = (float*)(YB + MLC_NS) + (size_t)bh * 32 * 64; float* MS = (float*)(YB + MLC_MS) + bh * 32;
    f32x4 C4 = (f32x4){0.f, 0.f, 0.f, 0.f}; float nv = 0.f, m = 0.f;
    const bool do_n = (sl == 0) && (c.tid < 64);
#pragma unroll 4
    for (int n = 0; n < 32; ++n) {
        *(u32x2*)(CS + (size_t)n * 8192) = (u32x2){pk2(C4[0], C4[1]), pk2(C4[2], C4[3])};
        if (do_n) NS[n * 64 + c.tid] = nv;
        if (sl == 0 && c.tid == 0) MS[n] = m;
        const float be = BE[n], ml = ML[n];
        const float mn = fmaxf(be + m, ml), keep = expf(be + m - mn), g = expf(ml - mn);
        m = mn;
        const f32x4 d = *(const f32x4*)(DC + (size_t)n * 8192);
        C4 = C4 * keep + d * g;
        if (do_n) nv = nv * keep + DN[n * 64 + c.tid] * g;
    }
}

__device__ __forceinline__ void mlc_passC(int u, const bf16_t* PROJ, const float* GATES, const float* b_i, const float* b_f, const unsigned char* YB,
                                          const float* gain  , bf16_t* MIXO, const Ctx& c) {
    const int bh = u >> 5, b = bh >> 2, h = bh & 3;
    const size_t t0 = (size_t)b * SEQ + (u & 31) * 64;
    unsigned char* smem = c.smem;
    float* csL = (float*)(smem + 32768); float* pmL = (float*)(smem + 33024); float* bcL = (float*)(smem + 33280); float* nnL = (float*)(smem + 33536); float* sqL = (float*)(smem + 33792);
    const int lane = c.lane, wid = __builtin_amdgcn_readfirstlane(c.wid);
    const bf16_t* CS = (const bf16_t*)(YB + MLC_CS) + (size_t)u * 8192;
#pragma unroll
    for (int i = 0; i < 4; ++i) { const int j = wid * 4 + i;
        glds16(PROJ + (t0 + 4 * j + (lane >> 4)) * NPAD + 512 + h * 128 + (lane & 15) * 8, smem + j * 1024 + lane * 16);
        glds16(CS + (4 * j + (lane >> 4)) * 128 + (lane & 15) * 8, smem + 16384 + j * 1024 + lane * 16); }
    float bcl = 0.f;
    if (wid == 0) {
        const float ip = GATES[(t0 + lane) * 8 + h] + b_i[h], lf = -softplusf_(-(GATES[(t0 + lane) * 8 + 4 + h] + b_f[h]));
        bcl = scan_add64(lf, lane);
        const float cs = ip - bcl;
        csL[lane] = cs; pmL[lane] = scan_max64(cs, lane);
        nnL[lane] = ((const float*)(YB + MLC_NS))[(size_t)u * 64 + lane];
        bcL[lane] = bcl;
    }
    asm volatile("s_waitcnt vmcnt(0)" ::: "memory");
    __syncthreads();
    const int h5 = lane >> 5, r = lane & 31, i16 = lane & 15, q4 = i16 >> 2, p = i16 & 3, blk = (lane >> 4) & 1;
    const int th = wid & 1, dvh = wid >> 1;
    const int t = th * 32 + r;
    const float m_n = ((const float*)(YB + MLC_MS))[u];
    const float Mt = fmaxf(m_n, pmL[t]), w_inter = __expf(m_n - Mt), em = __expf(-(bcL[t] + Mt));
    bf16x8 qf[4];
#pragma unroll
    for (int ks = 0; ks < 4; ++ks) qf[ks] = *(const bf16x8*)(PROJ + (t0 + t) * NPAD + h * 64 + ks * 16 + h5 * 8);
    float qn = 0.f; bf16x8 qw[4];
#pragma unroll
    for (int ks = 0; ks < 4; ++ks) {
        const u32x4 raw = __builtin_bit_cast(u32x4, qf[ks]); float f[8]; unpack8(raw, f);
#pragma unroll
        for (int j = 0; j < 8; ++j) qn += f[j] * nnL[ks * 16 + h5 * 8 + j];
        qw[ks] = __builtin_bit_cast(bf16x8, (u32x4){pk2(f[0] * w_inter, f[1] * w_inter), pk2(f[2] * w_inter, f[3] * w_inter), pk2(f[4] * w_inter, f[5] * w_inter), pk2(f[6] * w_inter, f[7] * w_inter)});
    }
    qn += __shfl_xor(qn, 32);
    f32x16 x0, x1;
#pragma unroll
    for (int i = 0; i < 16; ++i) { x0[i] = 0.f; x1[i] = 0.f; }
#pragma unroll
    for (int ks = 0; ks < 4; ++ks) {
        const bf16x8 kf0 = *(const bf16x8*)(PROJ + (t0 + r) * NPAD + 256 + h * 64 + ks * 16 + h5 * 8);
        x0 = MFMA32(kf0, qf[ks], x0);
        if (th) { const bf16x8 kf1 = *(const bf16x8*)(PROJ + (t0 + 32 + r) * NPAD + 256 + h * 64 + ks * 16 + h5 * 8); x1 = MFMA32(kf1, qf[ks], x1); }
    }
    float ps = 0.f;
#pragma unroll
    for (int i = 0; i < 16; ++i) {
        const int s = (i & 3) + 8 * (i >> 2) + 4 * h5;
        const float w0 = (s <= t) ? __expf(csL[s] - Mt) * 0.125f : 0.f;
        x0[i] *= w0; ps += x0[i];
        if (th) { const float w1 = (s <= r) ? __expf(csL[32 + s] - Mt) * 0.125f : 0.f; x1[i] *= w1; ps += x1[i]; }
    }
    ps += __shfl_xor(ps, 32);
    const float den = w_inter * qn + ps;
    f32x16 o0, o1;
#pragma unroll
    for (int i = 0; i < 16; ++i) { o0[i] = 0.f; o1[i] = 0.f; }
    {
        const unsigned vb = (unsigned)(size_t)smem + (unsigned)((4 * h5 + q4) * 256 + dvh * 128 + 32 * blk + 8 * p);
#pragma unroll
        for (int st = 0; st < 2; ++st) {
            if (st == 0 || th) {
                s16x4 l00, h00, l01, h01, l10, h10, l11, h11;
                const unsigned va = vb + st * 8192;
                asm volatile("ds_read_b64_tr_b16 %0, %8\n\t"
                             "ds_read_b64_tr_b16 %1, %8 offset:2048\n\t"
                             "ds_read_b64_tr_b16 %2, %8 offset:64\n\t"
                             "ds_read_b64_tr_b16 %3, %8 offset:2112\n\t"
                             "ds_read_b64_tr_b16 %4, %8 offset:4096\n\t"
                             "ds_read_b64_tr_b16 %5, %8 offset:6144\n\t"
                             "ds_read_b64_tr_b16 %6, %8 offset:4160\n\t"
                             "ds_read_b64_tr_b16 %7, %8 offset:6208\n\t"
                             "s_waitcnt lgkmcnt(0)"
                             : "=&v"(l00), "=&v"(h00), "=&v"(l01), "=&v"(h01), "=&v"(l10), "=&v"(h10), "=&v"(l11), "=&v"(h11) : "v"(va) : "memory");
                const bf16x8 v00 = __builtin_shufflevector(l00, h00, 0, 1, 2, 3, 4, 5, 6, 7), v01 = __builtin_shufflevector(l01, h01, 0, 1, 2, 3, 4, 5, 6, 7);
                const bf16x8 v10 = __builtin_shufflevector(l10, h10, 0, 1, 2, 3, 4, 5, 6, 7), v11 = __builtin_shufflevector(l11, h11, 0, 1, 2, 3, 4, 5, 6, 7);
                const bf16x8 pb0 = (st == 0) ? pack_step<0>(x0) : pack_step<0>(x1);
                const bf16x8 pb1 = (st == 0) ? pack_step<1>(x0) : pack_step<1>(x1);
                o0 = MFMA32(v00, pb0, o0); o1 = MFMA32(v01, pb0, o1);
                o0 = MFMA32(v10, pb1, o0); o1 = MFMA32(v11, pb1, o1);
            }
        }
    }
    {
        const unsigned cb = (unsigned)(size_t)smem + 16384u + (unsigned)((8 * h5 + q4) * 256 + dvh * 128 + 32 * blk + 8 * p);
#pragma unroll
        for (int kp = 0; kp < 2; ++kp) {
            s16x4 l00, h00, l01, h01, l10, h10, l11, h11;
            const unsigned ca = cb + kp * 8192;
            asm volatile("ds_read_b64_tr_b16 %0, %8\n\t"
                         "ds_read_b64_tr_b16 %1, %8 offset:1024\n\t"
                         "ds_read_b64_tr_b16 %2, %8 offset:64\n\t"
                         "ds_read_b64_tr_b16 %3, %8 offset:1088\n\t"
                         "ds_read_b64_tr_b16 %4, %8 offset:4096\n\t"
                         "ds_read_b64_tr_b16 %5, %8 offset:5120\n\t"
                         "ds_read_b64_tr_b16 %6, %8 offset:4160\n\t"
                         "ds_read_b64_tr_b16 %7, %8 offset:5184\n\t"
                         "s_waitcnt lgkmcnt(0)"
                         : "=&v"(l00), "=&v"(h00), "=&v"(l01), "=&v"(h01), "=&v"(l10), "=&v"(h10), "=&v"(l11), "=&v"(h11) : "v"(ca) : "memory");
            const bf16x8 c00 = __builtin_shufflevector(l00, h00, 0, 1, 2, 3, 4, 5, 6, 7), c01 = __builtin_shufflevector(l01, h01, 0, 1, 2, 3, 4, 5, 6, 7);
            const bf16x8 c10 = __builtin_shufflevector(l10, h10, 0, 1, 2, 3, 4, 5, 6, 7), c11 = __builtin_shufflevector(l11, h11, 0, 1, 2, 3, 4, 5, 6, 7);
            o0 = MFMA32(c00, qw[2 * kp], o0); o1 = MFMA32(c01, qw[2 * kp], o1);
            o0 = MFMA32(c10, qw[2 * kp + 1], o0); o1 = MFMA32(c11, qw[2 * kp + 1], o1);
        }
    }
    const float inv = __builtin_amdgcn_rcpf(fmaxf(fabsf(den), em));
    float ss = 0.f;
#pragma unroll
    for (int i = 0; i < 16; ++i) { o0[i] *= inv; o1[i] *= inv; ss += o0[i] * o0[i] + o1[i] * o1[i]; }
    ss += __shfl_xor(ss, 32);
    if (h5 == 0) sqL[wid * 32 + r] = ss;
    __syncthreads();
    const float rr = rsqrtf((sqL[th * 32 + r] + sqL[(th + 2) * 32 + r]) * (1.f / 128.f) + 1e-6f);
    const bf16_t* grow = PROJ + (t0 + t) * NPAD + 1032 + h * 128 + dvh * 64 + 4 * h5;
    const float* gn = gain + h * 128 + dvh * 64 + 4 * h5;
    bf16_t* orow = MIXO + (t0 + t) * 1024 + h * 128 + dvh * 64 + 4 * h5;
#pragma unroll
    for (int d = 0; d < 2; ++d)
#pragma unroll
        for (int g = 0; g < 4; ++g) {
            const u32x2 zr = *(const u32x2*)(grow + d * 32 + 8 * g);
            const f32x4 gv = *(const f32x4*)(gn + d * 32 + 8 * g);
            const float z0 = bflo(zr.x), z1 = bfhi(zr.x), z2 = bflo(zr.y), z3 = bfhi(zr.y);
            const float y0 = (d ? o1[4 * g] : o0[4 * g]) * rr * gv[0] * sigmoidf_(z0), y1 = (d ? o1[4 * g + 1] : o0[4 * g + 1]) * rr * gv[1] * sigmoidf_(z1);
            const float y2 = (d ? o1[4 * g + 2] : o0[4 * g + 2]) * rr * gv[2] * sigmoidf_(z2), y3 = (d ? o1[4 * g + 3] : o0[4 * g + 3]) * rr * gv[3] * sigmoidf_(z3);
            *(u32x2*)(orow + d * 32 + 8 * g) = (u32x2){pk2(y0, y1), pk2(y2, y3)};
        }
}

constexpr size_t GD_WN = 0, GD_UU = GD_WN + (size_t)1024 * 16384, GD_KGT = GD_UU + (size_t)1024 * 16384, GD_QG = GD_KGT + (size_t)1024 * 16384,
                 GD_AT = GD_QG + (size_t)1024 * 16384, GD_GL = GD_AT + (size_t)1024 * 8192, GD_END = GD_GL + 4096;
static_assert(GD_END <= (size_t)MAXROWS * 256 * 2, "GDN chunk records must fit the HBUF region");

__device__ __forceinline__ void gdc_passA(int u, const bf16_t* GQ, const bf16_t* GK, const bf16_t* GV, const float* BETA, const float* GLOG, unsigned char* HB, const Ctx& c) {
    const int bh = u >> 5, b = bh >> 2, h = bh & 3;
    const size_t t0 = (size_t)b * SEQ + (u & 31) * 64;
    unsigned char* smem = c.smem;
    float* Lm = (float*)(smem + 49152);
    float* GA = (float*)(smem + 65536 + 64); float* BT = GA + 64; float* EG = BT + 64; float* EK = EG + 64;
    const int lane = c.lane, wid = __builtin_amdgcn_readfirstlane(c.wid);
    const int h5 = lane >> 5, r = lane & 31;
    if (wid == 0) {
        const float g = GLOG[(t0 + lane) * 4 + h];
        const float G = scan_add64(g, lane), Gl = __shfl(G, 63);
        GA[lane] = G; BT[lane] = BETA[(t0 + lane) * 4 + h]; EG[lane] = expf(G); EK[lane] = expf(Gl - G);
        if (lane == 0) ((float*)(HB + GD_GL))[u] = expf(Gl);
    }
    __syncthreads();
    if (wid < 3) {
        const int it = (wid + 1) >> 1, jt = wid >> 1;
        f32x16 dl, da;
#pragma unroll
        for (int i = 0; i < 16; ++i) { dl[i] = 0.f; da[i] = 0.f; }
#pragma unroll
        for (int ks = 0; ks < 8; ++ks) {
            const bf16x8 ki = *(const bf16x8*)(GK + (t0 + 32 * it + r) * 512 + h * 128 + ks * 16 + h5 * 8);
            const bf16x8 kj = *(const bf16x8*)(GK + (t0 + 32 * jt + r) * 512 + h * 128 + ks * 16 + h5 * 8);
            const bf16x8 qi = *(const bf16x8*)(GQ + (t0 + 32 * it + r) * 512 + h * 128 + ks * 16 + h5 * 8);
            dl = MFMA32(ki, kj, dl); da = MFMA32(qi, kj, da);
        }
        const int j = 32 * jt + r; const float Gj = GA[j];
        bf16_t* AT = (bf16_t*)(HB + GD_AT) + (size_t)u * 4096;
#pragma unroll
        for (int i = 0; i < 16; ++i) {
            const int ii = 32 * it + (i & 3) + 8 * (i >> 2) + 4 * h5;
            const float dec = __expf(GA[ii] - Gj);
            Lm[ii * 64 + j] = (j < ii) ? dl[i] * BT[ii] * dec : 0.f;
            AT[ii * 64 + j] = (bf16_t)f2bf((j <= ii) ? da[i] * dec : 0.f);
        }
        if (wid == 0) {
#pragma unroll
            for (int i = 0; i < 16; ++i) { const int ii = (i & 3) + 8 * (i >> 2) + 4 * h5; Lm[ii * 64 + 32 + r] = 0.f; AT[ii * 64 + 32 + r] = 0; }
        }
    }
    __syncthreads();
    if (wid == 0) {
        float Tc[64];
#pragma unroll
        for (int i = 0; i < 64; ++i) {
            float s = (i == lane) ? 1.f : 0.f;
#pragma unroll
            for (int k = 0; k < i; ++k) s -= Lm[i * 64 + k] * Tc[k];
            Tc[i] = s;
        }
        bf16_t* Tm = (bf16_t*)Lm;
#pragma unroll
        for (int i = 0; i < 64; ++i) Tm[i * 64 + lane] = (bf16_t)f2bf(Tc[i]);
    } else {
        const int t3 = c.tid - 64;
        for (int idx = t3; idx < 4096; idx += 192) {
            const int arr = idx >> 10, rem = idx & 1023, row = rem >> 4, chk = rem & 15;
            const bf16_t* sp = ((arr == 1) ? GV : (arr == 3) ? GQ : GK) + (t0 + row) * 512 + h * 128 + chk * 8;
            const u32x4 raw = *(const u32x4*)sp; float f[8]; unpack8(raw, f);
            const float sc = (arr == 0) ? BT[row] * EG[row] : (arr == 1) ? BT[row] : (arr == 2) ? EK[row] : EG[row];
            const u32x4 o = (u32x4){pk2(f[0] * sc, f[1] * sc), pk2(f[2] * sc, f[3] * sc), pk2(f[4] * sc, f[5] * sc), pk2(f[6] * sc, f[7] * sc)};
            if (arr < 3) *(u32x4*)(smem + arr * 16384 + row * 256 + chk * 16) = o;
            else *(u32x4*)((bf16_t*)(HB + GD_QG) + (size_t)u * 8192 + row * 128 + chk * 8) = o;
        }
    }
    __syncthreads();
    {
        const int i16 = lane & 15, q4 = i16 >> 2, p = i16 & 3, blk = (lane >> 4) & 1;
        const unsigned char* Tm = smem + 49152;
        f32x16 u0, u1, w0, w1;
#pragma unroll
        for (int i = 0; i < 16; ++i) { u0[i] = 0.f; u1[i] = 0.f; w0[i] = 0.f; w1[i] = 0.f; }
        const unsigned ib = (unsigned)(size_t)smem + (unsigned)((8 * h5 + q4) * 256 + wid * 64 + 32 * blk + 8 * p);
#pragma unroll
        for (int ks = 0; ks < 4; ++ks) {
            s16x4 kl, kh, vl, vh;
            const unsigned ia = ib + ks * 4096;
            asm volatile("ds_read_b64_tr_b16 %0, %4\n\t"
                         "ds_read_b64_tr_b16 %1, %4 offset:1024\n\t"
                         "ds_read_b64_tr_b16 %2, %4 offset:16384\n\t"
                         "ds_read_b64_tr_b16 %3, %4 offset:17408\n\t"
                         "s_waitcnt lgkmcnt(0)"
                         : "=&v"(kl), "=&v"(kh), "=&v"(vl), "=&v"(vh) : "v"(ia) : "memory");
            const bf16x8 kb = __builtin_shufflevector(kl, kh, 0, 1, 2, 3, 4, 5, 6, 7), vb = __builtin_shufflevector(vl, vh, 0, 1, 2, 3, 4, 5, 6, 7);
            const bf16x8 t1 = *(const bf16x8*)(Tm + (32 + r) * 128 + ks * 32 + h5 * 16);
            w1 = MFMA32(t1, kb, w1); u1 = MFMA32(t1, vb, u1);
            if (ks < 2) { const bf16x8 tt0 = *(const bf16x8*)(Tm + r * 128 + ks * 32 + h5 * 16); w0 = MFMA32(tt0, kb, w0); u0 = MFMA32(tt0, vb, u0); }
        }
        bf16_t* WN = (bf16_t*)(HB + GD_WN) + (size_t)u * 8192; bf16_t* UU = (bf16_t*)(HB + GD_UU) + (size_t)u * 8192;
#pragma unroll
        for (int i = 0; i < 16; ++i) {
            const int s = (i & 3) + 8 * (i >> 2) + 4 * h5;
            WN[s * 128 + wid * 32 + r] = (bf16_t)f2bf(-w0[i]); WN[(32 + s) * 128 + wid * 32 + r] = (bf16_t)f2bf(-w1[i]);
        }
        {
            u32x4* up = (u32x4*)(UU + (size_t)(wid * 64 + lane) * 32);
            up[0] = (u32x4){pk2(u0[0], u0[1]), pk2(u0[2], u0[3]), pk2(u0[4], u0[5]), pk2(u0[6], u0[7])};
            up[1] = (u32x4){pk2(u0[8], u0[9]), pk2(u0[10], u0[11]), pk2(u0[12], u0[13]), pk2(u0[14], u0[15])};
            up[2] = (u32x4){pk2(u1[0], u1[1]), pk2(u1[2], u1[3]), pk2(u1[4], u1[5]), pk2(u1[6], u1[7])};
            up[3] = (u32x4){pk2(u1[8], u1[9]), pk2(u1[10], u1[11]), pk2(u1[12], u1[13]), pk2(u1[14], u1[15])};
        }
        bf16_t* KGT = (bf16_t*)(HB + GD_KGT) + (size_t)u * 8192;
        const int gq = lane >> 4;
        const unsigned kb0 = (unsigned)(size_t)smem + 32768u + (unsigned)(q4 * 256 + gq * 32 + 8 * p);
#pragma unroll
        for (int it2 = 0; it2 < 8; ++it2) {
            const int job = wid * 8 + it2, s0 = (job & 15) * 4, dkb = (job >> 4) * 64;
            s16x4 v;
            const unsigned ad = kb0 + s0 * 256 + dkb * 2;
            asm volatile("ds_read_b64_tr_b16 %0, %1\n\ts_waitcnt lgkmcnt(0)" : "=&v"(v) : "v"(ad) : "memory");
            *(s16x4*)(KGT + (size_t)(dkb + gq * 16 + i16) * 64 + s0) = v;
        }
    }
}

__device__ __forceinline__ void gdc_passB(int bh, const unsigned char* HB, float* OG, const Ctx& c) {
    const int b = bh >> 2, h = bh & 3;
    const int lane = c.lane, wid = __builtin_amdgcn_readfirstlane(c.wid);
    const int h5 = lane >> 5, r = lane & 31;
    unsigned char* smem = c.smem;
    f32x16 S0, S1, S2, S3;
#pragma unroll
    for (int i = 0; i < 16; ++i) { S0[i] = 0.f; S1[i] = 0.f; S2[i] = 0.f; S3[i] = 0.f; }
    const size_t u0 = (size_t)bh * 32;
#define GB_STAGE0(n_) do { const bf16_t* wn_ = (const bf16_t*)(HB + GD_WN) + (u0 + (n_)) * 8192; const bf16_t* qg_ = (const bf16_t*)(HB + GD_QG) + (u0 + (n_)) * 8192; \
        _Pragma("unroll") for (int i = 0; i < 8; ++i) { const int j = wid * 8 + i, jj = j & 15, row = 4 * jj + (lane >> 4), ch = (lane & 15) ^ (row & 15); \
            glds16(((j >> 4) ? qg_ : wn_) + row * 128 + ch * 8, smem + (j >> 4) * 16384 + jj * 1024 + lane * 16); } } while (0)
#define GB_STAGE1(n_) do { const bf16_t* kg_ = (const bf16_t*)(HB + GD_KGT) + (u0 + (n_)) * 8192; const bf16_t* at_ = (const bf16_t*)(HB + GD_AT) + (u0 + (n_)) * 4096; \
        _Pragma("unroll") for (int i = 0; i < 6; ++i) { const int j = wid * 6 + i, isat = (j >= 16), jj = isat ? j - 16 : j, row = 8 * jj + (lane >> 3), ch = (lane & 7) ^ ((row >> 1) & 7); \
            glds16((isat ? at_ : kg_) + row * 64 + ch * 8, smem + 32768 + isat * 16384 + jj * 1024 + lane * 16); } } while (0)
#define LD128(base_, R_, ks_) __builtin_shufflevector(*(const s16x4*)((base_) + (R_) * 256 + (((2 * (ks_)) ^ (rl & 15)) << 4) + 8 * hl), \
                                                      *(const s16x4*)((base_) + (R_) * 256 + (((2 * (ks_) + 1) ^ (rl & 15)) << 4) + 8 * hl), 0, 1, 2, 3, 4, 5, 6, 7)
#define LD64(base_, R_, k2_) __builtin_shufflevector(*(const s16x4*)((base_) + (R_) * 128 + (((2 * (k2_)) ^ ((rl >> 1) & 7)) << 4) + 8 * hl), \
                                                     *(const s16x4*)((base_) + (R_) * 128 + (((2 * (k2_) + 1) ^ ((rl >> 1) & 7)) << 4) + 8 * hl), 0, 1, 2, 3, 4, 5, 6, 7)
    u32x4 uu[4];
#define GB_LOADU(n_) do { const u32x4* up_ = (const u32x4*)((const bf16_t*)(HB + GD_UU) + (u0 + (n_)) * 8192 + (size_t)(wid * 64 + lane) * 32); \
        uu[0] = up_[0]; uu[1] = up_[1]; uu[2] = up_[2]; uu[3] = up_[3]; } while (0)
    __syncthreads();
    GB_STAGE0(0);
    GB_LOADU(0);
#pragma unroll 1
    for (int n = 0; n < 32; ++n) {
        const float gl = ((const float*)(HB + GD_GL))[u0 + n];
        const size_t t0 = (size_t)b * SEQ + n * 64;
        asm volatile("s_waitcnt vmcnt(0)" ::: "memory");
        __syncthreads();
        GB_STAGE1(n);
        int rl = r, hl = h5; asm volatile("" : "+v"(rl), "+v"(hl));
        f32x16 v0, v1;
#pragma unroll
        for (int q = 0; q < 2; ++q) {
            const u32x4 a = uu[q], bq = uu[2 + q];
            v0[8 * q + 0] = bflo(a.x); v0[8 * q + 1] = bfhi(a.x); v0[8 * q + 2] = bflo(a.y); v0[8 * q + 3] = bfhi(a.y);
            v0[8 * q + 4] = bflo(a.z); v0[8 * q + 5] = bfhi(a.z); v0[8 * q + 6] = bflo(a.w); v0[8 * q + 7] = bfhi(a.w);
            v1[8 * q + 0] = bflo(bq.x); v1[8 * q + 1] = bfhi(bq.x); v1[8 * q + 2] = bflo(bq.y); v1[8 * q + 3] = bfhi(bq.y);
            v1[8 * q + 4] = bflo(bq.z); v1[8 * q + 5] = bfhi(bq.z); v1[8 * q + 6] = bflo(bq.w); v1[8 * q + 7] = bfhi(bq.w);
        }
#define KS_V(SX, HF, ks_) do { const bf16x8 sbk = pack_step<HF>(SX); \
            v0 = MFMA32(LD128(smem, rl, ks_), sbk, v0); v1 = MFMA32(LD128(smem, 32 + rl, ks_), sbk, v1); } while (0)
        KS_V(S0, 0, 0); KS_V(S0, 1, 1); asm volatile("" ::: "memory"); KS_V(S1, 0, 2); KS_V(S1, 1, 3); asm volatile("" ::: "memory");
        KS_V(S2, 0, 4); KS_V(S2, 1, 5); asm volatile("" ::: "memory"); KS_V(S3, 0, 6); KS_V(S3, 1, 7);
#undef KS_V
        const bf16x8 vb0 = pack_step_m<0>(v0), vb1 = pack_step_m<1>(v0), vb2 = pack_step_m<0>(v1), vb3 = pack_step_m<1>(v1);
        asm volatile("" ::: "memory"); asm volatile("" : "+v"(rl), "+v"(hl));
        f32x16 o0, o1;
#pragma unroll
        for (int i = 0; i < 16; ++i) { o0[i] = 0.f; o1[i] = 0.f; }
#define KS_O(SX, HF, ks_) do { const bf16x8 sbk = pack_step<HF>(SX); \
            o0 = MFMA32(LD128(smem + 16384, rl, ks_), sbk, o0); o1 = MFMA32(LD128(smem + 16384, 32 + rl, ks_), sbk, o1); } while (0)
        KS_O(S0, 0, 0); KS_O(S0, 1, 1); asm volatile("" ::: "memory"); KS_O(S1, 0, 2); KS_O(S1, 1, 3); asm volatile("" ::: "memory");
        KS_O(S2, 0, 4); KS_O(S2, 1, 5); asm volatile("" ::: "memory"); KS_O(S3, 0, 6); KS_O(S3, 1, 7);
#undef KS_O
        asm volatile("s_waitcnt vmcnt(0)" ::: "memory");
        __syncthreads();
        if (n + 1 < 32) { GB_STAGE0(n + 1); GB_LOADU(n + 1); }
        asm volatile("" : "+v"(rl), "+v"(hl));
        o0 = MFMA32(LD64(smem + 49152, rl, 0), vb0, o0); o0 = MFMA32(LD64(smem + 49152, rl, 1), vb1, o0);
        o1 = MFMA32(LD64(smem + 49152, 32 + rl, 0), vb0, o1); o1 = MFMA32(LD64(smem + 49152, 32 + rl, 1), vb1, o1);
        o1 = MFMA32(LD64(smem + 49152, 32 + rl, 2), vb2, o1); o1 = MFMA32(LD64(smem + 49152, 32 + rl, 3), vb3, o1);
#pragma unroll
        for (int i = 0; i < 16; ++i) {
            const int t = (i & 3) + 8 * (i >> 2) + 4 * h5;
            OG[(t0 + t) * 512 + h * 128 + wid * 32 + r] = o0[i]; OG[(t0 + 32 + t) * 512 + h * 128 + wid * 32 + r] = o1[i];
        }
        asm volatile("" : "+v"(rl), "+v"(hl));
        S0 *= gl; S1 *= gl; S2 *= gl; S3 *= gl;
#define SUPD(SX, dt_) do { SX = MFMA32(LD64(smem + 32768, (dt_) * 32 + rl, 0), vb0, SX); SX = MFMA32(LD64(smem + 32768, (dt_) * 32 + rl, 1), vb1, SX); \
            SX = MFMA32(LD64(smem + 32768, (dt_) * 32 + rl, 2), vb2, SX); SX = MFMA32(LD64(smem + 32768, (dt_) * 32 + rl, 3), vb3, SX); } while (0)
        SUPD(S0, 0); asm volatile("" ::: "memory"); SUPD(S1, 1); asm volatile("" ::: "memory"); SUPD(S2, 2); asm volatile("" ::: "memory"); SUPD(S3, 3);
#undef SUPD
    }
#undef GB_STAGE0
#undef GB_STAGE1
#undef LD128
#undef LD64
#undef GB_LOADU
}

__device__ __forceinline__ void phase_post(const float* OG, const bf16_t* PROJ, const float* gain, bool odd, bf16_t* MIXO, const Ctx& c) {
    const int lane = c.lane;
    const int gcol = odd ? 1032 : 1960, ocol = odd ? 0 : 512;
    for (int t = c.bid * 4 + c.wid; t < T; t += c.nblk * 4) {
        const f32x4 a0 = *(const f32x4*)(OG + (size_t)t * 512 + lane * 8), a1 = *(const f32x4*)(OG + (size_t)t * 512 + lane * 8 + 4);
        float ss = (a0[0] * a0[0] + a0[1] * a0[1]) + (a0[2] * a0[2] + a0[3] * a0[3]) + (a1[0] * a1[0] + a1[1] * a1[1]) + (a1[2] * a1[2] + a1[3] * a1[3]);
        ss = red16(ss);
        const float rr = rsqrtf(ss * (1.f / 128.f) + 1e-6f);
        const u32x4 zr = *(const u32x4*)(PROJ + (size_t)t * NPAD + gcol + lane * 8);
        float z[8]; unpack8(zr, z);
        const int gi = odd ? lane * 8 : (lane & 15) * 8;
        const f32x4 g0 = *(const f32x4*)(gain + gi), g1 = *(const f32x4*)(gain + gi + 4);
        float y[8];
#pragma unroll
        for (int j = 0; j < 4; ++j) {
            const float ga = odd ? sigmoidf_(z[j]) : siluf_(z[j]), gb = odd ? sigmoidf_(z[4 + j]) : siluf_(z[4 + j]);
            y[j] = a0[j] * rr * g0[j] * ga; y[4 + j] = a1[j] * rr * g1[j] * gb;
        }
        *(u32x4*)(MIXO + (size_t)t * 1024 + ocol + lane * 8) = (u32x4){pk2(y[0], y[1]), pk2(y[2], y[3]), pk2(y[4], y[5]), pk2(y[6], y[7])};
    }
}

__global__ void __launch_bounds__(512, 2) fwd(Args a) {
    extern __shared__ __attribute__((aligned(16))) unsigned char smem[];
    Ctx c;
#define SET_CTX(cx) do { int t_ = threadIdx.x; asm volatile("" : "+v"(t_)); cx.tid0 = t_; cx.half = t_ >> 8; cx.tid = t_ & 255; cx.lane = t_ & 63; cx.wid = (t_ >> 6) & 3; \
        cx.wr = cx.wid >> 1; cx.wc = cx.wid & 1; cx.fr = cx.lane & 15; cx.fq = cx.lane >> 4; cx.bid = blockIdx.x * 2 + cx.half; cx.nblk = gridDim.x * 2; \
        cx.smem0 = smem; cx.smem = smem + cx.half * HALF_LDS; } while (0)
    SET_CTX(c);
#define PH_CTX() SET_CTX(c)
    unsigned char* const ws_base = a.ws;
    const void* const* const ain_base = (const void* const*)__builtin_amdgcn_kernarg_segment_ptr();
    unsigned* ctl = (unsigned*)(ws_base + WS_CTL);
    volatile LAS unsigned* xbw = (volatile LAS unsigned*)(smem + LDS_BLK);
    if (c.tid0 < 8) xbw[c.tid0] = 0u;
    __syncthreads();
    XcdBarrier bar; bar.bar = ctl; bar.x = 0; bar.st = xbw;
    if (a.use_bar) bar = xcd_barrier_post(ctl, xbw);
    const int lo = a.ph_lo, hi = a.ph_hi;
#define IN(k) (lo <= (k) && (k) < hi)
#define PH(k) if (IN(k)) { PH_CTX(); unsigned char* ws = ws_base; const void* const* ain = ain_base; asm volatile("" : "+s"(ws), "+s"(ain));
#define UNIT_CTX() Ctx cu; SET_CTX(cu)
#define SEAM(k) do { if ((k) + 1 < hi) xcd_barrier(bar); } while (0)

#define XBF ((bf16_t*)(ws + WS_XBF))
#define X1 ((float*)(ws + WS_X1))
#define PROJ ((bf16_t*)(ws + U_PROJ))
#define GATES ((float*)(ws + U_GATES))
#define MIXO ((bf16_t*)(ws + U_MIXO))
#define YBUF ((float*)(ws + U_YBUF))
#define ROPEM ((const float*)(ws + WS_ROPEM))
#define ROPES ((const float*)(ws + WS_ROPES))
#define XRES ((layer == 0) ? (const float*)ain[0] : (const float*)a.out)
#define CNT (ctl + CW_CNT + layer * 128)
#define WIN ((const bf16_t*)(ws + WS_WIN) + (size_t)layer * WIN_ELEMS)
#define WOUT ((const bf16_t*)(ws + WS_WOUT) + (size_t)layer * WOUT_ELEMS)

    PH(0) for (int rep = 0; rep < REP_PRO; ++rep) phase_prologue(a, c); SEAM(0); }

    for (int layer = 0; layer < 4; ++layer) {
        const int pb = 1 + layer * PPL;
        if (pb >= hi || pb + PPL <= lo) continue;
        const int jj = layer >> 1;
        const bool odd = (layer & 1) != 0;

        PH(pb + 0) {
                DenseSched S{T / 256, NPAD / 256, 1024, (int)blockIdx.x, (int)gridDim.x};
                EpiIn E{PROJ, GATES, odd ? 1024 : 1952};
                g8::phase<true, false>(smem, (const char*)XBF, (const char*)WIN, 1024, S, E);
            }
            SEAM(pb + 0); }
        PH(pb + 1) for (int rp = 0; rp < ((REP_PHASE == 1) ? 2 : 1); ++rp) { if (rp) xcd_barrier(bar);
            if (!odd) phase_prep_even(PROJ, GATES, (const float*)ain[3] + jj * 256, (const float*)ain[5] + jj * 128, (const float*)ain[7] + jj * 4 * 1536,
                                      (const float*)ain[8] + jj * 4, (const float*)ain[9] + jj * 4, ROPEM,
                                      (bf16_t*)(ws + U_CQ), (bf16_t*)(ws + U_CKV), (bf16_t*)(ws + U_KROPE), (bf16_t*)(ws + U_GQ), (bf16_t*)(ws + U_GK), (bf16_t*)(ws + U_GV),
                                      (float*)(ws + U_BETA), (float*)(ws + U_GLOG), c);
            else {
                phase_prep_odd(PROJ, ROPES, (bf16_t*)(ws + U_QF), (bf16_t*)(ws + U_KN), c);
                unsigned* ctr = ctl + CW_WORK + pb + 1 + 64 * rp;
                for (;;) {
                    const int u = next_unit(ctr, c); UNIT_CTX();
                    if (u >= 1024) break;
                    mlc_passA(u, PROJ, GATES, (const float*)ain[13] + jj * 4, (const float*)ain[14] + jj * 4, (unsigned char*)YBUF, cu);
                }
            }
            }
            SEAM(pb + 1);
        }
        PH(pb + 2) for (int rp = 0; rp < ((REP_PHASE == 2) ? 2 : 1); ++rp) { if (rp) xcd_barrier(bar);
            unsigned* ctr = ctl + CW_WORK + pb + 2 + 64 * rp;
            if (!odd) {
                for (;;) {
                    const int u = next_unit(ctr, c); UNIT_CTX();
                    if (u >= 1024 + MLAUP_TILES) break;
                    if (u < 1024) gdc_passA(u, (const bf16_t*)(ws + U_GQ), (const bf16_t*)(ws + U_GK), (const bf16_t*)(ws + U_GV), (const float*)(ws + U_BETA),
                                            (const float*)(ws + U_GLOG), ws + WS_HBUF, cu);
                    else mla_up_tile(u - 1024, (const bf16_t*)(ws + U_CQ), (const bf16_t*)(ws + WS_WQB) + (size_t)jj * WQB_ELEMS, (const bf16_t*)(ws + U_CKV),
                                     (const bf16_t*)(ws + WS_WKVB) + (size_t)jj * WKVB_ELEMS, ROPEM, (bf16_t*)(ws + U_QF), (bf16_t*)(ws + U_KN), (bf16_t*)(ws + U_VV), cu);
                }
            } else {
                for (;;) {
                    const int u = next_unit(ctr, c); UNIT_CTX();
                    if (u >= 256 + 1024) break;
                    if (u < 256) mlc_passB(u, (unsigned char*)YBUF, cu);
                    else {
                        const int v = u - 256, hq = v & 7, n = (v >> 3) & 15, b = v >> 7, kvh = hq >> 2;
                        const size_t tb = (size_t)b * SEQ;
                        attn_unit<4, true>((const bf16_t*)(ws + U_QF) + tb * 512 + hq * 64, 512, (const bf16_t*)(ws + U_KN) + tb * 128 + kvh * 64, 128,
                                           (const bf16_t*)(ws + U_KN), 0, PROJ + tb * NPAD + 2184 + kvh * 64, NPAD,
                                           MIXO + tb * 1024 + 512 + hq * 64, 1024, n * 128, ((const float*)ain[16])[jj * 8 + hq] * 1.4426950408889634f, cu);
                    }
                }
            }
            }
            SEAM(pb + 2);
        }
        PH(pb + 3) for (int rp = 0; rp < ((REP_PHASE == 3) ? 2 : 1); ++rp) { if (rp) xcd_barrier(bar);
            unsigned* ctr = ctl + CW_WORK + pb + 3 + 64 * rp;
            if (!odd) {
                for (;;) {
                    const int u = next_unit(ctr, c); UNIT_CTX();
                    if (u >= 32 + 1024) break;
                    if (u < 32) gdc_passB(u, ws + WS_HBUF, YBUF, cu);
                    else {
                        const int v = u - 32, qb = 15 - (v >> 6), bh = v & 63, b = bh >> 3, hh = bh & 7;
                        const size_t tb = (size_t)b * SEQ;
                        attn_unit<6, false>((const bf16_t*)(ws + U_QF) + tb * 768 + hh * 96, 768, (const bf16_t*)(ws + U_KN) + tb * 512 + hh * 64, 512,
                                            (const bf16_t*)(ws + U_KROPE) + tb * 32, 32, (const bf16_t*)(ws + U_VV) + tb * 512 + hh * 64, 512,
                                            MIXO + tb * 1024 + hh * 64, 1024, qb * 128, 0.f, cu);
                    }
                }
            } else {
                for (;;) {
                    const int u = next_unit(ctr, c); UNIT_CTX();
                    if (u >= 1024) break;
                    mlc_passC(u, PROJ, GATES, (const float*)ain[13] + jj * 4, (const float*)ain[14] + jj * 4, (const unsigned char*)YBUF, (const float*)ain[15] + jj * 512, MIXO, cu);
                }
            }
            }
            SEAM(pb + 3);
        }
        PH(pb + 4) for (int rp = 0; rp < ((REP_PHASE == 4) ? 2 : 1); ++rp) { if (rp) xcd_barrier(bar);
            if (!odd) { phase_post(YBUF, PROJ, (const float*)ain[10] + jj * 128, false, MIXO, c); }
            }
            if (!odd) SEAM(pb + 4);
        }
        PH(pb + 5) {
                DenseSched S{T / 256, 4, 1024, (int)blockIdx.x, (int)gridDim.x};
                EpiOut E{XRES, YBUF};
                g8::phase<false, false>(smem, (const char*)MIXO, (const char*)WOUT, 1024, S, E);
            }
            SEAM(pb + 5); }
        PH(pb + 6) for (int rep = 0; rep < REP_TOK; ++rep) phase_ln1(YBUF, (const float*)ain[18] + layer * 1024, (const float*)ain[19] + layer * 1024, X1, XBF, c); SEAM(pb + 6); }
        PH(pb + 7) for (int rep = 0; rep < REP_GEMM; ++rep) phase_router(XBF, (const bf16_t*)(ws + WS_WRT) + (size_t)layer * WRT_ELEMS, (float*)(ws + WS_LOG), c); SEAM(pb + 7); }
        PH(pb + 8) phase_route((const float*)(ws + WS_LOG), (const float*)ain[21] + layer * 64, CNT, (int*)(ws + WS_LTOK), (float*)(ws + WS_LW), (int*)(ws + WS_ASG), (float*)(ws + WS_ASGW), c); SEAM(pb + 8); }
        PH(pb + 9) {
                int* bst8 = (int*)(smem + LDS_BLK + 64); int* eb8 = bst8 + 256;
                build_block_table(CNT, bst8, c);
                for (int rb = c.tid0; rb < bst8[65]; rb += NT) { int e = 0; for (int q = 1; q < 65; ++q) e += (bst8[q] <= rb) ? 1 : 0; eb8[rb] = e; }
                __syncthreads();
                MoeSchedG S{bst8[65], (int)blockIdx.x, (int)gridDim.x, eb8, bst8, (const int*)(ws + WS_LTOK)};
                EpiMoe1 E{(bf16_t*)(ws + WS_HBUF)};
                g8::phase<false, true>(smem, (const char*)XBF, (const char*)((const bf16_t*)(ws + WS_WGU) + (size_t)layer * 65 * WGU_ELEMS), 1024, S, E);
            }
            SEAM(pb + 9); }
        PH(pb + 10)
#if MOE2_G8
            {
                int* bst8 = (int*)(smem + LDS_BLK + 64); int* eb8 = bst8 + 256;
                build_block_table(CNT, bst8, c);
                for (int rb = c.tid0; rb < bst8[65]; rb += NT) { int e = 0; for (int q = 1; q < 65; ++q) e += (bst8[q] <= rb) ? 1 : 0; eb8[rb] = e; }
                __syncthreads();
                MoeSched S{bst8[65], 4, (int)blockIdx.x, (int)gridDim.x, eb8};
                EpiMoe2 E{(bf16_t*)(ws + U_Y)};
                g8::phase<true, false>(smem, (const char*)(ws + WS_HBUF), (const char*)((const bf16_t*)(ws + WS_WDN) + (size_t)layer * 65 * WDN_ELEMS), 256, S, E);
            }
#else
            phase_moe2((const bf16_t*)(ws + WS_HBUF), (const bf16_t*)(ws + WS_WDN) + (size_t)layer * 65 * WDN_ELEMS, CNT, (bf16_t*)(ws + U_Y), c);
#endif
            SEAM(pb + 10); }
        PH(pb + 11) for (int rep = 0; rep < REP_CMB; ++rep) phase_combine(X1, (const bf16_t*)(ws + U_Y), (const int*)(ws + WS_ASG), (const float*)(ws + WS_ASGW), CNT, (const float*)ain[28] + layer * 1024, (const float*)ain[29] + layer * 1024,
                                         a.out, XBF, c); SEAM(pb + 11); }
    }
#undef IN
#undef XBF
#undef X1
#undef PROJ
#undef GATES
#undef MIXO
#undef YBUF
#undef ROPEM
#undef ROPES
#undef XRES
#undef CNT
#undef WIN
#undef WOUT
#undef PH
#undef PH_CTX
#undef UNIT_CTX
#undef SEAM
}

extern "C" void kernel_launch(void* const* d_in, const int* in_sizes, int n_in, void* d_out, int out_size, void* d_ws, size_t ws_size, hipStream_t stream) {
    static int grid = 0;
    if (grid == 0) {
        if (n_in != 30 || out_size != T * 1024 || ws_size < WS_END) {
            fprintf(stderr, "kernel_launch: unexpected shapes (n_in %d, out %d, ws %zu < %zu)\n", n_in, out_size, ws_size, (size_t)WS_END);
            grid = -1; return;
        }
        int dev = 0, cus = 0, per_cu = 0;
        (void)hipGetDevice(&dev);
        (void)hipDeviceGetAttribute(&cus, hipDeviceAttributeMultiprocessorCount, dev);
        (void)hipFuncSetAttribute((const void*)fwd, hipFuncAttributeMaxDynamicSharedMemorySize, DYN_LDS);
        (void)hipOccupancyMaxActiveBlocksPerMultiprocessor(&per_cu, (const void*)fwd, NT, DYN_LDS);
        (void)hipGetLastError();
        if (per_cu < 1) per_cu = 1;
        grid = cus;
    }
    if (grid < 0) return;
    (void)hipMemsetAsync((char*)d_ws + WS_CTL, 0, CTL_BYTES, stream);
    Args a{};
    for (int i = 0; i < 30; ++i) a.in[i] = d_in[i];
    a.out = (float*)d_out; a.ws = (unsigned char*)d_ws; a.pad = 0;
#if ONE_LAUNCH
    a.ph_lo = 0; a.ph_hi = NPH; a.use_bar = 1;
    hipLaunchKernelGGL(fwd, dim3(grid), dim3(NT), DYN_LDS, stream, a);
#else
    for (int p = 0; p < NPH; ++p) {
        a.ph_lo = p; a.ph_hi = p + 1; a.use_bar = 0;
        hipLaunchKernelGGL(fwd, dim3(grid), dim3(NT), DYN_LDS, stream, a);
    }
#endif
}
```

```cpp
#include <hip/hip_runtime.h>
#include <stdint.h>
#include <stdio.h>

#define REP_GEMM 1
#define REP_PHASE 0
#define REP_G0 1
#define REP_G1 1
#define REP_G2 1
#define REP_G3 1
#define REP_MIX 1
#define REP_ONLY 0
#define REP_CMB 1
#define REP_PRO 1
#define REP_TOK 1
#define MOE2_G8 1
#ifndef ONE_LAUNCH
#define ONE_LAUNCH 1
#endif

typedef unsigned short bf16_t;
typedef short bf16x8 __attribute__((ext_vector_type(8)));
typedef float f32x4 __attribute__((ext_vector_type(4)));
typedef unsigned u32x4 __attribute__((ext_vector_type(4)));
typedef unsigned u32x2 __attribute__((ext_vector_type(2)));
#define LAS __attribute__((address_space(3)))
#define GAS __attribute__((address_space(1)))

constexpr int T = 16384, SEQ = 2048;
constexpr int NPAD = 2560;
constexpr int CAP = 16384;
constexpr int RBR = 256;
constexpr int MAXRB = 512 + 64 + 64;
constexpr int MAXROWS = MAXRB * RBR;
constexpr float ALPHA = 1.681792830507429f;
constexpr int PPL = 12;
constexpr int NPH = 1 + 4 * PPL;
constexpr int NT = 512, NW = 8;
constexpr int HALF_LDS = 65536 + 64 + 1024;
constexpr int LDS_BLK = 2 * HALF_LDS;
constexpr int DYN_LDS = LDS_BLK + 64 + 1024 + 2560;

constexpr size_t cmax(size_t a, size_t b) { return a > b ? a : b; }
constexpr size_t WS_CTL = 0;
constexpr size_t CTL_BYTES = 65536;
constexpr size_t WS_WIN = WS_CTL + CTL_BYTES;
constexpr size_t WIN_ELEMS = (size_t)NPAD * 1024;
constexpr size_t WS_WQB = WS_WIN + 4 * WIN_ELEMS * 2;
constexpr size_t WQB_ELEMS = 768 * 256;
constexpr size_t WS_WKVB = WS_WQB + 2 * WQB_ELEMS * 2;
constexpr size_t WKVB_ELEMS = 1024 * 128;
constexpr size_t WS_WOUT = WS_WKVB + 2 * WKVB_ELEMS * 2;
constexpr size_t WOUT_ELEMS = 1024 * 1024;
constexpr size_t WS_WRT = WS_WOUT + 4 * WOUT_ELEMS * 2;
constexpr size_t WRT_ELEMS = 128 * 1024;
constexpr size_t WS_WGU = WS_WRT + 4 * WRT_ELEMS * 2;
constexpr size_t WGU_ELEMS = 512 * 1024;
constexpr size_t WS_WDN = WS_WGU + 4 * 65 * WGU_ELEMS * 2;
constexpr size_t WDN_ELEMS = 1024 * 256;
constexpr size_t WS_ROPEM = WS_WDN + 4 * 65 * WDN_ELEMS * 2;
constexpr size_t WS_ROPES = WS_ROPEM + (size_t)T * 16 * 2 * 4;
constexpr size_t WS_X1 = WS_ROPES + (size_t)T * 32 * 2 * 4;
constexpr size_t WS_XBF = WS_X1 + (size_t)T * 1024 * 4;
constexpr size_t WS_HBUF = WS_XBF + (size_t)T * 1024 * 2;
constexpr size_t WS_LOG = WS_HBUF + (size_t)MAXROWS * 256 * 2;
constexpr size_t WS_ASG = WS_LOG + (size_t)T * 64 * 4;
constexpr size_t WS_ASGW = WS_ASG + (size_t)T * 8 * 4;
constexpr size_t WS_LTOK = WS_ASGW + (size_t)T * 8 * 4;
constexpr size_t WS_LW = WS_LTOK + (size_t)65 * CAP * 4;
constexpr size_t WS_U = WS_LW + (size_t)65 * CAP * 4;
constexpr size_t U_Y = WS_U;
constexpr size_t U_PROJ = WS_U;
constexpr size_t U_GATES = U_PROJ + (size_t)T * NPAD * 2;
constexpr size_t U_CQ = U_GATES + (size_t)T * 8 * 4;
constexpr size_t U_CKV = U_CQ + (size_t)T * 256 * 2;
constexpr size_t U_KROPE = U_CKV + (size_t)T * 128 * 2;
constexpr size_t U_QF = U_KROPE + (size_t)T * 32 * 2;
constexpr size_t U_KN = U_QF + (size_t)T * 768 * 2;
constexpr size_t U_VV = U_KN + (size_t)T * 512 * 2;
constexpr size_t U_GQ = U_VV + (size_t)T * 512 * 2;
constexpr size_t U_GK = U_GQ + (size_t)T * 512 * 2;
constexpr size_t U_GV = U_GK + (size_t)T * 512 * 2;
constexpr size_t U_BETA = U_GV + (size_t)T * 512 * 2;
constexpr size_t U_GLOG = U_BETA + (size_t)T * 4 * 4;
constexpr size_t U_MIXO = U_GLOG + (size_t)T * 4 * 4;
constexpr size_t U_YBUF = U_MIXO + (size_t)T * 1024 * 2;
constexpr size_t U_END1 = U_YBUF + (size_t)T * 1024 * 4;
constexpr size_t WS_END = WS_U + cmax((size_t)MAXROWS * 1024 * 2, U_END1 - WS_U);

constexpr int CW_CNT = 4096;
constexpr int CW_WORK = 8192;

#define XB_TMO      128
#define XB_XCNT(j)  (256  + 64 * (j))
#define XB_XSUB(j)  (1280 + 64 * (j))
#define XB_XGEN(j)  (2304 + 64 * (j))
#define XB_TOP      3328
#define XB_TOPGEN   3392
#define XCD_BAR_WORDS 3456
#define XB_SPIN_CAP (1u << 18)

__device__ __forceinline__ unsigned xb_ld(unsigned* p)              { return __hip_atomic_load(p, __ATOMIC_RELAXED, __HIP_MEMORY_SCOPE_AGENT); }
__device__ __forceinline__ unsigned xb_add(unsigned* p, unsigned v) { return __hip_atomic_fetch_add(p, v, __ATOMIC_RELAXED, __HIP_MEMORY_SCOPE_AGENT); }
__device__ __forceinline__ unsigned xb_xcc_id() { return (unsigned)__builtin_amdgcn_s_getreg((3 << 11) | 20) & 0xFu; }
#define XB_SPIN(cond, bar) do { unsigned _sp = 0; while (cond) { __builtin_amdgcn_s_sleep(1); \
    if ((++_sp & 255u) == 0u) { if (xb_ld(&(bar)[XB_TMO])) break; if (_sp > XB_SPIN_CAP) { atomicAdd(&(bar)[XB_TMO], 1u); break; } } } } while (0)

struct XcdBarrier { unsigned* bar; unsigned x; volatile LAS unsigned* st; };

__device__ __forceinline__ XcdBarrier xcd_barrier_post(unsigned* bar, volatile LAS unsigned* st) {
    XcdBarrier b; b.bar = bar; b.x = xb_xcc_id(); b.st = st;
    if (threadIdx.x == 0) (void)xb_add(&bar[XB_XCNT(b.x)], 1u);
    return b;
}
__device__ __forceinline__ void xcd_barrier_complete(unsigned* bar, unsigned x, unsigned& nloc, unsigned& nx) {
    const unsigned G = gridDim.x * gridDim.y * gridDim.z;
    unsigned sum, cnt, mine, sp = 0u;
    for (;;) {
        sum = 0u; cnt = 0u; mine = 0u;
#pragma unroll
        for (unsigned j = 0; j < 16; ++j) { const unsigned c = xb_ld(&bar[XB_XCNT(j)]); sum += c; cnt += (c > 0u) ? 1u : 0u; mine = (j == x) ? c : mine; }
        if (sum == G) break;
        __builtin_amdgcn_s_sleep(1);
        if ((++sp & 255u) == 0u) { if (xb_ld(&bar[XB_TMO])) break; if (sp > XB_SPIN_CAP) { atomicAdd(&bar[XB_TMO], 1u); break; } }
    }
    nloc = mine > 0u ? mine : 1u; nx = cnt > 0u ? cnt : 1u;
}
__device__ __forceinline__ void xcd_barrier(const XcdBarrier& b) {
    asm volatile("s_waitcnt vmcnt(0)" ::: "memory");
    __syncthreads();
    if (threadIdx.x == 0) {
        unsigned* bar = b.bar;
        __builtin_amdgcn_s_waitcnt(0);
        unsigned nloc = b.st[0], nx = b.st[1];
        if (nloc == 0u) { xcd_barrier_complete(bar, b.x, nloc, nx); b.st[0] = nloc; b.st[1] = nx; }
        const unsigned old = xb_add(&bar[XB_XSUB(b.x)], 1u);
        const unsigned gen = old / nloc;
        if (old + 1u == (gen + 1u) * nloc) {
            __builtin_amdgcn_fence(__ATOMIC_RELEASE, "agent");
            asm volatile("s_waitcnt vmcnt(0)" ::: "memory");
            const unsigned og = xb_add(&bar[XB_TOP], 1u);
            const unsigned tg = og / nx;
            if (og + 1u == (tg + 1u) * nx) xb_add(&bar[XB_TOPGEN], 1u);
            else XB_SPIN(xb_ld(&bar[XB_TOPGEN]) == tg, bar);
            __builtin_amdgcn_fence(__ATOMIC_ACQUIRE, "agent");
            xb_add(&bar[XB_XGEN(b.x)], 1u);
            asm volatile("s_waitcnt vmcnt(0)" ::: "memory");
        } else {
            XB_SPIN(xb_ld(&bar[XB_XGEN(b.x)]) == gen, bar);
            __builtin_amdgcn_fence(__ATOMIC_ACQUIRE, "agent");
            asm volatile("s_waitcnt vmcnt(0)" ::: "memory");
        }
    }
    __syncthreads();
}

__device__ __forceinline__ float bf2f(unsigned v) { return __uint_as_float(v << 16); }
__device__ __forceinline__ float bflo(unsigned w) { return __uint_as_float(w << 16); }
__device__ __forceinline__ float bfhi(unsigned w) { return __uint_as_float(w & 0xffff0000u); }
__device__ __forceinline__ unsigned f2bf(float f) { unsigned u = __float_as_uint(f); u += 0x7fffu + ((u >> 16) & 1u); return u >> 16; }
__device__ __forceinline__ unsigned pk2(float lo, float hi) { return f2bf(lo) | (f2bf(hi) << 16); }
__device__ __forceinline__ unsigned cvt_pk(float lo, float hi) { unsigned r; asm volatile("v_cvt_pk_bf16_f32 %0, %1, %2" : "=v"(r) : "v"(lo), "v"(hi)); return r; }
__device__ __forceinline__ float wave_sum(float v) {
#pragma unroll
    for (int o = 32; o > 0; o >>= 1) v += __shfl_xor(v, o);
    return v;
}
__device__ __forceinline__ float sigmoidf_(float x) { return 1.f / (1.f + expf(-x)); }
__device__ __forceinline__ float siluf_(float x) { return x / (1.f + expf(-x)); }
__device__ __forceinline__ float softplusf_(float x) { return x > 20.f ? x : log1pf(expf(x)); }
__device__ __forceinline__ void glds16(const void* g, void* l) {
    __builtin_amdgcn_global_load_lds((const GAS unsigned*)g, (LAS unsigned*)l, 16, 0, 0);
}
__device__ __forceinline__ void unpack8(const u32x4 r, float (&f)[8]) {
    f[0] = bflo(r.x); f[1] = bfhi(r.x); f[2] = bflo(r.y); f[3] = bfhi(r.y);
    f[4] = bflo(r.z); f[5] = bfhi(r.z); f[6] = bflo(r.w); f[7] = bfhi(r.w);
}

struct Args {
    const void* in[30];
    float* out;
    unsigned char* ws;
    int ph_lo, ph_hi, use_bar, pad;
};

struct Ctx { int tid, lane, wid, wr, wc, fr, fq, bid, nblk; unsigned char* smem; int half, tid0; unsigned char* smem0; };

#define WAIT_V(n) asm volatile("s_waitcnt vmcnt(" #n ")" ::: "memory")
__device__ __forceinline__ void gemm_tile(const bf16_t* a0, const bf16_t* a1, const bf16_t* b0, const bf16_t* b1,
                                          int nk, f32x4 (&acc)[4][4], const Ctx& c) {
#pragma unroll
    for (int m = 0; m < 4; ++m)
#pragma unroll
        for (int n = 0; n < 4; ++n) acc[m][n] = (f32x4){0.f, 0.f, 0.f, 0.f};
    unsigned char* smem = c.smem;
    const int sb = c.tid * 16;
    const int kofs = ((c.tid & 3) ^ ((c.tid >> 4) & 3)) * 8;
    a0 += kofs; a1 += kofs; b0 += kofs; b1 += kofs;
#define G_STAGE(kt_) do { unsigned char* sp_ = smem + ((kt_) & 3) * 16384 + sb; const int ko_ = (kt_) * 32; \
        glds16(a0 + ko_, sp_); glds16(a1 + ko_, sp_ + 4096); glds16(b0 + ko_, sp_ + 8192); glds16(b1 + ko_, sp_ + 12288); } while (0)
#define G_READ(kt_, AF, BF) do { const unsigned char* sa_ = smem + ((kt_) & 3) * 16384 + c.wr * 4096 + roff; const unsigned char* sb_ = smem + ((kt_) & 3) * 16384 + 8192 + c.wc * 4096 + roff; \
        _Pragma("unroll") for (int m = 0; m < 4; ++m) AF[m] = *(const bf16x8*)(sa_ + m * 1024); \
        _Pragma("unroll") for (int n = 0; n < 4; ++n) BF[n] = *(const bf16x8*)(sb_ + n * 1024); } while (0)
#define G_MMA(AF, BF) do { __builtin_amdgcn_s_setprio(1); \
        _Pragma("unroll") for (int m = 0; m < 4; ++m) _Pragma("unroll") for (int n = 0; n < 4; ++n) acc[m][n] = __builtin_amdgcn_mfma_f32_16x16x32_bf16(BF[n], AF[m], acc[m][n], 0, 0, 0); \
        __builtin_amdgcn_s_setprio(0); } while (0)
#define G_BAR() do { asm volatile("" ::: "memory"); __builtin_amdgcn_s_barrier(); asm volatile("" ::: "memory"); } while (0)
    const int roff = (c.fr * 64) + ((c.fq ^ ((c.fr >> 2) & 3)) * 16);
    WAIT_V(0);
    G_STAGE(0); G_STAGE(1); G_STAGE(2); G_STAGE(3);
    bf16x8 fa0[4], fb0[4], fa1[4], fb1[4];
    WAIT_V(12); G_BAR();
    G_READ(0, fa0, fb0);
#define G_LGK0() asm volatile("s_waitcnt lgkmcnt(0)" ::: "memory")
    int kt = 0;
    for (; kt < nk - 4; kt += 4) {
        G_LGK0(); WAIT_V(8); G_BAR(); G_STAGE(kt + 4); G_READ(1, fa1, fb1); G_MMA(fa0, fb0);
        G_LGK0(); WAIT_V(8); G_BAR(); G_STAGE(kt + 5); G_READ(2, fa0, fb0); G_MMA(fa1, fb1);
        G_LGK0(); WAIT_V(8); G_BAR(); G_STAGE(kt + 6); G_READ(3, fa1, fb1); G_MMA(fa0, fb0);
        G_LGK0(); WAIT_V(8); G_BAR(); G_STAGE(kt + 7); G_READ(0, fa0, fb0); G_MMA(fa1, fb1);
    }
    G_LGK0(); WAIT_V(8); G_BAR(); G_READ(1, fa1, fb1); G_MMA(fa0, fb0);
    G_LGK0(); WAIT_V(4); G_BAR(); G_READ(2, fa0, fb0); G_MMA(fa1, fb1);
    G_LGK0(); WAIT_V(0); G_BAR(); G_READ(3, fa1, fb1); G_MMA(fa0, fb0);
    G_MMA(fa1, fb1);
#undef G_LGK0
#undef G_STAGE
#undef G_READ
#undef G_MMA
#undef G_BAR
    __syncthreads();
}

namespace g8 {
constexpr int BM = 256, BK = 64, HALF = 128, HTB = HALF * BK * 2, STAGE_BYTES = 8 * HTB;
__device__ __forceinline__ int lds_byte(int r, int c) { const int st = (r >> 4) * 2 + (c >> 5), rr = r & 15, cc = c & 31, ob = rr * 64 + cc * 2; return st * 1024 + (ob ^ (((ob >> 9) & 1) << 5)); }
__device__ __forceinline__ void stage_rc(int b, int& R, int& C) { const int st = b / 1024, sb = b % 1024, swz = sb ^ (((sb >> 9) & 1) << 5); R = (st >> 1) * 16 + swz / 64; C = (st & 1) * 32 + (swz % 64) / 2; }
__device__ __forceinline__ int perm32(int rho) { const int n = rho >> 4, i = rho & 15; return 8 * (i >> 2) + 4 * n + (i & 3); }
struct Unit { int pm, pn, bt; };

template <bool PERM, bool GATHER, class Sched, class Epi>
__device__ __forceinline__ void phase(unsigned char* ldsp, const char* Abase, const char* Bbase, int K, const Sched& S, const Epi& E) {
    LAS unsigned char* lds = (LAS unsigned char*)ldsp;
    int tid = threadIdx.x; asm volatile("" : "+v"(tid));
    const int wid = __builtin_amdgcn_readfirstlane(tid >> 6), lane = tid & 63, wr = wid >> 2, wc = wid & 3, fr = lane & 15, fq = lane >> 4;
    const int nt = K / BK;
    unsigned voffA[2], voffB[2];
#pragma unroll
    for (int i = 0; i < 2; ++i) { int R, C; stage_rc(tid * 16 + i * 8192, R, C); const int Rb = PERM ? ((R & ~31) + perm32(R & 31)) : R;
        voffA[i] = (unsigned)(R * K + C) * 2u; voffB[i] = (unsigned)(Rb * K + C) * 2u; }
    const size_t kstep = (size_t)(BK * 2);
    const size_t hstep = (size_t)HALF * K * 2, tstep = 2 * hstep;
    const unsigned ldsw = (unsigned)wid * 1024u;
    const int aoff = lds_byte(wr * 64 + fr, fq * 8), boff = lds_byte(wc * 32 + fr, fq * 8);
#define G8_SA(b, h) (((b) * 2 + (h)) * HTB)
#define G8_SB(b, h) ((4 + (b) * 2 + (h)) * HTB)
#define G8_STAGE(bufoff, gbase, voff) do { _Pragma("unroll") for (int _i = 0; _i < 2; ++_i) \
        __builtin_amdgcn_global_load_lds((const GAS unsigned*)((const char*)(gbase) + (voff)[_i]), (LAS unsigned*)(lds + (bufoff) + ldsw + _i * 8192), 16, 0, 0); } while (0)
#define G8_STAGEA(bufoff, gbase, h, kb) do { if constexpr (GATHER) { _Pragma("unroll") for (int _i = 0; _i < 2; ++_i) \
        __builtin_amdgcn_global_load_lds((const GAS unsigned*)(Abase + (kb) + vA[2 * (h) + _i]), (LAS unsigned*)(lds + (bufoff) + ldsw + _i * 8192), 16, 0, 0); } \
        else G8_STAGE(bufoff, (gbase) + (size_t)(h) * hstep + (kb), voffA); } while (0)
#define G8_LDA(dst, b, h) do { _Pragma("unroll") for (int m = 0; m < 4; ++m) _Pragma("unroll") for (int k = 0; k < 2; ++k) dst[m][k] = *(const LAS bf16x8*)(lds + G8_SA(b, h) + aoff + m * 2048 + k * 1024); } while (0)
#define G8_LDB(dst, b, h) do { _Pragma("unroll") for (int n = 0; n < 2; ++n) _Pragma("unroll") for (int k = 0; k < 2; ++k) dst[n][k] = *(const LAS bf16x8*)(lds + G8_SB(b, h) + boff + n * 2048 + k * 1024); } while (0)
#define G8_MMA(ai, bj, At, Bt) do { __builtin_amdgcn_s_setprio(1); _Pragma("unroll") for (int m = 0; m < 4; ++m) _Pragma("unroll") for (int n = 0; n < 2; ++n) _Pragma("unroll") for (int k = 0; k < 2; ++k) \
        acc[ai][bj][m][n] = __builtin_amdgcn_mfma_f32_16x16x32_bf16(Bt[n][k], At[m][k], acc[ai][bj][m][n], 0, 0, 0); __builtin_amdgcn_s_setprio(0); } while (0)
#define G8_WAIT_V(n) asm volatile("s_waitcnt vmcnt(" #n ")" ::: "memory")
#define G8_WAIT_L(n) asm volatile("s_waitcnt lgkmcnt(" #n ")" ::: "memory")
#define G8_BAR __builtin_amdgcn_s_barrier()
#define G8_SCHED __builtin_amdgcn_sched_barrier(0)
    Unit cur, nxt; int ui = 0;
    if (!S.next(0, cur)) return;
    f32x4 acc[2][2][4][2];
#pragma unroll
    for (int a = 0; a < 2; ++a)
#pragma unroll
        for (int b = 0; b < 2; ++b)
#pragma unroll
            for (int m = 0; m < 4; ++m)
#pragma unroll
                for (int n = 0; n < 2; ++n) acc[a][b][m][n] = (f32x4){0.f, 0.f, 0.f, 0.f};
    bf16x8 At[4][2], B0[2][2], B1[2][2];
    const char* cA = Abase + (size_t)cur.pm * tstep; const char* cB = Bbase + (size_t)cur.bt * tstep;
    unsigned vA[4] = {0u, 0u, 0u, 0u};
    if constexpr (GATHER) S.aoff(cur, tid, vA);
    asm volatile("s_waitcnt vmcnt(0)" ::: "memory");
    G8_STAGE(G8_SB(0, 0), cB, voffB); G8_STAGEA(G8_SA(0, 0), cA, 0, 0); G8_STAGE(G8_SB(0, 1), cB + hstep, voffB); G8_STAGEA(G8_SA(0, 1), cA, 1, 0);
    if (wr == 1) G8_BAR;
    G8_WAIT_V(4); G8_BAR;
    G8_STAGE(G8_SB(1, 0), cB + kstep, voffB); G8_STAGEA(G8_SA(1, 0), cA, 0, kstep); G8_STAGE(G8_SB(1, 1), cB + hstep + kstep, voffB);
    G8_WAIT_V(6); G8_BAR;
    for (;;) {
        const bool has_next = S.next(ui + 1, nxt);
        const char* nA = has_next ? Abase + (size_t)nxt.pm * tstep : cA; const char* nB = has_next ? Bbase + (size_t)nxt.bt * tstep : cB;
        for (int t = 0; t < nt; t += 2) {
            const bool last = (t == nt - 2);
            const size_t k1 = (size_t)(t + 1) * kstep, k2 = last ? 0 : (size_t)(t + 2) * kstep, k3 = k2 + kstep;
            const char* a2 = last ? nA : cA; const char* b2 = last ? nB : cB + (size_t)(t + 2) * kstep;
            const char* b3 = b2 + kstep;
            G8_LDB(B0, 0, 0); G8_SCHED; G8_LDA(At, 0, 0); G8_STAGEA(G8_SA(1, 1), cA, 1, k1);
            if constexpr (GATHER) { if (last && has_next) S.aoff(nxt, tid, vA); }
            G8_WAIT_L(8); G8_BAR; G8_WAIT_L(0); G8_MMA(0, 0, At, B0); G8_BAR; G8_SCHED;
            G8_LDB(B1, 0, 1); G8_STAGE(G8_SB(0, 0), b2, voffB);
            G8_BAR; G8_WAIT_L(0); G8_MMA(0, 1, At, B1); G8_BAR;
            G8_LDA(At, 0, 1); G8_STAGEA(G8_SA(0, 0), a2, 0, k2);
            G8_BAR; G8_WAIT_L(0); G8_MMA(1, 0, At, B0); G8_BAR; G8_SCHED;
            G8_STAGE(G8_SB(0, 1), b2 + hstep, voffB);
            G8_WAIT_V(6); G8_BAR; G8_MMA(1, 1, At, B1); G8_BAR;
            G8_LDB(B0, 1, 0); G8_SCHED; G8_LDA(At, 1, 0); G8_STAGEA(G8_SA(0, 1), a2, 1, k2);
            G8_WAIT_L(8); G8_BAR; G8_WAIT_L(0); G8_MMA(0, 0, At, B0); G8_BAR; G8_SCHED;
            G8_LDB(B1, 1, 1); G8_STAGE(G8_SB(1, 0), b3, voffB);
            G8_BAR; G8_WAIT_L(0); G8_MMA(0, 1, At, B1); G8_BAR;
            G8_LDA(At, 1, 1); G8_STAGEA(G8_SA(1, 0), a2, 0, k3);
            G8_BAR; G8_WAIT_L(0); G8_MMA(1, 0, At, B0); G8_BAR; G8_SCHED;
            G8_STAGE(G8_SB(1, 1), b3 + hstep, voffB);
            G8_WAIT_V(6); G8_BAR; G8_MMA(1, 1, At, B1); G8_BAR;
        }
        E(acc, cur, wr, wc, fr, fq);
        if (!has_next) break;
#pragma unroll
        for (int a = 0; a < 2; ++a)
#pragma unroll
            for (int b = 0; b < 2; ++b)
#pragma unroll
                for (int m = 0; m < 4; ++m)
#pragma unroll
                    for (int n = 0; n < 2; ++n) acc[a][b][m][n] = (f32x4){0.f, 0.f, 0.f, 0.f};
        cur = nxt; cA = nA; cB = nB; ++ui;
    }
    G8_WAIT_V(0);
    if (wr == 0) G8_BAR;
    G8_BAR;
#undef G8_SA
#undef G8_SB
#undef G8_STAGE
#undef G8_STAGEA
#undef G8_LDA
#undef G8_LDB
#undef G8_MMA
#undef G8_WAIT_V
#undef G8_WAIT_L
#undef G8_BAR
#undef G8_SCHED
}
}

__device__ __forceinline__ bool tile_map(int i, const Ctx& c, int ntm, int ntn, int& mt, int& nt) {
    const int vb = ((c.nblk & 15) == 0) ? ((c.bid >> 1) & 7) * (c.nblk >> 3) + (((c.bid >> 4) << 1) | (c.bid & 1)) : c.bid;
    const int L = i * c.nblk + vb;
    if (L >= ntm * ntn) return false;
    const int g = L / (8 * ntn), rem = L - g * 8 * ntn;
    const int gsz = (ntm - g * 8) < 8 ? (ntm - g * 8) : 8;
    mt = g * 8 + rem % gsz; nt = rem / gsz;
    return true;
}

__device__ __forceinline__ bool tile_map2(int i, const Ctx& c, int ntm, int ntn, int& mt, int& nt, bool& valid) {
    Ctx o = c; o.bid = c.bid ^ 1;
    int mo, no; const bool oko = tile_map(i, o, ntm, ntn, mo, no);
    valid = tile_map(i, c, ntm, ntn, mt, nt);
    if (!valid) { mt = 0; nt = 0; }
    return valid || oko;
}

struct DenseSched {
    int ntm, ntn, K, bid, nblk;
    __device__ __forceinline__ bool next(int i, g8::Unit& u) const {
        const int vb = ((nblk & 7) == 0) ? (bid & 7) * (nblk >> 3) + (bid >> 3) : bid;
        const int L = i * nblk + vb;
        if (L >= ntm * ntn) return false;
        const int g = L / (8 * ntn), rem = L - g * 8 * ntn;
        const int gsz = (ntm - g * 8) < 8 ? (ntm - g * 8) : 8;
        u.pm = g * 8 + rem % gsz; u.pn = rem / gsz; u.bt = u.pn;
        return true;
    }
};
struct MoeSched {
    int nrb, ntn, bid, nblk; const int* eb;
    __device__ __forceinline__ bool next(int i, g8::Unit& u) const {
        const int vb = ((nblk & 7) == 0) ? (bid & 7) * (nblk >> 3) + (bid >> 3) : bid;
        const int L = i * nblk + vb;
        if (L >= nrb * ntn) return false;
        const int g = L / (8 * ntn), rem = L - g * 8 * ntn;
        const int gsz = (nrb - g * 8) < 8 ? (nrb - g * 8) : 8;
        u.pm = g * 8 + rem % gsz; u.pn = rem / gsz;
        u.bt = eb[u.pm] * ntn + u.pn;
        return true;
    }
};
struct MoeSchedG {
    int nrb, bid, nblk; const int* eb; const int* bst; const int* LTOK;
    __device__ __forceinline__ bool next(int i, g8::Unit& u) const {
        const int vb = ((nblk & 7) == 0) ? (bid & 7) * (nblk >> 3) + (bid >> 3) : bid;
        const int L = i * nblk + vb;
        if (L >= nrb * 2) return false;
        const int g = L >> 4, rem = L & 15;
        const int gsz = (nrb - g * 8) < 8 ? (nrb - g * 8) : 8;
        u.pm = g * 8 + rem % gsz; u.pn = rem / gsz;
        u.bt = eb[u.pm] * 2 + u.pn;
        return true;
    }
    __device__ __forceinline__ void aoff(const g8::Unit& u, int tid, unsigned (&o)[4]) const {
        const int e = eb[u.pm], lb = u.pm - bst[e], cnt = bst[66 + e];
        int R0, C0, R1, C1; g8::stage_rc(tid * 16, R0, C0); g8::stage_rc(tid * 16 + 8192, R1, C1);
        const int* lt = LTOK + (size_t)e * CAP + lb * RBR;
        const int p00 = R0, p01 = R1, p10 = 128 + R0, p11 = 128 + R1;
        const int t00 = (lb * RBR + p00 < cnt) ? lt[p00] : 0, t01 = (lb * RBR + p01 < cnt) ? lt[p01] : 0;
        const int t10 = (lb * RBR + p10 < cnt) ? lt[p10] : 0, t11 = (lb * RBR + p11 < cnt) ? lt[p11] : 0;
        o[0] = (unsigned)t00 * 2048u + (unsigned)C0 * 2u; o[1] = (unsigned)t01 * 2048u + (unsigned)C1 * 2u;
        o[2] = (unsigned)t10 * 2048u + (unsigned)C0 * 2u; o[3] = (unsigned)t11 * 2048u + (unsigned)C1 * 2u;
    }
};
struct EpiMoe1 {
    bf16_t* H;
    __device__ __forceinline__ void operator()(const f32x4 (&acc)[2][2][4][2], const g8::Unit& u, int wr, int wc, int fr, int fq) const {
#pragma unroll
        for (int ai = 0; ai < 2; ++ai)
#pragma unroll
            for (int m = 0; m < 4; ++m) {
                const size_t row = (size_t)u.pm * RBR + ai * 128 + wr * 64 + m * 16 + fr;
#pragma unroll
                for (int bj = 0; bj < 2; ++bj) {
                    const int hc = (u.pn * 8 + bj * 4 + wc) * 16 + fq * 4;
                    const f32x4 g = acc[ai][bj][m][0], up = acc[ai][bj][m][1];
                    float h[4];
#pragma unroll
                    for (int j = 0; j < 4; ++j) h[j] = g[j] * __builtin_amdgcn_rcpf(1.f + __expf(-g[j])) * up[j];
                    *(u32x2*)(H + row * 256 + hc) = (u32x2){cvt_pk(h[0], h[1]), cvt_pk(h[2], h[3])};
                }
            }
    }
};
struct EpiIn {
    bf16_t* P; float* G; int gbase;
    __device__ __forceinline__ void operator()(const f32x4 (&acc)[2][2][4][2], const g8::Unit& u, int wr, int wc, int fr, int fq) const {
#pragma unroll
        for (int ai = 0; ai < 2; ++ai)
#pragma unroll
            for (int m = 0; m < 4; ++m) {
                const size_t row = (size_t)u.pm * 256 + ai * 128 + wr * 64 + m * 16 + fr;
#pragma unroll
                for (int bj = 0; bj < 2; ++bj) {
                    const int col = u.pn * 256 + bj * 128 + wc * 32 + fq * 8;
                    const f32x4 v0 = acc[ai][bj][m][0], v1 = acc[ai][bj][m][1];
                    *(u32x4*)(P + row * NPAD + col) = (u32x4){cvt_pk(v0[0], v0[1]), cvt_pk(v0[2], v0[3]), cvt_pk(v1[0], v1[1]), cvt_pk(v1[2], v1[3])};
                    if (col == gbase) { *(f32x4*)(G + row * 8) = v0; *(f32x4*)(G + row * 8 + 4) = v1; }
                }
            }
    }
};
struct EpiMoe2 {
    bf16_t* Y;
    __device__ __forceinline__ void operator()(const f32x4 (&acc)[2][2][4][2], const g8::Unit& u, int wr, int wc, int fr, int fq) const {
#pragma unroll
        for (int ai = 0; ai < 2; ++ai)
#pragma unroll
            for (int m = 0; m < 4; ++m) {
                const size_t row = (size_t)u.pm * RBR + ai * 128 + wr * 64 + m * 16 + fr;
#pragma unroll
                for (int bj = 0; bj < 2; ++bj) {
                    const int col = u.pn * 256 + bj * 128 + wc * 32 + fq * 8;
                    const f32x4 v0 = acc[ai][bj][m][0], v1 = acc[ai][bj][m][1];
                    *(u32x4*)(Y + row * 1024 + col) = (u32x4){cvt_pk(v0[0], v0[1]), cvt_pk(v0[2], v0[3]), cvt_pk(v1[0], v1[1]), cvt_pk(v1[2], v1[3])};
                }
            }
    }
};
struct EpiOut {
    const float* xres; float* Y;
    __device__ __forceinline__ void operator()(const f32x4 (&acc)[2][2][4][2], const g8::Unit& u, int wr, int wc, int fr, int fq) const {
#pragma unroll
        for (int ai = 0; ai < 2; ++ai)
#pragma unroll
            for (int m = 0; m < 4; ++m) {
                const size_t row = (size_t)u.pm * 256 + ai * 128 + wr * 64 + m * 16 + fr;
#pragma unroll
                for (int bj = 0; bj < 2; ++bj)
#pragma unroll
                    for (int n = 0; n < 2; ++n) {
                        const int col = u.pn * 256 + bj * 128 + wc * 32 + n * 16 + fq * 4;
                        const f32x4 xr = *(const f32x4*)(xres + row * 1024 + col);
                        *(f32x4*)(Y + row * 1024 + col) = xr * ALPHA + acc[ai][bj][m][n];
                    }
                asm volatile("" ::: "memory");
            }
    }
};

constexpr int TS_RS = 272;
__device__ __forceinline__ void tile_put(const Ctx& c, int row_l, int col_l, const u32x2 v) { *(u32x2*)(c.smem + row_l * TS_RS + col_l * 2) = v; }
template <int NCOL>
__device__ __forceinline__ void tile_flush(const Ctx& c, bf16_t* out, size_t ld, bool valid) {
    __syncthreads();
    constexpr int CPR = NCOL / 8, PER = (128 * CPR) / 256;
#pragma unroll
    for (int i = 0; i < PER; ++i) {
        const int idx = c.tid + 256 * i, row = idx / CPR, ch = idx % CPR;
        const u32x4 v = *(const u32x4*)(c.smem + row * TS_RS + ch * 16);
        if (valid) *(u32x4*)(out + (size_t)row * ld + ch * 8) = v;
    }
    __syncthreads();
}

__device__ __forceinline__ void conv_family(const float* src, int nmat, size_t src_stride, int K, int N, int Nout,
                            bf16_t* dst, size_t dst_stride, int grp, int kind, const Ctx& c) {
    float* lds = (float*)c.smem;
    const int tk = K / 128, tn = Nout / 64, per = tk * tn, total = nmat * per;
    const int tx = c.tid & 15, ty = c.tid >> 4;
    f32x4 r[8];
#define CV_LOAD(u_) do { const int mat_ = (u_) / per, r_ = (u_) - mat_ * per, kt_ = r_ / tn, nt_ = r_ - kt_ * tn; \
        const float* s_ = src + (size_t)mat_ * src_stride + (size_t)(kt_ * 128 + ty) * N + nt_ * 64 + tx * 4; const bool in_ = (nt_ * 64 + tx * 4) < N; \
        _Pragma("unroll") for (int i = 0; i < 8; ++i) r[i] = in_ ? *(const f32x4*)(s_ + (size_t)(16 * i) * N) : (f32x4){0.f, 0.f, 0.f, 0.f}; } while (0)
    if (c.bid < total) CV_LOAD(c.bid);
    for (int base = 0; base < total; base += c.nblk) {
        const int u = base + c.bid; const bool valid = u < total;
#pragma unroll
        for (int i = 0; i < 8; ++i) *(f32x4*)(lds + (ty + 16 * i) * 68 + tx * 4) = r[i];
        if (u + c.nblk < total) CV_LOAD(u + c.nblk);
        __syncthreads();
        if (valid) {
        const int mat = u / per, rr = u - mat * per, kt = rr / tn, nt = rr - kt * tn;
        const int dmat = grp ? (mat / grp) * (grp + 1) + (mat % grp) : mat;
        bf16_t* d = dst + (size_t)dmat * dst_stride;
        const int nl = c.tid & 63, kq = (c.tid >> 6) * 32;
        unsigned w[16];
#pragma unroll
        for (int j = 0; j < 16; ++j) w[j] = pk2(lds[(kq + 2 * j) * 68 + nl], lds[(kq + 2 * j + 1) * 68 + nl]);
        const int n = nt * 64 + nl;
        const int drow = (kind == 0) ? n : ((n >> 4) * 32 + (n & 15) + (kind == 2 ? 16 : 0));
        u32x4* dp = (u32x4*)(d + (size_t)drow * K + kt * 128 + kq);
        dp[0] = (u32x4){w[0], w[1], w[2], w[3]}; dp[1] = (u32x4){w[4], w[5], w[6], w[7]};
        dp[2] = (u32x4){w[8], w[9], w[10], w[11]}; dp[3] = (u32x4){w[12], w[13], w[14], w[15]};
        }
        __syncthreads();
    }
#undef CV_LOAD
}

__device__ __forceinline__ void phase_prologue(const Args& a, const Ctx& c) {
    unsigned char* ws = a.ws;
    bf16_t* WIN = (bf16_t*)(ws + WS_WIN);
    conv_family((const float*)a.in[2], 2, (size_t)1024 * 2472, 1024, 2472, NPAD, WIN, 2 * WIN_ELEMS, 0, 0, c);
    conv_family((const float*)a.in[12], 2, (size_t)1024 * 2312, 1024, 2312, NPAD, WIN + WIN_ELEMS, 2 * WIN_ELEMS, 0, 0, c);
    conv_family((const float*)a.in[4], 2, (size_t)256 * 768, 256, 768, 768, (bf16_t*)(ws + WS_WQB), WQB_ELEMS, 0, 0, c);
    conv_family((const float*)a.in[6], 2, (size_t)128 * 1024, 128, 1024, 1024, (bf16_t*)(ws + WS_WKVB), WKVB_ELEMS, 0, 0, c);
    bf16_t* WOUT = (bf16_t*)(ws + WS_WOUT);
    conv_family((const float*)a.in[11], 2, (size_t)1024 * 1024, 1024, 1024, 1024, WOUT, 2 * WOUT_ELEMS, 0, 0, c);
    conv_family((const float*)a.in[17], 2, (size_t)1024 * 1024, 1024, 1024, 1024, WOUT + WOUT_ELEMS, 2 * WOUT_ELEMS, 0, 0, c);
    conv_family((const float*)a.in[20], 4, (size_t)1024 * 64, 1024, 64, 128, (bf16_t*)(ws + WS_WRT), WRT_ELEMS, 0, 0, c);
    bf16_t* WGU = (bf16_t*)(ws + WS_WGU);
    conv_family((const float*)a.in[22], 256, (size_t)1024 * 256, 1024, 256, 256, WGU, WGU_ELEMS, 64, 1, c);
    conv_family((const float*)a.in[23], 256, (size_t)1024 * 256, 1024, 256, 256, WGU, WGU_ELEMS, 64, 2, c);
    conv_family((const float*)a.in[25], 4, (size_t)1024 * 256, 1024, 256, 256, WGU + 64 * WGU_ELEMS, 65 * WGU_ELEMS, 0, 1, c);
    conv_family((const float*)a.in[26], 4, (size_t)1024 * 256, 1024, 256, 256, WGU + 64 * WGU_ELEMS, 65 * WGU_ELEMS, 0, 2, c);
    bf16_t* WDN = (bf16_t*)(ws + WS_WDN);
    conv_family((const float*)a.in[24], 256, (size_t)256 * 1024, 256, 1024, 1024, WDN, WDN_ELEMS, 64, 0, c);
    conv_family((const float*)a.in[27], 4, (size_t)256 * 1024, 256, 1024, 1024, WDN + 64 * WDN_ELEMS, 65 * WDN_ELEMS, 0, 0, c);
    {
        const float* x = (const float*)a.in[0]; bf16_t* xb = (bf16_t*)(ws + WS_XBF);
        const size_t n8 = (size_t)T * 1024 / 8;
        for (size_t i = (size_t)c.bid * 256 + c.tid; i < n8; i += (size_t)c.nblk * 256) {
            const f32x4 v0 = *(const f32x4*)(x + i * 8), v1 = *(const f32x4*)(x + i * 8 + 4);
            *(u32x4*)(xb + i * 8) = (u32x4){pk2(v0[0], v0[1]), pk2(v0[2], v0[3]), pk2(v1[0], v1[1]), pk2(v1[2], v1[3])};
        }
    }
    {
        const int* pos = (const int*)a.in[1];
        float* rm = (float*)(ws + WS_ROPEM); float* rs = (float*)(ws + WS_ROPES);
        const float ln_theta = 9.210340371976184f;
        for (int i = c.bid * 256 + c.tid; i < T * 16; i += c.nblk * 256) {
            const int t = i >> 4, f = i & 15;
            const float inv = expf(-((float)(2 * f) / 32.f) * ln_theta);
            const float ang = (float)pos[t] * inv;
            rm[i * 2] = cosf(ang); rm[i * 2 + 1] = sinf(ang);
        }
        for (int i = c.bid * 256 + c.tid; i < T * 32; i += c.nblk * 256) {
            const int t = i >> 5, f = i & 31;
            const float inv = expf(-((float)(2 * f) / 64.f) * ln_theta);
            const float ang = (float)pos[t] * inv;
            rs[i * 2] = cosf(ang); rs[i * 2 + 1] = sinf(ang);
        }
    }
}

__device__ __forceinline__ void phase_inproj(const bf16_t* XBF, const bf16_t* W, bf16_t* PROJ, float* GATES, int gbase, const Ctx& c) {
    const int ntn = NPAD / 128;
    for (int i = 0;; ++i) {
        int mt, nt; bool valid; if (!tile_map2(i, c, T / 128, ntn, mt, nt, valid)) break;
        const bf16_t* a0 = XBF + (size_t)(mt * 128 + (c.tid >> 2)) * 1024;
        const bf16_t* b0 = W + (size_t)(nt * 128 + (c.tid >> 2)) * 1024;
        f32x4 acc[4][4];
        gemm_tile(a0, a0 + 64 * 1024, b0, b0 + 64 * 1024, 32, acc, c);
#pragma unroll
        for (int m = 0; m < 4; ++m) {
            const int rl = c.wr * 64 + m * 16 + c.fr, row = mt * 128 + rl;
#pragma unroll
            for (int n = 0; n < 4; ++n) {
                const int cl = c.wc * 64 + n * 16 + c.fq * 4, col = nt * 128 + cl;
                const f32x4 v = acc[m][n];
                tile_put(c, rl, cl, (u32x2){pk2(v[0], v[1]), pk2(v[2], v[3])});
                if (valid && col >= gbase && col < gbase + 8) *(f32x4*)(GATES + (size_t)row * 8 + (col - gbase)) = v;
            }
        }
        tile_flush<128>(c, PROJ + (size_t)mt * 128 * NPAD + nt * 128, NPAD, valid);
    }
}

constexpr int MLAUP_TILES = (T / 128) * 6 + (T / 128) * 8;
__device__ __forceinline__ void mla_up_tile(int u, const bf16_t* CQ, const bf16_t* WQB, const bf16_t* CKV, const bf16_t* WKVB,
                             const float* ROPEM, bf16_t* QF, bf16_t* KN, bf16_t* VV, const Ctx& c) {
    const int tq = (T / 128) * 6;
    const float qscale = 0.10206207261596577f * 1.4426950408889634f;
    {
        f32x4 acc[4][4];
        if (u < tq) {
            const int mt = u / 6, nt = u % 6;
            const bf16_t* a0 = CQ + (size_t)(mt * 128 + (c.tid >> 2)) * 256;
            const bf16_t* b0 = WQB + (size_t)(nt * 128 + (c.tid >> 2)) * 256;
            gemm_tile(a0, a0 + 64 * 256, b0, b0 + 64 * 256, 8, acc, c);
#pragma unroll
            for (int m = 0; m < 4; ++m) {
                const int row = mt * 128 + c.wr * 64 + m * 16 + c.fr;
#pragma unroll
                for (int np = 0; np < 2; ++np) {
                    const int cg = nt * 128 + c.wc * 64 + np * 32;
                    f32x4 v0 = acc[m][2 * np], v1 = acc[m][2 * np + 1];
                    if (((cg >> 5) % 3) == 2) {
#pragma unroll
                        for (int j = 0; j < 4; ++j) {
                            const int i = c.fq * 4 + j;
                            const float cs = ROPEM[((size_t)row * 16 + i) * 2], sn = ROPEM[((size_t)row * 16 + i) * 2 + 1];
                            const float x1 = v0[j], x2 = v1[j];
                            v0[j] = x1 * cs - x2 * sn; v1[j] = x2 * cs + x1 * sn;
                        }
                    }
                    v0 *= qscale; v1 *= qscale;
                    *(u32x2*)(QF + (size_t)row * 768 + cg + c.fq * 4) = (u32x2){pk2(v0[0], v0[1]), pk2(v0[2], v0[3])};
                    *(u32x2*)(QF + (size_t)row * 768 + cg + 16 + c.fq * 4) = (u32x2){pk2(v1[0], v1[1]), pk2(v1[2], v1[3])};
                }
            }
        } else {
            const int v = u - tq, mt = v / 8, nt = v % 8;
            const bf16_t* a0 = CKV + (size_t)(mt * 128 + (c.tid >> 2)) * 128;
            const bf16_t* b0 = WKVB + (size_t)(nt * 128 + (c.tid >> 2)) * 128;
            gemm_tile(a0, a0 + 64 * 128, b0, b0 + 64 * 128, 4, acc, c);
            bf16_t* dst = (c.wc == 0) ? KN : VV;
#pragma unroll
            for (int m = 0; m < 4; ++m) {
                const int row = mt * 128 + c.wr * 64 + m * 16 + c.fr;
#pragma unroll
                for (int n = 0; n < 4; ++n) {
                    const f32x4 x = acc[m][n];
                    *(u32x2*)(dst + (size_t)row * 512 + nt * 64 + n * 16 + c.fq * 4) = (u32x2){pk2(x[0], x[1]), pk2(x[2], x[3])};
                }
            }
        }
    }
}

__device__ __forceinline__ void phase_outproj(const bf16_t* MIXO, const bf16_t* W, const float* xres, float* YBUF, const Ctx& c) {
    for (int i = 0;; ++i) {
        int mt, nt; bool valid; if (!tile_map2(i, c, T / 128, 8, mt, nt, valid)) break;
        const bf16_t* a0 = MIXO + (size_t)(mt * 128 + (c.tid >> 2)) * 1024;
        const bf16_t* b0 = W + (size_t)(nt * 128 + (c.tid >> 2)) * 1024;
        f32x4 acc[4][4];
        gemm_tile(a0, a0 + 64 * 1024, b0, b0 + 64 * 1024, 32, acc, c);
#pragma unroll
        for (int m = 0; m < 4; ++m) {
            const int row = mt * 128 + c.wr * 64 + m * 16 + c.fr;
#pragma unroll
            for (int n = 0; n < 4; ++n) {
                const int col = nt * 128 + c.wc * 64 + n * 16 + c.fq * 4;
                const f32x4 xr = *(const f32x4*)(xres + (size_t)row * 1024 + col);
                if (valid) *(f32x4*)(YBUF + (size_t)row * 1024 + col) = xr * ALPHA + acc[m][n];
            }
        }
    }
}

__device__ __forceinline__ void phase_router(const bf16_t* XBF, const bf16_t* W, float* LOG, const Ctx& c) {
    for (int base = 0; base < T / 128; base += c.nblk) {
        const bool valid = (base + c.bid) < T / 128; const int mt = valid ? base + c.bid : 0;
        const bf16_t* a0 = XBF + (size_t)(mt * 128 + (c.tid >> 2)) * 1024;
        const bf16_t* b0 = W + (size_t)(c.tid >> 2) * 1024;
        f32x4 acc[4][4];
        gemm_tile(a0, a0 + 64 * 1024, b0, b0 + 64 * 1024, 32, acc, c);
        if (c.wc == 0 && valid) {
#pragma unroll
            for (int m = 0; m < 4; ++m) {
                const int row = mt * 128 + c.wr * 64 + m * 16 + c.fr;
#pragma unroll
                for (int n = 0; n < 4; ++n) *(f32x4*)(LOG + (size_t)row * 64 + n * 16 + c.fq * 4) = acc[m][n];
            }
        }
    }
}

__device__ __forceinline__ void build_block_table(const unsigned* CNT, int* bst, const Ctx& c) {
    __syncthreads();
    if (c.wid == 0) {
        const int cnt = (int)__hip_atomic_load(CNT + c.lane, __ATOMIC_RELAXED, __HIP_MEMORY_SCOPE_AGENT);
        const int nb = (cnt + RBR - 1) / RBR;
        int inc = nb;
#pragma unroll
        for (int o = 1; o < 64; o <<= 1) { const int x = __shfl_up(inc, o); if (c.lane >= o) inc += x; }
        bst[c.lane] = inc - nb; bst[66 + c.lane] = cnt;
        if (c.lane == 63) { bst[64] = inc; bst[65] = inc + T / RBR; bst[66 + 64] = T; }
    }
    __syncthreads();
}
__device__ __forceinline__ int find_expert(const int* bst, int rb, const Ctx& c) {
    return __popcll(__ballot(bst[1 + c.lane] <= rb));
}

__device__ __forceinline__ void phase_moe1(const bf16_t* XBF, const bf16_t* WGU, const unsigned* CNT, const int* LTOK, const float* LW, bf16_t* HBUF, const Ctx& c) {
    int* bst = (int*)(c.smem + 65536 + 64);
    build_block_table(CNT, bst, c);
    const int nsb = bst[65] * 2;
    for (int i = 0;; ++i) {
        int sbk, nt; bool valid; if (!tile_map2(i, c, nsb, 4, sbk, nt, valid)) break;
        const int rb = sbk >> 1, hb = sbk & 1;
        const int e = find_expert(bst, rb, c);
        const int lb = rb - bst[e], cnt = bst[66 + e];
        const int p0 = lb * RBR + hb * 128 + (c.tid >> 2), p1 = p0 + 64;
        const int t0 = (p0 < cnt) ? LTOK[(size_t)e * CAP + p0] : 0;
        const int t1 = (p1 < cnt) ? LTOK[(size_t)e * CAP + p1] : 0;
        const bf16_t* a0 = XBF + (size_t)t0 * 1024;
        const bf16_t* a1 = XBF + (size_t)t1 * 1024;
        const bf16_t* b0 = WGU + (size_t)e * WGU_ELEMS + (size_t)(nt * 128 + (c.tid >> 2)) * 1024;
        f32x4 acc[4][4];
        gemm_tile(a0, a1, b0, b0 + 64 * 1024, 32, acc, c);
#pragma unroll
        for (int m = 0; m < 4; ++m) {
            const int rl = c.wr * 64 + m * 16 + c.fr;
            const int pw = lb * RBR + hb * 128 + rl;
            const float wrow = (pw < cnt) ? LW[(size_t)e * CAP + pw] : 0.f;
#pragma unroll
            for (int n = 0; n < 2; ++n) {
                const f32x4 g = acc[m][n], up = acc[m][n + 2];
                float h[4];
#pragma unroll
                for (int j = 0; j < 4; ++j) h[j] = siluf_(g[j]) * up[j] * wrow;
                tile_put(c, rl, c.wc * 32 + n * 16 + c.fq * 4, (u32x2){pk2(h[0], h[1]), pk2(h[2], h[3])});
            }
        }
        tile_flush<64>(c, HBUF + ((size_t)rb * RBR + hb * 128) * 256 + nt * 64, 256, valid);
    }
}

__device__ __forceinline__ void phase_moe2(const bf16_t* HBUF, const bf16_t* WDN, const unsigned* CNT, bf16_t* Y, const Ctx& c) {
    int* bst = (int*)(c.smem + 65536 + 64);
    build_block_table(CNT, bst, c);
    const int nsb = bst[65] * 2;
    for (int i = 0;; ++i) {
        int sbk, nt; bool valid; if (!tile_map2(i, c, nsb, 8, sbk, nt, valid)) break;
        const int rb = sbk >> 1;
        const int e = find_expert(bst, rb, c);
        const bf16_t* a0 = HBUF + ((size_t)sbk * 128 + (c.tid >> 2)) * 256;
        const bf16_t* b0 = WDN + (size_t)e * WDN_ELEMS + (size_t)(nt * 128 + (c.tid >> 2)) * 256;
        f32x4 acc[4][4];
        gemm_tile(a0, a0 + 64 * 256, b0, b0 + 64 * 256, 8, acc, c);
#pragma unroll
        for (int m = 0; m < 4; ++m) {
            const int lr = c.wr * 64 + m * 16 + c.fr;
#pragma unroll
            for (int n = 0; n < 4; ++n) {
                const f32x4 v = acc[m][n];
                tile_put(c, lr, c.wc * 64 + n * 16 + c.fq * 4, (u32x2){pk2(v[0], v[1]), pk2(v[2], v[3])});
            }
        }
        tile_flush<128>(c, Y + (size_t)sbk * 128 * 1024 + nt * 128, 1024, valid);
    }
}

__device__ __forceinline__ float dppf(float v, int ctrl_sel) {
    int x = __builtin_bit_cast(int, v), r;
    if (ctrl_sel == 0) r = __builtin_amdgcn_update_dpp(0, x, 0xB1, 0xF, 0xF, true);
    else if (ctrl_sel == 1) r = __builtin_amdgcn_update_dpp(0, x, 0x4E, 0xF, 0xF, true);
    else if (ctrl_sel == 2) r = __builtin_amdgcn_update_dpp(0, x, 0x141, 0xF, 0xF, true);
    else r = __builtin_amdgcn_update_dpp(0, x, 0x140, 0xF, 0xF, true);
    return __builtin_bit_cast(float, r);
}
__device__ __forceinline__ float red16(float v) { v += dppf(v, 0); v += dppf(v, 1); v += dppf(v, 2); v += dppf(v, 3); return v; }

__device__ __forceinline__ void ln_row_store(float (&v)[16], const float* g, const float* b, float* of32, bf16_t* obf, int lane) {
    float s = 0.f;
#pragma unroll
    for (int i = 0; i < 16; ++i) s += v[i];
    const float mean = wave_sum(s) * (1.f / 1024.f);
    float q = 0.f;
#pragma unroll
    for (int i = 0; i < 16; ++i) { v[i] -= mean; q += v[i] * v[i]; }
    const float rstd = rsqrtf(wave_sum(q) * (1.f / 1024.f) + 1e-5f);
#pragma unroll
    for (int hf = 0; hf < 2; ++hf) {
        const int col = hf * 512 + lane * 8;
        const f32x4 g0 = *(const f32x4*)(g + col), g1 = *(const f32x4*)(g + col + 4);
        const f32x4 b0 = *(const f32x4*)(b + col), b1 = *(const f32x4*)(b + col + 4);
        f32x4 y0, y1;
#pragma unroll
        for (int j = 0; j < 4; ++j) { y0[j] = v[hf * 8 + j] * rstd * g0[j] + b0[j]; y1[j] = v[hf * 8 + 4 + j] * rstd * g1[j] + b1[j]; }
        *(f32x4*)(of32 + col) = y0; *(f32x4*)(of32 + col + 4) = y1;
        *(u32x4*)(obf + col) = (u32x4){pk2(y0[0], y0[1]), pk2(y0[2], y0[3]), pk2(y1[0], y1[1]), pk2(y1[2], y1[3])};
    }
}

__device__ __forceinline__ void phase_ln1(const float* YBUF, const float* g, const float* b, float* X1, bf16_t* XBF, const Ctx& c) {
    for (int t = c.bid * 4 + c.wid; t < T; t += c.nblk * 4) {
        float v[16];
#pragma unroll
        for (int hf = 0; hf < 2; ++hf) {
            const float* p = YBUF + (size_t)t * 1024 + hf * 512 + c.lane * 8;
            const f32x4 a0 = *(const f32x4*)p, a1 = *(const f32x4*)(p + 4);
#pragma unroll
            for (int j = 0; j < 4; ++j) { v[hf * 8 + j] = a0[j]; v[hf * 8 + 4 + j] = a1[j]; }
        }
        ln_row_store(v, g, b, X1 + (size_t)t * 1024, XBF + (size_t)t * 1024, c.lane);
    }
}

__device__ __forceinline__ void phase_combine(const float* X1, const bf16_t* Y, const int* ASG, const float* ASGW, const unsigned* CNT, const float* g, const float* b,
                              float* XOUT, bf16_t* XBF, const Ctx& c) {
    int* bst = (int*)(c.smem + 65536 + 64);
    build_block_table(CNT, bst, c);
    for (int t = c.bid * 4 + c.wid; t < T; t += c.nblk * 4) {
        float v[16];
#pragma unroll
        for (int hf = 0; hf < 2; ++hf) {
            const float* p = X1 + (size_t)t * 1024 + hf * 512 + c.lane * 8;
            const f32x4 a0 = *(const f32x4*)p, a1 = *(const f32x4*)(p + 4);
#pragma unroll
            for (int j = 0; j < 4; ++j) { v[hf * 8 + j] = a0[j] * ALPHA; v[hf * 8 + 4 + j] = a1[j] * ALPHA; }
        }
#pragma unroll
        for (int k = 0; k < 9; ++k) {
            size_t crow; float wk = 1.f;
            if (k < 8) { const int asg = ASG[(size_t)t * 8 + k]; crow = (size_t)bst[asg >> 16] * RBR + (asg & 0xffff); wk = ASGW[(size_t)t * 8 + k]; }
            else crow = (size_t)bst[64] * RBR + t;
#pragma unroll
            for (int hf = 0; hf < 2; ++hf) {
                const u32x4 r = *(const u32x4*)(Y + crow * 1024 + hf * 512 + c.lane * 8);
                float f[8]; unpack8(r, f);
#pragma unroll
                for (int j = 0; j < 8; ++j) v[hf * 8 + j] += f[j] * wk;
            }
        }
        ln_row_store(v, g, b, XOUT + (size_t)t * 1024, XBF + (size_t)t * 1024, c.lane);
    }
}

__device__ __forceinline__ void phase_route(const float* LOG, const float* rb, unsigned* CNT, int* LTOK, float* LW, int* ASG, float* ASGW, const Ctx& c) {
    int* lcnt = (int*)c.smem;
    int* lbase = lcnt + 64;
    int* sel_e = lbase + 64;
    int* sel_p = sel_e + 256;
    float* sel_w = (float*)(sel_p + 256);
    const float rbias = rb[c.lane];
    for (int base = 0; base < T / 32; base += c.nblk) {
        const int ch = base + c.bid; const bool valid = ch < T / 32;
        __syncthreads();
        if (c.tid < 64) lcnt[c.tid] = 0;
        __syncthreads();
        if (valid) for (int tl = c.wid; tl < 32; tl += 4) {
            const int t = ch * 32 + tl;
            const float lg = LOG[(size_t)t * 64 + c.lane];
            const float sc = 1.f / (1.f + expf(-lg));
            const float v = sc + rbias;
            float m1 = v;
            m1 = fmaxf(m1, __shfl_xor(m1, 1)); m1 = fmaxf(m1, __shfl_xor(m1, 2)); m1 = fmaxf(m1, __shfl_xor(m1, 4));
            int cand = (v == m1) ? c.lane : 999;
            cand = min(cand, __shfl_xor(cand, 1)); cand = min(cand, __shfl_xor(cand, 2)); cand = min(cand, __shfl_xor(cand, 4));
            float m2 = (c.lane == cand) ? -INFINITY : v;
            m2 = fmaxf(m2, __shfl_xor(m2, 1)); m2 = fmaxf(m2, __shfl_xor(m2, 2)); m2 = fmaxf(m2, __shfl_xor(m2, 4));
            const float gs = m1 + m2;
            const int g = c.lane >> 3;
            int grank = 0;
#pragma unroll
            for (int gg = 0; gg < 8; ++gg) { const float o = __shfl(gs, gg * 8); grank += ((o > gs) || (o == gs && gg < g)) ? 1 : 0; }
            const bool gsel = grank < 4;
            const float mv = gsel ? v : -INFINITY;
            int rank = 0;
#pragma unroll 8
            for (int jj = 0; jj < 64; ++jj) { const float o = __shfl(mv, jj); rank += ((o > mv) || (o == mv && jj < c.lane)) ? 1 : 0; }
            const bool sel = gsel && rank < 8;
            const float ssum = wave_sum(sel ? sc : 0.f);
            const float w = sc / ssum * 2.5f;
            const unsigned long long bal = __ballot(sel);
            const int slot = __popcll(bal & ((1ull << c.lane) - 1ull));
            if (sel) {
                const int p = atomicAdd(&lcnt[c.lane], 1);
                sel_e[tl * 8 + slot] = c.lane; sel_p[tl * 8 + slot] = p; sel_w[tl * 8 + slot] = w;
            }
        }
        __syncthreads();
        if (valid && c.tid < 64) { const int n = lcnt[c.tid]; lbase[c.tid] = n ? (int)atomicAdd(CNT + c.tid, (unsigned)n) : 0; }
        __syncthreads();
        if (valid) {
            const int tl = c.tid >> 3, t = ch * 32 + tl;
            const int e = sel_e[c.tid], pos = lbase[e] + sel_p[c.tid];
            LTOK[(size_t)e * CAP + pos] = t; LW[(size_t)e * CAP + pos] = sel_w[c.tid];
            ASG[(size_t)t * 8 + (c.tid & 7)] = (e << 16) | pos; ASGW[(size_t)t * 8 + (c.tid & 7)] = sel_w[c.tid];
            if (c.tid < 32) { const int ts = ch * 32 + c.tid; LTOK[(size_t)64 * CAP + ts] = ts; LW[(size_t)64 * CAP + ts] = 1.f; }
        }
    }
}

__device__ __forceinline__ void phase_prep_even(const bf16_t* PROJ, const float* GATES, const float* qn, const float* kvn, const float* cw,
                                const float* a_log, const float* dt_bias, const float* ROPEM,
                                bf16_t* CQ, bf16_t* CKV, bf16_t* KROPE, bf16_t* GQ, bf16_t* GK, bf16_t* GV, float* BETA, float* GLOG, const Ctx& c) {
    const int lane = c.lane;
    float* cwL = (float*)c.smem;
    __syncthreads();
    for (int i = c.tid; i < 4 * 1536 / 4; i += 256) *(f32x4*)(cwL + i * 4) = *(const f32x4*)(cw + i * 4);
    __syncthreads();
    for (int t = c.bid * 4 + c.wid; t < T; t += c.nblk * 4) {
        const bf16_t* pr = PROJ + (size_t)t * NPAD;
        {
            const u32x2 r = *(const u32x2*)(pr + lane * 4);
            float v[4] = {bflo(r.x), bfhi(r.x), bflo(r.y), bfhi(r.y)};
            const float ss = wave_sum(v[0] * v[0] + v[1] * v[1] + v[2] * v[2] + v[3] * v[3]);
            const float rr = rsqrtf(ss * (1.f / 256.f) + 1e-6f);
            const f32x4 gq = *(const f32x4*)(qn + lane * 4);
            *(u32x2*)(CQ + (size_t)t * 256 + lane * 4) = (u32x2){pk2(v[0] * rr * gq[0], v[1] * rr * gq[1]), pk2(v[2] * rr * gq[2], v[3] * rr * gq[3])};
        }
        {
            const unsigned r = *(const unsigned*)(pr + 256 + lane * 2);
            const float v0 = bflo(r), v1 = bfhi(r);
            const float ss = wave_sum(v0 * v0 + v1 * v1);
            const float rr = rsqrtf(ss * (1.f / 128.f) + 1e-6f);
            *(unsigned*)(CKV + (size_t)t * 128 + lane * 2) = pk2(v0 * rr * kvn[lane * 2], v1 * rr * kvn[lane * 2 + 1]);
        }
        if (lane < 16) {
            const float x1 = bf2f(pr[384 + lane]), x2 = bf2f(pr[400 + lane]);
            const float cs = ROPEM[((size_t)t * 16 + lane) * 2], sn = ROPEM[((size_t)t * 16 + lane) * 2 + 1];
            KROPE[(size_t)t * 32 + lane] = (bf16_t)f2bf(x1 * cs - x2 * sn);
            KROPE[(size_t)t * 32 + 16 + lane] = (bf16_t)f2bf(x2 * cs + x1 * sn);
        }
        const int s = t & (SEQ - 1);
        u32x4 xr[3][4];
#pragma unroll
        for (int arr = 0; arr < 3; ++arr)
#pragma unroll
            for (int w = 0; w < 4; ++w)
                xr[arr][w] = (s - 3 + w >= 0) ? *(const u32x4*)(PROJ + (size_t)(t - 3 + w) * NPAD + 416 + arr * 512 + lane * 8) : (u32x4){0u, 0u, 0u, 0u};
#pragma unroll
        for (int arr = 0; arr < 3; ++arr) {
            float y[8];
#pragma unroll
            for (int j = 0; j < 8; ++j) y[j] = 0.f;
#pragma unroll
            for (int w = 0; w < 4; ++w) {
                float f[8]; unpack8(xr[arr][w], f);
                const f32x4 c0 = *(const f32x4*)(cwL + w * 1536 + arr * 512 + lane * 8), c1 = *(const f32x4*)(cwL + w * 1536 + arr * 512 + lane * 8 + 4);
#pragma unroll
                for (int j = 0; j < 4; ++j) { y[j] += c0[j] * f[j]; y[4 + j] += c1[j] * f[4 + j]; }
            }
            float ss = 0.f;
#pragma unroll
            for (int j = 0; j < 8; ++j) { y[j] = siluf_(y[j]); ss += y[j] * y[j]; }
            if (arr < 2) {
                float rr = rsqrtf(red16(ss) + 1e-6f);
                if (arr == 0) rr *= 0.08838834764831845f;
#pragma unroll
                for (int j = 0; j < 8; ++j) y[j] *= rr;
            }
            bf16_t* dst = (arr == 0) ? GQ : (arr == 1) ? GK : GV;
            *(u32x4*)(dst + (size_t)t * 512 + lane * 8) = (u32x4){pk2(y[0], y[1]), pk2(y[2], y[3]), pk2(y[4], y[5]), pk2(y[6], y[7])};
        }
        if (lane < 4) BETA[(size_t)t * 4 + lane] = sigmoidf_(GATES[(size_t)t * 8 + lane]);
        else if (lane < 8) { const int h = lane - 4; GLOG[(size_t)t * 4 + h] = -expf(a_log[h]) * softplusf_(GATES[(size_t)t * 8 + lane] + dt_bias[h]); }
    }
}

__device__ __forceinline__ void phase_prep_odd(const bf16_t* PROJ, const float* ROPES, bf16_t* SQ, bf16_t* SK, const Ctx& c) {
    const int lane = c.lane;
    for (int t = c.bid * 4 + c.wid; t < T; t += c.nblk * 4) {
        const bf16_t* pr = PROJ + (size_t)t * NPAD;
        const int i = lane & 31;
        const float cs = ROPES[((size_t)t * 32 + i) * 2], sn = ROPES[((size_t)t * 32 + i) * 2 + 1];
#pragma unroll
        for (int r = 0; r < 4; ++r) {
            const int h = (lane >> 5) + 2 * r;
            const float x1 = bf2f(pr[1544 + h * 64 + i]), x2 = bf2f(pr[1544 + h * 64 + 32 + i]);
            SQ[(size_t)t * 512 + h * 64 + i] = (bf16_t)f2bf((x1 * cs - x2 * sn) * 0.18033688011112042f);
            SQ[(size_t)t * 512 + h * 64 + 32 + i] = (bf16_t)f2bf((x2 * cs + x1 * sn) * 0.18033688011112042f);
        }
        {
            const int h = lane >> 5;
            const float x1 = bf2f(pr[2056 + h * 64 + i]), x2 = bf2f(pr[2056 + h * 64 + 32 + i]);
            SK[(size_t)t * 128 + h * 64 + i] = (bf16_t)f2bf(x1 * cs - x2 * sn);
            SK[(size_t)t * 128 + h * 64 + 32 + i] = (bf16_t)f2bf(x2 * cs + x1 * sn);
        }
    }
}

__device__ __forceinline__ int next_unit(unsigned* ctr, const Ctx& c) {
    volatile int* su = (volatile int*)(c.smem0 + LDS_BLK + 16);
    __syncthreads();
    if (c.tid0 == 0) *su = (int)atomicAdd(ctr, 1u);
    __syncthreads();
    return *su * 2 + c.half;
}

typedef float f32x16 __attribute__((ext_vector_type(16)));
typedef short s16x4 __attribute__((ext_vector_type(4)));
#define MFMA32(a, b, c) __builtin_amdgcn_mfma_f32_32x32x16_bf16((a), (b), (c), 0, 0, 0)
template <int S_> __device__ __forceinline__ bf16x8 pack_step(const f32x16& x) {
    u32x4 p;
    asm volatile("v_cvt_pk_bf16_f32 %0, %4, %5\n\tv_cvt_pk_bf16_f32 %1, %6, %7\n\tv_cvt_pk_bf16_f32 %2, %8, %9\n\tv_cvt_pk_bf16_f32 %3, %10, %11\n\ts_nop 1"
                 : "=&v"(p[0]), "=&v"(p[1]), "=&v"(p[2]), "=&v"(p[3])
                 : "v"(x[8 * S_]), "v"(x[8 * S_ + 1]), "v"(x[8 * S_ + 2]), "v"(x[8 * S_ + 3]), "v"(x[8 * S_ + 4]), "v"(x[8 * S_ + 5]), "v"(x[8 * S_ + 6]), "v"(x[8 * S_ + 7]));
    return __builtin_bit_cast(bf16x8, p);
}
template <int S_> __device__ __forceinline__ bf16x8 pack_step_m(const f32x16& x) {
    u32x4 p;
    asm volatile("s_nop 15\n\tv_cvt_pk_bf16_f32 %0, %4, %5\n\tv_cvt_pk_bf16_f32 %1, %6, %7\n\tv_cvt_pk_bf16_f32 %2, %8, %9\n\tv_cvt_pk_bf16_f32 %3, %10, %11\n\ts_nop 1"
                 : "=&v"(p[0]), "=&v"(p[1]), "=&v"(p[2]), "=&v"(p[3])
                 : "v"(x[8 * S_]), "v"(x[8 * S_ + 1]), "v"(x[8 * S_ + 2]), "v"(x[8 * S_ + 3]), "v"(x[8 * S_ + 4]), "v"(x[8 * S_ + 5]), "v"(x[8 * S_ + 6]), "v"(x[8 * S_ + 7]));
    return __builtin_bit_cast(bf16x8, p);
}
constexpr int ATT_VB = 64 * 128;

template <int NKS, bool WIN>
__device__ __forceinline__ void attn_unit(const bf16_t* Qp, int q_ld, const bf16_t* K1, int k1_ld, const bf16_t* K2, int k2_ld, const bf16_t* Vp, int v_ld,
                          bf16_t* Op, int o_ld, int Q0, float sink_l2, const Ctx& c) {
    constexpr int KB = NKS * 2 * 1024, BUF = KB + ATT_VB;
    const int lane = c.lane, r = lane & 31, h = lane >> 5;
    const int wid = __builtin_amdgcn_readfirstlane(c.wid);
    const int q0w = Q0 + wid * 32;
    unsigned char* smem = c.smem;
    bf16x8 qf[NKS];
#pragma unroll
    for (int ks = 0; ks < NKS; ++ks) qf[ks] = *(const bf16x8*)(Qp + (size_t)(q0w + r) * q_ld + ks * 16 + h * 8);
    f32x16 o0, o1;
#pragma unroll
    for (int i = 0; i < 16; ++i) { o0[i] = 0.f; o1[i] = 0.f; }
    float m = WIN ? sink_l2 : -1e30f, l = (WIN && h == 0) ? 1.f : 0.f;
    const int kt_lo = WIN ? ((Q0 >> 6) - 2 < 0 ? 0 : (Q0 >> 6) - 2) : 0, kt_hi = (Q0 >> 6) + 1;
#define ATT_STAGE(kt_, buf_) do { unsigned char* bp = smem + (buf_) * BUF; const size_t kb = (size_t)(kt_) * 64; \
        _Pragma("unroll") for (int i = 0; i < (NKS * 2) / 4; ++i) { const int ch = wid + 4 * i; \
            const bf16_t* sp = (ch < 8) ? (K1 + (kb + lane) * k1_ld + ch * 8) : (K2 + (kb + lane) * k2_ld + (ch - 8) * 8); \
            glds16(sp, bp + ch * 1024 + lane * 16); } \
        _Pragma("unroll") for (int i = 0; i < 2; ++i) { const int j = wid + 4 * i; \
            glds16(Vp + (kb + 8 * j + (lane >> 3)) * v_ld + (lane & 7) * 8, bp + KB + j * 1024 + lane * 16); } } while (0)
    ATT_STAGE(kt_lo, 0);
    const int i16 = lane & 15;
    const unsigned vlane = (unsigned)((4 * h + (i16 >> 2)) * 128 + 32 * ((lane >> 4) & 1) + 8 * (i16 & 3));
    for (int kt = kt_lo; kt <= kt_hi; ++kt) {
        const int cur = (kt - kt_lo) & 1;
        asm volatile("s_waitcnt vmcnt(0)" ::: "memory");
        __syncthreads();
        if (kt < kt_hi) ATT_STAGE(kt + 1, cur ^ 1);
        const int k0 = kt * 64;
        const bool active = (k0 <= q0w + 31) && (!WIN || (k0 + 63 > q0w - 128));
        if (active) {
            const unsigned char* Kt = smem + cur * BUF;
            f32x16 x0, x1;
#pragma unroll
            for (int i = 0; i < 16; ++i) { x0[i] = 0.f; x1[i] = 0.f; }
#pragma unroll
            for (int ks = 0; ks < NKS; ++ks) {
                const bf16x8 kf0 = *(const bf16x8*)(Kt + (ks * 2 + h) * 1024 + r * 16);
                const bf16x8 kf1 = *(const bf16x8*)(Kt + (ks * 2 + h) * 1024 + (32 + r) * 16);
                x0 = MFMA32(kf0, qf[ks], x0); x1 = MFMA32(kf1, qf[ks], x1);
            }
            const bool need_mask = (k0 + 63 > q0w) || (WIN && (k0 <= q0w + 31 - 128));
            if (need_mask) {
                const int q = q0w + r;
#pragma unroll
                for (int i = 0; i < 16; ++i) {
                    const int key = k0 + (i & 3) + 8 * (i >> 2) + 4 * h;
                    const bool v0 = (key <= q) && (!WIN || key > q - 128);
                    const bool v1 = (key + 32 <= q) && (!WIN || key + 32 > q - 128);
                    x0[i] = v0 ? x0[i] : -INFINITY; x1[i] = v1 ? x1[i] : -INFINITY;
                }
            }
            float mx = fmaxf(x0[0], x1[0]);
#pragma unroll
            for (int i = 1; i < 16; ++i) mx = fmaxf(mx, fmaxf(x0[i], x1[i]));
            mx = fmaxf(mx, __shfl_xor(mx, 32));
            const float mn = fmaxf(m, mx);
            const float alpha = __builtin_amdgcn_exp2f(m - mn);
            m = mn;
            float ps = 0.f;
#pragma unroll
            for (int i = 0; i < 16; ++i) { x0[i] = __builtin_amdgcn_exp2f(x0[i] - mn); x1[i] = __builtin_amdgcn_exp2f(x1[i] - mn); ps += x0[i] + x1[i]; }
            l = l * alpha + ps;
            o0 *= alpha; o1 *= alpha;
            const unsigned vbase = (unsigned)(size_t)(smem + cur * BUF + KB) + vlane;
#pragma unroll
            for (int t = 0; t < 2; ++t) {
                s16x4 l00, h00, l01, h01, l10, h10, l11, h11;
                const unsigned va = vbase + t * 4096;
                asm volatile("ds_read_b64_tr_b16 %0, %8\n\t"
                             "ds_read_b64_tr_b16 %1, %8 offset:1024\n\t"
                             "ds_read_b64_tr_b16 %2, %8 offset:64\n\t"
                             "ds_read_b64_tr_b16 %3, %8 offset:1088\n\t"
                             "ds_read_b64_tr_b16 %4, %8 offset:2048\n\t"
                             "ds_read_b64_tr_b16 %5, %8 offset:3072\n\t"
                             "ds_read_b64_tr_b16 %6, %8 offset:2112\n\t"
                             "ds_read_b64_tr_b16 %7, %8 offset:3136\n\t"
                             "s_waitcnt lgkmcnt(0)"
                             : "=&v"(l00), "=&v"(h00), "=&v"(l01), "=&v"(h01), "=&v"(l10), "=&v"(h10), "=&v"(l11), "=&v"(h11) : "v"(va) : "memory");
                const bf16x8 v00 = __builtin_shufflevector(l00, h00, 0, 1, 2, 3, 4, 5, 6, 7), v01 = __builtin_shufflevector(l01, h01, 0, 1, 2, 3, 4, 5, 6, 7);
                const bf16x8 v10 = __builtin_shufflevector(l10, h10, 0, 1, 2, 3, 4, 5, 6, 7), v11 = __builtin_shufflevector(l11, h11, 0, 1, 2, 3, 4, 5, 6, 7);
                const bf16x8 pb0 = (t == 0) ? pack_step<0>(x0) : pack_step<0>(x1);
                const bf16x8 pb1 = (t == 0) ? pack_step<1>(x0) : pack_step<1>(x1);
                o0 = MFMA32(v00, pb0, o0); o1 = MFMA32(v01, pb0, o1);
                o0 = MFMA32(v10, pb1, o0); o1 = MFMA32(v11, pb1, o1);
            }
        }
    }
#undef ATT_STAGE
    l += __shfl_xor(l, 32);
    const float inv = 1.f / l;
    bf16_t* orow = Op + (size_t)(q0w + r) * o_ld + 4 * h;
#pragma unroll
    for (int g = 0; g < 4; ++g) {
        *(u32x2*)(orow + 8 * g) = (u32x2){pk2(o0[4 * g] * inv, o0[4 * g + 1] * inv), pk2(o0[4 * g + 2] * inv, o0[4 * g + 3] * inv)};
        *(u32x2*)(orow + 32 + 8 * g) = (u32x2){pk2(o1[4 * g] * inv, o1[4 * g + 1] * inv), pk2(o1[4 * g + 2] * inv, o1[4 * g + 3] * inv)};
    }
}

constexpr size_t MLC_DC = 0, MLC_CS = 33554432, MLC_DN = MLC_CS + 16777216, MLC_NS = MLC_DN + 262144, MLC_ML = MLC_NS + 262144, MLC_BE = MLC_ML + 4096, MLC_MS = MLC_BE + 4096;

__device__ __forceinline__ float scan_add64(float v, int lane) {
#pragma unroll
    for (int o = 1; o < 64; o <<= 1) { const float x = __shfl_up(v, o); if (lane >= o) v += x; }
    return v;
}
__device__ __forceinline__ float scan_max64(float v, int lane) {
#pragma unroll
    for (int o = 1; o < 64; o <<= 1) { const float x = __shfl_up(v, o); if (lane >= o) v = fmaxf(v, x); }
    return v;
}
__device__ __forceinline__ float wave_max(float v) {
#pragma unroll
    for (int o = 32; o > 0; o >>= 1) v = fmaxf(v, __shfl_xor(v, o));
    return v;
}

__device__ __forceinline__ void mlc_passA(int u, const bf16_t* PROJ, const float* GATES, const float* b_i, const float* b_f, unsigned char* YB, const Ctx& c) {
    const int bh = u >> 5, b = bh >> 2, h = bh & 3;
    const size_t t0 = (size_t)b * SEQ + (u & 31) * 64;
    unsigned char* smem = c.smem;
    float* saL = (float*)(smem + 24576);
    const int lane = c.lane, wid = __builtin_amdgcn_readfirstlane(c.wid);
#pragma unroll
    for (int i = 0; i < 4; ++i) { const int j = wid * 4 + i;
        glds16(PROJ + (t0 + 4 * j + (lane >> 4)) * NPAD + 512 + h * 128 + (lane & 15) * 8, smem + 8192 + j * 1024 + lane * 16); }
    if (wid == 0) {
        const float ip = GATES[(t0 + lane) * 8 + h] + b_i[h], lf = -softplusf_(-(GATES[(t0 + lane) * 8 + 4 + h] + b_f[h]));
        const float bc = scan_add64(lf, lane), bend = __shfl(bc, 63);
        const float a = bend - bc + ip, mloc = wave_max(a);
        saL[lane] = expf(a - mloc) * 0.125f;
        if (lane == 0) { ((float*)(YB + MLC_ML))[u] = mloc; ((float*)(YB + MLC_BE))[u] = bend; }
    }
    __syncthreads();
#pragma unroll
    for (int i = 0; i < 2; ++i) {
        const int idx = c.tid + 256 * i, row = idx >> 3, chk = idx & 7;
        const u32x4 r = *(const u32x4*)(PROJ + (t0 + row) * NPAD + 256 + h * 64 + chk * 8);
        float f[8]; unpack8(r, f);
        const float s = saL[row];
        *(u32x4*)(smem + row * 128 + chk * 16) = (u32x4){pk2(f[0] * s, f[1] * s), pk2(f[2] * s, f[3] * s), pk2(f[4] * s, f[5] * s), pk2(f[6] * s, f[7] * s)};
    }
    asm volatile("s_waitcnt vmcnt(0)" ::: "memory");
    __syncthreads();
    const int h5 = lane >> 5, r = lane & 31, i16 = lane & 15, q4 = i16 >> 2, p = i16 & 3, blk = (lane >> 4) & 1;
    const int dkt = wid & 1, dvp = wid >> 1;
    const unsigned kaddr = (unsigned)(size_t)smem + (unsigned)((8 * h5 + q4) * 128 + dkt * 64 + 32 * blk + 8 * p);
    const unsigned vaddr = (unsigned)(size_t)smem + 8192u + (unsigned)((8 * h5 + q4) * 256 + dvp * 128 + 32 * blk + 8 * p);
    f32x16 a0, a1;
#pragma unroll
    for (int i = 0; i < 16; ++i) { a0[i] = 0.f; a1[i] = 0.f; }
#pragma unroll
    for (int st = 0; st < 4; ++st) {
        s16x4 kl, kh, v0l, v0h, v1l, v1h;
        const unsigned ka = kaddr + st * 2048, va = vaddr + st * 4096;
        asm volatile("ds_read_b64_tr_b16 %0, %6\n\t"
                     "ds_read_b64_tr_b16 %1, %6 offset:512\n\t"
                     "ds_read_b64_tr_b16 %2, %7\n\t"
                     "ds_read_b64_tr_b16 %3, %7 offset:1024\n\t"
                     "ds_read_b64_tr_b16 %4, %7 offset:64\n\t"
                     "ds_read_b64_tr_b16 %5, %7 offset:1088\n\t"
                     "s_waitcnt lgkmcnt(0)"
                     : "=&v"(kl), "=&v"(kh), "=&v"(v0l), "=&v"(v0h), "=&v"(v1l), "=&v"(v1h) : "v"(ka), "v"(va) : "memory");
        const bf16x8 kf = __builtin_shufflevector(kl, kh, 0, 1, 2, 3, 4, 5, 6, 7);
        const bf16x8 vf0 = __builtin_shufflevector(v0l, v0h, 0, 1, 2, 3, 4, 5, 6, 7), vf1 = __builtin_shufflevector(v1l, v1h, 0, 1, 2, 3, 4, 5, 6, 7);
        a0 = MFMA32(kf, vf0, a0); a1 = MFMA32(kf, vf1, a1);
    }
    float* DC = (float*)(YB + MLC_DC) + (size_t)u * 8192;
#pragma unroll
    for (int i = 0; i < 16; ++i) {
        const int dk = dkt * 32 + (i & 3) + 8 * (i >> 2) + 4 * h5;
        DC[dk * 128 + dvp * 64 + r] = a0[i]; DC[dk * 128 + dvp * 64 + 32 + r] = a1[i];
    }
    if (c.tid < 64) {
        float s = 0.f;
#pragma unroll 8
        for (int t = 0; t < 64; ++t) s += bf2f(((const bf16_t*)smem)[t * 64 + c.tid]);
        ((float*)(YB + MLC_DN))[(size_t)u * 64 + c.tid] = s;
    }
}

__device__ __forceinline__ void mlc_passB(int u, unsigned char* YB, const Ctx& c) {
    const int bh = u >> 3, sl = u & 7;
    const float* ML = (const float*)(YB + MLC_ML) + bh * 32; const float* BE = (const float*)(YB + MLC_BE) + bh * 32;
    const float* DC = (const float*)(YB + MLC_DC) + (size_t)bh * 32 * 8192 + sl * 1024 + c.tid * 4;
    bf16_t* CS = (bf16_t*)(YB + MLC_CS) + (size_t)bh * 32 * 8192 + sl * 1024 + c.tid * 4;
    const float* DN = (const float*)(YB + MLC_DN) + (size_t)bh * 32 * 64; float* NS = (float*)(YB + MLC_NS) + (size_t)bh * 32 * 64; float* MS = (float*)(YB + MLC_MS) + bh * 32;
    f32x4 C4 = (f32x4){0.f, 0.f, 0.f, 0.f}; float nv = 0.f, m = 0.f;
    const bool do_n = (sl == 0) && (c.tid < 64);
#pragma unroll 4
    for (int n = 0; n < 32; ++n) {
        *(u32x2*)(CS + (size_t)n * 8192) = (u32x2){pk2(C4[0], C4[1]), pk2(C4[2], C4[3])};
        if (do_n) NS[n * 64 + c.tid] = nv;
        if (sl == 0 && c.tid == 0) MS[n] = m;
        const float be = BE[n], ml = ML[n];
        const float mn = fmaxf(be + m, ml), keep = expf(be + m - mn), g = expf(ml - mn);
        m = mn;
        const f32x4 d = *(const f32x4*)(DC + (size_t)n * 8192);
        C4 = C4 * keep + d * g;
        if (do_n) nv = nv * keep + DN[n * 64 + c.tid] * g;
    }
}

__device__ __forceinline__ void mlc_passC(int u, const bf16_t* PROJ, const float* GATES, const float* b_i, const float* b_f, const unsigned char* YB,
                                          const float* gain  , bf16_t* MIXO, const Ctx& c) {
    const int bh = u >> 5, b = bh >> 2, h = bh & 3;
    const size_t t0 = (size_t)b * SEQ + (u & 31) * 64;
    unsigned char* smem = c.smem;
    float* csL = (float*)(smem + 32768); float* pmL = (float*)(smem + 33024); float* bcL = (float*)(smem + 33280); float* nnL = (float*)(smem + 33536); float* sqL = (float*)(smem + 33792);
    const int lane = c.lane, wid = __builtin_amdgcn_readfirstlane(c.wid);
    const bf16_t* CS = (const bf16_t*)(YB + MLC_CS) + (size_t)u * 8192;
#pragma unroll
    for (int i = 0; i < 4; ++i) { const int j = wid * 4 + i;
        glds16(PROJ + (t0 + 4 * j + (lane >> 4)) * NPAD + 512 + h * 128 + (lane & 15) * 8, smem + j * 1024 + lane * 16);
        glds16(CS + (4 * j + (lane >> 4)) * 128 + (lane & 15) * 8, smem + 16384 + j * 1024 + lane * 16); }
    float bcl = 0.f;
    if (wid == 0) {
        const float ip = GATES[(t0 + lane) * 8 + h] + b_i[h], lf = -softplusf_(-(GATES[(t0 + lane) * 8 + 4 + h] + b_f[h]));
        bcl = scan_add64(lf, lane);
        const float cs = ip - bcl;
        csL[lane] = cs; pmL[lane] = scan_max64(cs, lane);
        nnL[lane] = ((const float*)(YB + MLC_NS))[(size_t)u * 64 + lane];
        bcL[lane] = bcl;
    }
    asm volatile("s_waitcnt vmcnt(0)" ::: "memory");
    __syncthreads();
    const int h5 = lane >> 5, r = lane & 31, i16 = lane & 15, q4 = i16 >> 2, p = i16 & 3, blk = (lane >> 4) & 1;
    const int th = wid & 1, dvh = wid >> 1;
    const int t = th * 32 + r;
    const float m_n = ((const float*)(YB + MLC_MS))[u];
    const float Mt = fmaxf(m_n, pmL[t]), w_inter = __expf(m_n - Mt), em = __expf(-(bcL[t] + Mt));
    bf16x8 qf[4];
#pragma unroll
    for (int ks = 0; ks < 4; ++ks) qf[ks] = *(const bf16x8*)(PROJ + (t0 + t) * NPAD + h * 64 + ks * 16 + h5 * 8);
    float qn = 0.f; bf16x8 qw[4];
#pragma unroll
    for (int ks = 0; ks < 4; ++ks) {
        const u32x4 raw = __builtin_bit_cast(u32x4, qf[ks]); float f[8]; unpack8(raw, f);
#pragma unroll
        for (int j = 0; j < 8; ++j) qn += f[j] * nnL[ks * 16 + h5 * 8 + j];
        qw[ks] = __builtin_bit_cast(bf16x8, (u32x4){pk2(f[0] * w_inter, f[1] * w_inter), pk2(f[2] * w_inter, f[3] * w_inter), pk2(f[4] * w_inter, f[5] * w_inter), pk2(f[6] * w_inter, f[7] * w_inter)});
    }
    qn += __shfl_xor(qn, 32);
    f32x16 x0, x1;
#pragma unroll
    for (int i = 0; i < 16; ++i) { x0[i] = 0.f; x1[i] = 0.f; }
#pragma unroll
    for (int ks = 0; ks < 4; ++ks) {
        const bf16x8 kf0 = *(const bf16x8*)(PROJ + (t0 + r) * NPAD + 256 + h * 64 + ks * 16 + h5 * 8);
        x0 = MFMA32(kf0, qf[ks], x0);
        if (th) { const bf16x8 kf1 = *(const bf16x8*)(PROJ + (t0 + 32 + r) * NPAD + 256 + h * 64 + ks * 16 + h5 * 8); x1 = MFMA32(kf1, qf[ks], x1); }
    }
    float ps = 0.f;
#pragma unroll
    for (int i = 0; i < 16; ++i) {
        const int s = (i & 3) + 8 * (i >> 2) + 4 * h5;
        const float w0 = (s <= t) ? __expf(csL[s] - Mt) * 0.125f : 0.f;
        x0[i] *= w0; ps += x0[i];
        if (th) { const float w1 = (s <= r) ? __expf(csL[32 + s] - Mt) * 0.125f : 0.f; x1[i] *= w1; ps += x1[i]; }
    }
    ps += __shfl_xor(ps, 32);
    const float den = w_inter * qn + ps;
    f32x16 o0, o1;
#pragma unroll
    for (int i = 0; i < 16; ++i) { o0[i] = 0.f; o1[i] = 0.f; }
    {
        const unsigned vb = (unsigned)(size_t)smem + (unsigned)((4 * h5 + q4) * 256 + dvh * 128 + 32 * blk + 8 * p);
#pragma unroll
        for (int st = 0; st < 2; ++st) {
            if (st == 0 || th) {
                s16x4 l00, h00, l01, h01, l10, h10, l11, h11;
                const unsigned va = vb + st * 8192;
                asm volatile("ds_read_b64_tr_b16 %0, %8\n\t"
                             "ds_read_b64_tr_b16 %1, %8 offset:2048\n\t"
                             "ds_read_b64_tr_b16 %2, %8 offset:64\n\t"
                             "ds_read_b64_tr_b16 %3, %8 offset:2112\n\t"
                             "ds_read_b64_tr_b16 %4, %8 offset:4096\n\t"
                             "ds_read_b64_tr_b16 %5, %8 offset:6144\n\t"
                             "ds_read_b64_tr_b16 %6, %8 offset:4160\n\t"
                             "ds_read_b64_tr_b16 %7, %8 offset:6208\n\t"
                             "s_waitcnt lgkmcnt(0)"
                             : "=&v"(l00), "=&v"(h00), "=&v"(l01), "=&v"(h01), "=&v"(l10), "=&v"(h10), "=&v"(l11), "=&v"(h11) : "v"(va) : "memory");
                const bf16x8 v00 = __builtin_shufflevector(l00, h00, 0, 1, 2, 3, 4, 5, 6, 7), v01 = __builtin_shufflevector(l01, h01, 0, 1, 2, 3, 4, 5, 6, 7);
                const bf16x8 v10 = __builtin_shufflevector(l10, h10, 0, 1, 2, 3, 4, 5, 6, 7), v11 = __builtin_shufflevector(l11, h11, 0, 1, 2, 3, 4, 5, 6, 7);
                const bf16x8 pb0 = (st == 0) ? pack_step<0>(x0) : pack_step<0>(x1);
                const bf16x8 pb1 = (st == 0) ? pack_step<1>(x0) : pack_step<1>(x1);
                o0 = MFMA32(v00, pb0, o0); o1 = MFMA32(v01, pb0, o1);
                o0 = MFMA32(v10, pb1, o0); o1 = MFMA32(v11, pb1, o1);
            }
        }
    }
    {
        const unsigned cb = (unsigned)(size_t)smem + 16384u + (unsigned)((8 * h5 + q4) * 256 + dvh * 128 + 32 * blk + 8 * p);
#pragma unroll
        for (int kp = 0; kp < 2; ++kp) {
            s16x4 l00, h00, l01, h01, l10, h10, l11, h11;
            const unsigned ca = cb + kp * 8192;
            asm volatile("ds_read_b64_tr_b16 %0, %8\n\t"
                         "ds_read_b64_tr_b16 %1, %8 offset:1024\n\t"
                         "ds_read_b64_tr_b16 %2, %8 offset:64\n\t"
                         "ds_read_b64_tr_b16 %3, %8 offset:1088\n\t"
                         "ds_read_b64_tr_b16 %4, %8 offset:4096\n\t"
                         "ds_read_b64_tr_b16 %5, %8 offset:5120\n\t"
                         "ds_read_b64_tr_b16 %6, %8 offset:4160\n\t"
                         "ds_read_b64_tr_b16 %7, %8 offset:5184\n\t"
                         "s_waitcnt lgkmcnt(0)"
                         : "=&v"(l00), "=&v"(h00), "=&v"(l01), "=&v"(h01), "=&v"(l10), "=&v"(h10), "=&v"(l11), "=&v"(h11) : "v"(ca) : "memory");
            const bf16x8 c00 = __builtin_shufflevector(l00, h00, 0, 1, 2, 3, 4, 5, 6, 7), c01 = __builtin_shufflevector(l01, h01, 0, 1, 2, 3, 4, 5, 6, 7);
            const bf16x8 c10 = __builtin_shufflevector(l10, h10, 0, 1, 2, 3, 4, 5, 6, 7), c11 = __builtin_shufflevector(l11, h11, 0, 1, 2, 3, 4, 5, 6, 7);
            o0 = MFMA32(c00, qw[2 * kp], o0); o1 = MFMA32(c01, qw[2 * kp], o1);
            o0 = MFMA32(c10, qw[2 * kp + 1], o0); o1 = MFMA32(c11, qw[2 * kp + 1], o1);
        }
    }
    const float inv = __builtin_amdgcn_rcpf(fmaxf(fabsf(den), em));
    float ss = 0.f;
#pragma unroll
    for (int i = 0; i < 16; ++i) { o0[i] *= inv; o1[i] *= inv; ss += o0[i] * o0[i] + o1[i] * o1[i]; }
    ss += __shfl_xor(ss, 32);
    if (h5 == 0) sqL[wid * 32 + r] = ss;
    __syncthreads();
    const float rr = rsqrtf((sqL[th * 32 + r] + sqL[(th + 2) * 32 + r]) * (1.f / 128.f) + 1e-6f);
    const bf16_t* grow = PROJ + (t0 + t) * NPAD + 1032 + h * 128 + dvh * 64 + 4 * h5;
    const float* gn = gain + h * 128 + dvh * 64 + 4 * h5;
    bf16_t* orow = MIXO + (t0 + t) * 1024 + h * 128 + dvh * 64 + 4 * h5;
#pragma unroll
    for (int d = 0; d < 2; ++d)
#pragma unroll
        for (int g = 0; g < 4; ++g) {
            const u32x2 zr = *(const u32x2*)(grow + d * 32 + 8 * g);
            const f32x4 gv = *(const f32x4*)(gn + d * 32 + 8 * g);
            const float z0 = bflo(zr.x), z1 = bfhi(zr.x), z2 = bflo(zr.y), z3 = bfhi(zr.y);
            const float y0 = (d ? o1[4 * g] : o0[4 * g]) * rr * gv[0] * sigmoidf_(z0), y1 = (d ? o1[4 * g + 1] : o0[4 * g + 1]) * rr * gv[1] * sigmoidf_(z1);
            const float y2 = (d ? o1[4 * g + 2] : o0[4 * g + 2]) * rr * gv[2] * sigmoidf_(z2), y3 = (d ? o1[4 * g + 3] : o0[4 * g + 3]) * rr * gv[3] * sigmoidf_(z3);
            *(u32x2*)(orow + d * 32 + 8 * g) = (u32x2){pk2(y0, y1), pk2(y2, y3)};
        }
}

constexpr size_t GD_WN = 0, GD_UU = GD_WN + (size_t)1024 * 16384, GD_KGT = GD_UU + (size_t)1024 * 16384, GD_QG = GD_KGT + (size_t)1024 * 16384,
                 GD_AT = GD_QG + (size_t)1024 * 16384, GD_GL = GD_AT + (size_t)1024 * 8192, GD_END = GD_GL + 4096;
static_assert(GD_END <= (size_t)MAXROWS * 256 * 2, "GDN chunk records must fit the HBUF region");

__device__ __forceinline__ void gdc_passA(int u, const bf16_t* GQ, const bf16_t* GK, const bf16_t* GV, const float* BETA, const float* GLOG, unsigned char* HB, const Ctx& c) {
    const int bh = u >> 5, b = bh >> 2, h = bh & 3;
    const size_t t0 = (size_t)b * SEQ + (u & 31) * 64;
    unsigned char* smem = c.smem;
    float* Lm = (float*)(smem + 49152);
    float* GA = (float*)(smem + 65536 + 64); float* BT = GA + 64; float* EG = BT + 64; float* EK = EG + 64;
    const int lane = c.lane, wid = __builtin_amdgcn_readfirstlane(c.wid);
    const int h5 = lane >> 5, r = lane & 31;
    if (wid == 0) {
        const float g = GLOG[(t0 + lane) * 4 + h];
        const float G = scan_add64(g, lane), Gl = __shfl(G, 63);
        GA[lane] = G; BT[lane] = BETA[(t0 + lane) * 4 + h]; EG[lane] = expf(G); EK[lane] = expf(Gl - G);
        if (lane == 0) ((float*)(HB + GD_GL))[u] = expf(Gl);
    }
    __syncthreads();
    if (wid < 3) {
        const int it = (wid + 1) >> 1, jt = wid >> 1;
        f32x16 dl, da;
#pragma unroll
        for (int i = 0; i < 16; ++i) { dl[i] = 0.f; da[i] = 0.f; }
#pragma unroll
        for (int ks = 0; ks < 8; ++ks) {
            const bf16x8 ki = *(const bf16x8*)(GK + (t0 + 32 * it + r) * 512 + h * 128 + ks * 16 + h5 * 8);
            const bf16x8 kj = *(const bf16x8*)(GK + (t0 + 32 * jt + r) * 512 + h * 128 + ks * 16 + h5 * 8);
            const bf16x8 qi = *(const bf16x8*)(GQ + (t0 + 32 * it + r) * 512 + h * 128 + ks * 16 + h5 * 8);
            dl = MFMA32(ki, kj, dl); da = MFMA32(qi, kj, da);
        }
        const int j = 32 * jt + r; const float Gj = GA[j];
        bf16_t* AT = (bf16_t*)(HB + GD_AT) + (size_t)u * 4096;
#pragma unroll
        for (int i = 0; i < 16; ++i) {
            const int ii = 32 * it + (i & 3) + 8 * (i >> 2) + 4 * h5;
            const float dec = __expf(GA[ii] - Gj);
            Lm[ii * 64 + j] = (j < ii) ? dl[i] * BT[ii] * dec : 0.f;
            AT[ii * 64 + j] = (bf16_t)f2bf((j <= ii) ? da[i] * dec : 0.f);
        }
        if (wid == 0) {
#pragma unroll
            for (int i = 0; i < 16; ++i) { const int ii = (i & 3) + 8 * (i >> 2) + 4 * h5; Lm[ii * 64 + 32 + r] = 0.f; AT[ii * 64 + 32 + r] = 0; }
        }
    }
    __syncthreads();
    if (wid == 0) {
        float Tc[64];
#pragma unroll
        for (int i = 0; i < 64; ++i) {
            float s = (i == lane) ? 1.f : 0.f;
#pragma unroll
            for (int k = 0; k < i; ++k) s -= Lm[i * 64 + k] * Tc[k];
            Tc[i] = s;
        }
        bf16_t* Tm = (bf16_t*)Lm;
#pragma unroll
        for (int i = 0; i < 64; ++i) Tm[i * 64 + lane] = (bf16_t)f2bf(Tc[i]);
    } else {
        const int t3 = c.tid - 64;
        for (int idx = t3; idx < 4096; idx += 192) {
            const int arr = idx >> 10, rem = idx & 1023, row = rem >> 4, chk = rem & 15;
            const bf16_t* sp = ((arr == 1) ? GV : (arr == 3) ? GQ : GK) + (t0 + row) * 512 + h * 128 + chk * 8;
            const u32x4 raw = *(const u32x4*)sp; float f[8]; unpack8(raw, f);
            const float sc = (arr == 0) ? BT[row] * EG[row] : (arr == 1) ? BT[row] : (arr == 2) ? EK[row] : EG[row];
            const u32x4 o = (u32x4){pk2(f[0] * sc, f[1] * sc), pk2(f[2] * sc, f[3] * sc), pk2(f[4] * sc, f[5] * sc), pk2(f[6] * sc, f[7] * sc)};
            if (arr < 3) *(u32x4*)(smem + arr * 16384 + row * 256 + chk * 16) = o;
            else *(u32x4*)((bf16_t*)(HB + GD_QG) + (size_t)u * 8192 + row * 128 + chk * 8) = o;
        }
    }
    __syncthreads();
    {
        const int i16 = lane & 15, q4 = i16 >> 2, p = i16 & 3, blk = (lane >> 4) & 1;
        const unsigned char* Tm = smem + 49152;
        f32x16 u0, u1, w0, w1;
#pragma unroll
        for (int i = 0; i < 16; ++i) { u0[i] = 0.f; u1[i] = 0.f; w0[i] = 0.f; w1[i] = 0.f; }
        const unsigned ib = (unsigned)(size_t)smem + (unsigned)((8 * h5 + q4) * 256 + wid * 64 + 32 * blk + 8 * p);
#pragma unroll
        for (int ks = 0; ks < 4; ++ks) {
            s16x4 kl, kh, vl, vh;
            const unsigned ia = ib + ks * 4096;
            asm volatile("ds_read_b64_tr_b16 %0, %4\n\t"
                         "ds_read_b64_tr_b16 %1, %4 offset:1024\n\t"
                         "ds_read_b64_tr_b16 %2, %4 offset:16384\n\t"
                         "ds_read_b64_tr_b16 %3, %4 offset:17408\n\t"
                         "s_waitcnt lgkmcnt(0)"
                         : "=&v"(kl), "=&v"(kh), "=&v"(vl), "=&v"(vh) : "v"(ia) : "memory");
            const bf16x8 kb = __builtin_shufflevector(kl, kh, 0, 1, 2, 3, 4, 5, 6, 7), vb = __builtin_shufflevector(vl, vh, 0, 1, 2, 3, 4, 5, 6, 7);
            const bf16x8 t1 = *(const bf16x8*)(Tm + (32 + r) * 128 + ks * 32 + h5 * 16);
            w1 = MFMA32(t1, kb, w1); u1 = MFMA32(t1, vb, u1);
            if (ks < 2) { const bf16x8 tt0 = *(const bf16x8*)(Tm + r * 128 + ks * 32 + h5 * 16); w0 = MFMA32(tt0, kb, w0); u0 = MFMA32(tt0, vb, u0); }
        }
        bf16_t* WN = (bf16_t*)(HB + GD_WN) + (size_t)u * 8192; bf16_t* UU = (bf16_t*)(HB + GD_UU) + (size_t)u * 8192;
#pragma unroll
        for (int i = 0; i < 16; ++i) {
            const int s = (i & 3) + 8 * (i >> 2) + 4 * h5;
            WN[s * 128 + wid * 32 + r] = (bf16_t)f2bf(-w0[i]); WN[(32 + s) * 128 + wid * 32 + r] = (bf16_t)f2bf(-w1[i]);
        }
        {
            u32x4* up = (u32x4*)(UU + (size_t)(wid * 64 + lane) * 32);
            up[0] = (u32x4){pk2(u0[0], u0[1]), pk2(u0[2], u0[3]), pk2(u0[4], u0[5]), pk2(u0[6], u0[7])};
            up[1] = (u32x4){pk2(u0[8], u0[9]), pk2(u0[10], u0[11]), pk2(u0[12], u0[13]), pk2(u0[14], u0[15])};
            up[2] = (u32x4){pk2(u1[0], u1[1]), pk2(u1[2], u1[3]), pk2(u1[4], u1[5]), pk2(u1[6], u1[7])};
            up[3] = (u32x4){pk2(u1[8], u1[9]), pk2(u1[10], u1[11]), pk2(u1[12], u1[13]), pk2(u1[14], u1[15])};
        }
        bf16_t* KGT = (bf16_t*)(HB + GD_KGT) + (size_t)u * 8192;
        const int gq = lane >> 4;
        const unsigned kb0 = (unsigned)(size_t)smem + 32768u + (unsigned)(q4 * 256 + gq * 32 + 8 * p);
#pragma unroll
        for (int it2 = 0; it2 < 8; ++it2) {
            const int job = wid * 8 + it2, s0 = (job & 15) * 4, dkb = (job >> 4) * 64;
            s16x4 v;
            const unsigned ad = kb0 + s0 * 256 + dkb * 2;
            asm volatile("ds_read_b64_tr_b16 %0, %1\n\ts_waitcnt lgkmcnt(0)" : "=&v"(v) : "v"(ad) : "memory");
            *(s16x4*)(KGT + (size_t)(dkb + gq * 16 + i16) * 64 + s0) = v;
        }
    }
}

constexpr size_t GC_ST = 0, GC_VT = (size_t)1024 * 32768;
__device__ __forceinline__ void gdc_passB(int bh, const unsigned char* HB, unsigned char* YB, const Ctx& c) {
    const int lane = c.lane, wid = __builtin_amdgcn_readfirstlane(c.wid);
    const int h5 = lane >> 5, r = lane & 31;
    unsigned char* smem = c.smem;
    f32x16 S0, S1, S2, S3;
#pragma unroll
    for (int i = 0; i < 16; ++i) { S0[i] = 0.f; S1[i] = 0.f; S2[i] = 0.f; S3[i] = 0.f; }
    const size_t u0 = (size_t)bh * 32;
#define GB_STAGE(n_, p_) do { const bf16_t* wn_ = (const bf16_t*)(HB + GD_WN) + (u0 + (n_)) * 8192; const bf16_t* kg_ = (const bf16_t*)(HB + GD_KGT) + (u0 + (n_)) * 8192; \
        unsigned char* bp_ = smem + (p_) * 32768; \
        _Pragma("unroll") for (int i = 0; i < 4; ++i) { const int jj = wid * 4 + i, row = 4 * jj + (lane >> 4), ch = (lane & 15) ^ (row & 15); \
            glds16(wn_ + row * 128 + ch * 8, bp_ + jj * 1024 + lane * 16); } \
        _Pragma("unroll") for (int i = 0; i < 4; ++i) { const int jj = wid * 4 + i, row = 8 * jj + (lane >> 3), ch = (lane & 7) ^ ((row >> 1) & 7); \
            glds16(kg_ + row * 64 + ch * 8, bp_ + 16384 + jj * 1024 + lane * 16); } } while (0)
#define LD128(base_, R_, ks_) __builtin_shufflevector(*(const s16x4*)((base_) + (R_) * 256 + (((2 * (ks_)) ^ (rl & 15)) << 4) + 8 * hl), \
                                                      *(const s16x4*)((base_) + (R_) * 256 + (((2 * (ks_) + 1) ^ (rl & 15)) << 4) + 8 * hl), 0, 1, 2, 3, 4, 5, 6, 7)
#define LD64(base_, R_, k2_) __builtin_shufflevector(*(const s16x4*)((base_) + (R_) * 128 + (((2 * (k2_)) ^ ((rl >> 1) & 7)) << 4) + 8 * hl), \
                                                     *(const s16x4*)((base_) + (R_) * 128 + (((2 * (k2_) + 1) ^ ((rl >> 1) & 7)) << 4) + 8 * hl), 0, 1, 2, 3, 4, 5, 6, 7)
    u32x4 uu[4];
#define GB_LOADU(n_) do { const u32x4* up_ = (const u32x4*)((const bf16_t*)(HB + GD_UU) + (u0 + (n_)) * 8192 + (size_t)(wid * 64 + lane) * 32); \
        uu[0] = up_[0]; uu[1] = up_[1]; uu[2] = up_[2]; uu[3] = up_[3]; } while (0)
    __syncthreads();
    GB_STAGE(0, 0);
    GB_LOADU(0);
#pragma unroll 1
    for (int n2 = 0; n2 < 16; ++n2) {
#pragma unroll
        for (int PBUF = 0; PBUF < 2; ++PBUF) {
        const int n = 2 * n2 + PBUF;
        const float gl = ((const float*)(HB + GD_GL))[u0 + n];
        if (n == 0) asm volatile("s_waitcnt vmcnt(0)" ::: "memory"); else asm volatile("s_waitcnt vmcnt(24)" ::: "memory");
        asm volatile("s_waitcnt lgkmcnt(0)" ::: "memory"); __builtin_amdgcn_s_barrier(); asm volatile("" ::: "memory");
        f32x16 v0, v1;
#pragma unroll
        for (int q = 0; q < 2; ++q) {
            const u32x4 a = uu[q], bq = uu[2 + q];
            v0[8 * q + 0] = bflo(a.x); v0[8 * q + 1] = bfhi(a.x); v0[8 * q + 2] = bflo(a.y); v0[8 * q + 3] = bfhi(a.y);
            v0[8 * q + 4] = bflo(a.z); v0[8 * q + 5] = bfhi(a.z); v0[8 * q + 6] = bflo(a.w); v0[8 * q + 7] = bfhi(a.w);
            v1[8 * q + 0] = bflo(bq.x); v1[8 * q + 1] = bfhi(bq.x); v1[8 * q + 2] = bflo(bq.y); v1[8 * q + 3] = bfhi(bq.y);
            v1[8 * q + 4] = bflo(bq.z); v1[8 * q + 5] = bfhi(bq.z); v1[8 * q + 6] = bflo(bq.w); v1[8 * q + 7] = bfhi(bq.w);
        }
        if (n + 1 < 32) { GB_STAGE(n + 1, (PBUF ^ 1)); GB_LOADU(n + 1); }
        int rl = r, hl = h5; asm volatile("" : "+v"(rl), "+v"(hl));
        const unsigned char* WNb = smem + PBUF * 32768; const unsigned char* KGb = WNb + 16384;
        {
            bf16_t* st = (bf16_t*)(YB + GC_ST) + (u0 + n) * 16384 + (size_t)h5 * 512 + (size_t)(wid * 32 + r) * 4;
#define ST_TILE(SX, dt_) do { _Pragma("unroll") for (int g = 0; g < 4; ++g) \
                *(u32x2*)(st + ((dt_) * 8 + 2 * g) * 512) = (u32x2){cvt_pk(SX[4 * g], SX[4 * g + 1]), cvt_pk(SX[4 * g + 2], SX[4 * g + 3])}; } while (0)
            ST_TILE(S0, 0); ST_TILE(S1, 1); ST_TILE(S2, 2); ST_TILE(S3, 3);
#undef ST_TILE
        }
        {
            bf16x8 fa0, fb0, fa1, fb1, fa2, fb2;
#define LDV(FA, FB, ks_) do { FA = LD128(WNb, rl, ks_); FB = LD128(WNb, 32 + rl, ks_); } while (0)
#define MMV(SX, HF, FA, FB) do { const bf16x8 sbk = pack_step<HF>(SX); v0 = MFMA32(FA, sbk, v0); v1 = MFMA32(FB, sbk, v1); } while (0)
            LDV(fa0, fb0, 0); LDV(fa1, fb1, 1); LDV(fa2, fb2, 2);
            MMV(S0, 0, fa0, fb0); LDV(fa0, fb0, 3);
            MMV(S0, 1, fa1, fb1); LDV(fa1, fb1, 4);
            MMV(S1, 0, fa2, fb2); LDV(fa2, fb2, 5);
            MMV(S1, 1, fa0, fb0); LDV(fa0, fb0, 6);
            MMV(S2, 0, fa1, fb1); LDV(fa1, fb1, 7);
            MMV(S2, 1, fa2, fb2);
            MMV(S3, 0, fa0, fb0);
            MMV(S3, 1, fa1, fb1);
#undef LDV
#undef MMV
        }
        const bf16x8 vb0 = pack_step_m<0>(v0), vb1 = pack_step_m<1>(v0), vb2 = pack_step_m<0>(v1), vb3 = pack_step_m<1>(v1);
        {
            bf16_t* vt = (bf16_t*)(YB + GC_VT) + (u0 + n) * 8192 + (size_t)h5 * 512 + (size_t)(wid * 32 + r) * 4;
            const u32x4 p0 = __builtin_bit_cast(u32x4, vb0), p1 = __builtin_bit_cast(u32x4, vb1), p2 = __builtin_bit_cast(u32x4, vb2), p3 = __builtin_bit_cast(u32x4, vb3);
            *(u32x2*)(vt + 0 * 512) = (u32x2){p0.x, p0.y};  *(u32x2*)(vt + 2 * 512) = (u32x2){p0.z, p0.w};
            *(u32x2*)(vt + 4 * 512) = (u32x2){p1.x, p1.y};  *(u32x2*)(vt + 6 * 512) = (u32x2){p1.z, p1.w};
            *(u32x2*)(vt + 8 * 512) = (u32x2){p2.x, p2.y};  *(u32x2*)(vt + 10 * 512) = (u32x2){p2.z, p2.w};
            *(u32x2*)(vt + 12 * 512) = (u32x2){p3.x, p3.y}; *(u32x2*)(vt + 14 * 512) = (u32x2){p3.z, p3.w};
        }
        asm volatile("" ::: "memory"); asm volatile("" : "+v"(rl), "+v"(hl));
        S0 *= gl; S1 *= gl; S2 *= gl; S3 *= gl;
        {
            bf16x8 g0, g1, g2;
            g0 = LD64(KGb, rl, 0); g1 = LD64(KGb, rl, 1); g2 = LD64(KGb, rl, 2);
            S0 = MFMA32(g0, vb0, S0); g0 = LD64(KGb, rl, 3);
            S0 = MFMA32(g1, vb1, S0); g1 = LD64(KGb, 32 + rl, 0);
            S0 = MFMA32(g2, vb2, S0); g2 = LD64(KGb, 32 + rl, 1);
            S0 = MFMA32(g0, vb3, S0); g0 = LD64(KGb, 32 + rl, 2);
            S1 = MFMA32(g1, vb0, S1); g1 = LD64(KGb, 32 + rl, 3);
            S1 = MFMA32(g2, vb1, S1); g2 = LD64(KGb, 64 + rl, 0);
            S1 = MFMA32(g0, vb2, S1); g0 = LD64(KGb, 64 + rl, 1);
            S1 = MFMA32(g1, vb3, S1); g1 = LD64(KGb, 64 + rl, 2);
            S2 = MFMA32(g2, vb0, S2); g2 = LD64(KGb, 64 + rl, 3);
            S2 = MFMA32(g0, vb1, S2); g0 = LD64(KGb, 96 + rl, 0);
            S2 = MFMA32(g1, vb2, S2); g1 = LD64(KGb, 96 + rl, 1);
            S2 = MFMA32(g2, vb3, S2); g2 = LD64(KGb, 96 + rl, 2);
            S3 = MFMA32(g0, vb0, S3); g0 = LD64(KGb, 96 + rl, 3);
            S3 = MFMA32(g1, vb1, S3);
            S3 = MFMA32(g2, vb2, S3);
            S3 = MFMA32(g0, vb3, S3);
        }
        }
    }
#undef GB_STAGE
#undef LD128
#undef LD64
#undef GB_LOADU
}

__device__ __forceinline__ void gdc_passB_idle() {
    __syncthreads();
    for (int n = 0; n < 32; ++n) { asm volatile("" ::: "memory"); __builtin_amdgcn_s_barrier(); asm volatile("" ::: "memory"); }
}

__device__ __forceinline__ void gdc_passC(int u, const unsigned char* HB, const unsigned char* YB, const bf16_t* PROJ, const float* gnorm, bf16_t* MIXO, const Ctx& c) {
    const int bh = u >> 5, b = bh >> 2, h = bh & 3;
    const size_t t0 = (size_t)b * SEQ + (u & 31) * 64;
    const int lane = c.lane, wid = __builtin_amdgcn_readfirstlane(c.wid);
    const int h5 = lane >> 5, r = lane & 31;
    float* sqL = (float*)c.smem;
    const bf16_t* ST = (const bf16_t*)(YB + GC_ST) + (size_t)u * 16384 + (size_t)(2 * h5) * 512 + (size_t)(wid * 32 + r) * 4;
    const bf16_t* VT = (const bf16_t*)(YB + GC_VT) + (size_t)u * 8192 + (size_t)(2 * h5) * 512 + (size_t)(wid * 32 + r) * 4;
    const bf16_t* QG = (const bf16_t*)(HB + GD_QG) + (size_t)u * 8192 + (size_t)r * 128 + 8 * h5;
    const bf16_t* AT = (const bf16_t*)(HB + GD_AT) + (size_t)u * 4096 + (size_t)r * 64 + 8 * h5;
    f32x16 o0, o1;
#pragma unroll
    for (int i = 0; i < 16; ++i) { o0[i] = 0.f; o1[i] = 0.f; }
#pragma unroll
    for (int ks = 0; ks < 8; ++ks) {
        const bf16x8 sa = __builtin_shufflevector(*(const s16x4*)(ST + (4 * ks) * 512), *(const s16x4*)(ST + (4 * ks + 1) * 512), 0, 1, 2, 3, 4, 5, 6, 7);
        const bf16x8 q0 = *(const bf16x8*)(QG + ks * 16), q1 = *(const bf16x8*)(QG + 32 * 128 + ks * 16);
        o0 = MFMA32(sa, q0, o0); o1 = MFMA32(sa, q1, o1);
        if (ks == 3) asm volatile("" ::: "memory");
    }
#pragma unroll
    for (int k2 = 0; k2 < 4; ++k2) {
        const bf16x8 va = __builtin_shufflevector(*(const s16x4*)(VT + (4 * k2) * 512), *(const s16x4*)(VT + (4 * k2 + 1) * 512), 0, 1, 2, 3, 4, 5, 6, 7);
        const bf16x8 a1 = *(const bf16x8*)(AT + 32 * 64 + k2 * 16);
        o1 = MFMA32(va, a1, o1);
        if (k2 < 2) { const bf16x8 a0 = *(const bf16x8*)(AT + k2 * 16); o0 = MFMA32(va, a0, o0); }
    }
    float s0 = 0.f, s1 = 0.f;
#pragma unroll
    for (int i = 0; i < 16; ++i) { s0 += o0[i] * o0[i]; s1 += o1[i] * o1[i]; }
    s0 += __shfl_xor(s0, 32); s1 += __shfl_xor(s1, 32);
    __syncthreads();
    if (h5 == 0) { sqL[wid * 64 + r] = s0; sqL[wid * 64 + 32 + r] = s1; }
    __syncthreads();
    const float rr0 = rsqrtf((sqL[r] + sqL[64 + r] + sqL[128 + r] + sqL[192 + r]) * (1.f / 128.f) + 1e-6f);
    const float rr1 = rsqrtf((sqL[32 + r] + sqL[96 + r] + sqL[160 + r] + sqL[224 + r]) * (1.f / 128.f) + 1e-6f);
#pragma unroll
    for (int tt = 0; tt < 2; ++tt) {
        const size_t t = t0 + tt * 32 + r;
        const bf16_t* zrow = PROJ + t * NPAD + 1960 + h * 128 + wid * 32 + 4 * h5;
        const float* gn = gnorm + wid * 32 + 4 * h5;
        bf16_t* orow = MIXO + t * 1024 + 512 + h * 128 + wid * 32 + 4 * h5;
        const float rr = tt ? rr1 : rr0;
#pragma unroll
        for (int g = 0; g < 4; ++g) {
            const u32x2 zr = *(const u32x2*)(zrow + 8 * g);
            const f32x4 gv = *(const f32x4*)(gn + 8 * g);
            const float z0 = bflo(zr.x), z1 = bfhi(zr.x), z2 = bflo(zr.y), z3 = bfhi(zr.y);
            const float y0 = (tt ? o1[4 * g] : o0[4 * g]) * rr * gv[0] * siluf_(z0), y1 = (tt ? o1[4 * g + 1] : o0[4 * g + 1]) * rr * gv[1] * siluf_(z1);
            const float y2 = (tt ? o1[4 * g + 2] : o0[4 * g + 2]) * rr * gv[2] * siluf_(z2), y3 = (tt ? o1[4 * g + 3] : o0[4 * g + 3]) * rr * gv[3] * siluf_(z3);
            *(u32x2*)(orow + 8 * g) = (u32x2){pk2(y0, y1), pk2(y2, y3)};
        }
    }
}

__device__ __forceinline__ void phase_post(const float* OG, const bf16_t* PROJ, const float* gain, bool odd, bf16_t* MIXO, const Ctx& c) {
    const int lane = c.lane;
    const int gcol = odd ? 1032 : 1960, ocol = odd ? 0 : 512;
    for (int t = c.bid * 4 + c.wid; t < T; t += c.nblk * 4) {
        const f32x4 a0 = *(const f32x4*)(OG + (size_t)t * 512 + lane * 8), a1 = *(const f32x4*)(OG + (size_t)t * 512 + lane * 8 + 4);
        float ss = (a0[0] * a0[0] + a0[1] * a0[1]) + (a0[2] * a0[2] + a0[3] * a0[3]) + (a1[0] * a1[0] + a1[1] * a1[1]) + (a1[2] * a1[2] + a1[3] * a1[3]);
        ss = red16(ss);
        const float rr = rsqrtf(ss * (1.f / 128.f) + 1e-6f);
        const u32x4 zr = *(const u32x4*)(PROJ + (size_t)t * NPAD + gcol + lane * 8);
        float z[8]; unpack8(zr, z);
        const int gi = odd ? lane * 8 : (lane & 15) * 8;
        const f32x4 g0 = *(const f32x4*)(gain + gi), g1 = *(const f32x4*)(gain + gi + 4);
        float y[8];
#pragma unroll
        for (int j = 0; j < 4; ++j) {
            const float ga = odd ? sigmoidf_(z[j]) : siluf_(z[j]), gb = odd ? sigmoidf_(z[4 + j]) : siluf_(z[4 + j]);
            y[j] = a0[j] * rr * g0[j] * ga; y[4 + j] = a1[j] * rr * g1[j] * gb;
        }
        *(u32x4*)(MIXO + (size_t)t * 1024 + ocol + lane * 8) = (u32x4){pk2(y[0], y[1]), pk2(y[2], y[3]), pk2(y[4], y[5]), pk2(y[6], y[7])};
    }
}

__global__ void __launch_bounds__(512, 2) fwd(Args a) {
    extern __shared__ __attribute__((aligned(16))) unsigned char smem[];
    Ctx c;
#define SET_CTX(cx) do { int t_ = threadIdx.x; asm volatile("" : "+v"(t_)); cx.tid0 = t_; cx.half = t_ >> 8; cx.tid = t_ & 255; cx.lane = t_ & 63; cx.wid = (t_ >> 6) & 3; \
        cx.wr = cx.wid >> 1; cx.wc = cx.wid & 1; cx.fr = cx.lane & 15; cx.fq = cx.lane >> 4; cx.bid = blockIdx.x * 2 + cx.half; cx.nblk = gridDim.x * 2; \
        cx.smem0 = smem; cx.smem = smem + cx.half * HALF_LDS; } while (0)
    SET_CTX(c);
#define PH_CTX() SET_CTX(c)
    unsigned char* const ws_base = a.ws;
    const void* const* const ain_base = (const void* const*)__builtin_amdgcn_kernarg_segment_ptr();
    unsigned* ctl = (unsigned*)(ws_base + WS_CTL);
    volatile LAS unsigned* xbw = (volatile LAS unsigned*)(smem + LDS_BLK);
    if (c.tid0 < 8) xbw[c.tid0] = 0u;
    __syncthreads();
    XcdBarrier bar; bar.bar = ctl; bar.x = 0; bar.st = xbw;
    if (a.use_bar) bar = xcd_barrier_post(ctl, xbw);
    const int lo = a.ph_lo, hi = a.ph_hi;
#define IN(k) (lo <= (k) && (k) < hi)
#define PH(k) if (IN(k)) { PH_CTX(); unsigned char* ws = ws_base; const void* const* ain = ain_base; asm volatile("" : "+s"(ws), "+s"(ain));
#define UNIT_CTX() Ctx cu; SET_CTX(cu)
#define SEAM(k) do { if ((k) + 1 < hi) xcd_barrier(bar); } while (0)

#define XBF ((bf16_t*)(ws + WS_XBF))
#define X1 ((float*)(ws + WS_X1))
#define PROJ ((bf16_t*)(ws + U_PROJ))
#define GATES ((float*)(ws + U_GATES))
#define MIXO ((bf16_t*)(ws + U_MIXO))
#define YBUF ((float*)(ws + U_YBUF))
#define ROPEM ((const float*)(ws + WS_ROPEM))
#define ROPES ((const float*)(ws + WS_ROPES))
#define XRES ((layer == 0) ? (const float*)ain[0] : (const float*)a.out)
#define CNT (ctl + CW_CNT + layer * 128)
#define WIN ((const bf16_t*)(ws + WS_WIN) + (size_t)layer * WIN_ELEMS)
#define WOUT ((const bf16_t*)(ws + WS_WOUT) + (size_t)layer * WOUT_ELEMS)

    PH(0) for (int rep = 0; rep < REP_PRO; ++rep) phase_prologue(a, c); SEAM(0); }

    for (int layer = 0; layer < 4; ++layer) {
        const int pb = 1 + layer * PPL;
        if (pb >= hi || pb + PPL <= lo) continue;
        const int jj = layer >> 1;
        const bool odd = (layer & 1) != 0;

        PH(pb + 0) {
                DenseSched S{T / 256, NPAD / 256, 1024, (int)blockIdx.x, (int)gridDim.x};
                EpiIn E{PROJ, GATES, odd ? 1024 : 1952};
                g8::phase<true, false>(smem, (const char*)XBF, (const char*)WIN, 1024, S, E);
            }
            SEAM(pb + 0); }
        PH(pb + 1) for (int rp = 0; rp < ((REP_PHASE == 1) ? 2 : 1); ++rp) { if (rp) xcd_barrier(bar);
            if (!odd) phase_prep_even(PROJ, GATES, (const float*)ain[3] + jj * 256, (const float*)ain[5] + jj * 128, (const float*)ain[7] + jj * 4 * 1536,
                                      (const float*)ain[8] + jj * 4, (const float*)ain[9] + jj * 4, ROPEM,
                                      (bf16_t*)(ws + U_CQ), (bf16_t*)(ws + U_CKV), (bf16_t*)(ws + U_KROPE), (bf16_t*)(ws + U_GQ), (bf16_t*)(ws + U_GK), (bf16_t*)(ws + U_GV),
                                      (float*)(ws + U_BETA), (float*)(ws + U_GLOG), c);
            else {
                phase_prep_odd(PROJ, ROPES, (bf16_t*)(ws + U_QF), (bf16_t*)(ws + U_KN), c);
                unsigned* ctr = ctl + CW_WORK + pb + 1 + 64 * rp;
                for (;;) {
                    const int u = next_unit(ctr, c); UNIT_CTX();
                    if (u >= 1024) break;
                    mlc_passA(u, PROJ, GATES, (const float*)ain[13] + jj * 4, (const float*)ain[14] + jj * 4, (unsigned char*)YBUF, cu);
                }
            }
            }
            SEAM(pb + 1);
        }
        PH(pb + 2) for (int rp = 0; rp < ((REP_PHASE == 2) ? 2 : 1); ++rp) { if (rp) xcd_barrier(bar);
            unsigned* ctr = ctl + CW_WORK + pb + 2 + 64 * rp;
            if (!odd) {
                for (;;) {
                    const int u = next_unit(ctr, c); UNIT_CTX();
                    if (u >= 1024 + MLAUP_TILES) break;
                    if (u < 1024) gdc_passA(u, (const bf16_t*)(ws + U_GQ), (const bf16_t*)(ws + U_GK), (const bf16_t*)(ws + U_GV), (const float*)(ws + U_BETA),
                                            (const float*)(ws + U_GLOG), ws + WS_HBUF, cu);
                    else mla_up_tile(u - 1024, (const bf16_t*)(ws + U_CQ), (const bf16_t*)(ws + WS_WQB) + (size_t)jj * WQB_ELEMS, (const bf16_t*)(ws + U_CKV),
                                     (const bf16_t*)(ws + WS_WKVB) + (size_t)jj * WKVB_ELEMS, ROPEM, (bf16_t*)(ws + U_QF), (bf16_t*)(ws + U_KN), (bf16_t*)(ws + U_VV), cu);
                }
            } else {
                for (;;) {
                    const int u = next_unit(ctr, c); UNIT_CTX();
                    if (u >= 256 + 1024) break;
                    if (u < 256) mlc_passB(u, (unsigned char*)YBUF, cu);
                    else {
                        const int v = u - 256, hq = v & 7, n = (v >> 3) & 15, b = v >> 7, kvh = hq >> 2;
                        const size_t tb = (size_t)b * SEQ;
                        attn_unit<4, true>((const bf16_t*)(ws + U_QF) + tb * 512 + hq * 64, 512, (const bf16_t*)(ws + U_KN) + tb * 128 + kvh * 64, 128,
                                           (const bf16_t*)(ws + U_KN), 0, PROJ + tb * NPAD + 2184 + kvh * 64, NPAD,
                                           MIXO + tb * 1024 + 512 + hq * 64, 1024, n * 128, ((const float*)ain[16])[jj * 8 + hq] * 1.4426950408889634f, cu);
                    }
                }
            }
            }
            SEAM(pb + 2);
        }
        PH(pb + 3) for (int rp = 0; rp < ((REP_PHASE == 3) ? 2 : 1); ++rp) { if (rp) xcd_barrier(bar);
            unsigned* ctr = ctl + CW_WORK + pb + 3 + 64 * rp;
            if (!odd) {
                for (;;) {
                    const int u = next_unit(ctr, c); UNIT_CTX();
                    if (u >= 64 + 1024) break;
                    if (rp > 0 && ((REP_ONLY == 1 && u >= 64) || (REP_ONLY == 2 && u < 64))) continue;
                    if (u < 64) { if ((u & 1) == 0) gdc_passB(u >> 1, ws + WS_HBUF, (unsigned char*)YBUF, cu); else gdc_passB_idle(); }
                    else {
                        const int v = u - 64, qb = 15 - (v >> 6), bh = v & 63, b = bh >> 3, hh = bh & 7;
                        const size_t tb = (size_t)b * SEQ;
                        attn_unit<6, false>((const bf16_t*)(ws + U_QF) + tb * 768 + hh * 96, 768, (const bf16_t*)(ws + U_KN) + tb * 512 + hh * 64, 512,
                                            (const bf16_t*)(ws + U_KROPE) + tb * 32, 32, (const bf16_t*)(ws + U_VV) + tb * 512 + hh * 64, 512,
                                            MIXO + tb * 1024 + hh * 64, 1024, qb * 128, 0.f, cu);
                    }
                }
            } else {
                for (;;) {
                    const int u = next_unit(ctr, c); UNIT_CTX();
                    if (u >= 1024) break;
                    mlc_passC(u, PROJ, GATES, (const float*)ain[13] + jj * 4, (const float*)ain[14] + jj * 4, (const unsigned char*)YBUF, (const float*)ain[15] + jj * 512, MIXO, cu);
                }
            }
            }
            SEAM(pb + 3);
        }
        PH(pb + 4) for (int rp = 0; rp < ((REP_PHASE == 4) ? 2 : 1); ++rp) { if (rp) xcd_barrier(bar);
            if (!odd) {
                unsigned* ctr = ctl + CW_WORK + pb + 4 + 64 * rp;
                for (;;) {
                    const int u = next_unit(ctr, c); UNIT_CTX();
                    if (u >= 1024) break;
                    gdc_passC(u, ws + WS_HBUF, (const unsigned char*)YBUF, PROJ, (const float*)ain[10] + jj * 128, MIXO, cu);
                }
            }
            }
            if (!odd) SEAM(pb + 4);
        }
        PH(pb + 5) {
                DenseSched S{T / 256, 4, 1024, (int)blockIdx.x, (int)gridDim.x};
                EpiOut E{XRES, YBUF};
                g8::phase<false, false>(smem, (const char*)MIXO, (const char*)WOUT, 1024, S, E);
            }
            SEAM(pb + 5); }
        PH(pb + 6) for (int rep = 0; rep < REP_TOK; ++rep) phase_ln1(YBUF, (const float*)ain[18] + layer * 1024, (const float*)ain[19] + layer * 1024, X1, XBF, c); SEAM(pb + 6); }
        PH(pb + 7) for (int rep = 0; rep < REP_GEMM; ++rep) phase_router(XBF, (const bf16_t*)(ws + WS_WRT) + (size_t)layer * WRT_ELEMS, (float*)(ws + WS_LOG), c); SEAM(pb + 7); }
        PH(pb + 8) phase_route((const float*)(ws + WS_LOG), (const float*)ain[21] + layer * 64, CNT, (int*)(ws + WS_LTOK), (float*)(ws + WS_LW), (int*)(ws + WS_ASG), (float*)(ws + WS_ASGW), c); SEAM(pb + 8); }
        PH(pb + 9) {
                int* bst8 = (int*)(smem + LDS_BLK + 64); int* eb8 = bst8 + 256;
                build_block_table(CNT, bst8, c);
                for (int rb = c.tid0; rb < bst8[65]; rb += NT) { int e = 0; for (int q = 1; q < 65; ++q) e += (bst8[q] <= rb) ? 1 : 0; eb8[rb] = e; }
                __syncthreads();
                MoeSchedG S{bst8[65], (int)blockIdx.x, (int)gridDim.x, eb8, bst8, (const int*)(ws + WS_LTOK)};
                EpiMoe1 E{(bf16_t*)(ws + WS_HBUF)};
                g8::phase<false, true>(smem, (const char*)XBF, (const char*)((const bf16_t*)(ws + WS_WGU) + (size_t)layer * 65 * WGU_ELEMS), 1024, S, E);
            }
            SEAM(pb + 9); }
        PH(pb + 10)
#if MOE2_G8
            {
                int* bst8 = (int*)(smem + LDS_BLK + 64); int* eb8 = bst8 + 256;
                build_block_table(CNT, bst8, c);
                for (int rb = c.tid0; rb < bst8[65]; rb += NT) { int e = 0; for (int q = 1; q < 65; ++q) e += (bst8[q] <= rb) ? 1 : 0; eb8[rb] = e; }
                __syncthreads();
                MoeSched S{bst8[65], 4, (int)blockIdx.x, (int)gridDim.x, eb8};
                EpiMoe2 E{(bf16_t*)(ws + U_Y)};
                g8::phase<true, false>(smem, (const char*)(ws + WS_HBUF), (const char*)((const bf16_t*)(ws + WS_WDN) + (size_t)layer * 65 * WDN_ELEMS), 256, S, E);
            }
#else
            phase_moe2((const bf16_t*)(ws + WS_HBUF), (const bf16_t*)(ws + WS_WDN) + (size_t)layer * 65 * WDN_ELEMS, CNT, (bf16_t*)(ws + U_Y), c);
#endif
            SEAM(pb + 10); }
        PH(pb + 11) for (int rep = 0; rep < REP_CMB; ++rep) phase_combine(X1, (const bf16_t*)(ws + U_Y), (const int*)(ws + WS_ASG), (const float*)(ws + WS_ASGW), CNT, (const float*)ain[28] + layer * 1024, (const float*)ain[29] + layer * 1024,
                                         a.out, XBF, c); SEAM(pb + 11); }
    }
#undef IN
#undef XBF
#undef X1
#undef PROJ
#undef GATES
#undef MIXO
#undef YBUF
#undef ROPEM
#undef ROPES
#undef XRES
#undef CNT
#undef WIN
#undef WOUT
#undef PH
#undef PH_CTX
#undef UNIT_CTX
#undef SEAM
}

extern "C" void kernel_launch(void* const* d_in, const int* in_sizes, int n_in, void* d_out, int out_size, void* d_ws, size_t ws_size, hipStream_t stream) {
    static int grid = 0;
    if (grid == 0) {
        if (n_in != 30 || out_size != T * 1024 || ws_size < WS_END) {
            fprintf(stderr, "kernel_launch: unexpected shapes (n_in %d, out %d, ws %zu < %zu)\n", n_in, out_size, ws_size, (size_t)WS_END);
            grid = -1; return;
        }
        int dev = 0, cus = 0, per_cu = 0;
        (void)hipGetDevice(&dev);
        (void)hipDeviceGetAttribute(&cus, hipDeviceAttributeMultiprocessorCount, dev);
        (void)hipFuncSetAttribute((const void*)fwd, hipFuncAttributeMaxDynamicSharedMemorySize, DYN_LDS);
        (void)hipOccupancyMaxActiveBlocksPerMultiprocessor(&per_cu, (const void*)fwd, NT, DYN_LDS);
        (void)hipGetLastError();
        if (per_cu < 1) per_cu = 1;
        grid = cus;
    }
    if (grid < 0) return;
    (void)hipMemsetAsync((char*)d_ws + WS_CTL, 0, CTL_BYTES, stream);
    Args a{};
    for (int i = 0; i < 30; ++i) a.in[i] = d_in[i];
    a.out = (float*)d_out; a.ws = (unsigned char*)d_ws; a.pad = 0;
#if ONE_LAUNCH
    a.ph_lo = 0; a.ph_hi = NPH; a.use_bar = 1;
    hipLaunchKernelGGL(fwd, dim3(grid), dim3(NT), DYN_LDS, stream, a);
#else
    for (int p = 0; p < NPH; ++p) {
        a.ph_lo = p; a.ph_hi = p + 1; a.use_bar = 0;
        hipLaunchKernelGGL(fwd, dim3(grid), dim3(NT), DYN_LDS, stream, a);
    }
#endif
}
```

```cpp
#include <hip/hip_runtime.h>
#include <stdint.h>
#include <stdio.h>

#define REP_GEMM 1
#define REP_PHASE 0
#define REP_G0 1
#define REP_G1 1
#define REP_G2 1
#define REP_G3 1
#define REP_MIX 1
#define REP_ONLY 0
#define REP_CMB 1
#define REP_PRO 1
#define REP_TOK 1
#define MOE2_G8 1
#ifndef ONE_LAUNCH
#define ONE_LAUNCH 1
#endif

typedef unsigned short bf16_t;
typedef short bf16x8 __attribute__((ext_vector_type(8)));
typedef float f32x4 __attribute__((ext_vector_type(4)));
typedef unsigned u32x4 __attribute__((ext_vector_type(4)));
typedef unsigned u32x2 __attribute__((ext_vector_type(2)));
#define LAS __attribute__((address_space(3)))
#define GAS __attribute__((address_space(1)))

constexpr int T = 16384, SEQ = 2048;
constexpr int NPAD = 2560;
constexpr int CAP = 16384;
constexpr int RBR = 256;
constexpr int MAXRB = 512 + 64 + 64;
constexpr int MAXROWS = MAXRB * RBR;
constexpr float ALPHA = 1.681792830507429f;
constexpr int PPL = 12;
constexpr int NPH = 1 + 4 * PPL;
constexpr int NT = 512, NW = 8;
constexpr int HALF_LDS = 65536 + 64 + 1024;
constexpr int LDS_BLK = 2 * HALF_LDS;
constexpr int DYN_LDS = LDS_BLK + 64 + 1024 + 2560;

constexpr size_t cmax(size_t a, size_t b) { return a > b ? a : b; }
constexpr size_t WS_CTL = 0;
constexpr size_t CTL_BYTES = 65536;
constexpr size_t WS_WIN = WS_CTL + CTL_BYTES;
constexpr size_t WIN_ELEMS = (size_t)NPAD * 1024;
constexpr size_t WS_WQB = WS_WIN + 4 * WIN_ELEMS * 2;
constexpr size_t WQB_ELEMS = 768 * 256;
constexpr size_t WS_WKVB = WS_WQB + 2 * WQB_ELEMS * 2;
constexpr size_t WKVB_ELEMS = 1024 * 128;
constexpr size_t WS_WOUT = WS_WKVB + 2 * WKVB_ELEMS * 2;
constexpr size_t WOUT_ELEMS = 1024 * 1024;
constexpr size_t WS_WRT = WS_WOUT + 4 * WOUT_ELEMS * 2;
constexpr size_t WRT_ELEMS = 128 * 1024;
constexpr size_t WS_WGU = WS_WRT + 4 * WRT_ELEMS * 2;
constexpr size_t WGU_ELEMS = 512 * 1024;
constexpr size_t WS_WDN = WS_WGU + 4 * 65 * WGU_ELEMS * 2;
constexpr size_t WDN_ELEMS = 1024 * 256;
constexpr size_t WS_ROPEM = WS_WDN + 4 * 65 * WDN_ELEMS * 2;
constexpr size_t WS_ROPES = WS_ROPEM + (size_t)T * 16 * 2 * 4;
constexpr size_t WS_X1 = WS_ROPES + (size_t)T * 32 * 2 * 4;
constexpr size_t WS_XBF = WS_X1 + (size_t)T * 1024 * 4;
constexpr size_t WS_HBUF = WS_XBF + (size_t)T * 1024 * 2;
constexpr size_t WS_LOG = WS_HBUF + (size_t)MAXROWS * 256 * 2;
constexpr size_t WS_ASG = WS_LOG + (size_t)T * 64 * 4;
constexpr size_t WS_ASGW = WS_ASG + (size_t)T * 8 * 4;
constexpr size_t WS_LTOK = WS_ASGW + (size_t)T * 8 * 4;
constexpr size_t WS_LW = WS_LTOK + (size_t)65 * CAP * 4;
constexpr size_t WS_U = WS_LW + (size_t)65 * CAP * 4;
constexpr size_t U_Y = WS_U;
constexpr size_t U_PROJ = WS_U;
constexpr size_t U_GATES = U_PROJ + (size_t)T * NPAD * 2;
constexpr size_t U_CQ = U_GATES + (size_t)T * 8 * 4;
constexpr size_t U_CKV = U_CQ + (size_t)T * 256 * 2;
constexpr size_t U_KROPE = U_CKV + (size_t)T * 128 * 2;
constexpr size_t U_QF = U_KROPE + (size_t)T * 32 * 2;
constexpr size_t U_KN = U_QF + (size_t)T * 768 * 2;
constexpr size_t U_VV = U_KN + (size_t)T * 512 * 2;
constexpr size_t U_GQ = U_VV + (size_t)T * 512 * 2;
constexpr size_t U_GK = U_GQ + (size_t)T * 512 * 2;
constexpr size_t U_GV = U_GK + (size_t)T * 512 * 2;
constexpr size_t U_BETA = U_GV + (size_t)T * 512 * 2;
constexpr size_t U_GLOG = U_BETA + (size_t)T * 4 * 4;
constexpr size_t U_MIXO = U_GLOG + (size_t)T * 4 * 4;
constexpr size_t U_YBUF = U_MIXO + (size_t)T * 1024 * 2;
constexpr size_t U_END1 = U_YBUF + (size_t)T * 1024 * 4;
constexpr size_t WS_END = WS_U + cmax((size_t)MAXROWS * 1024 * 2, U_END1 - WS_U);

constexpr int CW_CNT = 4096;
constexpr int CW_WORK = 8192;

#define XB_TMO      128
#define XB_XCNT(j)  (256  + 64 * (j))
#define XB_XSUB(j)  (1280 + 64 * (j))
#define XB_XGEN(j)  (2304 + 64 * (j))
#define XB_TOP      3328
#define XB_TOPGEN   3392
#define XCD_BAR_WORDS 3456
#define XB_SPIN_CAP (1u << 18)

__device__ __forceinline__ unsigned xb_ld(unsigned* p)              { return __hip_atomic_load(p, __ATOMIC_RELAXED, __HIP_MEMORY_SCOPE_AGENT); }
__device__ __forceinline__ unsigned xb_add(unsigned* p, unsigned v) { return __hip_atomic_fetch_add(p, v, __ATOMIC_RELAXED, __HIP_MEMORY_SCOPE_AGENT); }
__device__ __forceinline__ unsigned xb_xcc_id() { return (unsigned)__builtin_amdgcn_s_getreg((3 << 11) | 20) & 0xFu; }
#define XB_SPIN(cond, bar) do { unsigned _sp = 0; while (cond) { __builtin_amdgcn_s_sleep(1); \
    if ((++_sp & 255u) == 0u) { if (xb_ld(&(bar)[XB_TMO])) break; if (_sp > XB_SPIN_CAP) { atomicAdd(&(bar)[XB_TMO], 1u); break; } } } } while (0)

struct XcdBarrier { unsigned* bar; unsigned x; volatile LAS unsigned* st; };

__device__ __forceinline__ XcdBarrier xcd_barrier_post(unsigned* bar, volatile LAS unsigned* st) {
    XcdBarrier b; b.bar = bar; b.x = xb_xcc_id(); b.st = st;
    if (threadIdx.x == 0) (void)xb_add(&bar[XB_XCNT(b.x)], 1u);
    return b;
}
__device__ __forceinline__ void xcd_barrier_complete(unsigned* bar, unsigned x, unsigned& nloc, unsigned& nx) {
    const unsigned G = gridDim.x * gridDim.y * gridDim.z;
    unsigned sum, cnt, mine, sp = 0u;
    for (;;) {
        sum = 0u; cnt = 0u; mine = 0u;
#pragma unroll
        for (unsigned j = 0; j < 16; ++j) { const unsigned c = xb_ld(&bar[XB_XCNT(j)]); sum += c; cnt += (c > 0u) ? 1u : 0u; mine = (j == x) ? c : mine; }
        if (sum == G) break;
        __builtin_amdgcn_s_sleep(1);
        if ((++sp & 255u) == 0u) { if (xb_ld(&bar[XB_TMO])) break; if (sp > XB_SPIN_CAP) { atomicAdd(&bar[XB_TMO], 1u); break; } }
    }
    nloc = mine > 0u ? mine : 1u; nx = cnt > 0u ? cnt : 1u;
}
__device__ __forceinline__ void xcd_barrier(const XcdBarrier& b) {
    asm volatile("s_waitcnt vmcnt(0)" ::: "memory");
    __syncthreads();
    if (threadIdx.x == 0) {
        unsigned* bar = b.bar;
        __builtin_amdgcn_s_waitcnt(0);
        unsigned nloc = b.st[0], nx = b.st[1];
        if (nloc == 0u) { xcd_barrier_complete(bar, b.x, nloc, nx); b.st[0] = nloc; b.st[1] = nx; }
        const unsigned old = xb_add(&bar[XB_XSUB(b.x)], 1u);
        const unsigned gen = old / nloc;
        if (old + 1u == (gen + 1u) * nloc) {
            __builtin_amdgcn_fence(__ATOMIC_RELEASE, "agent");
            asm volatile("s_waitcnt vmcnt(0)" ::: "memory");
            const unsigned og = xb_add(&bar[XB_TOP], 1u);
            const unsigned tg = og / nx;
            if (og + 1u == (tg + 1u) * nx) xb_add(&bar[XB_TOPGEN], 1u);
            else XB_SPIN(xb_ld(&bar[XB_TOPGEN]) == tg, bar);
            __builtin_amdgcn_fence(__ATOMIC_ACQUIRE, "agent");
            xb_add(&bar[XB_XGEN(b.x)], 1u);
            asm volatile("s_waitcnt vmcnt(0)" ::: "memory");
        } else {
            XB_SPIN(xb_ld(&bar[XB_XGEN(b.x)]) == gen, bar);
            __builtin_amdgcn_fence(__ATOMIC_ACQUIRE, "agent");
            asm volatile("s_waitcnt vmcnt(0)" ::: "memory");
        }
    }
    __syncthreads();
}

__device__ __forceinline__ float bf2f(unsigned v) { return __uint_as_float(v << 16); }
__device__ __forceinline__ float bflo(unsigned w) { return __uint_as_float(w << 16); }
__device__ __forceinline__ float bfhi(unsigned w) { return __uint_as_float(w & 0xffff0000u); }
__device__ __forceinline__ unsigned f2bf(float f) { unsigned u = __float_as_uint(f); u += 0x7fffu + ((u >> 16) & 1u); return u >> 16; }
__device__ __forceinline__ unsigned pk2(float lo, float hi) { return f2bf(lo) | (f2bf(hi) << 16); }
__device__ __forceinline__ unsigned cvt_pk(float lo, float hi) { unsigned r; asm volatile("v_cvt_pk_bf16_f32 %0, %1, %2" : "=v"(r) : "v"(lo), "v"(hi)); return r; }
__device__ __forceinline__ float wave_sum(float v) {
#pragma unroll
    for (int o = 32; o > 0; o >>= 1) v += __shfl_xor(v, o);
    return v;
}
__device__ __forceinline__ float sigmoidf_(float x) { return 1.f / (1.f + expf(-x)); }
__device__ __forceinline__ float siluf_(float x) { return x / (1.f + expf(-x)); }
__device__ __forceinline__ float softplusf_(float x) { return x > 20.f ? x : log1pf(expf(x)); }
__device__ __forceinline__ void glds16(const void* g, void* l) {
    __builtin_amdgcn_global_load_lds((const GAS unsigned*)g, (LAS unsigned*)l, 16, 0, 0);
}
__device__ __forceinline__ void unpack8(const u32x4 r, float (&f)[8]) {
    f[0] = bflo(r.x); f[1] = bfhi(r.x); f[2] = bflo(r.y); f[3] = bfhi(r.y);
    f[4] = bflo(r.z); f[5] = bfhi(r.z); f[6] = bflo(r.w); f[7] = bfhi(r.w);
}

struct Args {
    const void* in[30];
    float* out;
    unsigned char* ws;
    int ph_lo, ph_hi, use_bar, pad;
};

struct Ctx { int tid, lane, wid, wr, wc, fr, fq, bid, nblk; unsigned char* smem; int half, tid0; unsigned char* smem0; };

#define WAIT_V(n) asm volatile("s_waitcnt vmcnt(" #n ")" ::: "memory")
__device__ __forceinline__ void gemm_tile(const bf16_t* a0, const bf16_t* a1, const bf16_t* b0, const bf16_t* b1,
                                          int nk, f32x4 (&acc)[4][4], const Ctx& c) {
#pragma unroll
    for (int m = 0; m < 4; ++m)
#pragma unroll
        for (int n = 0; n < 4; ++n) acc[m][n] = (f32x4){0.f, 0.f, 0.f, 0.f};
    unsigned char* smem = c.smem;
    const int sb = c.tid * 16;
    const int kofs = ((c.tid & 3) ^ ((c.tid >> 4) & 3)) * 8;
    a0 += kofs; a1 += kofs; b0 += kofs; b1 += kofs;
#define G_STAGE(kt_) do { unsigned char* sp_ = smem + ((kt_) & 3) * 16384 + sb; const int ko_ = (kt_) * 32; \
        glds16(a0 + ko_, sp_); glds16(a1 + ko_, sp_ + 4096); glds16(b0 + ko_, sp_ + 8192); glds16(b1 + ko_, sp_ + 12288); } while (0)
#define G_READ(kt_, AF, BF) do { const unsigned char* sa_ = smem + ((kt_) & 3) * 16384 + c.wr * 4096 + roff; const unsigned char* sb_ = smem + ((kt_) & 3) * 16384 + 8192 + c.wc * 4096 + roff; \
        _Pragma("unroll") for (int m = 0; m < 4; ++m) AF[m] = *(const bf16x8*)(sa_ + m * 1024); \
        _Pragma("unroll") for (int n = 0; n < 4; ++n) BF[n] = *(const bf16x8*)(sb_ + n * 1024); } while (0)
#define G_MMA(AF, BF) do { __builtin_amdgcn_s_setprio(1); \
        _Pragma("unroll") for (int m = 0; m < 4; ++m) _Pragma("unroll") for (int n = 0; n < 4; ++n) acc[m][n] = __builtin_amdgcn_mfma_f32_16x16x32_bf16(BF[n], AF[m], acc[m][n], 0, 0, 0); \
        __builtin_amdgcn_s_setprio(0); } while (0)
#define G_BAR() do { asm volatile("" ::: "memory"); __builtin_amdgcn_s_barrier(); asm volatile("" ::: "memory"); } while (0)
    const int roff = (c.fr * 64) + ((c.fq ^ ((c.fr >> 2) & 3)) * 16);
    WAIT_V(0);
    G_STAGE(0); G_STAGE(1); G_STAGE(2); G_STAGE(3);
    bf16x8 fa0[4], fb0[4], fa1[4], fb1[4];
    WAIT_V(12); G_BAR();
    G_READ(0, fa0, fb0);
#define G_LGK0() asm volatile("s_waitcnt lgkmcnt(0)" ::: "memory")
    int kt = 0;
    for (; kt < nk - 4; kt += 4) {
        G_LGK0(); WAIT_V(8); G_BAR(); G_STAGE(kt + 4); G_READ(1, fa1, fb1); G_MMA(fa0, fb0);
        G_LGK0(); WAIT_V(8); G_BAR(); G_STAGE(kt + 5); G_READ(2, fa0, fb0); G_MMA(fa1, fb1);
        G_LGK0(); WAIT_V(8); G_BAR(); G_STAGE(kt + 6); G_READ(3, fa1, fb1); G_MMA(fa0, fb0);
        G_LGK0(); WAIT_V(8); G_BAR(); G_STAGE(kt + 7); G_READ(0, fa0, fb0); G_MMA(fa1, fb1);
    }
    G_LGK0(); WAIT_V(8); G_BAR(); G_READ(1, fa1, fb1); G_MMA(fa0, fb0);
    G_LGK0(); WAIT_V(4); G_BAR(); G_READ(2, fa0, fb0); G_MMA(fa1, fb1);
    G_LGK0(); WAIT_V(0); G_BAR(); G_READ(3, fa1, fb1); G_MMA(fa0, fb0);
    G_MMA(fa1, fb1);
#undef G_LGK0
#undef G_STAGE
#undef G_READ
#undef G_MMA
#undef G_BAR
    __syncthreads();
}

namespace g8 {
constexpr int BM = 256, BK = 64, HALF = 128, HTB = HALF * BK * 2, STAGE_BYTES = 8 * HTB;
__device__ __forceinline__ int lds_byte(int r, int c) { const int st = (r >> 4) * 2 + (c >> 5), rr = r & 15, cc = c & 31, ob = rr * 64 + cc * 2; return st * 1024 + (ob ^ (((ob >> 9) & 1) << 5)); }
__device__ __forceinline__ void stage_rc(int b, int& R, int& C) { const int st = b / 1024, sb = b % 1024, swz = sb ^ (((sb >> 9) & 1) << 5); R = (st >> 1) * 16 + swz / 64; C = (st & 1) * 32 + (swz % 64) / 2; }
__device__ __forceinline__ int perm32(int rho) { const int n = rho >> 4, i = rho & 15; return 8 * (i >> 2) + 4 * n + (i & 3); }
struct Unit { int pm, pn, bt; };

template <bool PERM, bool GATHER, class Sched, class Epi>
__device__ __forceinline__ void phase(unsigned char* ldsp, const char* Abase, const char* Bbase, int K, const Sched& S, const Epi& E) {
    LAS unsigned char* lds = (LAS unsigned char*)ldsp;
    int tid = threadIdx.x; asm volatile("" : "+v"(tid));
    const int wid = __builtin_amdgcn_readfirstlane(tid >> 6), lane = tid & 63, wr = wid >> 2, wc = wid & 3, fr = lane & 15, fq = lane >> 4;
    const int nt = K / BK;
    unsigned voffA[2], voffB[2];
#pragma unroll
    for (int i = 0; i < 2; ++i) { int R, C; stage_rc(tid * 16 + i * 8192, R, C); const int Rb = PERM ? ((R & ~31) + perm32(R & 31)) : R;
        voffA[i] = (unsigned)(R * K + C) * 2u; voffB[i] = (unsigned)(Rb * K + C) * 2u; }
    const size_t kstep = (size_t)(BK * 2);
    const size_t hstep = (size_t)HALF * K * 2, tstep = 2 * hstep;
    const unsigned ldsw = (unsigned)wid * 1024u;
    const int aoff = lds_byte(wr * 64 + fr, fq * 8), boff = lds_byte(wc * 32 + fr, fq * 8);
#define G8_SA(b, h) (((b) * 2 + (h)) * HTB)
#define G8_SB(b, h) ((4 + (b) * 2 + (h)) * HTB)
#define G8_STAGE(bufoff, gbase, voff) do { _Pragma("unroll") for (int _i = 0; _i < 2; ++_i) \
        __builtin_amdgcn_global_load_lds((const GAS unsigned*)((const char*)(gbase) + (voff)[_i]), (LAS unsigned*)(lds + (bufoff) + ldsw + _i * 8192), 16, 0, 0); } while (0)
#define G8_STAGEA(bufoff, gbase, h, kb) do { if constexpr (GATHER) { _Pragma("unroll") for (int _i = 0; _i < 2; ++_i) \
        __builtin_amdgcn_global_load_lds((const GAS unsigned*)(Abase + (kb) + vA[2 * (h) + _i]), (LAS unsigned*)(lds + (bufoff) + ldsw + _i * 8192), 16, 0, 0); } \
        else G8_STAGE(bufoff, (gbase) + (size_t)(h) * hstep + (kb), voffA); } while (0)
#define G8_LDA(dst, b, h) do { _Pragma("unroll") for (int m = 0; m < 4; ++m) _Pragma("unroll") for (int k = 0; k < 2; ++k) dst[m][k] = *(const LAS bf16x8*)(lds + G8_SA(b, h) + aoff + m * 2048 + k * 1024); } while (0)
#define G8_LDB(dst, b, h) do { _Pragma("unroll") for (int n = 0; n < 2; ++n) _Pragma("unroll") for (int k = 0; k < 2; ++k) dst[n][k] = *(const LAS bf16x8*)(lds + G8_SB(b, h) + boff + n * 2048 + k * 1024); } while (0)
#define G8_MMA(ai, bj, At, Bt) do { __builtin_amdgcn_s_setprio(1); _Pragma("unroll") for (int m = 0; m < 4; ++m) _Pragma("unroll") for (int n = 0; n < 2; ++n) _Pragma("unroll") for (int k = 0; k < 2; ++k) \
        acc[ai][bj][m][n] = __builtin_amdgcn_mfma_f32_16x16x32_bf16(Bt[n][k], At[m][k], acc[ai][bj][m][n], 0, 0, 0); __builtin_amdgcn_s_setprio(0); } while (0)
#define G8_WAIT_V(n) asm volatile("s_waitcnt vmcnt(" #n ")" ::: "memory")
#define G8_WAIT_L(n) asm volatile("s_waitcnt lgkmcnt(" #n ")" ::: "memory")
#define G8_BAR __builtin_amdgcn_s_barrier()
#define G8_SCHED __builtin_amdgcn_sched_barrier(0)
    Unit cur, nxt; int ui = 0;
    if (!S.next(0, cur)) return;
    f32x4 acc[2][2][4][2];
#pragma unroll
    for (int a = 0; a < 2; ++a)
#pragma unroll
        for (int b = 0; b < 2; ++b)
#pragma unroll
            for (int m = 0; m < 4; ++m)
#pragma unroll
                for (int n = 0; n < 2; ++n) acc[a][b][m][n] = (f32x4){0.f, 0.f, 0.f, 0.f};
    bf16x8 At[4][2], B0[2][2], B1[2][2];
    const char* cA = Abase + (size_t)cur.pm * tstep; const char* cB = Bbase + (size_t)cur.bt * tstep;
    unsigned vA[4] = {0u, 0u, 0u, 0u};
    if constexpr (GATHER) S.aoff(cur, tid, vA);
    asm volatile("s_waitcnt vmcnt(0)" ::: "memory");
    G8_STAGE(G8_SB(0, 0), cB, voffB); G8_STAGEA(G8_SA(0, 0), cA, 0, 0); G8_STAGE(G8_SB(0, 1), cB + hstep, voffB); G8_STAGEA(G8_SA(0, 1), cA, 1, 0);
    if (wr == 1) G8_BAR;
    G8_WAIT_V(4); G8_BAR;
    G8_STAGE(G8_SB(1, 0), cB + kstep, voffB); G8_STAGEA(G8_SA(1, 0), cA, 0, kstep); G8_STAGE(G8_SB(1, 1), cB + hstep + kstep, voffB);
    G8_WAIT_V(6); G8_BAR;
    for (;;) {
        const bool has_next = S.next(ui + 1, nxt);
        const char* nA = has_next ? Abase + (size_t)nxt.pm * tstep : cA; const char* nB = has_next ? Bbase + (size_t)nxt.bt * tstep : cB;
        for (int t = 0; t < nt; t += 2) {
            const bool last = (t == nt - 2);
            const size_t k1 = (size_t)(t + 1) * kstep, k2 = last ? 0 : (size_t)(t + 2) * kstep, k3 = k2 + kstep;
            const char* a2 = last ? nA : cA; const char* b2 = last ? nB : cB + (size_t)(t + 2) * kstep;
            const char* b3 = b2 + kstep;
            G8_LDB(B0, 0, 0); G8_SCHED; G8_LDA(At, 0, 0); G8_STAGEA(G8_SA(1, 1), cA, 1, k1);
            if constexpr (GATHER) { if (last && has_next) S.aoff(nxt, tid, vA); }
            G8_WAIT_L(8); G8_BAR; G8_WAIT_L(0); G8_MMA(0, 0, At, B0); G8_BAR; G8_SCHED;
            G8_LDB(B1, 0, 1); G8_STAGE(G8_SB(0, 0), b2, voffB);
            G8_BAR; G8_WAIT_L(0); G8_MMA(0, 1, At, B1); G8_BAR;
            G8_LDA(At, 0, 1); G8_STAGEA(G8_SA(0, 0), a2, 0, k2);
            G8_BAR; G8_WAIT_L(0); G8_MMA(1, 0, At, B0); G8_BAR; G8_SCHED;
            G8_STAGE(G8_SB(0, 1), b2 + hstep, voffB);
            G8_WAIT_V(6); G8_BAR; G8_MMA(1, 1, At, B1); G8_BAR;
            G8_LDB(B0, 1, 0); G8_SCHED; G8_LDA(At, 1, 0); G8_STAGEA(G8_SA(0, 1), a2, 1, k2);
            G8_WAIT_L(8); G8_BAR; G8_WAIT_L(0); G8_MMA(0, 0, At, B0); G8_BAR; G8_SCHED;
            G8_LDB(B1, 1, 1); G8_STAGE(G8_SB(1, 0), b3, voffB);
            G8_BAR; G8_WAIT_L(0); G8_MMA(0, 1, At, B1); G8_BAR;
            G8_LDA(At, 1, 1); G8_STAGEA(G8_SA(1, 0), a2, 0, k3);
            G8_BAR; G8_WAIT_L(0); G8_MMA(1, 0, At, B0); G8_BAR; G8_SCHED;
            G8_STAGE(G8_SB(1, 1), b3 + hstep, voffB);
            G8_WAIT_V(6); G8_BAR; G8_MMA(1, 1, At, B1); G8_BAR;
        }
        E(acc, cur, wr, wc, fr, fq);
        if (!has_next) break;
#pragma unroll
        for (int a = 0; a < 2; ++a)
#pragma unroll
            for (int b = 0; b < 2; ++b)
#pragma unroll
                for (int m = 0; m < 4; ++m)
#pragma unroll
                    for (int n = 0; n < 2; ++n) acc[a][b][m][n] = (f32x4){0.f, 0.f, 0.f, 0.f};
        cur = nxt; cA = nA; cB = nB; ++ui;
    }
    G8_WAIT_V(0);
    if (wr == 0) G8_BAR;
    G8_BAR;
#undef G8_SA
#undef G8_SB
#undef G8_STAGE
#undef G8_STAGEA
#undef G8_LDA
#undef G8_LDB
#undef G8_MMA
#undef G8_WAIT_V
#undef G8_WAIT_L
#undef G8_BAR
#undef G8_SCHED
}
}

__device__ __forceinline__ bool tile_map(int i, const Ctx& c, int ntm, int ntn, int& mt, int& nt) {
    const int vb = ((c.nblk & 15) == 0) ? ((c.bid >> 1) & 7) * (c.nblk >> 3) + (((c.bid >> 4) << 1) | (c.bid & 1)) : c.bid;
    const int L = i * c.nblk + vb;
    if (L >= ntm * ntn) return false;
    const int g = L / (8 * ntn), rem = L - g * 8 * ntn;
    const int gsz = (ntm - g * 8) < 8 ? (ntm - g * 8) : 8;
    mt = g * 8 + rem % gsz; nt = rem / gsz;
    return true;
}

__device__ __forceinline__ bool tile_map2(int i, const Ctx& c, int ntm, int ntn, int& mt, int& nt, bool& valid) {
    Ctx o = c; o.bid = c.bid ^ 1;
    int mo, no; const bool oko = tile_map(i, o, ntm, ntn, mo, no);
    valid = tile_map(i, c, ntm, ntn, mt, nt);
    if (!valid) { mt = 0; nt = 0; }
    return valid || oko;
}

struct DenseSched {
    int ntm, ntn, K, bid, nblk;
    __device__ __forceinline__ bool next(int i, g8::Unit& u) const {
        const int vb = ((nblk & 7) == 0) ? (bid & 7) * (nblk >> 3) + (bid >> 3) : bid;
        const int L = i * nblk + vb;
        if (L >= ntm * ntn) return false;
        const int g = L / (8 * ntn), rem = L - g * 8 * ntn;
        const int gsz = (ntm - g * 8) < 8 ? (ntm - g * 8) : 8;
        u.pm = g * 8 + rem % gsz; u.pn = rem / gsz; u.bt = u.pn;
        return true;
    }
};
struct MoeSched {
    int nrb, ntn, bid, nblk; const int* eb;
    __device__ __forceinline__ bool next(int i, g8::Unit& u) const {
        const int vb = ((nblk & 7) == 0) ? (bid & 7) * (nblk >> 3) + (bid >> 3) : bid;
        const int L = i * nblk + vb;
        if (L >= nrb * ntn) return false;
        const int g = L / (8 * ntn), rem = L - g * 8 * ntn;
        const int gsz = (nrb - g * 8) < 8 ? (nrb - g * 8) : 8;
        u.pm = g * 8 + rem % gsz; u.pn = rem / gsz;
        u.bt = eb[u.pm] * ntn + u.pn;
        return true;
    }
};
struct MoeSchedG {
    int nrb, bid, nblk; const int* eb; const int* bst; const int* LTOK;
    __device__ __forceinline__ bool next(int i, g8::Unit& u) const {
        const int vb = ((nblk & 7) == 0) ? (bid & 7) * (nblk >> 3) + (bid >> 3) : bid;
        const int L = i * nblk + vb;
        if (L >= nrb * 2) return false;
        const int g = L >> 4, rem = L & 15;
        const int gsz = (nrb - g * 8) < 8 ? (nrb - g * 8) : 8;
        u.pm = g * 8 + rem % gsz; u.pn = rem / gsz;
        u.bt = eb[u.pm] * 2 + u.pn;
        return true;
    }
    __device__ __forceinline__ void aoff(const g8::Unit& u, int tid, unsigned (&o)[4]) const {
        const int e = eb[u.pm], lb = u.pm - bst[e], cnt = bst[66 + e];
        int R0, C0, R1, C1; g8::stage_rc(tid * 16, R0, C0); g8::stage_rc(tid * 16 + 8192, R1, C1);
        const int* lt = LTOK + (size_t)e * CAP + lb * RBR;
        const int p00 = R0, p01 = R1, p10 = 128 + R0, p11 = 128 + R1;
        const int t00 = (lb * RBR + p00 < cnt) ? lt[p00] : 0, t01 = (lb * RBR + p01 < cnt) ? lt[p01] : 0;
        const int t10 = (lb * RBR + p10 < cnt) ? lt[p10] : 0, t11 = (lb * RBR + p11 < cnt) ? lt[p11] : 0;
        o[0] = (unsigned)t00 * 2048u + (unsigned)C0 * 2u; o[1] = (unsigned)t01 * 2048u + (unsigned)C1 * 2u;
        o[2] = (unsigned)t10 * 2048u + (unsigned)C0 * 2u; o[3] = (unsigned)t11 * 2048u + (unsigned)C1 * 2u;
    }
};
struct EpiMoe1 {
    bf16_t* H;
    __device__ __forceinline__ void operator()(const f32x4 (&acc)[2][2][4][2], const g8::Unit& u, int wr, int wc, int fr, int fq) const {
#pragma unroll
        for (int ai = 0; ai < 2; ++ai)
#pragma unroll
            for (int m = 0; m < 4; ++m) {
                const size_t row = (size_t)u.pm * RBR + ai * 128 + wr * 64 + m * 16 + fr;
#pragma unroll
                for (int bj = 0; bj < 2; ++bj) {
                    const int hc = (u.pn * 8 + bj * 4 + wc) * 16 + fq * 4;
                    const f32x4 g = acc[ai][bj][m][0], up = acc[ai][bj][m][1];
                    float h[4];
#pragma unroll
                    for (int j = 0; j < 4; ++j) h[j] = g[j] * __builtin_amdgcn_rcpf(1.f + __expf(-g[j])) * up[j];
                    *(u32x2*)(H + row * 256 + hc) = (u32x2){cvt_pk(h[0], h[1]), cvt_pk(h[2], h[3])};
                }
            }
    }
};
struct EpiIn {
    bf16_t* P; float* G; int gbase;
    __device__ __forceinline__ void operator()(const f32x4 (&acc)[2][2][4][2], const g8::Unit& u, int wr, int wc, int fr, int fq) const {
#pragma unroll
        for (int ai = 0; ai < 2; ++ai)
#pragma unroll
            for (int m = 0; m < 4; ++m) {
                const size_t row = (size_t)u.pm * 256 + ai * 128 + wr * 64 + m * 16 + fr;
#pragma unroll
                for (int bj = 0; bj < 2; ++bj) {
                    const int col = u.pn * 256 + bj * 128 + wc * 32 + fq * 8;
                    const f32x4 v0 = acc[ai][bj][m][0], v1 = acc[ai][bj][m][1];
                    *(u32x4*)(P + row * NPAD + col) = (u32x4){cvt_pk(v0[0], v0[1]), cvt_pk(v0[2], v0[3]), cvt_pk(v1[0], v1[1]), cvt_pk(v1[2], v1[3])};
                    if (col == gbase) { *(f32x4*)(G + row * 8) = v0; *(f32x4*)(G + row * 8 + 4) = v1; }
                }
            }
    }
};
struct EpiMoe2 {
    bf16_t* Y;
    __device__ __forceinline__ void operator()(const f32x4 (&acc)[2][2][4][2], const g8::Unit& u, int wr, int wc, int fr, int fq) const {
#pragma unroll
        for (int ai = 0; ai < 2; ++ai)
#pragma unroll
            for (int m = 0; m < 4; ++m) {
                const size_t row = (size_t)u.pm * RBR + ai * 128 + wr * 64 + m * 16 + fr;
#pragma unroll
                for (int bj = 0; bj < 2; ++bj) {
                    const int col = u.pn * 256 + bj * 128 + wc * 32 + fq * 8;
                    const f32x4 v0 = acc[ai][bj][m][0], v1 = acc[ai][bj][m][1];
                    *(u32x4*)(Y + row * 1024 + col) = (u32x4){cvt_pk(v0[0], v0[1]), cvt_pk(v0[2], v0[3]), cvt_pk(v1[0], v1[1]), cvt_pk(v1[2], v1[3])};
                }
            }
    }
};
struct EpiOut {
    const bf16_t* xres; bf16_t* Y;
    __device__ __forceinline__ void operator()(const f32x4 (&acc)[2][2][4][2], const g8::Unit& u, int wr, int wc, int fr, int fq) const {
#pragma unroll
        for (int ai = 0; ai < 2; ++ai)
#pragma unroll
            for (int m = 0; m < 4; ++m) {
                const size_t row = (size_t)u.pm * 256 + ai * 128 + wr * 64 + m * 16 + fr;
#pragma unroll
                for (int bj = 0; bj < 2; ++bj) {
                    const int col = u.pn * 256 + bj * 128 + wc * 32 + fq * 8;
                    const u32x4 xr = *(const u32x4*)(xres + row * 1024 + col);
                    float f[8]; unpack8(xr, f);
                    const f32x4 v0 = acc[ai][bj][m][0], v1 = acc[ai][bj][m][1];
                    *(u32x4*)(Y + row * 1024 + col) = (u32x4){cvt_pk(f[0] * ALPHA + v0[0], f[1] * ALPHA + v0[1]), cvt_pk(f[2] * ALPHA + v0[2], f[3] * ALPHA + v0[3]),
                                                              cvt_pk(f[4] * ALPHA + v1[0], f[5] * ALPHA + v1[1]), cvt_pk(f[6] * ALPHA + v1[2], f[7] * ALPHA + v1[3])};
                }
                asm volatile("" ::: "memory");
            }
    }
};

constexpr int TS_RS = 272;
__device__ __forceinline__ void tile_put(const Ctx& c, int row_l, int col_l, const u32x2 v) { *(u32x2*)(c.smem + row_l * TS_RS + col_l * 2) = v; }
template <int NCOL>
__device__ __forceinline__ void tile_flush(const Ctx& c, bf16_t* out, size_t ld, bool valid) {
    __syncthreads();
    constexpr int CPR = NCOL / 8, PER = (128 * CPR) / 256;
#pragma unroll
    for (int i = 0; i < PER; ++i) {
        const int idx = c.tid + 256 * i, row = idx / CPR, ch = idx % CPR;
        const u32x4 v = *(const u32x4*)(c.smem + row * TS_RS + ch * 16);
        if (valid) *(u32x4*)(out + (size_t)row * ld + ch * 8) = v;
    }
    __syncthreads();
}

__device__ __forceinline__ void conv_family(const float* src, int nmat, size_t src_stride, int K, int N, int Nout,
                            bf16_t* dst, size_t dst_stride, int grp, int kind, const Ctx& c) {
    float* lds = (float*)c.smem;
    const int tk = K / 128, tn = Nout / 64, per = tk * tn, total = nmat * per;
    const int tx = c.tid & 15, ty = c.tid >> 4;
    f32x4 r[8];
#define CV_LOAD(u_) do { const int mat_ = (u_) / per, r_ = (u_) - mat_ * per, kt_ = r_ / tn, nt_ = r_ - kt_ * tn; \
        const float* s_ = src + (size_t)mat_ * src_stride + (size_t)(kt_ * 128 + ty) * N + nt_ * 64 + tx * 4; const bool in_ = (nt_ * 64 + tx * 4) < N; \
        _Pragma("unroll") for (int i = 0; i < 8; ++i) r[i] = in_ ? *(const f32x4*)(s_ + (size_t)(16 * i) * N) : (f32x4){0.f, 0.f, 0.f, 0.f}; } while (0)
    if (c.bid < total) CV_LOAD(c.bid);
    for (int base = 0; base < total; base += c.nblk) {
        const int u = base + c.bid; const bool valid = u < total;
#pragma unroll
        for (int i = 0; i < 8; ++i) *(f32x4*)(lds + (ty + 16 * i) * 68 + tx * 4) = r[i];
        if (u + c.nblk < total) CV_LOAD(u + c.nblk);
        __syncthreads();
        if (valid) {
        const int mat = u / per, rr = u - mat * per, kt = rr / tn, nt = rr - kt * tn;
        const int dmat = grp ? (mat / grp) * (grp + 1) + (mat % grp) : mat;
        bf16_t* d = dst + (size_t)dmat * dst_stride;
        const int nl = c.tid & 63, kq = (c.tid >> 6) * 32;
        unsigned w[16];
#pragma unroll
        for (int j = 0; j < 16; ++j) w[j] = pk2(lds[(kq + 2 * j) * 68 + nl], lds[(kq + 2 * j + 1) * 68 + nl]);
        const int n = nt * 64 + nl;
        const int drow = (kind == 0) ? n : ((n >> 4) * 32 + (n & 15) + (kind == 2 ? 16 : 0));
        u32x4* dp = (u32x4*)(d + (size_t)drow * K + kt * 128 + kq);
        dp[0] = (u32x4){w[0], w[1], w[2], w[3]}; dp[1] = (u32x4){w[4], w[5], w[6], w[7]};
        dp[2] = (u32x4){w[8], w[9], w[10], w[11]}; dp[3] = (u32x4){w[12], w[13], w[14], w[15]};
        }
        __syncthreads();
    }
#undef CV_LOAD
}

__device__ __forceinline__ void phase_prologue(const Args& a, const Ctx& c) {
    unsigned char* ws = a.ws;
    bf16_t* WIN = (bf16_t*)(ws + WS_WIN);
    conv_family((const float*)a.in[2], 2, (size_t)1024 * 2472, 1024, 2472, NPAD, WIN, 2 * WIN_ELEMS, 0, 0, c);
    conv_family((const float*)a.in[12], 2, (size_t)1024 * 2312, 1024, 2312, NPAD, WIN + WIN_ELEMS, 2 * WIN_ELEMS, 0, 0, c);
    conv_family((const float*)a.in[4], 2, (size_t)256 * 768, 256, 768, 768, (bf16_t*)(ws + WS_WQB), WQB_ELEMS, 0, 0, c);
    conv_family((const float*)a.in[6], 2, (size_t)128 * 1024, 128, 1024, 1024, (bf16_t*)(ws + WS_WKVB), WKVB_ELEMS, 0, 0, c);
    bf16_t* WOUT = (bf16_t*)(ws + WS_WOUT);
    conv_family((const float*)a.in[11], 2, (size_t)1024 * 1024, 1024, 1024, 1024, WOUT, 2 * WOUT_ELEMS, 0, 0, c);
    conv_family((const float*)a.in[17], 2, (size_t)1024 * 1024, 1024, 1024, 1024, WOUT + WOUT_ELEMS, 2 * WOUT_ELEMS, 0, 0, c);
    conv_family((const float*)a.in[20], 4, (size_t)1024 * 64, 1024, 64, 128, (bf16_t*)(ws + WS_WRT), WRT_ELEMS, 0, 0, c);
    bf16_t* WGU = (bf16_t*)(ws + WS_WGU);
    conv_family((const float*)a.in[22], 256, (size_t)1024 * 256, 1024, 256, 256, WGU, WGU_ELEMS, 64, 1, c);
    conv_family((const float*)a.in[23], 256, (size_t)1024 * 256, 1024, 256, 256, WGU, WGU_ELEMS, 64, 2, c);
    conv_family((const float*)a.in[25], 4, (size_t)1024 * 256, 1024, 256, 256, WGU + 64 * WGU_ELEMS, 65 * WGU_ELEMS, 0, 1, c);
    conv_family((const float*)a.in[26], 4, (size_t)1024 * 256, 1024, 256, 256, WGU + 64 * WGU_ELEMS, 65 * WGU_ELEMS, 0, 2, c);
    bf16_t* WDN = (bf16_t*)(ws + WS_WDN);
    conv_family((const float*)a.in[24], 256, (size_t)256 * 1024, 256, 1024, 1024, WDN, WDN_ELEMS, 64, 0, c);
    conv_family((const float*)a.in[27], 4, (size_t)256 * 1024, 256, 1024, 1024, WDN + 64 * WDN_ELEMS, 65 * WDN_ELEMS, 0, 0, c);
    {
        const float* x = (const float*)a.in[0]; bf16_t* xb = (bf16_t*)(ws + WS_XBF);
        const size_t n8 = (size_t)T * 1024 / 8;
        for (size_t i = (size_t)c.bid * 256 + c.tid; i < n8; i += (size_t)c.nblk * 256) {
            const f32x4 v0 = *(const f32x4*)(x + i * 8), v1 = *(const f32x4*)(x + i * 8 + 4);
            *(u32x4*)(xb + i * 8) = (u32x4){pk2(v0[0], v0[1]), pk2(v0[2], v0[3]), pk2(v1[0], v1[1]), pk2(v1[2], v1[3])};
        }
    }
    {
        const int* pos = (const int*)a.in[1];
        float* rm = (float*)(ws + WS_ROPEM); float* rs = (float*)(ws + WS_ROPES);
        const float ln_theta = 9.210340371976184f;
        for (int i = c.bid * 256 + c.tid; i < T * 16; i += c.nblk * 256) {
            const int t = i >> 4, f = i & 15;
            const float inv = expf(-((float)(2 * f) / 32.f) * ln_theta);
            const float ang = (float)pos[t] * inv;
            rm[i * 2] = cosf(ang); rm[i * 2 + 1] = sinf(ang);
        }
        for (int i = c.bid * 256 + c.tid; i < T * 32; i += c.nblk * 256) {
            const int t = i >> 5, f = i & 31;
            const float inv = expf(-((float)(2 * f) / 64.f) * ln_theta);
            const float ang = (float)pos[t] * inv;
            rs[i * 2] = cosf(ang); rs[i * 2 + 1] = sinf(ang);
        }
    }
}

__device__ __forceinline__ void phase_inproj(const bf16_t* XBF, const bf16_t* W, bf16_t* PROJ, float* GATES, int gbase, const Ctx& c) {
    const int ntn = NPAD / 128;
    for (int i = 0;; ++i) {
        int mt, nt; bool valid; if (!tile_map2(i, c, T / 128, ntn, mt, nt, valid)) break;
        const bf16_t* a0 = XBF + (size_t)(mt * 128 + (c.tid >> 2)) * 1024;
        const bf16_t* b0 = W + (size_t)(nt * 128 + (c.tid >> 2)) * 1024;
        f32x4 acc[4][4];
        gemm_tile(a0, a0 + 64 * 1024, b0, b0 + 64 * 1024, 32, acc, c);
#pragma unroll
        for (int m = 0; m < 4; ++m) {
            const int rl = c.wr * 64 + m * 16 + c.fr, row = mt * 128 + rl;
#pragma unroll
            for (int n = 0; n < 4; ++n) {
                const int cl = c.wc * 64 + n * 16 + c.fq * 4, col = nt * 128 + cl;
                const f32x4 v = acc[m][n];
                tile_put(c, rl, cl, (u32x2){pk2(v[0], v[1]), pk2(v[2], v[3])});
                if (valid && col >= gbase && col < gbase + 8) *(f32x4*)(GATES + (size_t)row * 8 + (col - gbase)) = v;
            }
        }
        tile_flush<128>(c, PROJ + (size_t)mt * 128 * NPAD + nt * 128, NPAD, valid);
    }
}

constexpr int MLAUP_TILES = (T / 128) * 6 + (T / 128) * 8;
__device__ __forceinline__ void mla_up_tile(int u, const bf16_t* CQ, const bf16_t* WQB, const bf16_t* CKV, const bf16_t* WKVB,
                             const float* ROPEM, bf16_t* QF, bf16_t* KN, bf16_t* VV, const Ctx& c) {
    const int tq = (T / 128) * 6;
    const float qscale = 0.10206207261596577f * 1.4426950408889634f;
    {
        f32x4 acc[4][4];
        if (u < tq) {
            const int mt = u / 6, nt = u % 6;
            const bf16_t* a0 = CQ + (size_t)(mt * 128 + (c.tid >> 2)) * 256;
            const bf16_t* b0 = WQB + (size_t)(nt * 128 + (c.tid >> 2)) * 256;
            gemm_tile(a0, a0 + 64 * 256, b0, b0 + 64 * 256, 8, acc, c);
#pragma unroll
            for (int m = 0; m < 4; ++m) {
                const int row = mt * 128 + c.wr * 64 + m * 16 + c.fr;
#pragma unroll
                for (int np = 0; np < 2; ++np) {
                    const int cg = nt * 128 + c.wc * 64 + np * 32;
                    f32x4 v0 = acc[m][2 * np], v1 = acc[m][2 * np + 1];
                    if (((cg >> 5) % 3) == 2) {
#pragma unroll
                        for (int j = 0; j < 4; ++j) {
                            const int i = c.fq * 4 + j;
                            const float cs = ROPEM[((size_t)row * 16 + i) * 2], sn = ROPEM[((size_t)row * 16 + i) * 2 + 1];
                            const float x1 = v0[j], x2 = v1[j];
                            v0[j] = x1 * cs - x2 * sn; v1[j] = x2 * cs + x1 * sn;
                        }
                    }
                    v0 *= qscale; v1 *= qscale;
                    *(u32x2*)(QF + (size_t)row * 768 + cg + c.fq * 4) = (u32x2){pk2(v0[0], v0[1]), pk2(v0[2], v0[3])};
                    *(u32x2*)(QF + (size_t)row * 768 + cg + 16 + c.fq * 4) = (u32x2){pk2(v1[0], v1[1]), pk2(v1[2], v1[3])};
                }
            }
        } else {
            const int v = u - tq, mt = v / 8, nt = v % 8;
            const bf16_t* a0 = CKV + (size_t)(mt * 128 + (c.tid >> 2)) * 128;
            const bf16_t* b0 = WKVB + (size_t)(nt * 128 + (c.tid >> 2)) * 128;
            gemm_tile(a0, a0 + 64 * 128, b0, b0 + 64 * 128, 4, acc, c);
            bf16_t* dst = (c.wc == 0) ? KN : VV;
#pragma unroll
            for (int m = 0; m < 4; ++m) {
                const int row = mt * 128 + c.wr * 64 + m * 16 + c.fr;
#pragma unroll
                for (int n = 0; n < 4; ++n) {
                    const f32x4 x = acc[m][n];
                    *(u32x2*)(dst + (size_t)row * 512 + nt * 64 + n * 16 + c.fq * 4) = (u32x2){pk2(x[0], x[1]), pk2(x[2], x[3])};
                }
            }
        }
    }
}

__device__ __forceinline__ void phase_outproj(const bf16_t* MIXO, const bf16_t* W, const float* xres, float* YBUF, const Ctx& c) {
    for (int i = 0;; ++i) {
        int mt, nt; bool valid; if (!tile_map2(i, c, T / 128, 8, mt, nt, valid)) break;
        const bf16_t* a0 = MIXO + (size_t)(mt * 128 + (c.tid >> 2)) * 1024;
        const bf16_t* b0 = W + (size_t)(nt * 128 + (c.tid >> 2)) * 1024;
        f32x4 acc[4][4];
        gemm_tile(a0, a0 + 64 * 1024, b0, b0 + 64 * 1024, 32, acc, c);
#pragma unroll
        for (int m = 0; m < 4; ++m) {
            const int row = mt * 128 + c.wr * 64 + m * 16 + c.fr;
#pragma unroll
            for (int n = 0; n < 4; ++n) {
                const int col = nt * 128 + c.wc * 64 + n * 16 + c.fq * 4;
                const f32x4 xr = *(const f32x4*)(xres + (size_t)row * 1024 + col);
                if (valid) *(f32x4*)(YBUF + (size_t)row * 1024 + col) = xr * ALPHA + acc[m][n];
            }
        }
    }
}

__device__ __forceinline__ void phase_router(const bf16_t* XBF, const bf16_t* W, float* LOG, const Ctx& c) {
    for (int base = 0; base < T / 128; base += c.nblk) {
        const bool valid = (base + c.bid) < T / 128; const int mt = valid ? base + c.bid : 0;
        const bf16_t* a0 = XBF + (size_t)(mt * 128 + (c.tid >> 2)) * 1024;
        const bf16_t* b0 = W + (size_t)(c.tid >> 2) * 1024;
        f32x4 acc[4][4];
        gemm_tile(a0, a0 + 64 * 1024, b0, b0 + 64 * 1024, 32, acc, c);
        if (c.wc == 0 && valid) {
#pragma unroll
            for (int m = 0; m < 4; ++m) {
                const int row = mt * 128 + c.wr * 64 + m * 16 + c.fr;
#pragma unroll
                for (int n = 0; n < 4; ++n) *(f32x4*)(LOG + (size_t)row * 64 + n * 16 + c.fq * 4) = acc[m][n];
            }
        }
    }
}

__device__ __forceinline__ void build_block_table(const unsigned* CNT, int* bst, const Ctx& c) {
    __syncthreads();
    if (c.wid == 0) {
        const int cnt = (int)__hip_atomic_load(CNT + c.lane, __ATOMIC_RELAXED, __HIP_MEMORY_SCOPE_AGENT);
        const int nb = (cnt + RBR - 1) / RBR;
        int inc = nb;
#pragma unroll
        for (int o = 1; o < 64; o <<= 1) { const int x = __shfl_up(inc, o); if (c.lane >= o) inc += x; }
        bst[c.lane] = inc - nb; bst[66 + c.lane] = cnt;
        if (c.lane == 63) { bst[64] = inc; bst[65] = inc + T / RBR; bst[66 + 64] = T; }
    }
    __syncthreads();
}
__device__ __forceinline__ int find_expert(const int* bst, int rb, const Ctx& c) {
    return __popcll(__ballot(bst[1 + c.lane] <= rb));
}

__device__ __forceinline__ void phase_moe1(const bf16_t* XBF, const bf16_t* WGU, const unsigned* CNT, const int* LTOK, const float* LW, bf16_t* HBUF, const Ctx& c) {
    int* bst = (int*)(c.smem + 65536 + 64);
    build_block_table(CNT, bst, c);
    const int nsb = bst[65] * 2;
    for (int i = 0;; ++i) {
        int sbk, nt; bool valid; if (!tile_map2(i, c, nsb, 4, sbk, nt, valid)) break;
        const int rb = sbk >> 1, hb = sbk & 1;
        const int e = find_expert(bst, rb, c);
        const int lb = rb - bst[e], cnt = bst[66 + e];
        const int p0 = lb * RBR + hb * 128 + (c.tid >> 2), p1 = p0 + 64;
        const int t0 = (p0 < cnt) ? LTOK[(size_t)e * CAP + p0] : 0;
        const int t1 = (p1 < cnt) ? LTOK[(size_t)e * CAP + p1] : 0;
        const bf16_t* a0 = XBF + (size_t)t0 * 1024;
        const bf16_t* a1 = XBF + (size_t)t1 * 1024;
        const bf16_t* b0 = WGU + (size_t)e * WGU_ELEMS + (size_t)(nt * 128 + (c.tid >> 2)) * 1024;
        f32x4 acc[4][4];
        gemm_tile(a0, a1, b0, b0 + 64 * 1024, 32, acc, c);
#pragma unroll
        for (int m = 0; m < 4; ++m) {
            const int rl = c.wr * 64 + m * 16 + c.fr;
            const int pw = lb * RBR + hb * 128 + rl;
            const float wrow = (pw < cnt) ? LW[(size_t)e * CAP + pw] : 0.f;
#pragma unroll
            for (int n = 0; n < 2; ++n) {
                const f32x4 g = acc[m][n], up = acc[m][n + 2];
                float h[4];
#pragma unroll
                for (int j = 0; j < 4; ++j) h[j] = siluf_(g[j]) * up[j] * wrow;
                tile_put(c, rl, c.wc * 32 + n * 16 + c.fq * 4, (u32x2){pk2(h[0], h[1]), pk2(h[2], h[3])});
            }
        }
        tile_flush<64>(c, HBUF + ((size_t)rb * RBR + hb * 128) * 256 + nt * 64, 256, valid);
    }
}

__device__ __forceinline__ void phase_moe2(const bf16_t* HBUF, const bf16_t* WDN, const unsigned* CNT, bf16_t* Y, const Ctx& c) {
    int* bst = (int*)(c.smem + 65536 + 64);
    build_block_table(CNT, bst, c);
    const int nsb = bst[65] * 2;
    for (int i = 0;; ++i) {
        int sbk, nt; bool valid; if (!tile_map2(i, c, nsb, 8, sbk, nt, valid)) break;
        const int rb = sbk >> 1;
        const int e = find_expert(bst, rb, c);
        const bf16_t* a0 = HBUF + ((size_t)sbk * 128 + (c.tid >> 2)) * 256;
        const bf16_t* b0 = WDN + (size_t)e * WDN_ELEMS + (size_t)(nt * 128 + (c.tid >> 2)) * 256;
        f32x4 acc[4][4];
        gemm_tile(a0, a0 + 64 * 256, b0, b0 + 64 * 256, 8, acc, c);
#pragma unroll
        for (int m = 0; m < 4; ++m) {
            const int lr = c.wr * 64 + m * 16 + c.fr;
#pragma unroll
            for (int n = 0; n < 4; ++n) {
                const f32x4 v = acc[m][n];
                tile_put(c, lr, c.wc * 64 + n * 16 + c.fq * 4, (u32x2){pk2(v[0], v[1]), pk2(v[2], v[3])});
            }
        }
        tile_flush<128>(c, Y + (size_t)sbk * 128 * 1024 + nt * 128, 1024, valid);
    }
}

__device__ __forceinline__ float dppf(float v, int ctrl_sel) {
    int x = __builtin_bit_cast(int, v), r;
    if (ctrl_sel == 0) r = __builtin_amdgcn_update_dpp(0, x, 0xB1, 0xF, 0xF, true);
    else if (ctrl_sel == 1) r = __builtin_amdgcn_update_dpp(0, x, 0x4E, 0xF, 0xF, true);
    else if (ctrl_sel == 2) r = __builtin_amdgcn_update_dpp(0, x, 0x141, 0xF, 0xF, true);
    else r = __builtin_amdgcn_update_dpp(0, x, 0x140, 0xF, 0xF, true);
    return __builtin_bit_cast(float, r);
}
__device__ __forceinline__ float red16(float v) { v += dppf(v, 0); v += dppf(v, 1); v += dppf(v, 2); v += dppf(v, 3); return v; }

template <bool F32OUT>
__device__ __forceinline__ void ln_row_store(float (&v)[16], const float* g, const float* b, float* of32, bf16_t* obf, int lane) {
    float s = 0.f;
#pragma unroll
    for (int i = 0; i < 16; ++i) s += v[i];
    const float mean = wave_sum(s) * (1.f / 1024.f);
    float q = 0.f;
#pragma unroll
    for (int i = 0; i < 16; ++i) { v[i] -= mean; q += v[i] * v[i]; }
    const float rstd = rsqrtf(wave_sum(q) * (1.f / 1024.f) + 1e-5f);
#pragma unroll
    for (int hf = 0; hf < 2; ++hf) {
        const int col = hf * 512 + lane * 8;
        const f32x4 g0 = *(const f32x4*)(g + col), g1 = *(const f32x4*)(g + col + 4);
        const f32x4 b0 = *(const f32x4*)(b + col), b1 = *(const f32x4*)(b + col + 4);
        f32x4 y0, y1;
#pragma unroll
        for (int j = 0; j < 4; ++j) { y0[j] = v[hf * 8 + j] * rstd * g0[j] + b0[j]; y1[j] = v[hf * 8 + 4 + j] * rstd * g1[j] + b1[j]; }
        if constexpr (F32OUT) { *(f32x4*)(of32 + col) = y0; *(f32x4*)(of32 + col + 4) = y1; }
        *(u32x4*)(obf + col) = (u32x4){pk2(y0[0], y0[1]), pk2(y0[2], y0[3]), pk2(y1[0], y1[1]), pk2(y1[2], y1[3])};
    }
}

__device__ __forceinline__ void phase_ln1(const bf16_t* YBUF, const float* g, const float* b, bf16_t* XBF, const Ctx& c) {
    for (int t = c.bid * 4 + c.wid; t < T; t += c.nblk * 4) {
        float v[16];
#pragma unroll
        for (int hf = 0; hf < 2; ++hf) {
            const u32x4 r = *(const u32x4*)(YBUF + (size_t)t * 1024 + hf * 512 + c.lane * 8);
            float f[8]; unpack8(r, f);
#pragma unroll
            for (int j = 0; j < 8; ++j) v[hf * 8 + j] = f[j];
        }
        ln_row_store<false>(v, g, b, nullptr, XBF + (size_t)t * 1024, c.lane);
    }
}

template <bool LASTL>
__device__ __forceinline__ void phase_combine(const bf16_t* Y, const int* ASG, const float* ASGW, const unsigned* CNT, const float* g, const float* b,
                              float* XOUT, bf16_t* XBF, const Ctx& c) {
    int* bst = (int*)(c.smem + 65536 + 64);
    build_block_table(CNT, bst, c);
    for (int t = c.bid * 4 + c.wid; t < T; t += c.nblk * 4) {
        float v[16];
#pragma unroll
        for (int hf = 0; hf < 2; ++hf) {
            const u32x4 r = *(const u32x4*)(XBF + (size_t)t * 1024 + hf * 512 + c.lane * 8);
            float f[8]; unpack8(r, f);
#pragma unroll
            for (int j = 0; j < 8; ++j) v[hf * 8 + j] = f[j] * ALPHA;
        }
#pragma unroll
        for (int k = 0; k < 9; ++k) {
            size_t crow; float wk = 1.f;
            if (k < 8) { const int asg = ASG[(size_t)t * 8 + k]; crow = (size_t)bst[asg >> 16] * RBR + (asg & 0xffff); wk = ASGW[(size_t)t * 8 + k]; }
            else crow = (size_t)bst[64] * RBR + t;
#pragma unroll
            for (int hf = 0; hf < 2; ++hf) {
                const u32x4 r = *(const u32x4*)(Y + crow * 1024 + hf * 512 + c.lane * 8);
                float f[8]; unpack8(r, f);
#pragma unroll
                for (int j = 0; j < 8; ++j) v[hf * 8 + j] += f[j] * wk;
            }
        }
        ln_row_store<LASTL>(v, g, b, XOUT + (size_t)t * 1024, XBF + (size_t)t * 1024, c.lane);
    }
}

__device__ __forceinline__ void phase_route(const float* LOG, const float* rb, unsigned* CNT, int* LTOK, float* LW, int* ASG, float* ASGW, const Ctx& c) {
    int* lcnt = (int*)c.smem;
    int* lbase = lcnt + 64;
    int* sel_e = lbase + 64;
    int* sel_p = sel_e + 256;
    float* sel_w = (float*)(sel_p + 256);
    const float rbias = rb[c.lane];
    for (int base = 0; base < T / 32; base += c.nblk) {
        const int ch = base + c.bid; const bool valid = ch < T / 32;
        __syncthreads();
        if (c.tid < 64) lcnt[c.tid] = 0;
        __syncthreads();
        if (valid) for (int tl = c.wid; tl < 32; tl += 4) {
            const int t = ch * 32 + tl;
            const float lg = LOG[(size_t)t * 64 + c.lane];
            const float sc = 1.f / (1.f + expf(-lg));
            const float v = sc + rbias;
            float m1 = v;
            m1 = fmaxf(m1, __shfl_xor(m1, 1)); m1 = fmaxf(m1, __shfl_xor(m1, 2)); m1 = fmaxf(m1, __shfl_xor(m1, 4));
            int cand = (v == m1) ? c.lane : 999;
            cand = min(cand, __shfl_xor(cand, 1)); cand = min(cand, __shfl_xor(cand, 2)); cand = min(cand, __shfl_xor(cand, 4));
            float m2 = (c.lane == cand) ? -INFINITY : v;
            m2 = fmaxf(m2, __shfl_xor(m2, 1)); m2 = fmaxf(m2, __shfl_xor(m2, 2)); m2 = fmaxf(m2, __shfl_xor(m2, 4));
            const float gs = m1 + m2;
            const int g = c.lane >> 3;
            int grank = 0;
#pragma unroll
            for (int gg = 0; gg < 8; ++gg) { const float o = __shfl(gs, gg * 8); grank += ((o > gs) || (o == gs && gg < g)) ? 1 : 0; }
            const bool gsel = grank < 4;
            const float mv = gsel ? v : -INFINITY;
            int rank = 0;
#pragma unroll 8
            for (int jj = 0; jj < 64; ++jj) { const float o = __shfl(mv, jj); rank += ((o > mv) || (o == mv && jj < c.lane)) ? 1 : 0; }
            const bool sel = gsel && rank < 8;
            const float ssum = wave_sum(sel ? sc : 0.f);
            const float w = sc / ssum * 2.5f;
            const unsigned long long bal = __ballot(sel);
            const int slot = __popcll(bal & ((1ull << c.lane) - 1ull));
            if (sel) {
                const int p = atomicAdd(&lcnt[c.lane], 1);
                sel_e[tl * 8 + slot] = c.lane; sel_p[tl * 8 + slot] = p; sel_w[tl * 8 + slot] = w;
            }
        }
        __syncthreads();
        if (valid && c.tid < 64) { const int n = lcnt[c.tid]; lbase[c.tid] = n ? (int)atomicAdd(CNT + c.tid, (unsigned)n) : 0; }
        __syncthreads();
        if (valid) {
            const int tl = c.tid >> 3, t = ch * 32 + tl;
            const int e = sel_e[c.tid], pos = lbase[e] + sel_p[c.tid];
            LTOK[(size_t)e * CAP + pos] = t; LW[(size_t)e * CAP + pos] = sel_w[c.tid];
            ASG[(size_t)t * 8 + (c.tid & 7)] = (e << 16) | pos; ASGW[(size_t)t * 8 + (c.tid & 7)] = sel_w[c.tid];
            if (c.tid < 32) { const int ts = ch * 32 + c.tid; LTOK[(size_t)64 * CAP + ts] = ts; LW[(size_t)64 * CAP + ts] = 1.f; }
        }
    }
}

__device__ __forceinline__ void phase_prep_even(const bf16_t* PROJ, const float* GATES, const float* qn, const float* kvn, const float* cw,
                                const float* a_log, const float* dt_bias, const float* ROPEM,
                                bf16_t* CQ, bf16_t* CKV, bf16_t* KROPE, bf16_t* GQ, bf16_t* GK, bf16_t* GV, float* BETA, float* GLOG, const Ctx& c) {
    const int lane = c.lane;
    float* cwL = (float*)c.smem;
    __syncthreads();
    for (int i = c.tid; i < 4 * 1536 / 4; i += 256) *(f32x4*)(cwL + i * 4) = *(const f32x4*)(cw + i * 4);
    __syncthreads();
    for (int t = c.bid * 4 + c.wid; t < T; t += c.nblk * 4) {
        const bf16_t* pr = PROJ + (size_t)t * NPAD;
        {
            const u32x2 r = *(const u32x2*)(pr + lane * 4);
            float v[4] = {bflo(r.x), bfhi(r.x), bflo(r.y), bfhi(r.y)};
            const float ss = wave_sum(v[0] * v[0] + v[1] * v[1] + v[2] * v[2] + v[3] * v[3]);
            const float rr = rsqrtf(ss * (1.f / 256.f) + 1e-6f);
            const f32x4 gq = *(const f32x4*)(qn + lane * 4);
            *(u32x2*)(CQ + (size_t)t * 256 + lane * 4) = (u32x2){pk2(v[0] * rr * gq[0], v[1] * rr * gq[1]), pk2(v[2] * rr * gq[2], v[3] * rr * gq[3])};
        }
        {
            const unsigned r = *(const unsigned*)(pr + 256 + lane * 2);
            const float v0 = bflo(r), v1 = bfhi(r);
            const float ss = wave_sum(v0 * v0 + v1 * v1);
            const float rr = rsqrtf(ss * (1.f / 128.f) + 1e-6f);
            *(unsigned*)(CKV + (size_t)t * 128 + lane * 2) = pk2(v0 * rr * kvn[lane * 2], v1 * rr * kvn[lane * 2 + 1]);
        }
        if (lane < 16) {
            const float x1 = bf2f(pr[384 + lane]), x2 = bf2f(pr[400 + lane]);
            const float cs = ROPEM[((size_t)t * 16 + lane) * 2], sn = ROPEM[((size_t)t * 16 + lane) * 2 + 1];
            KROPE[(size_t)t * 32 + lane] = (bf16_t)f2bf(x1 * cs - x2 * sn);
            KROPE[(size_t)t * 32 + 16 + lane] = (bf16_t)f2bf(x2 * cs + x1 * sn);
        }
        const int s = t & (SEQ - 1);
        u32x4 xr[3][4];
#pragma unroll
        for (int arr = 0; arr < 3; ++arr)
#pragma unroll
            for (int w = 0; w < 4; ++w)
                xr[arr][w] = (s - 3 + w >= 0) ? *(const u32x4*)(PROJ + (size_t)(t - 3 + w) * NPAD + 416 + arr * 512 + lane * 8) : (u32x4){0u, 0u, 0u, 0u};
#pragma unroll
        for (int arr = 0; arr < 3; ++arr) {
            float y[8];
#pragma unroll
            for (int j = 0; j < 8; ++j) y[j] = 0.f;
#pragma unroll
            for (int w = 0; w < 4; ++w) {
                float f[8]; unpack8(xr[arr][w], f);
                const f32x4 c0 = *(const f32x4*)(cwL + w * 1536 + arr * 512 + lane * 8), c1 = *(const f32x4*)(cwL + w * 1536 + arr * 512 + lane * 8 + 4);
#pragma unroll
                for (int j = 0; j < 4; ++j) { y[j] += c0[j] * f[j]; y[4 + j] += c1[j] * f[4 + j]; }
            }
            float ss = 0.f;
#pragma unroll
            for (int j = 0; j < 8; ++j) { y[j] = siluf_(y[j]); ss += y[j] * y[j]; }
            if (arr < 2) {
                float rr = rsqrtf(red16(ss) + 1e-6f);
                if (arr == 0) rr *= 0.08838834764831845f;
#pragma unroll
                for (int j = 0; j < 8; ++j) y[j] *= rr;
            }
            bf16_t* dst = (arr == 0) ? GQ : (arr == 1) ? GK : GV;
            *(u32x4*)(dst + (size_t)t * 512 + lane * 8) = (u32x4){pk2(y[0], y[1]), pk2(y[2], y[3]), pk2(y[4], y[5]), pk2(y[6], y[7])};
        }
        if (lane < 4) BETA[(size_t)t * 4 + lane] = sigmoidf_(GATES[(size_t)t * 8 + lane]);
        else if (lane < 8) { const int h = lane - 4; GLOG[(size_t)t * 4 + h] = -expf(a_log[h]) * softplusf_(GATES[(size_t)t * 8 + lane] + dt_bias[h]); }
    }
}

__device__ __forceinline__ void phase_prep_odd(const bf16_t* PROJ, const float* ROPES, bf16_t* SQ, bf16_t* SK, const Ctx& c) {
    const int lane = c.lane;
    for (int t = c.bid * 4 + c.wid; t < T; t += c.nblk * 4) {
        const bf16_t* pr = PROJ + (size_t)t * NPAD;
        const int i = lane & 31;
        const float cs = ROPES[((size_t)t * 32 + i) * 2], sn = ROPES[((size_t)t * 32 + i) * 2 + 1];
#pragma unroll
        for (int r = 0; r < 4; ++r) {
            const int h = (lane >> 5) + 2 * r;
            const float x1 = bf2f(pr[1544 + h * 64 + i]), x2 = bf2f(pr[1544 + h * 64 + 32 + i]);
            SQ[(size_t)t * 512 + h * 64 + i] = (bf16_t)f2bf((x1 * cs - x2 * sn) * 0.18033688011112042f);
            SQ[(size_t)t * 512 + h * 64 + 32 + i] = (bf16_t)f2bf((x2 * cs + x1 * sn) * 0.18033688011112042f);
        }
        {
            const int h = lane >> 5;
            const float x1 = bf2f(pr[2056 + h * 64 + i]), x2 = bf2f(pr[2056 + h * 64 + 32 + i]);
            SK[(size_t)t * 128 + h * 64 + i] = (bf16_t)f2bf(x1 * cs - x2 * sn);
            SK[(size_t)t * 128 + h * 64 + 32 + i] = (bf16_t)f2bf(x2 * cs + x1 * sn);
        }
    }
}

__device__ __forceinline__ int next_unit(unsigned* ctr, const Ctx& c) {
    volatile int* su = (volatile int*)(c.smem0 + LDS_BLK + 16);
    __syncthreads();
    if (c.tid0 == 0) *su = (int)atomicAdd(ctr, 1u);
    __syncthreads();
    return *su * 2 + c.half;
}

typedef float f32x16 __attribute__((ext_vector_type(16)));
typedef short s16x4 __attribute__((ext_vector_type(4)));
#define MFMA32(a, b, c) __builtin_amdgcn_mfma_f32_32x32x16_bf16((a), (b), (c), 0, 0, 0)
template <int S_> __device__ __forceinline__ bf16x8 pack_step(const f32x16& x) {
    u32x4 p;
    asm volatile("v_cvt_pk_bf16_f32 %0, %4, %5\n\tv_cvt_pk_bf16_f32 %1, %6, %7\n\tv_cvt_pk_bf16_f32 %2, %8, %9\n\tv_cvt_pk_bf16_f32 %3, %10, %11\n\ts_nop 1"
                 : "=&v"(p[0]), "=&v"(p[1]), "=&v"(p[2]), "=&v"(p[3])
                 : "v"(x[8 * S_]), "v"(x[8 * S_ + 1]), "v"(x[8 * S_ + 2]), "v"(x[8 * S_ + 3]), "v"(x[8 * S_ + 4]), "v"(x[8 * S_ + 5]), "v"(x[8 * S_ + 6]), "v"(x[8 * S_ + 7]));
    return __builtin_bit_cast(bf16x8, p);
}
template <int S_> __device__ __forceinline__ bf16x8 pack_step_m(const f32x16& x) {
    u32x4 p;
    asm volatile("s_nop 15\n\tv_cvt_pk_bf16_f32 %0, %4, %5\n\tv_cvt_pk_bf16_f32 %1, %6, %7\n\tv_cvt_pk_bf16_f32 %2, %8, %9\n\tv_cvt_pk_bf16_f32 %3, %10, %11\n\ts_nop 1"
                 : "=&v"(p[0]), "=&v"(p[1]), "=&v"(p[2]), "=&v"(p[3])
                 : "v"(x[8 * S_]), "v"(x[8 * S_ + 1]), "v"(x[8 * S_ + 2]), "v"(x[8 * S_ + 3]), "v"(x[8 * S_ + 4]), "v"(x[8 * S_ + 5]), "v"(x[8 * S_ + 6]), "v"(x[8 * S_ + 7]));
    return __builtin_bit_cast(bf16x8, p);
}
constexpr int ATT_VB = 64 * 128;

template <int NKS, bool WIN>
__device__ __forceinline__ void attn_unit(const bf16_t* Qp, int q_ld, const bf16_t* K1, int k1_ld, const bf16_t* K2, int k2_ld, const bf16_t* Vp, int v_ld,
                          bf16_t* Op, int o_ld, int Q0, float sink_l2, const Ctx& c) {
    constexpr int KB = NKS * 2 * 1024, BUF = KB + ATT_VB;
    const int lane = c.lane, r = lane & 31, h = lane >> 5;
    const int wid = __builtin_amdgcn_readfirstlane(c.wid);
    const int q0w = Q0 + wid * 32;
    unsigned char* smem = c.smem;
    bf16x8 qf[NKS];
#pragma unroll
    for (int ks = 0; ks < NKS; ++ks) qf[ks] = *(const bf16x8*)(Qp + (size_t)(q0w + r) * q_ld + ks * 16 + h * 8);
    f32x16 o0, o1;
#pragma unroll
    for (int i = 0; i < 16; ++i) { o0[i] = 0.f; o1[i] = 0.f; }
    float m = WIN ? sink_l2 : -1e30f, l = (WIN && h == 0) ? 1.f : 0.f;
    const int kt_lo = WIN ? ((Q0 >> 6) - 2 < 0 ? 0 : (Q0 >> 6) - 2) : 0, kt_hi = (Q0 >> 6) + 1;
#define ATT_STAGE(kt_, buf_) do { unsigned char* bp = smem + (buf_) * BUF; const size_t kb = (size_t)(kt_) * 64; \
        _Pragma("unroll") for (int i = 0; i < (NKS * 2) / 4; ++i) { const int ch = wid + 4 * i; \
            const bf16_t* sp = (ch < 8) ? (K1 + (kb + lane) * k1_ld + ch * 8) : (K2 + (kb + lane) * k2_ld + (ch - 8) * 8); \
            glds16(sp, bp + ch * 1024 + lane * 16); } \
        _Pragma("unroll") for (int i = 0; i < 2; ++i) { const int j = wid + 4 * i; \
            glds16(Vp + (kb + 8 * j + (lane >> 3)) * v_ld + (lane & 7) * 8, bp + KB + j * 1024 + lane * 16); } } while (0)
    ATT_STAGE(kt_lo, 0);
    const int i16 = lane & 15;
    const unsigned vlane = (unsigned)((4 * h + (i16 >> 2)) * 128 + 32 * ((lane >> 4) & 1) + 8 * (i16 & 3));
    for (int kt = kt_lo; kt <= kt_hi; ++kt) {
        const int cur = (kt - kt_lo) & 1;
        asm volatile("s_waitcnt vmcnt(0)" ::: "memory");
        __syncthreads();
        if (kt < kt_hi) ATT_STAGE(kt + 1, cur ^ 1);
        const int k0 = kt * 64;
        const bool active = (k0 <= q0w + 31) && (!WIN || (k0 + 63 > q0w - 128));
        if (active) {
            const unsigned char* Kt = smem + cur * BUF;
            f32x16 x0, x1;
#pragma unroll
            for (int i = 0; i < 16; ++i) { x0[i] = 0.f; x1[i] = 0.f; }
#pragma unroll
            for (int ks = 0; ks < NKS; ++ks) {
                const bf16x8 kf0 = *(const bf16x8*)(Kt + (ks * 2 + h) * 1024 + r * 16);
                const bf16x8 kf1 = *(const bf16x8*)(Kt + (ks * 2 + h) * 1024 + (32 + r) * 16);
                x0 = MFMA32(kf0, qf[ks], x0); x1 = MFMA32(kf1, qf[ks], x1);
            }
            const bool need_mask = (k0 + 63 > q0w) || (WIN && (k0 <= q0w + 31 - 128));
            if (need_mask) {
                const int q = q0w + r;
#pragma unroll
                for (int i = 0; i < 16; ++i) {
                    const int key = k0 + (i & 3) + 8 * (i >> 2) + 4 * h;
                    const bool v0 = (key <= q) && (!WIN || key > q - 128);
                    const bool v1 = (key + 32 <= q) && (!WIN || key + 32 > q - 128);
                    x0[i] = v0 ? x0[i] : -INFINITY; x1[i] = v1 ? x1[i] : -INFINITY;
                }
            }
            float mx = fmaxf(x0[0], x1[0]);
#pragma unroll
            for (int i = 1; i < 16; ++i) mx = fmaxf(mx, fmaxf(x0[i], x1[i]));
            mx = fmaxf(mx, __shfl_xor(mx, 32));
            const float mn = fmaxf(m, mx);
            const float alpha = __builtin_amdgcn_exp2f(m - mn);
            m = mn;
            float ps = 0.f;
#pragma unroll
            for (int i = 0; i < 16; ++i) { x0[i] = __builtin_amdgcn_exp2f(x0[i] - mn); x1[i] = __builtin_amdgcn_exp2f(x1[i] - mn); ps += x0[i] + x1[i]; }
            l = l * alpha + ps;
            o0 *= alpha; o1 *= alpha;
            const unsigned vbase = (unsigned)(size_t)(smem + cur * BUF + KB) + vlane;
#pragma unroll
            for (int t = 0; t < 2; ++t) {
                s16x4 l00, h00, l01, h01, l10, h10, l11, h11;
                const unsigned va = vbase + t * 4096;
                asm volatile("ds_read_b64_tr_b16 %0, %8\n\t"
                             "ds_read_b64_tr_b16 %1, %8 offset:1024\n\t"
                             "ds_read_b64_tr_b16 %2, %8 offset:64\n\t"
                             "ds_read_b64_tr_b16 %3, %8 offset:1088\n\t"
                             "ds_read_b64_tr_b16 %4, %8 offset:2048\n\t"
                             "ds_read_b64_tr_b16 %5, %8 offset:3072\n\t"
                             "ds_read_b64_tr_b16 %6, %8 offset:2112\n\t"
                             "ds_read_b64_tr_b16 %7, %8 offset:3136\n\t"
                             "s_waitcnt lgkmcnt(0)"
                             : "=&v"(l00), "=&v"(h00), "=&v"(l01), "=&v"(h01), "=&v"(l10), "=&v"(h10), "=&v"(l11), "=&v"(h11) : "v"(va) : "memory");
                const bf16x8 v00 = __builtin_shufflevector(l00, h00, 0, 1, 2, 3, 4, 5, 6, 7), v01 = __builtin_shufflevector(l01, h01, 0, 1, 2, 3, 4, 5, 6, 7);
                const bf16x8 v10 = __builtin_shufflevector(l10, h10, 0, 1, 2, 3, 4, 5, 6, 7), v11 = __builtin_shufflevector(l11, h11, 0, 1, 2, 3, 4, 5, 6, 7);
                const bf16x8 pb0 = (t == 0) ? pack_step<0>(x0) : pack_step<0>(x1);
                const bf16x8 pb1 = (t == 0) ? pack_step<1>(x0) : pack_step<1>(x1);
                o0 = MFMA32(v00, pb0, o0); o1 = MFMA32(v01, pb0, o1);
                o0 = MFMA32(v10, pb1, o0); o1 = MFMA32(v11, pb1, o1);
            }
        }
    }
#undef ATT_STAGE
    l += __shfl_xor(l, 32);
    const float inv = 1.f / l;
    bf16_t* orow = Op + (size_t)(q0w + r) * o_ld + 4 * h;
#pragma unroll
    for (int g = 0; g < 4; ++g) {
        *(u32x2*)(orow + 8 * g) = (u32x2){pk2(o0[4 * g] * inv, o0[4 * g + 1] * inv), pk2(o0[4 * g + 2] * inv, o0[4 * g + 3] * inv)};
        *(u32x2*)(orow + 32 + 8 * g) = (u32x2){pk2(o1[4 * g] * inv, o1[4 * g + 1] * inv), pk2(o1[4 * g + 2] * inv, o1[4 * g + 3] * inv)};
    }
}

constexpr size_t MLC_DC = 0, MLC_CS = 33554432, MLC_DN = MLC_CS + 16777216, MLC_NS = MLC_DN + 262144, MLC_ML = MLC_NS + 262144, MLC_BE = MLC_ML + 4096, MLC_MS = MLC_BE + 4096;

__device__ __forceinline__ float scan_add64(float v, int lane) {
#pragma unroll
    for (int o = 1; o < 64; o <<= 1) { const float x = __shfl_up(v, o); if (lane >= o) v += x; }
    return v;
}
__device__ __forceinline__ float scan_max64(float v, int lane) {
#pragma unroll
    for (int o = 1; o < 64; o <<= 1) { const float x = __shfl_up(v, o); if (lane >= o) v = fmaxf(v, x); }
    return v;
}
__device__ __forceinline__ float wave_max(float v) {
#pragma unroll
    for (int o = 32; o > 0; o >>= 1) v = fmaxf(v, __shfl_xor(v, o));
    return v;
}

__device__ __forceinline__ void mlc_passA(int u, const bf16_t* PROJ, const float* GATES, const float* b_i, const float* b_f, unsigned char* YB, const Ctx& c) {
    const int bh = u >> 5, b = bh >> 2, h = bh & 3;
    const size_t t0 = (size_t)b * SEQ + (u & 31) * 64;
    unsigned char* smem = c.smem;
    float* saL = (float*)(smem + 24576);
    const int lane = c.lane, wid = __builtin_amdgcn_readfirstlane(c.wid);
#pragma unroll
    for (int i = 0; i < 4; ++i) { const int j = wid * 4 + i;
        glds16(PROJ + (t0 + 4 * j + (lane >> 4)) * NPAD + 512 + h * 128 + (lane & 15) * 8, smem + 8192 + j * 1024 + lane * 16); }
    if (wid == 0) {
        const float ip = GATES[(t0 + lane) * 8 + h] + b_i[h], lf = -softplusf_(-(GATES[(t0 + lane) * 8 + 4 + h] + b_f[h]));
        const float bc = scan_add64(lf, lane), bend = __shfl(bc, 63);
        const float a = bend - bc + ip, mloc = wave_max(a);
        saL[lane] = expf(a - mloc) * 0.125f;
        if (lane == 0) { ((float*)(YB + MLC_ML))[u] = mloc; ((float*)(YB + MLC_BE))[u] = bend; }
    }
    __syncthreads();
#pragma unroll
    for (int i = 0; i < 2; ++i) {
        const int idx = c.tid + 256 * i, row = idx >> 3, chk = idx & 7;
        const u32x4 r = *(const u32x4*)(PROJ + (t0 + row) * NPAD + 256 + h * 64 + chk * 8);
        float f[8]; unpack8(r, f);
        const float s = saL[row];
        *(u32x4*)(smem + row * 128 + chk * 16) = (u32x4){pk2(f[0] * s, f[1] * s), pk2(f[2] * s, f[3] * s), pk2(f[4] * s, f[5] * s), pk2(f[6] * s, f[7] * s)};
    }
    asm volatile("s_waitcnt vmcnt(0)" ::: "memory");
    __syncthreads();
    const int h5 = lane >> 5, r = lane & 31, i16 = lane & 15, q4 = i16 >> 2, p = i16 & 3, blk = (lane >> 4) & 1;
    const int dkt = wid & 1, dvp = wid >> 1;
    const unsigned kaddr = (unsigned)(size_t)smem + (unsigned)((8 * h5 + q4) * 128 + dkt * 64 + 32 * blk + 8 * p);
    const unsigned vaddr = (unsigned)(size_t)smem + 8192u + (unsigned)((8 * h5 + q4) * 256 + dvp * 128 + 32 * blk + 8 * p);
    f32x16 a0, a1;
#pragma unroll
    for (int i = 0; i < 16; ++i) { a0[i] = 0.f; a1[i] = 0.f; }
#pragma unroll
    for (int st = 0; st < 4; ++st) {
        s16x4 kl, kh, v0l, v0h, v1l, v1h;
        const unsigned ka = kaddr + st * 2048, va = vaddr + st * 4096;
        asm volatile("ds_read_b64_tr_b16 %0, %6\n\t"
                     "ds_read_b64_tr_b16 %1, %6 offset:512\n\t"
                     "ds_read_b64_tr_b16 %2, %7\n\t"
                     "ds_read_b64_tr_b16 %3, %7 offset:1024\n\t"
                     "ds_read_b64_tr_b16 %4, %7 offset:64\n\t"
                     "ds_read_b64_tr_b16 %5, %7 offset:1088\n\t"
                     "s_waitcnt lgkmcnt(0)"
                     : "=&v"(kl), "=&v"(kh), "=&v"(v0l), "=&v"(v0h), "=&v"(v1l), "=&v"(v1h) : "v"(ka), "v"(va) : "memory");
        const bf16x8 kf = __builtin_shufflevector(kl, kh, 0, 1, 2, 3, 4, 5, 6, 7);
        const bf16x8 vf0 = __builtin_shufflevector(v0l, v0h, 0, 1, 2, 3, 4, 5, 6, 7), vf1 = __builtin_shufflevector(v1l, v1h, 0, 1, 2, 3, 4, 5, 6, 7);
        a0 = MFMA32(kf, vf0, a0); a1 = MFMA32(kf, vf1, a1);
    }
    float* DC = (float*)(YB + MLC_DC) + (size_t)u * 8192;
#pragma unroll
    for (int i = 0; i < 16; ++i) {
        const int dk = dkt * 32 + (i & 3) + 8 * (i >> 2) + 4 * h5;
        DC[dk * 128 + dvp * 64 + r] = a0[i]; DC[dk * 128 + dvp * 64 + 32 + r] = a1[i];
    }
    if (c.tid < 64) {
        float s = 0.f;
#pragma unroll 8
        for (int t = 0; t < 64; ++t) s += bf2f(((const bf16_t*)smem)[t * 64 + c.tid]);
        ((float*)(YB + MLC_DN))[(size_t)u * 64 + c.tid] = s;
    }
}

__device__ __forceinline__ void mlc_passB(int u, unsigned char* YB, const Ctx& c) {
    const int bh = u >> 3, sl = u & 7;
    const float* ML = (const float*)(YB + MLC_ML) + bh * 32; const float* BE = (const float*)(YB + MLC_BE) + bh * 32;
    const float* DC = (const float*)(YB + MLC_DC) + (size_t)bh * 32 * 8192 + sl * 1024 + c.tid * 4;
    bf16_t* CS = (bf16_t*)(YB + MLC_CS) + (size_t)bh * 32 * 8192 + sl * 1024 + c.tid * 4;
    const float* DN = (const float*)(YB + MLC_DN) + (size_t)bh * 32 * 64; float* NS = (float*)(YB + MLC_NS) + (size_t)bh * 32 * 64; float* MS = (float*)(YB + MLC_MS) + bh * 32;
    f32x4 C4 = (f32x4){0.f, 0.f, 0.f, 0.f}; float nv = 0.f, m = 0.f;
    const bool do_n = (sl == 0) && (c.tid < 64);
#pragma unroll 4
    for (int n = 0; n < 32; ++n) {
        *(u32x2*)(CS + (size_t)n * 8192) = (u32x2){pk2(C4[0], C4[1]), pk2(C4[2], C4[3])};
        if (do_n) NS[n * 64 + c.tid] = nv;
        if (sl == 0 && c.tid == 0) MS[n] = m;
        const float be = BE[n], ml = ML[n];
        const float mn = fmaxf(be + m, ml), keep = expf(be + m - mn), g = expf(ml - mn);
        m = mn;
        const f32x4 d = *(const f32x4*)(DC + (size_t)n * 8192);
        C4 = C4 * keep + d * g;
        if (do_n) nv = nv * keep + DN[n * 64 + c.tid] * g;
    }
}

__device__ __forceinline__ void mlc_passC(int u, const bf16_t* PROJ, const float* GATES, const float* b_i, const float* b_f, const unsigned char* YB,
                                          const float* gain  , bf16_t* MIXO, const Ctx& c) {
    const int bh = u >> 5, b = bh >> 2, h = bh & 3;
    const size_t t0 = (size_t)b * SEQ + (u & 31) * 64;
    unsigned char* smem = c.smem;
    float* csL = (float*)(smem + 32768); float* pmL = (float*)(smem + 33024); float* bcL = (float*)(smem + 33280); float* nnL = (float*)(smem + 33536); float* sqL = (float*)(smem + 33792);
    const int lane = c.lane, wid = __builtin_amdgcn_readfirstlane(c.wid);
    const bf16_t* CS = (const bf16_t*)(YB + MLC_CS) + (size_t)u * 8192;
#pragma unroll
    for (int i = 0; i < 4; ++i) { const int j = wid * 4 + i;
        glds16(PROJ + (t0 + 4 * j + (lane >> 4)) * NPAD + 512 + h * 128 + (lane & 15) * 8, smem + j * 1024 + lane * 16);
        glds16(CS + (4 * j + (lane >> 4)) * 128 + (lane & 15) * 8, smem + 16384 + j * 1024 + lane * 16); }
    float bcl = 0.f;
    if (wid == 0) {
        const float ip = GATES[(t0 + lane) * 8 + h] + b_i[h], lf = -softplusf_(-(GATES[(t0 + lane) * 8 + 4 + h] + b_f[h]));
        bcl = scan_add64(lf, lane);
        const float cs = ip - bcl;
        csL[lane] = cs; pmL[lane] = scan_max64(cs, lane);
        nnL[lane] = ((const float*)(YB + MLC_NS))[(size_t)u * 64 + lane];
        bcL[lane] = bcl;
    }
    asm volatile("s_waitcnt vmcnt(0)" ::: "memory");
    __syncthreads();
    const int h5 = lane >> 5, r = lane & 31, i16 = lane & 15, q4 = i16 >> 2, p = i16 & 3, blk = (lane >> 4) & 1;
    const int th = wid & 1, dvh = wid >> 1;
    const int t = th * 32 + r;
    const float m_n = ((const float*)(YB + MLC_MS))[u];
    const float Mt = fmaxf(m_n, pmL[t]), w_inter = __expf(m_n - Mt), em = __expf(-(bcL[t] + Mt));
    bf16x8 qf[4];
#pragma unroll
    for (int ks = 0; ks < 4; ++ks) qf[ks] = *(const bf16x8*)(PROJ + (t0 + t) * NPAD + h * 64 + ks * 16 + h5 * 8);
    float qn = 0.f; bf16x8 qw[4];
#pragma unroll
    for (int ks = 0; ks < 4; ++ks) {
        const u32x4 raw = __builtin_bit_cast(u32x4, qf[ks]); float f[8]; unpack8(raw, f);
#pragma unroll
        for (int j = 0; j < 8; ++j) qn += f[j] * nnL[ks * 16 + h5 * 8 + j];
        qw[ks] = __builtin_bit_cast(bf16x8, (u32x4){pk2(f[0] * w_inter, f[1] * w_inter), pk2(f[2] * w_inter, f[3] * w_inter), pk2(f[4] * w_inter, f[5] * w_inter), pk2(f[6] * w_inter, f[7] * w_inter)});
    }
    qn += __shfl_xor(qn, 32);
    f32x16 x0, x1;
#pragma unroll
    for (int i = 0; i < 16; ++i) { x0[i] = 0.f; x1[i] = 0.f; }
#pragma unroll
    for (int ks = 0; ks < 4; ++ks) {
        const bf16x8 kf0 = *(const bf16x8*)(PROJ + (t0 + r) * NPAD + 256 + h * 64 + ks * 16 + h5 * 8);
        x0 = MFMA32(kf0, qf[ks], x0);
        if (th) { const bf16x8 kf1 = *(const bf16x8*)(PROJ + (t0 + 32 + r) * NPAD + 256 + h * 64 + ks * 16 + h5 * 8); x1 = MFMA32(kf1, qf[ks], x1); }
    }
    float ps = 0.f;
#pragma unroll
    for (int i = 0; i < 16; ++i) {
        const int s = (i & 3) + 8 * (i >> 2) + 4 * h5;
        const float w0 = (s <= t) ? __expf(csL[s] - Mt) * 0.125f : 0.f;
        x0[i] *= w0; ps += x0[i];
        if (th) { const float w1 = (s <= r) ? __expf(csL[32 + s] - Mt) * 0.125f : 0.f; x1[i] *= w1; ps += x1[i]; }
    }
    ps += __shfl_xor(ps, 32);
    const float den = w_inter * qn + ps;
    f32x16 o0, o1;
#pragma unroll
    for (int i = 0; i < 16; ++i) { o0[i] = 0.f; o1[i] = 0.f; }
    {
        const unsigned vb = (unsigned)(size_t)smem + (unsigned)((4 * h5 + q4) * 256 + dvh * 128 + 32 * blk + 8 * p);
#pragma unroll
        for (int st = 0; st < 2; ++st) {
            if (st == 0 || th) {
                s16x4 l00, h00, l01, h01, l10, h10, l11, h11;
                const unsigned va = vb + st * 8192;
                asm volatile("ds_read_b64_tr_b16 %0, %8\n\t"
                             "ds_read_b64_tr_b16 %1, %8 offset:2048\n\t"
                             "ds_read_b64_tr_b16 %2, %8 offset:64\n\t"
                             "ds_read_b64_tr_b16 %3, %8 offset:2112\n\t"
                             "ds_read_b64_tr_b16 %4, %8 offset:4096\n\t"
                             "ds_read_b64_tr_b16 %5, %8 offset:6144\n\t"
                             "ds_read_b64_tr_b16 %6, %8 offset:4160\n\t"
                             "ds_read_b64_tr_b16 %7, %8 offset:6208\n\t"
                             "s_waitcnt lgkmcnt(0)"
                             : "=&v"(l00), "=&v"(h00), "=&v"(l01), "=&v"(h01), "=&v"(l10), "=&v"(h10), "=&v"(l11), "=&v"(h11) : "v"(va) : "memory");
                const bf16x8 v00 = __builtin_shufflevector(l00, h00, 0, 1, 2, 3, 4, 5, 6, 7), v01 = __builtin_shufflevector(l01, h01, 0, 1, 2, 3, 4, 5, 6, 7);
                const bf16x8 v10 = __builtin_shufflevector(l10, h10, 0, 1, 2, 3, 4, 5, 6, 7), v11 = __builtin_shufflevector(l11, h11, 0, 1, 2, 3, 4, 5, 6, 7);
                const bf16x8 pb0 = (st == 0) ? pack_step<0>(x0) : pack_step<0>(x1);
                const bf16x8 pb1 = (st == 0) ? pack_step<1>(x0) : pack_step<1>(x1);
                o0 = MFMA32(v00, pb0, o0); o1 = MFMA32(v01, pb0, o1);
                o0 = MFMA32(v10, pb1, o0); o1 = MFMA32(v11, pb1, o1);
            }
        }
    }
    {
        const unsigned cb = (unsigned)(size_t)smem + 16384u + (unsigned)((8 * h5 + q4) * 256 + dvh * 128 + 32 * blk + 8 * p);
#pragma unroll
        for (int kp = 0; kp < 2; ++kp) {
            s16x4 l00, h00, l01, h01, l10, h10, l11, h11;
            const unsigned ca = cb + kp * 8192;
            asm volatile("ds_read_b64_tr_b16 %0, %8\n\t"
                         "ds_read_b64_tr_b16 %1, %8 offset:1024\n\t"
                         "ds_read_b64_tr_b16 %2, %8 offset:64\n\t"
                         "ds_read_b64_tr_b16 %3, %8 offset:1088\n\t"
                         "ds_read_b64_tr_b16 %4, %8 offset:4096\n\t"
                         "ds_read_b64_tr_b16 %5, %8 offset:5120\n\t"
                         "ds_read_b64_tr_b16 %6, %8 offset:4160\n\t"
                         "ds_read_b64_tr_b16 %7, %8 offset:5184\n\t"
                         "s_waitcnt lgkmcnt(0)"
                         : "=&v"(l00), "=&v"(h00), "=&v"(l01), "=&v"(h01), "=&v"(l10), "=&v"(h10), "=&v"(l11), "=&v"(h11) : "v"(ca) : "memory");
            const bf16x8 c00 = __builtin_shufflevector(l00, h00, 0, 1, 2, 3, 4, 5, 6, 7), c01 = __builtin_shufflevector(l01, h01, 0, 1, 2, 3, 4, 5, 6, 7);
            const bf16x8 c10 = __builtin_shufflevector(l10, h10, 0, 1, 2, 3, 4, 5, 6, 7), c11 = __builtin_shufflevector(l11, h11, 0, 1, 2, 3, 4, 5, 6, 7);
            o0 = MFMA32(c00, qw[2 * kp], o0); o1 = MFMA32(c01, qw[2 * kp], o1);
            o0 = MFMA32(c10, qw[2 * kp + 1], o0); o1 = MFMA32(c11, qw[2 * kp + 1], o1);
        }
    }
    const float inv = __builtin_amdgcn_rcpf(fmaxf(fabsf(den), em));
    float ss = 0.f;
#pragma unroll
    for (int i = 0; i < 16; ++i) { o0[i] *= inv; o1[i] *= inv; ss += o0[i] * o0[i] + o1[i] * o1[i]; }
    ss += __shfl_xor(ss, 32);
    if (h5 == 0) sqL[wid * 32 + r] = ss;
    __syncthreads();
    const float rr = rsqrtf((sqL[th * 32 + r] + sqL[(th + 2) * 32 + r]) * (1.f / 128.f) + 1e-6f);
    const bf16_t* grow = PROJ + (t0 + t) * NPAD + 1032 + h * 128 + dvh * 64 + 4 * h5;
    const float* gn = gain + h * 128 + dvh * 64 + 4 * h5;
    bf16_t* orow = MIXO + (t0 + t) * 1024 + h * 128 + dvh * 64 + 4 * h5;
#pragma unroll
    for (int d = 0; d < 2; ++d)
#pragma unroll
        for (int g = 0; g < 4; ++g) {
            const u32x2 zr = *(const u32x2*)(grow + d * 32 + 8 * g);
            const f32x4 gv = *(const f32x4*)(gn + d * 32 + 8 * g);
            const float z0 = bflo(zr.x), z1 = bfhi(zr.x), z2 = bflo(zr.y), z3 = bfhi(zr.y);
            const float y0 = (d ? o1[4 * g] : o0[4 * g]) * rr * gv[0] * sigmoidf_(z0), y1 = (d ? o1[4 * g + 1] : o0[4 * g + 1]) * rr * gv[1] * sigmoidf_(z1);
            const float y2 = (d ? o1[4 * g + 2] : o0[4 * g + 2]) * rr * gv[2] * sigmoidf_(z2), y3 = (d ? o1[4 * g + 3] : o0[4 * g + 3]) * rr * gv[3] * sigmoidf_(z3);
            *(u32x2*)(orow + d * 32 + 8 * g) = (u32x2){pk2(y0, y1), pk2(y2, y3)};
        }
}

constexpr size_t GD_WN = 0, GD_UU = GD_WN + (size_t)1024 * 16384, GD_KGT = GD_UU + (size_t)1024 * 16384, GD_QG = GD_KGT + (size_t)1024 * 16384,
                 GD_AT = GD_QG + (size_t)1024 * 16384, GD_GL = GD_AT + (size_t)1024 * 8192, GD_END = GD_GL + 4096;
static_assert(GD_END <= (size_t)MAXROWS * 256 * 2, "GDN chunk records must fit the HBUF region");

__device__ __forceinline__ void gdc_passA(int u, const bf16_t* GQ, const bf16_t* GK, const bf16_t* GV, const float* BETA, const float* GLOG, unsigned char* HB, const Ctx& c) {
    const int bh = u >> 5, b = bh >> 2, h = bh & 3;
    const size_t t0 = (size_t)b * SEQ + (u & 31) * 64;
    unsigned char* smem = c.smem;
    float* Lm = (float*)(smem + 49152);
    float* GA = (float*)(smem + 65536 + 64); float* BT = GA + 64; float* EG = BT + 64; float* EK = EG + 64;
    const int lane = c.lane, wid = __builtin_amdgcn_readfirstlane(c.wid);
    const int h5 = lane >> 5, r = lane & 31;
    if (wid == 0) {
        const float g = GLOG[(t0 + lane) * 4 + h];
        const float G = scan_add64(g, lane), Gl = __shfl(G, 63);
        GA[lane] = G; BT[lane] = BETA[(t0 + lane) * 4 + h]; EG[lane] = expf(G); EK[lane] = expf(Gl - G);
        if (lane == 0) ((float*)(HB + GD_GL))[u] = expf(Gl);
    }
    __syncthreads();
    if (wid < 3) {
        const int it = (wid + 1) >> 1, jt = wid >> 1;
        f32x16 dl, da;
#pragma unroll
        for (int i = 0; i < 16; ++i) { dl[i] = 0.f; da[i] = 0.f; }
#pragma unroll
        for (int ks = 0; ks < 8; ++ks) {
            const bf16x8 ki = *(const bf16x8*)(GK + (t0 + 32 * it + r) * 512 + h * 128 + ks * 16 + h5 * 8);
            const bf16x8 kj = *(const bf16x8*)(GK + (t0 + 32 * jt + r) * 512 + h * 128 + ks * 16 + h5 * 8);
            const bf16x8 qi = *(const bf16x8*)(GQ + (t0 + 32 * it + r) * 512 + h * 128 + ks * 16 + h5 * 8);
            dl = MFMA32(ki, kj, dl); da = MFMA32(qi, kj, da);
        }
        const int j = 32 * jt + r; const float Gj = GA[j];
        bf16_t* AT = (bf16_t*)(HB + GD_AT) + (size_t)u * 4096;
#pragma unroll
        for (int i = 0; i < 16; ++i) {
            const int ii = 32 * it + (i & 3) + 8 * (i >> 2) + 4 * h5;
            const float dec = __expf(GA[ii] - Gj);
            Lm[ii * 64 + j] = (j < ii) ? dl[i] * BT[ii] * dec : 0.f;
            AT[ii * 64 + j] = (bf16_t)f2bf((j <= ii) ? da[i] * dec : 0.f);
        }
        if (wid == 0) {
#pragma unroll
            for (int i = 0; i < 16; ++i) { const int ii = (i & 3) + 8 * (i >> 2) + 4 * h5; Lm[ii * 64 + 32 + r] = 0.f; AT[ii * 64 + 32 + r] = 0; }
        }
    }
    __syncthreads();
    if (wid == 0) {
        float Tc[64];
#pragma unroll
        for (int i = 0; i < 64; ++i) {
            float s = (i == lane) ? 1.f : 0.f;
#pragma unroll
            for (int k = 0; k < i; ++k) s -= Lm[i * 64 + k] * Tc[k];
            Tc[i] = s;
        }
        bf16_t* Tm = (bf16_t*)Lm;
#pragma unroll
        for (int i = 0; i < 64; ++i) Tm[i * 64 + lane] = (bf16_t)f2bf(Tc[i]);
    } else {
        const int t3 = c.tid - 64;
        for (int idx = t3; idx < 4096; idx += 192) {
            const int arr = idx >> 10, rem = idx & 1023, row = rem >> 4, chk = rem & 15;
            const bf16_t* sp = ((arr == 1) ? GV : (arr == 3) ? GQ : GK) + (t0 + row) * 512 + h * 128 + chk * 8;
            const u32x4 raw = *(const u32x4*)sp; float f[8]; unpack8(raw, f);
            const float sc = (arr == 0) ? BT[row] * EG[row] : (arr == 1) ? BT[row] : (arr == 2) ? EK[row] : EG[row];
            const u32x4 o = (u32x4){pk2(f[0] * sc, f[1] * sc), pk2(f[2] * sc, f[3] * sc), pk2(f[4] * sc, f[5] * sc), pk2(f[6] * sc, f[7] * sc)};
            if (arr < 3) *(u32x4*)(smem + arr * 16384 + row * 256 + chk * 16) = o;
            else *(u32x4*)((bf16_t*)(HB + GD_QG) + (size_t)u * 8192 + row * 128 + chk * 8) = o;
        }
    }
    __syncthreads();
    {
        const int i16 = lane & 15, q4 = i16 >> 2, p = i16 & 3, blk = (lane >> 4) & 1;
        const unsigned char* Tm = smem + 49152;
        f32x16 u0, u1, w0, w1;
#pragma unroll
        for (int i = 0; i < 16; ++i) { u0[i] = 0.f; u1[i] = 0.f; w0[i] = 0.f; w1[i] = 0.f; }
        const unsigned ib = (unsigned)(size_t)smem + (unsigned)((8 * h5 + q4) * 256 + wid * 64 + 32 * blk + 8 * p);
#pragma unroll
        for (int ks = 0; ks < 4; ++ks) {
            s16x4 kl, kh, vl, vh;
            const unsigned ia = ib + ks * 4096;
            asm volatile("ds_read_b64_tr_b16 %0, %4\n\t"
                         "ds_read_b64_tr_b16 %1, %4 offset:1024\n\t"
                         "ds_read_b64_tr_b16 %2, %4 offset:16384\n\t"
                         "ds_read_b64_tr_b16 %3, %4 offset:17408\n\t"
                         "s_waitcnt lgkmcnt(0)"
                         : "=&v"(kl), "=&v"(kh), "=&v"(vl), "=&v"(vh) : "v"(ia) : "memory");
            const bf16x8 kb = __builtin_shufflevector(kl, kh, 0, 1, 2, 3, 4, 5, 6, 7), vb = __builtin_shufflevector(vl, vh, 0, 1, 2, 3, 4, 5, 6, 7);
            const bf16x8 t1 = *(const bf16x8*)(Tm + (32 + r) * 128 + ks * 32 + h5 * 16);
            w1 = MFMA32(t1, kb, w1); u1 = MFMA32(t1, vb, u1);
            if (ks < 2) { const bf16x8 tt0 = *(const bf16x8*)(Tm + r * 128 + ks * 32 + h5 * 16); w0 = MFMA32(tt0, kb, w0); u0 = MFMA32(tt0, vb, u0); }
        }
        bf16_t* WN = (bf16_t*)(HB + GD_WN) + (size_t)u * 8192; bf16_t* UU = (bf16_t*)(HB + GD_UU) + (size_t)u * 8192;
#pragma unroll
        for (int i = 0; i < 16; ++i) {
            const int s = (i & 3) + 8 * (i >> 2) + 4 * h5;
            WN[s * 128 + wid * 32 + r] = (bf16_t)f2bf(-w0[i]); WN[(32 + s) * 128 + wid * 32 + r] = (bf16_t)f2bf(-w1[i]);
        }
        {
            u32x4* up = (u32x4*)(UU + (size_t)(wid * 64 + lane) * 32);
            up[0] = (u32x4){pk2(u0[0], u0[1]), pk2(u0[2], u0[3]), pk2(u0[4], u0[5]), pk2(u0[6], u0[7])};
            up[1] = (u32x4){pk2(u0[8], u0[9]), pk2(u0[10], u0[11]), pk2(u0[12], u0[13]), pk2(u0[14], u0[15])};
            up[2] = (u32x4){pk2(u1[0], u1[1]), pk2(u1[2], u1[3]), pk2(u1[4], u1[5]), pk2(u1[6], u1[7])};
            up[3] = (u32x4){pk2(u1[8], u1[9]), pk2(u1[10], u1[11]), pk2(u1[12], u1[13]), pk2(u1[14], u1[15])};
        }
        bf16_t* KGT = (bf16_t*)(HB + GD_KGT) + (size_t)u * 8192;
        const int gq = lane >> 4;
        const unsigned kb0 = (unsigned)(size_t)smem + 32768u + (unsigned)(q4 * 256 + gq * 32 + 8 * p);
#pragma unroll
        for (int it2 = 0; it2 < 8; ++it2) {
            const int job = wid * 8 + it2, s0 = (job & 15) * 4, dkb = (job >> 4) * 64;
            s16x4 v;
            const unsigned ad = kb0 + s0 * 256 + dkb * 2;
            asm volatile("ds_read_b64_tr_b16 %0, %1\n\ts_waitcnt lgkmcnt(0)" : "=&v"(v) : "v"(ad) : "memory");
            *(s16x4*)(KGT + (size_t)(dkb + gq * 16 + i16) * 64 + s0) = v;
        }
    }
}

constexpr size_t GC_ST = 0, GC_VT = (size_t)1024 * 32768;
__device__ __forceinline__ void gdc_passB(int bh, const unsigned char* HB, unsigned char* YB, const Ctx& c) {
    const int lane = c.lane, wid = __builtin_amdgcn_readfirstlane(c.wid);
    const int h5 = lane >> 5, r = lane & 31;
    unsigned char* smem = c.smem;
    f32x16 S0, S1, S2, S3;
#pragma unroll
    for (int i = 0; i < 16; ++i) { S0[i] = 0.f; S1[i] = 0.f; S2[i] = 0.f; S3[i] = 0.f; }
    const size_t u0 = (size_t)bh * 32;
#define GB_STAGE(n_, p_) do { const bf16_t* wn_ = (const bf16_t*)(HB + GD_WN) + (u0 + (n_)) * 8192; const bf16_t* kg_ = (const bf16_t*)(HB + GD_KGT) + (u0 + (n_)) * 8192; \
        unsigned char* bp_ = smem + (p_) * 32768; \
        _Pragma("unroll") for (int i = 0; i < 4; ++i) { const int jj = wid * 4 + i, row = 4 * jj + (lane >> 4), ch = (lane & 15) ^ (row & 15); \
            glds16(wn_ + row * 128 + ch * 8, bp_ + jj * 1024 + lane * 16); } \
        _Pragma("unroll") for (int i = 0; i < 4; ++i) { const int jj = wid * 4 + i, row = 8 * jj + (lane >> 3), ch = (lane & 7) ^ ((row >> 1) & 7); \
            glds16(kg_ + row * 64 + ch * 8, bp_ + 16384 + jj * 1024 + lane * 16); } } while (0)
#define LD128(base_, R_, ks_) __builtin_shufflevector(*(const s16x4*)((base_) + (R_) * 256 + (((2 * (ks_)) ^ (rl & 15)) << 4) + 8 * hl), \
                                                      *(const s16x4*)((base_) + (R_) * 256 + (((2 * (ks_) + 1) ^ (rl & 15)) << 4) + 8 * hl), 0, 1, 2, 3, 4, 5, 6, 7)
#define LD64(base_, R_, k2_) __builtin_shufflevector(*(const s16x4*)((base_) + (R_) * 128 + (((2 * (k2_)) ^ ((rl >> 1) & 7)) << 4) + 8 * hl), \
                                                     *(const s16x4*)((base_) + (R_) * 128 + (((2 * (k2_) + 1) ^ ((rl >> 1) & 7)) << 4) + 8 * hl), 0, 1, 2, 3, 4, 5, 6, 7)
    u32x4 uu[4];
#define GB_LOADU(n_) do { const u32x4* up_ = (const u32x4*)((const bf16_t*)(HB + GD_UU) + (u0 + (n_)) * 8192 + (size_t)(wid * 64 + lane) * 32); \
        uu[0] = up_[0]; uu[1] = up_[1]; uu[2] = up_[2]; uu[3] = up_[3]; } while (0)
    __syncthreads();
    GB_STAGE(0, 0);
    GB_LOADU(0);
#pragma unroll 1
    for (int n2 = 0; n2 < 16; ++n2) {
#pragma unroll
        for (int PBUF = 0; PBUF < 2; ++PBUF) {
        const int n = 2 * n2 + PBUF;
        const float gl = ((const float*)(HB + GD_GL))[u0 + n];
        if (n == 0) asm volatile("s_waitcnt vmcnt(0)" ::: "memory"); else asm volatile("s_waitcnt vmcnt(24)" ::: "memory");
        asm volatile("s_waitcnt lgkmcnt(0)" ::: "memory"); __builtin_amdgcn_s_barrier(); asm volatile("" ::: "memory");
        f32x16 v0, v1;
#pragma unroll
        for (int q = 0; q < 2; ++q) {
            const u32x4 a = uu[q], bq = uu[2 + q];
            v0[8 * q + 0] = bflo(a.x); v0[8 * q + 1] = bfhi(a.x); v0[8 * q + 2] = bflo(a.y); v0[8 * q + 3] = bfhi(a.y);
            v0[8 * q + 4] = bflo(a.z); v0[8 * q + 5] = bfhi(a.z); v0[8 * q + 6] = bflo(a.w); v0[8 * q + 7] = bfhi(a.w);
            v1[8 * q + 0] = bflo(bq.x); v1[8 * q + 1] = bfhi(bq.x); v1[8 * q + 2] = bflo(bq.y); v1[8 * q + 3] = bfhi(bq.y);
            v1[8 * q + 4] = bflo(bq.z); v1[8 * q + 5] = bfhi(bq.z); v1[8 * q + 6] = bflo(bq.w); v1[8 * q + 7] = bfhi(bq.w);
        }
        if (n + 1 < 32) { GB_STAGE(n + 1, (PBUF ^ 1)); GB_LOADU(n + 1); }
        int rl = r, hl = h5; asm volatile("" : "+v"(rl), "+v"(hl));
        const unsigned char* WNb = smem + PBUF * 32768; const unsigned char* KGb = WNb + 16384;
        {
            bf16_t* st = (bf16_t*)(YB + GC_ST) + (u0 + n) * 16384 + (size_t)h5 * 512 + (size_t)(wid * 32 + r) * 4;
#define ST_TILE(SX, dt_) do { _Pragma("unroll") for (int g = 0; g < 4; ++g) \
                *(u32x2*)(st + ((dt_) * 8 + 2 * g) * 512) = (u32x2){cvt_pk(SX[4 * g], SX[4 * g + 1]), cvt_pk(SX[4 * g + 2], SX[4 * g + 3])}; } while (0)
            ST_TILE(S0, 0); ST_TILE(S1, 1); ST_TILE(S2, 2); ST_TILE(S3, 3);
#undef ST_TILE
        }
        {
            bf16x8 fa0, fb0, fa1, fb1, fa2, fb2;
#define LDV(FA, FB, ks_) do { FA = LD128(WNb, rl, ks_); FB = LD128(WNb, 32 + rl, ks_); } while (0)
#define MMV(SX, HF, FA, FB) do { const bf16x8 sbk = pack_step<HF>(SX); v0 = MFMA32(FA, sbk, v0); v1 = MFMA32(FB, sbk, v1); } while (0)
            LDV(fa0, fb0, 0); LDV(fa1, fb1, 1); LDV(fa2, fb2, 2);
            MMV(S0, 0, fa0, fb0); LDV(fa0, fb0, 3);
            MMV(S0, 1, fa1, fb1); LDV(fa1, fb1, 4);
            MMV(S1, 0, fa2, fb2); LDV(fa2, fb2, 5);
            MMV(S1, 1, fa0, fb0); LDV(fa0, fb0, 6);
            MMV(S2, 0, fa1, fb1); LDV(fa1, fb1, 7);
            MMV(S2, 1, fa2, fb2);
            MMV(S3, 0, fa0, fb0);
            MMV(S3, 1, fa1, fb1);
#undef LDV
#undef MMV
        }
        const bf16x8 vb0 = pack_step_m<0>(v0), vb1 = pack_step_m<1>(v0), vb2 = pack_step_m<0>(v1), vb3 = pack_step_m<1>(v1);
        {
            bf16_t* vt = (bf16_t*)(YB + GC_VT) + (u0 + n) * 8192 + (size_t)h5 * 512 + (size_t)(wid * 32 + r) * 4;
            const u32x4 p0 = __builtin_bit_cast(u32x4, vb0), p1 = __builtin_bit_cast(u32x4, vb1), p2 = __builtin_bit_cast(u32x4, vb2), p3 = __builtin_bit_cast(u32x4, vb3);
            *(u32x2*)(vt + 0 * 512) = (u32x2){p0.x, p0.y};  *(u32x2*)(vt + 2 * 512) = (u32x2){p0.z, p0.w};
            *(u32x2*)(vt + 4 * 512) = (u32x2){p1.x, p1.y};  *(u32x2*)(vt + 6 * 512) = (u32x2){p1.z, p1.w};
            *(u32x2*)(vt + 8 * 512) = (u32x2){p2.x, p2.y};  *(u32x2*)(vt + 10 * 512) = (u32x2){p2.z, p2.w};
            *(u32x2*)(vt + 12 * 512) = (u32x2){p3.x, p3.y}; *(u32x2*)(vt + 14 * 512) = (u32x2){p3.z, p3.w};
        }
        asm volatile("" ::: "memory"); asm volatile("" : "+v"(rl), "+v"(hl));
        S0 *= gl; S1 *= gl; S2 *= gl; S3 *= gl;
        {
            bf16x8 g0, g1, g2;
            g0 = LD64(KGb, rl, 0); g1 = LD64(KGb, rl, 1); g2 = LD64(KGb, rl, 2);
            S0 = MFMA32(g0, vb0, S0); g0 = LD64(KGb, rl, 3);
            S0 = MFMA32(g1, vb1, S0); g1 = LD64(KGb, 32 + rl, 0);
            S0 = MFMA32(g2, vb2, S0); g2 = LD64(KGb, 32 + rl, 1);
            S0 = MFMA32(g0, vb3, S0); g0 = LD64(KGb, 32 + rl, 2);
            S1 = MFMA32(g1, vb0, S1); g1 = LD64(KGb, 32 + rl, 3);
            S1 = MFMA32(g2, vb1, S1); g2 = LD64(KGb, 64 + rl, 0);
            S1 = MFMA32(g0, vb2, S1); g0 = LD64(KGb, 64 + rl, 1);
            S1 = MFMA32(g1, vb3, S1); g1 = LD64(KGb, 64 + rl, 2);
            S2 = MFMA32(g2, vb0, S2); g2 = LD64(KGb, 64 + rl, 3);
            S2 = MFMA32(g0, vb1, S2); g0 = LD64(KGb, 96 + rl, 0);
            S2 = MFMA32(g1, vb2, S2); g1 = LD64(KGb, 96 + rl, 1);
            S2 = MFMA32(g2, vb3, S2); g2 = LD64(KGb, 96 + rl, 2);
            S3 = MFMA32(g0, vb0, S3); g0 = LD64(KGb, 96 + rl, 3);
            S3 = MFMA32(g1, vb1, S3);
            S3 = MFMA32(g2, vb2, S3);
            S3 = MFMA32(g0, vb3, S3);
        }
        }
    }
#undef GB_STAGE
#undef LD128
#undef LD64
#undef GB_LOADU
}

__device__ __forceinline__ void gdc_passB_idle() {
    __syncthreads();
    for (int n = 0; n < 32; ++n) { asm volatile("" ::: "memory"); __builtin_amdgcn_s_barrier(); asm volatile("" ::: "memory"); }
}

__device__ __forceinline__ void gdc_passC(int u, const unsigned char* HB, const unsigned char* YB, const bf16_t* PROJ, const float* gnorm, bf16_t* MIXO, const Ctx& c) {
    const int bh = u >> 5, b = bh >> 2, h = bh & 3;
    const size_t t0 = (size_t)b * SEQ + (u & 31) * 64;
    const int lane = c.lane, wid = __builtin_amdgcn_readfirstlane(c.wid);
    const int h5 = lane >> 5, r = lane & 31;
    float* sqL = (float*)c.smem;
    const bf16_t* ST = (const bf16_t*)(YB + GC_ST) + (size_t)u * 16384 + (size_t)(2 * h5) * 512 + (size_t)(wid * 32 + r) * 4;
    const bf16_t* VT = (const bf16_t*)(YB + GC_VT) + (size_t)u * 8192 + (size_t)(2 * h5) * 512 + (size_t)(wid * 32 + r) * 4;
    const bf16_t* QG = (const bf16_t*)(HB + GD_QG) + (size_t)u * 8192 + (size_t)r * 128 + 8 * h5;
    const bf16_t* AT = (const bf16_t*)(HB + GD_AT) + (size_t)u * 4096 + (size_t)r * 64 + 8 * h5;
    f32x16 o0, o1;
#pragma unroll
    for (int i = 0; i < 16; ++i) { o0[i] = 0.f; o1[i] = 0.f; }
#pragma unroll
    for (int ks = 0; ks < 8; ++ks) {
        const bf16x8 sa = __builtin_shufflevector(*(const s16x4*)(ST + (4 * ks) * 512), *(const s16x4*)(ST + (4 * ks + 1) * 512), 0, 1, 2, 3, 4, 5, 6, 7);
        const bf16x8 q0 = *(const bf16x8*)(QG + ks * 16), q1 = *(const bf16x8*)(QG + 32 * 128 + ks * 16);
        o0 = MFMA32(sa, q0, o0); o1 = MFMA32(sa, q1, o1);
        if (ks == 3) asm volatile("" ::: "memory");
    }
#pragma unroll
    for (int k2 = 0; k2 < 4; ++k2) {
        const bf16x8 va = __builtin_shufflevector(*(const s16x4*)(VT + (4 * k2) * 512), *(const s16x4*)(VT + (4 * k2 + 1) * 512), 0, 1, 2, 3, 4, 5, 6, 7);
        const bf16x8 a1 = *(const bf16x8*)(AT + 32 * 64 + k2 * 16);
        o1 = MFMA32(va, a1, o1);
        if (k2 < 2) { const bf16x8 a0 = *(const bf16x8*)(AT + k2 * 16); o0 = MFMA32(va, a0, o0); }
    }
    float s0 = 0.f, s1 = 0.f;
#pragma unroll
    for (int i = 0; i < 16; ++i) { s0 += o0[i] * o0[i]; s1 += o1[i] * o1[i]; }
    s0 += __shfl_xor(s0, 32); s1 += __shfl_xor(s1, 32);
    __syncthreads();
    if (h5 == 0) { sqL[wid * 64 + r] = s0; sqL[wid * 64 + 32 + r] = s1; }
    __syncthreads();
    const float rr0 = rsqrtf((sqL[r] + sqL[64 + r] + sqL[128 + r] + sqL[192 + r]) * (1.f / 128.f) + 1e-6f);
    const float rr1 = rsqrtf((sqL[32 + r] + sqL[96 + r] + sqL[160 + r] + sqL[224 + r]) * (1.f / 128.f) + 1e-6f);
#pragma unroll
    for (int tt = 0; tt < 2; ++tt) {
        const size_t t = t0 + tt * 32 + r;
        const bf16_t* zrow = PROJ + t * NPAD + 1960 + h * 128 + wid * 32 + 4 * h5;
        const float* gn = gnorm + wid * 32 + 4 * h5;
        bf16_t* orow = MIXO + t * 1024 + 512 + h * 128 + wid * 32 + 4 * h5;
        const float rr = tt ? rr1 : rr0;
#pragma unroll
        for (int g = 0; g < 4; ++g) {
            const u32x2 zr = *(const u32x2*)(zrow + 8 * g);
            const f32x4 gv = *(const f32x4*)(gn + 8 * g);
            const float z0 = bflo(zr.x), z1 = bfhi(zr.x), z2 = bflo(zr.y), z3 = bfhi(zr.y);
            const float y0 = (tt ? o1[4 * g] : o0[4 * g]) * rr * gv[0] * siluf_(z0), y1 = (tt ? o1[4 * g + 1] : o0[4 * g + 1]) * rr * gv[1] * siluf_(z1);
            const float y2 = (tt ? o1[4 * g + 2] : o0[4 * g + 2]) * rr * gv[2] * siluf_(z2), y3 = (tt ? o1[4 * g + 3] : o0[4 * g + 3]) * rr * gv[3] * siluf_(z3);
            *(u32x2*)(orow + 8 * g) = (u32x2){pk2(y0, y1), pk2(y2, y3)};
        }
    }
}

__device__ __forceinline__ void phase_post(const float* OG, const bf16_t* PROJ, const float* gain, bool odd, bf16_t* MIXO, const Ctx& c) {
    const int lane = c.lane;
    const int gcol = odd ? 1032 : 1960, ocol = odd ? 0 : 512;
    for (int t = c.bid * 4 + c.wid; t < T; t += c.nblk * 4) {
        const f32x4 a0 = *(const f32x4*)(OG + (size_t)t * 512 + lane * 8), a1 = *(const f32x4*)(OG + (size_t)t * 512 + lane * 8 + 4);
        float ss = (a0[0] * a0[0] + a0[1] * a0[1]) + (a0[2] * a0[2] + a0[3] * a0[3]) + (a1[0] * a1[0] + a1[1] * a1[1]) + (a1[2] * a1[2] + a1[3] * a1[3]);
        ss = red16(ss);
        const float rr = rsqrtf(ss * (1.f / 128.f) + 1e-6f);
        const u32x4 zr = *(const u32x4*)(PROJ + (size_t)t * NPAD + gcol + lane * 8);
        float z[8]; unpack8(zr, z);
        const int gi = odd ? lane * 8 : (lane & 15) * 8;
        const f32x4 g0 = *(const f32x4*)(gain + gi), g1 = *(const f32x4*)(gain + gi + 4);
        float y[8];
#pragma unroll
        for (int j = 0; j < 4; ++j) {
            const float ga = odd ? sigmoidf_(z[j]) : siluf_(z[j]), gb = odd ? sigmoidf_(z[4 + j]) : siluf_(z[4 + j]);
            y[j] = a0[j] * rr * g0[j] * ga; y[4 + j] = a1[j] * rr * g1[j] * gb;
        }
        *(u32x4*)(MIXO + (size_t)t * 1024 + ocol + lane * 8) = (u32x4){pk2(y[0], y[1]), pk2(y[2], y[3]), pk2(y[4], y[5]), pk2(y[6], y[7])};
    }
}

__global__ void __launch_bounds__(512, 2) fwd(Args a) {
    extern __shared__ __attribute__((aligned(16))) unsigned char smem[];
    Ctx c;
#define SET_CTX(cx) do { int t_ = threadIdx.x; asm volatile("" : "+v"(t_)); cx.tid0 = t_; cx.half = t_ >> 8; cx.tid = t_ & 255; cx.lane = t_ & 63; cx.wid = (t_ >> 6) & 3; \
        cx.wr = cx.wid >> 1; cx.wc = cx.wid & 1; cx.fr = cx.lane & 15; cx.fq = cx.lane >> 4; cx.bid = blockIdx.x * 2 + cx.half; cx.nblk = gridDim.x * 2; \
        cx.smem0 = smem; cx.smem = smem + cx.half * HALF_LDS; } while (0)
    SET_CTX(c);
#define PH_CTX() SET_CTX(c)
    unsigned char* const ws_base = a.ws;
    const void* const* const ain_base = (const void* const*)__builtin_amdgcn_kernarg_segment_ptr();
    unsigned* ctl = (unsigned*)(ws_base + WS_CTL);
    volatile LAS unsigned* xbw = (volatile LAS unsigned*)(smem + LDS_BLK);
    if (c.tid0 < 8) xbw[c.tid0] = 0u;
    __syncthreads();
    XcdBarrier bar; bar.bar = ctl; bar.x = 0; bar.st = xbw;
    if (a.use_bar) bar = xcd_barrier_post(ctl, xbw);
    const int lo = a.ph_lo, hi = a.ph_hi;
#define IN(k) (lo <= (k) && (k) < hi)
#define PH(k) if (IN(k)) { PH_CTX(); unsigned char* ws = ws_base; const void* const* ain = ain_base; asm volatile("" : "+s"(ws), "+s"(ain));
#define UNIT_CTX() Ctx cu; SET_CTX(cu)
#define SEAM(k) do { if ((k) + 1 < hi) xcd_barrier(bar); } while (0)

#define XBF ((bf16_t*)(ws + WS_XBF))
#define X1 ((float*)(ws + WS_X1))
#define PROJ ((bf16_t*)(ws + U_PROJ))
#define GATES ((float*)(ws + U_GATES))
#define MIXO ((bf16_t*)(ws + U_MIXO))
#define YBUF ((float*)(ws + U_YBUF))
#define ROPEM ((const float*)(ws + WS_ROPEM))
#define ROPES ((const float*)(ws + WS_ROPES))
#define XRES ((layer == 0) ? (const float*)ain[0] : (const float*)a.out)
#define CNT (ctl + CW_CNT + layer * 128)
#define WIN ((const bf16_t*)(ws + WS_WIN) + (size_t)layer * WIN_ELEMS)
#define WOUT ((const bf16_t*)(ws + WS_WOUT) + (size_t)layer * WOUT_ELEMS)

    PH(0) for (int rep = 0; rep < REP_PRO; ++rep) phase_prologue(a, c); SEAM(0); }

    for (int layer = 0; layer < 4; ++layer) {
        const int pb = 1 + layer * PPL;
        if (pb >= hi || pb + PPL <= lo) continue;
        const int jj = layer >> 1;
        const bool odd = (layer & 1) != 0;

        PH(pb + 0) {
                DenseSched S{T / 256, NPAD / 256, 1024, (int)blockIdx.x, (int)gridDim.x};
                EpiIn E{PROJ, GATES, odd ? 1024 : 1952};
                g8::phase<true, false>(smem, (const char*)XBF, (const char*)WIN, 1024, S, E);
            }
            SEAM(pb + 0); }
        PH(pb + 1) for (int rp = 0; rp < ((REP_PHASE == 1) ? 2 : 1); ++rp) { if (rp) xcd_barrier(bar);
            if (!odd) phase_prep_even(PROJ, GATES, (const float*)ain[3] + jj * 256, (const float*)ain[5] + jj * 128, (const float*)ain[7] + jj * 4 * 1536,
                                      (const float*)ain[8] + jj * 4, (const float*)ain[9] + jj * 4, ROPEM,
                                      (bf16_t*)(ws + U_CQ), (bf16_t*)(ws + U_CKV), (bf16_t*)(ws + U_KROPE), (bf16_t*)(ws + U_GQ), (bf16_t*)(ws + U_GK), (bf16_t*)(ws + U_GV),
                                      (float*)(ws + U_BETA), (float*)(ws + U_GLOG), c);
            else {
                phase_prep_odd(PROJ, ROPES, (bf16_t*)(ws + U_QF), (bf16_t*)(ws + U_KN), c);
                unsigned* ctr = ctl + CW_WORK + pb + 1 + 64 * rp;
                for (;;) {
                    const int u = next_unit(ctr, c); UNIT_CTX();
                    if (u >= 1024) break;
                    mlc_passA(u, PROJ, GATES, (const float*)ain[13] + jj * 4, (const float*)ain[14] + jj * 4, (unsigned char*)YBUF, cu);
                }
            }
            }
            SEAM(pb + 1);
        }
        PH(pb + 2) for (int rp = 0; rp < ((REP_PHASE == 2) ? 2 : 1); ++rp) { if (rp) xcd_barrier(bar);
            unsigned* ctr = ctl + CW_WORK + pb + 2 + 64 * rp;
            if (!odd) {
                for (;;) {
                    const int u = next_unit(ctr, c); UNIT_CTX();
                    if (u >= 1024 + MLAUP_TILES) break;
                    if (u < 1024) gdc_passA(u, (const bf16_t*)(ws + U_GQ), (const bf16_t*)(ws + U_GK), (const bf16_t*)(ws + U_GV), (const float*)(ws + U_BETA),
                                            (const float*)(ws + U_GLOG), ws + WS_HBUF, cu);
                    else mla_up_tile(u - 1024, (const bf16_t*)(ws + U_CQ), (const bf16_t*)(ws + WS_WQB) + (size_t)jj * WQB_ELEMS, (const bf16_t*)(ws + U_CKV),
                                     (const bf16_t*)(ws + WS_WKVB) + (size_t)jj * WKVB_ELEMS, ROPEM, (bf16_t*)(ws + U_QF), (bf16_t*)(ws + U_KN), (bf16_t*)(ws + U_VV), cu);
                }
            } else {
                for (;;) {
                    const int u = next_unit(ctr, c); UNIT_CTX();
                    if (u >= 256 + 1024) break;
                    if (u < 256) mlc_passB(u, (unsigned char*)YBUF, cu);
                    else {
                        const int v = u - 256, hq = v & 7, n = (v >> 3) & 15, b = v >> 7, kvh = hq >> 2;
                        const size_t tb = (size_t)b * SEQ;
                        attn_unit<4, true>((const bf16_t*)(ws + U_QF) + tb * 512 + hq * 64, 512, (const bf16_t*)(ws + U_KN) + tb * 128 + kvh * 64, 128,
                                           (const bf16_t*)(ws + U_KN), 0, PROJ + tb * NPAD + 2184 + kvh * 64, NPAD,
                                           MIXO + tb * 1024 + 512 + hq * 64, 1024, n * 128, ((const float*)ain[16])[jj * 8 + hq] * 1.4426950408889634f, cu);
                    }
                }
            }
            }
            SEAM(pb + 2);
        }
        PH(pb + 3) for (int rp = 0; rp < ((REP_PHASE == 3) ? 2 : 1); ++rp) { if (rp) xcd_barrier(bar);
            unsigned* ctr = ctl + CW_WORK + pb + 3 + 64 * rp;
            if (!odd) {
                for (;;) {
                    const int u = next_unit(ctr, c); UNIT_CTX();
                    if (u >= 64 + 1024) break;
                    if (rp > 0 && ((REP_ONLY == 1 && u >= 64) || (REP_ONLY == 2 && u < 64))) continue;
                    if (u < 64) { if ((u & 1) == 0) gdc_passB(u >> 1, ws + WS_HBUF, (unsigned char*)YBUF, cu); else gdc_passB_idle(); }
                    else {
                        const int v = u - 64, qb = 15 - (v >> 6), bh = v & 63, b = bh >> 3, hh = bh & 7;
                        const size_t tb = (size_t)b * SEQ;
                        attn_unit<6, false>((const bf16_t*)(ws + U_QF) + tb * 768 + hh * 96, 768, (const bf16_t*)(ws + U_KN) + tb * 512 + hh * 64, 512,
                                            (const bf16_t*)(ws + U_KROPE) + tb * 32, 32, (const bf16_t*)(ws + U_VV) + tb * 512 + hh * 64, 512,
                                            MIXO + tb * 1024 + hh * 64, 1024, qb * 128, 0.f, cu);
                    }
                }
            } else {
                for (;;) {
                    const int u = next_unit(ctr, c); UNIT_CTX();
                    if (u >= 1024) break;
                    mlc_passC(u, PROJ, GATES, (const float*)ain[13] + jj * 4, (const float*)ain[14] + jj * 4, (const unsigned char*)YBUF, (const float*)ain[15] + jj * 512, MIXO, cu);
                }
            }
            }
            SEAM(pb + 3);
        }
        PH(pb + 4) for (int rp = 0; rp < ((REP_PHASE == 4) ? 2 : 1); ++rp) { if (rp) xcd_barrier(bar);
            if (!odd) {
                unsigned* ctr = ctl + CW_WORK + pb + 4 + 64 * rp;
                for (;;) {
                    const int u = next_unit(ctr, c); UNIT_CTX();
                    if (u >= 1024) break;
                    gdc_passC(u, ws + WS_HBUF, (const unsigned char*)YBUF, PROJ, (const float*)ain[10] + jj * 128, MIXO, cu);
                }
            }
            }
            if (!odd) SEAM(pb + 4);
        }
        PH(pb + 5) {
                DenseSched S{T / 256, 4, 1024, (int)blockIdx.x, (int)gridDim.x};
                EpiOut E{XBF, (bf16_t*)YBUF};
                g8::phase<true, false>(smem, (const char*)MIXO, (const char*)WOUT, 1024, S, E);
            }
            SEAM(pb + 5); }
        PH(pb + 6) for (int rep = 0; rep < REP_TOK; ++rep) phase_ln1((const bf16_t*)YBUF, (const float*)ain[18] + layer * 1024, (const float*)ain[19] + layer * 1024, XBF, c); SEAM(pb + 6); }
        PH(pb + 7) for (int rep = 0; rep < REP_GEMM; ++rep) phase_router(XBF, (const bf16_t*)(ws + WS_WRT) + (size_t)layer * WRT_ELEMS, (float*)(ws + WS_LOG), c); SEAM(pb + 7); }
        PH(pb + 8) phase_route((const float*)(ws + WS_LOG), (const float*)ain[21] + layer * 64, CNT, (int*)(ws + WS_LTOK), (float*)(ws + WS_LW), (int*)(ws + WS_ASG), (float*)(ws + WS_ASGW), c); SEAM(pb + 8); }
        PH(pb + 9) {
                int* bst8 = (int*)(smem + LDS_BLK + 64); int* eb8 = bst8 + 256;
                build_block_table(CNT, bst8, c);
                for (int rb = c.tid0; rb < bst8[65]; rb += NT) { int e = 0; for (int q = 1; q < 65; ++q) e += (bst8[q] <= rb) ? 1 : 0; eb8[rb] = e; }
                __syncthreads();
                MoeSchedG S{bst8[65], (int)blockIdx.x, (int)gridDim.x, eb8, bst8, (const int*)(ws + WS_LTOK)};
                EpiMoe1 E{(bf16_t*)(ws + WS_HBUF)};
                g8::phase<false, true>(smem, (const char*)XBF, (const char*)((const bf16_t*)(ws + WS_WGU) + (size_t)layer * 65 * WGU_ELEMS), 1024, S, E);
            }
            SEAM(pb + 9); }
        PH(pb + 10)
#if MOE2_G8
            {
                int* bst8 = (int*)(smem + LDS_BLK + 64); int* eb8 = bst8 + 256;
                build_block_table(CNT, bst8, c);
                for (int rb = c.tid0; rb < bst8[65]; rb += NT) { int e = 0; for (int q = 1; q < 65; ++q) e += (bst8[q] <= rb) ? 1 : 0; eb8[rb] = e; }
                __syncthreads();
                MoeSched S{bst8[65], 4, (int)blockIdx.x, (int)gridDim.x, eb8};
                EpiMoe2 E{(bf16_t*)(ws + U_Y)};
                g8::phase<true, false>(smem, (const char*)(ws + WS_HBUF), (const char*)((const bf16_t*)(ws + WS_WDN) + (size_t)layer * 65 * WDN_ELEMS), 256, S, E);
            }
#else
            phase_moe2((const bf16_t*)(ws + WS_HBUF), (const bf16_t*)(ws + WS_WDN) + (size_t)layer * 65 * WDN_ELEMS, CNT, (bf16_t*)(ws + U_Y), c);
#endif
            SEAM(pb + 10); }
        PH(pb + 11)
            if (layer == 3) phase_combine<true>((const bf16_t*)(ws + U_Y), (const int*)(ws + WS_ASG), (const float*)(ws + WS_ASGW), CNT, (const float*)ain[28] + layer * 1024, (const float*)ain[29] + layer * 1024, a.out, XBF, c);
            else phase_combine<false>((const bf16_t*)(ws + U_Y), (const int*)(ws + WS_ASG), (const float*)(ws + WS_ASGW), CNT, (const float*)ain[28] + layer * 1024, (const float*)ain[29] + layer * 1024, a.out, XBF, c);
            SEAM(pb + 11); }
    }
#undef IN
#undef XBF
#undef X1
#undef PROJ
#undef GATES
#undef MIXO
#undef YBUF
#undef ROPEM
#undef ROPES
#undef XRES
#undef CNT
#undef WIN
#undef WOUT
#undef PH
#undef PH_CTX
#undef UNIT_CTX
#undef SEAM
}

extern "C" void kernel_launch(void* const* d_in, const int* in_sizes, int n_in, void* d_out, int out_size, void* d_ws, size_t ws_size, hipStream_t stream) {
    static int grid = 0;
    if (grid == 0) {
        if (n_in != 30 || out_size != T * 1024 || ws_size < WS_END) {
            fprintf(stderr, "kernel_launch: unexpected shapes (n_in %d, out %d, ws %zu < %zu)\n", n_in, out_size, ws_size, (size_t)WS_END);
            grid = -1; return;
        }
        int dev = 0, cus = 0, per_cu = 0;
        (void)hipGetDevice(&dev);
        (void)hipDeviceGetAttribute(&cus, hipDeviceAttributeMultiprocessorCount, dev);
        (void)hipFuncSetAttribute((const void*)fwd, hipFuncAttributeMaxDynamicSharedMemorySize, DYN_LDS);
        (void)hipOccupancyMaxActiveBlocksPerMultiprocessor(&per_cu, (const void*)fwd, NT, DYN_LDS);
        (void)hipGetLastError();
        if (per_cu < 1) per_cu = 1;
        grid = cus;
    }
    if (grid < 0) return;
    (void)hipMemsetAsync((char*)d_ws + WS_CTL, 0, CTL_BYTES, stream);
    Args a{};
    for (int i = 0; i < 30; ++i) a.in[i] = d_in[i];
    a.out = (float*)d_out; a.ws = (unsigned char*)d_ws; a.pad = 0;
#if ONE_LAUNCH
    a.ph_lo = 0; a.ph_hi = NPH; a.use_bar = 1;
    hipLaunchKernelGGL(fwd, dim3(grid), dim3(NT), DYN_LDS, stream, a);
#else
    for (int p = 0; p < NPH; ++p) {
        a.ph_lo = p; a.ph_hi = p + 1; a.use_bar = 0;
        hipLaunchKernelGGL(fwd, dim3(grid), dim3(NT), DYN_LDS, stream, a);
    }
#endif
}
```

```cpp
#include <hip/hip_runtime.h>
#include <stdint.h>
#include <stdio.h>

#define REP_GEMM 1
#define REP_PHASE 0
#define REP_G0 1
#define REP_G1 1
#define REP_G2 1
#define REP_G3 1
#define REP_MIX 1
#define REP_ONLY 0
#define REP_CMB 1
#define REP_PRO 1
#define REP_TOK 1
#define MOE2_G8 1
#ifndef G8_SPLIT
#define G8_SPLIT 0
#endif
#ifndef ONE_LAUNCH
#define ONE_LAUNCH 1
#endif

typedef unsigned short bf16_t;
typedef short bf16x8 __attribute__((ext_vector_type(8)));
typedef float f32x4 __attribute__((ext_vector_type(4)));
typedef unsigned u32x4 __attribute__((ext_vector_type(4)));
typedef unsigned u32x2 __attribute__((ext_vector_type(2)));
#define LAS __attribute__((address_space(3)))
#define GAS __attribute__((address_space(1)))

constexpr int T = 16384, SEQ = 2048;
constexpr int NPAD = 2560;
constexpr int CAP = 16384;
constexpr int RBR = 256;
constexpr int MAXRB = 512 + 64 + 64;
constexpr int MAXROWS = MAXRB * RBR;
constexpr float ALPHA = 1.681792830507429f;
constexpr int PPL = 12;
constexpr int NPH = 1 + 4 * PPL;
constexpr int NT = 512, NW = 8;
constexpr int HALF_LDS = 65536 + 64 + 1024;
constexpr int LDS_BLK = 2 * HALF_LDS;
constexpr int DYN_LDS = LDS_BLK + 64 + 1024 + 2560;

constexpr size_t cmax(size_t a, size_t b) { return a > b ? a : b; }
constexpr size_t WS_CTL = 0;
constexpr size_t CTL_BYTES = 65536;
constexpr size_t WS_WIN = WS_CTL + CTL_BYTES;
constexpr size_t WIN_ELEMS = (size_t)NPAD * 1024;
constexpr size_t WS_WQB = WS_WIN + 4 * WIN_ELEMS * 2;
constexpr size_t WQB_ELEMS = 768 * 256;
constexpr size_t WS_WKVB = WS_WQB + 2 * WQB_ELEMS * 2;
constexpr size_t WKVB_ELEMS = 1024 * 128;
constexpr size_t WS_WOUT = WS_WKVB + 2 * WKVB_ELEMS * 2;
constexpr size_t WOUT_ELEMS = 1024 * 1024;
constexpr size_t WS_WRT = WS_WOUT + 4 * WOUT_ELEMS * 2;
constexpr size_t WRT_ELEMS = 128 * 1024;
constexpr size_t WS_WGU = WS_WRT + 4 * WRT_ELEMS * 2;
constexpr size_t WGU_ELEMS = 512 * 1024;
constexpr size_t WS_WDN = WS_WGU + 4 * 65 * WGU_ELEMS * 2;
constexpr size_t WDN_ELEMS = 1024 * 256;
constexpr size_t WS_ROPEM = WS_WDN + 4 * 65 * WDN_ELEMS * 2;
constexpr size_t WS_ROPES = WS_ROPEM + (size_t)T * 16 * 2 * 4;
constexpr size_t WS_X1 = WS_ROPES + (size_t)T * 32 * 2 * 4;
constexpr size_t WS_XBF = WS_X1 + (size_t)T * 1024 * 4;
constexpr size_t WS_HBUF = WS_XBF + (size_t)T * 1024 * 2;
constexpr size_t WS_LOG = WS_HBUF + (size_t)MAXROWS * 256 * 2;
constexpr size_t WS_ASG = WS_LOG + (size_t)T * 64 * 4;
constexpr size_t WS_ASGW = WS_ASG + (size_t)T * 8 * 4;
constexpr size_t WS_LTOK = WS_ASGW + (size_t)T * 8 * 4;
constexpr size_t WS_LW = WS_LTOK + (size_t)65 * CAP * 4;
constexpr size_t WS_U = WS_LW + (size_t)65 * CAP * 4;
constexpr size_t U_Y = WS_U;
constexpr size_t U_PROJ = WS_U;
constexpr size_t U_GATES = U_PROJ + (size_t)T * NPAD * 2;
constexpr size_t U_CQ = U_GATES + (size_t)T * 8 * 4;
constexpr size_t U_CKV = U_CQ + (size_t)T * 256 * 2;
constexpr size_t U_KROPE = U_CKV + (size_t)T * 128 * 2;
constexpr size_t U_QF = U_KROPE + (size_t)T * 32 * 2;
constexpr size_t U_KN = U_QF + (size_t)T * 768 * 2;
constexpr size_t U_VV = U_KN + (size_t)T * 512 * 2;
constexpr size_t U_GQ = U_VV + (size_t)T * 512 * 2;
constexpr size_t U_GK = U_GQ + (size_t)T * 512 * 2;
constexpr size_t U_GV = U_GK + (size_t)T * 512 * 2;
constexpr size_t U_BETA = U_GV + (size_t)T * 512 * 2;
constexpr size_t U_GLOG = U_BETA + (size_t)T * 4 * 4;
constexpr size_t U_MIXO = U_GLOG + (size_t)T * 4 * 4;
constexpr size_t U_YBUF = U_MIXO + (size_t)T * 1024 * 2;
constexpr size_t U_END1 = U_YBUF + (size_t)T * 1024 * 4;
constexpr size_t WS_END = WS_U + cmax((size_t)MAXROWS * 1024 * 2, U_END1 - WS_U);

constexpr int CW_CNT = 4096;
constexpr int CW_WORK = 8192;

#define XB_TMO      128
#define XB_XCNT(j)  (256  + 64 * (j))
#define XB_XSUB(j)  (1280 + 64 * (j))
#define XB_XGEN(j)  (2304 + 64 * (j))
#define XB_TOP      3328
#define XB_TOPGEN   3392
#define XCD_BAR_WORDS 3456
#define XB_SPIN_CAP (1u << 18)

__device__ __forceinline__ unsigned xb_ld(unsigned* p)              { return __hip_atomic_load(p, __ATOMIC_RELAXED, __HIP_MEMORY_SCOPE_AGENT); }
__device__ __forceinline__ unsigned xb_add(unsigned* p, unsigned v) { return __hip_atomic_fetch_add(p, v, __ATOMIC_RELAXED, __HIP_MEMORY_SCOPE_AGENT); }
__device__ __forceinline__ unsigned xb_xcc_id() { return (unsigned)__builtin_amdgcn_s_getreg((3 << 11) | 20) & 0xFu; }
#define XB_SPIN(cond, bar) do { unsigned _sp = 0; while (cond) { __builtin_amdgcn_s_sleep(1); \
    if ((++_sp & 255u) == 0u) { if (xb_ld(&(bar)[XB_TMO])) break; if (_sp > XB_SPIN_CAP) { atomicAdd(&(bar)[XB_TMO], 1u); break; } } } } while (0)

struct XcdBarrier { unsigned* bar; unsigned x; volatile LAS unsigned* st; };

__device__ __forceinline__ XcdBarrier xcd_barrier_post(unsigned* bar, volatile LAS unsigned* st) {
    XcdBarrier b; b.bar = bar; b.x = xb_xcc_id(); b.st = st;
    if (threadIdx.x == 0) (void)xb_add(&bar[XB_XCNT(b.x)], 1u);
    return b;
}
__device__ __forceinline__ void xcd_barrier_complete(unsigned* bar, unsigned x, unsigned& nloc, unsigned& nx) {
    const unsigned G = gridDim.x * gridDim.y * gridDim.z;
    unsigned sum, cnt, mine, sp = 0u;
    for (;;) {
        sum = 0u; cnt = 0u; mine = 0u;
#pragma unroll
        for (unsigned j = 0; j < 16; ++j) { const unsigned c = xb_ld(&bar[XB_XCNT(j)]); sum += c; cnt += (c > 0u) ? 1u : 0u; mine = (j == x) ? c : mine; }
        if (sum == G) break;
        __builtin_amdgcn_s_sleep(1);
        if ((++sp & 255u) == 0u) { if (xb_ld(&bar[XB_TMO])) break; if (sp > XB_SPIN_CAP) { atomicAdd(&bar[XB_TMO], 1u); break; } }
    }
    nloc = mine > 0u ? mine : 1u; nx = cnt > 0u ? cnt : 1u;
}
__device__ __forceinline__ void xcd_barrier(const XcdBarrier& b) {
    asm volatile("s_waitcnt vmcnt(0)" ::: "memory");
    __syncthreads();
    if (threadIdx.x == 0) {
        unsigned* bar = b.bar; unsigned bx = __builtin_amdgcn_readfirstlane(b.x);
        asm volatile("" : "+s"(bar), "+s"(bx));
        __builtin_amdgcn_s_waitcnt(0);
        unsigned nloc = b.st[0], nx = b.st[1];
        if (nloc == 0u) { xcd_barrier_complete(bar, bx, nloc, nx); b.st[0] = nloc; b.st[1] = nx; }
        const unsigned old = xb_add(&bar[XB_XSUB(bx)], 1u);
        const unsigned gen = old / nloc;
        if (old + 1u == (gen + 1u) * nloc) {
            __builtin_amdgcn_fence(__ATOMIC_RELEASE, "agent");
            asm volatile("s_waitcnt vmcnt(0)" ::: "memory");
            const unsigned og = xb_add(&bar[XB_TOP], 1u);
            const unsigned tg = og / nx;
            if (og + 1u == (tg + 1u) * nx) xb_add(&bar[XB_TOPGEN], 1u);
            else XB_SPIN(xb_ld(&bar[XB_TOPGEN]) == tg, bar);
            __builtin_amdgcn_fence(__ATOMIC_ACQUIRE, "agent");
            xb_add(&bar[XB_XGEN(bx)], 1u);
            asm volatile("s_waitcnt vmcnt(0)" ::: "memory");
        } else {
            XB_SPIN(xb_ld(&bar[XB_XGEN(bx)]) == gen, bar);
            __builtin_amdgcn_fence(__ATOMIC_ACQUIRE, "agent");
            asm volatile("s_waitcnt vmcnt(0)" ::: "memory");
        }
    }
    __syncthreads();
}

__device__ __forceinline__ float bf2f(unsigned v) { return __uint_as_float(v << 16); }
__device__ __forceinline__ float bflo(unsigned w) { return __uint_as_float(w << 16); }
__device__ __forceinline__ float bfhi(unsigned w) { return __uint_as_float(w & 0xffff0000u); }
__device__ __forceinline__ unsigned f2bf(float f) { unsigned u = __float_as_uint(f); u += 0x7fffu + ((u >> 16) & 1u); return u >> 16; }
__device__ __forceinline__ unsigned pk2(float lo, float hi) { return f2bf(lo) | (f2bf(hi) << 16); }
__device__ __forceinline__ unsigned cvt_pk(float lo, float hi) { unsigned r; asm volatile("v_cvt_pk_bf16_f32 %0, %1, %2" : "=v"(r) : "v"(lo), "v"(hi)); return r; }
__device__ __forceinline__ float wave_sum(float v) {
#pragma unroll
    for (int o = 32; o > 0; o >>= 1) v += __shfl_xor(v, o);
    return v;
}
__device__ __forceinline__ float sigmoidf_(float x) { return 1.f / (1.f + expf(-x)); }
__device__ __forceinline__ float siluf_(float x) { return x / (1.f + expf(-x)); }
__device__ __forceinline__ float softplusf_(float x) { return x > 20.f ? x : log1pf(expf(x)); }
__device__ __forceinline__ void glds16(const void* g, void* l) {
    __builtin_amdgcn_global_load_lds((const GAS unsigned*)g, (LAS unsigned*)l, 16, 0, 0);
}
__device__ __forceinline__ void unpack8(const u32x4 r, float (&f)[8]) {
    f[0] = bflo(r.x); f[1] = bfhi(r.x); f[2] = bflo(r.y); f[3] = bfhi(r.y);
    f[4] = bflo(r.z); f[5] = bfhi(r.z); f[6] = bflo(r.w); f[7] = bfhi(r.w);
}

struct Args {
    const void* in[30];
    float* out;
    unsigned char* ws;
    int ph_lo, ph_hi, use_bar, pad;
};

struct Ctx { int tid, lane, wid, wr, wc, fr, fq, bid, nblk; unsigned char* smem; int half, tid0; unsigned char* smem0; };

#define WAIT_V(n) asm volatile("s_waitcnt vmcnt(" #n ")" ::: "memory")
__device__ __forceinline__ void gemm_tile(const bf16_t* a0, const bf16_t* a1, const bf16_t* b0, const bf16_t* b1,
                                          int nk, f32x4 (&acc)[4][4], const Ctx& c) {
#pragma unroll
    for (int m = 0; m < 4; ++m)
#pragma unroll
        for (int n = 0; n < 4; ++n) acc[m][n] = (f32x4){0.f, 0.f, 0.f, 0.f};
    unsigned char* smem = c.smem;
    const int sb = c.tid * 16;
    const int kofs = ((c.tid & 3) ^ ((c.tid >> 4) & 3)) * 8;
    a0 += kofs; a1 += kofs; b0 += kofs; b1 += kofs;
#define G_STAGE(kt_) do { unsigned char* sp_ = smem + ((kt_) & 3) * 16384 + sb; const int ko_ = (kt_) * 32; \
        glds16(a0 + ko_, sp_); glds16(a1 + ko_, sp_ + 4096); glds16(b0 + ko_, sp_ + 8192); glds16(b1 + ko_, sp_ + 12288); } while (0)
#define G_READ(kt_, AF, BF) do { const unsigned char* sa_ = smem + ((kt_) & 3) * 16384 + c.wr * 4096 + roff; const unsigned char* sb_ = smem + ((kt_) & 3) * 16384 + 8192 + c.wc * 4096 + roff; \
        _Pragma("unroll") for (int m = 0; m < 4; ++m) AF[m] = *(const bf16x8*)(sa_ + m * 1024); \
        _Pragma("unroll") for (int n = 0; n < 4; ++n) BF[n] = *(const bf16x8*)(sb_ + n * 1024); } while (0)
#define G_MMA(AF, BF) do { __builtin_amdgcn_s_setprio(1); \
        _Pragma("unroll") for (int m = 0; m < 4; ++m) _Pragma("unroll") for (int n = 0; n < 4; ++n) acc[m][n] = __builtin_amdgcn_mfma_f32_16x16x32_bf16(BF[n], AF[m], acc[m][n], 0, 0, 0); \
        __builtin_amdgcn_s_setprio(0); } while (0)
#define G_BAR() do { asm volatile("" ::: "memory"); __builtin_amdgcn_s_barrier(); asm volatile("" ::: "memory"); } while (0)
    const int roff = (c.fr * 64) + ((c.fq ^ ((c.fr >> 2) & 3)) * 16);
    WAIT_V(0);
    G_STAGE(0); G_STAGE(1); G_STAGE(2); G_STAGE(3);
    bf16x8 fa0[4], fb0[4], fa1[4], fb1[4];
    WAIT_V(12); G_BAR();
    G_READ(0, fa0, fb0);
#define G_LGK0() asm volatile("s_waitcnt lgkmcnt(0)" ::: "memory")
    int kt = 0;
    for (; kt < nk - 4; kt += 4) {
        G_LGK0(); WAIT_V(8); G_BAR(); G_STAGE(kt + 4); G_READ(1, fa1, fb1); G_MMA(fa0, fb0);
        G_LGK0(); WAIT_V(8); G_BAR(); G_STAGE(kt + 5); G_READ(2, fa0, fb0); G_MMA(fa1, fb1);
        G_LGK0(); WAIT_V(8); G_BAR(); G_STAGE(kt + 6); G_READ(3, fa1, fb1); G_MMA(fa0, fb0);
        G_LGK0(); WAIT_V(8); G_BAR(); G_STAGE(kt + 7); G_READ(0, fa0, fb0); G_MMA(fa1, fb1);
    }
    G_LGK0(); WAIT_V(8); G_BAR(); G_READ(1, fa1, fb1); G_MMA(fa0, fb0);
    G_LGK0(); WAIT_V(4); G_BAR(); G_READ(2, fa0, fb0); G_MMA(fa1, fb1);
    G_LGK0(); WAIT_V(0); G_BAR(); G_READ(3, fa1, fb1); G_MMA(fa0, fb0);
    G_MMA(fa1, fb1);
#undef G_LGK0
#undef G_STAGE
#undef G_READ
#undef G_MMA
#undef G_BAR
    __syncthreads();
}

namespace g8 {
constexpr int BM = 256, BK = 64, HALF = 128, HTB = HALF * BK * 2, STAGE_BYTES = 8 * HTB;
__device__ __forceinline__ int lds_byte(int r, int c) { const int st = (r >> 4) * 2 + (c >> 5), rr = r & 15, cc = c & 31, ob = rr * 64 + cc * 2; return st * 1024 + (ob ^ (((ob >> 9) & 1) << 5)); }
__device__ __forceinline__ void stage_rc(int b, int& R, int& C) { const int st = b / 1024, sb = b % 1024, swz = sb ^ (((sb >> 9) & 1) << 5); R = (st >> 1) * 16 + swz / 64; C = (st & 1) * 32 + (swz % 64) / 2; }
__device__ __forceinline__ int perm32(int rho) { const int n = rho >> 4, i = rho & 15; return 8 * (i >> 2) + 4 * n + (i & 3); }
struct Unit { int pm, pn, bt; };

template <bool PERM, bool GATHER, class Sched, class Epi>
__device__ __forceinline__ void phase(unsigned char* ldsp, const char* Abase, const char* Bbase, int K, const Sched& S, const Epi& E) {
    LAS unsigned char* lds = (LAS unsigned char*)ldsp;
    int tid = threadIdx.x; asm volatile("" : "+v"(tid));
    const int wid = __builtin_amdgcn_readfirstlane(tid >> 6), lane = tid & 63, wr = wid >> 2, wc = wid & 3, fr = lane & 15, fq = lane >> 4;
    const int nt = K / BK;
    unsigned voffA[2], voffB[2];
#pragma unroll
    for (int i = 0; i < 2; ++i) { int R, C; stage_rc(tid * 16 + i * 8192, R, C); const int Rb = PERM ? ((R >> 5) * 64 + perm32(R & 31)) : R;
        voffA[i] = (unsigned)(R * K + C) * 2u; voffB[i] = (unsigned)(Rb * K + C) * 2u; }
    const size_t kstep = (size_t)(BK * 2);
    const size_t hstep = (size_t)HALF * K * 2, tstep = 2 * hstep, bhstep = PERM ? (size_t)32 * K * 2 : hstep;
    const unsigned ldsw = (unsigned)wid * 1024u;
    const int aoff = lds_byte(wr * 64 + fr, fq * 8), boff = lds_byte(wc * 32 + fr, fq * 8);
#define G8_SA(b, h) (((b) * 2 + (h)) * HTB)
#define G8_SB(b, h) ((4 + (b) * 2 + (h)) * HTB)
#define G8_DMA(gptr, voff32, ldsoff) do { const char* _gp = (gptr); const unsigned _lo = (unsigned)(size_t)(ldsp) + (unsigned)(ldsoff); \
        asm volatile("s_mov_b32 m0, %2\n\ts_nop 0\n\tglobal_load_lds_dwordx4 %0, %1" :: "v"(voff32), "s"(_gp), "s"(_lo) : "memory", "m0"); } while (0)
#define G8_STAGE(bufoff, gbase, voff) do { _Pragma("unroll") for (int _i = 0; _i < 2; ++_i) G8_DMA((const char*)(gbase), (voff)[_i], (bufoff) + ldsw + _i * 8192); } while (0)
#define G8_STAGEA(bufoff, gbase, h, kb) do { if constexpr (GATHER) { _Pragma("unroll") for (int _i = 0; _i < 2; ++_i) G8_DMA(Abase + (kb), vA[2 * (h) + _i], (bufoff) + ldsw + _i * 8192); } \
        else G8_STAGE(bufoff, (gbase) + (size_t)(h) * hstep + (kb), voffA); } while (0)
#define G8_LDA(dst, b, h) do { _Pragma("unroll") for (int m = 0; m < 4; ++m) _Pragma("unroll") for (int k = 0; k < 2; ++k) dst[m][k] = *(const LAS bf16x8*)(lds + G8_SA(b, h) + aoff + m * 2048 + k * 1024); } while (0)
#define G8_LDB(dst, b, h) do { _Pragma("unroll") for (int n = 0; n < 2; ++n) _Pragma("unroll") for (int k = 0; k < 2; ++k) dst[n][k] = *(const LAS bf16x8*)(lds + G8_SB(b, h) + boff + n * 2048 + k * 1024); } while (0)
#define G8_MMA(ai, bj, At, Bt) do { __builtin_amdgcn_s_setprio(1); _Pragma("unroll") for (int m = 0; m < 4; ++m) _Pragma("unroll") for (int n = 0; n < 2; ++n) _Pragma("unroll") for (int k = 0; k < 2; ++k) \
        acc[ai][bj][m][n] = __builtin_amdgcn_mfma_f32_16x16x32_bf16(Bt[n][k], At[m][k], acc[ai][bj][m][n], 0, 0, 0); __builtin_amdgcn_s_setprio(0); } while (0)
#define G8_WAIT_V(n) asm volatile("s_waitcnt vmcnt(" #n ")" ::: "memory")
#define G8_WAIT_L(n) asm volatile("s_waitcnt lgkmcnt(" #n ")" ::: "memory")
#define G8_BAR __builtin_amdgcn_s_barrier()
#define G8_SCHED __builtin_amdgcn_sched_barrier(0)
    Unit cur, nxt; int ui = 0;
    if (!S.next(0, cur)) return;
    f32x4 acc[2][2][4][2];
#pragma unroll
    for (int a = 0; a < 2; ++a)
#pragma unroll
        for (int b = 0; b < 2; ++b)
#pragma unroll
            for (int m = 0; m < 4; ++m)
#pragma unroll
                for (int n = 0; n < 2; ++n) acc[a][b][m][n] = (f32x4){0.f, 0.f, 0.f, 0.f};
    bf16x8 At[4][2], B0[2][2], B1[2][2];
    const char* cA = Abase + (size_t)cur.pm * tstep; const char* cB = Bbase + (size_t)cur.bt * tstep;
    unsigned vA[4] = {0u, 0u, 0u, 0u};
    if constexpr (GATHER) S.aoff(cur, tid, vA);
    asm volatile("s_waitcnt vmcnt(0)" ::: "memory");
    G8_STAGE(G8_SB(0, 0), cB, voffB); G8_STAGEA(G8_SA(0, 0), cA, 0, 0); G8_STAGE(G8_SB(0, 1), cB + bhstep, voffB); G8_STAGEA(G8_SA(0, 1), cA, 1, 0);
    if (wr == 1) G8_BAR;
    G8_WAIT_V(4); G8_BAR;
    G8_STAGE(G8_SB(1, 0), cB + kstep, voffB); G8_STAGEA(G8_SA(1, 0), cA, 0, kstep); G8_STAGE(G8_SB(1, 1), cB + bhstep + kstep, voffB);
    G8_WAIT_V(6); G8_BAR;
    G8_STAGEA(G8_SA(1, 1), cA, 1, kstep);
    for (;;) {
        const bool has_next = S.next(ui + 1, nxt);
        const char* nA = has_next ? Abase + (size_t)nxt.pm * tstep : cA; const char* nB = has_next ? Bbase + (size_t)nxt.bt * tstep : cB;
        for (int t = 0; t < nt; t += 2) {
            const bool last = (t == nt - 2);
            const int lastf = __builtin_amdgcn_readfirstlane(last ? 1 : 0);
            const size_t k2 = last ? 0 : (size_t)(t + 2) * kstep, k3 = k2 + kstep;
            const char* a2 = last ? nA : cA; const char* b2 = last ? nB : cB + (size_t)(t + 2) * kstep;
            const char* b3 = b2 + kstep;
            G8_LDB(B0, 0, 0); G8_SCHED; G8_LDA(At, 0, 0);
            if constexpr (GATHER) { if (last && has_next) S.aoff(nxt, tid, vA); }
            G8_WAIT_L(8); G8_BAR; G8_WAIT_L(0); G8_MMA(0, 0, At, B0); G8_BAR; G8_SCHED;
            G8_LDB(B1, 0, 1); G8_STAGE(G8_SB(0, 0), b2, voffB);
            G8_BAR; G8_WAIT_L(0); G8_MMA(0, 1, At, B1); G8_BAR;
            G8_LDA(At, 0, 1); G8_STAGEA(G8_SA(0, 0), a2, 0, k2);
            G8_BAR; G8_WAIT_L(0); G8_MMA(1, 0, At, B0); G8_BAR; G8_SCHED;
            G8_STAGE(G8_SB(0, 1), b2 + bhstep, voffB);
            const int pend = __builtin_amdgcn_readfirstlane((t == 0 && ui > 0) ? 1 : 0);
            asm volatile("s_cmp_lg_u32 %0, 0\n\ts_cbranch_scc1 1f\n\ts_waitcnt vmcnt(6)\n1:\n\ts_waitcnt vmcnt(%1)" :: "s"(pend), "n"(6 + (Epi::SPLIT ? Epi::NQ : Epi::NST)) : "memory", "scc");
            G8_BAR; G8_MMA(1, 1, At, B1); G8_BAR;
            G8_LDB(B0, 1, 0); G8_SCHED; G8_LDA(At, 1, 0); G8_STAGEA(G8_SA(0, 1), a2, 1, k2);
            G8_WAIT_L(8); G8_BAR; G8_WAIT_L(0); G8_MMA(0, 0, At, B0); G8_BAR; G8_SCHED;
            if constexpr (Epi::SPLIT) { E.template part_cond<0, 0>(acc, cur, wr, wc, fr, fq, lastf); G8_SCHED; }
            G8_LDB(B1, 1, 1); G8_STAGE(G8_SB(1, 0), b3, voffB);
            G8_BAR; G8_WAIT_L(0); G8_MMA(0, 1, At, B1); G8_BAR;
            if constexpr (Epi::SPLIT) { E.template part_cond<0, 1>(acc, cur, wr, wc, fr, fq, lastf); G8_SCHED; }
            G8_LDA(At, 1, 1); G8_STAGEA(G8_SA(1, 0), a2, 0, k3);
            G8_BAR; G8_WAIT_L(0); G8_MMA(1, 0, At, B0); G8_BAR; G8_SCHED;
            G8_STAGE(G8_SB(1, 1), b3 + bhstep, voffB);
            if constexpr (Epi::SPLIT) {
                asm volatile("s_cmp_lg_u32 %0, 0\n\ts_cbranch_scc1 1f\n\ts_waitcnt vmcnt(6)\n1:\n\ts_waitcnt vmcnt(%1)" :: "s"(lastf), "n"(6 + 2 * Epi::NQ) : "memory", "scc");
                G8_SCHED; E.template part_cond<1, 0>(acc, cur, wr, wc, fr, fq, lastf); G8_SCHED;
            } else G8_WAIT_V(6);
            G8_BAR; G8_MMA(1, 1, At, B1); G8_BAR;
            G8_STAGEA(G8_SA(1, 1), a2, 1, k3);
        }
        if constexpr (Epi::SPLIT) E.tail(acc, cur, wr, wc, fr, fq); else E(acc, cur, wr, wc, fr, fq);
        if (!has_next) break;
#pragma unroll
        for (int a = 0; a < 2; ++a)
#pragma unroll
            for (int b = 0; b < 2; ++b)
#pragma unroll
                for (int m = 0; m < 4; ++m)
#pragma unroll
                    for (int n = 0; n < 2; ++n) acc[a][b][m][n] = (f32x4){0.f, 0.f, 0.f, 0.f};
        cur = nxt; cA = nA; cB = nB; ++ui;
    }
    G8_WAIT_V(0);
    if (wr == 0) G8_BAR;
    G8_BAR;
#undef G8_SA
#undef G8_SB
#undef G8_STAGE
#undef G8_STAGEA
#undef G8_LDA
#undef G8_LDB
#undef G8_MMA
#undef G8_WAIT_V
#undef G8_WAIT_L
#undef G8_BAR
#undef G8_SCHED
}
}

__device__ __forceinline__ bool tile_map(int i, const Ctx& c, int ntm, int ntn, int& mt, int& nt) {
    const int vb = ((c.nblk & 15) == 0) ? ((c.bid >> 1) & 7) * (c.nblk >> 3) + (((c.bid >> 4) << 1) | (c.bid & 1)) : c.bid;
    const int L = i * c.nblk + vb;
    if (L >= ntm * ntn) return false;
    const int g = L / (8 * ntn), rem = L - g * 8 * ntn;
    const int gsz = (ntm - g * 8) < 8 ? (ntm - g * 8) : 8;
    mt = g * 8 + rem % gsz; nt = rem / gsz;
    return true;
}

__device__ __forceinline__ bool tile_map2(int i, const Ctx& c, int ntm, int ntn, int& mt, int& nt, bool& valid) {
    Ctx o = c; o.bid = c.bid ^ 1;
    int mo, no; const bool oko = tile_map(i, o, ntm, ntn, mo, no);
    valid = tile_map(i, c, ntm, ntn, mt, nt);
    if (!valid) { mt = 0; nt = 0; }
    return valid || oko;
}

struct DenseSched {
    int ntm, ntn, K, bid, nblk;
    __device__ __forceinline__ bool next(int i, g8::Unit& u) const {
        const int vb = ((nblk & 7) == 0) ? (bid & 7) * (nblk >> 3) + (bid >> 3) : bid;
        const int L = i * nblk + vb;
        if (L >= ntm * ntn) return false;
        const int g = L / (8 * ntn), rem = L - g * 8 * ntn;
        const int gsz = (ntm - g * 8) < 8 ? (ntm - g * 8) : 8;
        u.pm = g * 8 + rem % gsz; u.pn = rem / gsz; u.bt = u.pn;
        return true;
    }
};
struct MoeSched {
    int nrb, ntn, bid, nblk; const int* eb;
    __device__ __forceinline__ bool next(int i, g8::Unit& u) const {
        const int vb = ((nblk & 7) == 0) ? (bid & 7) * (nblk >> 3) + (bid >> 3) : bid;
        const int L = i * nblk + vb;
        if (L >= nrb * ntn) return false;
        const int g = L / (8 * ntn), rem = L - g * 8 * ntn;
        const int gsz = (nrb - g * 8) < 8 ? (nrb - g * 8) : 8;
        u.pm = g * 8 + rem % gsz; u.pn = rem / gsz;
        u.bt = __builtin_amdgcn_readfirstlane(eb[u.pm]) * ntn + u.pn;
        return true;
    }
};
struct MoeSchedG {
    int nrb, bid, nblk; const int* eb; const int* bst; const int* LTOK;
    __device__ __forceinline__ bool next(int i, g8::Unit& u) const {
        const int vb = ((nblk & 7) == 0) ? (bid & 7) * (nblk >> 3) + (bid >> 3) : bid;
        const int L = i * nblk + vb;
        if (L >= nrb * 2) return false;
        const int g = L >> 4, rem = L & 15;
        const int gsz = (nrb - g * 8) < 8 ? (nrb - g * 8) : 8;
        u.pm = g * 8 + rem % gsz; u.pn = rem / gsz;
        u.bt = __builtin_amdgcn_readfirstlane(eb[u.pm]) * 2 + u.pn;
        return true;
    }
    __device__ __forceinline__ void aoff(const g8::Unit& u, int tid, unsigned (&o)[4]) const {
        const int e = eb[u.pm], lb = u.pm - bst[e], cnt = bst[66 + e];
        int R0, C0, R1, C1; g8::stage_rc(tid * 16, R0, C0); g8::stage_rc(tid * 16 + 8192, R1, C1);
        const int* lt = LTOK + (size_t)e * CAP + lb * RBR;
        const int p00 = R0, p01 = R1, p10 = 128 + R0, p11 = 128 + R1;
        const int t00 = (lb * RBR + p00 < cnt) ? lt[p00] : 0, t01 = (lb * RBR + p01 < cnt) ? lt[p01] : 0;
        const int t10 = (lb * RBR + p10 < cnt) ? lt[p10] : 0, t11 = (lb * RBR + p11 < cnt) ? lt[p11] : 0;
        o[0] = (unsigned)t00 * 2048u + (unsigned)C0 * 2u; o[1] = (unsigned)t01 * 2048u + (unsigned)C1 * 2u;
        o[2] = (unsigned)t10 * 2048u + (unsigned)C0 * 2u; o[3] = (unsigned)t11 * 2048u + (unsigned)C1 * 2u;
    }
};
struct EpiMoe1 {
    static constexpr bool SPLIT = false; static constexpr int NQ = 4, NST = 16;
    bf16_t* H;
    __device__ __forceinline__ void operator()(const f32x4 (&acc)[2][2][4][2], const g8::Unit& u, int wr, int wc, int fr, int fq) const {
#pragma unroll
        for (int ai = 0; ai < 2; ++ai)
#pragma unroll
            for (int m = 0; m < 4; ++m) {
                const size_t row = (size_t)u.pm * RBR + ai * 128 + wr * 64 + m * 16 + fr;
#pragma unroll
                for (int bj = 0; bj < 2; ++bj) {
                    const int hc = (u.pn * 8 + bj * 4 + wc) * 16 + fq * 4;
                    const f32x4 g = acc[ai][bj][m][0], up = acc[ai][bj][m][1];
                    float h[4];
#pragma unroll
                    for (int j = 0; j < 4; ++j) h[j] = g[j] * __builtin_amdgcn_rcpf(1.f + __expf(-g[j])) * up[j];
                    *(u32x2*)(H + row * 256 + hc) = (u32x2){cvt_pk(h[0], h[1]), cvt_pk(h[2], h[3])};
                }
            }
    }
    template <int ai, int bj> __device__ __forceinline__ void part_cond(const f32x4 (&acc)[2][2][4][2], const g8::Unit& u, int wr, int wc, int fr, int fq, int flag) const {}
    __device__ __forceinline__ void tail(const f32x4 (&acc)[2][2][4][2], const g8::Unit& u, int wr, int wc, int fr, int fq) const {}
};
__device__ __forceinline__ u32x4 dpp_ror8(const u32x4 v) {
    u32x4 r;
#pragma unroll
    for (int i = 0; i < 4; ++i) r[i] = (unsigned)__builtin_amdgcn_update_dpp(0, (int)v[i], 0x128, 0xF, 0xF, true);
    return r;
}
__device__ __forceinline__ void perm_store(bf16_t* p  , size_t ld8  , const u32x4 p0, const u32x4 p1, int hi) {
    const u32x4 snd = hi ? p0 : p1, rcv = dpp_ror8(snd);
    *(u32x4*)p = hi ? rcv : p0;
    *(u32x4*)(p + ld8) = hi ? p1 : rcv;
}
struct EpiIn {
    static constexpr bool SPLIT = false; static constexpr int NQ = 4, NST = 16;
    bf16_t* P; float* G; int gbase;
    template <int ai, int bj> __device__ __forceinline__ void part_cond(const f32x4 (&acc)[2][2][4][2], const g8::Unit& u, int wr, int wc, int fr, int fq, int flag) const {}
    __device__ __forceinline__ void tail(const f32x4 (&acc)[2][2][4][2], const g8::Unit& u, int wr, int wc, int fr, int fq) const {}
    __device__ __forceinline__ void operator()(const f32x4 (&acc)[2][2][4][2], const g8::Unit& u, int wr, int wc, int fr, int fq) const {
        const int hi = fr >> 3, r8 = fr & 7;
#pragma unroll
        for (int ai = 0; ai < 2; ++ai)
#pragma unroll
            for (int m = 0; m < 4; ++m) {
                const size_t rg = (size_t)u.pm * 256 + ai * 128 + wr * 64 + m * 16;
                u32x4 pk[2];
#pragma unroll
                for (int bj = 0; bj < 2; ++bj) {
                    const f32x4 v0 = acc[ai][bj][m][0], v1 = acc[ai][bj][m][1];
                    pk[bj] = (u32x4){cvt_pk(v0[0], v0[1]), cvt_pk(v0[2], v0[3]), cvt_pk(v1[0], v1[1]), cvt_pk(v1[2], v1[3])};
                    if (u.pn * 256 + wc * 64 + bj * 32 + fq * 8 == gbase) { *(f32x4*)(G + (rg + fr) * 8) = v0; *(f32x4*)(G + (rg + fr) * 8 + 4) = v1; }
                }
                perm_store(P + (rg + r8) * NPAD + u.pn * 256 + wc * 64 + hi * 32 + fq * 8, (size_t)8 * NPAD, pk[0], pk[1], hi);
            }
    }
};
struct EpiMoe2 {
    static constexpr bool SPLIT = false; static constexpr int NQ = 4, NST = 16;
    bf16_t* Y;
    template <int ai, int bj> __device__ __forceinline__ void part_cond(const f32x4 (&acc)[2][2][4][2], const g8::Unit& u, int wr, int wc, int fr, int fq, int flag) const {}
    __device__ __forceinline__ void tail(const f32x4 (&acc)[2][2][4][2], const g8::Unit& u, int wr, int wc, int fr, int fq) const {}
    __device__ __forceinline__ void operator()(const f32x4 (&acc)[2][2][4][2], const g8::Unit& u, int wr, int wc, int fr, int fq) const {
        const int hi = fr >> 3, r8 = fr & 7;
#pragma unroll
        for (int ai = 0; ai < 2; ++ai)
#pragma unroll
            for (int m = 0; m < 4; ++m) {
                const size_t rg = (size_t)u.pm * RBR + ai * 128 + wr * 64 + m * 16;
                u32x4 pk[2];
#pragma unroll
                for (int bj = 0; bj < 2; ++bj) {
                    const f32x4 v0 = acc[ai][bj][m][0], v1 = acc[ai][bj][m][1];
                    pk[bj] = (u32x4){cvt_pk(v0[0], v0[1]), cvt_pk(v0[2], v0[3]), cvt_pk(v1[0], v1[1]), cvt_pk(v1[2], v1[3])};
                }
                perm_store(Y + (rg + r8) * 1024 + u.pn * 256 + wc * 64 + hi * 32 + fq * 8, (size_t)8 * 1024, pk[0], pk[1], hi);
            }
    }
};
struct EpiOut {
    static constexpr bool SPLIT = false; static constexpr int NQ = 8, NST = 32;
    template <int ai, int bj> __device__ __forceinline__ void part_cond(const f32x4 (&acc)[2][2][4][2], const g8::Unit& u, int wr, int wc, int fr, int fq, int flag) const {}
    __device__ __forceinline__ void tail(const f32x4 (&acc)[2][2][4][2], const g8::Unit& u, int wr, int wc, int fr, int fq) const {}
    const bf16_t* xres; bf16_t* Y;
    __device__ __forceinline__ void operator()(const f32x4 (&acc)[2][2][4][2], const g8::Unit& u, int wr, int wc, int fr, int fq) const {
        const int hi = fr >> 3, r8 = fr & 7;
#pragma unroll
        for (int ai = 0; ai < 2; ++ai)
#pragma unroll
            for (int m = 0; m < 4; ++m) {
                const size_t rg = (size_t)u.pm * 256 + ai * 128 + wr * 64 + m * 16;
                u32x4 pk[2];
#pragma unroll
                for (int bj = 0; bj < 2; ++bj) {
                    const u32x4 xr = *(const u32x4*)(xres + (rg + fr) * 1024 + u.pn * 256 + wc * 64 + bj * 32 + fq * 8);
                    float f[8]; unpack8(xr, f);
                    const f32x4 v0 = acc[ai][bj][m][0], v1 = acc[ai][bj][m][1];
                    pk[bj] = (u32x4){cvt_pk(f[0] * ALPHA + v0[0], f[1] * ALPHA + v0[1]), cvt_pk(f[2] * ALPHA + v0[2], f[3] * ALPHA + v0[3]),
                                     cvt_pk(f[4] * ALPHA + v1[0], f[5] * ALPHA + v1[1]), cvt_pk(f[6] * ALPHA + v1[2], f[7] * ALPHA + v1[3])};
                }
                perm_store(Y + (rg + r8) * 1024 + u.pn * 256 + wc * 64 + hi * 32 + fq * 8, (size_t)8 * 1024, pk[0], pk[1], hi);
                asm volatile("" ::: "memory");
            }
    }
};

constexpr int TS_RS = 272;
__device__ __forceinline__ void tile_put(const Ctx& c, int row_l, int col_l, const u32x2 v) { *(u32x2*)(c.smem + row_l * TS_RS + col_l * 2) = v; }
template <int NCOL>
__device__ __forceinline__ void tile_flush(const Ctx& c, bf16_t* out, size_t ld, bool valid) {
    __syncthreads();
    constexpr int CPR = NCOL / 8, PER = (128 * CPR) / 256;
#pragma unroll
    for (int i = 0; i < PER; ++i) {
        const int idx = c.tid + 256 * i, row = idx / CPR, ch = idx % CPR;
        const u32x4 v = *(const u32x4*)(c.smem + row * TS_RS + ch * 16);
        if (valid) *(u32x4*)(out + (size_t)row * ld + ch * 8) = v;
    }
    __syncthreads();
}

__device__ __forceinline__ void conv_family(const float* src, int nmat, size_t src_stride, int K, int N, int Nout,
                            bf16_t* dst, size_t dst_stride, int grp, int kind, const Ctx& c) {
    float* lds = (float*)c.smem;
    const int tk = K / 128, tn = Nout / 64, per = tk * tn, total = nmat * per;
    const int tx = c.tid & 15, ty = c.tid >> 4;
    f32x4 r[8];
#define CV_LOAD(u_) do { const int mat_ = (u_) / per, r_ = (u_) - mat_ * per, kt_ = r_ / tn, nt_ = r_ - kt_ * tn; \
        const float* s_ = src + (size_t)mat_ * src_stride + (size_t)(kt_ * 128 + ty) * N + nt_ * 64 + tx * 4; const bool in_ = (nt_ * 64 + tx * 4) < N; \
        _Pragma("unroll") for (int i = 0; i < 8; ++i) r[i] = in_ ? *(const f32x4*)(s_ + (size_t)(16 * i) * N) : (f32x4){0.f, 0.f, 0.f, 0.f}; } while (0)
    if (c.bid < total) CV_LOAD(c.bid);
    for (int base = 0; base < total; base += c.nblk) {
        const int u = base + c.bid; const bool valid = u < total;
#pragma unroll
        for (int i = 0; i < 8; ++i) *(f32x4*)(lds + (ty + 16 * i) * 68 + tx * 4) = r[i];
        if (u + c.nblk < total) CV_LOAD(u + c.nblk);
        __syncthreads();
        if (valid) {
        const int mat = u / per, rr = u - mat * per, kt = rr / tn, nt = rr - kt * tn;
        const int dmat = grp ? (mat / grp) * (grp + 1) + (mat % grp) : mat;
        bf16_t* d = dst + (size_t)dmat * dst_stride;
        const int nl = c.tid & 63, kq = (c.tid >> 6) * 32;
        unsigned w[16];
#pragma unroll
        for (int j = 0; j < 16; ++j) w[j] = pk2(lds[(kq + 2 * j) * 68 + nl], lds[(kq + 2 * j + 1) * 68 + nl]);
        const int n = nt * 64 + nl;
        const int drow = (kind == 0) ? n : ((n >> 4) * 32 + (n & 15) + (kind == 2 ? 16 : 0));
        u32x4* dp = (u32x4*)(d + (size_t)drow * K + kt * 128 + kq);
        dp[0] = (u32x4){w[0], w[1], w[2], w[3]}; dp[1] = (u32x4){w[4], w[5], w[6], w[7]};
        dp[2] = (u32x4){w[8], w[9], w[10], w[11]}; dp[3] = (u32x4){w[12], w[13], w[14], w[15]};
        }
        __syncthreads();
    }
#undef CV_LOAD
}

__device__ __forceinline__ void phase_prologue(const Args& a, const Ctx& c) {
    unsigned char* ws = a.ws;
    bf16_t* WIN = (bf16_t*)(ws + WS_WIN);
    conv_family((const float*)a.in[2], 2, (size_t)1024 * 2472, 1024, 2472, NPAD, WIN, 2 * WIN_ELEMS, 0, 0, c);
    conv_family((const float*)a.in[12], 2, (size_t)1024 * 2312, 1024, 2312, NPAD, WIN + WIN_ELEMS, 2 * WIN_ELEMS, 0, 0, c);
    conv_family((const float*)a.in[4], 2, (size_t)256 * 768, 256, 768, 768, (bf16_t*)(ws + WS_WQB), WQB_ELEMS, 0, 0, c);
    conv_family((const float*)a.in[6], 2, (size_t)128 * 1024, 128, 1024, 1024, (bf16_t*)(ws + WS_WKVB), WKVB_ELEMS, 0, 0, c);
    bf16_t* WOUT = (bf16_t*)(ws + WS_WOUT);
    conv_family((const float*)a.in[11], 2, (size_t)1024 * 1024, 1024, 1024, 1024, WOUT, 2 * WOUT_ELEMS, 0, 0, c);
    conv_family((const float*)a.in[17], 2, (size_t)1024 * 1024, 1024, 1024, 1024, WOUT + WOUT_ELEMS, 2 * WOUT_ELEMS, 0, 0, c);
    conv_family((const float*)a.in[20], 4, (size_t)1024 * 64, 1024, 64, 128, (bf16_t*)(ws + WS_WRT), WRT_ELEMS, 0, 0, c);
    bf16_t* WGU = (bf16_t*)(ws + WS_WGU);
    conv_family((const float*)a.in[22], 256, (size_t)1024 * 256, 1024, 256, 256, WGU, WGU_ELEMS, 64, 1, c);
    conv_family((const float*)a.in[23], 256, (size_t)1024 * 256, 1024, 256, 256, WGU, WGU_ELEMS, 64, 2, c);
    conv_family((const float*)a.in[25], 4, (size_t)1024 * 256, 1024, 256, 256, WGU + 64 * WGU_ELEMS, 65 * WGU_ELEMS, 0, 1, c);
    conv_family((const float*)a.in[26], 4, (size_t)1024 * 256, 1024, 256, 256, WGU + 64 * WGU_ELEMS, 65 * WGU_ELEMS, 0, 2, c);
    bf16_t* WDN = (bf16_t*)(ws + WS_WDN);
    conv_family((const float*)a.in[24], 256, (size_t)256 * 1024, 256, 1024, 1024, WDN, WDN_ELEMS, 64, 0, c);
    conv_family((const float*)a.in[27], 4, (size_t)256 * 1024, 256, 1024, 1024, WDN + 64 * WDN_ELEMS, 65 * WDN_ELEMS, 0, 0, c);
    {
        const float* x = (const float*)a.in[0]; bf16_t* xb = (bf16_t*)(ws + WS_XBF);
        const size_t n8 = (size_t)T * 1024 / 8;
        for (size_t i = (size_t)c.bid * 256 + c.tid; i < n8; i += (size_t)c.nblk * 256) {
            const f32x4 v0 = *(const f32x4*)(x + i * 8), v1 = *(const f32x4*)(x + i * 8 + 4);
            *(u32x4*)(xb + i * 8) = (u32x4){pk2(v0[0], v0[1]), pk2(v0[2], v0[3]), pk2(v1[0], v1[1]), pk2(v1[2], v1[3])};
        }
    }
    {
        const int* pos = (const int*)a.in[1];
        float* rm = (float*)(ws + WS_ROPEM); float* rs = (float*)(ws + WS_ROPES);
        const float ln_theta = 9.210340371976184f;
        for (int i = c.bid * 256 + c.tid; i < T * 16; i += c.nblk * 256) {
            const int t = i >> 4, f = i & 15;
            const float inv = expf(-((float)(2 * f) / 32.f) * ln_theta);
            const float ang = (float)pos[t] * inv;
            rm[i * 2] = cosf(ang); rm[i * 2 + 1] = sinf(ang);
        }
        for (int i = c.bid * 256 + c.tid; i < T * 32; i += c.nblk * 256) {
            const int t = i >> 5, f = i & 31;
            const float inv = expf(-((float)(2 * f) / 64.f) * ln_theta);
            const float ang = (float)pos[t] * inv;
            rs[i * 2] = cosf(ang); rs[i * 2 + 1] = sinf(ang);
        }
    }
}

__device__ __forceinline__ void phase_inproj(const bf16_t* XBF, const bf16_t* W, bf16_t* PROJ, float* GATES, int gbase, const Ctx& c) {
    const int ntn = NPAD / 128;
    for (int i = 0;; ++i) {
        int mt, nt; bool valid; if (!tile_map2(i, c, T / 128, ntn, mt, nt, valid)) break;
        const bf16_t* a0 = XBF + (size_t)(mt * 128 + (c.tid >> 2)) * 1024;
        const bf16_t* b0 = W + (size_t)(nt * 128 + (c.tid >> 2)) * 1024;
        f32x4 acc[4][4];
        gemm_tile(a0, a0 + 64 * 1024, b0, b0 + 64 * 1024, 32, acc, c);
#pragma unroll
        for (int m = 0; m < 4; ++m) {
            const int rl = c.wr * 64 + m * 16 + c.fr, row = mt * 128 + rl;
#pragma unroll
            for (int n = 0; n < 4; ++n) {
                const int cl = c.wc * 64 + n * 16 + c.fq * 4, col = nt * 128 + cl;
                const f32x4 v = acc[m][n];
                tile_put(c, rl, cl, (u32x2){pk2(v[0], v[1]), pk2(v[2], v[3])});
                if (valid && col >= gbase && col < gbase + 8) *(f32x4*)(GATES + (size_t)row * 8 + (col - gbase)) = v;
            }
        }
        tile_flush<128>(c, PROJ + (size_t)mt * 128 * NPAD + nt * 128, NPAD, valid);
    }
}

constexpr int MLAUP_TILES = (T / 128) * 6 + (T / 128) * 8;
__device__ __forceinline__ void mla_up_tile(int u, const bf16_t* CQ, const bf16_t* WQB, const bf16_t* CKV, const bf16_t* WKVB,
                             const float* ROPEM, bf16_t* QF, bf16_t* KN, bf16_t* VV, const Ctx& c) {
    const int tq = (T / 128) * 6;
    const float qscale = 0.10206207261596577f * 1.4426950408889634f;
    {
        f32x4 acc[4][4];
        if (u < tq) {
            const int mt = u / 6, nt = u % 6;
            const bf16_t* a0 = CQ + (size_t)(mt * 128 + (c.tid >> 2)) * 256;
            const bf16_t* b0 = WQB + (size_t)(nt * 128 + (c.tid >> 2)) * 256;
            gemm_tile(a0, a0 + 64 * 256, b0, b0 + 64 * 256, 8, acc, c);
#pragma unroll
            for (int m = 0; m < 4; ++m) {
                const int row = mt * 128 + c.wr * 64 + m * 16 + c.fr;
#pragma unroll
                for (int np = 0; np < 2; ++np) {
                    const int cg = nt * 128 + c.wc * 64 + np * 32;
                    f32x4 v0 = acc[m][2 * np], v1 = acc[m][2 * np + 1];
                    if (((cg >> 5) % 3) == 2) {
#pragma unroll
                        for (int j = 0; j < 4; ++j) {
                            const int i = c.fq * 4 + j;
                            const float cs = ROPEM[((size_t)row * 16 + i) * 2], sn = ROPEM[((size_t)row * 16 + i) * 2 + 1];
                            const float x1 = v0[j], x2 = v1[j];
                            v0[j] = x1 * cs - x2 * sn; v1[j] = x2 * cs + x1 * sn;
                        }
                    }
                    v0 *= qscale; v1 *= qscale;
                    *(u32x2*)(QF + (size_t)row * 768 + cg + c.fq * 4) = (u32x2){pk2(v0[0], v0[1]), pk2(v0[2], v0[3])};
                    *(u32x2*)(QF + (size_t)row * 768 + cg + 16 + c.fq * 4) = (u32x2){pk2(v1[0], v1[1]), pk2(v1[2], v1[3])};
                }
            }
        } else {
            const int v = u - tq, mt = v / 8, nt = v % 8;
            const bf16_t* a0 = CKV + (size_t)(mt * 128 + (c.tid >> 2)) * 128;
            const bf16_t* b0 = WKVB + (size_t)(nt * 128 + (c.tid >> 2)) * 128;
            gemm_tile(a0, a0 + 64 * 128, b0, b0 + 64 * 128, 4, acc, c);
            bf16_t* dst = (c.wc == 0) ? KN : VV;
#pragma unroll
            for (int m = 0; m < 4; ++m) {
                const int row = mt * 128 + c.wr * 64 + m * 16 + c.fr;
#pragma unroll
                for (int n = 0; n < 4; ++n) {
                    const f32x4 x = acc[m][n];
                    *(u32x2*)(dst + (size_t)row * 512 + nt * 64 + n * 16 + c.fq * 4) = (u32x2){pk2(x[0], x[1]), pk2(x[2], x[3])};
                }
            }
        }
    }
}

__device__ __forceinline__ void phase_outproj(const bf16_t* MIXO, const bf16_t* W, const float* xres, float* YBUF, const Ctx& c) {
    for (int i = 0;; ++i) {
        int mt, nt; bool valid; if (!tile_map2(i, c, T / 128, 8, mt, nt, valid)) break;
        const bf16_t* a0 = MIXO + (size_t)(mt * 128 + (c.tid >> 2)) * 1024;
        const bf16_t* b0 = W + (size_t)(nt * 128 + (c.tid >> 2)) * 1024;
        f32x4 acc[4][4];
        gemm_tile(a0, a0 + 64 * 1024, b0, b0 + 64 * 1024, 32, acc, c);
#pragma unroll
        for (int m = 0; m < 4; ++m) {
            const int row = mt * 128 + c.wr * 64 + m * 16 + c.fr;
#pragma unroll
            for (int n = 0; n < 4; ++n) {
                const int col = nt * 128 + c.wc * 64 + n * 16 + c.fq * 4;
                const f32x4 xr = *(const f32x4*)(xres + (size_t)row * 1024 + col);
                if (valid) *(f32x4*)(YBUF + (size_t)row * 1024 + col) = xr * ALPHA + acc[m][n];
            }
        }
    }
}

__device__ __forceinline__ void phase_router(const bf16_t* XBF, const bf16_t* W, float* LOG, const Ctx& c) {
    for (int base = 0; base < T / 128; base += c.nblk) {
        const bool valid = (base + c.bid) < T / 128; const int mt = valid ? base + c.bid : 0;
        const bf16_t* a0 = XBF + (size_t)(mt * 128 + (c.tid >> 2)) * 1024;
        const bf16_t* b0 = W + (size_t)(c.tid >> 2) * 1024;
        f32x4 acc[4][4];
        gemm_tile(a0, a0 + 64 * 1024, b0, b0 + 64 * 1024, 32, acc, c);
        if (c.wc == 0 && valid) {
#pragma unroll
            for (int m = 0; m < 4; ++m) {
                const int row = mt * 128 + c.wr * 64 + m * 16 + c.fr;
#pragma unroll
                for (int n = 0; n < 4; ++n) *(f32x4*)(LOG + (size_t)row * 64 + n * 16 + c.fq * 4) = acc[m][n];
            }
        }
    }
}

__device__ __forceinline__ void build_block_table(const unsigned* CNT, int* bst, const Ctx& c) {
    __syncthreads();
    if (c.wid == 0) {
        const int cnt = (int)__hip_atomic_load(CNT + c.lane, __ATOMIC_RELAXED, __HIP_MEMORY_SCOPE_AGENT);
        const int nb = (cnt + RBR - 1) / RBR;
        int inc = nb;
#pragma unroll
        for (int o = 1; o < 64; o <<= 1) { const int x = __shfl_up(inc, o); if (c.lane >= o) inc += x; }
        bst[c.lane] = inc - nb; bst[66 + c.lane] = cnt;
        if (c.lane == 63) { bst[64] = inc; bst[65] = inc + T / RBR; bst[66 + 64] = T; }
    }
    __syncthreads();
}
__device__ __forceinline__ int find_expert(const int* bst, int rb, const Ctx& c) {
    return __popcll(__ballot(bst[1 + c.lane] <= rb));
}

__device__ __forceinline__ void phase_moe1(const bf16_t* XBF, const bf16_t* WGU, const unsigned* CNT, const int* LTOK, const float* LW, bf16_t* HBUF, const Ctx& c) {
    int* bst = (int*)(c.smem + 65536 + 64);
    build_block_table(CNT, bst, c);
    const int nsb = bst[65] * 2;
    for (int i = 0;; ++i) {
        int sbk, nt; bool valid; if (!tile_map2(i, c, nsb, 4, sbk, nt, valid)) break;
        const int rb = sbk >> 1, hb = sbk & 1;
        const int e = find_expert(bst, rb, c);
        const int lb = rb - bst[e], cnt = bst[66 + e];
        const int p0 = lb * RBR + hb * 128 + (c.tid >> 2), p1 = p0 + 64;
        const int t0 = (p0 < cnt) ? LTOK[(size_t)e * CAP + p0] : 0;
        const int t1 = (p1 < cnt) ? LTOK[(size_t)e * CAP + p1] : 0;
        const bf16_t* a0 = XBF + (size_t)t0 * 1024;
        const bf16_t* a1 = XBF + (size_t)t1 * 1024;
        const bf16_t* b0 = WGU + (size_t)e * WGU_ELEMS + (size_t)(nt * 128 + (c.tid >> 2)) * 1024;
        f32x4 acc[4][4];
        gemm_tile(a0, a1, b0, b0 + 64 * 1024, 32, acc, c);
#pragma unroll
        for (int m = 0; m < 4; ++m) {
            const int rl = c.wr * 64 + m * 16 + c.fr;
            const int pw = lb * RBR + hb * 128 + rl;
            const float wrow = (pw < cnt) ? LW[(size_t)e * CAP + pw] : 0.f;
#pragma unroll
            for (int n = 0; n < 2; ++n) {
                const f32x4 g = acc[m][n], up = acc[m][n + 2];
                float h[4];
#pragma unroll
                for (int j = 0; j < 4; ++j) h[j] = siluf_(g[j]) * up[j] * wrow;
                tile_put(c, rl, c.wc * 32 + n * 16 + c.fq * 4, (u32x2){pk2(h[0], h[1]), pk2(h[2], h[3])});
            }
        }
        tile_flush<64>(c, HBUF + ((size_t)rb * RBR + hb * 128) * 256 + nt * 64, 256, valid);
    }
}

__device__ __forceinline__ void phase_moe2(const bf16_t* HBUF, const bf16_t* WDN, const unsigned* CNT, bf16_t* Y, const Ctx& c) {
    int* bst = (int*)(c.smem + 65536 + 64);
    build_block_table(CNT, bst, c);
    const int nsb = bst[65] * 2;
    for (int i = 0;; ++i) {
        int sbk, nt; bool valid; if (!tile_map2(i, c, nsb, 8, sbk, nt, valid)) break;
        const int rb = sbk >> 1;
        const int e = find_expert(bst, rb, c);
        const bf16_t* a0 = HBUF + ((size_t)sbk * 128 + (c.tid >> 2)) * 256;
        const bf16_t* b0 = WDN + (size_t)e * WDN_ELEMS + (size_t)(nt * 128 + (c.tid >> 2)) * 256;
        f32x4 acc[4][4];
        gemm_tile(a0, a0 + 64 * 256, b0, b0 + 64 * 256, 8, acc, c);
#pragma unroll
        for (int m = 0; m < 4; ++m) {
            const int lr = c.wr * 64 + m * 16 + c.fr;
#pragma unroll
            for (int n = 0; n < 4; ++n) {
                const f32x4 v = acc[m][n];
                tile_put(c, lr, c.wc * 64 + n * 16 + c.fq * 4, (u32x2){pk2(v[0], v[1]), pk2(v[2], v[3])});
            }
        }
        tile_flush<128>(c, Y + (size_t)sbk * 128 * 1024 + nt * 128, 1024, valid);
    }
}

__device__ __forceinline__ float dppf(float v, int ctrl_sel) {
    int x = __builtin_bit_cast(int, v), r;
    if (ctrl_sel == 0) r = __builtin_amdgcn_update_dpp(0, x, 0xB1, 0xF, 0xF, true);
    else if (ctrl_sel == 1) r = __builtin_amdgcn_update_dpp(0, x, 0x4E, 0xF, 0xF, true);
    else if (ctrl_sel == 2) r = __builtin_amdgcn_update_dpp(0, x, 0x141, 0xF, 0xF, true);
    else r = __builtin_amdgcn_update_dpp(0, x, 0x140, 0xF, 0xF, true);
    return __builtin_bit_cast(float, r);
}
__device__ __forceinline__ float red16(float v) { v += dppf(v, 0); v += dppf(v, 1); v += dppf(v, 2); v += dppf(v, 3); return v; }

template <bool F32OUT>
__device__ __forceinline__ void ln_row_store(float (&v)[16], const float* g, const float* b, float* of32, bf16_t* obf, int lane) {
    float s = 0.f;
#pragma unroll
    for (int i = 0; i < 16; ++i) s += v[i];
    const float mean = wave_sum(s) * (1.f / 1024.f);
    float q = 0.f;
#pragma unroll
    for (int i = 0; i < 16; ++i) { v[i] -= mean; q += v[i] * v[i]; }
    const float rstd = rsqrtf(wave_sum(q) * (1.f / 1024.f) + 1e-5f);
#pragma unroll
    for (int hf = 0; hf < 2; ++hf) {
        const int col = hf * 512 + lane * 8;
        const f32x4 g0 = *(const f32x4*)(g + col), g1 = *(const f32x4*)(g + col + 4);
        const f32x4 b0 = *(const f32x4*)(b + col), b1 = *(const f32x4*)(b + col + 4);
        f32x4 y0, y1;
#pragma unroll
        for (int j = 0; j < 4; ++j) { y0[j] = v[hf * 8 + j] * rstd * g0[j] + b0[j]; y1[j] = v[hf * 8 + 4 + j] * rstd * g1[j] + b1[j]; }
        if constexpr (F32OUT) { *(f32x4*)(of32 + col) = y0; *(f32x4*)(of32 + col + 4) = y1; }
        *(u32x4*)(obf + col) = (u32x4){pk2(y0[0], y0[1]), pk2(y0[2], y0[3]), pk2(y1[0], y1[1]), pk2(y1[2], y1[3])};
    }
}

__device__ __forceinline__ void phase_ln1(const bf16_t* YBUF, const float* g, const float* b, bf16_t* XBF, const Ctx& c) {
    for (int t = c.bid * 4 + c.wid; t < T; t += c.nblk * 4) {
        float v[16];
#pragma unroll
        for (int hf = 0; hf < 2; ++hf) {
            const u32x4 r = *(const u32x4*)(YBUF + (size_t)t * 1024 + hf * 512 + c.lane * 8);
            float f[8]; unpack8(r, f);
#pragma unroll
            for (int j = 0; j < 8; ++j) v[hf * 8 + j] = f[j];
        }
        ln_row_store<false>(v, g, b, nullptr, XBF + (size_t)t * 1024, c.lane);
    }
}

template <bool LASTL>
__device__ __forceinline__ void phase_combine(const bf16_t* Y, const int* ASG, const float* ASGW, const unsigned* CNT, const float* g, const float* b,
                              float* XOUT, bf16_t* XBF, const Ctx& c) {
    int* bst = (int*)(c.smem + 65536 + 64);
    build_block_table(CNT, bst, c);
    for (int t = c.bid * 4 + c.wid; t < T; t += c.nblk * 4) {
        float v[16];
#pragma unroll
        for (int hf = 0; hf < 2; ++hf) {
            const u32x4 r = *(const u32x4*)(XBF + (size_t)t * 1024 + hf * 512 + c.lane * 8);
            float f[8]; unpack8(r, f);
#pragma unroll
            for (int j = 0; j < 8; ++j) v[hf * 8 + j] = f[j] * ALPHA;
        }
#pragma unroll
        for (int k = 0; k < 9; ++k) {
            size_t crow; float wk = 1.f;
            if (k < 8) { const int asg = ASG[(size_t)t * 8 + k]; crow = (size_t)bst[asg >> 16] * RBR + (asg & 0xffff); wk = ASGW[(size_t)t * 8 + k]; }
            else crow = (size_t)bst[64] * RBR + t;
#pragma unroll
            for (int hf = 0; hf < 2; ++hf) {
                const u32x4 r = *(const u32x4*)(Y + crow * 1024 + hf * 512 + c.lane * 8);
                float f[8]; unpack8(r, f);
#pragma unroll
                for (int j = 0; j < 8; ++j) v[hf * 8 + j] += f[j] * wk;
            }
        }
        ln_row_store<LASTL>(v, g, b, XOUT + (size_t)t * 1024, XBF + (size_t)t * 1024, c.lane);
    }
}

__device__ __forceinline__ void phase_route(const float* LOG, const float* rb, unsigned* CNT, int* LTOK, float* LW, int* ASG, float* ASGW, const Ctx& c) {
    int* lcnt = (int*)c.smem;
    int* lbase = lcnt + 64;
    int* sel_e = lbase + 64;
    int* sel_p = sel_e + 256;
    float* sel_w = (float*)(sel_p + 256);
    const float rbias = rb[c.lane];
    for (int base = 0; base < T / 32; base += c.nblk) {
        const int ch = base + c.bid; const bool valid = ch < T / 32;
        __syncthreads();
        if (c.tid < 64) lcnt[c.tid] = 0;
        __syncthreads();
        if (valid) for (int tl = c.wid; tl < 32; tl += 4) {
            const int t = ch * 32 + tl;
            const float lg = LOG[(size_t)t * 64 + c.lane];
            const float sc = 1.f / (1.f + expf(-lg));
            const float v = sc + rbias;
            float m1 = v;
            m1 = fmaxf(m1, __shfl_xor(m1, 1)); m1 = fmaxf(m1, __shfl_xor(m1, 2)); m1 = fmaxf(m1, __shfl_xor(m1, 4));
            int cand = (v == m1) ? c.lane : 999;
            cand = min(cand, __shfl_xor(cand, 1)); cand = min(cand, __shfl_xor(cand, 2)); cand = min(cand, __shfl_xor(cand, 4));
            float m2 = (c.lane == cand) ? -INFINITY : v;
            m2 = fmaxf(m2, __shfl_xor(m2, 1)); m2 = fmaxf(m2, __shfl_xor(m2, 2)); m2 = fmaxf(m2, __shfl_xor(m2, 4));
            const float gs = m1 + m2;
            const int g = c.lane >> 3;
            int grank = 0;
#pragma unroll
            for (int gg = 0; gg < 8; ++gg) { const float o = __shfl(gs, gg * 8); grank += ((o > gs) || (o == gs && gg < g)) ? 1 : 0; }
            const bool gsel = grank < 4;
            const float mv = gsel ? v : -INFINITY;
            int rank = 0;
#pragma unroll 8
            for (int jj = 0; jj < 64; ++jj) { const float o = __shfl(mv, jj); rank += ((o > mv) || (o == mv && jj < c.lane)) ? 1 : 0; }
            const bool sel = gsel && rank < 8;
            const float ssum = wave_sum(sel ? sc : 0.f);
            const float w = sc / ssum * 2.5f;
            const unsigned long long bal = __ballot(sel);
            const int slot = __popcll(bal & ((1ull << c.lane) - 1ull));
            if (sel) {
                const int p = atomicAdd(&lcnt[c.lane], 1);
                sel_e[tl * 8 + slot] = c.lane; sel_p[tl * 8 + slot] = p; sel_w[tl * 8 + slot] = w;
            }
        }
        __syncthreads();
        if (valid && c.tid < 64) { const int n = lcnt[c.tid]; lbase[c.tid] = n ? (int)atomicAdd(CNT + c.tid, (unsigned)n) : 0; }
        __syncthreads();
        if (valid) {
            const int tl = c.tid >> 3, t = ch * 32 + tl;
            const int e = sel_e[c.tid], pos = lbase[e] + sel_p[c.tid];
            LTOK[(size_t)e * CAP + pos] = t; LW[(size_t)e * CAP + pos] = sel_w[c.tid];
            ASG[(size_t)t * 8 + (c.tid & 7)] = (e << 16) | pos; ASGW[(size_t)t * 8 + (c.tid & 7)] = sel_w[c.tid];
            if (c.tid < 32) { const int ts = ch * 32 + c.tid; LTOK[(size_t)64 * CAP + ts] = ts; LW[(size_t)64 * CAP + ts] = 1.f; }
        }
    }
}

__device__ __forceinline__ void phase_prep_even(const bf16_t* PROJ, const float* GATES, const float* qn, const float* kvn, const float* cw,
                                const float* a_log, const float* dt_bias, const float* ROPEM,
                                bf16_t* CQ, bf16_t* CKV, bf16_t* KROPE, bf16_t* GQ, bf16_t* GK, bf16_t* GV, float* BETA, float* GLOG, const Ctx& c) {
    const int lane = c.lane;
    float* cwL = (float*)c.smem;
    __syncthreads();
    for (int i = c.tid; i < 4 * 1536 / 4; i += 256) *(f32x4*)(cwL + i * 4) = *(const f32x4*)(cw + i * 4);
    __syncthreads();
    for (int t = c.bid * 4 + c.wid; t < T; t += c.nblk * 4) {
        const bf16_t* pr = PROJ + (size_t)t * NPAD;
        {
            const u32x2 r = *(const u32x2*)(pr + lane * 4);
            float v[4] = {bflo(r.x), bfhi(r.x), bflo(r.y), bfhi(r.y)};
            const float ss = wave_sum(v[0] * v[0] + v[1] * v[1] + v[2] * v[2] + v[3] * v[3]);
            const float rr = rsqrtf(ss * (1.f / 256.f) + 1e-6f);
            const f32x4 gq = *(const f32x4*)(qn + lane * 4);
            *(u32x2*)(CQ + (size_t)t * 256 + lane * 4) = (u32x2){pk2(v[0] * rr * gq[0], v[1] * rr * gq[1]), pk2(v[2] * rr * gq[2], v[3] * rr * gq[3])};
        }
        {
            const unsigned r = *(const unsigned*)(pr + 256 + lane * 2);
            const float v0 = bflo(r), v1 = bfhi(r);
            const float ss = wave_sum(v0 * v0 + v1 * v1);
            const float rr = rsqrtf(ss * (1.f / 128.f) + 1e-6f);
            *(unsigned*)(CKV + (size_t)t * 128 + lane * 2) = pk2(v0 * rr * kvn[lane * 2], v1 * rr * kvn[lane * 2 + 1]);
        }
        if (lane < 16) {
            const float x1 = bf2f(pr[384 + lane]), x2 = bf2f(pr[400 + lane]);
            const float cs = ROPEM[((size_t)t * 16 + lane) * 2], sn = ROPEM[((size_t)t * 16 + lane) * 2 + 1];
            KROPE[(size_t)t * 32 + lane] = (bf16_t)f2bf(x1 * cs - x2 * sn);
            KROPE[(size_t)t * 32 + 16 + lane] = (bf16_t)f2bf(x2 * cs + x1 * sn);
        }
        const int s = t & (SEQ - 1);
        u32x4 xr[3][4];
#pragma unroll
        for (int arr = 0; arr < 3; ++arr)
#pragma unroll
            for (int w = 0; w < 4; ++w)
                xr[arr][w] = (s - 3 + w >= 0) ? *(const u32x4*)(PROJ + (size_t)(t - 3 + w) * NPAD + 416 + arr * 512 + lane * 8) : (u32x4){0u, 0u, 0u, 0u};
#pragma unroll
        for (int arr = 0; arr < 3; ++arr) {
            float y[8];
#pragma unroll
            for (int j = 0; j < 8; ++j) y[j] = 0.f;
#pragma unroll
            for (int w = 0; w < 4; ++w) {
                float f[8]; unpack8(xr[arr][w], f);
                const f32x4 c0 = *(const f32x4*)(cwL + w * 1536 + arr * 512 + lane * 8), c1 = *(const f32x4*)(cwL + w * 1536 + arr * 512 + lane * 8 + 4);
#pragma unroll
                for (int j = 0; j < 4; ++j) { y[j] += c0[j] * f[j]; y[4 + j] += c1[j] * f[4 + j]; }
            }
            float ss = 0.f;
#pragma unroll
            for (int j = 0; j < 8; ++j) { y[j] = siluf_(y[j]); ss += y[j] * y[j]; }
            if (arr < 2) {
                float rr = rsqrtf(red16(ss) + 1e-6f);
                if (arr == 0) rr *= 0.08838834764831845f;
#pragma unroll
                for (int j = 0; j < 8; ++j) y[j] *= rr;
            }
            bf16_t* dst = (arr == 0) ? GQ : (arr == 1) ? GK : GV;
            *(u32x4*)(dst + (size_t)t * 512 + lane * 8) = (u32x4){pk2(y[0], y[1]), pk2(y[2], y[3]), pk2(y[4], y[5]), pk2(y[6], y[7])};
        }
        if (lane < 4) BETA[(size_t)t * 4 + lane] = sigmoidf_(GATES[(size_t)t * 8 + lane]);
        else if (lane < 8) { const int h = lane - 4; GLOG[(size_t)t * 4 + h] = -expf(a_log[h]) * softplusf_(GATES[(size_t)t * 8 + lane] + dt_bias[h]); }
    }
}

__device__ __forceinline__ void phase_prep_odd(const bf16_t* PROJ, const float* ROPES, bf16_t* SQ, bf16_t* SK, const Ctx& c) {
    const int lane = c.lane;
    for (int t = c.bid * 4 + c.wid; t < T; t += c.nblk * 4) {
        const bf16_t* pr = PROJ + (size_t)t * NPAD;
        const int i = lane & 31;
        const float cs = ROPES[((size_t)t * 32 + i) * 2], sn = ROPES[((size_t)t * 32 + i) * 2 + 1];
#pragma unroll
        for (int r = 0; r < 4; ++r) {
            const int h = (lane >> 5) + 2 * r;
            const float x1 = bf2f(pr[1544 + h * 64 + i]), x2 = bf2f(pr[1544 + h * 64 + 32 + i]);
            SQ[(size_t)t * 512 + h * 64 + i] = (bf16_t)f2bf((x1 * cs - x2 * sn) * 0.18033688011112042f);
            SQ[(size_t)t * 512 + h * 64 + 32 + i] = (bf16_t)f2bf((x2 * cs + x1 * sn) * 0.18033688011112042f);
        }
        {
            const int h = lane >> 5;
            const float x1 = bf2f(pr[2056 + h * 64 + i]), x2 = bf2f(pr[2056 + h * 64 + 32 + i]);
            SK[(size_t)t * 128 + h * 64 + i] = (bf16_t)f2bf(x1 * cs - x2 * sn);
            SK[(size_t)t * 128 + h * 64 + 32 + i] = (bf16_t)f2bf(x2 * cs + x1 * sn);
        }
    }
}

__device__ __forceinline__ int next_unit(unsigned* ctr, const Ctx& c) {
    volatile int* su = (volatile int*)(c.smem0 + LDS_BLK + 16);
    __syncthreads();
    if (c.tid0 == 0) *su = (int)atomicAdd(ctr, 1u);
    __syncthreads();
    return *su * 2 + c.half;
}

typedef float f32x16 __attribute__((ext_vector_type(16)));
typedef short s16x4 __attribute__((ext_vector_type(4)));
#define MFMA32(a, b, c) __builtin_amdgcn_mfma_f32_32x32x16_bf16((a), (b), (c), 0, 0, 0)
template <int S_> __device__ __forceinline__ bf16x8 pack_step(const f32x16& x) {
    u32x4 p;
    asm volatile("v_cvt_pk_bf16_f32 %0, %4, %5\n\tv_cvt_pk_bf16_f32 %1, %6, %7\n\tv_cvt_pk_bf16_f32 %2, %8, %9\n\tv_cvt_pk_bf16_f32 %3, %10, %11\n\ts_nop 1"
                 : "=&v"(p[0]), "=&v"(p[1]), "=&v"(p[2]), "=&v"(p[3])
                 : "v"(x[8 * S_]), "v"(x[8 * S_ + 1]), "v"(x[8 * S_ + 2]), "v"(x[8 * S_ + 3]), "v"(x[8 * S_ + 4]), "v"(x[8 * S_ + 5]), "v"(x[8 * S_ + 6]), "v"(x[8 * S_ + 7]));
    return __builtin_bit_cast(bf16x8, p);
}
template <int S_> __device__ __forceinline__ bf16x8 pack_step_m(const f32x16& x) {
    u32x4 p;
    asm volatile("s_nop 15\n\tv_cvt_pk_bf16_f32 %0, %4, %5\n\tv_cvt_pk_bf16_f32 %1, %6, %7\n\tv_cvt_pk_bf16_f32 %2, %8, %9\n\tv_cvt_pk_bf16_f32 %3, %10, %11\n\ts_nop 1"
                 : "=&v"(p[0]), "=&v"(p[1]), "=&v"(p[2]), "=&v"(p[3])
                 : "v"(x[8 * S_]), "v"(x[8 * S_ + 1]), "v"(x[8 * S_ + 2]), "v"(x[8 * S_ + 3]), "v"(x[8 * S_ + 4]), "v"(x[8 * S_ + 5]), "v"(x[8 * S_ + 6]), "v"(x[8 * S_ + 7]));
    return __builtin_bit_cast(bf16x8, p);
}
constexpr int ATT_VB = 64 * 128;

template <int NKS, bool WIN>
__device__ __forceinline__ void attn_unit(const bf16_t* Qp, int q_ld, const bf16_t* K1, int k1_ld, const bf16_t* K2, int k2_ld, const bf16_t* Vp, int v_ld,
                          bf16_t* Op, int o_ld, int Q0, float sink_l2, const Ctx& c) {
    constexpr int KB = NKS * 2 * 1024, BUF = KB + ATT_VB;
    const int lane = c.lane, r = lane & 31, h = lane >> 5;
    const int wid = __builtin_amdgcn_readfirstlane(c.wid);
    const int q0w = Q0 + wid * 32;
    unsigned char* smem = c.smem;
    bf16x8 qf[NKS];
#pragma unroll
    for (int ks = 0; ks < NKS; ++ks) qf[ks] = *(const bf16x8*)(Qp + (size_t)(q0w + r) * q_ld + ks * 16 + h * 8);
    f32x16 o0, o1;
#pragma unroll
    for (int i = 0; i < 16; ++i) { o0[i] = 0.f; o1[i] = 0.f; }
    float m = WIN ? sink_l2 : -1e30f, l = (WIN && h == 0) ? 1.f : 0.f;
    const int kt_lo = WIN ? ((Q0 >> 6) - 2 < 0 ? 0 : (Q0 >> 6) - 2) : 0, kt_hi = (Q0 >> 6) + 1;
#define ATT_STAGE(kt_, buf_) do { unsigned char* bp = smem + (buf_) * BUF; const size_t kb = (size_t)(kt_) * 64; \
        _Pragma("unroll") for (int i = 0; i < (NKS * 2) / 4; ++i) { const int ch = wid + 4 * i; \
            const bf16_t* sp = (ch < 8) ? (K1 + (kb + lane) * k1_ld + ch * 8) : (K2 + (kb + lane) * k2_ld + (ch - 8) * 8); \
            glds16(sp, bp + ch * 1024 + lane * 16); } \
        _Pragma("unroll") for (int i = 0; i < 2; ++i) { const int j = wid + 4 * i; \
            glds16(Vp + (kb + 8 * j + (lane >> 3)) * v_ld + (lane & 7) * 8, bp + KB + j * 1024 + lane * 16); } } while (0)
    ATT_STAGE(kt_lo, 0);
    const int i16 = lane & 15;
    const unsigned vlane = (unsigned)((4 * h + (i16 >> 2)) * 128 + 32 * ((lane >> 4) & 1) + 8 * (i16 & 3));
    for (int kt = kt_lo; kt <= kt_hi; ++kt) {
        const int cur = (kt - kt_lo) & 1;
        asm volatile("s_waitcnt vmcnt(0)" ::: "memory");
        __syncthreads();
        if (kt < kt_hi) ATT_STAGE(kt + 1, cur ^ 1);
        const int k0 = kt * 64;
        const bool active = (k0 <= q0w + 31) && (!WIN || (k0 + 63 > q0w - 128));
        if (active) {
            const unsigned char* Kt = smem + cur * BUF;
            f32x16 x0, x1;
#pragma unroll
            for (int i = 0; i < 16; ++i) { x0[i] = 0.f; x1[i] = 0.f; }
#pragma unroll
            for (int ks = 0; ks < NKS; ++ks) {
                const bf16x8 kf0 = *(const bf16x8*)(Kt + (ks * 2 + h) * 1024 + r * 16);
                const bf16x8 kf1 = *(const bf16x8*)(Kt + (ks * 2 + h) * 1024 + (32 + r) * 16);
                x0 = MFMA32(kf0, qf[ks], x0); x1 = MFMA32(kf1, qf[ks], x1);
            }
            const bool need_mask = (k0 + 63 > q0w) || (WIN && (k0 <= q0w + 31 - 128));
            if (need_mask) {
                const int q = q0w + r;
#pragma unroll
                for (int i = 0; i < 16; ++i) {
                    const int key = k0 + (i & 3) + 8 * (i >> 2) + 4 * h;
                    const bool v0 = (key <= q) && (!WIN || key > q - 128);
                    const bool v1 = (key + 32 <= q) && (!WIN || key + 32 > q - 128);
                    x0[i] = v0 ? x0[i] : -INFINITY; x1[i] = v1 ? x1[i] : -INFINITY;
                }
            }
            float mx = fmaxf(x0[0], x1[0]);
#pragma unroll
            for (int i = 1; i < 16; ++i) mx = fmaxf(mx, fmaxf(x0[i], x1[i]));
            mx = fmaxf(mx, __shfl_xor(mx, 32));
            const float mn = fmaxf(m, mx);
            const float alpha = __builtin_amdgcn_exp2f(m - mn);
            m = mn;
            float ps = 0.f;
#pragma unroll
            for (int i = 0; i < 16; ++i) { x0[i] = __builtin_amdgcn_exp2f(x0[i] - mn); x1[i] = __builtin_amdgcn_exp2f(x1[i] - mn); ps += x0[i] + x1[i]; }
            l = l * alpha + ps;
            o0 *= alpha; o1 *= alpha;
            const unsigned vbase = (unsigned)(size_t)(smem + cur * BUF + KB) + vlane;
#pragma unroll
            for (int t = 0; t < 2; ++t) {
                s16x4 l00, h00, l01, h01, l10, h10, l11, h11;
                const unsigned va = vbase + t * 4096;
                asm volatile("ds_read_b64_tr_b16 %0, %8\n\t"
                             "ds_read_b64_tr_b16 %1, %8 offset:1024\n\t"
                             "ds_read_b64_tr_b16 %2, %8 offset:64\n\t"
                             "ds_read_b64_tr_b16 %3, %8 offset:1088\n\t"
                             "ds_read_b64_tr_b16 %4, %8 offset:2048\n\t"
                             "ds_read_b64_tr_b16 %5, %8 offset:3072\n\t"
                             "ds_read_b64_tr_b16 %6, %8 offset:2112\n\t"
                             "ds_read_b64_tr_b16 %7, %8 offset:3136\n\t"
                             "s_waitcnt lgkmcnt(0)"
                             : "=&v"(l00), "=&v"(h00), "=&v"(l01), "=&v"(h01), "=&v"(l10), "=&v"(h10), "=&v"(l11), "=&v"(h11) : "v"(va) : "memory");
                const bf16x8 v00 = __builtin_shufflevector(l00, h00, 0, 1, 2, 3, 4, 5, 6, 7), v01 = __builtin_shufflevector(l01, h01, 0, 1, 2, 3, 4, 5, 6, 7);
                const bf16x8 v10 = __builtin_shufflevector(l10, h10, 0, 1, 2, 3, 4, 5, 6, 7), v11 = __builtin_shufflevector(l11, h11, 0, 1, 2, 3, 4, 5, 6, 7);
                const bf16x8 pb0 = (t == 0) ? pack_step<0>(x0) : pack_step<0>(x1);
                const bf16x8 pb1 = (t == 0) ? pack_step<1>(x0) : pack_step<1>(x1);
                o0 = MFMA32(v00, pb0, o0); o1 = MFMA32(v01, pb0, o1);
                o0 = MFMA32(v10, pb1, o0); o1 = MFMA32(v11, pb1, o1);
            }
        }
    }
#undef ATT_STAGE
    l += __shfl_xor(l, 32);
    const float inv = 1.f / l;
    bf16_t* orow = Op + (size_t)(q0w + r) * o_ld + 4 * h;
#pragma unroll
    for (int g = 0; g < 4; ++g) {
        *(u32x2*)(orow + 8 * g) = (u32x2){pk2(o0[4 * g] * inv, o0[4 * g + 1] * inv), pk2(o0[4 * g + 2] * inv, o0[4 * g + 3] * inv)};
        *(u32x2*)(orow + 32 + 8 * g) = (u32x2){pk2(o1[4 * g] * inv, o1[4 * g + 1] * inv), pk2(o1[4 * g + 2] * inv, o1[4 * g + 3] * inv)};
    }
}

constexpr size_t MLC_DC = 0, MLC_CS = 33554432, MLC_DN = MLC_CS + 16777216, MLC_NS = MLC_DN + 262144, MLC_ML = MLC_NS + 262144, MLC_BE = MLC_ML + 4096, MLC_MS = MLC_BE + 4096;

__device__ __forceinline__ float scan_add64(float v, int lane) {
#pragma unroll
    for (int o = 1; o < 64; o <<= 1) { const float x = __shfl_up(v, o); if (lane >= o) v += x; }
    return v;
}
__device__ __forceinline__ float scan_max64(float v, int lane) {
#pragma unroll
    for (int o = 1; o < 64; o <<= 1) { const float x = __shfl_up(v, o); if (lane >= o) v = fmaxf(v, x); }
    return v;
}
__device__ __forceinline__ float wave_max(float v) {
#pragma unroll
    for (int o = 32; o > 0; o >>= 1) v = fmaxf(v, __shfl_xor(v, o));
    return v;
}

__device__ __forceinline__ void mlc_passA(int u, const bf16_t* PROJ, const float* GATES, const float* b_i, const float* b_f, unsigned char* YB, const Ctx& c) {
    const int bh = u >> 5, b = bh >> 2, h = bh & 3;
    const size_t t0 = (size_t)b * SEQ + (u & 31) * 64;
    unsigned char* smem = c.smem;
    float* saL = (float*)(smem + 24576);
    const int lane = c.lane, wid = __builtin_amdgcn_readfirstlane(c.wid);
#pragma unroll
    for (int i = 0; i < 4; ++i) { const int j = wid * 4 + i;
        glds16(PROJ + (t0 + 4 * j + (lane >> 4)) * NPAD + 512 + h * 128 + (lane & 15) * 8, smem + 8192 + j * 1024 + lane * 16); }
    if (wid == 0) {
        const float ip = GATES[(t0 + lane) * 8 + h] + b_i[h], lf = -softplusf_(-(GATES[(t0 + lane) * 8 + 4 + h] + b_f[h]));
        const float bc = scan_add64(lf, lane), bend = __shfl(bc, 63);
        const float a = bend - bc + ip, mloc = wave_max(a);
        saL[lane] = expf(a - mloc) * 0.125f;
        if (lane == 0) { ((float*)(YB + MLC_ML))[u] = mloc; ((float*)(YB + MLC_BE))[u] = bend; }
    }
    __syncthreads();
#pragma unroll
    for (int i = 0; i < 2; ++i) {
        const int idx = c.tid + 256 * i, row = idx >> 3, chk = idx & 7;
        const u32x4 r = *(const u32x4*)(PROJ + (t0 + row) * NPAD + 256 + h * 64 + chk * 8);
        float f[8]; unpack8(r, f);
        const float s = saL[row];
        *(u32x4*)(smem + row * 128 + chk * 16) = (u32x4){pk2(f[0] * s, f[1] * s), pk2(f[2] * s, f[3] * s), pk2(f[4] * s, f[5] * s), pk2(f[6] * s, f[7] * s)};
    }
    asm volatile("s_waitcnt vmcnt(0)" ::: "memory");
    __syncthreads();
    const int h5 = lane >> 5, r = lane & 31, i16 = lane & 15, q4 = i16 >> 2, p = i16 & 3, blk = (lane >> 4) & 1;
    const int dkt = wid & 1, dvp = wid >> 1;
    const unsigned kaddr = (unsigned)(size_t)smem + (unsigned)((8 * h5 + q4) * 128 + dkt * 64 + 32 * blk + 8 * p);
    const unsigned vaddr = (unsigned)(size_t)smem + 8192u + (unsigned)((8 * h5 + q4) * 256 + dvp * 128 + 32 * blk + 8 * p);
    f32x16 a0, a1;
#pragma unroll
    for (int i = 0; i < 16; ++i) { a0[i] = 0.f; a1[i] = 0.f; }
#pragma unroll
    for (int st = 0; st < 4; ++st) {
        s16x4 kl, kh, v0l, v0h, v1l, v1h;
        const unsigned ka = kaddr + st * 2048, va = vaddr + st * 4096;
        asm volatile("ds_read_b64_tr_b16 %0, %6\n\t"
                     "ds_read_b64_tr_b16 %1, %6 offset:512\n\t"
                     "ds_read_b64_tr_b16 %2, %7\n\t"
                     "ds_read_b64_tr_b16 %3, %7 offset:1024\n\t"
                     "ds_read_b64_tr_b16 %4, %7 offset:64\n\t"
                     "ds_read_b64_tr_b16 %5, %7 offset:1088\n\t"
                     "s_waitcnt lgkmcnt(0)"
                     : "=&v"(kl), "=&v"(kh), "=&v"(v0l), "=&v"(v0h), "=&v"(v1l), "=&v"(v1h) : "v"(ka), "v"(va) : "memory");
        const bf16x8 kf = __builtin_shufflevector(kl, kh, 0, 1, 2, 3, 4, 5, 6, 7);
        const bf16x8 vf0 = __builtin_shufflevector(v0l, v0h, 0, 1, 2, 3, 4, 5, 6, 7), vf1 = __builtin_shufflevector(v1l, v1h, 0, 1, 2, 3, 4, 5, 6, 7);
        a0 = MFMA32(kf, vf0, a0); a1 = MFMA32(kf, vf1, a1);
    }
    float* DC = (float*)(YB + MLC_DC) + (size_t)u * 8192;
#pragma unroll
    for (int i = 0; i < 16; ++i) {
        const int dk = dkt * 32 + (i & 3) + 8 * (i >> 2) + 4 * h5;
        DC[dk * 128 + dvp * 64 + r] = a0[i]; DC[dk * 128 + dvp * 64 + 32 + r] = a1[i];
    }
    if (c.tid < 64) {
        float s = 0.f;
#pragma unroll 8
        for (int t = 0; t < 64; ++t) s += bf2f(((const bf16_t*)smem)[t * 64 + c.tid]);
        ((float*)(YB + MLC_DN))[(size_t)u * 64 + c.tid] = s;
    }
}

__device__ __forceinline__ void mlc_passB(int u, unsigned char* YB, const Ctx& c) {
    const int bh = u >> 3, sl = u & 7;
    const float* ML = (const float*)(YB + MLC_ML) + bh * 32; const float* BE = (const float*)(YB + MLC_BE) + bh * 32;
    const float* DC = (const float*)(YB + MLC_DC) + (size_t)bh * 32 * 8192 + sl * 1024 + c.tid * 4;
    bf16_t* CS = (bf16_t*)(YB + MLC_CS) + (size_t)bh * 32 * 8192 + sl * 1024 + c.tid * 4;
    const float* DN = (const float*)(YB + MLC_DN) + (size_t)bh * 32 * 64; float* NS = (float*)(YB + MLC_NS) + (size_t)bh * 32 * 64; float* MS = (float*)(YB + MLC_MS) + bh * 32;
    f32x4 C4 = (f32x4){0.f, 0.f, 0.f, 0.f}; float nv = 0.f, m = 0.f;
    const bool do_n = (sl == 0) && (c.tid < 64);
#pragma unroll 4
    for (int n = 0; n < 32; ++n) {
        *(u32x2*)(CS + (size_t)n * 8192) = (u32x2){pk2(C4[0], C4[1]), pk2(C4[2], C4[3])};
        if (do_n) NS[n * 64 + c.tid] = nv;
        if (sl == 0 && c.tid == 0) MS[n] = m;
        const float be = BE[n], ml = ML[n];
        const float mn = fmaxf(be + m, ml), keep = expf(be + m - mn), g = expf(ml - mn);
        m = mn;
        const f32x4 d = *(const f32x4*)(DC + (size_t)n * 8192);
        C4 = C4 * keep + d * g;
        if (do_n) nv = nv * keep + DN[n * 64 + c.tid] * g;
    }
}

__device__ __forceinline__ void mlc_passC(int u, const bf16_t* PROJ, const float* GATES, const float* b_i, const float* b_f, const unsigned char* YB,
                                          const float* gain  , bf16_t* MIXO, const Ctx& c) {
    const int bh = u >> 5, b = bh >> 2, h = bh & 3;
    const size_t t0 = (size_t)b * SEQ + (u & 31) * 64;
    unsigned char* smem = c.smem;
    float* csL = (float*)(smem + 32768); float* pmL = (float*)(smem + 33024); float* bcL = (float*)(smem + 33280); float* nnL = (float*)(smem + 33536); float* sqL = (float*)(smem + 33792);
    const int lane = c.lane, wid = __builtin_amdgcn_readfirstlane(c.wid);
    const bf16_t* CS = (const bf16_t*)(YB + MLC_CS) + (size_t)u * 8192;
#pragma unroll
    for (int i = 0; i < 4; ++i) { const int j = wid * 4 + i;
        glds16(PROJ + (t0 + 4 * j + (lane >> 4)) * NPAD + 512 + h * 128 + (lane & 15) * 8, smem + j * 1024 + lane * 16);
        glds16(CS + (4 * j + (lane >> 4)) * 128 + (lane & 15) * 8, smem + 16384 + j * 1024 + lane * 16); }
    float bcl = 0.f;
    if (wid == 0) {
        const float ip = GATES[(t0 + lane) * 8 + h] + b_i[h], lf = -softplusf_(-(GATES[(t0 + lane) * 8 + 4 + h] + b_f[h]));
        bcl = scan_add64(lf, lane);
        const float cs = ip - bcl;
        csL[lane] = cs; pmL[lane] = scan_max64(cs, lane);
        nnL[lane] = ((const float*)(YB + MLC_NS))[(size_t)u * 64 + lane];
        bcL[lane] = bcl;
    }
    asm volatile("s_waitcnt vmcnt(0)" ::: "memory");
    __syncthreads();
    const int h5 = lane >> 5, r = lane & 31, i16 = lane & 15, q4 = i16 >> 2, p = i16 & 3, blk = (lane >> 4) & 1;
    const int th = wid & 1, dvh = wid >> 1;
    const int t = th * 32 + r;
    const float m_n = ((const float*)(YB + MLC_MS))[u];
    const float Mt = fmaxf(m_n, pmL[t]), w_inter = __expf(m_n - Mt), em = __expf(-(bcL[t] + Mt));
    bf16x8 qf[4];
#pragma unroll
    for (int ks = 0; ks < 4; ++ks) qf[ks] = *(const bf16x8*)(PROJ + (t0 + t) * NPAD + h * 64 + ks * 16 + h5 * 8);
    float qn = 0.f; bf16x8 qw[4];
#pragma unroll
    for (int ks = 0; ks < 4; ++ks) {
        const u32x4 raw = __builtin_bit_cast(u32x4, qf[ks]); float f[8]; unpack8(raw, f);
#pragma unroll
        for (int j = 0; j < 8; ++j) qn += f[j] * nnL[ks * 16 + h5 * 8 + j];
        qw[ks] = __builtin_bit_cast(bf16x8, (u32x4){pk2(f[0] * w_inter, f[1] * w_inter), pk2(f[2] * w_inter, f[3] * w_inter), pk2(f[4] * w_inter, f[5] * w_inter), pk2(f[6] * w_inter, f[7] * w_inter)});
    }
    qn += __shfl_xor(qn, 32);
    f32x16 x0, x1;
#pragma unroll
    for (int i = 0; i < 16; ++i) { x0[i] = 0.f; x1[i] = 0.f; }
#pragma unroll
    for (int ks = 0; ks < 4; ++ks) {
        const bf16x8 kf0 = *(const bf16x8*)(PROJ + (t0 + r) * NPAD + 256 + h * 64 + ks * 16 + h5 * 8);
        x0 = MFMA32(kf0, qf[ks], x0);
        if (th) { const bf16x8 kf1 = *(const bf16x8*)(PROJ + (t0 + 32 + r) * NPAD + 256 + h * 64 + ks * 16 + h5 * 8); x1 = MFMA32(kf1, qf[ks], x1); }
    }
    float ps = 0.f;
#pragma unroll
    for (int i = 0; i < 16; ++i) {
        const int s = (i & 3) + 8 * (i >> 2) + 4 * h5;
        const float w0 = (s <= t) ? __expf(csL[s] - Mt) * 0.125f : 0.f;
        x0[i] *= w0; ps += x0[i];
        if (th) { const float w1 = (s <= r) ? __expf(csL[32 + s] - Mt) * 0.125f : 0.f; x1[i] *= w1; ps += x1[i]; }
    }
    ps += __shfl_xor(ps, 32);
    const float den = w_inter * qn + ps;
    f32x16 o0, o1;
#pragma unroll
    for (int i = 0; i < 16; ++i) { o0[i] = 0.f; o1[i] = 0.f; }
    {
        const unsigned vb = (unsigned)(size_t)smem + (unsigned)((4 * h5 + q4) * 256 + dvh * 128 + 32 * blk + 8 * p);
#pragma unroll
        for (int st = 0; st < 2; ++st) {
            if (st == 0 || th) {
                s16x4 l00, h00, l01, h01, l10, h10, l11, h11;
                const unsigned va = vb + st * 8192;
                asm volatile("ds_read_b64_tr_b16 %0, %8\n\t"
                             "ds_read_b64_tr_b16 %1, %8 offset:2048\n\t"
                             "ds_read_b64_tr_b16 %2, %8 offset:64\n\t"
                             "ds_read_b64_tr_b16 %3, %8 offset:2112\n\t"
                             "ds_read_b64_tr_b16 %4, %8 offset:4096\n\t"
                             "ds_read_b64_tr_b16 %5, %8 offset:6144\n\t"
                             "ds_read_b64_tr_b16 %6, %8 offset:4160\n\t"
                             "ds_read_b64_tr_b16 %7, %8 offset:6208\n\t"
                             "s_waitcnt lgkmcnt(0)"
                             : "=&v"(l00), "=&v"(h00), "=&v"(l01), "=&v"(h01), "=&v"(l10), "=&v"(h10), "=&v"(l11), "=&v"(h11) : "v"(va) : "memory");
                const bf16x8 v00 = __builtin_shufflevector(l00, h00, 0, 1, 2, 3, 4, 5, 6, 7), v01 = __builtin_shufflevector(l01, h01, 0, 1, 2, 3, 4, 5, 6, 7);
                const bf16x8 v10 = __builtin_shufflevector(l10, h10, 0, 1, 2, 3, 4, 5, 6, 7), v11 = __builtin_shufflevector(l11, h11, 0, 1, 2, 3, 4, 5, 6, 7);
                const bf16x8 pb0 = (st == 0) ? pack_step<0>(x0) : pack_step<0>(x1);
                const bf16x8 pb1 = (st == 0) ? pack_step<1>(x0) : pack_step<1>(x1);
                o0 = MFMA32(v00, pb0, o0); o1 = MFMA32(v01, pb0, o1);
                o0 = MFMA32(v10, pb1, o0); o1 = MFMA32(v11, pb1, o1);
            }
        }
    }
    {
        const unsigned cb = (unsigned)(size_t)smem + 16384u + (unsigned)((8 * h5 + q4) * 256 + dvh * 128 + 32 * blk + 8 * p);
#pragma unroll
        for (int kp = 0; kp < 2; ++kp) {
            s16x4 l00, h00, l01, h01, l10, h10, l11, h11;
            const unsigned ca = cb + kp * 8192;
            asm volatile("ds_read_b64_tr_b16 %0, %8\n\t"
                         "ds_read_b64_tr_b16 %1, %8 offset:1024\n\t"
                         "ds_read_b64_tr_b16 %2, %8 offset:64\n\t"
                         "ds_read_b64_tr_b16 %3, %8 offset:1088\n\t"
                         "ds_read_b64_tr_b16 %4, %8 offset:4096\n\t"
                         "ds_read_b64_tr_b16 %5, %8 offset:5120\n\t"
                         "ds_read_b64_tr_b16 %6, %8 offset:4160\n\t"
                         "ds_read_b64_tr_b16 %7, %8 offset:5184\n\t"
                         "s_waitcnt lgkmcnt(0)"
                         : "=&v"(l00), "=&v"(h00), "=&v"(l01), "=&v"(h01), "=&v"(l10), "=&v"(h10), "=&v"(l11), "=&v"(h11) : "v"(ca) : "memory");
            const bf16x8 c00 = __builtin_shufflevector(l00, h00, 0, 1, 2, 3, 4, 5, 6, 7), c01 = __builtin_shufflevector(l01, h01, 0, 1, 2, 3, 4, 5, 6, 7);
            const bf16x8 c10 = __builtin_shufflevector(l10, h10, 0, 1, 2, 3, 4, 5, 6, 7), c11 = __builtin_shufflevector(l11, h11, 0, 1, 2, 3, 4, 5, 6, 7);
            o0 = MFMA32(c00, qw[2 * kp], o0); o1 = MFMA32(c01, qw[2 * kp], o1);
            o0 = MFMA32(c10, qw[2 * kp + 1], o0); o1 = MFMA32(c11, qw[2 * kp + 1], o1);
        }
    }
    const float inv = __builtin_amdgcn_rcpf(fmaxf(fabsf(den), em));
    float ss = 0.f;
#pragma unroll
    for (int i = 0; i < 16; ++i) { o0[i] *= inv; o1[i] *= inv; ss += o0[i] * o0[i] + o1[i] * o1[i]; }
    ss += __shfl_xor(ss, 32);
    if (h5 == 0) sqL[wid * 32 + r] = ss;
    __syncthreads();
    const float rr = rsqrtf((sqL[th * 32 + r] + sqL[(th + 2) * 32 + r]) * (1.f / 128.f) + 1e-6f);
    const bf16_t* grow = PROJ + (t0 + t) * NPAD + 1032 + h * 128 + dvh * 64 + 4 * h5;
    const float* gn = gain + h * 128 + dvh * 64 + 4 * h5;
    bf16_t* orow = MIXO + (t0 + t) * 1024 + h * 128 + dvh * 64 + 4 * h5;
#pragma unroll
    for (int d = 0; d < 2; ++d)
#pragma unroll
        for (int g = 0; g < 4; ++g) {
            const u32x2 zr = *(const u32x2*)(grow + d * 32 + 8 * g);
            const f32x4 gv = *(const f32x4*)(gn + d * 32 + 8 * g);
            const float z0 = bflo(zr.x), z1 = bfhi(zr.x), z2 = bflo(zr.y), z3 = bfhi(zr.y);
            const float y0 = (d ? o1[4 * g] : o0[4 * g]) * rr * gv[0] * sigmoidf_(z0), y1 = (d ? o1[4 * g + 1] : o0[4 * g + 1]) * rr * gv[1] * sigmoidf_(z1);
            const float y2 = (d ? o1[4 * g + 2] : o0[4 * g + 2]) * rr * gv[2] * sigmoidf_(z2), y3 = (d ? o1[4 * g + 3] : o0[4 * g + 3]) * rr * gv[3] * sigmoidf_(z3);
            *(u32x2*)(orow + d * 32 + 8 * g) = (u32x2){pk2(y0, y1), pk2(y2, y3)};
        }
}

constexpr size_t GD_WN = 0, GD_UU = GD_WN + (size_t)1024 * 16384, GD_KGT = GD_UU + (size_t)1024 * 16384, GD_QG = GD_KGT + (size_t)1024 * 16384,
                 GD_AT = GD_QG + (size_t)1024 * 16384, GD_GL = GD_AT + (size_t)1024 * 8192, GD_END = GD_GL + 4096;
static_assert(GD_END <= (size_t)MAXROWS * 256 * 2, "GDN chunk records must fit the HBUF region");

__device__ __forceinline__ void gdc_passA(int u, const bf16_t* GQ, const bf16_t* GK, const bf16_t* GV, const float* BETA, const float* GLOG, unsigned char* HB, const Ctx& c) {
    const int bh = u >> 5, b = bh >> 2, h = bh & 3;
    const size_t t0 = (size_t)b * SEQ + (u & 31) * 64;
    unsigned char* smem = c.smem;
    float* Lm = (float*)(smem + 49152);
    float* GA = (float*)(smem + 65536 + 64); float* BT = GA + 64; float* EG = BT + 64; float* EK = EG + 64;
    const int lane = c.lane, wid = __builtin_amdgcn_readfirstlane(c.wid);
    const int h5 = lane >> 5, r = lane & 31;
    if (wid == 0) {
        const float g = GLOG[(t0 + lane) * 4 + h];
        const float G = scan_add64(g, lane), Gl = __shfl(G, 63);
        GA[lane] = G; BT[lane] = BETA[(t0 + lane) * 4 + h]; EG[lane] = expf(G); EK[lane] = expf(Gl - G);
        if (lane == 0) ((float*)(HB + GD_GL))[u] = expf(Gl);
    }
    __syncthreads();
    if (wid < 3) {
        const int it = (wid + 1) >> 1, jt = wid >> 1;
        f32x16 dl, da;
#pragma unroll
        for (int i = 0; i < 16; ++i) { dl[i] = 0.f; da[i] = 0.f; }
#pragma unroll
        for (int ks = 0; ks < 8; ++ks) {
            const bf16x8 ki = *(const bf16x8*)(GK + (t0 + 32 * it + r) * 512 + h * 128 + ks * 16 + h5 * 8);
            const bf16x8 kj = *(const bf16x8*)(GK + (t0 + 32 * jt + r) * 512 + h * 128 + ks * 16 + h5 * 8);
            const bf16x8 qi = *(const bf16x8*)(GQ + (t0 + 32 * it + r) * 512 + h * 128 + ks * 16 + h5 * 8);
            dl = MFMA32(ki, kj, dl); da = MFMA32(qi, kj, da);
        }
        const int j = 32 * jt + r; const float Gj = GA[j];
        bf16_t* AT = (bf16_t*)(HB + GD_AT) + (size_t)u * 4096;
#pragma unroll
        for (int i = 0; i < 16; ++i) {
            const int ii = 32 * it + (i & 3) + 8 * (i >> 2) + 4 * h5;
            const float dec = __expf(GA[ii] - Gj);
            Lm[ii * 64 + j] = (j < ii) ? dl[i] * BT[ii] * dec : 0.f;
            AT[ii * 64 + j] = (bf16_t)f2bf((j <= ii) ? da[i] * dec : 0.f);
        }
        if (wid == 0) {
#pragma unroll
            for (int i = 0; i < 16; ++i) { const int ii = (i & 3) + 8 * (i >> 2) + 4 * h5; Lm[ii * 64 + 32 + r] = 0.f; AT[ii * 64 + 32 + r] = 0; }
        }
    }
    __syncthreads();
    if (wid == 0) {
        float Tc[64];
#pragma unroll
        for (int i = 0; i < 64; ++i) {
            float s = (i == lane) ? 1.f : 0.f;
#pragma unroll
            for (int k = 0; k < i; ++k) s -= Lm[i * 64 + k] * Tc[k];
            Tc[i] = s;
        }
        bf16_t* Tm = (bf16_t*)Lm;
#pragma unroll
        for (int i = 0; i < 64; ++i) Tm[i * 64 + lane] = (bf16_t)f2bf(Tc[i]);
    } else {
        const int t3 = c.tid - 64;
        for (int idx = t3; idx < 4096; idx += 192) {
            const int arr = idx >> 10, rem = idx & 1023, row = rem >> 4, chk = rem & 15;
            const bf16_t* sp = ((arr == 1) ? GV : (arr == 3) ? GQ : GK) + (t0 + row) * 512 + h * 128 + chk * 8;
            const u32x4 raw = *(const u32x4*)sp; float f[8]; unpack8(raw, f);
            const float sc = (arr == 0) ? BT[row] * EG[row] : (arr == 1) ? BT[row] : (arr == 2) ? EK[row] : EG[row];
            const u32x4 o = (u32x4){pk2(f[0] * sc, f[1] * sc), pk2(f[2] * sc, f[3] * sc), pk2(f[4] * sc, f[5] * sc), pk2(f[6] * sc, f[7] * sc)};
            if (arr < 3) *(u32x4*)(smem + arr * 16384 + row * 256 + chk * 16) = o;
            else *(u32x4*)((bf16_t*)(HB + GD_QG) + (size_t)u * 8192 + row * 128 + chk * 8) = o;
        }
    }
    __syncthreads();
    {
        const int i16 = lane & 15, q4 = i16 >> 2, p = i16 & 3, blk = (lane >> 4) & 1;
        const unsigned char* Tm = smem + 49152;
        f32x16 u0, u1, w0, w1;
#pragma unroll
        for (int i = 0; i < 16; ++i) { u0[i] = 0.f; u1[i] = 0.f; w0[i] = 0.f; w1[i] = 0.f; }
        const unsigned ib = (unsigned)(size_t)smem + (unsigned)((8 * h5 + q4) * 256 + wid * 64 + 32 * blk + 8 * p);
#pragma unroll
        for (int ks = 0; ks < 4; ++ks) {
            s16x4 kl, kh, vl, vh;
            const unsigned ia = ib + ks * 4096;
            asm volatile("ds_read_b64_tr_b16 %0, %4\n\t"
                         "ds_read_b64_tr_b16 %1, %4 offset:1024\n\t"
                         "ds_read_b64_tr_b16 %2, %4 offset:16384\n\t"
                         "ds_read_b64_tr_b16 %3, %4 offset:17408\n\t"
                         "s_waitcnt lgkmcnt(0)"
                         : "=&v"(kl), "=&v"(kh), "=&v"(vl), "=&v"(vh) : "v"(ia) : "memory");
            const bf16x8 kb = __builtin_shufflevector(kl, kh, 0, 1, 2, 3, 4, 5, 6, 7), vb = __builtin_shufflevector(vl, vh, 0, 1, 2, 3, 4, 5, 6, 7);
            const bf16x8 t1 = *(const bf16x8*)(Tm + (32 + r) * 128 + ks * 32 + h5 * 16);
            w1 = MFMA32(t1, kb, w1); u1 = MFMA32(t1, vb, u1);
            if (ks < 2) { const bf16x8 tt0 = *(const bf16x8*)(Tm + r * 128 + ks * 32 + h5 * 16); w0 = MFMA32(tt0, kb, w0); u0 = MFMA32(tt0, vb, u0); }
        }
        bf16_t* WN = (bf16_t*)(HB + GD_WN) + (size_t)u * 8192; bf16_t* UU = (bf16_t*)(HB + GD_UU) + (size_t)u * 8192;
#pragma unroll
        for (int i = 0; i < 16; ++i) {
            const int s = (i & 3) + 8 * (i >> 2) + 4 * h5;
            WN[s * 128 + wid * 32 + r] = (bf16_t)f2bf(-w0[i]); WN[(32 + s) * 128 + wid * 32 + r] = (bf16_t)f2bf(-w1[i]);
        }
        {
            u32x4* up = (u32x4*)(UU + (size_t)(wid * 64 + lane) * 32);
            up[0] = (u32x4){pk2(u0[0], u0[1]), pk2(u0[2], u0[3]), pk2(u0[4], u0[5]), pk2(u0[6], u0[7])};
            up[1] = (u32x4){pk2(u0[8], u0[9]), pk2(u0[10], u0[11]), pk2(u0[12], u0[13]), pk2(u0[14], u0[15])};
            up[2] = (u32x4){pk2(u1[0], u1[1]), pk2(u1[2], u1[3]), pk2(u1[4], u1[5]), pk2(u1[6], u1[7])};
            up[3] = (u32x4){pk2(u1[8], u1[9]), pk2(u1[10], u1[11]), pk2(u1[12], u1[13]), pk2(u1[14], u1[15])};
        }
        bf16_t* KGT = (bf16_t*)(HB + GD_KGT) + (size_t)u * 8192;
        const int gq = lane >> 4;
        const unsigned kb0 = (unsigned)(size_t)smem + 32768u + (unsigned)(q4 * 256 + gq * 32 + 8 * p);
#pragma unroll
        for (int it2 = 0; it2 < 8; ++it2) {
            const int job = wid * 8 + it2, s0 = (job & 15) * 4, dkb = (job >> 4) * 64;
            s16x4 v;
            const unsigned ad = kb0 + s0 * 256 + dkb * 2;
            asm volatile("ds_read_b64_tr_b16 %0, %1\n\ts_waitcnt lgkmcnt(0)" : "=&v"(v) : "v"(ad) : "memory");
            *(s16x4*)(KGT + (size_t)(dkb + gq * 16 + i16) * 64 + s0) = v;
        }
    }
}

constexpr size_t GC_ST = 0, GC_VT = (size_t)1024 * 32768;
__device__ __forceinline__ void gdc_passB(int bh, const unsigned char* HB, unsigned char* YB, const Ctx& c) {
    const int lane = c.lane, wid = __builtin_amdgcn_readfirstlane(c.wid);
    const int h5 = lane >> 5, r = lane & 31;
    unsigned char* smem = c.smem;
    f32x16 S0, S1, S2, S3;
#pragma unroll
    for (int i = 0; i < 16; ++i) { S0[i] = 0.f; S1[i] = 0.f; S2[i] = 0.f; S3[i] = 0.f; }
    const size_t u0 = (size_t)bh * 32;
#define GB_STAGE(n_, p_) do { const bf16_t* wn_ = (const bf16_t*)(HB + GD_WN) + (u0 + (n_)) * 8192; const bf16_t* kg_ = (const bf16_t*)(HB + GD_KGT) + (u0 + (n_)) * 8192; \
        unsigned char* bp_ = smem + (p_) * 32768; \
        _Pragma("unroll") for (int i = 0; i < 4; ++i) { const int jj = wid * 4 + i, row = 4 * jj + (lane >> 4), ch = (lane & 15) ^ (row & 15); \
            glds16(wn_ + row * 128 + ch * 8, bp_ + jj * 1024 + lane * 16); } \
        _Pragma("unroll") for (int i = 0; i < 4; ++i) { const int jj = wid * 4 + i, row = 8 * jj + (lane >> 3), ch = (lane & 7) ^ ((row >> 1) & 7); \
            glds16(kg_ + row * 64 + ch * 8, bp_ + 16384 + jj * 1024 + lane * 16); } } while (0)
#define LD128(base_, R_, ks_) __builtin_shufflevector(*(const s16x4*)((base_) + (R_) * 256 + (((2 * (ks_)) ^ (rl & 15)) << 4) + 8 * hl), \
                                                      *(const s16x4*)((base_) + (R_) * 256 + (((2 * (ks_) + 1) ^ (rl & 15)) << 4) + 8 * hl), 0, 1, 2, 3, 4, 5, 6, 7)
#define LD64(base_, R_, k2_) __builtin_shufflevector(*(const s16x4*)((base_) + (R_) * 128 + (((2 * (k2_)) ^ ((rl >> 1) & 7)) << 4) + 8 * hl), \
                                                     *(const s16x4*)((base_) + (R_) * 128 + (((2 * (k2_) + 1) ^ ((rl >> 1) & 7)) << 4) + 8 * hl), 0, 1, 2, 3, 4, 5, 6, 7)
    u32x4 uu[4];
#define GB_LOADU(n_) do { const u32x4* up_ = (const u32x4*)((const bf16_t*)(HB + GD_UU) + (u0 + (n_)) * 8192 + (size_t)(wid * 64 + lane) * 32); \
        uu[0] = up_[0]; uu[1] = up_[1]; uu[2] = up_[2]; uu[3] = up_[3]; } while (0)
    __syncthreads();
    GB_STAGE(0, 0);
    GB_LOADU(0);
#pragma unroll 1
    for (int n2 = 0; n2 < 16; ++n2) {
#pragma unroll
        for (int PBUF = 0; PBUF < 2; ++PBUF) {
        const int n = 2 * n2 + PBUF;
        const float gl = ((const float*)(HB + GD_GL))[u0 + n];
        if (n == 0) asm volatile("s_waitcnt vmcnt(0)" ::: "memory"); else asm volatile("s_waitcnt vmcnt(24)" ::: "memory");
        asm volatile("s_waitcnt lgkmcnt(0)" ::: "memory"); __builtin_amdgcn_s_barrier(); asm volatile("" ::: "memory");
        f32x16 v0, v1;
#pragma unroll
        for (int q = 0; q < 2; ++q) {
            const u32x4 a = uu[q], bq = uu[2 + q];
            v0[8 * q + 0] = bflo(a.x); v0[8 * q + 1] = bfhi(a.x); v0[8 * q + 2] = bflo(a.y); v0[8 * q + 3] = bfhi(a.y);
            v0[8 * q + 4] = bflo(a.z); v0[8 * q + 5] = bfhi(a.z); v0[8 * q + 6] = bflo(a.w); v0[8 * q + 7] = bfhi(a.w);
            v1[8 * q + 0] = bflo(bq.x); v1[8 * q + 1] = bfhi(bq.x); v1[8 * q + 2] = bflo(bq.y); v1[8 * q + 3] = bfhi(bq.y);
            v1[8 * q + 4] = bflo(bq.z); v1[8 * q + 5] = bfhi(bq.z); v1[8 * q + 6] = bflo(bq.w); v1[8 * q + 7] = bfhi(bq.w);
        }
        if (n + 1 < 32) { GB_STAGE(n + 1, (PBUF ^ 1)); GB_LOADU(n + 1); }
        int rl = r, hl = h5; asm volatile("" : "+v"(rl), "+v"(hl));
        const unsigned char* WNb = smem + PBUF * 32768; const unsigned char* KGb = WNb + 16384;
        {
            bf16_t* st = (bf16_t*)(YB + GC_ST) + (u0 + n) * 16384 + (size_t)h5 * 512 + (size_t)(wid * 32 + r) * 4;
#define ST_TILE(SX, dt_) do { _Pragma("unroll") for (int g = 0; g < 4; ++g) \
                *(u32x2*)(st + ((dt_) * 8 + 2 * g) * 512) = (u32x2){cvt_pk(SX[4 * g], SX[4 * g + 1]), cvt_pk(SX[4 * g + 2], SX[4 * g + 3])}; } while (0)
            ST_TILE(S0, 0); ST_TILE(S1, 1); ST_TILE(S2, 2); ST_TILE(S3, 3);
#undef ST_TILE
        }
        {
            bf16x8 fa0, fb0, fa1, fb1, fa2, fb2;
#define LDV(FA, FB, ks_) do { FA = LD128(WNb, rl, ks_); FB = LD128(WNb, 32 + rl, ks_); } while (0)
#define MMV(SX, HF, FA, FB) do { const bf16x8 sbk = pack_step<HF>(SX); v0 = MFMA32(FA, sbk, v0); v1 = MFMA32(FB, sbk, v1); } while (0)
            LDV(fa0, fb0, 0); LDV(fa1, fb1, 1); LDV(fa2, fb2, 2);
            MMV(S0, 0, fa0, fb0); LDV(fa0, fb0, 3);
            MMV(S0, 1, fa1, fb1); LDV(fa1, fb1, 4);
            MMV(S1, 0, fa2, fb2); LDV(fa2, fb2, 5);
            MMV(S1, 1, fa0, fb0); LDV(fa0, fb0, 6);
            MMV(S2, 0, fa1, fb1); LDV(fa1, fb1, 7);
            MMV(S2, 1, fa2, fb2);
            MMV(S3, 0, fa0, fb0);
            MMV(S3, 1, fa1, fb1);
#undef LDV
#undef MMV
        }
        const bf16x8 vb0 = pack_step_m<0>(v0), vb1 = pack_step_m<1>(v0), vb2 = pack_step_m<0>(v1), vb3 = pack_step_m<1>(v1);
        {
            bf16_t* vt = (bf16_t*)(YB + GC_VT) + (u0 + n) * 8192 + (size_t)h5 * 512 + (size_t)(wid * 32 + r) * 4;
            const u32x4 p0 = __builtin_bit_cast(u32x4, vb0), p1 = __builtin_bit_cast(u32x4, vb1), p2 = __builtin_bit_cast(u32x4, vb2), p3 = __builtin_bit_cast(u32x4, vb3);
            *(u32x2*)(vt + 0 * 512) = (u32x2){p0.x, p0.y};  *(u32x2*)(vt + 2 * 512) = (u32x2){p0.z, p0.w};
            *(u32x2*)(vt + 4 * 512) = (u32x2){p1.x, p1.y};  *(u32x2*)(vt + 6 * 512) = (u32x2){p1.z, p1.w};
            *(u32x2*)(vt + 8 * 512) = (u32x2){p2.x, p2.y};  *(u32x2*)(vt + 10 * 512) = (u32x2){p2.z, p2.w};
            *(u32x2*)(vt + 12 * 512) = (u32x2){p3.x, p3.y}; *(u32x2*)(vt + 14 * 512) = (u32x2){p3.z, p3.w};
        }
        asm volatile("" ::: "memory"); asm volatile("" : "+v"(rl), "+v"(hl));
        S0 *= gl; S1 *= gl; S2 *= gl; S3 *= gl;
        {
            bf16x8 g0, g1, g2;
            g0 = LD64(KGb, rl, 0); g1 = LD64(KGb, rl, 1); g2 = LD64(KGb, rl, 2);
            S0 = MFMA32(g0, vb0, S0); g0 = LD64(KGb, rl, 3);
            S0 = MFMA32(g1, vb1, S0); g1 = LD64(KGb, 32 + rl, 0);
            S0 = MFMA32(g2, vb2, S0); g2 = LD64(KGb, 32 + rl, 1);
            S0 = MFMA32(g0, vb3, S0); g0 = LD64(KGb, 32 + rl, 2);
            S1 = MFMA32(g1, vb0, S1); g1 = LD64(KGb, 32 + rl, 3);
            S1 = MFMA32(g2, vb1, S1); g2 = LD64(KGb, 64 + rl, 0);
            S1 = MFMA32(g0, vb2, S1); g0 = LD64(KGb, 64 + rl, 1);
            S1 = MFMA32(g1, vb3, S1); g1 = LD64(KGb, 64 + rl, 2);
            S2 = MFMA32(g2, vb0, S2); g2 = LD64(KGb, 64 + rl, 3);
            S2 = MFMA32(g0, vb1, S2); g0 = LD64(KGb, 96 + rl, 0);
            S2 = MFMA32(g1, vb2, S2); g1 = LD64(KGb, 96 + rl, 1);
            S2 = MFMA32(g2, vb3, S2); g2 = LD64(KGb, 96 + rl, 2);
            S3 = MFMA32(g0, vb0, S3); g0 = LD64(KGb, 96 + rl, 3);
            S3 = MFMA32(g1, vb1, S3);
            S3 = MFMA32(g2, vb2, S3);
            S3 = MFMA32(g0, vb3, S3);
        }
        }
    }
#undef GB_STAGE
#undef LD128
#undef LD64
#undef GB_LOADU
}

__device__ __forceinline__ void gdc_passB_idle() {
    __syncthreads();
    for (int n = 0; n < 32; ++n) { asm volatile("" ::: "memory"); __builtin_amdgcn_s_barrier(); asm volatile("" ::: "memory"); }
}

__device__ __forceinline__ void gdc_passC(int u, const unsigned char* HB, const unsigned char* YB, const bf16_t* PROJ, const float* gnorm, bf16_t* MIXO, const Ctx& c) {
    const int bh = u >> 5, b = bh >> 2, h = bh & 3;
    const size_t t0 = (size_t)b * SEQ + (u & 31) * 64;
    const int lane = c.lane, wid = __builtin_amdgcn_readfirstlane(c.wid);
    const int h5 = lane >> 5, r = lane & 31;
    float* sqL = (float*)c.smem;
    const bf16_t* ST = (const bf16_t*)(YB + GC_ST) + (size_t)u * 16384 + (size_t)(2 * h5) * 512 + (size_t)(wid * 32 + r) * 4;
    const bf16_t* VT = (const bf16_t*)(YB + GC_VT) + (size_t)u * 8192 + (size_t)(2 * h5) * 512 + (size_t)(wid * 32 + r) * 4;
    const bf16_t* QG = (const bf16_t*)(HB + GD_QG) + (size_t)u * 8192 + (size_t)r * 128 + 8 * h5;
    const bf16_t* AT = (const bf16_t*)(HB + GD_AT) + (size_t)u * 4096 + (size_t)r * 64 + 8 * h5;
    f32x16 o0, o1;
#pragma unroll
    for (int i = 0; i < 16; ++i) { o0[i] = 0.f; o1[i] = 0.f; }
#pragma unroll
    for (int ks = 0; ks < 8; ++ks) {
        const bf16x8 sa = __builtin_shufflevector(*(const s16x4*)(ST + (4 * ks) * 512), *(const s16x4*)(ST + (4 * ks + 1) * 512), 0, 1, 2, 3, 4, 5, 6, 7);
        const bf16x8 q0 = *(const bf16x8*)(QG + ks * 16), q1 = *(const bf16x8*)(QG + 32 * 128 + ks * 16);
        o0 = MFMA32(sa, q0, o0); o1 = MFMA32(sa, q1, o1);
        if (ks == 3) asm volatile("" ::: "memory");
    }
#pragma unroll
    for (int k2 = 0; k2 < 4; ++k2) {
        const bf16x8 va = __builtin_shufflevector(*(const s16x4*)(VT + (4 * k2) * 512), *(const s16x4*)(VT + (4 * k2 + 1) * 512), 0, 1, 2, 3, 4, 5, 6, 7);
        const bf16x8 a1 = *(const bf16x8*)(AT + 32 * 64 + k2 * 16);
        o1 = MFMA32(va, a1, o1);
        if (k2 < 2) { const bf16x8 a0 = *(const bf16x8*)(AT + k2 * 16); o0 = MFMA32(va, a0, o0); }
    }
    float s0 = 0.f, s1 = 0.f;
#pragma unroll
    for (int i = 0; i < 16; ++i) { s0 += o0[i] * o0[i]; s1 += o1[i] * o1[i]; }
    s0 += __shfl_xor(s0, 32); s1 += __shfl_xor(s1, 32);
    __syncthreads();
    if (h5 == 0) { sqL[wid * 64 + r] = s0; sqL[wid * 64 + 32 + r] = s1; }
    __syncthreads();
    const float rr0 = rsqrtf((sqL[r] + sqL[64 + r] + sqL[128 + r] + sqL[192 + r]) * (1.f / 128.f) + 1e-6f);
    const float rr1 = rsqrtf((sqL[32 + r] + sqL[96 + r] + sqL[160 + r] + sqL[224 + r]) * (1.f / 128.f) + 1e-6f);
#pragma unroll
    for (int tt = 0; tt < 2; ++tt) {
        const size_t t = t0 + tt * 32 + r;
        const bf16_t* zrow = PROJ + t * NPAD + 1960 + h * 128 + wid * 32 + 4 * h5;
        const float* gn = gnorm + wid * 32 + 4 * h5;
        bf16_t* orow = MIXO + t * 1024 + 512 + h * 128 + wid * 32 + 4 * h5;
        const float rr = tt ? rr1 : rr0;
#pragma unroll
        for (int g = 0; g < 4; ++g) {
            const u32x2 zr = *(const u32x2*)(zrow + 8 * g);
            const f32x4 gv = *(const f32x4*)(gn + 8 * g);
            const float z0 = bflo(zr.x), z1 = bfhi(zr.x), z2 = bflo(zr.y), z3 = bfhi(zr.y);
            const float y0 = (tt ? o1[4 * g] : o0[4 * g]) * rr * gv[0] * siluf_(z0), y1 = (tt ? o1[4 * g + 1] : o0[4 * g + 1]) * rr * gv[1] * siluf_(z1);
            const float y2 = (tt ? o1[4 * g + 2] : o0[4 * g + 2]) * rr * gv[2] * siluf_(z2), y3 = (tt ? o1[4 * g + 3] : o0[4 * g + 3]) * rr * gv[3] * siluf_(z3);
            *(u32x2*)(orow + 8 * g) = (u32x2){pk2(y0, y1), pk2(y2, y3)};
        }
    }
}

__device__ __forceinline__ void phase_post(const float* OG, const bf16_t* PROJ, const float* gain, bool odd, bf16_t* MIXO, const Ctx& c) {
    const int lane = c.lane;
    const int gcol = odd ? 1032 : 1960, ocol = odd ? 0 : 512;
    for (int t = c.bid * 4 + c.wid; t < T; t += c.nblk * 4) {
        const f32x4 a0 = *(const f32x4*)(OG + (size_t)t * 512 + lane * 8), a1 = *(const f32x4*)(OG + (size_t)t * 512 + lane * 8 + 4);
        float ss = (a0[0] * a0[0] + a0[1] * a0[1]) + (a0[2] * a0[2] + a0[3] * a0[3]) + (a1[0] * a1[0] + a1[1] * a1[1]) + (a1[2] * a1[2] + a1[3] * a1[3]);
        ss = red16(ss);
        const float rr = rsqrtf(ss * (1.f / 128.f) + 1e-6f);
        const u32x4 zr = *(const u32x4*)(PROJ + (size_t)t * NPAD + gcol + lane * 8);
        float z[8]; unpack8(zr, z);
        const int gi = odd ? lane * 8 : (lane & 15) * 8;
        const f32x4 g0 = *(const f32x4*)(gain + gi), g1 = *(const f32x4*)(gain + gi + 4);
        float y[8];
#pragma unroll
        for (int j = 0; j < 4; ++j) {
            const float ga = odd ? sigmoidf_(z[j]) : siluf_(z[j]), gb = odd ? sigmoidf_(z[4 + j]) : siluf_(z[4 + j]);
            y[j] = a0[j] * rr * g0[j] * ga; y[4 + j] = a1[j] * rr * g1[j] * gb;
        }
        *(u32x4*)(MIXO + (size_t)t * 1024 + ocol + lane * 8) = (u32x4){pk2(y[0], y[1]), pk2(y[2], y[3]), pk2(y[4], y[5]), pk2(y[6], y[7])};
    }
}

__global__ void __launch_bounds__(512, 2) fwd(Args a) {
    extern __shared__ __attribute__((aligned(16))) unsigned char smem[];
    Ctx c;
#define SET_CTX(cx) do { int t_ = threadIdx.x; asm volatile("" : "+v"(t_)); cx.tid0 = t_; cx.half = t_ >> 8; cx.tid = t_ & 255; cx.lane = t_ & 63; cx.wid = (t_ >> 6) & 3; \
        cx.wr = cx.wid >> 1; cx.wc = cx.wid & 1; cx.fr = cx.lane & 15; cx.fq = cx.lane >> 4; cx.bid = blockIdx.x * 2 + cx.half; cx.nblk = gridDim.x * 2; \
        cx.smem0 = smem; cx.smem = smem + cx.half * HALF_LDS; } while (0)
    SET_CTX(c);
#define PH_CTX() SET_CTX(c)
    unsigned char* const ws_base = a.ws;
    const void* const* const ain_base = (const void* const*)__builtin_amdgcn_kernarg_segment_ptr();
    unsigned* ctl = (unsigned*)(ws_base + WS_CTL);
    volatile LAS unsigned* xbw = (volatile LAS unsigned*)(smem + LDS_BLK);
    if (c.tid0 < 8) xbw[c.tid0] = 0u;
    __syncthreads();
    XcdBarrier bar; bar.bar = ctl; bar.x = 0; bar.st = xbw;
    if (a.use_bar) bar = xcd_barrier_post(ctl, xbw);
#if ONE_LAUNCH
    const int hi = NPH;
#define IN(k) true
#else
    const int lo = a.ph_lo, hi = a.ph_hi;
#define IN(k) (lo <= (k) && (k) < hi)
#endif
#define PH(k) if (IN(k)) { PH_CTX(); unsigned char* ws = ws_base; const void* const* ain = ain_base; asm volatile("" : "+s"(ws), "+s"(ain));
#define UNIT_CTX() Ctx cu; SET_CTX(cu)
#define SEAM(k) do { if ((k) + 1 < hi) xcd_barrier(bar); } while (0)

#define XBF ((bf16_t*)(ws + WS_XBF))
#define X1 ((float*)(ws + WS_X1))
#define PROJ ((bf16_t*)(ws + U_PROJ))
#define GATES ((float*)(ws + U_GATES))
#define MIXO ((bf16_t*)(ws + U_MIXO))
#define YBUF ((float*)(ws + U_YBUF))
#define ROPEM ((const float*)(ws + WS_ROPEM))
#define ROPES ((const float*)(ws + WS_ROPES))
#define XRES ((layer == 0) ? (const float*)ain[0] : (const float*)a.out)
#define CNT (ctl + CW_CNT + layer * 128)
#define WIN ((const bf16_t*)(ws + WS_WIN) + (size_t)layer * WIN_ELEMS)
#define WOUT ((const bf16_t*)(ws + WS_WOUT) + (size_t)layer * WOUT_ELEMS)

    PH(0) for (int rep = 0; rep < REP_PRO; ++rep) phase_prologue(a, c); SEAM(0); }

    for (int layer = 0; layer < 4; ++layer) {
        const int pb = 1 + layer * PPL;
#if !ONE_LAUNCH
        if (pb >= hi || pb + PPL <= lo) continue;
#endif
        const int jj = layer >> 1;
        const bool odd = (layer & 1) != 0;

        PH(pb + 0) {
                DenseSched S{T / 256, NPAD / 256, 1024, (int)blockIdx.x, (int)gridDim.x};
                EpiIn E{PROJ, GATES, odd ? 1024 : 1952};
                g8::phase<true, false>(smem, (const char*)XBF, (const char*)WIN, 1024, S, E);
            }
            SEAM(pb + 0); }
        PH(pb + 1) for (int rp = 0; rp < ((REP_PHASE == 1) ? 2 : 1); ++rp) { if (rp) xcd_barrier(bar);
            if (!odd) phase_prep_even(PROJ, GATES, (const float*)ain[3] + jj * 256, (const float*)ain[5] + jj * 128, (const float*)ain[7] + jj * 4 * 1536,
                                      (const float*)ain[8] + jj * 4, (const float*)ain[9] + jj * 4, ROPEM,
                                      (bf16_t*)(ws + U_CQ), (bf16_t*)(ws + U_CKV), (bf16_t*)(ws + U_KROPE), (bf16_t*)(ws + U_GQ), (bf16_t*)(ws + U_GK), (bf16_t*)(ws + U_GV),
                                      (float*)(ws + U_BETA), (float*)(ws + U_GLOG), c);
            else {
                phase_prep_odd(PROJ, ROPES, (bf16_t*)(ws + U_QF), (bf16_t*)(ws + U_KN), c);
                unsigned* ctr = ctl + CW_WORK + pb + 1 + 64 * rp;
                for (;;) {
                    const int u = next_unit(ctr, c); UNIT_CTX();
                    if (u >= 1024) break;
                    mlc_passA(u, PROJ, GATES, (const float*)ain[13] + jj * 4, (const float*)ain[14] + jj * 4, (unsigned char*)YBUF, cu);
                }
            }
            }
            SEAM(pb + 1);
        }
        PH(pb + 2) for (int rp = 0; rp < ((REP_PHASE == 2) ? 2 : 1); ++rp) { if (rp) xcd_barrier(bar);
            unsigned* ctr = ctl + CW_WORK + pb + 2 + 64 * rp;
            if (!odd) {
                for (;;) {
                    const int u = next_unit(ctr, c); UNIT_CTX();
                    if (u >= 1024 + MLAUP_TILES) break;
                    if (u < 1024) gdc_passA(u, (const bf16_t*)(ws + U_GQ), (const bf16_t*)(ws + U_GK), (const bf16_t*)(ws + U_GV), (const float*)(ws + U_BETA),
                                            (const float*)(ws + U_GLOG), ws + WS_HBUF, cu);
                    else mla_up_tile(u - 1024, (const bf16_t*)(ws + U_CQ), (const bf16_t*)(ws + WS_WQB) + (size_t)jj * WQB_ELEMS, (const bf16_t*)(ws + U_CKV),
                                     (const bf16_t*)(ws + WS_WKVB) + (size_t)jj * WKVB_ELEMS, ROPEM, (bf16_t*)(ws + U_QF), (bf16_t*)(ws + U_KN), (bf16_t*)(ws + U_VV), cu);
                }
            } else {
                for (;;) {
                    const int u = next_unit(ctr, c); UNIT_CTX();
                    if (u >= 256 + 1024) break;
                    if (u < 256) mlc_passB(u, (unsigned char*)YBUF, cu);
                    else {
                        const int v = u - 256, hq = v & 7, n = (v >> 3) & 15, b = v >> 7, kvh = hq >> 2;
                        const size_t tb = (size_t)b * SEQ;
                        attn_unit<4, true>((const bf16_t*)(ws + U_QF) + tb * 512 + hq * 64, 512, (const bf16_t*)(ws + U_KN) + tb * 128 + kvh * 64, 128,
                                           (const bf16_t*)(ws + U_KN), 0, PROJ + tb * NPAD + 2184 + kvh * 64, NPAD,
                                           MIXO + tb * 1024 + 512 + hq * 64, 1024, n * 128, ((const float*)ain[16])[jj * 8 + hq] * 1.4426950408889634f, cu);
                    }
                }
            }
            }
            SEAM(pb + 2);
        }
        PH(pb + 3) for (int rp = 0; rp < ((REP_PHASE == 3) ? 2 : 1); ++rp) { if (rp) xcd_barrier(bar);
            unsigned* ctr = ctl + CW_WORK + pb + 3 + 64 * rp;
            if (!odd) {
                for (;;) {
                    const int u = next_unit(ctr, c); UNIT_CTX();
                    if (u >= 64 + 1024) break;
                    if (rp > 0 && ((REP_ONLY == 1 && u >= 64) || (REP_ONLY == 2 && u < 64))) continue;
                    if (u < 64) { if ((u & 1) == 0) gdc_passB(u >> 1, ws + WS_HBUF, (unsigned char*)YBUF, cu); else gdc_passB_idle(); }
                    else {
                        const int v = u - 64, qb = 15 - (v >> 6), bh = v & 63, b = bh >> 3, hh = bh & 7;
                        const size_t tb = (size_t)b * SEQ;
                        attn_unit<6, false>((const bf16_t*)(ws + U_QF) + tb * 768 + hh * 96, 768, (const bf16_t*)(ws + U_KN) + tb * 512 + hh * 64, 512,
                                            (const bf16_t*)(ws + U_KROPE) + tb * 32, 32, (const bf16_t*)(ws + U_VV) + tb * 512 + hh * 64, 512,
                                            MIXO + tb * 1024 + hh * 64, 1024, qb * 128, 0.f, cu);
                    }
                }
            } else {
                for (;;) {
                    const int u = next_unit(ctr, c); UNIT_CTX();
                    if (u >= 1024) break;
                    mlc_passC(u, PROJ, GATES, (const float*)ain[13] + jj * 4, (const float*)ain[14] + jj * 4, (const unsigned char*)YBUF, (const float*)ain[15] + jj * 512, MIXO, cu);
                }
            }
            }
            SEAM(pb + 3);
        }
        PH(pb + 4) for (int rp = 0; rp < ((REP_PHASE == 4) ? 2 : 1); ++rp) { if (rp) xcd_barrier(bar);
            if (!odd) {
                unsigned* ctr = ctl + CW_WORK + pb + 4 + 64 * rp;
                for (;;) {
                    const int u = next_unit(ctr, c); UNIT_CTX();
                    if (u >= 1024) break;
                    gdc_passC(u, ws + WS_HBUF, (const unsigned char*)YBUF, PROJ, (const float*)ain[10] + jj * 128, MIXO, cu);
                }
            }
            }
            if (!odd) SEAM(pb + 4);
        }
        PH(pb + 5) {
                DenseSched S{T / 256, 4, 1024, (int)blockIdx.x, (int)gridDim.x};
                EpiOut E{XBF, (bf16_t*)YBUF};
                g8::phase<true, false>(smem, (const char*)MIXO, (const char*)WOUT, 1024, S, E);
            }
            SEAM(pb + 5); }
        PH(pb + 6) for (int rep = 0; rep < REP_TOK; ++rep) phase_ln1((const bf16_t*)YBUF, (const float*)ain[18] + layer * 1024, (const float*)ain[19] + layer * 1024, XBF, c); SEAM(pb + 6); }
        PH(pb + 7) for (int rep = 0; rep < REP_GEMM; ++rep) phase_router(XBF, (const bf16_t*)(ws + WS_WRT) + (size_t)layer * WRT_ELEMS, (float*)(ws + WS_LOG), c); SEAM(pb + 7); }
        PH(pb + 8) phase_route((const float*)(ws + WS_LOG), (const float*)ain[21] + layer * 64, CNT, (int*)(ws + WS_LTOK), (float*)(ws + WS_LW), (int*)(ws + WS_ASG), (float*)(ws + WS_ASGW), c); SEAM(pb + 8); }
        PH(pb + 9) {
                int* bst8 = (int*)(smem + LDS_BLK + 64); int* eb8 = bst8 + 256;
                build_block_table(CNT, bst8, c);
                for (int rb = c.tid0; rb < bst8[65]; rb += NT) { int e = 0; for (int q = 1; q < 65; ++q) e += (bst8[q] <= rb) ? 1 : 0; eb8[rb] = e; }
                __syncthreads();
                MoeSchedG S{__builtin_amdgcn_readfirstlane(bst8[65]), (int)blockIdx.x, (int)gridDim.x, eb8, bst8, (const int*)(ws + WS_LTOK)};
                EpiMoe1 E{(bf16_t*)(ws + WS_HBUF)};
                g8::phase<false, true>(smem, (const char*)XBF, (const char*)((const bf16_t*)(ws + WS_WGU) + (size_t)layer * 65 * WGU_ELEMS), 1024, S, E);
            }
            SEAM(pb + 9); }
        PH(pb + 10)
#if MOE2_G8
            {
                int* bst8 = (int*)(smem + LDS_BLK + 64); int* eb8 = bst8 + 256;
                build_block_table(CNT, bst8, c);
                for (int rb = c.tid0; rb < bst8[65]; rb += NT) { int e = 0; for (int q = 1; q < 65; ++q) e += (bst8[q] <= rb) ? 1 : 0; eb8[rb] = e; }
                __syncthreads();
                MoeSched S{__builtin_amdgcn_readfirstlane(bst8[65]), 4, (int)blockIdx.x, (int)gridDim.x, eb8};
                EpiMoe2 E{(bf16_t*)(ws + U_Y)};
                g8::phase<true, false>(smem, (const char*)(ws + WS_HBUF), (const char*)((const bf16_t*)(ws + WS_WDN) + (size_t)layer * 65 * WDN_ELEMS), 256, S, E);
            }
#else
            phase_moe2((const bf16_t*)(ws + WS_HBUF), (const bf16_t*)(ws + WS_WDN) + (size_t)layer * 65 * WDN_ELEMS, CNT, (bf16_t*)(ws + U_Y), c);
#endif
            SEAM(pb + 10); }
        PH(pb + 11)
            if (layer == 3) phase_combine<true>((const bf16_t*)(ws + U_Y), (const int*)(ws + WS_ASG), (const float*)(ws + WS_ASGW), CNT, (const float*)ain[28] + layer * 1024, (const float*)ain[29] + layer * 1024, a.out, XBF, c);
            else phase_combine<false>((const bf16_t*)(ws + U_Y), (const int*)(ws + WS_ASG), (const float*)(ws + WS_ASGW), CNT, (const float*)ain[28] + layer * 1024, (const float*)ain[29] + layer * 1024, a.out, XBF, c);
            SEAM(pb + 11); }
    }
#undef IN
#undef XBF
#undef X1
#undef PROJ
#undef GATES
#undef MIXO
#undef YBUF
#undef ROPEM
#undef ROPES
#undef XRES
#undef CNT
#undef WIN
#undef WOUT
#undef PH
#undef PH_CTX
#undef UNIT_CTX
#undef SEAM
}

extern "C" void kernel_launch(void* const* d_in, const int* in_sizes, int n_in, void* d_out, int out_size, void* d_ws, size_t ws_size, hipStream_t stream) {
    static int grid = 0;
    if (grid == 0) {
        if (n_in != 30 || out_size != T * 1024 || ws_size < WS_END) {
            fprintf(stderr, "kernel_launch: unexpected shapes (n_in %d, out %d, ws %zu < %zu)\n", n_in, out_size, ws_size, (size_t)WS_END);
            grid = -1; return;
        }
        int dev = 0, cus = 0, per_cu = 0;
        (void)hipGetDevice(&dev);
        (void)hipDeviceGetAttribute(&cus, hipDeviceAttributeMultiprocessorCount, dev);
        (void)hipFuncSetAttribute((const void*)fwd, hipFuncAttributeMaxDynamicSharedMemorySize, DYN_LDS);
        (void)hipOccupancyMaxActiveBlocksPerMultiprocessor(&per_cu, (const void*)fwd, NT, DYN_LDS);
        (void)hipGetLastError();
        if (per_cu < 1) per_cu = 1;
        grid = cus;
    }
    if (grid < 0) return;
    (void)hipMemsetAsync((char*)d_ws + WS_CTL, 0, CTL_BYTES, stream);
    Args a{};
    for (int i = 0; i < 30; ++i) a.in[i] = d_in[i];
    a.out = (float*)d_out; a.ws = (unsigned char*)d_ws; a.pad = 0;
#if ONE_LAUNCH
    a.ph_lo = 0; a.ph_hi = NPH; a.use_bar = 1;
    hipLaunchKernelGGL(fwd, dim3(grid), dim3(NT), DYN_LDS, stream, a);
#else
    for (int p = 0; p < NPH; ++p) {
        a.ph_lo = p; a.ph_hi = p + 1; a.use_bar = 0;
        hipLaunchKernelGGL(fwd, dim3(grid), dim3(NT), DYN_LDS, stream, a);
    }
#endif
}
```

```cpp
#include <hip/hip_runtime.h>
#include <stdint.h>
#include <stdio.h>

#define REP_GEMM 1
#define REP_PHASE 0
#define REP_G0 1
#define REP_G1 1
#define REP_G2 1
#define REP_G3 1
#define REP_MIX 1
#define REP_ONLY 0
#define REP_CMB 1
#define REP_PRO 1
#define REP_TOK 1
#define MOE2_G8 1
#ifndef G8_SPLIT
#define G8_SPLIT 0
#endif
#ifndef FUSE_LNROUTE
#define FUSE_LNROUTE 1
#endif
#ifndef ONE_LAUNCH
#define ONE_LAUNCH 1
#endif

typedef unsigned short bf16_t;
typedef short bf16x8 __attribute__((ext_vector_type(8)));
typedef float f32x4 __attribute__((ext_vector_type(4)));
typedef unsigned u32x4 __attribute__((ext_vector_type(4)));
typedef unsigned u32x2 __attribute__((ext_vector_type(2)));
#define LAS __attribute__((address_space(3)))
#define GAS __attribute__((address_space(1)))

constexpr int T = 16384, SEQ = 2048;
constexpr int NPAD = 2560;
constexpr int CAP = 16384;
constexpr int RBR = 256;
constexpr int MAXRB = 512 + 64 + 64;
constexpr int MAXROWS = MAXRB * RBR;
constexpr float ALPHA = 1.681792830507429f;
constexpr int PPL = 12;
constexpr int NPH = 1 + 4 * PPL;
constexpr int NT = 512, NW = 8;
constexpr int HALF_LDS = 65536 + 64 + 1024;
constexpr int LDS_BLK = 2 * HALF_LDS;
constexpr int DYN_LDS = LDS_BLK + 64 + 1024 + 2560;

constexpr size_t cmax(size_t a, size_t b) { return a > b ? a : b; }
constexpr size_t WS_CTL = 0;
constexpr size_t CTL_BYTES = 65536;
constexpr size_t WS_WIN = WS_CTL + CTL_BYTES;
constexpr size_t WIN_ELEMS = (size_t)NPAD * 1024;
constexpr size_t WS_WQB = WS_WIN + 4 * WIN_ELEMS * 2;
constexpr size_t WQB_ELEMS = 768 * 256;
constexpr size_t WS_WKVB = WS_WQB + 2 * WQB_ELEMS * 2;
constexpr size_t WKVB_ELEMS = 1024 * 128;
constexpr size_t WS_WOUT = WS_WKVB + 2 * WKVB_ELEMS * 2;
constexpr size_t WOUT_ELEMS = 1024 * 1024;
constexpr size_t WS_WRT = WS_WOUT + 4 * WOUT_ELEMS * 2;
constexpr size_t WRT_ELEMS = 128 * 1024;
constexpr size_t WS_WGU = WS_WRT + 4 * WRT_ELEMS * 2;
constexpr size_t WGU_ELEMS = 512 * 1024;
constexpr size_t WS_WDN = WS_WGU + 4 * 65 * WGU_ELEMS * 2;
constexpr size_t WDN_ELEMS = 1024 * 256;
constexpr size_t WS_ROPEM = WS_WDN + 4 * 65 * WDN_ELEMS * 2;
constexpr size_t WS_ROPES = WS_ROPEM + (size_t)T * 16 * 2 * 4;
constexpr size_t WS_X1 = WS_ROPES + (size_t)T * 32 * 2 * 4;
constexpr size_t WS_XBF = WS_X1 + (size_t)T * 1024 * 4;
constexpr size_t WS_HBUF = WS_XBF + (size_t)T * 1024 * 2;
constexpr size_t WS_LOG = WS_HBUF + (size_t)MAXROWS * 256 * 2;
constexpr size_t WS_ASG = WS_LOG + (size_t)T * 64 * 4;
constexpr size_t WS_ASGW = WS_ASG + (size_t)T * 8 * 4;
constexpr size_t WS_LTOK = WS_ASGW + (size_t)T * 8 * 4;
constexpr size_t WS_LW = WS_LTOK + (size_t)65 * CAP * 4;
constexpr size_t WS_U = WS_LW + (size_t)65 * CAP * 4;
constexpr size_t U_Y = WS_U;
constexpr size_t U_PROJ = WS_U;
constexpr size_t U_GATES = U_PROJ + (size_t)T * NPAD * 2;
constexpr size_t U_CQ = U_GATES + (size_t)T * 8 * 4;
constexpr size_t U_CKV = U_CQ + (size_t)T * 256 * 2;
constexpr size_t U_KROPE = U_CKV + (size_t)T * 128 * 2;
constexpr size_t U_QF = U_KROPE + (size_t)T * 32 * 2;
constexpr size_t U_KN = U_QF + (size_t)T * 768 * 2;
constexpr size_t U_VV = U_KN + (size_t)T * 512 * 2;
constexpr size_t U_GQ = U_VV + (size_t)T * 512 * 2;
constexpr size_t U_GK = U_GQ + (size_t)T * 512 * 2;
constexpr size_t U_GV = U_GK + (size_t)T * 512 * 2;
constexpr size_t U_BETA = U_GV + (size_t)T * 512 * 2;
constexpr size_t U_GLOG = U_BETA + (size_t)T * 4 * 4;
constexpr size_t U_MIXO = U_GLOG + (size_t)T * 4 * 4;
constexpr size_t U_YBUF = U_MIXO + (size_t)T * 1024 * 2;
constexpr size_t U_END1 = U_YBUF + (size_t)T * 1024 * 4;
constexpr size_t WS_END = WS_U + cmax((size_t)MAXROWS * 1024 * 2, U_END1 - WS_U);

constexpr int CW_CNT = 4096;
constexpr int CW_WORK = 8192;

#define XB_TMO      128
#define XB_XCNT(j)  (256  + 64 * (j))
#define XB_XSUB(j)  (1280 + 64 * (j))
#define XB_XGEN(j)  (2304 + 64 * (j))
#define XB_TOP      3328
#define XB_TOPGEN   3392
#define XCD_BAR_WORDS 3456
#define XB_SPIN_CAP (1u << 18)

__device__ __forceinline__ unsigned xb_ld(unsigned* p)              { return __hip_atomic_load(p, __ATOMIC_RELAXED, __HIP_MEMORY_SCOPE_AGENT); }
__device__ __forceinline__ int lane_id_v() { int l; asm volatile("v_mbcnt_lo_u32_b32 %0, -1, 0\n\tv_mbcnt_hi_u32_b32 %0, -1, %0" : "=v"(l)); return l; }
__device__ __forceinline__ unsigned xb_add(unsigned* p, unsigned v) { return __hip_atomic_fetch_add(p, v, __ATOMIC_RELAXED, __HIP_MEMORY_SCOPE_AGENT); }
__device__ __forceinline__ unsigned xb_xcc_id() { return (unsigned)__builtin_amdgcn_s_getreg((3 << 11) | 20) & 0xFu; }
#define XB_SPIN(cond, bar) do { unsigned _sp = 0; while (cond) { __builtin_amdgcn_s_sleep(1); \
    if ((++_sp & 255u) == 0u) { if (xb_ld(&(bar)[XB_TMO])) break; if (_sp > XB_SPIN_CAP) { atomicAdd(&(bar)[XB_TMO], 1u); break; } } } } while (0)

struct XcdBarrier { unsigned* bar; unsigned x; volatile LAS unsigned* st; int wave; };

__device__ __forceinline__ XcdBarrier xcd_barrier_post(unsigned* bar, volatile LAS unsigned* st, int tid0) {
    XcdBarrier b; b.bar = bar; b.x = xb_xcc_id(); b.st = st; b.wave = __builtin_amdgcn_readfirstlane(tid0 >> 6);
    if (tid0 == 0) (void)xb_add(&bar[XB_XCNT(b.x)], 1u);
    return b;
}
__device__ __forceinline__ void xcd_barrier_complete(unsigned* bar, unsigned x, unsigned& nloc, unsigned& nx) {
    const unsigned G = gridDim.x * gridDim.y * gridDim.z;
    unsigned sum, cnt, mine, sp = 0u;
    for (;;) {
        sum = 0u; cnt = 0u; mine = 0u;
#pragma unroll
        for (unsigned j = 0; j < 16; ++j) { const unsigned c = xb_ld(&bar[XB_XCNT(j)]); sum += c; cnt += (c > 0u) ? 1u : 0u; mine = (j == x) ? c : mine; }
        if (sum == G) break;
        __builtin_amdgcn_s_sleep(1);
        if ((++sp & 255u) == 0u) { if (xb_ld(&bar[XB_TMO])) break; if (sp > XB_SPIN_CAP) { atomicAdd(&bar[XB_TMO], 1u); break; } }
    }
    nloc = mine > 0u ? mine : 1u; nx = cnt > 0u ? cnt : 1u;
}
__device__ __forceinline__ void xcd_barrier(const XcdBarrier& b) {
    asm volatile("s_waitcnt vmcnt(0)" ::: "memory");
    __syncthreads();
    if (b.wave == 0 && lane_id_v() == 0) {
        unsigned* bar = b.bar; unsigned bx = __builtin_amdgcn_readfirstlane(b.x);
        asm volatile("" : "+s"(bar), "+s"(bx));
        __builtin_amdgcn_s_waitcnt(0);
        unsigned nloc = b.st[0], nx = b.st[1];
        if (nloc == 0u) { xcd_barrier_complete(bar, bx, nloc, nx); b.st[0] = nloc; b.st[1] = nx; }
        const unsigned old = xb_add(&bar[XB_XSUB(bx)], 1u);
        const unsigned gen = old / nloc;
        if (old + 1u == (gen + 1u) * nloc) {
            __builtin_amdgcn_fence(__ATOMIC_RELEASE, "agent");
            asm volatile("s_waitcnt vmcnt(0)" ::: "memory");
            const unsigned og = xb_add(&bar[XB_TOP], 1u);
            const unsigned tg = og / nx;
            if (og + 1u == (tg + 1u) * nx) xb_add(&bar[XB_TOPGEN], 1u);
            else XB_SPIN(xb_ld(&bar[XB_TOPGEN]) == tg, bar);
            __builtin_amdgcn_fence(__ATOMIC_ACQUIRE, "agent");
            xb_add(&bar[XB_XGEN(bx)], 1u);
            asm volatile("s_waitcnt vmcnt(0)" ::: "memory");
        } else {
            XB_SPIN(xb_ld(&bar[XB_XGEN(bx)]) == gen, bar);
            __builtin_amdgcn_fence(__ATOMIC_ACQUIRE, "agent");
            asm volatile("s_waitcnt vmcnt(0)" ::: "memory");
        }
    }
    __syncthreads();
}

__device__ __forceinline__ float bf2f(unsigned v) { return __uint_as_float(v << 16); }
__device__ __forceinline__ float bflo(unsigned w) { return __uint_as_float(w << 16); }
__device__ __forceinline__ float bfhi(unsigned w) { return __uint_as_float(w & 0xffff0000u); }
__device__ __forceinline__ unsigned f2bf(float f) { unsigned u = __float_as_uint(f); u += 0x7fffu + ((u >> 16) & 1u); return u >> 16; }
__device__ __forceinline__ unsigned pk2(float lo, float hi) { return f2bf(lo) | (f2bf(hi) << 16); }
__device__ __forceinline__ unsigned cvt_pk(float lo, float hi) { unsigned r; asm volatile("v_cvt_pk_bf16_f32 %0, %1, %2" : "=v"(r) : "v"(lo), "v"(hi)); return r; }
template <class T> __device__ __forceinline__ T shfl_xor_(T v, int o) { return __builtin_bit_cast(T, __builtin_amdgcn_ds_bpermute((lane_id_v() ^ o) << 2, __builtin_bit_cast(int, v))); }
template <class T> __device__ __forceinline__ T shfl_up_(T v, int o) { const int l = lane_id_v(), s = (l - o < 0) ? l : l - o; return __builtin_bit_cast(T, __builtin_amdgcn_ds_bpermute(s << 2, __builtin_bit_cast(int, v))); }
template <class T> __device__ __forceinline__ T shfl_c_(T v, int src  ) { return __builtin_bit_cast(T, __builtin_amdgcn_readlane(__builtin_bit_cast(int, v), src)); }
__device__ __forceinline__ float wave_sum(float v) {
#pragma unroll
    for (int o = 32; o > 0; o >>= 1) v += shfl_xor_(v, o);
    return v;
}
__device__ __forceinline__ float sigmoidf_(float x) { return 1.f / (1.f + expf(-x)); }
__device__ __forceinline__ float siluf_(float x) { return x / (1.f + expf(-x)); }
__device__ __forceinline__ float softplusf_(float x) { return x > 20.f ? x : log1pf(expf(x)); }
__device__ __forceinline__ void glds16(const void* g, void* l) {
    __builtin_amdgcn_global_load_lds((const GAS unsigned*)g, (LAS unsigned*)l, 16, 0, 0);
}
__device__ __forceinline__ void unpack8(const u32x4 r, float (&f)[8]) {
    f[0] = bflo(r.x); f[1] = bfhi(r.x); f[2] = bflo(r.y); f[3] = bfhi(r.y);
    f[4] = bflo(r.z); f[5] = bfhi(r.z); f[6] = bflo(r.w); f[7] = bfhi(r.w);
}

struct Args {
    const void* in[30];
    float* out;
    unsigned char* ws;
    int ph_lo, ph_hi, use_bar, pad;
};

struct Ctx { int tid, lane, wid, wr, wc, fr, fq, bid, nblk; unsigned char* smem; int half, tid0; unsigned char* smem0; };

#define WAIT_V(n) asm volatile("s_waitcnt vmcnt(" #n ")" ::: "memory")
__device__ __forceinline__ void gemm_tile(const bf16_t* a0, const bf16_t* a1, const bf16_t* b0, const bf16_t* b1,
                                          int nk, f32x4 (&acc)[4][4], const Ctx& c) {
#pragma unroll
    for (int m = 0; m < 4; ++m)
#pragma unroll
        for (int n = 0; n < 4; ++n) acc[m][n] = (f32x4){0.f, 0.f, 0.f, 0.f};
    unsigned char* smem = c.smem;
    const int sb = c.tid * 16;
    const int kofs = ((c.tid & 3) ^ ((c.tid >> 4) & 3)) * 8;
    a0 += kofs; a1 += kofs; b0 += kofs; b1 += kofs;
#define G_STAGE(kt_) do { unsigned char* sp_ = smem + ((kt_) & 3) * 16384 + sb; const int ko_ = (kt_) * 32; \
        glds16(a0 + ko_, sp_); glds16(a1 + ko_, sp_ + 4096); glds16(b0 + ko_, sp_ + 8192); glds16(b1 + ko_, sp_ + 12288); } while (0)
#define G_READ(kt_, AF, BF) do { const unsigned char* sa_ = smem + ((kt_) & 3) * 16384 + c.wr * 4096 + roff; const unsigned char* sb_ = smem + ((kt_) & 3) * 16384 + 8192 + c.wc * 4096 + roff; \
        _Pragma("unroll") for (int m = 0; m < 4; ++m) AF[m] = *(const bf16x8*)(sa_ + m * 1024); \
        _Pragma("unroll") for (int n = 0; n < 4; ++n) BF[n] = *(const bf16x8*)(sb_ + n * 1024); } while (0)
#define G_MMA(AF, BF) do { __builtin_amdgcn_s_setprio(1); \
        _Pragma("unroll") for (int m = 0; m < 4; ++m) _Pragma("unroll") for (int n = 0; n < 4; ++n) acc[m][n] = __builtin_amdgcn_mfma_f32_16x16x32_bf16(BF[n], AF[m], acc[m][n], 0, 0, 0); \
        __builtin_amdgcn_s_setprio(0); } while (0)
#define G_BAR() do { asm volatile("" ::: "memory"); __builtin_amdgcn_s_barrier(); asm volatile("" ::: "memory"); } while (0)
    const int roff = (c.fr * 64) + ((c.fq ^ ((c.fr >> 2) & 3)) * 16);
    WAIT_V(0);
    G_STAGE(0); G_STAGE(1); G_STAGE(2); G_STAGE(3);
    bf16x8 fa0[4], fb0[4], fa1[4], fb1[4];
    WAIT_V(12); G_BAR();
    G_READ(0, fa0, fb0);
#define G_LGK0() asm volatile("s_waitcnt lgkmcnt(0)" ::: "memory")
    int kt = 0;
    for (; kt < nk - 4; kt += 4) {
        G_LGK0(); WAIT_V(8); G_BAR(); G_STAGE(kt + 4); G_READ(1, fa1, fb1); G_MMA(fa0, fb0);
        G_LGK0(); WAIT_V(8); G_BAR(); G_STAGE(kt + 5); G_READ(2, fa0, fb0); G_MMA(fa1, fb1);
        G_LGK0(); WAIT_V(8); G_BAR(); G_STAGE(kt + 6); G_READ(3, fa1, fb1); G_MMA(fa0, fb0);
        G_LGK0(); WAIT_V(8); G_BAR(); G_STAGE(kt + 7); G_READ(0, fa0, fb0); G_MMA(fa1, fb1);
    }
    G_LGK0(); WAIT_V(8); G_BAR(); G_READ(1, fa1, fb1); G_MMA(fa0, fb0);
    G_LGK0(); WAIT_V(4); G_BAR(); G_READ(2, fa0, fb0); G_MMA(fa1, fb1);
    G_LGK0(); WAIT_V(0); G_BAR(); G_READ(3, fa1, fb1); G_MMA(fa0, fb0);
    G_MMA(fa1, fb1);
#undef G_LGK0
#undef G_STAGE
#undef G_READ
#undef G_MMA
#undef G_BAR
    __syncthreads();
}

namespace g8 {
constexpr int BM = 256, BK = 64, HALF = 128, HTB = HALF * BK * 2, STAGE_BYTES = 8 * HTB;
__device__ __forceinline__ int lds_byte(int r, int c) { const int st = (r >> 4) * 2 + (c >> 5), rr = r & 15, cc = c & 31, ob = rr * 64 + cc * 2; return st * 1024 + (ob ^ (((ob >> 9) & 1) << 5)); }
__device__ __forceinline__ void stage_rc(int b, int& R, int& C) { const int st = b / 1024, sb = b % 1024, swz = sb ^ (((sb >> 9) & 1) << 5); R = (st >> 1) * 16 + swz / 64; C = (st & 1) * 32 + (swz % 64) / 2; }
__device__ __forceinline__ int perm32(int rho) { const int n = rho >> 4, i = rho & 15; return 8 * (i >> 2) + 4 * n + (i & 3); }
struct Unit { int pm, pn, bt; };

template <bool PERM, bool GATHER, class Sched, class Epi>
__device__ __forceinline__ void phase(unsigned char* ldsp, const char* Abase, const char* Bbase, int K, const Sched& S, const Epi& E, int tid_in) {
    LAS unsigned char* lds = (LAS unsigned char*)ldsp;
    int tid = tid_in; asm volatile("" : "+v"(tid));
    const int wid = __builtin_amdgcn_readfirstlane(tid >> 6), lane = tid & 63, wr = wid >> 2, wc = wid & 3, fr = lane & 15, fq = lane >> 4;
    const int nt = K / BK;
    unsigned voffA[2], voffB[2];
#pragma unroll
    for (int i = 0; i < 2; ++i) { int R, C; stage_rc(tid * 16 + i * 8192, R, C); const int Rb = PERM ? ((R >> 5) * 64 + perm32(R & 31)) : R;
        voffA[i] = (unsigned)(R * K + C) * 2u; voffB[i] = (unsigned)(Rb * K + C) * 2u; }
    const size_t kstep = (size_t)(BK * 2);
    const size_t hstep = (size_t)HALF * K * 2, tstep = 2 * hstep, bhstep = PERM ? (size_t)32 * K * 2 : hstep;
    const unsigned ldsw = (unsigned)wid * 1024u;
    const int aoff = lds_byte(wr * 64 + fr, fq * 8), boff = lds_byte(wc * 32 + fr, fq * 8);
#define G8_SA(b, h) (((b) * 2 + (h)) * HTB)
#define G8_SB(b, h) ((4 + (b) * 2 + (h)) * HTB)
#define G8_DMA(gptr, voff32, ldsoff) do { const char* _gp = (gptr); const unsigned _lo = (unsigned)(size_t)(ldsp) + (unsigned)(ldsoff); \
        asm volatile("s_mov_b32 m0, %2\n\ts_nop 0\n\tglobal_load_lds_dwordx4 %0, %1" :: "v"(voff32), "s"(_gp), "s"(_lo) : "memory", "m0"); } while (0)
#define G8_STAGE(bufoff, gbase, voff) do { _Pragma("unroll") for (int _i = 0; _i < 2; ++_i) G8_DMA((const char*)(gbase), (voff)[_i], (bufoff) + ldsw + _i * 8192); } while (0)
#define G8_STAGEA(bufoff, gbase, h, kb) do { if constexpr (GATHER) { _Pragma("unroll") for (int _i = 0; _i < 2; ++_i) G8_DMA(Abase + (kb), vA[2 * (h) + _i], (bufoff) + ldsw + _i * 8192); } \
        else G8_STAGE(bufoff, (gbase) + (size_t)(h) * hstep + (kb), voffA); } while (0)
#define G8_LDA(dst, b, h) do { _Pragma("unroll") for (int m = 0; m < 4; ++m) _Pragma("unroll") for (int k = 0; k < 2; ++k) dst[m][k] = *(const LAS bf16x8*)(lds + G8_SA(b, h) + aoff + m * 2048 + k * 1024); } while (0)
#define G8_LDB(dst, b, h) do { _Pragma("unroll") for (int n = 0; n < 2; ++n) _Pragma("unroll") for (int k = 0; k < 2; ++k) dst[n][k] = *(const LAS bf16x8*)(lds + G8_SB(b, h) + boff + n * 2048 + k * 1024); } while (0)
#define G8_MMA(ai, bj, At, Bt) do { __builtin_amdgcn_s_setprio(1); _Pragma("unroll") for (int m = 0; m < 4; ++m) _Pragma("unroll") for (int n = 0; n < 2; ++n) _Pragma("unroll") for (int k = 0; k < 2; ++k) \
        acc[ai][bj][m][n] = __builtin_amdgcn_mfma_f32_16x16x32_bf16(Bt[n][k], At[m][k], acc[ai][bj][m][n], 0, 0, 0); __builtin_amdgcn_s_setprio(0); } while (0)
#define G8_WAIT_V(n) asm volatile("s_waitcnt vmcnt(" #n ")" ::: "memory")
#define G8_WAIT_L(n) asm volatile("s_waitcnt lgkmcnt(" #n ")" ::: "memory")
#define G8_BAR __builtin_amdgcn_s_barrier()
#define G8_SCHED __builtin_amdgcn_sched_barrier(0)
    Unit cur, nxt; int ui = 0;
    if (!S.next(0, cur)) return;
    f32x4 acc[2][2][4][2];
#pragma unroll
    for (int a = 0; a < 2; ++a)
#pragma unroll
        for (int b = 0; b < 2; ++b)
#pragma unroll
            for (int m = 0; m < 4; ++m)
#pragma unroll
                for (int n = 0; n < 2; ++n) acc[a][b][m][n] = (f32x4){0.f, 0.f, 0.f, 0.f};
    bf16x8 At[4][2], B0[2][2], B1[2][2];
    const char* cA = Abase + (size_t)cur.pm * tstep; const char* cB = Bbase + (size_t)cur.bt * tstep;
    unsigned vA[4] = {0u, 0u, 0u, 0u};
    if constexpr (GATHER) S.aoff(cur, tid, vA);
    asm volatile("s_waitcnt vmcnt(0)" ::: "memory");
    G8_STAGE(G8_SB(0, 0), cB, voffB); G8_STAGEA(G8_SA(0, 0), cA, 0, 0); G8_STAGE(G8_SB(0, 1), cB + bhstep, voffB); G8_STAGEA(G8_SA(0, 1), cA, 1, 0);
    if (wr == 1) G8_BAR;
    G8_WAIT_V(4); G8_BAR;
    G8_STAGE(G8_SB(1, 0), cB + kstep, voffB); G8_STAGEA(G8_SA(1, 0), cA, 0, kstep); G8_STAGE(G8_SB(1, 1), cB + bhstep + kstep, voffB);
    G8_WAIT_V(6); G8_BAR;
    G8_STAGEA(G8_SA(1, 1), cA, 1, kstep);
    for (;;) {
        const bool has_next = S.next(ui + 1, nxt);
        const char* nA = has_next ? Abase + (size_t)nxt.pm * tstep : cA; const char* nB = has_next ? Bbase + (size_t)nxt.bt * tstep : cB;
        for (int t = 0; t < nt; t += 2) {
            const bool last = (t == nt - 2);
            const int lastf = __builtin_amdgcn_readfirstlane(last ? 1 : 0);
            const size_t k2 = last ? 0 : (size_t)(t + 2) * kstep, k3 = k2 + kstep;
            const char* a2 = last ? nA : cA; const char* b2 = last ? nB : cB + (size_t)(t + 2) * kstep;
            const char* b3 = b2 + kstep;
            G8_LDB(B0, 0, 0); G8_SCHED; G8_LDA(At, 0, 0);
            if constexpr (GATHER) { if (last && has_next) S.aoff(nxt, tid, vA); }
            G8_WAIT_L(8); G8_BAR; G8_WAIT_L(0); G8_MMA(0, 0, At, B0); G8_BAR; G8_SCHED;
            G8_LDB(B1, 0, 1); G8_STAGE(G8_SB(0, 0), b2, voffB);
            G8_BAR; G8_WAIT_L(0); G8_MMA(0, 1, At, B1); G8_BAR;
            G8_LDA(At, 0, 1); G8_STAGEA(G8_SA(0, 0), a2, 0, k2);
            G8_BAR; G8_WAIT_L(0); G8_MMA(1, 0, At, B0); G8_BAR; G8_SCHED;
            G8_STAGE(G8_SB(0, 1), b2 + bhstep, voffB);
            const int pend = __builtin_amdgcn_readfirstlane((t == 0 && ui > 0) ? 1 : 0);
            asm volatile("s_cmp_lg_u32 %0, 0\n\ts_cbranch_scc1 1f\n\ts_waitcnt vmcnt(6)\n1:\n\ts_waitcnt vmcnt(%1)" :: "s"(pend), "n"(6 + (Epi::SPLIT ? Epi::NQ : Epi::NST)) : "memory", "scc");
            G8_BAR; G8_MMA(1, 1, At, B1); G8_BAR;
            G8_LDB(B0, 1, 0); G8_SCHED; G8_LDA(At, 1, 0); G8_STAGEA(G8_SA(0, 1), a2, 1, k2);
            G8_WAIT_L(8); G8_BAR; G8_WAIT_L(0); G8_MMA(0, 0, At, B0); G8_BAR; G8_SCHED;
            if constexpr (Epi::SPLIT) { E.template part_cond<0, 0>(acc, cur, wr, wc, fr, fq, lastf); G8_SCHED; }
            G8_LDB(B1, 1, 1); G8_STAGE(G8_SB(1, 0), b3, voffB);
            G8_BAR; G8_WAIT_L(0); G8_MMA(0, 1, At, B1); G8_BAR;
            if constexpr (Epi::SPLIT) { E.template part_cond<0, 1>(acc, cur, wr, wc, fr, fq, lastf); G8_SCHED; }
            G8_LDA(At, 1, 1); G8_STAGEA(G8_SA(1, 0), a2, 0, k3);
            G8_BAR; G8_WAIT_L(0); G8_MMA(1, 0, At, B0); G8_BAR; G8_SCHED;
            G8_STAGE(G8_SB(1, 1), b3 + bhstep, voffB);
            if constexpr (Epi::SPLIT) {
                asm volatile("s_cmp_lg_u32 %0, 0\n\ts_cbranch_scc1 1f\n\ts_waitcnt vmcnt(6)\n1:\n\ts_waitcnt vmcnt(%1)" :: "s"(lastf), "n"(6 + 2 * Epi::NQ) : "memory", "scc");
                G8_SCHED; E.template part_cond<1, 0>(acc, cur, wr, wc, fr, fq, lastf); G8_SCHED;
            } else G8_WAIT_V(6);
            G8_BAR; G8_MMA(1, 1, At, B1); G8_BAR;
            G8_STAGEA(G8_SA(1, 1), a2, 1, k3);
        }
        if constexpr (Epi::SPLIT) E.tail(acc, cur, wr, wc, fr, fq); else E(acc, cur, wr, wc, fr, fq);
        if (!has_next) break;
#pragma unroll
        for (int a = 0; a < 2; ++a)
#pragma unroll
            for (int b = 0; b < 2; ++b)
#pragma unroll
                for (int m = 0; m < 4; ++m)
#pragma unroll
                    for (int n = 0; n < 2; ++n) acc[a][b][m][n] = (f32x4){0.f, 0.f, 0.f, 0.f};
        cur = nxt; cA = nA; cB = nB; ++ui;
    }
    G8_WAIT_V(0);
    if (wr == 0) G8_BAR;
    G8_BAR;
#undef G8_SA
#undef G8_SB
#undef G8_STAGE
#undef G8_STAGEA
#undef G8_LDA
#undef G8_LDB
#undef G8_MMA
#undef G8_WAIT_V
#undef G8_WAIT_L
#undef G8_BAR
#undef G8_SCHED
}
}

__device__ __forceinline__ bool tile_map(int i, const Ctx& c, int ntm, int ntn, int& mt, int& nt) {
    const int vb = ((c.nblk & 15) == 0) ? ((c.bid >> 1) & 7) * (c.nblk >> 3) + (((c.bid >> 4) << 1) | (c.bid & 1)) : c.bid;
    const int L = i * c.nblk + vb;
    if (L >= ntm * ntn) return false;
    const int g = L / (8 * ntn), rem = L - g * 8 * ntn;
    const int gsz = (ntm - g * 8) < 8 ? (ntm - g * 8) : 8;
    mt = g * 8 + rem % gsz; nt = rem / gsz;
    return true;
}

__device__ __forceinline__ bool tile_map2(int i, const Ctx& c, int ntm, int ntn, int& mt, int& nt, bool& valid) {
    Ctx o = c; o.bid = c.bid ^ 1;
    int mo, no; const bool oko = tile_map(i, o, ntm, ntn, mo, no);
    valid = tile_map(i, c, ntm, ntn, mt, nt);
    if (!valid) { mt = 0; nt = 0; }
    return valid || oko;
}

struct DenseSched {
    int ntm, ntn, K, bid, nblk;
    __device__ __forceinline__ bool next(int i, g8::Unit& u) const {
        const int vb = ((nblk & 7) == 0) ? (bid & 7) * (nblk >> 3) + (bid >> 3) : bid;
        const int L = i * nblk + vb;
        if (L >= ntm * ntn) return false;
        const int g = L / (8 * ntn), rem = L - g * 8 * ntn;
        const int gsz = (ntm - g * 8) < 8 ? (ntm - g * 8) : 8;
        u.pm = g * 8 + rem % gsz; u.pn = rem / gsz; u.bt = u.pn;
        return true;
    }
};
struct MoeSched {
    int nrb, ntn, bid, nblk; const int* eb;
    __device__ __forceinline__ bool next(int i, g8::Unit& u) const {
        const int vb = ((nblk & 7) == 0) ? (bid & 7) * (nblk >> 3) + (bid >> 3) : bid;
        const int L = i * nblk + vb;
        if (L >= nrb * ntn) return false;
        const int g = L / (8 * ntn), rem = L - g * 8 * ntn;
        const int gsz = (nrb - g * 8) < 8 ? (nrb - g * 8) : 8;
        u.pm = g * 8 + rem % gsz; u.pn = rem / gsz;
        u.bt = __builtin_amdgcn_readfirstlane(eb[u.pm]) * ntn + u.pn;
        return true;
    }
};
struct MoeSchedG {
    int nrb, bid, nblk; const int* eb; const int* bst; const int* LTOK;
    __device__ __forceinline__ bool next(int i, g8::Unit& u) const {
        const int vb = ((nblk & 7) == 0) ? (bid & 7) * (nblk >> 3) + (bid >> 3) : bid;
        const int L = i * nblk + vb;
        if (L >= nrb * 2) return false;
        const int g = L >> 4, rem = L & 15;
        const int gsz = (nrb - g * 8) < 8 ? (nrb - g * 8) : 8;
        u.pm = g * 8 + rem % gsz; u.pn = rem / gsz;
        u.bt = __builtin_amdgcn_readfirstlane(eb[u.pm]) * 2 + u.pn;
        return true;
    }
    __device__ __forceinline__ void aoff(const g8::Unit& u, int tid, unsigned (&o)[4]) const {
        const int e = eb[u.pm], lb = u.pm - bst[e], cnt = bst[66 + e];
        int R0, C0, R1, C1; g8::stage_rc(tid * 16, R0, C0); g8::stage_rc(tid * 16 + 8192, R1, C1);
        const int* lt = LTOK + (size_t)e * CAP + lb * RBR;
        const int p00 = R0, p01 = R1, p10 = 128 + R0, p11 = 128 + R1;
        const int t00 = (lb * RBR + p00 < cnt) ? lt[p00] : 0, t01 = (lb * RBR + p01 < cnt) ? lt[p01] : 0;
        const int t10 = (lb * RBR + p10 < cnt) ? lt[p10] : 0, t11 = (lb * RBR + p11 < cnt) ? lt[p11] : 0;
        o[0] = (unsigned)t00 * 2048u + (unsigned)C0 * 2u; o[1] = (unsigned)t01 * 2048u + (unsigned)C1 * 2u;
        o[2] = (unsigned)t10 * 2048u + (unsigned)C0 * 2u; o[3] = (unsigned)t11 * 2048u + (unsigned)C1 * 2u;
    }
};
struct EpiMoe1 {
    static constexpr bool SPLIT = false; static constexpr int NQ = 4, NST = 16;
    bf16_t* H;
    __device__ __forceinline__ void operator()(const f32x4 (&acc)[2][2][4][2], const g8::Unit& u, int wr, int wc, int fr, int fq) const {
#pragma unroll
        for (int ai = 0; ai < 2; ++ai)
#pragma unroll
            for (int m = 0; m < 4; ++m) {
                const size_t row = (size_t)u.pm * RBR + ai * 128 + wr * 64 + m * 16 + fr;
#pragma unroll
                for (int bj = 0; bj < 2; ++bj) {
                    const int hc = (u.pn * 8 + bj * 4 + wc) * 16 + fq * 4;
                    const f32x4 g = acc[ai][bj][m][0], up = acc[ai][bj][m][1];
                    float h[4];
#pragma unroll
                    for (int j = 0; j < 4; ++j) h[j] = g[j] * __builtin_amdgcn_rcpf(1.f + __expf(-g[j])) * up[j];
                    *(u32x2*)(H + row * 256 + hc) = (u32x2){cvt_pk(h[0], h[1]), cvt_pk(h[2], h[3])};
                }
            }
    }
    template <int ai, int bj> __device__ __forceinline__ void part_cond(const f32x4 (&acc)[2][2][4][2], const g8::Unit& u, int wr, int wc, int fr, int fq, int flag) const {}
    __device__ __forceinline__ void tail(const f32x4 (&acc)[2][2][4][2], const g8::Unit& u, int wr, int wc, int fr, int fq) const {}
};
__device__ __forceinline__ u32x4 dpp_ror8(const u32x4 v) {
    u32x4 r;
#pragma unroll
    for (int i = 0; i < 4; ++i) r[i] = (unsigned)__builtin_amdgcn_update_dpp(0, (int)v[i], 0x128, 0xF, 0xF, true);
    return r;
}
__device__ __forceinline__ void perm_store(bf16_t* p  , size_t ld8  , const u32x4 p0, const u32x4 p1, int hi) {
    const u32x4 snd = hi ? p0 : p1, rcv = dpp_ror8(snd);
    *(u32x4*)p = hi ? rcv : p0;
    *(u32x4*)(p + ld8) = hi ? p1 : rcv;
}
struct EpiIn {
    static constexpr bool SPLIT = false; static constexpr int NQ = 4, NST = 16;
    bf16_t* P; float* G; int gbase;
    template <int ai, int bj> __device__ __forceinline__ void part_cond(const f32x4 (&acc)[2][2][4][2], const g8::Unit& u, int wr, int wc, int fr, int fq, int flag) const {}
    __device__ __forceinline__ void tail(const f32x4 (&acc)[2][2][4][2], const g8::Unit& u, int wr, int wc, int fr, int fq) const {}
    __device__ __forceinline__ void operator()(const f32x4 (&acc)[2][2][4][2], const g8::Unit& u, int wr, int wc, int fr, int fq) const {
        const int hi = fr >> 3, r8 = fr & 7;
#pragma unroll
        for (int ai = 0; ai < 2; ++ai)
#pragma unroll
            for (int m = 0; m < 4; ++m) {
                const size_t rg = (size_t)u.pm * 256 + ai * 128 + wr * 64 + m * 16;
                u32x4 pk[2];
#pragma unroll
                for (int bj = 0; bj < 2; ++bj) {
                    const f32x4 v0 = acc[ai][bj][m][0], v1 = acc[ai][bj][m][1];
                    pk[bj] = (u32x4){cvt_pk(v0[0], v0[1]), cvt_pk(v0[2], v0[3]), cvt_pk(v1[0], v1[1]), cvt_pk(v1[2], v1[3])};
                    if (u.pn * 256 + wc * 64 + bj * 32 + fq * 8 == gbase) { *(f32x4*)(G + (rg + fr) * 8) = v0; *(f32x4*)(G + (rg + fr) * 8 + 4) = v1; }
                }
                perm_store(P + (rg + r8) * NPAD + u.pn * 256 + wc * 64 + hi * 32 + fq * 8, (size_t)8 * NPAD, pk[0], pk[1], hi);
            }
    }
};
struct EpiMoe2 {
    static constexpr bool SPLIT = false; static constexpr int NQ = 4, NST = 16;
    bf16_t* Y;
    template <int ai, int bj> __device__ __forceinline__ void part_cond(const f32x4 (&acc)[2][2][4][2], const g8::Unit& u, int wr, int wc, int fr, int fq, int flag) const {}
    __device__ __forceinline__ void tail(const f32x4 (&acc)[2][2][4][2], const g8::Unit& u, int wr, int wc, int fr, int fq) const {}
    __device__ __forceinline__ void operator()(const f32x4 (&acc)[2][2][4][2], const g8::Unit& u, int wr, int wc, int fr, int fq) const {
        const int hi = fr >> 3, r8 = fr & 7;
#pragma unroll
        for (int ai = 0; ai < 2; ++ai)
#pragma unroll
            for (int m = 0; m < 4; ++m) {
                const size_t rg = (size_t)u.pm * RBR + ai * 128 + wr * 64 + m * 16;
                u32x4 pk[2];
#pragma unroll
                for (int bj = 0; bj < 2; ++bj) {
                    const f32x4 v0 = acc[ai][bj][m][0], v1 = acc[ai][bj][m][1];
                    pk[bj] = (u32x4){cvt_pk(v0[0], v0[1]), cvt_pk(v0[2], v0[3]), cvt_pk(v1[0], v1[1]), cvt_pk(v1[2], v1[3])};
                }
                perm_store(Y + (rg + r8) * 1024 + u.pn * 256 + wc * 64 + hi * 32 + fq * 8, (size_t)8 * 1024, pk[0], pk[1], hi);
            }
    }
};
struct EpiOut {
    static constexpr bool SPLIT = false; static constexpr int NQ = 8, NST = 32;
    template <int ai, int bj> __device__ __forceinline__ void part_cond(const f32x4 (&acc)[2][2][4][2], const g8::Unit& u, int wr, int wc, int fr, int fq, int flag) const {}
    __device__ __forceinline__ void tail(const f32x4 (&acc)[2][2][4][2], const g8::Unit& u, int wr, int wc, int fr, int fq) const {}
    const bf16_t* xres; bf16_t* Y;
    __device__ __forceinline__ void operator()(const f32x4 (&acc)[2][2][4][2], const g8::Unit& u, int wr, int wc, int fr, int fq) const {
        const int hi = fr >> 3, r8 = fr & 7;
#pragma unroll
        for (int ai = 0; ai < 2; ++ai)
#pragma unroll
            for (int m = 0; m < 4; ++m) {
                const size_t rg = (size_t)u.pm * 256 + ai * 128 + wr * 64 + m * 16;
                u32x4 pk[2];
#pragma unroll
                for (int bj = 0; bj < 2; ++bj) {
                    const u32x4 xr = *(const u32x4*)(xres + (rg + fr) * 1024 + u.pn * 256 + wc * 64 + bj * 32 + fq * 8);
                    float f[8]; unpack8(xr, f);
                    const f32x4 v0 = acc[ai][bj][m][0], v1 = acc[ai][bj][m][1];
                    pk[bj] = (u32x4){cvt_pk(f[0] * ALPHA + v0[0], f[1] * ALPHA + v0[1]), cvt_pk(f[2] * ALPHA + v0[2], f[3] * ALPHA + v0[3]),
                                     cvt_pk(f[4] * ALPHA + v1[0], f[5] * ALPHA + v1[1]), cvt_pk(f[6] * ALPHA + v1[2], f[7] * ALPHA + v1[3])};
                }
                perm_store(Y + (rg + r8) * 1024 + u.pn * 256 + wc * 64 + hi * 32 + fq * 8, (size_t)8 * 1024, pk[0], pk[1], hi);
                asm volatile("" ::: "memory");
            }
    }
};

constexpr int TS_RS = 272;
__device__ __forceinline__ void tile_put(const Ctx& c, int row_l, int col_l, const u32x2 v) { *(u32x2*)(c.smem + row_l * TS_RS + col_l * 2) = v; }
template <int NCOL>
__device__ __forceinline__ void tile_flush(const Ctx& c, bf16_t* out, size_t ld, bool valid) {
    __syncthreads();
    constexpr int CPR = NCOL / 8, PER = (128 * CPR) / 256;
#pragma unroll
    for (int i = 0; i < PER; ++i) {
        const int idx = c.tid + 256 * i, row = idx / CPR, ch = idx % CPR;
        const u32x4 v = *(const u32x4*)(c.smem + row * TS_RS + ch * 16);
        if (valid) *(u32x4*)(out + (size_t)row * ld + ch * 8) = v;
    }
    __syncthreads();
}

__device__ __forceinline__ void conv_family(const float* src, int nmat, size_t src_stride, int K, int N, int Nout,
                            bf16_t* dst, size_t dst_stride, int grp, int kind, const Ctx& c) {
    float* lds = (float*)c.smem;
    const int tk = K / 128, tn = Nout / 64, per = tk * tn, total = nmat * per;
    const int tx = c.tid & 15, ty = c.tid >> 4;
    f32x4 r[8];
#define CV_LOAD(u_) do { const int mat_ = (u_) / per, r_ = (u_) - mat_ * per, kt_ = r_ / tn, nt_ = r_ - kt_ * tn; \
        const float* s_ = src + (size_t)mat_ * src_stride + (size_t)(kt_ * 128 + ty) * N + nt_ * 64 + tx * 4; const bool in_ = (nt_ * 64 + tx * 4) < N; \
        _Pragma("unroll") for (int i = 0; i < 8; ++i) r[i] = in_ ? *(const f32x4*)(s_ + (size_t)(16 * i) * N) : (f32x4){0.f, 0.f, 0.f, 0.f}; } while (0)
    if (c.bid < total) CV_LOAD(c.bid);
    for (int base = 0; base < total; base += c.nblk) {
        const int u = base + c.bid; const bool valid = u < total;
#pragma unroll
        for (int i = 0; i < 8; ++i) *(f32x4*)(lds + (ty + 16 * i) * 68 + tx * 4) = r[i];
        if (u + c.nblk < total) CV_LOAD(u + c.nblk);
        __syncthreads();
        if (valid) {
        const int mat = u / per, rr = u - mat * per, kt = rr / tn, nt = rr - kt * tn;
        const int dmat = grp ? (mat / grp) * (grp + 1) + (mat % grp) : mat;
        bf16_t* d = dst + (size_t)dmat * dst_stride;
        const int nl = c.tid & 63, kq = (c.tid >> 6) * 32;
        unsigned w[16];
#pragma unroll
        for (int j = 0; j < 16; ++j) w[j] = pk2(lds[(kq + 2 * j) * 68 + nl], lds[(kq + 2 * j + 1) * 68 + nl]);
        const int n = nt * 64 + nl;
        const int drow = (kind == 0) ? n : ((n >> 4) * 32 + (n & 15) + (kind == 2 ? 16 : 0));
        u32x4* dp = (u32x4*)(d + (size_t)drow * K + kt * 128 + kq);
        dp[0] = (u32x4){w[0], w[1], w[2], w[3]}; dp[1] = (u32x4){w[4], w[5], w[6], w[7]};
        dp[2] = (u32x4){w[8], w[9], w[10], w[11]}; dp[3] = (u32x4){w[12], w[13], w[14], w[15]};
        }
        __syncthreads();
    }
#undef CV_LOAD
}

__device__ __forceinline__ void phase_prologue(const Args& a, const Ctx& c) {
    unsigned char* ws = a.ws;
    bf16_t* WIN = (bf16_t*)(ws + WS_WIN);
    conv_family((const float*)a.in[2], 2, (size_t)1024 * 2472, 1024, 2472, NPAD, WIN, 2 * WIN_ELEMS, 0, 0, c);
    conv_family((const float*)a.in[12], 2, (size_t)1024 * 2312, 1024, 2312, NPAD, WIN + WIN_ELEMS, 2 * WIN_ELEMS, 0, 0, c);
    conv_family((const float*)a.in[4], 2, (size_t)256 * 768, 256, 768, 768, (bf16_t*)(ws + WS_WQB), WQB_ELEMS, 0, 0, c);
    conv_family((const float*)a.in[6], 2, (size_t)128 * 1024, 128, 1024, 1024, (bf16_t*)(ws + WS_WKVB), WKVB_ELEMS, 0, 0, c);
    bf16_t* WOUT = (bf16_t*)(ws + WS_WOUT);
    conv_family((const float*)a.in[11], 2, (size_t)1024 * 1024, 1024, 1024, 1024, WOUT, 2 * WOUT_ELEMS, 0, 0, c);
    conv_family((const float*)a.in[17], 2, (size_t)1024 * 1024, 1024, 1024, 1024, WOUT + WOUT_ELEMS, 2 * WOUT_ELEMS, 0, 0, c);
    conv_family((const float*)a.in[20], 4, (size_t)1024 * 64, 1024, 64, 128, (bf16_t*)(ws + WS_WRT), WRT_ELEMS, 0, 0, c);
    bf16_t* WGU = (bf16_t*)(ws + WS_WGU);
    conv_family((const float*)a.in[22], 256, (size_t)1024 * 256, 1024, 256, 256, WGU, WGU_ELEMS, 64, 1, c);
    conv_family((const float*)a.in[23], 256, (size_t)1024 * 256, 1024, 256, 256, WGU, WGU_ELEMS, 64, 2, c);
    conv_family((const float*)a.in[25], 4, (size_t)1024 * 256, 1024, 256, 256, WGU + 64 * WGU_ELEMS, 65 * WGU_ELEMS, 0, 1, c);
    conv_family((const float*)a.in[26], 4, (size_t)1024 * 256, 1024, 256, 256, WGU + 64 * WGU_ELEMS, 65 * WGU_ELEMS, 0, 2, c);
    bf16_t* WDN = (bf16_t*)(ws + WS_WDN);
    conv_family((const float*)a.in[24], 256, (size_t)256 * 1024, 256, 1024, 1024, WDN, WDN_ELEMS, 64, 0, c);
    conv_family((const float*)a.in[27], 4, (size_t)256 * 1024, 256, 1024, 1024, WDN + 64 * WDN_ELEMS, 65 * WDN_ELEMS, 0, 0, c);
    {
        const float* x = (const float*)a.in[0]; bf16_t* xb = (bf16_t*)(ws + WS_XBF);
        const size_t n8 = (size_t)T * 1024 / 8;
        for (size_t i = (size_t)c.bid * 256 + c.tid; i < n8; i += (size_t)c.nblk * 256) {
            const f32x4 v0 = *(const f32x4*)(x + i * 8), v1 = *(const f32x4*)(x + i * 8 + 4);
            *(u32x4*)(xb + i * 8) = (u32x4){pk2(v0[0], v0[1]), pk2(v0[2], v0[3]), pk2(v1[0], v1[1]), pk2(v1[2], v1[3])};
        }
    }
    {
        const int* pos = (const int*)a.in[1];
        float* rm = (float*)(ws + WS_ROPEM); float* rs = (float*)(ws + WS_ROPES);
        const float ln_theta = 9.210340371976184f;
        for (int i = c.bid * 256 + c.tid; i < T * 16; i += c.nblk * 256) {
            const int t = i >> 4, f = i & 15;
            const float inv = expf(-((float)(2 * f) / 32.f) * ln_theta);
            const float ang = (float)pos[t] * inv;
            rm[i * 2] = cosf(ang); rm[i * 2 + 1] = sinf(ang);
        }
        for (int i = c.bid * 256 + c.tid; i < T * 32; i += c.nblk * 256) {
            const int t = i >> 5, f = i & 31;
            const float inv = expf(-((float)(2 * f) / 64.f) * ln_theta);
            const float ang = (float)pos[t] * inv;
            rs[i * 2] = cosf(ang); rs[i * 2 + 1] = sinf(ang);
        }
    }
}

__device__ __forceinline__ void phase_inproj(const bf16_t* XBF, const bf16_t* W, bf16_t* PROJ, float* GATES, int gbase, const Ctx& c) {
    const int ntn = NPAD / 128;
    for (int i = 0;; ++i) {
        int mt, nt; bool valid; if (!tile_map2(i, c, T / 128, ntn, mt, nt, valid)) break;
        const bf16_t* a0 = XBF + (size_t)(mt * 128 + (c.tid >> 2)) * 1024;
        const bf16_t* b0 = W + (size_t)(nt * 128 + (c.tid >> 2)) * 1024;
        f32x4 acc[4][4];
        gemm_tile(a0, a0 + 64 * 1024, b0, b0 + 64 * 1024, 32, acc, c);
#pragma unroll
        for (int m = 0; m < 4; ++m) {
            const int rl = c.wr * 64 + m * 16 + c.fr, row = mt * 128 + rl;
#pragma unroll
            for (int n = 0; n < 4; ++n) {
                const int cl = c.wc * 64 + n * 16 + c.fq * 4, col = nt * 128 + cl;
                const f32x4 v = acc[m][n];
                tile_put(c, rl, cl, (u32x2){pk2(v[0], v[1]), pk2(v[2], v[3])});
                if (valid && col >= gbase && col < gbase + 8) *(f32x4*)(GATES + (size_t)row * 8 + (col - gbase)) = v;
            }
        }
        tile_flush<128>(c, PROJ + (size_t)mt * 128 * NPAD + nt * 128, NPAD, valid);
    }
}

constexpr int MLAUP_TILES = (T / 128) * 6 + (T / 128) * 8;
__device__ __forceinline__ void mla_up_tile(int u, const bf16_t* CQ, const bf16_t* WQB, const bf16_t* CKV, const bf16_t* WKVB,
                             const float* ROPEM, bf16_t* QF, bf16_t* KN, bf16_t* VV, const Ctx& c) {
    const int tq = (T / 128) * 6;
    const float qscale = 0.10206207261596577f * 1.4426950408889634f;
    {
        f32x4 acc[4][4];
        if (u < tq) {
            const int mt = u / 6, nt = u % 6;
            const bf16_t* a0 = CQ + (size_t)(mt * 128 + (c.tid >> 2)) * 256;
            const bf16_t* b0 = WQB + (size_t)(nt * 128 + (c.tid >> 2)) * 256;
            gemm_tile(a0, a0 + 64 * 256, b0, b0 + 64 * 256, 8, acc, c);
#pragma unroll
            for (int m = 0; m < 4; ++m) {
                const int row = mt * 128 + c.wr * 64 + m * 16 + c.fr;
#pragma unroll
                for (int np = 0; np < 2; ++np) {
                    const int cg = nt * 128 + c.wc * 64 + np * 32;
                    f32x4 v0 = acc[m][2 * np], v1 = acc[m][2 * np + 1];
                    if (((cg >> 5) % 3) == 2) {
#pragma unroll
                        for (int j = 0; j < 4; ++j) {
                            const int i = c.fq * 4 + j;
                            const float cs = ROPEM[((size_t)row * 16 + i) * 2], sn = ROPEM[((size_t)row * 16 + i) * 2 + 1];
                            const float x1 = v0[j], x2 = v1[j];
                            v0[j] = x1 * cs - x2 * sn; v1[j] = x2 * cs + x1 * sn;
                        }
                    }
                    v0 *= qscale; v1 *= qscale;
                    *(u32x2*)(QF + (size_t)row * 768 + cg + c.fq * 4) = (u32x2){pk2(v0[0], v0[1]), pk2(v0[2], v0[3])};
                    *(u32x2*)(QF + (size_t)row * 768 + cg + 16 + c.fq * 4) = (u32x2){pk2(v1[0], v1[1]), pk2(v1[2], v1[3])};
                }
            }
        } else {
            const int v = u - tq, mt = v / 8, nt = v % 8;
            const bf16_t* a0 = CKV + (size_t)(mt * 128 + (c.tid >> 2)) * 128;
            const bf16_t* b0 = WKVB + (size_t)(nt * 128 + (c.tid >> 2)) * 128;
            gemm_tile(a0, a0 + 64 * 128, b0, b0 + 64 * 128, 4, acc, c);
            bf16_t* dst = (c.wc == 0) ? KN : VV;
#pragma unroll
            for (int m = 0; m < 4; ++m) {
                const int row = mt * 128 + c.wr * 64 + m * 16 + c.fr;
#pragma unroll
                for (int n = 0; n < 4; ++n) {
                    const f32x4 x = acc[m][n];
                    *(u32x2*)(dst + (size_t)row * 512 + nt * 64 + n * 16 + c.fq * 4) = (u32x2){pk2(x[0], x[1]), pk2(x[2], x[3])};
                }
            }
        }
    }
}

__device__ __forceinline__ void phase_outproj(const bf16_t* MIXO, const bf16_t* W, const float* xres, float* YBUF, const Ctx& c) {
    for (int i = 0;; ++i) {
        int mt, nt; bool valid; if (!tile_map2(i, c, T / 128, 8, mt, nt, valid)) break;
        const bf16_t* a0 = MIXO + (size_t)(mt * 128 + (c.tid >> 2)) * 1024;
        const bf16_t* b0 = W + (size_t)(nt * 128 + (c.tid >> 2)) * 1024;
        f32x4 acc[4][4];
        gemm_tile(a0, a0 + 64 * 1024, b0, b0 + 64 * 1024, 32, acc, c);
#pragma unroll
        for (int m = 0; m < 4; ++m) {
            const int row = mt * 128 + c.wr * 64 + m * 16 + c.fr;
#pragma unroll
            for (int n = 0; n < 4; ++n) {
                const int col = nt * 128 + c.wc * 64 + n * 16 + c.fq * 4;
                const f32x4 xr = *(const f32x4*)(xres + (size_t)row * 1024 + col);
                if (valid) *(f32x4*)(YBUF + (size_t)row * 1024 + col) = xr * ALPHA + acc[m][n];
            }
        }
    }
}

__device__ __forceinline__ void phase_router(const bf16_t* XBF, const bf16_t* W, float* LOG, const Ctx& c) {
    for (int base = 0; base < T / 128; base += c.nblk) {
        const bool valid = (base + c.bid) < T / 128; const int mt = valid ? base + c.bid : 0;
        const bf16_t* a0 = XBF + (size_t)(mt * 128 + (c.tid >> 2)) * 1024;
        const bf16_t* b0 = W + (size_t)(c.tid >> 2) * 1024;
        f32x4 acc[4][4];
        gemm_tile(a0, a0 + 64 * 1024, b0, b0 + 64 * 1024, 32, acc, c);
        if (c.wc == 0 && valid) {
#pragma unroll
            for (int m = 0; m < 4; ++m) {
                const int row = mt * 128 + c.wr * 64 + m * 16 + c.fr;
#pragma unroll
                for (int n = 0; n < 4; ++n) *(f32x4*)(LOG + (size_t)row * 64 + n * 16 + c.fq * 4) = acc[m][n];
            }
        }
    }
}

__device__ __forceinline__ void build_block_table(const unsigned* CNT, int* bst, const Ctx& c) {
    __syncthreads();
    if (c.wid == 0) {
        const int cnt = (int)__hip_atomic_load(CNT + c.lane, __ATOMIC_RELAXED, __HIP_MEMORY_SCOPE_AGENT);
        const int nb = (cnt + RBR - 1) / RBR;
        int inc = nb;
#pragma unroll
        for (int o = 1; o < 64; o <<= 1) { const int x = shfl_up_(inc, o); if (c.lane >= o) inc += x; }
        bst[c.lane] = inc - nb; bst[66 + c.lane] = cnt;
        if (c.lane == 63) { bst[64] = inc; bst[65] = inc + T / RBR; bst[66 + 64] = T; }
    }
    __syncthreads();
}
__device__ __forceinline__ int find_expert(const int* bst, int rb, const Ctx& c) {
    return __popcll(__ballot(bst[1 + c.lane] <= rb));
}

__device__ __forceinline__ void phase_moe1(const bf16_t* XBF, const bf16_t* WGU, const unsigned* CNT, const int* LTOK, const float* LW, bf16_t* HBUF, const Ctx& c) {
    int* bst = (int*)(c.smem + 65536 + 64);
    build_block_table(CNT, bst, c);
    const int nsb = bst[65] * 2;
    for (int i = 0;; ++i) {
        int sbk, nt; bool valid; if (!tile_map2(i, c, nsb, 4, sbk, nt, valid)) break;
        const int rb = sbk >> 1, hb = sbk & 1;
        const int e = find_expert(bst, rb, c);
        const int lb = rb - bst[e], cnt = bst[66 + e];
        const int p0 = lb * RBR + hb * 128 + (c.tid >> 2), p1 = p0 + 64;
        const int t0 = (p0 < cnt) ? LTOK[(size_t)e * CAP + p0] : 0;
        const int t1 = (p1 < cnt) ? LTOK[(size_t)e * CAP + p1] : 0;
        const bf16_t* a0 = XBF + (size_t)t0 * 1024;
        const bf16_t* a1 = XBF + (size_t)t1 * 1024;
        const bf16_t* b0 = WGU + (size_t)e * WGU_ELEMS + (size_t)(nt * 128 + (c.tid >> 2)) * 1024;
        f32x4 acc[4][4];
        gemm_tile(a0, a1, b0, b0 + 64 * 1024, 32, acc, c);
#pragma unroll
        for (int m = 0; m < 4; ++m) {
            const int rl = c.wr * 64 + m * 16 + c.fr;
            const int pw = lb * RBR + hb * 128 + rl;
            const float wrow = (pw < cnt) ? LW[(size_t)e * CAP + pw] : 0.f;
#pragma unroll
            for (int n = 0; n < 2; ++n) {
                const f32x4 g = acc[m][n], up = acc[m][n + 2];
                float h[4];
#pragma unroll
                for (int j = 0; j < 4; ++j) h[j] = siluf_(g[j]) * up[j] * wrow;
                tile_put(c, rl, c.wc * 32 + n * 16 + c.fq * 4, (u32x2){pk2(h[0], h[1]), pk2(h[2], h[3])});
            }
        }
        tile_flush<64>(c, HBUF + ((size_t)rb * RBR + hb * 128) * 256 + nt * 64, 256, valid);
    }
}

__device__ __forceinline__ void phase_moe2(const bf16_t* HBUF, const bf16_t* WDN, const unsigned* CNT, bf16_t* Y, const Ctx& c) {
    int* bst = (int*)(c.smem + 65536 + 64);
    build_block_table(CNT, bst, c);
    const int nsb = bst[65] * 2;
    for (int i = 0;; ++i) {
        int sbk, nt; bool valid; if (!tile_map2(i, c, nsb, 8, sbk, nt, valid)) break;
        const int rb = sbk >> 1;
        const int e = find_expert(bst, rb, c);
        const bf16_t* a0 = HBUF + ((size_t)sbk * 128 + (c.tid >> 2)) * 256;
        const bf16_t* b0 = WDN + (size_t)e * WDN_ELEMS + (size_t)(nt * 128 + (c.tid >> 2)) * 256;
        f32x4 acc[4][4];
        gemm_tile(a0, a0 + 64 * 256, b0, b0 + 64 * 256, 8, acc, c);
#pragma unroll
        for (int m = 0; m < 4; ++m) {
            const int lr = c.wr * 64 + m * 16 + c.fr;
#pragma unroll
            for (int n = 0; n < 4; ++n) {
                const f32x4 v = acc[m][n];
                tile_put(c, lr, c.wc * 64 + n * 16 + c.fq * 4, (u32x2){pk2(v[0], v[1]), pk2(v[2], v[3])});
            }
        }
        tile_flush<128>(c, Y + (size_t)sbk * 128 * 1024 + nt * 128, 1024, valid);
    }
}

__device__ __forceinline__ float dppf(float v, int ctrl_sel) {
    int x = __builtin_bit_cast(int, v), r;
    if (ctrl_sel == 0) r = __builtin_amdgcn_update_dpp(0, x, 0xB1, 0xF, 0xF, true);
    else if (ctrl_sel == 1) r = __builtin_amdgcn_update_dpp(0, x, 0x4E, 0xF, 0xF, true);
    else if (ctrl_sel == 2) r = __builtin_amdgcn_update_dpp(0, x, 0x141, 0xF, 0xF, true);
    else r = __builtin_amdgcn_update_dpp(0, x, 0x140, 0xF, 0xF, true);
    return __builtin_bit_cast(float, r);
}
__device__ __forceinline__ float red16(float v) { v += dppf(v, 0); v += dppf(v, 1); v += dppf(v, 2); v += dppf(v, 3); return v; }

template <bool F32OUT>
__device__ __forceinline__ void ln_row_store(float (&v)[16], const float* g, const float* b, float* of32, bf16_t* obf, int lane) {
    float s = 0.f;
#pragma unroll
    for (int i = 0; i < 16; ++i) s += v[i];
    const float mean = wave_sum(s) * (1.f / 1024.f);
    float q = 0.f;
#pragma unroll
    for (int i = 0; i < 16; ++i) { v[i] -= mean; q += v[i] * v[i]; }
    const float rstd = rsqrtf(wave_sum(q) * (1.f / 1024.f) + 1e-5f);
#pragma unroll
    for (int hf = 0; hf < 2; ++hf) {
        const int col = hf * 512 + lane * 8;
        const f32x4 g0 = *(const f32x4*)(g + col), g1 = *(const f32x4*)(g + col + 4);
        const f32x4 b0 = *(const f32x4*)(b + col), b1 = *(const f32x4*)(b + col + 4);
        f32x4 y0, y1;
#pragma unroll
        for (int j = 0; j < 4; ++j) { y0[j] = v[hf * 8 + j] * rstd * g0[j] + b0[j]; y1[j] = v[hf * 8 + 4 + j] * rstd * g1[j] + b1[j]; }
        if constexpr (F32OUT) { *(f32x4*)(of32 + col) = y0; *(f32x4*)(of32 + col + 4) = y1; }
        *(u32x4*)(obf + col) = (u32x4){pk2(y0[0], y0[1]), pk2(y0[2], y0[3]), pk2(y1[0], y1[1]), pk2(y1[2], y1[3])};
    }
}

__device__ __forceinline__ void phase_ln1(const bf16_t* YBUF, const float* g, const float* b, bf16_t* XBF, const Ctx& c) {
    for (int t = c.bid * 4 + c.wid; t < T; t += c.nblk * 4) {
        float v[16];
#pragma unroll
        for (int hf = 0; hf < 2; ++hf) {
            const u32x4 r = *(const u32x4*)(YBUF + (size_t)t * 1024 + hf * 512 + c.lane * 8);
            float f[8]; unpack8(r, f);
#pragma unroll
            for (int j = 0; j < 8; ++j) v[hf * 8 + j] = f[j];
        }
        ln_row_store<false>(v, g, b, nullptr, XBF + (size_t)t * 1024, c.lane);
    }
}

template <bool LASTL>
__device__ __forceinline__ void phase_combine(const bf16_t* Y, const int* ASG, const float* ASGW, const unsigned* CNT, const float* g, const float* b,
                              float* XOUT, bf16_t* XBF, const Ctx& c) {
    int* bst = (int*)(c.smem + 65536 + 64);
    build_block_table(CNT, bst, c);
    for (int t = c.bid * 4 + c.wid; t < T; t += c.nblk * 4) {
        float v[16];
#pragma unroll
        for (int hf = 0; hf < 2; ++hf) {
            const u32x4 r = *(const u32x4*)(XBF + (size_t)t * 1024 + hf * 512 + c.lane * 8);
            float f[8]; unpack8(r, f);
#pragma unroll
            for (int j = 0; j < 8; ++j) v[hf * 8 + j] = f[j] * ALPHA;
        }
#pragma unroll
        for (int k = 0; k < 9; ++k) {
            size_t crow; float wk = 1.f;
            if (k < 8) { const int asg = ASG[(size_t)t * 8 + k]; crow = (size_t)bst[asg >> 16] * RBR + (asg & 0xffff); wk = ASGW[(size_t)t * 8 + k]; }
            else crow = (size_t)bst[64] * RBR + t;
#pragma unroll
            for (int hf = 0; hf < 2; ++hf) {
                const u32x4 r = *(const u32x4*)(Y + crow * 1024 + hf * 512 + c.lane * 8);
                float f[8]; unpack8(r, f);
#pragma unroll
                for (int j = 0; j < 8; ++j) v[hf * 8 + j] += f[j] * wk;
            }
        }
        ln_row_store<LASTL>(v, g, b, XOUT + (size_t)t * 1024, XBF + (size_t)t * 1024, c.lane);
    }
}

__device__ __forceinline__ void phase_route(const float* LOG, const float* rb, unsigned* CNT, int* LTOK, float* LW, int* ASG, float* ASGW, const Ctx& c) {
    int* lcnt = (int*)c.smem;
    int* lbase = lcnt + 64;
    int* sel_e = lbase + 64;
    int* sel_p = sel_e + 256;
    float* sel_w = (float*)(sel_p + 256);
    const float rbias = rb[c.lane];
    for (int base = 0; base < T / 32; base += c.nblk) {
        const int ch = base + c.bid; const bool valid = ch < T / 32;
        __syncthreads();
        if (c.tid < 64) lcnt[c.tid] = 0;
        __syncthreads();
        if (valid) for (int tl = c.wid; tl < 32; tl += 4) {
            const int t = ch * 32 + tl;
            const float lg = LOG[(size_t)t * 64 + c.lane];
            const float sc = 1.f / (1.f + expf(-lg));
            const float v = sc + rbias;
            float m1 = v;
            m1 = fmaxf(m1, shfl_xor_(m1, 1)); m1 = fmaxf(m1, shfl_xor_(m1, 2)); m1 = fmaxf(m1, shfl_xor_(m1, 4));
            int cand = (v == m1) ? c.lane : 999;
            cand = min(cand, shfl_xor_(cand, 1)); cand = min(cand, shfl_xor_(cand, 2)); cand = min(cand, shfl_xor_(cand, 4));
            float m2 = (c.lane == cand) ? -INFINITY : v;
            m2 = fmaxf(m2, shfl_xor_(m2, 1)); m2 = fmaxf(m2, shfl_xor_(m2, 2)); m2 = fmaxf(m2, shfl_xor_(m2, 4));
            const float gs = m1 + m2;
            const int g = c.lane >> 3;
            int grank = 0;
#pragma unroll
            for (int gg = 0; gg < 8; ++gg) { const float o = shfl_c_(gs, gg * 8); grank += ((o > gs) || (o == gs && gg < g)) ? 1 : 0; }
            const bool gsel = grank < 4;
            const float mv = gsel ? v : -INFINITY;
            int rank = 0;
#pragma unroll 8
            for (int jj = 0; jj < 64; ++jj) { const float o = shfl_c_(mv, jj); rank += ((o > mv) || (o == mv && jj < c.lane)) ? 1 : 0; }
            const bool sel = gsel && rank < 8;
            const float ssum = wave_sum(sel ? sc : 0.f);
            const float w = sc / ssum * 2.5f;
            const unsigned long long bal = __ballot(sel);
            const int slot = __popcll(bal & ((1ull << c.lane) - 1ull));
            if (sel) {
                const int p = atomicAdd(&lcnt[c.lane], 1);
                sel_e[tl * 8 + slot] = c.lane; sel_p[tl * 8 + slot] = p; sel_w[tl * 8 + slot] = w;
            }
        }
        __syncthreads();
        if (valid && c.tid < 64) { const int n = lcnt[c.tid]; lbase[c.tid] = n ? (int)atomicAdd(CNT + c.tid, (unsigned)n) : 0; }
        __syncthreads();
        if (valid) {
            const int tl = c.tid >> 3, t = ch * 32 + tl;
            const int e = sel_e[c.tid], pos = lbase[e] + sel_p[c.tid];
            LTOK[(size_t)e * CAP + pos] = t; LW[(size_t)e * CAP + pos] = sel_w[c.tid];
            ASG[(size_t)t * 8 + (c.tid & 7)] = (e << 16) | pos; ASGW[(size_t)t * 8 + (c.tid & 7)] = sel_w[c.tid];
            if (c.tid < 32) { const int ts = ch * 32 + c.tid; LTOK[(size_t)64 * CAP + ts] = ts; LW[(size_t)64 * CAP + ts] = 1.f; }
        }
    }
}

__device__ __forceinline__ void phase_lnroute(const bf16_t* YBUF, const float* g, const float* b, bf16_t* XBF, const bf16_t* W, const float* rb,
                                              unsigned* CNT, int* LTOK, float* LW, int* ASG, float* ASGW, const Ctx& c) {
    unsigned char* xa = c.smem;
    int* lcnt = (int*)(c.smem + 65536 + 64);
    int* lbase = lcnt + 64;
    float* lgt = (float*)c.smem;
    int* sel_e = (int*)(c.smem + 8192);
    int* sel_p = sel_e + 256;
    float* sel_w = (float*)(sel_p + 256);
    const int lane = c.lane;
    const float rbias = rb[lane];
    for (int base = 0; base < T / 32; base += c.nblk) {
        const int ch = base + c.bid; const bool valid = ch < T / 32;
        __syncthreads();
        if (c.tid < 64) lcnt[c.tid] = 0;
        if (valid) for (int tl = c.wid; tl < 32; tl += 4) {
            const int t = ch * 32 + tl;
            float v[16];
#pragma unroll
            for (int hf = 0; hf < 2; ++hf) {
                const u32x4 r = *(const u32x4*)(YBUF + (size_t)t * 1024 + hf * 512 + lane * 8);
                float f[8]; unpack8(r, f);
#pragma unroll
                for (int j = 0; j < 8; ++j) v[hf * 8 + j] = f[j];
            }
            float s = 0.f;
#pragma unroll
            for (int i = 0; i < 16; ++i) s += v[i];
            const float mean = wave_sum(s) * (1.f / 1024.f);
            float q = 0.f;
#pragma unroll
            for (int i = 0; i < 16; ++i) { v[i] -= mean; q += v[i] * v[i]; }
            const float rstd = rsqrtf(wave_sum(q) * (1.f / 1024.f) + 1e-5f);
#pragma unroll
            for (int hf = 0; hf < 2; ++hf) {
                const int col = hf * 512 + lane * 8;
                const f32x4 g0 = *(const f32x4*)(g + col), g1 = *(const f32x4*)(g + col + 4);
                const f32x4 b0 = *(const f32x4*)(b + col), b1 = *(const f32x4*)(b + col + 4);
                f32x4 y0, y1;
#pragma unroll
                for (int j = 0; j < 4; ++j) { y0[j] = v[hf * 8 + j] * rstd * g0[j] + b0[j]; y1[j] = v[hf * 8 + 4 + j] * rstd * g1[j] + b1[j]; }
                const u32x4 pk = (u32x4){pk2(y0[0], y0[1]), pk2(y0[2], y0[3]), pk2(y1[0], y1[1]), pk2(y1[2], y1[3])};
                *(u32x4*)(XBF + (size_t)t * 1024 + col) = pk;
                *(u32x4*)(xa + tl * 2048 + (((hf * 64 + lane) ^ (tl & 15)) * 16)) = pk;
            }
        }
        __syncthreads();
        f32x4 acc0 = (f32x4){0.f, 0.f, 0.f, 0.f}, acc1 = (f32x4){0.f, 0.f, 0.f, 0.f};
        {
            const int r = lane & 15, kq = lane >> 4;
            const bf16_t* wrow = W + (size_t)(c.wid * 16 + r) * 1024 + kq * 8;
#pragma unroll 1
            for (int kb = 0; kb < 32; kb += 8) {
                bf16x8 bfr[8];
#pragma unroll
                for (int j = 0; j < 8; ++j) bfr[j] = *(const bf16x8*)(wrow + (kb + j) * 32);
#pragma unroll
                for (int j = 0; j < 8; ++j) {
                    const int chunk = ((kb + j) * 4 + kq) ^ r;
                    const bf16x8 a0 = *(const bf16x8*)(xa + r * 2048 + chunk * 16), a1 = *(const bf16x8*)(xa + (16 + r) * 2048 + chunk * 16);
                    acc0 = __builtin_amdgcn_mfma_f32_16x16x32_bf16(a0, bfr[j], acc0, 0, 0, 0);
                    acc1 = __builtin_amdgcn_mfma_f32_16x16x32_bf16(a1, bfr[j], acc1, 0, 0, 0);
                }
            }
        }
        __syncthreads();
        {
            const int e = c.wid * 16 + (lane & 15), r0 = 4 * (lane >> 4);
#pragma unroll
            for (int j = 0; j < 4; ++j) { lgt[(r0 + j) * 64 + e] = acc0[j]; lgt[(16 + r0 + j) * 64 + e] = acc1[j]; }
        }
        __syncthreads();
        if (valid) for (int tl = c.wid; tl < 32; tl += 4) {
            const float lg = lgt[tl * 64 + lane];
            const float sc = 1.f / (1.f + expf(-lg));
            const float v = sc + rbias;
            float m1 = v;
            m1 = fmaxf(m1, shfl_xor_(m1, 1)); m1 = fmaxf(m1, shfl_xor_(m1, 2)); m1 = fmaxf(m1, shfl_xor_(m1, 4));
            int cand = (v == m1) ? lane : 999;
            cand = min(cand, shfl_xor_(cand, 1)); cand = min(cand, shfl_xor_(cand, 2)); cand = min(cand, shfl_xor_(cand, 4));
            float m2 = (lane == cand) ? -INFINITY : v;
            m2 = fmaxf(m2, shfl_xor_(m2, 1)); m2 = fmaxf(m2, shfl_xor_(m2, 2)); m2 = fmaxf(m2, shfl_xor_(m2, 4));
            const float gs = m1 + m2;
            const int gi = lane >> 3;
            int grank = 0;
#pragma unroll
            for (int gg = 0; gg < 8; ++gg) { const float o = shfl_c_(gs, gg * 8); grank += ((o > gs) || (o == gs && gg < gi)) ? 1 : 0; }
            const bool gsel = grank < 4;
            const float mv = gsel ? v : -INFINITY;
            int rank = 0;
#pragma unroll 8
            for (int jj = 0; jj < 64; ++jj) { const float o = shfl_c_(mv, jj); rank += ((o > mv) || (o == mv && jj < lane)) ? 1 : 0; }
            const bool sel = gsel && rank < 8;
            const float ssum = wave_sum(sel ? sc : 0.f);
            const float w = sc / ssum * 2.5f;
            const unsigned long long bal = __ballot(sel);
            const int slot = __popcll(bal & ((1ull << lane) - 1ull));
            if (sel) {
                const int p = atomicAdd(&lcnt[lane], 1);
                sel_e[tl * 8 + slot] = lane; sel_p[tl * 8 + slot] = p; sel_w[tl * 8 + slot] = w;
            }
        }
        __syncthreads();
        if (valid && c.tid < 64) { const int n = lcnt[c.tid]; lbase[c.tid] = n ? (int)atomicAdd(CNT + c.tid, (unsigned)n) : 0; }
        __syncthreads();
        if (valid) {
            const int tl = c.tid >> 3, t = ch * 32 + tl;
            const int e = sel_e[c.tid], pos = lbase[e] + sel_p[c.tid];
            LTOK[(size_t)e * CAP + pos] = t; LW[(size_t)e * CAP + pos] = sel_w[c.tid];
            ASG[(size_t)t * 8 + (c.tid & 7)] = (e << 16) | pos; ASGW[(size_t)t * 8 + (c.tid & 7)] = sel_w[c.tid];
            if (c.tid < 32) { const int ts = ch * 32 + c.tid; LTOK[(size_t)64 * CAP + ts] = ts; LW[(size_t)64 * CAP + ts] = 1.f; }
        }
    }
}

__device__ __forceinline__ void phase_prep_even(const bf16_t* PROJ, const float* GATES, const float* qn, const float* kvn, const float* cw,
                                const float* a_log, const float* dt_bias, const float* ROPEM,
                                bf16_t* CQ, bf16_t* CKV, bf16_t* KROPE, bf16_t* GQ, bf16_t* GK, bf16_t* GV, float* BETA, float* GLOG, const Ctx& c) {
    const int lane = c.lane;
    float* cwL = (float*)c.smem;
    __syncthreads();
    for (int i = c.tid; i < 4 * 1536 / 4; i += 256) *(f32x4*)(cwL + i * 4) = *(const f32x4*)(cw + i * 4);
    __syncthreads();
    for (int t = c.bid * 4 + c.wid; t < T; t += c.nblk * 4) {
        const bf16_t* pr = PROJ + (size_t)t * NPAD;
        {
            const u32x2 r = *(const u32x2*)(pr + lane * 4);
            float v[4] = {bflo(r.x), bfhi(r.x), bflo(r.y), bfhi(r.y)};
            const float ss = wave_sum(v[0] * v[0] + v[1] * v[1] + v[2] * v[2] + v[3] * v[3]);
            const float rr = rsqrtf(ss * (1.f / 256.f) + 1e-6f);
            const f32x4 gq = *(const f32x4*)(qn + lane * 4);
            *(u32x2*)(CQ + (size_t)t * 256 + lane * 4) = (u32x2){pk2(v[0] * rr * gq[0], v[1] * rr * gq[1]), pk2(v[2] * rr * gq[2], v[3] * rr * gq[3])};
        }
        {
            const unsigned r = *(const unsigned*)(pr + 256 + lane * 2);
            const float v0 = bflo(r), v1 = bfhi(r);
            const float ss = wave_sum(v0 * v0 + v1 * v1);
            const float rr = rsqrtf(ss * (1.f / 128.f) + 1e-6f);
            *(unsigned*)(CKV + (size_t)t * 128 + lane * 2) = pk2(v0 * rr * kvn[lane * 2], v1 * rr * kvn[lane * 2 + 1]);
        }
        if (lane < 16) {
            const float x1 = bf2f(pr[384 + lane]), x2 = bf2f(pr[400 + lane]);
            const float cs = ROPEM[((size_t)t * 16 + lane) * 2], sn = ROPEM[((size_t)t * 16 + lane) * 2 + 1];
            KROPE[(size_t)t * 32 + lane] = (bf16_t)f2bf(x1 * cs - x2 * sn);
            KROPE[(size_t)t * 32 + 16 + lane] = (bf16_t)f2bf(x2 * cs + x1 * sn);
        }
        const int s = t & (SEQ - 1);
        u32x4 xr[3][4];
#pragma unroll
        for (int arr = 0; arr < 3; ++arr)
#pragma unroll
            for (int w = 0; w < 4; ++w)
                xr[arr][w] = (s - 3 + w >= 0) ? *(const u32x4*)(PROJ + (size_t)(t - 3 + w) * NPAD + 416 + arr * 512 + lane * 8) : (u32x4){0u, 0u, 0u, 0u};
#pragma unroll
        for (int arr = 0; arr < 3; ++arr) {
            float y[8];
#pragma unroll
            for (int j = 0; j < 8; ++j) y[j] = 0.f;
#pragma unroll
            for (int w = 0; w < 4; ++w) {
                float f[8]; unpack8(xr[arr][w], f);
                const f32x4 c0 = *(const f32x4*)(cwL + w * 1536 + arr * 512 + lane * 8), c1 = *(const f32x4*)(cwL + w * 1536 + arr * 512 + lane * 8 + 4);
#pragma unroll
                for (int j = 0; j < 4; ++j) { y[j] += c0[j] * f[j]; y[4 + j] += c1[j] * f[4 + j]; }
            }
            float ss = 0.f;
#pragma unroll
            for (int j = 0; j < 8; ++j) { y[j] = siluf_(y[j]); ss += y[j] * y[j]; }
            if (arr < 2) {
                float rr = rsqrtf(red16(ss) + 1e-6f);
                if (arr == 0) rr *= 0.08838834764831845f;
#pragma unroll
                for (int j = 0; j < 8; ++j) y[j] *= rr;
            }
            bf16_t* dst = (arr == 0) ? GQ : (arr == 1) ? GK : GV;
            *(u32x4*)(dst + (size_t)t * 512 + lane * 8) = (u32x4){pk2(y[0], y[1]), pk2(y[2], y[3]), pk2(y[4], y[5]), pk2(y[6], y[7])};
        }
        if (lane < 4) BETA[(size_t)t * 4 + lane] = sigmoidf_(GATES[(size_t)t * 8 + lane]);
        else if (lane < 8) { const int h = lane - 4; GLOG[(size_t)t * 4 + h] = -expf(a_log[h]) * softplusf_(GATES[(size_t)t * 8 + lane] + dt_bias[h]); }
    }
}

__device__ __forceinline__ void phase_prep_odd(const bf16_t* PROJ, const float* ROPES, bf16_t* SQ, bf16_t* SK, const Ctx& c) {
    const int lane = c.lane;
    for (int t = c.bid * 4 + c.wid; t < T; t += c.nblk * 4) {
        const bf16_t* pr = PROJ + (size_t)t * NPAD;
        const int i = lane & 31;
        const float cs = ROPES[((size_t)t * 32 + i) * 2], sn = ROPES[((size_t)t * 32 + i) * 2 + 1];
#pragma unroll
        for (int r = 0; r < 4; ++r) {
            const int h = (lane >> 5) + 2 * r;
            const float x1 = bf2f(pr[1544 + h * 64 + i]), x2 = bf2f(pr[1544 + h * 64 + 32 + i]);
            SQ[(size_t)t * 512 + h * 64 + i] = (bf16_t)f2bf((x1 * cs - x2 * sn) * 0.18033688011112042f);
            SQ[(size_t)t * 512 + h * 64 + 32 + i] = (bf16_t)f2bf((x2 * cs + x1 * sn) * 0.18033688011112042f);
        }
        {
            const int h = lane >> 5;
            const float x1 = bf2f(pr[2056 + h * 64 + i]), x2 = bf2f(pr[2056 + h * 64 + 32 + i]);
            SK[(size_t)t * 128 + h * 64 + i] = (bf16_t)f2bf(x1 * cs - x2 * sn);
            SK[(size_t)t * 128 + h * 64 + 32 + i] = (bf16_t)f2bf(x2 * cs + x1 * sn);
        }
    }
}

__device__ __forceinline__ int next_unit(unsigned* ctr, const Ctx& c) {
    volatile int* su = (volatile int*)(c.smem0 + LDS_BLK + 16);
    __syncthreads();
    if (c.tid0 == 0) *su = (int)atomicAdd(ctr, 1u);
    __syncthreads();
    return *su * 2 + c.half;
}

typedef float f32x16 __attribute__((ext_vector_type(16)));
typedef short s16x4 __attribute__((ext_vector_type(4)));
#define MFMA32(a, b, c) __builtin_amdgcn_mfma_f32_32x32x16_bf16((a), (b), (c), 0, 0, 0)
template <int S_> __device__ __forceinline__ bf16x8 pack_step(const f32x16& x) {
    u32x4 p;
    asm volatile("v_cvt_pk_bf16_f32 %0, %4, %5\n\tv_cvt_pk_bf16_f32 %1, %6, %7\n\tv_cvt_pk_bf16_f32 %2, %8, %9\n\tv_cvt_pk_bf16_f32 %3, %10, %11\n\ts_nop 1"
                 : "=&v"(p[0]), "=&v"(p[1]), "=&v"(p[2]), "=&v"(p[3])
                 : "v"(x[8 * S_]), "v"(x[8 * S_ + 1]), "v"(x[8 * S_ + 2]), "v"(x[8 * S_ + 3]), "v"(x[8 * S_ + 4]), "v"(x[8 * S_ + 5]), "v"(x[8 * S_ + 6]), "v"(x[8 * S_ + 7]));
    return __builtin_bit_cast(bf16x8, p);
}
template <int S_> __device__ __forceinline__ bf16x8 pack_step_m(const f32x16& x) {
    u32x4 p;
    asm volatile("s_nop 15\n\tv_cvt_pk_bf16_f32 %0, %4, %5\n\tv_cvt_pk_bf16_f32 %1, %6, %7\n\tv_cvt_pk_bf16_f32 %2, %8, %9\n\tv_cvt_pk_bf16_f32 %3, %10, %11\n\ts_nop 1"
                 : "=&v"(p[0]), "=&v"(p[1]), "=&v"(p[2]), "=&v"(p[3])
                 : "v"(x[8 * S_]), "v"(x[8 * S_ + 1]), "v"(x[8 * S_ + 2]), "v"(x[8 * S_ + 3]), "v"(x[8 * S_ + 4]), "v"(x[8 * S_ + 5]), "v"(x[8 * S_ + 6]), "v"(x[8 * S_ + 7]));
    return __builtin_bit_cast(bf16x8, p);
}
constexpr int ATT_VB = 64 * 128;

template <int NKS, bool WIN>
__device__ __forceinline__ void attn_unit(const bf16_t* Qp, int q_ld, const bf16_t* K1, int k1_ld, const bf16_t* K2, int k2_ld, const bf16_t* Vp, int v_ld,
                          bf16_t* Op, int o_ld, int Q0, float sink_l2, const Ctx& c) {
    constexpr int KB = NKS * 2 * 1024, BUF = KB + ATT_VB;
    const int lane = c.lane, r = lane & 31, h = lane >> 5;
    const int wid = __builtin_amdgcn_readfirstlane(c.wid);
    const int q0w = Q0 + wid * 32;
    unsigned char* smem = c.smem;
    bf16x8 qf[NKS];
#pragma unroll
    for (int ks = 0; ks < NKS; ++ks) qf[ks] = *(const bf16x8*)(Qp + (size_t)(q0w + r) * q_ld + ks * 16 + h * 8);
    f32x16 o0, o1;
#pragma unroll
    for (int i = 0; i < 16; ++i) { o0[i] = 0.f; o1[i] = 0.f; }
    float m = WIN ? sink_l2 : -1e30f, l = (WIN && h == 0) ? 1.f : 0.f;
    const int kt_lo = WIN ? ((Q0 >> 6) - 2 < 0 ? 0 : (Q0 >> 6) - 2) : 0, kt_hi = (Q0 >> 6) + 1;
#define ATT_STAGE(kt_, buf_) do { unsigned char* bp = smem + (buf_) * BUF; const size_t kb = (size_t)(kt_) * 64; \
        _Pragma("unroll") for (int i = 0; i < (NKS * 2) / 4; ++i) { const int ch = wid + 4 * i; \
            const bf16_t* sp = (ch < 8) ? (K1 + (kb + lane) * k1_ld + ch * 8) : (K2 + (kb + lane) * k2_ld + (ch - 8) * 8); \
            glds16(sp, bp + ch * 1024 + lane * 16); } \
        _Pragma("unroll") for (int i = 0; i < 2; ++i) { const int j = wid + 4 * i; \
            glds16(Vp + (kb + 8 * j + (lane >> 3)) * v_ld + (lane & 7) * 8, bp + KB + j * 1024 + lane * 16); } } while (0)
    ATT_STAGE(kt_lo, 0);
    const int i16 = lane & 15;
    const unsigned vlane = (unsigned)((4 * h + (i16 >> 2)) * 128 + 32 * ((lane >> 4) & 1) + 8 * (i16 & 3));
    for (int kt = kt_lo; kt <= kt_hi; ++kt) {
        const int cur = (kt - kt_lo) & 1;
        asm volatile("s_waitcnt vmcnt(0)" ::: "memory");
        __syncthreads();
        if (kt < kt_hi) ATT_STAGE(kt + 1, cur ^ 1);
        const int k0 = kt * 64;
        const bool active = (k0 <= q0w + 31) && (!WIN || (k0 + 63 > q0w - 128));
        if (active) {
            const unsigned char* Kt = smem + cur * BUF;
            f32x16 x0, x1;
#pragma unroll
            for (int i = 0; i < 16; ++i) { x0[i] = 0.f; x1[i] = 0.f; }
#pragma unroll
            for (int ks = 0; ks < NKS; ++ks) {
                const bf16x8 kf0 = *(const bf16x8*)(Kt + (ks * 2 + h) * 1024 + r * 16);
                const bf16x8 kf1 = *(const bf16x8*)(Kt + (ks * 2 + h) * 1024 + (32 + r) * 16);
                x0 = MFMA32(kf0, qf[ks], x0); x1 = MFMA32(kf1, qf[ks], x1);
            }
            const bool need_mask = (k0 + 63 > q0w) || (WIN && (k0 <= q0w + 31 - 128));
            if (need_mask) {
                const int q = q0w + r;
#pragma unroll
                for (int i = 0; i < 16; ++i) {
                    const int key = k0 + (i & 3) + 8 * (i >> 2) + 4 * h;
                    const bool v0 = (key <= q) && (!WIN || key > q - 128);
                    const bool v1 = (key + 32 <= q) && (!WIN || key + 32 > q - 128);
                    x0[i] = v0 ? x0[i] : -INFINITY; x1[i] = v1 ? x1[i] : -INFINITY;
                }
            }
            float mx = fmaxf(x0[0], x1[0]);
#pragma unroll
            for (int i = 1; i < 16; ++i) mx = fmaxf(mx, fmaxf(x0[i], x1[i]));
            mx = fmaxf(mx, shfl_xor_(mx, 32));
            const float mn = fmaxf(m, mx);
            const float alpha = __builtin_amdgcn_exp2f(m - mn);
            m = mn;
            float ps = 0.f;
#pragma unroll
            for (int i = 0; i < 16; ++i) { x0[i] = __builtin_amdgcn_exp2f(x0[i] - mn); x1[i] = __builtin_amdgcn_exp2f(x1[i] - mn); ps += x0[i] + x1[i]; }
            l = l * alpha + ps;
            o0 *= alpha; o1 *= alpha;
            const unsigned vbase = (unsigned)(size_t)(smem + cur * BUF + KB) + vlane;
#pragma unroll
            for (int t = 0; t < 2; ++t) {
                s16x4 l00, h00, l01, h01, l10, h10, l11, h11;
                const unsigned va = vbase + t * 4096;
                asm volatile("ds_read_b64_tr_b16 %0, %8\n\t"
                             "ds_read_b64_tr_b16 %1, %8 offset:1024\n\t"
                             "ds_read_b64_tr_b16 %2, %8 offset:64\n\t"
                             "ds_read_b64_tr_b16 %3, %8 offset:1088\n\t"
                             "ds_read_b64_tr_b16 %4, %8 offset:2048\n\t"
                             "ds_read_b64_tr_b16 %5, %8 offset:3072\n\t"
                             "ds_read_b64_tr_b16 %6, %8 offset:2112\n\t"
                             "ds_read_b64_tr_b16 %7, %8 offset:3136\n\t"
                             "s_waitcnt lgkmcnt(0)"
                             : "=&v"(l00), "=&v"(h00), "=&v"(l01), "=&v"(h01), "=&v"(l10), "=&v"(h10), "=&v"(l11), "=&v"(h11) : "v"(va) : "memory");
                const bf16x8 v00 = __builtin_shufflevector(l00, h00, 0, 1, 2, 3, 4, 5, 6, 7), v01 = __builtin_shufflevector(l01, h01, 0, 1, 2, 3, 4, 5, 6, 7);
                const bf16x8 v10 = __builtin_shufflevector(l10, h10, 0, 1, 2, 3, 4, 5, 6, 7), v11 = __builtin_shufflevector(l11, h11, 0, 1, 2, 3, 4, 5, 6, 7);
                const bf16x8 pb0 = (t == 0) ? pack_step<0>(x0) : pack_step<0>(x1);
                const bf16x8 pb1 = (t == 0) ? pack_step<1>(x0) : pack_step<1>(x1);
                o0 = MFMA32(v00, pb0, o0); o1 = MFMA32(v01, pb0, o1);
                o0 = MFMA32(v10, pb1, o0); o1 = MFMA32(v11, pb1, o1);
            }
        }
    }
#undef ATT_STAGE
    l += shfl_xor_(l, 32);
    const float inv = 1.f / l;
    bf16_t* orow = Op + (size_t)(q0w + r) * o_ld + 4 * h;
#pragma unroll
    for (int g = 0; g < 4; ++g) {
        *(u32x2*)(orow + 8 * g) = (u32x2){pk2(o0[4 * g] * inv, o0[4 * g + 1] * inv), pk2(o0[4 * g + 2] * inv, o0[4 * g + 3] * inv)};
        *(u32x2*)(orow + 32 + 8 * g) = (u32x2){pk2(o1[4 * g] * inv, o1[4 * g + 1] * inv), pk2(o1[4 * g + 2] * inv, o1[4 * g + 3] * inv)};
    }
}

constexpr size_t MLC_DC = 0, MLC_CS = 33554432, MLC_DN = MLC_CS + 16777216, MLC_NS = MLC_DN + 262144, MLC_ML = MLC_NS + 262144, MLC_BE = MLC_ML + 4096, MLC_MS = MLC_BE + 4096;

__device__ __forceinline__ float scan_add64(float v, int lane) {
#pragma unroll
    for (int o = 1; o < 64; o <<= 1) { const float x = shfl_up_(v, o); if (lane >= o) v += x; }
    return v;
}
__device__ __forceinline__ float scan_max64(float v, int lane) {
#pragma unroll
    for (int o = 1; o < 64; o <<= 1) { const float x = shfl_up_(v, o); if (lane >= o) v = fmaxf(v, x); }
    return v;
}
__device__ __forceinline__ float wave_max(float v) {
#pragma unroll
    for (int o = 32; o > 0; o >>= 1) v = fmaxf(v, shfl_xor_(v, o));
    return v;
}

__device__ __forceinline__ void mlc_passA(int u, const bf16_t* PROJ, const float* GATES, const float* b_i, const float* b_f, unsigned char* YB, const Ctx& c) {
    const int bh = u >> 5, b = bh >> 2, h = bh & 3;
    const size_t t0 = (size_t)b * SEQ + (u & 31) * 64;
    unsigned char* smem = c.smem;
    float* saL = (float*)(smem + 24576);
    const int lane = c.lane, wid = __builtin_amdgcn_readfirstlane(c.wid);
#pragma unroll
    for (int i = 0; i < 4; ++i) { const int j = wid * 4 + i;
        glds16(PROJ + (t0 + 4 * j + (lane >> 4)) * NPAD + 512 + h * 128 + (lane & 15) * 8, smem + 8192 + j * 1024 + lane * 16); }
    if (wid == 0) {
        const float ip = GATES[(t0 + lane) * 8 + h] + b_i[h], lf = -softplusf_(-(GATES[(t0 + lane) * 8 + 4 + h] + b_f[h]));
        const float bc = scan_add64(lf, lane), bend = shfl_c_(bc, 63);
        const float a = bend - bc + ip, mloc = wave_max(a);
        saL[lane] = expf(a - mloc) * 0.125f;
        if (lane == 0) { ((float*)(YB + MLC_ML))[u] = mloc; ((float*)(YB + MLC_BE))[u] = bend; }
    }
    __syncthreads();
#pragma unroll
    for (int i = 0; i < 2; ++i) {
        const int idx = c.tid + 256 * i, row = idx >> 3, chk = idx & 7;
        const u32x4 r = *(const u32x4*)(PROJ + (t0 + row) * NPAD + 256 + h * 64 + chk * 8);
        float f[8]; unpack8(r, f);
        const float s = saL[row];
        *(u32x4*)(smem + row * 128 + chk * 16) = (u32x4){pk2(f[0] * s, f[1] * s), pk2(f[2] * s, f[3] * s), pk2(f[4] * s, f[5] * s), pk2(f[6] * s, f[7] * s)};
    }
    asm volatile("s_waitcnt vmcnt(0)" ::: "memory");
    __syncthreads();
    const int h5 = lane >> 5, r = lane & 31, i16 = lane & 15, q4 = i16 >> 2, p = i16 & 3, blk = (lane >> 4) & 1;
    const int dkt = wid & 1, dvp = wid >> 1;
    const unsigned kaddr = (unsigned)(size_t)smem + (unsigned)((8 * h5 + q4) * 128 + dkt * 64 + 32 * blk + 8 * p);
    const unsigned vaddr = (unsigned)(size_t)smem + 8192u + (unsigned)((8 * h5 + q4) * 256 + dvp * 128 + 32 * blk + 8 * p);
    f32x16 a0, a1;
#pragma unroll
    for (int i = 0; i < 16; ++i) { a0[i] = 0.f; a1[i] = 0.f; }
#pragma unroll
    for (int st = 0; st < 4; ++st) {
        s16x4 kl, kh, v0l, v0h, v1l, v1h;
        const unsigned ka = kaddr + st * 2048, va = vaddr + st * 4096;
        asm volatile("ds_read_b64_tr_b16 %0, %6\n\t"
                     "ds_read_b64_tr_b16 %1, %6 offset:512\n\t"
                     "ds_read_b64_tr_b16 %2, %7\n\t"
                     "ds_read_b64_tr_b16 %3, %7 offset:1024\n\t"
                     "ds_read_b64_tr_b16 %4, %7 offset:64\n\t"
                     "ds_read_b64_tr_b16 %5, %7 offset:1088\n\t"
                     "s_waitcnt lgkmcnt(0)"
                     : "=&v"(kl), "=&v"(kh), "=&v"(v0l), "=&v"(v0h), "=&v"(v1l), "=&v"(v1h) : "v"(ka), "v"(va) : "memory");
        const bf16x8 kf = __builtin_shufflevector(kl, kh, 0, 1, 2, 3, 4, 5, 6, 7);
        const bf16x8 vf0 = __builtin_shufflevector(v0l, v0h, 0, 1, 2, 3, 4, 5, 6, 7), vf1 = __builtin_shufflevector(v1l, v1h, 0, 1, 2, 3, 4, 5, 6, 7);
        a0 = MFMA32(kf, vf0, a0); a1 = MFMA32(kf, vf1, a1);
    }
    float* DC = (float*)(YB + MLC_DC) + (size_t)u * 8192;
#pragma unroll
    for (int i = 0; i < 16; ++i) {
        const int dk = dkt * 32 + (i & 3) + 8 * (i >> 2) + 4 * h5;
        DC[dk * 128 + dvp * 64 + r] = a0[i]; DC[dk * 128 + dvp * 64 + 32 + r] = a1[i];
    }
    if (c.tid < 64) {
        float s = 0.f;
#pragma unroll 8
        for (int t = 0; t < 64; ++t) s += bf2f(((const bf16_t*)smem)[t * 64 + c.tid]);
        ((float*)(YB + MLC_DN))[(size_t)u * 64 + c.tid] = s;
    }
}

__device__ __forceinline__ void mlc_passB(int u, unsigned char* YB, const Ctx& c) {
    const int bh = u >> 3, sl = u & 7;
    const float* ML = (const float*)(YB + MLC_ML) + bh * 32; const float* BE = (const float*)(YB + MLC_BE) + bh * 32;
    const float* DC = (const float*)(YB + MLC_DC) + (size_t)bh * 32 * 8192 + sl * 1024 + c.tid * 4;
    bf16_t* CS = (bf16_t*)(YB + MLC_CS) + (size_t)bh * 32 * 8192 + sl * 1024 + c.tid * 4;
    const float* DN = (const float*)(YB + MLC_DN) + (size_t)bh * 32 * 64; float* NS = (float*)(YB + MLC_NS) + (size_t)bh * 32 * 64; float* MS = (float*)(YB + MLC_MS) + bh * 32;
    f32x4 C4 = (f32x4){0.f, 0.f, 0.f, 0.f}; float nv = 0.f, m = 0.f;
    const bool do_n = (sl == 0) && (c.tid < 64);
#pragma unroll 4
    for (int n = 0; n < 32; ++n) {
        *(u32x2*)(CS + (size_t)n * 8192) = (u32x2){pk2(C4[0], C4[1]), pk2(C4[2], C4[3])};
        if (do_n) NS[n * 64 + c.tid] = nv;
        if (sl == 0 && c.tid == 0) MS[n] = m;
        const float be = BE[n], ml = ML[n];
        const float mn = fmaxf(be + m, ml), keep = expf(be + m - mn), g = expf(ml - mn);
        m = mn;
        const f32x4 d = *(const f32x4*)(DC + (size_t)n * 8192);
        C4 = C4 * keep + d * g;
        if (do_n) nv = nv * keep + DN[n * 64 + c.tid] * g;
    }
}

__device__ __forceinline__ void mlc_passC(int u, const bf16_t* PROJ, const float* GATES, const float* b_i, const float* b_f, const unsigned char* YB,
                                          const float* gain  , bf16_t* MIXO, const Ctx& c) {
    const int bh = u >> 5, b = bh >> 2, h = bh & 3;
    const size_t t0 = (size_t)b * SEQ + (u & 31) * 64;
    unsigned char* smem = c.smem;
    float* csL = (float*)(smem + 32768); float* pmL = (float*)(smem + 33024); float* bcL = (float*)(smem + 33280); float* nnL = (float*)(smem + 33536); float* sqL = (float*)(smem + 33792);
    const int lane = c.lane, wid = __builtin_amdgcn_readfirstlane(c.wid);
    const bf16_t* CS = (const bf16_t*)(YB + MLC_CS) + (size_t)u * 8192;
#pragma unroll
    for (int i = 0; i < 4; ++i) { const int j = wid * 4 + i;
        glds16(PROJ + (t0 + 4 * j + (lane >> 4)) * NPAD + 512 + h * 128 + (lane & 15) * 8, smem + j * 1024 + lane * 16);
        glds16(CS + (4 * j + (lane >> 4)) * 128 + (lane & 15) * 8, smem + 16384 + j * 1024 + lane * 16); }
    float bcl = 0.f;
    if (wid == 0) {
        const float ip = GATES[(t0 + lane) * 8 + h] + b_i[h], lf = -softplusf_(-(GATES[(t0 + lane) * 8 + 4 + h] + b_f[h]));
        bcl = scan_add64(lf, lane);
        const float cs = ip - bcl;
        csL[lane] = cs; pmL[lane] = scan_max64(cs, lane);
        nnL[lane] = ((const float*)(YB + MLC_NS))[(size_t)u * 64 + lane];
        bcL[lane] = bcl;
    }
    asm volatile("s_waitcnt vmcnt(0)" ::: "memory");
    __syncthreads();
    const int h5 = lane >> 5, r = lane & 31, i16 = lane & 15, q4 = i16 >> 2, p = i16 & 3, blk = (lane >> 4) & 1;
    const int th = wid & 1, dvh = wid >> 1;
    const int t = th * 32 + r;
    const float m_n = ((const float*)(YB + MLC_MS))[u];
    const float Mt = fmaxf(m_n, pmL[t]), w_inter = __expf(m_n - Mt), em = __expf(-(bcL[t] + Mt));
    bf16x8 qf[4];
#pragma unroll
    for (int ks = 0; ks < 4; ++ks) qf[ks] = *(const bf16x8*)(PROJ + (t0 + t) * NPAD + h * 64 + ks * 16 + h5 * 8);
    float qn = 0.f; bf16x8 qw[4];
#pragma unroll
    for (int ks = 0; ks < 4; ++ks) {
        const u32x4 raw = __builtin_bit_cast(u32x4, qf[ks]); float f[8]; unpack8(raw, f);
#pragma unroll
        for (int j = 0; j < 8; ++j) qn += f[j] * nnL[ks * 16 + h5 * 8 + j];
        qw[ks] = __builtin_bit_cast(bf16x8, (u32x4){pk2(f[0] * w_inter, f[1] * w_inter), pk2(f[2] * w_inter, f[3] * w_inter), pk2(f[4] * w_inter, f[5] * w_inter), pk2(f[6] * w_inter, f[7] * w_inter)});
    }
    qn += shfl_xor_(qn, 32);
    f32x16 x0, x1;
#pragma unroll
    for (int i = 0; i < 16; ++i) { x0[i] = 0.f; x1[i] = 0.f; }
#pragma unroll
    for (int ks = 0; ks < 4; ++ks) {
        const bf16x8 kf0 = *(const bf16x8*)(PROJ + (t0 + r) * NPAD + 256 + h * 64 + ks * 16 + h5 * 8);
        x0 = MFMA32(kf0, qf[ks], x0);
        if (th) { const bf16x8 kf1 = *(const bf16x8*)(PROJ + (t0 + 32 + r) * NPAD + 256 + h * 64 + ks * 16 + h5 * 8); x1 = MFMA32(kf1, qf[ks], x1); }
    }
    float ps = 0.f;
#pragma unroll
    for (int i = 0; i < 16; ++i) {
        const int s = (i & 3) + 8 * (i >> 2) + 4 * h5;
        const float w0 = (s <= t) ? __expf(csL[s] - Mt) * 0.125f : 0.f;
        x0[i] *= w0; ps += x0[i];
        if (th) { const float w1 = (s <= r) ? __expf(csL[32 + s] - Mt) * 0.125f : 0.f; x1[i] *= w1; ps += x1[i]; }
    }
    ps += shfl_xor_(ps, 32);
    const float den = w_inter * qn + ps;
    f32x16 o0, o1;
#pragma unroll
    for (int i = 0; i < 16; ++i) { o0[i] = 0.f; o1[i] = 0.f; }
    {
        const unsigned vb = (unsigned)(size_t)smem + (unsigned)((4 * h5 + q4) * 256 + dvh * 128 + 32 * blk + 8 * p);
#pragma unroll
        for (int st = 0; st < 2; ++st) {
            if (st == 0 || th) {
                s16x4 l00, h00, l01, h01, l10, h10, l11, h11;
                const unsigned va = vb + st * 8192;
                asm volatile("ds_read_b64_tr_b16 %0, %8\n\t"
                             "ds_read_b64_tr_b16 %1, %8 offset:2048\n\t"
                             "ds_read_b64_tr_b16 %2, %8 offset:64\n\t"
                             "ds_read_b64_tr_b16 %3, %8 offset:2112\n\t"
                             "ds_read_b64_tr_b16 %4, %8 offset:4096\n\t"
                             "ds_read_b64_tr_b16 %5, %8 offset:6144\n\t"
                             "ds_read_b64_tr_b16 %6, %8 offset:4160\n\t"
                             "ds_read_b64_tr_b16 %7, %8 offset:6208\n\t"
                             "s_waitcnt lgkmcnt(0)"
                             : "=&v"(l00), "=&v"(h00), "=&v"(l01), "=&v"(h01), "=&v"(l10), "=&v"(h10), "=&v"(l11), "=&v"(h11) : "v"(va) : "memory");
                const bf16x8 v00 = __builtin_shufflevector(l00, h00, 0, 1, 2, 3, 4, 5, 6, 7), v01 = __builtin_shufflevector(l01, h01, 0, 1, 2, 3, 4, 5, 6, 7);
                const bf16x8 v10 = __builtin_shufflevector(l10, h10, 0, 1, 2, 3, 4, 5, 6, 7), v11 = __builtin_shufflevector(l11, h11, 0, 1, 2, 3, 4, 5, 6, 7);
                const bf16x8 pb0 = (st == 0) ? pack_step<0>(x0) : pack_step<0>(x1);
                const bf16x8 pb1 = (st == 0) ? pack_step<1>(x0) : pack_step<1>(x1);
                o0 = MFMA32(v00, pb0, o0); o1 = MFMA32(v01, pb0, o1);
                o0 = MFMA32(v10, pb1, o0); o1 = MFMA32(v11, pb1, o1);
            }
        }
    }
    {
        const unsigned cb = (unsigned)(size_t)smem + 16384u + (unsigned)((8 * h5 + q4) * 256 + dvh * 128 + 32 * blk + 8 * p);
#pragma unroll
        for (int kp = 0; kp < 2; ++kp) {
            s16x4 l00, h00, l01, h01, l10, h10, l11, h11;
            const unsigned ca = cb + kp * 8192;
            asm volatile("ds_read_b64_tr_b16 %0, %8\n\t"
                         "ds_read_b64_tr_b16 %1, %8 offset:1024\n\t"
                         "ds_read_b64_tr_b16 %2, %8 offset:64\n\t"
                         "ds_read_b64_tr_b16 %3, %8 offset:1088\n\t"
                         "ds_read_b64_tr_b16 %4, %8 offset:4096\n\t"
                         "ds_read_b64_tr_b16 %5, %8 offset:5120\n\t"
                         "ds_read_b64_tr_b16 %6, %8 offset:4160\n\t"
                         "ds_read_b64_tr_b16 %7, %8 offset:5184\n\t"
                         "s_waitcnt lgkmcnt(0)"
                         : "=&v"(l00), "=&v"(h00), "=&v"(l01), "=&v"(h01), "=&v"(l10), "=&v"(h10), "=&v"(l11), "=&v"(h11) : "v"(ca) : "memory");
            const bf16x8 c00 = __builtin_shufflevector(l00, h00, 0, 1, 2, 3, 4, 5, 6, 7), c01 = __builtin_shufflevector(l01, h01, 0, 1, 2, 3, 4, 5, 6, 7);
            const bf16x8 c10 = __builtin_shufflevector(l10, h10, 0, 1, 2, 3, 4, 5, 6, 7), c11 = __builtin_shufflevector(l11, h11, 0, 1, 2, 3, 4, 5, 6, 7);
            o0 = MFMA32(c00, qw[2 * kp], o0); o1 = MFMA32(c01, qw[2 * kp], o1);
            o0 = MFMA32(c10, qw[2 * kp + 1], o0); o1 = MFMA32(c11, qw[2 * kp + 1], o1);
        }
    }
    const float inv = __builtin_amdgcn_rcpf(fmaxf(fabsf(den), em));
    float ss = 0.f;
#pragma unroll
    for (int i = 0; i < 16; ++i) { o0[i] *= inv; o1[i] *= inv; ss += o0[i] * o0[i] + o1[i] * o1[i]; }
    ss += shfl_xor_(ss, 32);
    if (h5 == 0) sqL[wid * 32 + r] = ss;
    __syncthreads();
    const float rr = rsqrtf((sqL[th * 32 + r] + sqL[(th + 2) * 32 + r]) * (1.f / 128.f) + 1e-6f);
    const bf16_t* grow = PROJ + (t0 + t) * NPAD + 1032 + h * 128 + dvh * 64 + 4 * h5;
    const float* gn = gain + h * 128 + dvh * 64 + 4 * h5;
    bf16_t* orow = MIXO + (t0 + t) * 1024 + h * 128 + dvh * 64 + 4 * h5;
#pragma unroll
    for (int d = 0; d < 2; ++d)
#pragma unroll
        for (int g = 0; g < 4; ++g) {
            const u32x2 zr = *(const u32x2*)(grow + d * 32 + 8 * g);
            const f32x4 gv = *(const f32x4*)(gn + d * 32 + 8 * g);
            const float z0 = bflo(zr.x), z1 = bfhi(zr.x), z2 = bflo(zr.y), z3 = bfhi(zr.y);
            const float y0 = (d ? o1[4 * g] : o0[4 * g]) * rr * gv[0] * sigmoidf_(z0), y1 = (d ? o1[4 * g + 1] : o0[4 * g + 1]) * rr * gv[1] * sigmoidf_(z1);
            const float y2 = (d ? o1[4 * g + 2] : o0[4 * g + 2]) * rr * gv[2] * sigmoidf_(z2), y3 = (d ? o1[4 * g + 3] : o0[4 * g + 3]) * rr * gv[3] * sigmoidf_(z3);
            *(u32x2*)(orow + d * 32 + 8 * g) = (u32x2){pk2(y0, y1), pk2(y2, y3)};
        }
}

constexpr size_t GD_WN = 0, GD_UU = GD_WN + (size_t)1024 * 16384, GD_KGT = GD_UU + (size_t)1024 * 16384, GD_QG = GD_KGT + (size_t)1024 * 16384,
                 GD_AT = GD_QG + (size_t)1024 * 16384, GD_GL = GD_AT + (size_t)1024 * 8192, GD_END = GD_GL + 4096;
static_assert(GD_END <= (size_t)MAXROWS * 256 * 2, "GDN chunk records must fit the HBUF region");

__device__ __forceinline__ void gdc_passA(int u, const bf16_t* GQ, const bf16_t* GK, const bf16_t* GV, const float* BETA, const float* GLOG, unsigned char* HB, const Ctx& c) {
    const int bh = u >> 5, b = bh >> 2, h = bh & 3;
    const size_t t0 = (size_t)b * SEQ + (u & 31) * 64;
    unsigned char* smem = c.smem;
    float* Lm = (float*)(smem + 49152);
    float* GA = (float*)(smem + 65536 + 64); float* BT = GA + 64; float* EG = BT + 64; float* EK = EG + 64;
    const int lane = c.lane, wid = __builtin_amdgcn_readfirstlane(c.wid);
    const int h5 = lane >> 5, r = lane & 31;
    if (wid == 0) {
        const float g = GLOG[(t0 + lane) * 4 + h];
        const float G = scan_add64(g, lane), Gl = shfl_c_(G, 63);
        GA[lane] = G; BT[lane] = BETA[(t0 + lane) * 4 + h]; EG[lane] = expf(G); EK[lane] = expf(Gl - G);
        if (lane == 0) ((float*)(HB + GD_GL))[u] = expf(Gl);
    }
    __syncthreads();
    if (wid < 3) {
        const int it = (wid + 1) >> 1, jt = wid >> 1;
        f32x16 dl, da;
#pragma unroll
        for (int i = 0; i < 16; ++i) { dl[i] = 0.f; da[i] = 0.f; }
#pragma unroll
        for (int ks = 0; ks < 8; ++ks) {
            const bf16x8 ki = *(const bf16x8*)(GK + (t0 + 32 * it + r) * 512 + h * 128 + ks * 16 + h5 * 8);
            const bf16x8 kj = *(const bf16x8*)(GK + (t0 + 32 * jt + r) * 512 + h * 128 + ks * 16 + h5 * 8);
            const bf16x8 qi = *(const bf16x8*)(GQ + (t0 + 32 * it + r) * 512 + h * 128 + ks * 16 + h5 * 8);
            dl = MFMA32(ki, kj, dl); da = MFMA32(qi, kj, da);
        }
        const int j = 32 * jt + r; const float Gj = GA[j];
        bf16_t* AT = (bf16_t*)(HB + GD_AT) + (size_t)u * 4096;
#pragma unroll
        for (int i = 0; i < 16; ++i) {
            const int ii = 32 * it + (i & 3) + 8 * (i >> 2) + 4 * h5;
            const float dec = __expf(GA[ii] - Gj);
            Lm[ii * 64 + j] = (j < ii) ? dl[i] * BT[ii] * dec : 0.f;
            AT[ii * 64 + j] = (bf16_t)f2bf((j <= ii) ? da[i] * dec : 0.f);
        }
        if (wid == 0) {
#pragma unroll
            for (int i = 0; i < 16; ++i) { const int ii = (i & 3) + 8 * (i >> 2) + 4 * h5; Lm[ii * 64 + 32 + r] = 0.f; AT[ii * 64 + 32 + r] = 0; }
        }
    }
    __syncthreads();
    if (wid == 0) {
        float Tc[64];
#pragma unroll
        for (int i = 0; i < 64; ++i) {
            float s = (i == lane) ? 1.f : 0.f;
#pragma unroll
            for (int k = 0; k < i; ++k) s -= Lm[i * 64 + k] * Tc[k];
            Tc[i] = s;
        }
        bf16_t* Tm = (bf16_t*)Lm;
#pragma unroll
        for (int i = 0; i < 64; ++i) Tm[i * 64 + lane] = (bf16_t)f2bf(Tc[i]);
    } else {
        const int t3 = c.tid - 64;
        for (int idx = t3; idx < 4096; idx += 192) {
            const int arr = idx >> 10, rem = idx & 1023, row = rem >> 4, chk = rem & 15;
            const bf16_t* sp = ((arr == 1) ? GV : (arr == 3) ? GQ : GK) + (t0 + row) * 512 + h * 128 + chk * 8;
            const u32x4 raw = *(const u32x4*)sp; float f[8]; unpack8(raw, f);
            const float sc = (arr == 0) ? BT[row] * EG[row] : (arr == 1) ? BT[row] : (arr == 2) ? EK[row] : EG[row];
            const u32x4 o = (u32x4){pk2(f[0] * sc, f[1] * sc), pk2(f[2] * sc, f[3] * sc), pk2(f[4] * sc, f[5] * sc), pk2(f[6] * sc, f[7] * sc)};
            if (arr < 3) *(u32x4*)(smem + arr * 16384 + row * 256 + chk * 16) = o;
            else *(u32x4*)((bf16_t*)(HB + GD_QG) + (size_t)u * 8192 + row * 128 + chk * 8) = o;
        }
    }
    __syncthreads();
    {
        const int i16 = lane & 15, q4 = i16 >> 2, p = i16 & 3, blk = (lane >> 4) & 1;
        const unsigned char* Tm = smem + 49152;
        f32x16 u0, u1, w0, w1;
#pragma unroll
        for (int i = 0; i < 16; ++i) { u0[i] = 0.f; u1[i] = 0.f; w0[i] = 0.f; w1[i] = 0.f; }
        const unsigned ib = (unsigned)(size_t)smem + (unsigned)((8 * h5 + q4) * 256 + wid * 64 + 32 * blk + 8 * p);
#pragma unroll
        for (int ks = 0; ks < 4; ++ks) {
            s16x4 kl, kh, vl, vh;
            const unsigned ia = ib + ks * 4096;
            asm volatile("ds_read_b64_tr_b16 %0, %4\n\t"
                         "ds_read_b64_tr_b16 %1, %4 offset:1024\n\t"
                         "ds_read_b64_tr_b16 %2, %4 offset:16384\n\t"
                         "ds_read_b64_tr_b16 %3, %4 offset:17408\n\t"
                         "s_waitcnt lgkmcnt(0)"
                         : "=&v"(kl), "=&v"(kh), "=&v"(vl), "=&v"(vh) : "v"(ia) : "memory");
            const bf16x8 kb = __builtin_shufflevector(kl, kh, 0, 1, 2, 3, 4, 5, 6, 7), vb = __builtin_shufflevector(vl, vh, 0, 1, 2, 3, 4, 5, 6, 7);
            const bf16x8 t1 = *(const bf16x8*)(Tm + (32 + r) * 128 + ks * 32 + h5 * 16);
            w1 = MFMA32(t1, kb, w1); u1 = MFMA32(t1, vb, u1);
            if (ks < 2) { const bf16x8 tt0 = *(const bf16x8*)(Tm + r * 128 + ks * 32 + h5 * 16); w0 = MFMA32(tt0, kb, w0); u0 = MFMA32(tt0, vb, u0); }
        }
        bf16_t* WN = (bf16_t*)(HB + GD_WN) + (size_t)u * 8192; bf16_t* UU = (bf16_t*)(HB + GD_UU) + (size_t)u * 8192;
#pragma unroll
        for (int i = 0; i < 16; ++i) {
            const int s = (i & 3) + 8 * (i >> 2) + 4 * h5;
            WN[s * 128 + wid * 32 + r] = (bf16_t)f2bf(-w0[i]); WN[(32 + s) * 128 + wid * 32 + r] = (bf16_t)f2bf(-w1[i]);
        }
        {
            u32x4* up = (u32x4*)(UU + (size_t)(wid * 64 + lane) * 32);
            up[0] = (u32x4){pk2(u0[0], u0[1]), pk2(u0[2], u0[3]), pk2(u0[4], u0[5]), pk2(u0[6], u0[7])};
            up[1] = (u32x4){pk2(u0[8], u0[9]), pk2(u0[10], u0[11]), pk2(u0[12], u0[13]), pk2(u0[14], u0[15])};
            up[2] = (u32x4){pk2(u1[0], u1[1]), pk2(u1[2], u1[3]), pk2(u1[4], u1[5]), pk2(u1[6], u1[7])};
            up[3] = (u32x4){pk2(u1[8], u1[9]), pk2(u1[10], u1[11]), pk2(u1[12], u1[13]), pk2(u1[14], u1[15])};
        }
        bf16_t* KGT = (bf16_t*)(HB + GD_KGT) + (size_t)u * 8192;
        const int gq = lane >> 4;
        const unsigned kb0 = (unsigned)(size_t)smem + 32768u + (unsigned)(q4 * 256 + gq * 32 + 8 * p);
#pragma unroll
        for (int it2 = 0; it2 < 8; ++it2) {
            const int job = wid * 8 + it2, s0 = (job & 15) * 4, dkb = (job >> 4) * 64;
            s16x4 v;
            const unsigned ad = kb0 + s0 * 256 + dkb * 2;
            asm volatile("ds_read_b64_tr_b16 %0, %1\n\ts_waitcnt lgkmcnt(0)" : "=&v"(v) : "v"(ad) : "memory");
            *(s16x4*)(KGT + (size_t)(dkb + gq * 16 + i16) * 64 + s0) = v;
        }
    }
}

constexpr size_t GC_ST = 0, GC_VT = (size_t)1024 * 32768;
__device__ __forceinline__ void gdc_passB(int bh, const unsigned char* HB, unsigned char* YB, const Ctx& c) {
    const int lane = c.lane, wid = __builtin_amdgcn_readfirstlane(c.wid);
    const int h5 = lane >> 5, r = lane & 31;
    unsigned char* smem = c.smem;
    f32x16 S0, S1, S2, S3;
#pragma unroll
    for (int i = 0; i < 16; ++i) { S0[i] = 0.f; S1[i] = 0.f; S2[i] = 0.f; S3[i] = 0.f; }
    const size_t u0 = (size_t)bh * 32;
#define GB_STAGE(n_, p_) do { const bf16_t* wn_ = (const bf16_t*)(HB + GD_WN) + (u0 + (n_)) * 8192; const bf16_t* kg_ = (const bf16_t*)(HB + GD_KGT) + (u0 + (n_)) * 8192; \
        unsigned char* bp_ = smem + (p_) * 32768; \
        _Pragma("unroll") for (int i = 0; i < 4; ++i) { const int jj = wid * 4 + i, row = 4 * jj + (lane >> 4), ch = (lane & 15) ^ (row & 15); \
            glds16(wn_ + row * 128 + ch * 8, bp_ + jj * 1024 + lane * 16); } \
        _Pragma("unroll") for (int i = 0; i < 4; ++i) { const int jj = wid * 4 + i, row = 8 * jj + (lane >> 3), ch = (lane & 7) ^ ((row >> 1) & 7); \
            glds16(kg_ + row * 64 + ch * 8, bp_ + 16384 + jj * 1024 + lane * 16); } } while (0)
#define LD128(base_, R_, ks_) __builtin_shufflevector(*(const s16x4*)((base_) + (R_) * 256 + (((2 * (ks_)) ^ (rl & 15)) << 4) + 8 * hl), \
                                                      *(const s16x4*)((base_) + (R_) * 256 + (((2 * (ks_) + 1) ^ (rl & 15)) << 4) + 8 * hl), 0, 1, 2, 3, 4, 5, 6, 7)
#define LD64(base_, R_, k2_) __builtin_shufflevector(*(const s16x4*)((base_) + (R_) * 128 + (((2 * (k2_)) ^ ((rl >> 1) & 7)) << 4) + 8 * hl), \
                                                     *(const s16x4*)((base_) + (R_) * 128 + (((2 * (k2_) + 1) ^ ((rl >> 1) & 7)) << 4) + 8 * hl), 0, 1, 2, 3, 4, 5, 6, 7)
    u32x4 uu[4];
#define GB_LOADU(n_) do { const u32x4* up_ = (const u32x4*)((const bf16_t*)(HB + GD_UU) + (u0 + (n_)) * 8192 + (size_t)(wid * 64 + lane) * 32); \
        uu[0] = up_[0]; uu[1] = up_[1]; uu[2] = up_[2]; uu[3] = up_[3]; } while (0)
    __syncthreads();
    GB_STAGE(0, 0);
    GB_LOADU(0);
#pragma unroll 1
    for (int n2 = 0; n2 < 16; ++n2) {
#pragma unroll
        for (int PBUF = 0; PBUF < 2; ++PBUF) {
        const int n = 2 * n2 + PBUF;
        const float gl = ((const float*)(HB + GD_GL))[u0 + n];
        if (n == 0) asm volatile("s_waitcnt vmcnt(0)" ::: "memory"); else asm volatile("s_waitcnt vmcnt(24)" ::: "memory");
        asm volatile("s_waitcnt lgkmcnt(0)" ::: "memory"); __builtin_amdgcn_s_barrier(); asm volatile("" ::: "memory");
        f32x16 v0, v1;
#pragma unroll
        for (int q = 0; q < 2; ++q) {
            const u32x4 a = uu[q], bq = uu[2 + q];
            v0[8 * q + 0] = bflo(a.x); v0[8 * q + 1] = bfhi(a.x); v0[8 * q + 2] = bflo(a.y); v0[8 * q + 3] = bfhi(a.y);
            v0[8 * q + 4] = bflo(a.z); v0[8 * q + 5] = bfhi(a.z); v0[8 * q + 6] = bflo(a.w); v0[8 * q + 7] = bfhi(a.w);
            v1[8 * q + 0] = bflo(bq.x); v1[8 * q + 1] = bfhi(bq.x); v1[8 * q + 2] = bflo(bq.y); v1[8 * q + 3] = bfhi(bq.y);
            v1[8 * q + 4] = bflo(bq.z); v1[8 * q + 5] = bfhi(bq.z); v1[8 * q + 6] = bflo(bq.w); v1[8 * q + 7] = bfhi(bq.w);
        }
        if (n + 1 < 32) { GB_STAGE(n + 1, (PBUF ^ 1)); GB_LOADU(n + 1); }
        int rl = r, hl = h5; asm volatile("" : "+v"(rl), "+v"(hl));
        const unsigned char* WNb = smem + PBUF * 32768; const unsigned char* KGb = WNb + 16384;
        {
            bf16_t* st = (bf16_t*)(YB + GC_ST) + (u0 + n) * 16384 + (size_t)h5 * 512 + (size_t)(wid * 32 + r) * 4;
#define ST_TILE(SX, dt_) do { _Pragma("unroll") for (int g = 0; g < 4; ++g) \
                *(u32x2*)(st + ((dt_) * 8 + 2 * g) * 512) = (u32x2){cvt_pk(SX[4 * g], SX[4 * g + 1]), cvt_pk(SX[4 * g + 2], SX[4 * g + 3])}; } while (0)
            ST_TILE(S0, 0); ST_TILE(S1, 1); ST_TILE(S2, 2); ST_TILE(S3, 3);
#undef ST_TILE
        }
        {
            bf16x8 fa0, fb0, fa1, fb1, fa2, fb2;
#define LDV(FA, FB, ks_) do { FA = LD128(WNb, rl, ks_); FB = LD128(WNb, 32 + rl, ks_); } while (0)
#define MMV(SX, HF, FA, FB) do { const bf16x8 sbk = pack_step<HF>(SX); v0 = MFMA32(FA, sbk, v0); v1 = MFMA32(FB, sbk, v1); } while (0)
            LDV(fa0, fb0, 0); LDV(fa1, fb1, 1); LDV(fa2, fb2, 2);
            MMV(S0, 0, fa0, fb0); LDV(fa0, fb0, 3);
            MMV(S0, 1, fa1, fb1); LDV(fa1, fb1, 4);
            MMV(S1, 0, fa2, fb2); LDV(fa2, fb2, 5);
            MMV(S1, 1, fa0, fb0); LDV(fa0, fb0, 6);
            MMV(S2, 0, fa1, fb1); LDV(fa1, fb1, 7);
            MMV(S2, 1, fa2, fb2);
            MMV(S3, 0, fa0, fb0);
            MMV(S3, 1, fa1, fb1);
#undef LDV
#undef MMV
        }
        const bf16x8 vb0 = pack_step_m<0>(v0), vb1 = pack_step_m<1>(v0), vb2 = pack_step_m<0>(v1), vb3 = pack_step_m<1>(v1);
        {
            bf16_t* vt = (bf16_t*)(YB + GC_VT) + (u0 + n) * 8192 + (size_t)h5 * 512 + (size_t)(wid * 32 + r) * 4;
            const u32x4 p0 = __builtin_bit_cast(u32x4, vb0), p1 = __builtin_bit_cast(u32x4, vb1), p2 = __builtin_bit_cast(u32x4, vb2), p3 = __builtin_bit_cast(u32x4, vb3);
            *(u32x2*)(vt + 0 * 512) = (u32x2){p0.x, p0.y};  *(u32x2*)(vt + 2 * 512) = (u32x2){p0.z, p0.w};
            *(u32x2*)(vt + 4 * 512) = (u32x2){p1.x, p1.y};  *(u32x2*)(vt + 6 * 512) = (u32x2){p1.z, p1.w};
            *(u32x2*)(vt + 8 * 512) = (u32x2){p2.x, p2.y};  *(u32x2*)(vt + 10 * 512) = (u32x2){p2.z, p2.w};
            *(u32x2*)(vt + 12 * 512) = (u32x2){p3.x, p3.y}; *(u32x2*)(vt + 14 * 512) = (u32x2){p3.z, p3.w};
        }
        asm volatile("" ::: "memory"); asm volatile("" : "+v"(rl), "+v"(hl));
        S0 *= gl; S1 *= gl; S2 *= gl; S3 *= gl;
        {
            bf16x8 g0, g1, g2;
            g0 = LD64(KGb, rl, 0); g1 = LD64(KGb, rl, 1); g2 = LD64(KGb, rl, 2);
            S0 = MFMA32(g0, vb0, S0); g0 = LD64(KGb, rl, 3);
            S0 = MFMA32(g1, vb1, S0); g1 = LD64(KGb, 32 + rl, 0);
            S0 = MFMA32(g2, vb2, S0); g2 = LD64(KGb, 32 + rl, 1);
            S0 = MFMA32(g0, vb3, S0); g0 = LD64(KGb, 32 + rl, 2);
            S1 = MFMA32(g1, vb0, S1); g1 = LD64(KGb, 32 + rl, 3);
            S1 = MFMA32(g2, vb1, S1); g2 = LD64(KGb, 64 + rl, 0);
            S1 = MFMA32(g0, vb2, S1); g0 = LD64(KGb, 64 + rl, 1);
            S1 = MFMA32(g1, vb3, S1); g1 = LD64(KGb, 64 + rl, 2);
            S2 = MFMA32(g2, vb0, S2); g2 = LD64(KGb, 64 + rl, 3);
            S2 = MFMA32(g0, vb1, S2); g0 = LD64(KGb, 96 + rl, 0);
            S2 = MFMA32(g1, vb2, S2); g1 = LD64(KGb, 96 + rl, 1);
            S2 = MFMA32(g2, vb3, S2); g2 = LD64(KGb, 96 + rl, 2);
            S3 = MFMA32(g0, vb0, S3); g0 = LD64(KGb, 96 + rl, 3);
            S3 = MFMA32(g1, vb1, S3);
            S3 = MFMA32(g2, vb2, S3);
            S3 = MFMA32(g0, vb3, S3);
        }
        }
    }
#undef GB_STAGE
#undef LD128
#undef LD64
#undef GB_LOADU
}

__device__ __forceinline__ void gdc_passB_idle() {
    __syncthreads();
    for (int n = 0; n < 32; ++n) { asm volatile("" ::: "memory"); __builtin_amdgcn_s_barrier(); asm volatile("" ::: "memory"); }
}

__device__ __forceinline__ void gdc_passC(int u, const unsigned char* HB, const unsigned char* YB, const bf16_t* PROJ, const float* gnorm, bf16_t* MIXO, const Ctx& c) {
    const int bh = u >> 5, b = bh >> 2, h = bh & 3;
    const size_t t0 = (size_t)b * SEQ + (u & 31) * 64;
    const int lane = c.lane, wid = __builtin_amdgcn_readfirstlane(c.wid);
    const int h5 = lane >> 5, r = lane & 31;
    float* sqL = (float*)c.smem;
    const bf16_t* ST = (const bf16_t*)(YB + GC_ST) + (size_t)u * 16384 + (size_t)(2 * h5) * 512 + (size_t)(wid * 32 + r) * 4;
    const bf16_t* VT = (const bf16_t*)(YB + GC_VT) + (size_t)u * 8192 + (size_t)(2 * h5) * 512 + (size_t)(wid * 32 + r) * 4;
    const bf16_t* QG = (const bf16_t*)(HB + GD_QG) + (size_t)u * 8192 + (size_t)r * 128 + 8 * h5;
    const bf16_t* AT = (const bf16_t*)(HB + GD_AT) + (size_t)u * 4096 + (size_t)r * 64 + 8 * h5;
    f32x16 o0, o1;
#pragma unroll
    for (int i = 0; i < 16; ++i) { o0[i] = 0.f; o1[i] = 0.f; }
#pragma unroll
    for (int ks = 0; ks < 8; ++ks) {
        const bf16x8 sa = __builtin_shufflevector(*(const s16x4*)(ST + (4 * ks) * 512), *(const s16x4*)(ST + (4 * ks + 1) * 512), 0, 1, 2, 3, 4, 5, 6, 7);
        const bf16x8 q0 = *(const bf16x8*)(QG + ks * 16), q1 = *(const bf16x8*)(QG + 32 * 128 + ks * 16);
        o0 = MFMA32(sa, q0, o0); o1 = MFMA32(sa, q1, o1);
        if (ks == 3) asm volatile("" ::: "memory");
    }
#pragma unroll
    for (int k2 = 0; k2 < 4; ++k2) {
        const bf16x8 va = __builtin_shufflevector(*(const s16x4*)(VT + (4 * k2) * 512), *(const s16x4*)(VT + (4 * k2 + 1) * 512), 0, 1, 2, 3, 4, 5, 6, 7);
        const bf16x8 a1 = *(const bf16x8*)(AT + 32 * 64 + k2 * 16);
        o1 = MFMA32(va, a1, o1);
        if (k2 < 2) { const bf16x8 a0 = *(const bf16x8*)(AT + k2 * 16); o0 = MFMA32(va, a0, o0); }
    }
    float s0 = 0.f, s1 = 0.f;
#pragma unroll
    for (int i = 0; i < 16; ++i) { s0 += o0[i] * o0[i]; s1 += o1[i] * o1[i]; }
    s0 += shfl_xor_(s0, 32); s1 += shfl_xor_(s1, 32);
    __syncthreads();
    if (h5 == 0) { sqL[wid * 64 + r] = s0; sqL[wid * 64 + 32 + r] = s1; }
    __syncthreads();
    const float rr0 = rsqrtf((sqL[r] + sqL[64 + r] + sqL[128 + r] + sqL[192 + r]) * (1.f / 128.f) + 1e-6f);
    const float rr1 = rsqrtf((sqL[32 + r] + sqL[96 + r] + sqL[160 + r] + sqL[224 + r]) * (1.f / 128.f) + 1e-6f);
#pragma unroll
    for (int tt = 0; tt < 2; ++tt) {
        const size_t t = t0 + tt * 32 + r;
        const bf16_t* zrow = PROJ + t * NPAD + 1960 + h * 128 + wid * 32 + 4 * h5;
        const float* gn = gnorm + wid * 32 + 4 * h5;
        bf16_t* orow = MIXO + t * 1024 + 512 + h * 128 + wid * 32 + 4 * h5;
        const float rr = tt ? rr1 : rr0;
#pragma unroll
        for (int g = 0; g < 4; ++g) {
            const u32x2 zr = *(const u32x2*)(zrow + 8 * g);
            const f32x4 gv = *(const f32x4*)(gn + 8 * g);
            const float z0 = bflo(zr.x), z1 = bfhi(zr.x), z2 = bflo(zr.y), z3 = bfhi(zr.y);
            const float y0 = (tt ? o1[4 * g] : o0[4 * g]) * rr * gv[0] * siluf_(z0), y1 = (tt ? o1[4 * g + 1] : o0[4 * g + 1]) * rr * gv[1] * siluf_(z1);
            const float y2 = (tt ? o1[4 * g + 2] : o0[4 * g + 2]) * rr * gv[2] * siluf_(z2), y3 = (tt ? o1[4 * g + 3] : o0[4 * g + 3]) * rr * gv[3] * siluf_(z3);
            *(u32x2*)(orow + 8 * g) = (u32x2){pk2(y0, y1), pk2(y2, y3)};
        }
    }
}

__device__ __forceinline__ void phase_post(const float* OG, const bf16_t* PROJ, const float* gain, bool odd, bf16_t* MIXO, const Ctx& c) {
    const int lane = c.lane;
    const int gcol = odd ? 1032 : 1960, ocol = odd ? 0 : 512;
    for (int t = c.bid * 4 + c.wid; t < T; t += c.nblk * 4) {
        const f32x4 a0 = *(const f32x4*)(OG + (size_t)t * 512 + lane * 8), a1 = *(const f32x4*)(OG + (size_t)t * 512 + lane * 8 + 4);
        float ss = (a0[0] * a0[0] + a0[1] * a0[1]) + (a0[2] * a0[2] + a0[3] * a0[3]) + (a1[0] * a1[0] + a1[1] * a1[1]) + (a1[2] * a1[2] + a1[3] * a1[3]);
        ss = red16(ss);
        const float rr = rsqrtf(ss * (1.f / 128.f) + 1e-6f);
        const u32x4 zr = *(const u32x4*)(PROJ + (size_t)t * NPAD + gcol + lane * 8);
        float z[8]; unpack8(zr, z);
        const int gi = odd ? lane * 8 : (lane & 15) * 8;
        const f32x4 g0 = *(const f32x4*)(gain + gi), g1 = *(const f32x4*)(gain + gi + 4);
        float y[8];
#pragma unroll
        for (int j = 0; j < 4; ++j) {
            const float ga = odd ? sigmoidf_(z[j]) : siluf_(z[j]), gb = odd ? sigmoidf_(z[4 + j]) : siluf_(z[4 + j]);
            y[j] = a0[j] * rr * g0[j] * ga; y[4 + j] = a1[j] * rr * g1[j] * gb;
        }
        *(u32x4*)(MIXO + (size_t)t * 1024 + ocol + lane * 8) = (u32x4){pk2(y[0], y[1]), pk2(y[2], y[3]), pk2(y[4], y[5]), pk2(y[6], y[7])};
    }
}

__global__ void __launch_bounds__(512, 2) fwd(Args a) {
    extern __shared__ __attribute__((aligned(16))) unsigned char smem[];
    Ctx c;
    const int wave_s = __builtin_amdgcn_readfirstlane((int)threadIdx.x >> 6);
#define SET_CTX(cx) do { int t_ = (wave_s << 6) | lane_id_v(); cx.tid0 = t_; cx.half = t_ >> 8; cx.tid = t_ & 255; cx.lane = t_ & 63; cx.wid = (t_ >> 6) & 3; \
        cx.wr = cx.wid >> 1; cx.wc = cx.wid & 1; cx.fr = cx.lane & 15; cx.fq = cx.lane >> 4; cx.bid = blockIdx.x * 2 + cx.half; cx.nblk = gridDim.x * 2; \
        cx.smem0 = smem; cx.smem = smem + cx.half * HALF_LDS; } while (0)
    SET_CTX(c);
#define PH_CTX() SET_CTX(c)
    unsigned char* const ws_base = a.ws;
    const void* const* const ain_base = (const void* const*)__builtin_amdgcn_kernarg_segment_ptr();
    unsigned* ctl = (unsigned*)(ws_base + WS_CTL);
    volatile LAS unsigned* xbw = (volatile LAS unsigned*)(smem + LDS_BLK);
    if (c.tid0 < 8) xbw[c.tid0] = 0u;
    __syncthreads();
    XcdBarrier bar; bar.bar = ctl; bar.x = 0; bar.st = xbw; bar.wave = wave_s;
    if (a.use_bar) bar = xcd_barrier_post(ctl, xbw, c.tid0);
#if ONE_LAUNCH
    const int hi = NPH;
#define IN(k) true
#else
    const int lo = a.ph_lo, hi = a.ph_hi;
#define IN(k) (lo <= (k) && (k) < hi)
#endif
#define PH(k) if (IN(k)) { PH_CTX(); unsigned char* ws = ws_base; const void* const* ain = ain_base; asm volatile("" : "+s"(ws), "+s"(ain));
#define UNIT_CTX() Ctx cu; SET_CTX(cu)
#define SEAM(k) do { if ((k) + 1 < hi) xcd_barrier(bar); } while (0)

#define XBF ((bf16_t*)(ws + WS_XBF))
#define X1 ((float*)(ws + WS_X1))
#define PROJ ((bf16_t*)(ws + U_PROJ))
#define GATES ((float*)(ws + U_GATES))
#define MIXO ((bf16_t*)(ws + U_MIXO))
#define YBUF ((float*)(ws + U_YBUF))
#define ROPEM ((const float*)(ws + WS_ROPEM))
#define ROPES ((const float*)(ws + WS_ROPES))
#define XRES ((layer == 0) ? (const float*)ain[0] : (const float*)a.out)
#define CNT (ctl + CW_CNT + layer * 128)
#define WIN ((const bf16_t*)(ws + WS_WIN) + (size_t)layer * WIN_ELEMS)
#define WOUT ((const bf16_t*)(ws + WS_WOUT) + (size_t)layer * WOUT_ELEMS)

    PH(0) for (int rep = 0; rep < REP_PRO; ++rep) phase_prologue(a, c); SEAM(0); }

    for (int layer = 0; layer < 4; ++layer) {
        const int pb = 1 + layer * PPL;
#if !ONE_LAUNCH
        if (pb >= hi || pb + PPL <= lo) continue;
#endif
        const int jj = layer >> 1;
        const bool odd = (layer & 1) != 0;

        PH(pb + 0) {
                DenseSched S{T / 256, NPAD / 256, 1024, (int)blockIdx.x, (int)gridDim.x};
                EpiIn E{PROJ, GATES, odd ? 1024 : 1952};
                g8::phase<true, false>(smem, (const char*)XBF, (const char*)WIN, 1024, S, E, c.tid0);
            }
            SEAM(pb + 0); }
        PH(pb + 1) for (int rp = 0; rp < ((REP_PHASE == 1) ? 2 : 1); ++rp) { if (rp) xcd_barrier(bar);
            if (!odd) phase_prep_even(PROJ, GATES, (const float*)ain[3] + jj * 256, (const float*)ain[5] + jj * 128, (const float*)ain[7] + jj * 4 * 1536,
                                      (const float*)ain[8] + jj * 4, (const float*)ain[9] + jj * 4, ROPEM,
                                      (bf16_t*)(ws + U_CQ), (bf16_t*)(ws + U_CKV), (bf16_t*)(ws + U_KROPE), (bf16_t*)(ws + U_GQ), (bf16_t*)(ws + U_GK), (bf16_t*)(ws + U_GV),
                                      (float*)(ws + U_BETA), (float*)(ws + U_GLOG), c);
            else {
                phase_prep_odd(PROJ, ROPES, (bf16_t*)(ws + U_QF), (bf16_t*)(ws + U_KN), c);
                unsigned* ctr = ctl + CW_WORK + pb + 1 + 64 * rp;
                for (;;) {
                    const int u = next_unit(ctr, c); UNIT_CTX();
                    if (u >= 1024) break;
                    mlc_passA(u, PROJ, GATES, (const float*)ain[13] + jj * 4, (const float*)ain[14] + jj * 4, (unsigned char*)YBUF, cu);
                }
            }
            }
            SEAM(pb + 1);
        }
        PH(pb + 2) for (int rp = 0; rp < ((REP_PHASE == 2) ? 2 : 1); ++rp) { if (rp) xcd_barrier(bar);
            unsigned* ctr = ctl + CW_WORK + pb + 2 + 64 * rp;
            if (!odd) {
                for (;;) {
                    const int u = next_unit(ctr, c); UNIT_CTX();
                    if (u >= 1024 + MLAUP_TILES) break;
                    if (u < 1024) gdc_passA(u, (const bf16_t*)(ws + U_GQ), (const bf16_t*)(ws + U_GK), (const bf16_t*)(ws + U_GV), (const float*)(ws + U_BETA),
                                            (const float*)(ws + U_GLOG), ws + WS_HBUF, cu);
                    else mla_up_tile(u - 1024, (const bf16_t*)(ws + U_CQ), (const bf16_t*)(ws + WS_WQB) + (size_t)jj * WQB_ELEMS, (const bf16_t*)(ws + U_CKV),
                                     (const bf16_t*)(ws + WS_WKVB) + (size_t)jj * WKVB_ELEMS, ROPEM, (bf16_t*)(ws + U_QF), (bf16_t*)(ws + U_KN), (bf16_t*)(ws + U_VV), cu);
                }
            } else {
                for (;;) {
                    const int u = next_unit(ctr, c); UNIT_CTX();
                    if (u >= 256 + 1024) break;
                    if (u < 256) mlc_passB(u, (unsigned char*)YBUF, cu);
                    else {
                        const int v = u - 256, hq = v & 7, n = (v >> 3) & 15, b = v >> 7, kvh = hq >> 2;
                        const size_t tb = (size_t)b * SEQ;
                        attn_unit<4, true>((const bf16_t*)(ws + U_QF) + tb * 512 + hq * 64, 512, (const bf16_t*)(ws + U_KN) + tb * 128 + kvh * 64, 128,
                                           (const bf16_t*)(ws + U_KN), 0, PROJ + tb * NPAD + 2184 + kvh * 64, NPAD,
                                           MIXO + tb * 1024 + 512 + hq * 64, 1024, n * 128, ((const float*)ain[16])[jj * 8 + hq] * 1.4426950408889634f, cu);
                    }
                }
            }
            }
            SEAM(pb + 2);
        }
        PH(pb + 3) for (int rp = 0; rp < ((REP_PHASE == 3) ? 2 : 1); ++rp) { if (rp) xcd_barrier(bar);
            unsigned* ctr = ctl + CW_WORK + pb + 3 + 64 * rp;
            if (!odd) {
                for (;;) {
                    const int u = next_unit(ctr, c); UNIT_CTX();
                    if (u >= 64 + 1024) break;
                    if (rp > 0 && ((REP_ONLY == 1 && u >= 64) || (REP_ONLY == 2 && u < 64))) continue;
                    if (u < 64) { if ((u & 1) == 0) gdc_passB(u >> 1, ws + WS_HBUF, (unsigned char*)YBUF, cu); else gdc_passB_idle(); }
                    else {
                        const int v = u - 64, qb = 15 - (v >> 6), bh = v & 63, b = bh >> 3, hh = bh & 7;
                        const size_t tb = (size_t)b * SEQ;
                        attn_unit<6, false>((const bf16_t*)(ws + U_QF) + tb * 768 + hh * 96, 768, (const bf16_t*)(ws + U_KN) + tb * 512 + hh * 64, 512,
                                            (const bf16_t*)(ws + U_KROPE) + tb * 32, 32, (const bf16_t*)(ws + U_VV) + tb * 512 + hh * 64, 512,
                                            MIXO + tb * 1024 + hh * 64, 1024, qb * 128, 0.f, cu);
                    }
                }
            } else {
                for (;;) {
                    const int u = next_unit(ctr, c); UNIT_CTX();
                    if (u >= 1024) break;
                    mlc_passC(u, PROJ, GATES, (const float*)ain[13] + jj * 4, (const float*)ain[14] + jj * 4, (const unsigned char*)YBUF, (const float*)ain[15] + jj * 512, MIXO, cu);
                }
            }
            }
            SEAM(pb + 3);
        }
        PH(pb + 4) for (int rp = 0; rp < ((REP_PHASE == 4) ? 2 : 1); ++rp) { if (rp) xcd_barrier(bar);
            if (!odd) {
                unsigned* ctr = ctl + CW_WORK + pb + 4 + 64 * rp;
                for (;;) {
                    const int u = next_unit(ctr, c); UNIT_CTX();
                    if (u >= 1024) break;
                    gdc_passC(u, ws + WS_HBUF, (const unsigned char*)YBUF, PROJ, (const float*)ain[10] + jj * 128, MIXO, cu);
                }
            }
            }
            if (!odd) SEAM(pb + 4);
        }
        PH(pb + 5) {
                DenseSched S{T / 256, 4, 1024, (int)blockIdx.x, (int)gridDim.x};
                EpiOut E{XBF, (bf16_t*)YBUF};
                g8::phase<true, false>(smem, (const char*)MIXO, (const char*)WOUT, 1024, S, E, c.tid0);
            }
            SEAM(pb + 5); }
#if FUSE_LNROUTE
        PH(pb + 6) phase_lnroute((const bf16_t*)YBUF, (const float*)ain[18] + layer * 1024, (const float*)ain[19] + layer * 1024, XBF, (const bf16_t*)(ws + WS_WRT) + (size_t)layer * WRT_ELEMS,
                                 (const float*)ain[21] + layer * 64, CNT, (int*)(ws + WS_LTOK), (float*)(ws + WS_LW), (int*)(ws + WS_ASG), (float*)(ws + WS_ASGW), c); SEAM(pb + 8); }
#else
        PH(pb + 6) for (int rep = 0; rep < REP_TOK; ++rep) phase_ln1((const bf16_t*)YBUF, (const float*)ain[18] + layer * 1024, (const float*)ain[19] + layer * 1024, XBF, c); SEAM(pb + 6); }
        PH(pb + 7) for (int rep = 0; rep < REP_GEMM; ++rep) phase_router(XBF, (const bf16_t*)(ws + WS_WRT) + (size_t)layer * WRT_ELEMS, (float*)(ws + WS_LOG), c); SEAM(pb + 7); }
        PH(pb + 8) phase_route((const float*)(ws + WS_LOG), (const float*)ain[21] + layer * 64, CNT, (int*)(ws + WS_LTOK), (float*)(ws + WS_LW), (int*)(ws + WS_ASG), (float*)(ws + WS_ASGW), c); SEAM(pb + 8); }
#endif
        PH(pb + 9) {
                int* bst8 = (int*)(smem + LDS_BLK + 64); int* eb8 = bst8 + 256;
                build_block_table(CNT, bst8, c);
                for (int rb = c.tid0; rb < bst8[65]; rb += NT) { int e = 0; for (int q = 1; q < 65; ++q) e += (bst8[q] <= rb) ? 1 : 0; eb8[rb] = e; }
                __syncthreads();
                MoeSchedG S{__builtin_amdgcn_readfirstlane(bst8[65]), (int)blockIdx.x, (int)gridDim.x, eb8, bst8, (const int*)(ws + WS_LTOK)};
                EpiMoe1 E{(bf16_t*)(ws + WS_HBUF)};
                g8::phase<false, true>(smem, (const char*)XBF, (const char*)((const bf16_t*)(ws + WS_WGU) + (size_t)layer * 65 * WGU_ELEMS), 1024, S, E, c.tid0);
            }
            SEAM(pb + 9); }
        PH(pb + 10)
#if MOE2_G8
            {
                int* bst8 = (int*)(smem + LDS_BLK + 64); int* eb8 = bst8 + 256;
                build_block_table(CNT, bst8, c);
                for (int rb = c.tid0; rb < bst8[65]; rb += NT) { int e = 0; for (int q = 1; q < 65; ++q) e += (bst8[q] <= rb) ? 1 : 0; eb8[rb] = e; }
                __syncthreads();
                MoeSched S{__builtin_amdgcn_readfirstlane(bst8[65]), 4, (int)blockIdx.x, (int)gridDim.x, eb8};
                EpiMoe2 E{(bf16_t*)(ws + U_Y)};
                g8::phase<true, false>(smem, (const char*)(ws + WS_HBUF), (const char*)((const bf16_t*)(ws + WS_WDN) + (size_t)layer * 65 * WDN_ELEMS), 256, S, E, c.tid0);
            }
#else
            phase_moe2((const bf16_t*)(ws + WS_HBUF), (const bf16_t*)(ws + WS_WDN) + (size_t)layer * 65 * WDN_ELEMS, CNT, (bf16_t*)(ws + U_Y), c);
#endif
            SEAM(pb + 10); }
        PH(pb + 11)
            if (layer == 3) phase_combine<true>((const bf16_t*)(ws + U_Y), (const int*)(ws + WS_ASG), (const float*)(ws + WS_ASGW), CNT, (const float*)ain[28] + layer * 1024, (const float*)ain[29] + layer * 1024, a.out, XBF, c);
            else phase_combine<false>((const bf16_t*)(ws + U_Y), (const int*)(ws + WS_ASG), (const float*)(ws + WS_ASGW), CNT, (const float*)ain[28] + layer * 1024, (const float*)ain[29] + layer * 1024, a.out, XBF, c);
            SEAM(pb + 11); }
    }
#undef IN
#undef XBF
#undef X1
#undef PROJ
#undef GATES
#undef MIXO
#undef YBUF
#undef ROPEM
#undef ROPES
#undef XRES
#undef CNT
#undef WIN
#undef WOUT
#undef PH
#undef PH_CTX
#undef UNIT_CTX
#undef SEAM
}

extern "C" void kernel_launch(void* const* d_in, const int* in_sizes, int n_in, void* d_out, int out_size, void* d_ws, size_t ws_size, hipStream_t stream) {
    static int grid = 0;
    if (grid == 0) {
        if (n_in != 30 || out_size != T * 1024 || ws_size < WS_END) {
            fprintf(stderr, "kernel_launch: unexpected shapes (n_in %d, out %d, ws %zu < %zu)\n", n_in, out_size, ws_size, (size_t)WS_END);
            grid = -1; return;
        }
        int dev = 0, cus = 0, per_cu = 0;
        (void)hipGetDevice(&dev);
        (void)hipDeviceGetAttribute(&cus, hipDeviceAttributeMultiprocessorCount, dev);
        (void)hipFuncSetAttribute((const void*)fwd, hipFuncAttributeMaxDynamicSharedMemorySize, DYN_LDS);
        (void)hipOccupancyMaxActiveBlocksPerMultiprocessor(&per_cu, (const void*)fwd, NT, DYN_LDS);
        (void)hipGetLastError();
        if (per_cu < 1) per_cu = 1;
        grid = cus;
    }
    if (grid < 0) return;
    (void)hipMemsetAsync((char*)d_ws + WS_CTL, 0, CTL_BYTES, stream);
    Args a{};
    for (int i = 0; i < 30; ++i) a.in[i] = d_in[i];
    a.out = (float*)d_out; a.ws = (unsigned char*)d_ws; a.pad = 0;
#if ONE_LAUNCH
    a.ph_lo = 0; a.ph_hi = NPH; a.use_bar = 1;
    hipLaunchKernelGGL(fwd, dim3(grid), dim3(NT), DYN_LDS, stream, a);
#else
    for (int p = 0; p < NPH; ++p) {
        a.ph_lo = p; a.ph_hi = p + 1; a.use_bar = 0;
        hipLaunchKernelGGL(fwd, dim3(grid), dim3(NT), DYN_LDS, stream, a);
    }
#endif
}
```

```cpp
#include <hip/hip_runtime.h>
#include <stdint.h>
#include <stdio.h>

#define REP_GEMM 1
#define REP_PHASE 0
#define REP_G0 1
#define REP_G1 1
#define REP_G2 1
#define REP_G3 1
#define REP_MIX 1
#define REP_ONLY 0
#define REP_CMB 1
#define REP_PRO 1
#define REP_TOK 1
#define MOE2_G8 1
#ifndef G8_SPLIT
#define G8_SPLIT 0
#endif
#ifndef FUSE_LNROUTE
#define FUSE_LNROUTE 1
#endif
#ifndef ONE_LAUNCH
#define ONE_LAUNCH 1
#endif

typedef unsigned short bf16_t;
typedef short bf16x8 __attribute__((ext_vector_type(8)));
typedef float f32x4 __attribute__((ext_vector_type(4)));
typedef unsigned u32x4 __attribute__((ext_vector_type(4)));
typedef unsigned u32x2 __attribute__((ext_vector_type(2)));
#define LAS __attribute__((address_space(3)))
#define GAS __attribute__((address_space(1)))

constexpr int T = 16384, SEQ = 2048;
constexpr int NPAD = 2560;
constexpr int CAP = 16384;
constexpr int RBR = 256;
constexpr int MAXRB = 512 + 64 + 64;
constexpr int MAXROWS = MAXRB * RBR;
constexpr float ALPHA = 1.681792830507429f;
constexpr int PPL = 12;
constexpr int NPH = 1 + 4 * PPL;
constexpr int NT = 512, NW = 8;
constexpr int HALF_LDS = 65536 + 64 + 1024;
constexpr int LDS_BLK = 2 * HALF_LDS;
constexpr int DYN_LDS = LDS_BLK + 64 + 1024 + 2560;

constexpr size_t cmax(size_t a, size_t b) { return a > b ? a : b; }
constexpr size_t WS_CTL = 0;
constexpr size_t CTL_BYTES = 65536;
constexpr size_t WS_WIN = WS_CTL + CTL_BYTES;
constexpr size_t WIN_ELEMS = (size_t)NPAD * 1024;
constexpr size_t WS_WQB = WS_WIN + 4 * WIN_ELEMS * 2;
constexpr size_t WQB_ELEMS = 768 * 256;
constexpr size_t WS_WKVB = WS_WQB + 2 * WQB_ELEMS * 2;
constexpr size_t WKVB_ELEMS = 1024 * 128;
constexpr size_t WS_WOUT = WS_WKVB + 2 * WKVB_ELEMS * 2;
constexpr size_t WOUT_ELEMS = 1024 * 1024;
constexpr size_t WS_WRT = WS_WOUT + 4 * WOUT_ELEMS * 2;
constexpr size_t WRT_ELEMS = 128 * 1024;
constexpr size_t WS_WGU = WS_WRT + 4 * WRT_ELEMS * 2;
constexpr size_t WGU_ELEMS = 512 * 1024;
constexpr size_t WS_WDN = WS_WGU + 4 * 65 * WGU_ELEMS * 2;
constexpr size_t WDN_ELEMS = 1024 * 256;
constexpr size_t WS_ROPEM = WS_WDN + 4 * 65 * WDN_ELEMS * 2;
constexpr size_t WS_ROPES = WS_ROPEM + (size_t)T * 16 * 2 * 4;
constexpr size_t WS_X1 = WS_ROPES + (size_t)T * 32 * 2 * 4;
constexpr size_t WS_XBF = WS_X1 + (size_t)T * 1024 * 4;
constexpr size_t WS_HBUF = WS_XBF + (size_t)T * 1024 * 2;
constexpr size_t WS_LOG = WS_HBUF + (size_t)MAXROWS * 256 * 2;
constexpr size_t WS_ASG = WS_LOG + (size_t)T * 64 * 4;
constexpr size_t WS_ASGW = WS_ASG + (size_t)T * 8 * 4;
constexpr size_t WS_LTOK = WS_ASGW + (size_t)T * 8 * 4;
constexpr size_t WS_LW = WS_LTOK + (size_t)65 * CAP * 4;
constexpr size_t WS_U = WS_LW + (size_t)65 * CAP * 4;
constexpr size_t U_Y = WS_U;
constexpr size_t U_PROJ = WS_U;
constexpr size_t U_GATES = U_PROJ + (size_t)T * NPAD * 2;
constexpr size_t U_CQ = U_GATES + (size_t)T * 8 * 4;
constexpr size_t U_CKV = U_CQ + (size_t)T * 256 * 2;
constexpr size_t U_KROPE = U_CKV + (size_t)T * 128 * 2;
constexpr size_t U_QF = U_KROPE + (size_t)T * 32 * 2;
constexpr size_t U_KN = U_QF + (size_t)T * 768 * 2;
constexpr size_t U_VV = U_KN + (size_t)T * 512 * 2;
constexpr size_t U_GQ = U_VV + (size_t)T * 512 * 2;
constexpr size_t U_GK = U_GQ + (size_t)T * 512 * 2;
constexpr size_t U_GV = U_GK + (size_t)T * 512 * 2;
constexpr size_t U_BETA = U_GV + (size_t)T * 512 * 2;
constexpr size_t U_GLOG = U_BETA + (size_t)T * 4 * 4;
constexpr size_t U_MIXO = U_GLOG + (size_t)T * 4 * 4;
constexpr size_t U_YBUF = U_MIXO + (size_t)T * 1024 * 2;
constexpr size_t U_END1 = U_YBUF + (size_t)T * 1024 * 4;
constexpr size_t WS_END = WS_U + cmax((size_t)MAXROWS * 1024 * 2, U_END1 - WS_U);

constexpr int CW_CNT = 4096;
constexpr int CW_WORK = 8192;

#define XB_TMO      128
#define XB_XCNT(j)  (256  + 64 * (j))
#define XB_XSUB(j)  (1280 + 64 * (j))
#define XB_XGEN(j)  (2304 + 64 * (j))
#define XB_TOP      3328
#define XB_TOPGEN   3392
#define XCD_BAR_WORDS 3456
#define XB_SPIN_CAP (1u << 18)

__device__ __forceinline__ unsigned xb_ld(unsigned* p)              { return __hip_atomic_load(p, __ATOMIC_RELAXED, __HIP_MEMORY_SCOPE_AGENT); }
__device__ __forceinline__ int lane_id_v() { int l; asm volatile("v_mbcnt_lo_u32_b32 %0, -1, 0\n\tv_mbcnt_hi_u32_b32 %0, -1, %0" : "=v"(l)); return l; }
__device__ __forceinline__ unsigned xb_add(unsigned* p, unsigned v) { return __hip_atomic_fetch_add(p, v, __ATOMIC_RELAXED, __HIP_MEMORY_SCOPE_AGENT); }
__device__ __forceinline__ unsigned xb_xcc_id() { return (unsigned)__builtin_amdgcn_s_getreg((3 << 11) | 20) & 0xFu; }
#define XB_SPIN(cond, bar) do { unsigned _sp = 0; while (cond) { __builtin_amdgcn_s_sleep(1); \
    if ((++_sp & 255u) == 0u) { if (xb_ld(&(bar)[XB_TMO])) break; if (_sp > XB_SPIN_CAP) { atomicAdd(&(bar)[XB_TMO], 1u); break; } } } } while (0)

struct XcdBarrier { unsigned* bar; unsigned x; volatile LAS unsigned* st; int wave; };

__device__ __forceinline__ XcdBarrier xcd_barrier_post(unsigned* bar, volatile LAS unsigned* st, int tid0) {
    XcdBarrier b; b.bar = bar; b.x = xb_xcc_id(); b.st = st; b.wave = __builtin_amdgcn_readfirstlane(tid0 >> 6);
    if (tid0 == 0) (void)xb_add(&bar[XB_XCNT(b.x)], 1u);
    return b;
}
__device__ __forceinline__ void xcd_barrier_complete(unsigned* bar, unsigned x, unsigned& nloc, unsigned& nx) {
    const unsigned G = gridDim.x * gridDim.y * gridDim.z;
    unsigned sum, cnt, mine, sp = 0u;
    for (;;) {
        sum = 0u; cnt = 0u; mine = 0u;
#pragma unroll
        for (unsigned j = 0; j < 16; ++j) { const unsigned c = xb_ld(&bar[XB_XCNT(j)]); sum += c; cnt += (c > 0u) ? 1u : 0u; mine = (j == x) ? c : mine; }
        if (sum == G) break;
        __builtin_amdgcn_s_sleep(1);
        if ((++sp & 255u) == 0u) { if (xb_ld(&bar[XB_TMO])) break; if (sp > XB_SPIN_CAP) { atomicAdd(&bar[XB_TMO], 1u); break; } }
    }
    nloc = mine > 0u ? mine : 1u; nx = cnt > 0u ? cnt : 1u;
}
__device__ __forceinline__ void xcd_barrier(const XcdBarrier& b) {
    asm volatile("s_waitcnt vmcnt(0)" ::: "memory");
    __syncthreads();
    if (b.wave == 0 && lane_id_v() == 0) {
        unsigned* bar = b.bar; unsigned bx = __builtin_amdgcn_readfirstlane(b.x);
        asm volatile("" : "+s"(bar), "+s"(bx));
        __builtin_amdgcn_s_waitcnt(0);
        unsigned nloc = b.st[0], nx = b.st[1];
        if (nloc == 0u) { xcd_barrier_complete(bar, bx, nloc, nx); b.st[0] = nloc; b.st[1] = nx; }
        const unsigned old = xb_add(&bar[XB_XSUB(bx)], 1u);
        const unsigned gen = old / nloc;
        if (old + 1u == (gen + 1u) * nloc) {
            __builtin_amdgcn_fence(__ATOMIC_RELEASE, "agent");
            asm volatile("s_waitcnt vmcnt(0)" ::: "memory");
            const unsigned og = xb_add(&bar[XB_TOP], 1u);
            const unsigned tg = og / nx;
            if (og + 1u == (tg + 1u) * nx) xb_add(&bar[XB_TOPGEN], 1u);
            else XB_SPIN(xb_ld(&bar[XB_TOPGEN]) == tg, bar);
            __builtin_amdgcn_fence(__ATOMIC_ACQUIRE, "agent");
            xb_add(&bar[XB_XGEN(bx)], 1u);
            asm volatile("s_waitcnt vmcnt(0)" ::: "memory");
        } else {
            XB_SPIN(xb_ld(&bar[XB_XGEN(bx)]) == gen, bar);
            __builtin_amdgcn_fence(__ATOMIC_ACQUIRE, "agent");
            asm volatile("s_waitcnt vmcnt(0)" ::: "memory");
        }
    }
    __syncthreads();
}

__device__ __forceinline__ float bf2f(unsigned v) { return __uint_as_float(v << 16); }
__device__ __forceinline__ float bflo(unsigned w) { return __uint_as_float(w << 16); }
__device__ __forceinline__ float bfhi(unsigned w) { return __uint_as_float(w & 0xffff0000u); }
__device__ __forceinline__ unsigned f2bf(float f) { unsigned u = __float_as_uint(f); u += 0x7fffu + ((u >> 16) & 1u); return u >> 16; }
__device__ __forceinline__ unsigned pk2(float lo, float hi) { return f2bf(lo) | (f2bf(hi) << 16); }
__device__ __forceinline__ unsigned cvt_pk(float lo, float hi) { unsigned r; asm volatile("v_cvt_pk_bf16_f32 %0, %1, %2" : "=v"(r) : "v"(lo), "v"(hi)); return r; }
template <class T> __device__ __forceinline__ T shfl_xor_(T v, int o) { return __builtin_bit_cast(T, __builtin_amdgcn_ds_bpermute((lane_id_v() ^ o) << 2, __builtin_bit_cast(int, v))); }
template <class T> __device__ __forceinline__ T shfl_up_(T v, int o) { const int l = lane_id_v(), s = (l - o < 0) ? l : l - o; return __builtin_bit_cast(T, __builtin_amdgcn_ds_bpermute(s << 2, __builtin_bit_cast(int, v))); }
template <class T> __device__ __forceinline__ T shfl_c_(T v, int src  ) { return __builtin_bit_cast(T, __builtin_amdgcn_readlane(__builtin_bit_cast(int, v), src)); }
__device__ __forceinline__ float wave_sum(float v) {
#pragma unroll
    for (int o = 32; o > 0; o >>= 1) v += shfl_xor_(v, o);
    return v;
}
__device__ __forceinline__ float sigmoidf_(float x) { return 1.f / (1.f + expf(-x)); }
__device__ __forceinline__ float siluf_(float x) { return x / (1.f + expf(-x)); }
__device__ __forceinline__ float softplusf_(float x) { return x > 20.f ? x : log1pf(expf(x)); }
__device__ __forceinline__ void glds16(const void* g, void* l) {
    __builtin_amdgcn_global_load_lds((const GAS unsigned*)g, (LAS unsigned*)l, 16, 0, 0);
}
__device__ __forceinline__ void unpack8(const u32x4 r, float (&f)[8]) {
    f[0] = bflo(r.x); f[1] = bfhi(r.x); f[2] = bflo(r.y); f[3] = bfhi(r.y);
    f[4] = bflo(r.z); f[5] = bfhi(r.z); f[6] = bflo(r.w); f[7] = bfhi(r.w);
}

struct Args {
    const void* in[30];
    float* out;
    unsigned char* ws;
    int ph_lo, ph_hi, use_bar, pad;
};

struct Ctx { int tid, lane, wid, wr, wc, fr, fq, bid, nblk; unsigned char* smem; int half, tid0; unsigned char* smem0; };

#define WAIT_V(n) asm volatile("s_waitcnt vmcnt(" #n ")" ::: "memory")
__device__ __forceinline__ void gemm_tile(const bf16_t* a0, const bf16_t* a1, const bf16_t* b0, const bf16_t* b1,
                                          int nk, f32x4 (&acc)[4][4], const Ctx& c) {
#pragma unroll
    for (int m = 0; m < 4; ++m)
#pragma unroll
        for (int n = 0; n < 4; ++n) acc[m][n] = (f32x4){0.f, 0.f, 0.f, 0.f};
    unsigned char* smem = c.smem;
    const int sb = c.tid * 16;
    const int kofs = ((c.tid & 3) ^ ((c.tid >> 4) & 3)) * 8;
    a0 += kofs; a1 += kofs; b0 += kofs; b1 += kofs;
#define G_STAGE(kt_) do { unsigned char* sp_ = smem + ((kt_) & 3) * 16384 + sb; const int ko_ = (kt_) * 32; \
        glds16(a0 + ko_, sp_); glds16(a1 + ko_, sp_ + 4096); glds16(b0 + ko_, sp_ + 8192); glds16(b1 + ko_, sp_ + 12288); } while (0)
#define G_READ(kt_, AF, BF) do { const unsigned char* sa_ = smem + ((kt_) & 3) * 16384 + c.wr * 4096 + roff; const unsigned char* sb_ = smem + ((kt_) & 3) * 16384 + 8192 + c.wc * 4096 + roff; \
        _Pragma("unroll") for (int m = 0; m < 4; ++m) AF[m] = *(const bf16x8*)(sa_ + m * 1024); \
        _Pragma("unroll") for (int n = 0; n < 4; ++n) BF[n] = *(const bf16x8*)(sb_ + n * 1024); } while (0)
#define G_MMA(AF, BF) do { __builtin_amdgcn_s_setprio(1); \
        _Pragma("unroll") for (int m = 0; m < 4; ++m) _Pragma("unroll") for (int n = 0; n < 4; ++n) acc[m][n] = __builtin_amdgcn_mfma_f32_16x16x32_bf16(BF[n], AF[m], acc[m][n], 0, 0, 0); \
        __builtin_amdgcn_s_setprio(0); } while (0)
#define G_BAR() do { asm volatile("" ::: "memory"); __builtin_amdgcn_s_barrier(); asm volatile("" ::: "memory"); } while (0)
    const int roff = (c.fr * 64) + ((c.fq ^ ((c.fr >> 2) & 3)) * 16);
    WAIT_V(0);
    G_STAGE(0); G_STAGE(1); G_STAGE(2); G_STAGE(3);
    bf16x8 fa0[4], fb0[4], fa1[4], fb1[4];
    WAIT_V(12); G_BAR();
    G_READ(0, fa0, fb0);
#define G_LGK0() asm volatile("s_waitcnt lgkmcnt(0)" ::: "memory")
    int kt = 0;
    for (; kt < nk - 4; kt += 4) {
        G_LGK0(); WAIT_V(8); G_BAR(); G_STAGE(kt + 4); G_READ(1, fa1, fb1); G_MMA(fa0, fb0);
        G_LGK0(); WAIT_V(8); G_BAR(); G_STAGE(kt + 5); G_READ(2, fa0, fb0); G_MMA(fa1, fb1);
        G_LGK0(); WAIT_V(8); G_BAR(); G_STAGE(kt + 6); G_READ(3, fa1, fb1); G_MMA(fa0, fb0);
        G_LGK0(); WAIT_V(8); G_BAR(); G_STAGE(kt + 7); G_READ(0, fa0, fb0); G_MMA(fa1, fb1);
    }
    G_LGK0(); WAIT_V(8); G_BAR(); G_READ(1, fa1, fb1); G_MMA(fa0, fb0);
    G_LGK0(); WAIT_V(4); G_BAR(); G_READ(2, fa0, fb0); G_MMA(fa1, fb1);
    G_LGK0(); WAIT_V(0); G_BAR(); G_READ(3, fa1, fb1); G_MMA(fa0, fb0);
    G_MMA(fa1, fb1);
#undef G_LGK0
#undef G_STAGE
#undef G_READ
#undef G_MMA
#undef G_BAR
    __syncthreads();
}

namespace g8 {
constexpr int BM = 256, BK = 64, HALF = 128, HTB = HALF * BK * 2, STAGE_BYTES = 8 * HTB;
__device__ __forceinline__ int lds_byte(int r, int c) { const int st = (r >> 4) * 2 + (c >> 5), rr = r & 15, cc = c & 31, ob = rr * 64 + cc * 2; return st * 1024 + (ob ^ (((ob >> 9) & 1) << 5)); }
__device__ __forceinline__ void stage_rc(int b, int& R, int& C) { const int st = b / 1024, sb = b % 1024, swz = sb ^ (((sb >> 9) & 1) << 5); R = (st >> 1) * 16 + swz / 64; C = (st & 1) * 32 + (swz % 64) / 2; }
__device__ __forceinline__ int perm32(int rho) { const int n = rho >> 4, i = rho & 15; return 8 * (i >> 2) + 4 * n + (i & 3); }
struct Unit { int pm, pn, bt; };

template <bool PERM, bool GATHER, class Sched, class Epi>
__device__ __forceinline__ void phase(unsigned char* ldsp, const char* Abase, const char* Bbase, int K, const Sched& S, const Epi& E, int tid_in) {
    LAS unsigned char* lds = (LAS unsigned char*)ldsp;
    int tid = tid_in; asm volatile("" : "+v"(tid));
    const int wid = __builtin_amdgcn_readfirstlane(tid >> 6), lane = tid & 63, wr = wid >> 2, wc = wid & 3, fr = lane & 15, fq = lane >> 4;
    const int nt = K / BK;
    unsigned voffA[2], voffB[2];
#pragma unroll
    for (int i = 0; i < 2; ++i) { int R, C; stage_rc(tid * 16 + i * 8192, R, C); const int Rb = PERM ? ((R >> 5) * 64 + perm32(R & 31)) : R;
        voffA[i] = (unsigned)(R * K + C) * 2u; voffB[i] = (unsigned)(Rb * K + C) * 2u; }
    const size_t kstep = (size_t)(BK * 2);
    const size_t hstep = (size_t)HALF * K * 2, tstep = 2 * hstep, bhstep = PERM ? (size_t)32 * K * 2 : hstep;
    const unsigned ldsw = (unsigned)wid * 1024u;
    const int aoff = lds_byte(wr * 64 + fr, fq * 8), boff = lds_byte(wc * 32 + fr, fq * 8);
#define G8_SA(b, h) (((b) * 2 + (h)) * HTB)
#define G8_SB(b, h) ((4 + (b) * 2 + (h)) * HTB)
#define G8_DMA(gptr, voff32, ldsoff) do { const char* _gp = (gptr); const unsigned _lo = (unsigned)(size_t)(ldsp) + (unsigned)(ldsoff); \
        asm volatile("s_mov_b32 m0, %2\n\ts_nop 0\n\tglobal_load_lds_dwordx4 %0, %1" :: "v"(voff32), "s"(_gp), "s"(_lo) : "memory", "m0"); } while (0)
#define G8_STAGE(bufoff, gbase, voff) do { _Pragma("unroll") for (int _i = 0; _i < 2; ++_i) G8_DMA((const char*)(gbase), (voff)[_i], (bufoff) + ldsw + _i * 8192); } while (0)
#define G8_STAGEA(bufoff, gbase, h, kb) do { if constexpr (GATHER) { _Pragma("unroll") for (int _i = 0; _i < 2; ++_i) G8_DMA(Abase + (kb), vA[2 * (h) + _i], (bufoff) + ldsw + _i * 8192); } \
        else G8_STAGE(bufoff, (gbase) + (size_t)(h) * hstep + (kb), voffA); } while (0)
#define G8_LDA(dst, b, h) do { _Pragma("unroll") for (int m = 0; m < 4; ++m) _Pragma("unroll") for (int k = 0; k < 2; ++k) dst[m][k] = *(const LAS bf16x8*)(lds + G8_SA(b, h) + aoff + m * 2048 + k * 1024); } while (0)
#define G8_LDB(dst, b, h) do { _Pragma("unroll") for (int n = 0; n < 2; ++n) _Pragma("unroll") for (int k = 0; k < 2; ++k) dst[n][k] = *(const LAS bf16x8*)(lds + G8_SB(b, h) + boff + n * 2048 + k * 1024); } while (0)
#define G8_MMA(ai, bj, At, Bt) do { __builtin_amdgcn_s_setprio(1); _Pragma("unroll") for (int m = 0; m < 4; ++m) _Pragma("unroll") for (int n = 0; n < 2; ++n) _Pragma("unroll") for (int k = 0; k < 2; ++k) \
        acc[ai][bj][m][n] = __builtin_amdgcn_mfma_f32_16x16x32_bf16(Bt[n][k], At[m][k], acc[ai][bj][m][n], 0, 0, 0); __builtin_amdgcn_s_setprio(0); } while (0)
#define G8_WAIT_V(n) asm volatile("s_waitcnt vmcnt(" #n ")" ::: "memory")
#define G8_WAIT_L(n) asm volatile("s_waitcnt lgkmcnt(" #n ")" ::: "memory")
#define G8_BAR __builtin_amdgcn_s_barrier()
#define G8_SCHED __builtin_amdgcn_sched_barrier(0)
    Unit cur, nxt; int ui = 0;
    if (!S.next(0, cur)) return;
    f32x4 acc[2][2][4][2];
#pragma unroll
    for (int a = 0; a < 2; ++a)
#pragma unroll
        for (int b = 0; b < 2; ++b)
#pragma unroll
            for (int m = 0; m < 4; ++m)
#pragma unroll
                for (int n = 0; n < 2; ++n) acc[a][b][m][n] = (f32x4){0.f, 0.f, 0.f, 0.f};
    bf16x8 At[4][2], B0[2][2], B1[2][2];
    const char* cA = Abase + (size_t)cur.pm * tstep; const char* cB = Bbase + (size_t)cur.bt * tstep;
    unsigned vA[4] = {0u, 0u, 0u, 0u};
    if constexpr (GATHER) S.aoff(cur, tid, vA);
    asm volatile("s_waitcnt vmcnt(0)" ::: "memory");
    G8_STAGE(G8_SB(0, 0), cB, voffB); G8_STAGEA(G8_SA(0, 0), cA, 0, 0); G8_STAGE(G8_SB(0, 1), cB + bhstep, voffB); G8_STAGEA(G8_SA(0, 1), cA, 1, 0);
    if (wr == 1) G8_BAR;
    G8_WAIT_V(4); G8_BAR;
    G8_STAGE(G8_SB(1, 0), cB + kstep, voffB); G8_STAGEA(G8_SA(1, 0), cA, 0, kstep); G8_STAGE(G8_SB(1, 1), cB + bhstep + kstep, voffB);
    G8_WAIT_V(6); G8_BAR;
    G8_STAGEA(G8_SA(1, 1), cA, 1, kstep);
    for (;;) {
        const bool has_next = S.next(ui + 1, nxt);
        const char* nA = has_next ? Abase + (size_t)nxt.pm * tstep : cA; const char* nB = has_next ? Bbase + (size_t)nxt.bt * tstep : cB;
        for (int t = 0; t < nt; t += 2) {
            const bool last = (t == nt - 2);
            const int lastf = __builtin_amdgcn_readfirstlane(last ? 1 : 0);
            const size_t k2 = last ? 0 : (size_t)(t + 2) * kstep, k3 = k2 + kstep;
            const char* a2 = last ? nA : cA; const char* b2 = last ? nB : cB + (size_t)(t + 2) * kstep;
            const char* b3 = b2 + kstep;
            G8_LDB(B0, 0, 0); G8_SCHED; G8_LDA(At, 0, 0);
            if constexpr (GATHER) { if (last && has_next) S.aoff(nxt, tid, vA); }
            G8_WAIT_L(8); G8_BAR; G8_WAIT_L(0); G8_MMA(0, 0, At, B0); G8_BAR; G8_SCHED;
            G8_LDB(B1, 0, 1); G8_STAGE(G8_SB(0, 0), b2, voffB);
            G8_BAR; G8_WAIT_L(0); G8_MMA(0, 1, At, B1); G8_BAR;
            G8_LDA(At, 0, 1); G8_STAGEA(G8_SA(0, 0), a2, 0, k2);
            G8_BAR; G8_WAIT_L(0); G8_MMA(1, 0, At, B0); G8_BAR; G8_SCHED;
            G8_STAGE(G8_SB(0, 1), b2 + bhstep, voffB);
            const int pend = __builtin_amdgcn_readfirstlane((t == 0 && ui > 0) ? 1 : 0);
            asm volatile("s_cmp_lg_u32 %0, 0\n\ts_cbranch_scc1 1f\n\ts_waitcnt vmcnt(6)\n1:\n\ts_waitcnt vmcnt(%1)" :: "s"(pend), "n"(6 + (Epi::SPLIT ? Epi::NQ : Epi::NST)) : "memory", "scc");
            G8_BAR; G8_MMA(1, 1, At, B1); G8_BAR;
            G8_LDB(B0, 1, 0); G8_SCHED; G8_LDA(At, 1, 0); G8_STAGEA(G8_SA(0, 1), a2, 1, k2);
            G8_WAIT_L(8); G8_BAR; G8_WAIT_L(0); G8_MMA(0, 0, At, B0); G8_BAR; G8_SCHED;
            if constexpr (Epi::SPLIT) { E.template part_cond<0, 0>(acc, cur, wr, wc, fr, fq, lastf); G8_SCHED; }
            G8_LDB(B1, 1, 1); G8_STAGE(G8_SB(1, 0), b3, voffB);
            G8_BAR; G8_WAIT_L(0); G8_MMA(0, 1, At, B1); G8_BAR;
            if constexpr (Epi::SPLIT) { E.template part_cond<0, 1>(acc, cur, wr, wc, fr, fq, lastf); G8_SCHED; }
            G8_LDA(At, 1, 1); G8_STAGEA(G8_SA(1, 0), a2, 0, k3);
            G8_BAR; G8_WAIT_L(0); G8_MMA(1, 0, At, B0); G8_BAR; G8_SCHED;
            G8_STAGE(G8_SB(1, 1), b3 + bhstep, voffB);
            if constexpr (Epi::SPLIT) {
                asm volatile("s_cmp_lg_u32 %0, 0\n\ts_cbranch_scc1 1f\n\ts_waitcnt vmcnt(6)\n1:\n\ts_waitcnt vmcnt(%1)" :: "s"(lastf), "n"(6 + 2 * Epi::NQ) : "memory", "scc");
                G8_SCHED; E.template part_cond<1, 0>(acc, cur, wr, wc, fr, fq, lastf); G8_SCHED;
            } else G8_WAIT_V(6);
            G8_BAR; G8_MMA(1, 1, At, B1); G8_BAR;
            G8_STAGEA(G8_SA(1, 1), a2, 1, k3);
        }
        if constexpr (Epi::SPLIT) E.tail(acc, cur, wr, wc, fr, fq); else E(acc, cur, wr, wc, fr, fq);
        if (!has_next) break;
#pragma unroll
        for (int a = 0; a < 2; ++a)
#pragma unroll
            for (int b = 0; b < 2; ++b)
#pragma unroll
                for (int m = 0; m < 4; ++m)
#pragma unroll
                    for (int n = 0; n < 2; ++n) acc[a][b][m][n] = (f32x4){0.f, 0.f, 0.f, 0.f};
        cur = nxt; cA = nA; cB = nB; ++ui;
    }
    G8_WAIT_V(0);
    if (wr == 0) G8_BAR;
    G8_BAR;
#undef G8_SA
#undef G8_SB
#undef G8_STAGE
#undef G8_STAGEA
#undef G8_LDA
#undef G8_LDB
#undef G8_MMA
#undef G8_WAIT_V
#undef G8_WAIT_L
#undef G8_BAR
#undef G8_SCHED
}
}

__device__ __forceinline__ bool tile_map(int i, const Ctx& c, int ntm, int ntn, int& mt, int& nt) {
    const int vb = ((c.nblk & 15) == 0) ? ((c.bid >> 1) & 7) * (c.nblk >> 3) + (((c.bid >> 4) << 1) | (c.bid & 1)) : c.bid;
    const int L = i * c.nblk + vb;
    if (L >= ntm * ntn) return false;
    const int g = L / (8 * ntn), rem = L - g * 8 * ntn;
    const int gsz = (ntm - g * 8) < 8 ? (ntm - g * 8) : 8;
    mt = g * 8 + rem % gsz; nt = rem / gsz;
    return true;
}

__device__ __forceinline__ bool tile_map2(int i, const Ctx& c, int ntm, int ntn, int& mt, int& nt, bool& valid) {
    Ctx o = c; o.bid = c.bid ^ 1;
    int mo, no; const bool oko = tile_map(i, o, ntm, ntn, mo, no);
    valid = tile_map(i, c, ntm, ntn, mt, nt);
    if (!valid) { mt = 0; nt = 0; }
    return valid || oko;
}

struct DenseSched {
    int ntm, ntn, K, bid, nblk;
    __device__ __forceinline__ bool next(int i, g8::Unit& u) const {
        const int vb = ((nblk & 7) == 0) ? (bid & 7) * (nblk >> 3) + (bid >> 3) : bid;
        const int L = i * nblk + vb;
        if (L >= ntm * ntn) return false;
        const int g = L / (8 * ntn), rem = L - g * 8 * ntn;
        const int gsz = (ntm - g * 8) < 8 ? (ntm - g * 8) : 8;
        u.pm = g * 8 + rem % gsz; u.pn = rem / gsz; u.bt = u.pn;
        return true;
    }
};
struct MoeSched {
    int nrb, ntn, bid, nblk; const int* eb;
    __device__ __forceinline__ bool next(int i, g8::Unit& u) const {
        const int vb = ((nblk & 7) == 0) ? (bid & 7) * (nblk >> 3) + (bid >> 3) : bid;
        const int L = i * nblk + vb;
        if (L >= nrb * ntn) return false;
        const int g = L / (8 * ntn), rem = L - g * 8 * ntn;
        const int gsz = (nrb - g * 8) < 8 ? (nrb - g * 8) : 8;
        u.pm = g * 8 + rem % gsz; u.pn = rem / gsz;
        u.bt = __builtin_amdgcn_readfirstlane(eb[u.pm]) * ntn + u.pn;
        return true;
    }
};
struct MoeSchedG {
    int nrb, bid, nblk; const int* eb; const int* bst; const int* LTOK;
    __device__ __forceinline__ bool next(int i, g8::Unit& u) const {
        const int vb = ((nblk & 7) == 0) ? (bid & 7) * (nblk >> 3) + (bid >> 3) : bid;
        const int L = i * nblk + vb;
        if (L >= nrb * 2) return false;
        const int g = L >> 4, rem = L & 15;
        const int gsz = (nrb - g * 8) < 8 ? (nrb - g * 8) : 8;
        u.pm = g * 8 + rem % gsz; u.pn = rem / gsz;
        u.bt = __builtin_amdgcn_readfirstlane(eb[u.pm]) * 2 + u.pn;
        return true;
    }
    __device__ __forceinline__ void aoff(const g8::Unit& u, int tid, unsigned (&o)[4]) const {
        const int e = eb[u.pm], lb = u.pm - bst[e], cnt = bst[66 + e];
        int R0, C0, R1, C1; g8::stage_rc(tid * 16, R0, C0); g8::stage_rc(tid * 16 + 8192, R1, C1);
        const int* lt = LTOK + (size_t)e * CAP + lb * RBR;
        const int p00 = R0, p01 = R1, p10 = 128 + R0, p11 = 128 + R1;
        const int t00 = (lb * RBR + p00 < cnt) ? lt[p00] : 0, t01 = (lb * RBR + p01 < cnt) ? lt[p01] : 0;
        const int t10 = (lb * RBR + p10 < cnt) ? lt[p10] : 0, t11 = (lb * RBR + p11 < cnt) ? lt[p11] : 0;
        o[0] = (unsigned)t00 * 2048u + (unsigned)C0 * 2u; o[1] = (unsigned)t01 * 2048u + (unsigned)C1 * 2u;
        o[2] = (unsigned)t10 * 2048u + (unsigned)C0 * 2u; o[3] = (unsigned)t11 * 2048u + (unsigned)C1 * 2u;
    }
};
struct EpiMoe1 {
    static constexpr bool SPLIT = false; static constexpr int NQ = 4, NST = 16;
    bf16_t* H;
    __device__ __forceinline__ void operator()(const f32x4 (&acc)[2][2][4][2], const g8::Unit& u, int wr, int wc, int fr, int fq) const {
#pragma unroll
        for (int ai = 0; ai < 2; ++ai)
#pragma unroll
            for (int m = 0; m < 4; ++m) {
                const size_t row = (size_t)u.pm * RBR + ai * 128 + wr * 64 + m * 16 + fr;
#pragma unroll
                for (int bj = 0; bj < 2; ++bj) {
                    const int hc = (u.pn * 8 + bj * 4 + wc) * 16 + fq * 4;
                    const f32x4 g = acc[ai][bj][m][0], up = acc[ai][bj][m][1];
                    float h[4];
#pragma unroll
                    for (int j = 0; j < 4; ++j) h[j] = g[j] * __builtin_amdgcn_rcpf(1.f + __expf(-g[j])) * up[j];
                    *(u32x2*)(H + row * 256 + hc) = (u32x2){cvt_pk(h[0], h[1]), cvt_pk(h[2], h[3])};
                }
            }
    }
    template <int ai, int bj> __device__ __forceinline__ void part_cond(const f32x4 (&acc)[2][2][4][2], const g8::Unit& u, int wr, int wc, int fr, int fq, int flag) const {}
    __device__ __forceinline__ void tail(const f32x4 (&acc)[2][2][4][2], const g8::Unit& u, int wr, int wc, int fr, int fq) const {}
};
__device__ __forceinline__ u32x4 dpp_ror8(const u32x4 v) {
    u32x4 r;
#pragma unroll
    for (int i = 0; i < 4; ++i) r[i] = (unsigned)__builtin_amdgcn_update_dpp(0, (int)v[i], 0x128, 0xF, 0xF, true);
    return r;
}
template <bool NT = false>
__device__ __forceinline__ void perm_store(bf16_t* p  , size_t ld8  , const u32x4 p0, const u32x4 p1, int hi) {
    const u32x4 snd = hi ? p0 : p1, rcv = dpp_ror8(snd);
    if constexpr (NT) { __builtin_nontemporal_store(hi ? rcv : p0, (u32x4*)p); __builtin_nontemporal_store(hi ? p1 : rcv, (u32x4*)(p + ld8)); }
    else { *(u32x4*)p = hi ? rcv : p0; *(u32x4*)(p + ld8) = hi ? p1 : rcv; }
}
struct EpiIn {
    static constexpr bool SPLIT = false; static constexpr int NQ = 4, NST = 16;
    bf16_t* P; float* G; int gbase;
    template <int ai, int bj> __device__ __forceinline__ void part_cond(const f32x4 (&acc)[2][2][4][2], const g8::Unit& u, int wr, int wc, int fr, int fq, int flag) const {}
    __device__ __forceinline__ void tail(const f32x4 (&acc)[2][2][4][2], const g8::Unit& u, int wr, int wc, int fr, int fq) const {}
    __device__ __forceinline__ void operator()(const f32x4 (&acc)[2][2][4][2], const g8::Unit& u, int wr, int wc, int fr, int fq) const {
        const int hi = fr >> 3, r8 = fr & 7;
#pragma unroll
        for (int ai = 0; ai < 2; ++ai)
#pragma unroll
            for (int m = 0; m < 4; ++m) {
                const size_t rg = (size_t)u.pm * 256 + ai * 128 + wr * 64 + m * 16;
                u32x4 pk[2];
#pragma unroll
                for (int bj = 0; bj < 2; ++bj) {
                    const f32x4 v0 = acc[ai][bj][m][0], v1 = acc[ai][bj][m][1];
                    pk[bj] = (u32x4){cvt_pk(v0[0], v0[1]), cvt_pk(v0[2], v0[3]), cvt_pk(v1[0], v1[1]), cvt_pk(v1[2], v1[3])};
                    if (u.pn * 256 + wc * 64 + bj * 32 + fq * 8 == gbase) { *(f32x4*)(G + (rg + fr) * 8) = v0; *(f32x4*)(G + (rg + fr) * 8 + 4) = v1; }
                }
                perm_store(P + (rg + r8) * NPAD + u.pn * 256 + wc * 64 + hi * 32 + fq * 8, (size_t)8 * NPAD, pk[0], pk[1], hi);
            }
    }
};
struct EpiMoe2 {
    static constexpr bool SPLIT = false; static constexpr int NQ = 4, NST = 16;
    bf16_t* Y;
    template <int ai, int bj> __device__ __forceinline__ void part_cond(const f32x4 (&acc)[2][2][4][2], const g8::Unit& u, int wr, int wc, int fr, int fq, int flag) const {}
    __device__ __forceinline__ void tail(const f32x4 (&acc)[2][2][4][2], const g8::Unit& u, int wr, int wc, int fr, int fq) const {}
    __device__ __forceinline__ void operator()(const f32x4 (&acc)[2][2][4][2], const g8::Unit& u, int wr, int wc, int fr, int fq) const {
        const int hi = fr >> 3, r8 = fr & 7;
#pragma unroll
        for (int ai = 0; ai < 2; ++ai)
#pragma unroll
            for (int m = 0; m < 4; ++m) {
                const size_t rg = (size_t)u.pm * RBR + ai * 128 + wr * 64 + m * 16;
                u32x4 pk[2];
#pragma unroll
                for (int bj = 0; bj < 2; ++bj) {
                    const f32x4 v0 = acc[ai][bj][m][0], v1 = acc[ai][bj][m][1];
                    pk[bj] = (u32x4){cvt_pk(v0[0], v0[1]), cvt_pk(v0[2], v0[3]), cvt_pk(v1[0], v1[1]), cvt_pk(v1[2], v1[3])};
                }
                perm_store<true>(Y + (rg + r8) * 1024 + u.pn * 256 + wc * 64 + hi * 32 + fq * 8, (size_t)8 * 1024, pk[0], pk[1], hi);
            }
    }
};
struct EpiOut {
    static constexpr bool SPLIT = false; static constexpr int NQ = 8, NST = 32;
    template <int ai, int bj> __device__ __forceinline__ void part_cond(const f32x4 (&acc)[2][2][4][2], const g8::Unit& u, int wr, int wc, int fr, int fq, int flag) const {}
    __device__ __forceinline__ void tail(const f32x4 (&acc)[2][2][4][2], const g8::Unit& u, int wr, int wc, int fr, int fq) const {}
    const bf16_t* xres; bf16_t* Y;
    __device__ __forceinline__ void operator()(const f32x4 (&acc)[2][2][4][2], const g8::Unit& u, int wr, int wc, int fr, int fq) const {
        const int hi = fr >> 3, r8 = fr & 7;
#pragma unroll
        for (int ai = 0; ai < 2; ++ai)
#pragma unroll
            for (int m = 0; m < 4; ++m) {
                const size_t rg = (size_t)u.pm * 256 + ai * 128 + wr * 64 + m * 16;
                u32x4 pk[2];
#pragma unroll
                for (int bj = 0; bj < 2; ++bj) {
                    const u32x4 xr = *(const u32x4*)(xres + (rg + fr) * 1024 + u.pn * 256 + wc * 64 + bj * 32 + fq * 8);
                    float f[8]; unpack8(xr, f);
                    const f32x4 v0 = acc[ai][bj][m][0], v1 = acc[ai][bj][m][1];
                    pk[bj] = (u32x4){cvt_pk(f[0] * ALPHA + v0[0], f[1] * ALPHA + v0[1]), cvt_pk(f[2] * ALPHA + v0[2], f[3] * ALPHA + v0[3]),
                                     cvt_pk(f[4] * ALPHA + v1[0], f[5] * ALPHA + v1[1]), cvt_pk(f[6] * ALPHA + v1[2], f[7] * ALPHA + v1[3])};
                }
                perm_store(Y + (rg + r8) * 1024 + u.pn * 256 + wc * 64 + hi * 32 + fq * 8, (size_t)8 * 1024, pk[0], pk[1], hi);
                asm volatile("" ::: "memory");
            }
    }
};

constexpr int TS_RS = 272;
__device__ __forceinline__ void tile_put(const Ctx& c, int row_l, int col_l, const u32x2 v) { *(u32x2*)(c.smem + row_l * TS_RS + col_l * 2) = v; }
template <int NCOL>
__device__ __forceinline__ void tile_flush(const Ctx& c, bf16_t* out, size_t ld, bool valid) {
    __syncthreads();
    constexpr int CPR = NCOL / 8, PER = (128 * CPR) / 256;
#pragma unroll
    for (int i = 0; i < PER; ++i) {
        const int idx = c.tid + 256 * i, row = idx / CPR, ch = idx % CPR;
        const u32x4 v = *(const u32x4*)(c.smem + row * TS_RS + ch * 16);
        if (valid) *(u32x4*)(out + (size_t)row * ld + ch * 8) = v;
    }
    __syncthreads();
}

__device__ __forceinline__ void conv_family(const float* src, int nmat, size_t src_stride, int K, int N, int Nout,
                            bf16_t* dst, size_t dst_stride, int grp, int kind, const Ctx& c) {
    float* lds = (float*)c.smem;
    const int tk = K / 128, tn = Nout / 64, per = tk * tn, total = nmat * per;
    const int tx = c.tid & 15, ty = c.tid >> 4;
    f32x4 r[8];
#define CV_LOAD(u_) do { const int mat_ = (u_) / per, r_ = (u_) - mat_ * per, kt_ = r_ / tn, nt_ = r_ - kt_ * tn; \
        const float* s_ = src + (size_t)mat_ * src_stride + (size_t)(kt_ * 128 + ty) * N + nt_ * 64 + tx * 4; const bool in_ = (nt_ * 64 + tx * 4) < N; \
        _Pragma("unroll") for (int i = 0; i < 8; ++i) r[i] = in_ ? *(const f32x4*)(s_ + (size_t)(16 * i) * N) : (f32x4){0.f, 0.f, 0.f, 0.f}; } while (0)
    if (c.bid < total) CV_LOAD(c.bid);
    for (int base = 0; base < total; base += c.nblk) {
        const int u = base + c.bid; const bool valid = u < total;
#pragma unroll
        for (int i = 0; i < 8; ++i) *(f32x4*)(lds + (ty + 16 * i) * 68 + tx * 4) = r[i];
        if (u + c.nblk < total) CV_LOAD(u + c.nblk);
        __syncthreads();
        if (valid) {
        const int mat = u / per, rr = u - mat * per, kt = rr / tn, nt = rr - kt * tn;
        const int dmat = grp ? (mat / grp) * (grp + 1) + (mat % grp) : mat;
        bf16_t* d = dst + (size_t)dmat * dst_stride;
        const int nl = c.tid & 63, kq = (c.tid >> 6) * 32;
        unsigned w[16];
#pragma unroll
        for (int j = 0; j < 16; ++j) w[j] = pk2(lds[(kq + 2 * j) * 68 + nl], lds[(kq + 2 * j + 1) * 68 + nl]);
        const int n = nt * 64 + nl;
        const int drow = (kind == 0) ? n : ((n >> 4) * 32 + (n & 15) + (kind == 2 ? 16 : 0));
        u32x4* dp = (u32x4*)(d + (size_t)drow * K + kt * 128 + kq);
        dp[0] = (u32x4){w[0], w[1], w[2], w[3]}; dp[1] = (u32x4){w[4], w[5], w[6], w[7]};
        dp[2] = (u32x4){w[8], w[9], w[10], w[11]}; dp[3] = (u32x4){w[12], w[13], w[14], w[15]};
        }
        __syncthreads();
    }
#undef CV_LOAD
}

__device__ __forceinline__ void phase_prologue(const Args& a, const Ctx& c) {
    unsigned char* ws = a.ws;
    bf16_t* WIN = (bf16_t*)(ws + WS_WIN);
    conv_family((const float*)a.in[2], 2, (size_t)1024 * 2472, 1024, 2472, NPAD, WIN, 2 * WIN_ELEMS, 0, 0, c);
    conv_family((const float*)a.in[12], 2, (size_t)1024 * 2312, 1024, 2312, NPAD, WIN + WIN_ELEMS, 2 * WIN_ELEMS, 0, 0, c);
    conv_family((const float*)a.in[4], 2, (size_t)256 * 768, 256, 768, 768, (bf16_t*)(ws + WS_WQB), WQB_ELEMS, 0, 0, c);
    conv_family((const float*)a.in[6], 2, (size_t)128 * 1024, 128, 1024, 1024, (bf16_t*)(ws + WS_WKVB), WKVB_ELEMS, 0, 0, c);
    bf16_t* WOUT = (bf16_t*)(ws + WS_WOUT);
    conv_family((const float*)a.in[11], 2, (size_t)1024 * 1024, 1024, 1024, 1024, WOUT, 2 * WOUT_ELEMS, 0, 0, c);
    conv_family((const float*)a.in[17], 2, (size_t)1024 * 1024, 1024, 1024, 1024, WOUT + WOUT_ELEMS, 2 * WOUT_ELEMS, 0, 0, c);
    conv_family((const float*)a.in[20], 4, (size_t)1024 * 64, 1024, 64, 128, (bf16_t*)(ws + WS_WRT), WRT_ELEMS, 0, 0, c);
    bf16_t* WGU = (bf16_t*)(ws + WS_WGU);
    conv_family((const float*)a.in[22], 256, (size_t)1024 * 256, 1024, 256, 256, WGU, WGU_ELEMS, 64, 1, c);
    conv_family((const float*)a.in[23], 256, (size_t)1024 * 256, 1024, 256, 256, WGU, WGU_ELEMS, 64, 2, c);
    conv_family((const float*)a.in[25], 4, (size_t)1024 * 256, 1024, 256, 256, WGU + 64 * WGU_ELEMS, 65 * WGU_ELEMS, 0, 1, c);
    conv_family((const float*)a.in[26], 4, (size_t)1024 * 256, 1024, 256, 256, WGU + 64 * WGU_ELEMS, 65 * WGU_ELEMS, 0, 2, c);
    bf16_t* WDN = (bf16_t*)(ws + WS_WDN);
    conv_family((const float*)a.in[24], 256, (size_t)256 * 1024, 256, 1024, 1024, WDN, WDN_ELEMS, 64, 0, c);
    conv_family((const float*)a.in[27], 4, (size_t)256 * 1024, 256, 1024, 1024, WDN + 64 * WDN_ELEMS, 65 * WDN_ELEMS, 0, 0, c);
    {
        const float* x = (const float*)a.in[0]; bf16_t* xb = (bf16_t*)(ws + WS_XBF);
        const size_t n8 = (size_t)T * 1024 / 8;
        for (size_t i = (size_t)c.bid * 256 + c.tid; i < n8; i += (size_t)c.nblk * 256) {
            const f32x4 v0 = *(const f32x4*)(x + i * 8), v1 = *(const f32x4*)(x + i * 8 + 4);
            *(u32x4*)(xb + i * 8) = (u32x4){pk2(v0[0], v0[1]), pk2(v0[2], v0[3]), pk2(v1[0], v1[1]), pk2(v1[2], v1[3])};
        }
    }
    {
        const int* pos = (const int*)a.in[1];
        float* rm = (float*)(ws + WS_ROPEM); float* rs = (float*)(ws + WS_ROPES);
        const float ln_theta = 9.210340371976184f;
        for (int i = c.bid * 256 + c.tid; i < T * 16; i += c.nblk * 256) {
            const int t = i >> 4, f = i & 15;
            const float inv = expf(-((float)(2 * f) / 32.f) * ln_theta);
            const float ang = (float)pos[t] * inv;
            rm[i * 2] = cosf(ang); rm[i * 2 + 1] = sinf(ang);
        }
        for (int i = c.bid * 256 + c.tid; i < T * 32; i += c.nblk * 256) {
            const int t = i >> 5, f = i & 31;
            const float inv = expf(-((float)(2 * f) / 64.f) * ln_theta);
            const float ang = (float)pos[t] * inv;
            rs[i * 2] = cosf(ang); rs[i * 2 + 1] = sinf(ang);
        }
    }
}

__device__ __forceinline__ void phase_inproj(const bf16_t* XBF, const bf16_t* W, bf16_t* PROJ, float* GATES, int gbase, const Ctx& c) {
    const int ntn = NPAD / 128;
    for (int i = 0;; ++i) {
        int mt, nt; bool valid; if (!tile_map2(i, c, T / 128, ntn, mt, nt, valid)) break;
        const bf16_t* a0 = XBF + (size_t)(mt * 128 + (c.tid >> 2)) * 1024;
        const bf16_t* b0 = W + (size_t)(nt * 128 + (c.tid >> 2)) * 1024;
        f32x4 acc[4][4];
        gemm_tile(a0, a0 + 64 * 1024, b0, b0 + 64 * 1024, 32, acc, c);
#pragma unroll
        for (int m = 0; m < 4; ++m) {
            const int rl = c.wr * 64 + m * 16 + c.fr, row = mt * 128 + rl;
#pragma unroll
            for (int n = 0; n < 4; ++n) {
                const int cl = c.wc * 64 + n * 16 + c.fq * 4, col = nt * 128 + cl;
                const f32x4 v = acc[m][n];
                tile_put(c, rl, cl, (u32x2){pk2(v[0], v[1]), pk2(v[2], v[3])});
                if (valid && col >= gbase && col < gbase + 8) *(f32x4*)(GATES + (size_t)row * 8 + (col - gbase)) = v;
            }
        }
        tile_flush<128>(c, PROJ + (size_t)mt * 128 * NPAD + nt * 128, NPAD, valid);
    }
}

constexpr int MLAUP_TILES = (T / 128) * 6 + (T / 128) * 8;
__device__ __forceinline__ void mla_up_tile(int u, const bf16_t* CQ, const bf16_t* WQB, const bf16_t* CKV, const bf16_t* WKVB,
                             const float* ROPEM, bf16_t* QF, bf16_t* KN, bf16_t* VV, const Ctx& c) {
    const int tq = (T / 128) * 6;
    const float qscale = 0.10206207261596577f * 1.4426950408889634f;
    {
        f32x4 acc[4][4];
        if (u < tq) {
            const int mt = u / 6, nt = u % 6;
            const bf16_t* a0 = CQ + (size_t)(mt * 128 + (c.tid >> 2)) * 256;
            const bf16_t* b0 = WQB + (size_t)(nt * 128 + (c.tid >> 2)) * 256;
            gemm_tile(a0, a0 + 64 * 256, b0, b0 + 64 * 256, 8, acc, c);
#pragma unroll
            for (int m = 0; m < 4; ++m) {
                const int row = mt * 128 + c.wr * 64 + m * 16 + c.fr;
#pragma unroll
                for (int np = 0; np < 2; ++np) {
                    const int cg = nt * 128 + c.wc * 64 + np * 32;
                    f32x4 v0 = acc[m][2 * np], v1 = acc[m][2 * np + 1];
                    if (((cg >> 5) % 3) == 2) {
#pragma unroll
                        for (int j = 0; j < 4; ++j) {
                            const int i = c.fq * 4 + j;
                            const float cs = ROPEM[((size_t)row * 16 + i) * 2], sn = ROPEM[((size_t)row * 16 + i) * 2 + 1];
                            const float x1 = v0[j], x2 = v1[j];
                            v0[j] = x1 * cs - x2 * sn; v1[j] = x2 * cs + x1 * sn;
                        }
                    }
                    v0 *= qscale; v1 *= qscale;
                    *(u32x2*)(QF + (size_t)row * 768 + cg + c.fq * 4) = (u32x2){pk2(v0[0], v0[1]), pk2(v0[2], v0[3])};
                    *(u32x2*)(QF + (size_t)row * 768 + cg + 16 + c.fq * 4) = (u32x2){pk2(v1[0], v1[1]), pk2(v1[2], v1[3])};
                }
            }
        } else {
            const int v = u - tq, mt = v / 8, nt = v % 8;
            const bf16_t* a0 = CKV + (size_t)(mt * 128 + (c.tid >> 2)) * 128;
            const bf16_t* b0 = WKVB + (size_t)(nt * 128 + (c.tid >> 2)) * 128;
            gemm_tile(a0, a0 + 64 * 128, b0, b0 + 64 * 128, 4, acc, c);
            bf16_t* dst = (c.wc == 0) ? KN : VV;
#pragma unroll
            for (int m = 0; m < 4; ++m) {
                const int row = mt * 128 + c.wr * 64 + m * 16 + c.fr;
#pragma unroll
                for (int n = 0; n < 4; ++n) {
                    const f32x4 x = acc[m][n];
                    *(u32x2*)(dst + (size_t)row * 512 + nt * 64 + n * 16 + c.fq * 4) = (u32x2){pk2(x[0], x[1]), pk2(x[2], x[3])};
                }
            }
        }
    }
}

__device__ __forceinline__ void phase_outproj(const bf16_t* MIXO, const bf16_t* W, const float* xres, float* YBUF, const Ctx& c) {
    for (int i = 0;; ++i) {
        int mt, nt; bool valid; if (!tile_map2(i, c, T / 128, 8, mt, nt, valid)) break;
        const bf16_t* a0 = MIXO + (size_t)(mt * 128 + (c.tid >> 2)) * 1024;
        const bf16_t* b0 = W + (size_t)(nt * 128 + (c.tid >> 2)) * 1024;
        f32x4 acc[4][4];
        gemm_tile(a0, a0 + 64 * 1024, b0, b0 + 64 * 1024, 32, acc, c);
#pragma unroll
        for (int m = 0; m < 4; ++m) {
            const int row = mt * 128 + c.wr * 64 + m * 16 + c.fr;
#pragma unroll
            for (int n = 0; n < 4; ++n) {
                const int col = nt * 128 + c.wc * 64 + n * 16 + c.fq * 4;
                const f32x4 xr = *(const f32x4*)(xres + (size_t)row * 1024 + col);
                if (valid) *(f32x4*)(YBUF + (size_t)row * 1024 + col) = xr * ALPHA + acc[m][n];
            }
        }
    }
}

__device__ __forceinline__ void phase_router(const bf16_t* XBF, const bf16_t* W, float* LOG, const Ctx& c) {
    for (int base = 0; base < T / 128; base += c.nblk) {
        const bool valid = (base + c.bid) < T / 128; const int mt = valid ? base + c.bid : 0;
        const bf16_t* a0 = XBF + (size_t)(mt * 128 + (c.tid >> 2)) * 1024;
        const bf16_t* b0 = W + (size_t)(c.tid >> 2) * 1024;
        f32x4 acc[4][4];
        gemm_tile(a0, a0 + 64 * 1024, b0, b0 + 64 * 1024, 32, acc, c);
        if (c.wc == 0 && valid) {
#pragma unroll
            for (int m = 0; m < 4; ++m) {
                const int row = mt * 128 + c.wr * 64 + m * 16 + c.fr;
#pragma unroll
                for (int n = 0; n < 4; ++n) *(f32x4*)(LOG + (size_t)row * 64 + n * 16 + c.fq * 4) = acc[m][n];
            }
        }
    }
}

__device__ __forceinline__ void build_block_table(const unsigned* CNT, int* bst, const Ctx& c) {
    __syncthreads();
    if (c.wid == 0) {
        const int cnt = (int)__hip_atomic_load(CNT + c.lane, __ATOMIC_RELAXED, __HIP_MEMORY_SCOPE_AGENT);
        const int nb = (cnt + RBR - 1) / RBR;
        int inc = nb;
#pragma unroll
        for (int o = 1; o < 64; o <<= 1) { const int x = shfl_up_(inc, o); if (c.lane >= o) inc += x; }
        bst[c.lane] = inc - nb; bst[66 + c.lane] = cnt;
        if (c.lane == 63) { bst[64] = inc; bst[65] = inc + T / RBR; bst[66 + 64] = T; }
    }
    __syncthreads();
}
__device__ __forceinline__ int find_expert(const int* bst, int rb, const Ctx& c) {
    return __popcll(__ballot(bst[1 + c.lane] <= rb));
}

__device__ __forceinline__ void phase_moe1(const bf16_t* XBF, const bf16_t* WGU, const unsigned* CNT, const int* LTOK, const float* LW, bf16_t* HBUF, const Ctx& c) {
    int* bst = (int*)(c.smem + 65536 + 64);
    build_block_table(CNT, bst, c);
    const int nsb = bst[65] * 2;
    for (int i = 0;; ++i) {
        int sbk, nt; bool valid; if (!tile_map2(i, c, nsb, 4, sbk, nt, valid)) break;
        const int rb = sbk >> 1, hb = sbk & 1;
        const int e = find_expert(bst, rb, c);
        const int lb = rb - bst[e], cnt = bst[66 + e];
        const int p0 = lb * RBR + hb * 128 + (c.tid >> 2), p1 = p0 + 64;
        const int t0 = (p0 < cnt) ? LTOK[(size_t)e * CAP + p0] : 0;
        const int t1 = (p1 < cnt) ? LTOK[(size_t)e * CAP + p1] : 0;
        const bf16_t* a0 = XBF + (size_t)t0 * 1024;
        const bf16_t* a1 = XBF + (size_t)t1 * 1024;
        const bf16_t* b0 = WGU + (size_t)e * WGU_ELEMS + (size_t)(nt * 128 + (c.tid >> 2)) * 1024;
        f32x4 acc[4][4];
        gemm_tile(a0, a1, b0, b0 + 64 * 1024, 32, acc, c);
#pragma unroll
        for (int m = 0; m < 4; ++m) {
            const int rl = c.wr * 64 + m * 16 + c.fr;
            const int pw = lb * RBR + hb * 128 + rl;
            const float wrow = (pw < cnt) ? LW[(size_t)e * CAP + pw] : 0.f;
#pragma unroll
            for (int n = 0; n < 2; ++n) {
                const f32x4 g = acc[m][n], up = acc[m][n + 2];
                float h[4];
#pragma unroll
                for (int j = 0; j < 4; ++j) h[j] = siluf_(g[j]) * up[j] * wrow;
                tile_put(c, rl, c.wc * 32 + n * 16 + c.fq * 4, (u32x2){pk2(h[0], h[1]), pk2(h[2], h[3])});
            }
        }
        tile_flush<64>(c, HBUF + ((size_t)rb * RBR + hb * 128) * 256 + nt * 64, 256, valid);
    }
}

__device__ __forceinline__ void phase_moe2(const bf16_t* HBUF, const bf16_t* WDN, const unsigned* CNT, bf16_t* Y, const Ctx& c) {
    int* bst = (int*)(c.smem + 65536 + 64);
    build_block_table(CNT, bst, c);
    const int nsb = bst[65] * 2;
    for (int i = 0;; ++i) {
        int sbk, nt; bool valid; if (!tile_map2(i, c, nsb, 8, sbk, nt, valid)) break;
        const int rb = sbk >> 1;
        const int e = find_expert(bst, rb, c);
        const bf16_t* a0 = HBUF + ((size_t)sbk * 128 + (c.tid >> 2)) * 256;
        const bf16_t* b0 = WDN + (size_t)e * WDN_ELEMS + (size_t)(nt * 128 + (c.tid >> 2)) * 256;
        f32x4 acc[4][4];
        gemm_tile(a0, a0 + 64 * 256, b0, b0 + 64 * 256, 8, acc, c);
#pragma unroll
        for (int m = 0; m < 4; ++m) {
            const int lr = c.wr * 64 + m * 16 + c.fr;
#pragma unroll
            for (int n = 0; n < 4; ++n) {
                const f32x4 v = acc[m][n];
                tile_put(c, lr, c.wc * 64 + n * 16 + c.fq * 4, (u32x2){pk2(v[0], v[1]), pk2(v[2], v[3])});
            }
        }
        tile_flush<128>(c, Y + (size_t)sbk * 128 * 1024 + nt * 128, 1024, valid);
    }
}

__device__ __forceinline__ float dppf(float v, int ctrl_sel) {
    int x = __builtin_bit_cast(int, v), r;
    if (ctrl_sel == 0) r = __builtin_amdgcn_update_dpp(0, x, 0xB1, 0xF, 0xF, true);
    else if (ctrl_sel == 1) r = __builtin_amdgcn_update_dpp(0, x, 0x4E, 0xF, 0xF, true);
    else if (ctrl_sel == 2) r = __builtin_amdgcn_update_dpp(0, x, 0x141, 0xF, 0xF, true);
    else r = __builtin_amdgcn_update_dpp(0, x, 0x140, 0xF, 0xF, true);
    return __builtin_bit_cast(float, r);
}
__device__ __forceinline__ float red16(float v) { v += dppf(v, 0); v += dppf(v, 1); v += dppf(v, 2); v += dppf(v, 3); return v; }

template <bool F32OUT>
__device__ __forceinline__ void ln_row_store(float (&v)[16], const float* g, const float* b, float* of32, bf16_t* obf, int lane) {
    float s = 0.f;
#pragma unroll
    for (int i = 0; i < 16; ++i) s += v[i];
    const float mean = wave_sum(s) * (1.f / 1024.f);
    float q = 0.f;
#pragma unroll
    for (int i = 0; i < 16; ++i) { v[i] -= mean; q += v[i] * v[i]; }
    const float rstd = rsqrtf(wave_sum(q) * (1.f / 1024.f) + 1e-5f);
#pragma unroll
    for (int hf = 0; hf < 2; ++hf) {
        const int col = hf * 512 + lane * 8;
        const f32x4 g0 = *(const f32x4*)(g + col), g1 = *(const f32x4*)(g + col + 4);
        const f32x4 b0 = *(const f32x4*)(b + col), b1 = *(const f32x4*)(b + col + 4);
        f32x4 y0, y1;
#pragma unroll
        for (int j = 0; j < 4; ++j) { y0[j] = v[hf * 8 + j] * rstd * g0[j] + b0[j]; y1[j] = v[hf * 8 + 4 + j] * rstd * g1[j] + b1[j]; }
        if constexpr (F32OUT) { *(f32x4*)(of32 + col) = y0; *(f32x4*)(of32 + col + 4) = y1; }
        *(u32x4*)(obf + col) = (u32x4){pk2(y0[0], y0[1]), pk2(y0[2], y0[3]), pk2(y1[0], y1[1]), pk2(y1[2], y1[3])};
    }
}

__device__ __forceinline__ void phase_ln1(const bf16_t* YBUF, const float* g, const float* b, bf16_t* XBF, const Ctx& c) {
    for (int t = c.bid * 4 + c.wid; t < T; t += c.nblk * 4) {
        float v[16];
#pragma unroll
        for (int hf = 0; hf < 2; ++hf) {
            const u32x4 r = *(const u32x4*)(YBUF + (size_t)t * 1024 + hf * 512 + c.lane * 8);
            float f[8]; unpack8(r, f);
#pragma unroll
            for (int j = 0; j < 8; ++j) v[hf * 8 + j] = f[j];
        }
        ln_row_store<false>(v, g, b, nullptr, XBF + (size_t)t * 1024, c.lane);
    }
}

template <bool LASTL>
__device__ __forceinline__ void phase_combine(const bf16_t* Y, const int* ASG, const float* ASGW, const unsigned* CNT, const float* g, const float* b,
                              float* XOUT, bf16_t* XBF, const Ctx& c) {
    int* bst = (int*)(c.smem + 65536 + 64);
    build_block_table(CNT, bst, c);
    for (int t = c.bid * 4 + c.wid; t < T; t += c.nblk * 4) {
        float v[16];
#pragma unroll
        for (int hf = 0; hf < 2; ++hf) {
            const u32x4 r = *(const u32x4*)(XBF + (size_t)t * 1024 + hf * 512 + c.lane * 8);
            float f[8]; unpack8(r, f);
#pragma unroll
            for (int j = 0; j < 8; ++j) v[hf * 8 + j] = f[j] * ALPHA;
        }
#pragma unroll
        for (int k = 0; k < 9; ++k) {
            size_t crow; float wk = 1.f;
            if (k < 8) { const int asg = ASG[(size_t)t * 8 + k]; crow = (size_t)bst[asg >> 16] * RBR + (asg & 0xffff); wk = ASGW[(size_t)t * 8 + k]; }
            else crow = (size_t)bst[64] * RBR + t;
#pragma unroll
            for (int hf = 0; hf < 2; ++hf) {
                const u32x4 r = *(const u32x4*)(Y + crow * 1024 + hf * 512 + c.lane * 8);
                float f[8]; unpack8(r, f);
#pragma unroll
                for (int j = 0; j < 8; ++j) v[hf * 8 + j] += f[j] * wk;
            }
        }
        ln_row_store<LASTL>(v, g, b, XOUT + (size_t)t * 1024, XBF + (size_t)t * 1024, c.lane);
    }
}

__device__ __forceinline__ void phase_route(const float* LOG, const float* rb, unsigned* CNT, int* LTOK, float* LW, int* ASG, float* ASGW, const Ctx& c) {
    int* lcnt = (int*)c.smem;
    int* lbase = lcnt + 64;
    int* sel_e = lbase + 64;
    int* sel_p = sel_e + 256;
    float* sel_w = (float*)(sel_p + 256);
    const float rbias = rb[c.lane];
    for (int base = 0; base < T / 32; base += c.nblk) {
        const int ch = base + c.bid; const bool valid = ch < T / 32;
        __syncthreads();
        if (c.tid < 64) lcnt[c.tid] = 0;
        __syncthreads();
        if (valid) for (int tl = c.wid; tl < 32; tl += 4) {
            const int t = ch * 32 + tl;
            const float lg = LOG[(size_t)t * 64 + c.lane];
            const float sc = 1.f / (1.f + expf(-lg));
            const float v = sc + rbias;
            float m1 = v;
            m1 = fmaxf(m1, shfl_xor_(m1, 1)); m1 = fmaxf(m1, shfl_xor_(m1, 2)); m1 = fmaxf(m1, shfl_xor_(m1, 4));
            int cand = (v == m1) ? c.lane : 999;
            cand = min(cand, shfl_xor_(cand, 1)); cand = min(cand, shfl_xor_(cand, 2)); cand = min(cand, shfl_xor_(cand, 4));
            float m2 = (c.lane == cand) ? -INFINITY : v;
            m2 = fmaxf(m2, shfl_xor_(m2, 1)); m2 = fmaxf(m2, shfl_xor_(m2, 2)); m2 = fmaxf(m2, shfl_xor_(m2, 4));
            const float gs = m1 + m2;
            const int g = c.lane >> 3;
            int grank = 0;
#pragma unroll
            for (int gg = 0; gg < 8; ++gg) { const float o = shfl_c_(gs, gg * 8); grank += ((o > gs) || (o == gs && gg < g)) ? 1 : 0; }
            const bool gsel = grank < 4;
            const float mv = gsel ? v : -INFINITY;
            int rank = 0;
#pragma unroll 8
            for (int jj = 0; jj < 64; ++jj) { const float o = shfl_c_(mv, jj); rank += ((o > mv) || (o == mv && jj < c.lane)) ? 1 : 0; }
            const bool sel = gsel && rank < 8;
            const float ssum = wave_sum(sel ? sc : 0.f);
            const float w = sc / ssum * 2.5f;
            const unsigned long long bal = __ballot(sel);
            const int slot = __popcll(bal & ((1ull << c.lane) - 1ull));
            if (sel) {
                const int p = atomicAdd(&lcnt[c.lane], 1);
                sel_e[tl * 8 + slot] = c.lane; sel_p[tl * 8 + slot] = p; sel_w[tl * 8 + slot] = w;
            }
        }
        __syncthreads();
        if (valid && c.tid < 64) { const int n = lcnt[c.tid]; lbase[c.tid] = n ? (int)atomicAdd(CNT + c.tid, (unsigned)n) : 0; }
        __syncthreads();
        if (valid) {
            const int tl = c.tid >> 3, t = ch * 32 + tl;
            const int e = sel_e[c.tid], pos = lbase[e] + sel_p[c.tid];
            LTOK[(size_t)e * CAP + pos] = t; LW[(size_t)e * CAP + pos] = sel_w[c.tid];
            ASG[(size_t)t * 8 + (c.tid & 7)] = (e << 16) | pos; ASGW[(size_t)t * 8 + (c.tid & 7)] = sel_w[c.tid];
            if (c.tid < 32) { const int ts = ch * 32 + c.tid; LTOK[(size_t)64 * CAP + ts] = ts; LW[(size_t)64 * CAP + ts] = 1.f; }
        }
    }
}

__device__ __forceinline__ void phase_lnroute(const bf16_t* YBUF, const float* g, const float* b, bf16_t* XBF, const bf16_t* W, const float* rb,
                                              unsigned* CNT, int* LTOK, float* LW, int* ASG, float* ASGW, const Ctx& c) {
    unsigned char* xa = c.smem;
    int* lcnt = (int*)(c.smem + 65536 + 64);
    int* lbase = lcnt + 64;
    float* lgt = (float*)c.smem;
    int* sel_e = (int*)(c.smem + 8192);
    int* sel_p = sel_e + 256;
    float* sel_w = (float*)(sel_p + 256);
    const int lane = c.lane;
    const float rbias = rb[lane];
    for (int base = 0; base < T / 32; base += c.nblk) {
        const int ch = base + c.bid; const bool valid = ch < T / 32;
        __syncthreads();
        if (c.tid < 64) lcnt[c.tid] = 0;
        u32x4 raw[8][2];
#pragma unroll
        for (int i = 0; i < 8; ++i)
#pragma unroll
            for (int hf = 0; hf < 2; ++hf) raw[i][hf] = valid ? *(const u32x4*)(YBUF + (size_t)(ch * 32 + c.wid + 4 * i) * 1024 + hf * 512 + lane * 8) : (u32x4){0u, 0u, 0u, 0u};
        if (valid)
#pragma unroll
        for (int i = 0; i < 8; ++i) {
            const int tl = c.wid + 4 * i;
            const int t = ch * 32 + tl;
            float v[16];
#pragma unroll
            for (int hf = 0; hf < 2; ++hf) {
                float f[8]; unpack8(raw[i][hf], f);
#pragma unroll
                for (int j = 0; j < 8; ++j) v[hf * 8 + j] = f[j];
            }
            float s = 0.f;
#pragma unroll
            for (int i = 0; i < 16; ++i) s += v[i];
            const float mean = wave_sum(s) * (1.f / 1024.f);
            float q = 0.f;
#pragma unroll
            for (int i = 0; i < 16; ++i) { v[i] -= mean; q += v[i] * v[i]; }
            const float rstd = rsqrtf(wave_sum(q) * (1.f / 1024.f) + 1e-5f);
#pragma unroll
            for (int hf = 0; hf < 2; ++hf) {
                const int col = hf * 512 + lane * 8;
                const f32x4 g0 = *(const f32x4*)(g + col), g1 = *(const f32x4*)(g + col + 4);
                const f32x4 b0 = *(const f32x4*)(b + col), b1 = *(const f32x4*)(b + col + 4);
                f32x4 y0, y1;
#pragma unroll
                for (int j = 0; j < 4; ++j) { y0[j] = v[hf * 8 + j] * rstd * g0[j] + b0[j]; y1[j] = v[hf * 8 + 4 + j] * rstd * g1[j] + b1[j]; }
                const u32x4 pk = (u32x4){pk2(y0[0], y0[1]), pk2(y0[2], y0[3]), pk2(y1[0], y1[1]), pk2(y1[2], y1[3])};
                *(u32x4*)(XBF + (size_t)t * 1024 + col) = pk;
                *(u32x4*)(xa + tl * 2048 + (((hf * 64 + lane) ^ (tl & 15)) * 16)) = pk;
            }
        }
        __syncthreads();
        f32x4 acc0 = (f32x4){0.f, 0.f, 0.f, 0.f}, acc1 = (f32x4){0.f, 0.f, 0.f, 0.f};
        {
            const int r = lane & 15, kq = lane >> 4;
            const bf16_t* wrow = W + (size_t)(c.wid * 16 + r) * 1024 + kq * 8;
#pragma unroll 1
            for (int kb = 0; kb < 32; kb += 8) {
                bf16x8 bfr[8];
#pragma unroll
                for (int j = 0; j < 8; ++j) bfr[j] = *(const bf16x8*)(wrow + (kb + j) * 32);
#pragma unroll
                for (int j = 0; j < 8; ++j) {
                    const int chunk = ((kb + j) * 4 + kq) ^ r;
                    const bf16x8 a0 = *(const bf16x8*)(xa + r * 2048 + chunk * 16), a1 = *(const bf16x8*)(xa + (16 + r) * 2048 + chunk * 16);
                    acc0 = __builtin_amdgcn_mfma_f32_16x16x32_bf16(a0, bfr[j], acc0, 0, 0, 0);
                    acc1 = __builtin_amdgcn_mfma_f32_16x16x32_bf16(a1, bfr[j], acc1, 0, 0, 0);
                }
            }
        }
        __syncthreads();
        {
            const int e = c.wid * 16 + (lane & 15), r0 = 4 * (lane >> 4);
#pragma unroll
            for (int j = 0; j < 4; ++j) { lgt[(r0 + j) * 64 + e] = acc0[j]; lgt[(16 + r0 + j) * 64 + e] = acc1[j]; }
        }
        __syncthreads();
        if (valid) for (int tl = c.wid; tl < 32; tl += 4) {
            const float lg = lgt[tl * 64 + lane];
            const float sc = 1.f / (1.f + expf(-lg));
            const float v = sc + rbias;
            float m1 = v;
            m1 = fmaxf(m1, shfl_xor_(m1, 1)); m1 = fmaxf(m1, shfl_xor_(m1, 2)); m1 = fmaxf(m1, shfl_xor_(m1, 4));
            int cand = (v == m1) ? lane : 999;
            cand = min(cand, shfl_xor_(cand, 1)); cand = min(cand, shfl_xor_(cand, 2)); cand = min(cand, shfl_xor_(cand, 4));
            float m2 = (lane == cand) ? -INFINITY : v;
            m2 = fmaxf(m2, shfl_xor_(m2, 1)); m2 = fmaxf(m2, shfl_xor_(m2, 2)); m2 = fmaxf(m2, shfl_xor_(m2, 4));
            const float gs = m1 + m2;
            const int gi = lane >> 3;
            int grank = 0;
#pragma unroll
            for (int gg = 0; gg < 8; ++gg) { const float o = shfl_c_(gs, gg * 8); grank += ((o > gs) || (o == gs && gg < gi)) ? 1 : 0; }
            const bool gsel = grank < 4;
            const float mv = gsel ? v : -INFINITY;
            int rank = 0;
#pragma unroll 8
            for (int jj = 0; jj < 64; ++jj) { const float o = shfl_c_(mv, jj); rank += ((o > mv) || (o == mv && jj < lane)) ? 1 : 0; }
            const bool sel = gsel && rank < 8;
            const float ssum = wave_sum(sel ? sc : 0.f);
            const float w = sc / ssum * 2.5f;
            const unsigned long long bal = __ballot(sel);
            const int slot = __popcll(bal & ((1ull << lane) - 1ull));
            if (sel) {
                const int p = atomicAdd(&lcnt[lane], 1);
                sel_e[tl * 8 + slot] = lane; sel_p[tl * 8 + slot] = p; sel_w[tl * 8 + slot] = w;
            }
        }
        __syncthreads();
        if (valid && c.tid < 64) { const int n = lcnt[c.tid]; lbase[c.tid] = n ? (int)atomicAdd(CNT + c.tid, (unsigned)n) : 0; }
        __syncthreads();
        if (valid) {
            const int tl = c.tid >> 3, t = ch * 32 + tl;
            const int e = sel_e[c.tid], pos = lbase[e] + sel_p[c.tid];
            LTOK[(size_t)e * CAP + pos] = t; LW[(size_t)e * CAP + pos] = sel_w[c.tid];
            ASG[(size_t)t * 8 + (c.tid & 7)] = (e << 16) | pos; ASGW[(size_t)t * 8 + (c.tid & 7)] = sel_w[c.tid];
            if (c.tid < 32) { const int ts = ch * 32 + c.tid; LTOK[(size_t)64 * CAP + ts] = ts; LW[(size_t)64 * CAP + ts] = 1.f; }
        }
    }
}

__device__ __forceinline__ void phase_prep_even(const bf16_t* PROJ, const float* GATES, const float* qn, const float* kvn, const float* cw,
                                const float* a_log, const float* dt_bias, const float* ROPEM,
                                bf16_t* CQ, bf16_t* CKV, bf16_t* KROPE, bf16_t* GQ, bf16_t* GK, bf16_t* GV, float* BETA, float* GLOG, const Ctx& c) {
    const int lane = c.lane;
    float* cwL = (float*)c.smem;
    __syncthreads();
    for (int i = c.tid; i < 4 * 1536 / 4; i += 256) *(f32x4*)(cwL + i * 4) = *(const f32x4*)(cw + i * 4);
    __syncthreads();
    for (int t = c.bid * 4 + c.wid; t < T; t += c.nblk * 4) {
        const bf16_t* pr = PROJ + (size_t)t * NPAD;
        {
            const u32x2 r = *(const u32x2*)(pr + lane * 4);
            float v[4] = {bflo(r.x), bfhi(r.x), bflo(r.y), bfhi(r.y)};
            const float ss = wave_sum(v[0] * v[0] + v[1] * v[1] + v[2] * v[2] + v[3] * v[3]);
            const float rr = rsqrtf(ss * (1.f / 256.f) + 1e-6f);
            const f32x4 gq = *(const f32x4*)(qn + lane * 4);
            *(u32x2*)(CQ + (size_t)t * 256 + lane * 4) = (u32x2){pk2(v[0] * rr * gq[0], v[1] * rr * gq[1]), pk2(v[2] * rr * gq[2], v[3] * rr * gq[3])};
        }
        {
            const unsigned r = *(const unsigned*)(pr + 256 + lane * 2);
            const float v0 = bflo(r), v1 = bfhi(r);
            const float ss = wave_sum(v0 * v0 + v1 * v1);
            const float rr = rsqrtf(ss * (1.f / 128.f) + 1e-6f);
            *(unsigned*)(CKV + (size_t)t * 128 + lane * 2) = pk2(v0 * rr * kvn[lane * 2], v1 * rr * kvn[lane * 2 + 1]);
        }
        if (lane < 16) {
            const float x1 = bf2f(pr[384 + lane]), x2 = bf2f(pr[400 + lane]);
            const float cs = ROPEM[((size_t)t * 16 + lane) * 2], sn = ROPEM[((size_t)t * 16 + lane) * 2 + 1];
            KROPE[(size_t)t * 32 + lane] = (bf16_t)f2bf(x1 * cs - x2 * sn);
            KROPE[(size_t)t * 32 + 16 + lane] = (bf16_t)f2bf(x2 * cs + x1 * sn);
        }
        const int s = t & (SEQ - 1);
        u32x4 xr[3][4];
#pragma unroll
        for (int arr = 0; arr < 3; ++arr)
#pragma unroll
            for (int w = 0; w < 4; ++w)
                xr[arr][w] = (s - 3 + w >= 0) ? *(const u32x4*)(PROJ + (size_t)(t - 3 + w) * NPAD + 416 + arr * 512 + lane * 8) : (u32x4){0u, 0u, 0u, 0u};
#pragma unroll
        for (int arr = 0; arr < 3; ++arr) {
            float y[8];
#pragma unroll
            for (int j = 0; j < 8; ++j) y[j] = 0.f;
#pragma unroll
            for (int w = 0; w < 4; ++w) {
                float f[8]; unpack8(xr[arr][w], f);
                const f32x4 c0 = *(const f32x4*)(cwL + w * 1536 + arr * 512 + lane * 8), c1 = *(const f32x4*)(cwL + w * 1536 + arr * 512 + lane * 8 + 4);
#pragma unroll
                for (int j = 0; j < 4; ++j) { y[j] += c0[j] * f[j]; y[4 + j] += c1[j] * f[4 + j]; }
            }
            float ss = 0.f;
#pragma unroll
            for (int j = 0; j < 8; ++j) { y[j] = siluf_(y[j]); ss += y[j] * y[j]; }
            if (arr < 2) {
                float rr = rsqrtf(red16(ss) + 1e-6f);
                if (arr == 0) rr *= 0.08838834764831845f;
#pragma unroll
                for (int j = 0; j < 8; ++j) y[j] *= rr;
            }
            bf16_t* dst = (arr == 0) ? GQ : (arr == 1) ? GK : GV;
            *(u32x4*)(dst + (size_t)t * 512 + lane * 8) = (u32x4){pk2(y[0], y[1]), pk2(y[2], y[3]), pk2(y[4], y[5]), pk2(y[6], y[7])};
        }
        if (lane < 4) BETA[(size_t)t * 4 + lane] = sigmoidf_(GATES[(size_t)t * 8 + lane]);
        else if (lane < 8) { const int h = lane - 4; GLOG[(size_t)t * 4 + h] = -expf(a_log[h]) * softplusf_(GATES[(size_t)t * 8 + lane] + dt_bias[h]); }
    }
}

__device__ __forceinline__ void phase_prep_odd(const bf16_t* PROJ, const float* ROPES, bf16_t* SQ, bf16_t* SK, const Ctx& c) {
    const int lane = c.lane;
    for (int t = c.bid * 4 + c.wid; t < T; t += c.nblk * 4) {
        const bf16_t* pr = PROJ + (size_t)t * NPAD;
        const int i = lane & 31;
        const float cs = ROPES[((size_t)t * 32 + i) * 2], sn = ROPES[((size_t)t * 32 + i) * 2 + 1];
#pragma unroll
        for (int r = 0; r < 4; ++r) {
            const int h = (lane >> 5) + 2 * r;
            const float x1 = bf2f(pr[1544 + h * 64 + i]), x2 = bf2f(pr[1544 + h * 64 + 32 + i]);
            SQ[(size_t)t * 512 + h * 64 + i] = (bf16_t)f2bf((x1 * cs - x2 * sn) * 0.18033688011112042f);
            SQ[(size_t)t * 512 + h * 64 + 32 + i] = (bf16_t)f2bf((x2 * cs + x1 * sn) * 0.18033688011112042f);
        }
        {
            const int h = lane >> 5;
            const float x1 = bf2f(pr[2056 + h * 64 + i]), x2 = bf2f(pr[2056 + h * 64 + 32 + i]);
            SK[(size_t)t * 128 + h * 64 + i] = (bf16_t)f2bf(x1 * cs - x2 * sn);
            SK[(size_t)t * 128 + h * 64 + 32 + i] = (bf16_t)f2bf(x2 * cs + x1 * sn);
        }
    }
}

__device__ __forceinline__ int next_unit(unsigned* ctr, const Ctx& c) {
    volatile int* su = (volatile int*)(c.smem0 + LDS_BLK + 16);
    __syncthreads();
    if (c.tid0 == 0) *su = (int)atomicAdd(ctr, 1u);
    __syncthreads();
    return *su * 2 + c.half;
}

typedef float f32x16 __attribute__((ext_vector_type(16)));
typedef short s16x4 __attribute__((ext_vector_type(4)));
#define MFMA32(a, b, c) __builtin_amdgcn_mfma_f32_32x32x16_bf16((a), (b), (c), 0, 0, 0)
template <int S_> __device__ __forceinline__ bf16x8 pack_step(const f32x16& x) {
    u32x4 p;
    asm volatile("v_cvt_pk_bf16_f32 %0, %4, %5\n\tv_cvt_pk_bf16_f32 %1, %6, %7\n\tv_cvt_pk_bf16_f32 %2, %8, %9\n\tv_cvt_pk_bf16_f32 %3, %10, %11\n\ts_nop 1"
                 : "=&v"(p[0]), "=&v"(p[1]), "=&v"(p[2]), "=&v"(p[3])
                 : "v"(x[8 * S_]), "v"(x[8 * S_ + 1]), "v"(x[8 * S_ + 2]), "v"(x[8 * S_ + 3]), "v"(x[8 * S_ + 4]), "v"(x[8 * S_ + 5]), "v"(x[8 * S_ + 6]), "v"(x[8 * S_ + 7]));
    return __builtin_bit_cast(bf16x8, p);
}
template <int S_> __device__ __forceinline__ bf16x8 pack_step_m(const f32x16& x) {
    u32x4 p;
    asm volatile("s_nop 15\n\tv_cvt_pk_bf16_f32 %0, %4, %5\n\tv_cvt_pk_bf16_f32 %1, %6, %7\n\tv_cvt_pk_bf16_f32 %2, %8, %9\n\tv_cvt_pk_bf16_f32 %3, %10, %11\n\ts_nop 1"
                 : "=&v"(p[0]), "=&v"(p[1]), "=&v"(p[2]), "=&v"(p[3])
                 : "v"(x[8 * S_]), "v"(x[8 * S_ + 1]), "v"(x[8 * S_ + 2]), "v"(x[8 * S_ + 3]), "v"(x[8 * S_ + 4]), "v"(x[8 * S_ + 5]), "v"(x[8 * S_ + 6]), "v"(x[8 * S_ + 7]));
    return __builtin_bit_cast(bf16x8, p);
}
constexpr int ATT_VB = 64 * 128;

template <int NKS, bool WIN>
__device__ __forceinline__ void attn_unit(const bf16_t* Qp, int q_ld, const bf16_t* K1, int k1_ld, const bf16_t* K2, int k2_ld, const bf16_t* Vp, int v_ld,
                          bf16_t* Op, int o_ld, int Q0, float sink_l2, const Ctx& c) {
    constexpr int KB = NKS * 2 * 1024, BUF = KB + ATT_VB;
    const int lane = c.lane, r = lane & 31, h = lane >> 5;
    const int wid = __builtin_amdgcn_readfirstlane(c.wid);
    const int q0w = Q0 + wid * 32;
    unsigned char* smem = c.smem;
    bf16x8 qf[NKS];
#pragma unroll
    for (int ks = 0; ks < NKS; ++ks) qf[ks] = *(const bf16x8*)(Qp + (size_t)(q0w + r) * q_ld + ks * 16 + h * 8);
    f32x16 o0, o1;
#pragma unroll
    for (int i = 0; i < 16; ++i) { o0[i] = 0.f; o1[i] = 0.f; }
    float m = WIN ? sink_l2 : -1e30f, l = (WIN && h == 0) ? 1.f : 0.f;
    const int kt_lo = WIN ? ((Q0 >> 6) - 2 < 0 ? 0 : (Q0 >> 6) - 2) : 0, kt_hi = (Q0 >> 6) + 1;
#define ATT_STAGE(kt_, buf_) do { unsigned char* bp = smem + (buf_) * BUF; const size_t kb = (size_t)(kt_) * 64; \
        _Pragma("unroll") for (int i = 0; i < (NKS * 2) / 4; ++i) { const int ch = wid + 4 * i; \
            const bf16_t* sp = (ch < 8) ? (K1 + (kb + lane) * k1_ld + ch * 8) : (K2 + (kb + lane) * k2_ld + (ch - 8) * 8); \
            glds16(sp, bp + ch * 1024 + lane * 16); } \
        _Pragma("unroll") for (int i = 0; i < 2; ++i) { const int j = wid + 4 * i; \
            glds16(Vp + (kb + 8 * j + (lane >> 3)) * v_ld + (lane & 7) * 8, bp + KB + j * 1024 + lane * 16); } } while (0)
    ATT_STAGE(kt_lo, 0);
    const int i16 = lane & 15;
    const unsigned vlane = (unsigned)((4 * h + (i16 >> 2)) * 128 + 32 * ((lane >> 4) & 1) + 8 * (i16 & 3));
    for (int kt = kt_lo; kt <= kt_hi; ++kt) {
        const int cur = (kt - kt_lo) & 1;
        asm volatile("s_waitcnt vmcnt(0)" ::: "memory");
        __syncthreads();
        if (kt < kt_hi) ATT_STAGE(kt + 1, cur ^ 1);
        const int k0 = kt * 64;
        const bool active = (k0 <= q0w + 31) && (!WIN || (k0 + 63 > q0w - 128));
        if (active) {
            const unsigned char* Kt = smem + cur * BUF;
            f32x16 x0, x1;
#pragma unroll
            for (int i = 0; i < 16; ++i) { x0[i] = 0.f; x1[i] = 0.f; }
#pragma unroll
            for (int ks = 0; ks < NKS; ++ks) {
                const bf16x8 kf0 = *(const bf16x8*)(Kt + (ks * 2 + h) * 1024 + r * 16);
                const bf16x8 kf1 = *(const bf16x8*)(Kt + (ks * 2 + h) * 1024 + (32 + r) * 16);
                x0 = MFMA32(kf0, qf[ks], x0); x1 = MFMA32(kf1, qf[ks], x1);
            }
            const bool need_mask = (k0 + 63 > q0w) || (WIN && (k0 <= q0w + 31 - 128));
            if (need_mask) {
                const int q = q0w + r;
#pragma unroll
                for (int i = 0; i < 16; ++i) {
                    const int key = k0 + (i & 3) + 8 * (i >> 2) + 4 * h;
                    const bool v0 = (key <= q) && (!WIN || key > q - 128);
                    const bool v1 = (key + 32 <= q) && (!WIN || key + 32 > q - 128);
                    x0[i] = v0 ? x0[i] : -INFINITY; x1[i] = v1 ? x1[i] : -INFINITY;
                }
            }
            float mx = fmaxf(x0[0], x1[0]);
#pragma unroll
            for (int i = 1; i < 16; ++i) mx = fmaxf(mx, fmaxf(x0[i], x1[i]));
            mx = fmaxf(mx, shfl_xor_(mx, 32));
            const float mn = fmaxf(m, mx);
            const float alpha = __builtin_amdgcn_exp2f(m - mn);
            m = mn;
            float ps = 0.f;
#pragma unroll
            for (int i = 0; i < 16; ++i) { x0[i] = __builtin_amdgcn_exp2f(x0[i] - mn); x1[i] = __builtin_amdgcn_exp2f(x1[i] - mn); ps += x0[i] + x1[i]; }
            l = l * alpha + ps;
            o0 *= alpha; o1 *= alpha;
            const unsigned vbase = (unsigned)(size_t)(smem + cur * BUF + KB) + vlane;
#pragma unroll
            for (int t = 0; t < 2; ++t) {
                s16x4 l00, h00, l01, h01, l10, h10, l11, h11;
                const unsigned va = vbase + t * 4096;
                asm volatile("ds_read_b64_tr_b16 %0, %8\n\t"
                             "ds_read_b64_tr_b16 %1, %8 offset:1024\n\t"
                             "ds_read_b64_tr_b16 %2, %8 offset:64\n\t"
                             "ds_read_b64_tr_b16 %3, %8 offset:1088\n\t"
                             "ds_read_b64_tr_b16 %4, %8 offset:2048\n\t"
                             "ds_read_b64_tr_b16 %5, %8 offset:3072\n\t"
                             "ds_read_b64_tr_b16 %6, %8 offset:2112\n\t"
                             "ds_read_b64_tr_b16 %7, %8 offset:3136\n\t"
                             "s_waitcnt lgkmcnt(0)"
                             : "=&v"(l00), "=&v"(h00), "=&v"(l01), "=&v"(h01), "=&v"(l10), "=&v"(h10), "=&v"(l11), "=&v"(h11) : "v"(va) : "memory");
                const bf16x8 v00 = __builtin_shufflevector(l00, h00, 0, 1, 2, 3, 4, 5, 6, 7), v01 = __builtin_shufflevector(l01, h01, 0, 1, 2, 3, 4, 5, 6, 7);
                const bf16x8 v10 = __builtin_shufflevector(l10, h10, 0, 1, 2, 3, 4, 5, 6, 7), v11 = __builtin_shufflevector(l11, h11, 0, 1, 2, 3, 4, 5, 6, 7);
                const bf16x8 pb0 = (t == 0) ? pack_step<0>(x0) : pack_step<0>(x1);
                const bf16x8 pb1 = (t == 0) ? pack_step<1>(x0) : pack_step<1>(x1);
                o0 = MFMA32(v00, pb0, o0); o1 = MFMA32(v01, pb0, o1);
                o0 = MFMA32(v10, pb1, o0); o1 = MFMA32(v11, pb1, o1);
            }
        }
    }
#undef ATT_STAGE
    l += shfl_xor_(l, 32);
    const float inv = 1.f / l;
    bf16_t* orow = Op + (size_t)(q0w + r) * o_ld + 4 * h;
#pragma unroll
    for (int g = 0; g < 4; ++g) {
        *(u32x2*)(orow + 8 * g) = (u32x2){pk2(o0[4 * g] * inv, o0[4 * g + 1] * inv), pk2(o0[4 * g + 2] * inv, o0[4 * g + 3] * inv)};
        *(u32x2*)(orow + 32 + 8 * g) = (u32x2){pk2(o1[4 * g] * inv, o1[4 * g + 1] * inv), pk2(o1[4 * g + 2] * inv, o1[4 * g + 3] * inv)};
    }
}

constexpr size_t MLC_DC = 0, MLC_CS = 33554432, MLC_DN = MLC_CS + 16777216, MLC_NS = MLC_DN + 262144, MLC_ML = MLC_NS + 262144, MLC_BE = MLC_ML + 4096, MLC_MS = MLC_BE + 4096;

__device__ __forceinline__ float scan_add64(float v, int lane) {
#pragma unroll
    for (int o = 1; o < 64; o <<= 1) { const float x = shfl_up_(v, o); if (lane >= o) v += x; }
    return v;
}
__device__ __forceinline__ float scan_max64(float v, int lane) {
#pragma unroll
    for (int o = 1; o < 64; o <<= 1) { const float x = shfl_up_(v, o); if (lane >= o) v = fmaxf(v, x); }
    return v;
}
__device__ __forceinline__ float wave_max(float v) {
#pragma unroll
    for (int o = 32; o > 0; o >>= 1) v = fmaxf(v, shfl_xor_(v, o));
    return v;
}

__device__ __forceinline__ void mlc_passA(int u, const bf16_t* PROJ, const float* GATES, const float* b_i, const float* b_f, unsigned char* YB, const Ctx& c) {
    const int bh = u >> 5, b = bh >> 2, h = bh & 3;
    const size_t t0 = (size_t)b * SEQ + (u & 31) * 64;
    unsigned char* smem = c.smem;
    float* saL = (float*)(smem + 24576);
    const int lane = c.lane, wid = __builtin_amdgcn_readfirstlane(c.wid);
#pragma unroll
    for (int i = 0; i < 4; ++i) { const int j = wid * 4 + i;
        glds16(PROJ + (t0 + 4 * j + (lane >> 4)) * NPAD + 512 + h * 128 + (lane & 15) * 8, smem + 8192 + j * 1024 + lane * 16); }
    if (wid == 0) {
        const float ip = GATES[(t0 + lane) * 8 + h] + b_i[h], lf = -softplusf_(-(GATES[(t0 + lane) * 8 + 4 + h] + b_f[h]));
        const float bc = scan_add64(lf, lane), bend = shfl_c_(bc, 63);
        const float a = bend - bc + ip, mloc = wave_max(a);
        saL[lane] = expf(a - mloc) * 0.125f;
        if (lane == 0) { ((float*)(YB + MLC_ML))[u] = mloc; ((float*)(YB + MLC_BE))[u] = bend; }
    }
    __syncthreads();
#pragma unroll
    for (int i = 0; i < 2; ++i) {
        const int idx = c.tid + 256 * i, row = idx >> 3, chk = idx & 7;
        const u32x4 r = *(const u32x4*)(PROJ + (t0 + row) * NPAD + 256 + h * 64 + chk * 8);
        float f[8]; unpack8(r, f);
        const float s = saL[row];
        *(u32x4*)(smem + row * 128 + chk * 16) = (u32x4){pk2(f[0] * s, f[1] * s), pk2(f[2] * s, f[3] * s), pk2(f[4] * s, f[5] * s), pk2(f[6] * s, f[7] * s)};
    }
    asm volatile("s_waitcnt vmcnt(0)" ::: "memory");
    __syncthreads();
    const int h5 = lane >> 5, r = lane & 31, i16 = lane & 15, q4 = i16 >> 2, p = i16 & 3, blk = (lane >> 4) & 1;
    const int dkt = wid & 1, dvp = wid >> 1;
    const unsigned kaddr = (unsigned)(size_t)smem + (unsigned)((8 * h5 + q4) * 128 + dkt * 64 + 32 * blk + 8 * p);
    const unsigned vaddr = (unsigned)(size_t)smem + 8192u + (unsigned)((8 * h5 + q4) * 256 + dvp * 128 + 32 * blk + 8 * p);
    f32x16 a0, a1;
#pragma unroll
    for (int i = 0; i < 16; ++i) { a0[i] = 0.f; a1[i] = 0.f; }
#pragma unroll
    for (int st = 0; st < 4; ++st) {
        s16x4 kl, kh, v0l, v0h, v1l, v1h;
        const unsigned ka = kaddr + st * 2048, va = vaddr + st * 4096;
        asm volatile("ds_read_b64_tr_b16 %0, %6\n\t"
                     "ds_read_b64_tr_b16 %1, %6 offset:512\n\t"
                     "ds_read_b64_tr_b16 %2, %7\n\t"
                     "ds_read_b64_tr_b16 %3, %7 offset:1024\n\t"
                     "ds_read_b64_tr_b16 %4, %7 offset:64\n\t"
                     "ds_read_b64_tr_b16 %5, %7 offset:1088\n\t"
                     "s_waitcnt lgkmcnt(0)"
                     : "=&v"(kl), "=&v"(kh), "=&v"(v0l), "=&v"(v0h), "=&v"(v1l), "=&v"(v1h) : "v"(ka), "v"(va) : "memory");
        const bf16x8 kf = __builtin_shufflevector(kl, kh, 0, 1, 2, 3, 4, 5, 6, 7);
        const bf16x8 vf0 = __builtin_shufflevector(v0l, v0h, 0, 1, 2, 3, 4, 5, 6, 7), vf1 = __builtin_shufflevector(v1l, v1h, 0, 1, 2, 3, 4, 5, 6, 7);
        a0 = MFMA32(kf, vf0, a0); a1 = MFMA32(kf, vf1, a1);
    }
    float* DC = (float*)(YB + MLC_DC) + (size_t)u * 8192;
#pragma unroll
    for (int i = 0; i < 16; ++i) {
        const int dk = dkt * 32 + (i & 3) + 8 * (i >> 2) + 4 * h5;
        DC[dk * 128 + dvp * 64 + r] = a0[i]; DC[dk * 128 + dvp * 64 + 32 + r] = a1[i];
    }
    if (c.tid < 64) {
        float s = 0.f;
#pragma unroll 8
        for (int t = 0; t < 64; ++t) s += bf2f(((const bf16_t*)smem)[t * 64 + c.tid]);
        ((float*)(YB + MLC_DN))[(size_t)u * 64 + c.tid] = s;
    }
}

__device__ __forceinline__ void mlc_passB(int u, unsigned char* YB, const Ctx& c) {
    const int bh = u >> 3, sl = u & 7;
    const float* ML = (const float*)(YB + MLC_ML) + bh * 32; const float* BE = (const float*)(YB + MLC_BE) + bh * 32;
    const float* DC = (const float*)(YB + MLC_DC) + (size_t)bh * 32 * 8192 + sl * 1024 + c.tid * 4;
    bf16_t* CS = (bf16_t*)(YB + MLC_CS) + (size_t)bh * 32 * 8192 + sl * 1024 + c.tid * 4;
    const float* DN = (const float*)(YB + MLC_DN) + (size_t)bh * 32 * 64; float* NS = (float*)(YB + MLC_NS) + (size_t)bh * 32 * 64; float* MS = (float*)(YB + MLC_MS) + bh * 32;
    f32x4 C4 = (f32x4){0.f, 0.f, 0.f, 0.f}; float nv = 0.f, m = 0.f;
    const bool do_n = (sl == 0) && (c.tid < 64);
#pragma unroll 4
    for (int n = 0; n < 32; ++n) {
        *(u32x2*)(CS + (size_t)n * 8192) = (u32x2){pk2(C4[0], C4[1]), pk2(C4[2], C4[3])};
        if (do_n) NS[n * 64 + c.tid] = nv;
        if (sl == 0 && c.tid == 0) MS[n] = m;
        const float be = BE[n], ml = ML[n];
        const float mn = fmaxf(be + m, ml), keep = expf(be + m - mn), g = expf(ml - mn);
        m = mn;
        const f32x4 d = *(const f32x4*)(DC + (size_t)n * 8192);
        C4 = C4 * keep + d * g;
        if (do_n) nv = nv * keep + DN[n * 64 + c.tid] * g;
    }
}

__device__ __forceinline__ void mlc_passC(int u, const bf16_t* PROJ, const float* GATES, const float* b_i, const float* b_f, const unsigned char* YB,
                                          const float* gain  , bf16_t* MIXO, const Ctx& c) {
    const int bh = u >> 5, b = bh >> 2, h = bh & 3;
    const size_t t0 = (size_t)b * SEQ + (u & 31) * 64;
    unsigned char* smem = c.smem;
    float* csL = (float*)(smem + 32768); float* pmL = (float*)(smem + 33024); float* bcL = (float*)(smem + 33280); float* nnL = (float*)(smem + 33536); float* sqL = (float*)(smem + 33792);
    const int lane = c.lane, wid = __builtin_amdgcn_readfirstlane(c.wid);
    const bf16_t* CS = (const bf16_t*)(YB + MLC_CS) + (size_t)u * 8192;
#pragma unroll
    for (int i = 0; i < 4; ++i) { const int j = wid * 4 + i;
        glds16(PROJ + (t0 + 4 * j + (lane >> 4)) * NPAD + 512 + h * 128 + (lane & 15) * 8, smem + j * 1024 + lane * 16);
        glds16(CS + (4 * j + (lane >> 4)) * 128 + (lane & 15) * 8, smem + 16384 + j * 1024 + lane * 16); }
    float bcl = 0.f;
    if (wid == 0) {
        const float ip = GATES[(t0 + lane) * 8 + h] + b_i[h], lf = -softplusf_(-(GATES[(t0 + lane) * 8 + 4 + h] + b_f[h]));
        bcl = scan_add64(lf, lane);
        const float cs = ip - bcl;
        csL[lane] = cs; pmL[lane] = scan_max64(cs, lane);
        nnL[lane] = ((const float*)(YB + MLC_NS))[(size_t)u * 64 + lane];
        bcL[lane] = bcl;
    }
    asm volatile("s_waitcnt vmcnt(0)" ::: "memory");
    __syncthreads();
    const int h5 = lane >> 5, r = lane & 31, i16 = lane & 15, q4 = i16 >> 2, p = i16 & 3, blk = (lane >> 4) & 1;
    const int th = wid & 1, dvh = wid >> 1;
    const int t = th * 32 + r;
    const float m_n = ((const float*)(YB + MLC_MS))[u];
    const float Mt = fmaxf(m_n, pmL[t]), w_inter = __expf(m_n - Mt), em = __expf(-(bcL[t] + Mt));
    bf16x8 qf[4];
#pragma unroll
    for (int ks = 0; ks < 4; ++ks) qf[ks] = *(const bf16x8*)(PROJ + (t0 + t) * NPAD + h * 64 + ks * 16 + h5 * 8);
    float qn = 0.f; bf16x8 qw[4];
#pragma unroll
    for (int ks = 0; ks < 4; ++ks) {
        const u32x4 raw = __builtin_bit_cast(u32x4, qf[ks]); float f[8]; unpack8(raw, f);
#pragma unroll
        for (int j = 0; j < 8; ++j) qn += f[j] * nnL[ks * 16 + h5 * 8 + j];
        qw[ks] = __builtin_bit_cast(bf16x8, (u32x4){pk2(f[0] * w_inter, f[1] * w_inter), pk2(f[2] * w_inter, f[3] * w_inter), pk2(f[4] * w_inter, f[5] * w_inter), pk2(f[6] * w_inter, f[7] * w_inter)});
    }
    qn += shfl_xor_(qn, 32);
    f32x16 x0, x1;
#pragma unroll
    for (int i = 0; i < 16; ++i) { x0[i] = 0.f; x1[i] = 0.f; }
#pragma unroll
    for (int ks = 0; ks < 4; ++ks) {
        const bf16x8 kf0 = *(const bf16x8*)(PROJ + (t0 + r) * NPAD + 256 + h * 64 + ks * 16 + h5 * 8);
        x0 = MFMA32(kf0, qf[ks], x0);
        if (th) { const bf16x8 kf1 = *(const bf16x8*)(PROJ + (t0 + 32 + r) * NPAD + 256 + h * 64 + ks * 16 + h5 * 8); x1 = MFMA32(kf1, qf[ks], x1); }
    }
    float ps = 0.f;
#pragma unroll
    for (int i = 0; i < 16; ++i) {
        const int s = (i & 3) + 8 * (i >> 2) + 4 * h5;
        const float w0 = (s <= t) ? __expf(csL[s] - Mt) * 0.125f : 0.f;
        x0[i] *= w0; ps += x0[i];
        if (th) { const float w1 = (s <= r) ? __expf(csL[32 + s] - Mt) * 0.125f : 0.f; x1[i] *= w1; ps += x1[i]; }
    }
    ps += shfl_xor_(ps, 32);
    const float den = w_inter * qn + ps;
    f32x16 o0, o1;
#pragma unroll
    for (int i = 0; i < 16; ++i) { o0[i] = 0.f; o1[i] = 0.f; }
    {
        const unsigned vb = (unsigned)(size_t)smem + (unsigned)((4 * h5 + q4) * 256 + dvh * 128 + 32 * blk + 8 * p);
#pragma unroll
        for (int st = 0; st < 2; ++st) {
            if (st == 0 || th) {
                s16x4 l00, h00, l01, h01, l10, h10, l11, h11;
                const unsigned va = vb + st * 8192;
                asm volatile("ds_read_b64_tr_b16 %0, %8\n\t"
                             "ds_read_b64_tr_b16 %1, %8 offset:2048\n\t"
                             "ds_read_b64_tr_b16 %2, %8 offset:64\n\t"
                             "ds_read_b64_tr_b16 %3, %8 offset:2112\n\t"
                             "ds_read_b64_tr_b16 %4, %8 offset:4096\n\t"
                             "ds_read_b64_tr_b16 %5, %8 offset:6144\n\t"
                             "ds_read_b64_tr_b16 %6, %8 offset:4160\n\t"
                             "ds_read_b64_tr_b16 %7, %8 offset:6208\n\t"
                             "s_waitcnt lgkmcnt(0)"
                             : "=&v"(l00), "=&v"(h00), "=&v"(l01), "=&v"(h01), "=&v"(l10), "=&v"(h10), "=&v"(l11), "=&v"(h11) : "v"(va) : "memory");
                const bf16x8 v00 = __builtin_shufflevector(l00, h00, 0, 1, 2, 3, 4, 5, 6, 7), v01 = __builtin_shufflevector(l01, h01, 0, 1, 2, 3, 4, 5, 6, 7);
                const bf16x8 v10 = __builtin_shufflevector(l10, h10, 0, 1, 2, 3, 4, 5, 6, 7), v11 = __builtin_shufflevector(l11, h11, 0, 1, 2, 3, 4, 5, 6, 7);
                const bf16x8 pb0 = (st == 0) ? pack_step<0>(x0) : pack_step<0>(x1);
                const bf16x8 pb1 = (st == 0) ? pack_step<1>(x0) : pack_step<1>(x1);
                o0 = MFMA32(v00, pb0, o0); o1 = MFMA32(v01, pb0, o1);
                o0 = MFMA32(v10, pb1, o0); o1 = MFMA32(v11, pb1, o1);
            }
        }
    }
    {
        const unsigned cb = (unsigned)(size_t)smem + 16384u + (unsigned)((8 * h5 + q4) * 256 + dvh * 128 + 32 * blk + 8 * p);
#pragma unroll
        for (int kp = 0; kp < 2; ++kp) {
            s16x4 l00, h00, l01, h01, l10, h10, l11, h11;
            const unsigned ca = cb + kp * 8192;
            asm volatile("ds_read_b64_tr_b16 %0, %8\n\t"
                         "ds_read_b64_tr_b16 %1, %8 offset:1024\n\t"
                         "ds_read_b64_tr_b16 %2, %8 offset:64\n\t"
                         "ds_read_b64_tr_b16 %3, %8 offset:1088\n\t"
                         "ds_read_b64_tr_b16 %4, %8 offset:4096\n\t"
                         "ds_read_b64_tr_b16 %5, %8 offset:5120\n\t"
                         "ds_read_b64_tr_b16 %6, %8 offset:4160\n\t"
                         "ds_read_b64_tr_b16 %7, %8 offset:5184\n\t"
                         "s_waitcnt lgkmcnt(0)"
                         : "=&v"(l00), "=&v"(h00), "=&v"(l01), "=&v"(h01), "=&v"(l10), "=&v"(h10), "=&v"(l11), "=&v"(h11) : "v"(ca) : "memory");
            const bf16x8 c00 = __builtin_shufflevector(l00, h00, 0, 1, 2, 3, 4, 5, 6, 7), c01 = __builtin_shufflevector(l01, h01, 0, 1, 2, 3, 4, 5, 6, 7);
            const bf16x8 c10 = __builtin_shufflevector(l10, h10, 0, 1, 2, 3, 4, 5, 6, 7), c11 = __builtin_shufflevector(l11, h11, 0, 1, 2, 3, 4, 5, 6, 7);
            o0 = MFMA32(c00, qw[2 * kp], o0); o1 = MFMA32(c01, qw[2 * kp], o1);
            o0 = MFMA32(c10, qw[2 * kp + 1], o0); o1 = MFMA32(c11, qw[2 * kp + 1], o1);
        }
    }
    const float inv = __builtin_amdgcn_rcpf(fmaxf(fabsf(den), em));
    float ss = 0.f;
#pragma unroll
    for (int i = 0; i < 16; ++i) { o0[i] *= inv; o1[i] *= inv; ss += o0[i] * o0[i] + o1[i] * o1[i]; }
    ss += shfl_xor_(ss, 32);
    if (h5 == 0) sqL[wid * 32 + r] = ss;
    __syncthreads();
    const float rr = rsqrtf((sqL[th * 32 + r] + sqL[(th + 2) * 32 + r]) * (1.f / 128.f) + 1e-6f);
    const bf16_t* grow = PROJ + (t0 + t) * NPAD + 1032 + h * 128 + dvh * 64 + 4 * h5;
    const float* gn = gain + h * 128 + dvh * 64 + 4 * h5;
    bf16_t* orow = MIXO + (t0 + t) * 1024 + h * 128 + dvh * 64 + 4 * h5;
#pragma unroll
    for (int d = 0; d < 2; ++d)
#pragma unroll
        for (int g = 0; g < 4; ++g) {
            const u32x2 zr = *(const u32x2*)(grow + d * 32 + 8 * g);
            const f32x4 gv = *(const f32x4*)(gn + d * 32 + 8 * g);
            const float z0 = bflo(zr.x), z1 = bfhi(zr.x), z2 = bflo(zr.y), z3 = bfhi(zr.y);
            const float y0 = (d ? o1[4 * g] : o0[4 * g]) * rr * gv[0] * sigmoidf_(z0), y1 = (d ? o1[4 * g + 1] : o0[4 * g + 1]) * rr * gv[1] * sigmoidf_(z1);
            const float y2 = (d ? o1[4 * g + 2] : o0[4 * g + 2]) * rr * gv[2] * sigmoidf_(z2), y3 = (d ? o1[4 * g + 3] : o0[4 * g + 3]) * rr * gv[3] * sigmoidf_(z3);
            *(u32x2*)(orow + d * 32 + 8 * g) = (u32x2){pk2(y0, y1), pk2(y2, y3)};
        }
}

constexpr size_t GD_WN = 0, GD_UU = GD_WN + (size_t)1024 * 16384, GD_KGT = GD_UU + (size_t)1024 * 16384, GD_QG = GD_KGT + (size_t)1024 * 16384,
                 GD_AT = GD_QG + (size_t)1024 * 16384, GD_GL = GD_AT + (size_t)1024 * 8192, GD_END = GD_GL + 4096;
static_assert(GD_END <= (size_t)MAXROWS * 256 * 2, "GDN chunk records must fit the HBUF region");

__device__ __forceinline__ void gdc_passA(int u, const bf16_t* GQ, const bf16_t* GK, const bf16_t* GV, const float* BETA, const float* GLOG, unsigned char* HB, const Ctx& c) {
    const int bh = u >> 5, b = bh >> 2, h = bh & 3;
    const size_t t0 = (size_t)b * SEQ + (u & 31) * 64;
    unsigned char* smem = c.smem;
    float* Lm = (float*)(smem + 49152);
    float* GA = (float*)(smem + 65536 + 64); float* BT = GA + 64; float* EG = BT + 64; float* EK = EG + 64;
    const int lane = c.lane, wid = __builtin_amdgcn_readfirstlane(c.wid);
    const int h5 = lane >> 5, r = lane & 31;
    if (wid == 0) {
        const float g = GLOG[(t0 + lane) * 4 + h];
        const float G = scan_add64(g, lane), Gl = shfl_c_(G, 63);
        GA[lane] = G; BT[lane] = BETA[(t0 + lane) * 4 + h]; EG[lane] = expf(G); EK[lane] = expf(Gl - G);
        if (lane == 0) ((float*)(HB + GD_GL))[u] = expf(Gl);
    }
    __syncthreads();
    if (wid < 3) {
        const int it = (wid + 1) >> 1, jt = wid >> 1;
        f32x16 dl, da;
#pragma unroll
        for (int i = 0; i < 16; ++i) { dl[i] = 0.f; da[i] = 0.f; }
#pragma unroll
        for (int ks = 0; ks < 8; ++ks) {
            const bf16x8 ki = *(const bf16x8*)(GK + (t0 + 32 * it + r) * 512 + h * 128 + ks * 16 + h5 * 8);
            const bf16x8 kj = *(const bf16x8*)(GK + (t0 + 32 * jt + r) * 512 + h * 128 + ks * 16 + h5 * 8);
            const bf16x8 qi = *(const bf16x8*)(GQ + (t0 + 32 * it + r) * 512 + h * 128 + ks * 16 + h5 * 8);
            dl = MFMA32(ki, kj, dl); da = MFMA32(qi, kj, da);
        }
        const int j = 32 * jt + r; const float Gj = GA[j];
        bf16_t* AT = (bf16_t*)(HB + GD_AT) + (size_t)u * 4096;
#pragma unroll
        for (int i = 0; i < 16; ++i) {
            const int ii = 32 * it + (i & 3) + 8 * (i >> 2) + 4 * h5;
            const float dec = __expf(GA[ii] - Gj);
            Lm[ii * 64 + j] = (j < ii) ? dl[i] * BT[ii] * dec : 0.f;
            AT[ii * 64 + j] = (bf16_t)f2bf((j <= ii) ? da[i] * dec : 0.f);
        }
        if (wid == 0) {
#pragma unroll
            for (int i = 0; i < 16; ++i) { const int ii = (i & 3) + 8 * (i >> 2) + 4 * h5; Lm[ii * 64 + 32 + r] = 0.f; AT[ii * 64 + 32 + r] = 0; }
        }
    }
    __syncthreads();
    if (wid == 0) {
        float Tc[64];
#pragma unroll
        for (int i = 0; i < 64; ++i) {
            float s = (i == lane) ? 1.f : 0.f;
#pragma unroll
            for (int k = 0; k < i; ++k) s -= Lm[i * 64 + k] * Tc[k];
            Tc[i] = s;
        }
        bf16_t* Tm = (bf16_t*)Lm;
#pragma unroll
        for (int i = 0; i < 64; ++i) Tm[i * 64 + lane] = (bf16_t)f2bf(Tc[i]);
    } else {
        const int t3 = c.tid - 64;
        for (int idx = t3; idx < 4096; idx += 192) {
            const int arr = idx >> 10, rem = idx & 1023, row = rem >> 4, chk = rem & 15;
            const bf16_t* sp = ((arr == 1) ? GV : (arr == 3) ? GQ : GK) + (t0 + row) * 512 + h * 128 + chk * 8;
            const u32x4 raw = *(const u32x4*)sp; float f[8]; unpack8(raw, f);
            const float sc = (arr == 0) ? BT[row] * EG[row] : (arr == 1) ? BT[row] : (arr == 2) ? EK[row] : EG[row];
            const u32x4 o = (u32x4){pk2(f[0] * sc, f[1] * sc), pk2(f[2] * sc, f[3] * sc), pk2(f[4] * sc, f[5] * sc), pk2(f[6] * sc, f[7] * sc)};
            if (arr < 3) *(u32x4*)(smem + arr * 16384 + row * 256 + chk * 16) = o;
            else *(u32x4*)((bf16_t*)(HB + GD_QG) + (size_t)u * 8192 + row * 128 + chk * 8) = o;
        }
    }
    __syncthreads();
    {
        const int i16 = lane & 15, q4 = i16 >> 2, p = i16 & 3, blk = (lane >> 4) & 1;
        const unsigned char* Tm = smem + 49152;
        f32x16 u0, u1, w0, w1;
#pragma unroll
        for (int i = 0; i < 16; ++i) { u0[i] = 0.f; u1[i] = 0.f; w0[i] = 0.f; w1[i] = 0.f; }
        const unsigned ib = (unsigned)(size_t)smem + (unsigned)((8 * h5 + q4) * 256 + wid * 64 + 32 * blk + 8 * p);
#pragma unroll
        for (int ks = 0; ks < 4; ++ks) {
            s16x4 kl, kh, vl, vh;
            const unsigned ia = ib + ks * 4096;
            asm volatile("ds_read_b64_tr_b16 %0, %4\n\t"
                         "ds_read_b64_tr_b16 %1, %4 offset:1024\n\t"
                         "ds_read_b64_tr_b16 %2, %4 offset:16384\n\t"
                         "ds_read_b64_tr_b16 %3, %4 offset:17408\n\t"
                         "s_waitcnt lgkmcnt(0)"
                         : "=&v"(kl), "=&v"(kh), "=&v"(vl), "=&v"(vh) : "v"(ia) : "memory");
            const bf16x8 kb = __builtin_shufflevector(kl, kh, 0, 1, 2, 3, 4, 5, 6, 7), vb = __builtin_shufflevector(vl, vh, 0, 1, 2, 3, 4, 5, 6, 7);
            const bf16x8 t1 = *(const bf16x8*)(Tm + (32 + r) * 128 + ks * 32 + h5 * 16);
            w1 = MFMA32(t1, kb, w1); u1 = MFMA32(t1, vb, u1);
            if (ks < 2) { const bf16x8 tt0 = *(const bf16x8*)(Tm + r * 128 + ks * 32 + h5 * 16); w0 = MFMA32(tt0, kb, w0); u0 = MFMA32(tt0, vb, u0); }
        }
        bf16_t* WN = (bf16_t*)(HB + GD_WN) + (size_t)u * 8192; bf16_t* UU = (bf16_t*)(HB + GD_UU) + (size_t)u * 8192;
#pragma unroll
        for (int i = 0; i < 16; ++i) {
            const int s = (i & 3) + 8 * (i >> 2) + 4 * h5;
            WN[s * 128 + wid * 32 + r] = (bf16_t)f2bf(-w0[i]); WN[(32 + s) * 128 + wid * 32 + r] = (bf16_t)f2bf(-w1[i]);
        }
        {
            u32x4* up = (u32x4*)(UU + (size_t)(wid * 64 + lane) * 32);
            up[0] = (u32x4){pk2(u0[0], u0[1]), pk2(u0[2], u0[3]), pk2(u0[4], u0[5]), pk2(u0[6], u0[7])};
            up[1] = (u32x4){pk2(u0[8], u0[9]), pk2(u0[10], u0[11]), pk2(u0[12], u0[13]), pk2(u0[14], u0[15])};
            up[2] = (u32x4){pk2(u1[0], u1[1]), pk2(u1[2], u1[3]), pk2(u1[4], u1[5]), pk2(u1[6], u1[7])};
            up[3] = (u32x4){pk2(u1[8], u1[9]), pk2(u1[10], u1[11]), pk2(u1[12], u1[13]), pk2(u1[14], u1[15])};
        }
        bf16_t* KGT = (bf16_t*)(HB + GD_KGT) + (size_t)u * 8192;
        const int gq = lane >> 4;
        const unsigned kb0 = (unsigned)(size_t)smem + 32768u + (unsigned)(q4 * 256 + gq * 32 + 8 * p);
#pragma unroll
        for (int it2 = 0; it2 < 8; ++it2) {
            const int job = wid * 8 + it2, s0 = (job & 15) * 4, dkb = (job >> 4) * 64;
            s16x4 v;
            const unsigned ad = kb0 + s0 * 256 + dkb * 2;
            asm volatile("ds_read_b64_tr_b16 %0, %1\n\ts_waitcnt lgkmcnt(0)" : "=&v"(v) : "v"(ad) : "memory");
            *(s16x4*)(KGT + (size_t)(dkb + gq * 16 + i16) * 64 + s0) = v;
        }
    }
}

constexpr size_t GC_ST = 0, GC_VT = (size_t)1024 * 32768;
__device__ __forceinline__ void gdc_passB(int bh, const unsigned char* HB, unsigned char* YB, const Ctx& c) {
    const int lane = c.lane, wid = __builtin_amdgcn_readfirstlane(c.wid);
    const int h5 = lane >> 5, r = lane & 31;
    unsigned char* smem = c.smem;
    f32x16 S0, S1, S2, S3;
#pragma unroll
    for (int i = 0; i < 16; ++i) { S0[i] = 0.f; S1[i] = 0.f; S2[i] = 0.f; S3[i] = 0.f; }
    const size_t u0 = (size_t)bh * 32;
#define GB_STAGE(n_, p_) do { const bf16_t* wn_ = (const bf16_t*)(HB + GD_WN) + (u0 + (n_)) * 8192; const bf16_t* kg_ = (const bf16_t*)(HB + GD_KGT) + (u0 + (n_)) * 8192; \
        unsigned char* bp_ = smem + (p_) * 32768; \
        _Pragma("unroll") for (int i = 0; i < 4; ++i) { const int jj = wid * 4 + i, row = 4 * jj + (lane >> 4), ch = (lane & 15) ^ (row & 15); \
            glds16(wn_ + row * 128 + ch * 8, bp_ + jj * 1024 + lane * 16); } \
        _Pragma("unroll") for (int i = 0; i < 4; ++i) { const int jj = wid * 4 + i, row = 8 * jj + (lane >> 3), ch = (lane & 7) ^ ((row >> 1) & 7); \
            glds16(kg_ + row * 64 + ch * 8, bp_ + 16384 + jj * 1024 + lane * 16); } } while (0)
#define LD128(base_, R_, ks_) __builtin_shufflevector(*(const s16x4*)((base_) + (R_) * 256 + (((2 * (ks_)) ^ (rl & 15)) << 4) + 8 * hl), \
                                                      *(const s16x4*)((base_) + (R_) * 256 + (((2 * (ks_) + 1) ^ (rl & 15)) << 4) + 8 * hl), 0, 1, 2, 3, 4, 5, 6, 7)
#define LD64(base_, R_, k2_) __builtin_shufflevector(*(const s16x4*)((base_) + (R_) * 128 + (((2 * (k2_)) ^ ((rl >> 1) & 7)) << 4) + 8 * hl), \
                                                     *(const s16x4*)((base_) + (R_) * 128 + (((2 * (k2_) + 1) ^ ((rl >> 1) & 7)) << 4) + 8 * hl), 0, 1, 2, 3, 4, 5, 6, 7)
    u32x4 uu[4];
#define GB_LOADU(n_) do { const u32x4* up_ = (const u32x4*)((const bf16_t*)(HB + GD_UU) + (u0 + (n_)) * 8192 + (size_t)(wid * 64 + lane) * 32); \
        uu[0] = up_[0]; uu[1] = up_[1]; uu[2] = up_[2]; uu[3] = up_[3]; } while (0)
    __syncthreads();
    GB_STAGE(0, 0);
    GB_LOADU(0);
#pragma unroll 1
    for (int n2 = 0; n2 < 16; ++n2) {
#pragma unroll
        for (int PBUF = 0; PBUF < 2; ++PBUF) {
        const int n = 2 * n2 + PBUF;
        const float gl = ((const float*)(HB + GD_GL))[u0 + n];
        if (n == 0) asm volatile("s_waitcnt vmcnt(0)" ::: "memory"); else asm volatile("s_waitcnt vmcnt(24)" ::: "memory");
        asm volatile("s_waitcnt lgkmcnt(0)" ::: "memory"); __builtin_amdgcn_s_barrier(); asm volatile("" ::: "memory");
        f32x16 v0, v1;
#pragma unroll
        for (int q = 0; q < 2; ++q) {
            const u32x4 a = uu[q], bq = uu[2 + q];
            v0[8 * q + 0] = bflo(a.x); v0[8 * q + 1] = bfhi(a.x); v0[8 * q + 2] = bflo(a.y); v0[8 * q + 3] = bfhi(a.y);
            v0[8 * q + 4] = bflo(a.z); v0[8 * q + 5] = bfhi(a.z); v0[8 * q + 6] = bflo(a.w); v0[8 * q + 7] = bfhi(a.w);
            v1[8 * q + 0] = bflo(bq.x); v1[8 * q + 1] = bfhi(bq.x); v1[8 * q + 2] = bflo(bq.y); v1[8 * q + 3] = bfhi(bq.y);
            v1[8 * q + 4] = bflo(bq.z); v1[8 * q + 5] = bfhi(bq.z); v1[8 * q + 6] = bflo(bq.w); v1[8 * q + 7] = bfhi(bq.w);
        }
        if (n + 1 < 32) { GB_STAGE(n + 1, (PBUF ^ 1)); GB_LOADU(n + 1); }
        int rl = r, hl = h5; asm volatile("" : "+v"(rl), "+v"(hl));
        const unsigned char* WNb = smem + PBUF * 32768; const unsigned char* KGb = WNb + 16384;
        {
            bf16_t* st = (bf16_t*)(YB + GC_ST) + (u0 + n) * 16384 + (size_t)h5 * 512 + (size_t)(wid * 32 + r) * 4;
#define ST_TILE(SX, dt_) do { _Pragma("unroll") for (int g = 0; g < 4; ++g) \
                *(u32x2*)(st + ((dt_) * 8 + 2 * g) * 512) = (u32x2){cvt_pk(SX[4 * g], SX[4 * g + 1]), cvt_pk(SX[4 * g + 2], SX[4 * g + 3])}; } while (0)
            ST_TILE(S0, 0); ST_TILE(S1, 1); ST_TILE(S2, 2); ST_TILE(S3, 3);
#undef ST_TILE
        }
        {
            bf16x8 fa0, fb0, fa1, fb1, fa2, fb2;
#define LDV(FA, FB, ks_) do { FA = LD128(WNb, rl, ks_); FB = LD128(WNb, 32 + rl, ks_); } while (0)
#define MMV(SX, HF, FA, FB) do { const bf16x8 sbk = pack_step<HF>(SX); v0 = MFMA32(FA, sbk, v0); v1 = MFMA32(FB, sbk, v1); } while (0)
            LDV(fa0, fb0, 0); LDV(fa1, fb1, 1); LDV(fa2, fb2, 2);
            MMV(S0, 0, fa0, fb0); LDV(fa0, fb0, 3);
            MMV(S0, 1, fa1, fb1); LDV(fa1, fb1, 4);
            MMV(S1, 0, fa2, fb2); LDV(fa2, fb2, 5);
            MMV(S1, 1, fa0, fb0); LDV(fa0, fb0, 6);
            MMV(S2, 0, fa1, fb1); LDV(fa1, fb1, 7);
            MMV(S2, 1, fa2, fb2);
            MMV(S3, 0, fa0, fb0);
            MMV(S3, 1, fa1, fb1);
#undef LDV
#undef MMV
        }
        const bf16x8 vb0 = pack_step_m<0>(v0), vb1 = pack_step_m<1>(v0), vb2 = pack_step_m<0>(v1), vb3 = pack_step_m<1>(v1);
        {
            bf16_t* vt = (bf16_t*)(YB + GC_VT) + (u0 + n) * 8192 + (size_t)h5 * 512 + (size_t)(wid * 32 + r) * 4;
            const u32x4 p0 = __builtin_bit_cast(u32x4, vb0), p1 = __builtin_bit_cast(u32x4, vb1), p2 = __builtin_bit_cast(u32x4, vb2), p3 = __builtin_bit_cast(u32x4, vb3);
            *(u32x2*)(vt + 0 * 512) = (u32x2){p0.x, p0.y};  *(u32x2*)(vt + 2 * 512) = (u32x2){p0.z, p0.w};
            *(u32x2*)(vt + 4 * 512) = (u32x2){p1.x, p1.y};  *(u32x2*)(vt + 6 * 512) = (u32x2){p1.z, p1.w};
            *(u32x2*)(vt + 8 * 512) = (u32x2){p2.x, p2.y};  *(u32x2*)(vt + 10 * 512) = (u32x2){p2.z, p2.w};
            *(u32x2*)(vt + 12 * 512) = (u32x2){p3.x, p3.y}; *(u32x2*)(vt + 14 * 512) = (u32x2){p3.z, p3.w};
        }
        asm volatile("" ::: "memory"); asm volatile("" : "+v"(rl), "+v"(hl));
        S0 *= gl; S1 *= gl; S2 *= gl; S3 *= gl;
        {
            bf16x8 g0, g1, g2;
            g0 = LD64(KGb, rl, 0); g1 = LD64(KGb, rl, 1); g2 = LD64(KGb, rl, 2);
            S0 = MFMA32(g0, vb0, S0); g0 = LD64(KGb, rl, 3);
            S0 = MFMA32(g1, vb1, S0); g1 = LD64(KGb, 32 + rl, 0);
            S0 = MFMA32(g2, vb2, S0); g2 = LD64(KGb, 32 + rl, 1);
            S0 = MFMA32(g0, vb3, S0); g0 = LD64(KGb, 32 + rl, 2);
            S1 = MFMA32(g1, vb0, S1); g1 = LD64(KGb, 32 + rl, 3);
            S1 = MFMA32(g2, vb1, S1); g2 = LD64(KGb, 64 + rl, 0);
            S1 = MFMA32(g0, vb2, S1); g0 = LD64(KGb, 64 + rl, 1);
            S1 = MFMA32(g1, vb3, S1); g1 = LD64(KGb, 64 + rl, 2);
            S2 = MFMA32(g2, vb0, S2); g2 = LD64(KGb, 64 + rl, 3);
            S2 = MFMA32(g0, vb1, S2); g0 = LD64(KGb, 96 + rl, 0);
            S2 = MFMA32(g1, vb2, S2); g1 = LD64(KGb, 96 + rl, 1);
            S2 = MFMA32(g2, vb3, S2); g2 = LD64(KGb, 96 + rl, 2);
            S3 = MFMA32(g0, vb0, S3); g0 = LD64(KGb, 96 + rl, 3);
            S3 = MFMA32(g1, vb1, S3);
            S3 = MFMA32(g2, vb2, S3);
            S3 = MFMA32(g0, vb3, S3);
        }
        }
    }
#undef GB_STAGE
#undef LD128
#undef LD64
#undef GB_LOADU
}

__device__ __forceinline__ void gdc_passB_idle() {
    __syncthreads();
    for (int n = 0; n < 32; ++n) { asm volatile("" ::: "memory"); __builtin_amdgcn_s_barrier(); asm volatile("" ::: "memory"); }
}

__device__ __forceinline__ void gdc_passC(int u, const unsigned char* HB, const unsigned char* YB, const bf16_t* PROJ, const float* gnorm, bf16_t* MIXO, const Ctx& c) {
    const int bh = u >> 5, b = bh >> 2, h = bh & 3;
    const size_t t0 = (size_t)b * SEQ + (u & 31) * 64;
    const int lane = c.lane, wid = __builtin_amdgcn_readfirstlane(c.wid);
    const int h5 = lane >> 5, r = lane & 31;
    float* sqL = (float*)c.smem;
    const bf16_t* ST = (const bf16_t*)(YB + GC_ST) + (size_t)u * 16384 + (size_t)(2 * h5) * 512 + (size_t)(wid * 32 + r) * 4;
    const bf16_t* VT = (const bf16_t*)(YB + GC_VT) + (size_t)u * 8192 + (size_t)(2 * h5) * 512 + (size_t)(wid * 32 + r) * 4;
    const bf16_t* QG = (const bf16_t*)(HB + GD_QG) + (size_t)u * 8192 + (size_t)r * 128 + 8 * h5;
    const bf16_t* AT = (const bf16_t*)(HB + GD_AT) + (size_t)u * 4096 + (size_t)r * 64 + 8 * h5;
    f32x16 o0, o1;
#pragma unroll
    for (int i = 0; i < 16; ++i) { o0[i] = 0.f; o1[i] = 0.f; }
#pragma unroll
    for (int ks = 0; ks < 8; ++ks) {
        const bf16x8 sa = __builtin_shufflevector(*(const s16x4*)(ST + (4 * ks) * 512), *(const s16x4*)(ST + (4 * ks + 1) * 512), 0, 1, 2, 3, 4, 5, 6, 7);
        const bf16x8 q0 = *(const bf16x8*)(QG + ks * 16), q1 = *(const bf16x8*)(QG + 32 * 128 + ks * 16);
        o0 = MFMA32(sa, q0, o0); o1 = MFMA32(sa, q1, o1);
        if (ks == 3) asm volatile("" ::: "memory");
    }
#pragma unroll
    for (int k2 = 0; k2 < 4; ++k2) {
        const bf16x8 va = __builtin_shufflevector(*(const s16x4*)(VT + (4 * k2) * 512), *(const s16x4*)(VT + (4 * k2 + 1) * 512), 0, 1, 2, 3, 4, 5, 6, 7);
        const bf16x8 a1 = *(const bf16x8*)(AT + 32 * 64 + k2 * 16);
        o1 = MFMA32(va, a1, o1);
        if (k2 < 2) { const bf16x8 a0 = *(const bf16x8*)(AT + k2 * 16); o0 = MFMA32(va, a0, o0); }
    }
    float s0 = 0.f, s1 = 0.f;
#pragma unroll
    for (int i = 0; i < 16; ++i) { s0 += o0[i] * o0[i]; s1 += o1[i] * o1[i]; }
    s0 += shfl_xor_(s0, 32); s1 += shfl_xor_(s1, 32);
    __syncthreads();
    if (h5 == 0) { sqL[wid * 64 + r] = s0; sqL[wid * 64 + 32 + r] = s1; }
    __syncthreads();
    const float rr0 = rsqrtf((sqL[r] + sqL[64 + r] + sqL[128 + r] + sqL[192 + r]) * (1.f / 128.f) + 1e-6f);
    const float rr1 = rsqrtf((sqL[32 + r] + sqL[96 + r] + sqL[160 + r] + sqL[224 + r]) * (1.f / 128.f) + 1e-6f);
#pragma unroll
    for (int tt = 0; tt < 2; ++tt) {
        const size_t t = t0 + tt * 32 + r;
        const bf16_t* zrow = PROJ + t * NPAD + 1960 + h * 128 + wid * 32 + 4 * h5;
        const float* gn = gnorm + wid * 32 + 4 * h5;
        bf16_t* orow = MIXO + t * 1024 + 512 + h * 128 + wid * 32 + 4 * h5;
        const float rr = tt ? rr1 : rr0;
#pragma unroll
        for (int g = 0; g < 4; ++g) {
            const u32x2 zr = *(const u32x2*)(zrow + 8 * g);
            const f32x4 gv = *(const f32x4*)(gn + 8 * g);
            const float z0 = bflo(zr.x), z1 = bfhi(zr.x), z2 = bflo(zr.y), z3 = bfhi(zr.y);
            const float y0 = (tt ? o1[4 * g] : o0[4 * g]) * rr * gv[0] * siluf_(z0), y1 = (tt ? o1[4 * g + 1] : o0[4 * g + 1]) * rr * gv[1] * siluf_(z1);
            const float y2 = (tt ? o1[4 * g + 2] : o0[4 * g + 2]) * rr * gv[2] * siluf_(z2), y3 = (tt ? o1[4 * g + 3] : o0[4 * g + 3]) * rr * gv[3] * siluf_(z3);
            *(u32x2*)(orow + 8 * g) = (u32x2){pk2(y0, y1), pk2(y2, y3)};
        }
    }
}

__device__ __forceinline__ void phase_post(const float* OG, const bf16_t* PROJ, const float* gain, bool odd, bf16_t* MIXO, const Ctx& c) {
    const int lane = c.lane;
    const int gcol = odd ? 1032 : 1960, ocol = odd ? 0 : 512;
    for (int t = c.bid * 4 + c.wid; t < T; t += c.nblk * 4) {
        const f32x4 a0 = *(const f32x4*)(OG + (size_t)t * 512 + lane * 8), a1 = *(const f32x4*)(OG + (size_t)t * 512 + lane * 8 + 4);
        float ss = (a0[0] * a0[0] + a0[1] * a0[1]) + (a0[2] * a0[2] + a0[3] * a0[3]) + (a1[0] * a1[0] + a1[1] * a1[1]) + (a1[2] * a1[2] + a1[3] * a1[3]);
        ss = red16(ss);
        const float rr = rsqrtf(ss * (1.f / 128.f) + 1e-6f);
        const u32x4 zr = *(const u32x4*)(PROJ + (size_t)t * NPAD + gcol + lane * 8);
        float z[8]; unpack8(zr, z);
        const int gi = odd ? lane * 8 : (lane & 15) * 8;
        const f32x4 g0 = *(const f32x4*)(gain + gi), g1 = *(const f32x4*)(gain + gi + 4);
        float y[8];
#pragma unroll
        for (int j = 0; j < 4; ++j) {
            const float ga = odd ? sigmoidf_(z[j]) : siluf_(z[j]), gb = odd ? sigmoidf_(z[4 + j]) : siluf_(z[4 + j]);
            y[j] = a0[j] * rr * g0[j] * ga; y[4 + j] = a1[j] * rr * g1[j] * gb;
        }
        *(u32x4*)(MIXO + (size_t)t * 1024 + ocol + lane * 8) = (u32x4){pk2(y[0], y[1]), pk2(y[2], y[3]), pk2(y[4], y[5]), pk2(y[6], y[7])};
    }
}

__global__ void __launch_bounds__(512, 2) fwd(Args a) {
    extern __shared__ __attribute__((aligned(16))) unsigned char smem[];
    Ctx c;
    const int wave_s = __builtin_amdgcn_readfirstlane((int)threadIdx.x >> 6);
#define SET_CTX(cx) do { int t_ = (wave_s << 6) | lane_id_v(); cx.tid0 = t_; cx.half = t_ >> 8; cx.tid = t_ & 255; cx.lane = t_ & 63; cx.wid = (t_ >> 6) & 3; \
        cx.wr = cx.wid >> 1; cx.wc = cx.wid & 1; cx.fr = cx.lane & 15; cx.fq = cx.lane >> 4; cx.bid = blockIdx.x * 2 + cx.half; cx.nblk = gridDim.x * 2; \
        cx.smem0 = smem; cx.smem = smem + cx.half * HALF_LDS; } while (0)
    SET_CTX(c);
#define PH_CTX() SET_CTX(c)
    unsigned char* const ws_base = a.ws;
    const void* const* const ain_base = (const void* const*)__builtin_amdgcn_kernarg_segment_ptr();
    unsigned* ctl = (unsigned*)(ws_base + WS_CTL);
    volatile LAS unsigned* xbw = (volatile LAS unsigned*)(smem + LDS_BLK);
    if (c.tid0 < 8) xbw[c.tid0] = 0u;
    __syncthreads();
    XcdBarrier bar; bar.bar = ctl; bar.x = 0; bar.st = xbw; bar.wave = wave_s;
    if (a.use_bar) bar = xcd_barrier_post(ctl, xbw, c.tid0);
#if ONE_LAUNCH
    const int hi = NPH;
#define IN(k) true
#else
    const int lo = a.ph_lo, hi = a.ph_hi;
#define IN(k) (lo <= (k) && (k) < hi)
#endif
#define PH(k) if (IN(k)) { PH_CTX(); unsigned char* ws = ws_base; const void* const* ain = ain_base; asm volatile("" : "+s"(ws), "+s"(ain));
#define UNIT_CTX() Ctx cu; SET_CTX(cu)
#define SEAM(k) do { if ((k) + 1 < hi) xcd_barrier(bar); } while (0)

#define XBF ((bf16_t*)(ws + WS_XBF))
#define X1 ((float*)(ws + WS_X1))
#define PROJ ((bf16_t*)(ws + U_PROJ))
#define GATES ((float*)(ws + U_GATES))
#define MIXO ((bf16_t*)(ws + U_MIXO))
#define YBUF ((float*)(ws + U_YBUF))
#define ROPEM ((const float*)(ws + WS_ROPEM))
#define ROPES ((const float*)(ws + WS_ROPES))
#define XRES ((layer == 0) ? (const float*)ain[0] : (const float*)a.out)
#define CNT (ctl + CW_CNT + layer * 128)
#define WIN ((const bf16_t*)(ws + WS_WIN) + (size_t)layer * WIN_ELEMS)
#define WOUT ((const bf16_t*)(ws + WS_WOUT) + (size_t)layer * WOUT_ELEMS)

    PH(0) for (int rep = 0; rep < REP_PRO; ++rep) phase_prologue(a, c); SEAM(0); }

    for (int layer = 0; layer < 4; ++layer) {
        const int pb = 1 + layer * PPL;
#if !ONE_LAUNCH
        if (pb >= hi || pb + PPL <= lo) continue;
#endif
        const int jj = layer >> 1;
        const bool odd = (layer & 1) != 0;

        PH(pb + 0) {
                DenseSched S{T / 256, NPAD / 256, 1024, (int)blockIdx.x, (int)gridDim.x};
                EpiIn E{PROJ, GATES, odd ? 1024 : 1952};
                g8::phase<true, false>(smem, (const char*)XBF, (const char*)WIN, 1024, S, E, c.tid0);
            }
            SEAM(pb + 0); }
        PH(pb + 1) for (int rp = 0; rp < ((REP_PHASE == 1) ? 2 : 1); ++rp) { if (rp) xcd_barrier(bar);
            if (!odd) phase_prep_even(PROJ, GATES, (const float*)ain[3] + jj * 256, (const float*)ain[5] + jj * 128, (const float*)ain[7] + jj * 4 * 1536,
                                      (const float*)ain[8] + jj * 4, (const float*)ain[9] + jj * 4, ROPEM,
                                      (bf16_t*)(ws + U_CQ), (bf16_t*)(ws + U_CKV), (bf16_t*)(ws + U_KROPE), (bf16_t*)(ws + U_GQ), (bf16_t*)(ws + U_GK), (bf16_t*)(ws + U_GV),
                                      (float*)(ws + U_BETA), (float*)(ws + U_GLOG), c);
            else {
                phase_prep_odd(PROJ, ROPES, (bf16_t*)(ws + U_QF), (bf16_t*)(ws + U_KN), c);
                unsigned* ctr = ctl + CW_WORK + pb + 1 + 64 * rp;
                for (;;) {
                    const int u = next_unit(ctr, c); UNIT_CTX();
                    if (u >= 1024) break;
                    mlc_passA(u, PROJ, GATES, (const float*)ain[13] + jj * 4, (const float*)ain[14] + jj * 4, (unsigned char*)YBUF, cu);
                }
            }
            }
            SEAM(pb + 1);
        }
        PH(pb + 2) for (int rp = 0; rp < ((REP_PHASE == 2) ? 2 : 1); ++rp) { if (rp) xcd_barrier(bar);
            unsigned* ctr = ctl + CW_WORK + pb + 2 + 64 * rp;
            if (!odd) {
                for (;;) {
                    const int u = next_unit(ctr, c); UNIT_CTX();
                    if (u >= 1024 + MLAUP_TILES) break;
                    if (u < 1024) gdc_passA(u, (const bf16_t*)(ws + U_GQ), (const bf16_t*)(ws + U_GK), (const bf16_t*)(ws + U_GV), (const float*)(ws + U_BETA),
                                            (const float*)(ws + U_GLOG), ws + WS_HBUF, cu);
                    else mla_up_tile(u - 1024, (const bf16_t*)(ws + U_CQ), (const bf16_t*)(ws + WS_WQB) + (size_t)jj * WQB_ELEMS, (const bf16_t*)(ws + U_CKV),
                                     (const bf16_t*)(ws + WS_WKVB) + (size_t)jj * WKVB_ELEMS, ROPEM, (bf16_t*)(ws + U_QF), (bf16_t*)(ws + U_KN), (bf16_t*)(ws + U_VV), cu);
                }
            } else {
                for (;;) {
                    const int u = next_unit(ctr, c); UNIT_CTX();
                    if (u >= 256 + 1024) break;
                    if (u < 256) mlc_passB(u, (unsigned char*)YBUF, cu);
                    else {
                        const int v = u - 256, hq = v & 7, n = (v >> 3) & 15, b = v >> 7, kvh = hq >> 2;
                        const size_t tb = (size_t)b * SEQ;
                        attn_unit<4, true>((const bf16_t*)(ws + U_QF) + tb * 512 + hq * 64, 512, (const bf16_t*)(ws + U_KN) + tb * 128 + kvh * 64, 128,
                                           (const bf16_t*)(ws + U_KN), 0, PROJ + tb * NPAD + 2184 + kvh * 64, NPAD,
                                           MIXO + tb * 1024 + 512 + hq * 64, 1024, n * 128, ((const float*)ain[16])[jj * 8 + hq] * 1.4426950408889634f, cu);
                    }
                }
            }
            }
            SEAM(pb + 2);
        }
        PH(pb + 3) for (int rp = 0; rp < ((REP_PHASE == 3) ? 2 : 1); ++rp) { if (rp) xcd_barrier(bar);
            unsigned* ctr = ctl + CW_WORK + pb + 3 + 64 * rp;
            if (!odd) {
                for (;;) {
                    const int u = next_unit(ctr, c); UNIT_CTX();
                    if (u >= 64 + 1024) break;
                    if (rp > 0 && ((REP_ONLY == 1 && u >= 64) || (REP_ONLY == 2 && u < 64))) continue;
                    if (u < 64) { if ((u & 1) == 0) gdc_passB(u >> 1, ws + WS_HBUF, (unsigned char*)YBUF, cu); else gdc_passB_idle(); }
                    else {
                        const int v = u - 64, qb = 15 - (v >> 6), bh = v & 63, b = bh >> 3, hh = bh & 7;
                        const size_t tb = (size_t)b * SEQ;
                        attn_unit<6, false>((const bf16_t*)(ws + U_QF) + tb * 768 + hh * 96, 768, (const bf16_t*)(ws + U_KN) + tb * 512 + hh * 64, 512,
                                            (const bf16_t*)(ws + U_KROPE) + tb * 32, 32, (const bf16_t*)(ws + U_VV) + tb * 512 + hh * 64, 512,
                                            MIXO + tb * 1024 + hh * 64, 1024, qb * 128, 0.f, cu);
                    }
                }
            } else {
                for (;;) {
                    const int u = next_unit(ctr, c); UNIT_CTX();
                    if (u >= 1024) break;
                    mlc_passC(u, PROJ, GATES, (const float*)ain[13] + jj * 4, (const float*)ain[14] + jj * 4, (const unsigned char*)YBUF, (const float*)ain[15] + jj * 512, MIXO, cu);
                }
            }
            }
            SEAM(pb + 3);
        }
        PH(pb + 4) for (int rp = 0; rp < ((REP_PHASE == 4) ? 2 : 1); ++rp) { if (rp) xcd_barrier(bar);
            if (!odd) {
                unsigned* ctr = ctl + CW_WORK + pb + 4 + 64 * rp;
                for (;;) {
                    const int u = next_unit(ctr, c); UNIT_CTX();
                    if (u >= 1024) break;
                    gdc_passC(u, ws + WS_HBUF, (const unsigned char*)YBUF, PROJ, (const float*)ain[10] + jj * 128, MIXO, cu);
                }
            }
            }
            if (!odd) SEAM(pb + 4);
        }
        PH(pb + 5) {
                DenseSched S{T / 256, 4, 1024, (int)blockIdx.x, (int)gridDim.x};
                EpiOut E{XBF, (bf16_t*)YBUF};
                g8::phase<true, false>(smem, (const char*)MIXO, (const char*)WOUT, 1024, S, E, c.tid0);
            }
            SEAM(pb + 5); }
#if FUSE_LNROUTE
        PH(pb + 6) phase_lnroute((const bf16_t*)YBUF, (const float*)ain[18] + layer * 1024, (const float*)ain[19] + layer * 1024, XBF, (const bf16_t*)(ws + WS_WRT) + (size_t)layer * WRT_ELEMS,
                                 (const float*)ain[21] + layer * 64, CNT, (int*)(ws + WS_LTOK), (float*)(ws + WS_LW), (int*)(ws + WS_ASG), (float*)(ws + WS_ASGW), c); SEAM(pb + 8); }
#else
        PH(pb + 6) for (int rep = 0; rep < REP_TOK; ++rep) phase_ln1((const bf16_t*)YBUF, (const float*)ain[18] + layer * 1024, (const float*)ain[19] + layer * 1024, XBF, c); SEAM(pb + 6); }
        PH(pb + 7) for (int rep = 0; rep < REP_GEMM; ++rep) phase_router(XBF, (const bf16_t*)(ws + WS_WRT) + (size_t)layer * WRT_ELEMS, (float*)(ws + WS_LOG), c); SEAM(pb + 7); }
        PH(pb + 8) phase_route((const float*)(ws + WS_LOG), (const float*)ain[21] + layer * 64, CNT, (int*)(ws + WS_LTOK), (float*)(ws + WS_LW), (int*)(ws + WS_ASG), (float*)(ws + WS_ASGW), c); SEAM(pb + 8); }
#endif
        PH(pb + 9) {
                int* bst8 = (int*)(smem + LDS_BLK + 64); int* eb8 = bst8 + 256;
                build_block_table(CNT, bst8, c);
                for (int rb = c.tid0; rb < bst8[65]; rb += NT) { int e = 0; for (int q = 1; q < 65; ++q) e += (bst8[q] <= rb) ? 1 : 0; eb8[rb] = e; }
                __syncthreads();
                MoeSchedG S{__builtin_amdgcn_readfirstlane(bst8[65]), (int)blockIdx.x, (int)gridDim.x, eb8, bst8, (const int*)(ws + WS_LTOK)};
                EpiMoe1 E{(bf16_t*)(ws + WS_HBUF)};
                g8::phase<false, true>(smem, (const char*)XBF, (const char*)((const bf16_t*)(ws + WS_WGU) + (size_t)layer * 65 * WGU_ELEMS), 1024, S, E, c.tid0);
            }
            SEAM(pb + 9); }
        PH(pb + 10)
#if MOE2_G8
            {
                int* bst8 = (int*)(smem + LDS_BLK + 64); int* eb8 = bst8 + 256;
                build_block_table(CNT, bst8, c);
                for (int rb = c.tid0; rb < bst8[65]; rb += NT) { int e = 0; for (int q = 1; q < 65; ++q) e += (bst8[q] <= rb) ? 1 : 0; eb8[rb] = e; }
                __syncthreads();
                MoeSched S{__builtin_amdgcn_readfirstlane(bst8[65]), 4, (int)blockIdx.x, (int)gridDim.x, eb8};
                EpiMoe2 E{(bf16_t*)(ws + U_Y)};
                g8::phase<true, false>(smem, (const char*)(ws + WS_HBUF), (const char*)((const bf16_t*)(ws + WS_WDN) + (size_t)layer * 65 * WDN_ELEMS), 256, S, E, c.tid0);
            }
#else
            phase_moe2((const bf16_t*)(ws + WS_HBUF), (const bf16_t*)(ws + WS_WDN) + (size_t)layer * 65 * WDN_ELEMS, CNT, (bf16_t*)(ws + U_Y), c);
#endif
            SEAM(pb + 10); }
        PH(pb + 11)
            if (layer == 3) phase_combine<true>((const bf16_t*)(ws + U_Y), (const int*)(ws + WS_ASG), (const float*)(ws + WS_ASGW), CNT, (const float*)ain[28] + layer * 1024, (const float*)ain[29] + layer * 1024, a.out, XBF, c);
            else phase_combine<false>((const bf16_t*)(ws + U_Y), (const int*)(ws + WS_ASG), (const float*)(ws + WS_ASGW), CNT, (const float*)ain[28] + layer * 1024, (const float*)ain[29] + layer * 1024, a.out, XBF, c);
            SEAM(pb + 11); }
    }
#undef IN
#undef XBF
#undef X1
#undef PROJ
#undef GATES
#undef MIXO
#undef YBUF
#undef ROPEM
#undef ROPES
#undef XRES
#undef CNT
#undef WIN
#undef WOUT
#undef PH
#undef PH_CTX
#undef UNIT_CTX
#undef SEAM
}

extern "C" void kernel_launch(void* const* d_in, const int* in_sizes, int n_in, void* d_out, int out_size, void* d_ws, size_t ws_size, hipStream_t stream) {
    static int grid = 0;
    if (grid == 0) {
        if (n_in != 30 || out_size != T * 1024 || ws_size < WS_END) {
            fprintf(stderr, "kernel_launch: unexpected shapes (n_in %d, out %d, ws %zu < %zu)\n", n_in, out_size, ws_size, (size_t)WS_END);
            grid = -1; return;
        }
        int dev = 0, cus = 0, per_cu = 0;
        (void)hipGetDevice(&dev);
        (void)hipDeviceGetAttribute(&cus, hipDeviceAttributeMultiprocessorCount, dev);
        (void)hipFuncSetAttribute((const void*)fwd, hipFuncAttributeMaxDynamicSharedMemorySize, DYN_LDS);
        (void)hipOccupancyMaxActiveBlocksPerMultiprocessor(&per_cu, (const void*)fwd, NT, DYN_LDS);
        (void)hipGetLastError();
        if (per_cu < 1) per_cu = 1;
        grid = cus;
    }
    if (grid < 0) return;
    (void)hipMemsetAsync((char*)d_ws + WS_CTL, 0, CTL_BYTES, stream);
    Args a{};
    for (int i = 0; i < 30; ++i) a.in[i] = d_in[i];
    a.out = (float*)d_out; a.ws = (unsigned char*)d_ws; a.pad = 0;
#if ONE_LAUNCH
    a.ph_lo = 0; a.ph_hi = NPH; a.use_bar = 1;
    hipLaunchKernelGGL(fwd, dim3(grid), dim3(NT), DYN_LDS, stream, a);
#else
    for (int p = 0; p < NPH; ++p) {
        a.ph_lo = p; a.ph_hi = p + 1; a.use_bar = 0;
        hipLaunchKernelGGL(fwd, dim3(grid), dim3(NT), DYN_LDS, stream, a);
    }
#endif
}
```

```cpp
#include <hip/hip_runtime.h>
#include <stdint.h>
#include <stdio.h>

#define REP_GEMM 1
#define REP_PHASE 0
#define REP_G0 1
#define REP_G1 1
#define REP_G2 1
#define REP_G3 1
#define REP_MIX 1
#define REP_ONLY 0
#define REP_CMB 1
#define REP_PRO 1
#define REP_TOK 1
#define MOE2_G8 1
#ifndef G8_SPLIT
#define G8_SPLIT 0
#endif
#ifndef FUSE_LNROUTE
#define FUSE_LNROUTE 1
#endif
#ifndef ONE_LAUNCH
#define ONE_LAUNCH 1
#endif

typedef unsigned short bf16_t;
typedef short bf16x8 __attribute__((ext_vector_type(8)));
typedef float f32x4 __attribute__((ext_vector_type(4)));
typedef unsigned u32x4 __attribute__((ext_vector_type(4)));
typedef unsigned u32x2 __attribute__((ext_vector_type(2)));
#define LAS __attribute__((address_space(3)))
#define GAS __attribute__((address_space(1)))

constexpr int T = 16384, SEQ = 2048;
constexpr int NPAD = 2560;
constexpr int CAP = 16384;
constexpr int RBR = 256;
constexpr int MAXRB = 512 + 64 + 64;
constexpr int MAXROWS = MAXRB * RBR;
constexpr float ALPHA = 1.681792830507429f;
constexpr int PPL = 12;
constexpr int NPH = 1 + 4 * PPL;
constexpr int NT = 512, NW = 8;
constexpr int HALF_LDS = 65536 + 64 + 1024;
constexpr int LDS_BLK = 2 * HALF_LDS;
constexpr int DYN_LDS = LDS_BLK + 64 + 1024 + 2560;

constexpr size_t cmax(size_t a, size_t b) { return a > b ? a : b; }
constexpr size_t WS_CTL = 0;
constexpr size_t CTL_BYTES = 65536;
constexpr size_t WS_WIN = WS_CTL + CTL_BYTES;
constexpr size_t WIN_ELEMS = (size_t)NPAD * 1024;
constexpr size_t WS_WQB = WS_WIN + 4 * WIN_ELEMS * 2;
constexpr size_t WQB_ELEMS = 768 * 256;
constexpr size_t WS_WKVB = WS_WQB + 2 * WQB_ELEMS * 2;
constexpr size_t WKVB_ELEMS = 1024 * 128;
constexpr size_t WS_WOUT = WS_WKVB + 2 * WKVB_ELEMS * 2;
constexpr size_t WOUT_ELEMS = 1024 * 1024;
constexpr size_t WS_WRT = WS_WOUT + 4 * WOUT_ELEMS * 2;
constexpr size_t WRT_ELEMS = 128 * 1024;
constexpr size_t WS_WGU = WS_WRT + 4 * WRT_ELEMS * 2;
constexpr size_t WGU_ELEMS = 512 * 1024;
constexpr size_t WS_WDN = WS_WGU + 4 * 65 * WGU_ELEMS * 2;
constexpr size_t WDN_ELEMS = 1024 * 256;
constexpr size_t WS_ROPEM = WS_WDN + 4 * 65 * WDN_ELEMS * 2;
constexpr size_t WS_ROPES = WS_ROPEM + (size_t)T * 16 * 2 * 4;
constexpr size_t WS_X1 = WS_ROPES + (size_t)T * 32 * 2 * 4;
constexpr size_t WS_XBF = WS_X1 + (size_t)T * 1024 * 4;
constexpr size_t WS_HBUF = WS_XBF + (size_t)T * 1024 * 2;
constexpr size_t WS_LOG = WS_HBUF + (size_t)MAXROWS * 256 * 2;
constexpr size_t WS_ASG = WS_LOG + (size_t)T * 64 * 4;
constexpr size_t WS_ASGW = WS_ASG + (size_t)T * 8 * 4;
constexpr size_t WS_LTOK = WS_ASGW + (size_t)T * 8 * 4;
constexpr size_t WS_LW = WS_LTOK + (size_t)65 * CAP * 4;
constexpr size_t WS_U = WS_LW + (size_t)65 * CAP * 4;
constexpr size_t U_Y = WS_U;
constexpr size_t U_PROJ = WS_U;
constexpr size_t U_GATES = U_PROJ + (size_t)T * NPAD * 2;
constexpr size_t U_CQ = U_GATES + (size_t)T * 8 * 4;
constexpr size_t U_CKV = U_CQ + (size_t)T * 256 * 2;
constexpr size_t U_KROPE = U_CKV + (size_t)T * 128 * 2;
constexpr size_t U_QF = U_KROPE + (size_t)T * 32 * 2;
constexpr size_t U_KN = U_QF + (size_t)T * 768 * 2;
constexpr size_t U_VV = U_KN + (size_t)T * 512 * 2;
constexpr size_t U_GQ = U_VV + (size_t)T * 512 * 2;
constexpr size_t U_GK = U_GQ + (size_t)T * 512 * 2;
constexpr size_t U_GV = U_GK + (size_t)T * 512 * 2;
constexpr size_t U_BETA = U_GV + (size_t)T * 512 * 2;
constexpr size_t U_GLOG = U_BETA + (size_t)T * 4 * 4;
constexpr size_t U_MIXO = U_GLOG + (size_t)T * 4 * 4;
constexpr size_t U_YBUF = U_MIXO + (size_t)T * 1024 * 2;
constexpr size_t U_END1 = U_YBUF + (size_t)T * 1024 * 4;
constexpr size_t WS_END = WS_U + cmax((size_t)MAXROWS * 1024 * 2, U_END1 - WS_U);

constexpr int CW_CNT = 4096;
constexpr int CW_WORK = 8192;

#define XB_TMO      128
#define XB_XCNT(j)  (256  + 64 * (j))
#define XB_XSUB(j)  (1280 + 64 * (j))
#define XB_XGEN(j)  (2304 + 64 * (j))
#define XB_TOP      3328
#define XB_TOPGEN   3392
#define XCD_BAR_WORDS 3456
#define XB_SPIN_CAP (1u << 18)

__device__ __forceinline__ unsigned xb_ld(unsigned* p)              { return __hip_atomic_load(p, __ATOMIC_RELAXED, __HIP_MEMORY_SCOPE_AGENT); }
__device__ __forceinline__ int lane_id_v() { int l; asm volatile("v_mbcnt_lo_u32_b32 %0, -1, 0\n\tv_mbcnt_hi_u32_b32 %0, -1, %0" : "=v"(l)); return l; }
__device__ __forceinline__ unsigned xb_add(unsigned* p, unsigned v) { return __hip_atomic_fetch_add(p, v, __ATOMIC_RELAXED, __HIP_MEMORY_SCOPE_AGENT); }
__device__ __forceinline__ unsigned xb_xcc_id() { return (unsigned)__builtin_amdgcn_s_getreg((3 << 11) | 20) & 0xFu; }
#define XB_SPIN(cond, bar) do { unsigned _sp = 0; while (cond) { __builtin_amdgcn_s_sleep(1); \
    if ((++_sp & 255u) == 0u) { if (xb_ld(&(bar)[XB_TMO])) break; if (_sp > XB_SPIN_CAP) { atomicAdd(&(bar)[XB_TMO], 1u); break; } } } } while (0)

struct XcdBarrier { unsigned* bar; unsigned x; volatile LAS unsigned* st; int wave; };

__device__ __forceinline__ XcdBarrier xcd_barrier_post(unsigned* bar, volatile LAS unsigned* st, int tid0) {
    XcdBarrier b; b.bar = bar; b.x = xb_xcc_id(); b.st = st; b.wave = __builtin_amdgcn_readfirstlane(tid0 >> 6);
    if (tid0 == 0) (void)xb_add(&bar[XB_XCNT(b.x)], 1u);
    return b;
}
__device__ __forceinline__ void xcd_barrier_complete(unsigned* bar, unsigned x, unsigned& nloc, unsigned& nx) {
    const unsigned G = gridDim.x * gridDim.y * gridDim.z;
    unsigned sum, cnt, mine, sp = 0u;
    for (;;) {
        sum = 0u; cnt = 0u; mine = 0u;
#pragma unroll
        for (unsigned j = 0; j < 16; ++j) { const unsigned c = xb_ld(&bar[XB_XCNT(j)]); sum += c; cnt += (c > 0u) ? 1u : 0u; mine = (j == x) ? c : mine; }
        if (sum == G) break;
        __builtin_amdgcn_s_sleep(1);
        if ((++sp & 255u) == 0u) { if (xb_ld(&bar[XB_TMO])) break; if (sp > XB_SPIN_CAP) { atomicAdd(&bar[XB_TMO], 1u); break; } }
    }
    nloc = mine > 0u ? mine : 1u; nx = cnt > 0u ? cnt : 1u;
}
__device__ __forceinline__ void xcd_barrier(const XcdBarrier& b) {
    asm volatile("s_waitcnt vmcnt(0)" ::: "memory");
    __syncthreads();
    if (b.wave == 0 && lane_id_v() == 0) {
        unsigned* bar = b.bar; unsigned bx = __builtin_amdgcn_readfirstlane(b.x);
        asm volatile("" : "+s"(bar), "+s"(bx));
        __builtin_amdgcn_s_waitcnt(0);
        unsigned nloc = b.st[0], nx = b.st[1];
        if (nloc == 0u) { xcd_barrier_complete(bar, bx, nloc, nx); b.st[0] = nloc; b.st[1] = nx; }
        const unsigned old = xb_add(&bar[XB_XSUB(bx)], 1u);
        const unsigned gen = old / nloc;
        if (old + 1u == (gen + 1u) * nloc) {
            __builtin_amdgcn_fence(__ATOMIC_RELEASE, "agent");
            asm volatile("s_waitcnt vmcnt(0)" ::: "memory");
            const unsigned og = xb_add(&bar[XB_TOP], 1u);
            const unsigned tg = og / nx;
            if (og + 1u == (tg + 1u) * nx) xb_add(&bar[XB_TOPGEN], 1u);
            else XB_SPIN(xb_ld(&bar[XB_TOPGEN]) == tg, bar);
            __builtin_amdgcn_fence(__ATOMIC_ACQUIRE, "agent");
            xb_add(&bar[XB_XGEN(bx)], 1u);
            asm volatile("s_waitcnt vmcnt(0)" ::: "memory");
        } else {
            XB_SPIN(xb_ld(&bar[XB_XGEN(bx)]) == gen, bar);
            __builtin_amdgcn_fence(__ATOMIC_ACQUIRE, "agent");
            asm volatile("s_waitcnt vmcnt(0)" ::: "memory");
        }
    }
    __syncthreads();
}

__device__ __forceinline__ float bf2f(unsigned v) { return __uint_as_float(v << 16); }
__device__ __forceinline__ float bflo(unsigned w) { return __uint_as_float(w << 16); }
__device__ __forceinline__ float bfhi(unsigned w) { return __uint_as_float(w & 0xffff0000u); }
__device__ __forceinline__ unsigned f2bf(float f) { unsigned u = __float_as_uint(f); u += 0x7fffu + ((u >> 16) & 1u); return u >> 16; }
__device__ __forceinline__ unsigned pk2(float lo, float hi) { return f2bf(lo) | (f2bf(hi) << 16); }
__device__ __forceinline__ unsigned cvt_pk(float lo, float hi) { unsigned r; asm volatile("v_cvt_pk_bf16_f32 %0, %1, %2" : "=v"(r) : "v"(lo), "v"(hi)); return r; }
template <class T> __device__ __forceinline__ T shfl_xor_(T v, int o) { return __builtin_bit_cast(T, __builtin_amdgcn_ds_bpermute((lane_id_v() ^ o) << 2, __builtin_bit_cast(int, v))); }
template <class T> __device__ __forceinline__ T shfl_up_(T v, int o) { const int l = lane_id_v(), s = (l - o < 0) ? l : l - o; return __builtin_bit_cast(T, __builtin_amdgcn_ds_bpermute(s << 2, __builtin_bit_cast(int, v))); }
template <class T> __device__ __forceinline__ T shfl_c_(T v, int src  ) { return __builtin_bit_cast(T, __builtin_amdgcn_readlane(__builtin_bit_cast(int, v), src)); }
__device__ __forceinline__ float wave_sum(float v) {
#pragma unroll
    for (int o = 32; o > 0; o >>= 1) v += shfl_xor_(v, o);
    return v;
}
__device__ __forceinline__ float sigmoidf_(float x) { return 1.f / (1.f + expf(-x)); }
__device__ __forceinline__ float siluf_(float x) { return x / (1.f + expf(-x)); }
__device__ __forceinline__ float softplusf_(float x) { return x > 20.f ? x : log1pf(expf(x)); }
__device__ __forceinline__ void glds16(const void* g, void* l) {
    __builtin_amdgcn_global_load_lds((const GAS unsigned*)g, (LAS unsigned*)l, 16, 0, 0);
}
__device__ __forceinline__ void unpack8(const u32x4 r, float (&f)[8]) {
    f[0] = bflo(r.x); f[1] = bfhi(r.x); f[2] = bflo(r.y); f[3] = bfhi(r.y);
    f[4] = bflo(r.z); f[5] = bfhi(r.z); f[6] = bflo(r.w); f[7] = bfhi(r.w);
}

struct Args {
    const void* in[30];
    float* out;
    unsigned char* ws;
    int ph_lo, ph_hi, use_bar, pad;
};

struct Ctx { int tid, lane, wid, wr, wc, fr, fq, bid, nblk; unsigned char* smem; int half, tid0; unsigned char* smem0; };

#define WAIT_V(n) asm volatile("s_waitcnt vmcnt(" #n ")" ::: "memory")
__device__ __forceinline__ void gemm_tile(const bf16_t* a0, const bf16_t* a1, const bf16_t* b0, const bf16_t* b1,
                                          int nk, f32x4 (&acc)[4][4], const Ctx& c) {
#pragma unroll
    for (int m = 0; m < 4; ++m)
#pragma unroll
        for (int n = 0; n < 4; ++n) acc[m][n] = (f32x4){0.f, 0.f, 0.f, 0.f};
    unsigned char* smem = c.smem;
    const int sb = c.tid * 16;
    const int kofs = ((c.tid & 3) ^ ((c.tid >> 4) & 3)) * 8;
    a0 += kofs; a1 += kofs; b0 += kofs; b1 += kofs;
#define G_STAGE(kt_) do { unsigned char* sp_ = smem + ((kt_) & 3) * 16384 + sb; const int ko_ = (kt_) * 32; \
        glds16(a0 + ko_, sp_); glds16(a1 + ko_, sp_ + 4096); glds16(b0 + ko_, sp_ + 8192); glds16(b1 + ko_, sp_ + 12288); } while (0)
#define G_READ(kt_, AF, BF) do { const unsigned char* sa_ = smem + ((kt_) & 3) * 16384 + c.wr * 4096 + roff; const unsigned char* sb_ = smem + ((kt_) & 3) * 16384 + 8192 + c.wc * 4096 + roff; \
        _Pragma("unroll") for (int m = 0; m < 4; ++m) AF[m] = *(const bf16x8*)(sa_ + m * 1024); \
        _Pragma("unroll") for (int n = 0; n < 4; ++n) BF[n] = *(const bf16x8*)(sb_ + n * 1024); } while (0)
#define G_MMA(AF, BF) do { __builtin_amdgcn_s_setprio(1); \
        _Pragma("unroll") for (int m = 0; m < 4; ++m) _Pragma("unroll") for (int n = 0; n < 4; ++n) acc[m][n] = __builtin_amdgcn_mfma_f32_16x16x32_bf16(BF[n], AF[m], acc[m][n], 0, 0, 0); \
        __builtin_amdgcn_s_setprio(0); } while (0)
#define G_BAR() do { asm volatile("" ::: "memory"); __builtin_amdgcn_s_barrier(); asm volatile("" ::: "memory"); } while (0)
    const int roff = (c.fr * 64) + ((c.fq ^ ((c.fr >> 2) & 3)) * 16);
    WAIT_V(0);
    G_STAGE(0); G_STAGE(1); G_STAGE(2); G_STAGE(3);
    bf16x8 fa0[4], fb0[4], fa1[4], fb1[4];
    WAIT_V(12); G_BAR();
    G_READ(0, fa0, fb0);
#define G_LGK0() asm volatile("s_waitcnt lgkmcnt(0)" ::: "memory")
    int kt = 0;
    for (; kt < nk - 4; kt += 4) {
        G_LGK0(); WAIT_V(8); G_BAR(); G_STAGE(kt + 4); G_READ(1, fa1, fb1); G_MMA(fa0, fb0);
        G_LGK0(); WAIT_V(8); G_BAR(); G_STAGE(kt + 5); G_READ(2, fa0, fb0); G_MMA(fa1, fb1);
        G_LGK0(); WAIT_V(8); G_BAR(); G_STAGE(kt + 6); G_READ(3, fa1, fb1); G_MMA(fa0, fb0);
        G_LGK0(); WAIT_V(8); G_BAR(); G_STAGE(kt + 7); G_READ(0, fa0, fb0); G_MMA(fa1, fb1);
    }
    G_LGK0(); WAIT_V(8); G_BAR(); G_READ(1, fa1, fb1); G_MMA(fa0, fb0);
    G_LGK0(); WAIT_V(4); G_BAR(); G_READ(2, fa0, fb0); G_MMA(fa1, fb1);
    G_LGK0(); WAIT_V(0); G_BAR(); G_READ(3, fa1, fb1); G_MMA(fa0, fb0);
    G_MMA(fa1, fb1);
#undef G_LGK0
#undef G_STAGE
#undef G_READ
#undef G_MMA
#undef G_BAR
    __syncthreads();
}

namespace g8 {
constexpr int BM = 256, BK = 64, HALF = 128, HTB = HALF * BK * 2, STAGE_BYTES = 8 * HTB;
__device__ __forceinline__ int lds_byte(int r, int c) { const int st = (r >> 4) * 2 + (c >> 5), rr = r & 15, cc = c & 31, ob = rr * 64 + cc * 2; return st * 1024 + (ob ^ (((ob >> 9) & 1) << 5)); }
__device__ __forceinline__ void stage_rc(int b, int& R, int& C) { const int st = b / 1024, sb = b % 1024, swz = sb ^ (((sb >> 9) & 1) << 5); R = (st >> 1) * 16 + swz / 64; C = (st & 1) * 32 + (swz % 64) / 2; }
__device__ __forceinline__ int perm32(int rho) { const int n = rho >> 4, i = rho & 15; return 8 * (i >> 2) + 4 * n + (i & 3); }
struct Unit { int pm, pn, bt; };

template <bool PERM, bool GATHER, class Sched, class Epi>
__device__ __forceinline__ void phase(unsigned char* ldsp, const char* Abase, const char* Bbase, int K, const Sched& S, const Epi& E, int tid_in) {
    LAS unsigned char* lds = (LAS unsigned char*)ldsp;
    int tid = tid_in; asm volatile("" : "+v"(tid));
    const int wid = __builtin_amdgcn_readfirstlane(tid >> 6), lane = tid & 63, wr = wid >> 2, wc = wid & 3, fr = lane & 15, fq = lane >> 4;
    const int nt = K / BK;
    unsigned voffA[2], voffB[2];
#pragma unroll
    for (int i = 0; i < 2; ++i) { int R, C; stage_rc(tid * 16 + i * 8192, R, C); const int Rb = PERM ? ((R >> 5) * 64 + perm32(R & 31)) : (((R >> 5) * 2 + ((R & 15) >> 3)) * 32 + ((R >> 4) & 1) * 16 + (((R & 15) >> 2) & 1) * 8 + (R & 3));
        voffA[i] = (unsigned)(R * K + C) * 2u; voffB[i] = (unsigned)(Rb * K + C) * 2u; }
    const size_t kstep = (size_t)(BK * 2);
    const size_t hstep = (size_t)HALF * K * 2, tstep = 2 * hstep, bhstep = PERM ? (size_t)32 * K * 2 : (size_t)4 * K * 2;
    const unsigned ldsw = (unsigned)wid * 1024u;
    const int aoff = lds_byte(wr * 64 + fr, fq * 8), boff = lds_byte(wc * 32 + fr, fq * 8);
#define G8_SA(b, h) (((b) * 2 + (h)) * HTB)
#define G8_SB(b, h) ((4 + (b) * 2 + (h)) * HTB)
#define G8_DMA(gptr, voff32, ldsoff) do { const char* _gp = (gptr); const unsigned _lo = (unsigned)(size_t)(ldsp) + (unsigned)(ldsoff); \
        asm volatile("s_mov_b32 m0, %2\n\ts_nop 0\n\tglobal_load_lds_dwordx4 %0, %1" :: "v"(voff32), "s"(_gp), "s"(_lo) : "memory", "m0"); } while (0)
#define G8_STAGE(bufoff, gbase, voff) do { _Pragma("unroll") for (int _i = 0; _i < 2; ++_i) G8_DMA((const char*)(gbase), (voff)[_i], (bufoff) + ldsw + _i * 8192); } while (0)
#define G8_STAGEA(bufoff, gbase, h, kb) do { if constexpr (GATHER) { _Pragma("unroll") for (int _i = 0; _i < 2; ++_i) G8_DMA(Abase + (kb), vA[2 * (h) + _i], (bufoff) + ldsw + _i * 8192); } \
        else G8_STAGE(bufoff, (gbase) + (size_t)(h) * hstep + (kb), voffA); } while (0)
#define G8_LDA(dst, b, h) do { _Pragma("unroll") for (int m = 0; m < 4; ++m) _Pragma("unroll") for (int k = 0; k < 2; ++k) dst[m][k] = *(const LAS bf16x8*)(lds + G8_SA(b, h) + aoff + m * 2048 + k * 1024); } while (0)
#define G8_LDB(dst, b, h) do { _Pragma("unroll") for (int n = 0; n < 2; ++n) _Pragma("unroll") for (int k = 0; k < 2; ++k) dst[n][k] = *(const LAS bf16x8*)(lds + G8_SB(b, h) + boff + n * 2048 + k * 1024); } while (0)
#define G8_MMA(ai, bj, At, Bt) do { __builtin_amdgcn_s_setprio(1); _Pragma("unroll") for (int m = 0; m < 4; ++m) _Pragma("unroll") for (int n = 0; n < 2; ++n) _Pragma("unroll") for (int k = 0; k < 2; ++k) \
        acc[ai][bj][m][n] = __builtin_amdgcn_mfma_f32_16x16x32_bf16(Bt[n][k], At[m][k], acc[ai][bj][m][n], 0, 0, 0); __builtin_amdgcn_s_setprio(0); } while (0)
#define G8_WAIT_V(n) asm volatile("s_waitcnt vmcnt(" #n ")" ::: "memory")
#define G8_WAIT_L(n) asm volatile("s_waitcnt lgkmcnt(" #n ")" ::: "memory")
#define G8_BAR __builtin_amdgcn_s_barrier()
#define G8_SCHED __builtin_amdgcn_sched_barrier(0)
    Unit cur, nxt; int ui = 0;
    if (!S.next(0, cur)) return;
    f32x4 acc[2][2][4][2];
#pragma unroll
    for (int a = 0; a < 2; ++a)
#pragma unroll
        for (int b = 0; b < 2; ++b)
#pragma unroll
            for (int m = 0; m < 4; ++m)
#pragma unroll
                for (int n = 0; n < 2; ++n) acc[a][b][m][n] = (f32x4){0.f, 0.f, 0.f, 0.f};
    bf16x8 At[4][2], B0[2][2], B1[2][2];
    const char* cA = Abase + (size_t)cur.pm * tstep; const char* cB = Bbase + (size_t)cur.bt * tstep;
    unsigned vA[4] = {0u, 0u, 0u, 0u};
    if constexpr (GATHER) S.aoff(cur, tid, vA);
    asm volatile("s_waitcnt vmcnt(0)" ::: "memory");
    G8_STAGE(G8_SB(0, 0), cB, voffB); G8_STAGEA(G8_SA(0, 0), cA, 0, 0); G8_STAGE(G8_SB(0, 1), cB + bhstep, voffB); G8_STAGEA(G8_SA(0, 1), cA, 1, 0);
    if (wr == 1) G8_BAR;
    G8_WAIT_V(4); G8_BAR;
    G8_STAGE(G8_SB(1, 0), cB + kstep, voffB); G8_STAGEA(G8_SA(1, 0), cA, 0, kstep); G8_STAGE(G8_SB(1, 1), cB + bhstep + kstep, voffB);
    G8_WAIT_V(6); G8_BAR;
    G8_STAGEA(G8_SA(1, 1), cA, 1, kstep);
    for (;;) {
        const bool has_next = S.next(ui + 1, nxt);
        const char* nA = has_next ? Abase + (size_t)nxt.pm * tstep : cA; const char* nB = has_next ? Bbase + (size_t)nxt.bt * tstep : cB;
        for (int t = 0; t < nt; t += 2) {
            const bool last = (t == nt - 2);
            const int lastf = __builtin_amdgcn_readfirstlane(last ? 1 : 0);
            const size_t k2 = last ? 0 : (size_t)(t + 2) * kstep, k3 = k2 + kstep;
            const char* a2 = last ? nA : cA; const char* b2 = last ? nB : cB + (size_t)(t + 2) * kstep;
            const char* b3 = b2 + kstep;
            G8_LDB(B0, 0, 0); G8_SCHED; G8_LDA(At, 0, 0);
            if constexpr (GATHER) { if (last && has_next) S.aoff(nxt, tid, vA); }
            G8_WAIT_L(8); G8_BAR; G8_WAIT_L(0); G8_MMA(0, 0, At, B0); G8_BAR; G8_SCHED;
            G8_LDB(B1, 0, 1); G8_STAGE(G8_SB(0, 0), b2, voffB);
            G8_BAR; G8_WAIT_L(0); G8_MMA(0, 1, At, B1); G8_BAR;
            G8_LDA(At, 0, 1); G8_STAGEA(G8_SA(0, 0), a2, 0, k2);
            G8_BAR; G8_WAIT_L(0); G8_MMA(1, 0, At, B0); G8_BAR; G8_SCHED;
            G8_STAGE(G8_SB(0, 1), b2 + bhstep, voffB);
            const int pend = __builtin_amdgcn_readfirstlane((t == 0 && ui > 0) ? 1 : 0);
            asm volatile("s_cmp_lg_u32 %0, 0\n\ts_cbranch_scc1 1f\n\ts_waitcnt vmcnt(6)\n1:\n\ts_waitcnt vmcnt(%1)" :: "s"(pend), "n"(6 + (Epi::SPLIT ? Epi::NQ : Epi::NST)) : "memory", "scc");
            G8_BAR; G8_MMA(1, 1, At, B1); G8_BAR;
            G8_LDB(B0, 1, 0); G8_SCHED; G8_LDA(At, 1, 0); G8_STAGEA(G8_SA(0, 1), a2, 1, k2);
            G8_WAIT_L(8); G8_BAR; G8_WAIT_L(0); G8_MMA(0, 0, At, B0); G8_BAR; G8_SCHED;
            if constexpr (Epi::SPLIT) { E.template part_cond<0, 0>(acc, cur, wr, wc, fr, fq, lastf); G8_SCHED; }
            G8_LDB(B1, 1, 1); G8_STAGE(G8_SB(1, 0), b3, voffB);
            G8_BAR; G8_WAIT_L(0); G8_MMA(0, 1, At, B1); G8_BAR;
            if constexpr (Epi::SPLIT) { E.template part_cond<0, 1>(acc, cur, wr, wc, fr, fq, lastf); G8_SCHED; }
            G8_LDA(At, 1, 1); G8_STAGEA(G8_SA(1, 0), a2, 0, k3);
            G8_BAR; G8_WAIT_L(0); G8_MMA(1, 0, At, B0); G8_BAR; G8_SCHED;
            G8_STAGE(G8_SB(1, 1), b3 + bhstep, voffB);
            if constexpr (Epi::SPLIT) {
                asm volatile("s_cmp_lg_u32 %0, 0\n\ts_cbranch_scc1 1f\n\ts_waitcnt vmcnt(6)\n1:\n\ts_waitcnt vmcnt(%1)" :: "s"(lastf), "n"(6 + 2 * Epi::NQ) : "memory", "scc");
                G8_SCHED; E.template part_cond<1, 0>(acc, cur, wr, wc, fr, fq, lastf); G8_SCHED;
            } else G8_WAIT_V(6);
            G8_BAR; G8_MMA(1, 1, At, B1); G8_BAR;
            G8_STAGEA(G8_SA(1, 1), a2, 1, k3);
        }
        if constexpr (Epi::SPLIT) E.tail(acc, cur, wr, wc, fr, fq); else E(acc, cur, wr, wc, fr, fq);
        if (!has_next) break;
#pragma unroll
        for (int a = 0; a < 2; ++a)
#pragma unroll
            for (int b = 0; b < 2; ++b)
#pragma unroll
                for (int m = 0; m < 4; ++m)
#pragma unroll
                    for (int n = 0; n < 2; ++n) acc[a][b][m][n] = (f32x4){0.f, 0.f, 0.f, 0.f};
        cur = nxt; cA = nA; cB = nB; ++ui;
    }
    G8_WAIT_V(0);
    if (wr == 0) G8_BAR;
    G8_BAR;
#undef G8_SA
#undef G8_SB
#undef G8_STAGE
#undef G8_STAGEA
#undef G8_LDA
#undef G8_LDB
#undef G8_MMA
#undef G8_WAIT_V
#undef G8_WAIT_L
#undef G8_BAR
#undef G8_SCHED
}
}

__device__ __forceinline__ bool tile_map(int i, const Ctx& c, int ntm, int ntn, int& mt, int& nt) {
    const int vb = ((c.nblk & 15) == 0) ? ((c.bid >> 1) & 7) * (c.nblk >> 3) + (((c.bid >> 4) << 1) | (c.bid & 1)) : c.bid;
    const int L = i * c.nblk + vb;
    if (L >= ntm * ntn) return false;
    const int g = L / (8 * ntn), rem = L - g * 8 * ntn;
    const int gsz = (ntm - g * 8) < 8 ? (ntm - g * 8) : 8;
    mt = g * 8 + rem % gsz; nt = rem / gsz;
    return true;
}

__device__ __forceinline__ bool tile_map2(int i, const Ctx& c, int ntm, int ntn, int& mt, int& nt, bool& valid) {
    Ctx o = c; o.bid = c.bid ^ 1;
    int mo, no; const bool oko = tile_map(i, o, ntm, ntn, mo, no);
    valid = tile_map(i, c, ntm, ntn, mt, nt);
    if (!valid) { mt = 0; nt = 0; }
    return valid || oko;
}

struct DenseSched {
    int ntm, ntn, K, bid, nblk;
    __device__ __forceinline__ bool next(int i, g8::Unit& u) const {
        const int vb = ((nblk & 7) == 0) ? (bid & 7) * (nblk >> 3) + (bid >> 3) : bid;
        const int L = i * nblk + vb;
        if (L >= ntm * ntn) return false;
        const int g = L / (8 * ntn), rem = L - g * 8 * ntn;
        const int gsz = (ntm - g * 8) < 8 ? (ntm - g * 8) : 8;
        u.pm = g * 8 + rem % gsz; u.pn = rem / gsz; u.bt = u.pn;
        return true;
    }
};
struct MoeSched {
    int nrb, ntn, bid, nblk; const int* eb;
    __device__ __forceinline__ bool next(int i, g8::Unit& u) const {
        const int vb = ((nblk & 7) == 0) ? (bid & 7) * (nblk >> 3) + (bid >> 3) : bid;
        const int L = i * nblk + vb;
        if (L >= nrb * ntn) return false;
        const int g = L / (8 * ntn), rem = L - g * 8 * ntn;
        const int gsz = (nrb - g * 8) < 8 ? (nrb - g * 8) : 8;
        u.pm = g * 8 + rem % gsz; u.pn = rem / gsz;
        u.bt = __builtin_amdgcn_readfirstlane(eb[u.pm]) * ntn + u.pn;
        return true;
    }
};
struct MoeSchedG {
    int nrb, bid, nblk; const int* eb; const int* bst; const int* LTOK;
    __device__ __forceinline__ bool next(int i, g8::Unit& u) const {
        const int vb = ((nblk & 7) == 0) ? (bid & 7) * (nblk >> 3) + (bid >> 3) : bid;
        const int L = i * nblk + vb;
        if (L >= nrb * 2) return false;
        const int g = L >> 4, rem = L & 15;
        const int gsz = (nrb - g * 8) < 8 ? (nrb - g * 8) : 8;
        u.pm = g * 8 + rem % gsz; u.pn = rem / gsz;
        u.bt = __builtin_amdgcn_readfirstlane(eb[u.pm]) * 2 + u.pn;
        return true;
    }
    __device__ __forceinline__ void aoff(const g8::Unit& u, int tid, unsigned (&o)[4]) const {
        const int e = eb[u.pm], lb = u.pm - bst[e], cnt = bst[66 + e];
        int R0, C0, R1, C1; g8::stage_rc(tid * 16, R0, C0); g8::stage_rc(tid * 16 + 8192, R1, C1);
        const int* lt = LTOK + (size_t)e * CAP + lb * RBR;
        const int p00 = R0, p01 = R1, p10 = 128 + R0, p11 = 128 + R1;
        const int t00 = (lb * RBR + p00 < cnt) ? lt[p00] : 0, t01 = (lb * RBR + p01 < cnt) ? lt[p01] : 0;
        const int t10 = (lb * RBR + p10 < cnt) ? lt[p10] : 0, t11 = (lb * RBR + p11 < cnt) ? lt[p11] : 0;
        o[0] = (unsigned)t00 * 2048u + (unsigned)C0 * 2u; o[1] = (unsigned)t01 * 2048u + (unsigned)C1 * 2u;
        o[2] = (unsigned)t10 * 2048u + (unsigned)C0 * 2u; o[3] = (unsigned)t11 * 2048u + (unsigned)C1 * 2u;
    }
};
struct EpiMoe1 {
    static constexpr bool SPLIT = false; static constexpr int NQ = 2, NST = 8;
    bf16_t* H;
    __device__ __forceinline__ void operator()(const f32x4 (&acc)[2][2][4][2], const g8::Unit& u, int wr, int wc, int fr, int fq) const {
#pragma unroll
        for (int ai = 0; ai < 2; ++ai)
#pragma unroll
            for (int m = 0; m < 4; ++m) {
                const size_t row = (size_t)u.pm * RBR + ai * 128 + wr * 64 + m * 16 + fr;
                float h[8];
#pragma unroll
                for (int bj = 0; bj < 2; ++bj) {
                    const f32x4 g = acc[ai][bj][m][0], up = acc[ai][bj][m][1];
#pragma unroll
                    for (int j = 0; j < 4; ++j) h[bj * 4 + j] = g[j] * __builtin_amdgcn_rcpf(1.f + __expf(-g[j])) * up[j];
                }
                *(u32x4*)(H + row * 256 + u.pn * 128 + wc * 32 + fq * 8) = (u32x4){cvt_pk(h[0], h[1]), cvt_pk(h[2], h[3]), cvt_pk(h[4], h[5]), cvt_pk(h[6], h[7])};
            }
    }
    template <int ai, int bj> __device__ __forceinline__ void part_cond(const f32x4 (&acc)[2][2][4][2], const g8::Unit& u, int wr, int wc, int fr, int fq, int flag) const {}
    __device__ __forceinline__ void tail(const f32x4 (&acc)[2][2][4][2], const g8::Unit& u, int wr, int wc, int fr, int fq) const {}
};
__device__ __forceinline__ u32x4 dpp_ror8(const u32x4 v) {
    u32x4 r;
#pragma unroll
    for (int i = 0; i < 4; ++i) r[i] = (unsigned)__builtin_amdgcn_update_dpp(0, (int)v[i], 0x128, 0xF, 0xF, true);
    return r;
}
template <bool NT = false>
__device__ __forceinline__ void perm_store(bf16_t* p  , size_t ld8  , const u32x4 p0, const u32x4 p1, int hi) {
    const u32x4 snd = hi ? p0 : p1, rcv = dpp_ror8(snd);
    if constexpr (NT) { __builtin_nontemporal_store(hi ? rcv : p0, (u32x4*)p); __builtin_nontemporal_store(hi ? p1 : rcv, (u32x4*)(p + ld8)); }
    else { *(u32x4*)p = hi ? rcv : p0; *(u32x4*)(p + ld8) = hi ? p1 : rcv; }
}
struct EpiIn {
    static constexpr bool SPLIT = false; static constexpr int NQ = 4, NST = 16;
    bf16_t* P; float* G; int gbase;
    template <int ai, int bj> __device__ __forceinline__ void part_cond(const f32x4 (&acc)[2][2][4][2], const g8::Unit& u, int wr, int wc, int fr, int fq, int flag) const {}
    __device__ __forceinline__ void tail(const f32x4 (&acc)[2][2][4][2], const g8::Unit& u, int wr, int wc, int fr, int fq) const {}
    __device__ __forceinline__ void operator()(const f32x4 (&acc)[2][2][4][2], const g8::Unit& u, int wr, int wc, int fr, int fq) const {
        const int hi = fr >> 3, r8 = fr & 7;
#pragma unroll
        for (int ai = 0; ai < 2; ++ai)
#pragma unroll
            for (int m = 0; m < 4; ++m) {
                const size_t rg = (size_t)u.pm * 256 + ai * 128 + wr * 64 + m * 16;
                u32x4 pk[2];
#pragma unroll
                for (int bj = 0; bj < 2; ++bj) {
                    const f32x4 v0 = acc[ai][bj][m][0], v1 = acc[ai][bj][m][1];
                    pk[bj] = (u32x4){cvt_pk(v0[0], v0[1]), cvt_pk(v0[2], v0[3]), cvt_pk(v1[0], v1[1]), cvt_pk(v1[2], v1[3])};
                    if (u.pn * 256 + wc * 64 + bj * 32 + fq * 8 == gbase) { *(f32x4*)(G + (rg + fr) * 8) = v0; *(f32x4*)(G + (rg + fr) * 8 + 4) = v1; }
                }
                perm_store(P + (rg + r8) * NPAD + u.pn * 256 + wc * 64 + hi * 32 + fq * 8, (size_t)8 * NPAD, pk[0], pk[1], hi);
            }
    }
};
struct EpiMoe2 {
    static constexpr bool SPLIT = false; static constexpr int NQ = 4, NST = 16;
    bf16_t* Y;
    template <int ai, int bj> __device__ __forceinline__ void part_cond(const f32x4 (&acc)[2][2][4][2], const g8::Unit& u, int wr, int wc, int fr, int fq, int flag) const {}
    __device__ __forceinline__ void tail(const f32x4 (&acc)[2][2][4][2], const g8::Unit& u, int wr, int wc, int fr, int fq) const {}
    __device__ __forceinline__ void operator()(const f32x4 (&acc)[2][2][4][2], const g8::Unit& u, int wr, int wc, int fr, int fq) const {
        const int hi = fr >> 3, r8 = fr & 7;
#pragma unroll
        for (int ai = 0; ai < 2; ++ai)
#pragma unroll
            for (int m = 0; m < 4; ++m) {
                const size_t rg = (size_t)u.pm * RBR + ai * 128 + wr * 64 + m * 16;
                u32x4 pk[2];
#pragma unroll
                for (int bj = 0; bj < 2; ++bj) {
                    const f32x4 v0 = acc[ai][bj][m][0], v1 = acc[ai][bj][m][1];
                    pk[bj] = (u32x4){cvt_pk(v0[0], v0[1]), cvt_pk(v0[2], v0[3]), cvt_pk(v1[0], v1[1]), cvt_pk(v1[2], v1[3])};
                }
                perm_store<true>(Y + (rg + r8) * 1024 + u.pn * 256 + wc * 64 + hi * 32 + fq * 8, (size_t)8 * 1024, pk[0], pk[1], hi);
            }
    }
};
struct EpiOut {
    static constexpr bool SPLIT = false; static constexpr int NQ = 8, NST = 32;
    template <int ai, int bj> __device__ __forceinline__ void part_cond(const f32x4 (&acc)[2][2][4][2], const g8::Unit& u, int wr, int wc, int fr, int fq, int flag) const {}
    __device__ __forceinline__ void tail(const f32x4 (&acc)[2][2][4][2], const g8::Unit& u, int wr, int wc, int fr, int fq) const {}
    const bf16_t* xres; bf16_t* Y;
    __device__ __forceinline__ void operator()(const f32x4 (&acc)[2][2][4][2], const g8::Unit& u, int wr, int wc, int fr, int fq) const {
        const int hi = fr >> 3, r8 = fr & 7;
#pragma unroll
        for (int ai = 0; ai < 2; ++ai)
#pragma unroll
            for (int m = 0; m < 4; ++m) {
                const size_t rg = (size_t)u.pm * 256 + ai * 128 + wr * 64 + m * 16;
                u32x4 pk[2];
#pragma unroll
                for (int bj = 0; bj < 2; ++bj) {
                    const u32x4 xr = *(const u32x4*)(xres + (rg + fr) * 1024 + u.pn * 256 + wc * 64 + bj * 32 + fq * 8);
                    float f[8]; unpack8(xr, f);
                    const f32x4 v0 = acc[ai][bj][m][0], v1 = acc[ai][bj][m][1];
                    pk[bj] = (u32x4){cvt_pk(f[0] * ALPHA + v0[0], f[1] * ALPHA + v0[1]), cvt_pk(f[2] * ALPHA + v0[2], f[3] * ALPHA + v0[3]),
                                     cvt_pk(f[4] * ALPHA + v1[0], f[5] * ALPHA + v1[1]), cvt_pk(f[6] * ALPHA + v1[2], f[7] * ALPHA + v1[3])};
                }
                perm_store(Y + (rg + r8) * 1024 + u.pn * 256 + wc * 64 + hi * 32 + fq * 8, (size_t)8 * 1024, pk[0], pk[1], hi);
                asm volatile("" ::: "memory");
            }
    }
};

constexpr int TS_RS = 272;
__device__ __forceinline__ void tile_put(const Ctx& c, int row_l, int col_l, const u32x2 v) { *(u32x2*)(c.smem + row_l * TS_RS + col_l * 2) = v; }
template <int NCOL>
__device__ __forceinline__ void tile_flush(const Ctx& c, bf16_t* out, size_t ld, bool valid) {
    __syncthreads();
    constexpr int CPR = NCOL / 8, PER = (128 * CPR) / 256;
#pragma unroll
    for (int i = 0; i < PER; ++i) {
        const int idx = c.tid + 256 * i, row = idx / CPR, ch = idx % CPR;
        const u32x4 v = *(const u32x4*)(c.smem + row * TS_RS + ch * 16);
        if (valid) *(u32x4*)(out + (size_t)row * ld + ch * 8) = v;
    }
    __syncthreads();
}

__device__ __forceinline__ void conv_family(const float* src, int nmat, size_t src_stride, int K, int N, int Nout,
                            bf16_t* dst, size_t dst_stride, int grp, int kind, const Ctx& c) {
    float* lds = (float*)c.smem;
    const int tk = K / 128, tn = Nout / 64, per = tk * tn, total = nmat * per;
    const int tx = c.tid & 15, ty = c.tid >> 4;
    f32x4 r[8];
#define CV_LOAD(u_) do { const int mat_ = (u_) / per, r_ = (u_) - mat_ * per, kt_ = r_ / tn, nt_ = r_ - kt_ * tn; \
        const float* s_ = src + (size_t)mat_ * src_stride + (size_t)(kt_ * 128 + ty) * N + nt_ * 64 + tx * 4; const bool in_ = (nt_ * 64 + tx * 4) < N; \
        _Pragma("unroll") for (int i = 0; i < 8; ++i) r[i] = in_ ? __builtin_nontemporal_load((const f32x4*)(s_ + (size_t)(16 * i) * N)) : (f32x4){0.f, 0.f, 0.f, 0.f}; } while (0)
    if (c.bid < total) CV_LOAD(c.bid);
    for (int base = 0; base < total; base += c.nblk) {
        const int u = base + c.bid; const bool valid = u < total;
#pragma unroll
        for (int i = 0; i < 8; ++i) *(f32x4*)(lds + (ty + 16 * i) * 68 + tx * 4) = r[i];
        if (u + c.nblk < total) CV_LOAD(u + c.nblk);
        __syncthreads();
        if (valid) {
        const int mat = u / per, rr = u - mat * per, kt = rr / tn, nt = rr - kt * tn;
        const int dmat = grp ? (mat / grp) * (grp + 1) + (mat % grp) : mat;
        bf16_t* d = dst + (size_t)dmat * dst_stride;
        const int nl = c.tid & 63, kq = (c.tid >> 6) * 32;
        unsigned w[16];
#pragma unroll
        for (int j = 0; j < 16; ++j) w[j] = pk2(lds[(kq + 2 * j) * 68 + nl], lds[(kq + 2 * j + 1) * 68 + nl]);
        const int n = nt * 64 + nl;
        const int drow = (kind == 0) ? n : ((n >> 4) * 32 + (n & 15) + (kind == 2 ? 16 : 0));
        u32x4* dp = (u32x4*)(d + (size_t)drow * K + kt * 128 + kq);
        dp[0] = (u32x4){w[0], w[1], w[2], w[3]}; dp[1] = (u32x4){w[4], w[5], w[6], w[7]};
        dp[2] = (u32x4){w[8], w[9], w[10], w[11]}; dp[3] = (u32x4){w[12], w[13], w[14], w[15]};
        }
        __syncthreads();
    }
#undef CV_LOAD
}

__device__ __forceinline__ void phase_prologue(const Args& a, const Ctx& c) {
    unsigned char* ws = a.ws;
    bf16_t* WIN = (bf16_t*)(ws + WS_WIN);
    conv_family((const float*)a.in[2], 2, (size_t)1024 * 2472, 1024, 2472, NPAD, WIN, 2 * WIN_ELEMS, 0, 0, c);
    conv_family((const float*)a.in[12], 2, (size_t)1024 * 2312, 1024, 2312, NPAD, WIN + WIN_ELEMS, 2 * WIN_ELEMS, 0, 0, c);
    conv_family((const float*)a.in[4], 2, (size_t)256 * 768, 256, 768, 768, (bf16_t*)(ws + WS_WQB), WQB_ELEMS, 0, 0, c);
    conv_family((const float*)a.in[6], 2, (size_t)128 * 1024, 128, 1024, 1024, (bf16_t*)(ws + WS_WKVB), WKVB_ELEMS, 0, 0, c);
    bf16_t* WOUT = (bf16_t*)(ws + WS_WOUT);
    conv_family((const float*)a.in[11], 2, (size_t)1024 * 1024, 1024, 1024, 1024, WOUT, 2 * WOUT_ELEMS, 0, 0, c);
    conv_family((const float*)a.in[17], 2, (size_t)1024 * 1024, 1024, 1024, 1024, WOUT + WOUT_ELEMS, 2 * WOUT_ELEMS, 0, 0, c);
    conv_family((const float*)a.in[20], 4, (size_t)1024 * 64, 1024, 64, 128, (bf16_t*)(ws + WS_WRT), WRT_ELEMS, 0, 0, c);
    bf16_t* WGU = (bf16_t*)(ws + WS_WGU);
    conv_family((const float*)a.in[22], 256, (size_t)1024 * 256, 1024, 256, 256, WGU, WGU_ELEMS, 64, 1, c);
    conv_family((const float*)a.in[23], 256, (size_t)1024 * 256, 1024, 256, 256, WGU, WGU_ELEMS, 64, 2, c);
    conv_family((const float*)a.in[25], 4, (size_t)1024 * 256, 1024, 256, 256, WGU + 64 * WGU_ELEMS, 65 * WGU_ELEMS, 0, 1, c);
    conv_family((const float*)a.in[26], 4, (size_t)1024 * 256, 1024, 256, 256, WGU + 64 * WGU_ELEMS, 65 * WGU_ELEMS, 0, 2, c);
    bf16_t* WDN = (bf16_t*)(ws + WS_WDN);
    conv_family((const float*)a.in[24], 256, (size_t)256 * 1024, 256, 1024, 1024, WDN, WDN_ELEMS, 64, 0, c);
    conv_family((const float*)a.in[27], 4, (size_t)256 * 1024, 256, 1024, 1024, WDN + 64 * WDN_ELEMS, 65 * WDN_ELEMS, 0, 0, c);
    {
        const float* x = (const float*)a.in[0]; bf16_t* xb = (bf16_t*)(ws + WS_XBF);
        const size_t n8 = (size_t)T * 1024 / 8;
        for (size_t i = (size_t)c.bid * 256 + c.tid; i < n8; i += (size_t)c.nblk * 256) {
            const f32x4 v0 = __builtin_nontemporal_load((const f32x4*)(x + i * 8)), v1 = __builtin_nontemporal_load((const f32x4*)(x + i * 8 + 4));
            *(u32x4*)(xb + i * 8) = (u32x4){pk2(v0[0], v0[1]), pk2(v0[2], v0[3]), pk2(v1[0], v1[1]), pk2(v1[2], v1[3])};
        }
    }
    {
        const int* pos = (const int*)a.in[1];
        float* rm = (float*)(ws + WS_ROPEM); float* rs = (float*)(ws + WS_ROPES);
        const float ln_theta = 9.210340371976184f;
        for (int i = c.bid * 256 + c.tid; i < T * 16; i += c.nblk * 256) {
            const int t = i >> 4, f = i & 15;
            const float inv = expf(-((float)(2 * f) / 32.f) * ln_theta);
            const float ang = (float)pos[t] * inv;
            rm[i * 2] = cosf(ang); rm[i * 2 + 1] = sinf(ang);
        }
        for (int i = c.bid * 256 + c.tid; i < T * 32; i += c.nblk * 256) {
            const int t = i >> 5, f = i & 31;
            const float inv = expf(-((float)(2 * f) / 64.f) * ln_theta);
            const float ang = (float)pos[t] * inv;
            rs[i * 2] = cosf(ang); rs[i * 2 + 1] = sinf(ang);
        }
    }
}

__device__ __forceinline__ void phase_inproj(const bf16_t* XBF, const bf16_t* W, bf16_t* PROJ, float* GATES, int gbase, const Ctx& c) {
    const int ntn = NPAD / 128;
    for (int i = 0;; ++i) {
        int mt, nt; bool valid; if (!tile_map2(i, c, T / 128, ntn, mt, nt, valid)) break;
        const bf16_t* a0 = XBF + (size_t)(mt * 128 + (c.tid >> 2)) * 1024;
        const bf16_t* b0 = W + (size_t)(nt * 128 + (c.tid >> 2)) * 1024;
        f32x4 acc[4][4];
        gemm_tile(a0, a0 + 64 * 1024, b0, b0 + 64 * 1024, 32, acc, c);
#pragma unroll
        for (int m = 0; m < 4; ++m) {
            const int rl = c.wr * 64 + m * 16 + c.fr, row = mt * 128 + rl;
#pragma unroll
            for (int n = 0; n < 4; ++n) {
                const int cl = c.wc * 64 + n * 16 + c.fq * 4, col = nt * 128 + cl;
                const f32x4 v = acc[m][n];
                tile_put(c, rl, cl, (u32x2){pk2(v[0], v[1]), pk2(v[2], v[3])});
                if (valid && col >= gbase && col < gbase + 8) *(f32x4*)(GATES + (size_t)row * 8 + (col - gbase)) = v;
            }
        }
        tile_flush<128>(c, PROJ + (size_t)mt * 128 * NPAD + nt * 128, NPAD, valid);
    }
}

constexpr int MLAUP_TILES = (T / 128) * 6 + (T / 128) * 8;
__device__ __forceinline__ void mla_up_tile(int u, const bf16_t* CQ, const bf16_t* WQB, const bf16_t* CKV, const bf16_t* WKVB,
                             const float* ROPEM, bf16_t* QF, bf16_t* KN, bf16_t* VV, const Ctx& c) {
    const int tq = (T / 128) * 6;
    const float qscale = 0.10206207261596577f * 1.4426950408889634f;
    {
        f32x4 acc[4][4];
        if (u < tq) {
            const int mt = u / 6, nt = u % 6;
            const bf16_t* a0 = CQ + (size_t)(mt * 128 + (c.tid >> 2)) * 256;
            const bf16_t* b0 = WQB + (size_t)(nt * 128 + (c.tid >> 2)) * 256;
            gemm_tile(a0, a0 + 64 * 256, b0, b0 + 64 * 256, 8, acc, c);
#pragma unroll
            for (int m = 0; m < 4; ++m) {
                const int row = mt * 128 + c.wr * 64 + m * 16 + c.fr;
#pragma unroll
                for (int np = 0; np < 2; ++np) {
                    const int cg = nt * 128 + c.wc * 64 + np * 32;
                    f32x4 v0 = acc[m][2 * np], v1 = acc[m][2 * np + 1];
                    if (((cg >> 5) % 3) == 2) {
#pragma unroll
                        for (int j = 0; j < 4; ++j) {
                            const int i = c.fq * 4 + j;
                            const float cs = ROPEM[((size_t)row * 16 + i) * 2], sn = ROPEM[((size_t)row * 16 + i) * 2 + 1];
                            const float x1 = v0[j], x2 = v1[j];
                            v0[j] = x1 * cs - x2 * sn; v1[j] = x2 * cs + x1 * sn;
                        }
                    }
                    v0 *= qscale; v1 *= qscale;
                    *(u32x2*)(QF + (size_t)row * 768 + cg + c.fq * 4) = (u32x2){pk2(v0[0], v0[1]), pk2(v0[2], v0[3])};
                    *(u32x2*)(QF + (size_t)row * 768 + cg + 16 + c.fq * 4) = (u32x2){pk2(v1[0], v1[1]), pk2(v1[2], v1[3])};
                }
            }
        } else {
            const int v = u - tq, mt = v / 8, nt = v % 8;
            const bf16_t* a0 = CKV + (size_t)(mt * 128 + (c.tid >> 2)) * 128;
            const bf16_t* b0 = WKVB + (size_t)(nt * 128 + (c.tid >> 2)) * 128;
            gemm_tile(a0, a0 + 64 * 128, b0, b0 + 64 * 128, 4, acc, c);
            bf16_t* dst = (c.wc == 0) ? KN : VV;
#pragma unroll
            for (int m = 0; m < 4; ++m) {
                const int row = mt * 128 + c.wr * 64 + m * 16 + c.fr;
#pragma unroll
                for (int n = 0; n < 4; ++n) {
                    const f32x4 x = acc[m][n];
                    *(u32x2*)(dst + (size_t)row * 512 + nt * 64 + n * 16 + c.fq * 4) = (u32x2){pk2(x[0], x[1]), pk2(x[2], x[3])};
                }
            }
        }
    }
}

__device__ __forceinline__ void phase_outproj(const bf16_t* MIXO, const bf16_t* W, const float* xres, float* YBUF, const Ctx& c) {
    for (int i = 0;; ++i) {
        int mt, nt; bool valid; if (!tile_map2(i, c, T / 128, 8, mt, nt, valid)) break;
        const bf16_t* a0 = MIXO + (size_t)(mt * 128 + (c.tid >> 2)) * 1024;
        const bf16_t* b0 = W + (size_t)(nt * 128 + (c.tid >> 2)) * 1024;
        f32x4 acc[4][4];
        gemm_tile(a0, a0 + 64 * 1024, b0, b0 + 64 * 1024, 32, acc, c);
#pragma unroll
        for (int m = 0; m < 4; ++m) {
            const int row = mt * 128 + c.wr * 64 + m * 16 + c.fr;
#pragma unroll
            for (int n = 0; n < 4; ++n) {
                const int col = nt * 128 + c.wc * 64 + n * 16 + c.fq * 4;
                const f32x4 xr = *(const f32x4*)(xres + (size_t)row * 1024 + col);
                if (valid) *(f32x4*)(YBUF + (size_t)row * 1024 + col) = xr * ALPHA + acc[m][n];
            }
        }
    }
}

__device__ __forceinline__ void phase_router(const bf16_t* XBF, const bf16_t* W, float* LOG, const Ctx& c) {
    for (int base = 0; base < T / 128; base += c.nblk) {
        const bool valid = (base + c.bid) < T / 128; const int mt = valid ? base + c.bid : 0;
        const bf16_t* a0 = XBF + (size_t)(mt * 128 + (c.tid >> 2)) * 1024;
        const bf16_t* b0 = W + (size_t)(c.tid >> 2) * 1024;
        f32x4 acc[4][4];
        gemm_tile(a0, a0 + 64 * 1024, b0, b0 + 64 * 1024, 32, acc, c);
        if (c.wc == 0 && valid) {
#pragma unroll
            for (int m = 0; m < 4; ++m) {
                const int row = mt * 128 + c.wr * 64 + m * 16 + c.fr;
#pragma unroll
                for (int n = 0; n < 4; ++n) *(f32x4*)(LOG + (size_t)row * 64 + n * 16 + c.fq * 4) = acc[m][n];
            }
        }
    }
}

__device__ __forceinline__ void build_block_table(const unsigned* CNT, int* bst, const Ctx& c) {
    __syncthreads();
    if (c.wid == 0) {
        const int cnt = (int)__hip_atomic_load(CNT + c.lane, __ATOMIC_RELAXED, __HIP_MEMORY_SCOPE_AGENT);
        const int nb = (cnt + RBR - 1) / RBR;
        int inc = nb;
#pragma unroll
        for (int o = 1; o < 64; o <<= 1) { const int x = shfl_up_(inc, o); if (c.lane >= o) inc += x; }
        bst[c.lane] = inc - nb; bst[66 + c.lane] = cnt;
        if (c.lane == 63) { bst[64] = inc; bst[65] = inc + T / RBR; bst[66 + 64] = T; }
    }
    __syncthreads();
}
__device__ __forceinline__ int find_expert(const int* bst, int rb, const Ctx& c) {
    return __popcll(__ballot(bst[1 + c.lane] <= rb));
}

__device__ __forceinline__ void phase_moe1(const bf16_t* XBF, const bf16_t* WGU, const unsigned* CNT, const int* LTOK, const float* LW, bf16_t* HBUF, const Ctx& c) {
    int* bst = (int*)(c.smem + 65536 + 64);
    build_block_table(CNT, bst, c);
    const int nsb = bst[65] * 2;
    for (int i = 0;; ++i) {
        int sbk, nt; bool valid; if (!tile_map2(i, c, nsb, 4, sbk, nt, valid)) break;
        const int rb = sbk >> 1, hb = sbk & 1;
        const int e = find_expert(bst, rb, c);
        const int lb = rb - bst[e], cnt = bst[66 + e];
        const int p0 = lb * RBR + hb * 128 + (c.tid >> 2), p1 = p0 + 64;
        const int t0 = (p0 < cnt) ? LTOK[(size_t)e * CAP + p0] : 0;
        const int t1 = (p1 < cnt) ? LTOK[(size_t)e * CAP + p1] : 0;
        const bf16_t* a0 = XBF + (size_t)t0 * 1024;
        const bf16_t* a1 = XBF + (size_t)t1 * 1024;
        const bf16_t* b0 = WGU + (size_t)e * WGU_ELEMS + (size_t)(nt * 128 + (c.tid >> 2)) * 1024;
        f32x4 acc[4][4];
        gemm_tile(a0, a1, b0, b0 + 64 * 1024, 32, acc, c);
#pragma unroll
        for (int m = 0; m < 4; ++m) {
            const int rl = c.wr * 64 + m * 16 + c.fr;
            const int pw = lb * RBR + hb * 128 + rl;
            const float wrow = (pw < cnt) ? LW[(size_t)e * CAP + pw] : 0.f;
#pragma unroll
            for (int n = 0; n < 2; ++n) {
                const f32x4 g = acc[m][n], up = acc[m][n + 2];
                float h[4];
#pragma unroll
                for (int j = 0; j < 4; ++j) h[j] = siluf_(g[j]) * up[j] * wrow;
                tile_put(c, rl, c.wc * 32 + n * 16 + c.fq * 4, (u32x2){pk2(h[0], h[1]), pk2(h[2], h[3])});
            }
        }
        tile_flush<64>(c, HBUF + ((size_t)rb * RBR + hb * 128) * 256 + nt * 64, 256, valid);
    }
}

__device__ __forceinline__ void phase_moe2(const bf16_t* HBUF, const bf16_t* WDN, const unsigned* CNT, bf16_t* Y, const Ctx& c) {
    int* bst = (int*)(c.smem + 65536 + 64);
    build_block_table(CNT, bst, c);
    const int nsb = bst[65] * 2;
    for (int i = 0;; ++i) {
        int sbk, nt; bool valid; if (!tile_map2(i, c, nsb, 8, sbk, nt, valid)) break;
        const int rb = sbk >> 1;
        const int e = find_expert(bst, rb, c);
        const bf16_t* a0 = HBUF + ((size_t)sbk * 128 + (c.tid >> 2)) * 256;
        const bf16_t* b0 = WDN + (size_t)e * WDN_ELEMS + (size_t)(nt * 128 + (c.tid >> 2)) * 256;
        f32x4 acc[4][4];
        gemm_tile(a0, a0 + 64 * 256, b0, b0 + 64 * 256, 8, acc, c);
#pragma unroll
        for (int m = 0; m < 4; ++m) {
            const int lr = c.wr * 64 + m * 16 + c.fr;
#pragma unroll
            for (int n = 0; n < 4; ++n) {
                const f32x4 v = acc[m][n];
                tile_put(c, lr, c.wc * 64 + n * 16 + c.fq * 4, (u32x2){pk2(v[0], v[1]), pk2(v[2], v[3])});
            }
        }
        tile_flush<128>(c, Y + (size_t)sbk * 128 * 1024 + nt * 128, 1024, valid);
    }
}

__device__ __forceinline__ float dppf(float v, int ctrl_sel) {
    int x = __builtin_bit_cast(int, v), r;
    if (ctrl_sel == 0) r = __builtin_amdgcn_update_dpp(0, x, 0xB1, 0xF, 0xF, true);
    else if (ctrl_sel == 1) r = __builtin_amdgcn_update_dpp(0, x, 0x4E, 0xF, 0xF, true);
    else if (ctrl_sel == 2) r = __builtin_amdgcn_update_dpp(0, x, 0x141, 0xF, 0xF, true);
    else r = __builtin_amdgcn_update_dpp(0, x, 0x140, 0xF, 0xF, true);
    return __builtin_bit_cast(float, r);
}
__device__ __forceinline__ float red16(float v) { v += dppf(v, 0); v += dppf(v, 1); v += dppf(v, 2); v += dppf(v, 3); return v; }

template <bool F32OUT>
__device__ __forceinline__ void ln_row_store(float (&v)[16], const float* g, const float* b, float* of32, bf16_t* obf, int lane) {
    float s = 0.f;
#pragma unroll
    for (int i = 0; i < 16; ++i) s += v[i];
    const float mean = wave_sum(s) * (1.f / 1024.f);
    float q = 0.f;
#pragma unroll
    for (int i = 0; i < 16; ++i) { v[i] -= mean; q += v[i] * v[i]; }
    const float rstd = rsqrtf(wave_sum(q) * (1.f / 1024.f) + 1e-5f);
#pragma unroll
    for (int hf = 0; hf < 2; ++hf) {
        const int col = hf * 512 + lane * 8;
        const f32x4 g0 = *(const f32x4*)(g + col), g1 = *(const f32x4*)(g + col + 4);
        const f32x4 b0 = *(const f32x4*)(b + col), b1 = *(const f32x4*)(b + col + 4);
        f32x4 y0, y1;
#pragma unroll
        for (int j = 0; j < 4; ++j) { y0[j] = v[hf * 8 + j] * rstd * g0[j] + b0[j]; y1[j] = v[hf * 8 + 4 + j] * rstd * g1[j] + b1[j]; }
        if constexpr (F32OUT) { *(f32x4*)(of32 + col) = y0; *(f32x4*)(of32 + col + 4) = y1; }
        *(u32x4*)(obf + col) = (u32x4){pk2(y0[0], y0[1]), pk2(y0[2], y0[3]), pk2(y1[0], y1[1]), pk2(y1[2], y1[3])};
    }
}

__device__ __forceinline__ void phase_ln1(const bf16_t* YBUF, const float* g, const float* b, bf16_t* XBF, const Ctx& c) {
    for (int t = c.bid * 4 + c.wid; t < T; t += c.nblk * 4) {
        float v[16];
#pragma unroll
        for (int hf = 0; hf < 2; ++hf) {
            const u32x4 r = *(const u32x4*)(YBUF + (size_t)t * 1024 + hf * 512 + c.lane * 8);
            float f[8]; unpack8(r, f);
#pragma unroll
            for (int j = 0; j < 8; ++j) v[hf * 8 + j] = f[j];
        }
        ln_row_store<false>(v, g, b, nullptr, XBF + (size_t)t * 1024, c.lane);
    }
}

template <bool LASTL>
__device__ __forceinline__ void phase_combine(const bf16_t* Y, const int* ASG, const float* ASGW, const unsigned* CNT, const float* g, const float* b,
                              float* XOUT, bf16_t* XBF, const Ctx& c) {
    int* bst = (int*)(c.smem + 65536 + 64);
    build_block_table(CNT, bst, c);
    for (int t = c.bid * 4 + c.wid; t < T; t += c.nblk * 4) {
        float v[16];
#pragma unroll
        for (int hf = 0; hf < 2; ++hf) {
            const u32x4 r = *(const u32x4*)(XBF + (size_t)t * 1024 + hf * 512 + c.lane * 8);
            float f[8]; unpack8(r, f);
#pragma unroll
            for (int j = 0; j < 8; ++j) v[hf * 8 + j] = f[j] * ALPHA;
        }
#pragma unroll
        for (int k = 0; k < 9; ++k) {
            size_t crow; float wk = 1.f;
            if (k < 8) { const int asg = ASG[(size_t)t * 8 + k]; crow = (size_t)bst[asg >> 16] * RBR + (asg & 0xffff); wk = ASGW[(size_t)t * 8 + k]; }
            else crow = (size_t)bst[64] * RBR + t;
#pragma unroll
            for (int hf = 0; hf < 2; ++hf) {
                const u32x4 r = *(const u32x4*)(Y + crow * 1024 + hf * 512 + c.lane * 8);
                float f[8]; unpack8(r, f);
#pragma unroll
                for (int j = 0; j < 8; ++j) v[hf * 8 + j] += f[j] * wk;
            }
        }
        ln_row_store<LASTL>(v, g, b, XOUT + (size_t)t * 1024, XBF + (size_t)t * 1024, c.lane);
    }
}

__device__ __forceinline__ void phase_route(const float* LOG, const float* rb, unsigned* CNT, int* LTOK, float* LW, int* ASG, float* ASGW, const Ctx& c) {
    int* lcnt = (int*)c.smem;
    int* lbase = lcnt + 64;
    int* sel_e = lbase + 64;
    int* sel_p = sel_e + 256;
    float* sel_w = (float*)(sel_p + 256);
    const float rbias = rb[c.lane];
    for (int base = 0; base < T / 32; base += c.nblk) {
        const int ch = base + c.bid; const bool valid = ch < T / 32;
        __syncthreads();
        if (c.tid < 64) lcnt[c.tid] = 0;
        __syncthreads();
        if (valid) for (int tl = c.wid; tl < 32; tl += 4) {
            const int t = ch * 32 + tl;
            const float lg = LOG[(size_t)t * 64 + c.lane];
            const float sc = 1.f / (1.f + expf(-lg));
            const float v = sc + rbias;
            float m1 = v;
            m1 = fmaxf(m1, shfl_xor_(m1, 1)); m1 = fmaxf(m1, shfl_xor_(m1, 2)); m1 = fmaxf(m1, shfl_xor_(m1, 4));
            int cand = (v == m1) ? c.lane : 999;
            cand = min(cand, shfl_xor_(cand, 1)); cand = min(cand, shfl_xor_(cand, 2)); cand = min(cand, shfl_xor_(cand, 4));
            float m2 = (c.lane == cand) ? -INFINITY : v;
            m2 = fmaxf(m2, shfl_xor_(m2, 1)); m2 = fmaxf(m2, shfl_xor_(m2, 2)); m2 = fmaxf(m2, shfl_xor_(m2, 4));
            const float gs = m1 + m2;
            const int g = c.lane >> 3;
            int grank = 0;
#pragma unroll
            for (int gg = 0; gg < 8; ++gg) { const float o = shfl_c_(gs, gg * 8); grank += ((o > gs) || (o == gs && gg < g)) ? 1 : 0; }
            const bool gsel = grank < 4;
            const float mv = gsel ? v : -INFINITY;
            int rank = 0;
#pragma unroll 8
            for (int jj = 0; jj < 64; ++jj) { const float o = shfl_c_(mv, jj); rank += ((o > mv) || (o == mv && jj < c.lane)) ? 1 : 0; }
            const bool sel = gsel && rank < 8;
            const float ssum = wave_sum(sel ? sc : 0.f);
            const float w = sc / ssum * 2.5f;
            const unsigned long long bal = __ballot(sel);
            const int slot = __popcll(bal & ((1ull << c.lane) - 1ull));
            if (sel) {
                const int p = atomicAdd(&lcnt[c.lane], 1);
                sel_e[tl * 8 + slot] = c.lane; sel_p[tl * 8 + slot] = p; sel_w[tl * 8 + slot] = w;
            }
        }
        __syncthreads();
        if (valid && c.tid < 64) { const int n = lcnt[c.tid]; lbase[c.tid] = n ? (int)atomicAdd(CNT + c.tid, (unsigned)n) : 0; }
        __syncthreads();
        if (valid) {
            const int tl = c.tid >> 3, t = ch * 32 + tl;
            const int e = sel_e[c.tid], pos = lbase[e] + sel_p[c.tid];
            LTOK[(size_t)e * CAP + pos] = t; LW[(size_t)e * CAP + pos] = sel_w[c.tid];
            ASG[(size_t)t * 8 + (c.tid & 7)] = (e << 16) | pos; ASGW[(size_t)t * 8 + (c.tid & 7)] = sel_w[c.tid];
            if (c.tid < 32) { const int ts = ch * 32 + c.tid; LTOK[(size_t)64 * CAP + ts] = ts; LW[(size_t)64 * CAP + ts] = 1.f; }
        }
    }
}

__device__ __forceinline__ void phase_lnroute(const bf16_t* YBUF, const float* g, const float* b, bf16_t* XBF, const bf16_t* W, const float* rb,
                                              unsigned* CNT, int* LTOK, float* LW, int* ASG, float* ASGW, const Ctx& c) {
    unsigned char* xa = c.smem;
    int* lcnt = (int*)(c.smem + 65536 + 64);
    int* lbase = lcnt + 64;
    float* lgt = (float*)c.smem;
    int* sel_e = (int*)(c.smem + 8192);
    int* sel_p = sel_e + 256;
    float* sel_w = (float*)(sel_p + 256);
    const int lane = c.lane;
    const float rbias = rb[lane];
    for (int base = 0; base < T / 32; base += c.nblk) {
        const int ch = base + c.bid; const bool valid = ch < T / 32;
        __syncthreads();
        if (c.tid < 64) lcnt[c.tid] = 0;
        u32x4 raw[8][2];
#pragma unroll
        for (int i = 0; i < 8; ++i)
#pragma unroll
            for (int hf = 0; hf < 2; ++hf) raw[i][hf] = valid ? *(const u32x4*)(YBUF + (size_t)(ch * 32 + c.wid + 4 * i) * 1024 + hf * 512 + lane * 8) : (u32x4){0u, 0u, 0u, 0u};
        if (valid)
#pragma unroll
        for (int i = 0; i < 8; ++i) {
            const int tl = c.wid + 4 * i;
            const int t = ch * 32 + tl;
            float v[16];
#pragma unroll
            for (int hf = 0; hf < 2; ++hf) {
                float f[8]; unpack8(raw[i][hf], f);
#pragma unroll
                for (int j = 0; j < 8; ++j) v[hf * 8 + j] = f[j];
            }
            float s = 0.f;
#pragma unroll
            for (int i = 0; i < 16; ++i) s += v[i];
            const float mean = wave_sum(s) * (1.f / 1024.f);
            float q = 0.f;
#pragma unroll
            for (int i = 0; i < 16; ++i) { v[i] -= mean; q += v[i] * v[i]; }
            const float rstd = rsqrtf(wave_sum(q) * (1.f / 1024.f) + 1e-5f);
#pragma unroll
            for (int hf = 0; hf < 2; ++hf) {
                const int col = hf * 512 + lane * 8;
                const f32x4 g0 = *(const f32x4*)(g + col), g1 = *(const f32x4*)(g + col + 4);
                const f32x4 b0 = *(const f32x4*)(b + col), b1 = *(const f32x4*)(b + col + 4);
                f32x4 y0, y1;
#pragma unroll
                for (int j = 0; j < 4; ++j) { y0[j] = v[hf * 8 + j] * rstd * g0[j] + b0[j]; y1[j] = v[hf * 8 + 4 + j] * rstd * g1[j] + b1[j]; }
                const u32x4 pk = (u32x4){pk2(y0[0], y0[1]), pk2(y0[2], y0[3]), pk2(y1[0], y1[1]), pk2(y1[2], y1[3])};
                *(u32x4*)(XBF + (size_t)t * 1024 + col) = pk;
                *(u32x4*)(xa + tl * 2048 + (((hf * 64 + lane) ^ (tl & 15)) * 16)) = pk;
            }
        }
        __syncthreads();
        f32x4 acc0 = (f32x4){0.f, 0.f, 0.f, 0.f}, acc1 = (f32x4){0.f, 0.f, 0.f, 0.f};
        {
            const int r = lane & 15, kq = lane >> 4;
            const bf16_t* wrow = W + (size_t)(c.wid * 16 + r) * 1024 + kq * 8;
#pragma unroll 1
            for (int kb = 0; kb < 32; kb += 8) {
                bf16x8 bfr[8];
#pragma unroll
                for (int j = 0; j < 8; ++j) bfr[j] = *(const bf16x8*)(wrow + (kb + j) * 32);
#pragma unroll
                for (int j = 0; j < 8; ++j) {
                    const int chunk = ((kb + j) * 4 + kq) ^ r;
                    const bf16x8 a0 = *(const bf16x8*)(xa + r * 2048 + chunk * 16), a1 = *(const bf16x8*)(xa + (16 + r) * 2048 + chunk * 16);
                    acc0 = __builtin_amdgcn_mfma_f32_16x16x32_bf16(a0, bfr[j], acc0, 0, 0, 0);
                    acc1 = __builtin_amdgcn_mfma_f32_16x16x32_bf16(a1, bfr[j], acc1, 0, 0, 0);
                }
            }
        }
        __syncthreads();
        {
            const int e = c.wid * 16 + (lane & 15), r0 = 4 * (lane >> 4);
#pragma unroll
            for (int j = 0; j < 4; ++j) { lgt[(r0 + j) * 64 + e] = acc0[j]; lgt[(16 + r0 + j) * 64 + e] = acc1[j]; }
        }
        __syncthreads();
        if (valid) for (int tl = c.wid; tl < 32; tl += 4) {
            const float lg = lgt[tl * 64 + lane];
            const float sc = 1.f / (1.f + expf(-lg));
            const float v = sc + rbias;
            float m1 = v;
            m1 = fmaxf(m1, shfl_xor_(m1, 1)); m1 = fmaxf(m1, shfl_xor_(m1, 2)); m1 = fmaxf(m1, shfl_xor_(m1, 4));
            int cand = (v == m1) ? lane : 999;
            cand = min(cand, shfl_xor_(cand, 1)); cand = min(cand, shfl_xor_(cand, 2)); cand = min(cand, shfl_xor_(cand, 4));
            float m2 = (lane == cand) ? -INFINITY : v;
            m2 = fmaxf(m2, shfl_xor_(m2, 1)); m2 = fmaxf(m2, shfl_xor_(m2, 2)); m2 = fmaxf(m2, shfl_xor_(m2, 4));
            const float gs = m1 + m2;
            const int gi = lane >> 3;
            int grank = 0;
#pragma unroll
            for (int gg = 0; gg < 8; ++gg) { const float o = shfl_c_(gs, gg * 8); grank += ((o > gs) || (o == gs && gg < gi)) ? 1 : 0; }
            const bool gsel = grank < 4;
            const float mv = gsel ? v : -INFINITY;
            int rank = 0;
#pragma unroll 8
            for (int jj = 0; jj < 64; ++jj) { const float o = shfl_c_(mv, jj); rank += ((o > mv) || (o == mv && jj < lane)) ? 1 : 0; }
            const bool sel = gsel && rank < 8;
            const float ssum = wave_sum(sel ? sc : 0.f);
            const float w = sc / ssum * 2.5f;
            const unsigned long long bal = __ballot(sel);
            const int slot = __popcll(bal & ((1ull << lane) - 1ull));
            if (sel) {
                const int p = atomicAdd(&lcnt[lane], 1);
                sel_e[tl * 8 + slot] = lane; sel_p[tl * 8 + slot] = p; sel_w[tl * 8 + slot] = w;
            }
        }
        __syncthreads();
        if (valid && c.tid < 64) { const int n = lcnt[c.tid]; lbase[c.tid] = n ? (int)atomicAdd(CNT + c.tid, (unsigned)n) : 0; }
        __syncthreads();
        if (valid) {
            const int tl = c.tid >> 3, t = ch * 32 + tl;
            const int e = sel_e[c.tid], pos = lbase[e] + sel_p[c.tid];
            LTOK[(size_t)e * CAP + pos] = t; LW[(size_t)e * CAP + pos] = sel_w[c.tid];
            ASG[(size_t)t * 8 + (c.tid & 7)] = (e << 16) | pos; ASGW[(size_t)t * 8 + (c.tid & 7)] = sel_w[c.tid];
            if (c.tid < 32) { const int ts = ch * 32 + c.tid; LTOK[(size_t)64 * CAP + ts] = ts; LW[(size_t)64 * CAP + ts] = 1.f; }
        }
    }
}

__device__ __forceinline__ void phase_prep_even(const bf16_t* PROJ, const float* GATES, const float* qn, const float* kvn, const float* cw,
                                const float* a_log, const float* dt_bias, const float* ROPEM,
                                bf16_t* CQ, bf16_t* CKV, bf16_t* KROPE, bf16_t* GQ, bf16_t* GK, bf16_t* GV, float* BETA, float* GLOG, const Ctx& c) {
    const int lane = c.lane;
    float* cwL = (float*)c.smem;
    __syncthreads();
    for (int i = c.tid; i < 4 * 1536 / 4; i += 256) *(f32x4*)(cwL + i * 4) = *(const f32x4*)(cw + i * 4);
    __syncthreads();
    for (int tb = (c.bid * 4 + c.wid) * 8; tb < T; tb += c.nblk * 4 * 8) {
        const int s0 = tb & (SEQ - 1);
        u32x4 xr[3][4];
#pragma unroll
        for (int arr = 0; arr < 3; ++arr)
#pragma unroll
            for (int w = 0; w < 3; ++w)
                xr[arr][w] = (s0 - 3 + w >= 0) ? *(const u32x4*)(PROJ + (size_t)(tb - 3 + w) * NPAD + 416 + arr * 512 + lane * 8) : (u32x4){0u, 0u, 0u, 0u};
        u32x4 nx[3]; u32x2 ncq; unsigned nckv; float nk1 = 0.f, nk2 = 0.f, ncs = 0.f, nsn = 0.f, ngate = 0.f;
#define PE_LOAD(t_) do { const bf16_t* pr_ = PROJ + (size_t)(t_) * NPAD; \
            _Pragma("unroll") for (int arr = 0; arr < 3; ++arr) nx[arr] = *(const u32x4*)(pr_ + 416 + arr * 512 + lane * 8); \
            ncq = *(const u32x2*)(pr_ + lane * 4); nckv = *(const unsigned*)(pr_ + 256 + lane * 2); \
            if (lane < 16) { nk1 = bf2f(pr_[384 + lane]); nk2 = bf2f(pr_[400 + lane]); ncs = ROPEM[((size_t)(t_) * 16 + lane) * 2]; nsn = ROPEM[((size_t)(t_) * 16 + lane) * 2 + 1]; } \
            if (lane < 8) ngate = GATES[(size_t)(t_) * 8 + lane]; } while (0)
        PE_LOAD(tb);
#pragma unroll
        for (int k = 0; k < 8; ++k) {
            const int t = tb + k;
#pragma unroll
            for (int arr = 0; arr < 3; ++arr) xr[arr][3] = nx[arr];
            const u32x2 r = ncq; const unsigned rkv = nckv; const float x1 = nk1, x2 = nk2, cs = ncs, sn = nsn, gate = ngate;
            if (k < 7) PE_LOAD(t + 1);
            {
                float v[4] = {bflo(r.x), bfhi(r.x), bflo(r.y), bfhi(r.y)};
                const float ss = wave_sum(v[0] * v[0] + v[1] * v[1] + v[2] * v[2] + v[3] * v[3]);
                const float rr = rsqrtf(ss * (1.f / 256.f) + 1e-6f);
                const f32x4 gq = *(const f32x4*)(qn + lane * 4);
                *(u32x2*)(CQ + (size_t)t * 256 + lane * 4) = (u32x2){pk2(v[0] * rr * gq[0], v[1] * rr * gq[1]), pk2(v[2] * rr * gq[2], v[3] * rr * gq[3])};
            }
            {
                const float v0 = bflo(rkv), v1 = bfhi(rkv);
                const float ss = wave_sum(v0 * v0 + v1 * v1);
                const float rr = rsqrtf(ss * (1.f / 128.f) + 1e-6f);
                *(unsigned*)(CKV + (size_t)t * 128 + lane * 2) = pk2(v0 * rr * kvn[lane * 2], v1 * rr * kvn[lane * 2 + 1]);
            }
            if (lane < 16) {
                KROPE[(size_t)t * 32 + lane] = (bf16_t)f2bf(x1 * cs - x2 * sn);
                KROPE[(size_t)t * 32 + 16 + lane] = (bf16_t)f2bf(x2 * cs + x1 * sn);
            }
#pragma unroll
            for (int arr = 0; arr < 3; ++arr) {
                float y[8];
#pragma unroll
                for (int j = 0; j < 8; ++j) y[j] = 0.f;
#pragma unroll
                for (int w = 0; w < 4; ++w) {
                    float f[8]; unpack8(xr[arr][w], f);
                    const f32x4 c0 = *(const f32x4*)(cwL + w * 1536 + arr * 512 + lane * 8), c1 = *(const f32x4*)(cwL + w * 1536 + arr * 512 + lane * 8 + 4);
#pragma unroll
                    for (int j = 0; j < 4; ++j) { y[j] += c0[j] * f[j]; y[4 + j] += c1[j] * f[4 + j]; }
                }
                float ss = 0.f;
#pragma unroll
                for (int j = 0; j < 8; ++j) { y[j] = siluf_(y[j]); ss += y[j] * y[j]; }
                if (arr < 2) {
                    float rr = rsqrtf(red16(ss) + 1e-6f);
                    if (arr == 0) rr *= 0.08838834764831845f;
#pragma unroll
                    for (int j = 0; j < 8; ++j) y[j] *= rr;
                }
                bf16_t* dst = (arr == 0) ? GQ : (arr == 1) ? GK : GV;
                *(u32x4*)(dst + (size_t)t * 512 + lane * 8) = (u32x4){pk2(y[0], y[1]), pk2(y[2], y[3]), pk2(y[4], y[5]), pk2(y[6], y[7])};
                xr[arr][0] = xr[arr][1]; xr[arr][1] = xr[arr][2]; xr[arr][2] = xr[arr][3];
            }
            if (lane < 4) BETA[(size_t)t * 4 + lane] = sigmoidf_(gate);
            else if (lane < 8) { const int h = lane - 4; GLOG[(size_t)t * 4 + h] = -expf(a_log[h]) * softplusf_(gate + dt_bias[h]); }
        }
#undef PE_LOAD
    }
}

__device__ __forceinline__ void phase_prep_odd(const bf16_t* PROJ, const float* ROPES, bf16_t* SQ, bf16_t* SK, const Ctx& c) {
    const int lane = c.lane;
    for (int t = c.bid * 4 + c.wid; t < T; t += c.nblk * 4) {
        const bf16_t* pr = PROJ + (size_t)t * NPAD;
        const int i = lane & 31;
        const float cs = ROPES[((size_t)t * 32 + i) * 2], sn = ROPES[((size_t)t * 32 + i) * 2 + 1];
#pragma unroll
        for (int r = 0; r < 4; ++r) {
            const int h = (lane >> 5) + 2 * r;
            const float x1 = bf2f(pr[1544 + h * 64 + i]), x2 = bf2f(pr[1544 + h * 64 + 32 + i]);
            SQ[(size_t)t * 512 + h * 64 + i] = (bf16_t)f2bf((x1 * cs - x2 * sn) * 0.18033688011112042f);
            SQ[(size_t)t * 512 + h * 64 + 32 + i] = (bf16_t)f2bf((x2 * cs + x1 * sn) * 0.18033688011112042f);
        }
        {
            const int h = lane >> 5;
            const float x1 = bf2f(pr[2056 + h * 64 + i]), x2 = bf2f(pr[2056 + h * 64 + 32 + i]);
            SK[(size_t)t * 128 + h * 64 + i] = (bf16_t)f2bf(x1 * cs - x2 * sn);
            SK[(size_t)t * 128 + h * 64 + 32 + i] = (bf16_t)f2bf(x2 * cs + x1 * sn);
        }
    }
}

__device__ __forceinline__ int next_unit(unsigned* ctr, const Ctx& c) {
    volatile int* su = (volatile int*)(c.smem0 + LDS_BLK + 16);
    __syncthreads();
    if (c.tid0 == 0) *su = (int)atomicAdd(ctr, 1u);
    __syncthreads();
    return *su * 2 + c.half;
}

typedef float f32x16 __attribute__((ext_vector_type(16)));
typedef short s16x4 __attribute__((ext_vector_type(4)));
#define MFMA32(a, b, c) __builtin_amdgcn_mfma_f32_32x32x16_bf16((a), (b), (c), 0, 0, 0)
template <int S_> __device__ __forceinline__ bf16x8 pack_step(const f32x16& x) {
    u32x4 p;
    asm volatile("v_cvt_pk_bf16_f32 %0, %4, %5\n\tv_cvt_pk_bf16_f32 %1, %6, %7\n\tv_cvt_pk_bf16_f32 %2, %8, %9\n\tv_cvt_pk_bf16_f32 %3, %10, %11\n\ts_nop 1"
                 : "=&v"(p[0]), "=&v"(p[1]), "=&v"(p[2]), "=&v"(p[3])
                 : "v"(x[8 * S_]), "v"(x[8 * S_ + 1]), "v"(x[8 * S_ + 2]), "v"(x[8 * S_ + 3]), "v"(x[8 * S_ + 4]), "v"(x[8 * S_ + 5]), "v"(x[8 * S_ + 6]), "v"(x[8 * S_ + 7]));
    return __builtin_bit_cast(bf16x8, p);
}
template <int S_> __device__ __forceinline__ bf16x8 pack_step_m(const f32x16& x) {
    u32x4 p;
    asm volatile("s_nop 15\n\tv_cvt_pk_bf16_f32 %0, %4, %5\n\tv_cvt_pk_bf16_f32 %1, %6, %7\n\tv_cvt_pk_bf16_f32 %2, %8, %9\n\tv_cvt_pk_bf16_f32 %3, %10, %11\n\ts_nop 1"
                 : "=&v"(p[0]), "=&v"(p[1]), "=&v"(p[2]), "=&v"(p[3])
                 : "v"(x[8 * S_]), "v"(x[8 * S_ + 1]), "v"(x[8 * S_ + 2]), "v"(x[8 * S_ + 3]), "v"(x[8 * S_ + 4]), "v"(x[8 * S_ + 5]), "v"(x[8 * S_ + 6]), "v"(x[8 * S_ + 7]));
    return __builtin_bit_cast(bf16x8, p);
}
constexpr int ATT_VB = 64 * 128;

template <int NKS, bool WIN>
__device__ __forceinline__ void attn_unit(const bf16_t* Qp, int q_ld, const bf16_t* K1, int k1_ld, const bf16_t* K2, int k2_ld, const bf16_t* Vp, int v_ld,
                          bf16_t* Op, int o_ld, int Q0, float sink_l2, const Ctx& c) {
    constexpr int KB = NKS * 2 * 1024, BUF = KB + ATT_VB;
    const int lane = c.lane, r = lane & 31, h = lane >> 5;
    const int wid = __builtin_amdgcn_readfirstlane(c.wid);
    const int q0w = Q0 + wid * 32;
    unsigned char* smem = c.smem;
    bf16x8 qf[NKS];
#pragma unroll
    for (int ks = 0; ks < NKS; ++ks) qf[ks] = *(const bf16x8*)(Qp + (size_t)(q0w + r) * q_ld + ks * 16 + h * 8);
    f32x16 o0, o1;
#pragma unroll
    for (int i = 0; i < 16; ++i) { o0[i] = 0.f; o1[i] = 0.f; }
    float m = WIN ? sink_l2 : -1e30f, l = (WIN && h == 0) ? 1.f : 0.f;
    const int kt_lo = WIN ? ((Q0 >> 6) - 2 < 0 ? 0 : (Q0 >> 6) - 2) : 0, kt_hi = (Q0 >> 6) + 1;
#define ATT_STAGE(kt_, buf_) do { unsigned char* bp = smem + (buf_) * BUF; const size_t kb = (size_t)(kt_) * 64; \
        _Pragma("unroll") for (int i = 0; i < (NKS * 2) / 4; ++i) { const int ch = wid + 4 * i; \
            const bf16_t* sp = (ch < 8) ? (K1 + (kb + lane) * k1_ld + ch * 8) : (K2 + (kb + lane) * k2_ld + (ch - 8) * 8); \
            glds16(sp, bp + ch * 1024 + lane * 16); } \
        _Pragma("unroll") for (int i = 0; i < 2; ++i) { const int j = wid + 4 * i; \
            glds16(Vp + (kb + 8 * j + (lane >> 3)) * v_ld + (lane & 7) * 8, bp + KB + j * 1024 + lane * 16); } } while (0)
    ATT_STAGE(kt_lo, 0);
    const int i16 = lane & 15;
    const unsigned vlane = (unsigned)((4 * h + (i16 >> 2)) * 128 + 32 * ((lane >> 4) & 1) + 8 * (i16 & 3));
    for (int kt = kt_lo; kt <= kt_hi; ++kt) {
        const int cur = (kt - kt_lo) & 1;
        asm volatile("s_waitcnt vmcnt(0)" ::: "memory");
        __syncthreads();
        if (kt < kt_hi) ATT_STAGE(kt + 1, cur ^ 1);
        const int k0 = kt * 64;
        const bool active = (k0 <= q0w + 31) && (!WIN || (k0 + 63 > q0w - 128));
        if (active) {
            const unsigned char* Kt = smem + cur * BUF;
            f32x16 x0, x1;
#pragma unroll
            for (int i = 0; i < 16; ++i) { x0[i] = 0.f; x1[i] = 0.f; }
#pragma unroll
            for (int ks = 0; ks < NKS; ++ks) {
                const bf16x8 kf0 = *(const bf16x8*)(Kt + (ks * 2 + h) * 1024 + r * 16);
                const bf16x8 kf1 = *(const bf16x8*)(Kt + (ks * 2 + h) * 1024 + (32 + r) * 16);
                x0 = MFMA32(kf0, qf[ks], x0); x1 = MFMA32(kf1, qf[ks], x1);
            }
            const bool need_mask = (k0 + 63 > q0w) || (WIN && (k0 <= q0w + 31 - 128));
            if (need_mask) {
                const int q = q0w + r;
#pragma unroll
                for (int i = 0; i < 16; ++i) {
                    const int key = k0 + (i & 3) + 8 * (i >> 2) + 4 * h;
                    const bool v0 = (key <= q) && (!WIN || key > q - 128);
                    const bool v1 = (key + 32 <= q) && (!WIN || key + 32 > q - 128);
                    x0[i] = v0 ? x0[i] : -INFINITY; x1[i] = v1 ? x1[i] : -INFINITY;
                }
            }
            float mx = fmaxf(x0[0], x1[0]);
#pragma unroll
            for (int i = 1; i < 16; ++i) mx = fmaxf(mx, fmaxf(x0[i], x1[i]));
            mx = fmaxf(mx, shfl_xor_(mx, 32));
            const float mn = fmaxf(m, mx);
            const float alpha = __builtin_amdgcn_exp2f(m - mn);
            m = mn;
            float ps = 0.f;
#pragma unroll
            for (int i = 0; i < 16; ++i) { x0[i] = __builtin_amdgcn_exp2f(x0[i] - mn); x1[i] = __builtin_amdgcn_exp2f(x1[i] - mn); ps += x0[i] + x1[i]; }
            l = l * alpha + ps;
            o0 *= alpha; o1 *= alpha;
            const unsigned vbase = (unsigned)(size_t)(smem + cur * BUF + KB) + vlane;
#pragma unroll
            for (int t = 0; t < 2; ++t) {
                s16x4 l00, h00, l01, h01, l10, h10, l11, h11;
                const unsigned va = vbase + t * 4096;
                asm volatile("ds_read_b64_tr_b16 %0, %8\n\t"
                             "ds_read_b64_tr_b16 %1, %8 offset:1024\n\t"
                             "ds_read_b64_tr_b16 %2, %8 offset:64\n\t"
                             "ds_read_b64_tr_b16 %3, %8 offset:1088\n\t"
                             "ds_read_b64_tr_b16 %4, %8 offset:2048\n\t"
                             "ds_read_b64_tr_b16 %5, %8 offset:3072\n\t"
                             "ds_read_b64_tr_b16 %6, %8 offset:2112\n\t"
                             "ds_read_b64_tr_b16 %7, %8 offset:3136\n\t"
                             "s_waitcnt lgkmcnt(0)"
                             : "=&v"(l00), "=&v"(h00), "=&v"(l01), "=&v"(h01), "=&v"(l10), "=&v"(h10), "=&v"(l11), "=&v"(h11) : "v"(va) : "memory");
                const bf16x8 v00 = __builtin_shufflevector(l00, h00, 0, 1, 2, 3, 4, 5, 6, 7), v01 = __builtin_shufflevector(l01, h01, 0, 1, 2, 3, 4, 5, 6, 7);
                const bf16x8 v10 = __builtin_shufflevector(l10, h10, 0, 1, 2, 3, 4, 5, 6, 7), v11 = __builtin_shufflevector(l11, h11, 0, 1, 2, 3, 4, 5, 6, 7);
                const bf16x8 pb0 = (t == 0) ? pack_step<0>(x0) : pack_step<0>(x1);
                const bf16x8 pb1 = (t == 0) ? pack_step<1>(x0) : pack_step<1>(x1);
                o0 = MFMA32(v00, pb0, o0); o1 = MFMA32(v01, pb0, o1);
                o0 = MFMA32(v10, pb1, o0); o1 = MFMA32(v11, pb1, o1);
            }
        }
    }
#undef ATT_STAGE
    l += shfl_xor_(l, 32);
    const float inv = 1.f / l;
    bf16_t* orow = Op + (size_t)(q0w + r) * o_ld + 4 * h;
#pragma unroll
    for (int g = 0; g < 4; ++g) {
        *(u32x2*)(orow + 8 * g) = (u32x2){pk2(o0[4 * g] * inv, o0[4 * g + 1] * inv), pk2(o0[4 * g + 2] * inv, o0[4 * g + 3] * inv)};
        *(u32x2*)(orow + 32 + 8 * g) = (u32x2){pk2(o1[4 * g] * inv, o1[4 * g + 1] * inv), pk2(o1[4 * g + 2] * inv, o1[4 * g + 3] * inv)};
    }
}

constexpr size_t MLC_DC = 0, MLC_CS = 33554432, MLC_DN = MLC_CS + 16777216, MLC_NS = MLC_DN + 262144, MLC_ML = MLC_NS + 262144, MLC_BE = MLC_ML + 4096, MLC_MS = MLC_BE + 4096;

__device__ __forceinline__ float scan_add64(float v, int lane) {
#pragma unroll
    for (int o = 1; o < 64; o <<= 1) { const float x = shfl_up_(v, o); if (lane >= o) v += x; }
    return v;
}
__device__ __forceinline__ float scan_max64(float v, int lane) {
#pragma unroll
    for (int o = 1; o < 64; o <<= 1) { const float x = shfl_up_(v, o); if (lane >= o) v = fmaxf(v, x); }
    return v;
}
__device__ __forceinline__ float wave_max(float v) {
#pragma unroll
    for (int o = 32; o > 0; o >>= 1) v = fmaxf(v, shfl_xor_(v, o));
    return v;
}

__device__ __forceinline__ void mlc_passA(int u, const bf16_t* PROJ, const float* GATES, const float* b_i, const float* b_f, unsigned char* YB, const Ctx& c) {
    const int bh = u >> 5, b = bh >> 2, h = bh & 3;
    const size_t t0 = (size_t)b * SEQ + (u & 31) * 64;
    unsigned char* smem = c.smem;
    float* saL = (float*)(smem + 24576);
    const int lane = c.lane, wid = __builtin_amdgcn_readfirstlane(c.wid);
#pragma unroll
    for (int i = 0; i < 4; ++i) { const int j = wid * 4 + i;
        glds16(PROJ + (t0 + 4 * j + (lane >> 4)) * NPAD + 512 + h * 128 + (lane & 15) * 8, smem + 8192 + j * 1024 + lane * 16); }
    if (wid == 0) {
        const float ip = GATES[(t0 + lane) * 8 + h] + b_i[h], lf = -softplusf_(-(GATES[(t0 + lane) * 8 + 4 + h] + b_f[h]));
        const float bc = scan_add64(lf, lane), bend = shfl_c_(bc, 63);
        const float a = bend - bc + ip, mloc = wave_max(a);
        saL[lane] = expf(a - mloc) * 0.125f;
        if (lane == 0) { ((float*)(YB + MLC_ML))[u] = mloc; ((float*)(YB + MLC_BE))[u] = bend; }
    }
    __syncthreads();
#pragma unroll
    for (int i = 0; i < 2; ++i) {
        const int idx = c.tid + 256 * i, row = idx >> 3, chk = idx & 7;
        const u32x4 r = *(const u32x4*)(PROJ + (t0 + row) * NPAD + 256 + h * 64 + chk * 8);
        float f[8]; unpack8(r, f);
        const float s = saL[row];
        *(u32x4*)(smem + row * 128 + chk * 16) = (u32x4){pk2(f[0] * s, f[1] * s), pk2(f[2] * s, f[3] * s), pk2(f[4] * s, f[5] * s), pk2(f[6] * s, f[7] * s)};
    }
    asm volatile("s_waitcnt vmcnt(0)" ::: "memory");
    __syncthreads();
    const int h5 = lane >> 5, r = lane & 31, i16 = lane & 15, q4 = i16 >> 2, p = i16 & 3, blk = (lane >> 4) & 1;
    const int dkt = wid & 1, dvp = wid >> 1;
    const unsigned kaddr = (unsigned)(size_t)smem + (unsigned)((8 * h5 + q4) * 128 + dkt * 64 + 32 * blk + 8 * p);
    const unsigned vaddr = (unsigned)(size_t)smem + 8192u + (unsigned)((8 * h5 + q4) * 256 + dvp * 128 + 32 * blk + 8 * p);
    f32x16 a0, a1;
#pragma unroll
    for (int i = 0; i < 16; ++i) { a0[i] = 0.f; a1[i] = 0.f; }
#pragma unroll
    for (int st = 0; st < 4; ++st) {
        s16x4 kl, kh, v0l, v0h, v1l, v1h;
        const unsigned ka = kaddr + st * 2048, va = vaddr + st * 4096;
        asm volatile("ds_read_b64_tr_b16 %0, %6\n\t"
                     "ds_read_b64_tr_b16 %1, %6 offset:512\n\t"
                     "ds_read_b64_tr_b16 %2, %7\n\t"
                     "ds_read_b64_tr_b16 %3, %7 offset:1024\n\t"
                     "ds_read_b64_tr_b16 %4, %7 offset:64\n\t"
                     "ds_read_b64_tr_b16 %5, %7 offset:1088\n\t"
                     "s_waitcnt lgkmcnt(0)"
                     : "=&v"(kl), "=&v"(kh), "=&v"(v0l), "=&v"(v0h), "=&v"(v1l), "=&v"(v1h) : "v"(ka), "v"(va) : "memory");
        const bf16x8 kf = __builtin_shufflevector(kl, kh, 0, 1, 2, 3, 4, 5, 6, 7);
        const bf16x8 vf0 = __builtin_shufflevector(v0l, v0h, 0, 1, 2, 3, 4, 5, 6, 7), vf1 = __builtin_shufflevector(v1l, v1h, 0, 1, 2, 3, 4, 5, 6, 7);
        a0 = MFMA32(kf, vf0, a0); a1 = MFMA32(kf, vf1, a1);
    }
    float* DC = (float*)(YB + MLC_DC) + (size_t)u * 8192;
#pragma unroll
    for (int i = 0; i < 16; ++i) {
        const int dk = dkt * 32 + (i & 3) + 8 * (i >> 2) + 4 * h5;
        DC[dk * 128 + dvp * 64 + r] = a0[i]; DC[dk * 128 + dvp * 64 + 32 + r] = a1[i];
    }
    if (c.tid < 64) {
        float s = 0.f;
#pragma unroll 8
        for (int t = 0; t < 64; ++t) s += bf2f(((const bf16_t*)smem)[t * 64 + c.tid]);
        ((float*)(YB + MLC_DN))[(size_t)u * 64 + c.tid] = s;
    }
}

__device__ __forceinline__ void mlc_passB(int u, unsigned char* YB, const Ctx& c) {
    const int bh = u >> 3, sl = u & 7;
    const float* ML = (const float*)(YB + MLC_ML) + bh * 32; const float* BE = (const float*)(YB + MLC_BE) + bh * 32;
    const float* DC = (const float*)(YB + MLC_DC) + (size_t)bh * 32 * 8192 + sl * 1024 + c.tid * 4;
    bf16_t* CS = (bf16_t*)(YB + MLC_CS) + (size_t)bh * 32 * 8192 + sl * 1024 + c.tid * 4;
    const float* DN = (const float*)(YB + MLC_DN) + (size_t)bh * 32 * 64; float* NS = (float*)(YB + MLC_NS) + (size_t)bh * 32 * 64; float* MS = (float*)(YB + MLC_MS) + bh * 32;
    f32x4 C4 = (f32x4){0.f, 0.f, 0.f, 0.f}; float nv = 0.f, m = 0.f;
    const bool do_n = (sl == 0) && (c.tid < 64);
#pragma unroll 4
    for (int n = 0; n < 32; ++n) {
        *(u32x2*)(CS + (size_t)n * 8192) = (u32x2){pk2(C4[0], C4[1]), pk2(C4[2], C4[3])};
        if (do_n) NS[n * 64 + c.tid] = nv;
        if (sl == 0 && c.tid == 0) MS[n] = m;
        const float be = BE[n], ml = ML[n];
        const float mn = fmaxf(be + m, ml), keep = expf(be + m - mn), g = expf(ml - mn);
        m = mn;
        const f32x4 d = *(const f32x4*)(DC + (size_t)n * 8192);
        C4 = C4 * keep + d * g;
        if (do_n) nv = nv * keep + DN[n * 64 + c.tid] * g;
    }
}

__device__ __forceinline__ void mlc_passC(int u, const bf16_t* PROJ, const float* GATES, const float* b_i, const float* b_f, const unsigned char* YB,
                                          const float* gain  , bf16_t* MIXO, const Ctx& c) {
    const int bh = u >> 5, b = bh >> 2, h = bh & 3;
    const size_t t0 = (size_t)b * SEQ + (u & 31) * 64;
    unsigned char* smem = c.smem;
    float* csL = (float*)(smem + 32768); float* pmL = (float*)(smem + 33024); float* bcL = (float*)(smem + 33280); float* nnL = (float*)(smem + 33536); float* sqL = (float*)(smem + 33792);
    const int lane = c.lane, wid = __builtin_amdgcn_readfirstlane(c.wid);
    const bf16_t* CS = (const bf16_t*)(YB + MLC_CS) + (size_t)u * 8192;
#pragma unroll
    for (int i = 0; i < 4; ++i) { const int j = wid * 4 + i;
        glds16(PROJ + (t0 + 4 * j + (lane >> 4)) * NPAD + 512 + h * 128 + (lane & 15) * 8, smem + j * 1024 + lane * 16);
        glds16(CS + (4 * j + (lane >> 4)) * 128 + (lane & 15) * 8, smem + 16384 + j * 1024 + lane * 16); }
    float bcl = 0.f;
    if (wid == 0) {
        const float ip = GATES[(t0 + lane) * 8 + h] + b_i[h], lf = -softplusf_(-(GATES[(t0 + lane) * 8 + 4 + h] + b_f[h]));
        bcl = scan_add64(lf, lane);
        const float cs = ip - bcl;
        csL[lane] = cs; pmL[lane] = scan_max64(cs, lane);
        nnL[lane] = ((const float*)(YB + MLC_NS))[(size_t)u * 64 + lane];
        bcL[lane] = bcl;
    }
    asm volatile("s_waitcnt vmcnt(0)" ::: "memory");
    __syncthreads();
    const int h5 = lane >> 5, r = lane & 31, i16 = lane & 15, q4 = i16 >> 2, p = i16 & 3, blk = (lane >> 4) & 1;
    const int th = wid & 1, dvh = wid >> 1;
    const int t = th * 32 + r;
    const float m_n = ((const float*)(YB + MLC_MS))[u];
    const float Mt = fmaxf(m_n, pmL[t]), w_inter = __expf(m_n - Mt), em = __expf(-(bcL[t] + Mt));
    bf16x8 qf[4];
#pragma unroll
    for (int ks = 0; ks < 4; ++ks) qf[ks] = *(const bf16x8*)(PROJ + (t0 + t) * NPAD + h * 64 + ks * 16 + h5 * 8);
    float qn = 0.f; bf16x8 qw[4];
#pragma unroll
    for (int ks = 0; ks < 4; ++ks) {
        const u32x4 raw = __builtin_bit_cast(u32x4, qf[ks]); float f[8]; unpack8(raw, f);
#pragma unroll
        for (int j = 0; j < 8; ++j) qn += f[j] * nnL[ks * 16 + h5 * 8 + j];
        qw[ks] = __builtin_bit_cast(bf16x8, (u32x4){pk2(f[0] * w_inter, f[1] * w_inter), pk2(f[2] * w_inter, f[3] * w_inter), pk2(f[4] * w_inter, f[5] * w_inter), pk2(f[6] * w_inter, f[7] * w_inter)});
    }
    qn += shfl_xor_(qn, 32);
    f32x16 x0, x1;
#pragma unroll
    for (int i = 0; i < 16; ++i) { x0[i] = 0.f; x1[i] = 0.f; }
#pragma unroll
    for (int ks = 0; ks < 4; ++ks) {
        const bf16x8 kf0 = *(const bf16x8*)(PROJ + (t0 + r) * NPAD + 256 + h * 64 + ks * 16 + h5 * 8);
        x0 = MFMA32(kf0, qf[ks], x0);
        if (th) { const bf16x8 kf1 = *(const bf16x8*)(PROJ + (t0 + 32 + r) * NPAD + 256 + h * 64 + ks * 16 + h5 * 8); x1 = MFMA32(kf1, qf[ks], x1); }
    }
    float ps = 0.f;
#pragma unroll
    for (int i = 0; i < 16; ++i) {
        const int s = (i & 3) + 8 * (i >> 2) + 4 * h5;
        const float w0 = (s <= t) ? __expf(csL[s] - Mt) * 0.125f : 0.f;
        x0[i] *= w0; ps += x0[i];
        if (th) { const float w1 = (s <= r) ? __expf(csL[32 + s] - Mt) * 0.125f : 0.f; x1[i] *= w1; ps += x1[i]; }
    }
    ps += shfl_xor_(ps, 32);
    const float den = w_inter * qn + ps;
    f32x16 o0, o1;
#pragma unroll
    for (int i = 0; i < 16; ++i) { o0[i] = 0.f; o1[i] = 0.f; }
    {
        const unsigned vb = (unsigned)(size_t)smem + (unsigned)((4 * h5 + q4) * 256 + dvh * 128 + 32 * blk + 8 * p);
#pragma unroll
        for (int st = 0; st < 2; ++st) {
            if (st == 0 || th) {
                s16x4 l00, h00, l01, h01, l10, h10, l11, h11;
                const unsigned va = vb + st * 8192;
                asm volatile("ds_read_b64_tr_b16 %0, %8\n\t"
                             "ds_read_b64_tr_b16 %1, %8 offset:2048\n\t"
                             "ds_read_b64_tr_b16 %2, %8 offset:64\n\t"
                             "ds_read_b64_tr_b16 %3, %8 offset:2112\n\t"
                             "ds_read_b64_tr_b16 %4, %8 offset:4096\n\t"
                             "ds_read_b64_tr_b16 %5, %8 offset:6144\n\t"
                             "ds_read_b64_tr_b16 %6, %8 offset:4160\n\t"
                             "ds_read_b64_tr_b16 %7, %8 offset:6208\n\t"
                             "s_waitcnt lgkmcnt(0)"
                             : "=&v"(l00), "=&v"(h00), "=&v"(l01), "=&v"(h01), "=&v"(l10), "=&v"(h10), "=&v"(l11), "=&v"(h11) : "v"(va) : "memory");
                const bf16x8 v00 = __builtin_shufflevector(l00, h00, 0, 1, 2, 3, 4, 5, 6, 7), v01 = __builtin_shufflevector(l01, h01, 0, 1, 2, 3, 4, 5, 6, 7);
                const bf16x8 v10 = __builtin_shufflevector(l10, h10, 0, 1, 2, 3, 4, 5, 6, 7), v11 = __builtin_shufflevector(l11, h11, 0, 1, 2, 3, 4, 5, 6, 7);
                const bf16x8 pb0 = (st == 0) ? pack_step<0>(x0) : pack_step<0>(x1);
                const bf16x8 pb1 = (st == 0) ? pack_step<1>(x0) : pack_step<1>(x1);
                o0 = MFMA32(v00, pb0, o0); o1 = MFMA32(v01, pb0, o1);
                o0 = MFMA32(v10, pb1, o0); o1 = MFMA32(v11, pb1, o1);
            }
        }
    }
    {
        const unsigned cb = (unsigned)(size_t)smem + 16384u + (unsigned)((8 * h5 + q4) * 256 + dvh * 128 + 32 * blk + 8 * p);
#pragma unroll
        for (int kp = 0; kp < 2; ++kp) {
            s16x4 l00, h00, l01, h01, l10, h10, l11, h11;
            const unsigned ca = cb + kp * 8192;
            asm volatile("ds_read_b64_tr_b16 %0, %8\n\t"
                         "ds_read_b64_tr_b16 %1, %8 offset:1024\n\t"
                         "ds_read_b64_tr_b16 %2, %8 offset:64\n\t"
                         "ds_read_b64_tr_b16 %3, %8 offset:1088\n\t"
                         "ds_read_b64_tr_b16 %4, %8 offset:4096\n\t"
                         "ds_read_b64_tr_b16 %5, %8 offset:5120\n\t"
                         "ds_read_b64_tr_b16 %6, %8 offset:4160\n\t"
                         "ds_read_b64_tr_b16 %7, %8 offset:5184\n\t"
                         "s_waitcnt lgkmcnt(0)"
                         : "=&v"(l00), "=&v"(h00), "=&v"(l01), "=&v"(h01), "=&v"(l10), "=&v"(h10), "=&v"(l11), "=&v"(h11) : "v"(ca) : "memory");
            const bf16x8 c00 = __builtin_shufflevector(l00, h00, 0, 1, 2, 3, 4, 5, 6, 7), c01 = __builtin_shufflevector(l01, h01, 0, 1, 2, 3, 4, 5, 6, 7);
            const bf16x8 c10 = __builtin_shufflevector(l10, h10, 0, 1, 2, 3, 4, 5, 6, 7), c11 = __builtin_shufflevector(l11, h11, 0, 1, 2, 3, 4, 5, 6, 7);
            o0 = MFMA32(c00, qw[2 * kp], o0); o1 = MFMA32(c01, qw[2 * kp], o1);
            o0 = MFMA32(c10, qw[2 * kp + 1], o0); o1 = MFMA32(c11, qw[2 * kp + 1], o1);
        }
    }
    const float inv = __builtin_amdgcn_rcpf(fmaxf(fabsf(den), em));
    float ss = 0.f;
#pragma unroll
    for (int i = 0; i < 16; ++i) { o0[i] *= inv; o1[i] *= inv; ss += o0[i] * o0[i] + o1[i] * o1[i]; }
    ss += shfl_xor_(ss, 32);
    if (h5 == 0) sqL[wid * 32 + r] = ss;
    __syncthreads();
    const float rr = rsqrtf((sqL[th * 32 + r] + sqL[(th + 2) * 32 + r]) * (1.f / 128.f) + 1e-6f);
    const bf16_t* grow = PROJ + (t0 + t) * NPAD + 1032 + h * 128 + dvh * 64 + 4 * h5;
    const float* gn = gain + h * 128 + dvh * 64 + 4 * h5;
    bf16_t* orow = MIXO + (t0 + t) * 1024 + h * 128 + dvh * 64 + 4 * h5;
#pragma unroll
    for (int d = 0; d < 2; ++d)
#pragma unroll
        for (int g = 0; g < 4; ++g) {
            const u32x2 zr = *(const u32x2*)(grow + d * 32 + 8 * g);
            const f32x4 gv = *(const f32x4*)(gn + d * 32 + 8 * g);
            const float z0 = bflo(zr.x), z1 = bfhi(zr.x), z2 = bflo(zr.y), z3 = bfhi(zr.y);
            const float y0 = (d ? o1[4 * g] : o0[4 * g]) * rr * gv[0] * sigmoidf_(z0), y1 = (d ? o1[4 * g + 1] : o0[4 * g + 1]) * rr * gv[1] * sigmoidf_(z1);
            const float y2 = (d ? o1[4 * g + 2] : o0[4 * g + 2]) * rr * gv[2] * sigmoidf_(z2), y3 = (d ? o1[4 * g + 3] : o0[4 * g + 3]) * rr * gv[3] * sigmoidf_(z3);
            *(u32x2*)(orow + d * 32 + 8 * g) = (u32x2){pk2(y0, y1), pk2(y2, y3)};
        }
}

constexpr size_t GD_WN = 0, GD_UU = GD_WN + (size_t)1024 * 16384, GD_KGT = GD_UU + (size_t)1024 * 16384, GD_QG = GD_KGT + (size_t)1024 * 16384,
                 GD_AT = GD_QG + (size_t)1024 * 16384, GD_GL = GD_AT + (size_t)1024 * 8192, GD_END = GD_GL + 4096;
static_assert(GD_END <= (size_t)MAXROWS * 256 * 2, "GDN chunk records must fit the HBUF region");

__device__ __forceinline__ void gdc_passA(int u, const bf16_t* GQ, const bf16_t* GK, const bf16_t* GV, const float* BETA, const float* GLOG, unsigned char* HB, const Ctx& c) {
    const int bh = u >> 5, b = bh >> 2, h = bh & 3;
    const size_t t0 = (size_t)b * SEQ + (u & 31) * 64;
    unsigned char* smem = c.smem;
    float* Lm = (float*)(smem + 49152);
    float* GA = (float*)(smem + 65536 + 64); float* BT = GA + 64; float* EG = BT + 64; float* EK = EG + 64;
    const int lane = c.lane, wid = __builtin_amdgcn_readfirstlane(c.wid);
    const int h5 = lane >> 5, r = lane & 31;
    if (wid == 0) {
        const float g = GLOG[(t0 + lane) * 4 + h];
        const float G = scan_add64(g, lane), Gl = shfl_c_(G, 63);
        GA[lane] = G; BT[lane] = BETA[(t0 + lane) * 4 + h]; EG[lane] = expf(G); EK[lane] = expf(Gl - G);
        if (lane == 0) ((float*)(HB + GD_GL))[u] = expf(Gl);
    }
    __syncthreads();
    if (wid < 3) {
        const int it = (wid + 1) >> 1, jt = wid >> 1;
        f32x16 dl, da;
#pragma unroll
        for (int i = 0; i < 16; ++i) { dl[i] = 0.f; da[i] = 0.f; }
#pragma unroll
        for (int ks = 0; ks < 8; ++ks) {
            const bf16x8 ki = *(const bf16x8*)(GK + (t0 + 32 * it + r) * 512 + h * 128 + ks * 16 + h5 * 8);
            const bf16x8 kj = *(const bf16x8*)(GK + (t0 + 32 * jt + r) * 512 + h * 128 + ks * 16 + h5 * 8);
            const bf16x8 qi = *(const bf16x8*)(GQ + (t0 + 32 * it + r) * 512 + h * 128 + ks * 16 + h5 * 8);
            dl = MFMA32(ki, kj, dl); da = MFMA32(qi, kj, da);
        }
        const int j = 32 * jt + r; const float Gj = GA[j];
        bf16_t* AT = (bf16_t*)(HB + GD_AT) + (size_t)u * 4096;
#pragma unroll
        for (int i = 0; i < 16; ++i) {
            const int ii = 32 * it + (i & 3) + 8 * (i >> 2) + 4 * h5;
            const float dec = __expf(GA[ii] - Gj);
            Lm[ii * 64 + j] = (j < ii) ? dl[i] * BT[ii] * dec : 0.f;
            AT[ii * 64 + j] = (bf16_t)f2bf((j <= ii) ? da[i] * dec : 0.f);
        }
        if (wid == 0) {
#pragma unroll
            for (int i = 0; i < 16; ++i) { const int ii = (i & 3) + 8 * (i >> 2) + 4 * h5; Lm[ii * 64 + 32 + r] = 0.f; AT[ii * 64 + 32 + r] = 0; }
        }
    }
    __syncthreads();
    if (wid == 0) {
        float Tc[64];
#pragma unroll
        for (int i = 0; i < 64; ++i) {
            float s = (i == lane) ? 1.f : 0.f;
#pragma unroll
            for (int k = 0; k < i; ++k) s -= Lm[i * 64 + k] * Tc[k];
            Tc[i] = s;
        }
        bf16_t* Tm = (bf16_t*)Lm;
#pragma unroll
        for (int i = 0; i < 64; ++i) Tm[i * 64 + lane] = (bf16_t)f2bf(Tc[i]);
    } else {
        const int t3 = c.tid - 64;
        for (int idx = t3; idx < 4096; idx += 192) {
            const int arr = idx >> 10, rem = idx & 1023, row = rem >> 4, chk = rem & 15;
            const bf16_t* sp = ((arr == 1) ? GV : (arr == 3) ? GQ : GK) + (t0 + row) * 512 + h * 128 + chk * 8;
            const u32x4 raw = *(const u32x4*)sp; float f[8]; unpack8(raw, f);
            const float sc = (arr == 0) ? BT[row] * EG[row] : (arr == 1) ? BT[row] : (arr == 2) ? EK[row] : EG[row];
            const u32x4 o = (u32x4){pk2(f[0] * sc, f[1] * sc), pk2(f[2] * sc, f[3] * sc), pk2(f[4] * sc, f[5] * sc), pk2(f[6] * sc, f[7] * sc)};
            if (arr < 3) *(u32x4*)(smem + arr * 16384 + row * 256 + chk * 16) = o;
            else *(u32x4*)((bf16_t*)(HB + GD_QG) + (size_t)u * 8192 + row * 128 + chk * 8) = o;
        }
    }
    __syncthreads();
    {
        const int i16 = lane & 15, q4 = i16 >> 2, p = i16 & 3, blk = (lane >> 4) & 1;
        const unsigned char* Tm = smem + 49152;
        f32x16 u0, u1, w0, w1;
#pragma unroll
        for (int i = 0; i < 16; ++i) { u0[i] = 0.f; u1[i] = 0.f; w0[i] = 0.f; w1[i] = 0.f; }
        const unsigned ib = (unsigned)(size_t)smem + (unsigned)((8 * h5 + q4) * 256 + wid * 64 + 32 * blk + 8 * p);
#pragma unroll
        for (int ks = 0; ks < 4; ++ks) {
            s16x4 kl, kh, vl, vh;
            const unsigned ia = ib + ks * 4096;
            asm volatile("ds_read_b64_tr_b16 %0, %4\n\t"
                         "ds_read_b64_tr_b16 %1, %4 offset:1024\n\t"
                         "ds_read_b64_tr_b16 %2, %4 offset:16384\n\t"
                         "ds_read_b64_tr_b16 %3, %4 offset:17408\n\t"
                         "s_waitcnt lgkmcnt(0)"
                         : "=&v"(kl), "=&v"(kh), "=&v"(vl), "=&v"(vh) : "v"(ia) : "memory");
            const bf16x8 kb = __builtin_shufflevector(kl, kh, 0, 1, 2, 3, 4, 5, 6, 7), vb = __builtin_shufflevector(vl, vh, 0, 1, 2, 3, 4, 5, 6, 7);
            const bf16x8 t1 = *(const bf16x8*)(Tm + (32 + r) * 128 + ks * 32 + h5 * 16);
            w1 = MFMA32(t1, kb, w1); u1 = MFMA32(t1, vb, u1);
            if (ks < 2) { const bf16x8 tt0 = *(const bf16x8*)(Tm + r * 128 + ks * 32 + h5 * 16); w0 = MFMA32(tt0, kb, w0); u0 = MFMA32(tt0, vb, u0); }
        }
        bf16_t* WN = (bf16_t*)(HB + GD_WN) + (size_t)u * 8192; bf16_t* UU = (bf16_t*)(HB + GD_UU) + (size_t)u * 8192;
#pragma unroll
        for (int i = 0; i < 16; ++i) {
            const int s = (i & 3) + 8 * (i >> 2) + 4 * h5;
            WN[s * 128 + wid * 32 + r] = (bf16_t)f2bf(-w0[i]); WN[(32 + s) * 128 + wid * 32 + r] = (bf16_t)f2bf(-w1[i]);
        }
        {
            u32x4* up = (u32x4*)(UU + (size_t)(wid * 64 + lane) * 32);
            up[0] = (u32x4){pk2(u0[0], u0[1]), pk2(u0[2], u0[3]), pk2(u0[4], u0[5]), pk2(u0[6], u0[7])};
            up[1] = (u32x4){pk2(u0[8], u0[9]), pk2(u0[10], u0[11]), pk2(u0[12], u0[13]), pk2(u0[14], u0[15])};
            up[2] = (u32x4){pk2(u1[0], u1[1]), pk2(u1[2], u1[3]), pk2(u1[4], u1[5]), pk2(u1[6], u1[7])};
            up[3] = (u32x4){pk2(u1[8], u1[9]), pk2(u1[10], u1[11]), pk2(u1[12], u1[13]), pk2(u1[14], u1[15])};
        }
        bf16_t* KGT = (bf16_t*)(HB + GD_KGT) + (size_t)u * 8192;
        const int gq = lane >> 4;
        const unsigned kb0 = (unsigned)(size_t)smem + 32768u + (unsigned)(q4 * 256 + gq * 32 + 8 * p);
#pragma unroll
        for (int it2 = 0; it2 < 8; ++it2) {
            const int job = wid * 8 + it2, s0 = (job & 15) * 4, dkb = (job >> 4) * 64;
            s16x4 v;
            const unsigned ad = kb0 + s0 * 256 + dkb * 2;
            asm volatile("ds_read_b64_tr_b16 %0, %1\n\ts_waitcnt lgkmcnt(0)" : "=&v"(v) : "v"(ad) : "memory");
            *(s16x4*)(KGT + (size_t)(dkb + gq * 16 + i16) * 64 + s0) = v;
        }
    }
}

constexpr size_t GC_ST = 0, GC_VT = (size_t)1024 * 32768;
__device__ __forceinline__ void gdc_passB(int bh, const unsigned char* HB, unsigned char* YB, const Ctx& c) {
    const int lane = c.lane, wid = __builtin_amdgcn_readfirstlane(c.wid);
    const int h5 = lane >> 5, r = lane & 31;
    unsigned char* smem = c.smem;
    f32x16 S0, S1, S2, S3;
#pragma unroll
    for (int i = 0; i < 16; ++i) { S0[i] = 0.f; S1[i] = 0.f; S2[i] = 0.f; S3[i] = 0.f; }
    const size_t u0 = (size_t)bh * 32;
#define GB_STAGE(n_, p_) do { const bf16_t* wn_ = (const bf16_t*)(HB + GD_WN) + (u0 + (n_)) * 8192; const bf16_t* kg_ = (const bf16_t*)(HB + GD_KGT) + (u0 + (n_)) * 8192; \
        unsigned char* bp_ = smem + (p_) * 32768; \
        _Pragma("unroll") for (int i = 0; i < 4; ++i) { const int jj = wid * 4 + i, row = 4 * jj + (lane >> 4), ch = (lane & 15) ^ (row & 15); \
            glds16(wn_ + row * 128 + ch * 8, bp_ + jj * 1024 + lane * 16); } \
        _Pragma("unroll") for (int i = 0; i < 4; ++i) { const int jj = wid * 4 + i, row = 8 * jj + (lane >> 3), ch = (lane & 7) ^ ((row >> 1) & 7); \
            glds16(kg_ + row * 64 + ch * 8, bp_ + 16384 + jj * 1024 + lane * 16); } } while (0)
#define LD128(base_, R_, ks_) __builtin_shufflevector(*(const s16x4*)((base_) + (R_) * 256 + (((2 * (ks_)) ^ (rl & 15)) << 4) + 8 * hl), \
                                                      *(const s16x4*)((base_) + (R_) * 256 + (((2 * (ks_) + 1) ^ (rl & 15)) << 4) + 8 * hl), 0, 1, 2, 3, 4, 5, 6, 7)
#define LD64(base_, R_, k2_) __builtin_shufflevector(*(const s16x4*)((base_) + (R_) * 128 + (((2 * (k2_)) ^ ((rl >> 1) & 7)) << 4) + 8 * hl), \
                                                     *(const s16x4*)((base_) + (R_) * 128 + (((2 * (k2_) + 1) ^ ((rl >> 1) & 7)) << 4) + 8 * hl), 0, 1, 2, 3, 4, 5, 6, 7)
    u32x4 uu[4];
#define GB_LOADU(n_) do { const u32x4* up_ = (const u32x4*)((const bf16_t*)(HB + GD_UU) + (u0 + (n_)) * 8192 + (size_t)(wid * 64 + lane) * 32); \
        uu[0] = up_[0]; uu[1] = up_[1]; uu[2] = up_[2]; uu[3] = up_[3]; } while (0)
    __syncthreads();
    GB_STAGE(0, 0);
    GB_LOADU(0);
#pragma unroll 1
    for (int n2 = 0; n2 < 16; ++n2) {
#pragma unroll
        for (int PBUF = 0; PBUF < 2; ++PBUF) {
        const int n = 2 * n2 + PBUF;
        const float gl = ((const float*)(HB + GD_GL))[u0 + n];
        if (n == 0) asm volatile("s_waitcnt vmcnt(0)" ::: "memory"); else asm volatile("s_waitcnt vmcnt(24)" ::: "memory");
        asm volatile("s_waitcnt lgkmcnt(0)" ::: "memory"); __builtin_amdgcn_s_barrier(); asm volatile("" ::: "memory");
        f32x16 v0, v1;
#pragma unroll
        for (int q = 0; q < 2; ++q) {
            const u32x4 a = uu[q], bq = uu[2 + q];
            v0[8 * q + 0] = bflo(a.x); v0[8 * q + 1] = bfhi(a.x); v0[8 * q + 2] = bflo(a.y); v0[8 * q + 3] = bfhi(a.y);
            v0[8 * q + 4] = bflo(a.z); v0[8 * q + 5] = bfhi(a.z); v0[8 * q + 6] = bflo(a.w); v0[8 * q + 7] = bfhi(a.w);
            v1[8 * q + 0] = bflo(bq.x); v1[8 * q + 1] = bfhi(bq.x); v1[8 * q + 2] = bflo(bq.y); v1[8 * q + 3] = bfhi(bq.y);
            v1[8 * q + 4] = bflo(bq.z); v1[8 * q + 5] = bfhi(bq.z); v1[8 * q + 6] = bflo(bq.w); v1[8 * q + 7] = bfhi(bq.w);
        }
        if (n + 1 < 32) { GB_STAGE(n + 1, (PBUF ^ 1)); GB_LOADU(n + 1); }
        int rl = r, hl = h5; asm volatile("" : "+v"(rl), "+v"(hl));
        const unsigned char* WNb = smem + PBUF * 32768; const unsigned char* KGb = WNb + 16384;
        {
            bf16_t* st = (bf16_t*)(YB + GC_ST) + (u0 + n) * 16384 + (size_t)h5 * 512 + (size_t)(wid * 32 + r) * 4;
#define ST_TILE(SX, dt_) do { _Pragma("unroll") for (int g = 0; g < 4; ++g) \
                *(u32x2*)(st + ((dt_) * 8 + 2 * g) * 512) = (u32x2){cvt_pk(SX[4 * g], SX[4 * g + 1]), cvt_pk(SX[4 * g + 2], SX[4 * g + 3])}; } while (0)
            ST_TILE(S0, 0); ST_TILE(S1, 1); ST_TILE(S2, 2); ST_TILE(S3, 3);
#undef ST_TILE
        }
        {
            bf16x8 fa0, fb0, fa1, fb1, fa2, fb2;
#define LDV(FA, FB, ks_) do { FA = LD128(WNb, rl, ks_); FB = LD128(WNb, 32 + rl, ks_); } while (0)
#define MMV(SX, HF, FA, FB) do { const bf16x8 sbk = pack_step<HF>(SX); v0 = MFMA32(FA, sbk, v0); v1 = MFMA32(FB, sbk, v1); } while (0)
            LDV(fa0, fb0, 0); LDV(fa1, fb1, 1); LDV(fa2, fb2, 2);
            MMV(S0, 0, fa0, fb0); LDV(fa0, fb0, 3);
            MMV(S0, 1, fa1, fb1); LDV(fa1, fb1, 4);
            MMV(S1, 0, fa2, fb2); LDV(fa2, fb2, 5);
            MMV(S1, 1, fa0, fb0); LDV(fa0, fb0, 6);
            MMV(S2, 0, fa1, fb1); LDV(fa1, fb1, 7);
            MMV(S2, 1, fa2, fb2);
            MMV(S3, 0, fa0, fb0);
            MMV(S3, 1, fa1, fb1);
#undef LDV
#undef MMV
        }
        const bf16x8 vb0 = pack_step_m<0>(v0), vb1 = pack_step_m<1>(v0), vb2 = pack_step_m<0>(v1), vb3 = pack_step_m<1>(v1);
        {
            bf16_t* vt = (bf16_t*)(YB + GC_VT) + (u0 + n) * 8192 + (size_t)h5 * 512 + (size_t)(wid * 32 + r) * 4;
            const u32x4 p0 = __builtin_bit_cast(u32x4, vb0), p1 = __builtin_bit_cast(u32x4, vb1), p2 = __builtin_bit_cast(u32x4, vb2), p3 = __builtin_bit_cast(u32x4, vb3);
            *(u32x2*)(vt + 0 * 512) = (u32x2){p0.x, p0.y};  *(u32x2*)(vt + 2 * 512) = (u32x2){p0.z, p0.w};
            *(u32x2*)(vt + 4 * 512) = (u32x2){p1.x, p1.y};  *(u32x2*)(vt + 6 * 512) = (u32x2){p1.z, p1.w};
            *(u32x2*)(vt + 8 * 512) = (u32x2){p2.x, p2.y};  *(u32x2*)(vt + 10 * 512) = (u32x2){p2.z, p2.w};
            *(u32x2*)(vt + 12 * 512) = (u32x2){p3.x, p3.y}; *(u32x2*)(vt + 14 * 512) = (u32x2){p3.z, p3.w};
        }
        asm volatile("" ::: "memory"); asm volatile("" : "+v"(rl), "+v"(hl));
        S0 *= gl; S1 *= gl; S2 *= gl; S3 *= gl;
        {
            bf16x8 g0, g1, g2;
            g0 = LD64(KGb, rl, 0); g1 = LD64(KGb, rl, 1); g2 = LD64(KGb, rl, 2);
            S0 = MFMA32(g0, vb0, S0); g0 = LD64(KGb, rl, 3);
            S0 = MFMA32(g1, vb1, S0); g1 = LD64(KGb, 32 + rl, 0);
            S0 = MFMA32(g2, vb2, S0); g2 = LD64(KGb, 32 + rl, 1);
            S0 = MFMA32(g0, vb3, S0); g0 = LD64(KGb, 32 + rl, 2);
            S1 = MFMA32(g1, vb0, S1); g1 = LD64(KGb, 32 + rl, 3);
            S1 = MFMA32(g2, vb1, S1); g2 = LD64(KGb, 64 + rl, 0);
            S1 = MFMA32(g0, vb2, S1); g0 = LD64(KGb, 64 + rl, 1);
            S1 = MFMA32(g1, vb3, S1); g1 = LD64(KGb, 64 + rl, 2);
            S2 = MFMA32(g2, vb0, S2); g2 = LD64(KGb, 64 + rl, 3);
            S2 = MFMA32(g0, vb1, S2); g0 = LD64(KGb, 96 + rl, 0);
            S2 = MFMA32(g1, vb2, S2); g1 = LD64(KGb, 96 + rl, 1);
            S2 = MFMA32(g2, vb3, S2); g2 = LD64(KGb, 96 + rl, 2);
            S3 = MFMA32(g0, vb0, S3); g0 = LD64(KGb, 96 + rl, 3);
            S3 = MFMA32(g1, vb1, S3);
            S3 = MFMA32(g2, vb2, S3);
            S3 = MFMA32(g0, vb3, S3);
        }
        }
    }
#undef GB_STAGE
#undef LD128
#undef LD64
#undef GB_LOADU
}

__device__ __forceinline__ void gdc_passB_idle() {
    __syncthreads();
    for (int n = 0; n < 32; ++n) { asm volatile("" ::: "memory"); __builtin_amdgcn_s_barrier(); asm volatile("" ::: "memory"); }
}

__device__ __forceinline__ void gdc_passC(int u, const unsigned char* HB, const unsigned char* YB, const bf16_t* PROJ, const float* gnorm, bf16_t* MIXO, const Ctx& c) {
    const int bh = u >> 5, b = bh >> 2, h = bh & 3;
    const size_t t0 = (size_t)b * SEQ + (u & 31) * 64;
    const int lane = c.lane, wid = __builtin_amdgcn_readfirstlane(c.wid);
    const int h5 = lane >> 5, r = lane & 31;
    float* sqL = (float*)c.smem;
    const bf16_t* ST = (const bf16_t*)(YB + GC_ST) + (size_t)u * 16384 + (size_t)(2 * h5) * 512 + (size_t)(wid * 32 + r) * 4;
    const bf16_t* VT = (const bf16_t*)(YB + GC_VT) + (size_t)u * 8192 + (size_t)(2 * h5) * 512 + (size_t)(wid * 32 + r) * 4;
    const bf16_t* QG = (const bf16_t*)(HB + GD_QG) + (size_t)u * 8192 + (size_t)r * 128 + 8 * h5;
    const bf16_t* AT = (const bf16_t*)(HB + GD_AT) + (size_t)u * 4096 + (size_t)r * 64 + 8 * h5;
    f32x16 o0, o1;
#pragma unroll
    for (int i = 0; i < 16; ++i) { o0[i] = 0.f; o1[i] = 0.f; }
#pragma unroll
    for (int ks = 0; ks < 8; ++ks) {
        const bf16x8 sa = __builtin_shufflevector(*(const s16x4*)(ST + (4 * ks) * 512), *(const s16x4*)(ST + (4 * ks + 1) * 512), 0, 1, 2, 3, 4, 5, 6, 7);
        const bf16x8 q0 = *(const bf16x8*)(QG + ks * 16), q1 = *(const bf16x8*)(QG + 32 * 128 + ks * 16);
        o0 = MFMA32(sa, q0, o0); o1 = MFMA32(sa, q1, o1);
        if (ks == 3) asm volatile("" ::: "memory");
    }
#pragma unroll
    for (int k2 = 0; k2 < 4; ++k2) {
        const bf16x8 va = __builtin_shufflevector(*(const s16x4*)(VT + (4 * k2) * 512), *(const s16x4*)(VT + (4 * k2 + 1) * 512), 0, 1, 2, 3, 4, 5, 6, 7);
        const bf16x8 a1 = *(const bf16x8*)(AT + 32 * 64 + k2 * 16);
        o1 = MFMA32(va, a1, o1);
        if (k2 < 2) { const bf16x8 a0 = *(const bf16x8*)(AT + k2 * 16); o0 = MFMA32(va, a0, o0); }
    }
    float s0 = 0.f, s1 = 0.f;
#pragma unroll
    for (int i = 0; i < 16; ++i) { s0 += o0[i] * o0[i]; s1 += o1[i] * o1[i]; }
    s0 += shfl_xor_(s0, 32); s1 += shfl_xor_(s1, 32);
    __syncthreads();
    if (h5 == 0) { sqL[wid * 64 + r] = s0; sqL[wid * 64 + 32 + r] = s1; }
    __syncthreads();
    const float rr0 = rsqrtf((sqL[r] + sqL[64 + r] + sqL[128 + r] + sqL[192 + r]) * (1.f / 128.f) + 1e-6f);
    const float rr1 = rsqrtf((sqL[32 + r] + sqL[96 + r] + sqL[160 + r] + sqL[224 + r]) * (1.f / 128.f) + 1e-6f);
#pragma unroll
    for (int tt = 0; tt < 2; ++tt) {
        const size_t t = t0 + tt * 32 + r;
        const bf16_t* zrow = PROJ + t * NPAD + 1960 + h * 128 + wid * 32 + 4 * h5;
        const float* gn = gnorm + wid * 32 + 4 * h5;
        bf16_t* orow = MIXO + t * 1024 + 512 + h * 128 + wid * 32 + 4 * h5;
        const float rr = tt ? rr1 : rr0;
#pragma unroll
        for (int g = 0; g < 4; ++g) {
            const u32x2 zr = *(const u32x2*)(zrow + 8 * g);
            const f32x4 gv = *(const f32x4*)(gn + 8 * g);
            const float z0 = bflo(zr.x), z1 = bfhi(zr.x), z2 = bflo(zr.y), z3 = bfhi(zr.y);
            const float y0 = (tt ? o1[4 * g] : o0[4 * g]) * rr * gv[0] * siluf_(z0), y1 = (tt ? o1[4 * g + 1] : o0[4 * g + 1]) * rr * gv[1] * siluf_(z1);
            const float y2 = (tt ? o1[4 * g + 2] : o0[4 * g + 2]) * rr * gv[2] * siluf_(z2), y3 = (tt ? o1[4 * g + 3] : o0[4 * g + 3]) * rr * gv[3] * siluf_(z3);
            *(u32x2*)(orow + 8 * g) = (u32x2){pk2(y0, y1), pk2(y2, y3)};
        }
    }
}

__device__ __forceinline__ void phase_post(const float* OG, const bf16_t* PROJ, const float* gain, bool odd, bf16_t* MIXO, const Ctx& c) {
    const int lane = c.lane;
    const int gcol = odd ? 1032 : 1960, ocol = odd ? 0 : 512;
    for (int t = c.bid * 4 + c.wid; t < T; t += c.nblk * 4) {
        const f32x4 a0 = *(const f32x4*)(OG + (size_t)t * 512 + lane * 8), a1 = *(const f32x4*)(OG + (size_t)t * 512 + lane * 8 + 4);
        float ss = (a0[0] * a0[0] + a0[1] * a0[1]) + (a0[2] * a0[2] + a0[3] * a0[3]) + (a1[0] * a1[0] + a1[1] * a1[1]) + (a1[2] * a1[2] + a1[3] * a1[3]);
        ss = red16(ss);
        const float rr = rsqrtf(ss * (1.f / 128.f) + 1e-6f);
        const u32x4 zr = *(const u32x4*)(PROJ + (size_t)t * NPAD + gcol + lane * 8);
        float z[8]; unpack8(zr, z);
        const int gi = odd ? lane * 8 : (lane & 15) * 8;
        const f32x4 g0 = *(const f32x4*)(gain + gi), g1 = *(const f32x4*)(gain + gi + 4);
        float y[8];
#pragma unroll
        for (int j = 0; j < 4; ++j) {
            const float ga = odd ? sigmoidf_(z[j]) : siluf_(z[j]), gb = odd ? sigmoidf_(z[4 + j]) : siluf_(z[4 + j]);
            y[j] = a0[j] * rr * g0[j] * ga; y[4 + j] = a1[j] * rr * g1[j] * gb;
        }
        *(u32x4*)(MIXO + (size_t)t * 1024 + ocol + lane * 8) = (u32x4){pk2(y[0], y[1]), pk2(y[2], y[3]), pk2(y[4], y[5]), pk2(y[6], y[7])};
    }
}

__global__ void __launch_bounds__(512, 2) fwd(Args a) {
    extern __shared__ __attribute__((aligned(16))) unsigned char smem[];
    Ctx c;
    const int wave_s = __builtin_amdgcn_readfirstlane((int)threadIdx.x >> 6);
#define SET_CTX(cx) do { int t_ = (wave_s << 6) | lane_id_v(); cx.tid0 = t_; cx.half = t_ >> 8; cx.tid = t_ & 255; cx.lane = t_ & 63; cx.wid = (t_ >> 6) & 3; \
        cx.wr = cx.wid >> 1; cx.wc = cx.wid & 1; cx.fr = cx.lane & 15; cx.fq = cx.lane >> 4; cx.bid = blockIdx.x * 2 + cx.half; cx.nblk = gridDim.x * 2; \
        cx.smem0 = smem; cx.smem = smem + cx.half * HALF_LDS; } while (0)
    SET_CTX(c);
#define PH_CTX() SET_CTX(c)
    unsigned char* const ws_base = a.ws;
    const void* const* const ain_base = (const void* const*)__builtin_amdgcn_kernarg_segment_ptr();
    unsigned* ctl = (unsigned*)(ws_base + WS_CTL);
    volatile LAS unsigned* xbw = (volatile LAS unsigned*)(smem + LDS_BLK);
    if (c.tid0 < 8) xbw[c.tid0] = 0u;
    __syncthreads();
    XcdBarrier bar; bar.bar = ctl; bar.x = 0; bar.st = xbw; bar.wave = wave_s;
    if (a.use_bar) bar = xcd_barrier_post(ctl, xbw, c.tid0);
#if ONE_LAUNCH
    const int hi = NPH;
#define IN(k) true
#else
    const int lo = a.ph_lo, hi = a.ph_hi;
#define IN(k) (lo <= (k) && (k) < hi)
#endif
#define PH(k) if (IN(k)) { PH_CTX(); unsigned char* ws = ws_base; const void* const* ain = ain_base; asm volatile("" : "+s"(ws), "+s"(ain));
#define UNIT_CTX() Ctx cu; SET_CTX(cu)
#define SEAM(k) do { if ((k) + 1 < hi) xcd_barrier(bar); } while (0)

#define XBF ((bf16_t*)(ws + WS_XBF))
#define X1 ((float*)(ws + WS_X1))
#define PROJ ((bf16_t*)(ws + U_PROJ))
#define GATES ((float*)(ws + U_GATES))
#define MIXO ((bf16_t*)(ws + U_MIXO))
#define YBUF ((float*)(ws + U_YBUF))
#define ROPEM ((const float*)(ws + WS_ROPEM))
#define ROPES ((const float*)(ws + WS_ROPES))
#define XRES ((layer == 0) ? (const float*)ain[0] : (const float*)a.out)
#define CNT (ctl + CW_CNT + layer * 128)
#define WIN ((const bf16_t*)(ws + WS_WIN) + (size_t)layer * WIN_ELEMS)
#define WOUT ((const bf16_t*)(ws + WS_WOUT) + (size_t)layer * WOUT_ELEMS)

    PH(0) for (int rep = 0; rep < REP_PRO; ++rep) phase_prologue(a, c); SEAM(0); }

    for (int layer = 0; layer < 4; ++layer) {
        const int pb = 1 + layer * PPL;
#if !ONE_LAUNCH
        if (pb >= hi || pb + PPL <= lo) continue;
#endif
        const int jj = layer >> 1;
        const bool odd = (layer & 1) != 0;

        PH(pb + 0) {
                DenseSched S{T / 256, NPAD / 256, 1024, (int)blockIdx.x, (int)gridDim.x};
                EpiIn E{PROJ, GATES, odd ? 1024 : 1952};
                g8::phase<true, false>(smem, (const char*)XBF, (const char*)WIN, 1024, S, E, c.tid0);
            }
            SEAM(pb + 0); }
        PH(pb + 1) for (int rp = 0; rp < ((REP_PHASE == 1) ? 2 : 1); ++rp) { if (rp) xcd_barrier(bar);
            if (!odd) phase_prep_even(PROJ, GATES, (const float*)ain[3] + jj * 256, (const float*)ain[5] + jj * 128, (const float*)ain[7] + jj * 4 * 1536,
                                      (const float*)ain[8] + jj * 4, (const float*)ain[9] + jj * 4, ROPEM,
                                      (bf16_t*)(ws + U_CQ), (bf16_t*)(ws + U_CKV), (bf16_t*)(ws + U_KROPE), (bf16_t*)(ws + U_GQ), (bf16_t*)(ws + U_GK), (bf16_t*)(ws + U_GV),
                                      (float*)(ws + U_BETA), (float*)(ws + U_GLOG), c);
            else {
                phase_prep_odd(PROJ, ROPES, (bf16_t*)(ws + U_QF), (bf16_t*)(ws + U_KN), c);
                unsigned* ctr = ctl + CW_WORK + pb + 1 + 64 * rp;
                for (;;) {
                    const int u = next_unit(ctr, c); UNIT_CTX();
                    if (u >= 1024) break;
                    mlc_passA(u, PROJ, GATES, (const float*)ain[13] + jj * 4, (const float*)ain[14] + jj * 4, (unsigned char*)YBUF, cu);
                }
            }
            }
            SEAM(pb + 1);
        }
        PH(pb + 2) for (int rp = 0; rp < ((REP_PHASE == 2) ? 2 : 1); ++rp) { if (rp) xcd_barrier(bar);
            unsigned* ctr = ctl + CW_WORK + pb + 2 + 64 * rp;
            if (!odd) {
                for (;;) {
                    const int u = next_unit(ctr, c); UNIT_CTX();
                    if (u >= 1024 + MLAUP_TILES) break;
                    if (u < 1024) gdc_passA(u, (const bf16_t*)(ws + U_GQ), (const bf16_t*)(ws + U_GK), (const bf16_t*)(ws + U_GV), (const float*)(ws + U_BETA),
                                            (const float*)(ws + U_GLOG), ws + WS_HBUF, cu);
                    else mla_up_tile(u - 1024, (const bf16_t*)(ws + U_CQ), (const bf16_t*)(ws + WS_WQB) + (size_t)jj * WQB_ELEMS, (const bf16_t*)(ws + U_CKV),
                                     (const bf16_t*)(ws + WS_WKVB) + (size_t)jj * WKVB_ELEMS, ROPEM, (bf16_t*)(ws + U_QF), (bf16_t*)(ws + U_KN), (bf16_t*)(ws + U_VV), cu);
                }
            } else {
                for (;;) {
                    const int u = next_unit(ctr, c); UNIT_CTX();
                    if (u >= 256 + 1024) break;
                    if (u < 256) mlc_passB(u, (unsigned char*)YBUF, cu);
                    else {
                        const int v = u - 256, hq = v & 7, n = (v >> 3) & 15, b = v >> 7, kvh = hq >> 2;
                        const size_t tb = (size_t)b * SEQ;
                        attn_unit<4, true>((const bf16_t*)(ws + U_QF) + tb * 512 + hq * 64, 512, (const bf16_t*)(ws + U_KN) + tb * 128 + kvh * 64, 128,
                                           (const bf16_t*)(ws + U_KN), 0, PROJ + tb * NPAD + 2184 + kvh * 64, NPAD,
                                           MIXO + tb * 1024 + 512 + hq * 64, 1024, n * 128, ((const float*)ain[16])[jj * 8 + hq] * 1.4426950408889634f, cu);
                    }
                }
            }
            }
            SEAM(pb + 2);
        }
        PH(pb + 3) for (int rp = 0; rp < ((REP_PHASE == 3) ? 2 : 1); ++rp) { if (rp) xcd_barrier(bar);
            unsigned* ctr = ctl + CW_WORK + pb + 3 + 64 * rp;
            if (!odd) {
                for (;;) {
                    const int u = next_unit(ctr, c); UNIT_CTX();
                    if (u >= 64 + 1024) break;
                    if (rp > 0 && ((REP_ONLY == 1 && u >= 64) || (REP_ONLY == 2 && u < 64))) continue;
                    if (u < 64) { if ((u & 1) == 0) gdc_passB(u >> 1, ws + WS_HBUF, (unsigned char*)YBUF, cu); else gdc_passB_idle(); }
                    else {
                        const int v = u - 64, qb = 15 - (v >> 6), bh = v & 63, b = bh >> 3, hh = bh & 7;
                        const size_t tb = (size_t)b * SEQ;
                        attn_unit<6, false>((const bf16_t*)(ws + U_QF) + tb * 768 + hh * 96, 768, (const bf16_t*)(ws + U_KN) + tb * 512 + hh * 64, 512,
                                            (const bf16_t*)(ws + U_KROPE) + tb * 32, 32, (const bf16_t*)(ws + U_VV) + tb * 512 + hh * 64, 512,
                                            MIXO + tb * 1024 + hh * 64, 1024, qb * 128, 0.f, cu);
                    }
                }
            } else {
                for (;;) {
                    const int u = next_unit(ctr, c); UNIT_CTX();
                    if (u >= 1024) break;
                    mlc_passC(u, PROJ, GATES, (const float*)ain[13] + jj * 4, (const float*)ain[14] + jj * 4, (const unsigned char*)YBUF, (const float*)ain[15] + jj * 512, MIXO, cu);
                }
            }
            }
            SEAM(pb + 3);
        }
        PH(pb + 4) for (int rp = 0; rp < ((REP_PHASE == 4) ? 2 : 1); ++rp) { if (rp) xcd_barrier(bar);
            if (!odd) {
                unsigned* ctr = ctl + CW_WORK + pb + 4 + 64 * rp;
                for (;;) {
                    const int u = next_unit(ctr, c); UNIT_CTX();
                    if (u >= 1024) break;
                    gdc_passC(u, ws + WS_HBUF, (const unsigned char*)YBUF, PROJ, (const float*)ain[10] + jj * 128, MIXO, cu);
                }
            }
            }
            if (!odd) SEAM(pb + 4);
        }
        PH(pb + 5) {
                DenseSched S{T / 256, 4, 1024, (int)blockIdx.x, (int)gridDim.x};
                EpiOut E{XBF, (bf16_t*)YBUF};
                g8::phase<true, false>(smem, (const char*)MIXO, (const char*)WOUT, 1024, S, E, c.tid0);
            }
            SEAM(pb + 5); }
#if FUSE_LNROUTE
        PH(pb + 6) phase_lnroute((const bf16_t*)YBUF, (const float*)ain[18] + layer * 1024, (const float*)ain[19] + layer * 1024, XBF, (const bf16_t*)(ws + WS_WRT) + (size_t)layer * WRT_ELEMS,
                                 (const float*)ain[21] + layer * 64, CNT, (int*)(ws + WS_LTOK), (float*)(ws + WS_LW), (int*)(ws + WS_ASG), (float*)(ws + WS_ASGW), c); SEAM(pb + 8); }
#else
        PH(pb + 6) for (int rep = 0; rep < REP_TOK; ++rep) phase_ln1((const bf16_t*)YBUF, (const float*)ain[18] + layer * 1024, (const float*)ain[19] + layer * 1024, XBF, c); SEAM(pb + 6); }
        PH(pb + 7) for (int rep = 0; rep < REP_GEMM; ++rep) phase_router(XBF, (const bf16_t*)(ws + WS_WRT) + (size_t)layer * WRT_ELEMS, (float*)(ws + WS_LOG), c); SEAM(pb + 7); }
        PH(pb + 8) phase_route((const float*)(ws + WS_LOG), (const float*)ain[21] + layer * 64, CNT, (int*)(ws + WS_LTOK), (float*)(ws + WS_LW), (int*)(ws + WS_ASG), (float*)(ws + WS_ASGW), c); SEAM(pb + 8); }
#endif
        PH(pb + 9) {
                int* bst8 = (int*)(smem + LDS_BLK + 64); int* eb8 = bst8 + 256;
                build_block_table(CNT, bst8, c);
                for (int rb = c.tid0; rb < bst8[65]; rb += NT) { int e = 0; for (int q = 1; q < 65; ++q) e += (bst8[q] <= rb) ? 1 : 0; eb8[rb] = e; }
                __syncthreads();
                MoeSchedG S{__builtin_amdgcn_readfirstlane(bst8[65]), (int)blockIdx.x, (int)gridDim.x, eb8, bst8, (const int*)(ws + WS_LTOK)};
                EpiMoe1 E{(bf16_t*)(ws + WS_HBUF)};
                g8::phase<false, true>(smem, (const char*)XBF, (const char*)((const bf16_t*)(ws + WS_WGU) + (size_t)layer * 65 * WGU_ELEMS), 1024, S, E, c.tid0);
            }
            SEAM(pb + 9); }
        PH(pb + 10)
#if MOE2_G8
            {
                int* bst8 = (int*)(smem + LDS_BLK + 64); int* eb8 = bst8 + 256;
                build_block_table(CNT, bst8, c);
                for (int rb = c.tid0; rb < bst8[65]; rb += NT) { int e = 0; for (int q = 1; q < 65; ++q) e += (bst8[q] <= rb) ? 1 : 0; eb8[rb] = e; }
                __syncthreads();
                MoeSched S{__builtin_amdgcn_readfirstlane(bst8[65]), 4, (int)blockIdx.x, (int)gridDim.x, eb8};
                EpiMoe2 E{(bf16_t*)(ws + U_Y)};
                g8::phase<true, false>(smem, (const char*)(ws + WS_HBUF), (const char*)((const bf16_t*)(ws + WS_WDN) + (size_t)layer * 65 * WDN_ELEMS), 256, S, E, c.tid0);
            }
#else
            phase_moe2((const bf16_t*)(ws + WS_HBUF), (const bf16_t*)(ws + WS_WDN) + (size_t)layer * 65 * WDN_ELEMS, CNT, (bf16_t*)(ws + U_Y), c);
#endif
            SEAM(pb + 10); }
        PH(pb + 11)
            if (layer == 3) phase_combine<true>((const bf16_t*)(ws + U_Y), (const int*)(ws + WS_ASG), (const float*)(ws + WS_ASGW), CNT, (const float*)ain[28] + layer * 1024, (const float*)ain[29] + layer * 1024, a.out, XBF, c);
            else phase_combine<false>((const bf16_t*)(ws + U_Y), (const int*)(ws + WS_ASG), (const float*)(ws + WS_ASGW), CNT, (const float*)ain[28] + layer * 1024, (const float*)ain[29] + layer * 1024, a.out, XBF, c);
            SEAM(pb + 11); }
    }
#undef IN
#undef XBF
#undef X1
#undef PROJ
#undef GATES
#undef MIXO
#undef YBUF
#undef ROPEM
#undef ROPES
#undef XRES
#undef CNT
#undef WIN
#undef WOUT
#undef PH
#undef PH_CTX
#undef UNIT_CTX
#undef SEAM
}

extern "C" void kernel_launch(void* const* d_in, const int* in_sizes, int n_in, void* d_out, int out_size, void* d_ws, size_t ws_size, hipStream_t stream) {
    static int grid = 0;
    if (grid == 0) {
        if (n_in != 30 || out_size != T * 1024 || ws_size < WS_END) {
            fprintf(stderr, "kernel_launch: unexpected shapes (n_in %d, out %d, ws %zu < %zu)\n", n_in, out_size, ws_size, (size_t)WS_END);
            grid = -1; return;
        }
        int dev = 0, cus = 0, per_cu = 0;
        (void)hipGetDevice(&dev);
        (void)hipDeviceGetAttribute(&cus, hipDeviceAttributeMultiprocessorCount, dev);
        (void)hipFuncSetAttribute((const void*)fwd, hipFuncAttributeMaxDynamicSharedMemorySize, DYN_LDS);
        (void)hipOccupancyMaxActiveBlocksPerMultiprocessor(&per_cu, (const void*)fwd, NT, DYN_LDS);
        (void)hipGetLastError();
        if (per_cu < 1) per_cu = 1;
        grid = cus;
    }
    if (grid < 0) return;
    (void)hipMemsetAsync((char*)d_ws + WS_CTL, 0, CTL_BYTES, stream);
    Args a{};
    for (int i = 0; i < 30; ++i) a.in[i] = d_in[i];
    a.out = (float*)d_out; a.ws = (unsigned char*)d_ws; a.pad = 0;
#if ONE_LAUNCH
    a.ph_lo = 0; a.ph_hi = NPH; a.use_bar = 1;
    hipLaunchKernelGGL(fwd, dim3(grid), dim3(NT), DYN_LDS, stream, a);
#else
    for (int p = 0; p < NPH; ++p) {
        a.ph_lo = p; a.ph_hi = p + 1; a.use_bar = 0;
        hipLaunchKernelGGL(fwd, dim3(grid), dim3(NT), DYN_LDS, stream, a);
    }
#endif
}
```

```cpp
#include <hip/hip_runtime.h>
#include <stdint.h>
#include <stdio.h>

#define REP_GEMM 1
#define REP_PHASE 0
#define REP_G0 1
#define REP_G1 1
#define REP_G2 1
#define REP_G3 1
#define REP_MIX 1
#define REP_ONLY 0
#define REP_CMB 1
#define REP_PRO 1
#define REP_TOK 1
#define MOE2_G8 1
#ifndef G8_SPLIT
#define G8_SPLIT 0
#endif
#ifndef FUSE_LNROUTE
#define FUSE_LNROUTE 1
#endif
#ifndef ONE_LAUNCH
#define ONE_LAUNCH 1
#endif

typedef unsigned short bf16_t;
typedef short bf16x8 __attribute__((ext_vector_type(8)));
typedef float f32x4 __attribute__((ext_vector_type(4)));
typedef unsigned u32x4 __attribute__((ext_vector_type(4)));
typedef unsigned u32x2 __attribute__((ext_vector_type(2)));
#define LAS __attribute__((address_space(3)))
#define GAS __attribute__((address_space(1)))

constexpr int T = 16384, SEQ = 2048;
constexpr int NPAD = 2560;
constexpr int CAP = 16384;
constexpr int RBR = 256;
constexpr int MAXRB = 512 + 64 + 64;
constexpr int MAXROWS = MAXRB * RBR;
constexpr float ALPHA = 1.681792830507429f;
constexpr int PPL = 12;
constexpr int NPH = 1 + 4 * PPL;
constexpr int NT = 512, NW = 8;
constexpr int HALF_LDS = 65536 + 64 + 1024;
constexpr int LDS_BLK = 2 * HALF_LDS;
constexpr int DYN_LDS = LDS_BLK + 64 + 1024 + 2560;

constexpr size_t cmax(size_t a, size_t b) { return a > b ? a : b; }
constexpr size_t WS_CTL = 0;
constexpr size_t CTL_BYTES = 65536;
constexpr size_t WS_WIN = WS_CTL + CTL_BYTES;
constexpr size_t WIN_ELEMS = (size_t)NPAD * 1024;
constexpr size_t WS_WQB = WS_WIN + 4 * WIN_ELEMS * 2;
constexpr size_t WQB_ELEMS = 768 * 256;
constexpr size_t WS_WKVB = WS_WQB + 2 * WQB_ELEMS * 2;
constexpr size_t WKVB_ELEMS = 1024 * 128;
constexpr size_t WS_WOUT = WS_WKVB + 2 * WKVB_ELEMS * 2;
constexpr size_t WOUT_ELEMS = 1024 * 1024;
constexpr size_t WS_WRT = WS_WOUT + 4 * WOUT_ELEMS * 2;
constexpr size_t WRT_ELEMS = 128 * 1024;
constexpr size_t WS_WGU = WS_WRT + 4 * WRT_ELEMS * 2;
constexpr size_t WGU_ELEMS = 512 * 1024;
constexpr size_t WS_WDN = WS_WGU + 4 * 65 * WGU_ELEMS * 2;
constexpr size_t WDN_ELEMS = 1024 * 256;
constexpr size_t WS_ROPEM = WS_WDN + 4 * 65 * WDN_ELEMS * 2;
constexpr size_t WS_ROPES = WS_ROPEM + (size_t)T * 16 * 2 * 4;
constexpr size_t WS_X1 = WS_ROPES + (size_t)T * 32 * 2 * 4;
constexpr size_t WS_XBF = WS_X1 + (size_t)T * 1024 * 4;
constexpr size_t WS_HBUF = WS_XBF + (size_t)T * 1024 * 2;
constexpr size_t WS_LOG = WS_HBUF + (size_t)MAXROWS * 256 * 2;
constexpr size_t WS_ASG = WS_LOG + (size_t)T * 64 * 4;
constexpr size_t WS_ASGW = WS_ASG + (size_t)T * 8 * 4;
constexpr size_t WS_LTOK = WS_ASGW + (size_t)T * 8 * 4;
constexpr size_t WS_LW = WS_LTOK + (size_t)65 * CAP * 4;
constexpr size_t WS_U = WS_LW + (size_t)65 * CAP * 4;
constexpr size_t U_Y = WS_U;
constexpr size_t U_PROJ = WS_U;
constexpr size_t U_GATES = U_PROJ + (size_t)T * NPAD * 2;
constexpr size_t U_CQ = U_GATES + (size_t)T * 8 * 4;
constexpr size_t U_CKV = U_CQ + (size_t)T * 256 * 2;
constexpr size_t U_KROPE = U_CKV + (size_t)T * 128 * 2;
constexpr size_t U_QF = U_KROPE + (size_t)T * 32 * 2;
constexpr size_t U_KN = U_QF + (size_t)T * 768 * 2;
constexpr size_t U_VV = U_KN + (size_t)T * 512 * 2;
constexpr size_t U_GQ = U_VV + (size_t)T * 512 * 2;
constexpr size_t U_GK = U_GQ + (size_t)T * 512 * 2;
constexpr size_t U_GV = U_GK + (size_t)T * 512 * 2;
constexpr size_t U_BETA = U_GV + (size_t)T * 512 * 2;
constexpr size_t U_GLOG = U_BETA + (size_t)T * 4 * 4;
constexpr size_t U_MIXO = U_GLOG + (size_t)T * 4 * 4;
constexpr size_t U_YBUF = U_MIXO + (size_t)T * 1024 * 2;
constexpr size_t U_END1 = U_YBUF + (size_t)T * 1024 * 4;
constexpr size_t WS_END = WS_U + cmax((size_t)MAXROWS * 1024 * 2, U_END1 - WS_U);

constexpr int CW_CNT = 4096;
constexpr int CW_WORK = 8192;

#define XB_TMO      128
#define XB_XCNT(j)  (256  + 64 * (j))
#define XB_XSUB(j)  (1280 + 64 * (j))
#define XB_XGEN(j)  (2304 + 64 * (j))
#define XB_TOP      3328
#define XB_TOPGEN   3392
#define XCD_BAR_WORDS 3456
#define XB_SPIN_CAP (1u << 18)

__device__ __forceinline__ unsigned xb_ld(unsigned* p)              { return __hip_atomic_load(p, __ATOMIC_RELAXED, __HIP_MEMORY_SCOPE_AGENT); }
__device__ __forceinline__ int lane_id_v() { int l; asm volatile("v_mbcnt_lo_u32_b32 %0, -1, 0\n\tv_mbcnt_hi_u32_b32 %0, -1, %0" : "=v"(l)); return l; }
__device__ __forceinline__ unsigned xb_add(unsigned* p, unsigned v) { return __hip_atomic_fetch_add(p, v, __ATOMIC_RELAXED, __HIP_MEMORY_SCOPE_AGENT); }
__device__ __forceinline__ unsigned xb_xcc_id() { return (unsigned)__builtin_amdgcn_s_getreg((3 << 11) | 20) & 0xFu; }
#define XB_SPIN(cond, bar) do { unsigned _sp = 0; while (cond) { __builtin_amdgcn_s_sleep(1); \
    if ((++_sp & 255u) == 0u) { if (xb_ld(&(bar)[XB_TMO])) break; if (_sp > XB_SPIN_CAP) { atomicAdd(&(bar)[XB_TMO], 1u); break; } } } } while (0)

struct XcdBarrier { unsigned* bar; unsigned x; volatile LAS unsigned* st; int wave; };

__device__ __forceinline__ XcdBarrier xcd_barrier_post(unsigned* bar, volatile LAS unsigned* st, int tid0) {
    XcdBarrier b; b.bar = bar; b.x = xb_xcc_id(); b.st = st; b.wave = __builtin_amdgcn_readfirstlane(tid0 >> 6);
    if (tid0 == 0) (void)xb_add(&bar[XB_XCNT(b.x)], 1u);
    return b;
}
__device__ __forceinline__ void xcd_barrier_complete(unsigned* bar, unsigned x, unsigned& nloc, unsigned& nx) {
    const unsigned G = gridDim.x * gridDim.y * gridDim.z;
    unsigned sum, cnt, mine, sp = 0u;
    for (;;) {
        sum = 0u; cnt = 0u; mine = 0u;
#pragma unroll
        for (unsigned j = 0; j < 16; ++j) { const unsigned c = xb_ld(&bar[XB_XCNT(j)]); sum += c; cnt += (c > 0u) ? 1u : 0u; mine = (j == x) ? c : mine; }
        if (sum == G) break;
        __builtin_amdgcn_s_sleep(1);
        if ((++sp & 255u) == 0u) { if (xb_ld(&bar[XB_TMO])) break; if (sp > XB_SPIN_CAP) { atomicAdd(&bar[XB_TMO], 1u); break; } }
    }
    nloc = mine > 0u ? mine : 1u; nx = cnt > 0u ? cnt : 1u;
}
__device__ __forceinline__ void xcd_barrier(const XcdBarrier& b) {
    asm volatile("s_waitcnt vmcnt(0)" ::: "memory");
    __syncthreads();
    if (b.wave == 0 && lane_id_v() == 0) {
        unsigned* bar = b.bar; unsigned bx = __builtin_amdgcn_readfirstlane(b.x);
        asm volatile("" : "+s"(bar), "+s"(bx));
        __builtin_amdgcn_s_waitcnt(0);
        unsigned nloc = b.st[0], nx = b.st[1];
        if (nloc == 0u) { xcd_barrier_complete(bar, bx, nloc, nx); b.st[0] = nloc; b.st[1] = nx; }
        const unsigned old = xb_add(&bar[XB_XSUB(bx)], 1u);
        const unsigned gen = old / nloc;
        if (old + 1u == (gen + 1u) * nloc) {
            __builtin_amdgcn_fence(__ATOMIC_RELEASE, "agent");
            asm volatile("s_waitcnt vmcnt(0)" ::: "memory");
            const unsigned og = xb_add(&bar[XB_TOP], 1u);
            const unsigned tg = og / nx;
            if (og + 1u == (tg + 1u) * nx) xb_add(&bar[XB_TOPGEN], 1u);
            else XB_SPIN(xb_ld(&bar[XB_TOPGEN]) == tg, bar);
            __builtin_amdgcn_fence(__ATOMIC_ACQUIRE, "agent");
            xb_add(&bar[XB_XGEN(bx)], 1u);
            asm volatile("s_waitcnt vmcnt(0)" ::: "memory");
        } else {
            XB_SPIN(xb_ld(&bar[XB_XGEN(bx)]) == gen, bar);
            __builtin_amdgcn_fence(__ATOMIC_ACQUIRE, "agent");
            asm volatile("s_waitcnt vmcnt(0)" ::: "memory");
        }
    }
    __syncthreads();
}

__device__ __forceinline__ float bf2f(unsigned v) { return __uint_as_float(v << 16); }
__device__ __forceinline__ float bflo(unsigned w) { return __uint_as_float(w << 16); }
__device__ __forceinline__ float bfhi(unsigned w) { return __uint_as_float(w & 0xffff0000u); }
__device__ __forceinline__ unsigned f2bf(float f) { unsigned u = __float_as_uint(f); u += 0x7fffu + ((u >> 16) & 1u); return u >> 16; }
__device__ __forceinline__ unsigned pk2(float lo, float hi) { return f2bf(lo) | (f2bf(hi) << 16); }
__device__ __forceinline__ unsigned cvt_pk(float lo, float hi) { unsigned r; asm volatile("v_cvt_pk_bf16_f32 %0, %1, %2" : "=v"(r) : "v"(lo), "v"(hi)); return r; }
template <class T> __device__ __forceinline__ T shfl_xor_(T v, int o) { return __builtin_bit_cast(T, __builtin_amdgcn_ds_bpermute((lane_id_v() ^ o) << 2, __builtin_bit_cast(int, v))); }
template <class T> __device__ __forceinline__ T shfl_up_(T v, int o) { const int l = lane_id_v(), s = (l - o < 0) ? l : l - o; return __builtin_bit_cast(T, __builtin_amdgcn_ds_bpermute(s << 2, __builtin_bit_cast(int, v))); }
template <class T> __device__ __forceinline__ T shfl_c_(T v, int src  ) { return __builtin_bit_cast(T, __builtin_amdgcn_readlane(__builtin_bit_cast(int, v), src)); }
__device__ __forceinline__ float wave_sum(float v) {
#pragma unroll
    for (int o = 32; o > 0; o >>= 1) v += shfl_xor_(v, o);
    return v;
}
__device__ __forceinline__ float sigmoidf_(float x) { return 1.f / (1.f + expf(-x)); }
__device__ __forceinline__ float siluf_(float x) { return x / (1.f + expf(-x)); }
__device__ __forceinline__ float softplusf_(float x) { return x > 20.f ? x : log1pf(expf(x)); }
__device__ __forceinline__ void glds16(const void* g, void* l) {
    __builtin_amdgcn_global_load_lds((const GAS unsigned*)g, (LAS unsigned*)l, 16, 0, 0);
}
__device__ __forceinline__ void unpack8(const u32x4 r, float (&f)[8]) {
    f[0] = bflo(r.x); f[1] = bfhi(r.x); f[2] = bflo(r.y); f[3] = bfhi(r.y);
    f[4] = bflo(r.z); f[5] = bfhi(r.z); f[6] = bflo(r.w); f[7] = bfhi(r.w);
}

struct Args {
    const void* in[30];
    float* out;
    unsigned char* ws;
    int ph_lo, ph_hi, use_bar, pad;
};

struct Ctx { int tid, lane, wid, wr, wc, fr, fq, bid, nblk; unsigned char* smem; int half, tid0; unsigned char* smem0; };

#define WAIT_V(n) asm volatile("s_waitcnt vmcnt(" #n ")" ::: "memory")
__device__ __forceinline__ void gemm_tile(const bf16_t* a0, const bf16_t* a1, const bf16_t* b0, const bf16_t* b1,
                                          int nk, f32x4 (&acc)[4][4], const Ctx& c) {
#pragma unroll
    for (int m = 0; m < 4; ++m)
#pragma unroll
        for (int n = 0; n < 4; ++n) acc[m][n] = (f32x4){0.f, 0.f, 0.f, 0.f};
    unsigned char* smem = c.smem;
    const int sb = c.tid * 16;
    const int kofs = ((c.tid & 3) ^ ((c.tid >> 4) & 3)) * 8;
    a0 += kofs; a1 += kofs; b0 += kofs; b1 += kofs;
#define G_STAGE(kt_) do { unsigned char* sp_ = smem + ((kt_) & 3) * 16384 + sb; const int ko_ = (kt_) * 32; \
        glds16(a0 + ko_, sp_); glds16(a1 + ko_, sp_ + 4096); glds16(b0 + ko_, sp_ + 8192); glds16(b1 + ko_, sp_ + 12288); } while (0)
#define G_READ(kt_, AF, BF) do { const unsigned char* sa_ = smem + ((kt_) & 3) * 16384 + c.wr * 4096 + roff; const unsigned char* sb_ = smem + ((kt_) & 3) * 16384 + 8192 + c.wc * 4096 + roff; \
        _Pragma("unroll") for (int m = 0; m < 4; ++m) AF[m] = *(const bf16x8*)(sa_ + m * 1024); \
        _Pragma("unroll") for (int n = 0; n < 4; ++n) BF[n] = *(const bf16x8*)(sb_ + n * 1024); } while (0)
#define G_MMA(AF, BF) do { __builtin_amdgcn_s_setprio(1); \
        _Pragma("unroll") for (int m = 0; m < 4; ++m) _Pragma("unroll") for (int n = 0; n < 4; ++n) acc[m][n] = __builtin_amdgcn_mfma_f32_16x16x32_bf16(BF[n], AF[m], acc[m][n], 0, 0, 0); \
        __builtin_amdgcn_s_setprio(0); } while (0)
#define G_BAR() do { asm volatile("" ::: "memory"); __builtin_amdgcn_s_barrier(); asm volatile("" ::: "memory"); } while (0)
    const int roff = (c.fr * 64) + ((c.fq ^ ((c.fr >> 2) & 3)) * 16);
    WAIT_V(0);
    G_STAGE(0); G_STAGE(1); G_STAGE(2); G_STAGE(3);
    bf16x8 fa0[4], fb0[4], fa1[4], fb1[4];
    WAIT_V(12); G_BAR();
    G_READ(0, fa0, fb0);
#define G_LGK0() asm volatile("s_waitcnt lgkmcnt(0)" ::: "memory")
    int kt = 0;
    for (; kt < nk - 4; kt += 4) {
        G_LGK0(); WAIT_V(8); G_BAR(); G_STAGE(kt + 4); G_READ(1, fa1, fb1); G_MMA(fa0, fb0);
        G_LGK0(); WAIT_V(8); G_BAR(); G_STAGE(kt + 5); G_READ(2, fa0, fb0); G_MMA(fa1, fb1);
        G_LGK0(); WAIT_V(8); G_BAR(); G_STAGE(kt + 6); G_READ(3, fa1, fb1); G_MMA(fa0, fb0);
        G_LGK0(); WAIT_V(8); G_BAR(); G_STAGE(kt + 7); G_READ(0, fa0, fb0); G_MMA(fa1, fb1);
    }
    G_LGK0(); WAIT_V(8); G_BAR(); G_READ(1, fa1, fb1); G_MMA(fa0, fb0);
    G_LGK0(); WAIT_V(4); G_BAR(); G_READ(2, fa0, fb0); G_MMA(fa1, fb1);
    G_LGK0(); WAIT_V(0); G_BAR(); G_READ(3, fa1, fb1); G_MMA(fa0, fb0);
    G_MMA(fa1, fb1);
#undef G_LGK0
#undef G_STAGE
#undef G_READ
#undef G_MMA
#undef G_BAR
    __syncthreads();
}

namespace g8 {
constexpr int BM = 256, BK = 64, HALF = 128, HTB = HALF * BK * 2, STAGE_BYTES = 8 * HTB;
__device__ __forceinline__ int lds_byte(int r, int c) { const int st = (r >> 4) * 2 + (c >> 5), rr = r & 15, cc = c & 31, ob = rr * 64 + cc * 2; return st * 1024 + (ob ^ (((ob >> 9) & 1) << 5)); }
__device__ __forceinline__ void stage_rc(int b, int& R, int& C) { const int st = b / 1024, sb = b % 1024, swz = sb ^ (((sb >> 9) & 1) << 5); R = (st >> 1) * 16 + swz / 64; C = (st & 1) * 32 + (swz % 64) / 2; }
__device__ __forceinline__ int perm32(int rho) { const int n = rho >> 4, i = rho & 15; return 8 * (i >> 2) + 4 * n + (i & 3); }
struct Unit { int pm, pn, bt; };

template <bool PERM, bool GATHER, class Sched, class Epi>
__device__ __forceinline__ void phase(unsigned char* ldsp, const char* Abase, const char* Bbase, int K, const Sched& S, const Epi& E, int tid_in) {
    LAS unsigned char* lds = (LAS unsigned char*)ldsp;
    int tid = tid_in; asm volatile("" : "+v"(tid));
    const int wid = __builtin_amdgcn_readfirstlane(tid >> 6), lane = tid & 63, wr = wid >> 2, wc = wid & 3, fr = lane & 15, fq = lane >> 4;
    const int nt = K / BK;
    unsigned voffA[2], voffB[2];
#pragma unroll
    for (int i = 0; i < 2; ++i) { int R, C; stage_rc(tid * 16 + i * 8192, R, C); const int Rb = PERM ? ((R >> 5) * 64 + perm32(R & 31)) : (((R >> 5) * 2 + ((R & 15) >> 3)) * 32 + ((R >> 4) & 1) * 16 + (((R & 15) >> 2) & 1) * 8 + (R & 3));
        voffA[i] = (unsigned)(R * K + C) * 2u; voffB[i] = (unsigned)(Rb * K + C) * 2u; }
    const size_t kstep = (size_t)(BK * 2);
    const size_t hstep = (size_t)HALF * K * 2, tstep = 2 * hstep, bhstep = PERM ? (size_t)32 * K * 2 : (size_t)4 * K * 2;
    const unsigned ldsw = (unsigned)wid * 1024u;
    const int aoff = lds_byte(wr * 64 + fr, fq * 8), boff = lds_byte(wc * 32 + fr, fq * 8);
#define G8_SA(b, h) (((b) * 2 + (h)) * HTB)
#define G8_SB(b, h) ((4 + (b) * 2 + (h)) * HTB)
#define G8_DMA(gptr, voff32, ldsoff) do { const char* _gp = (gptr); const unsigned _lo = (unsigned)(size_t)(ldsp) + (unsigned)(ldsoff); \
        asm volatile("s_mov_b32 m0, %2\n\ts_nop 0\n\tglobal_load_lds_dwordx4 %0, %1" :: "v"(voff32), "s"(_gp), "s"(_lo) : "memory", "m0"); } while (0)
#define G8_STAGE(bufoff, gbase, voff) do { _Pragma("unroll") for (int _i = 0; _i < 2; ++_i) G8_DMA((const char*)(gbase), (voff)[_i], (bufoff) + ldsw + _i * 8192); } while (0)
#define G8_STAGEA(bufoff, gbase, h, kb) do { if constexpr (GATHER) { _Pragma("unroll") for (int _i = 0; _i < 2; ++_i) G8_DMA(Abase + (kb), vA[2 * (h) + _i], (bufoff) + ldsw + _i * 8192); } \
        else G8_STAGE(bufoff, (gbase) + (size_t)(h) * hstep + (kb), voffA); } while (0)
#define G8_LDA(dst, b, h) do { _Pragma("unroll") for (int m = 0; m < 4; ++m) _Pragma("unroll") for (int k = 0; k < 2; ++k) dst[m][k] = *(const LAS bf16x8*)(lds + G8_SA(b, h) + aoff + m * 2048 + k * 1024); } while (0)
#define G8_LDB(dst, b, h) do { _Pragma("unroll") for (int n = 0; n < 2; ++n) _Pragma("unroll") for (int k = 0; k < 2; ++k) dst[n][k] = *(const LAS bf16x8*)(lds + G8_SB(b, h) + boff + n * 2048 + k * 1024); } while (0)
#define G8_MMA(ai, bj, At, Bt) do { __builtin_amdgcn_s_setprio(1); _Pragma("unroll") for (int m = 0; m < 4; ++m) _Pragma("unroll") for (int n = 0; n < 2; ++n) _Pragma("unroll") for (int k = 0; k < 2; ++k) \
        acc[ai][bj][m][n] = __builtin_amdgcn_mfma_f32_16x16x32_bf16(Bt[n][k], At[m][k], acc[ai][bj][m][n], 0, 0, 0); __builtin_amdgcn_s_setprio(0); } while (0)
#define G8_WAIT_V(n) asm volatile("s_waitcnt vmcnt(" #n ")" ::: "memory")
#define G8_WAIT_L(n) asm volatile("s_waitcnt lgkmcnt(" #n ")" ::: "memory")
#define G8_BAR __builtin_amdgcn_s_barrier()
#define G8_SCHED __builtin_amdgcn_sched_barrier(0)
    Unit cur, nxt; int ui = 0;
    if (!S.next(0, cur)) return;
    f32x4 acc[2][2][4][2];
#pragma unroll
    for (int a = 0; a < 2; ++a)
#pragma unroll
        for (int b = 0; b < 2; ++b)
#pragma unroll
            for (int m = 0; m < 4; ++m)
#pragma unroll
                for (int n = 0; n < 2; ++n) acc[a][b][m][n] = (f32x4){0.f, 0.f, 0.f, 0.f};
    bf16x8 At[4][2], B0[2][2], B1[2][2];
    const char* cA = Abase + (size_t)cur.pm * tstep; const char* cB = Bbase + (size_t)cur.bt * tstep;
    unsigned vA[4] = {0u, 0u, 0u, 0u};
    if constexpr (GATHER) S.aoff(cur, tid, vA);
    asm volatile("s_waitcnt vmcnt(0)" ::: "memory");
    G8_STAGE(G8_SB(0, 0), cB, voffB); G8_STAGEA(G8_SA(0, 0), cA, 0, 0); G8_STAGE(G8_SB(0, 1), cB + bhstep, voffB); G8_STAGEA(G8_SA(0, 1), cA, 1, 0);
    if (wr == 1) G8_BAR;
    G8_WAIT_V(4); G8_BAR;
    G8_STAGE(G8_SB(1, 0), cB + kstep, voffB); G8_STAGEA(G8_SA(1, 0), cA, 0, kstep); G8_STAGE(G8_SB(1, 1), cB + bhstep + kstep, voffB);
    G8_WAIT_V(6); G8_BAR;
    G8_STAGEA(G8_SA(1, 1), cA, 1, kstep);
    for (;;) {
        const bool has_next = S.next(ui + 1, nxt);
        const char* nA = has_next ? Abase + (size_t)nxt.pm * tstep : cA; const char* nB = has_next ? Bbase + (size_t)nxt.bt * tstep : cB;
        for (int t = 0; t < nt; t += 2) {
            const bool last = (t == nt - 2);
            const int lastf = __builtin_amdgcn_readfirstlane(last ? 1 : 0);
            const size_t k2 = last ? 0 : (size_t)(t + 2) * kstep, k3 = k2 + kstep;
            const char* a2 = last ? nA : cA; const char* b2 = last ? nB : cB + (size_t)(t + 2) * kstep;
            const char* b3 = b2 + kstep;
            G8_LDB(B0, 0, 0); G8_SCHED; G8_LDA(At, 0, 0);
            if constexpr (GATHER) { if (last && has_next) S.aoff(nxt, tid, vA); }
            G8_WAIT_L(8); G8_BAR; G8_WAIT_L(0); G8_MMA(0, 0, At, B0); G8_BAR; G8_SCHED;
            G8_LDB(B1, 0, 1); G8_STAGE(G8_SB(0, 0), b2, voffB);
            G8_BAR; G8_WAIT_L(0); G8_MMA(0, 1, At, B1); G8_BAR;
            G8_LDA(At, 0, 1); G8_STAGEA(G8_SA(0, 0), a2, 0, k2);
            G8_BAR; G8_WAIT_L(0); G8_MMA(1, 0, At, B0); G8_BAR; G8_SCHED;
            G8_STAGE(G8_SB(0, 1), b2 + bhstep, voffB);
            const int pend = __builtin_amdgcn_readfirstlane((t == 0 && ui > 0) ? 1 : 0);
            asm volatile("s_cmp_lg_u32 %0, 0\n\ts_cbranch_scc1 1f\n\ts_waitcnt vmcnt(6)\n1:\n\ts_waitcnt vmcnt(%1)" :: "s"(pend), "n"(6 + (Epi::SPLIT ? Epi::NQ : Epi::NST)) : "memory", "scc");
            G8_BAR; G8_MMA(1, 1, At, B1); G8_BAR;
            G8_LDB(B0, 1, 0); G8_SCHED; G8_LDA(At, 1, 0); G8_STAGEA(G8_SA(0, 1), a2, 1, k2);
            G8_WAIT_L(8); G8_BAR; G8_WAIT_L(0); G8_MMA(0, 0, At, B0); G8_BAR; G8_SCHED;
            if constexpr (Epi::SPLIT) { E.template part_cond<0, 0>(acc, cur, wr, wc, fr, fq, lastf); G8_SCHED; }
            G8_LDB(B1, 1, 1); G8_STAGE(G8_SB(1, 0), b3, voffB);
            G8_BAR; G8_WAIT_L(0); G8_MMA(0, 1, At, B1); G8_BAR;
            if constexpr (Epi::SPLIT) { E.template part_cond<0, 1>(acc, cur, wr, wc, fr, fq, lastf); G8_SCHED; }
            G8_LDA(At, 1, 1); G8_STAGEA(G8_SA(1, 0), a2, 0, k3);
            G8_BAR; G8_WAIT_L(0); G8_MMA(1, 0, At, B0); G8_BAR; G8_SCHED;
            G8_STAGE(G8_SB(1, 1), b3 + bhstep, voffB);
            if constexpr (Epi::SPLIT) {
                asm volatile("s_cmp_lg_u32 %0, 0\n\ts_cbranch_scc1 1f\n\ts_waitcnt vmcnt(6)\n1:\n\ts_waitcnt vmcnt(%1)" :: "s"(lastf), "n"(6 + 2 * Epi::NQ) : "memory", "scc");
                G8_SCHED; E.template part_cond<1, 0>(acc, cur, wr, wc, fr, fq, lastf); G8_SCHED;
            } else G8_WAIT_V(6);
            G8_BAR; G8_MMA(1, 1, At, B1); G8_BAR;
            G8_STAGEA(G8_SA(1, 1), a2, 1, k3);
        }
        if constexpr (Epi::SPLIT) E.tail(acc, cur, wr, wc, fr, fq); else E(acc, cur, wr, wc, fr, fq);
        if (!has_next) break;
#pragma unroll
        for (int a = 0; a < 2; ++a)
#pragma unroll
            for (int b = 0; b < 2; ++b)
#pragma unroll
                for (int m = 0; m < 4; ++m)
#pragma unroll
                    for (int n = 0; n < 2; ++n) acc[a][b][m][n] = (f32x4){0.f, 0.f, 0.f, 0.f};
        cur = nxt; cA = nA; cB = nB; ++ui;
    }
    G8_WAIT_V(0);
    if (wr == 0) G8_BAR;
    G8_BAR;
#undef G8_SA
#undef G8_SB
#undef G8_STAGE
#undef G8_STAGEA
#undef G8_LDA
#undef G8_LDB
#undef G8_MMA
#undef G8_WAIT_V
#undef G8_WAIT_L
#undef G8_BAR
#undef G8_SCHED
}
}

__device__ __forceinline__ bool tile_map(int i, const Ctx& c, int ntm, int ntn, int& mt, int& nt) {
    const int vb = ((c.nblk & 15) == 0) ? ((c.bid >> 1) & 7) * (c.nblk >> 3) + (((c.bid >> 4) << 1) | (c.bid & 1)) : c.bid;
    const int L = i * c.nblk + vb;
    if (L >= ntm * ntn) return false;
    const int g = L / (8 * ntn), rem = L - g * 8 * ntn;
    const int gsz = (ntm - g * 8) < 8 ? (ntm - g * 8) : 8;
    mt = g * 8 + rem % gsz; nt = rem / gsz;
    return true;
}

__device__ __forceinline__ bool tile_map2(int i, const Ctx& c, int ntm, int ntn, int& mt, int& nt, bool& valid) {
    Ctx o = c; o.bid = c.bid ^ 1;
    int mo, no; const bool oko = tile_map(i, o, ntm, ntn, mo, no);
    valid = tile_map(i, c, ntm, ntn, mt, nt);
    if (!valid) { mt = 0; nt = 0; }
    return valid || oko;
}

struct DenseSched {
    int ntm, ntn, K, bid, nblk;
    __device__ __forceinline__ bool next(int i, g8::Unit& u) const {
        const int vb = ((nblk & 7) == 0) ? (bid & 7) * (nblk >> 3) + (bid >> 3) : bid;
        const int L = i * nblk + vb;
        if (L >= ntm * ntn) return false;
        const int g = L / (8 * ntn), rem = L - g * 8 * ntn;
        const int gsz = (ntm - g * 8) < 8 ? (ntm - g * 8) : 8;
        u.pm = g * 8 + rem % gsz; u.pn = rem / gsz; u.bt = u.pn;
        return true;
    }
};
struct MoeSched {
    int nrb, ntn, bid, nblk; const int* eb;
    __device__ __forceinline__ bool next(int i, g8::Unit& u) const {
        const int vb = ((nblk & 7) == 0) ? (bid & 7) * (nblk >> 3) + (bid >> 3) : bid;
        const int L = i * nblk + vb;
        if (L >= nrb * ntn) return false;
        const int g = L / (8 * ntn), rem = L - g * 8 * ntn;
        const int gsz = (nrb - g * 8) < 8 ? (nrb - g * 8) : 8;
        u.pm = g * 8 + rem % gsz; u.pn = rem / gsz;
        u.bt = __builtin_amdgcn_readfirstlane(eb[u.pm]) * ntn + u.pn;
        return true;
    }
};
struct MoeSchedG {
    int nrb, bid, nblk; const int* eb; const int* bst; const int* LTOK;
    __device__ __forceinline__ bool next(int i, g8::Unit& u) const {
        const int vb = ((nblk & 7) == 0) ? (bid & 7) * (nblk >> 3) + (bid >> 3) : bid;
        const int L = i * nblk + vb;
        if (L >= nrb * 2) return false;
        const int g = L >> 4, rem = L & 15;
        const int gsz = (nrb - g * 8) < 8 ? (nrb - g * 8) : 8;
        u.pm = g * 8 + rem % gsz; u.pn = rem / gsz;
        u.bt = __builtin_amdgcn_readfirstlane(eb[u.pm]) * 2 + u.pn;
        return true;
    }
    __device__ __forceinline__ void aoff(const g8::Unit& u, int tid, unsigned (&o)[4]) const {
        const int e = eb[u.pm], lb = u.pm - bst[e], cnt = bst[66 + e];
        int R0, C0, R1, C1; g8::stage_rc(tid * 16, R0, C0); g8::stage_rc(tid * 16 + 8192, R1, C1);
        const int* lt = LTOK + (size_t)e * CAP + lb * RBR;
        const int p00 = R0, p01 = R1, p10 = 128 + R0, p11 = 128 + R1;
        const int t00 = (lb * RBR + p00 < cnt) ? lt[p00] : 0, t01 = (lb * RBR + p01 < cnt) ? lt[p01] : 0;
        const int t10 = (lb * RBR + p10 < cnt) ? lt[p10] : 0, t11 = (lb * RBR + p11 < cnt) ? lt[p11] : 0;
        o[0] = (unsigned)t00 * 2048u + (unsigned)C0 * 2u; o[1] = (unsigned)t01 * 2048u + (unsigned)C1 * 2u;
        o[2] = (unsigned)t10 * 2048u + (unsigned)C0 * 2u; o[3] = (unsigned)t11 * 2048u + (unsigned)C1 * 2u;
    }
};
struct EpiMoe1 {
    static constexpr bool SPLIT = false; static constexpr int NQ = 2, NST = 8;
    bf16_t* H;
    __device__ __forceinline__ void operator()(const f32x4 (&acc)[2][2][4][2], const g8::Unit& u, int wr, int wc, int fr, int fq) const {
#pragma unroll
        for (int ai = 0; ai < 2; ++ai)
#pragma unroll
            for (int m = 0; m < 4; ++m) {
                const size_t row = (size_t)u.pm * RBR + ai * 128 + wr * 64 + m * 16 + fr;
                float h[8];
#pragma unroll
                for (int bj = 0; bj < 2; ++bj) {
                    const f32x4 g = acc[ai][bj][m][0], up = acc[ai][bj][m][1];
#pragma unroll
                    for (int j = 0; j < 4; ++j) h[bj * 4 + j] = g[j] * __builtin_amdgcn_rcpf(1.f + __expf(-g[j])) * up[j];
                }
                *(u32x4*)(H + row * 256 + u.pn * 128 + wc * 32 + fq * 8) = (u32x4){cvt_pk(h[0], h[1]), cvt_pk(h[2], h[3]), cvt_pk(h[4], h[5]), cvt_pk(h[6], h[7])};
            }
    }
    template <int ai, int bj> __device__ __forceinline__ void part_cond(const f32x4 (&acc)[2][2][4][2], const g8::Unit& u, int wr, int wc, int fr, int fq, int flag) const {}
    __device__ __forceinline__ void tail(const f32x4 (&acc)[2][2][4][2], const g8::Unit& u, int wr, int wc, int fr, int fq) const {}
};
__device__ __forceinline__ u32x4 dpp_ror8(const u32x4 v) {
    u32x4 r;
#pragma unroll
    for (int i = 0; i < 4; ++i) r[i] = (unsigned)__builtin_amdgcn_update_dpp(0, (int)v[i], 0x128, 0xF, 0xF, true);
    return r;
}
template <bool NT = false>
__device__ __forceinline__ void perm_store(bf16_t* p  , size_t ld8  , const u32x4 p0, const u32x4 p1, int hi) {
    const u32x4 snd = hi ? p0 : p1, rcv = dpp_ror8(snd);
    if constexpr (NT) { __builtin_nontemporal_store(hi ? rcv : p0, (u32x4*)p); __builtin_nontemporal_store(hi ? p1 : rcv, (u32x4*)(p + ld8)); }
    else { *(u32x4*)p = hi ? rcv : p0; *(u32x4*)(p + ld8) = hi ? p1 : rcv; }
}
struct EpiIn {
    static constexpr bool SPLIT = false; static constexpr int NQ = 4, NST = 16;
    bf16_t* P; float* G; int gbase;
    template <int ai, int bj> __device__ __forceinline__ void part_cond(const f32x4 (&acc)[2][2][4][2], const g8::Unit& u, int wr, int wc, int fr, int fq, int flag) const {}
    __device__ __forceinline__ void tail(const f32x4 (&acc)[2][2][4][2], const g8::Unit& u, int wr, int wc, int fr, int fq) const {}
    __device__ __forceinline__ void operator()(const f32x4 (&acc)[2][2][4][2], const g8::Unit& u, int wr, int wc, int fr, int fq) const {
        const int hi = fr >> 3, r8 = fr & 7;
#pragma unroll
        for (int ai = 0; ai < 2; ++ai)
#pragma unroll
            for (int m = 0; m < 4; ++m) {
                const size_t rg = (size_t)u.pm * 256 + ai * 128 + wr * 64 + m * 16;
                u32x4 pk[2];
#pragma unroll
                for (int bj = 0; bj < 2; ++bj) {
                    const f32x4 v0 = acc[ai][bj][m][0], v1 = acc[ai][bj][m][1];
                    pk[bj] = (u32x4){cvt_pk(v0[0], v0[1]), cvt_pk(v0[2], v0[3]), cvt_pk(v1[0], v1[1]), cvt_pk(v1[2], v1[3])};
                    if (u.pn * 256 + wc * 64 + bj * 32 + fq * 8 == gbase) { *(f32x4*)(G + (rg + fr) * 8) = v0; *(f32x4*)(G + (rg + fr) * 8 + 4) = v1; }
                }
                perm_store(P + (rg + r8) * NPAD + u.pn * 256 + wc * 64 + hi * 32 + fq * 8, (size_t)8 * NPAD, pk[0], pk[1], hi);
            }
    }
};
struct EpiMoe2 {
    static constexpr bool SPLIT = false; static constexpr int NQ = 4, NST = 16;
    bf16_t* Y;
    template <int ai, int bj> __device__ __forceinline__ void part_cond(const f32x4 (&acc)[2][2][4][2], const g8::Unit& u, int wr, int wc, int fr, int fq, int flag) const {}
    __device__ __forceinline__ void tail(const f32x4 (&acc)[2][2][4][2], const g8::Unit& u, int wr, int wc, int fr, int fq) const {}
    __device__ __forceinline__ void operator()(const f32x4 (&acc)[2][2][4][2], const g8::Unit& u, int wr, int wc, int fr, int fq) const {
        const int hi = fr >> 3, r8 = fr & 7;
#pragma unroll
        for (int ai = 0; ai < 2; ++ai)
#pragma unroll
            for (int m = 0; m < 4; ++m) {
                const size_t rg = (size_t)u.pm * RBR + ai * 128 + wr * 64 + m * 16;
                u32x4 pk[2];
#pragma unroll
                for (int bj = 0; bj < 2; ++bj) {
                    const f32x4 v0 = acc[ai][bj][m][0], v1 = acc[ai][bj][m][1];
                    pk[bj] = (u32x4){cvt_pk(v0[0], v0[1]), cvt_pk(v0[2], v0[3]), cvt_pk(v1[0], v1[1]), cvt_pk(v1[2], v1[3])};
                }
                perm_store<true>(Y + (rg + r8) * 1024 + u.pn * 256 + wc * 64 + hi * 32 + fq * 8, (size_t)8 * 1024, pk[0], pk[1], hi);
            }
    }
};
struct EpiOut {
    static constexpr bool SPLIT = false; static constexpr int NQ = 8, NST = 32;
    template <int ai, int bj> __device__ __forceinline__ void part_cond(const f32x4 (&acc)[2][2][4][2], const g8::Unit& u, int wr, int wc, int fr, int fq, int flag) const {}
    __device__ __forceinline__ void tail(const f32x4 (&acc)[2][2][4][2], const g8::Unit& u, int wr, int wc, int fr, int fq) const {}
    const bf16_t* xres; bf16_t* Y;
    __device__ __forceinline__ void operator()(const f32x4 (&acc)[2][2][4][2], const g8::Unit& u, int wr, int wc, int fr, int fq) const {
        const int hi = fr >> 3, r8 = fr & 7;
#pragma unroll
        for (int ai = 0; ai < 2; ++ai)
#pragma unroll
            for (int m = 0; m < 4; ++m) {
                const size_t rg = (size_t)u.pm * 256 + ai * 128 + wr * 64 + m * 16;
                u32x4 pk[2];
#pragma unroll
                for (int bj = 0; bj < 2; ++bj) {
                    const u32x4 xr = *(const u32x4*)(xres + (rg + fr) * 1024 + u.pn * 256 + wc * 64 + bj * 32 + fq * 8);
                    float f[8]; unpack8(xr, f);
                    const f32x4 v0 = acc[ai][bj][m][0], v1 = acc[ai][bj][m][1];
                    pk[bj] = (u32x4){cvt_pk(f[0] * ALPHA + v0[0], f[1] * ALPHA + v0[1]), cvt_pk(f[2] * ALPHA + v0[2], f[3] * ALPHA + v0[3]),
                                     cvt_pk(f[4] * ALPHA + v1[0], f[5] * ALPHA + v1[1]), cvt_pk(f[6] * ALPHA + v1[2], f[7] * ALPHA + v1[3])};
                }
                perm_store(Y + (rg + r8) * 1024 + u.pn * 256 + wc * 64 + hi * 32 + fq * 8, (size_t)8 * 1024, pk[0], pk[1], hi);
                asm volatile("" ::: "memory");
            }
    }
};

constexpr int TS_RS = 272;
__device__ __forceinline__ void tile_put(const Ctx& c, int row_l, int col_l, const u32x2 v) { *(u32x2*)(c.smem + row_l * TS_RS + col_l * 2) = v; }
template <int NCOL>
__device__ __forceinline__ void tile_flush(const Ctx& c, bf16_t* out, size_t ld, bool valid) {
    __syncthreads();
    constexpr int CPR = NCOL / 8, PER = (128 * CPR) / 256;
#pragma unroll
    for (int i = 0; i < PER; ++i) {
        const int idx = c.tid + 256 * i, row = idx / CPR, ch = idx % CPR;
        const u32x4 v = *(const u32x4*)(c.smem + row * TS_RS + ch * 16);
        if (valid) *(u32x4*)(out + (size_t)row * ld + ch * 8) = v;
    }
    __syncthreads();
}

__device__ __forceinline__ void conv_family(const float* src, int nmat, size_t src_stride, int K, int N, int Nout,
                            bf16_t* dst, size_t dst_stride, int grp, int kind, const Ctx& c) {
    float* lds = (float*)c.smem;
    const int tk = K / 128, tn = Nout / 64, per = tk * tn, total = nmat * per;
    const int tx = c.tid & 15, ty = c.tid >> 4;
    f32x4 r[8];
#define CV_LOAD(u_) do { const int mat_ = (u_) / per, r_ = (u_) - mat_ * per, kt_ = r_ / tn, nt_ = r_ - kt_ * tn; \
        const float* s_ = src + (size_t)mat_ * src_stride + (size_t)(kt_ * 128 + ty) * N + nt_ * 64 + tx * 4; const bool in_ = (nt_ * 64 + tx * 4) < N; \
        _Pragma("unroll") for (int i = 0; i < 8; ++i) r[i] = in_ ? __builtin_nontemporal_load((const f32x4*)(s_ + (size_t)(16 * i) * N)) : (f32x4){0.f, 0.f, 0.f, 0.f}; } while (0)
    if (c.bid < total) CV_LOAD(c.bid);
    for (int base = 0; base < total; base += c.nblk) {
        const int u = base + c.bid; const bool valid = u < total;
#pragma unroll
        for (int i = 0; i < 8; ++i) *(f32x4*)(lds + (ty + 16 * i) * 68 + tx * 4) = r[i];
        if (u + c.nblk < total) CV_LOAD(u + c.nblk);
        __syncthreads();
        if (valid) {
        const int mat = u / per, rr = u - mat * per, kt = rr / tn, nt = rr - kt * tn;
        const int dmat = grp ? (mat / grp) * (grp + 1) + (mat % grp) : mat;
        bf16_t* d = dst + (size_t)dmat * dst_stride;
        const int nl = c.tid & 63, kq = (c.tid >> 6) * 32;
        unsigned w[16];
#pragma unroll
        for (int j = 0; j < 16; ++j) w[j] = pk2(lds[(kq + 2 * j) * 68 + nl], lds[(kq + 2 * j + 1) * 68 + nl]);
        const int n = nt * 64 + nl;
        const int drow = (kind == 0) ? n : ((n >> 4) * 32 + (n & 15) + (kind == 2 ? 16 : 0));
        u32x4* dp = (u32x4*)(d + (size_t)drow * K + kt * 128 + kq);
        dp[0] = (u32x4){w[0], w[1], w[2], w[3]}; dp[1] = (u32x4){w[4], w[5], w[6], w[7]};
        dp[2] = (u32x4){w[8], w[9], w[10], w[11]}; dp[3] = (u32x4){w[12], w[13], w[14], w[15]};
        }
        __syncthreads();
    }
#undef CV_LOAD
}

__device__ __forceinline__ void phase_prologue(const Args& a, const Ctx& c) {
    unsigned char* ws = a.ws;
    bf16_t* WIN = (bf16_t*)(ws + WS_WIN);
    conv_family((const float*)a.in[2], 2, (size_t)1024 * 2472, 1024, 2472, NPAD, WIN, 2 * WIN_ELEMS, 0, 0, c);
    conv_family((const float*)a.in[12], 2, (size_t)1024 * 2312, 1024, 2312, NPAD, WIN + WIN_ELEMS, 2 * WIN_ELEMS, 0, 0, c);
    conv_family((const float*)a.in[4], 2, (size_t)256 * 768, 256, 768, 768, (bf16_t*)(ws + WS_WQB), WQB_ELEMS, 0, 0, c);
    conv_family((const float*)a.in[6], 2, (size_t)128 * 1024, 128, 1024, 1024, (bf16_t*)(ws + WS_WKVB), WKVB_ELEMS, 0, 0, c);
    bf16_t* WOUT = (bf16_t*)(ws + WS_WOUT);
    conv_family((const float*)a.in[11], 2, (size_t)1024 * 1024, 1024, 1024, 1024, WOUT, 2 * WOUT_ELEMS, 0, 0, c);
    conv_family((const float*)a.in[17], 2, (size_t)1024 * 1024, 1024, 1024, 1024, WOUT + WOUT_ELEMS, 2 * WOUT_ELEMS, 0, 0, c);
    conv_family((const float*)a.in[20], 4, (size_t)1024 * 64, 1024, 64, 128, (bf16_t*)(ws + WS_WRT), WRT_ELEMS, 0, 0, c);
    bf16_t* WGU = (bf16_t*)(ws + WS_WGU);
    conv_family((const float*)a.in[22], 256, (size_t)1024 * 256, 1024, 256, 256, WGU, WGU_ELEMS, 64, 1, c);
    conv_family((const float*)a.in[23], 256, (size_t)1024 * 256, 1024, 256, 256, WGU, WGU_ELEMS, 64, 2, c);
    conv_family((const float*)a.in[25], 4, (size_t)1024 * 256, 1024, 256, 256, WGU + 64 * WGU_ELEMS, 65 * WGU_ELEMS, 0, 1, c);
    conv_family((const float*)a.in[26], 4, (size_t)1024 * 256, 1024, 256, 256, WGU + 64 * WGU_ELEMS, 65 * WGU_ELEMS, 0, 2, c);
    bf16_t* WDN = (bf16_t*)(ws + WS_WDN);
    conv_family((const float*)a.in[24], 256, (size_t)256 * 1024, 256, 1024, 1024, WDN, WDN_ELEMS, 64, 0, c);
    conv_family((const float*)a.in[27], 4, (size_t)256 * 1024, 256, 1024, 1024, WDN + 64 * WDN_ELEMS, 65 * WDN_ELEMS, 0, 0, c);
    {
        const float* x = (const float*)a.in[0]; bf16_t* xb = (bf16_t*)(ws + WS_XBF);
        const size_t n8 = (size_t)T * 1024 / 8;
        for (size_t i = (size_t)c.bid * 256 + c.tid; i < n8; i += (size_t)c.nblk * 256) {
            const f32x4 v0 = __builtin_nontemporal_load((const f32x4*)(x + i * 8)), v1 = __builtin_nontemporal_load((const f32x4*)(x + i * 8 + 4));
            *(u32x4*)(xb + i * 8) = (u32x4){pk2(v0[0], v0[1]), pk2(v0[2], v0[3]), pk2(v1[0], v1[1]), pk2(v1[2], v1[3])};
        }
    }
    {
        const int* pos = (const int*)a.in[1];
        float* rm = (float*)(ws + WS_ROPEM); float* rs = (float*)(ws + WS_ROPES);
        const float ln_theta = 9.210340371976184f;
        for (int i = c.bid * 256 + c.tid; i < T * 16; i += c.nblk * 256) {
            const int t = i >> 4, f = i & 15;
            const float inv = expf(-((float)(2 * f) / 32.f) * ln_theta);
            const float ang = (float)pos[t] * inv;
            rm[i * 2] = cosf(ang); rm[i * 2 + 1] = sinf(ang);
        }
        for (int i = c.bid * 256 + c.tid; i < T * 32; i += c.nblk * 256) {
            const int t = i >> 5, f = i & 31;
            const float inv = expf(-((float)(2 * f) / 64.f) * ln_theta);
            const float ang = (float)pos[t] * inv;
            rs[i * 2] = cosf(ang); rs[i * 2 + 1] = sinf(ang);
        }
    }
}

__device__ __forceinline__ void phase_inproj(const bf16_t* XBF, const bf16_t* W, bf16_t* PROJ, float* GATES, int gbase, const Ctx& c) {
    const int ntn = NPAD / 128;
    for (int i = 0;; ++i) {
        int mt, nt; bool valid; if (!tile_map2(i, c, T / 128, ntn, mt, nt, valid)) break;
        const bf16_t* a0 = XBF + (size_t)(mt * 128 + (c.tid >> 2)) * 1024;
        const bf16_t* b0 = W + (size_t)(nt * 128 + (c.tid >> 2)) * 1024;
        f32x4 acc[4][4];
        gemm_tile(a0, a0 + 64 * 1024, b0, b0 + 64 * 1024, 32, acc, c);
#pragma unroll
        for (int m = 0; m < 4; ++m) {
            const int rl = c.wr * 64 + m * 16 + c.fr, row = mt * 128 + rl;
#pragma unroll
            for (int n = 0; n < 4; ++n) {
                const int cl = c.wc * 64 + n * 16 + c.fq * 4, col = nt * 128 + cl;
                const f32x4 v = acc[m][n];
                tile_put(c, rl, cl, (u32x2){pk2(v[0], v[1]), pk2(v[2], v[3])});
                if (valid && col >= gbase && col < gbase + 8) *(f32x4*)(GATES + (size_t)row * 8 + (col - gbase)) = v;
            }
        }
        tile_flush<128>(c, PROJ + (size_t)mt * 128 * NPAD + nt * 128, NPAD, valid);
    }
}

constexpr int MLAUP_TILES = (T / 128) * 6 + (T / 128) * 8;
__device__ __forceinline__ void mla_up_tile(int u, const bf16_t* CQ, const bf16_t* WQB, const bf16_t* CKV, const bf16_t* WKVB,
                             const float* ROPEM, bf16_t* QF, bf16_t* KN, bf16_t* VV, const Ctx& c) {
    const int tq = (T / 128) * 6;
    const float qscale = 0.10206207261596577f * 1.4426950408889634f;
    {
        f32x4 acc[4][4];
        if (u < tq) {
            const int mt = u / 6, nt = u % 6;
            const bf16_t* a0 = CQ + (size_t)(mt * 128 + (c.tid >> 2)) * 256;
            const bf16_t* b0 = WQB + (size_t)(nt * 128 + (c.tid >> 2)) * 256;
            gemm_tile(a0, a0 + 64 * 256, b0, b0 + 64 * 256, 8, acc, c);
#pragma unroll
            for (int m = 0; m < 4; ++m) {
                const int row = mt * 128 + c.wr * 64 + m * 16 + c.fr;
#pragma unroll
                for (int np = 0; np < 2; ++np) {
                    const int cg = nt * 128 + c.wc * 64 + np * 32;
                    f32x4 v0 = acc[m][2 * np], v1 = acc[m][2 * np + 1];
                    if (((cg >> 5) % 3) == 2) {
#pragma unroll
                        for (int j = 0; j < 4; ++j) {
                            const int i = c.fq * 4 + j;
                            const float cs = ROPEM[((size_t)row * 16 + i) * 2], sn = ROPEM[((size_t)row * 16 + i) * 2 + 1];
                            const float x1 = v0[j], x2 = v1[j];
                            v0[j] = x1 * cs - x2 * sn; v1[j] = x2 * cs + x1 * sn;
                        }
                    }
                    v0 *= qscale; v1 *= qscale;
                    *(u32x2*)(QF + (size_t)row * 768 + cg + c.fq * 4) = (u32x2){pk2(v0[0], v0[1]), pk2(v0[2], v0[3])};
                    *(u32x2*)(QF + (size_t)row * 768 + cg + 16 + c.fq * 4) = (u32x2){pk2(v1[0], v1[1]), pk2(v1[2], v1[3])};
                }
            }
        } else {
            const int v = u - tq, mt = v / 8, nt = v % 8;
            const bf16_t* a0 = CKV + (size_t)(mt * 128 + (c.tid >> 2)) * 128;
            const bf16_t* b0 = WKVB + (size_t)(nt * 128 + (c.tid >> 2)) * 128;
            gemm_tile(a0, a0 + 64 * 128, b0, b0 + 64 * 128, 4, acc, c);
            bf16_t* dst = (c.wc == 0) ? KN : VV;
#pragma unroll
            for (int m = 0; m < 4; ++m) {
                const int row = mt * 128 + c.wr * 64 + m * 16 + c.fr;
#pragma unroll
                for (int n = 0; n < 4; ++n) {
                    const f32x4 x = acc[m][n];
                    *(u32x2*)(dst + (size_t)row * 512 + nt * 64 + n * 16 + c.fq * 4) = (u32x2){pk2(x[0], x[1]), pk2(x[2], x[3])};
                }
            }
        }
    }
}

__device__ __forceinline__ void phase_outproj(const bf16_t* MIXO, const bf16_t* W, const float* xres, float* YBUF, const Ctx& c) {
    for (int i = 0;; ++i) {
        int mt, nt; bool valid; if (!tile_map2(i, c, T / 128, 8, mt, nt, valid)) break;
        const bf16_t* a0 = MIXO + (size_t)(mt * 128 + (c.tid >> 2)) * 1024;
        const bf16_t* b0 = W + (size_t)(nt * 128 + (c.tid >> 2)) * 1024;
        f32x4 acc[4][4];
        gemm_tile(a0, a0 + 64 * 1024, b0, b0 + 64 * 1024, 32, acc, c);
#pragma unroll
        for (int m = 0; m < 4; ++m) {
            const int row = mt * 128 + c.wr * 64 + m * 16 + c.fr;
#pragma unroll
            for (int n = 0; n < 4; ++n) {
                const int col = nt * 128 + c.wc * 64 + n * 16 + c.fq * 4;
                const f32x4 xr = *(const f32x4*)(xres + (size_t)row * 1024 + col);
                if (valid) *(f32x4*)(YBUF + (size_t)row * 1024 + col) = xr * ALPHA + acc[m][n];
            }
        }
    }
}

__device__ __forceinline__ void phase_router(const bf16_t* XBF, const bf16_t* W, float* LOG, const Ctx& c) {
    for (int base = 0; base < T / 128; base += c.nblk) {
        const bool valid = (base + c.bid) < T / 128; const int mt = valid ? base + c.bid : 0;
        const bf16_t* a0 = XBF + (size_t)(mt * 128 + (c.tid >> 2)) * 1024;
        const bf16_t* b0 = W + (size_t)(c.tid >> 2) * 1024;
        f32x4 acc[4][4];
        gemm_tile(a0, a0 + 64 * 1024, b0, b0 + 64 * 1024, 32, acc, c);
        if (c.wc == 0 && valid) {
#pragma unroll
            for (int m = 0; m < 4; ++m) {
                const int row = mt * 128 + c.wr * 64 + m * 16 + c.fr;
#pragma unroll
                for (int n = 0; n < 4; ++n) *(f32x4*)(LOG + (size_t)row * 64 + n * 16 + c.fq * 4) = acc[m][n];
            }
        }
    }
}

__device__ __forceinline__ void build_block_table(const unsigned* CNT, int* bst, const Ctx& c) {
    __syncthreads();
    if (c.wid == 0) {
        const int cnt = (int)__hip_atomic_load(CNT + c.lane, __ATOMIC_RELAXED, __HIP_MEMORY_SCOPE_AGENT);
        const int nb = (cnt + RBR - 1) / RBR;
        int inc = nb;
#pragma unroll
        for (int o = 1; o < 64; o <<= 1) { const int x = shfl_up_(inc, o); if (c.lane >= o) inc += x; }
        bst[c.lane] = inc - nb; bst[66 + c.lane] = cnt;
        if (c.lane == 63) { bst[64] = inc; bst[65] = inc + T / RBR; bst[66 + 64] = T; }
    }
    __syncthreads();
}
__device__ __forceinline__ int find_expert(const int* bst, int rb, const Ctx& c) {
    return __popcll(__ballot(bst[1 + c.lane] <= rb));
}

__device__ __forceinline__ void phase_moe1(const bf16_t* XBF, const bf16_t* WGU, const unsigned* CNT, const int* LTOK, const float* LW, bf16_t* HBUF, const Ctx& c) {
    int* bst = (int*)(c.smem + 65536 + 64);
    build_block_table(CNT, bst, c);
    const int nsb = bst[65] * 2;
    for (int i = 0;; ++i) {
        int sbk, nt; bool valid; if (!tile_map2(i, c, nsb, 4, sbk, nt, valid)) break;
        const int rb = sbk >> 1, hb = sbk & 1;
        const int e = find_expert(bst, rb, c);
        const int lb = rb - bst[e], cnt = bst[66 + e];
        const int p0 = lb * RBR + hb * 128 + (c.tid >> 2), p1 = p0 + 64;
        const int t0 = (p0 < cnt) ? LTOK[(size_t)e * CAP + p0] : 0;
        const int t1 = (p1 < cnt) ? LTOK[(size_t)e * CAP + p1] : 0;
        const bf16_t* a0 = XBF + (size_t)t0 * 1024;
        const bf16_t* a1 = XBF + (size_t)t1 * 1024;
        const bf16_t* b0 = WGU + (size_t)e * WGU_ELEMS + (size_t)(nt * 128 + (c.tid >> 2)) * 1024;
        f32x4 acc[4][4];
        gemm_tile(a0, a1, b0, b0 + 64 * 1024, 32, acc, c);
#pragma unroll
        for (int m = 0; m < 4; ++m) {
            const int rl = c.wr * 64 + m * 16 + c.fr;
            const int pw = lb * RBR + hb * 128 + rl;
            const float wrow = (pw < cnt) ? LW[(size_t)e * CAP + pw] : 0.f;
#pragma unroll
            for (int n = 0; n < 2; ++n) {
                const f32x4 g = acc[m][n], up = acc[m][n + 2];
                float h[4];
#pragma unroll
                for (int j = 0; j < 4; ++j) h[j] = siluf_(g[j]) * up[j] * wrow;
                tile_put(c, rl, c.wc * 32 + n * 16 + c.fq * 4, (u32x2){pk2(h[0], h[1]), pk2(h[2], h[3])});
            }
        }
        tile_flush<64>(c, HBUF + ((size_t)rb * RBR + hb * 128) * 256 + nt * 64, 256, valid);
    }
}

__device__ __forceinline__ void phase_moe2(const bf16_t* HBUF, const bf16_t* WDN, const unsigned* CNT, bf16_t* Y, const Ctx& c) {
    int* bst = (int*)(c.smem + 65536 + 64);
    build_block_table(CNT, bst, c);
    const int nsb = bst[65] * 2;
    for (int i = 0;; ++i) {
        int sbk, nt; bool valid; if (!tile_map2(i, c, nsb, 8, sbk, nt, valid)) break;
        const int rb = sbk >> 1;
        const int e = find_expert(bst, rb, c);
        const bf16_t* a0 = HBUF + ((size_t)sbk * 128 + (c.tid >> 2)) * 256;
        const bf16_t* b0 = WDN + (size_t)e * WDN_ELEMS + (size_t)(nt * 128 + (c.tid >> 2)) * 256;
        f32x4 acc[4][4];
        gemm_tile(a0, a0 + 64 * 256, b0, b0 + 64 * 256, 8, acc, c);
#pragma unroll
        for (int m = 0; m < 4; ++m) {
            const int lr = c.wr * 64 + m * 16 + c.fr;
#pragma unroll
            for (int n = 0; n < 4; ++n) {
                const f32x4 v = acc[m][n];
                tile_put(c, lr, c.wc * 64 + n * 16 + c.fq * 4, (u32x2){pk2(v[0], v[1]), pk2(v[2], v[3])});
            }
        }
        tile_flush<128>(c, Y + (size_t)sbk * 128 * 1024 + nt * 128, 1024, valid);
    }
}

__device__ __forceinline__ float dppf(float v, int ctrl_sel) {
    int x = __builtin_bit_cast(int, v), r;
    if (ctrl_sel == 0) r = __builtin_amdgcn_update_dpp(0, x, 0xB1, 0xF, 0xF, true);
    else if (ctrl_sel == 1) r = __builtin_amdgcn_update_dpp(0, x, 0x4E, 0xF, 0xF, true);
    else if (ctrl_sel == 2) r = __builtin_amdgcn_update_dpp(0, x, 0x141, 0xF, 0xF, true);
    else r = __builtin_amdgcn_update_dpp(0, x, 0x140, 0xF, 0xF, true);
    return __builtin_bit_cast(float, r);
}
__device__ __forceinline__ float red16(float v) { v += dppf(v, 0); v += dppf(v, 1); v += dppf(v, 2); v += dppf(v, 3); return v; }

template <bool F32OUT>
__device__ __forceinline__ void ln_row_store(float (&v)[16], const float* g, const float* b, float* of32, bf16_t* obf, int lane) {
    float s = 0.f;
#pragma unroll
    for (int i = 0; i < 16; ++i) s += v[i];
    const float mean = wave_sum(s) * (1.f / 1024.f);
    float q = 0.f;
#pragma unroll
    for (int i = 0; i < 16; ++i) { v[i] -= mean; q += v[i] * v[i]; }
    const float rstd = rsqrtf(wave_sum(q) * (1.f / 1024.f) + 1e-5f);
#pragma unroll
    for (int hf = 0; hf < 2; ++hf) {
        const int col = hf * 512 + lane * 8;
        const f32x4 g0 = *(const f32x4*)(g + col), g1 = *(const f32x4*)(g + col + 4);
        const f32x4 b0 = *(const f32x4*)(b + col), b1 = *(const f32x4*)(b + col + 4);
        f32x4 y0, y1;
#pragma unroll
        for (int j = 0; j < 4; ++j) { y0[j] = v[hf * 8 + j] * rstd * g0[j] + b0[j]; y1[j] = v[hf * 8 + 4 + j] * rstd * g1[j] + b1[j]; }
        if constexpr (F32OUT) { *(f32x4*)(of32 + col) = y0; *(f32x4*)(of32 + col + 4) = y1; }
        *(u32x4*)(obf + col) = (u32x4){pk2(y0[0], y0[1]), pk2(y0[2], y0[3]), pk2(y1[0], y1[1]), pk2(y1[2], y1[3])};
    }
}

__device__ __forceinline__ void phase_ln1(const bf16_t* YBUF, const float* g, const float* b, bf16_t* XBF, const Ctx& c) {
    for (int t = c.bid * 4 + c.wid; t < T; t += c.nblk * 4) {
        float v[16];
#pragma unroll
        for (int hf = 0; hf < 2; ++hf) {
            const u32x4 r = *(const u32x4*)(YBUF + (size_t)t * 1024 + hf * 512 + c.lane * 8);
            float f[8]; unpack8(r, f);
#pragma unroll
            for (int j = 0; j < 8; ++j) v[hf * 8 + j] = f[j];
        }
        ln_row_store<false>(v, g, b, nullptr, XBF + (size_t)t * 1024, c.lane);
    }
}

template <bool LASTL>
__device__ __forceinline__ void phase_combine(const bf16_t* Y, const int* ASG, const float* ASGW, const unsigned* CNT, const float* g, const float* b,
                              float* XOUT, bf16_t* XBF, const Ctx& c) {
    int* bst = (int*)(c.smem + 65536 + 64);
    build_block_table(CNT, bst, c);
    for (int t = c.bid * 4 + c.wid; t < T; t += c.nblk * 4) {
        float v[16];
#pragma unroll
        for (int hf = 0; hf < 2; ++hf) {
            const u32x4 r = *(const u32x4*)(XBF + (size_t)t * 1024 + hf * 512 + c.lane * 8);
            float f[8]; unpack8(r, f);
#pragma unroll
            for (int j = 0; j < 8; ++j) v[hf * 8 + j] = f[j] * ALPHA;
        }
#pragma unroll
        for (int k = 0; k < 9; ++k) {
            size_t crow; float wk = 1.f;
            if (k < 8) { const int asg = ASG[(size_t)t * 8 + k]; crow = (size_t)bst[asg >> 16] * RBR + (asg & 0xffff); wk = ASGW[(size_t)t * 8 + k]; }
            else crow = (size_t)bst[64] * RBR + t;
#pragma unroll
            for (int hf = 0; hf < 2; ++hf) {
                const u32x4 r = *(const u32x4*)(Y + crow * 1024 + hf * 512 + c.lane * 8);
                float f[8]; unpack8(r, f);
#pragma unroll
                for (int j = 0; j < 8; ++j) v[hf * 8 + j] += f[j] * wk;
            }
        }
        ln_row_store<LASTL>(v, g, b, XOUT + (size_t)t * 1024, XBF + (size_t)t * 1024, c.lane);
    }
}

__device__ __forceinline__ void phase_route(const float* LOG, const float* rb, unsigned* CNT, int* LTOK, float* LW, int* ASG, float* ASGW, const Ctx& c) {
    int* lcnt = (int*)c.smem;
    int* lbase = lcnt + 64;
    int* sel_e = lbase + 64;
    int* sel_p = sel_e + 256;
    float* sel_w = (float*)(sel_p + 256);
    const float rbias = rb[c.lane];
    for (int base = 0; base < T / 32; base += c.nblk) {
        const int ch = base + c.bid; const bool valid = ch < T / 32;
        __syncthreads();
        if (c.tid < 64) lcnt[c.tid] = 0;
        __syncthreads();
        if (valid) for (int tl = c.wid; tl < 32; tl += 4) {
            const int t = ch * 32 + tl;
            const float lg = LOG[(size_t)t * 64 + c.lane];
            const float sc = 1.f / (1.f + expf(-lg));
            const float v = sc + rbias;
            float m1 = v;
            m1 = fmaxf(m1, shfl_xor_(m1, 1)); m1 = fmaxf(m1, shfl_xor_(m1, 2)); m1 = fmaxf(m1, shfl_xor_(m1, 4));
            int cand = (v == m1) ? c.lane : 999;
            cand = min(cand, shfl_xor_(cand, 1)); cand = min(cand, shfl_xor_(cand, 2)); cand = min(cand, shfl_xor_(cand, 4));
            float m2 = (c.lane == cand) ? -INFINITY : v;
            m2 = fmaxf(m2, shfl_xor_(m2, 1)); m2 = fmaxf(m2, shfl_xor_(m2, 2)); m2 = fmaxf(m2, shfl_xor_(m2, 4));
            const float gs = m1 + m2;
            const int g = c.lane >> 3;
            int grank = 0;
#pragma unroll
            for (int gg = 0; gg < 8; ++gg) { const float o = shfl_c_(gs, gg * 8); grank += ((o > gs) || (o == gs && gg < g)) ? 1 : 0; }
            const bool gsel = grank < 4;
            const float mv = gsel ? v : -INFINITY;
            int rank = 0;
#pragma unroll 8
            for (int jj = 0; jj < 64; ++jj) { const float o = shfl_c_(mv, jj); rank += ((o > mv) || (o == mv && jj < c.lane)) ? 1 : 0; }
            const bool sel = gsel && rank < 8;
            const float ssum = wave_sum(sel ? sc : 0.f);
            const float w = sc / ssum * 2.5f;
            const unsigned long long bal = __ballot(sel);
            const int slot = __popcll(bal & ((1ull << c.lane) - 1ull));
            if (sel) {
                const int p = atomicAdd(&lcnt[c.lane], 1);
                sel_e[tl * 8 + slot] = c.lane; sel_p[tl * 8 + slot] = p; sel_w[tl * 8 + slot] = w;
            }
        }
        __syncthreads();
        if (valid && c.tid < 64) { const int n = lcnt[c.tid]; lbase[c.tid] = n ? (int)atomicAdd(CNT + c.tid, (unsigned)n) : 0; }
        __syncthreads();
        if (valid) {
            const int tl = c.tid >> 3, t = ch * 32 + tl;
            const int e = sel_e[c.tid], pos = lbase[e] + sel_p[c.tid];
            LTOK[(size_t)e * CAP + pos] = t; LW[(size_t)e * CAP + pos] = sel_w[c.tid];
            ASG[(size_t)t * 8 + (c.tid & 7)] = (e << 16) | pos; ASGW[(size_t)t * 8 + (c.tid & 7)] = sel_w[c.tid];
            if (c.tid < 32) { const int ts = ch * 32 + c.tid; LTOK[(size_t)64 * CAP + ts] = ts; LW[(size_t)64 * CAP + ts] = 1.f; }
        }
    }
}

__device__ __forceinline__ void phase_lnroute(const bf16_t* YBUF, const float* g, const float* b, bf16_t* XBF, const bf16_t* W, const float* rb,
                                              unsigned* CNT, int* LTOK, float* LW, int* ASG, float* ASGW, const Ctx& c) {
    unsigned char* xa = c.smem;
    int* lcnt = (int*)(c.smem + 65536 + 64);
    int* lbase = lcnt + 64;
    float* lgt = (float*)c.smem;
    int* sel_e = (int*)(c.smem + 8192);
    int* sel_p = sel_e + 256;
    float* sel_w = (float*)(sel_p + 256);
    const int lane = c.lane;
    const float rbias = rb[lane];
    for (int base = 0; base < T / 32; base += c.nblk) {
        const int ch = base + c.bid; const bool valid = ch < T / 32;
        __syncthreads();
        if (c.tid < 64) lcnt[c.tid] = 0;
        u32x4 raw[8][2];
#pragma unroll
        for (int i = 0; i < 8; ++i)
#pragma unroll
            for (int hf = 0; hf < 2; ++hf) raw[i][hf] = valid ? *(const u32x4*)(YBUF + (size_t)(ch * 32 + c.wid + 4 * i) * 1024 + hf * 512 + lane * 8) : (u32x4){0u, 0u, 0u, 0u};
        if (valid)
#pragma unroll
        for (int i = 0; i < 8; ++i) {
            const int tl = c.wid + 4 * i;
            const int t = ch * 32 + tl;
            float v[16];
#pragma unroll
            for (int hf = 0; hf < 2; ++hf) {
                float f[8]; unpack8(raw[i][hf], f);
#pragma unroll
                for (int j = 0; j < 8; ++j) v[hf * 8 + j] = f[j];
            }
            float s = 0.f;
#pragma unroll
            for (int i = 0; i < 16; ++i) s += v[i];
            const float mean = wave_sum(s) * (1.f / 1024.f);
            float q = 0.f;
#pragma unroll
            for (int i = 0; i < 16; ++i) { v[i] -= mean; q += v[i] * v[i]; }
            const float rstd = rsqrtf(wave_sum(q) * (1.f / 1024.f) + 1e-5f);
#pragma unroll
            for (int hf = 0; hf < 2; ++hf) {
                const int col = hf * 512 + lane * 8;
                const f32x4 g0 = *(const f32x4*)(g + col), g1 = *(const f32x4*)(g + col + 4);
                const f32x4 b0 = *(const f32x4*)(b + col), b1 = *(const f32x4*)(b + col + 4);
                f32x4 y0, y1;
#pragma unroll
                for (int j = 0; j < 4; ++j) { y0[j] = v[hf * 8 + j] * rstd * g0[j] + b0[j]; y1[j] = v[hf * 8 + 4 + j] * rstd * g1[j] + b1[j]; }
                const u32x4 pk = (u32x4){pk2(y0[0], y0[1]), pk2(y0[2], y0[3]), pk2(y1[0], y1[1]), pk2(y1[2], y1[3])};
                *(u32x4*)(XBF + (size_t)t * 1024 + col) = pk;
                *(u32x4*)(xa + tl * 2048 + (((hf * 64 + lane) ^ (tl & 15)) * 16)) = pk;
            }
        }
        __syncthreads();
        f32x4 acc0 = (f32x4){0.f, 0.f, 0.f, 0.f}, acc1 = (f32x4){0.f, 0.f, 0.f, 0.f};
        {
            const int r = lane & 15, kq = lane >> 4;
            const bf16_t* wrow = W + (size_t)(c.wid * 16 + r) * 1024 + kq * 8;
#pragma unroll 1
            for (int kb = 0; kb < 32; kb += 8) {
                bf16x8 bfr[8];
#pragma unroll
                for (int j = 0; j < 8; ++j) bfr[j] = *(const bf16x8*)(wrow + (kb + j) * 32);
#pragma unroll
                for (int j = 0; j < 8; ++j) {
                    const int chunk = ((kb + j) * 4 + kq) ^ r;
                    const bf16x8 a0 = *(const bf16x8*)(xa + r * 2048 + chunk * 16), a1 = *(const bf16x8*)(xa + (16 + r) * 2048 + chunk * 16);
                    acc0 = __builtin_amdgcn_mfma_f32_16x16x32_bf16(a0, bfr[j], acc0, 0, 0, 0);
                    acc1 = __builtin_amdgcn_mfma_f32_16x16x32_bf16(a1, bfr[j], acc1, 0, 0, 0);
                }
            }
        }
        __syncthreads();
        {
            const int e = c.wid * 16 + (lane & 15), r0 = 4 * (lane >> 4);
#pragma unroll
            for (int j = 0; j < 4; ++j) { lgt[(r0 + j) * 64 + e] = acc0[j]; lgt[(16 + r0 + j) * 64 + e] = acc1[j]; }
        }
        __syncthreads();
        if (valid) for (int tl = c.wid; tl < 32; tl += 4) {
            const float lg = lgt[tl * 64 + lane];
            const float sc = 1.f / (1.f + expf(-lg));
            const float v = sc + rbias;
            float m1 = v;
            m1 = fmaxf(m1, shfl_xor_(m1, 1)); m1 = fmaxf(m1, shfl_xor_(m1, 2)); m1 = fmaxf(m1, shfl_xor_(m1, 4));
            int cand = (v == m1) ? lane : 999;
            cand = min(cand, shfl_xor_(cand, 1)); cand = min(cand, shfl_xor_(cand, 2)); cand = min(cand, shfl_xor_(cand, 4));
            float m2 = (lane == cand) ? -INFINITY : v;
            m2 = fmaxf(m2, shfl_xor_(m2, 1)); m2 = fmaxf(m2, shfl_xor_(m2, 2)); m2 = fmaxf(m2, shfl_xor_(m2, 4));
            const float gs = m1 + m2;
            const int gi = lane >> 3;
            int grank = 0;
#pragma unroll
            for (int gg = 0; gg < 8; ++gg) { const float o = shfl_c_(gs, gg * 8); grank += ((o > gs) || (o == gs && gg < gi)) ? 1 : 0; }
            const bool gsel = grank < 4;
            const float mv = gsel ? v : -INFINITY;
            int rank = 0;
#pragma unroll 8
            for (int jj = 0; jj < 64; ++jj) { const float o = shfl_c_(mv, jj); rank += ((o > mv) || (o == mv && jj < lane)) ? 1 : 0; }
            const bool sel = gsel && rank < 8;
            const float ssum = wave_sum(sel ? sc : 0.f);
            const float w = sc / ssum * 2.5f;
            const unsigned long long bal = __ballot(sel);
            const int slot = __popcll(bal & ((1ull << lane) - 1ull));
            if (sel) {
                const int p = atomicAdd(&lcnt[lane], 1);
                sel_e[tl * 8 + slot] = lane; sel_p[tl * 8 + slot] = p; sel_w[tl * 8 + slot] = w;
            }
        }
        __syncthreads();
        if (valid && c.tid < 64) { const int n = lcnt[c.tid]; lbase[c.tid] = n ? (int)atomicAdd(CNT + c.tid, (unsigned)n) : 0; }
        __syncthreads();
        if (valid) {
            const int tl = c.tid >> 3, t = ch * 32 + tl;
            const int e = sel_e[c.tid], pos = lbase[e] + sel_p[c.tid];
            LTOK[(size_t)e * CAP + pos] = t; LW[(size_t)e * CAP + pos] = sel_w[c.tid];
            ASG[(size_t)t * 8 + (c.tid & 7)] = (e << 16) | pos; ASGW[(size_t)t * 8 + (c.tid & 7)] = sel_w[c.tid];
            if (c.tid < 32) { const int ts = ch * 32 + c.tid; LTOK[(size_t)64 * CAP + ts] = ts; LW[(size_t)64 * CAP + ts] = 1.f; }
        }
    }
}

__device__ __forceinline__ void phase_prep_even(const bf16_t* PROJ, const float* GATES, const float* qn, const float* kvn, const float* cw,
                                const float* a_log, const float* dt_bias, const float* ROPEM,
                                bf16_t* CQ, bf16_t* CKV, bf16_t* KROPE, bf16_t* GQ, bf16_t* GK, bf16_t* GV, float* BETA, float* GLOG, const Ctx& c) {
    const int lane = c.lane;
    float* cwL = (float*)c.smem;
    __syncthreads();
    for (int i = c.tid; i < 4 * 1536 / 4; i += 256) *(f32x4*)(cwL + i * 4) = *(const f32x4*)(cw + i * 4);
    __syncthreads();
    for (int tb = (c.bid * 4 + c.wid) * 8; tb < T; tb += c.nblk * 4 * 8) {
        const int s0 = tb & (SEQ - 1);
        u32x4 xr[3][4];
#pragma unroll
        for (int arr = 0; arr < 3; ++arr)
#pragma unroll
            for (int w = 0; w < 3; ++w)
                xr[arr][w] = (s0 - 3 + w >= 0) ? *(const u32x4*)(PROJ + (size_t)(tb - 3 + w) * NPAD + 416 + arr * 512 + lane * 8) : (u32x4){0u, 0u, 0u, 0u};
        u32x4 nx[3]; u32x2 ncq; unsigned nckv; float nk1 = 0.f, nk2 = 0.f, ncs = 0.f, nsn = 0.f, ngate = 0.f;
#define PE_LOAD(t_) do { const bf16_t* pr_ = PROJ + (size_t)(t_) * NPAD; \
            _Pragma("unroll") for (int arr = 0; arr < 3; ++arr) nx[arr] = *(const u32x4*)(pr_ + 416 + arr * 512 + lane * 8); \
            ncq = *(const u32x2*)(pr_ + lane * 4); nckv = *(const unsigned*)(pr_ + 256 + lane * 2); \
            if (lane < 16) { nk1 = bf2f(pr_[384 + lane]); nk2 = bf2f(pr_[400 + lane]); ncs = ROPEM[((size_t)(t_) * 16 + lane) * 2]; nsn = ROPEM[((size_t)(t_) * 16 + lane) * 2 + 1]; } \
            if (lane < 8) ngate = GATES[(size_t)(t_) * 8 + lane]; } while (0)
        PE_LOAD(tb);
#pragma unroll
        for (int k = 0; k < 8; ++k) {
            const int t = tb + k;
#pragma unroll
            for (int arr = 0; arr < 3; ++arr) xr[arr][3] = nx[arr];
            const u32x2 r = ncq; const unsigned rkv = nckv; const float x1 = nk1, x2 = nk2, cs = ncs, sn = nsn, gate = ngate;
            if (k < 7) PE_LOAD(t + 1);
            {
                float v[4] = {bflo(r.x), bfhi(r.x), bflo(r.y), bfhi(r.y)};
                const float ss = wave_sum(v[0] * v[0] + v[1] * v[1] + v[2] * v[2] + v[3] * v[3]);
                const float rr = rsqrtf(ss * (1.f / 256.f) + 1e-6f);
                const f32x4 gq = *(const f32x4*)(qn + lane * 4);
                *(u32x2*)(CQ + (size_t)t * 256 + lane * 4) = (u32x2){pk2(v[0] * rr * gq[0], v[1] * rr * gq[1]), pk2(v[2] * rr * gq[2], v[3] * rr * gq[3])};
            }
            {
                const float v0 = bflo(rkv), v1 = bfhi(rkv);
                const float ss = wave_sum(v0 * v0 + v1 * v1);
                const float rr = rsqrtf(ss * (1.f / 128.f) + 1e-6f);
                *(unsigned*)(CKV + (size_t)t * 128 + lane * 2) = pk2(v0 * rr * kvn[lane * 2], v1 * rr * kvn[lane * 2 + 1]);
            }
            if (lane < 16) {
                KROPE[(size_t)t * 32 + lane] = (bf16_t)f2bf(x1 * cs - x2 * sn);
                KROPE[(size_t)t * 32 + 16 + lane] = (bf16_t)f2bf(x2 * cs + x1 * sn);
            }
#pragma unroll
            for (int arr = 0; arr < 3; ++arr) {
                float y[8];
#pragma unroll
                for (int j = 0; j < 8; ++j) y[j] = 0.f;
#pragma unroll
                for (int w = 0; w < 4; ++w) {
                    float f[8]; unpack8(xr[arr][w], f);
                    const f32x4 c0 = *(const f32x4*)(cwL + w * 1536 + arr * 512 + lane * 8), c1 = *(const f32x4*)(cwL + w * 1536 + arr * 512 + lane * 8 + 4);
#pragma unroll
                    for (int j = 0; j < 4; ++j) { y[j] += c0[j] * f[j]; y[4 + j] += c1[j] * f[4 + j]; }
                }
                float ss = 0.f;
#pragma unroll
                for (int j = 0; j < 8; ++j) { y[j] = siluf_(y[j]); ss += y[j] * y[j]; }
                if (arr < 2) {
                    float rr = rsqrtf(red16(ss) + 1e-6f);
                    if (arr == 0) rr *= 0.08838834764831845f;
#pragma unroll
                    for (int j = 0; j < 8; ++j) y[j] *= rr;
                }
                bf16_t* dst = (arr == 0) ? GQ : (arr == 1) ? GK : GV;
                *(u32x4*)(dst + (size_t)t * 512 + lane * 8) = (u32x4){pk2(y[0], y[1]), pk2(y[2], y[3]), pk2(y[4], y[5]), pk2(y[6], y[7])};
                xr[arr][0] = xr[arr][1]; xr[arr][1] = xr[arr][2]; xr[arr][2] = xr[arr][3];
            }
            if (lane < 4) BETA[(size_t)t * 4 + lane] = sigmoidf_(gate);
            else if (lane < 8) { const int h = lane - 4; GLOG[(size_t)t * 4 + h] = -expf(a_log[h]) * softplusf_(gate + dt_bias[h]); }
        }
#undef PE_LOAD
    }
}

__device__ __forceinline__ void phase_prep_odd(const bf16_t* PROJ, const float* ROPES, bf16_t* SQ, bf16_t* SK, const Ctx& c) {
    const int lane = c.lane;
    const int hh = lane >> 2, j = lane & 3;
    const bool isq = lane < 32, act = lane < 40;
    const int scol = isq ? 1544 + hh * 64 + j * 8 : 2056 + (hh - 8) * 64 + j * 8;
    const float sc = isq ? 0.18033688011112042f : 1.f;
    for (int t = c.bid * 4 + c.wid; t < T; t += c.nblk * 4) {
        if (act) {
            const bf16_t* pr = PROJ + (size_t)t * NPAD + scol;
            const u32x4 r1 = *(const u32x4*)pr, r2 = *(const u32x4*)(pr + 32);
            const float* rp = ROPES + ((size_t)t * 32 + j * 8) * 2;
            const f32x4 t0 = *(const f32x4*)rp, t1 = *(const f32x4*)(rp + 4), t2 = *(const f32x4*)(rp + 8), t3 = *(const f32x4*)(rp + 12);
            const float cs[8] = {t0[0], t0[2], t1[0], t1[2], t2[0], t2[2], t3[0], t3[2]}, sn[8] = {t0[1], t0[3], t1[1], t1[3], t2[1], t2[3], t3[1], t3[3]};
            float x1[8], x2[8], o1[8], o2[8]; unpack8(r1, x1); unpack8(r2, x2);
#pragma unroll
            for (int k = 0; k < 8; ++k) { o1[k] = (x1[k] * cs[k] - x2[k] * sn[k]) * sc; o2[k] = (x2[k] * cs[k] + x1[k] * sn[k]) * sc; }
            bf16_t* d = isq ? SQ + (size_t)t * 512 + hh * 64 + j * 8 : SK + (size_t)t * 128 + (hh - 8) * 64 + j * 8;
            *(u32x4*)d = (u32x4){pk2(o1[0], o1[1]), pk2(o1[2], o1[3]), pk2(o1[4], o1[5]), pk2(o1[6], o1[7])};
            *(u32x4*)(d + 32) = (u32x4){pk2(o2[0], o2[1]), pk2(o2[2], o2[3]), pk2(o2[4], o2[5]), pk2(o2[6], o2[7])};
        }
    }
}

__device__ __forceinline__ int next_unit(unsigned* ctr, const Ctx& c) {
    volatile int* su = (volatile int*)(c.smem0 + LDS_BLK + 16);
    __syncthreads();
    if (c.tid0 == 0) *su = (int)atomicAdd(ctr, 1u);
    __syncthreads();
    return *su * 2 + c.half;
}

typedef float f32x16 __attribute__((ext_vector_type(16)));
typedef short s16x4 __attribute__((ext_vector_type(4)));
#define MFMA32(a, b, c) __builtin_amdgcn_mfma_f32_32x32x16_bf16((a), (b), (c), 0, 0, 0)
template <int S_> __device__ __forceinline__ bf16x8 pack_step(const f32x16& x) {
    u32x4 p;
    asm volatile("v_cvt_pk_bf16_f32 %0, %4, %5\n\tv_cvt_pk_bf16_f32 %1, %6, %7\n\tv_cvt_pk_bf16_f32 %2, %8, %9\n\tv_cvt_pk_bf16_f32 %3, %10, %11\n\ts_nop 1"
                 : "=&v"(p[0]), "=&v"(p[1]), "=&v"(p[2]), "=&v"(p[3])
                 : "v"(x[8 * S_]), "v"(x[8 * S_ + 1]), "v"(x[8 * S_ + 2]), "v"(x[8 * S_ + 3]), "v"(x[8 * S_ + 4]), "v"(x[8 * S_ + 5]), "v"(x[8 * S_ + 6]), "v"(x[8 * S_ + 7]));
    return __builtin_bit_cast(bf16x8, p);
}
template <int S_> __device__ __forceinline__ bf16x8 pack_step_m(const f32x16& x) {
    u32x4 p;
    asm volatile("s_nop 15\n\tv_cvt_pk_bf16_f32 %0, %4, %5\n\tv_cvt_pk_bf16_f32 %1, %6, %7\n\tv_cvt_pk_bf16_f32 %2, %8, %9\n\tv_cvt_pk_bf16_f32 %3, %10, %11\n\ts_nop 1"
                 : "=&v"(p[0]), "=&v"(p[1]), "=&v"(p[2]), "=&v"(p[3])
                 : "v"(x[8 * S_]), "v"(x[8 * S_ + 1]), "v"(x[8 * S_ + 2]), "v"(x[8 * S_ + 3]), "v"(x[8 * S_ + 4]), "v"(x[8 * S_ + 5]), "v"(x[8 * S_ + 6]), "v"(x[8 * S_ + 7]));
    return __builtin_bit_cast(bf16x8, p);
}
constexpr int ATT_VB = 64 * 128;

template <int NKS, bool WIN>
__device__ __forceinline__ void attn_unit(const bf16_t* Qp, int q_ld, const bf16_t* K1, int k1_ld, const bf16_t* K2, int k2_ld, const bf16_t* Vp, int v_ld,
                          bf16_t* Op, int o_ld, int Q0, float sink_l2, const Ctx& c) {
    constexpr int KB = NKS * 2 * 1024, BUF = KB + ATT_VB;
    const int lane = c.lane, r = lane & 31, h = lane >> 5;
    const int wid = __builtin_amdgcn_readfirstlane(c.wid);
    const int q0w = Q0 + wid * 32;
    unsigned char* smem = c.smem;
    bf16x8 qf[NKS];
#pragma unroll
    for (int ks = 0; ks < NKS; ++ks) qf[ks] = *(const bf16x8*)(Qp + (size_t)(q0w + r) * q_ld + ks * 16 + h * 8);
    f32x16 o0, o1;
#pragma unroll
    for (int i = 0; i < 16; ++i) { o0[i] = 0.f; o1[i] = 0.f; }
    float m = WIN ? sink_l2 : -1e30f, l = (WIN && h == 0) ? 1.f : 0.f;
    const int kt_lo = WIN ? ((Q0 >> 6) - 2 < 0 ? 0 : (Q0 >> 6) - 2) : 0, kt_hi = (Q0 >> 6) + 1;
#define ATT_STAGE(kt_, buf_) do { unsigned char* bp = smem + (buf_) * BUF; const size_t kb = (size_t)(kt_) * 64; \
        _Pragma("unroll") for (int i = 0; i < (NKS * 2) / 4; ++i) { const int ch = wid + 4 * i; \
            const bf16_t* sp = (ch < 8) ? (K1 + (kb + lane) * k1_ld + ch * 8) : (K2 + (kb + lane) * k2_ld + (ch - 8) * 8); \
            glds16(sp, bp + ch * 1024 + lane * 16); } \
        _Pragma("unroll") for (int i = 0; i < 2; ++i) { const int j = wid + 4 * i; \
            glds16(Vp + (kb + 8 * j + (lane >> 3)) * v_ld + (lane & 7) * 8, bp + KB + j * 1024 + lane * 16); } } while (0)
    ATT_STAGE(kt_lo, 0);
    const int i16 = lane & 15;
    const unsigned vlane = (unsigned)((4 * h + (i16 >> 2)) * 128 + 32 * ((lane >> 4) & 1) + 8 * (i16 & 3));
    for (int kt = kt_lo; kt <= kt_hi; ++kt) {
        const int cur = (kt - kt_lo) & 1;
        asm volatile("s_waitcnt vmcnt(0)" ::: "memory");
        __syncthreads();
        if (kt < kt_hi) ATT_STAGE(kt + 1, cur ^ 1);
        const int k0 = kt * 64;
        const bool active = (k0 <= q0w + 31) && (!WIN || (k0 + 63 > q0w - 128));
        if (active) {
            const unsigned char* Kt = smem + cur * BUF;
            f32x16 x0, x1;
#pragma unroll
            for (int i = 0; i < 16; ++i) { x0[i] = 0.f; x1[i] = 0.f; }
#pragma unroll
            for (int ks = 0; ks < NKS; ++ks) {
                const bf16x8 kf0 = *(const bf16x8*)(Kt + (ks * 2 + h) * 1024 + r * 16);
                const bf16x8 kf1 = *(const bf16x8*)(Kt + (ks * 2 + h) * 1024 + (32 + r) * 16);
                x0 = MFMA32(kf0, qf[ks], x0); x1 = MFMA32(kf1, qf[ks], x1);
            }
            const bool need_mask = (k0 + 63 > q0w) || (WIN && (k0 <= q0w + 31 - 128));
            if (need_mask) {
                const int q = q0w + r;
#pragma unroll
                for (int i = 0; i < 16; ++i) {
                    const int key = k0 + (i & 3) + 8 * (i >> 2) + 4 * h;
                    const bool v0 = (key <= q) && (!WIN || key > q - 128);
                    const bool v1 = (key + 32 <= q) && (!WIN || key + 32 > q - 128);
                    x0[i] = v0 ? x0[i] : -INFINITY; x1[i] = v1 ? x1[i] : -INFINITY;
                }
            }
            float mx = fmaxf(x0[0], x1[0]);
#pragma unroll
            for (int i = 1; i < 16; ++i) mx = fmaxf(mx, fmaxf(x0[i], x1[i]));
            mx = fmaxf(mx, shfl_xor_(mx, 32));
            const float mn = fmaxf(m, mx);
            const float alpha = __builtin_amdgcn_exp2f(m - mn);
            m = mn;
            float ps = 0.f;
#pragma unroll
            for (int i = 0; i < 16; ++i) { x0[i] = __builtin_amdgcn_exp2f(x0[i] - mn); x1[i] = __builtin_amdgcn_exp2f(x1[i] - mn); ps += x0[i] + x1[i]; }
            l = l * alpha + ps;
            o0 *= alpha; o1 *= alpha;
            const unsigned vbase = (unsigned)(size_t)(smem + cur * BUF + KB) + vlane;
#pragma unroll
            for (int t = 0; t < 2; ++t) {
                s16x4 l00, h00, l01, h01, l10, h10, l11, h11;
                const unsigned va = vbase + t * 4096;
                asm volatile("ds_read_b64_tr_b16 %0, %8\n\t"
                             "ds_read_b64_tr_b16 %1, %8 offset:1024\n\t"
                             "ds_read_b64_tr_b16 %2, %8 offset:64\n\t"
                             "ds_read_b64_tr_b16 %3, %8 offset:1088\n\t"
                             "ds_read_b64_tr_b16 %4, %8 offset:2048\n\t"
                             "ds_read_b64_tr_b16 %5, %8 offset:3072\n\t"
                             "ds_read_b64_tr_b16 %6, %8 offset:2112\n\t"
                             "ds_read_b64_tr_b16 %7, %8 offset:3136\n\t"
                             "s_waitcnt lgkmcnt(0)"
                             : "=&v"(l00), "=&v"(h00), "=&v"(l01), "=&v"(h01), "=&v"(l10), "=&v"(h10), "=&v"(l11), "=&v"(h11) : "v"(va) : "memory");
                const bf16x8 v00 = __builtin_shufflevector(l00, h00, 0, 1, 2, 3, 4, 5, 6, 7), v01 = __builtin_shufflevector(l01, h01, 0, 1, 2, 3, 4, 5, 6, 7);
                const bf16x8 v10 = __builtin_shufflevector(l10, h10, 0, 1, 2, 3, 4, 5, 6, 7), v11 = __builtin_shufflevector(l11, h11, 0, 1, 2, 3, 4, 5, 6, 7);
                const bf16x8 pb0 = (t == 0) ? pack_step<0>(x0) : pack_step<0>(x1);
                const bf16x8 pb1 = (t == 0) ? pack_step<1>(x0) : pack_step<1>(x1);
                o0 = MFMA32(v00, pb0, o0); o1 = MFMA32(v01, pb0, o1);
                o0 = MFMA32(v10, pb1, o0); o1 = MFMA32(v11, pb1, o1);
            }
        }
    }
#undef ATT_STAGE
    l += shfl_xor_(l, 32);
    const float inv = 1.f / l;
    bf16_t* orow = Op + (size_t)(q0w + r) * o_ld + 4 * h;
#pragma unroll
    for (int g = 0; g < 4; ++g) {
        *(u32x2*)(orow + 8 * g) = (u32x2){pk2(o0[4 * g] * inv, o0[4 * g + 1] * inv), pk2(o0[4 * g + 2] * inv, o0[4 * g + 3] * inv)};
        *(u32x2*)(orow + 32 + 8 * g) = (u32x2){pk2(o1[4 * g] * inv, o1[4 * g + 1] * inv), pk2(o1[4 * g + 2] * inv, o1[4 * g + 3] * inv)};
    }
}

constexpr size_t MLC_DC = 0, MLC_CS = 33554432, MLC_DN = MLC_CS + 16777216, MLC_NS = MLC_DN + 262144, MLC_ML = MLC_NS + 262144, MLC_BE = MLC_ML + 4096, MLC_MS = MLC_BE + 4096;

__device__ __forceinline__ float scan_add64(float v, int lane) {
#pragma unroll
    for (int o = 1; o < 64; o <<= 1) { const float x = shfl_up_(v, o); if (lane >= o) v += x; }
    return v;
}
__device__ __forceinline__ float scan_max64(float v, int lane) {
#pragma unroll
    for (int o = 1; o < 64; o <<= 1) { const float x = shfl_up_(v, o); if (lane >= o) v = fmaxf(v, x); }
    return v;
}
__device__ __forceinline__ float wave_max(float v) {
#pragma unroll
    for (int o = 32; o > 0; o >>= 1) v = fmaxf(v, shfl_xor_(v, o));
    return v;
}

__device__ __forceinline__ void mlc_passA(int u, const bf16_t* PROJ, const float* GATES, const float* b_i, const float* b_f, unsigned char* YB, const Ctx& c) {
    const int bh = u >> 5, b = bh >> 2, h = bh & 3;
    const size_t t0 = (size_t)b * SEQ + (u & 31) * 64;
    unsigned char* smem = c.smem;
    float* saL = (float*)(smem + 24576);
    const int lane = c.lane, wid = __builtin_amdgcn_readfirstlane(c.wid);
#pragma unroll
    for (int i = 0; i < 4; ++i) { const int j = wid * 4 + i;
        glds16(PROJ + (t0 + 4 * j + (lane >> 4)) * NPAD + 512 + h * 128 + (lane & 15) * 8, smem + 8192 + j * 1024 + lane * 16); }
    if (wid == 0) {
        const float ip = GATES[(t0 + lane) * 8 + h] + b_i[h], lf = -softplusf_(-(GATES[(t0 + lane) * 8 + 4 + h] + b_f[h]));
        const float bc = scan_add64(lf, lane), bend = shfl_c_(bc, 63);
        const float a = bend - bc + ip, mloc = wave_max(a);
        saL[lane] = expf(a - mloc) * 0.125f;
        if (lane == 0) { ((float*)(YB + MLC_ML))[u] = mloc; ((float*)(YB + MLC_BE))[u] = bend; }
    }
    __syncthreads();
#pragma unroll
    for (int i = 0; i < 2; ++i) {
        const int idx = c.tid + 256 * i, row = idx >> 3, chk = idx & 7;
        const u32x4 r = *(const u32x4*)(PROJ + (t0 + row) * NPAD + 256 + h * 64 + chk * 8);
        float f[8]; unpack8(r, f);
        const float s = saL[row];
        *(u32x4*)(smem + row * 128 + chk * 16) = (u32x4){pk2(f[0] * s, f[1] * s), pk2(f[2] * s, f[3] * s), pk2(f[4] * s, f[5] * s), pk2(f[6] * s, f[7] * s)};
    }
    asm volatile("s_waitcnt vmcnt(0)" ::: "memory");
    __syncthreads();
    const int h5 = lane >> 5, r = lane & 31, i16 = lane & 15, q4 = i16 >> 2, p = i16 & 3, blk = (lane >> 4) & 1;
    const int dkt = wid & 1, dvp = wid >> 1;
    const unsigned kaddr = (unsigned)(size_t)smem + (unsigned)((8 * h5 + q4) * 128 + dkt * 64 + 32 * blk + 8 * p);
    const unsigned vaddr = (unsigned)(size_t)smem + 8192u + (unsigned)((8 * h5 + q4) * 256 + dvp * 128 + 32 * blk + 8 * p);
    f32x16 a0, a1;
#pragma unroll
    for (int i = 0; i < 16; ++i) { a0[i] = 0.f; a1[i] = 0.f; }
#pragma unroll
    for (int st = 0; st < 4; ++st) {
        s16x4 kl, kh, v0l, v0h, v1l, v1h;
        const unsigned ka = kaddr + st * 2048, va = vaddr + st * 4096;
        asm volatile("ds_read_b64_tr_b16 %0, %6\n\t"
                     "ds_read_b64_tr_b16 %1, %6 offset:512\n\t"
                     "ds_read_b64_tr_b16 %2, %7\n\t"
                     "ds_read_b64_tr_b16 %3, %7 offset:1024\n\t"
                     "ds_read_b64_tr_b16 %4, %7 offset:64\n\t"
                     "ds_read_b64_tr_b16 %5, %7 offset:1088\n\t"
                     "s_waitcnt lgkmcnt(0)"
                     : "=&v"(kl), "=&v"(kh), "=&v"(v0l), "=&v"(v0h), "=&v"(v1l), "=&v"(v1h) : "v"(ka), "v"(va) : "memory");
        const bf16x8 kf = __builtin_shufflevector(kl, kh, 0, 1, 2, 3, 4, 5, 6, 7);
        const bf16x8 vf0 = __builtin_shufflevector(v0l, v0h, 0, 1, 2, 3, 4, 5, 6, 7), vf1 = __builtin_shufflevector(v1l, v1h, 0, 1, 2, 3, 4, 5, 6, 7);
        a0 = MFMA32(kf, vf0, a0); a1 = MFMA32(kf, vf1, a1);
    }
    float* DC = (float*)(YB + MLC_DC) + (size_t)u * 8192;
#pragma unroll
    for (int i = 0; i < 16; ++i) {
        const int dk = dkt * 32 + (i & 3) + 8 * (i >> 2) + 4 * h5;
        DC[dk * 128 + dvp * 64 + r] = a0[i]; DC[dk * 128 + dvp * 64 + 32 + r] = a1[i];
    }
    if (c.tid < 64) {
        float s = 0.f;
#pragma unroll 8
        for (int t = 0; t < 64; ++t) s += bf2f(((const bf16_t*)smem)[t * 64 + c.tid]);
        ((float*)(YB + MLC_DN))[(size_t)u * 64 + c.tid] = s;
    }
}

__device__ __forceinline__ void mlc_passB(int u, unsigned char* YB, const Ctx& c) {
    const int bh = u >> 3, sl = u & 7;
    const float* ML = (const float*)(YB + MLC_ML) + bh * 32; const float* BE = (const float*)(YB + MLC_BE) + bh * 32;
    const float* DC = (const float*)(YB + MLC_DC) + (size_t)bh * 32 * 8192 + sl * 1024 + c.tid * 4;
    bf16_t* CS = (bf16_t*)(YB + MLC_CS) + (size_t)bh * 32 * 8192 + sl * 1024 + c.tid * 4;
    const float* DN = (const float*)(YB + MLC_DN) + (size_t)bh * 32 * 64; float* NS = (float*)(YB + MLC_NS) + (size_t)bh * 32 * 64; float* MS = (float*)(YB + MLC_MS) + bh * 32;
    f32x4 C4 = (f32x4){0.f, 0.f, 0.f, 0.f}; float nv = 0.f, m = 0.f;
    const bool do_n = (sl == 0) && (c.tid < 64);
#pragma unroll 4
    for (int n = 0; n < 32; ++n) {
        *(u32x2*)(CS + (size_t)n * 8192) = (u32x2){pk2(C4[0], C4[1]), pk2(C4[2], C4[3])};
        if (do_n) NS[n * 64 + c.tid] = nv;
        if (sl == 0 && c.tid == 0) MS[n] = m;
        const float be = BE[n], ml = ML[n];
        const float mn = fmaxf(be + m, ml), keep = expf(be + m - mn), g = expf(ml - mn);
        m = mn;
        const f32x4 d = *(const f32x4*)(DC + (size_t)n * 8192);
        C4 = C4 * keep + d * g;
        if (do_n) nv = nv * keep + DN[n * 64 + c.tid] * g;
    }
}

__device__ __forceinline__ void mlc_passC(int u, const bf16_t* PROJ, const float* GATES, const float* b_i, const float* b_f, const unsigned char* YB,
                                          const float* gain  , bf16_t* MIXO, const Ctx& c) {
    const int bh = u >> 5, b = bh >> 2, h = bh & 3;
    const size_t t0 = (size_t)b * SEQ + (u & 31) * 64;
    unsigned char* smem = c.smem;
    float* csL = (float*)(smem + 32768); float* pmL = (float*)(smem + 33024); float* bcL = (float*)(smem + 33280); float* nnL = (float*)(smem + 33536); float* sqL = (float*)(smem + 33792);
    const int lane = c.lane, wid = __builtin_amdgcn_readfirstlane(c.wid);
    const bf16_t* CS = (const bf16_t*)(YB + MLC_CS) + (size_t)u * 8192;
#pragma unroll
    for (int i = 0; i < 4; ++i) { const int j = wid * 4 + i;
        glds16(PROJ + (t0 + 4 * j + (lane >> 4)) * NPAD + 512 + h * 128 + (lane & 15) * 8, smem + j * 1024 + lane * 16);
        glds16(CS + (4 * j + (lane >> 4)) * 128 + (lane & 15) * 8, smem + 16384 + j * 1024 + lane * 16); }
    float bcl = 0.f;
    if (wid == 0) {
        const float ip = GATES[(t0 + lane) * 8 + h] + b_i[h], lf = -softplusf_(-(GATES[(t0 + lane) * 8 + 4 + h] + b_f[h]));
        bcl = scan_add64(lf, lane);
        const float cs = ip - bcl;
        csL[lane] = cs; pmL[lane] = scan_max64(cs, lane);
        nnL[lane] = ((const float*)(YB + MLC_NS))[(size_t)u * 64 + lane];
        bcL[lane] = bcl;
    }
    asm volatile("s_waitcnt vmcnt(0)" ::: "memory");
    __syncthreads();
    const int h5 = lane >> 5, r = lane & 31, i16 = lane & 15, q4 = i16 >> 2, p = i16 & 3, blk = (lane >> 4) & 1;
    const int th = wid & 1, dvh = wid >> 1;
    const int t = th * 32 + r;
    const float m_n = ((const float*)(YB + MLC_MS))[u];
    const float Mt = fmaxf(m_n, pmL[t]), w_inter = __expf(m_n - Mt), em = __expf(-(bcL[t] + Mt));
    bf16x8 qf[4];
#pragma unroll
    for (int ks = 0; ks < 4; ++ks) qf[ks] = *(const bf16x8*)(PROJ + (t0 + t) * NPAD + h * 64 + ks * 16 + h5 * 8);
    float qn = 0.f; bf16x8 qw[4];
#pragma unroll
    for (int ks = 0; ks < 4; ++ks) {
        const u32x4 raw = __builtin_bit_cast(u32x4, qf[ks]); float f[8]; unpack8(raw, f);
#pragma unroll
        for (int j = 0; j < 8; ++j) qn += f[j] * nnL[ks * 16 + h5 * 8 + j];
        qw[ks] = __builtin_bit_cast(bf16x8, (u32x4){pk2(f[0] * w_inter, f[1] * w_inter), pk2(f[2] * w_inter, f[3] * w_inter), pk2(f[4] * w_inter, f[5] * w_inter), pk2(f[6] * w_inter, f[7] * w_inter)});
    }
    qn += shfl_xor_(qn, 32);
    f32x16 x0, x1;
#pragma unroll
    for (int i = 0; i < 16; ++i) { x0[i] = 0.f; x1[i] = 0.f; }
#pragma unroll
    for (int ks = 0; ks < 4; ++ks) {
        const bf16x8 kf0 = *(const bf16x8*)(PROJ + (t0 + r) * NPAD + 256 + h * 64 + ks * 16 + h5 * 8);
        x0 = MFMA32(kf0, qf[ks], x0);
        if (th) { const bf16x8 kf1 = *(const bf16x8*)(PROJ + (t0 + 32 + r) * NPAD + 256 + h * 64 + ks * 16 + h5 * 8); x1 = MFMA32(kf1, qf[ks], x1); }
    }
    float ps = 0.f;
#pragma unroll
    for (int i = 0; i < 16; ++i) {
        const int s = (i & 3) + 8 * (i >> 2) + 4 * h5;
        const float w0 = (s <= t) ? __expf(csL[s] - Mt) * 0.125f : 0.f;
        x0[i] *= w0; ps += x0[i];
        if (th) { const float w1 = (s <= r) ? __expf(csL[32 + s] - Mt) * 0.125f : 0.f; x1[i] *= w1; ps += x1[i]; }
    }
    ps += shfl_xor_(ps, 32);
    const float den = w_inter * qn + ps;
    f32x16 o0, o1;
#pragma unroll
    for (int i = 0; i < 16; ++i) { o0[i] = 0.f; o1[i] = 0.f; }
    {
        const unsigned vb = (unsigned)(size_t)smem + (unsigned)((4 * h5 + q4) * 256 + dvh * 128 + 32 * blk + 8 * p);
#pragma unroll
        for (int st = 0; st < 2; ++st) {
            if (st == 0 || th) {
                s16x4 l00, h00, l01, h01, l10, h10, l11, h11;
                const unsigned va = vb + st * 8192;
                asm volatile("ds_read_b64_tr_b16 %0, %8\n\t"
                             "ds_read_b64_tr_b16 %1, %8 offset:2048\n\t"
                             "ds_read_b64_tr_b16 %2, %8 offset:64\n\t"
                             "ds_read_b64_tr_b16 %3, %8 offset:2112\n\t"
                             "ds_read_b64_tr_b16 %4, %8 offset:4096\n\t"
                             "ds_read_b64_tr_b16 %5, %8 offset:6144\n\t"
                             "ds_read_b64_tr_b16 %6, %8 offset:4160\n\t"
                             "ds_read_b64_tr_b16 %7, %8 offset:6208\n\t"
                             "s_waitcnt lgkmcnt(0)"
                             : "=&v"(l00), "=&v"(h00), "=&v"(l01), "=&v"(h01), "=&v"(l10), "=&v"(h10), "=&v"(l11), "=&v"(h11) : "v"(va) : "memory");
                const bf16x8 v00 = __builtin_shufflevector(l00, h00, 0, 1, 2, 3, 4, 5, 6, 7), v01 = __builtin_shufflevector(l01, h01, 0, 1, 2, 3, 4, 5, 6, 7);
                const bf16x8 v10 = __builtin_shufflevector(l10, h10, 0, 1, 2, 3, 4, 5, 6, 7), v11 = __builtin_shufflevector(l11, h11, 0, 1, 2, 3, 4, 5, 6, 7);
                const bf16x8 pb0 = (st == 0) ? pack_step<0>(x0) : pack_step<0>(x1);
                const bf16x8 pb1 = (st == 0) ? pack_step<1>(x0) : pack_step<1>(x1);
                o0 = MFMA32(v00, pb0, o0); o1 = MFMA32(v01, pb0, o1);
                o0 = MFMA32(v10, pb1, o0); o1 = MFMA32(v11, pb1, o1);
            }
        }
    }
    {
        const unsigned cb = (unsigned)(size_t)smem + 16384u + (unsigned)((8 * h5 + q4) * 256 + dvh * 128 + 32 * blk + 8 * p);
#pragma unroll
        for (int kp = 0; kp < 2; ++kp) {
            s16x4 l00, h00, l01, h01, l10, h10, l11, h11;
            const unsigned ca = cb + kp * 8192;
            asm volatile("ds_read_b64_tr_b16 %0, %8\n\t"
                         "ds_read_b64_tr_b16 %1, %8 offset:1024\n\t"
                         "ds_read_b64_tr_b16 %2, %8 offset:64\n\t"
                         "ds_read_b64_tr_b16 %3, %8 offset:1088\n\t"
                         "ds_read_b64_tr_b16 %4, %8 offset:4096\n\t"
                         "ds_read_b64_tr_b16 %5, %8 offset:5120\n\t"
                         "ds_read_b64_tr_b16 %6, %8 offset:4160\n\t"
                         "ds_read_b64_tr_b16 %7, %8 offset:5184\n\t"
                         "s_waitcnt lgkmcnt(0)"
                         : "=&v"(l00), "=&v"(h00), "=&v"(l01), "=&v"(h01), "=&v"(l10), "=&v"(h10), "=&v"(l11), "=&v"(h11) : "v"(ca) : "memory");
            const bf16x8 c00 = __builtin_shufflevector(l00, h00, 0, 1, 2, 3, 4, 5, 6, 7), c01 = __builtin_shufflevector(l01, h01, 0, 1, 2, 3, 4, 5, 6, 7);
            const bf16x8 c10 = __builtin_shufflevector(l10, h10, 0, 1, 2, 3, 4, 5, 6, 7), c11 = __builtin_shufflevector(l11, h11, 0, 1, 2, 3, 4, 5, 6, 7);
            o0 = MFMA32(c00, qw[2 * kp], o0); o1 = MFMA32(c01, qw[2 * kp], o1);
            o0 = MFMA32(c10, qw[2 * kp + 1], o0); o1 = MFMA32(c11, qw[2 * kp + 1], o1);
        }
    }
    const float inv = __builtin_amdgcn_rcpf(fmaxf(fabsf(den), em));
    float ss = 0.f;
#pragma unroll
    for (int i = 0; i < 16; ++i) { o0[i] *= inv; o1[i] *= inv; ss += o0[i] * o0[i] + o1[i] * o1[i]; }
    ss += shfl_xor_(ss, 32);
    if (h5 == 0) sqL[wid * 32 + r] = ss;
    __syncthreads();
    const float rr = rsqrtf((sqL[th * 32 + r] + sqL[(th + 2) * 32 + r]) * (1.f / 128.f) + 1e-6f);
    const bf16_t* grow = PROJ + (t0 + t) * NPAD + 1032 + h * 128 + dvh * 64 + 4 * h5;
    const float* gn = gain + h * 128 + dvh * 64 + 4 * h5;
    bf16_t* orow = MIXO + (t0 + t) * 1024 + h * 128 + dvh * 64 + 4 * h5;
#pragma unroll
    for (int d = 0; d < 2; ++d)
#pragma unroll
        for (int g = 0; g < 4; ++g) {
            const u32x2 zr = *(const u32x2*)(grow + d * 32 + 8 * g);
            const f32x4 gv = *(const f32x4*)(gn + d * 32 + 8 * g);
            const float z0 = bflo(zr.x), z1 = bfhi(zr.x), z2 = bflo(zr.y), z3 = bfhi(zr.y);
            const float y0 = (d ? o1[4 * g] : o0[4 * g]) * rr * gv[0] * sigmoidf_(z0), y1 = (d ? o1[4 * g + 1] : o0[4 * g + 1]) * rr * gv[1] * sigmoidf_(z1);
            const float y2 = (d ? o1[4 * g + 2] : o0[4 * g + 2]) * rr * gv[2] * sigmoidf_(z2), y3 = (d ? o1[4 * g + 3] : o0[4 * g + 3]) * rr * gv[3] * sigmoidf_(z3);
            *(u32x2*)(orow + d * 32 + 8 * g) = (u32x2){pk2(y0, y1), pk2(y2, y3)};
        }
}

constexpr size_t GD_WN = 0, GD_UU = GD_WN + (size_t)1024 * 16384, GD_KGT = GD_UU + (size_t)1024 * 16384, GD_QG = GD_KGT + (size_t)1024 * 16384,
                 GD_AT = GD_QG + (size_t)1024 * 16384, GD_GL = GD_AT + (size_t)1024 * 8192, GD_END = GD_GL + 4096;
static_assert(GD_END <= (size_t)MAXROWS * 256 * 2, "GDN chunk records must fit the HBUF region");

__device__ __forceinline__ void gdc_passA(int u, const bf16_t* GQ, const bf16_t* GK, const bf16_t* GV, const float* BETA, const float* GLOG, unsigned char* HB, const Ctx& c) {
    const int bh = u >> 5, b = bh >> 2, h = bh & 3;
    const size_t t0 = (size_t)b * SEQ + (u & 31) * 64;
    unsigned char* smem = c.smem;
    float* Lm = (float*)(smem + 49152);
    float* GA = (float*)(smem + 65536 + 64); float* BT = GA + 64; float* EG = BT + 64; float* EK = EG + 64;
    const int lane = c.lane, wid = __builtin_amdgcn_readfirstlane(c.wid);
    const int h5 = lane >> 5, r = lane & 31;
    if (wid == 0) {
        const float g = GLOG[(t0 + lane) * 4 + h];
        const float G = scan_add64(g, lane), Gl = shfl_c_(G, 63);
        GA[lane] = G; BT[lane] = BETA[(t0 + lane) * 4 + h]; EG[lane] = expf(G); EK[lane] = expf(Gl - G);
        if (lane == 0) ((float*)(HB + GD_GL))[u] = expf(Gl);
    }
    __syncthreads();
    if (wid < 3) {
        const int it = (wid + 1) >> 1, jt = wid >> 1;
        f32x16 dl, da;
#pragma unroll
        for (int i = 0; i < 16; ++i) { dl[i] = 0.f; da[i] = 0.f; }
#pragma unroll
        for (int ks = 0; ks < 8; ++ks) {
            const bf16x8 ki = *(const bf16x8*)(GK + (t0 + 32 * it + r) * 512 + h * 128 + ks * 16 + h5 * 8);
            const bf16x8 kj = *(const bf16x8*)(GK + (t0 + 32 * jt + r) * 512 + h * 128 + ks * 16 + h5 * 8);
            const bf16x8 qi = *(const bf16x8*)(GQ + (t0 + 32 * it + r) * 512 + h * 128 + ks * 16 + h5 * 8);
            dl = MFMA32(ki, kj, dl); da = MFMA32(qi, kj, da);
        }
        const int j = 32 * jt + r; const float Gj = GA[j];
        bf16_t* AT = (bf16_t*)(HB + GD_AT) + (size_t)u * 4096;
#pragma unroll
        for (int i = 0; i < 16; ++i) {
            const int ii = 32 * it + (i & 3) + 8 * (i >> 2) + 4 * h5;
            const float dec = __expf(GA[ii] - Gj);
            Lm[ii * 64 + j] = (j < ii) ? dl[i] * BT[ii] * dec : 0.f;
            AT[ii * 64 + j] = (bf16_t)f2bf((j <= ii) ? da[i] * dec : 0.f);
        }
        if (wid == 0) {
#pragma unroll
            for (int i = 0; i < 16; ++i) { const int ii = (i & 3) + 8 * (i >> 2) + 4 * h5; Lm[ii * 64 + 32 + r] = 0.f; AT[ii * 64 + 32 + r] = 0; }
        }
    }
    __syncthreads();
    if (wid == 0) {
        float Tc[64];
#pragma unroll
        for (int i = 0; i < 64; ++i) {
            float s = (i == lane) ? 1.f : 0.f;
#pragma unroll
            for (int k = 0; k < i; ++k) s -= Lm[i * 64 + k] * Tc[k];
            Tc[i] = s;
        }
        bf16_t* Tm = (bf16_t*)Lm;
#pragma unroll
        for (int i = 0; i < 64; ++i) Tm[i * 64 + lane] = (bf16_t)f2bf(Tc[i]);
    } else {
        const int t3 = c.tid - 64;
        for (int idx = t3; idx < 4096; idx += 192) {
            const int arr = idx >> 10, rem = idx & 1023, row = rem >> 4, chk = rem & 15;
            const bf16_t* sp = ((arr == 1) ? GV : (arr == 3) ? GQ : GK) + (t0 + row) * 512 + h * 128 + chk * 8;
            const u32x4 raw = *(const u32x4*)sp; float f[8]; unpack8(raw, f);
            const float sc = (arr == 0) ? BT[row] * EG[row] : (arr == 1) ? BT[row] : (arr == 2) ? EK[row] : EG[row];
            const u32x4 o = (u32x4){pk2(f[0] * sc, f[1] * sc), pk2(f[2] * sc, f[3] * sc), pk2(f[4] * sc, f[5] * sc), pk2(f[6] * sc, f[7] * sc)};
            if (arr < 3) *(u32x4*)(smem + arr * 16384 + row * 256 + chk * 16) = o;
            else *(u32x4*)((bf16_t*)(HB + GD_QG) + (size_t)u * 8192 + row * 128 + chk * 8) = o;
        }
    }
    __syncthreads();
    {
        const int i16 = lane & 15, q4 = i16 >> 2, p = i16 & 3, blk = (lane >> 4) & 1;
        const unsigned char* Tm = smem + 49152;
        f32x16 u0, u1, w0, w1;
#pragma unroll
        for (int i = 0; i < 16; ++i) { u0[i] = 0.f; u1[i] = 0.f; w0[i] = 0.f; w1[i] = 0.f; }
        const unsigned ib = (unsigned)(size_t)smem + (unsigned)((8 * h5 + q4) * 256 + wid * 64 + 32 * blk + 8 * p);
#pragma unroll
        for (int ks = 0; ks < 4; ++ks) {
            s16x4 kl, kh, vl, vh;
            const unsigned ia = ib + ks * 4096;
            asm volatile("ds_read_b64_tr_b16 %0, %4\n\t"
                         "ds_read_b64_tr_b16 %1, %4 offset:1024\n\t"
                         "ds_read_b64_tr_b16 %2, %4 offset:16384\n\t"
                         "ds_read_b64_tr_b16 %3, %4 offset:17408\n\t"
                         "s_waitcnt lgkmcnt(0)"
                         : "=&v"(kl), "=&v"(kh), "=&v"(vl), "=&v"(vh) : "v"(ia) : "memory");
            const bf16x8 kb = __builtin_shufflevector(kl, kh, 0, 1, 2, 3, 4, 5, 6, 7), vb = __builtin_shufflevector(vl, vh, 0, 1, 2, 3, 4, 5, 6, 7);
            const bf16x8 t1 = *(const bf16x8*)(Tm + (32 + r) * 128 + ks * 32 + h5 * 16);
            w1 = MFMA32(t1, kb, w1); u1 = MFMA32(t1, vb, u1);
            if (ks < 2) { const bf16x8 tt0 = *(const bf16x8*)(Tm + r * 128 + ks * 32 + h5 * 16); w0 = MFMA32(tt0, kb, w0); u0 = MFMA32(tt0, vb, u0); }
        }
        bf16_t* WN = (bf16_t*)(HB + GD_WN) + (size_t)u * 8192; bf16_t* UU = (bf16_t*)(HB + GD_UU) + (size_t)u * 8192;
#pragma unroll
        for (int i = 0; i < 16; ++i) {
            const int s = (i & 3) + 8 * (i >> 2) + 4 * h5;
            WN[s * 128 + wid * 32 + r] = (bf16_t)f2bf(-w0[i]); WN[(32 + s) * 128 + wid * 32 + r] = (bf16_t)f2bf(-w1[i]);
        }
        {
            u32x4* up = (u32x4*)(UU + (size_t)(wid * 64 + lane) * 32);
            up[0] = (u32x4){pk2(u0[0], u0[1]), pk2(u0[2], u0[3]), pk2(u0[4], u0[5]), pk2(u0[6], u0[7])};
            up[1] = (u32x4){pk2(u0[8], u0[9]), pk2(u0[10], u0[11]), pk2(u0[12], u0[13]), pk2(u0[14], u0[15])};
            up[2] = (u32x4){pk2(u1[0], u1[1]), pk2(u1[2], u1[3]), pk2(u1[4], u1[5]), pk2(u1[6], u1[7])};
            up[3] = (u32x4){pk2(u1[8], u1[9]), pk2(u1[10], u1[11]), pk2(u1[12], u1[13]), pk2(u1[14], u1[15])};
        }
        bf16_t* KGT = (bf16_t*)(HB + GD_KGT) + (size_t)u * 8192;
        const int gq = lane >> 4;
        const unsigned kb0 = (unsigned)(size_t)smem + 32768u + (unsigned)(q4 * 256 + gq * 32 + 8 * p);
#pragma unroll
        for (int it2 = 0; it2 < 8; ++it2) {
            const int job = wid * 8 + it2, s0 = (job & 15) * 4, dkb = (job >> 4) * 64;
            s16x4 v;
            const unsigned ad = kb0 + s0 * 256 + dkb * 2;
            asm volatile("ds_read_b64_tr_b16 %0, %1\n\ts_waitcnt lgkmcnt(0)" : "=&v"(v) : "v"(ad) : "memory");
            *(s16x4*)(KGT + (size_t)(dkb + gq * 16 + i16) * 64 + s0) = v;
        }
    }
}

constexpr size_t GC_ST = 0, GC_VT = (size_t)1024 * 32768;
__device__ __forceinline__ void gdc_passB(int bh, const unsigned char* HB, unsigned char* YB, const Ctx& c) {
    const int lane = c.lane, wid = __builtin_amdgcn_readfirstlane(c.wid);
    const int h5 = lane >> 5, r = lane & 31;
    unsigned char* smem = c.smem;
    f32x16 S0, S1, S2, S3;
#pragma unroll
    for (int i = 0; i < 16; ++i) { S0[i] = 0.f; S1[i] = 0.f; S2[i] = 0.f; S3[i] = 0.f; }
    const size_t u0 = (size_t)bh * 32;
#define GB_STAGE(n_, p_) do { const bf16_t* wn_ = (const bf16_t*)(HB + GD_WN) + (u0 + (n_)) * 8192; const bf16_t* kg_ = (const bf16_t*)(HB + GD_KGT) + (u0 + (n_)) * 8192; \
        unsigned char* bp_ = smem + (p_) * 32768; \
        _Pragma("unroll") for (int i = 0; i < 4; ++i) { const int jj = wid * 4 + i, row = 4 * jj + (lane >> 4), ch = (lane & 15) ^ (row & 15); \
            glds16(wn_ + row * 128 + ch * 8, bp_ + jj * 1024 + lane * 16); } \
        _Pragma("unroll") for (int i = 0; i < 4; ++i) { const int jj = wid * 4 + i, row = 8 * jj + (lane >> 3), ch = (lane & 7) ^ ((row >> 1) & 7); \
            glds16(kg_ + row * 64 + ch * 8, bp_ + 16384 + jj * 1024 + lane * 16); } } while (0)
#define LD128(base_, R_, ks_) __builtin_shufflevector(*(const s16x4*)((base_) + (R_) * 256 + (((2 * (ks_)) ^ (rl & 15)) << 4) + 8 * hl), \
                                                      *(const s16x4*)((base_) + (R_) * 256 + (((2 * (ks_) + 1) ^ (rl & 15)) << 4) + 8 * hl), 0, 1, 2, 3, 4, 5, 6, 7)
#define LD64(base_, R_, k2_) __builtin_shufflevector(*(const s16x4*)((base_) + (R_) * 128 + (((2 * (k2_)) ^ ((rl >> 1) & 7)) << 4) + 8 * hl), \
                                                     *(const s16x4*)((base_) + (R_) * 128 + (((2 * (k2_) + 1) ^ ((rl >> 1) & 7)) << 4) + 8 * hl), 0, 1, 2, 3, 4, 5, 6, 7)
    u32x4 uu[4];
#define GB_LOADU(n_) do { const u32x4* up_ = (const u32x4*)((const bf16_t*)(HB + GD_UU) + (u0 + (n_)) * 8192 + (size_t)(wid * 64 + lane) * 32); \
        uu[0] = up_[0]; uu[1] = up_[1]; uu[2] = up_[2]; uu[3] = up_[3]; } while (0)
    __syncthreads();
    GB_STAGE(0, 0);
    GB_LOADU(0);
#pragma unroll 1
    for (int n2 = 0; n2 < 16; ++n2) {
#pragma unroll
        for (int PBUF = 0; PBUF < 2; ++PBUF) {
        const int n = 2 * n2 + PBUF;
        const float gl = ((const float*)(HB + GD_GL))[u0 + n];
        if (n == 0) asm volatile("s_waitcnt vmcnt(0)" ::: "memory"); else asm volatile("s_waitcnt vmcnt(24)" ::: "memory");
        asm volatile("s_waitcnt lgkmcnt(0)" ::: "memory"); __builtin_amdgcn_s_barrier(); asm volatile("" ::: "memory");
        f32x16 v0, v1;
#pragma unroll
        for (int q = 0; q < 2; ++q) {
            const u32x4 a = uu[q], bq = uu[2 + q];
            v0[8 * q + 0] = bflo(a.x); v0[8 * q + 1] = bfhi(a.x); v0[8 * q + 2] = bflo(a.y); v0[8 * q + 3] = bfhi(a.y);
            v0[8 * q + 4] = bflo(a.z); v0[8 * q + 5] = bfhi(a.z); v0[8 * q + 6] = bflo(a.w); v0[8 * q + 7] = bfhi(a.w);
            v1[8 * q + 0] = bflo(bq.x); v1[8 * q + 1] = bfhi(bq.x); v1[8 * q + 2] = bflo(bq.y); v1[8 * q + 3] = bfhi(bq.y);
            v1[8 * q + 4] = bflo(bq.z); v1[8 * q + 5] = bfhi(bq.z); v1[8 * q + 6] = bflo(bq.w); v1[8 * q + 7] = bfhi(bq.w);
        }
        if (n + 1 < 32) { GB_STAGE(n + 1, (PBUF ^ 1)); GB_LOADU(n + 1); }
        int rl = r, hl = h5; asm volatile("" : "+v"(rl), "+v"(hl));
        const unsigned char* WNb = smem + PBUF * 32768; const unsigned char* KGb = WNb + 16384;
        {
            bf16_t* st = (bf16_t*)(YB + GC_ST) + (u0 + n) * 16384 + (size_t)h5 * 512 + (size_t)(wid * 32 + r) * 4;
#define ST_TILE(SX, dt_) do { _Pragma("unroll") for (int g = 0; g < 4; ++g) \
                *(u32x2*)(st + ((dt_) * 8 + 2 * g) * 512) = (u32x2){cvt_pk(SX[4 * g], SX[4 * g + 1]), cvt_pk(SX[4 * g + 2], SX[4 * g + 3])}; } while (0)
            ST_TILE(S0, 0); ST_TILE(S1, 1); ST_TILE(S2, 2); ST_TILE(S3, 3);
#undef ST_TILE
        }
        {
            bf16x8 fa0, fb0, fa1, fb1, fa2, fb2;
#define LDV(FA, FB, ks_) do { FA = LD128(WNb, rl, ks_); FB = LD128(WNb, 32 + rl, ks_); } while (0)
#define MMV(SX, HF, FA, FB) do { const bf16x8 sbk = pack_step<HF>(SX); v0 = MFMA32(FA, sbk, v0); v1 = MFMA32(FB, sbk, v1); } while (0)
            LDV(fa0, fb0, 0); LDV(fa1, fb1, 1); LDV(fa2, fb2, 2);
            MMV(S0, 0, fa0, fb0); LDV(fa0, fb0, 3);
            MMV(S0, 1, fa1, fb1); LDV(fa1, fb1, 4);
            MMV(S1, 0, fa2, fb2); LDV(fa2, fb2, 5);
            MMV(S1, 1, fa0, fb0); LDV(fa0, fb0, 6);
            MMV(S2, 0, fa1, fb1); LDV(fa1, fb1, 7);
            MMV(S2, 1, fa2, fb2);
            MMV(S3, 0, fa0, fb0);
            MMV(S3, 1, fa1, fb1);
#undef LDV
#undef MMV
        }
        const bf16x8 vb0 = pack_step_m<0>(v0), vb1 = pack_step_m<1>(v0), vb2 = pack_step_m<0>(v1), vb3 = pack_step_m<1>(v1);
        {
            bf16_t* vt = (bf16_t*)(YB + GC_VT) + (u0 + n) * 8192 + (size_t)h5 * 512 + (size_t)(wid * 32 + r) * 4;
            const u32x4 p0 = __builtin_bit_cast(u32x4, vb0), p1 = __builtin_bit_cast(u32x4, vb1), p2 = __builtin_bit_cast(u32x4, vb2), p3 = __builtin_bit_cast(u32x4, vb3);
            *(u32x2*)(vt + 0 * 512) = (u32x2){p0.x, p0.y};  *(u32x2*)(vt + 2 * 512) = (u32x2){p0.z, p0.w};
            *(u32x2*)(vt + 4 * 512) = (u32x2){p1.x, p1.y};  *(u32x2*)(vt + 6 * 512) = (u32x2){p1.z, p1.w};
            *(u32x2*)(vt + 8 * 512) = (u32x2){p2.x, p2.y};  *(u32x2*)(vt + 10 * 512) = (u32x2){p2.z, p2.w};
            *(u32x2*)(vt + 12 * 512) = (u32x2){p3.x, p3.y}; *(u32x2*)(vt + 14 * 512) = (u32x2){p3.z, p3.w};
        }
        asm volatile("" ::: "memory"); asm volatile("" : "+v"(rl), "+v"(hl));
        S0 *= gl; S1 *= gl; S2 *= gl; S3 *= gl;
        {
            bf16x8 g0, g1, g2;
            g0 = LD64(KGb, rl, 0); g1 = LD64(KGb, rl, 1); g2 = LD64(KGb, rl, 2);
            S0 = MFMA32(g0, vb0, S0); g0 = LD64(KGb, rl, 3);
            S0 = MFMA32(g1, vb1, S0); g1 = LD64(KGb, 32 + rl, 0);
            S0 = MFMA32(g2, vb2, S0); g2 = LD64(KGb, 32 + rl, 1);
            S0 = MFMA32(g0, vb3, S0); g0 = LD64(KGb, 32 + rl, 2);
            S1 = MFMA32(g1, vb0, S1); g1 = LD64(KGb, 32 + rl, 3);
            S1 = MFMA32(g2, vb1, S1); g2 = LD64(KGb, 64 + rl, 0);
            S1 = MFMA32(g0, vb2, S1); g0 = LD64(KGb, 64 + rl, 1);
            S1 = MFMA32(g1, vb3, S1); g1 = LD64(KGb, 64 + rl, 2);
            S2 = MFMA32(g2, vb0, S2); g2 = LD64(KGb, 64 + rl, 3);
            S2 = MFMA32(g0, vb1, S2); g0 = LD64(KGb, 96 + rl, 0);
            S2 = MFMA32(g1, vb2, S2); g1 = LD64(KGb, 96 + rl, 1);
            S2 = MFMA32(g2, vb3, S2); g2 = LD64(KGb, 96 + rl, 2);
            S3 = MFMA32(g0, vb0, S3); g0 = LD64(KGb, 96 + rl, 3);
            S3 = MFMA32(g1, vb1, S3);
            S3 = MFMA32(g2, vb2, S3);
            S3 = MFMA32(g0, vb3, S3);
        }
        }
    }
#undef GB_STAGE
#undef LD128
#undef LD64
#undef GB_LOADU
}

__device__ __forceinline__ void gdc_passB_idle() {
    __syncthreads();
    for (int n = 0; n < 32; ++n) { asm volatile("" ::: "memory"); __builtin_amdgcn_s_barrier(); asm volatile("" ::: "memory"); }
}

__device__ __forceinline__ void gdc_passC(int u, const unsigned char* HB, const unsigned char* YB, const bf16_t* PROJ, const float* gnorm, bf16_t* MIXO, const Ctx& c) {
    const int bh = u >> 5, b = bh >> 2, h = bh & 3;
    const size_t t0 = (size_t)b * SEQ + (u & 31) * 64;
    const int lane = c.lane, wid = __builtin_amdgcn_readfirstlane(c.wid);
    const int h5 = lane >> 5, r = lane & 31;
    float* sqL = (float*)c.smem;
    const bf16_t* ST = (const bf16_t*)(YB + GC_ST) + (size_t)u * 16384 + (size_t)(2 * h5) * 512 + (size_t)(wid * 32 + r) * 4;
    const bf16_t* VT = (const bf16_t*)(YB + GC_VT) + (size_t)u * 8192 + (size_t)(2 * h5) * 512 + (size_t)(wid * 32 + r) * 4;
    const bf16_t* QG = (const bf16_t*)(HB + GD_QG) + (size_t)u * 8192 + (size_t)r * 128 + 8 * h5;
    const bf16_t* AT = (const bf16_t*)(HB + GD_AT) + (size_t)u * 4096 + (size_t)r * 64 + 8 * h5;
    f32x16 o0, o1;
#pragma unroll
    for (int i = 0; i < 16; ++i) { o0[i] = 0.f; o1[i] = 0.f; }
#pragma unroll
    for (int ks = 0; ks < 8; ++ks) {
        const bf16x8 sa = __builtin_shufflevector(*(const s16x4*)(ST + (4 * ks) * 512), *(const s16x4*)(ST + (4 * ks + 1) * 512), 0, 1, 2, 3, 4, 5, 6, 7);
        const bf16x8 q0 = *(const bf16x8*)(QG + ks * 16), q1 = *(const bf16x8*)(QG + 32 * 128 + ks * 16);
        o0 = MFMA32(sa, q0, o0); o1 = MFMA32(sa, q1, o1);
        if (ks == 3) asm volatile("" ::: "memory");
    }
#pragma unroll
    for (int k2 = 0; k2 < 4; ++k2) {
        const bf16x8 va = __builtin_shufflevector(*(const s16x4*)(VT + (4 * k2) * 512), *(const s16x4*)(VT + (4 * k2 + 1) * 512), 0, 1, 2, 3, 4, 5, 6, 7);
        const bf16x8 a1 = *(const bf16x8*)(AT + 32 * 64 + k2 * 16);
        o1 = MFMA32(va, a1, o1);
        if (k2 < 2) { const bf16x8 a0 = *(const bf16x8*)(AT + k2 * 16); o0 = MFMA32(va, a0, o0); }
    }
    float s0 = 0.f, s1 = 0.f;
#pragma unroll
    for (int i = 0; i < 16; ++i) { s0 += o0[i] * o0[i]; s1 += o1[i] * o1[i]; }
    s0 += shfl_xor_(s0, 32); s1 += shfl_xor_(s1, 32);
    __syncthreads();
    if (h5 == 0) { sqL[wid * 64 + r] = s0; sqL[wid * 64 + 32 + r] = s1; }
    __syncthreads();
    const float rr0 = rsqrtf((sqL[r] + sqL[64 + r] + sqL[128 + r] + sqL[192 + r]) * (1.f / 128.f) + 1e-6f);
    const float rr1 = rsqrtf((sqL[32 + r] + sqL[96 + r] + sqL[160 + r] + sqL[224 + r]) * (1.f / 128.f) + 1e-6f);
#pragma unroll
    for (int tt = 0; tt < 2; ++tt) {
        const size_t t = t0 + tt * 32 + r;
        const bf16_t* zrow = PROJ + t * NPAD + 1960 + h * 128 + wid * 32 + 4 * h5;
        const float* gn = gnorm + wid * 32 + 4 * h5;
        bf16_t* orow = MIXO + t * 1024 + 512 + h * 128 + wid * 32 + 4 * h5;
        const float rr = tt ? rr1 : rr0;
#pragma unroll
        for (int g = 0; g < 4; ++g) {
            const u32x2 zr = *(const u32x2*)(zrow + 8 * g);
            const f32x4 gv = *(const f32x4*)(gn + 8 * g);
            const float z0 = bflo(zr.x), z1 = bfhi(zr.x), z2 = bflo(zr.y), z3 = bfhi(zr.y);
            const float y0 = (tt ? o1[4 * g] : o0[4 * g]) * rr * gv[0] * siluf_(z0), y1 = (tt ? o1[4 * g + 1] : o0[4 * g + 1]) * rr * gv[1] * siluf_(z1);
            const float y2 = (tt ? o1[4 * g + 2] : o0[4 * g + 2]) * rr * gv[2] * siluf_(z2), y3 = (tt ? o1[4 * g + 3] : o0[4 * g + 3]) * rr * gv[3] * siluf_(z3);
            *(u32x2*)(orow + 8 * g) = (u32x2){pk2(y0, y1), pk2(y2, y3)};
        }
    }
}

__device__ __forceinline__ void phase_post(const float* OG, const bf16_t* PROJ, const float* gain, bool odd, bf16_t* MIXO, const Ctx& c) {
    const int lane = c.lane;
    const int gcol = odd ? 1032 : 1960, ocol = odd ? 0 : 512;
    for (int t = c.bid * 4 + c.wid; t < T; t += c.nblk * 4) {
        const f32x4 a0 = *(const f32x4*)(OG + (size_t)t * 512 + lane * 8), a1 = *(const f32x4*)(OG + (size_t)t * 512 + lane * 8 + 4);
        float ss = (a0[0] * a0[0] + a0[1] * a0[1]) + (a0[2] * a0[2] + a0[3] * a0[3]) + (a1[0] * a1[0] + a1[1] * a1[1]) + (a1[2] * a1[2] + a1[3] * a1[3]);
        ss = red16(ss);
        const float rr = rsqrtf(ss * (1.f / 128.f) + 1e-6f);
        const u32x4 zr = *(const u32x4*)(PROJ + (size_t)t * NPAD + gcol + lane * 8);
        float z[8]; unpack8(zr, z);
        const int gi = odd ? lane * 8 : (lane & 15) * 8;
        const f32x4 g0 = *(const f32x4*)(gain + gi), g1 = *(const f32x4*)(gain + gi + 4);
        float y[8];
#pragma unroll
        for (int j = 0; j < 4; ++j) {
            const float ga = odd ? sigmoidf_(z[j]) : siluf_(z[j]), gb = odd ? sigmoidf_(z[4 + j]) : siluf_(z[4 + j]);
            y[j] = a0[j] * rr * g0[j] * ga; y[4 + j] = a1[j] * rr * g1[j] * gb;
        }
        *(u32x4*)(MIXO + (size_t)t * 1024 + ocol + lane * 8) = (u32x4){pk2(y[0], y[1]), pk2(y[2], y[3]), pk2(y[4], y[5]), pk2(y[6], y[7])};
    }
}

__global__ void __launch_bounds__(512, 2) fwd(Args a) {
    extern __shared__ __attribute__((aligned(16))) unsigned char smem[];
    Ctx c;
    const int wave_s = __builtin_amdgcn_readfirstlane((int)threadIdx.x >> 6);
#define SET_CTX(cx) do { int t_ = (wave_s << 6) | lane_id_v(); cx.tid0 = t_; cx.half = t_ >> 8; cx.tid = t_ & 255; cx.lane = t_ & 63; cx.wid = (t_ >> 6) & 3; \
        cx.wr = cx.wid >> 1; cx.wc = cx.wid & 1; cx.fr = cx.lane & 15; cx.fq = cx.lane >> 4; cx.bid = blockIdx.x * 2 + cx.half; cx.nblk = gridDim.x * 2; \
        cx.smem0 = smem; cx.smem = smem + cx.half * HALF_LDS; } while (0)
    SET_CTX(c);
#define PH_CTX() SET_CTX(c)
    unsigned char* const ws_base = a.ws;
    const void* const* const ain_base = (const void* const*)__builtin_amdgcn_kernarg_segment_ptr();
    unsigned* ctl = (unsigned*)(ws_base + WS_CTL);
    volatile LAS unsigned* xbw = (volatile LAS unsigned*)(smem + LDS_BLK);
    if (c.tid0 < 8) xbw[c.tid0] = 0u;
    __syncthreads();
    XcdBarrier bar; bar.bar = ctl; bar.x = 0; bar.st = xbw; bar.wave = wave_s;
    if (a.use_bar) bar = xcd_barrier_post(ctl, xbw, c.tid0);
#if ONE_LAUNCH
    const int hi = NPH;
#define IN(k) true
#else
    const int lo = a.ph_lo, hi = a.ph_hi;
#define IN(k) (lo <= (k) && (k) < hi)
#endif
#define PH(k) if (IN(k)) { PH_CTX(); unsigned char* ws = ws_base; const void* const* ain = ain_base; asm volatile("" : "+s"(ws), "+s"(ain));
#define UNIT_CTX() Ctx cu; SET_CTX(cu)
#define SEAM(k) do { if ((k) + 1 < hi) xcd_barrier(bar); } while (0)

#define XBF ((bf16_t*)(ws + WS_XBF))
#define X1 ((float*)(ws + WS_X1))
#define PROJ ((bf16_t*)(ws + U_PROJ))
#define GATES ((float*)(ws + U_GATES))
#define MIXO ((bf16_t*)(ws + U_MIXO))
#define YBUF ((float*)(ws + U_YBUF))
#define ROPEM ((const float*)(ws + WS_ROPEM))
#define ROPES ((const float*)(ws + WS_ROPES))
#define XRES ((layer == 0) ? (const float*)ain[0] : (const float*)a.out)
#define CNT (ctl + CW_CNT + layer * 128)
#define WIN ((const bf16_t*)(ws + WS_WIN) + (size_t)layer * WIN_ELEMS)
#define WOUT ((const bf16_t*)(ws + WS_WOUT) + (size_t)layer * WOUT_ELEMS)

    PH(0) for (int rep = 0; rep < REP_PRO; ++rep) phase_prologue(a, c); SEAM(0); }

    for (int layer = 0; layer < 4; ++layer) {
        const int pb = 1 + layer * PPL;
#if !ONE_LAUNCH
        if (pb >= hi || pb + PPL <= lo) continue;
#endif
        const int jj = layer >> 1;
        const bool odd = (layer & 1) != 0;

        PH(pb + 0) {
                DenseSched S{T / 256, NPAD / 256, 1024, (int)blockIdx.x, (int)gridDim.x};
                EpiIn E{PROJ, GATES, odd ? 1024 : 1952};
                g8::phase<true, false>(smem, (const char*)XBF, (const char*)WIN, 1024, S, E, c.tid0);
            }
            SEAM(pb + 0); }
        PH(pb + 1) for (int rp = 0; rp < ((REP_PHASE == 1) ? 2 : 1); ++rp) { if (rp) xcd_barrier(bar);
            if (!odd) phase_prep_even(PROJ, GATES, (const float*)ain[3] + jj * 256, (const float*)ain[5] + jj * 128, (const float*)ain[7] + jj * 4 * 1536,
                                      (const float*)ain[8] + jj * 4, (const float*)ain[9] + jj * 4, ROPEM,
                                      (bf16_t*)(ws + U_CQ), (bf16_t*)(ws + U_CKV), (bf16_t*)(ws + U_KROPE), (bf16_t*)(ws + U_GQ), (bf16_t*)(ws + U_GK), (bf16_t*)(ws + U_GV),
                                      (float*)(ws + U_BETA), (float*)(ws + U_GLOG), c);
            else {
                phase_prep_odd(PROJ, ROPES, (bf16_t*)(ws + U_QF), (bf16_t*)(ws + U_KN), c);
                unsigned* ctr = ctl + CW_WORK + pb + 1 + 64 * rp;
                for (;;) {
                    const int u = next_unit(ctr, c); UNIT_CTX();
                    if (u >= 1024) break;
                    mlc_passA(u, PROJ, GATES, (const float*)ain[13] + jj * 4, (const float*)ain[14] + jj * 4, (unsigned char*)YBUF, cu);
                }
            }
            }
            SEAM(pb + 1);
        }
        PH(pb + 2) for (int rp = 0; rp < ((REP_PHASE == 2) ? 2 : 1); ++rp) { if (rp) xcd_barrier(bar);
            unsigned* ctr = ctl + CW_WORK + pb + 2 + 64 * rp;
            if (!odd) {
                for (;;) {
                    const int u = next_unit(ctr, c); UNIT_CTX();
                    if (u >= 1024 + MLAUP_TILES) break;
                    if (u < 1024) gdc_passA(u, (const bf16_t*)(ws + U_GQ), (const bf16_t*)(ws + U_GK), (const bf16_t*)(ws + U_GV), (const float*)(ws + U_BETA),
                                            (const float*)(ws + U_GLOG), ws + WS_HBUF, cu);
                    else mla_up_tile(u - 1024, (const bf16_t*)(ws + U_CQ), (const bf16_t*)(ws + WS_WQB) + (size_t)jj * WQB_ELEMS, (const bf16_t*)(ws + U_CKV),
                                     (const bf16_t*)(ws + WS_WKVB) + (size_t)jj * WKVB_ELEMS, ROPEM, (bf16_t*)(ws + U_QF), (bf16_t*)(ws + U_KN), (bf16_t*)(ws + U_VV), cu);
                }
            } else {
                for (;;) {
                    const int u = next_unit(ctr, c); UNIT_CTX();
                    if (u >= 256 + 1024) break;
                    if (u < 256) mlc_passB(u, (unsigned char*)YBUF, cu);
                    else {
                        const int v = u - 256, hq = v & 7, n = (v >> 3) & 15, b = v >> 7, kvh = hq >> 2;
                        const size_t tb = (size_t)b * SEQ;
                        attn_unit<4, true>((const bf16_t*)(ws + U_QF) + tb * 512 + hq * 64, 512, (const bf16_t*)(ws + U_KN) + tb * 128 + kvh * 64, 128,
                                           (const bf16_t*)(ws + U_KN), 0, PROJ + tb * NPAD + 2184 + kvh * 64, NPAD,
                                           MIXO + tb * 1024 + 512 + hq * 64, 1024, n * 128, ((const float*)ain[16])[jj * 8 + hq] * 1.4426950408889634f, cu);
                    }
                }
            }
            }
            SEAM(pb + 2);
        }
        PH(pb + 3) for (int rp = 0; rp < ((REP_PHASE == 3) ? 2 : 1); ++rp) { if (rp) xcd_barrier(bar);
            unsigned* ctr = ctl + CW_WORK + pb + 3 + 64 * rp;
            if (!odd) {
                for (;;) {
                    const int u = next_unit(ctr, c); UNIT_CTX();
                    if (u >= 64 + 1024) break;
                    if (rp > 0 && ((REP_ONLY == 1 && u >= 64) || (REP_ONLY == 2 && u < 64))) continue;
                    if (u < 64) { if ((u & 1) == 0) gdc_passB(u >> 1, ws + WS_HBUF, (unsigned char*)YBUF, cu); else gdc_passB_idle(); }
                    else {
                        const int v = u - 64, qb = 15 - (v >> 6), bh = v & 63, b = bh >> 3, hh = bh & 7;
                        const size_t tb = (size_t)b * SEQ;
                        attn_unit<6, false>((const bf16_t*)(ws + U_QF) + tb * 768 + hh * 96, 768, (const bf16_t*)(ws + U_KN) + tb * 512 + hh * 64, 512,
                                            (const bf16_t*)(ws + U_KROPE) + tb * 32, 32, (const bf16_t*)(ws + U_VV) + tb * 512 + hh * 64, 512,
                                            MIXO + tb * 1024 + hh * 64, 1024, qb * 128, 0.f, cu);
                    }
                }
            } else {
                for (;;) {
                    const int u = next_unit(ctr, c); UNIT_CTX();
                    if (u >= 1024) break;
                    mlc_passC(u, PROJ, GATES, (const float*)ain[13] + jj * 4, (const float*)ain[14] + jj * 4, (const unsigned char*)YBUF, (const float*)ain[15] + jj * 512, MIXO, cu);
                }
            }
            }
            SEAM(pb + 3);
        }
        PH(pb + 4) for (int rp = 0; rp < ((REP_PHASE == 4) ? 2 : 1); ++rp) { if (rp) xcd_barrier(bar);
            if (!odd) {
                unsigned* ctr = ctl + CW_WORK + pb + 4 + 64 * rp;
                for (;;) {
                    const int u = next_unit(ctr, c); UNIT_CTX();
                    if (u >= 1024) break;
                    gdc_passC(u, ws + WS_HBUF, (const unsigned char*)YBUF, PROJ, (const float*)ain[10] + jj * 128, MIXO, cu);
                }
            }
            }
            if (!odd) SEAM(pb + 4);
        }
        PH(pb + 5) {
                DenseSched S{T / 256, 4, 1024, (int)blockIdx.x, (int)gridDim.x};
                EpiOut E{XBF, (bf16_t*)YBUF};
                g8::phase<true, false>(smem, (const char*)MIXO, (const char*)WOUT, 1024, S, E, c.tid0);
            }
            SEAM(pb + 5); }
#if FUSE_LNROUTE
        PH(pb + 6) phase_lnroute((const bf16_t*)YBUF, (const float*)ain[18] + layer * 1024, (const float*)ain[19] + layer * 1024, XBF, (const bf16_t*)(ws + WS_WRT) + (size_t)layer * WRT_ELEMS,
                                 (const float*)ain[21] + layer * 64, CNT, (int*)(ws + WS_LTOK), (float*)(ws + WS_LW), (int*)(ws + WS_ASG), (float*)(ws + WS_ASGW), c); SEAM(pb + 8); }
#else
        PH(pb + 6) for (int rep = 0; rep < REP_TOK; ++rep) phase_ln1((const bf16_t*)YBUF, (const float*)ain[18] + layer * 1024, (const float*)ain[19] + layer * 1024, XBF, c); SEAM(pb + 6); }
        PH(pb + 7) for (int rep = 0; rep < REP_GEMM; ++rep) phase_router(XBF, (const bf16_t*)(ws + WS_WRT) + (size_t)layer * WRT_ELEMS, (float*)(ws + WS_LOG), c); SEAM(pb + 7); }
        PH(pb + 8) phase_route((const float*)(ws + WS_LOG), (const float*)ain[21] + layer * 64, CNT, (int*)(ws + WS_LTOK), (float*)(ws + WS_LW), (int*)(ws + WS_ASG), (float*)(ws + WS_ASGW), c); SEAM(pb + 8); }
#endif
        PH(pb + 9) {
                int* bst8 = (int*)(smem + LDS_BLK + 64); int* eb8 = bst8 + 256;
                build_block_table(CNT, bst8, c);
                for (int rb = c.tid0; rb < bst8[65]; rb += NT) { int e = 0; for (int q = 1; q < 65; ++q) e += (bst8[q] <= rb) ? 1 : 0; eb8[rb] = e; }
                __syncthreads();
                MoeSchedG S{__builtin_amdgcn_readfirstlane(bst8[65]), (int)blockIdx.x, (int)gridDim.x, eb8, bst8, (const int*)(ws + WS_LTOK)};
                EpiMoe1 E{(bf16_t*)(ws + WS_HBUF)};
                g8::phase<false, true>(smem, (const char*)XBF, (const char*)((const bf16_t*)(ws + WS_WGU) + (size_t)layer * 65 * WGU_ELEMS), 1024, S, E, c.tid0);
            }
            SEAM(pb + 9); }
        PH(pb + 10)
#if MOE2_G8
            {
                int* bst8 = (int*)(smem + LDS_BLK + 64); int* eb8 = bst8 + 256;
                build_block_table(CNT, bst8, c);
                for (int rb = c.tid0; rb < bst8[65]; rb += NT) { int e = 0; for (int q = 1; q < 65; ++q) e += (bst8[q] <= rb) ? 1 : 0; eb8[rb] = e; }
                __syncthreads();
                MoeSched S{__builtin_amdgcn_readfirstlane(bst8[65]), 4, (int)blockIdx.x, (int)gridDim.x, eb8};
                EpiMoe2 E{(bf16_t*)(ws + U_Y)};
                g8::phase<true, false>(smem, (const char*)(ws + WS_HBUF), (const char*)((const bf16_t*)(ws + WS_WDN) + (size_t)layer * 65 * WDN_ELEMS), 256, S, E, c.tid0);
            }
#else
            phase_moe2((const bf16_t*)(ws + WS_HBUF), (const bf16_t*)(ws + WS_WDN) + (size_t)layer * 65 * WDN_ELEMS, CNT, (bf16_t*)(ws + U_Y), c);
#endif
            SEAM(pb + 10); }
        PH(pb + 11)
            if (layer == 3) phase_combine<true>((const bf16_t*)(ws + U_Y), (const int*)(ws + WS_ASG), (const float*)(ws + WS_ASGW), CNT, (const float*)ain[28] + layer * 1024, (const float*)ain[29] + layer * 1024, a.out, XBF, c);
            else phase_combine<false>((const bf16_t*)(ws + U_Y), (const int*)(ws + WS_ASG), (const float*)(ws + WS_ASGW), CNT, (const float*)ain[28] + layer * 1024, (const float*)ain[29] + layer * 1024, a.out, XBF, c);
            SEAM(pb + 11); }
    }
#undef IN
#undef XBF
#undef X1
#undef PROJ
#undef GATES
#undef MIXO
#undef YBUF
#undef ROPEM
#undef ROPES
#undef XRES
#undef CNT
#undef WIN
#undef WOUT
#undef PH
#undef PH_CTX
#undef UNIT_CTX
#undef SEAM
}

extern "C" void kernel_launch(void* const* d_in, const int* in_sizes, int n_in, void* d_out, int out_size, void* d_ws, size_t ws_size, hipStream_t stream) {
    static int grid = 0;
    if (grid == 0) {
        if (n_in != 30 || out_size != T * 1024 || ws_size < WS_END) {
            fprintf(stderr, "kernel_launch: unexpected shapes (n_in %d, out %d, ws %zu < %zu)\n", n_in, out_size, ws_size, (size_t)WS_END);
            grid = -1; return;
        }
        int dev = 0, cus = 0, per_cu = 0;
        (void)hipGetDevice(&dev);
        (void)hipDeviceGetAttribute(&cus, hipDeviceAttributeMultiprocessorCount, dev);
        (void)hipFuncSetAttribute((const void*)fwd, hipFuncAttributeMaxDynamicSharedMemorySize, DYN_LDS);
        (void)hipOccupancyMaxActiveBlocksPerMultiprocessor(&per_cu, (const void*)fwd, NT, DYN_LDS);
        (void)hipGetLastError();
        if (per_cu < 1) per_cu = 1;
        grid = cus;
    }
    if (grid < 0) return;
    (void)hipMemsetAsync((char*)d_ws + WS_CTL, 0, CTL_BYTES, stream);
    Args a{};
    for (int i = 0; i < 30; ++i) a.in[i] = d_in[i];
    a.out = (float*)d_out; a.ws = (unsigned char*)d_ws; a.pad = 0;
#if ONE_LAUNCH
    a.ph_lo = 0; a.ph_hi = NPH; a.use_bar = 1;
    hipLaunchKernelGGL(fwd, dim3(grid), dim3(NT), DYN_LDS, stream, a);
#else
    for (int p = 0; p < NPH; ++p) {
        a.ph_lo = p; a.ph_hi = p + 1; a.use_bar = 0;
        hipLaunchKernelGGL(fwd, dim3(grid), dim3(NT), DYN_LDS, stream, a);
    }
#endif
}
```

```cpp
#include <hip/hip_runtime.h>
#include <stdint.h>
#include <stdio.h>

#define REP_GEMM 1
#define REP_PHASE 0
#define REP_G0 1
#define REP_G1 1
#define REP_G2 1
#define REP_G3 1
#define REP_MIX 1
#define REP_ONLY 0
#define REP_CMB 1
#define REP_PRO 1
#define REP_TOK 1
#define MOE2_G8 1
#ifndef G8_SPLIT
#define G8_SPLIT 0
#endif
#ifndef FUSE_LNROUTE
#define FUSE_LNROUTE 1
#endif
#ifndef Y_FP8
#define Y_FP8 1
#endif
#ifndef ONE_LAUNCH
#define ONE_LAUNCH 1
#endif

typedef unsigned short bf16_t;
typedef short bf16x8 __attribute__((ext_vector_type(8)));
typedef float f32x4 __attribute__((ext_vector_type(4)));
typedef float f32x2 __attribute__((ext_vector_type(2)));
typedef unsigned u32x4 __attribute__((ext_vector_type(4)));
typedef unsigned u32x2 __attribute__((ext_vector_type(2)));
#define LAS __attribute__((address_space(3)))
#define GAS __attribute__((address_space(1)))

constexpr int T = 16384, SEQ = 2048;
constexpr int NPAD = 2560;
constexpr int CAP = 16384;
constexpr int RBR = 256;
constexpr int MAXRB = 512 + 64 + 64;
constexpr int MAXROWS = MAXRB * RBR;
constexpr float ALPHA = 1.681792830507429f;
constexpr int PPL = 12;
constexpr int NPH = 1 + 4 * PPL;
constexpr int NT = 512, NW = 8;
constexpr int HALF_LDS = 65536 + 64 + 1024;
constexpr int LDS_BLK = 2 * HALF_LDS;
constexpr int DYN_LDS = LDS_BLK + 64 + 1024 + 2560;

constexpr size_t cmax(size_t a, size_t b) { return a > b ? a : b; }
constexpr size_t WS_CTL = 0;
constexpr size_t CTL_BYTES = 65536;
constexpr size_t WS_WIN = WS_CTL + CTL_BYTES;
constexpr size_t WIN_ELEMS = (size_t)NPAD * 1024;
constexpr size_t WS_WQB = WS_WIN + 4 * WIN_ELEMS * 2;
constexpr size_t WQB_ELEMS = 768 * 256;
constexpr size_t WS_WKVB = WS_WQB + 2 * WQB_ELEMS * 2;
constexpr size_t WKVB_ELEMS = 1024 * 128;
constexpr size_t WS_WOUT = WS_WKVB + 2 * WKVB_ELEMS * 2;
constexpr size_t WOUT_ELEMS = 1024 * 1024;
constexpr size_t WS_WRT = WS_WOUT + 4 * WOUT_ELEMS * 2;
constexpr size_t WRT_ELEMS = 128 * 1024;
constexpr size_t WS_WGU = WS_WRT + 4 * WRT_ELEMS * 2;
constexpr size_t WGU_ELEMS = 512 * 1024;
constexpr size_t WS_WDN = WS_WGU + 4 * 65 * WGU_ELEMS * 2;
constexpr size_t WDN_ELEMS = 1024 * 256;
constexpr size_t WS_ROPEM = WS_WDN + 4 * 65 * WDN_ELEMS * 2;
constexpr size_t WS_ROPES = WS_ROPEM + (size_t)T * 16 * 2 * 4;
constexpr size_t WS_X1 = WS_ROPES + (size_t)T * 32 * 2 * 4;
constexpr size_t WS_XBF = WS_X1 + (size_t)T * 1024 * 4;
constexpr size_t WS_HBUF = WS_XBF + (size_t)T * 1024 * 2;
constexpr size_t WS_LOG = WS_HBUF + (size_t)MAXROWS * 256 * 2;
constexpr size_t WS_ASG = WS_LOG + (size_t)T * 64 * 4;
constexpr size_t WS_ASGW = WS_ASG + (size_t)T * 8 * 4;
constexpr size_t WS_LTOK = WS_ASGW + (size_t)T * 8 * 4;
constexpr size_t WS_LW = WS_LTOK + (size_t)65 * CAP * 4;
constexpr size_t WS_U = WS_LW + (size_t)65 * CAP * 4;
constexpr size_t U_Y = WS_U;
constexpr size_t U_PROJ = WS_U;
constexpr size_t U_GATES = U_PROJ + (size_t)T * NPAD * 2;
constexpr size_t U_CQ = U_GATES + (size_t)T * 8 * 4;
constexpr size_t U_CKV = U_CQ + (size_t)T * 256 * 2;
constexpr size_t U_KROPE = U_CKV + (size_t)T * 128 * 2;
constexpr size_t U_QF = U_KROPE + (size_t)T * 32 * 2;
constexpr size_t U_KN = U_QF + (size_t)T * 768 * 2;
constexpr size_t U_VV = U_KN + (size_t)T * 512 * 2;
constexpr size_t U_GQ = U_VV + (size_t)T * 512 * 2;
constexpr size_t U_GK = U_GQ + (size_t)T * 512 * 2;
constexpr size_t U_GV = U_GK + (size_t)T * 512 * 2;
constexpr size_t U_BETA = U_GV + (size_t)T * 512 * 2;
constexpr size_t U_GLOG = U_BETA + (size_t)T * 4 * 4;
constexpr size_t U_MIXO = U_GLOG + (size_t)T * 4 * 4;
constexpr size_t U_YBUF = U_MIXO + (size_t)T * 1024 * 2;
constexpr size_t U_END1 = U_YBUF + (size_t)T * 1024 * 4;
constexpr size_t WS_END = WS_U + cmax((size_t)MAXROWS * 1024 * 2, U_END1 - WS_U);

constexpr int CW_CNT = 4096;
constexpr int CW_WORK = 8192;

#define XB_TMO      128
#define XB_XCNT(j)  (256  + 64 * (j))
#define XB_XSUB(j)  (1280 + 64 * (j))
#define XB_XGEN(j)  (2304 + 64 * (j))
#define XB_TOP      3328
#define XB_TOPGEN   3392
#define XCD_BAR_WORDS 3456
#define XB_SPIN_CAP (1u << 18)

__device__ __forceinline__ unsigned xb_ld(unsigned* p)              { return __hip_atomic_load(p, __ATOMIC_RELAXED, __HIP_MEMORY_SCOPE_AGENT); }
__device__ __forceinline__ int lane_id_v() { int l; asm volatile("v_mbcnt_lo_u32_b32 %0, -1, 0\n\tv_mbcnt_hi_u32_b32 %0, -1, %0" : "=v"(l)); return l; }
__device__ __forceinline__ unsigned xb_add(unsigned* p, unsigned v) { return __hip_atomic_fetch_add(p, v, __ATOMIC_RELAXED, __HIP_MEMORY_SCOPE_AGENT); }
__device__ __forceinline__ unsigned xb_xcc_id() { return (unsigned)__builtin_amdgcn_s_getreg((3 << 11) | 20) & 0xFu; }
#define XB_SPIN(cond, bar) do { unsigned _sp = 0; while (cond) { __builtin_amdgcn_s_sleep(1); \
    if ((++_sp & 255u) == 0u) { if (xb_ld(&(bar)[XB_TMO])) break; if (_sp > XB_SPIN_CAP) { atomicAdd(&(bar)[XB_TMO], 1u); break; } } } } while (0)

struct XcdBarrier { unsigned* bar; unsigned x; volatile LAS unsigned* st; int wave; };

__device__ __forceinline__ XcdBarrier xcd_barrier_post(unsigned* bar, volatile LAS unsigned* st, int tid0) {
    XcdBarrier b; b.bar = bar; b.x = xb_xcc_id(); b.st = st; b.wave = __builtin_amdgcn_readfirstlane(tid0 >> 6);
    if (tid0 == 0) (void)xb_add(&bar[XB_XCNT(b.x)], 1u);
    return b;
}
__device__ __forceinline__ void xcd_barrier_complete(unsigned* bar, unsigned x, unsigned& nloc, unsigned& nx) {
    const unsigned G = gridDim.x * gridDim.y * gridDim.z;
    unsigned sum, cnt, mine, sp = 0u;
    for (;;) {
        sum = 0u; cnt = 0u; mine = 0u;
#pragma unroll
        for (unsigned j = 0; j < 16; ++j) { const unsigned c = xb_ld(&bar[XB_XCNT(j)]); sum += c; cnt += (c > 0u) ? 1u : 0u; mine = (j == x) ? c : mine; }
        if (sum == G) break;
        __builtin_amdgcn_s_sleep(1);
        if ((++sp & 255u) == 0u) { if (xb_ld(&bar[XB_TMO])) break; if (sp > XB_SPIN_CAP) { atomicAdd(&bar[XB_TMO], 1u); break; } }
    }
    nloc = mine > 0u ? mine : 1u; nx = cnt > 0u ? cnt : 1u;
}
__device__ __forceinline__ void xcd_barrier(const XcdBarrier& b) {
    asm volatile("s_waitcnt vmcnt(0)" ::: "memory");
    __syncthreads();
    if (b.wave == 0 && lane_id_v() == 0) {
        unsigned* bar = b.bar; unsigned bx = __builtin_amdgcn_readfirstlane(b.x);
        asm volatile("" : "+s"(bar), "+s"(bx));
        __builtin_amdgcn_s_waitcnt(0);
        unsigned nloc = b.st[0], nx = b.st[1];
        if (nloc == 0u) { xcd_barrier_complete(bar, bx, nloc, nx); b.st[0] = nloc; b.st[1] = nx; }
        const unsigned old = xb_add(&bar[XB_XSUB(bx)], 1u);
        const unsigned gen = old / nloc;
        if (old + 1u == (gen + 1u) * nloc) {
            __builtin_amdgcn_fence(__ATOMIC_RELEASE, "agent");
            asm volatile("s_waitcnt vmcnt(0)" ::: "memory");
            const unsigned og = xb_add(&bar[XB_TOP], 1u);
            const unsigned tg = og / nx;
            if (og + 1u == (tg + 1u) * nx) xb_add(&bar[XB_TOPGEN], 1u);
            else XB_SPIN(xb_ld(&bar[XB_TOPGEN]) == tg, bar);
            __builtin_amdgcn_fence(__ATOMIC_ACQUIRE, "agent");
            xb_add(&bar[XB_XGEN(bx)], 1u);
            asm volatile("s_waitcnt vmcnt(0)" ::: "memory");
        } else {
            XB_SPIN(xb_ld(&bar[XB_XGEN(bx)]) == gen, bar);
            __builtin_amdgcn_fence(__ATOMIC_ACQUIRE, "agent");
            asm volatile("s_waitcnt vmcnt(0)" ::: "memory");
        }
    }
    __syncthreads();
}

__device__ __forceinline__ float bf2f(unsigned v) { return __uint_as_float(v << 16); }
__device__ __forceinline__ float bflo(unsigned w) { return __uint_as_float(w << 16); }
__device__ __forceinline__ float bfhi(unsigned w) { return __uint_as_float(w & 0xffff0000u); }
__device__ __forceinline__ unsigned f2bf(float f) { unsigned u = __float_as_uint(f); u += 0x7fffu + ((u >> 16) & 1u); return u >> 16; }
__device__ __forceinline__ unsigned pk2(float lo, float hi) { return f2bf(lo) | (f2bf(hi) << 16); }
__device__ __forceinline__ unsigned cvt_pk(float lo, float hi) { unsigned r; asm volatile("v_cvt_pk_bf16_f32 %0, %1, %2" : "=v"(r) : "v"(lo), "v"(hi)); return r; }
template <class T> __device__ __forceinline__ T shfl_xor_(T v, int o) { return __builtin_bit_cast(T, __builtin_amdgcn_ds_bpermute((lane_id_v() ^ o) << 2, __builtin_bit_cast(int, v))); }
template <class T> __device__ __forceinline__ T shfl_up_(T v, int o) { const int l = lane_id_v(), s = (l - o < 0) ? l : l - o; return __builtin_bit_cast(T, __builtin_amdgcn_ds_bpermute(s << 2, __builtin_bit_cast(int, v))); }
template <class T> __device__ __forceinline__ T shfl_c_(T v, int src  ) { return __builtin_bit_cast(T, __builtin_amdgcn_readlane(__builtin_bit_cast(int, v), src)); }
__device__ __forceinline__ float wave_sum(float v) {
#pragma unroll
    for (int o = 32; o > 0; o >>= 1) v += shfl_xor_(v, o);
    return v;
}
__device__ __forceinline__ float sigmoidf_(float x) { return 1.f / (1.f + expf(-x)); }
__device__ __forceinline__ float siluf_(float x) { return x / (1.f + expf(-x)); }
__device__ __forceinline__ float softplusf_(float x) { return x > 20.f ? x : log1pf(expf(x)); }
__device__ __forceinline__ void glds16(const void* g, void* l) {
    __builtin_amdgcn_global_load_lds((const GAS unsigned*)g, (LAS unsigned*)l, 16, 0, 0);
}
__device__ __forceinline__ void unpack8(const u32x4 r, float (&f)[8]) {
    f[0] = bflo(r.x); f[1] = bfhi(r.x); f[2] = bflo(r.y); f[3] = bfhi(r.y);
    f[4] = bflo(r.z); f[5] = bfhi(r.z); f[6] = bflo(r.w); f[7] = bfhi(r.w);
}

struct Args {
    const void* in[30];
    float* out;
    unsigned char* ws;
    int ph_lo, ph_hi, use_bar, pad;
};

struct Ctx { int tid, lane, wid, wr, wc, fr, fq, bid, nblk; unsigned char* smem; int half, tid0; unsigned char* smem0; };

#define WAIT_V(n) asm volatile("s_waitcnt vmcnt(" #n ")" ::: "memory")
__device__ __forceinline__ void gemm_tile(const bf16_t* a0, const bf16_t* a1, const bf16_t* b0, const bf16_t* b1,
                                          int nk, f32x4 (&acc)[4][4], const Ctx& c) {
#pragma unroll
    for (int m = 0; m < 4; ++m)
#pragma unroll
        for (int n = 0; n < 4; ++n) acc[m][n] = (f32x4){0.f, 0.f, 0.f, 0.f};
    unsigned char* smem = c.smem;
    const int sb = c.tid * 16;
    const int kofs = ((c.tid & 3) ^ ((c.tid >> 4) & 3)) * 8;
    a0 += kofs; a1 += kofs; b0 += kofs; b1 += kofs;
#define G_STAGE(kt_) do { unsigned char* sp_ = smem + ((kt_) & 3) * 16384 + sb; const int ko_ = (kt_) * 32; \
        glds16(a0 + ko_, sp_); glds16(a1 + ko_, sp_ + 4096); glds16(b0 + ko_, sp_ + 8192); glds16(b1 + ko_, sp_ + 12288); } while (0)
#define G_READ(kt_, AF, BF) do { const unsigned char* sa_ = smem + ((kt_) & 3) * 16384 + c.wr * 4096 + roff; const unsigned char* sb_ = smem + ((kt_) & 3) * 16384 + 8192 + c.wc * 4096 + roff; \
        _Pragma("unroll") for (int m = 0; m < 4; ++m) AF[m] = *(const bf16x8*)(sa_ + m * 1024); \
        _Pragma("unroll") for (int n = 0; n < 4; ++n) BF[n] = *(const bf16x8*)(sb_ + n * 1024); } while (0)
#define G_MMA(AF, BF) do { __builtin_amdgcn_s_setprio(1); \
        _Pragma("unroll") for (int m = 0; m < 4; ++m) _Pragma("unroll") for (int n = 0; n < 4; ++n) acc[m][n] = __builtin_amdgcn_mfma_f32_16x16x32_bf16(BF[n], AF[m], acc[m][n], 0, 0, 0); \
        __builtin_amdgcn_s_setprio(0); } while (0)
#define G_BAR() do { asm volatile("" ::: "memory"); __builtin_amdgcn_s_barrier(); asm volatile("" ::: "memory"); } while (0)
    const int roff = (c.fr * 64) + ((c.fq ^ ((c.fr >> 2) & 3)) * 16);
    WAIT_V(0);
    G_STAGE(0); G_STAGE(1); G_STAGE(2); G_STAGE(3);
    bf16x8 fa0[4], fb0[4], fa1[4], fb1[4];
    WAIT_V(12); G_BAR();
    G_READ(0, fa0, fb0);
#define G_LGK0() asm volatile("s_waitcnt lgkmcnt(0)" ::: "memory")
    int kt = 0;
    for (; kt < nk - 4; kt += 4) {
        G_LGK0(); WAIT_V(8); G_BAR(); G_STAGE(kt + 4); G_READ(1, fa1, fb1); G_MMA(fa0, fb0);
        G_LGK0(); WAIT_V(8); G_BAR(); G_STAGE(kt + 5); G_READ(2, fa0, fb0); G_MMA(fa1, fb1);
        G_LGK0(); WAIT_V(8); G_BAR(); G_STAGE(kt + 6); G_READ(3, fa1, fb1); G_MMA(fa0, fb0);
        G_LGK0(); WAIT_V(8); G_BAR(); G_STAGE(kt + 7); G_READ(0, fa0, fb0); G_MMA(fa1, fb1);
    }
    G_LGK0(); WAIT_V(8); G_BAR(); G_READ(1, fa1, fb1); G_MMA(fa0, fb0);
    G_LGK0(); WAIT_V(4); G_BAR(); G_READ(2, fa0, fb0); G_MMA(fa1, fb1);
    G_LGK0(); WAIT_V(0); G_BAR(); G_READ(3, fa1, fb1); G_MMA(fa0, fb0);
    G_MMA(fa1, fb1);
#undef G_LGK0
#undef G_STAGE
#undef G_READ
#undef G_MMA
#undef G_BAR
    __syncthreads();
}

namespace g8 {
constexpr int BM = 256, BK = 64, HALF = 128, HTB = HALF * BK * 2, STAGE_BYTES = 8 * HTB;
__device__ __forceinline__ int lds_byte(int r, int c) { const int st = (r >> 4) * 2 + (c >> 5), rr = r & 15, cc = c & 31, ob = rr * 64 + cc * 2; return st * 1024 + (ob ^ (((ob >> 9) & 1) << 5)); }
__device__ __forceinline__ void stage_rc(int b, int& R, int& C) { const int st = b / 1024, sb = b % 1024, swz = sb ^ (((sb >> 9) & 1) << 5); R = (st >> 1) * 16 + swz / 64; C = (st & 1) * 32 + (swz % 64) / 2; }
__device__ __forceinline__ int perm32(int rho) { const int n = rho >> 4, i = rho & 15; return 8 * (i >> 2) + 4 * n + (i & 3); }
struct Unit { int pm, pn, bt; };

template <int PERM, bool GATHER, class Sched, class Epi>
__device__ __forceinline__ void phase(unsigned char* ldsp, const char* Abase, const char* Bbase, int K, const Sched& S, const Epi& E, int tid_in) {
    LAS unsigned char* lds = (LAS unsigned char*)ldsp;
    int tid = tid_in; asm volatile("" : "+v"(tid));
    const int wid = __builtin_amdgcn_readfirstlane(tid >> 6), lane = tid & 63, wr = wid >> 2, wc = wid & 3, fr = lane & 15, fq = lane >> 4;
    const int nt = K / BK;
    unsigned voffA[2], voffB[2];
#pragma unroll
    for (int i = 0; i < 2; ++i) { int R, C; stage_rc(tid * 16 + i * 8192, R, C); const int Rb = (PERM == 2) ? ((R >> 5) * 64 + ((R & 15) >> 2) * 16 + ((R >> 4) & 1) * 4 + (R & 3)) : (PERM == 1) ? ((R >> 5) * 64 + perm32(R & 31)) : (((R >> 5) * 2 + ((R & 15) >> 3)) * 32 + ((R >> 4) & 1) * 16 + (((R & 15) >> 2) & 1) * 8 + (R & 3));
        voffA[i] = (unsigned)(R * K + C) * 2u; voffB[i] = (unsigned)(Rb * K + C) * 2u; }
    const size_t kstep = (size_t)(BK * 2);
    const size_t hstep = (size_t)HALF * K * 2, tstep = 2 * hstep, bhstep = (PERM == 2) ? (size_t)8 * K * 2 : (PERM == 1) ? (size_t)32 * K * 2 : (size_t)4 * K * 2;
    const unsigned ldsw = (unsigned)wid * 1024u;
    const int aoff = lds_byte(wr * 64 + fr, fq * 8), boff = lds_byte(wc * 32 + fr, fq * 8);
#define G8_SA(b, h) (((b) * 2 + (h)) * HTB)
#define G8_SB(b, h) ((4 + (b) * 2 + (h)) * HTB)
#define G8_DMA(gptr, voff32, ldsoff) do { const char* _gp = (gptr); const unsigned _lo = (unsigned)(size_t)(ldsp) + (unsigned)(ldsoff); \
        asm volatile("s_mov_b32 m0, %2\n\ts_nop 0\n\tglobal_load_lds_dwordx4 %0, %1" :: "v"(voff32), "s"(_gp), "s"(_lo) : "memory", "m0"); } while (0)
#define G8_STAGE(bufoff, gbase, voff) do { _Pragma("unroll") for (int _i = 0; _i < 2; ++_i) G8_DMA((const char*)(gbase), (voff)[_i], (bufoff) + ldsw + _i * 8192); } while (0)
#define G8_STAGEA(bufoff, gbase, h, kb) do { if constexpr (GATHER) { _Pragma("unroll") for (int _i = 0; _i < 2; ++_i) G8_DMA(Abase + (kb), vA[2 * (h) + _i], (bufoff) + ldsw + _i * 8192); } \
        else G8_STAGE(bufoff, (gbase) + (size_t)(h) * hstep + (kb), voffA); } while (0)
#define G8_LDA(dst, b, h) do { _Pragma("unroll") for (int m = 0; m < 4; ++m) _Pragma("unroll") for (int k = 0; k < 2; ++k) dst[m][k] = *(const LAS bf16x8*)(lds + G8_SA(b, h) + aoff + m * 2048 + k * 1024); } while (0)
#define G8_LDB(dst, b, h) do { _Pragma("unroll") for (int n = 0; n < 2; ++n) _Pragma("unroll") for (int k = 0; k < 2; ++k) dst[n][k] = *(const LAS bf16x8*)(lds + G8_SB(b, h) + boff + n * 2048 + k * 1024); } while (0)
#define G8_MMA(ai, bj, At, Bt) do { __builtin_amdgcn_s_setprio(1); _Pragma("unroll") for (int m = 0; m < 4; ++m) _Pragma("unroll") for (int n = 0; n < 2; ++n) _Pragma("unroll") for (int k = 0; k < 2; ++k) \
        acc[ai][bj][m][n] = __builtin_amdgcn_mfma_f32_16x16x32_bf16(Bt[n][k], At[m][k], acc[ai][bj][m][n], 0, 0, 0); __builtin_amdgcn_s_setprio(0); } while (0)
#define G8_WAIT_V(n) asm volatile("s_waitcnt vmcnt(" #n ")" ::: "memory")
#define G8_WAIT_L(n) asm volatile("s_waitcnt lgkmcnt(" #n ")" ::: "memory")
#define G8_BAR __builtin_amdgcn_s_barrier()
#define G8_SCHED __builtin_amdgcn_sched_barrier(0)
    Unit cur, nxt; int ui = 0;
    if (!S.next(0, cur)) return;
    f32x4 acc[2][2][4][2];
#pragma unroll
    for (int a = 0; a < 2; ++a)
#pragma unroll
        for (int b = 0; b < 2; ++b)
#pragma unroll
            for (int m = 0; m < 4; ++m)
#pragma unroll
                for (int n = 0; n < 2; ++n) acc[a][b][m][n] = (f32x4){0.f, 0.f, 0.f, 0.f};
    bf16x8 At[4][2], B0[2][2], B1[2][2];
    const char* cA = Abase + (size_t)cur.pm * tstep; const char* cB = Bbase + (size_t)cur.bt * tstep;
    unsigned vA[4] = {0u, 0u, 0u, 0u};
    if constexpr (GATHER) S.aoff(cur, tid, vA);
    asm volatile("s_waitcnt vmcnt(0)" ::: "memory");
    G8_STAGE(G8_SB(0, 0), cB, voffB); G8_STAGEA(G8_SA(0, 0), cA, 0, 0); G8_STAGE(G8_SB(0, 1), cB + bhstep, voffB); G8_STAGEA(G8_SA(0, 1), cA, 1, 0);
    if (wr == 1) G8_BAR;
    G8_WAIT_V(4); G8_BAR;
    G8_STAGE(G8_SB(1, 0), cB + kstep, voffB); G8_STAGEA(G8_SA(1, 0), cA, 0, kstep); G8_STAGE(G8_SB(1, 1), cB + bhstep + kstep, voffB);
    G8_WAIT_V(6); G8_BAR;
    G8_STAGEA(G8_SA(1, 1), cA, 1, kstep);
    for (;;) {
        const bool has_next = S.next(ui + 1, nxt);
        const char* nA = has_next ? Abase + (size_t)nxt.pm * tstep : cA; const char* nB = has_next ? Bbase + (size_t)nxt.bt * tstep : cB;
        for (int t = 0; t < nt; t += 2) {
            const bool last = (t == nt - 2);
            const int lastf = __builtin_amdgcn_readfirstlane(last ? 1 : 0);
            const size_t k2 = last ? 0 : (size_t)(t + 2) * kstep, k3 = k2 + kstep;
            const char* a2 = last ? nA : cA; const char* b2 = last ? nB : cB + (size_t)(t + 2) * kstep;
            const char* b3 = b2 + kstep;
            G8_LDB(B0, 0, 0); G8_SCHED; G8_LDA(At, 0, 0);
            if constexpr (GATHER) { if (last && has_next) S.aoff(nxt, tid, vA); }
            G8_WAIT_L(8); G8_BAR; G8_WAIT_L(0); G8_MMA(0, 0, At, B0); G8_BAR; G8_SCHED;
            G8_LDB(B1, 0, 1); G8_STAGE(G8_SB(0, 0), b2, voffB);
            G8_BAR; G8_WAIT_L(0); G8_MMA(0, 1, At, B1); G8_BAR;
            G8_LDA(At, 0, 1); G8_STAGEA(G8_SA(0, 0), a2, 0, k2);
            G8_BAR; G8_WAIT_L(0); G8_MMA(1, 0, At, B0); G8_BAR; G8_SCHED;
            G8_STAGE(G8_SB(0, 1), b2 + bhstep, voffB);
            const int pend = __builtin_amdgcn_readfirstlane((t == 0 && ui > 0) ? 1 : 0);
            asm volatile("s_cmp_lg_u32 %0, 0\n\ts_cbranch_scc1 1f\n\ts_waitcnt vmcnt(6)\n1:\n\ts_waitcnt vmcnt(%1)" :: "s"(pend), "n"(6 + (Epi::SPLIT ? Epi::NQ : Epi::NST)) : "memory", "scc");
            G8_BAR; G8_MMA(1, 1, At, B1); G8_BAR;
            G8_LDB(B0, 1, 0); G8_SCHED; G8_LDA(At, 1, 0); G8_STAGEA(G8_SA(0, 1), a2, 1, k2);
            G8_WAIT_L(8); G8_BAR; G8_WAIT_L(0); G8_MMA(0, 0, At, B0); G8_BAR; G8_SCHED;
            if constexpr (Epi::SPLIT) { E.template part_cond<0, 0>(acc, cur, wr, wc, fr, fq, lastf); G8_SCHED; }
            G8_LDB(B1, 1, 1); G8_STAGE(G8_SB(1, 0), b3, voffB);
            G8_BAR; G8_WAIT_L(0); G8_MMA(0, 1, At, B1); G8_BAR;
            if constexpr (Epi::SPLIT) { E.template part_cond<0, 1>(acc, cur, wr, wc, fr, fq, lastf); G8_SCHED; }
            G8_LDA(At, 1, 1); G8_STAGEA(G8_SA(1, 0), a2, 0, k3);
            G8_BAR; G8_WAIT_L(0); G8_MMA(1, 0, At, B0); G8_BAR; G8_SCHED;
            G8_STAGE(G8_SB(1, 1), b3 + bhstep, voffB);
            if constexpr (Epi::SPLIT) {
                asm volatile("s_cmp_lg_u32 %0, 0\n\ts_cbranch_scc1 1f\n\ts_waitcnt vmcnt(6)\n1:\n\ts_waitcnt vmcnt(%1)" :: "s"(lastf), "n"(6 + 2 * Epi::NQ) : "memory", "scc");
                G8_SCHED; E.template part_cond<1, 0>(acc, cur, wr, wc, fr, fq, lastf); G8_SCHED;
            } else G8_WAIT_V(6);
            G8_BAR; G8_MMA(1, 1, At, B1); G8_BAR;
            G8_STAGEA(G8_SA(1, 1), a2, 1, k3);
        }
        if constexpr (Epi::SPLIT) E.tail(acc, cur, wr, wc, fr, fq); else E(acc, cur, wr, wc, fr, fq);
        if (!has_next) break;
#pragma unroll
        for (int a = 0; a < 2; ++a)
#pragma unroll
            for (int b = 0; b < 2; ++b)
#pragma unroll
                for (int m = 0; m < 4; ++m)
#pragma unroll
                    for (int n = 0; n < 2; ++n) acc[a][b][m][n] = (f32x4){0.f, 0.f, 0.f, 0.f};
        cur = nxt; cA = nA; cB = nB; ++ui;
    }
    G8_WAIT_V(0);
    if (wr == 0) G8_BAR;
    G8_BAR;
#undef G8_SA
#undef G8_SB
#undef G8_STAGE
#undef G8_STAGEA
#undef G8_LDA
#undef G8_LDB
#undef G8_MMA
#undef G8_WAIT_V
#undef G8_WAIT_L
#undef G8_BAR
#undef G8_SCHED
}
}

__device__ __forceinline__ bool tile_map(int i, const Ctx& c, int ntm, int ntn, int& mt, int& nt) {
    const int vb = ((c.nblk & 15) == 0) ? ((c.bid >> 1) & 7) * (c.nblk >> 3) + (((c.bid >> 4) << 1) | (c.bid & 1)) : c.bid;
    const int L = i * c.nblk + vb;
    if (L >= ntm * ntn) return false;
    const int g = L / (8 * ntn), rem = L - g * 8 * ntn;
    const int gsz = (ntm - g * 8) < 8 ? (ntm - g * 8) : 8;
    mt = g * 8 + rem % gsz; nt = rem / gsz;
    return true;
}

__device__ __forceinline__ bool tile_map2(int i, const Ctx& c, int ntm, int ntn, int& mt, int& nt, bool& valid) {
    Ctx o = c; o.bid = c.bid ^ 1;
    int mo, no; const bool oko = tile_map(i, o, ntm, ntn, mo, no);
    valid = tile_map(i, c, ntm, ntn, mt, nt);
    if (!valid) { mt = 0; nt = 0; }
    return valid || oko;
}

struct DenseSched {
    int ntm, ntn, K, bid, nblk;
    __device__ __forceinline__ bool next(int i, g8::Unit& u) const {
        const int vb = ((nblk & 7) == 0) ? (bid & 7) * (nblk >> 3) + (bid >> 3) : bid;
        const int L = i * nblk + vb;
        if (L >= ntm * ntn) return false;
        const int g = L / (8 * ntn), rem = L - g * 8 * ntn;
        const int gsz = (ntm - g * 8) < 8 ? (ntm - g * 8) : 8;
        u.pm = g * 8 + rem % gsz; u.pn = rem / gsz; u.bt = u.pn;
        return true;
    }
};
struct MoeSched {
    int nrb, ntn, bid, nblk; const int* eb;
    __device__ __forceinline__ bool next(int i, g8::Unit& u) const {
        const int vb = ((nblk & 7) == 0) ? (bid & 7) * (nblk >> 3) + (bid >> 3) : bid;
        const int L = i * nblk + vb;
        if (L >= nrb * ntn) return false;
        const int g = L / (8 * ntn), rem = L - g * 8 * ntn;
        const int gsz = (nrb - g * 8) < 8 ? (nrb - g * 8) : 8;
        u.pm = g * 8 + rem % gsz; u.pn = rem / gsz;
        u.bt = __builtin_amdgcn_readfirstlane(eb[u.pm]) * ntn + u.pn;
        return true;
    }
};
struct MoeSchedG {
    int nrb, bid, nblk; const int* eb; const int* bst; const int* LTOK;
    __device__ __forceinline__ bool next(int i, g8::Unit& u) const {
        const int vb = ((nblk & 7) == 0) ? (bid & 7) * (nblk >> 3) + (bid >> 3) : bid;
        const int L = i * nblk + vb;
        if (L >= nrb * 2) return false;
        const int g = L >> 4, rem = L & 15;
        const int gsz = (nrb - g * 8) < 8 ? (nrb - g * 8) : 8;
        u.pm = g * 8 + rem % gsz; u.pn = rem / gsz;
        u.bt = __builtin_amdgcn_readfirstlane(eb[u.pm]) * 2 + u.pn;
        return true;
    }
    __device__ __forceinline__ void aoff(const g8::Unit& u, int tid, unsigned (&o)[4]) const {
        const int e = eb[u.pm], lb = u.pm - bst[e], cnt = bst[66 + e];
        int R0, C0, R1, C1; g8::stage_rc(tid * 16, R0, C0); g8::stage_rc(tid * 16 + 8192, R1, C1);
        const int* lt = LTOK + (size_t)e * CAP + lb * RBR;
        const int p00 = R0, p01 = R1, p10 = 128 + R0, p11 = 128 + R1;
        const int t00 = (lb * RBR + p00 < cnt) ? lt[p00] : 0, t01 = (lb * RBR + p01 < cnt) ? lt[p01] : 0;
        const int t10 = (lb * RBR + p10 < cnt) ? lt[p10] : 0, t11 = (lb * RBR + p11 < cnt) ? lt[p11] : 0;
        o[0] = (unsigned)t00 * 2048u + (unsigned)C0 * 2u; o[1] = (unsigned)t01 * 2048u + (unsigned)C1 * 2u;
        o[2] = (unsigned)t10 * 2048u + (unsigned)C0 * 2u; o[3] = (unsigned)t11 * 2048u + (unsigned)C1 * 2u;
    }
};
struct EpiMoe1 {
    static constexpr bool SPLIT = false; static constexpr int NQ = 2, NST = 8;
    bf16_t* H;
    __device__ __forceinline__ void operator()(const f32x4 (&acc)[2][2][4][2], const g8::Unit& u, int wr, int wc, int fr, int fq) const {
#pragma unroll
        for (int ai = 0; ai < 2; ++ai)
#pragma unroll
            for (int m = 0; m < 4; ++m) {
                const size_t row = (size_t)u.pm * RBR + ai * 128 + wr * 64 + m * 16 + fr;
                float h[8];
#pragma unroll
                for (int bj = 0; bj < 2; ++bj) {
                    const f32x4 g = acc[ai][bj][m][0], up = acc[ai][bj][m][1];
#pragma unroll
                    for (int j = 0; j < 4; ++j) h[bj * 4 + j] = g[j] * __builtin_amdgcn_rcpf(1.f + __expf(-g[j])) * up[j];
                }
                *(u32x4*)(H + row * 256 + u.pn * 128 + wc * 32 + fq * 8) = (u32x4){cvt_pk(h[0], h[1]), cvt_pk(h[2], h[3]), cvt_pk(h[4], h[5]), cvt_pk(h[6], h[7])};
            }
    }
    template <int ai, int bj> __device__ __forceinline__ void part_cond(const f32x4 (&acc)[2][2][4][2], const g8::Unit& u, int wr, int wc, int fr, int fq, int flag) const {}
    __device__ __forceinline__ void tail(const f32x4 (&acc)[2][2][4][2], const g8::Unit& u, int wr, int wc, int fr, int fq) const {}
};
__device__ __forceinline__ u32x4 dpp_ror8(const u32x4 v) {
    u32x4 r;
#pragma unroll
    for (int i = 0; i < 4; ++i) r[i] = (unsigned)__builtin_amdgcn_update_dpp(0, (int)v[i], 0x128, 0xF, 0xF, true);
    return r;
}
template <bool NT = false>
__device__ __forceinline__ void perm_store(bf16_t* p  , size_t ld8  , const u32x4 p0, const u32x4 p1, int hi) {
    const u32x4 snd = hi ? p0 : p1, rcv = dpp_ror8(snd);
    if constexpr (NT) { __builtin_nontemporal_store(hi ? rcv : p0, (u32x4*)p); __builtin_nontemporal_store(hi ? p1 : rcv, (u32x4*)(p + ld8)); }
    else { *(u32x4*)p = hi ? rcv : p0; *(u32x4*)(p + ld8) = hi ? p1 : rcv; }
}
struct EpiIn {
    static constexpr bool SPLIT = false; static constexpr int NQ = 4, NST = 16;
    bf16_t* P; float* G; int gbase;
    template <int ai, int bj> __device__ __forceinline__ void part_cond(const f32x4 (&acc)[2][2][4][2], const g8::Unit& u, int wr, int wc, int fr, int fq, int flag) const {}
    __device__ __forceinline__ void tail(const f32x4 (&acc)[2][2][4][2], const g8::Unit& u, int wr, int wc, int fr, int fq) const {}
    __device__ __forceinline__ void operator()(const f32x4 (&acc)[2][2][4][2], const g8::Unit& u, int wr, int wc, int fr, int fq) const {
        const int hi = fr >> 3, r8 = fr & 7;
#pragma unroll
        for (int ai = 0; ai < 2; ++ai)
#pragma unroll
            for (int m = 0; m < 4; ++m) {
                const size_t rg = (size_t)u.pm * 256 + ai * 128 + wr * 64 + m * 16;
                u32x4 pk[2];
#pragma unroll
                for (int bj = 0; bj < 2; ++bj) {
                    const f32x4 v0 = acc[ai][bj][m][0], v1 = acc[ai][bj][m][1];
                    pk[bj] = (u32x4){cvt_pk(v0[0], v0[1]), cvt_pk(v0[2], v0[3]), cvt_pk(v1[0], v1[1]), cvt_pk(v1[2], v1[3])};
                    if (u.pn * 256 + wc * 64 + bj * 32 + fq * 8 == gbase) { *(f32x4*)(G + (rg + fr) * 8) = v0; *(f32x4*)(G + (rg + fr) * 8 + 4) = v1; }
                }
                perm_store(P + (rg + r8) * NPAD + u.pn * 256 + wc * 64 + hi * 32 + fq * 8, (size_t)8 * NPAD, pk[0], pk[1], hi);
            }
    }
};
struct EpiMoe2 {
    static constexpr bool SPLIT = false; static constexpr int NQ = 4, NST = 16;
    bf16_t* Y;
    template <int ai, int bj> __device__ __forceinline__ void part_cond(const f32x4 (&acc)[2][2][4][2], const g8::Unit& u, int wr, int wc, int fr, int fq, int flag) const {}
    __device__ __forceinline__ void tail(const f32x4 (&acc)[2][2][4][2], const g8::Unit& u, int wr, int wc, int fr, int fq) const {}
    __device__ __forceinline__ void operator()(const f32x4 (&acc)[2][2][4][2], const g8::Unit& u, int wr, int wc, int fr, int fq) const {
        const int hi = fr >> 3, r8 = fr & 7;
#pragma unroll
        for (int ai = 0; ai < 2; ++ai)
#pragma unroll
            for (int m = 0; m < 4; ++m) {
                const size_t rg = (size_t)u.pm * RBR + ai * 128 + wr * 64 + m * 16;
                u32x4 pk[2];
#pragma unroll
                for (int bj = 0; bj < 2; ++bj) {
                    const f32x4 v0 = acc[ai][bj][m][0], v1 = acc[ai][bj][m][1];
                    pk[bj] = (u32x4){cvt_pk(v0[0], v0[1]), cvt_pk(v0[2], v0[3]), cvt_pk(v1[0], v1[1]), cvt_pk(v1[2], v1[3])};
                }
                perm_store<true>(Y + (rg + r8) * 1024 + u.pn * 256 + wc * 64 + hi * 32 + fq * 8, (size_t)8 * 1024, pk[0], pk[1], hi);
            }
    }
};
struct EpiMoe2F8 {
    static constexpr bool SPLIT = false; static constexpr int NQ = 2, NST = 8;
    unsigned char* Y;
    template <int ai, int bj> __device__ __forceinline__ void part_cond(const f32x4 (&acc)[2][2][4][2], const g8::Unit& u, int wr, int wc, int fr, int fq, int flag) const {}
    __device__ __forceinline__ void tail(const f32x4 (&acc)[2][2][4][2], const g8::Unit& u, int wr, int wc, int fr, int fq) const {}
    __device__ __forceinline__ void operator()(const f32x4 (&acc)[2][2][4][2], const g8::Unit& u, int wr, int wc, int fr, int fq) const {
#pragma unroll
        for (int ai = 0; ai < 2; ++ai)
#pragma unroll
            for (int m = 0; m < 4; ++m) {
                const size_t row = (size_t)u.pm * RBR + ai * 128 + wr * 64 + m * 16 + fr;
                u32x4 d;
#pragma unroll
                for (int bj = 0; bj < 2; ++bj)
#pragma unroll
                    for (int n = 0; n < 2; ++n) {
                        const f32x4 v = acc[ai][bj][m][n] * 16.f;
                        int w = __builtin_amdgcn_cvt_pk_fp8_f32(v[0], v[1], 0, false);
                        w = __builtin_amdgcn_cvt_pk_fp8_f32(v[2], v[3], w, true);
                        d[bj * 2 + n] = (unsigned)w;
                    }
                *(u32x4*)(Y + row * 1024 + u.pn * 256 + wc * 64 + fq * 16) = d;
            }
    }
};
struct EpiOut {
    static constexpr bool SPLIT = false; static constexpr int NQ = 8, NST = 32;
    template <int ai, int bj> __device__ __forceinline__ void part_cond(const f32x4 (&acc)[2][2][4][2], const g8::Unit& u, int wr, int wc, int fr, int fq, int flag) const {}
    __device__ __forceinline__ void tail(const f32x4 (&acc)[2][2][4][2], const g8::Unit& u, int wr, int wc, int fr, int fq) const {}
    const bf16_t* xres; bf16_t* Y;
    __device__ __forceinline__ void operator()(const f32x4 (&acc)[2][2][4][2], const g8::Unit& u, int wr, int wc, int fr, int fq) const {
        const int hi = fr >> 3, r8 = fr & 7;
#pragma unroll
        for (int ai = 0; ai < 2; ++ai)
#pragma unroll
            for (int m = 0; m < 4; ++m) {
                const size_t rg = (size_t)u.pm * 256 + ai * 128 + wr * 64 + m * 16;
                u32x4 pk[2];
#pragma unroll
                for (int bj = 0; bj < 2; ++bj) {
                    const u32x4 xr = *(const u32x4*)(xres + (rg + fr) * 1024 + u.pn * 256 + wc * 64 + bj * 32 + fq * 8);
                    float f[8]; unpack8(xr, f);
                    const f32x4 v0 = acc[ai][bj][m][0], v1 = acc[ai][bj][m][1];
                    pk[bj] = (u32x4){cvt_pk(f[0] * ALPHA + v0[0], f[1] * ALPHA + v0[1]), cvt_pk(f[2] * ALPHA + v0[2], f[3] * ALPHA + v0[3]),
                                     cvt_pk(f[4] * ALPHA + v1[0], f[5] * ALPHA + v1[1]), cvt_pk(f[6] * ALPHA + v1[2], f[7] * ALPHA + v1[3])};
                }
                perm_store(Y + (rg + r8) * 1024 + u.pn * 256 + wc * 64 + hi * 32 + fq * 8, (size_t)8 * 1024, pk[0], pk[1], hi);
                asm volatile("" ::: "memory");
            }
    }
};

constexpr int TS_RS = 272;
__device__ __forceinline__ void tile_put(const Ctx& c, int row_l, int col_l, const u32x2 v) { *(u32x2*)(c.smem + row_l * TS_RS + col_l * 2) = v; }
template <int NCOL>
__device__ __forceinline__ void tile_flush(const Ctx& c, bf16_t* out, size_t ld, bool valid) {
    __syncthreads();
    constexpr int CPR = NCOL / 8, PER = (128 * CPR) / 256;
#pragma unroll
    for (int i = 0; i < PER; ++i) {
        const int idx = c.tid + 256 * i, row = idx / CPR, ch = idx % CPR;
        const u32x4 v = *(const u32x4*)(c.smem + row * TS_RS + ch * 16);
        if (valid) *(u32x4*)(out + (size_t)row * ld + ch * 8) = v;
    }
    __syncthreads();
}

__device__ __forceinline__ void conv_family(const float* src, int nmat, size_t src_stride, int K, int N, int Nout,
                            bf16_t* dst, size_t dst_stride, int grp, int kind, const Ctx& c) {
    float* lds = (float*)c.smem;
    const int tk = K / 128, tn = Nout / 64, per = tk * tn, total = nmat * per;
    const int tx = c.tid & 15, ty = c.tid >> 4;
    f32x4 r[8];
#define CV_LOAD(u_) do { const int mat_ = (u_) / per, r_ = (u_) - mat_ * per, kt_ = r_ / tn, nt_ = r_ - kt_ * tn; \
        const float* s_ = src + (size_t)mat_ * src_stride + (size_t)(kt_ * 128 + ty) * N + nt_ * 64 + tx * 4; const bool in_ = (nt_ * 64 + tx * 4) < N; \
        _Pragma("unroll") for (int i = 0; i < 8; ++i) r[i] = in_ ? __builtin_nontemporal_load((const f32x4*)(s_ + (size_t)(16 * i) * N)) : (f32x4){0.f, 0.f, 0.f, 0.f}; } while (0)
    if (c.bid < total) CV_LOAD(c.bid);
    for (int base = 0; base < total; base += c.nblk) {
        const int u = base + c.bid; const bool valid = u < total;
#pragma unroll
        for (int i = 0; i < 8; ++i) *(f32x4*)(lds + (ty + 16 * i) * 68 + tx * 4) = r[i];
        if (u + c.nblk < total) CV_LOAD(u + c.nblk);
        __syncthreads();
        if (valid) {
        const int mat = u / per, rr = u - mat * per, kt = rr / tn, nt = rr - kt * tn;
        const int dmat = grp ? (mat / grp) * (grp + 1) + (mat % grp) : mat;
        bf16_t* d = dst + (size_t)dmat * dst_stride;
        const int nl = c.tid & 63, kq = (c.tid >> 6) * 32;
        unsigned w[16];
#pragma unroll
        for (int j = 0; j < 16; ++j) w[j] = pk2(lds[(kq + 2 * j) * 68 + nl], lds[(kq + 2 * j + 1) * 68 + nl]);
        const int n = nt * 64 + nl;
        const int drow = (kind == 0) ? n : ((n >> 4) * 32 + (n & 15) + (kind == 2 ? 16 : 0));
        u32x4* dp = (u32x4*)(d + (size_t)drow * K + kt * 128 + kq);
        dp[0] = (u32x4){w[0], w[1], w[2], w[3]}; dp[1] = (u32x4){w[4], w[5], w[6], w[7]};
        dp[2] = (u32x4){w[8], w[9], w[10], w[11]}; dp[3] = (u32x4){w[12], w[13], w[14], w[15]};
        }
        __syncthreads();
    }
#undef CV_LOAD
}

__device__ __forceinline__ void phase_prologue(const Args& a, const Ctx& c) {
    unsigned char* ws = a.ws;
    bf16_t* WIN = (bf16_t*)(ws + WS_WIN);
    conv_family((const float*)a.in[2], 2, (size_t)1024 * 2472, 1024, 2472, NPAD, WIN, 2 * WIN_ELEMS, 0, 0, c);
    conv_family((const float*)a.in[12], 2, (size_t)1024 * 2312, 1024, 2312, NPAD, WIN + WIN_ELEMS, 2 * WIN_ELEMS, 0, 0, c);
    conv_family((const float*)a.in[4], 2, (size_t)256 * 768, 256, 768, 768, (bf16_t*)(ws + WS_WQB), WQB_ELEMS, 0, 0, c);
    conv_family((const float*)a.in[6], 2, (size_t)128 * 1024, 128, 1024, 1024, (bf16_t*)(ws + WS_WKVB), WKVB_ELEMS, 0, 0, c);
    bf16_t* WOUT = (bf16_t*)(ws + WS_WOUT);
    conv_family((const float*)a.in[11], 2, (size_t)1024 * 1024, 1024, 1024, 1024, WOUT, 2 * WOUT_ELEMS, 0, 0, c);
    conv_family((const float*)a.in[17], 2, (size_t)1024 * 1024, 1024, 1024, 1024, WOUT + WOUT_ELEMS, 2 * WOUT_ELEMS, 0, 0, c);
    conv_family((const float*)a.in[20], 4, (size_t)1024 * 64, 1024, 64, 128, (bf16_t*)(ws + WS_WRT), WRT_ELEMS, 0, 0, c);
    bf16_t* WGU = (bf16_t*)(ws + WS_WGU);
    conv_family((const float*)a.in[22], 256, (size_t)1024 * 256, 1024, 256, 256, WGU, WGU_ELEMS, 64, 1, c);
    conv_family((const float*)a.in[23], 256, (size_t)1024 * 256, 1024, 256, 256, WGU, WGU_ELEMS, 64, 2, c);
    conv_family((const float*)a.in[25], 4, (size_t)1024 * 256, 1024, 256, 256, WGU + 64 * WGU_ELEMS, 65 * WGU_ELEMS, 0, 1, c);
    conv_family((const float*)a.in[26], 4, (size_t)1024 * 256, 1024, 256, 256, WGU + 64 * WGU_ELEMS, 65 * WGU_ELEMS, 0, 2, c);
    bf16_t* WDN = (bf16_t*)(ws + WS_WDN);
    conv_family((const float*)a.in[24], 256, (size_t)256 * 1024, 256, 1024, 1024, WDN, WDN_ELEMS, 64, 0, c);
    conv_family((const float*)a.in[27], 4, (size_t)256 * 1024, 256, 1024, 1024, WDN + 64 * WDN_ELEMS, 65 * WDN_ELEMS, 0, 0, c);
    {
        const float* x = (const float*)a.in[0]; bf16_t* xb = (bf16_t*)(ws + WS_XBF);
        const size_t n8 = (size_t)T * 1024 / 8;
        for (size_t i = (size_t)c.bid * 256 + c.tid; i < n8; i += (size_t)c.nblk * 256) {
            const f32x4 v0 = __builtin_nontemporal_load((const f32x4*)(x + i * 8)), v1 = __builtin_nontemporal_load((const f32x4*)(x + i * 8 + 4));
            *(u32x4*)(xb + i * 8) = (u32x4){pk2(v0[0], v0[1]), pk2(v0[2], v0[3]), pk2(v1[0], v1[1]), pk2(v1[2], v1[3])};
        }
    }
    {
        const int* pos = (const int*)a.in[1];
        float* rm = (float*)(ws + WS_ROPEM); float* rs = (float*)(ws + WS_ROPES);
        const float ln_theta = 9.210340371976184f;
        for (int i = c.bid * 256 + c.tid; i < T * 16; i += c.nblk * 256) {
            const int t = i >> 4, f = i & 15;
            const float inv = expf(-((float)(2 * f) / 32.f) * ln_theta);
            const float ang = (float)pos[t] * inv;
            rm[i * 2] = cosf(ang); rm[i * 2 + 1] = sinf(ang);
        }
        for (int i = c.bid * 256 + c.tid; i < T * 32; i += c.nblk * 256) {
            const int t = i >> 5, f = i & 31;
            const float inv = expf(-((float)(2 * f) / 64.f) * ln_theta);
            const float ang = (float)pos[t] * inv;
            rs[i * 2] = cosf(ang); rs[i * 2 + 1] = sinf(ang);
        }
    }
}

__device__ __forceinline__ void phase_inproj(const bf16_t* XBF, const bf16_t* W, bf16_t* PROJ, float* GATES, int gbase, const Ctx& c) {
    const int ntn = NPAD / 128;
    for (int i = 0;; ++i) {
        int mt, nt; bool valid; if (!tile_map2(i, c, T / 128, ntn, mt, nt, valid)) break;
        const bf16_t* a0 = XBF + (size_t)(mt * 128 + (c.tid >> 2)) * 1024;
        const bf16_t* b0 = W + (size_t)(nt * 128 + (c.tid >> 2)) * 1024;
        f32x4 acc[4][4];
        gemm_tile(a0, a0 + 64 * 1024, b0, b0 + 64 * 1024, 32, acc, c);
#pragma unroll
        for (int m = 0; m < 4; ++m) {
            const int rl = c.wr * 64 + m * 16 + c.fr, row = mt * 128 + rl;
#pragma unroll
            for (int n = 0; n < 4; ++n) {
                const int cl = c.wc * 64 + n * 16 + c.fq * 4, col = nt * 128 + cl;
                const f32x4 v = acc[m][n];
                tile_put(c, rl, cl, (u32x2){pk2(v[0], v[1]), pk2(v[2], v[3])});
                if (valid && col >= gbase && col < gbase + 8) *(f32x4*)(GATES + (size_t)row * 8 + (col - gbase)) = v;
            }
        }
        tile_flush<128>(c, PROJ + (size_t)mt * 128 * NPAD + nt * 128, NPAD, valid);
    }
}

constexpr int MLAUP_TILES = (T / 128) * 6 + (T / 128) * 8;
__device__ __forceinline__ void mla_up_tile(int u, const bf16_t* CQ, const bf16_t* WQB, const bf16_t* CKV, const bf16_t* WKVB,
                             const float* ROPEM, bf16_t* QF, bf16_t* KN, bf16_t* VV, const Ctx& c) {
    const int tq = (T / 128) * 6;
    const float qscale = 0.10206207261596577f * 1.4426950408889634f;
    {
        f32x4 acc[4][4];
        if (u < tq) {
            const int mt = u / 6, nt = u % 6;
            const bf16_t* a0 = CQ + (size_t)(mt * 128 + (c.tid >> 2)) * 256;
            const bf16_t* b0 = WQB + (size_t)(nt * 128 + (c.tid >> 2)) * 256;
            gemm_tile(a0, a0 + 64 * 256, b0, b0 + 64 * 256, 8, acc, c);
#pragma unroll
            for (int m = 0; m < 4; ++m) {
                const int row = mt * 128 + c.wr * 64 + m * 16 + c.fr;
#pragma unroll
                for (int np = 0; np < 2; ++np) {
                    const int cg = nt * 128 + c.wc * 64 + np * 32;
                    f32x4 v0 = acc[m][2 * np], v1 = acc[m][2 * np + 1];
                    if (((cg >> 5) % 3) == 2) {
#pragma unroll
                        for (int j = 0; j < 4; ++j) {
                            const int i = c.fq * 4 + j;
                            const float cs = ROPEM[((size_t)row * 16 + i) * 2], sn = ROPEM[((size_t)row * 16 + i) * 2 + 1];
                            const float x1 = v0[j], x2 = v1[j];
                            v0[j] = x1 * cs - x2 * sn; v1[j] = x2 * cs + x1 * sn;
                        }
                    }
                    v0 *= qscale; v1 *= qscale;
                    *(u32x2*)(QF + (size_t)row * 768 + cg + c.fq * 4) = (u32x2){pk2(v0[0], v0[1]), pk2(v0[2], v0[3])};
                    *(u32x2*)(QF + (size_t)row * 768 + cg + 16 + c.fq * 4) = (u32x2){pk2(v1[0], v1[1]), pk2(v1[2], v1[3])};
                }
            }
        } else {
            const int v = u - tq, mt = v / 8, nt = v % 8;
            const bf16_t* a0 = CKV + (size_t)(mt * 128 + (c.tid >> 2)) * 128;
            const bf16_t* b0 = WKVB + (size_t)(nt * 128 + (c.tid >> 2)) * 128;
            gemm_tile(a0, a0 + 64 * 128, b0, b0 + 64 * 128, 4, acc, c);
            bf16_t* dst = (c.wc == 0) ? KN : VV;
#pragma unroll
            for (int m = 0; m < 4; ++m) {
                const int row = mt * 128 + c.wr * 64 + m * 16 + c.fr;
#pragma unroll
                for (int n = 0; n < 4; ++n) {
                    const f32x4 x = acc[m][n];
                    *(u32x2*)(dst + (size_t)row * 512 + nt * 64 + n * 16 + c.fq * 4) = (u32x2){pk2(x[0], x[1]), pk2(x[2], x[3])};
                }
            }
        }
    }
}

__device__ __forceinline__ void phase_outproj(const bf16_t* MIXO, const bf16_t* W, const float* xres, float* YBUF, const Ctx& c) {
    for (int i = 0;; ++i) {
        int mt, nt; bool valid; if (!tile_map2(i, c, T / 128, 8, mt, nt, valid)) break;
        const bf16_t* a0 = MIXO + (size_t)(mt * 128 + (c.tid >> 2)) * 1024;
        const bf16_t* b0 = W + (size_t)(nt * 128 + (c.tid >> 2)) * 1024;
        f32x4 acc[4][4];
        gemm_tile(a0, a0 + 64 * 1024, b0, b0 + 64 * 1024, 32, acc, c);
#pragma unroll
        for (int m = 0; m < 4; ++m) {
            const int row = mt * 128 + c.wr * 64 + m * 16 + c.fr;
#pragma unroll
            for (int n = 0; n < 4; ++n) {
                const int col = nt * 128 + c.wc * 64 + n * 16 + c.fq * 4;
                const f32x4 xr = *(const f32x4*)(xres + (size_t)row * 1024 + col);
                if (valid) *(f32x4*)(YBUF + (size_t)row * 1024 + col) = xr * ALPHA + acc[m][n];
            }
        }
    }
}

__device__ __forceinline__ void phase_router(const bf16_t* XBF, const bf16_t* W, float* LOG, const Ctx& c) {
    for (int base = 0; base < T / 128; base += c.nblk) {
        const bool valid = (base + c.bid) < T / 128; const int mt = valid ? base + c.bid : 0;
        const bf16_t* a0 = XBF + (size_t)(mt * 128 + (c.tid >> 2)) * 1024;
        const bf16_t* b0 = W + (size_t)(c.tid >> 2) * 1024;
        f32x4 acc[4][4];
        gemm_tile(a0, a0 + 64 * 1024, b0, b0 + 64 * 1024, 32, acc, c);
        if (c.wc == 0 && valid) {
#pragma unroll
            for (int m = 0; m < 4; ++m) {
                const int row = mt * 128 + c.wr * 64 + m * 16 + c.fr;
#pragma unroll
                for (int n = 0; n < 4; ++n) *(f32x4*)(LOG + (size_t)row * 64 + n * 16 + c.fq * 4) = acc[m][n];
            }
        }
    }
}

__device__ __forceinline__ void build_block_table(const unsigned* CNT, int* bst, const Ctx& c) {
    __syncthreads();
    if (c.wid == 0) {
        const int cnt = (int)__hip_atomic_load(CNT + c.lane, __ATOMIC_RELAXED, __HIP_MEMORY_SCOPE_AGENT);
        const int nb = (cnt + RBR - 1) / RBR;
        int inc = nb;
#pragma unroll
        for (int o = 1; o < 64; o <<= 1) { const int x = shfl_up_(inc, o); if (c.lane >= o) inc += x; }
        bst[c.lane] = inc - nb; bst[66 + c.lane] = cnt;
        if (c.lane == 63) { bst[64] = inc; bst[65] = inc + T / RBR; bst[66 + 64] = T; }
    }
    __syncthreads();
}
__device__ __forceinline__ int find_expert(const int* bst, int rb, const Ctx& c) {
    return __popcll(__ballot(bst[1 + c.lane] <= rb));
}

__device__ __forceinline__ void phase_moe1(const bf16_t* XBF, const bf16_t* WGU, const unsigned* CNT, const int* LTOK, const float* LW, bf16_t* HBUF, const Ctx& c) {
    int* bst = (int*)(c.smem + 65536 + 64);
    build_block_table(CNT, bst, c);
    const int nsb = bst[65] * 2;
    for (int i = 0;; ++i) {
        int sbk, nt; bool valid; if (!tile_map2(i, c, nsb, 4, sbk, nt, valid)) break;
        const int rb = sbk >> 1, hb = sbk & 1;
        const int e = find_expert(bst, rb, c);
        const int lb = rb - bst[e], cnt = bst[66 + e];
        const int p0 = lb * RBR + hb * 128 + (c.tid >> 2), p1 = p0 + 64;
        const int t0 = (p0 < cnt) ? LTOK[(size_t)e * CAP + p0] : 0;
        const int t1 = (p1 < cnt) ? LTOK[(size_t)e * CAP + p1] : 0;
        const bf16_t* a0 = XBF + (size_t)t0 * 1024;
        const bf16_t* a1 = XBF + (size_t)t1 * 1024;
        const bf16_t* b0 = WGU + (size_t)e * WGU_ELEMS + (size_t)(nt * 128 + (c.tid >> 2)) * 1024;
        f32x4 acc[4][4];
        gemm_tile(a0, a1, b0, b0 + 64 * 1024, 32, acc, c);
#pragma unroll
        for (int m = 0; m < 4; ++m) {
            const int rl = c.wr * 64 + m * 16 + c.fr;
            const int pw = lb * RBR + hb * 128 + rl;
            const float wrow = (pw < cnt) ? LW[(size_t)e * CAP + pw] : 0.f;
#pragma unroll
            for (int n = 0; n < 2; ++n) {
                const f32x4 g = acc[m][n], up = acc[m][n + 2];
                float h[4];
#pragma unroll
                for (int j = 0; j < 4; ++j) h[j] = siluf_(g[j]) * up[j] * wrow;
                tile_put(c, rl, c.wc * 32 + n * 16 + c.fq * 4, (u32x2){pk2(h[0], h[1]), pk2(h[2], h[3])});
            }
        }
        tile_flush<64>(c, HBUF + ((size_t)rb * RBR + hb * 128) * 256 + nt * 64, 256, valid);
    }
}

__device__ __forceinline__ void phase_moe2(const bf16_t* HBUF, const bf16_t* WDN, const unsigned* CNT, bf16_t* Y, const Ctx& c) {
    int* bst = (int*)(c.smem + 65536 + 64);
    build_block_table(CNT, bst, c);
    const int nsb = bst[65] * 2;
    for (int i = 0;; ++i) {
        int sbk, nt; bool valid; if (!tile_map2(i, c, nsb, 8, sbk, nt, valid)) break;
        const int rb = sbk >> 1;
        const int e = find_expert(bst, rb, c);
        const bf16_t* a0 = HBUF + ((size_t)sbk * 128 + (c.tid >> 2)) * 256;
        const bf16_t* b0 = WDN + (size_t)e * WDN_ELEMS + (size_t)(nt * 128 + (c.tid >> 2)) * 256;
        f32x4 acc[4][4];
        gemm_tile(a0, a0 + 64 * 256, b0, b0 + 64 * 256, 8, acc, c);
#pragma unroll
        for (int m = 0; m < 4; ++m) {
            const int lr = c.wr * 64 + m * 16 + c.fr;
#pragma unroll
            for (int n = 0; n < 4; ++n) {
                const f32x4 v = acc[m][n];
                tile_put(c, lr, c.wc * 64 + n * 16 + c.fq * 4, (u32x2){pk2(v[0], v[1]), pk2(v[2], v[3])});
            }
        }
        tile_flush<128>(c, Y + (size_t)sbk * 128 * 1024 + nt * 128, 1024, valid);
    }
}

__device__ __forceinline__ float dppf(float v, int ctrl_sel) {
    int x = __builtin_bit_cast(int, v), r;
    if (ctrl_sel == 0) r = __builtin_amdgcn_update_dpp(0, x, 0xB1, 0xF, 0xF, true);
    else if (ctrl_sel == 1) r = __builtin_amdgcn_update_dpp(0, x, 0x4E, 0xF, 0xF, true);
    else if (ctrl_sel == 2) r = __builtin_amdgcn_update_dpp(0, x, 0x141, 0xF, 0xF, true);
    else r = __builtin_amdgcn_update_dpp(0, x, 0x140, 0xF, 0xF, true);
    return __builtin_bit_cast(float, r);
}
__device__ __forceinline__ float red16(float v) { v += dppf(v, 0); v += dppf(v, 1); v += dppf(v, 2); v += dppf(v, 3); return v; }

template <bool F32OUT>
__device__ __forceinline__ void ln_row_store(float (&v)[16], const float* g, const float* b, float* of32, bf16_t* obf, int lane) {
    float s = 0.f;
#pragma unroll
    for (int i = 0; i < 16; ++i) s += v[i];
    const float mean = wave_sum(s) * (1.f / 1024.f);
    float q = 0.f;
#pragma unroll
    for (int i = 0; i < 16; ++i) { v[i] -= mean; q += v[i] * v[i]; }
    const float rstd = rsqrtf(wave_sum(q) * (1.f / 1024.f) + 1e-5f);
#pragma unroll
    for (int hf = 0; hf < 2; ++hf) {
        const int col = hf * 512 + lane * 8;
        const f32x4 g0 = *(const f32x4*)(g + col), g1 = *(const f32x4*)(g + col + 4);
        const f32x4 b0 = *(const f32x4*)(b + col), b1 = *(const f32x4*)(b + col + 4);
        f32x4 y0, y1;
#pragma unroll
        for (int j = 0; j < 4; ++j) { y0[j] = v[hf * 8 + j] * rstd * g0[j] + b0[j]; y1[j] = v[hf * 8 + 4 + j] * rstd * g1[j] + b1[j]; }
        if constexpr (F32OUT) { *(f32x4*)(of32 + col) = y0; *(f32x4*)(of32 + col + 4) = y1; }
        *(u32x4*)(obf + col) = (u32x4){pk2(y0[0], y0[1]), pk2(y0[2], y0[3]), pk2(y1[0], y1[1]), pk2(y1[2], y1[3])};
    }
}

__device__ __forceinline__ void phase_ln1(const bf16_t* YBUF, const float* g, const float* b, bf16_t* XBF, const Ctx& c) {
    for (int t = c.bid * 4 + c.wid; t < T; t += c.nblk * 4) {
        float v[16];
#pragma unroll
        for (int hf = 0; hf < 2; ++hf) {
            const u32x4 r = *(const u32x4*)(YBUF + (size_t)t * 1024 + hf * 512 + c.lane * 8);
            float f[8]; unpack8(r, f);
#pragma unroll
            for (int j = 0; j < 8; ++j) v[hf * 8 + j] = f[j];
        }
        ln_row_store<false>(v, g, b, nullptr, XBF + (size_t)t * 1024, c.lane);
    }
}

template <bool LASTL>
__device__ __forceinline__ void phase_combine8(const unsigned char* Y, const int* ASG, const float* ASGW, const unsigned* CNT, const float* g, const float* b,
                                               float* XOUT, bf16_t* XBF, const Ctx& c) {
    int* bst = (int*)(c.smem + 65536 + 64);
    build_block_table(CNT, bst, c);
    const int lane = c.lane;
    for (int t = c.bid * 4 + c.wid; t < T; t += c.nblk * 4) {
        float v[16];
        {
            const u32x4 r0 = *(const u32x4*)(XBF + (size_t)t * 1024 + lane * 16), r1 = *(const u32x4*)(XBF + (size_t)t * 1024 + lane * 16 + 8);
            float f[8]; unpack8(r0, f);
#pragma unroll
            for (int j = 0; j < 8; ++j) v[j] = f[j] * ALPHA;
            unpack8(r1, f);
#pragma unroll
            for (int j = 0; j < 8; ++j) v[8 + j] = f[j] * ALPHA;
        }
        u32x4 yr[9]; float wk[9];
#pragma unroll
        for (int k = 0; k < 9; ++k) {
            size_t crow; wk[k] = 1.f / 16.f;
            if (k < 8) { const int asg = ASG[(size_t)t * 8 + k]; crow = (size_t)bst[asg >> 16] * RBR + (asg & 0xffff); wk[k] = ASGW[(size_t)t * 8 + k] * (1.f / 16.f); }
            else crow = (size_t)bst[64] * RBR + t;
            yr[k] = *(const u32x4*)(Y + crow * 1024 + lane * 16);
        }
#pragma unroll
        for (int k = 0; k < 9; ++k)
#pragma unroll
            for (int q = 0; q < 4; ++q) {
                const f32x2 lo = __builtin_amdgcn_cvt_pk_f32_fp8((int)yr[k][q], false), hi = __builtin_amdgcn_cvt_pk_f32_fp8((int)yr[k][q], true);
                v[q * 4 + 0] += lo[0] * wk[k]; v[q * 4 + 1] += lo[1] * wk[k]; v[q * 4 + 2] += hi[0] * wk[k]; v[q * 4 + 3] += hi[1] * wk[k];
            }
        float s = 0.f;
#pragma unroll
        for (int i = 0; i < 16; ++i) s += v[i];
        const float mean = wave_sum(s) * (1.f / 1024.f);
        float q2 = 0.f;
#pragma unroll
        for (int i = 0; i < 16; ++i) { v[i] -= mean; q2 += v[i] * v[i]; }
        const float rstd = rsqrtf(wave_sum(q2) * (1.f / 1024.f) + 1e-5f);
        float y[16];
#pragma unroll
        for (int q = 0; q < 4; ++q) {
            const f32x4 gg = *(const f32x4*)(g + lane * 16 + q * 4), bb = *(const f32x4*)(b + lane * 16 + q * 4);
#pragma unroll
            for (int j = 0; j < 4; ++j) y[q * 4 + j] = v[q * 4 + j] * rstd * gg[j] + bb[j];
            if constexpr (LASTL) *(f32x4*)(XOUT + (size_t)t * 1024 + lane * 16 + q * 4) = (f32x4){y[q * 4], y[q * 4 + 1], y[q * 4 + 2], y[q * 4 + 3]};
        }
        *(u32x4*)(XBF + (size_t)t * 1024 + lane * 16) = (u32x4){pk2(y[0], y[1]), pk2(y[2], y[3]), pk2(y[4], y[5]), pk2(y[6], y[7])};
        *(u32x4*)(XBF + (size_t)t * 1024 + lane * 16 + 8) = (u32x4){pk2(y[8], y[9]), pk2(y[10], y[11]), pk2(y[12], y[13]), pk2(y[14], y[15])};
    }
}

template <bool LASTL>
__device__ __forceinline__ void phase_combine(const bf16_t* Y, const int* ASG, const float* ASGW, const unsigned* CNT, const float* g, const float* b,
                              float* XOUT, bf16_t* XBF, const Ctx& c) {
    int* bst = (int*)(c.smem + 65536 + 64);
    build_block_table(CNT, bst, c);
    for (int t = c.bid * 4 + c.wid; t < T; t += c.nblk * 4) {
        float v[16];
#pragma unroll
        for (int hf = 0; hf < 2; ++hf) {
            const u32x4 r = *(const u32x4*)(XBF + (size_t)t * 1024 + hf * 512 + c.lane * 8);
            float f[8]; unpack8(r, f);
#pragma unroll
            for (int j = 0; j < 8; ++j) v[hf * 8 + j] = f[j] * ALPHA;
        }
#pragma unroll
        for (int k = 0; k < 9; ++k) {
            size_t crow; float wk = 1.f;
            if (k < 8) { const int asg = ASG[(size_t)t * 8 + k]; crow = (size_t)bst[asg >> 16] * RBR + (asg & 0xffff); wk = ASGW[(size_t)t * 8 + k]; }
            else crow = (size_t)bst[64] * RBR + t;
#pragma unroll
            for (int hf = 0; hf < 2; ++hf) {
                const u32x4 r = *(const u32x4*)(Y + crow * 1024 + hf * 512 + c.lane * 8);
                float f[8]; unpack8(r, f);
#pragma unroll
                for (int j = 0; j < 8; ++j) v[hf * 8 + j] += f[j] * wk;
            }
        }
        ln_row_store<LASTL>(v, g, b, XOUT + (size_t)t * 1024, XBF + (size_t)t * 1024, c.lane);
    }
}

__device__ __forceinline__ void phase_route(const float* LOG, const float* rb, unsigned* CNT, int* LTOK, float* LW, int* ASG, float* ASGW, const Ctx& c) {
    int* lcnt = (int*)c.smem;
    int* lbase = lcnt + 64;
    int* sel_e = lbase + 64;
    int* sel_p = sel_e + 256;
    float* sel_w = (float*)(sel_p + 256);
    const float rbias = rb[c.lane];
    for (int base = 0; base < T / 32; base += c.nblk) {
        const int ch = base + c.bid; const bool valid = ch < T / 32;
        __syncthreads();
        if (c.tid < 64) lcnt[c.tid] = 0;
        __syncthreads();
        if (valid) for (int tl = c.wid; tl < 32; tl += 4) {
            const int t = ch * 32 + tl;
            const float lg = LOG[(size_t)t * 64 + c.lane];
            const float sc = 1.f / (1.f + expf(-lg));
            const float v = sc + rbias;
            float m1 = v;
            m1 = fmaxf(m1, shfl_xor_(m1, 1)); m1 = fmaxf(m1, shfl_xor_(m1, 2)); m1 = fmaxf(m1, shfl_xor_(m1, 4));
            int cand = (v == m1) ? c.lane : 999;
            cand = min(cand, shfl_xor_(cand, 1)); cand = min(cand, shfl_xor_(cand, 2)); cand = min(cand, shfl_xor_(cand, 4));
            float m2 = (c.lane == cand) ? -INFINITY : v;
            m2 = fmaxf(m2, shfl_xor_(m2, 1)); m2 = fmaxf(m2, shfl_xor_(m2, 2)); m2 = fmaxf(m2, shfl_xor_(m2, 4));
            const float gs = m1 + m2;
            const int g = c.lane >> 3;
            int grank = 0;
#pragma unroll
            for (int gg = 0; gg < 8; ++gg) { const float o = shfl_c_(gs, gg * 8); grank += ((o > gs) || (o == gs && gg < g)) ? 1 : 0; }
            const bool gsel = grank < 4;
            const float mv = gsel ? v : -INFINITY;
            int rank = 0;
#pragma unroll 8
            for (int jj = 0; jj < 64; ++jj) { const float o = shfl_c_(mv, jj); rank += ((o > mv) || (o == mv && jj < c.lane)) ? 1 : 0; }
            const bool sel = gsel && rank < 8;
            const float ssum = wave_sum(sel ? sc : 0.f);
            const float w = sc / ssum * 2.5f;
            const unsigned long long bal = __ballot(sel);
            const int slot = __popcll(bal & ((1ull << c.lane) - 1ull));
            if (sel) {
                const int p = atomicAdd(&lcnt[c.lane], 1);
                sel_e[tl * 8 + slot] = c.lane; sel_p[tl * 8 + slot] = p; sel_w[tl * 8 + slot] = w;
            }
        }
        __syncthreads();
        if (valid && c.tid < 64) { const int n = lcnt[c.tid]; lbase[c.tid] = n ? (int)atomicAdd(CNT + c.tid, (unsigned)n) : 0; }
        __syncthreads();
        if (valid) {
            const int tl = c.tid >> 3, t = ch * 32 + tl;
            const int e = sel_e[c.tid], pos = lbase[e] + sel_p[c.tid];
            LTOK[(size_t)e * CAP + pos] = t; LW[(size_t)e * CAP + pos] = sel_w[c.tid];
            ASG[(size_t)t * 8 + (c.tid & 7)] = (e << 16) | pos; ASGW[(size_t)t * 8 + (c.tid & 7)] = sel_w[c.tid];
            if (c.tid < 32) { const int ts = ch * 32 + c.tid; LTOK[(size_t)64 * CAP + ts] = ts; LW[(size_t)64 * CAP + ts] = 1.f; }
        }
    }
}

__device__ __forceinline__ void phase_lnroute(const bf16_t* YBUF, const float* g, const float* b, bf16_t* XBF, const bf16_t* W, const float* rb,
                                              unsigned* CNT, int* LTOK, float* LW, int* ASG, float* ASGW, const Ctx& c) {
    unsigned char* xa = c.smem;
    int* lcnt = (int*)(c.smem + 65536 + 64);
    int* lbase = lcnt + 64;
    float* lgt = (float*)c.smem;
    int* sel_e = (int*)(c.smem + 8192);
    int* sel_p = sel_e + 256;
    float* sel_w = (float*)(sel_p + 256);
    const int lane = c.lane;
    const float rbias = rb[lane];
    for (int base = 0; base < T / 32; base += c.nblk) {
        const int ch = base + c.bid; const bool valid = ch < T / 32;
        __syncthreads();
        if (c.tid < 64) lcnt[c.tid] = 0;
        u32x4 raw[8][2];
#pragma unroll
        for (int i = 0; i < 8; ++i)
#pragma unroll
            for (int hf = 0; hf < 2; ++hf) raw[i][hf] = valid ? *(const u32x4*)(YBUF + (size_t)(ch * 32 + c.wid + 4 * i) * 1024 + hf * 512 + lane * 8) : (u32x4){0u, 0u, 0u, 0u};
        if (valid)
#pragma unroll
        for (int i = 0; i < 8; ++i) {
            const int tl = c.wid + 4 * i;
            const int t = ch * 32 + tl;
            float v[16];
#pragma unroll
            for (int hf = 0; hf < 2; ++hf) {
                float f[8]; unpack8(raw[i][hf], f);
#pragma unroll
                for (int j = 0; j < 8; ++j) v[hf * 8 + j] = f[j];
            }
            float s = 0.f;
#pragma unroll
            for (int i = 0; i < 16; ++i) s += v[i];
            const float mean = wave_sum(s) * (1.f / 1024.f);
            float q = 0.f;
#pragma unroll
            for (int i = 0; i < 16; ++i) { v[i] -= mean; q += v[i] * v[i]; }
            const float rstd = rsqrtf(wave_sum(q) * (1.f / 1024.f) + 1e-5f);
#pragma unroll
            for (int hf = 0; hf < 2; ++hf) {
                const int col = hf * 512 + lane * 8;
                const f32x4 g0 = *(const f32x4*)(g + col), g1 = *(const f32x4*)(g + col + 4);
                const f32x4 b0 = *(const f32x4*)(b + col), b1 = *(const f32x4*)(b + col + 4);
                f32x4 y0, y1;
#pragma unroll
                for (int j = 0; j < 4; ++j) { y0[j] = v[hf * 8 + j] * rstd * g0[j] + b0[j]; y1[j] = v[hf * 8 + 4 + j] * rstd * g1[j] + b1[j]; }
                const u32x4 pk = (u32x4){pk2(y0[0], y0[1]), pk2(y0[2], y0[3]), pk2(y1[0], y1[1]), pk2(y1[2], y1[3])};
                *(u32x4*)(XBF + (size_t)t * 1024 + col) = pk;
                *(u32x4*)(xa + tl * 2048 + (((hf * 64 + lane) ^ (tl & 15)) * 16)) = pk;
            }
        }
        __syncthreads();
        f32x4 acc0 = (f32x4){0.f, 0.f, 0.f, 0.f}, acc1 = (f32x4){0.f, 0.f, 0.f, 0.f};
        {
            const int r = lane & 15, kq = lane >> 4;
            const bf16_t* wrow = W + (size_t)(c.wid * 16 + r) * 1024 + kq * 8;
#pragma unroll 1
            for (int kb = 0; kb < 32; kb += 8) {
                bf16x8 bfr[8];
#pragma unroll
                for (int j = 0; j < 8; ++j) bfr[j] = *(const bf16x8*)(wrow + (kb + j) * 32);
#pragma unroll
                for (int j = 0; j < 8; ++j) {
                    const int chunk = ((kb + j) * 4 + kq) ^ r;
                    const bf16x8 a0 = *(const bf16x8*)(xa + r * 2048 + chunk * 16), a1 = *(const bf16x8*)(xa + (16 + r) * 2048 + chunk * 16);
                    acc0 = __builtin_amdgcn_mfma_f32_16x16x32_bf16(a0, bfr[j], acc0, 0, 0, 0);
                    acc1 = __builtin_amdgcn_mfma_f32_16x16x32_bf16(a1, bfr[j], acc1, 0, 0, 0);
                }
            }
        }
        __syncthreads();
        {
            const int e = c.wid * 16 + (lane & 15), r0 = 4 * (lane >> 4);
#pragma unroll
            for (int j = 0; j < 4; ++j) { lgt[(r0 + j) * 64 + e] = acc0[j]; lgt[(16 + r0 + j) * 64 + e] = acc1[j]; }
        }
        __syncthreads();
        if (valid) for (int tl = c.wid; tl < 32; tl += 4) {
            const float lg = lgt[tl * 64 + lane];
            const float sc = 1.f / (1.f + expf(-lg));
            const float v = sc + rbias;
            float m1 = v;
            m1 = fmaxf(m1, shfl_xor_(m1, 1)); m1 = fmaxf(m1, shfl_xor_(m1, 2)); m1 = fmaxf(m1, shfl_xor_(m1, 4));
            int cand = (v == m1) ? lane : 999;
            cand = min(cand, shfl_xor_(cand, 1)); cand = min(cand, shfl_xor_(cand, 2)); cand = min(cand, shfl_xor_(cand, 4));
            float m2 = (lane == cand) ? -INFINITY : v;
            m2 = fmaxf(m2, shfl_xor_(m2, 1)); m2 = fmaxf(m2, shfl_xor_(m2, 2)); m2 = fmaxf(m2, shfl_xor_(m2, 4));
            const float gs = m1 + m2;
            const int gi = lane >> 3;
            int grank = 0;
#pragma unroll
            for (int gg = 0; gg < 8; ++gg) { const float o = shfl_c_(gs, gg * 8); grank += ((o > gs) || (o == gs && gg < gi)) ? 1 : 0; }
            const bool gsel = grank < 4;
            const float mv = gsel ? v : -INFINITY;
            int rank = 0;
#pragma unroll 8
            for (int jj = 0; jj < 64; ++jj) { const float o = shfl_c_(mv, jj); rank += ((o > mv) || (o == mv && jj < lane)) ? 1 : 0; }
            const bool sel = gsel && rank < 8;
            const float ssum = wave_sum(sel ? sc : 0.f);
            const float w = sc / ssum * 2.5f;
            const unsigned long long bal = __ballot(sel);
            const int slot = __popcll(bal & ((1ull << lane) - 1ull));
            if (sel) {
                const int p = atomicAdd(&lcnt[lane], 1);
                sel_e[tl * 8 + slot] = lane; sel_p[tl * 8 + slot] = p; sel_w[tl * 8 + slot] = w;
            }
        }
        __syncthreads();
        if (valid && c.tid < 64) { const int n = lcnt[c.tid]; lbase[c.tid] = n ? (int)atomicAdd(CNT + c.tid, (unsigned)n) : 0; }
        __syncthreads();
        if (valid) {
            const int tl = c.tid >> 3, t = ch * 32 + tl;
            const int e = sel_e[c.tid], pos = lbase[e] + sel_p[c.tid];
            LTOK[(size_t)e * CAP + pos] = t; LW[(size_t)e * CAP + pos] = sel_w[c.tid];
            ASG[(size_t)t * 8 + (c.tid & 7)] = (e << 16) | pos; ASGW[(size_t)t * 8 + (c.tid & 7)] = sel_w[c.tid];
            if (c.tid < 32) { const int ts = ch * 32 + c.tid; LTOK[(size_t)64 * CAP + ts] = ts; LW[(size_t)64 * CAP + ts] = 1.f; }
        }
    }
}

__device__ __forceinline__ void phase_prep_even(const bf16_t* PROJ, const float* GATES, const float* qn, const float* kvn, const float* cw,
                                const float* a_log, const float* dt_bias, const float* ROPEM,
                                bf16_t* CQ, bf16_t* CKV, bf16_t* KROPE, bf16_t* GQ, bf16_t* GK, bf16_t* GV, float* BETA, float* GLOG, const Ctx& c) {
    const int lane = c.lane;
    float* cwL = (float*)c.smem;
    __syncthreads();
    for (int i = c.tid; i < 4 * 1536 / 4; i += 256) *(f32x4*)(cwL + i * 4) = *(const f32x4*)(cw + i * 4);
    __syncthreads();
    for (int tb = (c.bid * 4 + c.wid) * 8; tb < T; tb += c.nblk * 4 * 8) {
        const int s0 = tb & (SEQ - 1);
        u32x4 xr[3][4];
#pragma unroll
        for (int arr = 0; arr < 3; ++arr)
#pragma unroll
            for (int w = 0; w < 3; ++w)
                xr[arr][w] = (s0 - 3 + w >= 0) ? *(const u32x4*)(PROJ + (size_t)(tb - 3 + w) * NPAD + 416 + arr * 512 + lane * 8) : (u32x4){0u, 0u, 0u, 0u};
        u32x4 nx[3]; u32x2 ncq; unsigned nckv; float nk1 = 0.f, nk2 = 0.f, ncs = 0.f, nsn = 0.f, ngate = 0.f;
#define PE_LOAD(t_) do { const bf16_t* pr_ = PROJ + (size_t)(t_) * NPAD; \
            _Pragma("unroll") for (int arr = 0; arr < 3; ++arr) nx[arr] = *(const u32x4*)(pr_ + 416 + arr * 512 + lane * 8); \
            ncq = *(const u32x2*)(pr_ + lane * 4); nckv = *(const unsigned*)(pr_ + 256 + lane * 2); \
            if (lane < 16) { nk1 = bf2f(pr_[384 + lane]); nk2 = bf2f(pr_[400 + lane]); ncs = ROPEM[((size_t)(t_) * 16 + lane) * 2]; nsn = ROPEM[((size_t)(t_) * 16 + lane) * 2 + 1]; } \
            if (lane < 8) ngate = GATES[(size_t)(t_) * 8 + lane]; } while (0)
        PE_LOAD(tb);
#pragma unroll
        for (int k = 0; k < 8; ++k) {
            const int t = tb + k;
#pragma unroll
            for (int arr = 0; arr < 3; ++arr) xr[arr][3] = nx[arr];
            const u32x2 r = ncq; const unsigned rkv = nckv; const float x1 = nk1, x2 = nk2, cs = ncs, sn = nsn, gate = ngate;
            if (k < 7) PE_LOAD(t + 1);
            {
                float v[4] = {bflo(r.x), bfhi(r.x), bflo(r.y), bfhi(r.y)};
                const float ss = wave_sum(v[0] * v[0] + v[1] * v[1] + v[2] * v[2] + v[3] * v[3]);
                const float rr = rsqrtf(ss * (1.f / 256.f) + 1e-6f);
                const f32x4 gq = *(const f32x4*)(qn + lane * 4);
                *(u32x2*)(CQ + (size_t)t * 256 + lane * 4) = (u32x2){pk2(v[0] * rr * gq[0], v[1] * rr * gq[1]), pk2(v[2] * rr * gq[2], v[3] * rr * gq[3])};
            }
            {
                const float v0 = bflo(rkv), v1 = bfhi(rkv);
                const float ss = wave_sum(v0 * v0 + v1 * v1);
                const float rr = rsqrtf(ss * (1.f / 128.f) + 1e-6f);
                *(unsigned*)(CKV + (size_t)t * 128 + lane * 2) = pk2(v0 * rr * kvn[lane * 2], v1 * rr * kvn[lane * 2 + 1]);
            }
            if (lane < 16) {
                KROPE[(size_t)t * 32 + lane] = (bf16_t)f2bf(x1 * cs - x2 * sn);
                KROPE[(size_t)t * 32 + 16 + lane] = (bf16_t)f2bf(x2 * cs + x1 * sn);
            }
#pragma unroll
            for (int arr = 0; arr < 3; ++arr) {
                float y[8];
#pragma unroll
                for (int j = 0; j < 8; ++j) y[j] = 0.f;
#pragma unroll
                for (int w = 0; w < 4; ++w) {
                    float f[8]; unpack8(xr[arr][w], f);
                    const f32x4 c0 = *(const f32x4*)(cwL + w * 1536 + arr * 512 + lane * 8), c1 = *(const f32x4*)(cwL + w * 1536 + arr * 512 + lane * 8 + 4);
#pragma unroll
                    for (int j = 0; j < 4; ++j) { y[j] += c0[j] * f[j]; y[4 + j] += c1[j] * f[4 + j]; }
                }
                float ss = 0.f;
#pragma unroll
                for (int j = 0; j < 8; ++j) { y[j] = siluf_(y[j]); ss += y[j] * y[j]; }
                if (arr < 2) {
                    float rr = rsqrtf(red16(ss) + 1e-6f);
                    if (arr == 0) rr *= 0.08838834764831845f;
#pragma unroll
                    for (int j = 0; j < 8; ++j) y[j] *= rr;
                }
                bf16_t* dst = (arr == 0) ? GQ : (arr == 1) ? GK : GV;
                *(u32x4*)(dst + (size_t)t * 512 + lane * 8) = (u32x4){pk2(y[0], y[1]), pk2(y[2], y[3]), pk2(y[4], y[5]), pk2(y[6], y[7])};
                xr[arr][0] = xr[arr][1]; xr[arr][1] = xr[arr][2]; xr[arr][2] = xr[arr][3];
            }
            if (lane < 4) BETA[(size_t)t * 4 + lane] = sigmoidf_(gate);
            else if (lane < 8) { const int h = lane - 4; GLOG[(size_t)t * 4 + h] = -expf(a_log[h]) * softplusf_(gate + dt_bias[h]); }
        }
#undef PE_LOAD
    }
}

__device__ __forceinline__ void phase_prep_odd(const bf16_t* PROJ, const float* ROPES, bf16_t* SQ, bf16_t* SK, const Ctx& c) {
    const int lane = c.lane;
    const int hh = lane >> 2, j = lane & 3;
    const bool isq = lane < 32, act = lane < 40;
    const int scol = isq ? 1544 + hh * 64 + j * 8 : 2056 + (hh - 8) * 64 + j * 8;
    const float sc = isq ? 0.18033688011112042f : 1.f;
    for (int t = c.bid * 4 + c.wid; t < T; t += c.nblk * 4) {
        if (act) {
            const bf16_t* pr = PROJ + (size_t)t * NPAD + scol;
            const u32x4 r1 = *(const u32x4*)pr, r2 = *(const u32x4*)(pr + 32);
            const float* rp = ROPES + ((size_t)t * 32 + j * 8) * 2;
            const f32x4 t0 = *(const f32x4*)rp, t1 = *(const f32x4*)(rp + 4), t2 = *(const f32x4*)(rp + 8), t3 = *(const f32x4*)(rp + 12);
            const float cs[8] = {t0[0], t0[2], t1[0], t1[2], t2[0], t2[2], t3[0], t3[2]}, sn[8] = {t0[1], t0[3], t1[1], t1[3], t2[1], t2[3], t3[1], t3[3]};
            float x1[8], x2[8], o1[8], o2[8]; unpack8(r1, x1); unpack8(r2, x2);
#pragma unroll
            for (int k = 0; k < 8; ++k) { o1[k] = (x1[k] * cs[k] - x2[k] * sn[k]) * sc; o2[k] = (x2[k] * cs[k] + x1[k] * sn[k]) * sc; }
            bf16_t* d = isq ? SQ + (size_t)t * 512 + hh * 64 + j * 8 : SK + (size_t)t * 128 + (hh - 8) * 64 + j * 8;
            *(u32x4*)d = (u32x4){pk2(o1[0], o1[1]), pk2(o1[2], o1[3]), pk2(o1[4], o1[5]), pk2(o1[6], o1[7])};
            *(u32x4*)(d + 32) = (u32x4){pk2(o2[0], o2[1]), pk2(o2[2], o2[3]), pk2(o2[4], o2[5]), pk2(o2[6], o2[7])};
        }
    }
}

__device__ __forceinline__ int next_unit(unsigned* ctr, const Ctx& c) {
    volatile int* su = (volatile int*)(c.smem0 + LDS_BLK + 16);
    __syncthreads();
    if (c.tid0 == 0) *su = (int)atomicAdd(ctr, 1u);
    __syncthreads();
    return *su * 2 + c.half;
}

typedef float f32x16 __attribute__((ext_vector_type(16)));
typedef short s16x4 __attribute__((ext_vector_type(4)));
#define MFMA32(a, b, c) __builtin_amdgcn_mfma_f32_32x32x16_bf16((a), (b), (c), 0, 0, 0)
template <int S_> __device__ __forceinline__ bf16x8 pack_step(const f32x16& x) {
    u32x4 p;
    asm volatile("v_cvt_pk_bf16_f32 %0, %4, %5\n\tv_cvt_pk_bf16_f32 %1, %6, %7\n\tv_cvt_pk_bf16_f32 %2, %8, %9\n\tv_cvt_pk_bf16_f32 %3, %10, %11\n\ts_nop 1"
                 : "=&v"(p[0]), "=&v"(p[1]), "=&v"(p[2]), "=&v"(p[3])
                 : "v"(x[8 * S_]), "v"(x[8 * S_ + 1]), "v"(x[8 * S_ + 2]), "v"(x[8 * S_ + 3]), "v"(x[8 * S_ + 4]), "v"(x[8 * S_ + 5]), "v"(x[8 * S_ + 6]), "v"(x[8 * S_ + 7]));
    return __builtin_bit_cast(bf16x8, p);
}
template <int S_> __device__ __forceinline__ bf16x8 pack_step_m(const f32x16& x) {
    u32x4 p;
    asm volatile("s_nop 15\n\tv_cvt_pk_bf16_f32 %0, %4, %5\n\tv_cvt_pk_bf16_f32 %1, %6, %7\n\tv_cvt_pk_bf16_f32 %2, %8, %9\n\tv_cvt_pk_bf16_f32 %3, %10, %11\n\ts_nop 1"
                 : "=&v"(p[0]), "=&v"(p[1]), "=&v"(p[2]), "=&v"(p[3])
                 : "v"(x[8 * S_]), "v"(x[8 * S_ + 1]), "v"(x[8 * S_ + 2]), "v"(x[8 * S_ + 3]), "v"(x[8 * S_ + 4]), "v"(x[8 * S_ + 5]), "v"(x[8 * S_ + 6]), "v"(x[8 * S_ + 7]));
    return __builtin_bit_cast(bf16x8, p);
}
constexpr int ATT_VB = 64 * 128;

template <int NKS, bool WIN>
__device__ __forceinline__ void attn_unit(const bf16_t* Qp, int q_ld, const bf16_t* K1, int k1_ld, const bf16_t* K2, int k2_ld, const bf16_t* Vp, int v_ld,
                          bf16_t* Op, int o_ld, int Q0, float sink_l2, const Ctx& c) {
    constexpr int KB = NKS * 2 * 1024, BUF = KB + ATT_VB;
    const int lane = c.lane, r = lane & 31, h = lane >> 5;
    const int wid = __builtin_amdgcn_readfirstlane(c.wid);
    const int q0w = Q0 + wid * 32;
    unsigned char* smem = c.smem;
    bf16x8 qf[NKS];
#pragma unroll
    for (int ks = 0; ks < NKS; ++ks) qf[ks] = *(const bf16x8*)(Qp + (size_t)(q0w + r) * q_ld + ks * 16 + h * 8);
    f32x16 o0, o1;
#pragma unroll
    for (int i = 0; i < 16; ++i) { o0[i] = 0.f; o1[i] = 0.f; }
    float m = WIN ? sink_l2 : -1e30f, l = (WIN && h == 0) ? 1.f : 0.f;
    const int kt_lo = WIN ? ((Q0 >> 6) - 2 < 0 ? 0 : (Q0 >> 6) - 2) : 0, kt_hi = (Q0 >> 6) + 1;
#define ATT_STAGE(kt_, buf_) do { unsigned char* bp = smem + (buf_) * BUF; const size_t kb = (size_t)(kt_) * 64; \
        _Pragma("unroll") for (int i = 0; i < (NKS * 2) / 4; ++i) { const int ch = wid + 4 * i; \
            const bf16_t* sp = (ch < 8) ? (K1 + (kb + lane) * k1_ld + ch * 8) : (K2 + (kb + lane) * k2_ld + (ch - 8) * 8); \
            glds16(sp, bp + ch * 1024 + lane * 16); } \
        _Pragma("unroll") for (int i = 0; i < 2; ++i) { const int j = wid + 4 * i; \
            glds16(Vp + (kb + 8 * j + (lane >> 3)) * v_ld + (lane & 7) * 8, bp + KB + j * 1024 + lane * 16); } } while (0)
    ATT_STAGE(kt_lo, 0);
    const int i16 = lane & 15;
    const unsigned vlane = (unsigned)((4 * h + (i16 >> 2)) * 128 + 32 * ((lane >> 4) & 1) + 8 * (i16 & 3));
    for (int kt = kt_lo; kt <= kt_hi; ++kt) {
        const int cur = (kt - kt_lo) & 1;
        asm volatile("s_waitcnt vmcnt(0)" ::: "memory");
        __syncthreads();
        if (kt < kt_hi) ATT_STAGE(kt + 1, cur ^ 1);
        const int k0 = kt * 64;
        const bool active = (k0 <= q0w + 31) && (!WIN || (k0 + 63 > q0w - 128));
        if (active) {
            const unsigned char* Kt = smem + cur * BUF;
            f32x16 x0, x1;
#pragma unroll
            for (int i = 0; i < 16; ++i) { x0[i] = 0.f; x1[i] = 0.f; }
#pragma unroll
            for (int ks = 0; ks < NKS; ++ks) {
                const bf16x8 kf0 = *(const bf16x8*)(Kt + (ks * 2 + h) * 1024 + r * 16);
                const bf16x8 kf1 = *(const bf16x8*)(Kt + (ks * 2 + h) * 1024 + (32 + r) * 16);
                x0 = MFMA32(kf0, qf[ks], x0); x1 = MFMA32(kf1, qf[ks], x1);
            }
            const bool need_mask = (k0 + 63 > q0w) || (WIN && (k0 <= q0w + 31 - 128));
            if (need_mask) {
                const int q = q0w + r;
#pragma unroll
                for (int i = 0; i < 16; ++i) {
                    const int key = k0 + (i & 3) + 8 * (i >> 2) + 4 * h;
                    const bool v0 = (key <= q) && (!WIN || key > q - 128);
                    const bool v1 = (key + 32 <= q) && (!WIN || key + 32 > q - 128);
                    x0[i] = v0 ? x0[i] : -INFINITY; x1[i] = v1 ? x1[i] : -INFINITY;
                }
            }
            float mx = fmaxf(x0[0], x1[0]);
#pragma unroll
            for (int i = 1; i < 16; ++i) mx = fmaxf(mx, fmaxf(x0[i], x1[i]));
            mx = fmaxf(mx, shfl_xor_(mx, 32));
            const float mn = fmaxf(m, mx);
            const float alpha = __builtin_amdgcn_exp2f(m - mn);
            m = mn;
            float ps = 0.f;
#pragma unroll
            for (int i = 0; i < 16; ++i) { x0[i] = __builtin_amdgcn_exp2f(x0[i] - mn); x1[i] = __builtin_amdgcn_exp2f(x1[i] - mn); ps += x0[i] + x1[i]; }
            l = l * alpha + ps;
            o0 *= alpha; o1 *= alpha;
            const unsigned vbase = (unsigned)(size_t)(smem + cur * BUF + KB) + vlane;
#pragma unroll
            for (int t = 0; t < 2; ++t) {
                s16x4 l00, h00, l01, h01, l10, h10, l11, h11;
                const unsigned va = vbase + t * 4096;
                asm volatile("ds_read_b64_tr_b16 %0, %8\n\t"
                             "ds_read_b64_tr_b16 %1, %8 offset:1024\n\t"
                             "ds_read_b64_tr_b16 %2, %8 offset:64\n\t"
                             "ds_read_b64_tr_b16 %3, %8 offset:1088\n\t"
                             "ds_read_b64_tr_b16 %4, %8 offset:2048\n\t"
                             "ds_read_b64_tr_b16 %5, %8 offset:3072\n\t"
                             "ds_read_b64_tr_b16 %6, %8 offset:2112\n\t"
                             "ds_read_b64_tr_b16 %7, %8 offset:3136\n\t"
                             "s_waitcnt lgkmcnt(0)"
                             : "=&v"(l00), "=&v"(h00), "=&v"(l01), "=&v"(h01), "=&v"(l10), "=&v"(h10), "=&v"(l11), "=&v"(h11) : "v"(va) : "memory");
                const bf16x8 v00 = __builtin_shufflevector(l00, h00, 0, 1, 2, 3, 4, 5, 6, 7), v01 = __builtin_shufflevector(l01, h01, 0, 1, 2, 3, 4, 5, 6, 7);
                const bf16x8 v10 = __builtin_shufflevector(l10, h10, 0, 1, 2, 3, 4, 5, 6, 7), v11 = __builtin_shufflevector(l11, h11, 0, 1, 2, 3, 4, 5, 6, 7);
                const bf16x8 pb0 = (t == 0) ? pack_step<0>(x0) : pack_step<0>(x1);
                const bf16x8 pb1 = (t == 0) ? pack_step<1>(x0) : pack_step<1>(x1);
                o0 = MFMA32(v00, pb0, o0); o1 = MFMA32(v01, pb0, o1);
                o0 = MFMA32(v10, pb1, o0); o1 = MFMA32(v11, pb1, o1);
            }
        }
    }
#undef ATT_STAGE
    l += shfl_xor_(l, 32);
    const float inv = 1.f / l;
    bf16_t* orow = Op + (size_t)(q0w + r) * o_ld + 4 * h;
#pragma unroll
    for (int g = 0; g < 4; ++g) {
        *(u32x2*)(orow + 8 * g) = (u32x2){pk2(o0[4 * g] * inv, o0[4 * g + 1] * inv), pk2(o0[4 * g + 2] * inv, o0[4 * g + 3] * inv)};
        *(u32x2*)(orow + 32 + 8 * g) = (u32x2){pk2(o1[4 * g] * inv, o1[4 * g + 1] * inv), pk2(o1[4 * g + 2] * inv, o1[4 * g + 3] * inv)};
    }
}

constexpr size_t MLC_DC = 0, MLC_CS = 33554432, MLC_DN = MLC_CS + 16777216, MLC_NS = MLC_DN + 262144, MLC_ML = MLC_NS + 262144, MLC_BE = MLC_ML + 4096, MLC_MS = MLC_BE + 4096;

__device__ __forceinline__ float scan_add64(float v, int lane) {
#pragma unroll
    for (int o = 1; o < 64; o <<= 1) { const float x = shfl_up_(v, o); if (lane >= o) v += x; }
    return v;
}
__device__ __forceinline__ float scan_max64(float v, int lane) {
#pragma unroll
    for (int o = 1; o < 64; o <<= 1) { const float x = shfl_up_(v, o); if (lane >= o) v = fmaxf(v, x); }
    return v;
}
__device__ __forceinline__ float wave_max(float v) {
#pragma unroll
    for (int o = 32; o > 0; o >>= 1) v = fmaxf(v, shfl_xor_(v, o));
    return v;
}

__device__ __forceinline__ void mlc_passA(int u, const bf16_t* PROJ, const float* GATES, const float* b_i, const float* b_f, unsigned char* YB, const Ctx& c) {
    const int bh = u >> 5, b = bh >> 2, h = bh & 3;
    const size_t t0 = (size_t)b * SEQ + (u & 31) * 64;
    unsigned char* smem = c.smem;
    float* saL = (float*)(smem + 24576);
    const int lane = c.lane, wid = __builtin_amdgcn_readfirstlane(c.wid);
#pragma unroll
    for (int i = 0; i < 4; ++i) { const int j = wid * 4 + i;
        glds16(PROJ + (t0 + 4 * j + (lane >> 4)) * NPAD + 512 + h * 128 + (lane & 15) * 8, smem + 8192 + j * 1024 + lane * 16); }
    if (wid == 0) {
        const float ip = GATES[(t0 + lane) * 8 + h] + b_i[h], lf = -softplusf_(-(GATES[(t0 + lane) * 8 + 4 + h] + b_f[h]));
        const float bc = scan_add64(lf, lane), bend = shfl_c_(bc, 63);
        const float a = bend - bc + ip, mloc = wave_max(a);
        saL[lane] = expf(a - mloc) * 0.125f;
        if (lane == 0) { ((float*)(YB + MLC_ML))[u] = mloc; ((float*)(YB + MLC_BE))[u] = bend; }
    }
    __syncthreads();
#pragma unroll
    for (int i = 0; i < 2; ++i) {
        const int idx = c.tid + 256 * i, row = idx >> 3, chk = idx & 7;
        const u32x4 r = *(const u32x4*)(PROJ + (t0 + row) * NPAD + 256 + h * 64 + chk * 8);
        float f[8]; unpack8(r, f);
        const float s = saL[row];
        *(u32x4*)(smem + row * 128 + chk * 16) = (u32x4){pk2(f[0] * s, f[1] * s), pk2(f[2] * s, f[3] * s), pk2(f[4] * s, f[5] * s), pk2(f[6] * s, f[7] * s)};
    }
    asm volatile("s_waitcnt vmcnt(0)" ::: "memory");
    __syncthreads();
    const int h5 = lane >> 5, r = lane & 31, i16 = lane & 15, q4 = i16 >> 2, p = i16 & 3, blk = (lane >> 4) & 1;
    const int dkt = wid & 1, dvp = wid >> 1;
    const unsigned kaddr = (unsigned)(size_t)smem + (unsigned)((8 * h5 + q4) * 128 + dkt * 64 + 32 * blk + 8 * p);
    const unsigned vaddr = (unsigned)(size_t)smem + 8192u + (unsigned)((8 * h5 + q4) * 256 + dvp * 128 + 32 * blk + 8 * p);
    f32x16 a0, a1;
#pragma unroll
    for (int i = 0; i < 16; ++i) { a0[i] = 0.f; a1[i] = 0.f; }
#pragma unroll
    for (int st = 0; st < 4; ++st) {
        s16x4 kl, kh, v0l, v0h, v1l, v1h;
        const unsigned ka = kaddr + st * 2048, va = vaddr + st * 4096;
        asm volatile("ds_read_b64_tr_b16 %0, %6\n\t"
                     "ds_read_b64_tr_b16 %1, %6 offset:512\n\t"
                     "ds_read_b64_tr_b16 %2, %7\n\t"
                     "ds_read_b64_tr_b16 %3, %7 offset:1024\n\t"
                     "ds_read_b64_tr_b16 %4, %7 offset:64\n\t"
                     "ds_read_b64_tr_b16 %5, %7 offset:1088\n\t"
                     "s_waitcnt lgkmcnt(0)"
                     : "=&v"(kl), "=&v"(kh), "=&v"(v0l), "=&v"(v0h), "=&v"(v1l), "=&v"(v1h) : "v"(ka), "v"(va) : "memory");
        const bf16x8 kf = __builtin_shufflevector(kl, kh, 0, 1, 2, 3, 4, 5, 6, 7);
        const bf16x8 vf0 = __builtin_shufflevector(v0l, v0h, 0, 1, 2, 3, 4, 5, 6, 7), vf1 = __builtin_shufflevector(v1l, v1h, 0, 1, 2, 3, 4, 5, 6, 7);
        a0 = MFMA32(kf, vf0, a0); a1 = MFMA32(kf, vf1, a1);
    }
    float* DC = (float*)(YB + MLC_DC) + (size_t)u * 8192;
#pragma unroll
    for (int i = 0; i < 16; ++i) {
        const int dk = dkt * 32 + (i & 3) + 8 * (i >> 2) + 4 * h5;
        DC[dk * 128 + dvp * 64 + r] = a0[i]; DC[dk * 128 + dvp * 64 + 32 + r] = a1[i];
    }
    if (c.tid < 64) {
        float s = 0.f;
#pragma unroll 8
        for (int t = 0; t < 64; ++t) s += bf2f(((const bf16_t*)smem)[t * 64 + c.tid]);
        ((float*)(YB + MLC_DN))[(size_t)u * 64 + c.tid] = s;
    }
}

__device__ __forceinline__ void mlc_passB(int u, unsigned char* YB, const Ctx& c) {
    const int bh = u >> 3, sl = u & 7;
    const float* ML = (const float*)(YB + MLC_ML) + bh * 32; const float* BE = (const float*)(YB + MLC_BE) + bh * 32;
    const float* DC = (const float*)(YB + MLC_DC) + (size_t)bh * 32 * 8192 + sl * 1024 + c.tid * 4;
    bf16_t* CS = (bf16_t*)(YB + MLC_CS) + (size_t)bh * 32 * 8192 + sl * 1024 + c.tid * 4;
    const float* DN = (const float*)(YB + MLC_DN) + (size_t)bh * 32 * 64; float* NS = (float*)(YB + MLC_NS) + (size_t)bh * 32 * 64; float* MS = (float*)(YB + MLC_MS) + bh * 32;
    f32x4 C4 = (f32x4){0.f, 0.f, 0.f, 0.f}; float nv = 0.f, m = 0.f;
    const bool do_n = (sl == 0) && (c.tid < 64);
#pragma unroll 4
    for (int n = 0; n < 32; ++n) {
        *(u32x2*)(CS + (size_t)n * 8192) = (u32x2){pk2(C4[0], C4[1]), pk2(C4[2], C4[3])};
        if (do_n) NS[n * 64 + c.tid] = nv;
        if (sl == 0 && c.tid == 0) MS[n] = m;
        const float be = BE[n], ml = ML[n];
        const float mn = fmaxf(be + m, ml), keep = expf(be + m - mn), g = expf(ml - mn);
        m = mn;
        const f32x4 d = *(const f32x4*)(DC + (size_t)n * 8192);
        C4 = C4 * keep + d * g;
        if (do_n) nv = nv * keep + DN[n * 64 + c.tid] * g;
    }
}

__device__ __forceinline__ void mlc_passC(int u, const bf16_t* PROJ, const float* GATES, const float* b_i, const float* b_f, const unsigned char* YB,
                                          const float* gain  , bf16_t* MIXO, const Ctx& c) {
    const int bh = u >> 5, b = bh >> 2, h = bh & 3;
    const size_t t0 = (size_t)b * SEQ + (u & 31) * 64;
    unsigned char* smem = c.smem;
    float* csL = (float*)(smem + 32768); float* pmL = (float*)(smem + 33024); float* bcL = (float*)(smem + 33280); float* nnL = (float*)(smem + 33536); float* sqL = (float*)(smem + 33792);
    const int lane = c.lane, wid = __builtin_amdgcn_readfirstlane(c.wid);
    const bf16_t* CS = (const bf16_t*)(YB + MLC_CS) + (size_t)u * 8192;
#pragma unroll
    for (int i = 0; i < 4; ++i) { const int j = wid * 4 + i;
        glds16(PROJ + (t0 + 4 * j + (lane >> 4)) * NPAD + 512 + h * 128 + (lane & 15) * 8, smem + j * 1024 + lane * 16);
        glds16(CS + (4 * j + (lane >> 4)) * 128 + (lane & 15) * 8, smem + 16384 + j * 1024 + lane * 16); }
    float bcl = 0.f;
    if (wid == 0) {
        const float ip = GATES[(t0 + lane) * 8 + h] + b_i[h], lf = -softplusf_(-(GATES[(t0 + lane) * 8 + 4 + h] + b_f[h]));
        bcl = scan_add64(lf, lane);
        const float cs = ip - bcl;
        csL[lane] = cs; pmL[lane] = scan_max64(cs, lane);
        nnL[lane] = ((const float*)(YB + MLC_NS))[(size_t)u * 64 + lane];
        bcL[lane] = bcl;
    }
    asm volatile("s_waitcnt vmcnt(0)" ::: "memory");
    __syncthreads();
    const int h5 = lane >> 5, r = lane & 31, i16 = lane & 15, q4 = i16 >> 2, p = i16 & 3, blk = (lane >> 4) & 1;
    const int th = wid & 1, dvh = wid >> 1;
    const int t = th * 32 + r;
    const float m_n = ((const float*)(YB + MLC_MS))[u];
    const float Mt = fmaxf(m_n, pmL[t]), w_inter = __expf(m_n - Mt), em = __expf(-(bcL[t] + Mt));
    bf16x8 qf[4];
#pragma unroll
    for (int ks = 0; ks < 4; ++ks) qf[ks] = *(const bf16x8*)(PROJ + (t0 + t) * NPAD + h * 64 + ks * 16 + h5 * 8);
    float qn = 0.f; bf16x8 qw[4];
#pragma unroll
    for (int ks = 0; ks < 4; ++ks) {
        const u32x4 raw = __builtin_bit_cast(u32x4, qf[ks]); float f[8]; unpack8(raw, f);
#pragma unroll
        for (int j = 0; j < 8; ++j) qn += f[j] * nnL[ks * 16 + h5 * 8 + j];
        qw[ks] = __builtin_bit_cast(bf16x8, (u32x4){pk2(f[0] * w_inter, f[1] * w_inter), pk2(f[2] * w_inter, f[3] * w_inter), pk2(f[4] * w_inter, f[5] * w_inter), pk2(f[6] * w_inter, f[7] * w_inter)});
    }
    qn += shfl_xor_(qn, 32);
    f32x16 x0, x1;
#pragma unroll
    for (int i = 0; i < 16; ++i) { x0[i] = 0.f; x1[i] = 0.f; }
#pragma unroll
    for (int ks = 0; ks < 4; ++ks) {
        const bf16x8 kf0 = *(const bf16x8*)(PROJ + (t0 + r) * NPAD + 256 + h * 64 + ks * 16 + h5 * 8);
        x0 = MFMA32(kf0, qf[ks], x0);
        if (th) { const bf16x8 kf1 = *(const bf16x8*)(PROJ + (t0 + 32 + r) * NPAD + 256 + h * 64 + ks * 16 + h5 * 8); x1 = MFMA32(kf1, qf[ks], x1); }
    }
    float ps = 0.f;
#pragma unroll
    for (int i = 0; i < 16; ++i) {
        const int s = (i & 3) + 8 * (i >> 2) + 4 * h5;
        const float w0 = (s <= t) ? __expf(csL[s] - Mt) * 0.125f : 0.f;
        x0[i] *= w0; ps += x0[i];
        if (th) { const float w1 = (s <= r) ? __expf(csL[32 + s] - Mt) * 0.125f : 0.f; x1[i] *= w1; ps += x1[i]; }
    }
    ps += shfl_xor_(ps, 32);
    const float den = w_inter * qn + ps;
    f32x16 o0, o1;
#pragma unroll
    for (int i = 0; i < 16; ++i) { o0[i] = 0.f; o1[i] = 0.f; }
    {
        const unsigned vb = (unsigned)(size_t)smem + (unsigned)((4 * h5 + q4) * 256 + dvh * 128 + 32 * blk + 8 * p);
#pragma unroll
        for (int st = 0; st < 2; ++st) {
            if (st == 0 || th) {
                s16x4 l00, h00, l01, h01, l10, h10, l11, h11;
                const unsigned va = vb + st * 8192;
                asm volatile("ds_read_b64_tr_b16 %0, %8\n\t"
                             "ds_read_b64_tr_b16 %1, %8 offset:2048\n\t"
                             "ds_read_b64_tr_b16 %2, %8 offset:64\n\t"
                             "ds_read_b64_tr_b16 %3, %8 offset:2112\n\t"
                             "ds_read_b64_tr_b16 %4, %8 offset:4096\n\t"
                             "ds_read_b64_tr_b16 %5, %8 offset:6144\n\t"
                             "ds_read_b64_tr_b16 %6, %8 offset:4160\n\t"
                             "ds_read_b64_tr_b16 %7, %8 offset:6208\n\t"
                             "s_waitcnt lgkmcnt(0)"
                             : "=&v"(l00), "=&v"(h00), "=&v"(l01), "=&v"(h01), "=&v"(l10), "=&v"(h10), "=&v"(l11), "=&v"(h11) : "v"(va) : "memory");
                const bf16x8 v00 = __builtin_shufflevector(l00, h00, 0, 1, 2, 3, 4, 5, 6, 7), v01 = __builtin_shufflevector(l01, h01, 0, 1, 2, 3, 4, 5, 6, 7);
                const bf16x8 v10 = __builtin_shufflevector(l10, h10, 0, 1, 2, 3, 4, 5, 6, 7), v11 = __builtin_shufflevector(l11, h11, 0, 1, 2, 3, 4, 5, 6, 7);
                const bf16x8 pb0 = (st == 0) ? pack_step<0>(x0) : pack_step<0>(x1);
                const bf16x8 pb1 = (st == 0) ? pack_step<1>(x0) : pack_step<1>(x1);
                o0 = MFMA32(v00, pb0, o0); o1 = MFMA32(v01, pb0, o1);
                o0 = MFMA32(v10, pb1, o0); o1 = MFMA32(v11, pb1, o1);
            }
        }
    }
    {
        const unsigned cb = (unsigned)(size_t)smem + 16384u + (unsigned)((8 * h5 + q4) * 256 + dvh * 128 + 32 * blk + 8 * p);
#pragma unroll
        for (int kp = 0; kp < 2; ++kp) {
            s16x4 l00, h00, l01, h01, l10, h10, l11, h11;
            const unsigned ca = cb + kp * 8192;
            asm volatile("ds_read_b64_tr_b16 %0, %8\n\t"
                         "ds_read_b64_tr_b16 %1, %8 offset:1024\n\t"
                         "ds_read_b64_tr_b16 %2, %8 offset:64\n\t"
                         "ds_read_b64_tr_b16 %3, %8 offset:1088\n\t"
                         "ds_read_b64_tr_b16 %4, %8 offset:4096\n\t"
                         "ds_read_b64_tr_b16 %5, %8 offset:5120\n\t"
                         "ds_read_b64_tr_b16 %6, %8 offset:4160\n\t"
                         "ds_read_b64_tr_b16 %7, %8 offset:5184\n\t"
                         "s_waitcnt lgkmcnt(0)"
                         : "=&v"(l00), "=&v"(h00), "=&v"(l01), "=&v"(h01), "=&v"(l10), "=&v"(h10), "=&v"(l11), "=&v"(h11) : "v"(ca) : "memory");
            const bf16x8 c00 = __builtin_shufflevector(l00, h00, 0, 1, 2, 3, 4, 5, 6, 7), c01 = __builtin_shufflevector(l01, h01, 0, 1, 2, 3, 4, 5, 6, 7);
            const bf16x8 c10 = __builtin_shufflevector(l10, h10, 0, 1, 2, 3, 4, 5, 6, 7), c11 = __builtin_shufflevector(l11, h11, 0, 1, 2, 3, 4, 5, 6, 7);
            o0 = MFMA32(c00, qw[2 * kp], o0); o1 = MFMA32(c01, qw[2 * kp], o1);
            o0 = MFMA32(c10, qw[2 * kp + 1], o0); o1 = MFMA32(c11, qw[2 * kp + 1], o1);
        }
    }
    const float inv = __builtin_amdgcn_rcpf(fmaxf(fabsf(den), em));
    float ss = 0.f;
#pragma unroll
    for (int i = 0; i < 16; ++i) { o0[i] *= inv; o1[i] *= inv; ss += o0[i] * o0[i] + o1[i] * o1[i]; }
    ss += shfl_xor_(ss, 32);
    if (h5 == 0) sqL[wid * 32 + r] = ss;
    __syncthreads();
    const float rr = rsqrtf((sqL[th * 32 + r] + sqL[(th + 2) * 32 + r]) * (1.f / 128.f) + 1e-6f);
    const bf16_t* grow = PROJ + (t0 + t) * NPAD + 1032 + h * 128 + dvh * 64 + 4 * h5;
    const float* gn = gain + h * 128 + dvh * 64 + 4 * h5;
    bf16_t* orow = MIXO + (t0 + t) * 1024 + h * 128 + dvh * 64 + 4 * h5;
#pragma unroll
    for (int d = 0; d < 2; ++d)
#pragma unroll
        for (int g = 0; g < 4; ++g) {
            const u32x2 zr = *(const u32x2*)(grow + d * 32 + 8 * g);
            const f32x4 gv = *(const f32x4*)(gn + d * 32 + 8 * g);
            const float z0 = bflo(zr.x), z1 = bfhi(zr.x), z2 = bflo(zr.y), z3 = bfhi(zr.y);
            const float y0 = (d ? o1[4 * g] : o0[4 * g]) * rr * gv[0] * sigmoidf_(z0), y1 = (d ? o1[4 * g + 1] : o0[4 * g + 1]) * rr * gv[1] * sigmoidf_(z1);
            const float y2 = (d ? o1[4 * g + 2] : o0[4 * g + 2]) * rr * gv[2] * sigmoidf_(z2), y3 = (d ? o1[4 * g + 3] : o0[4 * g + 3]) * rr * gv[3] * sigmoidf_(z3);
            *(u32x2*)(orow + d * 32 + 8 * g) = (u32x2){pk2(y0, y1), pk2(y2, y3)};
        }
}

constexpr size_t GD_WN = 0, GD_UU = GD_WN + (size_t)1024 * 16384, GD_KGT = GD_UU + (size_t)1024 * 16384, GD_QG = GD_KGT + (size_t)1024 * 16384,
                 GD_AT = GD_QG + (size_t)1024 * 16384, GD_GL = GD_AT + (size_t)1024 * 8192, GD_END = GD_GL + 4096;
static_assert(GD_END <= (size_t)MAXROWS * 256 * 2, "GDN chunk records must fit the HBUF region");

__device__ __forceinline__ void gdc_passA(int u, const bf16_t* GQ, const bf16_t* GK, const bf16_t* GV, const float* BETA, const float* GLOG, unsigned char* HB, const Ctx& c) {
    const int bh = u >> 5, b = bh >> 2, h = bh & 3;
    const size_t t0 = (size_t)b * SEQ + (u & 31) * 64;
    unsigned char* smem = c.smem;
    float* Lm = (float*)(smem + 49152);
    float* GA = (float*)(smem + 65536 + 64); float* BT = GA + 64; float* EG = BT + 64; float* EK = EG + 64;
    const int lane = c.lane, wid = __builtin_amdgcn_readfirstlane(c.wid);
    const int h5 = lane >> 5, r = lane & 31;
    if (wid == 0) {
        const float g = GLOG[(t0 + lane) * 4 + h];
        const float G = scan_add64(g, lane), Gl = shfl_c_(G, 63);
        GA[lane] = G; BT[lane] = BETA[(t0 + lane) * 4 + h]; EG[lane] = expf(G); EK[lane] = expf(Gl - G);
        if (lane == 0) ((float*)(HB + GD_GL))[u] = expf(Gl);
    }
    __syncthreads();
    if (wid < 3) {
        const int it = (wid + 1) >> 1, jt = wid >> 1;
        f32x16 dl, da;
#pragma unroll
        for (int i = 0; i < 16; ++i) { dl[i] = 0.f; da[i] = 0.f; }
#pragma unroll
        for (int ks = 0; ks < 8; ++ks) {
            const bf16x8 ki = *(const bf16x8*)(GK + (t0 + 32 * it + r) * 512 + h * 128 + ks * 16 + h5 * 8);
            const bf16x8 kj = *(const bf16x8*)(GK + (t0 + 32 * jt + r) * 512 + h * 128 + ks * 16 + h5 * 8);
            const bf16x8 qi = *(const bf16x8*)(GQ + (t0 + 32 * it + r) * 512 + h * 128 + ks * 16 + h5 * 8);
            dl = MFMA32(ki, kj, dl); da = MFMA32(qi, kj, da);
        }
        const int j = 32 * jt + r; const float Gj = GA[j];
        bf16_t* AT = (bf16_t*)(HB + GD_AT) + (size_t)u * 4096;
#pragma unroll
        for (int i = 0; i < 16; ++i) {
            const int ii = 32 * it + (i & 3) + 8 * (i >> 2) + 4 * h5;
            const float dec = __expf(GA[ii] - Gj);
            Lm[ii * 64 + j] = (j < ii) ? dl[i] * BT[ii] * dec : 0.f;
            AT[ii * 64 + j] = (bf16_t)f2bf((j <= ii) ? da[i] * dec : 0.f);
        }
        if (wid == 0) {
#pragma unroll
            for (int i = 0; i < 16; ++i) { const int ii = (i & 3) + 8 * (i >> 2) + 4 * h5; Lm[ii * 64 + 32 + r] = 0.f; AT[ii * 64 + 32 + r] = 0; }
        }
    }
    __syncthreads();
    if (wid == 0) {
        float Tc[64];
#pragma unroll
        for (int i = 0; i < 64; ++i) {
            float s = (i == lane) ? 1.f : 0.f;
#pragma unroll
            for (int k = 0; k < i; ++k) s -= Lm[i * 64 + k] * Tc[k];
            Tc[i] = s;
        }
        bf16_t* Tm = (bf16_t*)Lm;
#pragma unroll
        for (int i = 0; i < 64; ++i) Tm[i * 64 + lane] = (bf16_t)f2bf(Tc[i]);
    } else {
        const int t3 = c.tid - 64;
        for (int idx = t3; idx < 4096; idx += 192) {
            const int arr = idx >> 10, rem = idx & 1023, row = rem >> 4, chk = rem & 15;
            const bf16_t* sp = ((arr == 1) ? GV : (arr == 3) ? GQ : GK) + (t0 + row) * 512 + h * 128 + chk * 8;
            const u32x4 raw = *(const u32x4*)sp; float f[8]; unpack8(raw, f);
            const float sc = (arr == 0) ? BT[row] * EG[row] : (arr == 1) ? BT[row] : (arr == 2) ? EK[row] : EG[row];
            const u32x4 o = (u32x4){pk2(f[0] * sc, f[1] * sc), pk2(f[2] * sc, f[3] * sc), pk2(f[4] * sc, f[5] * sc), pk2(f[6] * sc, f[7] * sc)};
            if (arr < 3) *(u32x4*)(smem + arr * 16384 + row * 256 + chk * 16) = o;
            else *(u32x4*)((bf16_t*)(HB + GD_QG) + (size_t)u * 8192 + row * 128 + chk * 8) = o;
        }
    }
    __syncthreads();
    {
        const int i16 = lane & 15, q4 = i16 >> 2, p = i16 & 3, blk = (lane >> 4) & 1;
        const unsigned char* Tm = smem + 49152;
        f32x16 u0, u1, w0, w1;
#pragma unroll
        for (int i = 0; i < 16; ++i) { u0[i] = 0.f; u1[i] = 0.f; w0[i] = 0.f; w1[i] = 0.f; }
        const unsigned ib = (unsigned)(size_t)smem + (unsigned)((8 * h5 + q4) * 256 + wid * 64 + 32 * blk + 8 * p);
#pragma unroll
        for (int ks = 0; ks < 4; ++ks) {
            s16x4 kl, kh, vl, vh;
            const unsigned ia = ib + ks * 4096;
            asm volatile("ds_read_b64_tr_b16 %0, %4\n\t"
                         "ds_read_b64_tr_b16 %1, %4 offset:1024\n\t"
                         "ds_read_b64_tr_b16 %2, %4 offset:16384\n\t"
                         "ds_read_b64_tr_b16 %3, %4 offset:17408\n\t"
                         "s_waitcnt lgkmcnt(0)"
                         : "=&v"(kl), "=&v"(kh), "=&v"(vl), "=&v"(vh) : "v"(ia) : "memory");
            const bf16x8 kb = __builtin_shufflevector(kl, kh, 0, 1, 2, 3, 4, 5, 6, 7), vb = __builtin_shufflevector(vl, vh, 0, 1, 2, 3, 4, 5, 6, 7);
            const bf16x8 t1 = *(const bf16x8*)(Tm + (32 + r) * 128 + ks * 32 + h5 * 16);
            w1 = MFMA32(t1, kb, w1); u1 = MFMA32(t1, vb, u1);
            if (ks < 2) { const bf16x8 tt0 = *(const bf16x8*)(Tm + r * 128 + ks * 32 + h5 * 16); w0 = MFMA32(tt0, kb, w0); u0 = MFMA32(tt0, vb, u0); }
        }
        bf16_t* WN = (bf16_t*)(HB + GD_WN) + (size_t)u * 8192; bf16_t* UU = (bf16_t*)(HB + GD_UU) + (size_t)u * 8192;
#pragma unroll
        for (int i = 0; i < 16; ++i) {
            const int s = (i & 3) + 8 * (i >> 2) + 4 * h5;
            WN[s * 128 + wid * 32 + r] = (bf16_t)f2bf(-w0[i]); WN[(32 + s) * 128 + wid * 32 + r] = (bf16_t)f2bf(-w1[i]);
        }
        {
            u32x4* up = (u32x4*)(UU + (size_t)(wid * 64 + lane) * 32);
            up[0] = (u32x4){pk2(u0[0], u0[1]), pk2(u0[2], u0[3]), pk2(u0[4], u0[5]), pk2(u0[6], u0[7])};
            up[1] = (u32x4){pk2(u0[8], u0[9]), pk2(u0[10], u0[11]), pk2(u0[12], u0[13]), pk2(u0[14], u0[15])};
            up[2] = (u32x4){pk2(u1[0], u1[1]), pk2(u1[2], u1[3]), pk2(u1[4], u1[5]), pk2(u1[6], u1[7])};
            up[3] = (u32x4){pk2(u1[8], u1[9]), pk2(u1[10], u1[11]), pk2(u1[12], u1[13]), pk2(u1[14], u1[15])};
        }
        bf16_t* KGT = (bf16_t*)(HB + GD_KGT) + (size_t)u * 8192;
        const int gq = lane >> 4;
        const unsigned kb0 = (unsigned)(size_t)smem + 32768u + (unsigned)(q4 * 256 + gq * 32 + 8 * p);
#pragma unroll
        for (int it2 = 0; it2 < 8; ++it2) {
            const int job = wid * 8 + it2, s0 = (job & 15) * 4, dkb = (job >> 4) * 64;
            s16x4 v;
            const unsigned ad = kb0 + s0 * 256 + dkb * 2;
            asm volatile("ds_read_b64_tr_b16 %0, %1\n\ts_waitcnt lgkmcnt(0)" : "=&v"(v) : "v"(ad) : "memory");
            *(s16x4*)(KGT + (size_t)(dkb + gq * 16 + i16) * 64 + s0) = v;
        }
    }
}

constexpr size_t GC_ST = 0, GC_VT = (size_t)1024 * 32768;
__device__ __forceinline__ void gdc_passB(int bh, const unsigned char* HB, unsigned char* YB, const Ctx& c) {
    const int lane = c.lane, wid = __builtin_amdgcn_readfirstlane(c.wid);
    const int h5 = lane >> 5, r = lane & 31;
    unsigned char* smem = c.smem;
    f32x16 S0, S1, S2, S3;
#pragma unroll
    for (int i = 0; i < 16; ++i) { S0[i] = 0.f; S1[i] = 0.f; S2[i] = 0.f; S3[i] = 0.f; }
    const size_t u0 = (size_t)bh * 32;
#define GB_STAGE(n_, p_) do { const bf16_t* wn_ = (const bf16_t*)(HB + GD_WN) + (u0 + (n_)) * 8192; const bf16_t* kg_ = (const bf16_t*)(HB + GD_KGT) + (u0 + (n_)) * 8192; \
        unsigned char* bp_ = smem + (p_) * 32768; \
        _Pragma("unroll") for (int i = 0; i < 4; ++i) { const int jj = wid * 4 + i, row = 4 * jj + (lane >> 4), ch = (lane & 15) ^ (row & 15); \
            glds16(wn_ + row * 128 + ch * 8, bp_ + jj * 1024 + lane * 16); } \
        _Pragma("unroll") for (int i = 0; i < 4; ++i) { const int jj = wid * 4 + i, row = 8 * jj + (lane >> 3), ch = (lane & 7) ^ ((row >> 1) & 7); \
            glds16(kg_ + row * 64 + ch * 8, bp_ + 16384 + jj * 1024 + lane * 16); } } while (0)
#define LD128(base_, R_, ks_) __builtin_shufflevector(*(const s16x4*)((base_) + (R_) * 256 + (((2 * (ks_)) ^ (rl & 15)) << 4) + 8 * hl), \
                                                      *(const s16x4*)((base_) + (R_) * 256 + (((2 * (ks_) + 1) ^ (rl & 15)) << 4) + 8 * hl), 0, 1, 2, 3, 4, 5, 6, 7)
#define LD64(base_, R_, k2_) __builtin_shufflevector(*(const s16x4*)((base_) + (R_) * 128 + (((2 * (k2_)) ^ ((rl >> 1) & 7)) << 4) + 8 * hl), \
                                                     *(const s16x4*)((base_) + (R_) * 128 + (((2 * (k2_) + 1) ^ ((rl >> 1) & 7)) << 4) + 8 * hl), 0, 1, 2, 3, 4, 5, 6, 7)
    u32x4 uu[4];
#define GB_LOADU(n_) do { const u32x4* up_ = (const u32x4*)((const bf16_t*)(HB + GD_UU) + (u0 + (n_)) * 8192 + (size_t)(wid * 64 + lane) * 32); \
        uu[0] = up_[0]; uu[1] = up_[1]; uu[2] = up_[2]; uu[3] = up_[3]; } while (0)
    __syncthreads();
    GB_STAGE(0, 0);
    GB_LOADU(0);
#pragma unroll 1
    for (int n2 = 0; n2 < 16; ++n2) {
#pragma unroll
        for (int PBUF = 0; PBUF < 2; ++PBUF) {
        const int n = 2 * n2 + PBUF;
        const float gl = ((const float*)(HB + GD_GL))[u0 + n];
        if (n == 0) asm volatile("s_waitcnt vmcnt(0)" ::: "memory"); else asm volatile("s_waitcnt vmcnt(24)" ::: "memory");
        asm volatile("s_waitcnt lgkmcnt(0)" ::: "memory"); __builtin_amdgcn_s_barrier(); asm volatile("" ::: "memory");
        f32x16 v0, v1;
#pragma unroll
        for (int q = 0; q < 2; ++q) {
            const u32x4 a = uu[q], bq = uu[2 + q];
            v0[8 * q + 0] = bflo(a.x); v0[8 * q + 1] = bfhi(a.x); v0[8 * q + 2] = bflo(a.y); v0[8 * q + 3] = bfhi(a.y);
            v0[8 * q + 4] = bflo(a.z); v0[8 * q + 5] = bfhi(a.z); v0[8 * q + 6] = bflo(a.w); v0[8 * q + 7] = bfhi(a.w);
            v1[8 * q + 0] = bflo(bq.x); v1[8 * q + 1] = bfhi(bq.x); v1[8 * q + 2] = bflo(bq.y); v1[8 * q + 3] = bfhi(bq.y);
            v1[8 * q + 4] = bflo(bq.z); v1[8 * q + 5] = bfhi(bq.z); v1[8 * q + 6] = bflo(bq.w); v1[8 * q + 7] = bfhi(bq.w);
        }
        if (n + 1 < 32) { GB_STAGE(n + 1, (PBUF ^ 1)); GB_LOADU(n + 1); }
        int rl = r, hl = h5; asm volatile("" : "+v"(rl), "+v"(hl));
        const unsigned char* WNb = smem + PBUF * 32768; const unsigned char* KGb = WNb + 16384;
        {
            bf16_t* st = (bf16_t*)(YB + GC_ST) + (u0 + n) * 16384 + (size_t)h5 * 512 + (size_t)(wid * 32 + r) * 4;
#define ST_TILE(SX, dt_) do { _Pragma("unroll") for (int g = 0; g < 4; ++g) \
                *(u32x2*)(st + ((dt_) * 8 + 2 * g) * 512) = (u32x2){cvt_pk(SX[4 * g], SX[4 * g + 1]), cvt_pk(SX[4 * g + 2], SX[4 * g + 3])}; } while (0)
            ST_TILE(S0, 0); ST_TILE(S1, 1); ST_TILE(S2, 2); ST_TILE(S3, 3);
#undef ST_TILE
        }
        {
            bf16x8 fa0, fb0, fa1, fb1, fa2, fb2;
#define LDV(FA, FB, ks_) do { FA = LD128(WNb, rl, ks_); FB = LD128(WNb, 32 + rl, ks_); } while (0)
#define MMV(SX, HF, FA, FB) do { const bf16x8 sbk = pack_step<HF>(SX); v0 = MFMA32(FA, sbk, v0); v1 = MFMA32(FB, sbk, v1); } while (0)
            LDV(fa0, fb0, 0); LDV(fa1, fb1, 1); LDV(fa2, fb2, 2);
            MMV(S0, 0, fa0, fb0); LDV(fa0, fb0, 3);
            MMV(S0, 1, fa1, fb1); LDV(fa1, fb1, 4);
            MMV(S1, 0, fa2, fb2); LDV(fa2, fb2, 5);
            MMV(S1, 1, fa0, fb0); LDV(fa0, fb0, 6);
            MMV(S2, 0, fa1, fb1); LDV(fa1, fb1, 7);
            MMV(S2, 1, fa2, fb2);
            MMV(S3, 0, fa0, fb0);
            MMV(S3, 1, fa1, fb1);
#undef LDV
#undef MMV
        }
        const bf16x8 vb0 = pack_step_m<0>(v0), vb1 = pack_step_m<1>(v0), vb2 = pack_step_m<0>(v1), vb3 = pack_step_m<1>(v1);
        {
            bf16_t* vt = (bf16_t*)(YB + GC_VT) + (u0 + n) * 8192 + (size_t)h5 * 512 + (size_t)(wid * 32 + r) * 4;
            const u32x4 p0 = __builtin_bit_cast(u32x4, vb0), p1 = __builtin_bit_cast(u32x4, vb1), p2 = __builtin_bit_cast(u32x4, vb2), p3 = __builtin_bit_cast(u32x4, vb3);
            *(u32x2*)(vt + 0 * 512) = (u32x2){p0.x, p0.y};  *(u32x2*)(vt + 2 * 512) = (u32x2){p0.z, p0.w};
            *(u32x2*)(vt + 4 * 512) = (u32x2){p1.x, p1.y};  *(u32x2*)(vt + 6 * 512) = (u32x2){p1.z, p1.w};
            *(u32x2*)(vt + 8 * 512) = (u32x2){p2.x, p2.y};  *(u32x2*)(vt + 10 * 512) = (u32x2){p2.z, p2.w};
            *(u32x2*)(vt + 12 * 512) = (u32x2){p3.x, p3.y}; *(u32x2*)(vt + 14 * 512) = (u32x2){p3.z, p3.w};
        }
        asm volatile("" ::: "memory"); asm volatile("" : "+v"(rl), "+v"(hl));
        S0 *= gl; S1 *= gl; S2 *= gl; S3 *= gl;
        {
            bf16x8 g0, g1, g2;
            g0 = LD64(KGb, rl, 0); g1 = LD64(KGb, rl, 1); g2 = LD64(KGb, rl, 2);
            S0 = MFMA32(g0, vb0, S0); g0 = LD64(KGb, rl, 3);
            S0 = MFMA32(g1, vb1, S0); g1 = LD64(KGb, 32 + rl, 0);
            S0 = MFMA32(g2, vb2, S0); g2 = LD64(KGb, 32 + rl, 1);
            S0 = MFMA32(g0, vb3, S0); g0 = LD64(KGb, 32 + rl, 2);
            S1 = MFMA32(g1, vb0, S1); g1 = LD64(KGb, 32 + rl, 3);
            S1 = MFMA32(g2, vb1, S1); g2 = LD64(KGb, 64 + rl, 0);
            S1 = MFMA32(g0, vb2, S1); g0 = LD64(KGb, 64 + rl, 1);
            S1 = MFMA32(g1, vb3, S1); g1 = LD64(KGb, 64 + rl, 2);
            S2 = MFMA32(g2, vb0, S2); g2 = LD64(KGb, 64 + rl, 3);
            S2 = MFMA32(g0, vb1, S2); g0 = LD64(KGb, 96 + rl, 0);
            S2 = MFMA32(g1, vb2, S2); g1 = LD64(KGb, 96 + rl, 1);
            S2 = MFMA32(g2, vb3, S2); g2 = LD64(KGb, 96 + rl, 2);
            S3 = MFMA32(g0, vb0, S3); g0 = LD64(KGb, 96 + rl, 3);
            S3 = MFMA32(g1, vb1, S3);
            S3 = MFMA32(g2, vb2, S3);
            S3 = MFMA32(g0, vb3, S3);
        }
        }
    }
#undef GB_STAGE
#undef LD128
#undef LD64
#undef GB_LOADU
}

__device__ __forceinline__ void gdc_passB_idle() {
    __syncthreads();
    for (int n = 0; n < 32; ++n) { asm volatile("" ::: "memory"); __builtin_amdgcn_s_barrier(); asm volatile("" ::: "memory"); }
}

__device__ __forceinline__ void gdc_passC(int u, const unsigned char* HB, const unsigned char* YB, const bf16_t* PROJ, const float* gnorm, bf16_t* MIXO, const Ctx& c) {
    const int bh = u >> 5, b = bh >> 2, h = bh & 3;
    const size_t t0 = (size_t)b * SEQ + (u & 31) * 64;
    const int lane = c.lane, wid = __builtin_amdgcn_readfirstlane(c.wid);
    const int h5 = lane >> 5, r = lane & 31;
    float* sqL = (float*)c.smem;
    const bf16_t* ST = (const bf16_t*)(YB + GC_ST) + (size_t)u * 16384 + (size_t)(2 * h5) * 512 + (size_t)(wid * 32 + r) * 4;
    const bf16_t* VT = (const bf16_t*)(YB + GC_VT) + (size_t)u * 8192 + (size_t)(2 * h5) * 512 + (size_t)(wid * 32 + r) * 4;
    const bf16_t* QG = (const bf16_t*)(HB + GD_QG) + (size_t)u * 8192 + (size_t)r * 128 + 8 * h5;
    const bf16_t* AT = (const bf16_t*)(HB + GD_AT) + (size_t)u * 4096 + (size_t)r * 64 + 8 * h5;
    f32x16 o0, o1;
#pragma unroll
    for (int i = 0; i < 16; ++i) { o0[i] = 0.f; o1[i] = 0.f; }
#pragma unroll
    for (int ks = 0; ks < 8; ++ks) {
        const bf16x8 sa = __builtin_shufflevector(*(const s16x4*)(ST + (4 * ks) * 512), *(const s16x4*)(ST + (4 * ks + 1) * 512), 0, 1, 2, 3, 4, 5, 6, 7);
        const bf16x8 q0 = *(const bf16x8*)(QG + ks * 16), q1 = *(const bf16x8*)(QG + 32 * 128 + ks * 16);
        o0 = MFMA32(sa, q0, o0); o1 = MFMA32(sa, q1, o1);
        if (ks == 3) asm volatile("" ::: "memory");
    }
#pragma unroll
    for (int k2 = 0; k2 < 4; ++k2) {
        const bf16x8 va = __builtin_shufflevector(*(const s16x4*)(VT + (4 * k2) * 512), *(const s16x4*)(VT + (4 * k2 + 1) * 512), 0, 1, 2, 3, 4, 5, 6, 7);
        const bf16x8 a1 = *(const bf16x8*)(AT + 32 * 64 + k2 * 16);
        o1 = MFMA32(va, a1, o1);
        if (k2 < 2) { const bf16x8 a0 = *(const bf16x8*)(AT + k2 * 16); o0 = MFMA32(va, a0, o0); }
    }
    float s0 = 0.f, s1 = 0.f;
#pragma unroll
    for (int i = 0; i < 16; ++i) { s0 += o0[i] * o0[i]; s1 += o1[i] * o1[i]; }
    s0 += shfl_xor_(s0, 32); s1 += shfl_xor_(s1, 32);
    __syncthreads();
    if (h5 == 0) { sqL[wid * 64 + r] = s0; sqL[wid * 64 + 32 + r] = s1; }
    __syncthreads();
    const float rr0 = rsqrtf((sqL[r] + sqL[64 + r] + sqL[128 + r] + sqL[192 + r]) * (1.f / 128.f) + 1e-6f);
    const float rr1 = rsqrtf((sqL[32 + r] + sqL[96 + r] + sqL[160 + r] + sqL[224 + r]) * (1.f / 128.f) + 1e-6f);
#pragma unroll
    for (int tt = 0; tt < 2; ++tt) {
        const size_t t = t0 + tt * 32 + r;
        const bf16_t* zrow = PROJ + t * NPAD + 1960 + h * 128 + wid * 32 + 4 * h5;
        const float* gn = gnorm + wid * 32 + 4 * h5;
        bf16_t* orow = MIXO + t * 1024 + 512 + h * 128 + wid * 32 + 4 * h5;
        const float rr = tt ? rr1 : rr0;
#pragma unroll
        for (int g = 0; g < 4; ++g) {
            const u32x2 zr = *(const u32x2*)(zrow + 8 * g);
            const f32x4 gv = *(const f32x4*)(gn + 8 * g);
            const float z0 = bflo(zr.x), z1 = bfhi(zr.x), z2 = bflo(zr.y), z3 = bfhi(zr.y);
            const float y0 = (tt ? o1[4 * g] : o0[4 * g]) * rr * gv[0] * siluf_(z0), y1 = (tt ? o1[4 * g + 1] : o0[4 * g + 1]) * rr * gv[1] * siluf_(z1);
            const float y2 = (tt ? o1[4 * g + 2] : o0[4 * g + 2]) * rr * gv[2] * siluf_(z2), y3 = (tt ? o1[4 * g + 3] : o0[4 * g + 3]) * rr * gv[3] * siluf_(z3);
            *(u32x2*)(orow + 8 * g) = (u32x2){pk2(y0, y1), pk2(y2, y3)};
        }
    }
}

__device__ __forceinline__ void phase_post(const float* OG, const bf16_t* PROJ, const float* gain, bool odd, bf16_t* MIXO, const Ctx& c) {
    const int lane = c.lane;
    const int gcol = odd ? 1032 : 1960, ocol = odd ? 0 : 512;
    for (int t = c.bid * 4 + c.wid; t < T; t += c.nblk * 4) {
        const f32x4 a0 = *(const f32x4*)(OG + (size_t)t * 512 + lane * 8), a1 = *(const f32x4*)(OG + (size_t)t * 512 + lane * 8 + 4);
        float ss = (a0[0] * a0[0] + a0[1] * a0[1]) + (a0[2] * a0[2] + a0[3] * a0[3]) + (a1[0] * a1[0] + a1[1] * a1[1]) + (a1[2] * a1[2] + a1[3] * a1[3]);
        ss = red16(ss);
        const float rr = rsqrtf(ss * (1.f / 128.f) + 1e-6f);
        const u32x4 zr = *(const u32x4*)(PROJ + (size_t)t * NPAD + gcol + lane * 8);
        float z[8]; unpack8(zr, z);
        const int gi = odd ? lane * 8 : (lane & 15) * 8;
        const f32x4 g0 = *(const f32x4*)(gain + gi), g1 = *(const f32x4*)(gain + gi + 4);
        float y[8];
#pragma unroll
        for (int j = 0; j < 4; ++j) {
            const float ga = odd ? sigmoidf_(z[j]) : siluf_(z[j]), gb = odd ? sigmoidf_(z[4 + j]) : siluf_(z[4 + j]);
            y[j] = a0[j] * rr * g0[j] * ga; y[4 + j] = a1[j] * rr * g1[j] * gb;
        }
        *(u32x4*)(MIXO + (size_t)t * 1024 + ocol + lane * 8) = (u32x4){pk2(y[0], y[1]), pk2(y[2], y[3]), pk2(y[4], y[5]), pk2(y[6], y[7])};
    }
}

__global__ void __launch_bounds__(512, 2) fwd(Args a) {
    extern __shared__ __attribute__((aligned(16))) unsigned char smem[];
    Ctx c;
    const int wave_s = __builtin_amdgcn_readfirstlane((int)threadIdx.x >> 6);
#define SET_CTX(cx) do { int t_ = (wave_s << 6) | lane_id_v(); cx.tid0 = t_; cx.half = t_ >> 8; cx.tid = t_ & 255; cx.lane = t_ & 63; cx.wid = (t_ >> 6) & 3; \
        cx.wr = cx.wid >> 1; cx.wc = cx.wid & 1; cx.fr = cx.lane & 15; cx.fq = cx.lane >> 4; cx.bid = blockIdx.x * 2 + cx.half; cx.nblk = gridDim.x * 2; \
        cx.smem0 = smem; cx.smem = smem + cx.half * HALF_LDS; } while (0)
    SET_CTX(c);
#define PH_CTX() SET_CTX(c)
    unsigned char* const ws_base = a.ws;
    const void* const* const ain_base = (const void* const*)__builtin_amdgcn_kernarg_segment_ptr();
    unsigned* ctl = (unsigned*)(ws_base + WS_CTL);
    volatile LAS unsigned* xbw = (volatile LAS unsigned*)(smem + LDS_BLK);
    if (c.tid0 < 8) xbw[c.tid0] = 0u;
    __syncthreads();
    XcdBarrier bar; bar.bar = ctl; bar.x = 0; bar.st = xbw; bar.wave = wave_s;
    if (a.use_bar) bar = xcd_barrier_post(ctl, xbw, c.tid0);
#if ONE_LAUNCH
    const int hi = NPH;
#define IN(k) true
#else
    const int lo = a.ph_lo, hi = a.ph_hi;
#define IN(k) (lo <= (k) && (k) < hi)
#endif
#define PH(k) if (IN(k)) { PH_CTX(); unsigned char* ws = ws_base; const void* const* ain = ain_base; asm volatile("" : "+s"(ws), "+s"(ain));
#define UNIT_CTX() Ctx cu; SET_CTX(cu)
#define SEAM(k) do { if ((k) + 1 < hi) xcd_barrier(bar); } while (0)

#define XBF ((bf16_t*)(ws + WS_XBF))
#define X1 ((float*)(ws + WS_X1))
#define PROJ ((bf16_t*)(ws + U_PROJ))
#define GATES ((float*)(ws + U_GATES))
#define MIXO ((bf16_t*)(ws + U_MIXO))
#define YBUF ((float*)(ws + U_YBUF))
#define ROPEM ((const float*)(ws + WS_ROPEM))
#define ROPES ((const float*)(ws + WS_ROPES))
#define XRES ((layer == 0) ? (const float*)ain[0] : (const float*)a.out)
#define CNT (ctl + CW_CNT + layer * 128)
#define WIN ((const bf16_t*)(ws + WS_WIN) + (size_t)layer * WIN_ELEMS)
#define WOUT ((const bf16_t*)(ws + WS_WOUT) + (size_t)layer * WOUT_ELEMS)

    PH(0) for (int rep = 0; rep < REP_PRO; ++rep) phase_prologue(a, c); SEAM(0); }

    for (int layer = 0; layer < 4; ++layer) {
        const int pb = 1 + layer * PPL;
#if !ONE_LAUNCH
        if (pb >= hi || pb + PPL <= lo) continue;
#endif
        const int jj = layer >> 1;
        const bool odd = (layer & 1) != 0;

        PH(pb + 0) {
                DenseSched S{T / 256, NPAD / 256, 1024, (int)blockIdx.x, (int)gridDim.x};
                EpiIn E{PROJ, GATES, odd ? 1024 : 1952};
                g8::phase<1, false>(smem, (const char*)XBF, (const char*)WIN, 1024, S, E, c.tid0);
            }
            SEAM(pb + 0); }
        PH(pb + 1) for (int rp = 0; rp < ((REP_PHASE == 1) ? 2 : 1); ++rp) { if (rp) xcd_barrier(bar);
            if (!odd) phase_prep_even(PROJ, GATES, (const float*)ain[3] + jj * 256, (const float*)ain[5] + jj * 128, (const float*)ain[7] + jj * 4 * 1536,
                                      (const float*)ain[8] + jj * 4, (const float*)ain[9] + jj * 4, ROPEM,
                                      (bf16_t*)(ws + U_CQ), (bf16_t*)(ws + U_CKV), (bf16_t*)(ws + U_KROPE), (bf16_t*)(ws + U_GQ), (bf16_t*)(ws + U_GK), (bf16_t*)(ws + U_GV),
                                      (float*)(ws + U_BETA), (float*)(ws + U_GLOG), c);
            else {
                phase_prep_odd(PROJ, ROPES, (bf16_t*)(ws + U_QF), (bf16_t*)(ws + U_KN), c);
                unsigned* ctr = ctl + CW_WORK + pb + 1 + 64 * rp;
                for (;;) {
                    const int u = next_unit(ctr, c); UNIT_CTX();
                    if (u >= 1024) break;
                    mlc_passA(u, PROJ, GATES, (const float*)ain[13] + jj * 4, (const float*)ain[14] + jj * 4, (unsigned char*)YBUF, cu);
                }
            }
            }
            SEAM(pb + 1);
        }
        PH(pb + 2) for (int rp = 0; rp < ((REP_PHASE == 2) ? 2 : 1); ++rp) { if (rp) xcd_barrier(bar);
            unsigned* ctr = ctl + CW_WORK + pb + 2 + 64 * rp;
            if (!odd) {
                for (;;) {
                    const int u = next_unit(ctr, c); UNIT_CTX();
                    if (u >= 1024 + MLAUP_TILES) break;
                    if (u < 1024) gdc_passA(u, (const bf16_t*)(ws + U_GQ), (const bf16_t*)(ws + U_GK), (const bf16_t*)(ws + U_GV), (const float*)(ws + U_BETA),
                                            (const float*)(ws + U_GLOG), ws + WS_HBUF, cu);
                    else mla_up_tile(u - 1024, (const bf16_t*)(ws + U_CQ), (const bf16_t*)(ws + WS_WQB) + (size_t)jj * WQB_ELEMS, (const bf16_t*)(ws + U_CKV),
                                     (const bf16_t*)(ws + WS_WKVB) + (size_t)jj * WKVB_ELEMS, ROPEM, (bf16_t*)(ws + U_QF), (bf16_t*)(ws + U_KN), (bf16_t*)(ws + U_VV), cu);
                }
            } else {
                for (;;) {
                    const int u = next_unit(ctr, c); UNIT_CTX();
                    if (u >= 256 + 1024) break;
                    if (u < 256) mlc_passB(u, (unsigned char*)YBUF, cu);
                    else {
                        const int v = u - 256, hq = v & 7, n = (v >> 3) & 15, b = v >> 7, kvh = hq >> 2;
                        const size_t tb = (size_t)b * SEQ;
                        attn_unit<4, true>((const bf16_t*)(ws + U_QF) + tb * 512 + hq * 64, 512, (const bf16_t*)(ws + U_KN) + tb * 128 + kvh * 64, 128,
                                           (const bf16_t*)(ws + U_KN), 0, PROJ + tb * NPAD + 2184 + kvh * 64, NPAD,
                                           MIXO + tb * 1024 + 512 + hq * 64, 1024, n * 128, ((const float*)ain[16])[jj * 8 + hq] * 1.4426950408889634f, cu);
                    }
                }
            }
            }
            SEAM(pb + 2);
        }
        PH(pb + 3) for (int rp = 0; rp < ((REP_PHASE == 3) ? 2 : 1); ++rp) { if (rp) xcd_barrier(bar);
            unsigned* ctr = ctl + CW_WORK + pb + 3 + 64 * rp;
            if (!odd) {
                for (;;) {
                    const int u = next_unit(ctr, c); UNIT_CTX();
                    if (u >= 64 + 1024) break;
                    if (rp > 0 && ((REP_ONLY == 1 && u >= 64) || (REP_ONLY == 2 && u < 64))) continue;
                    if (u < 64) { if ((u & 1) == 0) gdc_passB(u >> 1, ws + WS_HBUF, (unsigned char*)YBUF, cu); else gdc_passB_idle(); }
                    else {
                        const int v = u - 64, qb = 15 - (v >> 6), bh = v & 63, b = bh >> 3, hh = bh & 7;
                        const size_t tb = (size_t)b * SEQ;
                        attn_unit<6, false>((const bf16_t*)(ws + U_QF) + tb * 768 + hh * 96, 768, (const bf16_t*)(ws + U_KN) + tb * 512 + hh * 64, 512,
                                            (const bf16_t*)(ws + U_KROPE) + tb * 32, 32, (const bf16_t*)(ws + U_VV) + tb * 512 + hh * 64, 512,
                                            MIXO + tb * 1024 + hh * 64, 1024, qb * 128, 0.f, cu);
                    }
                }
            } else {
                for (;;) {
                    const int u = next_unit(ctr, c); UNIT_CTX();
                    if (u >= 1024) break;
                    mlc_passC(u, PROJ, GATES, (const float*)ain[13] + jj * 4, (const float*)ain[14] + jj * 4, (const unsigned char*)YBUF, (const float*)ain[15] + jj * 512, MIXO, cu);
                }
            }
            }
            SEAM(pb + 3);
        }
        PH(pb + 4) for (int rp = 0; rp < ((REP_PHASE == 4) ? 2 : 1); ++rp) { if (rp) xcd_barrier(bar);
            if (!odd) {
                unsigned* ctr = ctl + CW_WORK + pb + 4 + 64 * rp;
                for (;;) {
                    const int u = next_unit(ctr, c); UNIT_CTX();
                    if (u >= 1024) break;
                    gdc_passC(u, ws + WS_HBUF, (const unsigned char*)YBUF, PROJ, (const float*)ain[10] + jj * 128, MIXO, cu);
                }
            }
            }
            if (!odd) SEAM(pb + 4);
        }
        PH(pb + 5) {
                DenseSched S{T / 256, 4, 1024, (int)blockIdx.x, (int)gridDim.x};
                EpiOut E{XBF, (bf16_t*)YBUF};
                g8::phase<1, false>(smem, (const char*)MIXO, (const char*)WOUT, 1024, S, E, c.tid0);
            }
            SEAM(pb + 5); }
#if FUSE_LNROUTE
        PH(pb + 6) phase_lnroute((const bf16_t*)YBUF, (const float*)ain[18] + layer * 1024, (const float*)ain[19] + layer * 1024, XBF, (const bf16_t*)(ws + WS_WRT) + (size_t)layer * WRT_ELEMS,
                                 (const float*)ain[21] + layer * 64, CNT, (int*)(ws + WS_LTOK), (float*)(ws + WS_LW), (int*)(ws + WS_ASG), (float*)(ws + WS_ASGW), c); SEAM(pb + 8); }
#else
        PH(pb + 6) for (int rep = 0; rep < REP_TOK; ++rep) phase_ln1((const bf16_t*)YBUF, (const float*)ain[18] + layer * 1024, (const float*)ain[19] + layer * 1024, XBF, c); SEAM(pb + 6); }
        PH(pb + 7) for (int rep = 0; rep < REP_GEMM; ++rep) phase_router(XBF, (const bf16_t*)(ws + WS_WRT) + (size_t)layer * WRT_ELEMS, (float*)(ws + WS_LOG), c); SEAM(pb + 7); }
        PH(pb + 8) phase_route((const float*)(ws + WS_LOG), (const float*)ain[21] + layer * 64, CNT, (int*)(ws + WS_LTOK), (float*)(ws + WS_LW), (int*)(ws + WS_ASG), (float*)(ws + WS_ASGW), c); SEAM(pb + 8); }
#endif
        PH(pb + 9) {
                int* bst8 = (int*)(smem + LDS_BLK + 64); int* eb8 = bst8 + 256;
                build_block_table(CNT, bst8, c);
                for (int rb = c.tid0; rb < bst8[65]; rb += NT) { int e = 0; for (int q = 1; q < 65; ++q) e += (bst8[q] <= rb) ? 1 : 0; eb8[rb] = e; }
                __syncthreads();
                MoeSchedG S{__builtin_amdgcn_readfirstlane(bst8[65]), (int)blockIdx.x, (int)gridDim.x, eb8, bst8, (const int*)(ws + WS_LTOK)};
                EpiMoe1 E{(bf16_t*)(ws + WS_HBUF)};
                g8::phase<0, true>(smem, (const char*)XBF, (const char*)((const bf16_t*)(ws + WS_WGU) + (size_t)layer * 65 * WGU_ELEMS), 1024, S, E, c.tid0);
            }
            SEAM(pb + 9); }
        PH(pb + 10)
#if MOE2_G8
            {
                int* bst8 = (int*)(smem + LDS_BLK + 64); int* eb8 = bst8 + 256;
                build_block_table(CNT, bst8, c);
                for (int rb = c.tid0; rb < bst8[65]; rb += NT) { int e = 0; for (int q = 1; q < 65; ++q) e += (bst8[q] <= rb) ? 1 : 0; eb8[rb] = e; }
                __syncthreads();
                MoeSched S{__builtin_amdgcn_readfirstlane(bst8[65]), 4, (int)blockIdx.x, (int)gridDim.x, eb8};
#if Y_FP8
                EpiMoe2F8 E{(unsigned char*)(ws + U_Y)};
#else
                EpiMoe2 E{(bf16_t*)(ws + U_Y)};
#endif
                g8::phase<(Y_FP8 ? 2 : 1), false>(smem, (const char*)(ws + WS_HBUF), (const char*)((const bf16_t*)(ws + WS_WDN) + (size_t)layer * 65 * WDN_ELEMS), 256, S, E, c.tid0);
            }
#else
            phase_moe2((const bf16_t*)(ws + WS_HBUF), (const bf16_t*)(ws + WS_WDN) + (size_t)layer * 65 * WDN_ELEMS, CNT, (bf16_t*)(ws + U_Y), c);
#endif
            SEAM(pb + 10); }
        PH(pb + 11)
#if Y_FP8
            if (layer == 3) phase_combine8<true>((const unsigned char*)(ws + U_Y), (const int*)(ws + WS_ASG), (const float*)(ws + WS_ASGW), CNT, (const float*)ain[28] + layer * 1024, (const float*)ain[29] + layer * 1024, a.out, XBF, c);
            else phase_combine8<false>((const unsigned char*)(ws + U_Y), (const int*)(ws + WS_ASG), (const float*)(ws + WS_ASGW), CNT, (const float*)ain[28] + layer * 1024, (const float*)ain[29] + layer * 1024, a.out, XBF, c);
            SEAM(pb + 11); }
#else
            if (layer == 3) phase_combine<true>((const bf16_t*)(ws + U_Y), (const int*)(ws + WS_ASG), (const float*)(ws + WS_ASGW), CNT, (const float*)ain[28] + layer * 1024, (const float*)ain[29] + layer * 1024, a.out, XBF, c);
            else phase_combine<false>((const bf16_t*)(ws + U_Y), (const int*)(ws + WS_ASG), (const float*)(ws + WS_ASGW), CNT, (const float*)ain[28] + layer * 1024, (const float*)ain[29] + layer * 1024, a.out, XBF, c);
            SEAM(pb + 11); }
#endif
    }
#undef IN
#undef XBF
#undef X1
#undef PROJ
#undef GATES
#undef MIXO
#undef YBUF
#undef ROPEM
#undef ROPES
#undef XRES
#undef CNT
#undef WIN
#undef WOUT
#undef PH
#undef PH_CTX
#undef UNIT_CTX
#undef SEAM
}

extern "C" void kernel_launch(void* const* d_in, const int* in_sizes, int n_in, void* d_out, int out_size, void* d_ws, size_t ws_size, hipStream_t stream) {
    static int grid = 0;
    if (grid == 0) {
        if (n_in != 30 || out_size != T * 1024 || ws_size < WS_END) {
            fprintf(stderr, "kernel_launch: unexpected shapes (n_in %d, out %d, ws %zu < %zu)\n", n_in, out_size, ws_size, (size_t)WS_END);
            grid = -1; return;
        }
        int dev = 0, cus = 0, per_cu = 0;
        (void)hipGetDevice(&dev);
        (void)hipDeviceGetAttribute(&cus, hipDeviceAttributeMultiprocessorCount, dev);
        (void)hipFuncSetAttribute((const void*)fwd, hipFuncAttributeMaxDynamicSharedMemorySize, DYN_LDS);
        (void)hipOccupancyMaxActiveBlocksPerMultiprocessor(&per_cu, (const void*)fwd, NT, DYN_LDS);
        (void)hipGetLastError();
        if (per_cu < 1) per_cu = 1;
        grid = cus;
    }
    if (grid < 0) return;
    (void)hipMemsetAsync((char*)d_ws + WS_CTL, 0, CTL_BYTES, stream);
    Args a{};
    for (int i = 0; i < 30; ++i) a.in[i] = d_in[i];
    a.out = (float*)d_out; a.ws = (unsigned char*)d_ws; a.pad = 0;
#if ONE_LAUNCH
    a.ph_lo = 0; a.ph_hi = NPH; a.use_bar = 1;
    hipLaunchKernelGGL(fwd, dim3(grid), dim3(NT), DYN_LDS, stream, a);
#else
    for (int p = 0; p < NPH; ++p) {
        a.ph_lo = p; a.ph_hi = p + 1; a.use_bar = 0;
        hipLaunchKernelGGL(fwd, dim3(grid), dim3(NT), DYN_LDS, stream, a);
    }
#endif
}
```

```cpp
#include <hip/hip_runtime.h>
#include <stdint.h>
#include <stdio.h>

#define REP_GEMM 1
#define REP_PHASE 0
#define REP_G0 1
#define REP_G1 1
#define REP_G2 1
#define REP_G3 1
#define REP_MIX 1
#define REP_ONLY 0
#define REP_CMB 1
#define REP_PRO 1
#define REP_TOK 1
#define MOE2_G8 1
#ifndef G8_SPLIT
#define G8_SPLIT 0
#endif
#ifndef FUSE_LNROUTE
#define FUSE_LNROUTE 1
#endif
#ifndef Y_FP8
#define Y_FP8 1
#endif
#ifndef MOE2_F8
#define MOE2_F8 1
#endif
#ifndef ONE_LAUNCH
#define ONE_LAUNCH 1
#endif

typedef unsigned short bf16_t;
typedef short bf16x8 __attribute__((ext_vector_type(8)));
typedef float f32x4 __attribute__((ext_vector_type(4)));
typedef float f32x2 __attribute__((ext_vector_type(2)));
typedef int i32x4 __attribute__((ext_vector_type(4)));
typedef int i32x8 __attribute__((ext_vector_type(8)));
typedef unsigned u32x4 __attribute__((ext_vector_type(4)));
typedef unsigned u32x2 __attribute__((ext_vector_type(2)));
#define LAS __attribute__((address_space(3)))
#define GAS __attribute__((address_space(1)))

constexpr int T = 16384, SEQ = 2048;
constexpr int NPAD = 2560;
constexpr int CAP = 16384;
constexpr int RBR = 256;
constexpr int MAXRB = 512 + 64 + 64;
constexpr int MAXROWS = MAXRB * RBR;
constexpr float ALPHA = 1.681792830507429f;
constexpr int PPL = 12;
constexpr int NPH = 1 + 4 * PPL;
constexpr int NT = 512, NW = 8;
constexpr int HALF_LDS = 65536 + 64 + 1024;
constexpr int LDS_BLK = 2 * HALF_LDS;
constexpr int DYN_LDS = LDS_BLK + 64 + 1024 + 2560;

constexpr size_t cmax(size_t a, size_t b) { return a > b ? a : b; }
constexpr size_t WS_CTL = 0;
constexpr size_t CTL_BYTES = 65536;
constexpr size_t WS_WIN = WS_CTL + CTL_BYTES;
constexpr size_t WIN_ELEMS = (size_t)NPAD * 1024;
constexpr size_t WS_WQB = WS_WIN + 4 * WIN_ELEMS * 2;
constexpr size_t WQB_ELEMS = 768 * 256;
constexpr size_t WS_WKVB = WS_WQB + 2 * WQB_ELEMS * 2;
constexpr size_t WKVB_ELEMS = 1024 * 128;
constexpr size_t WS_WOUT = WS_WKVB + 2 * WKVB_ELEMS * 2;
constexpr size_t WOUT_ELEMS = 1024 * 1024;
constexpr size_t WS_WRT = WS_WOUT + 4 * WOUT_ELEMS * 2;
constexpr size_t WRT_ELEMS = 128 * 1024;
constexpr size_t WS_WGU = WS_WRT + 4 * WRT_ELEMS * 2;
constexpr size_t WGU_ELEMS = 512 * 1024;
constexpr size_t WS_WDN = WS_WGU + 4 * 65 * WGU_ELEMS * 2;
constexpr size_t WDN_ELEMS = 1024 * 256;
constexpr size_t WS_ROPEM = WS_WDN + 4 * 65 * WDN_ELEMS * 2;
constexpr size_t WS_ROPES = WS_ROPEM + (size_t)T * 16 * 2 * 4;
constexpr size_t WS_X1 = WS_ROPES + (size_t)T * 32 * 2 * 4;
constexpr size_t WS_XBF = WS_X1 + (size_t)T * 1024 * 4;
constexpr size_t WS_HBUF = WS_XBF + (size_t)T * 1024 * 2;
constexpr size_t WS_LOG = WS_HBUF + (size_t)MAXROWS * 256 * 2;
constexpr size_t WS_ASG = WS_LOG + (size_t)T * 64 * 4;
constexpr size_t WS_ASGW = WS_ASG + (size_t)T * 8 * 4;
constexpr size_t WS_LTOK = WS_ASGW + (size_t)T * 8 * 4;
constexpr size_t WS_LW = WS_LTOK + (size_t)65 * CAP * 4;
constexpr size_t WS_U = WS_LW + (size_t)65 * CAP * 4;
constexpr size_t U_Y = WS_U;
constexpr size_t U_PROJ = WS_U;
constexpr size_t U_GATES = U_PROJ + (size_t)T * NPAD * 2;
constexpr size_t U_CQ = U_GATES + (size_t)T * 8 * 4;
constexpr size_t U_CKV = U_CQ + (size_t)T * 256 * 2;
constexpr size_t U_KROPE = U_CKV + (size_t)T * 128 * 2;
constexpr size_t U_QF = U_KROPE + (size_t)T * 32 * 2;
constexpr size_t U_KN = U_QF + (size_t)T * 768 * 2;
constexpr size_t U_VV = U_KN + (size_t)T * 512 * 2;
constexpr size_t U_GQ = U_VV + (size_t)T * 512 * 2;
constexpr size_t U_GK = U_GQ + (size_t)T * 512 * 2;
constexpr size_t U_GV = U_GK + (size_t)T * 512 * 2;
constexpr size_t U_BETA = U_GV + (size_t)T * 512 * 2;
constexpr size_t U_GLOG = U_BETA + (size_t)T * 4 * 4;
constexpr size_t U_MIXO = U_GLOG + (size_t)T * 4 * 4;
constexpr size_t U_YBUF = U_MIXO + (size_t)T * 1024 * 2;
constexpr size_t U_END1 = U_YBUF + (size_t)T * 1024 * 4;
constexpr size_t WS_END = WS_U + cmax((size_t)MAXROWS * 1024 * 2, U_END1 - WS_U);

constexpr int CW_CNT = 4096;
constexpr int CW_WORK = 8192;

#define XB_TMO      128
#define XB_XCNT(j)  (256  + 64 * (j))
#define XB_XSUB(j)  (1280 + 64 * (j))
#define XB_XGEN(j)  (2304 + 64 * (j))
#define XB_TOP      3328
#define XB_TOPGEN   3392
#define XCD_BAR_WORDS 3456
#define XB_SPIN_CAP (1u << 18)

__device__ __forceinline__ unsigned xb_ld(unsigned* p)              { return __hip_atomic_load(p, __ATOMIC_RELAXED, __HIP_MEMORY_SCOPE_AGENT); }
__device__ __forceinline__ int lane_id_v() { int l; asm volatile("v_mbcnt_lo_u32_b32 %0, -1, 0\n\tv_mbcnt_hi_u32_b32 %0, -1, %0" : "=v"(l)); return l; }
__device__ __forceinline__ unsigned xb_add(unsigned* p, unsigned v) { return __hip_atomic_fetch_add(p, v, __ATOMIC_RELAXED, __HIP_MEMORY_SCOPE_AGENT); }
__device__ __forceinline__ unsigned xb_xcc_id() { return (unsigned)__builtin_amdgcn_s_getreg((3 << 11) | 20) & 0xFu; }
#define XB_SPIN(cond, bar) do { unsigned _sp = 0; while (cond) { __builtin_amdgcn_s_sleep(1); \
    if ((++_sp & 255u) == 0u) { if (xb_ld(&(bar)[XB_TMO])) break; if (_sp > XB_SPIN_CAP) { atomicAdd(&(bar)[XB_TMO], 1u); break; } } } } while (0)

struct XcdBarrier { unsigned* bar; unsigned x; volatile LAS unsigned* st; int wave; };

__device__ __forceinline__ XcdBarrier xcd_barrier_post(unsigned* bar, volatile LAS unsigned* st, int tid0) {
    XcdBarrier b; b.bar = bar; b.x = xb_xcc_id(); b.st = st; b.wave = __builtin_amdgcn_readfirstlane(tid0 >> 6);
    if (tid0 == 0) (void)xb_add(&bar[XB_XCNT(b.x)], 1u);
    return b;
}
__device__ __forceinline__ void xcd_barrier_complete(unsigned* bar, unsigned x, unsigned& nloc, unsigned& nx) {
    const unsigned G = gridDim.x * gridDim.y * gridDim.z;
    unsigned sum, cnt, mine, sp = 0u;
    for (;;) {
        sum = 0u; cnt = 0u; mine = 0u;
#pragma unroll
        for (unsigned j = 0; j < 16; ++j) { const unsigned c = xb_ld(&bar[XB_XCNT(j)]); sum += c; cnt += (c > 0u) ? 1u : 0u; mine = (j == x) ? c : mine; }
        if (sum == G) break;
        __builtin_amdgcn_s_sleep(1);
        if ((++sp & 255u) == 0u) { if (xb_ld(&bar[XB_TMO])) break; if (sp > XB_SPIN_CAP) { atomicAdd(&bar[XB_TMO], 1u); break; } }
    }
    nloc = mine > 0u ? mine : 1u; nx = cnt > 0u ? cnt : 1u;
}
__device__ __forceinline__ void xcd_barrier(const XcdBarrier& b) {
    asm volatile("s_waitcnt vmcnt(0)" ::: "memory");
    __syncthreads();
    if (b.wave == 0 && lane_id_v() == 0) {
        unsigned* bar = b.bar; unsigned bx = __builtin_amdgcn_readfirstlane(b.x);
        asm volatile("" : "+s"(bar), "+s"(bx));
        __builtin_amdgcn_s_waitcnt(0);
        unsigned nloc = b.st[0], nx = b.st[1];
        if (nloc == 0u) { xcd_barrier_complete(bar, bx, nloc, nx); b.st[0] = nloc; b.st[1] = nx; }
        const unsigned old = xb_add(&bar[XB_XSUB(bx)], 1u);
        const unsigned gen = old / nloc;
        if (old + 1u == (gen + 1u) * nloc) {
            __builtin_amdgcn_fence(__ATOMIC_RELEASE, "agent");
            asm volatile("s_waitcnt vmcnt(0)" ::: "memory");
            const unsigned og = xb_add(&bar[XB_TOP], 1u);
            const unsigned tg = og / nx;
            if (og + 1u == (tg + 1u) * nx) xb_add(&bar[XB_TOPGEN], 1u);
            else XB_SPIN(xb_ld(&bar[XB_TOPGEN]) == tg, bar);
            __builtin_amdgcn_fence(__ATOMIC_ACQUIRE, "agent");
            xb_add(&bar[XB_XGEN(bx)], 1u);
            asm volatile("s_waitcnt vmcnt(0)" ::: "memory");
        } else {
            XB_SPIN(xb_ld(&bar[XB_XGEN(bx)]) == gen, bar);
            __builtin_amdgcn_fence(__ATOMIC_ACQUIRE, "agent");
            asm volatile("s_waitcnt vmcnt(0)" ::: "memory");
        }
    }
    __syncthreads();
}

__device__ __forceinline__ float bf2f(unsigned v) { return __uint_as_float(v << 16); }
__device__ __forceinline__ float bflo(unsigned w) { return __uint_as_float(w << 16); }
__device__ __forceinline__ float bfhi(unsigned w) { return __uint_as_float(w & 0xffff0000u); }
__device__ __forceinline__ unsigned f2bf(float f) { unsigned u = __float_as_uint(f); u += 0x7fffu + ((u >> 16) & 1u); return u >> 16; }
__device__ __forceinline__ unsigned pk2(float lo, float hi) { return f2bf(lo) | (f2bf(hi) << 16); }
__device__ __forceinline__ unsigned cvt_pk(float lo, float hi) { unsigned r; asm volatile("v_cvt_pk_bf16_f32 %0, %1, %2" : "=v"(r) : "v"(lo), "v"(hi)); return r; }
template <class T> __device__ __forceinline__ T shfl_xor_(T v, int o) { return __builtin_bit_cast(T, __builtin_amdgcn_ds_bpermute((lane_id_v() ^ o) << 2, __builtin_bit_cast(int, v))); }
template <class T> __device__ __forceinline__ T shfl_up_(T v, int o) { const int l = lane_id_v(), s = (l - o < 0) ? l : l - o; return __builtin_bit_cast(T, __builtin_amdgcn_ds_bpermute(s << 2, __builtin_bit_cast(int, v))); }
template <class T> __device__ __forceinline__ T shfl_c_(T v, int src  ) { return __builtin_bit_cast(T, __builtin_amdgcn_readlane(__builtin_bit_cast(int, v), src)); }
__device__ __forceinline__ float wave_sum(float v) {
#pragma unroll
    for (int o = 32; o > 0; o >>= 1) v += shfl_xor_(v, o);
    return v;
}
__device__ __forceinline__ float sigmoidf_(float x) { return 1.f / (1.f + expf(-x)); }
__device__ __forceinline__ float siluf_(float x) { return x / (1.f + expf(-x)); }
__device__ __forceinline__ float softplusf_(float x) { return x > 20.f ? x : log1pf(expf(x)); }
__device__ __forceinline__ void glds16(const void* g, void* l) {
    __builtin_amdgcn_global_load_lds((const GAS unsigned*)g, (LAS unsigned*)l, 16, 0, 0);
}
__device__ __forceinline__ void unpack8(const u32x4 r, float (&f)[8]) {
    f[0] = bflo(r.x); f[1] = bfhi(r.x); f[2] = bflo(r.y); f[3] = bfhi(r.y);
    f[4] = bflo(r.z); f[5] = bfhi(r.z); f[6] = bflo(r.w); f[7] = bfhi(r.w);
}

struct Args {
    const void* in[30];
    float* out;
    unsigned char* ws;
    int ph_lo, ph_hi, use_bar, pad;
};

struct Ctx { int tid, lane, wid, wr, wc, fr, fq, bid, nblk; unsigned char* smem; int half, tid0; unsigned char* smem0; };

#define WAIT_V(n) asm volatile("s_waitcnt vmcnt(" #n ")" ::: "memory")
__device__ __forceinline__ void gemm_tile(const bf16_t* a0, const bf16_t* a1, const bf16_t* b0, const bf16_t* b1,
                                          int nk, f32x4 (&acc)[4][4], const Ctx& c) {
#pragma unroll
    for (int m = 0; m < 4; ++m)
#pragma unroll
        for (int n = 0; n < 4; ++n) acc[m][n] = (f32x4){0.f, 0.f, 0.f, 0.f};
    unsigned char* smem = c.smem;
    const int sb = c.tid * 16;
    const int kofs = ((c.tid & 3) ^ ((c.tid >> 4) & 3)) * 8;
    a0 += kofs; a1 += kofs; b0 += kofs; b1 += kofs;
#define G_STAGE(kt_) do { unsigned char* sp_ = smem + ((kt_) & 3) * 16384 + sb; const int ko_ = (kt_) * 32; \
        glds16(a0 + ko_, sp_); glds16(a1 + ko_, sp_ + 4096); glds16(b0 + ko_, sp_ + 8192); glds16(b1 + ko_, sp_ + 12288); } while (0)
#define G_READ(kt_, AF, BF) do { const unsigned char* sa_ = smem + ((kt_) & 3) * 16384 + c.wr * 4096 + roff; const unsigned char* sb_ = smem + ((kt_) & 3) * 16384 + 8192 + c.wc * 4096 + roff; \
        _Pragma("unroll") for (int m = 0; m < 4; ++m) AF[m] = *(const bf16x8*)(sa_ + m * 1024); \
        _Pragma("unroll") for (int n = 0; n < 4; ++n) BF[n] = *(const bf16x8*)(sb_ + n * 1024); } while (0)
#define G_MMA(AF, BF) do { __builtin_amdgcn_s_setprio(1); \
        _Pragma("unroll") for (int m = 0; m < 4; ++m) _Pragma("unroll") for (int n = 0; n < 4; ++n) acc[m][n] = __builtin_amdgcn_mfma_f32_16x16x32_bf16(BF[n], AF[m], acc[m][n], 0, 0, 0); \
        __builtin_amdgcn_s_setprio(0); } while (0)
#define G_BAR() do { asm volatile("" ::: "memory"); __builtin_amdgcn_s_barrier(); asm volatile("" ::: "memory"); } while (0)
    const int roff = (c.fr * 64) + ((c.fq ^ ((c.fr >> 2) & 3)) * 16);
    WAIT_V(0);
    G_STAGE(0); G_STAGE(1); G_STAGE(2); G_STAGE(3);
    bf16x8 fa0[4], fb0[4], fa1[4], fb1[4];
    WAIT_V(12); G_BAR();
    G_READ(0, fa0, fb0);
#define G_LGK0() asm volatile("s_waitcnt lgkmcnt(0)" ::: "memory")
    int kt = 0;
    for (; kt < nk - 4; kt += 4) {
        G_LGK0(); WAIT_V(8); G_BAR(); G_STAGE(kt + 4); G_READ(1, fa1, fb1); G_MMA(fa0, fb0);
        G_LGK0(); WAIT_V(8); G_BAR(); G_STAGE(kt + 5); G_READ(2, fa0, fb0); G_MMA(fa1, fb1);
        G_LGK0(); WAIT_V(8); G_BAR(); G_STAGE(kt + 6); G_READ(3, fa1, fb1); G_MMA(fa0, fb0);
        G_LGK0(); WAIT_V(8); G_BAR(); G_STAGE(kt + 7); G_READ(0, fa0, fb0); G_MMA(fa1, fb1);
    }
    G_LGK0(); WAIT_V(8); G_BAR(); G_READ(1, fa1, fb1); G_MMA(fa0, fb0);
    G_LGK0(); WAIT_V(4); G_BAR(); G_READ(2, fa0, fb0); G_MMA(fa1, fb1);
    G_LGK0(); WAIT_V(0); G_BAR(); G_READ(3, fa1, fb1); G_MMA(fa0, fb0);
    G_MMA(fa1, fb1);
#undef G_LGK0
#undef G_STAGE
#undef G_READ
#undef G_MMA
#undef G_BAR
    __syncthreads();
}

namespace g8 {
constexpr int BM = 256, BK = 64, HALF = 128, HTB = HALF * BK * 2, STAGE_BYTES = 8 * HTB;
__device__ __forceinline__ int lds_byte(int r, int c) { const int st = (r >> 4) * 2 + (c >> 5), rr = r & 15, cc = c & 31, ob = rr * 64 + cc * 2; return st * 1024 + (ob ^ (((ob >> 9) & 1) << 5)); }
__device__ __forceinline__ void stage_rc(int b, int& R, int& C) { const int st = b / 1024, sb = b % 1024, swz = sb ^ (((sb >> 9) & 1) << 5); R = (st >> 1) * 16 + swz / 64; C = (st & 1) * 32 + (swz % 64) / 2; }
__device__ __forceinline__ int perm32(int rho) { const int n = rho >> 4, i = rho & 15; return 8 * (i >> 2) + 4 * n + (i & 3); }
struct Unit { int pm, pn, bt; };

template <int PERM, bool GATHER, bool F8, class Sched, class Epi>
__device__ __forceinline__ void phase(unsigned char* ldsp, const char* Abase, const char* Bbase, int K, const Sched& S, const Epi& E, int tid_in) {
    LAS unsigned char* lds = (LAS unsigned char*)ldsp;
    int tid = tid_in; asm volatile("" : "+v"(tid));
    const int wid = __builtin_amdgcn_readfirstlane(tid >> 6), lane = tid & 63, wr = wid >> 2, wc = wid & 3, fr = lane & 15, fq = lane >> 4;
    const int nt = K / BK;
    unsigned voffA[2], voffB[2];
#pragma unroll
    for (int i = 0; i < 2; ++i) { int R, C; stage_rc(tid * 16 + i * 8192, R, C); const int Rb = (PERM == 2) ? ((R >> 5) * 64 + ((R & 15) >> 2) * 16 + ((R >> 4) & 1) * 4 + (R & 3)) : (PERM == 1) ? ((R >> 5) * 64 + perm32(R & 31)) : (((R >> 5) * 2 + ((R & 15) >> 3)) * 32 + ((R >> 4) & 1) * 16 + (((R & 15) >> 2) & 1) * 8 + (R & 3));
        voffA[i] = (unsigned)(R * K + C) * 2u; voffB[i] = (unsigned)(Rb * K + C) * 2u; }
    const size_t kstep = (size_t)(BK * 2);
    const size_t hstep = (size_t)HALF * K * 2, tstep = 2 * hstep, bhstep = (PERM == 2) ? (size_t)8 * K * 2 : (PERM == 1) ? (size_t)32 * K * 2 : (size_t)4 * K * 2;
    const unsigned ldsw = (unsigned)wid * 1024u;
    const int aoff = F8 ? lds_byte(wr * 64 + fr, fq * 16) : lds_byte(wr * 64 + fr, fq * 8), boff = F8 ? lds_byte(wc * 32 + fr, fq * 16) : lds_byte(wc * 32 + fr, fq * 8);
    constexpr int KP = F8 ? 16 : 1024;
#define G8_SA(b, h) (((b) * 2 + (h)) * HTB)
#define G8_SB(b, h) ((4 + (b) * 2 + (h)) * HTB)
#define G8_DMA(gptr, voff32, ldsoff) do { const char* _gp = (gptr); const unsigned _lo = (unsigned)(size_t)(ldsp) + (unsigned)(ldsoff); \
        asm volatile("s_mov_b32 m0, %2\n\ts_nop 0\n\tglobal_load_lds_dwordx4 %0, %1" :: "v"(voff32), "s"(_gp), "s"(_lo) : "memory", "m0"); } while (0)
#define G8_STAGE(bufoff, gbase, voff) do { _Pragma("unroll") for (int _i = 0; _i < 2; ++_i) G8_DMA((const char*)(gbase), (voff)[_i], (bufoff) + ldsw + _i * 8192); } while (0)
#define G8_STAGEA(bufoff, gbase, h, kb) do { if constexpr (GATHER) { _Pragma("unroll") for (int _i = 0; _i < 2; ++_i) G8_DMA(Abase + (kb), vA[2 * (h) + _i], (bufoff) + ldsw + _i * 8192); } \
        else G8_STAGE(bufoff, (gbase) + (size_t)(h) * hstep + (kb), voffA); } while (0)
#define G8_LDA(dst, b, h) do { _Pragma("unroll") for (int m = 0; m < 4; ++m) _Pragma("unroll") for (int k = 0; k < 2; ++k) dst[m][k] = *(const LAS bf16x8*)(lds + G8_SA(b, h) + aoff + m * 2048 + k * KP); } while (0)
#define G8_LDB(dst, b, h) do { _Pragma("unroll") for (int n = 0; n < 2; ++n) _Pragma("unroll") for (int k = 0; k < 2; ++k) dst[n][k] = *(const LAS bf16x8*)(lds + G8_SB(b, h) + boff + n * 2048 + k * KP); } while (0)
#define G8_CAT(x, y) __builtin_shufflevector(__builtin_bit_cast(i32x4, (x)), __builtin_bit_cast(i32x4, (y)), 0, 1, 2, 3, 4, 5, 6, 7)
#define G8_MMA(ai, bj, At, Bt) do { __builtin_amdgcn_s_setprio(1); _Pragma("unroll") for (int m = 0; m < 4; ++m) _Pragma("unroll") for (int n = 0; n < 2; ++n) { \
        if constexpr (F8) acc[ai][bj][m][n] = __builtin_amdgcn_mfma_scale_f32_16x16x128_f8f6f4(G8_CAT(Bt[n][0], Bt[n][1]), G8_CAT(At[m][0], At[m][1]), acc[ai][bj][m][n], 0, 0, 0, 0, 0, 0); \
        else { _Pragma("unroll") for (int k = 0; k < 2; ++k) acc[ai][bj][m][n] = __builtin_amdgcn_mfma_f32_16x16x32_bf16(Bt[n][k], At[m][k], acc[ai][bj][m][n], 0, 0, 0); } } \
        __builtin_amdgcn_s_setprio(0); } while (0)
#define G8_WAIT_V(n) asm volatile("s_waitcnt vmcnt(" #n ")" ::: "memory")
#define G8_WAIT_L(n) asm volatile("s_waitcnt lgkmcnt(" #n ")" ::: "memory")
#define G8_BAR __builtin_amdgcn_s_barrier()
#define G8_SCHED __builtin_amdgcn_sched_barrier(0)
    Unit cur, nxt; int ui = 0;
    if (!S.next(0, cur)) return;
    f32x4 acc[2][2][4][2];
#pragma unroll
    for (int a = 0; a < 2; ++a)
#pragma unroll
        for (int b = 0; b < 2; ++b)
#pragma unroll
            for (int m = 0; m < 4; ++m)
#pragma unroll
                for (int n = 0; n < 2; ++n) acc[a][b][m][n] = (f32x4){0.f, 0.f, 0.f, 0.f};
    bf16x8 At[4][2], B0[2][2], B1[2][2];
    const char* cA = Abase + (size_t)cur.pm * tstep; const char* cB = Bbase + (size_t)cur.bt * tstep;
    unsigned vA[4] = {0u, 0u, 0u, 0u};
    if constexpr (GATHER) S.aoff(cur, tid, vA);
    asm volatile("s_waitcnt vmcnt(0)" ::: "memory");
    G8_STAGE(G8_SB(0, 0), cB, voffB); G8_STAGEA(G8_SA(0, 0), cA, 0, 0); G8_STAGE(G8_SB(0, 1), cB + bhstep, voffB); G8_STAGEA(G8_SA(0, 1), cA, 1, 0);
    if (wr == 1) G8_BAR;
    G8_WAIT_V(4); G8_BAR;
    G8_STAGE(G8_SB(1, 0), cB + kstep, voffB); G8_STAGEA(G8_SA(1, 0), cA, 0, kstep); G8_STAGE(G8_SB(1, 1), cB + bhstep + kstep, voffB);
    G8_WAIT_V(6); G8_BAR;
    G8_STAGEA(G8_SA(1, 1), cA, 1, kstep);
    for (;;) {
        const bool has_next = S.next(ui + 1, nxt);
        const char* nA = has_next ? Abase + (size_t)nxt.pm * tstep : cA; const char* nB = has_next ? Bbase + (size_t)nxt.bt * tstep : cB;
        for (int t = 0; t < nt; t += 2) {
            const bool last = (t == nt - 2);
            const int lastf = __builtin_amdgcn_readfirstlane(last ? 1 : 0);
            const size_t k2 = last ? 0 : (size_t)(t + 2) * kstep, k3 = k2 + kstep;
            const char* a2 = last ? nA : cA; const char* b2 = last ? nB : cB + (size_t)(t + 2) * kstep;
            const char* b3 = b2 + kstep;
            G8_LDB(B0, 0, 0); G8_SCHED; G8_LDA(At, 0, 0);
            if constexpr (GATHER) { if (last && has_next) S.aoff(nxt, tid, vA); }
            G8_WAIT_L(8); G8_BAR; G8_WAIT_L(0); G8_MMA(0, 0, At, B0); G8_BAR; G8_SCHED;
            G8_LDB(B1, 0, 1); G8_STAGE(G8_SB(0, 0), b2, voffB);
            G8_BAR; G8_WAIT_L(0); G8_MMA(0, 1, At, B1); G8_BAR;
            G8_LDA(At, 0, 1); G8_STAGEA(G8_SA(0, 0), a2, 0, k2);
            G8_BAR; G8_WAIT_L(0); G8_MMA(1, 0, At, B0); G8_BAR; G8_SCHED;
            G8_STAGE(G8_SB(0, 1), b2 + bhstep, voffB);
            const int pend = __builtin_amdgcn_readfirstlane((t == 0 && ui > 0) ? 1 : 0);
            asm volatile("s_cmp_lg_u32 %0, 0\n\ts_cbranch_scc1 1f\n\ts_waitcnt vmcnt(6)\n1:\n\ts_waitcnt vmcnt(%1)" :: "s"(pend), "n"(6 + (Epi::SPLIT ? Epi::NQ : Epi::NST)) : "memory", "scc");
            G8_BAR; G8_MMA(1, 1, At, B1); G8_BAR;
            G8_LDB(B0, 1, 0); G8_SCHED; G8_LDA(At, 1, 0); G8_STAGEA(G8_SA(0, 1), a2, 1, k2);
            G8_WAIT_L(8); G8_BAR; G8_WAIT_L(0); G8_MMA(0, 0, At, B0); G8_BAR; G8_SCHED;
            if constexpr (Epi::SPLIT) { E.template part_cond<0, 0>(acc, cur, wr, wc, fr, fq, lastf); G8_SCHED; }
            G8_LDB(B1, 1, 1); G8_STAGE(G8_SB(1, 0), b3, voffB);
            G8_BAR; G8_WAIT_L(0); G8_MMA(0, 1, At, B1); G8_BAR;
            if constexpr (Epi::SPLIT) { E.template part_cond<0, 1>(acc, cur, wr, wc, fr, fq, lastf); G8_SCHED; }
            G8_LDA(At, 1, 1); G8_STAGEA(G8_SA(1, 0), a2, 0, k3);
            G8_BAR; G8_WAIT_L(0); G8_MMA(1, 0, At, B0); G8_BAR; G8_SCHED;
            G8_STAGE(G8_SB(1, 1), b3 + bhstep, voffB);
            if constexpr (Epi::SPLIT) {
                asm volatile("s_cmp_lg_u32 %0, 0\n\ts_cbranch_scc1 1f\n\ts_waitcnt vmcnt(6)\n1:\n\ts_waitcnt vmcnt(%1)" :: "s"(lastf), "n"(6 + 2 * Epi::NQ) : "memory", "scc");
                G8_SCHED; E.template part_cond<1, 0>(acc, cur, wr, wc, fr, fq, lastf); G8_SCHED;
            } else G8_WAIT_V(6);
            G8_BAR; G8_MMA(1, 1, At, B1); G8_BAR;
            G8_STAGEA(G8_SA(1, 1), a2, 1, k3);
        }
        if constexpr (Epi::SPLIT) E.tail(acc, cur, wr, wc, fr, fq); else E(acc, cur, wr, wc, fr, fq);
        if (!has_next) break;
#pragma unroll
        for (int a = 0; a < 2; ++a)
#pragma unroll
            for (int b = 0; b < 2; ++b)
#pragma unroll
                for (int m = 0; m < 4; ++m)
#pragma unroll
                    for (int n = 0; n < 2; ++n) acc[a][b][m][n] = (f32x4){0.f, 0.f, 0.f, 0.f};
        cur = nxt; cA = nA; cB = nB; ++ui;
    }
    G8_WAIT_V(0);
    if (wr == 0) G8_BAR;
    G8_BAR;
#undef G8_SA
#undef G8_SB
#undef G8_STAGE
#undef G8_STAGEA
#undef G8_LDA
#undef G8_LDB
#undef G8_MMA
#undef G8_CAT
#undef G8_WAIT_V
#undef G8_WAIT_L
#undef G8_BAR
#undef G8_SCHED
}
}

__device__ __forceinline__ bool tile_map(int i, const Ctx& c, int ntm, int ntn, int& mt, int& nt) {
    const int vb = ((c.nblk & 15) == 0) ? ((c.bid >> 1) & 7) * (c.nblk >> 3) + (((c.bid >> 4) << 1) | (c.bid & 1)) : c.bid;
    const int L = i * c.nblk + vb;
    if (L >= ntm * ntn) return false;
    const int g = L / (8 * ntn), rem = L - g * 8 * ntn;
    const int gsz = (ntm - g * 8) < 8 ? (ntm - g * 8) : 8;
    mt = g * 8 + rem % gsz; nt = rem / gsz;
    return true;
}

__device__ __forceinline__ bool tile_map2(int i, const Ctx& c, int ntm, int ntn, int& mt, int& nt, bool& valid) {
    Ctx o = c; o.bid = c.bid ^ 1;
    int mo, no; const bool oko = tile_map(i, o, ntm, ntn, mo, no);
    valid = tile_map(i, c, ntm, ntn, mt, nt);
    if (!valid) { mt = 0; nt = 0; }
    return valid || oko;
}

struct DenseSched {
    int ntm, ntn, K, bid, nblk;
    __device__ __forceinline__ bool next(int i, g8::Unit& u) const {
        const int vb = ((nblk & 7) == 0) ? (bid & 7) * (nblk >> 3) + (bid >> 3) : bid;
        const int L = i * nblk + vb;
        if (L >= ntm * ntn) return false;
        const int g = L / (8 * ntn), rem = L - g * 8 * ntn;
        const int gsz = (ntm - g * 8) < 8 ? (ntm - g * 8) : 8;
        u.pm = g * 8 + rem % gsz; u.pn = rem / gsz; u.bt = u.pn;
        return true;
    }
};
struct MoeSched {
    int nrb, ntn, bid, nblk; const int* eb;
    __device__ __forceinline__ bool next(int i, g8::Unit& u) const {
        const int vb = ((nblk & 7) == 0) ? (bid & 7) * (nblk >> 3) + (bid >> 3) : bid;
        const int L = i * nblk + vb;
        if (L >= nrb * ntn) return false;
        const int g = L / (8 * ntn), rem = L - g * 8 * ntn;
        const int gsz = (nrb - g * 8) < 8 ? (nrb - g * 8) : 8;
        u.pm = g * 8 + rem % gsz; u.pn = rem / gsz;
        u.bt = __builtin_amdgcn_readfirstlane(eb[u.pm]) * ntn + u.pn;
        return true;
    }
};
struct MoeSchedG {
    int nrb, bid, nblk; const int* eb; const int* bst; const int* LTOK;
    __device__ __forceinline__ bool next(int i, g8::Unit& u) const {
        const int vb = ((nblk & 7) == 0) ? (bid & 7) * (nblk >> 3) + (bid >> 3) : bid;
        const int L = i * nblk + vb;
        if (L >= nrb * 2) return false;
        const int g = L >> 4, rem = L & 15;
        const int gsz = (nrb - g * 8) < 8 ? (nrb - g * 8) : 8;
        u.pm = g * 8 + rem % gsz; u.pn = rem / gsz;
        u.bt = __builtin_amdgcn_readfirstlane(eb[u.pm]) * 2 + u.pn;
        return true;
    }
    __device__ __forceinline__ void aoff(const g8::Unit& u, int tid, unsigned (&o)[4]) const {
        const int e = eb[u.pm], lb = u.pm - bst[e], cnt = bst[66 + e];
        int R0, C0, R1, C1; g8::stage_rc(tid * 16, R0, C0); g8::stage_rc(tid * 16 + 8192, R1, C1);
        const int* lt = LTOK + (size_t)e * CAP + lb * RBR;
        const int p00 = R0, p01 = R1, p10 = 128 + R0, p11 = 128 + R1;
        const int t00 = (lb * RBR + p00 < cnt) ? lt[p00] : 0, t01 = (lb * RBR + p01 < cnt) ? lt[p01] : 0;
        const int t10 = (lb * RBR + p10 < cnt) ? lt[p10] : 0, t11 = (lb * RBR + p11 < cnt) ? lt[p11] : 0;
        o[0] = (unsigned)t00 * 2048u + (unsigned)C0 * 2u; o[1] = (unsigned)t01 * 2048u + (unsigned)C1 * 2u;
        o[2] = (unsigned)t10 * 2048u + (unsigned)C0 * 2u; o[3] = (unsigned)t11 * 2048u + (unsigned)C1 * 2u;
    }
};
struct EpiMoe1 {
    static constexpr bool SPLIT = false; static constexpr int NQ = 2, NST = 8;
    bf16_t* H;
    __device__ __forceinline__ void operator()(const f32x4 (&acc)[2][2][4][2], const g8::Unit& u, int wr, int wc, int fr, int fq) const {
#pragma unroll
        for (int ai = 0; ai < 2; ++ai)
#pragma unroll
            for (int m = 0; m < 4; ++m) {
                const size_t row = (size_t)u.pm * RBR + ai * 128 + wr * 64 + m * 16 + fr;
                float h[8];
#pragma unroll
                for (int bj = 0; bj < 2; ++bj) {
                    const f32x4 g = acc[ai][bj][m][0], up = acc[ai][bj][m][1];
#pragma unroll
                    for (int j = 0; j < 4; ++j) h[bj * 4 + j] = g[j] * __builtin_amdgcn_rcpf(1.f + __expf(-g[j])) * up[j];
                }
                *(u32x4*)(H + row * 256 + u.pn * 128 + wc * 32 + fq * 8) = (u32x4){cvt_pk(h[0], h[1]), cvt_pk(h[2], h[3]), cvt_pk(h[4], h[5]), cvt_pk(h[6], h[7])};
            }
    }
    template <int ai, int bj> __device__ __forceinline__ void part_cond(const f32x4 (&acc)[2][2][4][2], const g8::Unit& u, int wr, int wc, int fr, int fq, int flag) const {}
    __device__ __forceinline__ void tail(const f32x4 (&acc)[2][2][4][2], const g8::Unit& u, int wr, int wc, int fr, int fq) const {}
};
struct EpiMoe1F8 {
    static constexpr bool SPLIT = false; static constexpr int NQ = 2, NST = 8;
    unsigned char* H;
    __device__ __forceinline__ void operator()(const f32x4 (&acc)[2][2][4][2], const g8::Unit& u, int wr, int wc, int fr, int fq) const {
#pragma unroll
        for (int ai = 0; ai < 2; ++ai)
#pragma unroll
            for (int m = 0; m < 4; ++m) {
                const size_t row = (size_t)u.pm * RBR + ai * 128 + wr * 64 + m * 16 + fr;
                u32x2 d;
#pragma unroll
                for (int bj = 0; bj < 2; ++bj) {
                    const f32x4 g = acc[ai][bj][m][0], up = acc[ai][bj][m][1];
                    float h[4];
#pragma unroll
                    for (int j = 0; j < 4; ++j) h[j] = g[j] * __builtin_amdgcn_rcpf(1.f + __expf(-g[j])) * up[j] * 2.f;
                    int w = __builtin_amdgcn_cvt_pk_fp8_f32(h[0], h[1], 0, false);
                    w = __builtin_amdgcn_cvt_pk_fp8_f32(h[2], h[3], w, true);
                    d[bj] = (unsigned)w;
                }
                *(u32x2*)(H + row * 256 + u.pn * 128 + wc * 32 + fq * 8) = d;
            }
    }
    template <int ai, int bj> __device__ __forceinline__ void part_cond(const f32x4 (&acc)[2][2][4][2], const g8::Unit& u, int wr, int wc, int fr, int fq, int flag) const {}
    __device__ __forceinline__ void tail(const f32x4 (&acc)[2][2][4][2], const g8::Unit& u, int wr, int wc, int fr, int fq) const {}
};
__device__ __forceinline__ u32x4 dpp_ror8(const u32x4 v) {
    u32x4 r;
#pragma unroll
    for (int i = 0; i < 4; ++i) r[i] = (unsigned)__builtin_amdgcn_update_dpp(0, (int)v[i], 0x128, 0xF, 0xF, true);
    return r;
}
template <bool NT = false>
__device__ __forceinline__ void perm_store(bf16_t* p  , size_t ld8  , const u32x4 p0, const u32x4 p1, int hi) {
    const u32x4 snd = hi ? p0 : p1, rcv = dpp_ror8(snd);
    if constexpr (NT) { __builtin_nontemporal_store(hi ? rcv : p0, (u32x4*)p); __builtin_nontemporal_store(hi ? p1 : rcv, (u32x4*)(p + ld8)); }
    else { *(u32x4*)p = hi ? rcv : p0; *(u32x4*)(p + ld8) = hi ? p1 : rcv; }
}
struct EpiIn {
    static constexpr bool SPLIT = false; static constexpr int NQ = 4, NST = 16;
    bf16_t* P; float* G; int gbase;
    template <int ai, int bj> __device__ __forceinline__ void part_cond(const f32x4 (&acc)[2][2][4][2], const g8::Unit& u, int wr, int wc, int fr, int fq, int flag) const {}
    __device__ __forceinline__ void tail(const f32x4 (&acc)[2][2][4][2], const g8::Unit& u, int wr, int wc, int fr, int fq) const {}
    __device__ __forceinline__ void operator()(const f32x4 (&acc)[2][2][4][2], const g8::Unit& u, int wr, int wc, int fr, int fq) const {
        const int hi = fr >> 3, r8 = fr & 7;
#pragma unroll
        for (int ai = 0; ai < 2; ++ai)
#pragma unroll
            for (int m = 0; m < 4; ++m) {
                const size_t rg = (size_t)u.pm * 256 + ai * 128 + wr * 64 + m * 16;
                u32x4 pk[2];
#pragma unroll
                for (int bj = 0; bj < 2; ++bj) {
                    const f32x4 v0 = acc[ai][bj][m][0], v1 = acc[ai][bj][m][1];
                    pk[bj] = (u32x4){cvt_pk(v0[0], v0[1]), cvt_pk(v0[2], v0[3]), cvt_pk(v1[0], v1[1]), cvt_pk(v1[2], v1[3])};
                    if (u.pn * 256 + wc * 64 + bj * 32 + fq * 8 == gbase) { *(f32x4*)(G + (rg + fr) * 8) = v0; *(f32x4*)(G + (rg + fr) * 8 + 4) = v1; }
                }
                perm_store(P + (rg + r8) * NPAD + u.pn * 256 + wc * 64 + hi * 32 + fq * 8, (size_t)8 * NPAD, pk[0], pk[1], hi);
            }
    }
};
struct EpiMoe2 {
    static constexpr bool SPLIT = false; static constexpr int NQ = 4, NST = 16;
    bf16_t* Y;
    template <int ai, int bj> __device__ __forceinline__ void part_cond(const f32x4 (&acc)[2][2][4][2], const g8::Unit& u, int wr, int wc, int fr, int fq, int flag) const {}
    __device__ __forceinline__ void tail(const f32x4 (&acc)[2][2][4][2], const g8::Unit& u, int wr, int wc, int fr, int fq) const {}
    __device__ __forceinline__ void operator()(const f32x4 (&acc)[2][2][4][2], const g8::Unit& u, int wr, int wc, int fr, int fq) const {
        const int hi = fr >> 3, r8 = fr & 7;
#pragma unroll
        for (int ai = 0; ai < 2; ++ai)
#pragma unroll
            for (int m = 0; m < 4; ++m) {
                const size_t rg = (size_t)u.pm * RBR + ai * 128 + wr * 64 + m * 16;
                u32x4 pk[2];
#pragma unroll
                for (int bj = 0; bj < 2; ++bj) {
                    const f32x4 v0 = acc[ai][bj][m][0], v1 = acc[ai][bj][m][1];
                    pk[bj] = (u32x4){cvt_pk(v0[0], v0[1]), cvt_pk(v0[2], v0[3]), cvt_pk(v1[0], v1[1]), cvt_pk(v1[2], v1[3])};
                }
                perm_store<true>(Y + (rg + r8) * 1024 + u.pn * 256 + wc * 64 + hi * 32 + fq * 8, (size_t)8 * 1024, pk[0], pk[1], hi);
            }
    }
};
struct EpiMoe2F8 {
    static constexpr bool SPLIT = false; static constexpr int NQ = 2, NST = 8;
    unsigned char* Y;
    template <int ai, int bj> __device__ __forceinline__ void part_cond(const f32x4 (&acc)[2][2][4][2], const g8::Unit& u, int wr, int wc, int fr, int fq, int flag) const {}
    __device__ __forceinline__ void tail(const f32x4 (&acc)[2][2][4][2], const g8::Unit& u, int wr, int wc, int fr, int fq) const {}
    __device__ __forceinline__ void operator()(const f32x4 (&acc)[2][2][4][2], const g8::Unit& u, int wr, int wc, int fr, int fq) const {
#pragma unroll
        for (int ai = 0; ai < 2; ++ai)
#pragma unroll
            for (int m = 0; m < 4; ++m) {
                const size_t row = (size_t)u.pm * RBR + ai * 128 + wr * 64 + m * 16 + fr;
                u32x4 d;
#pragma unroll
                for (int bj = 0; bj < 2; ++bj)
#pragma unroll
                    for (int n = 0; n < 2; ++n) {
#if MOE2_F8
                        const f32x4 v = acc[ai][bj][m][n];
#else
                        const f32x4 v = acc[ai][bj][m][n] * 16.f;
#endif
                        int w = __builtin_amdgcn_cvt_pk_fp8_f32(v[0], v[1], 0, false);
                        w = __builtin_amdgcn_cvt_pk_fp8_f32(v[2], v[3], w, true);
                        d[bj * 2 + n] = (unsigned)w;
                    }
                *(u32x4*)(Y + row * 1024 + u.pn * 256 + wc * 64 + fq * 16) = d;
            }
    }
};
struct EpiOut {
    static constexpr bool SPLIT = false; static constexpr int NQ = 8, NST = 32;
    template <int ai, int bj> __device__ __forceinline__ void part_cond(const f32x4 (&acc)[2][2][4][2], const g8::Unit& u, int wr, int wc, int fr, int fq, int flag) const {}
    __device__ __forceinline__ void tail(const f32x4 (&acc)[2][2][4][2], const g8::Unit& u, int wr, int wc, int fr, int fq) const {}
    const bf16_t* xres; bf16_t* Y;
    __device__ __forceinline__ void operator()(const f32x4 (&acc)[2][2][4][2], const g8::Unit& u, int wr, int wc, int fr, int fq) const {
        const int hi = fr >> 3, r8 = fr & 7;
#pragma unroll
        for (int ai = 0; ai < 2; ++ai)
#pragma unroll
            for (int m = 0; m < 4; ++m) {
                const size_t rg = (size_t)u.pm * 256 + ai * 128 + wr * 64 + m * 16;
                u32x4 pk[2];
#pragma unroll
                for (int bj = 0; bj < 2; ++bj) {
                    const u32x4 xr = *(const u32x4*)(xres + (rg + fr) * 1024 + u.pn * 256 + wc * 64 + bj * 32 + fq * 8);
                    float f[8]; unpack8(xr, f);
                    const f32x4 v0 = acc[ai][bj][m][0], v1 = acc[ai][bj][m][1];
                    pk[bj] = (u32x4){cvt_pk(f[0] * ALPHA + v0[0], f[1] * ALPHA + v0[1]), cvt_pk(f[2] * ALPHA + v0[2], f[3] * ALPHA + v0[3]),
                                     cvt_pk(f[4] * ALPHA + v1[0], f[5] * ALPHA + v1[1]), cvt_pk(f[6] * ALPHA + v1[2], f[7] * ALPHA + v1[3])};
                }
                perm_store(Y + (rg + r8) * 1024 + u.pn * 256 + wc * 64 + hi * 32 + fq * 8, (size_t)8 * 1024, pk[0], pk[1], hi);
                asm volatile("" ::: "memory");
            }
    }
};

constexpr int TS_RS = 272;
__device__ __forceinline__ void tile_put(const Ctx& c, int row_l, int col_l, const u32x2 v) { *(u32x2*)(c.smem + row_l * TS_RS + col_l * 2) = v; }
template <int NCOL>
__device__ __forceinline__ void tile_flush(const Ctx& c, bf16_t* out, size_t ld, bool valid) {
    __syncthreads();
    constexpr int CPR = NCOL / 8, PER = (128 * CPR) / 256;
#pragma unroll
    for (int i = 0; i < PER; ++i) {
        const int idx = c.tid + 256 * i, row = idx / CPR, ch = idx % CPR;
        const u32x4 v = *(const u32x4*)(c.smem + row * TS_RS + ch * 16);
        if (valid) *(u32x4*)(out + (size_t)row * ld + ch * 8) = v;
    }
    __syncthreads();
}

__device__ __forceinline__ void conv_family(const float* src, int nmat, size_t src_stride, int K, int N, int Nout,
                            bf16_t* dst, size_t dst_stride, int grp, int kind, const Ctx& c) {
    float* lds = (float*)c.smem;
    const int tk = K / 128, tn = Nout / 64, per = tk * tn, total = nmat * per;
    const int tx = c.tid & 15, ty = c.tid >> 4;
    f32x4 r[8];
#define CV_LOAD(u_) do { const int mat_ = (u_) / per, r_ = (u_) - mat_ * per, kt_ = r_ / tn, nt_ = r_ - kt_ * tn; \
        const float* s_ = src + (size_t)mat_ * src_stride + (size_t)(kt_ * 128 + ty) * N + nt_ * 64 + tx * 4; const bool in_ = (nt_ * 64 + tx * 4) < N; \
        _Pragma("unroll") for (int i = 0; i < 8; ++i) r[i] = in_ ? __builtin_nontemporal_load((const f32x4*)(s_ + (size_t)(16 * i) * N)) : (f32x4){0.f, 0.f, 0.f, 0.f}; } while (0)
    if (c.bid < total) CV_LOAD(c.bid);
    for (int base = 0; base < total; base += c.nblk) {
        const int u = base + c.bid; const bool valid = u < total;
#pragma unroll
        for (int i = 0; i < 8; ++i) *(f32x4*)(lds + (ty + 16 * i) * 68 + tx * 4) = r[i];
        if (u + c.nblk < total) CV_LOAD(u + c.nblk);
        __syncthreads();
        if (valid) {
        const int mat = u / per, rr = u - mat * per, kt = rr / tn, nt = rr - kt * tn;
        const int dmat = grp ? (mat / grp) * (grp + 1) + (mat % grp) : mat;
        bf16_t* d = dst + (size_t)dmat * dst_stride;
        const int nl = c.tid & 63, kq = (c.tid >> 6) * 32;
        if (kind == 3) {
            unsigned char* d8 = (unsigned char*)dst + (size_t)dmat * dst_stride;
            unsigned w8[8];
#pragma unroll
            for (int j = 0; j < 8; ++j) {
                int w_ = __builtin_amdgcn_cvt_pk_fp8_f32(lds[(kq + 4 * j) * 68 + nl] * 8.f, lds[(kq + 4 * j + 1) * 68 + nl] * 8.f, 0, false);
                w_ = __builtin_amdgcn_cvt_pk_fp8_f32(lds[(kq + 4 * j + 2) * 68 + nl] * 8.f, lds[(kq + 4 * j + 3) * 68 + nl] * 8.f, w_, true);
                w8[j] = (unsigned)w_;
            }
            u32x4* dp8 = (u32x4*)(d8 + (size_t)(nt * 64 + nl) * K + kt * 128 + kq);
            dp8[0] = (u32x4){w8[0], w8[1], w8[2], w8[3]}; dp8[1] = (u32x4){w8[4], w8[5], w8[6], w8[7]};
        } else {
        unsigned w[16];
#pragma unroll
        for (int j = 0; j < 16; ++j) w[j] = pk2(lds[(kq + 2 * j) * 68 + nl], lds[(kq + 2 * j + 1) * 68 + nl]);
        const int n = nt * 64 + nl;
        const int drow = (kind == 0) ? n : ((n >> 4) * 32 + (n & 15) + (kind == 2 ? 16 : 0));
        u32x4* dp = (u32x4*)(d + (size_t)drow * K + kt * 128 + kq);
        dp[0] = (u32x4){w[0], w[1], w[2], w[3]}; dp[1] = (u32x4){w[4], w[5], w[6], w[7]};
        dp[2] = (u32x4){w[8], w[9], w[10], w[11]}; dp[3] = (u32x4){w[12], w[13], w[14], w[15]};
        }
        }
        __syncthreads();
    }
#undef CV_LOAD
}

__device__ __forceinline__ void phase_prologue(const Args& a, const Ctx& c) {
    unsigned char* ws = a.ws;
    bf16_t* WIN = (bf16_t*)(ws + WS_WIN);
    conv_family((const float*)a.in[2], 2, (size_t)1024 * 2472, 1024, 2472, NPAD, WIN, 2 * WIN_ELEMS, 0, 0, c);
    conv_family((const float*)a.in[12], 2, (size_t)1024 * 2312, 1024, 2312, NPAD, WIN + WIN_ELEMS, 2 * WIN_ELEMS, 0, 0, c);
    conv_family((const float*)a.in[4], 2, (size_t)256 * 768, 256, 768, 768, (bf16_t*)(ws + WS_WQB), WQB_ELEMS, 0, 0, c);
    conv_family((const float*)a.in[6], 2, (size_t)128 * 1024, 128, 1024, 1024, (bf16_t*)(ws + WS_WKVB), WKVB_ELEMS, 0, 0, c);
    bf16_t* WOUT = (bf16_t*)(ws + WS_WOUT);
    conv_family((const float*)a.in[11], 2, (size_t)1024 * 1024, 1024, 1024, 1024, WOUT, 2 * WOUT_ELEMS, 0, 0, c);
    conv_family((const float*)a.in[17], 2, (size_t)1024 * 1024, 1024, 1024, 1024, WOUT + WOUT_ELEMS, 2 * WOUT_ELEMS, 0, 0, c);
    conv_family((const float*)a.in[20], 4, (size_t)1024 * 64, 1024, 64, 128, (bf16_t*)(ws + WS_WRT), WRT_ELEMS, 0, 0, c);
    bf16_t* WGU = (bf16_t*)(ws + WS_WGU);
    conv_family((const float*)a.in[22], 256, (size_t)1024 * 256, 1024, 256, 256, WGU, WGU_ELEMS, 64, 1, c);
    conv_family((const float*)a.in[23], 256, (size_t)1024 * 256, 1024, 256, 256, WGU, WGU_ELEMS, 64, 2, c);
    conv_family((const float*)a.in[25], 4, (size_t)1024 * 256, 1024, 256, 256, WGU + 64 * WGU_ELEMS, 65 * WGU_ELEMS, 0, 1, c);
    conv_family((const float*)a.in[26], 4, (size_t)1024 * 256, 1024, 256, 256, WGU + 64 * WGU_ELEMS, 65 * WGU_ELEMS, 0, 2, c);
    bf16_t* WDN = (bf16_t*)(ws + WS_WDN);
#if MOE2_F8
    conv_family((const float*)a.in[24], 256, (size_t)256 * 1024, 256, 1024, 1024, WDN, WDN_ELEMS, 64, 3, c);
    conv_family((const float*)a.in[27], 4, (size_t)256 * 1024, 256, 1024, 1024, (bf16_t*)((unsigned char*)WDN + 64 * WDN_ELEMS), 65 * WDN_ELEMS, 0, 3, c);
#else
    conv_family((const float*)a.in[24], 256, (size_t)256 * 1024, 256, 1024, 1024, WDN, WDN_ELEMS, 64, 0, c);
    conv_family((const float*)a.in[27], 4, (size_t)256 * 1024, 256, 1024, 1024, WDN + 64 * WDN_ELEMS, 65 * WDN_ELEMS, 0, 0, c);
#endif
    {
        const float* x = (const float*)a.in[0]; bf16_t* xb = (bf16_t*)(ws + WS_XBF);
        const size_t n8 = (size_t)T * 1024 / 8;
        for (size_t i = (size_t)c.bid * 256 + c.tid; i < n8; i += (size_t)c.nblk * 256) {
            const f32x4 v0 = __builtin_nontemporal_load((const f32x4*)(x + i * 8)), v1 = __builtin_nontemporal_load((const f32x4*)(x + i * 8 + 4));
            *(u32x4*)(xb + i * 8) = (u32x4){pk2(v0[0], v0[1]), pk2(v0[2], v0[3]), pk2(v1[0], v1[1]), pk2(v1[2], v1[3])};
        }
    }
    {
        const int* pos = (const int*)a.in[1];
        float* rm = (float*)(ws + WS_ROPEM); float* rs = (float*)(ws + WS_ROPES);
        const float ln_theta = 9.210340371976184f;
        for (int i = c.bid * 256 + c.tid; i < T * 16; i += c.nblk * 256) {
            const int t = i >> 4, f = i & 15;
            const float inv = expf(-((float)(2 * f) / 32.f) * ln_theta);
            const float ang = (float)pos[t] * inv;
            rm[i * 2] = cosf(ang); rm[i * 2 + 1] = sinf(ang);
        }
        for (int i = c.bid * 256 + c.tid; i < T * 32; i += c.nblk * 256) {
            const int t = i >> 5, f = i & 31;
            const float inv = expf(-((float)(2 * f) / 64.f) * ln_theta);
            const float ang = (float)pos[t] * inv;
            rs[i * 2] = cosf(ang); rs[i * 2 + 1] = sinf(ang);
        }
    }
}

__device__ __forceinline__ void phase_inproj(const bf16_t* XBF, const bf16_t* W, bf16_t* PROJ, float* GATES, int gbase, const Ctx& c) {
    const int ntn = NPAD / 128;
    for (int i = 0;; ++i) {
        int mt, nt; bool valid; if (!tile_map2(i, c, T / 128, ntn, mt, nt, valid)) break;
        const bf16_t* a0 = XBF + (size_t)(mt * 128 + (c.tid >> 2)) * 1024;
        const bf16_t* b0 = W + (size_t)(nt * 128 + (c.tid >> 2)) * 1024;
        f32x4 acc[4][4];
        gemm_tile(a0, a0 + 64 * 1024, b0, b0 + 64 * 1024, 32, acc, c);
#pragma unroll
        for (int m = 0; m < 4; ++m) {
            const int rl = c.wr * 64 + m * 16 + c.fr, row = mt * 128 + rl;
#pragma unroll
            for (int n = 0; n < 4; ++n) {
                const int cl = c.wc * 64 + n * 16 + c.fq * 4, col = nt * 128 + cl;
                const f32x4 v = acc[m][n];
                tile_put(c, rl, cl, (u32x2){pk2(v[0], v[1]), pk2(v[2], v[3])});
                if (valid && col >= gbase && col < gbase + 8) *(f32x4*)(GATES + (size_t)row * 8 + (col - gbase)) = v;
            }
        }
        tile_flush<128>(c, PROJ + (size_t)mt * 128 * NPAD + nt * 128, NPAD, valid);
    }
}

constexpr int MLAUP_TILES = (T / 128) * 6 + (T / 128) * 8;
__device__ __forceinline__ void mla_up_tile(int u, const bf16_t* CQ, const bf16_t* WQB, const bf16_t* CKV, const bf16_t* WKVB,
                             const float* ROPEM, bf16_t* QF, bf16_t* KN, bf16_t* VV, const Ctx& c) {
    const int tq = (T / 128) * 6;
    const float qscale = 0.10206207261596577f * 1.4426950408889634f;
    {
        f32x4 acc[4][4];
        if (u < tq) {
            const int mt = u / 6, nt = u % 6;
            const bf16_t* a0 = CQ + (size_t)(mt * 128 + (c.tid >> 2)) * 256;
            const bf16_t* b0 = WQB + (size_t)(nt * 128 + (c.tid >> 2)) * 256;
            gemm_tile(a0, a0 + 64 * 256, b0, b0 + 64 * 256, 8, acc, c);
#pragma unroll
            for (int m = 0; m < 4; ++m) {
                const int row = mt * 128 + c.wr * 64 + m * 16 + c.fr;
#pragma unroll
                for (int np = 0; np < 2; ++np) {
                    const int cg = nt * 128 + c.wc * 64 + np * 32;
                    f32x4 v0 = acc[m][2 * np], v1 = acc[m][2 * np + 1];
                    if (((cg >> 5) % 3) == 2) {
#pragma unroll
                        for (int j = 0; j < 4; ++j) {
                            const int i = c.fq * 4 + j;
                            const float cs = ROPEM[((size_t)row * 16 + i) * 2], sn = ROPEM[((size_t)row * 16 + i) * 2 + 1];
                            const float x1 = v0[j], x2 = v1[j];
                            v0[j] = x1 * cs - x2 * sn; v1[j] = x2 * cs + x1 * sn;
                        }
                    }
                    v0 *= qscale; v1 *= qscale;
                    *(u32x2*)(QF + (size_t)row * 768 + cg + c.fq * 4) = (u32x2){pk2(v0[0], v0[1]), pk2(v0[2], v0[3])};
                    *(u32x2*)(QF + (size_t)row * 768 + cg + 16 + c.fq * 4) = (u32x2){pk2(v1[0], v1[1]), pk2(v1[2], v1[3])};
                }
            }
        } else {
            const int v = u - tq, mt = v / 8, nt = v % 8;
            const bf16_t* a0 = CKV + (size_t)(mt * 128 + (c.tid >> 2)) * 128;
            const bf16_t* b0 = WKVB + (size_t)(nt * 128 + (c.tid >> 2)) * 128;
            gemm_tile(a0, a0 + 64 * 128, b0, b0 + 64 * 128, 4, acc, c);
            bf16_t* dst = (c.wc == 0) ? KN : VV;
#pragma unroll
            for (int m = 0; m < 4; ++m) {
                const int row = mt * 128 + c.wr * 64 + m * 16 + c.fr;
#pragma unroll
                for (int n = 0; n < 4; ++n) {
                    const f32x4 x = acc[m][n];
                    *(u32x2*)(dst + (size_t)row * 512 + nt * 64 + n * 16 + c.fq * 4) = (u32x2){pk2(x[0], x[1]), pk2(x[2], x[3])};
                }
            }
        }
    }
}

__device__ __forceinline__ void phase_outproj(const bf16_t* MIXO, const bf16_t* W, const float* xres, float* YBUF, const Ctx& c) {
    for (int i = 0;; ++i) {
        int mt, nt; bool valid; if (!tile_map2(i, c, T / 128, 8, mt, nt, valid)) break;
        const bf16_t* a0 = MIXO + (size_t)(mt * 128 + (c.tid >> 2)) * 1024;
        const bf16_t* b0 = W + (size_t)(nt * 128 + (c.tid >> 2)) * 1024;
        f32x4 acc[4][4];
        gemm_tile(a0, a0 + 64 * 1024, b0, b0 + 64 * 1024, 32, acc, c);
#pragma unroll
        for (int m = 0; m < 4; ++m) {
            const int row = mt * 128 + c.wr * 64 + m * 16 + c.fr;
#pragma unroll
            for (int n = 0; n < 4; ++n) {
                const int col = nt * 128 + c.wc * 64 + n * 16 + c.fq * 4;
                const f32x4 xr = *(const f32x4*)(xres + (size_t)row * 1024 + col);
                if (valid) *(f32x4*)(YBUF + (size_t)row * 1024 + col) = xr * ALPHA + acc[m][n];
            }
        }
    }
}

__device__ __forceinline__ void phase_router(const bf16_t* XBF, const bf16_t* W, float* LOG, const Ctx& c) {
    for (int base = 0; base < T / 128; base += c.nblk) {
        const bool valid = (base + c.bid) < T / 128; const int mt = valid ? base + c.bid : 0;
        const bf16_t* a0 = XBF + (size_t)(mt * 128 + (c.tid >> 2)) * 1024;
        const bf16_t* b0 = W + (size_t)(c.tid >> 2) * 1024;
        f32x4 acc[4][4];
        gemm_tile(a0, a0 + 64 * 1024, b0, b0 + 64 * 1024, 32, acc, c);
        if (c.wc == 0 && valid) {
#pragma unroll
            for (int m = 0; m < 4; ++m) {
                const int row = mt * 128 + c.wr * 64 + m * 16 + c.fr;
#pragma unroll
                for (int n = 0; n < 4; ++n) *(f32x4*)(LOG + (size_t)row * 64 + n * 16 + c.fq * 4) = acc[m][n];
            }
        }
    }
}

__device__ __forceinline__ void build_block_table(const unsigned* CNT, int* bst, const Ctx& c) {
    __syncthreads();
    if (c.wid == 0) {
        const int cnt = (int)__hip_atomic_load(CNT + c.lane, __ATOMIC_RELAXED, __HIP_MEMORY_SCOPE_AGENT);
        const int nb = (cnt + RBR - 1) / RBR;
        int inc = nb;
#pragma unroll
        for (int o = 1; o < 64; o <<= 1) { const int x = shfl_up_(inc, o); if (c.lane >= o) inc += x; }
        bst[c.lane] = inc - nb; bst[66 + c.lane] = cnt;
        if (c.lane == 63) { bst[64] = inc; bst[65] = inc + T / RBR; bst[66 + 64] = T; }
    }
    __syncthreads();
}
__device__ __forceinline__ int find_expert(const int* bst, int rb, const Ctx& c) {
    return __popcll(__ballot(bst[1 + c.lane] <= rb));
}

__device__ __forceinline__ void phase_moe1(const bf16_t* XBF, const bf16_t* WGU, const unsigned* CNT, const int* LTOK, const float* LW, bf16_t* HBUF, const Ctx& c) {
    int* bst = (int*)(c.smem + 65536 + 64);
    build_block_table(CNT, bst, c);
    const int nsb = bst[65] * 2;
    for (int i = 0;; ++i) {
        int sbk, nt; bool valid; if (!tile_map2(i, c, nsb, 4, sbk, nt, valid)) break;
        const int rb = sbk >> 1, hb = sbk & 1;
        const int e = find_expert(bst, rb, c);
        const int lb = rb - bst[e], cnt = bst[66 + e];
        const int p0 = lb * RBR + hb * 128 + (c.tid >> 2), p1 = p0 + 64;
        const int t0 = (p0 < cnt) ? LTOK[(size_t)e * CAP + p0] : 0;
        const int t1 = (p1 < cnt) ? LTOK[(size_t)e * CAP + p1] : 0;
        const bf16_t* a0 = XBF + (size_t)t0 * 1024;
        const bf16_t* a1 = XBF + (size_t)t1 * 1024;
        const bf16_t* b0 = WGU + (size_t)e * WGU_ELEMS + (size_t)(nt * 128 + (c.tid >> 2)) * 1024;
        f32x4 acc[4][4];
        gemm_tile(a0, a1, b0, b0 + 64 * 1024, 32, acc, c);
#pragma unroll
        for (int m = 0; m < 4; ++m) {
            const int rl = c.wr * 64 + m * 16 + c.fr;
            const int pw = lb * RBR + hb * 128 + rl;
            const float wrow = (pw < cnt) ? LW[(size_t)e * CAP + pw] : 0.f;
#pragma unroll
            for (int n = 0; n < 2; ++n) {
                const f32x4 g = acc[m][n], up = acc[m][n + 2];
                float h[4];
#pragma unroll
                for (int j = 0; j < 4; ++j) h[j] = siluf_(g[j]) * up[j] * wrow;
                tile_put(c, rl, c.wc * 32 + n * 16 + c.fq * 4, (u32x2){pk2(h[0], h[1]), pk2(h[2], h[3])});
            }
        }
        tile_flush<64>(c, HBUF + ((size_t)rb * RBR + hb * 128) * 256 + nt * 64, 256, valid);
    }
}

__device__ __forceinline__ void phase_moe2(const bf16_t* HBUF, const bf16_t* WDN, const unsigned* CNT, bf16_t* Y, const Ctx& c) {
    int* bst = (int*)(c.smem + 65536 + 64);
    build_block_table(CNT, bst, c);
    const int nsb = bst[65] * 2;
    for (int i = 0;; ++i) {
        int sbk, nt; bool valid; if (!tile_map2(i, c, nsb, 8, sbk, nt, valid)) break;
        const int rb = sbk >> 1;
        const int e = find_expert(bst, rb, c);
        const bf16_t* a0 = HBUF + ((size_t)sbk * 128 + (c.tid >> 2)) * 256;
        const bf16_t* b0 = WDN + (size_t)e * WDN_ELEMS + (size_t)(nt * 128 + (c.tid >> 2)) * 256;
        f32x4 acc[4][4];
        gemm_tile(a0, a0 + 64 * 256, b0, b0 + 64 * 256, 8, acc, c);
#pragma unroll
        for (int m = 0; m < 4; ++m) {
            const int lr = c.wr * 64 + m * 16 + c.fr;
#pragma unroll
            for (int n = 0; n < 4; ++n) {
                const f32x4 v = acc[m][n];
                tile_put(c, lr, c.wc * 64 + n * 16 + c.fq * 4, (u32x2){pk2(v[0], v[1]), pk2(v[2], v[3])});
            }
        }
        tile_flush<128>(c, Y + (size_t)sbk * 128 * 1024 + nt * 128, 1024, valid);
    }
}

__device__ __forceinline__ float dppf(float v, int ctrl_sel) {
    int x = __builtin_bit_cast(int, v), r;
    if (ctrl_sel == 0) r = __builtin_amdgcn_update_dpp(0, x, 0xB1, 0xF, 0xF, true);
    else if (ctrl_sel == 1) r = __builtin_amdgcn_update_dpp(0, x, 0x4E, 0xF, 0xF, true);
    else if (ctrl_sel == 2) r = __builtin_amdgcn_update_dpp(0, x, 0x141, 0xF, 0xF, true);
    else r = __builtin_amdgcn_update_dpp(0, x, 0x140, 0xF, 0xF, true);
    return __builtin_bit_cast(float, r);
}
__device__ __forceinline__ float red16(float v) { v += dppf(v, 0); v += dppf(v, 1); v += dppf(v, 2); v += dppf(v, 3); return v; }

template <bool F32OUT>
__device__ __forceinline__ void ln_row_store(float (&v)[16], const float* g, const float* b, float* of32, bf16_t* obf, int lane) {
    float s = 0.f;
#pragma unroll
    for (int i = 0; i < 16; ++i) s += v[i];
    const float mean = wave_sum(s) * (1.f / 1024.f);
    float q = 0.f;
#pragma unroll
    for (int i = 0; i < 16; ++i) { v[i] -= mean; q += v[i] * v[i]; }
    const float rstd = rsqrtf(wave_sum(q) * (1.f / 1024.f) + 1e-5f);
#pragma unroll
    for (int hf = 0; hf < 2; ++hf) {
        const int col = hf * 512 + lane * 8;
        const f32x4 g0 = *(const f32x4*)(g + col), g1 = *(const f32x4*)(g + col + 4);
        const f32x4 b0 = *(const f32x4*)(b + col), b1 = *(const f32x4*)(b + col + 4);
        f32x4 y0, y1;
#pragma unroll
        for (int j = 0; j < 4; ++j) { y0[j] = v[hf * 8 + j] * rstd * g0[j] + b0[j]; y1[j] = v[hf * 8 + 4 + j] * rstd * g1[j] + b1[j]; }
        if constexpr (F32OUT) { *(f32x4*)(of32 + col) = y0; *(f32x4*)(of32 + col + 4) = y1; }
        *(u32x4*)(obf + col) = (u32x4){pk2(y0[0], y0[1]), pk2(y0[2], y0[3]), pk2(y1[0], y1[1]), pk2(y1[2], y1[3])};
    }
}

__device__ __forceinline__ void phase_ln1(const bf16_t* YBUF, const float* g, const float* b, bf16_t* XBF, const Ctx& c) {
    for (int t = c.bid * 4 + c.wid; t < T; t += c.nblk * 4) {
        float v[16];
#pragma unroll
        for (int hf = 0; hf < 2; ++hf) {
            const u32x4 r = *(const u32x4*)(YBUF + (size_t)t * 1024 + hf * 512 + c.lane * 8);
            float f[8]; unpack8(r, f);
#pragma unroll
            for (int j = 0; j < 8; ++j) v[hf * 8 + j] = f[j];
        }
        ln_row_store<false>(v, g, b, nullptr, XBF + (size_t)t * 1024, c.lane);
    }
}

template <bool LASTL>
__device__ __forceinline__ void phase_combine8(const unsigned char* Y, const int* ASG, const float* ASGW, const unsigned* CNT, const float* g, const float* b,
                                               float* XOUT, bf16_t* XBF, const Ctx& c) {
    int* bst = (int*)(c.smem + 65536 + 64);
    build_block_table(CNT, bst, c);
    const int lane = c.lane;
    for (int t = c.bid * 4 + c.wid; t < T; t += c.nblk * 4) {
        float v[16];
        {
            const u32x4 r0 = *(const u32x4*)(XBF + (size_t)t * 1024 + lane * 16), r1 = *(const u32x4*)(XBF + (size_t)t * 1024 + lane * 16 + 8);
            float f[8]; unpack8(r0, f);
#pragma unroll
            for (int j = 0; j < 8; ++j) v[j] = f[j] * ALPHA;
            unpack8(r1, f);
#pragma unroll
            for (int j = 0; j < 8; ++j) v[8 + j] = f[j] * ALPHA;
        }
        u32x4 yr[9]; float wk[9];
#pragma unroll
        for (int k = 0; k < 9; ++k) {
            size_t crow; wk[k] = 1.f / 16.f;
            if (k < 8) { const int asg = ASG[(size_t)t * 8 + k]; crow = (size_t)bst[asg >> 16] * RBR + (asg & 0xffff); wk[k] = ASGW[(size_t)t * 8 + k] * (1.f / 16.f); }
            else crow = (size_t)bst[64] * RBR + t;
            yr[k] = *(const u32x4*)(Y + crow * 1024 + lane * 16);
        }
#pragma unroll
        for (int k = 0; k < 9; ++k)
#pragma unroll
            for (int q = 0; q < 4; ++q) {
                const f32x2 lo = __builtin_amdgcn_cvt_pk_f32_fp8((int)yr[k][q], false), hi = __builtin_amdgcn_cvt_pk_f32_fp8((int)yr[k][q], true);
                v[q * 4 + 0] += lo[0] * wk[k]; v[q * 4 + 1] += lo[1] * wk[k]; v[q * 4 + 2] += hi[0] * wk[k]; v[q * 4 + 3] += hi[1] * wk[k];
            }
        float s = 0.f;
#pragma unroll
        for (int i = 0; i < 16; ++i) s += v[i];
        const float mean = wave_sum(s) * (1.f / 1024.f);
        float q2 = 0.f;
#pragma unroll
        for (int i = 0; i < 16; ++i) { v[i] -= mean; q2 += v[i] * v[i]; }
        const float rstd = rsqrtf(wave_sum(q2) * (1.f / 1024.f) + 1e-5f);
        float y[16];
#pragma unroll
        for (int q = 0; q < 4; ++q) {
            const f32x4 gg = *(const f32x4*)(g + lane * 16 + q * 4), bb = *(const f32x4*)(b + lane * 16 + q * 4);
#pragma unroll
            for (int j = 0; j < 4; ++j) y[q * 4 + j] = v[q * 4 + j] * rstd * gg[j] + bb[j];
            if constexpr (LASTL) *(f32x4*)(XOUT + (size_t)t * 1024 + lane * 16 + q * 4) = (f32x4){y[q * 4], y[q * 4 + 1], y[q * 4 + 2], y[q * 4 + 3]};
        }
        *(u32x4*)(XBF + (size_t)t * 1024 + lane * 16) = (u32x4){pk2(y[0], y[1]), pk2(y[2], y[3]), pk2(y[4], y[5]), pk2(y[6], y[7])};
        *(u32x4*)(XBF + (size_t)t * 1024 + lane * 16 + 8) = (u32x4){pk2(y[8], y[9]), pk2(y[10], y[11]), pk2(y[12], y[13]), pk2(y[14], y[15])};
    }
}

template <bool LASTL>
__device__ __forceinline__ void phase_combine(const bf16_t* Y, const int* ASG, const float* ASGW, const unsigned* CNT, const float* g, const float* b,
                              float* XOUT, bf16_t* XBF, const Ctx& c) {
    int* bst = (int*)(c.smem + 65536 + 64);
    build_block_table(CNT, bst, c);
    for (int t = c.bid * 4 + c.wid; t < T; t += c.nblk * 4) {
        float v[16];
#pragma unroll
        for (int hf = 0; hf < 2; ++hf) {
            const u32x4 r = *(const u32x4*)(XBF + (size_t)t * 1024 + hf * 512 + c.lane * 8);
            float f[8]; unpack8(r, f);
#pragma unroll
            for (int j = 0; j < 8; ++j) v[hf * 8 + j] = f[j] * ALPHA;
        }
#pragma unroll
        for (int k = 0; k < 9; ++k) {
            size_t crow; float wk = 1.f;
            if (k < 8) { const int asg = ASG[(size_t)t * 8 + k]; crow = (size_t)bst[asg >> 16] * RBR + (asg & 0xffff); wk = ASGW[(size_t)t * 8 + k]; }
            else crow = (size_t)bst[64] * RBR + t;
#pragma unroll
            for (int hf = 0; hf < 2; ++hf) {
                const u32x4 r = *(const u32x4*)(Y + crow * 1024 + hf * 512 + c.lane * 8);
                float f[8]; unpack8(r, f);
#pragma unroll
                for (int j = 0; j < 8; ++j) v[hf * 8 + j] += f[j] * wk;
            }
        }
        ln_row_store<LASTL>(v, g, b, XOUT + (size_t)t * 1024, XBF + (size_t)t * 1024, c.lane);
    }
}

__device__ __forceinline__ void phase_route(const float* LOG, const float* rb, unsigned* CNT, int* LTOK, float* LW, int* ASG, float* ASGW, const Ctx& c) {
    int* lcnt = (int*)c.smem;
    int* lbase = lcnt + 64;
    int* sel_e = lbase + 64;
    int* sel_p = sel_e + 256;
    float* sel_w = (float*)(sel_p + 256);
    const float rbias = rb[c.lane];
    for (int base = 0; base < T / 32; base += c.nblk) {
        const int ch = base + c.bid; const bool valid = ch < T / 32;
        __syncthreads();
        if (c.tid < 64) lcnt[c.tid] = 0;
        __syncthreads();
        if (valid) for (int tl = c.wid; tl < 32; tl += 4) {
            const int t = ch * 32 + tl;
            const float lg = LOG[(size_t)t * 64 + c.lane];
            const float sc = 1.f / (1.f + expf(-lg));
            const float v = sc + rbias;
            float m1 = v;
            m1 = fmaxf(m1, shfl_xor_(m1, 1)); m1 = fmaxf(m1, shfl_xor_(m1, 2)); m1 = fmaxf(m1, shfl_xor_(m1, 4));
            int cand = (v == m1) ? c.lane : 999;
            cand = min(cand, shfl_xor_(cand, 1)); cand = min(cand, shfl_xor_(cand, 2)); cand = min(cand, shfl_xor_(cand, 4));
            float m2 = (c.lane == cand) ? -INFINITY : v;
            m2 = fmaxf(m2, shfl_xor_(m2, 1)); m2 = fmaxf(m2, shfl_xor_(m2, 2)); m2 = fmaxf(m2, shfl_xor_(m2, 4));
            const float gs = m1 + m2;
            const int g = c.lane >> 3;
            int grank = 0;
#pragma unroll
            for (int gg = 0; gg < 8; ++gg) { const float o = shfl_c_(gs, gg * 8); grank += ((o > gs) || (o == gs && gg < g)) ? 1 : 0; }
            const bool gsel = grank < 4;
            const float mv = gsel ? v : -INFINITY;
            int rank = 0;
#pragma unroll 8
            for (int jj = 0; jj < 64; ++jj) { const float o = shfl_c_(mv, jj); rank += ((o > mv) || (o == mv && jj < c.lane)) ? 1 : 0; }
            const bool sel = gsel && rank < 8;
            const float ssum = wave_sum(sel ? sc : 0.f);
            const float w = sc / ssum * 2.5f;
            const unsigned long long bal = __ballot(sel);
            const int slot = __popcll(bal & ((1ull << c.lane) - 1ull));
            if (sel) {
                const int p = atomicAdd(&lcnt[c.lane], 1);
                sel_e[tl * 8 + slot] = c.lane; sel_p[tl * 8 + slot] = p; sel_w[tl * 8 + slot] = w;
            }
        }
        __syncthreads();
        if (valid && c.tid < 64) { const int n = lcnt[c.tid]; lbase[c.tid] = n ? (int)atomicAdd(CNT + c.tid, (unsigned)n) : 0; }
        __syncthreads();
        if (valid) {
            const int tl = c.tid >> 3, t = ch * 32 + tl;
            const int e = sel_e[c.tid], pos = lbase[e] + sel_p[c.tid];
            LTOK[(size_t)e * CAP + pos] = t; LW[(size_t)e * CAP + pos] = sel_w[c.tid];
            ASG[(size_t)t * 8 + (c.tid & 7)] = (e << 16) | pos; ASGW[(size_t)t * 8 + (c.tid & 7)] = sel_w[c.tid];
            if (c.tid < 32) { const int ts = ch * 32 + c.tid; LTOK[(size_t)64 * CAP + ts] = ts; LW[(size_t)64 * CAP + ts] = 1.f; }
        }
    }
}

__device__ __forceinline__ void phase_lnroute(const bf16_t* YBUF, const float* g, const float* b, bf16_t* XBF, const bf16_t* W, const float* rb,
                                              unsigned* CNT, int* LTOK, float* LW, int* ASG, float* ASGW, const Ctx& c) {
    unsigned char* xa = c.smem;
    int* lcnt = (int*)(c.smem + 65536 + 64);
    int* lbase = lcnt + 64;
    float* lgt = (float*)c.smem;
    int* sel_e = (int*)(c.smem + 8192);
    int* sel_p = sel_e + 256;
    float* sel_w = (float*)(sel_p + 256);
    const int lane = c.lane;
    const float rbias = rb[lane];
    for (int base = 0; base < T / 32; base += c.nblk) {
        const int ch = base + c.bid; const bool valid = ch < T / 32;
        __syncthreads();
        if (c.tid < 64) lcnt[c.tid] = 0;
        u32x4 raw[8][2];
#pragma unroll
        for (int i = 0; i < 8; ++i)
#pragma unroll
            for (int hf = 0; hf < 2; ++hf) raw[i][hf] = valid ? *(const u32x4*)(YBUF + (size_t)(ch * 32 + c.wid + 4 * i) * 1024 + hf * 512 + lane * 8) : (u32x4){0u, 0u, 0u, 0u};
        if (valid)
#pragma unroll
        for (int i = 0; i < 8; ++i) {
            const int tl = c.wid + 4 * i;
            const int t = ch * 32 + tl;
            float v[16];
#pragma unroll
            for (int hf = 0; hf < 2; ++hf) {
                float f[8]; unpack8(raw[i][hf], f);
#pragma unroll
                for (int j = 0; j < 8; ++j) v[hf * 8 + j] = f[j];
            }
            float s = 0.f;
#pragma unroll
            for (int i = 0; i < 16; ++i) s += v[i];
            const float mean = wave_sum(s) * (1.f / 1024.f);
            float q = 0.f;
#pragma unroll
            for (int i = 0; i < 16; ++i) { v[i] -= mean; q += v[i] * v[i]; }
            const float rstd = rsqrtf(wave_sum(q) * (1.f / 1024.f) + 1e-5f);
#pragma unroll
            for (int hf = 0; hf < 2; ++hf) {
                const int col = hf * 512 + lane * 8;
                const f32x4 g0 = *(const f32x4*)(g + col), g1 = *(const f32x4*)(g + col + 4);
                const f32x4 b0 = *(const f32x4*)(b + col), b1 = *(const f32x4*)(b + col + 4);
                f32x4 y0, y1;
#pragma unroll
                for (int j = 0; j < 4; ++j) { y0[j] = v[hf * 8 + j] * rstd * g0[j] + b0[j]; y1[j] = v[hf * 8 + 4 + j] * rstd * g1[j] + b1[j]; }
                const u32x4 pk = (u32x4){pk2(y0[0], y0[1]), pk2(y0[2], y0[3]), pk2(y1[0], y1[1]), pk2(y1[2], y1[3])};
                *(u32x4*)(XBF + (size_t)t * 1024 + col) = pk;
                *(u32x4*)(xa + tl * 2048 + (((hf * 64 + lane) ^ (tl & 15)) * 16)) = pk;
            }
        }
        __syncthreads();
        f32x4 acc0 = (f32x4){0.f, 0.f, 0.f, 0.f}, acc1 = (f32x4){0.f, 0.f, 0.f, 0.f};
        {
            const int r = lane & 15, kq = lane >> 4;
            const bf16_t* wrow = W + (size_t)(c.wid * 16 + r) * 1024 + kq * 8;
#pragma unroll 1
            for (int kb = 0; kb < 32; kb += 8) {
                bf16x8 bfr[8];
#pragma unroll
                for (int j = 0; j < 8; ++j) bfr[j] = *(const bf16x8*)(wrow + (kb + j) * 32);
#pragma unroll
                for (int j = 0; j < 8; ++j) {
                    const int chunk = ((kb + j) * 4 + kq) ^ r;
                    const bf16x8 a0 = *(const bf16x8*)(xa + r * 2048 + chunk * 16), a1 = *(const bf16x8*)(xa + (16 + r) * 2048 + chunk * 16);
                    acc0 = __builtin_amdgcn_mfma_f32_16x16x32_bf16(a0, bfr[j], acc0, 0, 0, 0);
                    acc1 = __builtin_amdgcn_mfma_f32_16x16x32_bf16(a1, bfr[j], acc1, 0, 0, 0);
                }
            }
        }
        __syncthreads();
        {
            const int e = c.wid * 16 + (lane & 15), r0 = 4 * (lane >> 4);
#pragma unroll
            for (int j = 0; j < 4; ++j) { lgt[(r0 + j) * 64 + e] = acc0[j]; lgt[(16 + r0 + j) * 64 + e] = acc1[j]; }
        }
        __syncthreads();
        if (valid) for (int tl = c.wid; tl < 32; tl += 4) {
            const float lg = lgt[tl * 64 + lane];
            const float sc = 1.f / (1.f + expf(-lg));
            const float v = sc + rbias;
            float m1 = v;
            m1 = fmaxf(m1, shfl_xor_(m1, 1)); m1 = fmaxf(m1, shfl_xor_(m1, 2)); m1 = fmaxf(m1, shfl_xor_(m1, 4));
            int cand = (v == m1) ? lane : 999;
            cand = min(cand, shfl_xor_(cand, 1)); cand = min(cand, shfl_xor_(cand, 2)); cand = min(cand, shfl_xor_(cand, 4));
            float m2 = (lane == cand) ? -INFINITY : v;
            m2 = fmaxf(m2, shfl_xor_(m2, 1)); m2 = fmaxf(m2, shfl_xor_(m2, 2)); m2 = fmaxf(m2, shfl_xor_(m2, 4));
            const float gs = m1 + m2;
            const int gi = lane >> 3;
            int grank = 0;
#pragma unroll
            for (int gg = 0; gg < 8; ++gg) { const float o = shfl_c_(gs, gg * 8); grank += ((o > gs) || (o == gs && gg < gi)) ? 1 : 0; }
            const bool gsel = grank < 4;
            const float mv = gsel ? v : -INFINITY;
            int rank = 0;
#pragma unroll 8
            for (int jj = 0; jj < 64; ++jj) { const float o = shfl_c_(mv, jj); rank += ((o > mv) || (o == mv && jj < lane)) ? 1 : 0; }
            const bool sel = gsel && rank < 8;
            const float ssum = wave_sum(sel ? sc : 0.f);
            const float w = sc / ssum * 2.5f;
            const unsigned long long bal = __ballot(sel);
            const int slot = __popcll(bal & ((1ull << lane) - 1ull));
            if (sel) {
                const int p = atomicAdd(&lcnt[lane], 1);
                sel_e[tl * 8 + slot] = lane; sel_p[tl * 8 + slot] = p; sel_w[tl * 8 + slot] = w;
            }
        }
        __syncthreads();
        if (valid && c.tid < 64) { const int n = lcnt[c.tid]; lbase[c.tid] = n ? (int)atomicAdd(CNT + c.tid, (unsigned)n) : 0; }
        __syncthreads();
        if (valid) {
            const int tl = c.tid >> 3, t = ch * 32 + tl;
            const int e = sel_e[c.tid], pos = lbase[e] + sel_p[c.tid];
            LTOK[(size_t)e * CAP + pos] = t; LW[(size_t)e * CAP + pos] = sel_w[c.tid];
            ASG[(size_t)t * 8 + (c.tid & 7)] = (e << 16) | pos; ASGW[(size_t)t * 8 + (c.tid & 7)] = sel_w[c.tid];
            if (c.tid < 32) { const int ts = ch * 32 + c.tid; LTOK[(size_t)64 * CAP + ts] = ts; LW[(size_t)64 * CAP + ts] = 1.f; }
        }
    }
}

__device__ __forceinline__ void phase_prep_even(const bf16_t* PROJ, const float* GATES, const float* qn, const float* kvn, const float* cw,
                                const float* a_log, const float* dt_bias, const float* ROPEM,
                                bf16_t* CQ, bf16_t* CKV, bf16_t* KROPE, bf16_t* GQ, bf16_t* GK, bf16_t* GV, float* BETA, float* GLOG, const Ctx& c) {
    const int lane = c.lane;
    float* cwL = (float*)c.smem;
    __syncthreads();
    for (int i = c.tid; i < 4 * 1536 / 4; i += 256) *(f32x4*)(cwL + i * 4) = *(const f32x4*)(cw + i * 4);
    __syncthreads();
    for (int tb = (c.bid * 4 + c.wid) * 8; tb < T; tb += c.nblk * 4 * 8) {
        const int s0 = tb & (SEQ - 1);
        u32x4 xr[3][4];
#pragma unroll
        for (int arr = 0; arr < 3; ++arr)
#pragma unroll
            for (int w = 0; w < 3; ++w)
                xr[arr][w] = (s0 - 3 + w >= 0) ? *(const u32x4*)(PROJ + (size_t)(tb - 3 + w) * NPAD + 416 + arr * 512 + lane * 8) : (u32x4){0u, 0u, 0u, 0u};
        u32x4 nx[3]; u32x2 ncq; unsigned nckv; float nk1 = 0.f, nk2 = 0.f, ncs = 0.f, nsn = 0.f, ngate = 0.f;
#define PE_LOAD(t_) do { const bf16_t* pr_ = PROJ + (size_t)(t_) * NPAD; \
            _Pragma("unroll") for (int arr = 0; arr < 3; ++arr) nx[arr] = *(const u32x4*)(pr_ + 416 + arr * 512 + lane * 8); \
            ncq = *(const u32x2*)(pr_ + lane * 4); nckv = *(const unsigned*)(pr_ + 256 + lane * 2); \
            if (lane < 16) { nk1 = bf2f(pr_[384 + lane]); nk2 = bf2f(pr_[400 + lane]); ncs = ROPEM[((size_t)(t_) * 16 + lane) * 2]; nsn = ROPEM[((size_t)(t_) * 16 + lane) * 2 + 1]; } \
            if (lane < 8) ngate = GATES[(size_t)(t_) * 8 + lane]; } while (0)
        PE_LOAD(tb);
#pragma unroll
        for (int k = 0; k < 8; ++k) {
            const int t = tb + k;
#pragma unroll
            for (int arr = 0; arr < 3; ++arr) xr[arr][3] = nx[arr];
            const u32x2 r = ncq; const unsigned rkv = nckv; const float x1 = nk1, x2 = nk2, cs = ncs, sn = nsn, gate = ngate;
            if (k < 7) PE_LOAD(t + 1);
            {
                float v[4] = {bflo(r.x), bfhi(r.x), bflo(r.y), bfhi(r.y)};
                const float ss = wave_sum(v[0] * v[0] + v[1] * v[1] + v[2] * v[2] + v[3] * v[3]);
                const float rr = rsqrtf(ss * (1.f / 256.f) + 1e-6f);
                const f32x4 gq = *(const f32x4*)(qn + lane * 4);
                *(u32x2*)(CQ + (size_t)t * 256 + lane * 4) = (u32x2){pk2(v[0] * rr * gq[0], v[1] * rr * gq[1]), pk2(v[2] * rr * gq[2], v[3] * rr * gq[3])};
            }
            {
                const float v0 = bflo(rkv), v1 = bfhi(rkv);
                const float ss = wave_sum(v0 * v0 + v1 * v1);
                const float rr = rsqrtf(ss * (1.f / 128.f) + 1e-6f);
                *(unsigned*)(CKV + (size_t)t * 128 + lane * 2) = pk2(v0 * rr * kvn[lane * 2], v1 * rr * kvn[lane * 2 + 1]);
            }
            if (lane < 16) {
                KROPE[(size_t)t * 32 + lane] = (bf16_t)f2bf(x1 * cs - x2 * sn);
                KROPE[(size_t)t * 32 + 16 + lane] = (bf16_t)f2bf(x2 * cs + x1 * sn);
            }
#pragma unroll
            for (int arr = 0; arr < 3; ++arr) {
                float y[8];
#pragma unroll
                for (int j = 0; j < 8; ++j) y[j] = 0.f;
#pragma unroll
                for (int w = 0; w < 4; ++w) {
                    float f[8]; unpack8(xr[arr][w], f);
                    const f32x4 c0 = *(const f32x4*)(cwL + w * 1536 + arr * 512 + lane * 8), c1 = *(const f32x4*)(cwL + w * 1536 + arr * 512 + lane * 8 + 4);
#pragma unroll
                    for (int j = 0; j < 4; ++j) { y[j] += c0[j] * f[j]; y[4 + j] += c1[j] * f[4 + j]; }
                }
                float ss = 0.f;
#pragma unroll
                for (int j = 0; j < 8; ++j) { y[j] = siluf_(y[j]); ss += y[j] * y[j]; }
                if (arr < 2) {
                    float rr = rsqrtf(red16(ss) + 1e-6f);
                    if (arr == 0) rr *= 0.08838834764831845f;
#pragma unroll
                    for (int j = 0; j < 8; ++j) y[j] *= rr;
                }
                bf16_t* dst = (arr == 0) ? GQ : (arr == 1) ? GK : GV;
                *(u32x4*)(dst + (size_t)t * 512 + lane * 8) = (u32x4){pk2(y[0], y[1]), pk2(y[2], y[3]), pk2(y[4], y[5]), pk2(y[6], y[7])};
                xr[arr][0] = xr[arr][1]; xr[arr][1] = xr[arr][2]; xr[arr][2] = xr[arr][3];
            }
            if (lane < 4) BETA[(size_t)t * 4 + lane] = sigmoidf_(gate);
            else if (lane < 8) { const int h = lane - 4; GLOG[(size_t)t * 4 + h] = -expf(a_log[h]) * softplusf_(gate + dt_bias[h]); }
        }
#undef PE_LOAD
    }
}

__device__ __forceinline__ void phase_prep_odd(const bf16_t* PROJ, const float* ROPES, bf16_t* SQ, bf16_t* SK, const Ctx& c) {
    const int lane = c.lane;
    const int hh = lane >> 2, j = lane & 3;
    const bool isq = lane < 32, act = lane < 40;
    const int scol = isq ? 1544 + hh * 64 + j * 8 : 2056 + (hh - 8) * 64 + j * 8;
    const float sc = isq ? 0.18033688011112042f : 1.f;
    for (int t = c.bid * 4 + c.wid; t < T; t += c.nblk * 4) {
        if (act) {
            const bf16_t* pr = PROJ + (size_t)t * NPAD + scol;
            const u32x4 r1 = *(const u32x4*)pr, r2 = *(const u32x4*)(pr + 32);
            const float* rp = ROPES + ((size_t)t * 32 + j * 8) * 2;
            const f32x4 t0 = *(const f32x4*)rp, t1 = *(const f32x4*)(rp + 4), t2 = *(const f32x4*)(rp + 8), t3 = *(const f32x4*)(rp + 12);
            const float cs[8] = {t0[0], t0[2], t1[0], t1[2], t2[0], t2[2], t3[0], t3[2]}, sn[8] = {t0[1], t0[3], t1[1], t1[3], t2[1], t2[3], t3[1], t3[3]};
            float x1[8], x2[8], o1[8], o2[8]; unpack8(r1, x1); unpack8(r2, x2);
#pragma unroll
            for (int k = 0; k < 8; ++k) { o1[k] = (x1[k] * cs[k] - x2[k] * sn[k]) * sc; o2[k] = (x2[k] * cs[k] + x1[k] * sn[k]) * sc; }
            bf16_t* d = isq ? SQ + (size_t)t * 512 + hh * 64 + j * 8 : SK + (size_t)t * 128 + (hh - 8) * 64 + j * 8;
            *(u32x4*)d = (u32x4){pk2(o1[0], o1[1]), pk2(o1[2], o1[3]), pk2(o1[4], o1[5]), pk2(o1[6], o1[7])};
            *(u32x4*)(d + 32) = (u32x4){pk2(o2[0], o2[1]), pk2(o2[2], o2[3]), pk2(o2[4], o2[5]), pk2(o2[6], o2[7])};
        }
    }
}

__device__ __forceinline__ int next_unit(unsigned* ctr, const Ctx& c) {
    volatile int* su = (volatile int*)(c.smem0 + LDS_BLK + 16);
    __syncthreads();
    if (c.tid0 == 0) *su = (int)atomicAdd(ctr, 1u);
    __syncthreads();
    return *su * 2 + c.half;
}

typedef float f32x16 __attribute__((ext_vector_type(16)));
typedef short s16x4 __attribute__((ext_vector_type(4)));
#define MFMA32(a, b, c) __builtin_amdgcn_mfma_f32_32x32x16_bf16((a), (b), (c), 0, 0, 0)
template <int S_> __device__ __forceinline__ bf16x8 pack_step(const f32x16& x) {
    u32x4 p;
    asm volatile("v_cvt_pk_bf16_f32 %0, %4, %5\n\tv_cvt_pk_bf16_f32 %1, %6, %7\n\tv_cvt_pk_bf16_f32 %2, %8, %9\n\tv_cvt_pk_bf16_f32 %3, %10, %11\n\ts_nop 1"
                 : "=&v"(p[0]), "=&v"(p[1]), "=&v"(p[2]), "=&v"(p[3])
                 : "v"(x[8 * S_]), "v"(x[8 * S_ + 1]), "v"(x[8 * S_ + 2]), "v"(x[8 * S_ + 3]), "v"(x[8 * S_ + 4]), "v"(x[8 * S_ + 5]), "v"(x[8 * S_ + 6]), "v"(x[8 * S_ + 7]));
    return __builtin_bit_cast(bf16x8, p);
}
template <int S_> __device__ __forceinline__ bf16x8 pack_step_m(const f32x16& x) {
    u32x4 p;
    asm volatile("s_nop 15\n\tv_cvt_pk_bf16_f32 %0, %4, %5\n\tv_cvt_pk_bf16_f32 %1, %6, %7\n\tv_cvt_pk_bf16_f32 %2, %8, %9\n\tv_cvt_pk_bf16_f32 %3, %10, %11\n\ts_nop 1"
                 : "=&v"(p[0]), "=&v"(p[1]), "=&v"(p[2]), "=&v"(p[3])
                 : "v"(x[8 * S_]), "v"(x[8 * S_ + 1]), "v"(x[8 * S_ + 2]), "v"(x[8 * S_ + 3]), "v"(x[8 * S_ + 4]), "v"(x[8 * S_ + 5]), "v"(x[8 * S_ + 6]), "v"(x[8 * S_ + 7]));
    return __builtin_bit_cast(bf16x8, p);
}
constexpr int ATT_VB = 64 * 128;

template <int NKS, bool WIN>
__device__ __forceinline__ void attn_unit(const bf16_t* Qp, int q_ld, const bf16_t* K1, int k1_ld, const bf16_t* K2, int k2_ld, const bf16_t* Vp, int v_ld,
                          bf16_t* Op, int o_ld, int Q0, float sink_l2, const Ctx& c) {
    constexpr int KB = NKS * 2 * 1024, BUF = KB + ATT_VB;
    const int lane = c.lane, r = lane & 31, h = lane >> 5;
    const int wid = __builtin_amdgcn_readfirstlane(c.wid);
    const int q0w = Q0 + wid * 32;
    unsigned char* smem = c.smem;
    bf16x8 qf[NKS];
#pragma unroll
    for (int ks = 0; ks < NKS; ++ks) qf[ks] = *(const bf16x8*)(Qp + (size_t)(q0w + r) * q_ld + ks * 16 + h * 8);
    f32x16 o0, o1;
#pragma unroll
    for (int i = 0; i < 16; ++i) { o0[i] = 0.f; o1[i] = 0.f; }
    float m = WIN ? sink_l2 : -1e30f, l = (WIN && h == 0) ? 1.f : 0.f;
    const int kt_lo = WIN ? ((Q0 >> 6) - 2 < 0 ? 0 : (Q0 >> 6) - 2) : 0, kt_hi = (Q0 >> 6) + 1;
#define ATT_STAGE(kt_, buf_) do { unsigned char* bp = smem + (buf_) * BUF; const size_t kb = (size_t)(kt_) * 64; \
        _Pragma("unroll") for (int i = 0; i < (NKS * 2) / 4; ++i) { const int ch = wid + 4 * i; \
            const bf16_t* sp = (ch < 8) ? (K1 + (kb + lane) * k1_ld + ch * 8) : (K2 + (kb + lane) * k2_ld + (ch - 8) * 8); \
            glds16(sp, bp + ch * 1024 + lane * 16); } \
        _Pragma("unroll") for (int i = 0; i < 2; ++i) { const int j = wid + 4 * i; \
            glds16(Vp + (kb + 8 * j + (lane >> 3)) * v_ld + (lane & 7) * 8, bp + KB + j * 1024 + lane * 16); } } while (0)
    ATT_STAGE(kt_lo, 0);
    const int i16 = lane & 15;
    const unsigned vlane = (unsigned)((4 * h + (i16 >> 2)) * 128 + 32 * ((lane >> 4) & 1) + 8 * (i16 & 3));
    for (int kt = kt_lo; kt <= kt_hi; ++kt) {
        const int cur = (kt - kt_lo) & 1;
        asm volatile("s_waitcnt vmcnt(0)" ::: "memory");
        __syncthreads();
        if (kt < kt_hi) ATT_STAGE(kt + 1, cur ^ 1);
        const int k0 = kt * 64;
        const bool active = (k0 <= q0w + 31) && (!WIN || (k0 + 63 > q0w - 128));
        if (active) {
            const unsigned char* Kt = smem + cur * BUF;
            f32x16 x0, x1;
#pragma unroll
            for (int i = 0; i < 16; ++i) { x0[i] = 0.f; x1[i] = 0.f; }
#pragma unroll
            for (int ks = 0; ks < NKS; ++ks) {
                const bf16x8 kf0 = *(const bf16x8*)(Kt + (ks * 2 + h) * 1024 + r * 16);
                const bf16x8 kf1 = *(const bf16x8*)(Kt + (ks * 2 + h) * 1024 + (32 + r) * 16);
                x0 = MFMA32(kf0, qf[ks], x0); x1 = MFMA32(kf1, qf[ks], x1);
            }
            const bool need_mask = (k0 + 63 > q0w) || (WIN && (k0 <= q0w + 31 - 128));
            if (need_mask) {
                const int q = q0w + r;
#pragma unroll
                for (int i = 0; i < 16; ++i) {
                    const int key = k0 + (i & 3) + 8 * (i >> 2) + 4 * h;
                    const bool v0 = (key <= q) && (!WIN || key > q - 128);
                    const bool v1 = (key + 32 <= q) && (!WIN || key + 32 > q - 128);
                    x0[i] = v0 ? x0[i] : -INFINITY; x1[i] = v1 ? x1[i] : -INFINITY;
                }
            }
            float mx = fmaxf(x0[0], x1[0]);
#pragma unroll
            for (int i = 1; i < 16; ++i) mx = fmaxf(mx, fmaxf(x0[i], x1[i]));
            mx = fmaxf(mx, shfl_xor_(mx, 32));
            const float mn = fmaxf(m, mx);
            const float alpha = __builtin_amdgcn_exp2f(m - mn);
            m = mn;
            float ps = 0.f;
#pragma unroll
            for (int i = 0; i < 16; ++i) { x0[i] = __builtin_amdgcn_exp2f(x0[i] - mn); x1[i] = __builtin_amdgcn_exp2f(x1[i] - mn); ps += x0[i] + x1[i]; }
            l = l * alpha + ps;
            o0 *= alpha; o1 *= alpha;
            const unsigned vbase = (unsigned)(size_t)(smem + cur * BUF + KB) + vlane;
#pragma unroll
            for (int t = 0; t < 2; ++t) {
                s16x4 l00, h00, l01, h01, l10, h10, l11, h11;
                const unsigned va = vbase + t * 4096;
                asm volatile("ds_read_b64_tr_b16 %0, %8\n\t"
                             "ds_read_b64_tr_b16 %1, %8 offset:1024\n\t"
                             "ds_read_b64_tr_b16 %2, %8 offset:64\n\t"
                             "ds_read_b64_tr_b16 %3, %8 offset:1088\n\t"
                             "ds_read_b64_tr_b16 %4, %8 offset:2048\n\t"
                             "ds_read_b64_tr_b16 %5, %8 offset:3072\n\t"
                             "ds_read_b64_tr_b16 %6, %8 offset:2112\n\t"
                             "ds_read_b64_tr_b16 %7, %8 offset:3136\n\t"
                             "s_waitcnt lgkmcnt(0)"
                             : "=&v"(l00), "=&v"(h00), "=&v"(l01), "=&v"(h01), "=&v"(l10), "=&v"(h10), "=&v"(l11), "=&v"(h11) : "v"(va) : "memory");
                const bf16x8 v00 = __builtin_shufflevector(l00, h00, 0, 1, 2, 3, 4, 5, 6, 7), v01 = __builtin_shufflevector(l01, h01, 0, 1, 2, 3, 4, 5, 6, 7);
                const bf16x8 v10 = __builtin_shufflevector(l10, h10, 0, 1, 2, 3, 4, 5, 6, 7), v11 = __builtin_shufflevector(l11, h11, 0, 1, 2, 3, 4, 5, 6, 7);
                const bf16x8 pb0 = (t == 0) ? pack_step<0>(x0) : pack_step<0>(x1);
                const bf16x8 pb1 = (t == 0) ? pack_step<1>(x0) : pack_step<1>(x1);
                o0 = MFMA32(v00, pb0, o0); o1 = MFMA32(v01, pb0, o1);
                o0 = MFMA32(v10, pb1, o0); o1 = MFMA32(v11, pb1, o1);
            }
        }
    }
#undef ATT_STAGE
    l += shfl_xor_(l, 32);
    const float inv = 1.f / l;
    bf16_t* orow = Op + (size_t)(q0w + r) * o_ld + 4 * h;
#pragma unroll
    for (int g = 0; g < 4; ++g) {
        *(u32x2*)(orow + 8 * g) = (u32x2){pk2(o0[4 * g] * inv, o0[4 * g + 1] * inv), pk2(o0[4 * g + 2] * inv, o0[4 * g + 3] * inv)};
        *(u32x2*)(orow + 32 + 8 * g) = (u32x2){pk2(o1[4 * g] * inv, o1[4 * g + 1] * inv), pk2(o1[4 * g + 2] * inv, o1[4 * g + 3] * inv)};
    }
}

constexpr size_t MLC_DC = 0, MLC_CS = 33554432, MLC_DN = MLC_CS + 16777216, MLC_NS = MLC_DN + 262144, MLC_ML = MLC_NS + 262144, MLC_BE = MLC_ML + 4096, MLC_MS = MLC_BE + 4096;

__device__ __forceinline__ float scan_add64(float v, int lane) {
#pragma unroll
    for (int o = 1; o < 64; o <<= 1) { const float x = shfl_up_(v, o); if (lane >= o) v += x; }
    return v;
}
__device__ __forceinline__ float scan_max64(float v, int lane) {
#pragma unroll
    for (int o = 1; o < 64; o <<= 1) { const float x = shfl_up_(v, o); if (lane >= o) v = fmaxf(v, x); }
    return v;
}
__device__ __forceinline__ float wave_max(float v) {
#pragma unroll
    for (int o = 32; o > 0; o >>= 1) v = fmaxf(v, shfl_xor_(v, o));
    return v;
}

__device__ __forceinline__ void mlc_passA(int u, const bf16_t* PROJ, const float* GATES, const float* b_i, const float* b_f, unsigned char* YB, const Ctx& c) {
    const int bh = u >> 5, b = bh >> 2, h = bh & 3;
    const size_t t0 = (size_t)b * SEQ + (u & 31) * 64;
    unsigned char* smem = c.smem;
    float* saL = (float*)(smem + 24576);
    const int lane = c.lane, wid = __builtin_amdgcn_readfirstlane(c.wid);
#pragma unroll
    for (int i = 0; i < 4; ++i) { const int j = wid * 4 + i;
        glds16(PROJ + (t0 + 4 * j + (lane >> 4)) * NPAD + 512 + h * 128 + (lane & 15) * 8, smem + 8192 + j * 1024 + lane * 16); }
    if (wid == 0) {
        const float ip = GATES[(t0 + lane) * 8 + h] + b_i[h], lf = -softplusf_(-(GATES[(t0 + lane) * 8 + 4 + h] + b_f[h]));
        const float bc = scan_add64(lf, lane), bend = shfl_c_(bc, 63);
        const float a = bend - bc + ip, mloc = wave_max(a);
        saL[lane] = expf(a - mloc) * 0.125f;
        if (lane == 0) { ((float*)(YB + MLC_ML))[u] = mloc; ((float*)(YB + MLC_BE))[u] = bend; }
    }
    __syncthreads();
#pragma unroll
    for (int i = 0; i < 2; ++i) {
        const int idx = c.tid + 256 * i, row = idx >> 3, chk = idx & 7;
        const u32x4 r = *(const u32x4*)(PROJ + (t0 + row) * NPAD + 256 + h * 64 + chk * 8);
        float f[8]; unpack8(r, f);
        const float s = saL[row];
        *(u32x4*)(smem + row * 128 + chk * 16) = (u32x4){pk2(f[0] * s, f[1] * s), pk2(f[2] * s, f[3] * s), pk2(f[4] * s, f[5] * s), pk2(f[6] * s, f[7] * s)};
    }
    asm volatile("s_waitcnt vmcnt(0)" ::: "memory");
    __syncthreads();
    const int h5 = lane >> 5, r = lane & 31, i16 = lane & 15, q4 = i16 >> 2, p = i16 & 3, blk = (lane >> 4) & 1;
    const int dkt = wid & 1, dvp = wid >> 1;
    const unsigned kaddr = (unsigned)(size_t)smem + (unsigned)((8 * h5 + q4) * 128 + dkt * 64 + 32 * blk + 8 * p);
    const unsigned vaddr = (unsigned)(size_t)smem + 8192u + (unsigned)((8 * h5 + q4) * 256 + dvp * 128 + 32 * blk + 8 * p);
    f32x16 a0, a1;
#pragma unroll
    for (int i = 0; i < 16; ++i) { a0[i] = 0.f; a1[i] = 0.f; }
#pragma unroll
    for (int st = 0; st < 4; ++st) {
        s16x4 kl, kh, v0l, v0h, v1l, v1h;
        const unsigned ka = kaddr + st * 2048, va = vaddr + st * 4096;
        asm volatile("ds_read_b64_tr_b16 %0, %6\n\t"
                     "ds_read_b64_tr_b16 %1, %6 offset:512\n\t"
                     "ds_read_b64_tr_b16 %2, %7\n\t"
                     "ds_read_b64_tr_b16 %3, %7 offset:1024\n\t"
                     "ds_read_b64_tr_b16 %4, %7 offset:64\n\t"
                     "ds_read_b64_tr_b16 %5, %7 offset:1088\n\t"
                     "s_waitcnt lgkmcnt(0)"
                     : "=&v"(kl), "=&v"(kh), "=&v"(v0l), "=&v"(v0h), "=&v"(v1l), "=&v"(v1h) : "v"(ka), "v"(va) : "memory");
        const bf16x8 kf = __builtin_shufflevector(kl, kh, 0, 1, 2, 3, 4, 5, 6, 7);
        const bf16x8 vf0 = __builtin_shufflevector(v0l, v0h, 0, 1, 2, 3, 4, 5, 6, 7), vf1 = __builtin_shufflevector(v1l, v1h, 0, 1, 2, 3, 4, 5, 6, 7);
        a0 = MFMA32(kf, vf0, a0); a1 = MFMA32(kf, vf1, a1);
    }
    float* DC = (float*)(YB + MLC_DC) + (size_t)u * 8192;
#pragma unroll
    for (int i = 0; i < 16; ++i) {
        const int dk = dkt * 32 + (i & 3) + 8 * (i >> 2) + 4 * h5;
        DC[dk * 128 + dvp * 64 + r] = a0[i]; DC[dk * 128 + dvp * 64 + 32 + r] = a1[i];
    }
    if (c.tid < 64) {
        float s = 0.f;
#pragma unroll 8
        for (int t = 0; t < 64; ++t) s += bf2f(((const bf16_t*)smem)[t * 64 + c.tid]);
        ((float*)(YB + MLC_DN))[(size_t)u * 64 + c.tid] = s;
    }
}

__device__ __forceinline__ void mlc_passB(int u, unsigned char* YB, const Ctx& c) {
    const int bh = u >> 3, sl = u & 7;
    const float* ML = (const float*)(YB + MLC_ML) + bh * 32; const float* BE = (const float*)(YB + MLC_BE) + bh * 32;
    const float* DC = (const float*)(YB + MLC_DC) + (size_t)bh * 32 * 8192 + sl * 1024 + c.tid * 4;
    bf16_t* CS = (bf16_t*)(YB + MLC_CS) + (size_t)bh * 32 * 8192 + sl * 1024 + c.tid * 4;
    const float* DN = (const float*)(YB + MLC_DN) + (size_t)bh * 32 * 64; float* NS = (float*)(YB + MLC_NS) + (size_t)bh * 32 * 64; float* MS = (float*)(YB + MLC_MS) + bh * 32;
    f32x4 C4 = (f32x4){0.f, 0.f, 0.f, 0.f}; float nv = 0.f, m = 0.f;
    const bool do_n = (sl == 0) && (c.tid < 64);
#pragma unroll 4
    for (int n = 0; n < 32; ++n) {
        *(u32x2*)(CS + (size_t)n * 8192) = (u32x2){pk2(C4[0], C4[1]), pk2(C4[2], C4[3])};
        if (do_n) NS[n * 64 + c.tid] = nv;
        if (sl == 0 && c.tid == 0) MS[n] = m;
        const float be = BE[n], ml = ML[n];
        const float mn = fmaxf(be + m, ml), keep = expf(be + m - mn), g = expf(ml - mn);
        m = mn;
        const f32x4 d = *(const f32x4*)(DC + (size_t)n * 8192);
        C4 = C4 * keep + d * g;
        if (do_n) nv = nv * keep + DN[n * 64 + c.tid] * g;
    }
}

__device__ __forceinline__ void mlc_passC(int u, const bf16_t* PROJ, const float* GATES, const float* b_i, const float* b_f, const unsigned char* YB,
                                          const float* gain  , bf16_t* MIXO, const Ctx& c) {
    const int bh = u >> 5, b = bh >> 2, h = bh & 3;
    const size_t t0 = (size_t)b * SEQ + (u & 31) * 64;
    unsigned char* smem = c.smem;
    float* csL = (float*)(smem + 32768); float* pmL = (float*)(smem + 33024); float* bcL = (float*)(smem + 33280); float* nnL = (float*)(smem + 33536); float* sqL = (float*)(smem + 33792);
    const int lane = c.lane, wid = __builtin_amdgcn_readfirstlane(c.wid);
    const bf16_t* CS = (const bf16_t*)(YB + MLC_CS) + (size_t)u * 8192;
#pragma unroll
    for (int i = 0; i < 4; ++i) { const int j = wid * 4 + i;
        glds16(PROJ + (t0 + 4 * j + (lane >> 4)) * NPAD + 512 + h * 128 + (lane & 15) * 8, smem + j * 1024 + lane * 16);
        glds16(CS + (4 * j + (lane >> 4)) * 128 + (lane & 15) * 8, smem + 16384 + j * 1024 + lane * 16); }
    float bcl = 0.f;
    if (wid == 0) {
        const float ip = GATES[(t0 + lane) * 8 + h] + b_i[h], lf = -softplusf_(-(GATES[(t0 + lane) * 8 + 4 + h] + b_f[h]));
        bcl = scan_add64(lf, lane);
        const float cs = ip - bcl;
        csL[lane] = cs; pmL[lane] = scan_max64(cs, lane);
        nnL[lane] = ((const float*)(YB + MLC_NS))[(size_t)u * 64 + lane];
        bcL[lane] = bcl;
    }
    asm volatile("s_waitcnt vmcnt(0)" ::: "memory");
    __syncthreads();
    const int h5 = lane >> 5, r = lane & 31, i16 = lane & 15, q4 = i16 >> 2, p = i16 & 3, blk = (lane >> 4) & 1;
    const int th = wid & 1, dvh = wid >> 1;
    const int t = th * 32 + r;
    const float m_n = ((const float*)(YB + MLC_MS))[u];
    const float Mt = fmaxf(m_n, pmL[t]), w_inter = __expf(m_n - Mt), em = __expf(-(bcL[t] + Mt));
    bf16x8 qf[4];
#pragma unroll
    for (int ks = 0; ks < 4; ++ks) qf[ks] = *(const bf16x8*)(PROJ + (t0 + t) * NPAD + h * 64 + ks * 16 + h5 * 8);
    float qn = 0.f; bf16x8 qw[4];
#pragma unroll
    for (int ks = 0; ks < 4; ++ks) {
        const u32x4 raw = __builtin_bit_cast(u32x4, qf[ks]); float f[8]; unpack8(raw, f);
#pragma unroll
        for (int j = 0; j < 8; ++j) qn += f[j] * nnL[ks * 16 + h5 * 8 + j];
        qw[ks] = __builtin_bit_cast(bf16x8, (u32x4){pk2(f[0] * w_inter, f[1] * w_inter), pk2(f[2] * w_inter, f[3] * w_inter), pk2(f[4] * w_inter, f[5] * w_inter), pk2(f[6] * w_inter, f[7] * w_inter)});
    }
    qn += shfl_xor_(qn, 32);
    f32x16 x0, x1;
#pragma unroll
    for (int i = 0; i < 16; ++i) { x0[i] = 0.f; x1[i] = 0.f; }
#pragma unroll
    for (int ks = 0; ks < 4; ++ks) {
        const bf16x8 kf0 = *(const bf16x8*)(PROJ + (t0 + r) * NPAD + 256 + h * 64 + ks * 16 + h5 * 8);
        x0 = MFMA32(kf0, qf[ks], x0);
        if (th) { const bf16x8 kf1 = *(const bf16x8*)(PROJ + (t0 + 32 + r) * NPAD + 256 + h * 64 + ks * 16 + h5 * 8); x1 = MFMA32(kf1, qf[ks], x1); }
    }
    float ps = 0.f;
#pragma unroll
    for (int i = 0; i < 16; ++i) {
        const int s = (i & 3) + 8 * (i >> 2) + 4 * h5;
        const float w0 = (s <= t) ? __expf(csL[s] - Mt) * 0.125f : 0.f;
        x0[i] *= w0; ps += x0[i];
        if (th) { const float w1 = (s <= r) ? __expf(csL[32 + s] - Mt) * 0.125f : 0.f; x1[i] *= w1; ps += x1[i]; }
    }
    ps += shfl_xor_(ps, 32);
    const float den = w_inter * qn + ps;
    f32x16 o0, o1;
#pragma unroll
    for (int i = 0; i < 16; ++i) { o0[i] = 0.f; o1[i] = 0.f; }
    {
        const unsigned vb = (unsigned)(size_t)smem + (unsigned)((4 * h5 + q4) * 256 + dvh * 128 + 32 * blk + 8 * p);
#pragma unroll
        for (int st = 0; st < 2; ++st) {
            if (st == 0 || th) {
                s16x4 l00, h00, l01, h01, l10, h10, l11, h11;
                const unsigned va = vb + st * 8192;
                asm volatile("ds_read_b64_tr_b16 %0, %8\n\t"
                             "ds_read_b64_tr_b16 %1, %8 offset:2048\n\t"
                             "ds_read_b64_tr_b16 %2, %8 offset:64\n\t"
                             "ds_read_b64_tr_b16 %3, %8 offset:2112\n\t"
                             "ds_read_b64_tr_b16 %4, %8 offset:4096\n\t"
                             "ds_read_b64_tr_b16 %5, %8 offset:6144\n\t"
                             "ds_read_b64_tr_b16 %6, %8 offset:4160\n\t"
                             "ds_read_b64_tr_b16 %7, %8 offset:6208\n\t"
                             "s_waitcnt lgkmcnt(0)"
                             : "=&v"(l00), "=&v"(h00), "=&v"(l01), "=&v"(h01), "=&v"(l10), "=&v"(h10), "=&v"(l11), "=&v"(h11) : "v"(va) : "memory");
                const bf16x8 v00 = __builtin_shufflevector(l00, h00, 0, 1, 2, 3, 4, 5, 6, 7), v01 = __builtin_shufflevector(l01, h01, 0, 1, 2, 3, 4, 5, 6, 7);
                const bf16x8 v10 = __builtin_shufflevector(l10, h10, 0, 1, 2, 3, 4, 5, 6, 7), v11 = __builtin_shufflevector(l11, h11, 0, 1, 2, 3, 4, 5, 6, 7);
                const bf16x8 pb0 = (st == 0) ? pack_step<0>(x0) : pack_step<0>(x1);
                const bf16x8 pb1 = (st == 0) ? pack_step<1>(x0) : pack_step<1>(x1);
                o0 = MFMA32(v00, pb0, o0); o1 = MFMA32(v01, pb0, o1);
                o0 = MFMA32(v10, pb1, o0); o1 = MFMA32(v11, pb1, o1);
            }
        }
    }
    {
        const unsigned cb = (unsigned)(size_t)smem + 16384u + (unsigned)((8 * h5 + q4) * 256 + dvh * 128 + 32 * blk + 8 * p);
#pragma unroll
        for (int kp = 0; kp < 2; ++kp) {
            s16x4 l00, h00, l01, h01, l10, h10, l11, h11;
            const unsigned ca = cb + kp * 8192;
            asm volatile("ds_read_b64_tr_b16 %0, %8\n\t"
                         "ds_read_b64_tr_b16 %1, %8 offset:1024\n\t"
                         "ds_read_b64_tr_b16 %2, %8 offset:64\n\t"
                         "ds_read_b64_tr_b16 %3, %8 offset:1088\n\t"
                         "ds_read_b64_tr_b16 %4, %8 offset:4096\n\t"
                         "ds_read_b64_tr_b16 %5, %8 offset:5120\n\t"
                         "ds_read_b64_tr_b16 %6, %8 offset:4160\n\t"
                         "ds_read_b64_tr_b16 %7, %8 offset:5184\n\t"
                         "s_waitcnt lgkmcnt(0)"
                         : "=&v"(l00), "=&v"(h00), "=&v"(l01), "=&v"(h01), "=&v"(l10), "=&v"(h10), "=&v"(l11), "=&v"(h11) : "v"(ca) : "memory");
            const bf16x8 c00 = __builtin_shufflevector(l00, h00, 0, 1, 2, 3, 4, 5, 6, 7), c01 = __builtin_shufflevector(l01, h01, 0, 1, 2, 3, 4, 5, 6, 7);
            const bf16x8 c10 = __builtin_shufflevector(l10, h10, 0, 1, 2, 3, 4, 5, 6, 7), c11 = __builtin_shufflevector(l11, h11, 0, 1, 2, 3, 4, 5, 6, 7);
            o0 = MFMA32(c00, qw[2 * kp], o0); o1 = MFMA32(c01, qw[2 * kp], o1);
            o0 = MFMA32(c10, qw[2 * kp + 1], o0); o1 = MFMA32(c11, qw[2 * kp + 1], o1);
        }
    }
    const float inv = __builtin_amdgcn_rcpf(fmaxf(fabsf(den), em));
    float ss = 0.f;
#pragma unroll
    for (int i = 0; i < 16; ++i) { o0[i] *= inv; o1[i] *= inv; ss += o0[i] * o0[i] + o1[i] * o1[i]; }
    ss += shfl_xor_(ss, 32);
    if (h5 == 0) sqL[wid * 32 + r] = ss;
    __syncthreads();
    const float rr = rsqrtf((sqL[th * 32 + r] + sqL[(th + 2) * 32 + r]) * (1.f / 128.f) + 1e-6f);
    const bf16_t* grow = PROJ + (t0 + t) * NPAD + 1032 + h * 128 + dvh * 64 + 4 * h5;
    const float* gn = gain + h * 128 + dvh * 64 + 4 * h5;
    bf16_t* orow = MIXO + (t0 + t) * 1024 + h * 128 + dvh * 64 + 4 * h5;
#pragma unroll
    for (int d = 0; d < 2; ++d)
#pragma unroll
        for (int g = 0; g < 4; ++g) {
            const u32x2 zr = *(const u32x2*)(grow + d * 32 + 8 * g);
            const f32x4 gv = *(const f32x4*)(gn + d * 32 + 8 * g);
            const float z0 = bflo(zr.x), z1 = bfhi(zr.x), z2 = bflo(zr.y), z3 = bfhi(zr.y);
            const float y0 = (d ? o1[4 * g] : o0[4 * g]) * rr * gv[0] * sigmoidf_(z0), y1 = (d ? o1[4 * g + 1] : o0[4 * g + 1]) * rr * gv[1] * sigmoidf_(z1);
            const float y2 = (d ? o1[4 * g + 2] : o0[4 * g + 2]) * rr * gv[2] * sigmoidf_(z2), y3 = (d ? o1[4 * g + 3] : o0[4 * g + 3]) * rr * gv[3] * sigmoidf_(z3);
            *(u32x2*)(orow + d * 32 + 8 * g) = (u32x2){pk2(y0, y1), pk2(y2, y3)};
        }
}

constexpr size_t GD_WN = 0, GD_UU = GD_WN + (size_t)1024 * 16384, GD_KGT = GD_UU + (size_t)1024 * 16384, GD_QG = GD_KGT + (size_t)1024 * 16384,
                 GD_AT = GD_QG + (size_t)1024 * 16384, GD_GL = GD_AT + (size_t)1024 * 8192, GD_END = GD_GL + 4096;
static_assert(GD_END <= (size_t)MAXROWS * 256 * 2, "GDN chunk records must fit the HBUF region");

__device__ __forceinline__ void gdc_passA(int u, const bf16_t* GQ, const bf16_t* GK, const bf16_t* GV, const float* BETA, const float* GLOG, unsigned char* HB, const Ctx& c) {
    const int bh = u >> 5, b = bh >> 2, h = bh & 3;
    const size_t t0 = (size_t)b * SEQ + (u & 31) * 64;
    unsigned char* smem = c.smem;
    float* Lm = (float*)(smem + 49152);
    float* GA = (float*)(smem + 65536 + 64); float* BT = GA + 64; float* EG = BT + 64; float* EK = EG + 64;
    const int lane = c.lane, wid = __builtin_amdgcn_readfirstlane(c.wid);
    const int h5 = lane >> 5, r = lane & 31;
    if (wid == 0) {
        const float g = GLOG[(t0 + lane) * 4 + h];
        const float G = scan_add64(g, lane), Gl = shfl_c_(G, 63);
        GA[lane] = G; BT[lane] = BETA[(t0 + lane) * 4 + h]; EG[lane] = expf(G); EK[lane] = expf(Gl - G);
        if (lane == 0) ((float*)(HB + GD_GL))[u] = expf(Gl);
    }
    __syncthreads();
    if (wid < 3) {
        const int it = (wid + 1) >> 1, jt = wid >> 1;
        f32x16 dl, da;
#pragma unroll
        for (int i = 0; i < 16; ++i) { dl[i] = 0.f; da[i] = 0.f; }
#pragma unroll
        for (int ks = 0; ks < 8; ++ks) {
            const bf16x8 ki = *(const bf16x8*)(GK + (t0 + 32 * it + r) * 512 + h * 128 + ks * 16 + h5 * 8);
            const bf16x8 kj = *(const bf16x8*)(GK + (t0 + 32 * jt + r) * 512 + h * 128 + ks * 16 + h5 * 8);
            const bf16x8 qi = *(const bf16x8*)(GQ + (t0 + 32 * it + r) * 512 + h * 128 + ks * 16 + h5 * 8);
            dl = MFMA32(ki, kj, dl); da = MFMA32(qi, kj, da);
        }
        const int j = 32 * jt + r; const float Gj = GA[j];
        bf16_t* AT = (bf16_t*)(HB + GD_AT) + (size_t)u * 4096;
#pragma unroll
        for (int i = 0; i < 16; ++i) {
            const int ii = 32 * it + (i & 3) + 8 * (i >> 2) + 4 * h5;
            const float dec = __expf(GA[ii] - Gj);
            Lm[ii * 64 + j] = (j < ii) ? dl[i] * BT[ii] * dec : 0.f;
            AT[ii * 64 + j] = (bf16_t)f2bf((j <= ii) ? da[i] * dec : 0.f);
        }
        if (wid == 0) {
#pragma unroll
            for (int i = 0; i < 16; ++i) { const int ii = (i & 3) + 8 * (i >> 2) + 4 * h5; Lm[ii * 64 + 32 + r] = 0.f; AT[ii * 64 + 32 + r] = 0; }
        }
    }
    __syncthreads();
    if (wid == 0) {
        float Tc[64];
#pragma unroll
        for (int i = 0; i < 64; ++i) {
            float s = (i == lane) ? 1.f : 0.f;
#pragma unroll
            for (int k = 0; k < i; ++k) s -= Lm[i * 64 + k] * Tc[k];
            Tc[i] = s;
        }
        bf16_t* Tm = (bf16_t*)Lm;
#pragma unroll
        for (int i = 0; i < 64; ++i) Tm[i * 64 + lane] = (bf16_t)f2bf(Tc[i]);
    } else {
        const int t3 = c.tid - 64;
        for (int idx = t3; idx < 4096; idx += 192) {
            const int arr = idx >> 10, rem = idx & 1023, row = rem >> 4, chk = rem & 15;
            const bf16_t* sp = ((arr == 1) ? GV : (arr == 3) ? GQ : GK) + (t0 + row) * 512 + h * 128 + chk * 8;
            const u32x4 raw = *(const u32x4*)sp; float f[8]; unpack8(raw, f);
            const float sc = (arr == 0) ? BT[row] * EG[row] : (arr == 1) ? BT[row] : (arr == 2) ? EK[row] : EG[row];
            const u32x4 o = (u32x4){pk2(f[0] * sc, f[1] * sc), pk2(f[2] * sc, f[3] * sc), pk2(f[4] * sc, f[5] * sc), pk2(f[6] * sc, f[7] * sc)};
            if (arr < 3) *(u32x4*)(smem + arr * 16384 + row * 256 + chk * 16) = o;
            else *(u32x4*)((bf16_t*)(HB + GD_QG) + (size_t)u * 8192 + row * 128 + chk * 8) = o;
        }
    }
    __syncthreads();
    {
        const int i16 = lane & 15, q4 = i16 >> 2, p = i16 & 3, blk = (lane >> 4) & 1;
        const unsigned char* Tm = smem + 49152;
        f32x16 u0, u1, w0, w1;
#pragma unroll
        for (int i = 0; i < 16; ++i) { u0[i] = 0.f; u1[i] = 0.f; w0[i] = 0.f; w1[i] = 0.f; }
        const unsigned ib = (unsigned)(size_t)smem + (unsigned)((8 * h5 + q4) * 256 + wid * 64 + 32 * blk + 8 * p);
#pragma unroll
        for (int ks = 0; ks < 4; ++ks) {
            s16x4 kl, kh, vl, vh;
            const unsigned ia = ib + ks * 4096;
            asm volatile("ds_read_b64_tr_b16 %0, %4\n\t"
                         "ds_read_b64_tr_b16 %1, %4 offset:1024\n\t"
                         "ds_read_b64_tr_b16 %2, %4 offset:16384\n\t"
                         "ds_read_b64_tr_b16 %3, %4 offset:17408\n\t"
                         "s_waitcnt lgkmcnt(0)"
                         : "=&v"(kl), "=&v"(kh), "=&v"(vl), "=&v"(vh) : "v"(ia) : "memory");
            const bf16x8 kb = __builtin_shufflevector(kl, kh, 0, 1, 2, 3, 4, 5, 6, 7), vb = __builtin_shufflevector(vl, vh, 0, 1, 2, 3, 4, 5, 6, 7);
            const bf16x8 t1 = *(const bf16x8*)(Tm + (32 + r) * 128 + ks * 32 + h5 * 16);
            w1 = MFMA32(t1, kb, w1); u1 = MFMA32(t1, vb, u1);
            if (ks < 2) { const bf16x8 tt0 = *(const bf16x8*)(Tm + r * 128 + ks * 32 + h5 * 16); w0 = MFMA32(tt0, kb, w0); u0 = MFMA32(tt0, vb, u0); }
        }
        bf16_t* WN = (bf16_t*)(HB + GD_WN) + (size_t)u * 8192; bf16_t* UU = (bf16_t*)(HB + GD_UU) + (size_t)u * 8192;
#pragma unroll
        for (int i = 0; i < 16; ++i) {
            const int s = (i & 3) + 8 * (i >> 2) + 4 * h5;
            WN[s * 128 + wid * 32 + r] = (bf16_t)f2bf(-w0[i]); WN[(32 + s) * 128 + wid * 32 + r] = (bf16_t)f2bf(-w1[i]);
        }
        {
            u32x4* up = (u32x4*)(UU + (size_t)(wid * 64 + lane) * 32);
            up[0] = (u32x4){pk2(u0[0], u0[1]), pk2(u0[2], u0[3]), pk2(u0[4], u0[5]), pk2(u0[6], u0[7])};
            up[1] = (u32x4){pk2(u0[8], u0[9]), pk2(u0[10], u0[11]), pk2(u0[12], u0[13]), pk2(u0[14], u0[15])};
            up[2] = (u32x4){pk2(u1[0], u1[1]), pk2(u1[2], u1[3]), pk2(u1[4], u1[5]), pk2(u1[6], u1[7])};
            up[3] = (u32x4){pk2(u1[8], u1[9]), pk2(u1[10], u1[11]), pk2(u1[12], u1[13]), pk2(u1[14], u1[15])};
        }
        bf16_t* KGT = (bf16_t*)(HB + GD_KGT) + (size_t)u * 8192;
        const int gq = lane >> 4;
        const unsigned kb0 = (unsigned)(size_t)smem + 32768u + (unsigned)(q4 * 256 + gq * 32 + 8 * p);
#pragma unroll
        for (int it2 = 0; it2 < 8; ++it2) {
            const int job = wid * 8 + it2, s0 = (job & 15) * 4, dkb = (job >> 4) * 64;
            s16x4 v;
            const unsigned ad = kb0 + s0 * 256 + dkb * 2;
            asm volatile("ds_read_b64_tr_b16 %0, %1\n\ts_waitcnt lgkmcnt(0)" : "=&v"(v) : "v"(ad) : "memory");
            *(s16x4*)(KGT + (size_t)(dkb + gq * 16 + i16) * 64 + s0) = v;
        }
    }
}

constexpr size_t GC_ST = 0, GC_VT = (size_t)1024 * 32768;
__device__ __forceinline__ void gdc_passB(int bh, const unsigned char* HB, unsigned char* YB, const Ctx& c) {
    const int lane = c.lane, wid = __builtin_amdgcn_readfirstlane(c.wid);
    const int h5 = lane >> 5, r = lane & 31;
    unsigned char* smem = c.smem;
    f32x16 S0, S1, S2, S3;
#pragma unroll
    for (int i = 0; i < 16; ++i) { S0[i] = 0.f; S1[i] = 0.f; S2[i] = 0.f; S3[i] = 0.f; }
    const size_t u0 = (size_t)bh * 32;
#define GB_STAGE(n_, p_) do { const bf16_t* wn_ = (const bf16_t*)(HB + GD_WN) + (u0 + (n_)) * 8192; const bf16_t* kg_ = (const bf16_t*)(HB + GD_KGT) + (u0 + (n_)) * 8192; \
        unsigned char* bp_ = smem + (p_) * 32768; \
        _Pragma("unroll") for (int i = 0; i < 4; ++i) { const int jj = wid * 4 + i, row = 4 * jj + (lane >> 4), ch = (lane & 15) ^ (row & 15); \
            glds16(wn_ + row * 128 + ch * 8, bp_ + jj * 1024 + lane * 16); } \
        _Pragma("unroll") for (int i = 0; i < 4; ++i) { const int jj = wid * 4 + i, row = 8 * jj + (lane >> 3), ch = (lane & 7) ^ ((row >> 1) & 7); \
            glds16(kg_ + row * 64 + ch * 8, bp_ + 16384 + jj * 1024 + lane * 16); } } while (0)
#define LD128(base_, R_, ks_) __builtin_shufflevector(*(const s16x4*)((base_) + (R_) * 256 + (((2 * (ks_)) ^ (rl & 15)) << 4) + 8 * hl), \
                                                      *(const s16x4*)((base_) + (R_) * 256 + (((2 * (ks_) + 1) ^ (rl & 15)) << 4) + 8 * hl), 0, 1, 2, 3, 4, 5, 6, 7)
#define LD64(base_, R_, k2_) __builtin_shufflevector(*(const s16x4*)((base_) + (R_) * 128 + (((2 * (k2_)) ^ ((rl >> 1) & 7)) << 4) + 8 * hl), \
                                                     *(const s16x4*)((base_) + (R_) * 128 + (((2 * (k2_) + 1) ^ ((rl >> 1) & 7)) << 4) + 8 * hl), 0, 1, 2, 3, 4, 5, 6, 7)
    u32x4 uu[4];
#define GB_LOADU(n_) do { const u32x4* up_ = (const u32x4*)((const bf16_t*)(HB + GD_UU) + (u0 + (n_)) * 8192 + (size_t)(wid * 64 + lane) * 32); \
        uu[0] = up_[0]; uu[1] = up_[1]; uu[2] = up_[2]; uu[3] = up_[3]; } while (0)
    __syncthreads();
    GB_STAGE(0, 0);
    GB_LOADU(0);
#pragma unroll 1
    for (int n2 = 0; n2 < 16; ++n2) {
#pragma unroll
        for (int PBUF = 0; PBUF < 2; ++PBUF) {
        const int n = 2 * n2 + PBUF;
        const float gl = ((const float*)(HB + GD_GL))[u0 + n];
        if (n == 0) asm volatile("s_waitcnt vmcnt(0)" ::: "memory"); else asm volatile("s_waitcnt vmcnt(24)" ::: "memory");
        asm volatile("s_waitcnt lgkmcnt(0)" ::: "memory"); __builtin_amdgcn_s_barrier(); asm volatile("" ::: "memory");
        f32x16 v0, v1;
#pragma unroll
        for (int q = 0; q < 2; ++q) {
            const u32x4 a = uu[q], bq = uu[2 + q];
            v0[8 * q + 0] = bflo(a.x); v0[8 * q + 1] = bfhi(a.x); v0[8 * q + 2] = bflo(a.y); v0[8 * q + 3] = bfhi(a.y);
            v0[8 * q + 4] = bflo(a.z); v0[8 * q + 5] = bfhi(a.z); v0[8 * q + 6] = bflo(a.w); v0[8 * q + 7] = bfhi(a.w);
            v1[8 * q + 0] = bflo(bq.x); v1[8 * q + 1] = bfhi(bq.x); v1[8 * q + 2] = bflo(bq.y); v1[8 * q + 3] = bfhi(bq.y);
            v1[8 * q + 4] = bflo(bq.z); v1[8 * q + 5] = bfhi(bq.z); v1[8 * q + 6] = bflo(bq.w); v1[8 * q + 7] = bfhi(bq.w);
        }
        if (n + 1 < 32) { GB_STAGE(n + 1, (PBUF ^ 1)); GB_LOADU(n + 1); }
        int rl = r, hl = h5; asm volatile("" : "+v"(rl), "+v"(hl));
        const unsigned char* WNb = smem + PBUF * 32768; const unsigned char* KGb = WNb + 16384;
        {
            bf16_t* st = (bf16_t*)(YB + GC_ST) + (u0 + n) * 16384 + (size_t)h5 * 512 + (size_t)(wid * 32 + r) * 4;
#define ST_TILE(SX, dt_) do { _Pragma("unroll") for (int g = 0; g < 4; ++g) \
                *(u32x2*)(st + ((dt_) * 8 + 2 * g) * 512) = (u32x2){cvt_pk(SX[4 * g], SX[4 * g + 1]), cvt_pk(SX[4 * g + 2], SX[4 * g + 3])}; } while (0)
            ST_TILE(S0, 0); ST_TILE(S1, 1); ST_TILE(S2, 2); ST_TILE(S3, 3);
#undef ST_TILE
        }
        {
            bf16x8 fa0, fb0, fa1, fb1, fa2, fb2;
#define LDV(FA, FB, ks_) do { FA = LD128(WNb, rl, ks_); FB = LD128(WNb, 32 + rl, ks_); } while (0)
#define MMV(SX, HF, FA, FB) do { const bf16x8 sbk = pack_step<HF>(SX); v0 = MFMA32(FA, sbk, v0); v1 = MFMA32(FB, sbk, v1); } while (0)
            LDV(fa0, fb0, 0); LDV(fa1, fb1, 1); LDV(fa2, fb2, 2);
            MMV(S0, 0, fa0, fb0); LDV(fa0, fb0, 3);
            MMV(S0, 1, fa1, fb1); LDV(fa1, fb1, 4);
            MMV(S1, 0, fa2, fb2); LDV(fa2, fb2, 5);
            MMV(S1, 1, fa0, fb0); LDV(fa0, fb0, 6);
            MMV(S2, 0, fa1, fb1); LDV(fa1, fb1, 7);
            MMV(S2, 1, fa2, fb2);
            MMV(S3, 0, fa0, fb0);
            MMV(S3, 1, fa1, fb1);
#undef LDV
#undef MMV
        }
        const bf16x8 vb0 = pack_step_m<0>(v0), vb1 = pack_step_m<1>(v0), vb2 = pack_step_m<0>(v1), vb3 = pack_step_m<1>(v1);
        {
            bf16_t* vt = (bf16_t*)(YB + GC_VT) + (u0 + n) * 8192 + (size_t)h5 * 512 + (size_t)(wid * 32 + r) * 4;
            const u32x4 p0 = __builtin_bit_cast(u32x4, vb0), p1 = __builtin_bit_cast(u32x4, vb1), p2 = __builtin_bit_cast(u32x4, vb2), p3 = __builtin_bit_cast(u32x4, vb3);
            *(u32x2*)(vt + 0 * 512) = (u32x2){p0.x, p0.y};  *(u32x2*)(vt + 2 * 512) = (u32x2){p0.z, p0.w};
            *(u32x2*)(vt + 4 * 512) = (u32x2){p1.x, p1.y};  *(u32x2*)(vt + 6 * 512) = (u32x2){p1.z, p1.w};
            *(u32x2*)(vt + 8 * 512) = (u32x2){p2.x, p2.y};  *(u32x2*)(vt + 10 * 512) = (u32x2){p2.z, p2.w};
            *(u32x2*)(vt + 12 * 512) = (u32x2){p3.x, p3.y}; *(u32x2*)(vt + 14 * 512) = (u32x2){p3.z, p3.w};
        }
        asm volatile("" ::: "memory"); asm volatile("" : "+v"(rl), "+v"(hl));
        S0 *= gl; S1 *= gl; S2 *= gl; S3 *= gl;
        {
            bf16x8 g0, g1, g2;
            g0 = LD64(KGb, rl, 0); g1 = LD64(KGb, rl, 1); g2 = LD64(KGb, rl, 2);
            S0 = MFMA32(g0, vb0, S0); g0 = LD64(KGb, rl, 3);
            S0 = MFMA32(g1, vb1, S0); g1 = LD64(KGb, 32 + rl, 0);
            S0 = MFMA32(g2, vb2, S0); g2 = LD64(KGb, 32 + rl, 1);
            S0 = MFMA32(g0, vb3, S0); g0 = LD64(KGb, 32 + rl, 2);
            S1 = MFMA32(g1, vb0, S1); g1 = LD64(KGb, 32 + rl, 3);
            S1 = MFMA32(g2, vb1, S1); g2 = LD64(KGb, 64 + rl, 0);
            S1 = MFMA32(g0, vb2, S1); g0 = LD64(KGb, 64 + rl, 1);
            S1 = MFMA32(g1, vb3, S1); g1 = LD64(KGb, 64 + rl, 2);
            S2 = MFMA32(g2, vb0, S2); g2 = LD64(KGb, 64 + rl, 3);
            S2 = MFMA32(g0, vb1, S2); g0 = LD64(KGb, 96 + rl, 0);
            S2 = MFMA32(g1, vb2, S2); g1 = LD64(KGb, 96 + rl, 1);
            S2 = MFMA32(g2, vb3, S2); g2 = LD64(KGb, 96 + rl, 2);
            S3 = MFMA32(g0, vb0, S3); g0 = LD64(KGb, 96 + rl, 3);
            S3 = MFMA32(g1, vb1, S3);
            S3 = MFMA32(g2, vb2, S3);
            S3 = MFMA32(g0, vb3, S3);
        }
        }
    }
#undef GB_STAGE
#undef LD128
#undef LD64
#undef GB_LOADU
}

__device__ __forceinline__ void gdc_passB_idle() {
    __syncthreads();
    for (int n = 0; n < 32; ++n) { asm volatile("" ::: "memory"); __builtin_amdgcn_s_barrier(); asm volatile("" ::: "memory"); }
}

__device__ __forceinline__ void gdc_passC(int u, const unsigned char* HB, const unsigned char* YB, const bf16_t* PROJ, const float* gnorm, bf16_t* MIXO, const Ctx& c) {
    const int bh = u >> 5, b = bh >> 2, h = bh & 3;
    const size_t t0 = (size_t)b * SEQ + (u & 31) * 64;
    const int lane = c.lane, wid = __builtin_amdgcn_readfirstlane(c.wid);
    const int h5 = lane >> 5, r = lane & 31;
    float* sqL = (float*)c.smem;
    const bf16_t* ST = (const bf16_t*)(YB + GC_ST) + (size_t)u * 16384 + (size_t)(2 * h5) * 512 + (size_t)(wid * 32 + r) * 4;
    const bf16_t* VT = (const bf16_t*)(YB + GC_VT) + (size_t)u * 8192 + (size_t)(2 * h5) * 512 + (size_t)(wid * 32 + r) * 4;
    const bf16_t* QG = (const bf16_t*)(HB + GD_QG) + (size_t)u * 8192 + (size_t)r * 128 + 8 * h5;
    const bf16_t* AT = (const bf16_t*)(HB + GD_AT) + (size_t)u * 4096 + (size_t)r * 64 + 8 * h5;
    f32x16 o0, o1;
#pragma unroll
    for (int i = 0; i < 16; ++i) { o0[i] = 0.f; o1[i] = 0.f; }
#pragma unroll
    for (int ks = 0; ks < 8; ++ks) {
        const bf16x8 sa = __builtin_shufflevector(*(const s16x4*)(ST + (4 * ks) * 512), *(const s16x4*)(ST + (4 * ks + 1) * 512), 0, 1, 2, 3, 4, 5, 6, 7);
        const bf16x8 q0 = *(const bf16x8*)(QG + ks * 16), q1 = *(const bf16x8*)(QG + 32 * 128 + ks * 16);
        o0 = MFMA32(sa, q0, o0); o1 = MFMA32(sa, q1, o1);
        if (ks == 3) asm volatile("" ::: "memory");
    }
#pragma unroll
    for (int k2 = 0; k2 < 4; ++k2) {
        const bf16x8 va = __builtin_shufflevector(*(const s16x4*)(VT + (4 * k2) * 512), *(const s16x4*)(VT + (4 * k2 + 1) * 512), 0, 1, 2, 3, 4, 5, 6, 7);
        const bf16x8 a1 = *(const bf16x8*)(AT + 32 * 64 + k2 * 16);
        o1 = MFMA32(va, a1, o1);
        if (k2 < 2) { const bf16x8 a0 = *(const bf16x8*)(AT + k2 * 16); o0 = MFMA32(va, a0, o0); }
    }
    float s0 = 0.f, s1 = 0.f;
#pragma unroll
    for (int i = 0; i < 16; ++i) { s0 += o0[i] * o0[i]; s1 += o1[i] * o1[i]; }
    s0 += shfl_xor_(s0, 32); s1 += shfl_xor_(s1, 32);
    __syncthreads();
    if (h5 == 0) { sqL[wid * 64 + r] = s0; sqL[wid * 64 + 32 + r] = s1; }
    __syncthreads();
    const float rr0 = rsqrtf((sqL[r] + sqL[64 + r] + sqL[128 + r] + sqL[192 + r]) * (1.f / 128.f) + 1e-6f);
    const float rr1 = rsqrtf((sqL[32 + r] + sqL[96 + r] + sqL[160 + r] + sqL[224 + r]) * (1.f / 128.f) + 1e-6f);
#pragma unroll
    for (int tt = 0; tt < 2; ++tt) {
        const size_t t = t0 + tt * 32 + r;
        const bf16_t* zrow = PROJ + t * NPAD + 1960 + h * 128 + wid * 32 + 4 * h5;
        const float* gn = gnorm + wid * 32 + 4 * h5;
        bf16_t* orow = MIXO + t * 1024 + 512 + h * 128 + wid * 32 + 4 * h5;
        const float rr = tt ? rr1 : rr0;
#pragma unroll
        for (int g = 0; g < 4; ++g) {
            const u32x2 zr = *(const u32x2*)(zrow + 8 * g);
            const f32x4 gv = *(const f32x4*)(gn + 8 * g);
            const float z0 = bflo(zr.x), z1 = bfhi(zr.x), z2 = bflo(zr.y), z3 = bfhi(zr.y);
            const float y0 = (tt ? o1[4 * g] : o0[4 * g]) * rr * gv[0] * siluf_(z0), y1 = (tt ? o1[4 * g + 1] : o0[4 * g + 1]) * rr * gv[1] * siluf_(z1);
            const float y2 = (tt ? o1[4 * g + 2] : o0[4 * g + 2]) * rr * gv[2] * siluf_(z2), y3 = (tt ? o1[4 * g + 3] : o0[4 * g + 3]) * rr * gv[3] * siluf_(z3);
            *(u32x2*)(orow + 8 * g) = (u32x2){pk2(y0, y1), pk2(y2, y3)};
        }
    }
}

__device__ __forceinline__ void phase_post(const float* OG, const bf16_t* PROJ, const float* gain, bool odd, bf16_t* MIXO, const Ctx& c) {
    const int lane = c.lane;
    const int gcol = odd ? 1032 : 1960, ocol = odd ? 0 : 512;
    for (int t = c.bid * 4 + c.wid; t < T; t += c.nblk * 4) {
        const f32x4 a0 = *(const f32x4*)(OG + (size_t)t * 512 + lane * 8), a1 = *(const f32x4*)(OG + (size_t)t * 512 + lane * 8 + 4);
        float ss = (a0[0] * a0[0] + a0[1] * a0[1]) + (a0[2] * a0[2] + a0[3] * a0[3]) + (a1[0] * a1[0] + a1[1] * a1[1]) + (a1[2] * a1[2] + a1[3] * a1[3]);
        ss = red16(ss);
        const float rr = rsqrtf(ss * (1.f / 128.f) + 1e-6f);
        const u32x4 zr = *(const u32x4*)(PROJ + (size_t)t * NPAD + gcol + lane * 8);
        float z[8]; unpack8(zr, z);
        const int gi = odd ? lane * 8 : (lane & 15) * 8;
        const f32x4 g0 = *(const f32x4*)(gain + gi), g1 = *(const f32x4*)(gain + gi + 4);
        float y[8];
#pragma unroll
        for (int j = 0; j < 4; ++j) {
            const float ga = odd ? sigmoidf_(z[j]) : siluf_(z[j]), gb = odd ? sigmoidf_(z[4 + j]) : siluf_(z[4 + j]);
            y[j] = a0[j] * rr * g0[j] * ga; y[4 + j] = a1[j] * rr * g1[j] * gb;
        }
        *(u32x4*)(MIXO + (size_t)t * 1024 + ocol + lane * 8) = (u32x4){pk2(y[0], y[1]), pk2(y[2], y[3]), pk2(y[4], y[5]), pk2(y[6], y[7])};
    }
}

__global__ void __launch_bounds__(512, 2) fwd(Args a) {
    extern __shared__ __attribute__((aligned(16))) unsigned char smem[];
    Ctx c;
    const int wave_s = __builtin_amdgcn_readfirstlane((int)threadIdx.x >> 6);
#define SET_CTX(cx) do { int t_ = (wave_s << 6) | lane_id_v(); cx.tid0 = t_; cx.half = t_ >> 8; cx.tid = t_ & 255; cx.lane = t_ & 63; cx.wid = (t_ >> 6) & 3; \
        cx.wr = cx.wid >> 1; cx.wc = cx.wid & 1; cx.fr = cx.lane & 15; cx.fq = cx.lane >> 4; cx.bid = blockIdx.x * 2 + cx.half; cx.nblk = gridDim.x * 2; \
        cx.smem0 = smem; cx.smem = smem + cx.half * HALF_LDS; } while (0)
    SET_CTX(c);
#define PH_CTX() SET_CTX(c)
    unsigned char* const ws_base = a.ws;
    const void* const* const ain_base = (const void* const*)__builtin_amdgcn_kernarg_segment_ptr();
    unsigned* ctl = (unsigned*)(ws_base + WS_CTL);
    volatile LAS unsigned* xbw = (volatile LAS unsigned*)(smem + LDS_BLK);
    if (c.tid0 < 8) xbw[c.tid0] = 0u;
    __syncthreads();
    XcdBarrier bar; bar.bar = ctl; bar.x = 0; bar.st = xbw; bar.wave = wave_s;
    if (a.use_bar) bar = xcd_barrier_post(ctl, xbw, c.tid0);
#if ONE_LAUNCH
    const int hi = NPH;
#define IN(k) true
#else
    const int lo = a.ph_lo, hi = a.ph_hi;
#define IN(k) (lo <= (k) && (k) < hi)
#endif
#define PH(k) if (IN(k)) { PH_CTX(); unsigned char* ws = ws_base; const void* const* ain = ain_base; asm volatile("" : "+s"(ws), "+s"(ain));
#define UNIT_CTX() Ctx cu; SET_CTX(cu)
#define SEAM(k) do { if ((k) + 1 < hi) xcd_barrier(bar); } while (0)

#define XBF ((bf16_t*)(ws + WS_XBF))
#define X1 ((float*)(ws + WS_X1))
#define PROJ ((bf16_t*)(ws + U_PROJ))
#define GATES ((float*)(ws + U_GATES))
#define MIXO ((bf16_t*)(ws + U_MIXO))
#define YBUF ((float*)(ws + U_YBUF))
#define ROPEM ((const float*)(ws + WS_ROPEM))
#define ROPES ((const float*)(ws + WS_ROPES))
#define XRES ((layer == 0) ? (const float*)ain[0] : (const float*)a.out)
#define CNT (ctl + CW_CNT + layer * 128)
#define WIN ((const bf16_t*)(ws + WS_WIN) + (size_t)layer * WIN_ELEMS)
#define WOUT ((const bf16_t*)(ws + WS_WOUT) + (size_t)layer * WOUT_ELEMS)

    PH(0) for (int rep = 0; rep < REP_PRO; ++rep) phase_prologue(a, c); SEAM(0); }

    for (int layer = 0; layer < 4; ++layer) {
        const int pb = 1 + layer * PPL;
#if !ONE_LAUNCH
        if (pb >= hi || pb + PPL <= lo) continue;
#endif
        const int jj = layer >> 1;
        const bool odd = (layer & 1) != 0;

        PH(pb + 0) {
                DenseSched S{T / 256, NPAD / 256, 1024, (int)blockIdx.x, (int)gridDim.x};
                EpiIn E{PROJ, GATES, odd ? 1024 : 1952};
                g8::phase<1, false, false>(smem, (const char*)XBF, (const char*)WIN, 1024, S, E, c.tid0);
            }
            SEAM(pb + 0); }
        PH(pb + 1) for (int rp = 0; rp < ((REP_PHASE == 1) ? 2 : 1); ++rp) { if (rp) xcd_barrier(bar);
            if (!odd) phase_prep_even(PROJ, GATES, (const float*)ain[3] + jj * 256, (const float*)ain[5] + jj * 128, (const float*)ain[7] + jj * 4 * 1536,
                                      (const float*)ain[8] + jj * 4, (const float*)ain[9] + jj * 4, ROPEM,
                                      (bf16_t*)(ws + U_CQ), (bf16_t*)(ws + U_CKV), (bf16_t*)(ws + U_KROPE), (bf16_t*)(ws + U_GQ), (bf16_t*)(ws + U_GK), (bf16_t*)(ws + U_GV),
                                      (float*)(ws + U_BETA), (float*)(ws + U_GLOG), c);
            else {
                phase_prep_odd(PROJ, ROPES, (bf16_t*)(ws + U_QF), (bf16_t*)(ws + U_KN), c);
                unsigned* ctr = ctl + CW_WORK + pb + 1 + 64 * rp;
                for (;;) {
                    const int u = next_unit(ctr, c); UNIT_CTX();
                    if (u >= 1024) break;
                    mlc_passA(u, PROJ, GATES, (const float*)ain[13] + jj * 4, (const float*)ain[14] + jj * 4, (unsigned char*)YBUF, cu);
                }
            }
            }
            SEAM(pb + 1);
        }
        PH(pb + 2) for (int rp = 0; rp < ((REP_PHASE == 2) ? 2 : 1); ++rp) { if (rp) xcd_barrier(bar);
            unsigned* ctr = ctl + CW_WORK + pb + 2 + 64 * rp;
            if (!odd) {
                for (;;) {
                    const int u = next_unit(ctr, c); UNIT_CTX();
                    if (u >= 1024 + MLAUP_TILES) break;
                    if (u < 1024) gdc_passA(u, (const bf16_t*)(ws + U_GQ), (const bf16_t*)(ws + U_GK), (const bf16_t*)(ws + U_GV), (const float*)(ws + U_BETA),
                                            (const float*)(ws + U_GLOG), ws + WS_HBUF, cu);
                    else mla_up_tile(u - 1024, (const bf16_t*)(ws + U_CQ), (const bf16_t*)(ws + WS_WQB) + (size_t)jj * WQB_ELEMS, (const bf16_t*)(ws + U_CKV),
                                     (const bf16_t*)(ws + WS_WKVB) + (size_t)jj * WKVB_ELEMS, ROPEM, (bf16_t*)(ws + U_QF), (bf16_t*)(ws + U_KN), (bf16_t*)(ws + U_VV), cu);
                }
            } else {
                for (;;) {
                    const int u = next_unit(ctr, c); UNIT_CTX();
                    if (u >= 256 + 1024) break;
                    if (u < 256) mlc_passB(u, (unsigned char*)YBUF, cu);
                    else {
                        const int v = u - 256, hq = v & 7, n = (v >> 3) & 15, b = v >> 7, kvh = hq >> 2;
                        const size_t tb = (size_t)b * SEQ;
                        attn_unit<4, true>((const bf16_t*)(ws + U_QF) + tb * 512 + hq * 64, 512, (const bf16_t*)(ws + U_KN) + tb * 128 + kvh * 64, 128,
                                           (const bf16_t*)(ws + U_KN), 0, PROJ + tb * NPAD + 2184 + kvh * 64, NPAD,
                                           MIXO + tb * 1024 + 512 + hq * 64, 1024, n * 128, ((const float*)ain[16])[jj * 8 + hq] * 1.4426950408889634f, cu);
                    }
                }
            }
            }
            SEAM(pb + 2);
        }
        PH(pb + 3) for (int rp = 0; rp < ((REP_PHASE == 3) ? 2 : 1); ++rp) { if (rp) xcd_barrier(bar);
            unsigned* ctr = ctl + CW_WORK + pb + 3 + 64 * rp;
            if (!odd) {
                for (;;) {
                    const int u = next_unit(ctr, c); UNIT_CTX();
                    if (u >= 64 + 1024) break;
                    if (rp > 0 && ((REP_ONLY == 1 && u >= 64) || (REP_ONLY == 2 && u < 64))) continue;
                    if (u < 64) { if ((u & 1) == 0) gdc_passB(u >> 1, ws + WS_HBUF, (unsigned char*)YBUF, cu); else gdc_passB_idle(); }
                    else {
                        const int v = u - 64, qb = 15 - (v >> 6), bh = v & 63, b = bh >> 3, hh = bh & 7;
                        const size_t tb = (size_t)b * SEQ;
                        attn_unit<6, false>((const bf16_t*)(ws + U_QF) + tb * 768 + hh * 96, 768, (const bf16_t*)(ws + U_KN) + tb * 512 + hh * 64, 512,
                                            (const bf16_t*)(ws + U_KROPE) + tb * 32, 32, (const bf16_t*)(ws + U_VV) + tb * 512 + hh * 64, 512,
                                            MIXO + tb * 1024 + hh * 64, 1024, qb * 128, 0.f, cu);
                    }
                }
            } else {
                for (;;) {
                    const int u = next_unit(ctr, c); UNIT_CTX();
                    if (u >= 1024) break;
                    mlc_passC(u, PROJ, GATES, (const float*)ain[13] + jj * 4, (const float*)ain[14] + jj * 4, (const unsigned char*)YBUF, (const float*)ain[15] + jj * 512, MIXO, cu);
                }
            }
            }
            SEAM(pb + 3);
        }
        PH(pb + 4) for (int rp = 0; rp < ((REP_PHASE == 4) ? 2 : 1); ++rp) { if (rp) xcd_barrier(bar);
            if (!odd) {
                unsigned* ctr = ctl + CW_WORK + pb + 4 + 64 * rp;
                for (;;) {
                    const int u = next_unit(ctr, c); UNIT_CTX();
                    if (u >= 1024) break;
                    gdc_passC(u, ws + WS_HBUF, (const unsigned char*)YBUF, PROJ, (const float*)ain[10] + jj * 128, MIXO, cu);
                }
            }
            }
            if (!odd) SEAM(pb + 4);
        }
        PH(pb + 5) {
                DenseSched S{T / 256, 4, 1024, (int)blockIdx.x, (int)gridDim.x};
                EpiOut E{XBF, (bf16_t*)YBUF};
                g8::phase<1, false, false>(smem, (const char*)MIXO, (const char*)WOUT, 1024, S, E, c.tid0);
            }
            SEAM(pb + 5); }
#if FUSE_LNROUTE
        PH(pb + 6) phase_lnroute((const bf16_t*)YBUF, (const float*)ain[18] + layer * 1024, (const float*)ain[19] + layer * 1024, XBF, (const bf16_t*)(ws + WS_WRT) + (size_t)layer * WRT_ELEMS,
                                 (const float*)ain[21] + layer * 64, CNT, (int*)(ws + WS_LTOK), (float*)(ws + WS_LW), (int*)(ws + WS_ASG), (float*)(ws + WS_ASGW), c); SEAM(pb + 8); }
#else
        PH(pb + 6) for (int rep = 0; rep < REP_TOK; ++rep) phase_ln1((const bf16_t*)YBUF, (const float*)ain[18] + layer * 1024, (const float*)ain[19] + layer * 1024, XBF, c); SEAM(pb + 6); }
        PH(pb + 7) for (int rep = 0; rep < REP_GEMM; ++rep) phase_router(XBF, (const bf16_t*)(ws + WS_WRT) + (size_t)layer * WRT_ELEMS, (float*)(ws + WS_LOG), c); SEAM(pb + 7); }
        PH(pb + 8) phase_route((const float*)(ws + WS_LOG), (const float*)ain[21] + layer * 64, CNT, (int*)(ws + WS_LTOK), (float*)(ws + WS_LW), (int*)(ws + WS_ASG), (float*)(ws + WS_ASGW), c); SEAM(pb + 8); }
#endif
        PH(pb + 9) {
                int* bst8 = (int*)(smem + LDS_BLK + 64); int* eb8 = bst8 + 256;
                build_block_table(CNT, bst8, c);
                for (int rb = c.tid0; rb < bst8[65]; rb += NT) { int e = 0; for (int q = 1; q < 65; ++q) e += (bst8[q] <= rb) ? 1 : 0; eb8[rb] = e; }
                __syncthreads();
                MoeSchedG S{__builtin_amdgcn_readfirstlane(bst8[65]), (int)blockIdx.x, (int)gridDim.x, eb8, bst8, (const int*)(ws + WS_LTOK)};
#if MOE2_F8
                EpiMoe1F8 E{(unsigned char*)(ws + WS_HBUF)};
#else
                EpiMoe1 E{(bf16_t*)(ws + WS_HBUF)};
#endif
                g8::phase<0, true, false>(smem, (const char*)XBF, (const char*)((const bf16_t*)(ws + WS_WGU) + (size_t)layer * 65 * WGU_ELEMS), 1024, S, E, c.tid0);
            }
            SEAM(pb + 9); }
        PH(pb + 10)
#if MOE2_G8
            {
                int* bst8 = (int*)(smem + LDS_BLK + 64); int* eb8 = bst8 + 256;
                build_block_table(CNT, bst8, c);
                for (int rb = c.tid0; rb < bst8[65]; rb += NT) { int e = 0; for (int q = 1; q < 65; ++q) e += (bst8[q] <= rb) ? 1 : 0; eb8[rb] = e; }
                __syncthreads();
                MoeSched S{__builtin_amdgcn_readfirstlane(bst8[65]), 4, (int)blockIdx.x, (int)gridDim.x, eb8};
#if Y_FP8
                EpiMoe2F8 E{(unsigned char*)(ws + U_Y)};
#else
                EpiMoe2 E{(bf16_t*)(ws + U_Y)};
#endif
                #if MOE2_F8
                g8::phase<2, false, true>(smem, (const char*)(ws + WS_HBUF), (const char*)(ws + WS_WDN) + (size_t)layer * 65 * WDN_ELEMS, 128, S, E, c.tid0);
#else
                g8::phase<(Y_FP8 ? 2 : 1), false, false>(smem, (const char*)(ws + WS_HBUF), (const char*)((const bf16_t*)(ws + WS_WDN) + (size_t)layer * 65 * WDN_ELEMS), 256, S, E, c.tid0);
#endif
            }
#else
            phase_moe2((const bf16_t*)(ws + WS_HBUF), (const bf16_t*)(ws + WS_WDN) + (size_t)layer * 65 * WDN_ELEMS, CNT, (bf16_t*)(ws + U_Y), c);
#endif
            SEAM(pb + 10); }
        PH(pb + 11)
#if Y_FP8
            if (layer == 3) phase_combine8<true>((const unsigned char*)(ws + U_Y), (const int*)(ws + WS_ASG), (const float*)(ws + WS_ASGW), CNT, (const float*)ain[28] + layer * 1024, (const float*)ain[29] + layer * 1024, a.out, XBF, c);
            else phase_combine8<false>((const unsigned char*)(ws + U_Y), (const int*)(ws + WS_ASG), (const float*)(ws + WS_ASGW), CNT, (const float*)ain[28] + layer * 1024, (const float*)ain[29] + layer * 1024, a.out, XBF, c);
            SEAM(pb + 11); }
#else
            if (layer == 3) phase_combine<true>((const bf16_t*)(ws + U_Y), (const int*)(ws + WS_ASG), (const float*)(ws + WS_ASGW), CNT, (const float*)ain[28] + layer * 1024, (const float*)ain[29] + layer * 1024, a.out, XBF, c);
            else phase_combine<false>((const bf16_t*)(ws + U_Y), (const int*)(ws + WS_ASG), (const float*)(ws + WS_ASGW), CNT, (const float*)ain[28] + layer * 1024, (const float*)ain[29] + layer * 1024, a.out, XBF, c);
            SEAM(pb + 11); }
#endif
    }
#undef IN
#undef XBF
#undef X1
#undef PROJ
#undef GATES
#undef MIXO
#undef YBUF
#undef ROPEM
#undef ROPES
#undef XRES
#undef CNT
#undef WIN
#undef WOUT
#undef PH
#undef PH_CTX
#undef UNIT_CTX
#undef SEAM
}

extern "C" void kernel_launch(void* const* d_in, const int* in_sizes, int n_in, void* d_out, int out_size, void* d_ws, size_t ws_size, hipStream_t stream) {
    static int grid = 0;
    if (grid == 0) {
        if (n_in != 30 || out_size != T * 1024 || ws_size < WS_END) {
            fprintf(stderr, "kernel_launch: unexpected shapes (n_in %d, out %d, ws %zu < %zu)\n", n_in, out_size, ws_size, (size_t)WS_END);
            grid = -1; return;
        }
        int dev = 0, cus = 0, per_cu = 0;
        (void)hipGetDevice(&dev);
        (void)hipDeviceGetAttribute(&cus, hipDeviceAttributeMultiprocessorCount, dev);
        (void)hipFuncSetAttribute((const void*)fwd, hipFuncAttributeMaxDynamicSharedMemorySize, DYN_LDS);
        (void)hipOccupancyMaxActiveBlocksPerMultiprocessor(&per_cu, (const void*)fwd, NT, DYN_LDS);
        (void)hipGetLastError();
        if (per_cu < 1) per_cu = 1;
        grid = cus;
    }
    if (grid < 0) return;
    (void)hipMemsetAsync((char*)d_ws + WS_CTL, 0, CTL_BYTES, stream);
    Args a{};
    for (int i = 0; i < 30; ++i) a.in[i] = d_in[i];
    a.out = (float*)d_out; a.ws = (unsigned char*)d_ws; a.pad = 0;
#if ONE_LAUNCH
    a.ph_lo = 0; a.ph_hi = NPH; a.use_bar = 1;
    hipLaunchKernelGGL(fwd, dim3(grid), dim3(NT), DYN_LDS, stream, a);
#else
    for (int p = 0; p < NPH; ++p) {
        a.ph_lo = p; a.ph_hi = p + 1; a.use_bar = 0;
        hipLaunchKernelGGL(fwd, dim3(grid), dim3(NT), DYN_LDS, stream, a);
    }
#endif
}
```

```cpp
#include <hip/hip_runtime.h>
#include <stdint.h>
#include <stdio.h>

#define REP_GEMM 1
#define REP_PHASE 0
#define REP_G0 1
#define REP_G1 1
#define REP_G2 1
#define REP_G3 1
#define REP_MIX 1
#define REP_ONLY 0
#define REP_CMB 1
#define REP_PRO 1
#define REP_TOK 1
#define MOE2_G8 1
#ifndef G8_SPLIT
#define G8_SPLIT 0
#endif
#ifndef FUSE_LNROUTE
#define FUSE_LNROUTE 1
#endif
#ifndef Y_FP8
#define Y_FP8 1
#endif
#ifndef MOE2_F8
#define MOE2_F8 1
#endif
#ifndef ONE_LAUNCH
#define ONE_LAUNCH 1
#endif

typedef unsigned short bf16_t;
typedef short bf16x8 __attribute__((ext_vector_type(8)));
typedef float f32x4 __attribute__((ext_vector_type(4)));
typedef float f32x2 __attribute__((ext_vector_type(2)));
typedef int i32x4 __attribute__((ext_vector_type(4)));
typedef int i32x8 __attribute__((ext_vector_type(8)));
typedef unsigned u32x4 __attribute__((ext_vector_type(4)));
typedef unsigned u32x2 __attribute__((ext_vector_type(2)));
#define LAS __attribute__((address_space(3)))
#define GAS __attribute__((address_space(1)))

constexpr int T = 16384, SEQ = 2048;
constexpr int NPAD = 2560;
constexpr int CAP = 16384;
constexpr int RBR = 256;
constexpr int MAXRB = 512 + 64 + 64;
constexpr int MAXROWS = MAXRB * RBR;
constexpr float ALPHA = 1.681792830507429f;
constexpr int PPL = 12;
constexpr int NPH = 1 + 4 * PPL;
constexpr int NT = 512, NW = 8;
constexpr int HALF_LDS = 65536 + 64 + 1024;
constexpr int LDS_BLK = 2 * HALF_LDS;
constexpr int DYN_LDS = LDS_BLK + 64 + 1024 + 2560;

constexpr size_t cmax(size_t a, size_t b) { return a > b ? a : b; }
constexpr size_t WS_CTL = 0;
constexpr size_t CTL_BYTES = 65536;
constexpr size_t WS_WIN = WS_CTL + CTL_BYTES;
constexpr size_t WIN_ELEMS = (size_t)NPAD * 1024;
constexpr size_t WS_WQB = WS_WIN + 4 * WIN_ELEMS * 2;
constexpr size_t WQB_ELEMS = 768 * 256;
constexpr size_t WS_WKVB = WS_WQB + 2 * WQB_ELEMS * 2;
constexpr size_t WKVB_ELEMS = 1024 * 128;
constexpr size_t WS_WOUT = WS_WKVB + 2 * WKVB_ELEMS * 2;
constexpr size_t WOUT_ELEMS = 1024 * 1024;
constexpr size_t WS_WRT = WS_WOUT + 4 * WOUT_ELEMS * 2;
constexpr size_t WRT_ELEMS = 128 * 1024;
constexpr size_t WS_WGU = WS_WRT + 4 * WRT_ELEMS * 2;
constexpr size_t WGU_ELEMS = 512 * 1024;
constexpr size_t WS_WDN = WS_WGU + 4 * 65 * WGU_ELEMS * 2;
constexpr size_t WDN_ELEMS = 1024 * 256;
constexpr size_t WS_ROPEM = WS_WDN + 4 * 65 * WDN_ELEMS * 2;
constexpr size_t WS_ROPES = WS_ROPEM + (size_t)T * 16 * 2 * 4;
constexpr size_t WS_X1 = WS_ROPES + (size_t)T * 32 * 2 * 4;
constexpr size_t WS_XBF = WS_X1 + (size_t)T * 1024 * 4;
constexpr size_t WS_HBUF = WS_XBF + (size_t)T * 1024 * 2;
constexpr size_t WS_LOG = WS_HBUF + (size_t)MAXROWS * 256 * 2;
constexpr size_t WS_ASG = WS_LOG + (size_t)T * 64 * 4;
constexpr size_t WS_ASGW = WS_ASG + (size_t)T * 8 * 4;
constexpr size_t WS_LTOK = WS_ASGW + (size_t)T * 8 * 4;
constexpr size_t WS_LW = WS_LTOK + (size_t)65 * CAP * 4;
constexpr size_t WS_U = WS_LW + (size_t)65 * CAP * 4;
constexpr size_t U_Y = WS_U;
constexpr size_t U_PROJ = WS_U;
constexpr size_t U_GATES = U_PROJ + (size_t)T * NPAD * 2;
constexpr size_t U_CQ = U_GATES + (size_t)T * 8 * 4;
constexpr size_t U_CKV = U_CQ + (size_t)T * 256 * 2;
constexpr size_t U_KROPE = U_CKV + (size_t)T * 128 * 2;
constexpr size_t U_QF = U_KROPE + (size_t)T * 32 * 2;
constexpr size_t U_KN = U_QF + (size_t)T * 768 * 2;
constexpr size_t U_VV = U_KN + (size_t)T * 512 * 2;
constexpr size_t U_GQ = U_VV + (size_t)T * 512 * 2;
constexpr size_t U_GK = U_GQ + (size_t)T * 512 * 2;
constexpr size_t U_GV = U_GK + (size_t)T * 512 * 2;
constexpr size_t U_BETA = U_GV + (size_t)T * 512 * 2;
constexpr size_t U_GLOG = U_BETA + (size_t)T * 4 * 4;
constexpr size_t U_MIXO = U_GLOG + (size_t)T * 4 * 4;
constexpr size_t U_YBUF = U_MIXO + (size_t)T * 1024 * 2;
constexpr size_t U_END1 = U_YBUF + (size_t)T * 1024 * 4;
constexpr size_t WS_END = WS_U + cmax((size_t)MAXROWS * 1024 * 2, U_END1 - WS_U);

constexpr int CW_CNT = 4096;
constexpr int CW_WORK = 8192;

#define XB_TMO      128
#define XB_XCNT(j)  (256  + 64 * (j))
#define XB_XSUB(j)  (1280 + 64 * (j))
#define XB_XGEN(j)  (2304 + 64 * (j))
#define XB_TOP      3328
#define XB_TOPGEN   3392
#define XCD_BAR_WORDS 3456
#define XB_SPIN_CAP (1u << 18)

__device__ __forceinline__ unsigned xb_ld(unsigned* p)              { return __hip_atomic_load(p, __ATOMIC_RELAXED, __HIP_MEMORY_SCOPE_AGENT); }
__device__ __forceinline__ int lane_id_v() { int l; asm volatile("v_mbcnt_lo_u32_b32 %0, -1, 0\n\tv_mbcnt_hi_u32_b32 %0, -1, %0" : "=v"(l)); return l; }
__device__ __forceinline__ unsigned xb_add(unsigned* p, unsigned v) { return __hip_atomic_fetch_add(p, v, __ATOMIC_RELAXED, __HIP_MEMORY_SCOPE_AGENT); }
__device__ __forceinline__ unsigned xb_xcc_id() { return (unsigned)__builtin_amdgcn_s_getreg((3 << 11) | 20) & 0xFu; }
#define XB_SPIN(cond, bar) do { unsigned _sp = 0; while (cond) { __builtin_amdgcn_s_sleep(1); \
    if ((++_sp & 255u) == 0u) { if (xb_ld(&(bar)[XB_TMO])) break; if (_sp > XB_SPIN_CAP) { atomicAdd(&(bar)[XB_TMO], 1u); break; } } } } while (0)

struct XcdBarrier { unsigned* bar; unsigned x; volatile LAS unsigned* st; int wave; };

__device__ __forceinline__ XcdBarrier xcd_barrier_post(unsigned* bar, volatile LAS unsigned* st, int tid0) {
    XcdBarrier b; b.bar = bar; b.x = xb_xcc_id(); b.st = st; b.wave = __builtin_amdgcn_readfirstlane(tid0 >> 6);
    if (tid0 == 0) (void)xb_add(&bar[XB_XCNT(b.x)], 1u);
    return b;
}
__device__ __forceinline__ void xcd_barrier_complete(unsigned* bar, unsigned x, unsigned& nloc, unsigned& nx) {
    const unsigned G = gridDim.x * gridDim.y * gridDim.z;
    unsigned sum, cnt, mine, sp = 0u;
    for (;;) {
        sum = 0u; cnt = 0u; mine = 0u;
#pragma unroll
        for (unsigned j = 0; j < 16; ++j) { const unsigned c = xb_ld(&bar[XB_XCNT(j)]); sum += c; cnt += (c > 0u) ? 1u : 0u; mine = (j == x) ? c : mine; }
        if (sum == G) break;
        __builtin_amdgcn_s_sleep(1);
        if ((++sp & 255u) == 0u) { if (xb_ld(&bar[XB_TMO])) break; if (sp > XB_SPIN_CAP) { atomicAdd(&bar[XB_TMO], 1u); break; } }
    }
    nloc = mine > 0u ? mine : 1u; nx = cnt > 0u ? cnt : 1u;
}
__device__ __forceinline__ void xcd_barrier(const XcdBarrier& b) {
    asm volatile("s_waitcnt vmcnt(0)" ::: "memory");
    __syncthreads();
    if (b.wave == 0 && lane_id_v() == 0) {
        unsigned* bar = b.bar; unsigned bx = __builtin_amdgcn_readfirstlane(b.x);
        asm volatile("" : "+s"(bar), "+s"(bx));
        __builtin_amdgcn_s_waitcnt(0);
        unsigned nloc = b.st[0], nx = b.st[1];
        if (nloc == 0u) { xcd_barrier_complete(bar, bx, nloc, nx); b.st[0] = nloc; b.st[1] = nx; }
        const unsigned old = xb_add(&bar[XB_XSUB(bx)], 1u);
        const unsigned gen = old / nloc;
        if (old + 1u == (gen + 1u) * nloc) {
            __builtin_amdgcn_fence(__ATOMIC_RELEASE, "agent");
            asm volatile("s_waitcnt vmcnt(0)" ::: "memory");
            const unsigned og = xb_add(&bar[XB_TOP], 1u);
            const unsigned tg = og / nx;
            if (og + 1u == (tg + 1u) * nx) xb_add(&bar[XB_TOPGEN], 1u);
            else XB_SPIN(xb_ld(&bar[XB_TOPGEN]) == tg, bar);
            __builtin_amdgcn_fence(__ATOMIC_ACQUIRE, "agent");
            xb_add(&bar[XB_XGEN(bx)], 1u);
            asm volatile("s_waitcnt vmcnt(0)" ::: "memory");
        } else {
            XB_SPIN(xb_ld(&bar[XB_XGEN(bx)]) == gen, bar);
            __builtin_amdgcn_fence(__ATOMIC_ACQUIRE, "agent");
            asm volatile("s_waitcnt vmcnt(0)" ::: "memory");
        }
    }
    __syncthreads();
}

__device__ __forceinline__ float bf2f(unsigned v) { return __uint_as_float(v << 16); }
__device__ __forceinline__ float bflo(unsigned w) { return __uint_as_float(w << 16); }
__device__ __forceinline__ float bfhi(unsigned w) { return __uint_as_float(w & 0xffff0000u); }
__device__ __forceinline__ unsigned f2bf(float f) { unsigned u = __float_as_uint(f); u += 0x7fffu + ((u >> 16) & 1u); return u >> 16; }
__device__ __forceinline__ unsigned pk2(float lo, float hi) { return f2bf(lo) | (f2bf(hi) << 16); }
__device__ __forceinline__ unsigned cvt_pk(float lo, float hi) { unsigned r; asm volatile("v_cvt_pk_bf16_f32 %0, %1, %2" : "=v"(r) : "v"(lo), "v"(hi)); return r; }
template <class T> __device__ __forceinline__ T shfl_xor_(T v, int o) { return __builtin_bit_cast(T, __builtin_amdgcn_ds_bpermute((lane_id_v() ^ o) << 2, __builtin_bit_cast(int, v))); }
template <class T> __device__ __forceinline__ T shfl_up_(T v, int o) { const int l = lane_id_v(), s = (l - o < 0) ? l : l - o; return __builtin_bit_cast(T, __builtin_amdgcn_ds_bpermute(s << 2, __builtin_bit_cast(int, v))); }
template <class T> __device__ __forceinline__ T shfl_c_(T v, int src  ) { return __builtin_bit_cast(T, __builtin_amdgcn_readlane(__builtin_bit_cast(int, v), src)); }
__device__ __forceinline__ float wave_dpp_(float v, int ctrl_sel) {
    int x = __builtin_bit_cast(int, v), r;
    if (ctrl_sel == 0) r = __builtin_amdgcn_update_dpp(0, x, 0xB1, 0xF, 0xF, true);
    else if (ctrl_sel == 1) r = __builtin_amdgcn_update_dpp(0, x, 0x4E, 0xF, 0xF, true);
    else if (ctrl_sel == 2) r = __builtin_amdgcn_update_dpp(0, x, 0x141, 0xF, 0xF, true);
    else r = __builtin_amdgcn_update_dpp(0, x, 0x140, 0xF, 0xF, true);
    return __builtin_bit_cast(float, r);
}
__device__ __forceinline__ float wave_sum_dpp(float v) {
    v += wave_dpp_(v, 0); v += wave_dpp_(v, 1); v += wave_dpp_(v, 2); v += wave_dpp_(v, 3);
    v += shfl_xor_(v, 16); v += shfl_xor_(v, 32);
    return v;
}
__device__ __forceinline__ float wave_sum(float v) { return wave_sum_dpp(v); }
__device__ __forceinline__ float grp8_max(float v) { v = fmaxf(v, wave_dpp_(v, 0)); v = fmaxf(v, wave_dpp_(v, 1)); v = fmaxf(v, wave_dpp_(v, 2)); return v; }
__device__ __forceinline__ int grp8_min(int v) {
    v = min(v, __builtin_amdgcn_update_dpp(0, v, 0xB1, 0xF, 0xF, true)); v = min(v, __builtin_amdgcn_update_dpp(0, v, 0x4E, 0xF, 0xF, true)); v = min(v, __builtin_amdgcn_update_dpp(0, v, 0x141, 0xF, 0xF, true));
    return v;
}
__device__ __forceinline__ float sigmoidf_(float x) { return 1.f / (1.f + expf(-x)); }
__device__ __forceinline__ float siluf_(float x) { return x / (1.f + expf(-x)); }
__device__ __forceinline__ float softplusf_(float x) { return x > 20.f ? x : log1pf(expf(x)); }
__device__ __forceinline__ void glds16(const void* g, void* l) {
    __builtin_amdgcn_global_load_lds((const GAS unsigned*)g, (LAS unsigned*)l, 16, 0, 0);
}
__device__ __forceinline__ void unpack8(const u32x4 r, float (&f)[8]) {
    f[0] = bflo(r.x); f[1] = bfhi(r.x); f[2] = bflo(r.y); f[3] = bfhi(r.y);
    f[4] = bflo(r.z); f[5] = bfhi(r.z); f[6] = bflo(r.w); f[7] = bfhi(r.w);
}

struct Args {
    const void* in[30];
    float* out;
    unsigned char* ws;
    int ph_lo, ph_hi, use_bar, pad;
};

struct Ctx { int tid, lane, wid, wr, wc, fr, fq, bid, nblk; unsigned char* smem; int half, tid0; unsigned char* smem0; };

#define WAIT_V(n) asm volatile("s_waitcnt vmcnt(" #n ")" ::: "memory")
__device__ __forceinline__ void gemm_tile(const bf16_t* a0, const bf16_t* a1, const bf16_t* b0, const bf16_t* b1,
                                          int nk, f32x4 (&acc)[4][4], const Ctx& c) {
#pragma unroll
    for (int m = 0; m < 4; ++m)
#pragma unroll
        for (int n = 0; n < 4; ++n) acc[m][n] = (f32x4){0.f, 0.f, 0.f, 0.f};
    unsigned char* smem = c.smem;
    const int sb = c.tid * 16;
    const int kofs = ((c.tid & 3) ^ ((c.tid >> 4) & 3)) * 8;
    a0 += kofs; a1 += kofs; b0 += kofs; b1 += kofs;
#define G_STAGE(kt_) do { unsigned char* sp_ = smem + ((kt_) & 3) * 16384 + sb; const int ko_ = (kt_) * 32; \
        glds16(a0 + ko_, sp_); glds16(a1 + ko_, sp_ + 4096); glds16(b0 + ko_, sp_ + 8192); glds16(b1 + ko_, sp_ + 12288); } while (0)
#define G_READ(kt_, AF, BF) do { const unsigned char* sa_ = smem + ((kt_) & 3) * 16384 + c.wr * 4096 + roff; const unsigned char* sb_ = smem + ((kt_) & 3) * 16384 + 8192 + c.wc * 4096 + roff; \
        _Pragma("unroll") for (int m = 0; m < 4; ++m) AF[m] = *(const bf16x8*)(sa_ + m * 1024); \
        _Pragma("unroll") for (int n = 0; n < 4; ++n) BF[n] = *(const bf16x8*)(sb_ + n * 1024); } while (0)
#define G_MMA(AF, BF) do { __builtin_amdgcn_s_setprio(1); \
        _Pragma("unroll") for (int m = 0; m < 4; ++m) _Pragma("unroll") for (int n = 0; n < 4; ++n) acc[m][n] = __builtin_amdgcn_mfma_f32_16x16x32_bf16(BF[n], AF[m], acc[m][n], 0, 0, 0); \
        __builtin_amdgcn_s_setprio(0); } while (0)
#define G_BAR() do { asm volatile("" ::: "memory"); __builtin_amdgcn_s_barrier(); asm volatile("" ::: "memory"); } while (0)
    const int roff = (c.fr * 64) + ((c.fq ^ ((c.fr >> 2) & 3)) * 16);
    WAIT_V(0);
    G_STAGE(0); G_STAGE(1); G_STAGE(2); G_STAGE(3);
    bf16x8 fa0[4], fb0[4], fa1[4], fb1[4];
    WAIT_V(12); G_BAR();
    G_READ(0, fa0, fb0);
#define G_LGK0() asm volatile("s_waitcnt lgkmcnt(0)" ::: "memory")
    int kt = 0;
    for (; kt < nk - 4; kt += 4) {
        G_LGK0(); WAIT_V(8); G_BAR(); G_STAGE(kt + 4); G_READ(1, fa1, fb1); G_MMA(fa0, fb0);
        G_LGK0(); WAIT_V(8); G_BAR(); G_STAGE(kt + 5); G_READ(2, fa0, fb0); G_MMA(fa1, fb1);
        G_LGK0(); WAIT_V(8); G_BAR(); G_STAGE(kt + 6); G_READ(3, fa1, fb1); G_MMA(fa0, fb0);
        G_LGK0(); WAIT_V(8); G_BAR(); G_STAGE(kt + 7); G_READ(0, fa0, fb0); G_MMA(fa1, fb1);
    }
    G_LGK0(); WAIT_V(8); G_BAR(); G_READ(1, fa1, fb1); G_MMA(fa0, fb0);
    G_LGK0(); WAIT_V(4); G_BAR(); G_READ(2, fa0, fb0); G_MMA(fa1, fb1);
    G_LGK0(); WAIT_V(0); G_BAR(); G_READ(3, fa1, fb1); G_MMA(fa0, fb0);
    G_MMA(fa1, fb1);
#undef G_LGK0
#undef G_STAGE
#undef G_READ
#undef G_MMA
#undef G_BAR
    __syncthreads();
}

namespace g8 {
constexpr int BM = 256, BK = 64, HALF = 128, HTB = HALF * BK * 2, STAGE_BYTES = 8 * HTB;
__device__ __forceinline__ int lds_byte(int r, int c) { const int st = (r >> 4) * 2 + (c >> 5), rr = r & 15, cc = c & 31, ob = rr * 64 + cc * 2; return st * 1024 + (ob ^ (((ob >> 9) & 1) << 5)); }
__device__ __forceinline__ void stage_rc(int b, int& R, int& C) { const int st = b / 1024, sb = b % 1024, swz = sb ^ (((sb >> 9) & 1) << 5); R = (st >> 1) * 16 + swz / 64; C = (st & 1) * 32 + (swz % 64) / 2; }
__device__ __forceinline__ int perm32(int rho) { const int n = rho >> 4, i = rho & 15; return 8 * (i >> 2) + 4 * n + (i & 3); }
struct Unit { int pm, pn, bt; };

template <int PERM, bool GATHER, bool F8, class Sched, class Epi>
__device__ __forceinline__ void phase(unsigned char* ldsp, const char* Abase, const char* Bbase, int K, const Sched& S, const Epi& E, int tid_in) {
    LAS unsigned char* lds = (LAS unsigned char*)ldsp;
    int tid = tid_in; asm volatile("" : "+v"(tid));
    const int wid = __builtin_amdgcn_readfirstlane(tid >> 6), lane = tid & 63, wr = wid >> 2, wc = wid & 3, fr = lane & 15, fq = lane >> 4;
    const int nt = K / BK;
    unsigned voffA[2], voffB[2];
#pragma unroll
    for (int i = 0; i < 2; ++i) { int R, C; stage_rc(tid * 16 + i * 8192, R, C); const int Rb = (PERM == 2) ? ((R >> 5) * 64 + ((R & 15) >> 2) * 16 + ((R >> 4) & 1) * 4 + (R & 3)) : (PERM == 1) ? ((R >> 5) * 64 + perm32(R & 31)) : (((R >> 5) * 2 + ((R & 15) >> 3)) * 32 + ((R >> 4) & 1) * 16 + (((R & 15) >> 2) & 1) * 8 + (R & 3));
        voffA[i] = (unsigned)(R * K + C) * 2u; voffB[i] = (unsigned)(Rb * K + C) * 2u; }
    const size_t kstep = (size_t)(BK * 2);
    const size_t hstep = (size_t)HALF * K * 2, tstep = 2 * hstep, bhstep = (PERM == 2) ? (size_t)8 * K * 2 : (PERM == 1) ? (size_t)32 * K * 2 : (size_t)4 * K * 2;
    const unsigned ldsw = (unsigned)wid * 1024u;
    const int aoff = F8 ? lds_byte(wr * 64 + fr, fq * 16) : lds_byte(wr * 64 + fr, fq * 8), boff = F8 ? lds_byte(wc * 32 + fr, fq * 16) : lds_byte(wc * 32 + fr, fq * 8);
    constexpr int KP = F8 ? 16 : 1024;
#define G8_SA(b, h) (((b) * 2 + (h)) * HTB)
#define G8_SB(b, h) ((4 + (b) * 2 + (h)) * HTB)
#define G8_DMA(gptr, voff32, ldsoff) do { const char* _gp = (gptr); const unsigned _lo = (unsigned)(size_t)(ldsp) + (unsigned)(ldsoff); \
        asm volatile("s_mov_b32 m0, %2\n\ts_nop 0\n\tglobal_load_lds_dwordx4 %0, %1" :: "v"(voff32), "s"(_gp), "s"(_lo) : "memory", "m0"); } while (0)
#define G8_STAGE(bufoff, gbase, voff) do { _Pragma("unroll") for (int _i = 0; _i < 2; ++_i) G8_DMA((const char*)(gbase), (voff)[_i], (bufoff) + ldsw + _i * 8192); } while (0)
#define G8_STAGEA(bufoff, gbase, h, kb) do { if constexpr (GATHER) { _Pragma("unroll") for (int _i = 0; _i < 2; ++_i) G8_DMA(Abase + (kb), vA[2 * (h) + _i], (bufoff) + ldsw + _i * 8192); } \
        else G8_STAGE(bufoff, (gbase) + (size_t)(h) * hstep + (kb), voffA); } while (0)
#define G8_LDA(dst, b, h) do { _Pragma("unroll") for (int m = 0; m < 4; ++m) _Pragma("unroll") for (int k = 0; k < 2; ++k) dst[m][k] = *(const LAS bf16x8*)(lds + G8_SA(b, h) + aoff + m * 2048 + k * KP); } while (0)
#define G8_LDB(dst, b, h) do { _Pragma("unroll") for (int n = 0; n < 2; ++n) _Pragma("unroll") for (int k = 0; k < 2; ++k) dst[n][k] = *(const LAS bf16x8*)(lds + G8_SB(b, h) + boff + n * 2048 + k * KP); } while (0)
#define G8_CAT(x, y) __builtin_shufflevector(__builtin_bit_cast(i32x4, (x)), __builtin_bit_cast(i32x4, (y)), 0, 1, 2, 3, 4, 5, 6, 7)
#define G8_MMA(ai, bj, At, Bt) do { __builtin_amdgcn_s_setprio(1); _Pragma("unroll") for (int m = 0; m < 4; ++m) _Pragma("unroll") for (int n = 0; n < 2; ++n) { \
        if constexpr (F8) acc[ai][bj][m][n] = __builtin_amdgcn_mfma_scale_f32_16x16x128_f8f6f4(G8_CAT(Bt[n][0], Bt[n][1]), G8_CAT(At[m][0], At[m][1]), acc[ai][bj][m][n], 0, 0, 0, 0, 0, 0); \
        else { _Pragma("unroll") for (int k = 0; k < 2; ++k) acc[ai][bj][m][n] = __builtin_amdgcn_mfma_f32_16x16x32_bf16(Bt[n][k], At[m][k], acc[ai][bj][m][n], 0, 0, 0); } } \
        __builtin_amdgcn_s_setprio(0); } while (0)
#define G8_WAIT_V(n) asm volatile("s_waitcnt vmcnt(" #n ")" ::: "memory")
#define G8_WAIT_L(n) asm volatile("s_waitcnt lgkmcnt(" #n ")" ::: "memory")
#define G8_BAR __builtin_amdgcn_s_barrier()
#define G8_SCHED __builtin_amdgcn_sched_barrier(0)
    Unit cur, nxt; int ui = 0;
    if (!S.next(0, cur)) return;
    f32x4 acc[2][2][4][2];
#pragma unroll
    for (int a = 0; a < 2; ++a)
#pragma unroll
        for (int b = 0; b < 2; ++b)
#pragma unroll
            for (int m = 0; m < 4; ++m)
#pragma unroll
                for (int n = 0; n < 2; ++n) acc[a][b][m][n] = (f32x4){0.f, 0.f, 0.f, 0.f};
    bf16x8 At[4][2], B0[2][2], B1[2][2];
    const char* cA = Abase + (size_t)cur.pm * tstep; const char* cB = Bbase + (size_t)cur.bt * tstep;
    unsigned vA[4] = {0u, 0u, 0u, 0u};
    if constexpr (GATHER) S.aoff(cur, tid, vA);
    asm volatile("s_waitcnt vmcnt(0)" ::: "memory");
    G8_STAGE(G8_SB(0, 0), cB, voffB); G8_STAGEA(G8_SA(0, 0), cA, 0, 0); G8_STAGE(G8_SB(0, 1), cB + bhstep, voffB); G8_STAGEA(G8_SA(0, 1), cA, 1, 0);
    if (wr == 1) G8_BAR;
    G8_WAIT_V(4); G8_BAR;
    G8_STAGE(G8_SB(1, 0), cB + kstep, voffB); G8_STAGEA(G8_SA(1, 0), cA, 0, kstep); G8_STAGE(G8_SB(1, 1), cB + bhstep + kstep, voffB);
    G8_WAIT_V(6); G8_BAR;
    G8_STAGEA(G8_SA(1, 1), cA, 1, kstep);
    for (;;) {
        const bool has_next = S.next(ui + 1, nxt);
        const char* nA = has_next ? Abase + (size_t)nxt.pm * tstep : cA; const char* nB = has_next ? Bbase + (size_t)nxt.bt * tstep : cB;
        for (int t = 0; t < nt; t += 2) {
            const bool last = (t == nt - 2);
            const int lastf = __builtin_amdgcn_readfirstlane(last ? 1 : 0);
            const size_t k2 = last ? 0 : (size_t)(t + 2) * kstep, k3 = k2 + kstep;
            const char* a2 = last ? nA : cA; const char* b2 = last ? nB : cB + (size_t)(t + 2) * kstep;
            const char* b3 = b2 + kstep;
            G8_LDB(B0, 0, 0); G8_SCHED; G8_LDA(At, 0, 0);
            if constexpr (GATHER) { if (last && has_next) S.aoff(nxt, tid, vA); }
            G8_WAIT_L(8); G8_BAR; G8_WAIT_L(0); G8_MMA(0, 0, At, B0); G8_BAR; G8_SCHED;
            G8_LDB(B1, 0, 1); G8_STAGE(G8_SB(0, 0), b2, voffB);
            G8_BAR; G8_WAIT_L(0); G8_MMA(0, 1, At, B1); G8_BAR;
            G8_LDA(At, 0, 1); G8_STAGEA(G8_SA(0, 0), a2, 0, k2);
            G8_BAR; G8_WAIT_L(0); G8_MMA(1, 0, At, B0); G8_BAR; G8_SCHED;
            G8_STAGE(G8_SB(0, 1), b2 + bhstep, voffB);
            const int pend = __builtin_amdgcn_readfirstlane((t == 0 && ui > 0) ? 1 : 0);
            asm volatile("s_cmp_lg_u32 %0, 0\n\ts_cbranch_scc1 1f\n\ts_waitcnt vmcnt(6)\n1:\n\ts_waitcnt vmcnt(%1)" :: "s"(pend), "n"(6 + (Epi::SPLIT ? Epi::NQ : Epi::NST)) : "memory", "scc");
            G8_BAR; G8_MMA(1, 1, At, B1); G8_BAR;
            G8_LDB(B0, 1, 0); G8_SCHED; G8_LDA(At, 1, 0); G8_STAGEA(G8_SA(0, 1), a2, 1, k2);
            G8_WAIT_L(8); G8_BAR; G8_WAIT_L(0); G8_MMA(0, 0, At, B0); G8_BAR; G8_SCHED;
            if constexpr (Epi::SPLIT) { E.template part_cond<0, 0>(acc, cur, wr, wc, fr, fq, lastf); G8_SCHED; }
            G8_LDB(B1, 1, 1); G8_STAGE(G8_SB(1, 0), b3, voffB);
            G8_BAR; G8_WAIT_L(0); G8_MMA(0, 1, At, B1); G8_BAR;
            if constexpr (Epi::SPLIT) { E.template part_cond<0, 1>(acc, cur, wr, wc, fr, fq, lastf); G8_SCHED; }
            G8_LDA(At, 1, 1); G8_STAGEA(G8_SA(1, 0), a2, 0, k3);
            G8_BAR; G8_WAIT_L(0); G8_MMA(1, 0, At, B0); G8_BAR; G8_SCHED;
            G8_STAGE(G8_SB(1, 1), b3 + bhstep, voffB);
            if constexpr (Epi::SPLIT) {
                asm volatile("s_cmp_lg_u32 %0, 0\n\ts_cbranch_scc1 1f\n\ts_waitcnt vmcnt(6)\n1:\n\ts_waitcnt vmcnt(%1)" :: "s"(lastf), "n"(6 + 2 * Epi::NQ) : "memory", "scc");
                G8_SCHED; E.template part_cond<1, 0>(acc, cur, wr, wc, fr, fq, lastf); G8_SCHED;
            } else G8_WAIT_V(6);
            G8_BAR; G8_MMA(1, 1, At, B1); G8_BAR;
            G8_STAGEA(G8_SA(1, 1), a2, 1, k3);
        }
        if constexpr (Epi::SPLIT) E.tail(acc, cur, wr, wc, fr, fq); else E(acc, cur, wr, wc, fr, fq);
        if (!has_next) break;
#pragma unroll
        for (int a = 0; a < 2; ++a)
#pragma unroll
            for (int b = 0; b < 2; ++b)
#pragma unroll
                for (int m = 0; m < 4; ++m)
#pragma unroll
                    for (int n = 0; n < 2; ++n) acc[a][b][m][n] = (f32x4){0.f, 0.f, 0.f, 0.f};
        cur = nxt; cA = nA; cB = nB; ++ui;
    }
    G8_WAIT_V(0);
    if (wr == 0) G8_BAR;
    G8_BAR;
#undef G8_SA
#undef G8_SB
#undef G8_STAGE
#undef G8_STAGEA
#undef G8_LDA
#undef G8_LDB
#undef G8_MMA
#undef G8_CAT
#undef G8_WAIT_V
#undef G8_WAIT_L
#undef G8_BAR
#undef G8_SCHED
}
}

__device__ __forceinline__ bool tile_map(int i, const Ctx& c, int ntm, int ntn, int& mt, int& nt) {
    const int vb = ((c.nblk & 15) == 0) ? ((c.bid >> 1) & 7) * (c.nblk >> 3) + (((c.bid >> 4) << 1) | (c.bid & 1)) : c.bid;
    const int L = i * c.nblk + vb;
    if (L >= ntm * ntn) return false;
    const int g = L / (8 * ntn), rem = L - g * 8 * ntn;
    const int gsz = (ntm - g * 8) < 8 ? (ntm - g * 8) : 8;
    mt = g * 8 + rem % gsz; nt = rem / gsz;
    return true;
}

__device__ __forceinline__ bool tile_map2(int i, const Ctx& c, int ntm, int ntn, int& mt, int& nt, bool& valid) {
    Ctx o = c; o.bid = c.bid ^ 1;
    int mo, no; const bool oko = tile_map(i, o, ntm, ntn, mo, no);
    valid = tile_map(i, c, ntm, ntn, mt, nt);
    if (!valid) { mt = 0; nt = 0; }
    return valid || oko;
}

struct DenseSched {
    int ntm, ntn, K, bid, nblk;
    __device__ __forceinline__ bool next(int i, g8::Unit& u) const {
        const int vb = ((nblk & 7) == 0) ? (bid & 7) * (nblk >> 3) + (bid >> 3) : bid;
        const int L = i * nblk + vb;
        if (L >= ntm * ntn) return false;
        const int g = L / (8 * ntn), rem = L - g * 8 * ntn;
        const int gsz = (ntm - g * 8) < 8 ? (ntm - g * 8) : 8;
        u.pm = g * 8 + rem % gsz; u.pn = rem / gsz; u.bt = u.pn;
        return true;
    }
};
struct MoeSched {
    int nrb, ntn, bid, nblk; const int* eb;
    __device__ __forceinline__ bool next(int i, g8::Unit& u) const {
        const int vb = ((nblk & 7) == 0) ? (bid & 7) * (nblk >> 3) + (bid >> 3) : bid;
        const int L = i * nblk + vb;
        if (L >= nrb * ntn) return false;
        const int g = L / (8 * ntn), rem = L - g * 8 * ntn;
        const int gsz = (nrb - g * 8) < 8 ? (nrb - g * 8) : 8;
        u.pm = g * 8 + rem % gsz; u.pn = rem / gsz;
        u.bt = __builtin_amdgcn_readfirstlane(eb[u.pm]) * ntn + u.pn;
        return true;
    }
};
struct MoeSchedG {
    int nrb, bid, nblk; const int* eb; const int* bst; const int* LTOK;
    __device__ __forceinline__ bool next(int i, g8::Unit& u) const {
        const int vb = ((nblk & 7) == 0) ? (bid & 7) * (nblk >> 3) + (bid >> 3) : bid;
        const int L = i * nblk + vb;
        if (L >= nrb * 2) return false;
        const int g = L >> 4, rem = L & 15;
        const int gsz = (nrb - g * 8) < 8 ? (nrb - g * 8) : 8;
        u.pm = g * 8 + rem % gsz; u.pn = rem / gsz;
        u.bt = __builtin_amdgcn_readfirstlane(eb[u.pm]) * 2 + u.pn;
        return true;
    }
    __device__ __forceinline__ void aoff(const g8::Unit& u, int tid, unsigned (&o)[4]) const {
        const int e = eb[u.pm], lb = u.pm - bst[e], cnt = bst[66 + e];
        int R0, C0, R1, C1; g8::stage_rc(tid * 16, R0, C0); g8::stage_rc(tid * 16 + 8192, R1, C1);
        const int* lt = LTOK + (size_t)e * CAP + lb * RBR;
        const int p00 = R0, p01 = R1, p10 = 128 + R0, p11 = 128 + R1;
        const int t00 = (lb * RBR + p00 < cnt) ? lt[p00] : 0, t01 = (lb * RBR + p01 < cnt) ? lt[p01] : 0;
        const int t10 = (lb * RBR + p10 < cnt) ? lt[p10] : 0, t11 = (lb * RBR + p11 < cnt) ? lt[p11] : 0;
        o[0] = (unsigned)t00 * 2048u + (unsigned)C0 * 2u; o[1] = (unsigned)t01 * 2048u + (unsigned)C1 * 2u;
        o[2] = (unsigned)t10 * 2048u + (unsigned)C0 * 2u; o[3] = (unsigned)t11 * 2048u + (unsigned)C1 * 2u;
    }
};
struct EpiMoe1 {
    static constexpr bool SPLIT = false; static constexpr int NQ = 2, NST = 8;
    bf16_t* H;
    __device__ __forceinline__ void operator()(const f32x4 (&acc)[2][2][4][2], const g8::Unit& u, int wr, int wc, int fr, int fq) const {
#pragma unroll
        for (int ai = 0; ai < 2; ++ai)
#pragma unroll
            for (int m = 0; m < 4; ++m) {
                const size_t row = (size_t)u.pm * RBR + ai * 128 + wr * 64 + m * 16 + fr;
                float h[8];
#pragma unroll
                for (int bj = 0; bj < 2; ++bj) {
                    const f32x4 g = acc[ai][bj][m][0], up = acc[ai][bj][m][1];
#pragma unroll
                    for (int j = 0; j < 4; ++j) h[bj * 4 + j] = g[j] * __builtin_amdgcn_rcpf(1.f + __expf(-g[j])) * up[j];
                }
                *(u32x4*)(H + row * 256 + u.pn * 128 + wc * 32 + fq * 8) = (u32x4){cvt_pk(h[0], h[1]), cvt_pk(h[2], h[3]), cvt_pk(h[4], h[5]), cvt_pk(h[6], h[7])};
            }
    }
    template <int ai, int bj> __device__ __forceinline__ void part_cond(const f32x4 (&acc)[2][2][4][2], const g8::Unit& u, int wr, int wc, int fr, int fq, int flag) const {}
    __device__ __forceinline__ void tail(const f32x4 (&acc)[2][2][4][2], const g8::Unit& u, int wr, int wc, int fr, int fq) const {}
};
struct EpiMoe1F8 {
    static constexpr bool SPLIT = false; static constexpr int NQ = 2, NST = 8;
    unsigned char* H;
    __device__ __forceinline__ void operator()(const f32x4 (&acc)[2][2][4][2], const g8::Unit& u, int wr, int wc, int fr, int fq) const {
#pragma unroll
        for (int ai = 0; ai < 2; ++ai)
#pragma unroll
            for (int m = 0; m < 4; ++m) {
                const size_t row = (size_t)u.pm * RBR + ai * 128 + wr * 64 + m * 16 + fr;
                u32x2 d;
#pragma unroll
                for (int bj = 0; bj < 2; ++bj) {
                    const f32x4 g = acc[ai][bj][m][0], up = acc[ai][bj][m][1];
                    float h[4];
#pragma unroll
                    for (int j = 0; j < 4; ++j) h[j] = g[j] * __builtin_amdgcn_rcpf(1.f + __expf(-g[j])) * up[j] * 2.f;
                    int w = __builtin_amdgcn_cvt_pk_fp8_f32(h[0], h[1], 0, false);
                    w = __builtin_amdgcn_cvt_pk_fp8_f32(h[2], h[3], w, true);
                    d[bj] = (unsigned)w;
                }
                *(u32x2*)(H + row * 256 + u.pn * 128 + wc * 32 + fq * 8) = d;
            }
    }
    template <int ai, int bj> __device__ __forceinline__ void part_cond(const f32x4 (&acc)[2][2][4][2], const g8::Unit& u, int wr, int wc, int fr, int fq, int flag) const {}
    __device__ __forceinline__ void tail(const f32x4 (&acc)[2][2][4][2], const g8::Unit& u, int wr, int wc, int fr, int fq) const {}
};
__device__ __forceinline__ u32x4 dpp_ror8(const u32x4 v) {
    u32x4 r;
#pragma unroll
    for (int i = 0; i < 4; ++i) r[i] = (unsigned)__builtin_amdgcn_update_dpp(0, (int)v[i], 0x128, 0xF, 0xF, true);
    return r;
}
template <bool NT = false>
__device__ __forceinline__ void perm_store(bf16_t* p  , size_t ld8  , const u32x4 p0, const u32x4 p1, int hi) {
    const u32x4 snd = hi ? p0 : p1, rcv = dpp_ror8(snd);
    if constexpr (NT) { __builtin_nontemporal_store(hi ? rcv : p0, (u32x4*)p); __builtin_nontemporal_store(hi ? p1 : rcv, (u32x4*)(p + ld8)); }
    else { *(u32x4*)p = hi ? rcv : p0; *(u32x4*)(p + ld8) = hi ? p1 : rcv; }
}
struct EpiIn {
    static constexpr bool SPLIT = false; static constexpr int NQ = 4, NST = 16;
    bf16_t* P; float* G; int gbase;
    template <int ai, int bj> __device__ __forceinline__ void part_cond(const f32x4 (&acc)[2][2][4][2], const g8::Unit& u, int wr, int wc, int fr, int fq, int flag) const {}
    __device__ __forceinline__ void tail(const f32x4 (&acc)[2][2][4][2], const g8::Unit& u, int wr, int wc, int fr, int fq) const {}
    __device__ __forceinline__ void operator()(const f32x4 (&acc)[2][2][4][2], const g8::Unit& u, int wr, int wc, int fr, int fq) const {
        const int hi = fr >> 3, r8 = fr & 7;
#pragma unroll
        for (int ai = 0; ai < 2; ++ai)
#pragma unroll
            for (int m = 0; m < 4; ++m) {
                const size_t rg = (size_t)u.pm * 256 + ai * 128 + wr * 64 + m * 16;
                u32x4 pk[2];
#pragma unroll
                for (int bj = 0; bj < 2; ++bj) {
                    const f32x4 v0 = acc[ai][bj][m][0], v1 = acc[ai][bj][m][1];
                    pk[bj] = (u32x4){cvt_pk(v0[0], v0[1]), cvt_pk(v0[2], v0[3]), cvt_pk(v1[0], v1[1]), cvt_pk(v1[2], v1[3])};
                    if (u.pn * 256 + wc * 64 + bj * 32 + fq * 8 == gbase) { *(f32x4*)(G + (rg + fr) * 8) = v0; *(f32x4*)(G + (rg + fr) * 8 + 4) = v1; }
                }
                perm_store(P + (rg + r8) * NPAD + u.pn * 256 + wc * 64 + hi * 32 + fq * 8, (size_t)8 * NPAD, pk[0], pk[1], hi);
            }
    }
};
struct EpiMoe2 {
    static constexpr bool SPLIT = false; static constexpr int NQ = 4, NST = 16;
    bf16_t* Y;
    template <int ai, int bj> __device__ __forceinline__ void part_cond(const f32x4 (&acc)[2][2][4][2], const g8::Unit& u, int wr, int wc, int fr, int fq, int flag) const {}
    __device__ __forceinline__ void tail(const f32x4 (&acc)[2][2][4][2], const g8::Unit& u, int wr, int wc, int fr, int fq) const {}
    __device__ __forceinline__ void operator()(const f32x4 (&acc)[2][2][4][2], const g8::Unit& u, int wr, int wc, int fr, int fq) const {
        const int hi = fr >> 3, r8 = fr & 7;
#pragma unroll
        for (int ai = 0; ai < 2; ++ai)
#pragma unroll
            for (int m = 0; m < 4; ++m) {
                const size_t rg = (size_t)u.pm * RBR + ai * 128 + wr * 64 + m * 16;
                u32x4 pk[2];
#pragma unroll
                for (int bj = 0; bj < 2; ++bj) {
                    const f32x4 v0 = acc[ai][bj][m][0], v1 = acc[ai][bj][m][1];
                    pk[bj] = (u32x4){cvt_pk(v0[0], v0[1]), cvt_pk(v0[2], v0[3]), cvt_pk(v1[0], v1[1]), cvt_pk(v1[2], v1[3])};
                }
                perm_store<true>(Y + (rg + r8) * 1024 + u.pn * 256 + wc * 64 + hi * 32 + fq * 8, (size_t)8 * 1024, pk[0], pk[1], hi);
            }
    }
};
struct EpiMoe2F8 {
    static constexpr bool SPLIT = false; static constexpr int NQ = 2, NST = 8;
    unsigned char* Y;
    template <int ai, int bj> __device__ __forceinline__ void part_cond(const f32x4 (&acc)[2][2][4][2], const g8::Unit& u, int wr, int wc, int fr, int fq, int flag) const {}
    __device__ __forceinline__ void tail(const f32x4 (&acc)[2][2][4][2], const g8::Unit& u, int wr, int wc, int fr, int fq) const {}
    __device__ __forceinline__ void operator()(const f32x4 (&acc)[2][2][4][2], const g8::Unit& u, int wr, int wc, int fr, int fq) const {
#pragma unroll
        for (int ai = 0; ai < 2; ++ai)
#pragma unroll
            for (int m = 0; m < 4; ++m) {
                const size_t row = (size_t)u.pm * RBR + ai * 128 + wr * 64 + m * 16 + fr;
                u32x4 d;
#pragma unroll
                for (int bj = 0; bj < 2; ++bj)
#pragma unroll
                    for (int n = 0; n < 2; ++n) {
#if MOE2_F8
                        const f32x4 v = acc[ai][bj][m][n];
#else
                        const f32x4 v = acc[ai][bj][m][n] * 16.f;
#endif
                        int w = __builtin_amdgcn_cvt_pk_fp8_f32(v[0], v[1], 0, false);
                        w = __builtin_amdgcn_cvt_pk_fp8_f32(v[2], v[3], w, true);
                        d[bj * 2 + n] = (unsigned)w;
                    }
                *(u32x4*)(Y + row * 1024 + u.pn * 256 + wc * 64 + fq * 16) = d;
            }
    }
};
struct EpiOut {
    static constexpr bool SPLIT = false; static constexpr int NQ = 8, NST = 32;
    template <int ai, int bj> __device__ __forceinline__ void part_cond(const f32x4 (&acc)[2][2][4][2], const g8::Unit& u, int wr, int wc, int fr, int fq, int flag) const {}
    __device__ __forceinline__ void tail(const f32x4 (&acc)[2][2][4][2], const g8::Unit& u, int wr, int wc, int fr, int fq) const {}
    const bf16_t* xres; bf16_t* Y;
    __device__ __forceinline__ void operator()(const f32x4 (&acc)[2][2][4][2], const g8::Unit& u, int wr, int wc, int fr, int fq) const {
        const int hi = fr >> 3, r8 = fr & 7;
#pragma unroll
        for (int ai = 0; ai < 2; ++ai)
#pragma unroll
            for (int m = 0; m < 4; ++m) {
                const size_t rg = (size_t)u.pm * 256 + ai * 128 + wr * 64 + m * 16;
                u32x4 pk[2];
#pragma unroll
                for (int bj = 0; bj < 2; ++bj) {
                    const u32x4 xr = *(const u32x4*)(xres + (rg + fr) * 1024 + u.pn * 256 + wc * 64 + bj * 32 + fq * 8);
                    float f[8]; unpack8(xr, f);
                    const f32x4 v0 = acc[ai][bj][m][0], v1 = acc[ai][bj][m][1];
                    pk[bj] = (u32x4){cvt_pk(f[0] * ALPHA + v0[0], f[1] * ALPHA + v0[1]), cvt_pk(f[2] * ALPHA + v0[2], f[3] * ALPHA + v0[3]),
                                     cvt_pk(f[4] * ALPHA + v1[0], f[5] * ALPHA + v1[1]), cvt_pk(f[6] * ALPHA + v1[2], f[7] * ALPHA + v1[3])};
                }
                perm_store(Y + (rg + r8) * 1024 + u.pn * 256 + wc * 64 + hi * 32 + fq * 8, (size_t)8 * 1024, pk[0], pk[1], hi);
                asm volatile("" ::: "memory");
            }
    }
};

constexpr int TS_RS = 272;
__device__ __forceinline__ void tile_put(const Ctx& c, int row_l, int col_l, const u32x2 v) { *(u32x2*)(c.smem + row_l * TS_RS + col_l * 2) = v; }
template <int NCOL>
__device__ __forceinline__ void tile_flush(const Ctx& c, bf16_t* out, size_t ld, bool valid) {
    __syncthreads();
    constexpr int CPR = NCOL / 8, PER = (128 * CPR) / 256;
#pragma unroll
    for (int i = 0; i < PER; ++i) {
        const int idx = c.tid + 256 * i, row = idx / CPR, ch = idx % CPR;
        const u32x4 v = *(const u32x4*)(c.smem + row * TS_RS + ch * 16);
        if (valid) *(u32x4*)(out + (size_t)row * ld + ch * 8) = v;
    }
    __syncthreads();
}

__device__ __forceinline__ void conv_family(const float* src, int nmat, size_t src_stride, int K, int N, int Nout,
                            bf16_t* dst, size_t dst_stride, int grp, int kind, const Ctx& c) {
    float* lds = (float*)c.smem;
    const int tk = K / 128, tn = Nout / 64, per = tk * tn, total = nmat * per;
    const int tx = c.tid & 15, ty = c.tid >> 4;
    f32x4 r[8];
#define CV_LOAD(u_) do { const int mat_ = (u_) / per, r_ = (u_) - mat_ * per, kt_ = r_ / tn, nt_ = r_ - kt_ * tn; \
        const float* s_ = src + (size_t)mat_ * src_stride + (size_t)(kt_ * 128 + ty) * N + nt_ * 64 + tx * 4; const bool in_ = (nt_ * 64 + tx * 4) < N; \
        _Pragma("unroll") for (int i = 0; i < 8; ++i) r[i] = in_ ? __builtin_nontemporal_load((const f32x4*)(s_ + (size_t)(16 * i) * N)) : (f32x4){0.f, 0.f, 0.f, 0.f}; } while (0)
    if (c.bid < total) CV_LOAD(c.bid);
    for (int base = 0; base < total; base += c.nblk) {
        const int u = base + c.bid; const bool valid = u < total;
#pragma unroll
        for (int i = 0; i < 8; ++i) *(f32x4*)(lds + (ty + 16 * i) * 68 + tx * 4) = r[i];
        if (u + c.nblk < total) CV_LOAD(u + c.nblk);
        __syncthreads();
        if (valid) {
        const int mat = u / per, rr = u - mat * per, kt = rr / tn, nt = rr - kt * tn;
        const int dmat = grp ? (mat / grp) * (grp + 1) + (mat % grp) : mat;
        bf16_t* d = dst + (size_t)dmat * dst_stride;
        const int nl = c.tid & 63, kq = (c.tid >> 6) * 32;
        if (kind == 3) {
            unsigned char* d8 = (unsigned char*)dst + (size_t)dmat * dst_stride;
            unsigned w8[8];
#pragma unroll
            for (int j = 0; j < 8; ++j) {
                int w_ = __builtin_amdgcn_cvt_pk_fp8_f32(lds[(kq + 4 * j) * 68 + nl] * 8.f, lds[(kq + 4 * j + 1) * 68 + nl] * 8.f, 0, false);
                w_ = __builtin_amdgcn_cvt_pk_fp8_f32(lds[(kq + 4 * j + 2) * 68 + nl] * 8.f, lds[(kq + 4 * j + 3) * 68 + nl] * 8.f, w_, true);
                w8[j] = (unsigned)w_;
            }
            u32x4* dp8 = (u32x4*)(d8 + (size_t)(nt * 64 + nl) * K + kt * 128 + kq);
            dp8[0] = (u32x4){w8[0], w8[1], w8[2], w8[3]}; dp8[1] = (u32x4){w8[4], w8[5], w8[6], w8[7]};
        } else {
        unsigned w[16];
#pragma unroll
        for (int j = 0; j < 16; ++j) w[j] = pk2(lds[(kq + 2 * j) * 68 + nl], lds[(kq + 2 * j + 1) * 68 + nl]);
        const int n = nt * 64 + nl;
        const int drow = (kind == 0) ? n : ((n >> 4) * 32 + (n & 15) + (kind == 2 ? 16 : 0));
        u32x4* dp = (u32x4*)(d + (size_t)drow * K + kt * 128 + kq);
        dp[0] = (u32x4){w[0], w[1], w[2], w[3]}; dp[1] = (u32x4){w[4], w[5], w[6], w[7]};
        dp[2] = (u32x4){w[8], w[9], w[10], w[11]}; dp[3] = (u32x4){w[12], w[13], w[14], w[15]};
        }
        }
        __syncthreads();
    }
#undef CV_LOAD
}

__device__ __forceinline__ void phase_prologue(const Args& a, const Ctx& c) {
    unsigned char* ws = a.ws;
    bf16_t* WIN = (bf16_t*)(ws + WS_WIN);
    conv_family((const float*)a.in[2], 2, (size_t)1024 * 2472, 1024, 2472, NPAD, WIN, 2 * WIN_ELEMS, 0, 0, c);
    conv_family((const float*)a.in[12], 2, (size_t)1024 * 2312, 1024, 2312, NPAD, WIN + WIN_ELEMS, 2 * WIN_ELEMS, 0, 0, c);
    conv_family((const float*)a.in[4], 2, (size_t)256 * 768, 256, 768, 768, (bf16_t*)(ws + WS_WQB), WQB_ELEMS, 0, 0, c);
    conv_family((const float*)a.in[6], 2, (size_t)128 * 1024, 128, 1024, 1024, (bf16_t*)(ws + WS_WKVB), WKVB_ELEMS, 0, 0, c);
    bf16_t* WOUT = (bf16_t*)(ws + WS_WOUT);
    conv_family((const float*)a.in[11], 2, (size_t)1024 * 1024, 1024, 1024, 1024, WOUT, 2 * WOUT_ELEMS, 0, 0, c);
    conv_family((const float*)a.in[17], 2, (size_t)1024 * 1024, 1024, 1024, 1024, WOUT + WOUT_ELEMS, 2 * WOUT_ELEMS, 0, 0, c);
    conv_family((const float*)a.in[20], 4, (size_t)1024 * 64, 1024, 64, 128, (bf16_t*)(ws + WS_WRT), WRT_ELEMS, 0, 0, c);
    bf16_t* WGU = (bf16_t*)(ws + WS_WGU);
    conv_family((const float*)a.in[22], 256, (size_t)1024 * 256, 1024, 256, 256, WGU, WGU_ELEMS, 64, 1, c);
    conv_family((const float*)a.in[23], 256, (size_t)1024 * 256, 1024, 256, 256, WGU, WGU_ELEMS, 64, 2, c);
    conv_family((const float*)a.in[25], 4, (size_t)1024 * 256, 1024, 256, 256, WGU + 64 * WGU_ELEMS, 65 * WGU_ELEMS, 0, 1, c);
    conv_family((const float*)a.in[26], 4, (size_t)1024 * 256, 1024, 256, 256, WGU + 64 * WGU_ELEMS, 65 * WGU_ELEMS, 0, 2, c);
    bf16_t* WDN = (bf16_t*)(ws + WS_WDN);
#if MOE2_F8
    conv_family((const float*)a.in[24], 256, (size_t)256 * 1024, 256, 1024, 1024, WDN, WDN_ELEMS, 64, 3, c);
    conv_family((const float*)a.in[27], 4, (size_t)256 * 1024, 256, 1024, 1024, (bf16_t*)((unsigned char*)WDN + 64 * WDN_ELEMS), 65 * WDN_ELEMS, 0, 3, c);
#else
    conv_family((const float*)a.in[24], 256, (size_t)256 * 1024, 256, 1024, 1024, WDN, WDN_ELEMS, 64, 0, c);
    conv_family((const float*)a.in[27], 4, (size_t)256 * 1024, 256, 1024, 1024, WDN + 64 * WDN_ELEMS, 65 * WDN_ELEMS, 0, 0, c);
#endif
    {
        const float* x = (const float*)a.in[0]; bf16_t* xb = (bf16_t*)(ws + WS_XBF);
        const size_t n8 = (size_t)T * 1024 / 8;
        for (size_t i = (size_t)c.bid * 256 + c.tid; i < n8; i += (size_t)c.nblk * 256) {
            const f32x4 v0 = __builtin_nontemporal_load((const f32x4*)(x + i * 8)), v1 = __builtin_nontemporal_load((const f32x4*)(x + i * 8 + 4));
            *(u32x4*)(xb + i * 8) = (u32x4){pk2(v0[0], v0[1]), pk2(v0[2], v0[3]), pk2(v1[0], v1[1]), pk2(v1[2], v1[3])};
        }
    }
    {
        const int* pos = (const int*)a.in[1];
        float* rm = (float*)(ws + WS_ROPEM); float* rs = (float*)(ws + WS_ROPES);
        const float ln_theta = 9.210340371976184f;
        for (int i = c.bid * 256 + c.tid; i < T * 16; i += c.nblk * 256) {
            const int t = i >> 4, f = i & 15;
            const float inv = expf(-((float)(2 * f) / 32.f) * ln_theta);
            const float ang = (float)pos[t] * inv;
            rm[i * 2] = cosf(ang); rm[i * 2 + 1] = sinf(ang);
        }
        for (int i = c.bid * 256 + c.tid; i < T * 32; i += c.nblk * 256) {
            const int t = i >> 5, f = i & 31;
            const float inv = expf(-((float)(2 * f) / 64.f) * ln_theta);
            const float ang = (float)pos[t] * inv;
            rs[i * 2] = cosf(ang); rs[i * 2 + 1] = sinf(ang);
        }
    }
}

__device__ __forceinline__ void phase_inproj(const bf16_t* XBF, const bf16_t* W, bf16_t* PROJ, float* GATES, int gbase, const Ctx& c) {
    const int ntn = NPAD / 128;
    for (int i = 0;; ++i) {
        int mt, nt; bool valid; if (!tile_map2(i, c, T / 128, ntn, mt, nt, valid)) break;
        const bf16_t* a0 = XBF + (size_t)(mt * 128 + (c.tid >> 2)) * 1024;
        const bf16_t* b0 = W + (size_t)(nt * 128 + (c.tid >> 2)) * 1024;
        f32x4 acc[4][4];
        gemm_tile(a0, a0 + 64 * 1024, b0, b0 + 64 * 1024, 32, acc, c);
#pragma unroll
        for (int m = 0; m < 4; ++m) {
            const int rl = c.wr * 64 + m * 16 + c.fr, row = mt * 128 + rl;
#pragma unroll
            for (int n = 0; n < 4; ++n) {
                const int cl = c.wc * 64 + n * 16 + c.fq * 4, col = nt * 128 + cl;
                const f32x4 v = acc[m][n];
                tile_put(c, rl, cl, (u32x2){pk2(v[0], v[1]), pk2(v[2], v[3])});
                if (valid && col >= gbase && col < gbase + 8) *(f32x4*)(GATES + (size_t)row * 8 + (col - gbase)) = v;
            }
        }
        tile_flush<128>(c, PROJ + (size_t)mt * 128 * NPAD + nt * 128, NPAD, valid);
    }
}

constexpr int MLAUP_TILES = (T / 128) * 6 + (T / 128) * 8;
__device__ __forceinline__ void mla_up_tile(int u, const bf16_t* CQ, const bf16_t* WQB, const bf16_t* CKV, const bf16_t* WKVB,
                             const float* ROPEM, bf16_t* QF, bf16_t* KN, bf16_t* VV, const Ctx& c) {
    const int tq = (T / 128) * 6;
    const float qscale = 0.10206207261596577f * 1.4426950408889634f;
    {
        f32x4 acc[4][4];
        if (u < tq) {
            const int mt = u / 6, nt = u % 6;
            const bf16_t* a0 = CQ + (size_t)(mt * 128 + (c.tid >> 2)) * 256;
            const bf16_t* b0 = WQB + (size_t)(nt * 128 + (c.tid >> 2)) * 256;
            gemm_tile(a0, a0 + 64 * 256, b0, b0 + 64 * 256, 8, acc, c);
#pragma unroll
            for (int m = 0; m < 4; ++m) {
                const int row = mt * 128 + c.wr * 64 + m * 16 + c.fr;
#pragma unroll
                for (int np = 0; np < 2; ++np) {
                    const int cg = nt * 128 + c.wc * 64 + np * 32;
                    f32x4 v0 = acc[m][2 * np], v1 = acc[m][2 * np + 1];
                    if (((cg >> 5) % 3) == 2) {
#pragma unroll
                        for (int j = 0; j < 4; ++j) {
                            const int i = c.fq * 4 + j;
                            const float cs = ROPEM[((size_t)row * 16 + i) * 2], sn = ROPEM[((size_t)row * 16 + i) * 2 + 1];
                            const float x1 = v0[j], x2 = v1[j];
                            v0[j] = x1 * cs - x2 * sn; v1[j] = x2 * cs + x1 * sn;
                        }
                    }
                    v0 *= qscale; v1 *= qscale;
                    *(u32x2*)(QF + (size_t)row * 768 + cg + c.fq * 4) = (u32x2){pk2(v0[0], v0[1]), pk2(v0[2], v0[3])};
                    *(u32x2*)(QF + (size_t)row * 768 + cg + 16 + c.fq * 4) = (u32x2){pk2(v1[0], v1[1]), pk2(v1[2], v1[3])};
                }
            }
        } else {
            const int v = u - tq, mt = v / 8, nt = v % 8;
            const bf16_t* a0 = CKV + (size_t)(mt * 128 + (c.tid >> 2)) * 128;
            const bf16_t* b0 = WKVB + (size_t)(nt * 128 + (c.tid >> 2)) * 128;
            gemm_tile(a0, a0 + 64 * 128, b0, b0 + 64 * 128, 4, acc, c);
            bf16_t* dst = (c.wc == 0) ? KN : VV;
#pragma unroll
            for (int m = 0; m < 4; ++m) {
                const int row = mt * 128 + c.wr * 64 + m * 16 + c.fr;
#pragma unroll
                for (int n = 0; n < 4; ++n) {
                    const f32x4 x = acc[m][n];
                    *(u32x2*)(dst + (size_t)row * 512 + nt * 64 + n * 16 + c.fq * 4) = (u32x2){pk2(x[0], x[1]), pk2(x[2], x[3])};
                }
            }
        }
    }
}

__device__ __forceinline__ void phase_outproj(const bf16_t* MIXO, const bf16_t* W, const float* xres, float* YBUF, const Ctx& c) {
    for (int i = 0;; ++i) {
        int mt, nt; bool valid; if (!tile_map2(i, c, T / 128, 8, mt, nt, valid)) break;
        const bf16_t* a0 = MIXO + (size_t)(mt * 128 + (c.tid >> 2)) * 1024;
        const bf16_t* b0 = W + (size_t)(nt * 128 + (c.tid >> 2)) * 1024;
        f32x4 acc[4][4];
        gemm_tile(a0, a0 + 64 * 1024, b0, b0 + 64 * 1024, 32, acc, c);
#pragma unroll
        for (int m = 0; m < 4; ++m) {
            const int row = mt * 128 + c.wr * 64 + m * 16 + c.fr;
#pragma unroll
            for (int n = 0; n < 4; ++n) {
                const int col = nt * 128 + c.wc * 64 + n * 16 + c.fq * 4;
                const f32x4 xr = *(const f32x4*)(xres + (size_t)row * 1024 + col);
                if (valid) *(f32x4*)(YBUF + (size_t)row * 1024 + col) = xr * ALPHA + acc[m][n];
            }
        }
    }
}

__device__ __forceinline__ void phase_router(const bf16_t* XBF, const bf16_t* W, float* LOG, const Ctx& c) {
    for (int base = 0; base < T / 128; base += c.nblk) {
        const bool valid = (base + c.bid) < T / 128; const int mt = valid ? base + c.bid : 0;
        const bf16_t* a0 = XBF + (size_t)(mt * 128 + (c.tid >> 2)) * 1024;
        const bf16_t* b0 = W + (size_t)(c.tid >> 2) * 1024;
        f32x4 acc[4][4];
        gemm_tile(a0, a0 + 64 * 1024, b0, b0 + 64 * 1024, 32, acc, c);
        if (c.wc == 0 && valid) {
#pragma unroll
            for (int m = 0; m < 4; ++m) {
                const int row = mt * 128 + c.wr * 64 + m * 16 + c.fr;
#pragma unroll
                for (int n = 0; n < 4; ++n) *(f32x4*)(LOG + (size_t)row * 64 + n * 16 + c.fq * 4) = acc[m][n];
            }
        }
    }
}

__device__ __forceinline__ void build_block_table(const unsigned* CNT, int* bst, const Ctx& c) {
    __syncthreads();
    if (c.wid == 0) {
        const int cnt = (int)__hip_atomic_load(CNT + c.lane, __ATOMIC_RELAXED, __HIP_MEMORY_SCOPE_AGENT);
        const int nb = (cnt + RBR - 1) / RBR;
        int inc = nb;
#pragma unroll
        for (int o = 1; o < 64; o <<= 1) { const int x = shfl_up_(inc, o); if (c.lane >= o) inc += x; }
        bst[c.lane] = inc - nb; bst[66 + c.lane] = cnt;
        if (c.lane == 63) { bst[64] = inc; bst[65] = inc + T / RBR; bst[66 + 64] = T; }
    }
    __syncthreads();
}
__device__ __forceinline__ int find_expert(const int* bst, int rb, const Ctx& c) {
    return __popcll(__ballot(bst[1 + c.lane] <= rb));
}

__device__ __forceinline__ void phase_moe1(const bf16_t* XBF, const bf16_t* WGU, const unsigned* CNT, const int* LTOK, const float* LW, bf16_t* HBUF, const Ctx& c) {
    int* bst = (int*)(c.smem + 65536 + 64);
    build_block_table(CNT, bst, c);
    const int nsb = bst[65] * 2;
    for (int i = 0;; ++i) {
        int sbk, nt; bool valid; if (!tile_map2(i, c, nsb, 4, sbk, nt, valid)) break;
        const int rb = sbk >> 1, hb = sbk & 1;
        const int e = find_expert(bst, rb, c);
        const int lb = rb - bst[e], cnt = bst[66 + e];
        const int p0 = lb * RBR + hb * 128 + (c.tid >> 2), p1 = p0 + 64;
        const int t0 = (p0 < cnt) ? LTOK[(size_t)e * CAP + p0] : 0;
        const int t1 = (p1 < cnt) ? LTOK[(size_t)e * CAP + p1] : 0;
        const bf16_t* a0 = XBF + (size_t)t0 * 1024;
        const bf16_t* a1 = XBF + (size_t)t1 * 1024;
        const bf16_t* b0 = WGU + (size_t)e * WGU_ELEMS + (size_t)(nt * 128 + (c.tid >> 2)) * 1024;
        f32x4 acc[4][4];
        gemm_tile(a0, a1, b0, b0 + 64 * 1024, 32, acc, c);
#pragma unroll
        for (int m = 0; m < 4; ++m) {
            const int rl = c.wr * 64 + m * 16 + c.fr;
            const int pw = lb * RBR + hb * 128 + rl;
            const float wrow = (pw < cnt) ? LW[(size_t)e * CAP + pw] : 0.f;
#pragma unroll
            for (int n = 0; n < 2; ++n) {
                const f32x4 g = acc[m][n], up = acc[m][n + 2];
                float h[4];
#pragma unroll
                for (int j = 0; j < 4; ++j) h[j] = siluf_(g[j]) * up[j] * wrow;
                tile_put(c, rl, c.wc * 32 + n * 16 + c.fq * 4, (u32x2){pk2(h[0], h[1]), pk2(h[2], h[3])});
            }
        }
        tile_flush<64>(c, HBUF + ((size_t)rb * RBR + hb * 128) * 256 + nt * 64, 256, valid);
    }
}

__device__ __forceinline__ void phase_moe2(const bf16_t* HBUF, const bf16_t* WDN, const unsigned* CNT, bf16_t* Y, const Ctx& c) {
    int* bst = (int*)(c.smem + 65536 + 64);
    build_block_table(CNT, bst, c);
    const int nsb = bst[65] * 2;
    for (int i = 0;; ++i) {
        int sbk, nt; bool valid; if (!tile_map2(i, c, nsb, 8, sbk, nt, valid)) break;
        const int rb = sbk >> 1;
        const int e = find_expert(bst, rb, c);
        const bf16_t* a0 = HBUF + ((size_t)sbk * 128 + (c.tid >> 2)) * 256;
        const bf16_t* b0 = WDN + (size_t)e * WDN_ELEMS + (size_t)(nt * 128 + (c.tid >> 2)) * 256;
        f32x4 acc[4][4];
        gemm_tile(a0, a0 + 64 * 256, b0, b0 + 64 * 256, 8, acc, c);
#pragma unroll
        for (int m = 0; m < 4; ++m) {
            const int lr = c.wr * 64 + m * 16 + c.fr;
#pragma unroll
            for (int n = 0; n < 4; ++n) {
                const f32x4 v = acc[m][n];
                tile_put(c, lr, c.wc * 64 + n * 16 + c.fq * 4, (u32x2){pk2(v[0], v[1]), pk2(v[2], v[3])});
            }
        }
        tile_flush<128>(c, Y + (size_t)sbk * 128 * 1024 + nt * 128, 1024, valid);
    }
}

__device__ __forceinline__ float dppf(float v, int ctrl_sel) {
    int x = __builtin_bit_cast(int, v), r;
    if (ctrl_sel == 0) r = __builtin_amdgcn_update_dpp(0, x, 0xB1, 0xF, 0xF, true);
    else if (ctrl_sel == 1) r = __builtin_amdgcn_update_dpp(0, x, 0x4E, 0xF, 0xF, true);
    else if (ctrl_sel == 2) r = __builtin_amdgcn_update_dpp(0, x, 0x141, 0xF, 0xF, true);
    else r = __builtin_amdgcn_update_dpp(0, x, 0x140, 0xF, 0xF, true);
    return __builtin_bit_cast(float, r);
}
__device__ __forceinline__ float red16(float v) { v += dppf(v, 0); v += dppf(v, 1); v += dppf(v, 2); v += dppf(v, 3); return v; }

template <bool F32OUT>
__device__ __forceinline__ void ln_row_store(float (&v)[16], const float* g, const float* b, float* of32, bf16_t* obf, int lane) {
    float s = 0.f;
#pragma unroll
    for (int i = 0; i < 16; ++i) s += v[i];
    const float mean = wave_sum(s) * (1.f / 1024.f);
    float q = 0.f;
#pragma unroll
    for (int i = 0; i < 16; ++i) { v[i] -= mean; q += v[i] * v[i]; }
    const float rstd = rsqrtf(wave_sum(q) * (1.f / 1024.f) + 1e-5f);
#pragma unroll
    for (int hf = 0; hf < 2; ++hf) {
        const int col = hf * 512 + lane * 8;
        const f32x4 g0 = *(const f32x4*)(g + col), g1 = *(const f32x4*)(g + col + 4);
        const f32x4 b0 = *(const f32x4*)(b + col), b1 = *(const f32x4*)(b + col + 4);
        f32x4 y0, y1;
#pragma unroll
        for (int j = 0; j < 4; ++j) { y0[j] = v[hf * 8 + j] * rstd * g0[j] + b0[j]; y1[j] = v[hf * 8 + 4 + j] * rstd * g1[j] + b1[j]; }
        if constexpr (F32OUT) { *(f32x4*)(of32 + col) = y0; *(f32x4*)(of32 + col + 4) = y1; }
        *(u32x4*)(obf + col) = (u32x4){pk2(y0[0], y0[1]), pk2(y0[2], y0[3]), pk2(y1[0], y1[1]), pk2(y1[2], y1[3])};
    }
}

__device__ __forceinline__ void phase_ln1(const bf16_t* YBUF, const float* g, const float* b, bf16_t* XBF, const Ctx& c) {
    for (int t = c.bid * 4 + c.wid; t < T; t += c.nblk * 4) {
        float v[16];
#pragma unroll
        for (int hf = 0; hf < 2; ++hf) {
            const u32x4 r = *(const u32x4*)(YBUF + (size_t)t * 1024 + hf * 512 + c.lane * 8);
            float f[8]; unpack8(r, f);
#pragma unroll
            for (int j = 0; j < 8; ++j) v[hf * 8 + j] = f[j];
        }
        ln_row_store<false>(v, g, b, nullptr, XBF + (size_t)t * 1024, c.lane);
    }
}

template <bool LASTL>
__device__ __forceinline__ void phase_combine8(const unsigned char* Y, const int* ASG, const float* ASGW, const unsigned* CNT, const float* g, const float* b,
                                               float* XOUT, bf16_t* XBF, const Ctx& c) {
    int* bst = (int*)(c.smem + 65536 + 64);
    build_block_table(CNT, bst, c);
    const int lane = c.lane;
    for (int t = c.bid * 4 + c.wid; t < T; t += c.nblk * 4) {
        float v[16];
        {
            const u32x4 r0 = *(const u32x4*)(XBF + (size_t)t * 1024 + lane * 16), r1 = *(const u32x4*)(XBF + (size_t)t * 1024 + lane * 16 + 8);
            float f[8]; unpack8(r0, f);
#pragma unroll
            for (int j = 0; j < 8; ++j) v[j] = f[j] * ALPHA;
            unpack8(r1, f);
#pragma unroll
            for (int j = 0; j < 8; ++j) v[8 + j] = f[j] * ALPHA;
        }
        u32x4 yr[9]; float wk[9];
#pragma unroll
        for (int k = 0; k < 9; ++k) {
            size_t crow; wk[k] = 1.f / 16.f;
            if (k < 8) { const int asg = ASG[(size_t)t * 8 + k]; crow = (size_t)bst[asg >> 16] * RBR + (asg & 0xffff); wk[k] = ASGW[(size_t)t * 8 + k] * (1.f / 16.f); }
            else crow = (size_t)bst[64] * RBR + t;
            yr[k] = *(const u32x4*)(Y + crow * 1024 + lane * 16);
        }
#pragma unroll
        for (int k = 0; k < 9; ++k)
#pragma unroll
            for (int q = 0; q < 4; ++q) {
                const f32x2 lo = __builtin_amdgcn_cvt_pk_f32_fp8((int)yr[k][q], false), hi = __builtin_amdgcn_cvt_pk_f32_fp8((int)yr[k][q], true);
                v[q * 4 + 0] += lo[0] * wk[k]; v[q * 4 + 1] += lo[1] * wk[k]; v[q * 4 + 2] += hi[0] * wk[k]; v[q * 4 + 3] += hi[1] * wk[k];
            }
        float s = 0.f;
#pragma unroll
        for (int i = 0; i < 16; ++i) s += v[i];
        const float mean = wave_sum_dpp(s) * (1.f / 1024.f);
        float q2 = 0.f;
#pragma unroll
        for (int i = 0; i < 16; ++i) { v[i] -= mean; q2 += v[i] * v[i]; }
        const float rstd = rsqrtf(wave_sum_dpp(q2) * (1.f / 1024.f) + 1e-5f);
        float y[16];
#pragma unroll
        for (int q = 0; q < 4; ++q) {
            const f32x4 gg = *(const f32x4*)(g + lane * 16 + q * 4), bb = *(const f32x4*)(b + lane * 16 + q * 4);
#pragma unroll
            for (int j = 0; j < 4; ++j) y[q * 4 + j] = v[q * 4 + j] * rstd * gg[j] + bb[j];
            if constexpr (LASTL) *(f32x4*)(XOUT + (size_t)t * 1024 + lane * 16 + q * 4) = (f32x4){y[q * 4], y[q * 4 + 1], y[q * 4 + 2], y[q * 4 + 3]};
        }
        *(u32x4*)(XBF + (size_t)t * 1024 + lane * 16) = (u32x4){pk2(y[0], y[1]), pk2(y[2], y[3]), pk2(y[4], y[5]), pk2(y[6], y[7])};
        *(u32x4*)(XBF + (size_t)t * 1024 + lane * 16 + 8) = (u32x4){pk2(y[8], y[9]), pk2(y[10], y[11]), pk2(y[12], y[13]), pk2(y[14], y[15])};
    }
}

template <bool LASTL>
__device__ __forceinline__ void phase_combine(const bf16_t* Y, const int* ASG, const float* ASGW, const unsigned* CNT, const float* g, const float* b,
                              float* XOUT, bf16_t* XBF, const Ctx& c) {
    int* bst = (int*)(c.smem + 65536 + 64);
    build_block_table(CNT, bst, c);
    for (int t = c.bid * 4 + c.wid; t < T; t += c.nblk * 4) {
        float v[16];
#pragma unroll
        for (int hf = 0; hf < 2; ++hf) {
            const u32x4 r = *(const u32x4*)(XBF + (size_t)t * 1024 + hf * 512 + c.lane * 8);
            float f[8]; unpack8(r, f);
#pragma unroll
            for (int j = 0; j < 8; ++j) v[hf * 8 + j] = f[j] * ALPHA;
        }
#pragma unroll
        for (int k = 0; k < 9; ++k) {
            size_t crow; float wk = 1.f;
            if (k < 8) { const int asg = ASG[(size_t)t * 8 + k]; crow = (size_t)bst[asg >> 16] * RBR + (asg & 0xffff); wk = ASGW[(size_t)t * 8 + k]; }
            else crow = (size_t)bst[64] * RBR + t;
#pragma unroll
            for (int hf = 0; hf < 2; ++hf) {
                const u32x4 r = *(const u32x4*)(Y + crow * 1024 + hf * 512 + c.lane * 8);
                float f[8]; unpack8(r, f);
#pragma unroll
                for (int j = 0; j < 8; ++j) v[hf * 8 + j] += f[j] * wk;
            }
        }
        ln_row_store<LASTL>(v, g, b, XOUT + (size_t)t * 1024, XBF + (size_t)t * 1024, c.lane);
    }
}

__device__ __forceinline__ void phase_route(const float* LOG, const float* rb, unsigned* CNT, int* LTOK, float* LW, int* ASG, float* ASGW, const Ctx& c) {
    int* lcnt = (int*)c.smem;
    int* lbase = lcnt + 64;
    int* sel_e = lbase + 64;
    int* sel_p = sel_e + 256;
    float* sel_w = (float*)(sel_p + 256);
    const float rbias = rb[c.lane];
    for (int base = 0; base < T / 32; base += c.nblk) {
        const int ch = base + c.bid; const bool valid = ch < T / 32;
        __syncthreads();
        if (c.tid < 64) lcnt[c.tid] = 0;
        __syncthreads();
        if (valid) for (int tl = c.wid; tl < 32; tl += 4) {
            const int t = ch * 32 + tl;
            const float lg = LOG[(size_t)t * 64 + c.lane];
            const float sc = 1.f / (1.f + expf(-lg));
            const float v = sc + rbias;
            float m1 = v;
            m1 = grp8_max(m1);
            int cand = (v == m1) ? c.lane : 999;
            cand = grp8_min(cand);
            float m2 = (c.lane == cand) ? -INFINITY : v;
            m2 = grp8_max(m2);
            const float gs = m1 + m2;
            const int g = c.lane >> 3;
            int grank = 0;
#pragma unroll
            for (int gg = 0; gg < 8; ++gg) { const float o = shfl_c_(gs, gg * 8); grank += ((o > gs) || (o == gs && gg < g)) ? 1 : 0; }
            const bool gsel = grank < 4;
            const float mv = gsel ? v : -INFINITY;
            int rank = 0;
#pragma unroll 8
            for (int jj = 0; jj < 64; ++jj) { const float o = shfl_c_(mv, jj); rank += ((o > mv) || (o == mv && jj < c.lane)) ? 1 : 0; }
            const bool sel = gsel && rank < 8;
            const float ssum = wave_sum(sel ? sc : 0.f);
            const float w = sc / ssum * 2.5f;
            const unsigned long long bal = __ballot(sel);
            const int slot = __popcll(bal & ((1ull << c.lane) - 1ull));
            if (sel) {
                const int p = atomicAdd(&lcnt[c.lane], 1);
                sel_e[tl * 8 + slot] = c.lane; sel_p[tl * 8 + slot] = p; sel_w[tl * 8 + slot] = w;
            }
        }
        __syncthreads();
        if (valid && c.tid < 64) { const int n = lcnt[c.tid]; lbase[c.tid] = n ? (int)atomicAdd(CNT + c.tid, (unsigned)n) : 0; }
        __syncthreads();
        if (valid) {
            const int tl = c.tid >> 3, t = ch * 32 + tl;
            const int e = sel_e[c.tid], pos = lbase[e] + sel_p[c.tid];
            LTOK[(size_t)e * CAP + pos] = t; LW[(size_t)e * CAP + pos] = sel_w[c.tid];
            ASG[(size_t)t * 8 + (c.tid & 7)] = (e << 16) | pos; ASGW[(size_t)t * 8 + (c.tid & 7)] = sel_w[c.tid];
            if (c.tid < 32) { const int ts = ch * 32 + c.tid; LTOK[(size_t)64 * CAP + ts] = ts; LW[(size_t)64 * CAP + ts] = 1.f; }
        }
    }
}

__device__ __forceinline__ void phase_lnroute(const bf16_t* YBUF, const float* g, const float* b, bf16_t* XBF, const bf16_t* W, const float* rb,
                                              unsigned* CNT, int* LTOK, float* LW, int* ASG, float* ASGW, const Ctx& c) {
    unsigned char* xa = c.smem;
    int* lcnt = (int*)(c.smem + 65536 + 64);
    int* lbase = lcnt + 64;
    float* lgt = (float*)c.smem;
    int* sel_e = (int*)(c.smem + 8192);
    int* sel_p = sel_e + 256;
    float* sel_w = (float*)(sel_p + 256);
    const int lane = c.lane;
    const float rbias = rb[lane];
    for (int base = 0; base < T / 32; base += c.nblk) {
        const int ch = base + c.bid; const bool valid = ch < T / 32;
        __syncthreads();
        if (c.tid < 64) lcnt[c.tid] = 0;
        u32x4 raw[8][2];
#pragma unroll
        for (int i = 0; i < 8; ++i)
#pragma unroll
            for (int hf = 0; hf < 2; ++hf) raw[i][hf] = valid ? *(const u32x4*)(YBUF + (size_t)(ch * 32 + c.wid + 4 * i) * 1024 + hf * 512 + lane * 8) : (u32x4){0u, 0u, 0u, 0u};
        if (valid)
#pragma unroll
        for (int i = 0; i < 8; ++i) {
            const int tl = c.wid + 4 * i;
            const int t = ch * 32 + tl;
            float v[16];
#pragma unroll
            for (int hf = 0; hf < 2; ++hf) {
                float f[8]; unpack8(raw[i][hf], f);
#pragma unroll
                for (int j = 0; j < 8; ++j) v[hf * 8 + j] = f[j];
            }
            float s = 0.f;
#pragma unroll
            for (int i = 0; i < 16; ++i) s += v[i];
            const float mean = wave_sum(s) * (1.f / 1024.f);
            float q = 0.f;
#pragma unroll
            for (int i = 0; i < 16; ++i) { v[i] -= mean; q += v[i] * v[i]; }
            const float rstd = rsqrtf(wave_sum(q) * (1.f / 1024.f) + 1e-5f);
#pragma unroll
            for (int hf = 0; hf < 2; ++hf) {
                const int col = hf * 512 + lane * 8;
                const f32x4 g0 = *(const f32x4*)(g + col), g1 = *(const f32x4*)(g + col + 4);
                const f32x4 b0 = *(const f32x4*)(b + col), b1 = *(const f32x4*)(b + col + 4);
                f32x4 y0, y1;
#pragma unroll
                for (int j = 0; j < 4; ++j) { y0[j] = v[hf * 8 + j] * rstd * g0[j] + b0[j]; y1[j] = v[hf * 8 + 4 + j] * rstd * g1[j] + b1[j]; }
                const u32x4 pk = (u32x4){pk2(y0[0], y0[1]), pk2(y0[2], y0[3]), pk2(y1[0], y1[1]), pk2(y1[2], y1[3])};
                *(u32x4*)(XBF + (size_t)t * 1024 + col) = pk;
                *(u32x4*)(xa + tl * 2048 + (((hf * 64 + lane) ^ (tl & 15)) * 16)) = pk;
            }
        }
        __syncthreads();
        f32x4 acc0 = (f32x4){0.f, 0.f, 0.f, 0.f}, acc1 = (f32x4){0.f, 0.f, 0.f, 0.f};
        {
            const int r = lane & 15, kq = lane >> 4;
            const bf16_t* wrow = W + (size_t)(c.wid * 16 + r) * 1024 + kq * 8;
#pragma unroll 1
            for (int kb = 0; kb < 32; kb += 8) {
                bf16x8 bfr[8];
#pragma unroll
                for (int j = 0; j < 8; ++j) bfr[j] = *(const bf16x8*)(wrow + (kb + j) * 32);
#pragma unroll
                for (int j = 0; j < 8; ++j) {
                    const int chunk = ((kb + j) * 4 + kq) ^ r;
                    const bf16x8 a0 = *(const bf16x8*)(xa + r * 2048 + chunk * 16), a1 = *(const bf16x8*)(xa + (16 + r) * 2048 + chunk * 16);
                    acc0 = __builtin_amdgcn_mfma_f32_16x16x32_bf16(a0, bfr[j], acc0, 0, 0, 0);
                    acc1 = __builtin_amdgcn_mfma_f32_16x16x32_bf16(a1, bfr[j], acc1, 0, 0, 0);
                }
            }
        }
        __syncthreads();
        {
            const int e = c.wid * 16 + (lane & 15), r0 = 4 * (lane >> 4);
#pragma unroll
            for (int j = 0; j < 4; ++j) { lgt[(r0 + j) * 64 + e] = acc0[j]; lgt[(16 + r0 + j) * 64 + e] = acc1[j]; }
        }
        __syncthreads();
        if (valid) for (int tl = c.wid; tl < 32; tl += 4) {
            const float lg = lgt[tl * 64 + lane];
            const float sc = 1.f / (1.f + expf(-lg));
            const float v = sc + rbias;
            float m1 = v;
            m1 = grp8_max(m1);
            int cand = (v == m1) ? lane : 999;
            cand = grp8_min(cand);
            float m2 = (lane == cand) ? -INFINITY : v;
            m2 = grp8_max(m2);
            const float gs = m1 + m2;
            const int gi = lane >> 3;
            int grank = 0;
#pragma unroll
            for (int gg = 0; gg < 8; ++gg) { const float o = shfl_c_(gs, gg * 8); grank += ((o > gs) || (o == gs && gg < gi)) ? 1 : 0; }
            const bool gsel = grank < 4;
            const float mv = gsel ? v : -INFINITY;
            int rank = 0;
#pragma unroll 8
            for (int jj = 0; jj < 64; ++jj) { const float o = shfl_c_(mv, jj); rank += ((o > mv) || (o == mv && jj < lane)) ? 1 : 0; }
            const bool sel = gsel && rank < 8;
            const float ssum = wave_sum(sel ? sc : 0.f);
            const float w = sc / ssum * 2.5f;
            const unsigned long long bal = __ballot(sel);
            const int slot = __popcll(bal & ((1ull << lane) - 1ull));
            if (sel) {
                const int p = atomicAdd(&lcnt[lane], 1);
                sel_e[tl * 8 + slot] = lane; sel_p[tl * 8 + slot] = p; sel_w[tl * 8 + slot] = w;
            }
        }
        __syncthreads();
        if (valid && c.tid < 64) { const int n = lcnt[c.tid]; lbase[c.tid] = n ? (int)atomicAdd(CNT + c.tid, (unsigned)n) : 0; }
        __syncthreads();
        if (valid) {
            const int tl = c.tid >> 3, t = ch * 32 + tl;
            const int e = sel_e[c.tid], pos = lbase[e] + sel_p[c.tid];
            LTOK[(size_t)e * CAP + pos] = t; LW[(size_t)e * CAP + pos] = sel_w[c.tid];
            ASG[(size_t)t * 8 + (c.tid & 7)] = (e << 16) | pos; ASGW[(size_t)t * 8 + (c.tid & 7)] = sel_w[c.tid];
            if (c.tid < 32) { const int ts = ch * 32 + c.tid; LTOK[(size_t)64 * CAP + ts] = ts; LW[(size_t)64 * CAP + ts] = 1.f; }
        }
    }
}

__device__ __forceinline__ void phase_prep_even(const bf16_t* PROJ, const float* GATES, const float* qn, const float* kvn, const float* cw,
                                const float* a_log, const float* dt_bias, const float* ROPEM,
                                bf16_t* CQ, bf16_t* CKV, bf16_t* KROPE, bf16_t* GQ, bf16_t* GK, bf16_t* GV, float* BETA, float* GLOG, const Ctx& c) {
    const int lane = c.lane;
    float* cwL = (float*)c.smem;
    __syncthreads();
    for (int i = c.tid; i < 4 * 1536 / 4; i += 256) *(f32x4*)(cwL + i * 4) = *(const f32x4*)(cw + i * 4);
    __syncthreads();
    for (int tb = (c.bid * 4 + c.wid) * 8; tb < T; tb += c.nblk * 4 * 8) {
        const int s0 = tb & (SEQ - 1);
        u32x4 xr[3][4];
#pragma unroll
        for (int arr = 0; arr < 3; ++arr)
#pragma unroll
            for (int w = 0; w < 3; ++w)
                xr[arr][w] = (s0 - 3 + w >= 0) ? *(const u32x4*)(PROJ + (size_t)(tb - 3 + w) * NPAD + 416 + arr * 512 + lane * 8) : (u32x4){0u, 0u, 0u, 0u};
        u32x4 nx[3]; u32x2 ncq; unsigned nckv; float nk1 = 0.f, nk2 = 0.f, ncs = 0.f, nsn = 0.f, ngate = 0.f;
#define PE_LOAD(t_) do { const bf16_t* pr_ = PROJ + (size_t)(t_) * NPAD; \
            _Pragma("unroll") for (int arr = 0; arr < 3; ++arr) nx[arr] = *(const u32x4*)(pr_ + 416 + arr * 512 + lane * 8); \
            ncq = *(const u32x2*)(pr_ + lane * 4); nckv = *(const unsigned*)(pr_ + 256 + lane * 2); \
            if (lane < 16) { nk1 = bf2f(pr_[384 + lane]); nk2 = bf2f(pr_[400 + lane]); ncs = ROPEM[((size_t)(t_) * 16 + lane) * 2]; nsn = ROPEM[((size_t)(t_) * 16 + lane) * 2 + 1]; } \
            if (lane < 8) ngate = GATES[(size_t)(t_) * 8 + lane]; } while (0)
        PE_LOAD(tb);
#pragma unroll
        for (int k = 0; k < 8; ++k) {
            const int t = tb + k;
#pragma unroll
            for (int arr = 0; arr < 3; ++arr) xr[arr][3] = nx[arr];
            const u32x2 r = ncq; const unsigned rkv = nckv; const float x1 = nk1, x2 = nk2, cs = ncs, sn = nsn, gate = ngate;
            if (k < 7) PE_LOAD(t + 1);
            {
                float v[4] = {bflo(r.x), bfhi(r.x), bflo(r.y), bfhi(r.y)};
                const float ss = wave_sum(v[0] * v[0] + v[1] * v[1] + v[2] * v[2] + v[3] * v[3]);
                const float rr = rsqrtf(ss * (1.f / 256.f) + 1e-6f);
                const f32x4 gq = *(const f32x4*)(qn + lane * 4);
                *(u32x2*)(CQ + (size_t)t * 256 + lane * 4) = (u32x2){pk2(v[0] * rr * gq[0], v[1] * rr * gq[1]), pk2(v[2] * rr * gq[2], v[3] * rr * gq[3])};
            }
            {
                const float v0 = bflo(rkv), v1 = bfhi(rkv);
                const float ss = wave_sum(v0 * v0 + v1 * v1);
                const float rr = rsqrtf(ss * (1.f / 128.f) + 1e-6f);
                *(unsigned*)(CKV + (size_t)t * 128 + lane * 2) = pk2(v0 * rr * kvn[lane * 2], v1 * rr * kvn[lane * 2 + 1]);
            }
            if (lane < 16) {
                KROPE[(size_t)t * 32 + lane] = (bf16_t)f2bf(x1 * cs - x2 * sn);
                KROPE[(size_t)t * 32 + 16 + lane] = (bf16_t)f2bf(x2 * cs + x1 * sn);
            }
#pragma unroll
            for (int arr = 0; arr < 3; ++arr) {
                float y[8];
#pragma unroll
                for (int j = 0; j < 8; ++j) y[j] = 0.f;
#pragma unroll
                for (int w = 0; w < 4; ++w) {
                    float f[8]; unpack8(xr[arr][w], f);
                    const f32x4 c0 = *(const f32x4*)(cwL + w * 1536 + arr * 512 + lane * 8), c1 = *(const f32x4*)(cwL + w * 1536 + arr * 512 + lane * 8 + 4);
#pragma unroll
                    for (int j = 0; j < 4; ++j) { y[j] += c0[j] * f[j]; y[4 + j] += c1[j] * f[4 + j]; }
                }
                float ss = 0.f;
#pragma unroll
                for (int j = 0; j < 8; ++j) { y[j] = siluf_(y[j]); ss += y[j] * y[j]; }
                if (arr < 2) {
                    float rr = rsqrtf(red16(ss) + 1e-6f);
                    if (arr == 0) rr *= 0.08838834764831845f;
#pragma unroll
                    for (int j = 0; j < 8; ++j) y[j] *= rr;
                }
                bf16_t* dst = (arr == 0) ? GQ : (arr == 1) ? GK : GV;
                *(u32x4*)(dst + (size_t)t * 512 + lane * 8) = (u32x4){pk2(y[0], y[1]), pk2(y[2], y[3]), pk2(y[4], y[5]), pk2(y[6], y[7])};
                xr[arr][0] = xr[arr][1]; xr[arr][1] = xr[arr][2]; xr[arr][2] = xr[arr][3];
            }
            if (lane < 4) BETA[(size_t)t * 4 + lane] = sigmoidf_(gate);
            else if (lane < 8) { const int h = lane - 4; GLOG[(size_t)t * 4 + h] = -expf(a_log[h]) * softplusf_(gate + dt_bias[h]); }
        }
#undef PE_LOAD
    }
}

__device__ __forceinline__ void phase_prep_odd(const bf16_t* PROJ, const float* ROPES, bf16_t* SQ, bf16_t* SK, const Ctx& c) {
    const int lane = c.lane;
    const int hh = lane >> 2, j = lane & 3;
    const bool isq = lane < 32, act = lane < 40;
    const int scol = isq ? 1544 + hh * 64 + j * 8 : 2056 + (hh - 8) * 64 + j * 8;
    const float sc = isq ? 0.18033688011112042f : 1.f;
    for (int t = c.bid * 4 + c.wid; t < T; t += c.nblk * 4) {
        if (act) {
            const bf16_t* pr = PROJ + (size_t)t * NPAD + scol;
            const u32x4 r1 = *(const u32x4*)pr, r2 = *(const u32x4*)(pr + 32);
            const float* rp = ROPES + ((size_t)t * 32 + j * 8) * 2;
            const f32x4 t0 = *(const f32x4*)rp, t1 = *(const f32x4*)(rp + 4), t2 = *(const f32x4*)(rp + 8), t3 = *(const f32x4*)(rp + 12);
            const float cs[8] = {t0[0], t0[2], t1[0], t1[2], t2[0], t2[2], t3[0], t3[2]}, sn[8] = {t0[1], t0[3], t1[1], t1[3], t2[1], t2[3], t3[1], t3[3]};
            float x1[8], x2[8], o1[8], o2[8]; unpack8(r1, x1); unpack8(r2, x2);
#pragma unroll
            for (int k = 0; k < 8; ++k) { o1[k] = (x1[k] * cs[k] - x2[k] * sn[k]) * sc; o2[k] = (x2[k] * cs[k] + x1[k] * sn[k]) * sc; }
            bf16_t* d = isq ? SQ + (size_t)t * 512 + hh * 64 + j * 8 : SK + (size_t)t * 128 + (hh - 8) * 64 + j * 8;
            *(u32x4*)d = (u32x4){pk2(o1[0], o1[1]), pk2(o1[2], o1[3]), pk2(o1[4], o1[5]), pk2(o1[6], o1[7])};
            *(u32x4*)(d + 32) = (u32x4){pk2(o2[0], o2[1]), pk2(o2[2], o2[3]), pk2(o2[4], o2[5]), pk2(o2[6], o2[7])};
        }
    }
}

__device__ __forceinline__ int next_unit(unsigned* ctr, const Ctx& c) {
    volatile int* su = (volatile int*)(c.smem0 + LDS_BLK + 16);
    __syncthreads();
    if (c.tid0 == 0) *su = (int)atomicAdd(ctr, 1u);
    __syncthreads();
    return *su * 2 + c.half;
}

typedef float f32x16 __attribute__((ext_vector_type(16)));
typedef short s16x4 __attribute__((ext_vector_type(4)));
#define MFMA32(a, b, c) __builtin_amdgcn_mfma_f32_32x32x16_bf16((a), (b), (c), 0, 0, 0)
template <int S_> __device__ __forceinline__ bf16x8 pack_step(const f32x16& x) {
    u32x4 p;
    asm volatile("v_cvt_pk_bf16_f32 %0, %4, %5\n\tv_cvt_pk_bf16_f32 %1, %6, %7\n\tv_cvt_pk_bf16_f32 %2, %8, %9\n\tv_cvt_pk_bf16_f32 %3, %10, %11\n\ts_nop 1"
                 : "=&v"(p[0]), "=&v"(p[1]), "=&v"(p[2]), "=&v"(p[3])
                 : "v"(x[8 * S_]), "v"(x[8 * S_ + 1]), "v"(x[8 * S_ + 2]), "v"(x[8 * S_ + 3]), "v"(x[8 * S_ + 4]), "v"(x[8 * S_ + 5]), "v"(x[8 * S_ + 6]), "v"(x[8 * S_ + 7]));
    return __builtin_bit_cast(bf16x8, p);
}
template <int S_> __device__ __forceinline__ bf16x8 pack_step_m(const f32x16& x) {
    u32x4 p;
    asm volatile("s_nop 15\n\tv_cvt_pk_bf16_f32 %0, %4, %5\n\tv_cvt_pk_bf16_f32 %1, %6, %7\n\tv_cvt_pk_bf16_f32 %2, %8, %9\n\tv_cvt_pk_bf16_f32 %3, %10, %11\n\ts_nop 1"
                 : "=&v"(p[0]), "=&v"(p[1]), "=&v"(p[2]), "=&v"(p[3])
                 : "v"(x[8 * S_]), "v"(x[8 * S_ + 1]), "v"(x[8 * S_ + 2]), "v"(x[8 * S_ + 3]), "v"(x[8 * S_ + 4]), "v"(x[8 * S_ + 5]), "v"(x[8 * S_ + 6]), "v"(x[8 * S_ + 7]));
    return __builtin_bit_cast(bf16x8, p);
}
constexpr int ATT_VB = 64 * 128;

template <int NKS, bool WIN>
__device__ __forceinline__ void attn_unit(const bf16_t* Qp, int q_ld, const bf16_t* K1, int k1_ld, const bf16_t* K2, int k2_ld, const bf16_t* Vp, int v_ld,
                          bf16_t* Op, int o_ld, int Q0, float sink_l2, const Ctx& c) {
    constexpr int KB = NKS * 2 * 1024, BUF = KB + ATT_VB;
    const int lane = c.lane, r = lane & 31, h = lane >> 5;
    const int wid = __builtin_amdgcn_readfirstlane(c.wid);
    const int q0w = Q0 + wid * 32;
    unsigned char* smem = c.smem;
    bf16x8 qf[NKS];
#pragma unroll
    for (int ks = 0; ks < NKS; ++ks) qf[ks] = *(const bf16x8*)(Qp + (size_t)(q0w + r) * q_ld + ks * 16 + h * 8);
    f32x16 o0, o1;
#pragma unroll
    for (int i = 0; i < 16; ++i) { o0[i] = 0.f; o1[i] = 0.f; }
    float m = WIN ? sink_l2 : -1e30f, l = (WIN && h == 0) ? 1.f : 0.f;
    const int kt_lo = WIN ? ((Q0 >> 6) - 2 < 0 ? 0 : (Q0 >> 6) - 2) : 0, kt_hi = (Q0 >> 6) + 1;
#define ATT_STAGE(kt_, buf_) do { unsigned char* bp = smem + (buf_) * BUF; const size_t kb = (size_t)(kt_) * 64; \
        _Pragma("unroll") for (int i = 0; i < (NKS * 2) / 4; ++i) { const int ch = wid + 4 * i; \
            const bf16_t* sp = (ch < 8) ? (K1 + (kb + lane) * k1_ld + ch * 8) : (K2 + (kb + lane) * k2_ld + (ch - 8) * 8); \
            glds16(sp, bp + ch * 1024 + lane * 16); } \
        _Pragma("unroll") for (int i = 0; i < 2; ++i) { const int j = wid + 4 * i; \
            glds16(Vp + (kb + 8 * j + (lane >> 3)) * v_ld + (lane & 7) * 8, bp + KB + j * 1024 + lane * 16); } } while (0)
    ATT_STAGE(kt_lo, 0);
    const int i16 = lane & 15;
    const unsigned vlane = (unsigned)((4 * h + (i16 >> 2)) * 128 + 32 * ((lane >> 4) & 1) + 8 * (i16 & 3));
    for (int kt = kt_lo; kt <= kt_hi; ++kt) {
        const int cur = (kt - kt_lo) & 1;
        asm volatile("s_waitcnt vmcnt(0)" ::: "memory");
        __syncthreads();
        if (kt < kt_hi) ATT_STAGE(kt + 1, cur ^ 1);
        const int k0 = kt * 64;
        const bool active = (k0 <= q0w + 31) && (!WIN || (k0 + 63 > q0w - 128));
        if (active) {
            const unsigned char* Kt = smem + cur * BUF;
            f32x16 x0, x1;
#pragma unroll
            for (int i = 0; i < 16; ++i) { x0[i] = 0.f; x1[i] = 0.f; }
#pragma unroll
            for (int ks = 0; ks < NKS; ++ks) {
                const bf16x8 kf0 = *(const bf16x8*)(Kt + (ks * 2 + h) * 1024 + r * 16);
                const bf16x8 kf1 = *(const bf16x8*)(Kt + (ks * 2 + h) * 1024 + (32 + r) * 16);
                x0 = MFMA32(kf0, qf[ks], x0); x1 = MFMA32(kf1, qf[ks], x1);
            }
            const bool need_mask = (k0 + 63 > q0w) || (WIN && (k0 <= q0w + 31 - 128));
            if (need_mask) {
                const int q = q0w + r;
#pragma unroll
                for (int i = 0; i < 16; ++i) {
                    const int key = k0 + (i & 3) + 8 * (i >> 2) + 4 * h;
                    const bool v0 = (key <= q) && (!WIN || key > q - 128);
                    const bool v1 = (key + 32 <= q) && (!WIN || key + 32 > q - 128);
                    x0[i] = v0 ? x0[i] : -INFINITY; x1[i] = v1 ? x1[i] : -INFINITY;
                }
            }
            float mx = fmaxf(x0[0], x1[0]);
#pragma unroll
            for (int i = 1; i < 16; ++i) mx = fmaxf(mx, fmaxf(x0[i], x1[i]));
            mx = fmaxf(mx, shfl_xor_(mx, 32));
            const float mn = fmaxf(m, mx);
            const float alpha = __builtin_amdgcn_exp2f(m - mn);
            m = mn;
            float ps = 0.f;
#pragma unroll
            for (int i = 0; i < 16; ++i) { x0[i] = __builtin_amdgcn_exp2f(x0[i] - mn); x1[i] = __builtin_amdgcn_exp2f(x1[i] - mn); ps += x0[i] + x1[i]; }
            l = l * alpha + ps;
            o0 *= alpha; o1 *= alpha;
            const unsigned vbase = (unsigned)(size_t)(smem + cur * BUF + KB) + vlane;
#pragma unroll
            for (int t = 0; t < 2; ++t) {
                s16x4 l00, h00, l01, h01, l10, h10, l11, h11;
                const unsigned va = vbase + t * 4096;
                asm volatile("ds_read_b64_tr_b16 %0, %8\n\t"
                             "ds_read_b64_tr_b16 %1, %8 offset:1024\n\t"
                             "ds_read_b64_tr_b16 %2, %8 offset:64\n\t"
                             "ds_read_b64_tr_b16 %3, %8 offset:1088\n\t"
                             "ds_read_b64_tr_b16 %4, %8 offset:2048\n\t"
                             "ds_read_b64_tr_b16 %5, %8 offset:3072\n\t"
                             "ds_read_b64_tr_b16 %6, %8 offset:2112\n\t"
                             "ds_read_b64_tr_b16 %7, %8 offset:3136\n\t"
                             "s_waitcnt lgkmcnt(0)"
                             : "=&v"(l00), "=&v"(h00), "=&v"(l01), "=&v"(h01), "=&v"(l10), "=&v"(h10), "=&v"(l11), "=&v"(h11) : "v"(va) : "memory");
                const bf16x8 v00 = __builtin_shufflevector(l00, h00, 0, 1, 2, 3, 4, 5, 6, 7), v01 = __builtin_shufflevector(l01, h01, 0, 1, 2, 3, 4, 5, 6, 7);
                const bf16x8 v10 = __builtin_shufflevector(l10, h10, 0, 1, 2, 3, 4, 5, 6, 7), v11 = __builtin_shufflevector(l11, h11, 0, 1, 2, 3, 4, 5, 6, 7);
                const bf16x8 pb0 = (t == 0) ? pack_step<0>(x0) : pack_step<0>(x1);
                const bf16x8 pb1 = (t == 0) ? pack_step<1>(x0) : pack_step<1>(x1);
                o0 = MFMA32(v00, pb0, o0); o1 = MFMA32(v01, pb0, o1);
                o0 = MFMA32(v10, pb1, o0); o1 = MFMA32(v11, pb1, o1);
            }
        }
    }
#undef ATT_STAGE
    l += shfl_xor_(l, 32);
    const float inv = 1.f / l;
    bf16_t* orow = Op + (size_t)(q0w + r) * o_ld + 4 * h;
#pragma unroll
    for (int g = 0; g < 4; ++g) {
        *(u32x2*)(orow + 8 * g) = (u32x2){pk2(o0[4 * g] * inv, o0[4 * g + 1] * inv), pk2(o0[4 * g + 2] * inv, o0[4 * g + 3] * inv)};
        *(u32x2*)(orow + 32 + 8 * g) = (u32x2){pk2(o1[4 * g] * inv, o1[4 * g + 1] * inv), pk2(o1[4 * g + 2] * inv, o1[4 * g + 3] * inv)};
    }
}

constexpr size_t MLC_DC = 0, MLC_CS = 33554432, MLC_DN = MLC_CS + 16777216, MLC_NS = MLC_DN + 262144, MLC_ML = MLC_NS + 262144, MLC_BE = MLC_ML + 4096, MLC_MS = MLC_BE + 4096;

__device__ __forceinline__ float scan_add64(float v, int lane) {
#pragma unroll
    for (int o = 1; o < 64; o <<= 1) { const float x = shfl_up_(v, o); if (lane >= o) v += x; }
    return v;
}
__device__ __forceinline__ float scan_max64(float v, int lane) {
#pragma unroll
    for (int o = 1; o < 64; o <<= 1) { const float x = shfl_up_(v, o); if (lane >= o) v = fmaxf(v, x); }
    return v;
}
__device__ __forceinline__ float wave_max(float v) {
#pragma unroll
    for (int o = 32; o > 0; o >>= 1) v = fmaxf(v, shfl_xor_(v, o));
    return v;
}

__device__ __forceinline__ void mlc_passA(int u, const bf16_t* PROJ, const float* GATES, const float* b_i, const float* b_f, unsigned char* YB, const Ctx& c) {
    const int bh = u >> 5, b = bh >> 2, h = bh & 3;
    const size_t t0 = (size_t)b * SEQ + (u & 31) * 64;
    unsigned char* smem = c.smem;
    float* saL = (float*)(smem + 24576);
    const int lane = c.lane, wid = __builtin_amdgcn_readfirstlane(c.wid);
#pragma unroll
    for (int i = 0; i < 4; ++i) { const int j = wid * 4 + i;
        glds16(PROJ + (t0 + 4 * j + (lane >> 4)) * NPAD + 512 + h * 128 + (lane & 15) * 8, smem + 8192 + j * 1024 + lane * 16); }
    if (wid == 0) {
        const float ip = GATES[(t0 + lane) * 8 + h] + b_i[h], lf = -softplusf_(-(GATES[(t0 + lane) * 8 + 4 + h] + b_f[h]));
        const float bc = scan_add64(lf, lane), bend = shfl_c_(bc, 63);
        const float a = bend - bc + ip, mloc = wave_max(a);
        saL[lane] = expf(a - mloc) * 0.125f;
        if (lane == 0) { ((float*)(YB + MLC_ML))[u] = mloc; ((float*)(YB + MLC_BE))[u] = bend; }
    }
    __syncthreads();
#pragma unroll
    for (int i = 0; i < 2; ++i) {
        const int idx = c.tid + 256 * i, row = idx >> 3, chk = idx & 7;
        const u32x4 r = *(const u32x4*)(PROJ + (t0 + row) * NPAD + 256 + h * 64 + chk * 8);
        float f[8]; unpack8(r, f);
        const float s = saL[row];
        *(u32x4*)(smem + row * 128 + chk * 16) = (u32x4){pk2(f[0] * s, f[1] * s), pk2(f[2] * s, f[3] * s), pk2(f[4] * s, f[5] * s), pk2(f[6] * s, f[7] * s)};
    }
    asm volatile("s_waitcnt vmcnt(0)" ::: "memory");
    __syncthreads();
    const int h5 = lane >> 5, r = lane & 31, i16 = lane & 15, q4 = i16 >> 2, p = i16 & 3, blk = (lane >> 4) & 1;
    const int dkt = wid & 1, dvp = wid >> 1;
    const unsigned kaddr = (unsigned)(size_t)smem + (unsigned)((8 * h5 + q4) * 128 + dkt * 64 + 32 * blk + 8 * p);
    const unsigned vaddr = (unsigned)(size_t)smem + 8192u + (unsigned)((8 * h5 + q4) * 256 + dvp * 128 + 32 * blk + 8 * p);
    f32x16 a0, a1;
#pragma unroll
    for (int i = 0; i < 16; ++i) { a0[i] = 0.f; a1[i] = 0.f; }
#pragma unroll
    for (int st = 0; st < 4; ++st) {
        s16x4 kl, kh, v0l, v0h, v1l, v1h;
        const unsigned ka = kaddr + st * 2048, va = vaddr + st * 4096;
        asm volatile("ds_read_b64_tr_b16 %0, %6\n\t"
                     "ds_read_b64_tr_b16 %1, %6 offset:512\n\t"
                     "ds_read_b64_tr_b16 %2, %7\n\t"
                     "ds_read_b64_tr_b16 %3, %7 offset:1024\n\t"
                     "ds_read_b64_tr_b16 %4, %7 offset:64\n\t"
                     "ds_read_b64_tr_b16 %5, %7 offset:1088\n\t"
                     "s_waitcnt lgkmcnt(0)"
                     : "=&v"(kl), "=&v"(kh), "=&v"(v0l), "=&v"(v0h), "=&v"(v1l), "=&v"(v1h) : "v"(ka), "v"(va) : "memory");
        const bf16x8 kf = __builtin_shufflevector(kl, kh, 0, 1, 2, 3, 4, 5, 6, 7);
        const bf16x8 vf0 = __builtin_shufflevector(v0l, v0h, 0, 1, 2, 3, 4, 5, 6, 7), vf1 = __builtin_shufflevector(v1l, v1h, 0, 1, 2, 3, 4, 5, 6, 7);
        a0 = MFMA32(kf, vf0, a0); a1 = MFMA32(kf, vf1, a1);
    }
    float* DC = (float*)(YB + MLC_DC) + (size_t)u * 8192;
#pragma unroll
    for (int i = 0; i < 16; ++i) {
        const int dk = dkt * 32 + (i & 3) + 8 * (i >> 2) + 4 * h5;
        DC[dk * 128 + dvp * 64 + r] = a0[i]; DC[dk * 128 + dvp * 64 + 32 + r] = a1[i];
    }
    if (c.tid < 64) {
        float s = 0.f;
#pragma unroll 8
        for (int t = 0; t < 64; ++t) s += bf2f(((const bf16_t*)smem)[t * 64 + c.tid]);
        ((float*)(YB + MLC_DN))[(size_t)u * 64 + c.tid] = s;
    }
}

__device__ __forceinline__ void mlc_passB(int u, unsigned char* YB, const Ctx& c) {
    const int bh = u >> 3, sl = u & 7;
    const float* ML = (const float*)(YB + MLC_ML) + bh * 32; const float* BE = (const float*)(YB + MLC_BE) + bh * 32;
    const float* DC = (const float*)(YB + MLC_DC) + (size_t)bh * 32 * 8192 + sl * 1024 + c.tid * 4;
    bf16_t* CS = (bf16_t*)(YB + MLC_CS) + (size_t)bh * 32 * 8192 + sl * 1024 + c.tid * 4;
    const float* DN = (const float*)(YB + MLC_DN) + (size_t)bh * 32 * 64; float* NS = (float*)(YB + MLC_NS) + (size_t)bh * 32 * 64; float* MS = (float*)(YB + MLC_MS) + bh * 32;
    f32x4 C4 = (f32x4){0.f, 0.f, 0.f, 0.f}; float nv = 0.f, m = 0.f;
    const bool do_n = (sl == 0) && (c.tid < 64);
#pragma unroll 1
    for (int nb = 0; nb < 32; nb += 16) {
        f32x4 d[16]; float be[16], ml[16], dn[16];
#pragma unroll
        for (int i = 0; i < 16; ++i) { d[i] = *(const f32x4*)(DC + (size_t)(nb + i) * 8192); be[i] = BE[nb + i]; ml[i] = ML[nb + i]; dn[i] = do_n ? DN[(nb + i) * 64 + c.tid] : 0.f; }
#pragma unroll
        for (int i = 0; i < 16; ++i) {
            const int n = nb + i;
            *(u32x2*)(CS + (size_t)n * 8192) = (u32x2){pk2(C4[0], C4[1]), pk2(C4[2], C4[3])};
            if (do_n) NS[n * 64 + c.tid] = nv;
            if (sl == 0 && c.tid == 0) MS[n] = m;
            const float mn = fmaxf(be[i] + m, ml[i]), keep = expf(be[i] + m - mn), g = expf(ml[i] - mn);
            m = mn;
            C4 = C4 * keep + d[i] * g;
            nv = nv * keep + dn[i] * g;
        }
    }
}

__device__ __forceinline__ void mlc_passC(int u, const bf16_t* PROJ, const float* GATES, const float* b_i, const float* b_f, const unsigned char* YB,
                                          const float* gain  , bf16_t* MIXO, const Ctx& c) {
    const int bh = u >> 5, b = bh >> 2, h = bh & 3;
    const size_t t0 = (size_t)b * SEQ + (u & 31) * 64;
    unsigned char* smem = c.smem;
    float* csL = (float*)(smem + 32768); float* pmL = (float*)(smem + 33024); float* bcL = (float*)(smem + 33280); float* nnL = (float*)(smem + 33536); float* sqL = (float*)(smem + 33792);
    const int lane = c.lane, wid = __builtin_amdgcn_readfirstlane(c.wid);
    const bf16_t* CS = (const bf16_t*)(YB + MLC_CS) + (size_t)u * 8192;
#pragma unroll
    for (int i = 0; i < 4; ++i) { const int j = wid * 4 + i;
        glds16(PROJ + (t0 + 4 * j + (lane >> 4)) * NPAD + 512 + h * 128 + (lane & 15) * 8, smem + j * 1024 + lane * 16);
        glds16(CS + (4 * j + (lane >> 4)) * 128 + (lane & 15) * 8, smem + 16384 + j * 1024 + lane * 16); }
    const int h5 = lane >> 5, r = lane & 31, i16 = lane & 15, q4 = i16 >> 2, p = i16 & 3, blk = (lane >> 4) & 1;
    const int th = wid & 1, dvh = wid >> 1;
    const int t = th * 32 + r;
    const float m_n = ((const float*)(YB + MLC_MS))[u];
    bf16x8 qf[4], kfa[4], kfb[4];
#pragma unroll
    for (int ks = 0; ks < 4; ++ks) {
        qf[ks] = *(const bf16x8*)(PROJ + (t0 + t) * NPAD + h * 64 + ks * 16 + h5 * 8);
        kfa[ks] = *(const bf16x8*)(PROJ + (t0 + r) * NPAD + 256 + h * 64 + ks * 16 + h5 * 8);
        kfb[ks] = *(const bf16x8*)(PROJ + (t0 + 32 + r) * NPAD + 256 + h * 64 + ks * 16 + h5 * 8);
    }
    const bf16_t* grow = PROJ + (t0 + t) * NPAD + 1032 + h * 128 + dvh * 64 + 4 * h5;
    const float* gn = gain + h * 128 + dvh * 64 + 4 * h5;
    u32x2 zrp[2][4]; f32x4 gvp[2][4];
#pragma unroll
    for (int d = 0; d < 2; ++d)
#pragma unroll
        for (int g = 0; g < 4; ++g) { zrp[d][g] = *(const u32x2*)(grow + d * 32 + 8 * g); gvp[d][g] = *(const f32x4*)(gn + d * 32 + 8 * g); }
    float bcl = 0.f;
    if (wid == 0) {
        const float ip = GATES[(t0 + lane) * 8 + h] + b_i[h], lf = -softplusf_(-(GATES[(t0 + lane) * 8 + 4 + h] + b_f[h]));
        bcl = scan_add64(lf, lane);
        const float cs = ip - bcl;
        csL[lane] = cs; pmL[lane] = scan_max64(cs, lane);
        nnL[lane] = ((const float*)(YB + MLC_NS))[(size_t)u * 64 + lane];
        bcL[lane] = bcl;
    }
    asm volatile("s_waitcnt vmcnt(0)" ::: "memory");
    __syncthreads();
    const float Mt = fmaxf(m_n, pmL[t]), w_inter = __expf(m_n - Mt), em = __expf(-(bcL[t] + Mt));
    float qn = 0.f; bf16x8 qw[4];
#pragma unroll
    for (int ks = 0; ks < 4; ++ks) {
        const u32x4 raw = __builtin_bit_cast(u32x4, qf[ks]); float f[8]; unpack8(raw, f);
#pragma unroll
        for (int j = 0; j < 8; ++j) qn += f[j] * nnL[ks * 16 + h5 * 8 + j];
        qw[ks] = __builtin_bit_cast(bf16x8, (u32x4){pk2(f[0] * w_inter, f[1] * w_inter), pk2(f[2] * w_inter, f[3] * w_inter), pk2(f[4] * w_inter, f[5] * w_inter), pk2(f[6] * w_inter, f[7] * w_inter)});
    }
    qn += shfl_xor_(qn, 32);
    f32x16 x0, x1;
#pragma unroll
    for (int i = 0; i < 16; ++i) { x0[i] = 0.f; x1[i] = 0.f; }
#pragma unroll
    for (int ks = 0; ks < 4; ++ks) {
        x0 = MFMA32(kfa[ks], qf[ks], x0);
        if (th) x1 = MFMA32(kfb[ks], qf[ks], x1);
    }
    float ps = 0.f;
#pragma unroll
    for (int i = 0; i < 16; ++i) {
        const int s = (i & 3) + 8 * (i >> 2) + 4 * h5;
        const float w0 = (s <= t) ? __expf(csL[s] - Mt) * 0.125f : 0.f;
        x0[i] *= w0; ps += x0[i];
        if (th) { const float w1 = (s <= r) ? __expf(csL[32 + s] - Mt) * 0.125f : 0.f; x1[i] *= w1; ps += x1[i]; }
    }
    ps += shfl_xor_(ps, 32);
    const float den = w_inter * qn + ps;
    f32x16 o0, o1;
#pragma unroll
    for (int i = 0; i < 16; ++i) { o0[i] = 0.f; o1[i] = 0.f; }
    {
        const unsigned vb = (unsigned)(size_t)smem + (unsigned)((4 * h5 + q4) * 256 + dvh * 128 + 32 * blk + 8 * p);
#pragma unroll
        for (int st = 0; st < 2; ++st) {
            if (st == 0 || th) {
                s16x4 l00, h00, l01, h01, l10, h10, l11, h11;
                const unsigned va = vb + st * 8192;
                asm volatile("ds_read_b64_tr_b16 %0, %8\n\t"
                             "ds_read_b64_tr_b16 %1, %8 offset:2048\n\t"
                             "ds_read_b64_tr_b16 %2, %8 offset:64\n\t"
                             "ds_read_b64_tr_b16 %3, %8 offset:2112\n\t"
                             "ds_read_b64_tr_b16 %4, %8 offset:4096\n\t"
                             "ds_read_b64_tr_b16 %5, %8 offset:6144\n\t"
                             "ds_read_b64_tr_b16 %6, %8 offset:4160\n\t"
                             "ds_read_b64_tr_b16 %7, %8 offset:6208\n\t"
                             "s_waitcnt lgkmcnt(0)"
                             : "=&v"(l00), "=&v"(h00), "=&v"(l01), "=&v"(h01), "=&v"(l10), "=&v"(h10), "=&v"(l11), "=&v"(h11) : "v"(va) : "memory");
                const bf16x8 v00 = __builtin_shufflevector(l00, h00, 0, 1, 2, 3, 4, 5, 6, 7), v01 = __builtin_shufflevector(l01, h01, 0, 1, 2, 3, 4, 5, 6, 7);
                const bf16x8 v10 = __builtin_shufflevector(l10, h10, 0, 1, 2, 3, 4, 5, 6, 7), v11 = __builtin_shufflevector(l11, h11, 0, 1, 2, 3, 4, 5, 6, 7);
                const bf16x8 pb0 = (st == 0) ? pack_step<0>(x0) : pack_step<0>(x1);
                const bf16x8 pb1 = (st == 0) ? pack_step<1>(x0) : pack_step<1>(x1);
                o0 = MFMA32(v00, pb0, o0); o1 = MFMA32(v01, pb0, o1);
                o0 = MFMA32(v10, pb1, o0); o1 = MFMA32(v11, pb1, o1);
            }
        }
    }
    {
        const unsigned cb = (unsigned)(size_t)smem + 16384u + (unsigned)((8 * h5 + q4) * 256 + dvh * 128 + 32 * blk + 8 * p);
#pragma unroll
        for (int kp = 0; kp < 2; ++kp) {
            s16x4 l00, h00, l01, h01, l10, h10, l11, h11;
            const unsigned ca = cb + kp * 8192;
            asm volatile("ds_read_b64_tr_b16 %0, %8\n\t"
                         "ds_read_b64_tr_b16 %1, %8 offset:1024\n\t"
                         "ds_read_b64_tr_b16 %2, %8 offset:64\n\t"
                         "ds_read_b64_tr_b16 %3, %8 offset:1088\n\t"
                         "ds_read_b64_tr_b16 %4, %8 offset:4096\n\t"
                         "ds_read_b64_tr_b16 %5, %8 offset:5120\n\t"
                         "ds_read_b64_tr_b16 %6, %8 offset:4160\n\t"
                         "ds_read_b64_tr_b16 %7, %8 offset:5184\n\t"
                         "s_waitcnt lgkmcnt(0)"
                         : "=&v"(l00), "=&v"(h00), "=&v"(l01), "=&v"(h01), "=&v"(l10), "=&v"(h10), "=&v"(l11), "=&v"(h11) : "v"(ca) : "memory");
            const bf16x8 c00 = __builtin_shufflevector(l00, h00, 0, 1, 2, 3, 4, 5, 6, 7), c01 = __builtin_shufflevector(l01, h01, 0, 1, 2, 3, 4, 5, 6, 7);
            const bf16x8 c10 = __builtin_shufflevector(l10, h10, 0, 1, 2, 3, 4, 5, 6, 7), c11 = __builtin_shufflevector(l11, h11, 0, 1, 2, 3, 4, 5, 6, 7);
            o0 = MFMA32(c00, qw[2 * kp], o0); o1 = MFMA32(c01, qw[2 * kp], o1);
            o0 = MFMA32(c10, qw[2 * kp + 1], o0); o1 = MFMA32(c11, qw[2 * kp + 1], o1);
        }
    }
    const float inv = __builtin_amdgcn_rcpf(fmaxf(fabsf(den), em));
    float ss = 0.f;
#pragma unroll
    for (int i = 0; i < 16; ++i) { o0[i] *= inv; o1[i] *= inv; ss += o0[i] * o0[i] + o1[i] * o1[i]; }
    ss += shfl_xor_(ss, 32);
    if (h5 == 0) sqL[wid * 32 + r] = ss;
    __syncthreads();
    const float rr = rsqrtf((sqL[th * 32 + r] + sqL[(th + 2) * 32 + r]) * (1.f / 128.f) + 1e-6f);
    bf16_t* orow = MIXO + (t0 + t) * 1024 + h * 128 + dvh * 64 + 4 * h5;
#pragma unroll
    for (int d = 0; d < 2; ++d)
#pragma unroll
        for (int g = 0; g < 4; ++g) {
            const u32x2 zr = zrp[d][g];
            const f32x4 gv = gvp[d][g];
            const float z0 = bflo(zr.x), z1 = bfhi(zr.x), z2 = bflo(zr.y), z3 = bfhi(zr.y);
            const float y0 = (d ? o1[4 * g] : o0[4 * g]) * rr * gv[0] * sigmoidf_(z0), y1 = (d ? o1[4 * g + 1] : o0[4 * g + 1]) * rr * gv[1] * sigmoidf_(z1);
            const float y2 = (d ? o1[4 * g + 2] : o0[4 * g + 2]) * rr * gv[2] * sigmoidf_(z2), y3 = (d ? o1[4 * g + 3] : o0[4 * g + 3]) * rr * gv[3] * sigmoidf_(z3);
            *(u32x2*)(orow + d * 32 + 8 * g) = (u32x2){pk2(y0, y1), pk2(y2, y3)};
        }
}

constexpr size_t GD_WN = 0, GD_UU = GD_WN + (size_t)1024 * 16384, GD_KGT = GD_UU + (size_t)1024 * 16384, GD_QG = GD_KGT + (size_t)1024 * 16384,
                 GD_AT = GD_QG + (size_t)1024 * 16384, GD_GL = GD_AT + (size_t)1024 * 8192, GD_END = GD_GL + 4096;
static_assert(GD_END <= (size_t)MAXROWS * 256 * 2, "GDN chunk records must fit the HBUF region");

__device__ __forceinline__ void gdc_passA(int u, const bf16_t* GQ, const bf16_t* GK, const bf16_t* GV, const float* BETA, const float* GLOG, unsigned char* HB, const Ctx& c) {
    const int bh = u >> 5, b = bh >> 2, h = bh & 3;
    const size_t t0 = (size_t)b * SEQ + (u & 31) * 64;
    unsigned char* smem = c.smem;
    float* Lm = (float*)(smem + 49152);
    float* GA = (float*)(smem + 65536 + 64); float* BT = GA + 64; float* EG = BT + 64; float* EK = EG + 64;
    const int lane = c.lane, wid = __builtin_amdgcn_readfirstlane(c.wid);
    const int h5 = lane >> 5, r = lane & 31;
    if (wid == 0) {
        const float g = GLOG[(t0 + lane) * 4 + h];
        const float G = scan_add64(g, lane), Gl = shfl_c_(G, 63);
        GA[lane] = G; BT[lane] = BETA[(t0 + lane) * 4 + h]; EG[lane] = expf(G); EK[lane] = expf(Gl - G);
        if (lane == 0) ((float*)(HB + GD_GL))[u] = expf(Gl);
    }
    __syncthreads();
    if (wid < 3) {
        const int it = (wid + 1) >> 1, jt = wid >> 1;
        f32x16 dl, da;
#pragma unroll
        for (int i = 0; i < 16; ++i) { dl[i] = 0.f; da[i] = 0.f; }
#pragma unroll
        for (int ks = 0; ks < 8; ++ks) {
            const bf16x8 ki = *(const bf16x8*)(GK + (t0 + 32 * it + r) * 512 + h * 128 + ks * 16 + h5 * 8);
            const bf16x8 kj = *(const bf16x8*)(GK + (t0 + 32 * jt + r) * 512 + h * 128 + ks * 16 + h5 * 8);
            const bf16x8 qi = *(const bf16x8*)(GQ + (t0 + 32 * it + r) * 512 + h * 128 + ks * 16 + h5 * 8);
            dl = MFMA32(ki, kj, dl); da = MFMA32(qi, kj, da);
        }
        const int j = 32 * jt + r; const float Gj = GA[j];
        bf16_t* AT = (bf16_t*)(HB + GD_AT) + (size_t)u * 4096;
#pragma unroll
        for (int i = 0; i < 16; ++i) {
            const int ii = 32 * it + (i & 3) + 8 * (i >> 2) + 4 * h5;
            const float dec = __expf(GA[ii] - Gj);
            Lm[ii * 64 + j] = (j < ii) ? dl[i] * BT[ii] * dec : 0.f;
            AT[ii * 64 + j] = (bf16_t)f2bf((j <= ii) ? da[i] * dec : 0.f);
        }
        if (wid == 0) {
#pragma unroll
            for (int i = 0; i < 16; ++i) { const int ii = (i & 3) + 8 * (i >> 2) + 4 * h5; Lm[ii * 64 + 32 + r] = 0.f; AT[ii * 64 + 32 + r] = 0; }
        }
    }
    __syncthreads();
    if (wid == 0) {
        float Tc[64];
#pragma unroll
        for (int i = 0; i < 64; ++i) {
            float s = (i == lane) ? 1.f : 0.f;
#pragma unroll
            for (int k = 0; k < i; ++k) s -= Lm[i * 64 + k] * Tc[k];
            Tc[i] = s;
        }
        bf16_t* Tm = (bf16_t*)Lm;
#pragma unroll
        for (int i = 0; i < 64; ++i) Tm[i * 64 + lane] = (bf16_t)f2bf(Tc[i]);
    } else {
        const int t3 = c.tid - 64;
        for (int idx = t3; idx < 4096; idx += 192) {
            const int arr = idx >> 10, rem = idx & 1023, row = rem >> 4, chk = rem & 15;
            const bf16_t* sp = ((arr == 1) ? GV : (arr == 3) ? GQ : GK) + (t0 + row) * 512 + h * 128 + chk * 8;
            const u32x4 raw = *(const u32x4*)sp; float f[8]; unpack8(raw, f);
            const float sc = (arr == 0) ? BT[row] * EG[row] : (arr == 1) ? BT[row] : (arr == 2) ? EK[row] : EG[row];
            const u32x4 o = (u32x4){pk2(f[0] * sc, f[1] * sc), pk2(f[2] * sc, f[3] * sc), pk2(f[4] * sc, f[5] * sc), pk2(f[6] * sc, f[7] * sc)};
            if (arr < 3) *(u32x4*)(smem + arr * 16384 + row * 256 + chk * 16) = o;
            else *(u32x4*)((bf16_t*)(HB + GD_QG) + (size_t)u * 8192 + row * 128 + chk * 8) = o;
        }
    }
    __syncthreads();
    {
        const int i16 = lane & 15, q4 = i16 >> 2, p = i16 & 3, blk = (lane >> 4) & 1;
        const unsigned char* Tm = smem + 49152;
        f32x16 u0, u1, w0, w1;
#pragma unroll
        for (int i = 0; i < 16; ++i) { u0[i] = 0.f; u1[i] = 0.f; w0[i] = 0.f; w1[i] = 0.f; }
        const unsigned ib = (unsigned)(size_t)smem + (unsigned)((8 * h5 + q4) * 256 + wid * 64 + 32 * blk + 8 * p);
#pragma unroll
        for (int ks = 0; ks < 4; ++ks) {
            s16x4 kl, kh, vl, vh;
            const unsigned ia = ib + ks * 4096;
            asm volatile("ds_read_b64_tr_b16 %0, %4\n\t"
                         "ds_read_b64_tr_b16 %1, %4 offset:1024\n\t"
                         "ds_read_b64_tr_b16 %2, %4 offset:16384\n\t"
                         "ds_read_b64_tr_b16 %3, %4 offset:17408\n\t"
                         "s_waitcnt lgkmcnt(0)"
                         : "=&v"(kl), "=&v"(kh), "=&v"(vl), "=&v"(vh) : "v"(ia) : "memory");
            const bf16x8 kb = __builtin_shufflevector(kl, kh, 0, 1, 2, 3, 4, 5, 6, 7), vb = __builtin_shufflevector(vl, vh, 0, 1, 2, 3, 4, 5, 6, 7);
            const bf16x8 t1 = *(const bf16x8*)(Tm + (32 + r) * 128 + ks * 32 + h5 * 16);
            w1 = MFMA32(t1, kb, w1); u1 = MFMA32(t1, vb, u1);
            if (ks < 2) { const bf16x8 tt0 = *(const bf16x8*)(Tm + r * 128 + ks * 32 + h5 * 16); w0 = MFMA32(tt0, kb, w0); u0 = MFMA32(tt0, vb, u0); }
        }
        bf16_t* WN = (bf16_t*)(HB + GD_WN) + (size_t)u * 8192; bf16_t* UU = (bf16_t*)(HB + GD_UU) + (size_t)u * 8192;
#pragma unroll
        for (int i = 0; i < 16; ++i) {
            const int s = (i & 3) + 8 * (i >> 2) + 4 * h5;
            WN[s * 128 + wid * 32 + r] = (bf16_t)f2bf(-w0[i]); WN[(32 + s) * 128 + wid * 32 + r] = (bf16_t)f2bf(-w1[i]);
        }
        {
            u32x4* up = (u32x4*)(UU + (size_t)(wid * 64 + lane) * 32);
            up[0] = (u32x4){pk2(u0[0], u0[1]), pk2(u0[2], u0[3]), pk2(u0[4], u0[5]), pk2(u0[6], u0[7])};
            up[1] = (u32x4){pk2(u0[8], u0[9]), pk2(u0[10], u0[11]), pk2(u0[12], u0[13]), pk2(u0[14], u0[15])};
            up[2] = (u32x4){pk2(u1[0], u1[1]), pk2(u1[2], u1[3]), pk2(u1[4], u1[5]), pk2(u1[6], u1[7])};
            up[3] = (u32x4){pk2(u1[8], u1[9]), pk2(u1[10], u1[11]), pk2(u1[12], u1[13]), pk2(u1[14], u1[15])};
        }
        bf16_t* KGT = (bf16_t*)(HB + GD_KGT) + (size_t)u * 8192;
        const int gq = lane >> 4;
        const unsigned kb0 = (unsigned)(size_t)smem + 32768u + (unsigned)(q4 * 256 + gq * 32 + 8 * p);
#pragma unroll
        for (int it2 = 0; it2 < 8; ++it2) {
            const int job = wid * 8 + it2, s0 = (job & 15) * 4, dkb = (job >> 4) * 64;
            s16x4 v;
            const unsigned ad = kb0 + s0 * 256 + dkb * 2;
            asm volatile("ds_read_b64_tr_b16 %0, %1\n\ts_waitcnt lgkmcnt(0)" : "=&v"(v) : "v"(ad) : "memory");
            *(s16x4*)(KGT + (size_t)(dkb + gq * 16 + i16) * 64 + s0) = v;
        }
    }
}

constexpr size_t GC_ST = 0, GC_VT = (size_t)1024 * 32768;
__device__ __forceinline__ void gdc_passB(int bh, const unsigned char* HB, unsigned char* YB, const Ctx& c) {
    const int lane = c.lane, wid = __builtin_amdgcn_readfirstlane(c.wid);
    const int h5 = lane >> 5, r = lane & 31;
    unsigned char* smem = c.smem;
    f32x16 S0, S1, S2, S3;
#pragma unroll
    for (int i = 0; i < 16; ++i) { S0[i] = 0.f; S1[i] = 0.f; S2[i] = 0.f; S3[i] = 0.f; }
    const size_t u0 = (size_t)bh * 32;
#define GB_STAGE(n_, p_) do { const bf16_t* wn_ = (const bf16_t*)(HB + GD_WN) + (u0 + (n_)) * 8192; const bf16_t* kg_ = (const bf16_t*)(HB + GD_KGT) + (u0 + (n_)) * 8192; \
        unsigned char* bp_ = smem + (p_) * 32768; \
        _Pragma("unroll") for (int i = 0; i < 4; ++i) { const int jj = wid * 4 + i, row = 4 * jj + (lane >> 4), ch = (lane & 15) ^ (row & 15); \
            glds16(wn_ + row * 128 + ch * 8, bp_ + jj * 1024 + lane * 16); } \
        _Pragma("unroll") for (int i = 0; i < 4; ++i) { const int jj = wid * 4 + i, row = 8 * jj + (lane >> 3), ch = (lane & 7) ^ ((row >> 1) & 7); \
            glds16(kg_ + row * 64 + ch * 8, bp_ + 16384 + jj * 1024 + lane * 16); } } while (0)
#define LD128(base_, R_, ks_) __builtin_shufflevector(*(const s16x4*)((base_) + (R_) * 256 + (((2 * (ks_)) ^ (rl & 15)) << 4) + 8 * hl), \
                                                      *(const s16x4*)((base_) + (R_) * 256 + (((2 * (ks_) + 1) ^ (rl & 15)) << 4) + 8 * hl), 0, 1, 2, 3, 4, 5, 6, 7)
#define LD64(base_, R_, k2_) __builtin_shufflevector(*(const s16x4*)((base_) + (R_) * 128 + (((2 * (k2_)) ^ ((rl >> 1) & 7)) << 4) + 8 * hl), \
                                                     *(const s16x4*)((base_) + (R_) * 128 + (((2 * (k2_) + 1) ^ ((rl >> 1) & 7)) << 4) + 8 * hl), 0, 1, 2, 3, 4, 5, 6, 7)
    u32x4 uu[4];
#define GB_LOADU(n_) do { const u32x4* up_ = (const u32x4*)((const bf16_t*)(HB + GD_UU) + (u0 + (n_)) * 8192 + (size_t)(wid * 64 + lane) * 32); \
        uu[0] = up_[0]; uu[1] = up_[1]; uu[2] = up_[2]; uu[3] = up_[3]; } while (0)
    __syncthreads();
    GB_STAGE(0, 0);
    GB_LOADU(0);
#pragma unroll 1
    for (int n2 = 0; n2 < 16; ++n2) {
#pragma unroll
        for (int PBUF = 0; PBUF < 2; ++PBUF) {
        const int n = 2 * n2 + PBUF;
        const float gl = ((const float*)(HB + GD_GL))[u0 + n];
        if (n == 0) asm volatile("s_waitcnt vmcnt(0)" ::: "memory"); else asm volatile("s_waitcnt vmcnt(24)" ::: "memory");
        asm volatile("s_waitcnt lgkmcnt(0)" ::: "memory"); __builtin_amdgcn_s_barrier(); asm volatile("" ::: "memory");
        f32x16 v0, v1;
#pragma unroll
        for (int q = 0; q < 2; ++q) {
            const u32x4 a = uu[q], bq = uu[2 + q];
            v0[8 * q + 0] = bflo(a.x); v0[8 * q + 1] = bfhi(a.x); v0[8 * q + 2] = bflo(a.y); v0[8 * q + 3] = bfhi(a.y);
            v0[8 * q + 4] = bflo(a.z); v0[8 * q + 5] = bfhi(a.z); v0[8 * q + 6] = bflo(a.w); v0[8 * q + 7] = bfhi(a.w);
            v1[8 * q + 0] = bflo(bq.x); v1[8 * q + 1] = bfhi(bq.x); v1[8 * q + 2] = bflo(bq.y); v1[8 * q + 3] = bfhi(bq.y);
            v1[8 * q + 4] = bflo(bq.z); v1[8 * q + 5] = bfhi(bq.z); v1[8 * q + 6] = bflo(bq.w); v1[8 * q + 7] = bfhi(bq.w);
        }
        if (n + 1 < 32) { GB_STAGE(n + 1, (PBUF ^ 1)); GB_LOADU(n + 1); }
        int rl = r, hl = h5; asm volatile("" : "+v"(rl), "+v"(hl));
        const unsigned char* WNb = smem + PBUF * 32768; const unsigned char* KGb = WNb + 16384;
        {
            bf16_t* st = (bf16_t*)(YB + GC_ST) + (u0 + n) * 16384 + (size_t)h5 * 512 + (size_t)(wid * 32 + r) * 4;
#define ST_TILE(SX, dt_) do { _Pragma("unroll") for (int g = 0; g < 4; ++g) \
                *(u32x2*)(st + ((dt_) * 8 + 2 * g) * 512) = (u32x2){cvt_pk(SX[4 * g], SX[4 * g + 1]), cvt_pk(SX[4 * g + 2], SX[4 * g + 3])}; } while (0)
            ST_TILE(S0, 0); ST_TILE(S1, 1); ST_TILE(S2, 2); ST_TILE(S3, 3);
#undef ST_TILE
        }
        {
            bf16x8 fa0, fb0, fa1, fb1, fa2, fb2;
#define LDV(FA, FB, ks_) do { FA = LD128(WNb, rl, ks_); FB = LD128(WNb, 32 + rl, ks_); } while (0)
#define MMV(SX, HF, FA, FB) do { const bf16x8 sbk = pack_step<HF>(SX); v0 = MFMA32(FA, sbk, v0); v1 = MFMA32(FB, sbk, v1); } while (0)
            LDV(fa0, fb0, 0); LDV(fa1, fb1, 1); LDV(fa2, fb2, 2);
            MMV(S0, 0, fa0, fb0); LDV(fa0, fb0, 3);
            MMV(S0, 1, fa1, fb1); LDV(fa1, fb1, 4);
            MMV(S1, 0, fa2, fb2); LDV(fa2, fb2, 5);
            MMV(S1, 1, fa0, fb0); LDV(fa0, fb0, 6);
            MMV(S2, 0, fa1, fb1); LDV(fa1, fb1, 7);
            MMV(S2, 1, fa2, fb2);
            MMV(S3, 0, fa0, fb0);
            MMV(S3, 1, fa1, fb1);
#undef LDV
#undef MMV
        }
        const bf16x8 vb0 = pack_step_m<0>(v0), vb1 = pack_step_m<1>(v0), vb2 = pack_step_m<0>(v1), vb3 = pack_step_m<1>(v1);
        {
            bf16_t* vt = (bf16_t*)(YB + GC_VT) + (u0 + n) * 8192 + (size_t)h5 * 512 + (size_t)(wid * 32 + r) * 4;
            const u32x4 p0 = __builtin_bit_cast(u32x4, vb0), p1 = __builtin_bit_cast(u32x4, vb1), p2 = __builtin_bit_cast(u32x4, vb2), p3 = __builtin_bit_cast(u32x4, vb3);
            *(u32x2*)(vt + 0 * 512) = (u32x2){p0.x, p0.y};  *(u32x2*)(vt + 2 * 512) = (u32x2){p0.z, p0.w};
            *(u32x2*)(vt + 4 * 512) = (u32x2){p1.x, p1.y};  *(u32x2*)(vt + 6 * 512) = (u32x2){p1.z, p1.w};
            *(u32x2*)(vt + 8 * 512) = (u32x2){p2.x, p2.y};  *(u32x2*)(vt + 10 * 512) = (u32x2){p2.z, p2.w};
            *(u32x2*)(vt + 12 * 512) = (u32x2){p3.x, p3.y}; *(u32x2*)(vt + 14 * 512) = (u32x2){p3.z, p3.w};
        }
        asm volatile("" ::: "memory"); asm volatile("" : "+v"(rl), "+v"(hl));
        S0 *= gl; S1 *= gl; S2 *= gl; S3 *= gl;
        {
            bf16x8 g0, g1, g2;
            g0 = LD64(KGb, rl, 0); g1 = LD64(KGb, rl, 1); g2 = LD64(KGb, rl, 2);
            S0 = MFMA32(g0, vb0, S0); g0 = LD64(KGb, rl, 3);
            S0 = MFMA32(g1, vb1, S0); g1 = LD64(KGb, 32 + rl, 0);
            S0 = MFMA32(g2, vb2, S0); g2 = LD64(KGb, 32 + rl, 1);
            S0 = MFMA32(g0, vb3, S0); g0 = LD64(KGb, 32 + rl, 2);
            S1 = MFMA32(g1, vb0, S1); g1 = LD64(KGb, 32 + rl, 3);
            S1 = MFMA32(g2, vb1, S1); g2 = LD64(KGb, 64 + rl, 0);
            S1 = MFMA32(g0, vb2, S1); g0 = LD64(KGb, 64 + rl, 1);
            S1 = MFMA32(g1, vb3, S1); g1 = LD64(KGb, 64 + rl, 2);
            S2 = MFMA32(g2, vb0, S2); g2 = LD64(KGb, 64 + rl, 3);
            S2 = MFMA32(g0, vb1, S2); g0 = LD64(KGb, 96 + rl, 0);
            S2 = MFMA32(g1, vb2, S2); g1 = LD64(KGb, 96 + rl, 1);
            S2 = MFMA32(g2, vb3, S2); g2 = LD64(KGb, 96 + rl, 2);
            S3 = MFMA32(g0, vb0, S3); g0 = LD64(KGb, 96 + rl, 3);
            S3 = MFMA32(g1, vb1, S3);
            S3 = MFMA32(g2, vb2, S3);
            S3 = MFMA32(g0, vb3, S3);
        }
        }
    }
#undef GB_STAGE
#undef LD128
#undef LD64
#undef GB_LOADU
}

__device__ __forceinline__ void gdc_passB_idle() {
    __syncthreads();
    for (int n = 0; n < 32; ++n) { asm volatile("" ::: "memory"); __builtin_amdgcn_s_barrier(); asm volatile("" ::: "memory"); }
}

__device__ __forceinline__ void gdc_passC(int u, const unsigned char* HB, const unsigned char* YB, const bf16_t* PROJ, const float* gnorm, bf16_t* MIXO, const Ctx& c) {
    const int bh = u >> 5, b = bh >> 2, h = bh & 3;
    const size_t t0 = (size_t)b * SEQ + (u & 31) * 64;
    const int lane = c.lane, wid = __builtin_amdgcn_readfirstlane(c.wid);
    const int h5 = lane >> 5, r = lane & 31;
    float* sqL = (float*)c.smem;
    const bf16_t* ST = (const bf16_t*)(YB + GC_ST) + (size_t)u * 16384 + (size_t)(2 * h5) * 512 + (size_t)(wid * 32 + r) * 4;
    const bf16_t* VT = (const bf16_t*)(YB + GC_VT) + (size_t)u * 8192 + (size_t)(2 * h5) * 512 + (size_t)(wid * 32 + r) * 4;
    const bf16_t* QG = (const bf16_t*)(HB + GD_QG) + (size_t)u * 8192 + (size_t)r * 128 + 8 * h5;
    const bf16_t* AT = (const bf16_t*)(HB + GD_AT) + (size_t)u * 4096 + (size_t)r * 64 + 8 * h5;
    f32x16 o0, o1;
#pragma unroll
    for (int i = 0; i < 16; ++i) { o0[i] = 0.f; o1[i] = 0.f; }
#pragma unroll
    for (int ks = 0; ks < 8; ++ks) {
        const bf16x8 sa = __builtin_shufflevector(*(const s16x4*)(ST + (4 * ks) * 512), *(const s16x4*)(ST + (4 * ks + 1) * 512), 0, 1, 2, 3, 4, 5, 6, 7);
        const bf16x8 q0 = *(const bf16x8*)(QG + ks * 16), q1 = *(const bf16x8*)(QG + 32 * 128 + ks * 16);
        o0 = MFMA32(sa, q0, o0); o1 = MFMA32(sa, q1, o1);
        if (ks == 3) asm volatile("" ::: "memory");
    }
#pragma unroll
    for (int k2 = 0; k2 < 4; ++k2) {
        const bf16x8 va = __builtin_shufflevector(*(const s16x4*)(VT + (4 * k2) * 512), *(const s16x4*)(VT + (4 * k2 + 1) * 512), 0, 1, 2, 3, 4, 5, 6, 7);
        const bf16x8 a1 = *(const bf16x8*)(AT + 32 * 64 + k2 * 16);
        o1 = MFMA32(va, a1, o1);
        if (k2 < 2) { const bf16x8 a0 = *(const bf16x8*)(AT + k2 * 16); o0 = MFMA32(va, a0, o0); }
    }
    float s0 = 0.f, s1 = 0.f;
#pragma unroll
    for (int i = 0; i < 16; ++i) { s0 += o0[i] * o0[i]; s1 += o1[i] * o1[i]; }
    s0 += shfl_xor_(s0, 32); s1 += shfl_xor_(s1, 32);
    __syncthreads();
    if (h5 == 0) { sqL[wid * 64 + r] = s0; sqL[wid * 64 + 32 + r] = s1; }
    __syncthreads();
    const float rr0 = rsqrtf((sqL[r] + sqL[64 + r] + sqL[128 + r] + sqL[192 + r]) * (1.f / 128.f) + 1e-6f);
    const float rr1 = rsqrtf((sqL[32 + r] + sqL[96 + r] + sqL[160 + r] + sqL[224 + r]) * (1.f / 128.f) + 1e-6f);
#pragma unroll
    for (int tt = 0; tt < 2; ++tt) {
        const size_t t = t0 + tt * 32 + r;
        const bf16_t* zrow = PROJ + t * NPAD + 1960 + h * 128 + wid * 32 + 4 * h5;
        const float* gn = gnorm + wid * 32 + 4 * h5;
        bf16_t* orow = MIXO + t * 1024 + 512 + h * 128 + wid * 32 + 4 * h5;
        const float rr = tt ? rr1 : rr0;
#pragma unroll
        for (int g = 0; g < 4; ++g) {
            const u32x2 zr = *(const u32x2*)(zrow + 8 * g);
            const f32x4 gv = *(const f32x4*)(gn + 8 * g);
            const float z0 = bflo(zr.x), z1 = bfhi(zr.x), z2 = bflo(zr.y), z3 = bfhi(zr.y);
            const float y0 = (tt ? o1[4 * g] : o0[4 * g]) * rr * gv[0] * siluf_(z0), y1 = (tt ? o1[4 * g + 1] : o0[4 * g + 1]) * rr * gv[1] * siluf_(z1);
            const float y2 = (tt ? o1[4 * g + 2] : o0[4 * g + 2]) * rr * gv[2] * siluf_(z2), y3 = (tt ? o1[4 * g + 3] : o0[4 * g + 3]) * rr * gv[3] * siluf_(z3);
            *(u32x2*)(orow + 8 * g) = (u32x2){pk2(y0, y1), pk2(y2, y3)};
        }
    }
}

__device__ __forceinline__ void phase_post(const float* OG, const bf16_t* PROJ, const float* gain, bool odd, bf16_t* MIXO, const Ctx& c) {
    const int lane = c.lane;
    const int gcol = odd ? 1032 : 1960, ocol = odd ? 0 : 512;
    for (int t = c.bid * 4 + c.wid; t < T; t += c.nblk * 4) {
        const f32x4 a0 = *(const f32x4*)(OG + (size_t)t * 512 + lane * 8), a1 = *(const f32x4*)(OG + (size_t)t * 512 + lane * 8 + 4);
        float ss = (a0[0] * a0[0] + a0[1] * a0[1]) + (a0[2] * a0[2] + a0[3] * a0[3]) + (a1[0] * a1[0] + a1[1] * a1[1]) + (a1[2] * a1[2] + a1[3] * a1[3]);
        ss = red16(ss);
        const float rr = rsqrtf(ss * (1.f / 128.f) + 1e-6f);
        const u32x4 zr = *(const u32x4*)(PROJ + (size_t)t * NPAD + gcol + lane * 8);
        float z[8]; unpack8(zr, z);
        const int gi = odd ? lane * 8 : (lane & 15) * 8;
        const f32x4 g0 = *(const f32x4*)(gain + gi), g1 = *(const f32x4*)(gain + gi + 4);
        float y[8];
#pragma unroll
        for (int j = 0; j < 4; ++j) {
            const float ga = odd ? sigmoidf_(z[j]) : siluf_(z[j]), gb = odd ? sigmoidf_(z[4 + j]) : siluf_(z[4 + j]);
            y[j] = a0[j] * rr * g0[j] * ga; y[4 + j] = a1[j] * rr * g1[j] * gb;
        }
        *(u32x4*)(MIXO + (size_t)t * 1024 + ocol + lane * 8) = (u32x4){pk2(y[0], y[1]), pk2(y[2], y[3]), pk2(y[4], y[5]), pk2(y[6], y[7])};
    }
}

__global__ void __launch_bounds__(512, 2) fwd(Args a) {
    extern __shared__ __attribute__((aligned(16))) unsigned char smem[];
    Ctx c;
    const int wave_s = __builtin_amdgcn_readfirstlane((int)threadIdx.x >> 6);
#define SET_CTX(cx) do { int t_ = (wave_s << 6) | lane_id_v(); cx.tid0 = t_; cx.half = t_ >> 8; cx.tid = t_ & 255; cx.lane = t_ & 63; cx.wid = (t_ >> 6) & 3; \
        cx.wr = cx.wid >> 1; cx.wc = cx.wid & 1; cx.fr = cx.lane & 15; cx.fq = cx.lane >> 4; cx.bid = blockIdx.x * 2 + cx.half; cx.nblk = gridDim.x * 2; \
        cx.smem0 = smem; cx.smem = smem + cx.half * HALF_LDS; } while (0)
    SET_CTX(c);
#define PH_CTX() SET_CTX(c)
    unsigned char* const ws_base = a.ws;
    const void* const* const ain_base = (const void* const*)__builtin_amdgcn_kernarg_segment_ptr();
    unsigned* ctl = (unsigned*)(ws_base + WS_CTL);
    volatile LAS unsigned* xbw = (volatile LAS unsigned*)(smem + LDS_BLK);
    if (c.tid0 < 8) xbw[c.tid0] = 0u;
    __syncthreads();
    XcdBarrier bar; bar.bar = ctl; bar.x = 0; bar.st = xbw; bar.wave = wave_s;
    if (a.use_bar) bar = xcd_barrier_post(ctl, xbw, c.tid0);
#if ONE_LAUNCH
    const int hi = NPH;
#define IN(k) true
#else
    const int lo = a.ph_lo, hi = a.ph_hi;
#define IN(k) (lo <= (k) && (k) < hi)
#endif
#define PH(k) if (IN(k)) { PH_CTX(); unsigned char* ws = ws_base; const void* const* ain = ain_base; asm volatile("" : "+s"(ws), "+s"(ain));
#define UNIT_CTX() Ctx cu; SET_CTX(cu)
#define SEAM(k) do { if ((k) + 1 < hi) xcd_barrier(bar); } while (0)

#define XBF ((bf16_t*)(ws + WS_XBF))
#define X1 ((float*)(ws + WS_X1))
#define PROJ ((bf16_t*)(ws + U_PROJ))
#define GATES ((float*)(ws + U_GATES))
#define MIXO ((bf16_t*)(ws + U_MIXO))
#define YBUF ((float*)(ws + U_YBUF))
#define ROPEM ((const float*)(ws + WS_ROPEM))
#define ROPES ((const float*)(ws + WS_ROPES))
#define XRES ((layer == 0) ? (const float*)ain[0] : (const float*)a.out)
#define CNT (ctl + CW_CNT + layer * 128)
#define WIN ((const bf16_t*)(ws + WS_WIN) + (size_t)layer * WIN_ELEMS)
#define WOUT ((const bf16_t*)(ws + WS_WOUT) + (size_t)layer * WOUT_ELEMS)

    PH(0) for (int rep = 0; rep < REP_PRO; ++rep) phase_prologue(a, c); SEAM(0); }

    for (int layer = 0; layer < 4; ++layer) {
        const int pb = 1 + layer * PPL;
#if !ONE_LAUNCH
        if (pb >= hi || pb + PPL <= lo) continue;
#endif
        const int jj = layer >> 1;
        const bool odd = (layer & 1) != 0;

        PH(pb + 0) {
                DenseSched S{T / 256, NPAD / 256, 1024, (int)blockIdx.x, (int)gridDim.x};
                EpiIn E{PROJ, GATES, odd ? 1024 : 1952};
                g8::phase<1, false, false>(smem, (const char*)XBF, (const char*)WIN, 1024, S, E, c.tid0);
            }
            SEAM(pb + 0); }
        PH(pb + 1) for (int rp = 0; rp < ((REP_PHASE == 1) ? 2 : 1); ++rp) { if (rp) xcd_barrier(bar);
            if (!odd) phase_prep_even(PROJ, GATES, (const float*)ain[3] + jj * 256, (const float*)ain[5] + jj * 128, (const float*)ain[7] + jj * 4 * 1536,
                                      (const float*)ain[8] + jj * 4, (const float*)ain[9] + jj * 4, ROPEM,
                                      (bf16_t*)(ws + U_CQ), (bf16_t*)(ws + U_CKV), (bf16_t*)(ws + U_KROPE), (bf16_t*)(ws + U_GQ), (bf16_t*)(ws + U_GK), (bf16_t*)(ws + U_GV),
                                      (float*)(ws + U_BETA), (float*)(ws + U_GLOG), c);
            else {
                phase_prep_odd(PROJ, ROPES, (bf16_t*)(ws + U_QF), (bf16_t*)(ws + U_KN), c);
                unsigned* ctr = ctl + CW_WORK + pb + 1 + 64 * rp;
                for (;;) {
                    const int u = next_unit(ctr, c); UNIT_CTX();
                    if (u >= 1024) break;
                    mlc_passA(u, PROJ, GATES, (const float*)ain[13] + jj * 4, (const float*)ain[14] + jj * 4, (unsigned char*)YBUF, cu);
                }
            }
            }
            SEAM(pb + 1);
        }
        PH(pb + 2) for (int rp = 0; rp < ((REP_PHASE == 2) ? 2 : 1); ++rp) { if (rp) xcd_barrier(bar);
            unsigned* ctr = ctl + CW_WORK + pb + 2 + 64 * rp;
            if (!odd) {
                for (;;) {
                    const int u = next_unit(ctr, c); UNIT_CTX();
                    if (u >= 1024 + MLAUP_TILES) break;
                    if (u < 1024) gdc_passA(u, (const bf16_t*)(ws + U_GQ), (const bf16_t*)(ws + U_GK), (const bf16_t*)(ws + U_GV), (const float*)(ws + U_BETA),
                                            (const float*)(ws + U_GLOG), ws + WS_HBUF, cu);
                    else mla_up_tile(u - 1024, (const bf16_t*)(ws + U_CQ), (const bf16_t*)(ws + WS_WQB) + (size_t)jj * WQB_ELEMS, (const bf16_t*)(ws + U_CKV),
                                     (const bf16_t*)(ws + WS_WKVB) + (size_t)jj * WKVB_ELEMS, ROPEM, (bf16_t*)(ws + U_QF), (bf16_t*)(ws + U_KN), (bf16_t*)(ws + U_VV), cu);
                }
            } else {
                for (;;) {
                    const int u = next_unit(ctr, c); UNIT_CTX();
                    if (u >= 256 + 1024) break;
                    if (u < 256) mlc_passB(u, (unsigned char*)YBUF, cu);
                    else {
                        const int v = u - 256, hq = v & 7, n = (v >> 3) & 15, b = v >> 7, kvh = hq >> 2;
                        const size_t tb = (size_t)b * SEQ;
                        attn_unit<4, true>((const bf16_t*)(ws + U_QF) + tb * 512 + hq * 64, 512, (const bf16_t*)(ws + U_KN) + tb * 128 + kvh * 64, 128,
                                           (const bf16_t*)(ws + U_KN), 0, PROJ + tb * NPAD + 2184 + kvh * 64, NPAD,
                                           MIXO + tb * 1024 + 512 + hq * 64, 1024, n * 128, ((const float*)ain[16])[jj * 8 + hq] * 1.4426950408889634f, cu);
                    }
                }
            }
            }
            SEAM(pb + 2);
        }
        PH(pb + 3) for (int rp = 0; rp < ((REP_PHASE == 3) ? 2 : 1); ++rp) { if (rp) xcd_barrier(bar);
            unsigned* ctr = ctl + CW_WORK + pb + 3 + 64 * rp;
            if (!odd) {
                for (;;) {
                    const int u = next_unit(ctr, c); UNIT_CTX();
                    if (u >= 64 + 1024) break;
                    if (rp > 0 && ((REP_ONLY == 1 && u >= 64) || (REP_ONLY == 2 && u < 64))) continue;
                    if (u < 64) { if ((u & 1) == 0) gdc_passB(u >> 1, ws + WS_HBUF, (unsigned char*)YBUF, cu); else gdc_passB_idle(); }
                    else {
                        const int v = u - 64, qb = 15 - (v >> 6), bh = v & 63, b = bh >> 3, hh = bh & 7;
                        const size_t tb = (size_t)b * SEQ;
                        attn_unit<6, false>((const bf16_t*)(ws + U_QF) + tb * 768 + hh * 96, 768, (const bf16_t*)(ws + U_KN) + tb * 512 + hh * 64, 512,
                                            (const bf16_t*)(ws + U_KROPE) + tb * 32, 32, (const bf16_t*)(ws + U_VV) + tb * 512 + hh * 64, 512,
                                            MIXO + tb * 1024 + hh * 64, 1024, qb * 128, 0.f, cu);
                    }
                }
            } else {
                for (;;) {
                    const int u = next_unit(ctr, c); UNIT_CTX();
                    if (u >= 1024) break;
                    mlc_passC(u, PROJ, GATES, (const float*)ain[13] + jj * 4, (const float*)ain[14] + jj * 4, (const unsigned char*)YBUF, (const float*)ain[15] + jj * 512, MIXO, cu);
                }
            }
            }
            SEAM(pb + 3);
        }
        PH(pb + 4) for (int rp = 0; rp < ((REP_PHASE == 4) ? 2 : 1); ++rp) { if (rp) xcd_barrier(bar);
            if (!odd) {
                unsigned* ctr = ctl + CW_WORK + pb + 4 + 64 * rp;
                for (;;) {
                    const int u = next_unit(ctr, c); UNIT_CTX();
                    if (u >= 1024) break;
                    gdc_passC(u, ws + WS_HBUF, (const unsigned char*)YBUF, PROJ, (const float*)ain[10] + jj * 128, MIXO, cu);
                }
            }
            }
            if (!odd) SEAM(pb + 4);
        }
        PH(pb + 5) {
                DenseSched S{T / 256, 4, 1024, (int)blockIdx.x, (int)gridDim.x};
                EpiOut E{XBF, (bf16_t*)YBUF};
                g8::phase<1, false, false>(smem, (const char*)MIXO, (const char*)WOUT, 1024, S, E, c.tid0);
            }
            SEAM(pb + 5); }
#if FUSE_LNROUTE
        PH(pb + 6) phase_lnroute((const bf16_t*)YBUF, (const float*)ain[18] + layer * 1024, (const float*)ain[19] + layer * 1024, XBF, (const bf16_t*)(ws + WS_WRT) + (size_t)layer * WRT_ELEMS,
                                 (const float*)ain[21] + layer * 64, CNT, (int*)(ws + WS_LTOK), (float*)(ws + WS_LW), (int*)(ws + WS_ASG), (float*)(ws + WS_ASGW), c); SEAM(pb + 8); }
#else
        PH(pb + 6) for (int rep = 0; rep < REP_TOK; ++rep) phase_ln1((const bf16_t*)YBUF, (const float*)ain[18] + layer * 1024, (const float*)ain[19] + layer * 1024, XBF, c); SEAM(pb + 6); }
        PH(pb + 7) for (int rep = 0; rep < REP_GEMM; ++rep) phase_router(XBF, (const bf16_t*)(ws + WS_WRT) + (size_t)layer * WRT_ELEMS, (float*)(ws + WS_LOG), c); SEAM(pb + 7); }
        PH(pb + 8) phase_route((const float*)(ws + WS_LOG), (const float*)ain[21] + layer * 64, CNT, (int*)(ws + WS_LTOK), (float*)(ws + WS_LW), (int*)(ws + WS_ASG), (float*)(ws + WS_ASGW), c); SEAM(pb + 8); }
#endif
        PH(pb + 9) {
                int* bst8 = (int*)(smem + LDS_BLK + 64); int* eb8 = bst8 + 256;
                build_block_table(CNT, bst8, c);
                for (int rb = c.tid0; rb < bst8[65]; rb += NT) { int e = 0; for (int q = 1; q < 65; ++q) e += (bst8[q] <= rb) ? 1 : 0; eb8[rb] = e; }
                __syncthreads();
                MoeSchedG S{__builtin_amdgcn_readfirstlane(bst8[65]), (int)blockIdx.x, (int)gridDim.x, eb8, bst8, (const int*)(ws + WS_LTOK)};
#if MOE2_F8
                EpiMoe1F8 E{(unsigned char*)(ws + WS_HBUF)};
#else
                EpiMoe1 E{(bf16_t*)(ws + WS_HBUF)};
#endif
                g8::phase<0, true, false>(smem, (const char*)XBF, (const char*)((const bf16_t*)(ws + WS_WGU) + (size_t)layer * 65 * WGU_ELEMS), 1024, S, E, c.tid0);
            }
            SEAM(pb + 9); }
        PH(pb + 10)
#if MOE2_G8
            {
                int* bst8 = (int*)(smem + LDS_BLK + 64); int* eb8 = bst8 + 256;
                build_block_table(CNT, bst8, c);
                for (int rb = c.tid0; rb < bst8[65]; rb += NT) { int e = 0; for (int q = 1; q < 65; ++q) e += (bst8[q] <= rb) ? 1 : 0; eb8[rb] = e; }
                __syncthreads();
                MoeSched S{__builtin_amdgcn_readfirstlane(bst8[65]), 4, (int)blockIdx.x, (int)gridDim.x, eb8};
#if Y_FP8
                EpiMoe2F8 E{(unsigned char*)(ws + U_Y)};
#else
                EpiMoe2 E{(bf16_t*)(ws + U_Y)};
#endif
                #if MOE2_F8
                g8::phase<2, false, true>(smem, (const char*)(ws + WS_HBUF), (const char*)(ws + WS_WDN) + (size_t)layer * 65 * WDN_ELEMS, 128, S, E, c.tid0);
#else
                g8::phase<(Y_FP8 ? 2 : 1), false, false>(smem, (const char*)(ws + WS_HBUF), (const char*)((const bf16_t*)(ws + WS_WDN) + (size_t)layer * 65 * WDN_ELEMS), 256, S, E, c.tid0);
#endif
            }
#else
            phase_moe2((const bf16_t*)(ws + WS_HBUF), (const bf16_t*)(ws + WS_WDN) + (size_t)layer * 65 * WDN_ELEMS, CNT, (bf16_t*)(ws + U_Y), c);
#endif
            SEAM(pb + 10); }
        PH(pb + 11)
#if Y_FP8
            if (layer == 3) phase_combine8<true>((const unsigned char*)(ws + U_Y), (const int*)(ws + WS_ASG), (const float*)(ws + WS_ASGW), CNT, (const float*)ain[28] + layer * 1024, (const float*)ain[29] + layer * 1024, a.out, XBF, c);
            else phase_combine8<false>((const unsigned char*)(ws + U_Y), (const int*)(ws + WS_ASG), (const float*)(ws + WS_ASGW), CNT, (const float*)ain[28] + layer * 1024, (const float*)ain[29] + layer * 1024, a.out, XBF, c);
            SEAM(pb + 11); }
#else
            if (layer == 3) phase_combine<true>((const bf16_t*)(ws + U_Y), (const int*)(ws + WS_ASG), (const float*)(ws + WS_ASGW), CNT, (const float*)ain[28] + layer * 1024, (const float*)ain[29] + layer * 1024, a.out, XBF, c);
            else phase_combine<false>((const bf16_t*)(ws + U_Y), (const int*)(ws + WS_ASG), (const float*)(ws + WS_ASGW), CNT, (const float*)ain[28] + layer * 1024, (const float*)ain[29] + layer * 1024, a.out, XBF, c);
            SEAM(pb + 11); }
#endif
    }
#undef IN
#undef XBF
#undef X1
#undef PROJ
#undef GATES
#undef MIXO
#undef YBUF
#undef ROPEM
#undef ROPES
#undef XRES
#undef CNT
#undef WIN
#undef WOUT
#undef PH
#undef PH_CTX
#undef UNIT_CTX
#undef SEAM
}

extern "C" void kernel_launch(void* const* d_in, const int* in_sizes, int n_in, void* d_out, int out_size, void* d_ws, size_t ws_size, hipStream_t stream) {
    static int grid = 0;
    if (grid == 0) {
        if (n_in != 30 || out_size != T * 1024 || ws_size < WS_END) {
            fprintf(stderr, "kernel_launch: unexpected shapes (n_in %d, out %d, ws %zu < %zu)\n", n_in, out_size, ws_size, (size_t)WS_END);
            grid = -1; return;
        }
        int dev = 0, cus = 0, per_cu = 0;
        (void)hipGetDevice(&dev);
        (void)hipDeviceGetAttribute(&cus, hipDeviceAttributeMultiprocessorCount, dev);
        (void)hipFuncSetAttribute((const void*)fwd, hipFuncAttributeMaxDynamicSharedMemorySize, DYN_LDS);
        (void)hipOccupancyMaxActiveBlocksPerMultiprocessor(&per_cu, (const void*)fwd, NT, DYN_LDS);
        (void)hipGetLastError();
        if (per_cu < 1) per_cu = 1;
        grid = cus;
    }
    if (grid < 0) return;
    (void)hipMemsetAsync((char*)d_ws + WS_CTL, 0, CTL_BYTES, stream);
    Args a{};
    for (int i = 0; i < 30; ++i) a.in[i] = d_in[i];
    a.out = (float*)d_out; a.ws = (unsigned char*)d_ws; a.pad = 0;
#if ONE_LAUNCH
    a.ph_lo = 0; a.ph_hi = NPH; a.use_bar = 1;
    hipLaunchKernelGGL(fwd, dim3(grid), dim3(NT), DYN_LDS, stream, a);
#else
    for (int p = 0; p < NPH; ++p) {
        a.ph_lo = p; a.ph_hi = p + 1; a.use_bar = 0;
        hipLaunchKernelGGL(fwd, dim3(grid), dim3(NT), DYN_LDS, stream, a);
    }
#endif
}
```

```cpp
#include <hip/hip_runtime.h>
#include <stdint.h>
#include <stdio.h>

#define REP_GEMM 1
#define REP_PHASE 0
#define REP_G0 1
#define REP_G1 1
#define REP_G2 1
#define REP_G3 1
#define REP_MIX 1
#define REP_ONLY 0
#define REP_CMB 1
#define REP_PRO 1
#define REP_TOK 1
#define MOE2_G8 1
#ifndef G8_SPLIT
#define G8_SPLIT 0
#endif
#ifndef FUSE_LNROUTE
#define FUSE_LNROUTE 1
#endif
#ifndef Y_FP8
#define Y_FP8 1
#endif
#ifndef MOE2_F8
#define MOE2_F8 1
#endif
#ifndef ONE_LAUNCH
#define ONE_LAUNCH 1
#endif

typedef unsigned short bf16_t;
typedef short bf16x8 __attribute__((ext_vector_type(8)));
typedef float f32x4 __attribute__((ext_vector_type(4)));
typedef float f32x2 __attribute__((ext_vector_type(2)));
typedef int i32x4 __attribute__((ext_vector_type(4)));
typedef int i32x8 __attribute__((ext_vector_type(8)));
typedef unsigned u32x4 __attribute__((ext_vector_type(4)));
typedef unsigned u32x2 __attribute__((ext_vector_type(2)));
#define LAS __attribute__((address_space(3)))
#define GAS __attribute__((address_space(1)))

constexpr int T = 16384, SEQ = 2048;
constexpr int NPAD = 2560;
constexpr int CAP = 16384;
constexpr int RBR = 256;
constexpr int MAXRB = 512 + 64 + 64;
constexpr int MAXROWS = MAXRB * RBR;
constexpr float ALPHA = 1.681792830507429f;
constexpr int PPL = 12;
constexpr int NPH = 1 + 4 * PPL;
constexpr int NT = 512, NW = 8;
constexpr int HALF_LDS = 65536 + 64 + 1024;
constexpr int LDS_BLK = 2 * HALF_LDS;
constexpr int DYN_LDS = LDS_BLK + 64 + 1024 + 2560;

constexpr size_t cmax(size_t a, size_t b) { return a > b ? a : b; }
constexpr size_t WS_CTL = 0;
constexpr size_t CTL_BYTES = 65536;
constexpr size_t WS_WIN = WS_CTL + CTL_BYTES;
constexpr size_t WIN_ELEMS = (size_t)NPAD * 1024;
constexpr size_t WS_WQB = WS_WIN + 4 * WIN_ELEMS * 2;
constexpr size_t WQB_ELEMS = 768 * 256;
constexpr size_t WS_WKVB = WS_WQB + 2 * WQB_ELEMS * 2;
constexpr size_t WKVB_ELEMS = 1024 * 128;
constexpr size_t WS_WOUT = WS_WKVB + 2 * WKVB_ELEMS * 2;
constexpr size_t WOUT_ELEMS = 1024 * 1024;
constexpr size_t WS_WRT = WS_WOUT + 4 * WOUT_ELEMS * 2;
constexpr size_t WRT_ELEMS = 128 * 1024;
constexpr size_t WS_WGU = WS_WRT + 4 * WRT_ELEMS * 2;
constexpr size_t WGU_ELEMS = 512 * 1024;
constexpr size_t WS_WDN = WS_WGU + 4 * 65 * WGU_ELEMS * 2;
constexpr size_t WDN_ELEMS = 1024 * 256;
constexpr size_t WS_ROPEM = WS_WDN + 4 * 65 * WDN_ELEMS * 2;
constexpr size_t WS_ROPES = WS_ROPEM + (size_t)T * 16 * 2 * 4;
constexpr size_t WS_X1 = WS_ROPES + (size_t)T * 32 * 2 * 4;
constexpr size_t WS_XBF = WS_X1 + (size_t)T * 1024 * 4;
constexpr size_t WS_HBUF = WS_XBF + (size_t)T * 1024 * 2;
constexpr size_t WS_LOG = WS_HBUF + (size_t)MAXROWS * 256 * 2;
constexpr size_t WS_ASG = WS_LOG + (size_t)T * 64 * 4;
constexpr size_t WS_ASGW = WS_ASG + (size_t)T * 8 * 4;
constexpr size_t WS_LTOK = WS_ASGW + (size_t)T * 8 * 4;
constexpr size_t WS_LW = WS_LTOK + (size_t)65 * CAP * 4;
constexpr size_t WS_U = WS_LW + (size_t)65 * CAP * 4;
constexpr size_t U_Y = WS_U;
constexpr size_t U_PROJ = WS_U;
constexpr size_t U_GATES = U_PROJ + (size_t)T * NPAD * 2;
constexpr size_t U_CQ = U_GATES + (size_t)T * 8 * 4;
constexpr size_t U_CKV = U_CQ + (size_t)T * 256 * 2;
constexpr size_t U_KROPE = U_CKV + (size_t)T * 128 * 2;
constexpr size_t U_QF = U_KROPE + (size_t)T * 32 * 2;
constexpr size_t U_KN = U_QF + (size_t)T * 768 * 2;
constexpr size_t U_VV = U_KN + (size_t)T * 512 * 2;
constexpr size_t U_GQ = U_VV + (size_t)T * 512 * 2;
constexpr size_t U_GK = U_GQ + (size_t)T * 512 * 2;
constexpr size_t U_GV = U_GK + (size_t)T * 512 * 2;
constexpr size_t U_BETA = U_GV + (size_t)T * 512 * 2;
constexpr size_t U_GLOG = U_BETA + (size_t)T * 4 * 4;
constexpr size_t U_MIXO = U_GLOG + (size_t)T * 4 * 4;
constexpr size_t U_YBUF = U_MIXO + (size_t)T * 1024 * 2;
constexpr size_t U_END1 = U_YBUF + (size_t)T * 1024 * 4;
constexpr size_t WS_END = WS_U + cmax((size_t)MAXROWS * 1024 * 2, U_END1 - WS_U);

constexpr int CW_CNT = 4096;
constexpr int CW_WORK = 8192;

#define XB_TMO      128
#define XB_XCNT(j)  (256  + 64 * (j))
#define XB_XSUB(j)  (1280 + 64 * (j))
#define XB_XGEN(j)  (2304 + 64 * (j))
#define XB_TOP      3328
#define XB_TOPGEN   3392
#define XCD_BAR_WORDS 3456
#define XB_SPIN_CAP (1u << 18)

__device__ __forceinline__ unsigned xb_ld(unsigned* p)              { return __hip_atomic_load(p, __ATOMIC_RELAXED, __HIP_MEMORY_SCOPE_AGENT); }
__device__ __forceinline__ int lane_id_v() { int l; asm volatile("v_mbcnt_lo_u32_b32 %0, -1, 0\n\tv_mbcnt_hi_u32_b32 %0, -1, %0" : "=v"(l)); return l; }
__device__ __forceinline__ unsigned xb_add(unsigned* p, unsigned v) { return __hip_atomic_fetch_add(p, v, __ATOMIC_RELAXED, __HIP_MEMORY_SCOPE_AGENT); }
__device__ __forceinline__ unsigned xb_xcc_id() { return (unsigned)__builtin_amdgcn_s_getreg((3 << 11) | 20) & 0xFu; }
#define XB_SPIN(cond, bar) do { unsigned _sp = 0; while (cond) { __builtin_amdgcn_s_sleep(1); \
    if ((++_sp & 255u) == 0u) { if (xb_ld(&(bar)[XB_TMO])) break; if (_sp > XB_SPIN_CAP) { atomicAdd(&(bar)[XB_TMO], 1u); break; } } } } while (0)

struct XcdBarrier { unsigned* bar; unsigned x; volatile LAS unsigned* st; int wave; };

__device__ __forceinline__ XcdBarrier xcd_barrier_post(unsigned* bar, volatile LAS unsigned* st, int tid0) {
    XcdBarrier b; b.bar = bar; b.x = xb_xcc_id(); b.st = st; b.wave = __builtin_amdgcn_readfirstlane(tid0 >> 6);
    if (tid0 == 0) (void)xb_add(&bar[XB_XCNT(b.x)], 1u);
    return b;
}
__device__ __forceinline__ void xcd_barrier_complete(unsigned* bar, unsigned x, unsigned& nloc, unsigned& nx) {
    const unsigned G = gridDim.x * gridDim.y * gridDim.z;
    unsigned sum, cnt, mine, sp = 0u;
    for (;;) {
        sum = 0u; cnt = 0u; mine = 0u;
#pragma unroll
        for (unsigned j = 0; j < 16; ++j) { const unsigned c = xb_ld(&bar[XB_XCNT(j)]); sum += c; cnt += (c > 0u) ? 1u : 0u; mine = (j == x) ? c : mine; }
        if (sum == G) break;
        __builtin_amdgcn_s_sleep(1);
        if ((++sp & 255u) == 0u) { if (xb_ld(&bar[XB_TMO])) break; if (sp > XB_SPIN_CAP) { atomicAdd(&bar[XB_TMO], 1u); break; } }
    }
    nloc = mine > 0u ? mine : 1u; nx = cnt > 0u ? cnt : 1u;
}
__device__ __forceinline__ void xcd_barrier(const XcdBarrier& b) {
    asm volatile("s_waitcnt vmcnt(0)" ::: "memory");
    __syncthreads();
    if (b.wave == 0 && lane_id_v() == 0) {
        unsigned* bar = b.bar; unsigned bx = __builtin_amdgcn_readfirstlane(b.x);
        asm volatile("" : "+s"(bar), "+s"(bx));
        __builtin_amdgcn_s_waitcnt(0);
        unsigned nloc = b.st[0], nx = b.st[1];
        if (nloc == 0u) { xcd_barrier_complete(bar, bx, nloc, nx); b.st[0] = nloc; b.st[1] = nx; }
        const unsigned old = xb_add(&bar[XB_XSUB(bx)], 1u);
        const unsigned gen = old / nloc;
        if (old + 1u == (gen + 1u) * nloc) {
            __builtin_amdgcn_fence(__ATOMIC_RELEASE, "agent");
            asm volatile("s_waitcnt vmcnt(0)" ::: "memory");
            const unsigned og = xb_add(&bar[XB_TOP], 1u);
            const unsigned tg = og / nx;
            if (og + 1u == (tg + 1u) * nx) xb_add(&bar[XB_TOPGEN], 1u);
            else XB_SPIN(xb_ld(&bar[XB_TOPGEN]) == tg, bar);
            __builtin_amdgcn_fence(__ATOMIC_ACQUIRE, "agent");
            xb_add(&bar[XB_XGEN(bx)], 1u);
            asm volatile("s_waitcnt vmcnt(0)" ::: "memory");
        } else {
            XB_SPIN(xb_ld(&bar[XB_XGEN(bx)]) == gen, bar);
            __builtin_amdgcn_fence(__ATOMIC_ACQUIRE, "agent");
            asm volatile("s_waitcnt vmcnt(0)" ::: "memory");
        }
    }
    __syncthreads();
}

__device__ __forceinline__ float bf2f(unsigned v) { return __uint_as_float(v << 16); }
__device__ __forceinline__ float bflo(unsigned w) { return __uint_as_float(w << 16); }
__device__ __forceinline__ float bfhi(unsigned w) { return __uint_as_float(w & 0xffff0000u); }
__device__ __forceinline__ unsigned f2bf(float f) { unsigned u = __float_as_uint(f); u += 0x7fffu + ((u >> 16) & 1u); return u >> 16; }
__device__ __forceinline__ unsigned pk2(float lo, float hi) { return f2bf(lo) | (f2bf(hi) << 16); }
__device__ __forceinline__ unsigned cvt_pk(float lo, float hi) { unsigned r; asm volatile("v_cvt_pk_bf16_f32 %0, %1, %2" : "=v"(r) : "v"(lo), "v"(hi)); return r; }
template <class T> __device__ __forceinline__ T shfl_xor_(T v, int o) { return __builtin_bit_cast(T, __builtin_amdgcn_ds_bpermute((lane_id_v() ^ o) << 2, __builtin_bit_cast(int, v))); }
template <class T> __device__ __forceinline__ T shfl_up_(T v, int o) { const int l = lane_id_v(), s = (l - o < 0) ? l : l - o; return __builtin_bit_cast(T, __builtin_amdgcn_ds_bpermute(s << 2, __builtin_bit_cast(int, v))); }
template <class T> __device__ __forceinline__ T shfl_c_(T v, int src  ) { return __builtin_bit_cast(T, __builtin_amdgcn_readlane(__builtin_bit_cast(int, v), src)); }
__device__ __forceinline__ float wave_dpp_(float v, int ctrl_sel) {
    int x = __builtin_bit_cast(int, v), r;
    if (ctrl_sel == 0) r = __builtin_amdgcn_update_dpp(0, x, 0xB1, 0xF, 0xF, true);
    else if (ctrl_sel == 1) r = __builtin_amdgcn_update_dpp(0, x, 0x4E, 0xF, 0xF, true);
    else if (ctrl_sel == 2) r = __builtin_amdgcn_update_dpp(0, x, 0x141, 0xF, 0xF, true);
    else r = __builtin_amdgcn_update_dpp(0, x, 0x140, 0xF, 0xF, true);
    return __builtin_bit_cast(float, r);
}
__device__ __forceinline__ float wave_sum_dpp(float v) {
    v += wave_dpp_(v, 0); v += wave_dpp_(v, 1); v += wave_dpp_(v, 2); v += wave_dpp_(v, 3);
    v += shfl_xor_(v, 16); v += shfl_xor_(v, 32);
    return v;
}
__device__ __forceinline__ float wave_sum(float v) { return wave_sum_dpp(v); }
__device__ __forceinline__ float grp8_max(float v) { v = fmaxf(v, wave_dpp_(v, 0)); v = fmaxf(v, wave_dpp_(v, 1)); v = fmaxf(v, wave_dpp_(v, 2)); return v; }
__device__ __forceinline__ int grp8_min(int v) {
    v = min(v, __builtin_amdgcn_update_dpp(0, v, 0xB1, 0xF, 0xF, true)); v = min(v, __builtin_amdgcn_update_dpp(0, v, 0x4E, 0xF, 0xF, true)); v = min(v, __builtin_amdgcn_update_dpp(0, v, 0x141, 0xF, 0xF, true));
    return v;
}
__device__ __forceinline__ float sigmoidf_(float x) { return 1.f / (1.f + expf(-x)); }
__device__ __forceinline__ float siluf_(float x) { return x / (1.f + expf(-x)); }
__device__ __forceinline__ float softplusf_(float x) { return x > 20.f ? x : log1pf(expf(x)); }
__device__ __forceinline__ void glds16(const void* g, void* l) {
    __builtin_amdgcn_global_load_lds((const GAS unsigned*)g, (LAS unsigned*)l, 16, 0, 0);
}
__device__ __forceinline__ void glds16s(const char* sbase, unsigned voff, unsigned lds_uniform) {
    asm volatile("s_mov_b32 m0, %2\n\ts_nop 0\n\tglobal_load_lds_dwordx4 %0, %1" :: "v"(voff), "s"(sbase), "s"(lds_uniform) : "memory", "m0");
}
__device__ __forceinline__ const char* uniform_ptr(const void* p) {
    const unsigned long long v = (unsigned long long)p;
    const unsigned lo = (unsigned)__builtin_amdgcn_readfirstlane((int)(unsigned)v), hi = (unsigned)__builtin_amdgcn_readfirstlane((int)(unsigned)(v >> 32));
    return (const char*)(((unsigned long long)hi << 32) | lo);
}
__device__ __forceinline__ void unpack8(const u32x4 r, float (&f)[8]) {
    f[0] = bflo(r.x); f[1] = bfhi(r.x); f[2] = bflo(r.y); f[3] = bfhi(r.y);
    f[4] = bflo(r.z); f[5] = bfhi(r.z); f[6] = bflo(r.w); f[7] = bfhi(r.w);
}

struct Args {
    const void* in[30];
    float* out;
    unsigned char* ws;
    int ph_lo, ph_hi, use_bar, pad;
};

struct Ctx { int tid, lane, wid, wr, wc, fr, fq, bid, nblk; unsigned char* smem; int half, tid0; unsigned char* smem0; };

#define WAIT_V(n) asm volatile("s_waitcnt vmcnt(" #n ")" ::: "memory")
__device__ __forceinline__ void gemm_tile(const bf16_t* a0, const bf16_t* a1, const bf16_t* b0, const bf16_t* b1,
                                          int nk, f32x4 (&acc)[4][4], const Ctx& c) {
#pragma unroll
    for (int m = 0; m < 4; ++m)
#pragma unroll
        for (int n = 0; n < 4; ++n) acc[m][n] = (f32x4){0.f, 0.f, 0.f, 0.f};
    unsigned char* smem = c.smem;
    const int sb = c.tid * 16;
    const int kofs = ((c.tid & 3) ^ ((c.tid >> 4) & 3)) * 8;
    a0 += kofs; a1 += kofs; b0 += kofs; b1 += kofs;
#define G_STAGE(kt_) do { unsigned char* sp_ = smem + ((kt_) & 3) * 16384 + sb; const int ko_ = (kt_) * 32; \
        glds16(a0 + ko_, sp_); glds16(a1 + ko_, sp_ + 4096); glds16(b0 + ko_, sp_ + 8192); glds16(b1 + ko_, sp_ + 12288); } while (0)
#define G_READ(kt_, AF, BF) do { const unsigned char* sa_ = smem + ((kt_) & 3) * 16384 + c.wr * 4096 + roff; const unsigned char* sb_ = smem + ((kt_) & 3) * 16384 + 8192 + c.wc * 4096 + roff; \
        _Pragma("unroll") for (int m = 0; m < 4; ++m) AF[m] = *(const bf16x8*)(sa_ + m * 1024); \
        _Pragma("unroll") for (int n = 0; n < 4; ++n) BF[n] = *(const bf16x8*)(sb_ + n * 1024); } while (0)
#define G_MMA(AF, BF) do { __builtin_amdgcn_s_setprio(1); \
        _Pragma("unroll") for (int m = 0; m < 4; ++m) _Pragma("unroll") for (int n = 0; n < 4; ++n) acc[m][n] = __builtin_amdgcn_mfma_f32_16x16x32_bf16(BF[n], AF[m], acc[m][n], 0, 0, 0); \
        __builtin_amdgcn_s_setprio(0); } while (0)
#define G_BAR() do { asm volatile("" ::: "memory"); __builtin_amdgcn_s_barrier(); asm volatile("" ::: "memory"); } while (0)
    const int roff = (c.fr * 64) + ((c.fq ^ ((c.fr >> 2) & 3)) * 16);
    WAIT_V(0);
    G_STAGE(0); G_STAGE(1); G_STAGE(2); G_STAGE(3);
    bf16x8 fa0[4], fb0[4], fa1[4], fb1[4];
    WAIT_V(12); G_BAR();
    G_READ(0, fa0, fb0);
#define G_LGK0() asm volatile("s_waitcnt lgkmcnt(0)" ::: "memory")
    int kt = 0;
    for (; kt < nk - 4; kt += 4) {
        G_LGK0(); WAIT_V(8); G_BAR(); G_STAGE(kt + 4); G_READ(1, fa1, fb1); G_MMA(fa0, fb0);
        G_LGK0(); WAIT_V(8); G_BAR(); G_STAGE(kt + 5); G_READ(2, fa0, fb0); G_MMA(fa1, fb1);
        G_LGK0(); WAIT_V(8); G_BAR(); G_STAGE(kt + 6); G_READ(3, fa1, fb1); G_MMA(fa0, fb0);
        G_LGK0(); WAIT_V(8); G_BAR(); G_STAGE(kt + 7); G_READ(0, fa0, fb0); G_MMA(fa1, fb1);
    }
    G_LGK0(); WAIT_V(8); G_BAR(); G_READ(1, fa1, fb1); G_MMA(fa0, fb0);
    G_LGK0(); WAIT_V(4); G_BAR(); G_READ(2, fa0, fb0); G_MMA(fa1, fb1);
    G_LGK0(); WAIT_V(0); G_BAR(); G_READ(3, fa1, fb1); G_MMA(fa0, fb0);
    G_MMA(fa1, fb1);
#undef G_LGK0
#undef G_STAGE
#undef G_READ
#undef G_MMA
#undef G_BAR
    __syncthreads();
}

namespace g8 {
constexpr int BM = 256, BK = 64, HALF = 128, HTB = HALF * BK * 2, STAGE_BYTES = 8 * HTB;
__device__ __forceinline__ int lds_byte(int r, int c) { const int st = (r >> 4) * 2 + (c >> 5), rr = r & 15, cc = c & 31, ob = rr * 64 + cc * 2; return st * 1024 + (ob ^ (((ob >> 9) & 1) << 5)); }
__device__ __forceinline__ void stage_rc(int b, int& R, int& C) { const int st = b / 1024, sb = b % 1024, swz = sb ^ (((sb >> 9) & 1) << 5); R = (st >> 1) * 16 + swz / 64; C = (st & 1) * 32 + (swz % 64) / 2; }
__device__ __forceinline__ int perm32(int rho) { const int n = rho >> 4, i = rho & 15; return 8 * (i >> 2) + 4 * n + (i & 3); }
struct Unit { int pm, pn, bt; };

template <int PERM, bool GATHER, bool F8, class Sched, class Epi>
__device__ __forceinline__ void phase(unsigned char* ldsp, const char* Abase, const char* Bbase, int K, const Sched& S, const Epi& E, int tid_in) {
    LAS unsigned char* lds = (LAS unsigned char*)ldsp;
    int tid = tid_in; asm volatile("" : "+v"(tid));
    const int wid = __builtin_amdgcn_readfirstlane(tid >> 6), lane = tid & 63, wr = wid >> 2, wc = wid & 3, fr = lane & 15, fq = lane >> 4;
    const int nt = K / BK;
    unsigned voffA[2], voffB[2];
#pragma unroll
    for (int i = 0; i < 2; ++i) { int R, C; stage_rc(tid * 16 + i * 8192, R, C); const int Rb = (PERM == 2) ? ((R >> 5) * 64 + ((R & 15) >> 2) * 16 + ((R >> 4) & 1) * 4 + (R & 3)) : (PERM == 1) ? ((R >> 5) * 64 + perm32(R & 31)) : (((R >> 5) * 2 + ((R & 15) >> 3)) * 32 + ((R >> 4) & 1) * 16 + (((R & 15) >> 2) & 1) * 8 + (R & 3));
        voffA[i] = (unsigned)(R * K + C) * 2u; voffB[i] = (unsigned)(Rb * K + C) * 2u; }
    const size_t kstep = (size_t)(BK * 2);
    const size_t hstep = (size_t)HALF * K * 2, tstep = 2 * hstep, bhstep = (PERM == 2) ? (size_t)8 * K * 2 : (PERM == 1) ? (size_t)32 * K * 2 : (size_t)4 * K * 2;
    const unsigned ldsw = (unsigned)wid * 1024u;
    const int aoff = F8 ? lds_byte(wr * 64 + fr, fq * 16) : lds_byte(wr * 64 + fr, fq * 8), boff = F8 ? lds_byte(wc * 32 + fr, fq * 16) : lds_byte(wc * 32 + fr, fq * 8);
    constexpr int KP = F8 ? 16 : 1024;
#define G8_SA(b, h) (((b) * 2 + (h)) * HTB)
#define G8_SB(b, h) ((4 + (b) * 2 + (h)) * HTB)
#define G8_DMA(gptr, voff32, ldsoff) do { const char* _gp = (gptr); const unsigned _lo = (unsigned)(size_t)(ldsp) + (unsigned)(ldsoff); \
        asm volatile("s_mov_b32 m0, %2\n\ts_nop 0\n\tglobal_load_lds_dwordx4 %0, %1" :: "v"(voff32), "s"(_gp), "s"(_lo) : "memory", "m0"); } while (0)
#define G8_STAGE(bufoff, gbase, voff) do { _Pragma("unroll") for (int _i = 0; _i < 2; ++_i) G8_DMA((const char*)(gbase), (voff)[_i], (bufoff) + ldsw + _i * 8192); } while (0)
#define G8_STAGEA(bufoff, gbase, h, kb) do { if constexpr (GATHER) { _Pragma("unroll") for (int _i = 0; _i < 2; ++_i) G8_DMA(Abase + (kb), vA[2 * (h) + _i], (bufoff) + ldsw + _i * 8192); } \
        else G8_STAGE(bufoff, (gbase) + (size_t)(h) * hstep + (kb), voffA); } while (0)
#define G8_LDA(dst, b, h) do { _Pragma("unroll") for (int m = 0; m < 4; ++m) _Pragma("unroll") for (int k = 0; k < 2; ++k) dst[m][k] = *(const LAS bf16x8*)(lds + G8_SA(b, h) + aoff + m * 2048 + k * KP); } while (0)
#define G8_LDB(dst, b, h) do { _Pragma("unroll") for (int n = 0; n < 2; ++n) _Pragma("unroll") for (int k = 0; k < 2; ++k) dst[n][k] = *(const LAS bf16x8*)(lds + G8_SB(b, h) + boff + n * 2048 + k * KP); } while (0)
#define G8_CAT(x, y) __builtin_shufflevector(__builtin_bit_cast(i32x4, (x)), __builtin_bit_cast(i32x4, (y)), 0, 1, 2, 3, 4, 5, 6, 7)
#define G8_MMA(ai, bj, At, Bt) do { __builtin_amdgcn_s_setprio(1); _Pragma("unroll") for (int m = 0; m < 4; ++m) _Pragma("unroll") for (int n = 0; n < 2; ++n) { \
        if constexpr (F8) acc[ai][bj][m][n] = __builtin_amdgcn_mfma_scale_f32_16x16x128_f8f6f4(G8_CAT(Bt[n][0], Bt[n][1]), G8_CAT(At[m][0], At[m][1]), acc[ai][bj][m][n], 0, 0, 0, 0, 0, 0); \
        else { _Pragma("unroll") for (int k = 0; k < 2; ++k) acc[ai][bj][m][n] = __builtin_amdgcn_mfma_f32_16x16x32_bf16(Bt[n][k], At[m][k], acc[ai][bj][m][n], 0, 0, 0); } } \
        __builtin_amdgcn_s_setprio(0); } while (0)
#define G8_WAIT_V(n) asm volatile("s_waitcnt vmcnt(" #n ")" ::: "memory")
#define G8_WAIT_L(n) asm volatile("s_waitcnt lgkmcnt(" #n ")" ::: "memory")
#define G8_BAR __builtin_amdgcn_s_barrier()
#define G8_SCHED __builtin_amdgcn_sched_barrier(0)
    Unit cur, nxt; int ui = 0;
    if (!S.next(0, cur)) return;
    f32x4 acc[2][2][4][2];
#pragma unroll
    for (int a = 0; a < 2; ++a)
#pragma unroll
        for (int b = 0; b < 2; ++b)
#pragma unroll
            for (int m = 0; m < 4; ++m)
#pragma unroll
                for (int n = 0; n < 2; ++n) acc[a][b][m][n] = (f32x4){0.f, 0.f, 0.f, 0.f};
    bf16x8 At[4][2], B0[2][2], B1[2][2];
    const char* cA = Abase + (size_t)cur.pm * tstep; const char* cB = Bbase + (size_t)cur.bt * tstep;
    unsigned vA[4] = {0u, 0u, 0u, 0u};
    if constexpr (GATHER) S.aoff(cur, tid, vA);
    asm volatile("s_waitcnt vmcnt(0)" ::: "memory");
    G8_STAGE(G8_SB(0, 0), cB, voffB); G8_STAGEA(G8_SA(0, 0), cA, 0, 0); G8_STAGE(G8_SB(0, 1), cB + bhstep, voffB); G8_STAGEA(G8_SA(0, 1), cA, 1, 0);
    if (wr == 1) G8_BAR;
    G8_WAIT_V(4); G8_BAR;
    G8_STAGE(G8_SB(1, 0), cB + kstep, voffB); G8_STAGEA(G8_SA(1, 0), cA, 0, kstep); G8_STAGE(G8_SB(1, 1), cB + bhstep + kstep, voffB);
    G8_WAIT_V(6); G8_BAR;
    G8_STAGEA(G8_SA(1, 1), cA, 1, kstep);
    for (;;) {
        const bool has_next = S.next(ui + 1, nxt);
        const char* nA = has_next ? Abase + (size_t)nxt.pm * tstep : cA; const char* nB = has_next ? Bbase + (size_t)nxt.bt * tstep : cB;
        for (int t = 0; t < nt; t += 2) {
            const bool last = (t == nt - 2);
            const int lastf = __builtin_amdgcn_readfirstlane(last ? 1 : 0);
            const size_t k2 = last ? 0 : (size_t)(t + 2) * kstep, k3 = k2 + kstep;
            const char* a2 = last ? nA : cA; const char* b2 = last ? nB : cB + (size_t)(t + 2) * kstep;
            const char* b3 = b2 + kstep;
            G8_LDB(B0, 0, 0); G8_SCHED; G8_LDA(At, 0, 0);
            if constexpr (GATHER) { if (last && has_next) S.aoff(nxt, tid, vA); }
            G8_WAIT_L(8); G8_BAR; G8_WAIT_L(0); G8_MMA(0, 0, At, B0); G8_BAR; G8_SCHED;
            G8_LDB(B1, 0, 1); G8_STAGE(G8_SB(0, 0), b2, voffB);
            G8_BAR; G8_WAIT_L(0); G8_MMA(0, 1, At, B1); G8_BAR;
            G8_LDA(At, 0, 1); G8_STAGEA(G8_SA(0, 0), a2, 0, k2);
            G8_BAR; G8_WAIT_L(0); G8_MMA(1, 0, At, B0); G8_BAR; G8_SCHED;
            G8_STAGE(G8_SB(0, 1), b2 + bhstep, voffB);
            const int pend = __builtin_amdgcn_readfirstlane((t == 0 && ui > 0) ? 1 : 0);
            asm volatile("s_cmp_lg_u32 %0, 0\n\ts_cbranch_scc1 1f\n\ts_waitcnt vmcnt(6)\n1:\n\ts_waitcnt vmcnt(%1)" :: "s"(pend), "n"(6 + (Epi::SPLIT ? Epi::NQ : Epi::NST)) : "memory", "scc");
            G8_BAR; G8_MMA(1, 1, At, B1); G8_BAR;
            G8_LDB(B0, 1, 0); G8_SCHED; G8_LDA(At, 1, 0); G8_STAGEA(G8_SA(0, 1), a2, 1, k2);
            G8_WAIT_L(8); G8_BAR; G8_WAIT_L(0); G8_MMA(0, 0, At, B0); G8_BAR; G8_SCHED;
            if constexpr (Epi::SPLIT) { E.template part_cond<0, 0>(acc, cur, wr, wc, fr, fq, lastf); G8_SCHED; }
            G8_LDB(B1, 1, 1); G8_STAGE(G8_SB(1, 0), b3, voffB);
            G8_BAR; G8_WAIT_L(0); G8_MMA(0, 1, At, B1); G8_BAR;
            if constexpr (Epi::SPLIT) { E.template part_cond<0, 1>(acc, cur, wr, wc, fr, fq, lastf); G8_SCHED; }
            G8_LDA(At, 1, 1); G8_STAGEA(G8_SA(1, 0), a2, 0, k3);
            G8_BAR; G8_WAIT_L(0); G8_MMA(1, 0, At, B0); G8_BAR; G8_SCHED;
            G8_STAGE(G8_SB(1, 1), b3 + bhstep, voffB);
            if constexpr (Epi::SPLIT) {
                asm volatile("s_cmp_lg_u32 %0, 0\n\ts_cbranch_scc1 1f\n\ts_waitcnt vmcnt(6)\n1:\n\ts_waitcnt vmcnt(%1)" :: "s"(lastf), "n"(6 + 2 * Epi::NQ) : "memory", "scc");
                G8_SCHED; E.template part_cond<1, 0>(acc, cur, wr, wc, fr, fq, lastf); G8_SCHED;
            } else G8_WAIT_V(6);
            G8_BAR; G8_MMA(1, 1, At, B1); G8_BAR;
            G8_STAGEA(G8_SA(1, 1), a2, 1, k3);
        }
        if constexpr (Epi::SPLIT) E.tail(acc, cur, wr, wc, fr, fq); else E(acc, cur, wr, wc, fr, fq);
        if (!has_next) break;
#pragma unroll
        for (int a = 0; a < 2; ++a)
#pragma unroll
            for (int b = 0; b < 2; ++b)
#pragma unroll
                for (int m = 0; m < 4; ++m)
#pragma unroll
                    for (int n = 0; n < 2; ++n) acc[a][b][m][n] = (f32x4){0.f, 0.f, 0.f, 0.f};
        cur = nxt; cA = nA; cB = nB; ++ui;
    }
    G8_WAIT_V(0);
    if (wr == 0) G8_BAR;
    G8_BAR;
#undef G8_SA
#undef G8_SB
#undef G8_STAGE
#undef G8_STAGEA
#undef G8_LDA
#undef G8_LDB
#undef G8_MMA
#undef G8_CAT
#undef G8_WAIT_V
#undef G8_WAIT_L
#undef G8_BAR
#undef G8_SCHED
}
}

__device__ __forceinline__ bool tile_map(int i, const Ctx& c, int ntm, int ntn, int& mt, int& nt) {
    const int vb = ((c.nblk & 15) == 0) ? ((c.bid >> 1) & 7) * (c.nblk >> 3) + (((c.bid >> 4) << 1) | (c.bid & 1)) : c.bid;
    const int L = i * c.nblk + vb;
    if (L >= ntm * ntn) return false;
    const int g = L / (8 * ntn), rem = L - g * 8 * ntn;
    const int gsz = (ntm - g * 8) < 8 ? (ntm - g * 8) : 8;
    mt = g * 8 + rem % gsz; nt = rem / gsz;
    return true;
}

__device__ __forceinline__ bool tile_map2(int i, const Ctx& c, int ntm, int ntn, int& mt, int& nt, bool& valid) {
    Ctx o = c; o.bid = c.bid ^ 1;
    int mo, no; const bool oko = tile_map(i, o, ntm, ntn, mo, no);
    valid = tile_map(i, c, ntm, ntn, mt, nt);
    if (!valid) { mt = 0; nt = 0; }
    return valid || oko;
}

struct DenseSched {
    int ntm, ntn, K, bid, nblk;
    __device__ __forceinline__ bool next(int i, g8::Unit& u) const {
        const int vb = ((nblk & 7) == 0) ? (bid & 7) * (nblk >> 3) + (bid >> 3) : bid;
        const int L = i * nblk + vb;
        if (L >= ntm * ntn) return false;
        const int g = L / (8 * ntn), rem = L - g * 8 * ntn;
        const int gsz = (ntm - g * 8) < 8 ? (ntm - g * 8) : 8;
        u.pm = g * 8 + rem % gsz; u.pn = rem / gsz; u.bt = u.pn;
        return true;
    }
};
struct MoeSched {
    int nrb, ntn, bid, nblk; const int* eb;
    __device__ __forceinline__ bool next(int i, g8::Unit& u) const {
        const int vb = ((nblk & 7) == 0) ? (bid & 7) * (nblk >> 3) + (bid >> 3) : bid;
        const int L = i * nblk + vb;
        if (L >= nrb * ntn) return false;
        const int g = L / (8 * ntn), rem = L - g * 8 * ntn;
        const int gsz = (nrb - g * 8) < 8 ? (nrb - g * 8) : 8;
        u.pm = g * 8 + rem % gsz; u.pn = rem / gsz;
        u.bt = __builtin_amdgcn_readfirstlane(eb[u.pm]) * ntn + u.pn;
        return true;
    }
};
struct MoeSchedG {
    int nrb, bid, nblk; const int* eb; const int* bst; const int* LTOK;
    __device__ __forceinline__ bool next(int i, g8::Unit& u) const {
        const int vb = ((nblk & 7) == 0) ? (bid & 7) * (nblk >> 3) + (bid >> 3) : bid;
        const int L = i * nblk + vb;
        if (L >= nrb * 2) return false;
        const int g = L >> 4, rem = L & 15;
        const int gsz = (nrb - g * 8) < 8 ? (nrb - g * 8) : 8;
        u.pm = g * 8 + rem % gsz; u.pn = rem / gsz;
        u.bt = __builtin_amdgcn_readfirstlane(eb[u.pm]) * 2 + u.pn;
        return true;
    }
    __device__ __forceinline__ void aoff(const g8::Unit& u, int tid, unsigned (&o)[4]) const {
        const int e = eb[u.pm], lb = u.pm - bst[e], cnt = bst[66 + e];
        int R0, C0, R1, C1; g8::stage_rc(tid * 16, R0, C0); g8::stage_rc(tid * 16 + 8192, R1, C1);
        const int* lt = LTOK + (size_t)e * CAP + lb * RBR;
        const int p00 = R0, p01 = R1, p10 = 128 + R0, p11 = 128 + R1;
        const int t00 = (lb * RBR + p00 < cnt) ? lt[p00] : 0, t01 = (lb * RBR + p01 < cnt) ? lt[p01] : 0;
        const int t10 = (lb * RBR + p10 < cnt) ? lt[p10] : 0, t11 = (lb * RBR + p11 < cnt) ? lt[p11] : 0;
        o[0] = (unsigned)t00 * 2048u + (unsigned)C0 * 2u; o[1] = (unsigned)t01 * 2048u + (unsigned)C1 * 2u;
        o[2] = (unsigned)t10 * 2048u + (unsigned)C0 * 2u; o[3] = (unsigned)t11 * 2048u + (unsigned)C1 * 2u;
    }
};
struct EpiMoe1 {
    static constexpr bool SPLIT = false; static constexpr int NQ = 2, NST = 8;
    bf16_t* H;
    __device__ __forceinline__ void operator()(const f32x4 (&acc)[2][2][4][2], const g8::Unit& u, int wr, int wc, int fr, int fq) const {
#pragma unroll
        for (int ai = 0; ai < 2; ++ai)
#pragma unroll
            for (int m = 0; m < 4; ++m) {
                const size_t row = (size_t)u.pm * RBR + ai * 128 + wr * 64 + m * 16 + fr;
                float h[8];
#pragma unroll
                for (int bj = 0; bj < 2; ++bj) {
                    const f32x4 g = acc[ai][bj][m][0], up = acc[ai][bj][m][1];
#pragma unroll
                    for (int j = 0; j < 4; ++j) h[bj * 4 + j] = g[j] * __builtin_amdgcn_rcpf(1.f + __expf(-g[j])) * up[j];
                }
                *(u32x4*)(H + row * 256 + u.pn * 128 + wc * 32 + fq * 8) = (u32x4){cvt_pk(h[0], h[1]), cvt_pk(h[2], h[3]), cvt_pk(h[4], h[5]), cvt_pk(h[6], h[7])};
            }
    }
    template <int ai, int bj> __device__ __forceinline__ void part_cond(const f32x4 (&acc)[2][2][4][2], const g8::Unit& u, int wr, int wc, int fr, int fq, int flag) const {}
    __device__ __forceinline__ void tail(const f32x4 (&acc)[2][2][4][2], const g8::Unit& u, int wr, int wc, int fr, int fq) const {}
};
struct EpiMoe1F8 {
    static constexpr bool SPLIT = false; static constexpr int NQ = 2, NST = 8;
    unsigned char* H;
    __device__ __forceinline__ void operator()(const f32x4 (&acc)[2][2][4][2], const g8::Unit& u, int wr, int wc, int fr, int fq) const {
#pragma unroll
        for (int ai = 0; ai < 2; ++ai)
#pragma unroll
            for (int m = 0; m < 4; ++m) {
                const size_t row = (size_t)u.pm * RBR + ai * 128 + wr * 64 + m * 16 + fr;
                u32x2 d;
#pragma unroll
                for (int bj = 0; bj < 2; ++bj) {
                    const f32x4 g = acc[ai][bj][m][0], up = acc[ai][bj][m][1];
                    float h[4];
#pragma unroll
                    for (int j = 0; j < 4; ++j) h[j] = g[j] * __builtin_amdgcn_rcpf(1.f + __expf(-g[j])) * up[j] * 2.f;
                    int w = __builtin_amdgcn_cvt_pk_fp8_f32(h[0], h[1], 0, false);
                    w = __builtin_amdgcn_cvt_pk_fp8_f32(h[2], h[3], w, true);
                    d[bj] = (unsigned)w;
                }
                *(u32x2*)(H + row * 256 + u.pn * 128 + wc * 32 + fq * 8) = d;
            }
    }
    template <int ai, int bj> __device__ __forceinline__ void part_cond(const f32x4 (&acc)[2][2][4][2], const g8::Unit& u, int wr, int wc, int fr, int fq, int flag) const {}
    __device__ __forceinline__ void tail(const f32x4 (&acc)[2][2][4][2], const g8::Unit& u, int wr, int wc, int fr, int fq) const {}
};
__device__ __forceinline__ u32x4 dpp_ror8(const u32x4 v) {
    u32x4 r;
#pragma unroll
    for (int i = 0; i < 4; ++i) r[i] = (unsigned)__builtin_amdgcn_update_dpp(0, (int)v[i], 0x128, 0xF, 0xF, true);
    return r;
}
template <bool NT = false>
__device__ __forceinline__ void perm_store(bf16_t* p  , size_t ld8  , const u32x4 p0, const u32x4 p1, int hi) {
    const u32x4 snd = hi ? p0 : p1, rcv = dpp_ror8(snd);
    if constexpr (NT) { __builtin_nontemporal_store(hi ? rcv : p0, (u32x4*)p); __builtin_nontemporal_store(hi ? p1 : rcv, (u32x4*)(p + ld8)); }
    else { *(u32x4*)p = hi ? rcv : p0; *(u32x4*)(p + ld8) = hi ? p1 : rcv; }
}
struct EpiIn {
    static constexpr bool SPLIT = false; static constexpr int NQ = 4, NST = 16;
    bf16_t* P; float* G; int gbase;
    template <int ai, int bj> __device__ __forceinline__ void part_cond(const f32x4 (&acc)[2][2][4][2], const g8::Unit& u, int wr, int wc, int fr, int fq, int flag) const {}
    __device__ __forceinline__ void tail(const f32x4 (&acc)[2][2][4][2], const g8::Unit& u, int wr, int wc, int fr, int fq) const {}
    __device__ __forceinline__ void operator()(const f32x4 (&acc)[2][2][4][2], const g8::Unit& u, int wr, int wc, int fr, int fq) const {
        const int hi = fr >> 3, r8 = fr & 7;
#pragma unroll
        for (int ai = 0; ai < 2; ++ai)
#pragma unroll
            for (int m = 0; m < 4; ++m) {
                const size_t rg = (size_t)u.pm * 256 + ai * 128 + wr * 64 + m * 16;
                u32x4 pk[2];
#pragma unroll
                for (int bj = 0; bj < 2; ++bj) {
                    const f32x4 v0 = acc[ai][bj][m][0], v1 = acc[ai][bj][m][1];
                    pk[bj] = (u32x4){cvt_pk(v0[0], v0[1]), cvt_pk(v0[2], v0[3]), cvt_pk(v1[0], v1[1]), cvt_pk(v1[2], v1[3])};
                    if (u.pn * 256 + wc * 64 + bj * 32 + fq * 8 == gbase) { *(f32x4*)(G + (rg + fr) * 8) = v0; *(f32x4*)(G + (rg + fr) * 8 + 4) = v1; }
                }
                perm_store(P + (rg + r8) * NPAD + u.pn * 256 + wc * 64 + hi * 32 + fq * 8, (size_t)8 * NPAD, pk[0], pk[1], hi);
            }
    }
};
struct EpiMoe2 {
    static constexpr bool SPLIT = false; static constexpr int NQ = 4, NST = 16;
    bf16_t* Y;
    template <int ai, int bj> __device__ __forceinline__ void part_cond(const f32x4 (&acc)[2][2][4][2], const g8::Unit& u, int wr, int wc, int fr, int fq, int flag) const {}
    __device__ __forceinline__ void tail(const f32x4 (&acc)[2][2][4][2], const g8::Unit& u, int wr, int wc, int fr, int fq) const {}
    __device__ __forceinline__ void operator()(const f32x4 (&acc)[2][2][4][2], const g8::Unit& u, int wr, int wc, int fr, int fq) const {
        const int hi = fr >> 3, r8 = fr & 7;
#pragma unroll
        for (int ai = 0; ai < 2; ++ai)
#pragma unroll
            for (int m = 0; m < 4; ++m) {
                const size_t rg = (size_t)u.pm * RBR + ai * 128 + wr * 64 + m * 16;
                u32x4 pk[2];
#pragma unroll
                for (int bj = 0; bj < 2; ++bj) {
                    const f32x4 v0 = acc[ai][bj][m][0], v1 = acc[ai][bj][m][1];
                    pk[bj] = (u32x4){cvt_pk(v0[0], v0[1]), cvt_pk(v0[2], v0[3]), cvt_pk(v1[0], v1[1]), cvt_pk(v1[2], v1[3])};
                }
                perm_store<true>(Y + (rg + r8) * 1024 + u.pn * 256 + wc * 64 + hi * 32 + fq * 8, (size_t)8 * 1024, pk[0], pk[1], hi);
            }
    }
};
struct EpiMoe2F8 {
    static constexpr bool SPLIT = false; static constexpr int NQ = 2, NST = 8;
    unsigned char* Y;
    template <int ai, int bj> __device__ __forceinline__ void part_cond(const f32x4 (&acc)[2][2][4][2], const g8::Unit& u, int wr, int wc, int fr, int fq, int flag) const {}
    __device__ __forceinline__ void tail(const f32x4 (&acc)[2][2][4][2], const g8::Unit& u, int wr, int wc, int fr, int fq) const {}
    __device__ __forceinline__ void operator()(const f32x4 (&acc)[2][2][4][2], const g8::Unit& u, int wr, int wc, int fr, int fq) const {
#pragma unroll
        for (int ai = 0; ai < 2; ++ai)
#pragma unroll
            for (int m = 0; m < 4; ++m) {
                const size_t row = (size_t)u.pm * RBR + ai * 128 + wr * 64 + m * 16 + fr;
                u32x4 d;
#pragma unroll
                for (int bj = 0; bj < 2; ++bj)
#pragma unroll
                    for (int n = 0; n < 2; ++n) {
#if MOE2_F8
                        const f32x4 v = acc[ai][bj][m][n];
#else
                        const f32x4 v = acc[ai][bj][m][n] * 16.f;
#endif
                        int w = __builtin_amdgcn_cvt_pk_fp8_f32(v[0], v[1], 0, false);
                        w = __builtin_amdgcn_cvt_pk_fp8_f32(v[2], v[3], w, true);
                        d[bj * 2 + n] = (unsigned)w;
                    }
                *(u32x4*)(Y + row * 1024 + u.pn * 256 + wc * 64 + fq * 16) = d;
            }
    }
};
struct EpiOut {
    static constexpr bool SPLIT = false; static constexpr int NQ = 8, NST = 32;
    template <int ai, int bj> __device__ __forceinline__ void part_cond(const f32x4 (&acc)[2][2][4][2], const g8::Unit& u, int wr, int wc, int fr, int fq, int flag) const {}
    __device__ __forceinline__ void tail(const f32x4 (&acc)[2][2][4][2], const g8::Unit& u, int wr, int wc, int fr, int fq) const {}
    const bf16_t* xres; bf16_t* Y;
    __device__ __forceinline__ void operator()(const f32x4 (&acc)[2][2][4][2], const g8::Unit& u, int wr, int wc, int fr, int fq) const {
        const int hi = fr >> 3, r8 = fr & 7;
#pragma unroll
        for (int ai = 0; ai < 2; ++ai)
#pragma unroll
            for (int m = 0; m < 4; ++m) {
                const size_t rg = (size_t)u.pm * 256 + ai * 128 + wr * 64 + m * 16;
                u32x4 pk[2];
#pragma unroll
                for (int bj = 0; bj < 2; ++bj) {
                    const u32x4 xr = *(const u32x4*)(xres + (rg + fr) * 1024 + u.pn * 256 + wc * 64 + bj * 32 + fq * 8);
                    float f[8]; unpack8(xr, f);
                    const f32x4 v0 = acc[ai][bj][m][0], v1 = acc[ai][bj][m][1];
                    pk[bj] = (u32x4){cvt_pk(f[0] * ALPHA + v0[0], f[1] * ALPHA + v0[1]), cvt_pk(f[2] * ALPHA + v0[2], f[3] * ALPHA + v0[3]),
                                     cvt_pk(f[4] * ALPHA + v1[0], f[5] * ALPHA + v1[1]), cvt_pk(f[6] * ALPHA + v1[2], f[7] * ALPHA + v1[3])};
                }
                perm_store(Y + (rg + r8) * 1024 + u.pn * 256 + wc * 64 + hi * 32 + fq * 8, (size_t)8 * 1024, pk[0], pk[1], hi);
                asm volatile("" ::: "memory");
            }
    }
};

constexpr int TS_RS = 272;
__device__ __forceinline__ void tile_put(const Ctx& c, int row_l, int col_l, const u32x2 v) { *(u32x2*)(c.smem + row_l * TS_RS + col_l * 2) = v; }
template <int NCOL>
__device__ __forceinline__ void tile_flush(const Ctx& c, bf16_t* out, size_t ld, bool valid) {
    __syncthreads();
    constexpr int CPR = NCOL / 8, PER = (128 * CPR) / 256;
#pragma unroll
    for (int i = 0; i < PER; ++i) {
        const int idx = c.tid + 256 * i, row = idx / CPR, ch = idx % CPR;
        const u32x4 v = *(const u32x4*)(c.smem + row * TS_RS + ch * 16);
        if (valid) *(u32x4*)(out + (size_t)row * ld + ch * 8) = v;
    }
    __syncthreads();
}

__device__ __forceinline__ void conv_family(const float* src, int nmat, size_t src_stride, int K, int N, int Nout,
                            bf16_t* dst, size_t dst_stride, int grp, int kind, const Ctx& c) {
    float* lds = (float*)c.smem;
    const int tk = K / 128, tn = Nout / 64, per = tk * tn, total = nmat * per;
    const int tx = c.tid & 15, ty = c.tid >> 4;
    f32x4 r[8];
#define CV_LOAD(u_) do { const int mat_ = (u_) / per, r_ = (u_) - mat_ * per, kt_ = r_ / tn, nt_ = r_ - kt_ * tn; \
        const float* s_ = src + (size_t)mat_ * src_stride + (size_t)(kt_ * 128 + ty) * N + nt_ * 64 + tx * 4; const bool in_ = (nt_ * 64 + tx * 4) < N; \
        _Pragma("unroll") for (int i = 0; i < 8; ++i) r[i] = in_ ? __builtin_nontemporal_load((const f32x4*)(s_ + (size_t)(16 * i) * N)) : (f32x4){0.f, 0.f, 0.f, 0.f}; } while (0)
    if (c.bid < total) CV_LOAD(c.bid);
    for (int base = 0; base < total; base += c.nblk) {
        const int u = base + c.bid; const bool valid = u < total;
#pragma unroll
        for (int i = 0; i < 8; ++i) *(f32x4*)(lds + (ty + 16 * i) * 68 + tx * 4) = r[i];
        if (u + c.nblk < total) CV_LOAD(u + c.nblk);
        __syncthreads();
        if (valid) {
        const int mat = u / per, rr = u - mat * per, kt = rr / tn, nt = rr - kt * tn;
        const int dmat = grp ? (mat / grp) * (grp + 1) + (mat % grp) : mat;
        bf16_t* d = dst + (size_t)dmat * dst_stride;
        const int nl = c.tid & 63, kq = (c.tid >> 6) * 32;
        if (kind == 3) {
            unsigned char* d8 = (unsigned char*)dst + (size_t)dmat * dst_stride;
            unsigned w8[8];
#pragma unroll
            for (int j = 0; j < 8; ++j) {
                int w_ = __builtin_amdgcn_cvt_pk_fp8_f32(lds[(kq + 4 * j) * 68 + nl] * 8.f, lds[(kq + 4 * j + 1) * 68 + nl] * 8.f, 0, false);
                w_ = __builtin_amdgcn_cvt_pk_fp8_f32(lds[(kq + 4 * j + 2) * 68 + nl] * 8.f, lds[(kq + 4 * j + 3) * 68 + nl] * 8.f, w_, true);
                w8[j] = (unsigned)w_;
            }
            u32x4* dp8 = (u32x4*)(d8 + (size_t)(nt * 64 + nl) * K + kt * 128 + kq);
            dp8[0] = (u32x4){w8[0], w8[1], w8[2], w8[3]}; dp8[1] = (u32x4){w8[4], w8[5], w8[6], w8[7]};
        } else {
        unsigned w[16];
#pragma unroll
        for (int j = 0; j < 16; ++j) w[j] = pk2(lds[(kq + 2 * j) * 68 + nl], lds[(kq + 2 * j + 1) * 68 + nl]);
        const int n = nt * 64 + nl;
        const int drow = (kind == 0) ? n : ((n >> 4) * 32 + (n & 15) + (kind == 2 ? 16 : 0));
        u32x4* dp = (u32x4*)(d + (size_t)drow * K + kt * 128 + kq);
        dp[0] = (u32x4){w[0], w[1], w[2], w[3]}; dp[1] = (u32x4){w[4], w[5], w[6], w[7]};
        dp[2] = (u32x4){w[8], w[9], w[10], w[11]}; dp[3] = (u32x4){w[12], w[13], w[14], w[15]};
        }
        }
        __syncthreads();
    }
#undef CV_LOAD
}

__device__ __forceinline__ void phase_prologue(const Args& a, const Ctx& c) {
    unsigned char* ws = a.ws;
    bf16_t* WIN = (bf16_t*)(ws + WS_WIN);
    conv_family((const float*)a.in[2], 2, (size_t)1024 * 2472, 1024, 2472, NPAD, WIN, 2 * WIN_ELEMS, 0, 0, c);
    conv_family((const float*)a.in[12], 2, (size_t)1024 * 2312, 1024, 2312, NPAD, WIN + WIN_ELEMS, 2 * WIN_ELEMS, 0, 0, c);
    conv_family((const float*)a.in[4], 2, (size_t)256 * 768, 256, 768, 768, (bf16_t*)(ws + WS_WQB), WQB_ELEMS, 0, 0, c);
    conv_family((const float*)a.in[6], 2, (size_t)128 * 1024, 128, 1024, 1024, (bf16_t*)(ws + WS_WKVB), WKVB_ELEMS, 0, 0, c);
    bf16_t* WOUT = (bf16_t*)(ws + WS_WOUT);
    conv_family((const float*)a.in[11], 2, (size_t)1024 * 1024, 1024, 1024, 1024, WOUT, 2 * WOUT_ELEMS, 0, 0, c);
    conv_family((const float*)a.in[17], 2, (size_t)1024 * 1024, 1024, 1024, 1024, WOUT + WOUT_ELEMS, 2 * WOUT_ELEMS, 0, 0, c);
    conv_family((const float*)a.in[20], 4, (size_t)1024 * 64, 1024, 64, 128, (bf16_t*)(ws + WS_WRT), WRT_ELEMS, 0, 0, c);
    bf16_t* WGU = (bf16_t*)(ws + WS_WGU);
    conv_family((const float*)a.in[22], 256, (size_t)1024 * 256, 1024, 256, 256, WGU, WGU_ELEMS, 64, 1, c);
    conv_family((const float*)a.in[23], 256, (size_t)1024 * 256, 1024, 256, 256, WGU, WGU_ELEMS, 64, 2, c);
    conv_family((const float*)a.in[25], 4, (size_t)1024 * 256, 1024, 256, 256, WGU + 64 * WGU_ELEMS, 65 * WGU_ELEMS, 0, 1, c);
    conv_family((const float*)a.in[26], 4, (size_t)1024 * 256, 1024, 256, 256, WGU + 64 * WGU_ELEMS, 65 * WGU_ELEMS, 0, 2, c);
    bf16_t* WDN = (bf16_t*)(ws + WS_WDN);
#if MOE2_F8
    conv_family((const float*)a.in[24], 256, (size_t)256 * 1024, 256, 1024, 1024, WDN, WDN_ELEMS, 64, 3, c);
    conv_family((const float*)a.in[27], 4, (size_t)256 * 1024, 256, 1024, 1024, (bf16_t*)((unsigned char*)WDN + 64 * WDN_ELEMS), 65 * WDN_ELEMS, 0, 3, c);
#else
    conv_family((const float*)a.in[24], 256, (size_t)256 * 1024, 256, 1024, 1024, WDN, WDN_ELEMS, 64, 0, c);
    conv_family((const float*)a.in[27], 4, (size_t)256 * 1024, 256, 1024, 1024, WDN + 64 * WDN_ELEMS, 65 * WDN_ELEMS, 0, 0, c);
#endif
    {
        const float* x = (const float*)a.in[0]; bf16_t* xb = (bf16_t*)(ws + WS_XBF);
        const size_t n8 = (size_t)T * 1024 / 8;
        for (size_t i = (size_t)c.bid * 256 + c.tid; i < n8; i += (size_t)c.nblk * 256) {
            const f32x4 v0 = __builtin_nontemporal_load((const f32x4*)(x + i * 8)), v1 = __builtin_nontemporal_load((const f32x4*)(x + i * 8 + 4));
            *(u32x4*)(xb + i * 8) = (u32x4){pk2(v0[0], v0[1]), pk2(v0[2], v0[3]), pk2(v1[0], v1[1]), pk2(v1[2], v1[3])};
        }
    }
    {
        const int* pos = (const int*)a.in[1];
        float* rm = (float*)(ws + WS_ROPEM); float* rs = (float*)(ws + WS_ROPES);
        const float ln_theta = 9.210340371976184f;
        for (int i = c.bid * 256 + c.tid; i < T * 16; i += c.nblk * 256) {
            const int t = i >> 4, f = i & 15;
            const float inv = expf(-((float)(2 * f) / 32.f) * ln_theta);
            const float ang = (float)pos[t] * inv;
            rm[i * 2] = cosf(ang); rm[i * 2 + 1] = sinf(ang);
        }
        for (int i = c.bid * 256 + c.tid; i < T * 32; i += c.nblk * 256) {
            const int t = i >> 5, f = i & 31;
            const float inv = expf(-((float)(2 * f) / 64.f) * ln_theta);
            const float ang = (float)pos[t] * inv;
            rs[i * 2] = cosf(ang); rs[i * 2 + 1] = sinf(ang);
        }
    }
}

__device__ __forceinline__ void phase_inproj(const bf16_t* XBF, const bf16_t* W, bf16_t* PROJ, float* GATES, int gbase, const Ctx& c) {
    const int ntn = NPAD / 128;
    for (int i = 0;; ++i) {
        int mt, nt; bool valid; if (!tile_map2(i, c, T / 128, ntn, mt, nt, valid)) break;
        const bf16_t* a0 = XBF + (size_t)(mt * 128 + (c.tid >> 2)) * 1024;
        const bf16_t* b0 = W + (size_t)(nt * 128 + (c.tid >> 2)) * 1024;
        f32x4 acc[4][4];
        gemm_tile(a0, a0 + 64 * 1024, b0, b0 + 64 * 1024, 32, acc, c);
#pragma unroll
        for (int m = 0; m < 4; ++m) {
            const int rl = c.wr * 64 + m * 16 + c.fr, row = mt * 128 + rl;
#pragma unroll
            for (int n = 0; n < 4; ++n) {
                const int cl = c.wc * 64 + n * 16 + c.fq * 4, col = nt * 128 + cl;
                const f32x4 v = acc[m][n];
                tile_put(c, rl, cl, (u32x2){pk2(v[0], v[1]), pk2(v[2], v[3])});
                if (valid && col >= gbase && col < gbase + 8) *(f32x4*)(GATES + (size_t)row * 8 + (col - gbase)) = v;
            }
        }
        tile_flush<128>(c, PROJ + (size_t)mt * 128 * NPAD + nt * 128, NPAD, valid);
    }
}

constexpr int MLAUP_TILES = (T / 128) * 6 + (T / 128) * 8;
__device__ __forceinline__ void mla_up_tile(int u, const bf16_t* CQ, const bf16_t* WQB, const bf16_t* CKV, const bf16_t* WKVB,
                             const float* ROPEM, bf16_t* QF, bf16_t* KN, bf16_t* VV, const Ctx& c) {
    const int tq = (T / 128) * 6;
    const float qscale = 0.10206207261596577f * 1.4426950408889634f;
    {
        f32x4 acc[4][4];
        if (u < tq) {
            const int mt = u / 6, nt = u % 6;
            const bf16_t* a0 = CQ + (size_t)(mt * 128 + (c.tid >> 2)) * 256;
            const bf16_t* b0 = WQB + (size_t)(nt * 128 + (c.tid >> 2)) * 256;
            gemm_tile(a0, a0 + 64 * 256, b0, b0 + 64 * 256, 8, acc, c);
#pragma unroll
            for (int m = 0; m < 4; ++m) {
                const int row = mt * 128 + c.wr * 64 + m * 16 + c.fr;
#pragma unroll
                for (int np = 0; np < 2; ++np) {
                    const int cg = nt * 128 + c.wc * 64 + np * 32;
                    f32x4 v0 = acc[m][2 * np], v1 = acc[m][2 * np + 1];
                    if (((cg >> 5) % 3) == 2) {
#pragma unroll
                        for (int j = 0; j < 4; ++j) {
                            const int i = c.fq * 4 + j;
                            const float cs = ROPEM[((size_t)row * 16 + i) * 2], sn = ROPEM[((size_t)row * 16 + i) * 2 + 1];
                            const float x1 = v0[j], x2 = v1[j];
                            v0[j] = x1 * cs - x2 * sn; v1[j] = x2 * cs + x1 * sn;
                        }
                    }
                    v0 *= qscale; v1 *= qscale;
                    *(u32x2*)(QF + (size_t)row * 768 + cg + c.fq * 4) = (u32x2){pk2(v0[0], v0[1]), pk2(v0[2], v0[3])};
                    *(u32x2*)(QF + (size_t)row * 768 + cg + 16 + c.fq * 4) = (u32x2){pk2(v1[0], v1[1]), pk2(v1[2], v1[3])};
                }
            }
        } else {
            const int v = u - tq, mt = v / 8, nt = v % 8;
            const bf16_t* a0 = CKV + (size_t)(mt * 128 + (c.tid >> 2)) * 128;
            const bf16_t* b0 = WKVB + (size_t)(nt * 128 + (c.tid >> 2)) * 128;
            gemm_tile(a0, a0 + 64 * 128, b0, b0 + 64 * 128, 4, acc, c);
            bf16_t* dst = (c.wc == 0) ? KN : VV;
#pragma unroll
            for (int m = 0; m < 4; ++m) {
                const int row = mt * 128 + c.wr * 64 + m * 16 + c.fr;
#pragma unroll
                for (int n = 0; n < 4; ++n) {
                    const f32x4 x = acc[m][n];
                    *(u32x2*)(dst + (size_t)row * 512 + nt * 64 + n * 16 + c.fq * 4) = (u32x2){pk2(x[0], x[1]), pk2(x[2], x[3])};
                }
            }
        }
    }
}

__device__ __forceinline__ void phase_outproj(const bf16_t* MIXO, const bf16_t* W, const float* xres, float* YBUF, const Ctx& c) {
    for (int i = 0;; ++i) {
        int mt, nt; bool valid; if (!tile_map2(i, c, T / 128, 8, mt, nt, valid)) break;
        const bf16_t* a0 = MIXO + (size_t)(mt * 128 + (c.tid >> 2)) * 1024;
        const bf16_t* b0 = W + (size_t)(nt * 128 + (c.tid >> 2)) * 1024;
        f32x4 acc[4][4];
        gemm_tile(a0, a0 + 64 * 1024, b0, b0 + 64 * 1024, 32, acc, c);
#pragma unroll
        for (int m = 0; m < 4; ++m) {
            const int row = mt * 128 + c.wr * 64 + m * 16 + c.fr;
#pragma unroll
            for (int n = 0; n < 4; ++n) {
                const int col = nt * 128 + c.wc * 64 + n * 16 + c.fq * 4;
                const f32x4 xr = *(const f32x4*)(xres + (size_t)row * 1024 + col);
                if (valid) *(f32x4*)(YBUF + (size_t)row * 1024 + col) = xr * ALPHA + acc[m][n];
            }
        }
    }
}

__device__ __forceinline__ void phase_router(const bf16_t* XBF, const bf16_t* W, float* LOG, const Ctx& c) {
    for (int base = 0; base < T / 128; base += c.nblk) {
        const bool valid = (base + c.bid) < T / 128; const int mt = valid ? base + c.bid : 0;
        const bf16_t* a0 = XBF + (size_t)(mt * 128 + (c.tid >> 2)) * 1024;
        const bf16_t* b0 = W + (size_t)(c.tid >> 2) * 1024;
        f32x4 acc[4][4];
        gemm_tile(a0, a0 + 64 * 1024, b0, b0 + 64 * 1024, 32, acc, c);
        if (c.wc == 0 && valid) {
#pragma unroll
            for (int m = 0; m < 4; ++m) {
                const int row = mt * 128 + c.wr * 64 + m * 16 + c.fr;
#pragma unroll
                for (int n = 0; n < 4; ++n) *(f32x4*)(LOG + (size_t)row * 64 + n * 16 + c.fq * 4) = acc[m][n];
            }
        }
    }
}

__device__ __forceinline__ void build_block_table(const unsigned* CNT, int* bst, const Ctx& c) {
    __syncthreads();
    if (c.wid == 0) {
        const int cnt = (int)__hip_atomic_load(CNT + c.lane, __ATOMIC_RELAXED, __HIP_MEMORY_SCOPE_AGENT);
        const int nb = (cnt + RBR - 1) / RBR;
        int inc = nb;
#pragma unroll
        for (int o = 1; o < 64; o <<= 1) { const int x = shfl_up_(inc, o); if (c.lane >= o) inc += x; }
        bst[c.lane] = inc - nb; bst[66 + c.lane] = cnt;
        if (c.lane == 63) { bst[64] = inc; bst[65] = inc + T / RBR; bst[66 + 64] = T; }
    }
    __syncthreads();
}
__device__ __forceinline__ int find_expert(const int* bst, int rb, const Ctx& c) {
    return __popcll(__ballot(bst[1 + c.lane] <= rb));
}

__device__ __forceinline__ void phase_moe1(const bf16_t* XBF, const bf16_t* WGU, const unsigned* CNT, const int* LTOK, const float* LW, bf16_t* HBUF, const Ctx& c) {
    int* bst = (int*)(c.smem + 65536 + 64);
    build_block_table(CNT, bst, c);
    const int nsb = bst[65] * 2;
    for (int i = 0;; ++i) {
        int sbk, nt; bool valid; if (!tile_map2(i, c, nsb, 4, sbk, nt, valid)) break;
        const int rb = sbk >> 1, hb = sbk & 1;
        const int e = find_expert(bst, rb, c);
        const int lb = rb - bst[e], cnt = bst[66 + e];
        const int p0 = lb * RBR + hb * 128 + (c.tid >> 2), p1 = p0 + 64;
        const int t0 = (p0 < cnt) ? LTOK[(size_t)e * CAP + p0] : 0;
        const int t1 = (p1 < cnt) ? LTOK[(size_t)e * CAP + p1] : 0;
        const bf16_t* a0 = XBF + (size_t)t0 * 1024;
        const bf16_t* a1 = XBF + (size_t)t1 * 1024;
        const bf16_t* b0 = WGU + (size_t)e * WGU_ELEMS + (size_t)(nt * 128 + (c.tid >> 2)) * 1024;
        f32x4 acc[4][4];
        gemm_tile(a0, a1, b0, b0 + 64 * 1024, 32, acc, c);
#pragma unroll
        for (int m = 0; m < 4; ++m) {
            const int rl = c.wr * 64 + m * 16 + c.fr;
            const int pw = lb * RBR + hb * 128 + rl;
            const float wrow = (pw < cnt) ? LW[(size_t)e * CAP + pw] : 0.f;
#pragma unroll
            for (int n = 0; n < 2; ++n) {
                const f32x4 g = acc[m][n], up = acc[m][n + 2];
                float h[4];
#pragma unroll
                for (int j = 0; j < 4; ++j) h[j] = siluf_(g[j]) * up[j] * wrow;
                tile_put(c, rl, c.wc * 32 + n * 16 + c.fq * 4, (u32x2){pk2(h[0], h[1]), pk2(h[2], h[3])});
            }
        }
        tile_flush<64>(c, HBUF + ((size_t)rb * RBR + hb * 128) * 256 + nt * 64, 256, valid);
    }
}

__device__ __forceinline__ void phase_moe2(const bf16_t* HBUF, const bf16_t* WDN, const unsigned* CNT, bf16_t* Y, const Ctx& c) {
    int* bst = (int*)(c.smem + 65536 + 64);
    build_block_table(CNT, bst, c);
    const int nsb = bst[65] * 2;
    for (int i = 0;; ++i) {
        int sbk, nt; bool valid; if (!tile_map2(i, c, nsb, 8, sbk, nt, valid)) break;
        const int rb = sbk >> 1;
        const int e = find_expert(bst, rb, c);
        const bf16_t* a0 = HBUF + ((size_t)sbk * 128 + (c.tid >> 2)) * 256;
        const bf16_t* b0 = WDN + (size_t)e * WDN_ELEMS + (size_t)(nt * 128 + (c.tid >> 2)) * 256;
        f32x4 acc[4][4];
        gemm_tile(a0, a0 + 64 * 256, b0, b0 + 64 * 256, 8, acc, c);
#pragma unroll
        for (int m = 0; m < 4; ++m) {
            const int lr = c.wr * 64 + m * 16 + c.fr;
#pragma unroll
            for (int n = 0; n < 4; ++n) {
                const f32x4 v = acc[m][n];
                tile_put(c, lr, c.wc * 64 + n * 16 + c.fq * 4, (u32x2){pk2(v[0], v[1]), pk2(v[2], v[3])});
            }
        }
        tile_flush<128>(c, Y + (size_t)sbk * 128 * 1024 + nt * 128, 1024, valid);
    }
}

__device__ __forceinline__ float dppf(float v, int ctrl_sel) {
    int x = __builtin_bit_cast(int, v), r;
    if (ctrl_sel == 0) r = __builtin_amdgcn_update_dpp(0, x, 0xB1, 0xF, 0xF, true);
    else if (ctrl_sel == 1) r = __builtin_amdgcn_update_dpp(0, x, 0x4E, 0xF, 0xF, true);
    else if (ctrl_sel == 2) r = __builtin_amdgcn_update_dpp(0, x, 0x141, 0xF, 0xF, true);
    else r = __builtin_amdgcn_update_dpp(0, x, 0x140, 0xF, 0xF, true);
    return __builtin_bit_cast(float, r);
}
__device__ __forceinline__ float red16(float v) { v += dppf(v, 0); v += dppf(v, 1); v += dppf(v, 2); v += dppf(v, 3); return v; }

template <bool F32OUT>
__device__ __forceinline__ void ln_row_store(float (&v)[16], const float* g, const float* b, float* of32, bf16_t* obf, int lane) {
    float s = 0.f;
#pragma unroll
    for (int i = 0; i < 16; ++i) s += v[i];
    const float mean = wave_sum(s) * (1.f / 1024.f);
    float q = 0.f;
#pragma unroll
    for (int i = 0; i < 16; ++i) { v[i] -= mean; q += v[i] * v[i]; }
    const float rstd = rsqrtf(wave_sum(q) * (1.f / 1024.f) + 1e-5f);
#pragma unroll
    for (int hf = 0; hf < 2; ++hf) {
        const int col = hf * 512 + lane * 8;
        const f32x4 g0 = *(const f32x4*)(g + col), g1 = *(const f32x4*)(g + col + 4);
        const f32x4 b0 = *(const f32x4*)(b + col), b1 = *(const f32x4*)(b + col + 4);
        f32x4 y0, y1;
#pragma unroll
        for (int j = 0; j < 4; ++j) { y0[j] = v[hf * 8 + j] * rstd * g0[j] + b0[j]; y1[j] = v[hf * 8 + 4 + j] * rstd * g1[j] + b1[j]; }
        if constexpr (F32OUT) { *(f32x4*)(of32 + col) = y0; *(f32x4*)(of32 + col + 4) = y1; }
        *(u32x4*)(obf + col) = (u32x4){pk2(y0[0], y0[1]), pk2(y0[2], y0[3]), pk2(y1[0], y1[1]), pk2(y1[2], y1[3])};
    }
}

__device__ __forceinline__ void phase_ln1(const bf16_t* YBUF, const float* g, const float* b, bf16_t* XBF, const Ctx& c) {
    for (int t = c.bid * 4 + c.wid; t < T; t += c.nblk * 4) {
        float v[16];
#pragma unroll
        for (int hf = 0; hf < 2; ++hf) {
            const u32x4 r = *(const u32x4*)(YBUF + (size_t)t * 1024 + hf * 512 + c.lane * 8);
            float f[8]; unpack8(r, f);
#pragma unroll
            for (int j = 0; j < 8; ++j) v[hf * 8 + j] = f[j];
        }
        ln_row_store<false>(v, g, b, nullptr, XBF + (size_t)t * 1024, c.lane);
    }
}

template <bool LASTL>
__device__ __forceinline__ void phase_combine8(const unsigned char* Y, const int* ASG, const float* ASGW, const unsigned* CNT, const float* g, const float* b,
                                               float* XOUT, bf16_t* XBF, const Ctx& c) {
    int* bst = (int*)(c.smem + 65536 + 64);
    build_block_table(CNT, bst, c);
    const int lane = c.lane;
    for (int t = c.bid * 4 + c.wid; t < T; t += c.nblk * 4) {
        float v[16];
        {
            const u32x4 r0 = *(const u32x4*)(XBF + (size_t)t * 1024 + lane * 16), r1 = *(const u32x4*)(XBF + (size_t)t * 1024 + lane * 16 + 8);
            float f[8]; unpack8(r0, f);
#pragma unroll
            for (int j = 0; j < 8; ++j) v[j] = f[j] * ALPHA;
            unpack8(r1, f);
#pragma unroll
            for (int j = 0; j < 8; ++j) v[8 + j] = f[j] * ALPHA;
        }
        u32x4 yr[9]; float wk[9];
#pragma unroll
        for (int k = 0; k < 9; ++k) {
            size_t crow; wk[k] = 1.f / 16.f;
            if (k < 8) { const int asg = ASG[(size_t)t * 8 + k]; crow = (size_t)bst[asg >> 16] * RBR + (asg & 0xffff); wk[k] = ASGW[(size_t)t * 8 + k] * (1.f / 16.f); }
            else crow = (size_t)bst[64] * RBR + t;
            yr[k] = *(const u32x4*)(Y + crow * 1024 + lane * 16);
        }
#pragma unroll
        for (int k = 0; k < 9; ++k)
#pragma unroll
            for (int q = 0; q < 4; ++q) {
                const f32x2 lo = __builtin_amdgcn_cvt_pk_f32_fp8((int)yr[k][q], false), hi = __builtin_amdgcn_cvt_pk_f32_fp8((int)yr[k][q], true);
                v[q * 4 + 0] += lo[0] * wk[k]; v[q * 4 + 1] += lo[1] * wk[k]; v[q * 4 + 2] += hi[0] * wk[k]; v[q * 4 + 3] += hi[1] * wk[k];
            }
        float s = 0.f;
#pragma unroll
        for (int i = 0; i < 16; ++i) s += v[i];
        const float mean = wave_sum_dpp(s) * (1.f / 1024.f);
        float q2 = 0.f;
#pragma unroll
        for (int i = 0; i < 16; ++i) { v[i] -= mean; q2 += v[i] * v[i]; }
        const float rstd = rsqrtf(wave_sum_dpp(q2) * (1.f / 1024.f) + 1e-5f);
        float y[16];
#pragma unroll
        for (int q = 0; q < 4; ++q) {
            const f32x4 gg = *(const f32x4*)(g + lane * 16 + q * 4), bb = *(const f32x4*)(b + lane * 16 + q * 4);
#pragma unroll
            for (int j = 0; j < 4; ++j) y[q * 4 + j] = v[q * 4 + j] * rstd * gg[j] + bb[j];
            if constexpr (LASTL) *(f32x4*)(XOUT + (size_t)t * 1024 + lane * 16 + q * 4) = (f32x4){y[q * 4], y[q * 4 + 1], y[q * 4 + 2], y[q * 4 + 3]};
        }
        *(u32x4*)(XBF + (size_t)t * 1024 + lane * 16) = (u32x4){pk2(y[0], y[1]), pk2(y[2], y[3]), pk2(y[4], y[5]), pk2(y[6], y[7])};
        *(u32x4*)(XBF + (size_t)t * 1024 + lane * 16 + 8) = (u32x4){pk2(y[8], y[9]), pk2(y[10], y[11]), pk2(y[12], y[13]), pk2(y[14], y[15])};
    }
}

template <bool LASTL>
__device__ __forceinline__ void phase_combine(const bf16_t* Y, const int* ASG, const float* ASGW, const unsigned* CNT, const float* g, const float* b,
                              float* XOUT, bf16_t* XBF, const Ctx& c) {
    int* bst = (int*)(c.smem + 65536 + 64);
    build_block_table(CNT, bst, c);
    for (int t = c.bid * 4 + c.wid; t < T; t += c.nblk * 4) {
        float v[16];
#pragma unroll
        for (int hf = 0; hf < 2; ++hf) {
            const u32x4 r = *(const u32x4*)(XBF + (size_t)t * 1024 + hf * 512 + c.lane * 8);
            float f[8]; unpack8(r, f);
#pragma unroll
            for (int j = 0; j < 8; ++j) v[hf * 8 + j] = f[j] * ALPHA;
        }
#pragma unroll
        for (int k = 0; k < 9; ++k) {
            size_t crow; float wk = 1.f;
            if (k < 8) { const int asg = ASG[(size_t)t * 8 + k]; crow = (size_t)bst[asg >> 16] * RBR + (asg & 0xffff); wk = ASGW[(size_t)t * 8 + k]; }
            else crow = (size_t)bst[64] * RBR + t;
#pragma unroll
            for (int hf = 0; hf < 2; ++hf) {
                const u32x4 r = *(const u32x4*)(Y + crow * 1024 + hf * 512 + c.lane * 8);
                float f[8]; unpack8(r, f);
#pragma unroll
                for (int j = 0; j < 8; ++j) v[hf * 8 + j] += f[j] * wk;
            }
        }
        ln_row_store<LASTL>(v, g, b, XOUT + (size_t)t * 1024, XBF + (size_t)t * 1024, c.lane);
    }
}

__device__ __forceinline__ void phase_route(const float* LOG, const float* rb, unsigned* CNT, int* LTOK, float* LW, int* ASG, float* ASGW, const Ctx& c) {
    int* lcnt = (int*)c.smem;
    int* lbase = lcnt + 64;
    int* sel_e = lbase + 64;
    int* sel_p = sel_e + 256;
    float* sel_w = (float*)(sel_p + 256);
    const float rbias = rb[c.lane];
    for (int base = 0; base < T / 32; base += c.nblk) {
        const int ch = base + c.bid; const bool valid = ch < T / 32;
        __syncthreads();
        if (c.tid < 64) lcnt[c.tid] = 0;
        __syncthreads();
        if (valid) for (int tl = c.wid; tl < 32; tl += 4) {
            const int t = ch * 32 + tl;
            const float lg = LOG[(size_t)t * 64 + c.lane];
            const float sc = 1.f / (1.f + expf(-lg));
            const float v = sc + rbias;
            float m1 = v;
            m1 = grp8_max(m1);
            int cand = (v == m1) ? c.lane : 999;
            cand = grp8_min(cand);
            float m2 = (c.lane == cand) ? -INFINITY : v;
            m2 = grp8_max(m2);
            const float gs = m1 + m2;
            const int g = c.lane >> 3;
            int grank = 0;
#pragma unroll
            for (int gg = 0; gg < 8; ++gg) { const float o = shfl_c_(gs, gg * 8); grank += ((o > gs) || (o == gs && gg < g)) ? 1 : 0; }
            const bool gsel = grank < 4;
            const float mv = gsel ? v : -INFINITY;
            int rank = 0;
#pragma unroll 8
            for (int jj = 0; jj < 64; ++jj) { const float o = shfl_c_(mv, jj); rank += ((o > mv) || (o == mv && jj < c.lane)) ? 1 : 0; }
            const bool sel = gsel && rank < 8;
            const float ssum = wave_sum(sel ? sc : 0.f);
            const float w = sc / ssum * 2.5f;
            const unsigned long long bal = __ballot(sel);
            const int slot = __popcll(bal & ((1ull << c.lane) - 1ull));
            if (sel) {
                const int p = atomicAdd(&lcnt[c.lane], 1);
                sel_e[tl * 8 + slot] = c.lane; sel_p[tl * 8 + slot] = p; sel_w[tl * 8 + slot] = w;
            }
        }
        __syncthreads();
        if (valid && c.tid < 64) { const int n = lcnt[c.tid]; lbase[c.tid] = n ? (int)atomicAdd(CNT + c.tid, (unsigned)n) : 0; }
        __syncthreads();
        if (valid) {
            const int tl = c.tid >> 3, t = ch * 32 + tl;
            const int e = sel_e[c.tid], pos = lbase[e] + sel_p[c.tid];
            LTOK[(size_t)e * CAP + pos] = t; LW[(size_t)e * CAP + pos] = sel_w[c.tid];
            ASG[(size_t)t * 8 + (c.tid & 7)] = (e << 16) | pos; ASGW[(size_t)t * 8 + (c.tid & 7)] = sel_w[c.tid];
            if (c.tid < 32) { const int ts = ch * 32 + c.tid; LTOK[(size_t)64 * CAP + ts] = ts; LW[(size_t)64 * CAP + ts] = 1.f; }
        }
    }
}

__device__ __forceinline__ void phase_lnroute(const bf16_t* YBUF, const float* g, const float* b, bf16_t* XBF, const bf16_t* W, const float* rb,
                                              unsigned* CNT, int* LTOK, float* LW, int* ASG, float* ASGW, const Ctx& c) {
    unsigned char* xa = c.smem;
    int* lcnt = (int*)(c.smem + 65536 + 64);
    int* lbase = lcnt + 64;
    float* lgt = (float*)c.smem;
    int* sel_e = (int*)(c.smem + 8192);
    int* sel_p = sel_e + 256;
    float* sel_w = (float*)(sel_p + 256);
    const int lane = c.lane;
    const float rbias = rb[lane];
    for (int base = 0; base < T / 32; base += c.nblk) {
        const int ch = base + c.bid; const bool valid = ch < T / 32;
        __syncthreads();
        if (c.tid < 64) lcnt[c.tid] = 0;
        u32x4 raw[8][2];
#pragma unroll
        for (int i = 0; i < 8; ++i)
#pragma unroll
            for (int hf = 0; hf < 2; ++hf) raw[i][hf] = valid ? *(const u32x4*)(YBUF + (size_t)(ch * 32 + c.wid + 4 * i) * 1024 + hf * 512 + lane * 8) : (u32x4){0u, 0u, 0u, 0u};
        if (valid)
#pragma unroll
        for (int i = 0; i < 8; ++i) {
            const int tl = c.wid + 4 * i;
            const int t = ch * 32 + tl;
            float v[16];
#pragma unroll
            for (int hf = 0; hf < 2; ++hf) {
                float f[8]; unpack8(raw[i][hf], f);
#pragma unroll
                for (int j = 0; j < 8; ++j) v[hf * 8 + j] = f[j];
            }
            float s = 0.f;
#pragma unroll
            for (int i = 0; i < 16; ++i) s += v[i];
            const float mean = wave_sum(s) * (1.f / 1024.f);
            float q = 0.f;
#pragma unroll
            for (int i = 0; i < 16; ++i) { v[i] -= mean; q += v[i] * v[i]; }
            const float rstd = rsqrtf(wave_sum(q) * (1.f / 1024.f) + 1e-5f);
#pragma unroll
            for (int hf = 0; hf < 2; ++hf) {
                const int col = hf * 512 + lane * 8;
                const f32x4 g0 = *(const f32x4*)(g + col), g1 = *(const f32x4*)(g + col + 4);
                const f32x4 b0 = *(const f32x4*)(b + col), b1 = *(const f32x4*)(b + col + 4);
                f32x4 y0, y1;
#pragma unroll
                for (int j = 0; j < 4; ++j) { y0[j] = v[hf * 8 + j] * rstd * g0[j] + b0[j]; y1[j] = v[hf * 8 + 4 + j] * rstd * g1[j] + b1[j]; }
                const u32x4 pk = (u32x4){pk2(y0[0], y0[1]), pk2(y0[2], y0[3]), pk2(y1[0], y1[1]), pk2(y1[2], y1[3])};
                *(u32x4*)(XBF + (size_t)t * 1024 + col) = pk;
                *(u32x4*)(xa + tl * 2048 + (((hf * 64 + lane) ^ (tl & 15)) * 16)) = pk;
            }
        }
        __syncthreads();
        f32x4 acc0 = (f32x4){0.f, 0.f, 0.f, 0.f}, acc1 = (f32x4){0.f, 0.f, 0.f, 0.f};
        {
            const int r = lane & 15, kq = lane >> 4;
            const bf16_t* wrow = W + (size_t)(c.wid * 16 + r) * 1024 + kq * 8;
#pragma unroll 1
            for (int kb = 0; kb < 32; kb += 8) {
                bf16x8 bfr[8];
#pragma unroll
                for (int j = 0; j < 8; ++j) bfr[j] = *(const bf16x8*)(wrow + (kb + j) * 32);
#pragma unroll
                for (int j = 0; j < 8; ++j) {
                    const int chunk = ((kb + j) * 4 + kq) ^ r;
                    const bf16x8 a0 = *(const bf16x8*)(xa + r * 2048 + chunk * 16), a1 = *(const bf16x8*)(xa + (16 + r) * 2048 + chunk * 16);
                    acc0 = __builtin_amdgcn_mfma_f32_16x16x32_bf16(a0, bfr[j], acc0, 0, 0, 0);
                    acc1 = __builtin_amdgcn_mfma_f32_16x16x32_bf16(a1, bfr[j], acc1, 0, 0, 0);
                }
            }
        }
        __syncthreads();
        {
            const int e = c.wid * 16 + (lane & 15), r0 = 4 * (lane >> 4);
#pragma unroll
            for (int j = 0; j < 4; ++j) { lgt[(r0 + j) * 64 + e] = acc0[j]; lgt[(16 + r0 + j) * 64 + e] = acc1[j]; }
        }
        __syncthreads();
        if (valid) for (int tl = c.wid; tl < 32; tl += 4) {
            const float lg = lgt[tl * 64 + lane];
            const float sc = 1.f / (1.f + expf(-lg));
            const float v = sc + rbias;
            float m1 = v;
            m1 = grp8_max(m1);
            int cand = (v == m1) ? lane : 999;
            cand = grp8_min(cand);
            float m2 = (lane == cand) ? -INFINITY : v;
            m2 = grp8_max(m2);
            const float gs = m1 + m2;
            const int gi = lane >> 3;
            int grank = 0;
#pragma unroll
            for (int gg = 0; gg < 8; ++gg) { const float o = shfl_c_(gs, gg * 8); grank += ((o > gs) || (o == gs && gg < gi)) ? 1 : 0; }
            const bool gsel = grank < 4;
            const float mv = gsel ? v : -INFINITY;
            int rank = 0;
#pragma unroll 8
            for (int jj = 0; jj < 64; ++jj) { const float o = shfl_c_(mv, jj); rank += ((o > mv) || (o == mv && jj < lane)) ? 1 : 0; }
            const bool sel = gsel && rank < 8;
            const float ssum = wave_sum(sel ? sc : 0.f);
            const float w = sc / ssum * 2.5f;
            const unsigned long long bal = __ballot(sel);
            const int slot = __popcll(bal & ((1ull << lane) - 1ull));
            if (sel) {
                const int p = atomicAdd(&lcnt[lane], 1);
                sel_e[tl * 8 + slot] = lane; sel_p[tl * 8 + slot] = p; sel_w[tl * 8 + slot] = w;
            }
        }
        __syncthreads();
        if (valid && c.tid < 64) { const int n = lcnt[c.tid]; lbase[c.tid] = n ? (int)atomicAdd(CNT + c.tid, (unsigned)n) : 0; }
        __syncthreads();
        if (valid) {
            const int tl = c.tid >> 3, t = ch * 32 + tl;
            const int e = sel_e[c.tid], pos = lbase[e] + sel_p[c.tid];
            LTOK[(size_t)e * CAP + pos] = t; LW[(size_t)e * CAP + pos] = sel_w[c.tid];
            ASG[(size_t)t * 8 + (c.tid & 7)] = (e << 16) | pos; ASGW[(size_t)t * 8 + (c.tid & 7)] = sel_w[c.tid];
            if (c.tid < 32) { const int ts = ch * 32 + c.tid; LTOK[(size_t)64 * CAP + ts] = ts; LW[(size_t)64 * CAP + ts] = 1.f; }
        }
    }
}

__device__ __forceinline__ void phase_prep_even(const bf16_t* PROJ, const float* GATES, const float* qn, const float* kvn, const float* cw,
                                const float* a_log, const float* dt_bias, const float* ROPEM,
                                bf16_t* CQ, bf16_t* CKV, bf16_t* KROPE, bf16_t* GQ, bf16_t* GK, bf16_t* GV, float* BETA, float* GLOG, const Ctx& c) {
    const int lane = c.lane;
    float* cwL = (float*)c.smem;
    __syncthreads();
    for (int i = c.tid; i < 4 * 1536 / 4; i += 256) *(f32x4*)(cwL + i * 4) = *(const f32x4*)(cw + i * 4);
    __syncthreads();
    for (int tb = (c.bid * 4 + c.wid) * 8; tb < T; tb += c.nblk * 4 * 8) {
        const int s0 = tb & (SEQ - 1);
        u32x4 xr[3][4];
#pragma unroll
        for (int arr = 0; arr < 3; ++arr)
#pragma unroll
            for (int w = 0; w < 3; ++w)
                xr[arr][w] = (s0 - 3 + w >= 0) ? *(const u32x4*)(PROJ + (size_t)(tb - 3 + w) * NPAD + 416 + arr * 512 + lane * 8) : (u32x4){0u, 0u, 0u, 0u};
        u32x4 nx[3]; u32x2 ncq; unsigned nckv; float nk1 = 0.f, nk2 = 0.f, ncs = 0.f, nsn = 0.f, ngate = 0.f;
#define PE_LOAD(t_) do { const bf16_t* pr_ = PROJ + (size_t)(t_) * NPAD; \
            _Pragma("unroll") for (int arr = 0; arr < 3; ++arr) nx[arr] = *(const u32x4*)(pr_ + 416 + arr * 512 + lane * 8); \
            ncq = *(const u32x2*)(pr_ + lane * 4); nckv = *(const unsigned*)(pr_ + 256 + lane * 2); \
            if (lane < 16) { nk1 = bf2f(pr_[384 + lane]); nk2 = bf2f(pr_[400 + lane]); ncs = ROPEM[((size_t)(t_) * 16 + lane) * 2]; nsn = ROPEM[((size_t)(t_) * 16 + lane) * 2 + 1]; } \
            if (lane < 8) ngate = GATES[(size_t)(t_) * 8 + lane]; } while (0)
        PE_LOAD(tb);
#pragma unroll
        for (int k = 0; k < 8; ++k) {
            const int t = tb + k;
#pragma unroll
            for (int arr = 0; arr < 3; ++arr) xr[arr][3] = nx[arr];
            const u32x2 r = ncq; const unsigned rkv = nckv; const float x1 = nk1, x2 = nk2, cs = ncs, sn = nsn, gate = ngate;
            if (k < 7) PE_LOAD(t + 1);
            {
                float v[4] = {bflo(r.x), bfhi(r.x), bflo(r.y), bfhi(r.y)};
                const float ss = wave_sum(v[0] * v[0] + v[1] * v[1] + v[2] * v[2] + v[3] * v[3]);
                const float rr = rsqrtf(ss * (1.f / 256.f) + 1e-6f);
                const f32x4 gq = *(const f32x4*)(qn + lane * 4);
                *(u32x2*)(CQ + (size_t)t * 256 + lane * 4) = (u32x2){pk2(v[0] * rr * gq[0], v[1] * rr * gq[1]), pk2(v[2] * rr * gq[2], v[3] * rr * gq[3])};
            }
            {
                const float v0 = bflo(rkv), v1 = bfhi(rkv);
                const float ss = wave_sum(v0 * v0 + v1 * v1);
                const float rr = rsqrtf(ss * (1.f / 128.f) + 1e-6f);
                *(unsigned*)(CKV + (size_t)t * 128 + lane * 2) = pk2(v0 * rr * kvn[lane * 2], v1 * rr * kvn[lane * 2 + 1]);
            }
            if (lane < 16) {
                KROPE[(size_t)t * 32 + lane] = (bf16_t)f2bf(x1 * cs - x2 * sn);
                KROPE[(size_t)t * 32 + 16 + lane] = (bf16_t)f2bf(x2 * cs + x1 * sn);
            }
#pragma unroll
            for (int arr = 0; arr < 3; ++arr) {
                float y[8];
#pragma unroll
                for (int j = 0; j < 8; ++j) y[j] = 0.f;
#pragma unroll
                for (int w = 0; w < 4; ++w) {
                    float f[8]; unpack8(xr[arr][w], f);
                    const f32x4 c0 = *(const f32x4*)(cwL + w * 1536 + arr * 512 + lane * 8), c1 = *(const f32x4*)(cwL + w * 1536 + arr * 512 + lane * 8 + 4);
#pragma unroll
                    for (int j = 0; j < 4; ++j) { y[j] += c0[j] * f[j]; y[4 + j] += c1[j] * f[4 + j]; }
                }
                float ss = 0.f;
#pragma unroll
                for (int j = 0; j < 8; ++j) { y[j] = siluf_(y[j]); ss += y[j] * y[j]; }
                if (arr < 2) {
                    float rr = rsqrtf(red16(ss) + 1e-6f);
                    if (arr == 0) rr *= 0.08838834764831845f;
#pragma unroll
                    for (int j = 0; j < 8; ++j) y[j] *= rr;
                }
                bf16_t* dst = (arr == 0) ? GQ : (arr == 1) ? GK : GV;
                *(u32x4*)(dst + (size_t)t * 512 + lane * 8) = (u32x4){pk2(y[0], y[1]), pk2(y[2], y[3]), pk2(y[4], y[5]), pk2(y[6], y[7])};
                xr[arr][0] = xr[arr][1]; xr[arr][1] = xr[arr][2]; xr[arr][2] = xr[arr][3];
            }
            if (lane < 4) BETA[(size_t)t * 4 + lane] = sigmoidf_(gate);
            else if (lane < 8) { const int h = lane - 4; GLOG[(size_t)t * 4 + h] = -expf(a_log[h]) * softplusf_(gate + dt_bias[h]); }
        }
#undef PE_LOAD
    }
}

__device__ __forceinline__ void phase_prep_odd(const bf16_t* PROJ, const float* ROPES, bf16_t* SQ, bf16_t* SK, const Ctx& c) {
    const int lane = c.lane;
    const int hh = lane >> 2, j = lane & 3;
    const bool isq = lane < 32, act = lane < 40;
    const int scol = isq ? 1544 + hh * 64 + j * 8 : 2056 + (hh - 8) * 64 + j * 8;
    const float sc = isq ? 0.18033688011112042f : 1.f;
    for (int t = c.bid * 4 + c.wid; t < T; t += c.nblk * 4) {
        if (act) {
            const bf16_t* pr = PROJ + (size_t)t * NPAD + scol;
            const u32x4 r1 = *(const u32x4*)pr, r2 = *(const u32x4*)(pr + 32);
            const float* rp = ROPES + ((size_t)t * 32 + j * 8) * 2;
            const f32x4 t0 = *(const f32x4*)rp, t1 = *(const f32x4*)(rp + 4), t2 = *(const f32x4*)(rp + 8), t3 = *(const f32x4*)(rp + 12);
            const float cs[8] = {t0[0], t0[2], t1[0], t1[2], t2[0], t2[2], t3[0], t3[2]}, sn[8] = {t0[1], t0[3], t1[1], t1[3], t2[1], t2[3], t3[1], t3[3]};
            float x1[8], x2[8], o1[8], o2[8]; unpack8(r1, x1); unpack8(r2, x2);
#pragma unroll
            for (int k = 0; k < 8; ++k) { o1[k] = (x1[k] * cs[k] - x2[k] * sn[k]) * sc; o2[k] = (x2[k] * cs[k] + x1[k] * sn[k]) * sc; }
            bf16_t* d = isq ? SQ + (size_t)t * 512 + hh * 64 + j * 8 : SK + (size_t)t * 128 + (hh - 8) * 64 + j * 8;
            *(u32x4*)d = (u32x4){pk2(o1[0], o1[1]), pk2(o1[2], o1[3]), pk2(o1[4], o1[5]), pk2(o1[6], o1[7])};
            *(u32x4*)(d + 32) = (u32x4){pk2(o2[0], o2[1]), pk2(o2[2], o2[3]), pk2(o2[4], o2[5]), pk2(o2[6], o2[7])};
        }
    }
}

__device__ __forceinline__ int next_unit(unsigned* ctr, const Ctx& c) {
    volatile int* su = (volatile int*)(c.smem0 + LDS_BLK + 16);
    __syncthreads();
    if (c.tid0 == 0) *su = (int)atomicAdd(ctr, 1u);
    __syncthreads();
    return *su * 2 + c.half;
}

typedef float f32x16 __attribute__((ext_vector_type(16)));
typedef short s16x4 __attribute__((ext_vector_type(4)));
#define MFMA32(a, b, c) __builtin_amdgcn_mfma_f32_32x32x16_bf16((a), (b), (c), 0, 0, 0)
template <int S_> __device__ __forceinline__ bf16x8 pack_step(const f32x16& x) {
    u32x4 p;
    asm volatile("v_cvt_pk_bf16_f32 %0, %4, %5\n\tv_cvt_pk_bf16_f32 %1, %6, %7\n\tv_cvt_pk_bf16_f32 %2, %8, %9\n\tv_cvt_pk_bf16_f32 %3, %10, %11\n\ts_nop 1"
                 : "=&v"(p[0]), "=&v"(p[1]), "=&v"(p[2]), "=&v"(p[3])
                 : "v"(x[8 * S_]), "v"(x[8 * S_ + 1]), "v"(x[8 * S_ + 2]), "v"(x[8 * S_ + 3]), "v"(x[8 * S_ + 4]), "v"(x[8 * S_ + 5]), "v"(x[8 * S_ + 6]), "v"(x[8 * S_ + 7]));
    return __builtin_bit_cast(bf16x8, p);
}
template <int S_> __device__ __forceinline__ bf16x8 pack_step_m(const f32x16& x) {
    u32x4 p;
    asm volatile("s_nop 15\n\tv_cvt_pk_bf16_f32 %0, %4, %5\n\tv_cvt_pk_bf16_f32 %1, %6, %7\n\tv_cvt_pk_bf16_f32 %2, %8, %9\n\tv_cvt_pk_bf16_f32 %3, %10, %11\n\ts_nop 1"
                 : "=&v"(p[0]), "=&v"(p[1]), "=&v"(p[2]), "=&v"(p[3])
                 : "v"(x[8 * S_]), "v"(x[8 * S_ + 1]), "v"(x[8 * S_ + 2]), "v"(x[8 * S_ + 3]), "v"(x[8 * S_ + 4]), "v"(x[8 * S_ + 5]), "v"(x[8 * S_ + 6]), "v"(x[8 * S_ + 7]));
    return __builtin_bit_cast(bf16x8, p);
}
constexpr int ATT_VB = 64 * 128;

template <int NKS, bool WIN>
__device__ __forceinline__ void attn_unit(const bf16_t* Qp, int q_ld, const bf16_t* K1, int k1_ld, const bf16_t* K2, int k2_ld, const bf16_t* Vp, int v_ld,
                          bf16_t* Op, int o_ld, int Q0_in, float sink_l2, const Ctx& c) {
    constexpr int KB = NKS * 2 * 1024, BUF = KB + ATT_VB;
    const int Q0 = __builtin_amdgcn_readfirstlane(Q0_in);
    const int lane = c.lane, r = lane & 31, h = lane >> 5;
    const int wid = __builtin_amdgcn_readfirstlane(c.wid);
    const int q0w = Q0 + wid * 32;
    unsigned char* smem = c.smem;
    bf16x8 qf[NKS];
#pragma unroll
    for (int ks = 0; ks < NKS; ++ks) qf[ks] = *(const bf16x8*)(Qp + (size_t)(q0w + r) * q_ld + ks * 16 + h * 8);
    f32x16 o0, o1;
#pragma unroll
    for (int i = 0; i < 16; ++i) { o0[i] = 0.f; o1[i] = 0.f; }
    float m = WIN ? sink_l2 : -1e30f, l = (WIN && h == 0) ? 1.f : 0.f;
    const int kt_lo = WIN ? ((Q0 >> 6) - 2 < 0 ? 0 : (Q0 >> 6) - 2) : 0, kt_hi = (Q0 >> 6) + 1;
    const char* K1u = uniform_ptr(K1); const char* K2u = uniform_ptr(K2); const char* Vu = uniform_ptr(Vp);
    const unsigned lds0 = (unsigned)__builtin_amdgcn_readfirstlane((int)(unsigned)(size_t)smem);
    const unsigned voK1 = (unsigned)(lane * k1_ld * 2), voK2 = (unsigned)(lane * k2_ld * 2), voV = (unsigned)(((lane >> 3) * v_ld + (lane & 7) * 8) * 2);
#define ATT_STAGE(kt_, buf_) do { const unsigned bp = lds0 + (unsigned)((buf_) * BUF); const size_t kb = (size_t)(kt_) * 64; \
        _Pragma("unroll") for (int i = 0; i < (NKS * 2) / 4; ++i) { const int ch = wid + 4 * i; \
            if (ch < 8) glds16s(K1u + (kb * k1_ld + ch * 8) * 2, voK1, bp + ch * 1024); \
            else glds16s(K2u + (kb * k2_ld + (ch - 8) * 8) * 2, voK2, bp + ch * 1024); } \
        _Pragma("unroll") for (int i = 0; i < 2; ++i) { const int j = wid + 4 * i; \
            glds16s(Vu + ((kb + 8 * j) * v_ld) * 2, voV, bp + KB + j * 1024); } } while (0)
    ATT_STAGE(kt_lo, 0);
    const int i16 = lane & 15;
    const unsigned vlane = (unsigned)((4 * h + (i16 >> 2)) * 128 + 32 * ((lane >> 4) & 1) + 8 * (i16 & 3));
    for (int kt = kt_lo; kt <= kt_hi; ++kt) {
        const int cur = (kt - kt_lo) & 1;
        asm volatile("s_waitcnt vmcnt(0)" ::: "memory");
        __syncthreads();
        if (kt < kt_hi) ATT_STAGE(kt + 1, cur ^ 1);
        const int k0 = kt * 64;
        const bool active = (k0 <= q0w + 31) && (!WIN || (k0 + 63 > q0w - 128));
        if (active) {
            const LAS unsigned char* Kt = (const LAS unsigned char*)smem + cur * BUF + h * 1024 + r * 16;
            f32x16 x0, x1;
            const f32x16 zero16 = (f32x16){0.f, 0.f, 0.f, 0.f, 0.f, 0.f, 0.f, 0.f, 0.f, 0.f, 0.f, 0.f, 0.f, 0.f, 0.f, 0.f};
#pragma unroll
            for (int ks = 0; ks < NKS; ++ks) {
                const bf16x8 kf0 = *(const LAS bf16x8*)(Kt + ks * 2048);
                const bf16x8 kf1 = *(const LAS bf16x8*)(Kt + ks * 2048 + 512);
                x0 = MFMA32(kf0, qf[ks], ks == 0 ? zero16 : x0); x1 = MFMA32(kf1, qf[ks], ks == 0 ? zero16 : x1);
            }
            const bool need_mask = (k0 + 63 > q0w) || (WIN && (k0 <= q0w + 31 - 128));
            if (need_mask) {
                const int q = q0w + r;
#pragma unroll
                for (int i = 0; i < 16; ++i) {
                    const int key = k0 + (i & 3) + 8 * (i >> 2) + 4 * h;
                    const bool v0 = (key <= q) && (!WIN || key > q - 128);
                    const bool v1 = (key + 32 <= q) && (!WIN || key + 32 > q - 128);
                    x0[i] = v0 ? x0[i] : -INFINITY; x1[i] = v1 ? x1[i] : -INFINITY;
                }
            }
            float mx = fmaxf(x0[0], x1[0]);
#pragma unroll
            for (int i = 1; i < 16; ++i) mx = fmaxf(mx, fmaxf(x0[i], x1[i]));
            mx = fmaxf(mx, shfl_xor_(mx, 32));
            const float mn = fmaxf(m, mx);
            const float alpha = __builtin_amdgcn_exp2f(m - mn);
            m = mn;
            float ps = 0.f;
#pragma unroll
            for (int i = 0; i < 16; ++i) { x0[i] = __builtin_amdgcn_exp2f(x0[i] - mn); x1[i] = __builtin_amdgcn_exp2f(x1[i] - mn); ps += x0[i] + x1[i]; }
            l = l * alpha + ps;
            o0 *= alpha; o1 *= alpha;
            const unsigned vbase = (unsigned)(size_t)(smem + cur * BUF + KB) + vlane;
#pragma unroll
            for (int t = 0; t < 2; ++t) {
                s16x4 l00, h00, l01, h01, l10, h10, l11, h11;
                const unsigned va = vbase + t * 4096;
                asm volatile("ds_read_b64_tr_b16 %0, %8\n\t"
                             "ds_read_b64_tr_b16 %1, %8 offset:1024\n\t"
                             "ds_read_b64_tr_b16 %2, %8 offset:64\n\t"
                             "ds_read_b64_tr_b16 %3, %8 offset:1088\n\t"
                             "ds_read_b64_tr_b16 %4, %8 offset:2048\n\t"
                             "ds_read_b64_tr_b16 %5, %8 offset:3072\n\t"
                             "ds_read_b64_tr_b16 %6, %8 offset:2112\n\t"
                             "ds_read_b64_tr_b16 %7, %8 offset:3136\n\t"
                             "s_waitcnt lgkmcnt(0)"
                             : "=&v"(l00), "=&v"(h00), "=&v"(l01), "=&v"(h01), "=&v"(l10), "=&v"(h10), "=&v"(l11), "=&v"(h11) : "v"(va) : "memory");
                const bf16x8 v00 = __builtin_shufflevector(l00, h00, 0, 1, 2, 3, 4, 5, 6, 7), v01 = __builtin_shufflevector(l01, h01, 0, 1, 2, 3, 4, 5, 6, 7);
                const bf16x8 v10 = __builtin_shufflevector(l10, h10, 0, 1, 2, 3, 4, 5, 6, 7), v11 = __builtin_shufflevector(l11, h11, 0, 1, 2, 3, 4, 5, 6, 7);
                const bf16x8 pb0 = (t == 0) ? pack_step<0>(x0) : pack_step<0>(x1);
                const bf16x8 pb1 = (t == 0) ? pack_step<1>(x0) : pack_step<1>(x1);
                o0 = MFMA32(v00, pb0, o0); o1 = MFMA32(v01, pb0, o1);
                o0 = MFMA32(v10, pb1, o0); o1 = MFMA32(v11, pb1, o1);
            }
        }
    }
#undef ATT_STAGE
    l += shfl_xor_(l, 32);
    const float inv = 1.f / l;
    bf16_t* orow = Op + (size_t)(q0w + r) * o_ld + 4 * h;
#pragma unroll
    for (int g = 0; g < 4; ++g) {
        *(u32x2*)(orow + 8 * g) = (u32x2){pk2(o0[4 * g] * inv, o0[4 * g + 1] * inv), pk2(o0[4 * g + 2] * inv, o0[4 * g + 3] * inv)};
        *(u32x2*)(orow + 32 + 8 * g) = (u32x2){pk2(o1[4 * g] * inv, o1[4 * g + 1] * inv), pk2(o1[4 * g + 2] * inv, o1[4 * g + 3] * inv)};
    }
}

constexpr size_t MLC_DC = 0, MLC_CS = 33554432, MLC_DN = MLC_CS + 16777216, MLC_NS = MLC_DN + 262144, MLC_ML = MLC_NS + 262144, MLC_BE = MLC_ML + 4096, MLC_MS = MLC_BE + 4096;

__device__ __forceinline__ float scan_add64(float v, int lane) {
#pragma unroll
    for (int o = 1; o < 64; o <<= 1) { const float x = shfl_up_(v, o); if (lane >= o) v += x; }
    return v;
}
__device__ __forceinline__ float scan_max64(float v, int lane) {
#pragma unroll
    for (int o = 1; o < 64; o <<= 1) { const float x = shfl_up_(v, o); if (lane >= o) v = fmaxf(v, x); }
    return v;
}
__device__ __forceinline__ float wave_max(float v) {
#pragma unroll
    for (int o = 32; o > 0; o >>= 1) v = fmaxf(v, shfl_xor_(v, o));
    return v;
}

__device__ __forceinline__ void mlc_passA(int u, const bf16_t* PROJ, const float* GATES, const float* b_i, const float* b_f, unsigned char* YB, const Ctx& c) {
    const int bh = u >> 5, b = bh >> 2, h = bh & 3;
    const size_t t0 = (size_t)b * SEQ + (u & 31) * 64;
    unsigned char* smem = c.smem;
    float* saL = (float*)(smem + 24576);
    const int lane = c.lane, wid = __builtin_amdgcn_readfirstlane(c.wid);
#pragma unroll
    for (int i = 0; i < 4; ++i) { const int j = wid * 4 + i;
        glds16(PROJ + (t0 + 4 * j + (lane >> 4)) * NPAD + 512 + h * 128 + (lane & 15) * 8, smem + 8192 + j * 1024 + lane * 16); }
    if (wid == 0) {
        const float ip = GATES[(t0 + lane) * 8 + h] + b_i[h], lf = -softplusf_(-(GATES[(t0 + lane) * 8 + 4 + h] + b_f[h]));
        const float bc = scan_add64(lf, lane), bend = shfl_c_(bc, 63);
        const float a = bend - bc + ip, mloc = wave_max(a);
        saL[lane] = expf(a - mloc) * 0.125f;
        if (lane == 0) { ((float*)(YB + MLC_ML))[u] = mloc; ((float*)(YB + MLC_BE))[u] = bend; }
    }
    __syncthreads();
#pragma unroll
    for (int i = 0; i < 2; ++i) {
        const int idx = c.tid + 256 * i, row = idx >> 3, chk = idx & 7;
        const u32x4 r = *(const u32x4*)(PROJ + (t0 + row) * NPAD + 256 + h * 64 + chk * 8);
        float f[8]; unpack8(r, f);
        const float s = saL[row];
        *(u32x4*)(smem + row * 128 + chk * 16) = (u32x4){pk2(f[0] * s, f[1] * s), pk2(f[2] * s, f[3] * s), pk2(f[4] * s, f[5] * s), pk2(f[6] * s, f[7] * s)};
    }
    asm volatile("s_waitcnt vmcnt(0)" ::: "memory");
    __syncthreads();
    const int h5 = lane >> 5, r = lane & 31, i16 = lane & 15, q4 = i16 >> 2, p = i16 & 3, blk = (lane >> 4) & 1;
    const int dkt = wid & 1, dvp = wid >> 1;
    const unsigned kaddr = (unsigned)(size_t)smem + (unsigned)((8 * h5 + q4) * 128 + dkt * 64 + 32 * blk + 8 * p);
    const unsigned vaddr = (unsigned)(size_t)smem + 8192u + (unsigned)((8 * h5 + q4) * 256 + dvp * 128 + 32 * blk + 8 * p);
    f32x16 a0, a1;
#pragma unroll
    for (int i = 0; i < 16; ++i) { a0[i] = 0.f; a1[i] = 0.f; }
#pragma unroll
    for (int st = 0; st < 4; ++st) {
        s16x4 kl, kh, v0l, v0h, v1l, v1h;
        const unsigned ka = kaddr + st * 2048, va = vaddr + st * 4096;
        asm volatile("ds_read_b64_tr_b16 %0, %6\n\t"
                     "ds_read_b64_tr_b16 %1, %6 offset:512\n\t"
                     "ds_read_b64_tr_b16 %2, %7\n\t"
                     "ds_read_b64_tr_b16 %3, %7 offset:1024\n\t"
                     "ds_read_b64_tr_b16 %4, %7 offset:64\n\t"
                     "ds_read_b64_tr_b16 %5, %7 offset:1088\n\t"
                     "s_waitcnt lgkmcnt(0)"
                     : "=&v"(kl), "=&v"(kh), "=&v"(v0l), "=&v"(v0h), "=&v"(v1l), "=&v"(v1h) : "v"(ka), "v"(va) : "memory");
        const bf16x8 kf = __builtin_shufflevector(kl, kh, 0, 1, 2, 3, 4, 5, 6, 7);
        const bf16x8 vf0 = __builtin_shufflevector(v0l, v0h, 0, 1, 2, 3, 4, 5, 6, 7), vf1 = __builtin_shufflevector(v1l, v1h, 0, 1, 2, 3, 4, 5, 6, 7);
        a0 = MFMA32(kf, vf0, a0); a1 = MFMA32(kf, vf1, a1);
    }
    float* DC = (float*)(YB + MLC_DC) + (size_t)u * 8192;
#pragma unroll
    for (int i = 0; i < 16; ++i) {
        const int dk = dkt * 32 + (i & 3) + 8 * (i >> 2) + 4 * h5;
        DC[dk * 128 + dvp * 64 + r] = a0[i]; DC[dk * 128 + dvp * 64 + 32 + r] = a1[i];
    }
    if (c.tid < 64) {
        float s = 0.f;
#pragma unroll 8
        for (int t = 0; t < 64; ++t) s += bf2f(((const bf16_t*)smem)[t * 64 + c.tid]);
        ((float*)(YB + MLC_DN))[(size_t)u * 64 + c.tid] = s;
    }
}

__device__ __forceinline__ void mlc_passB(int u, unsigned char* YB, const Ctx& c) {
    const int bh = u >> 3, sl = u & 7;
    const float* ML = (const float*)(YB + MLC_ML) + bh * 32; const float* BE = (const float*)(YB + MLC_BE) + bh * 32;
    const float* DC = (const float*)(YB + MLC_DC) + (size_t)bh * 32 * 8192 + sl * 1024 + c.tid * 4;
    bf16_t* CS = (bf16_t*)(YB + MLC_CS) + (size_t)bh * 32 * 8192 + sl * 1024 + c.tid * 4;
    const float* DN = (const float*)(YB + MLC_DN) + (size_t)bh * 32 * 64; float* NS = (float*)(YB + MLC_NS) + (size_t)bh * 32 * 64; float* MS = (float*)(YB + MLC_MS) + bh * 32;
    f32x4 C4 = (f32x4){0.f, 0.f, 0.f, 0.f}; float nv = 0.f, m = 0.f;
    const bool do_n = (sl == 0) && (c.tid < 64);
#pragma unroll 1
    for (int nb = 0; nb < 32; nb += 16) {
        f32x4 d[16]; float be[16], ml[16], dn[16];
#pragma unroll
        for (int i = 0; i < 16; ++i) { d[i] = *(const f32x4*)(DC + (size_t)(nb + i) * 8192); be[i] = BE[nb + i]; ml[i] = ML[nb + i]; dn[i] = do_n ? DN[(nb + i) * 64 + c.tid] : 0.f; }
#pragma unroll
        for (int i = 0; i < 16; ++i) {
            const int n = nb + i;
            *(u32x2*)(CS + (size_t)n * 8192) = (u32x2){pk2(C4[0], C4[1]), pk2(C4[2], C4[3])};
            if (do_n) NS[n * 64 + c.tid] = nv;
            if (sl == 0 && c.tid == 0) MS[n] = m;
            const float mn = fmaxf(be[i] + m, ml[i]), keep = expf(be[i] + m - mn), g = expf(ml[i] - mn);
            m = mn;
            C4 = C4 * keep + d[i] * g;
            nv = nv * keep + dn[i] * g;
        }
    }
}

__device__ __forceinline__ void mlc_passC(int u, const bf16_t* PROJ, const float* GATES, const float* b_i, const float* b_f, const unsigned char* YB,
                                          const float* gain  , bf16_t* MIXO, const Ctx& c) {
    const int bh = u >> 5, b = bh >> 2, h = bh & 3;
    const size_t t0 = (size_t)b * SEQ + (u & 31) * 64;
    unsigned char* smem = c.smem;
    float* csL = (float*)(smem + 32768); float* pmL = (float*)(smem + 33024); float* bcL = (float*)(smem + 33280); float* nnL = (float*)(smem + 33536); float* sqL = (float*)(smem + 33792);
    const int lane = c.lane, wid = __builtin_amdgcn_readfirstlane(c.wid);
    const bf16_t* CS = (const bf16_t*)(YB + MLC_CS) + (size_t)u * 8192;
#pragma unroll
    for (int i = 0; i < 4; ++i) { const int j = wid * 4 + i;
        glds16(PROJ + (t0 + 4 * j + (lane >> 4)) * NPAD + 512 + h * 128 + (lane & 15) * 8, smem + j * 1024 + lane * 16);
        glds16(CS + (4 * j + (lane >> 4)) * 128 + (lane & 15) * 8, smem + 16384 + j * 1024 + lane * 16); }
    const int h5 = lane >> 5, r = lane & 31, i16 = lane & 15, q4 = i16 >> 2, p = i16 & 3, blk = (lane >> 4) & 1;
    const int th = wid & 1, dvh = wid >> 1;
    const int t = th * 32 + r;
    const float m_n = ((const float*)(YB + MLC_MS))[u];
    bf16x8 qf[4], kfa[4], kfb[4];
#pragma unroll
    for (int ks = 0; ks < 4; ++ks) {
        qf[ks] = *(const bf16x8*)(PROJ + (t0 + t) * NPAD + h * 64 + ks * 16 + h5 * 8);
        kfa[ks] = *(const bf16x8*)(PROJ + (t0 + r) * NPAD + 256 + h * 64 + ks * 16 + h5 * 8);
        kfb[ks] = *(const bf16x8*)(PROJ + (t0 + 32 + r) * NPAD + 256 + h * 64 + ks * 16 + h5 * 8);
    }
    const bf16_t* grow = PROJ + (t0 + t) * NPAD + 1032 + h * 128 + dvh * 64 + 4 * h5;
    const float* gn = gain + h * 128 + dvh * 64 + 4 * h5;
    u32x2 zrp[2][4]; f32x4 gvp[2][4];
#pragma unroll
    for (int d = 0; d < 2; ++d)
#pragma unroll
        for (int g = 0; g < 4; ++g) { zrp[d][g] = *(const u32x2*)(grow + d * 32 + 8 * g); gvp[d][g] = *(const f32x4*)(gn + d * 32 + 8 * g); }
    float bcl = 0.f;
    if (wid == 0) {
        const float ip = GATES[(t0 + lane) * 8 + h] + b_i[h], lf = -softplusf_(-(GATES[(t0 + lane) * 8 + 4 + h] + b_f[h]));
        bcl = scan_add64(lf, lane);
        const float cs = ip - bcl;
        csL[lane] = cs; pmL[lane] = scan_max64(cs, lane);
        nnL[lane] = ((const float*)(YB + MLC_NS))[(size_t)u * 64 + lane];
        bcL[lane] = bcl;
    }
    asm volatile("s_waitcnt vmcnt(0)" ::: "memory");
    __syncthreads();
    const float Mt = fmaxf(m_n, pmL[t]), w_inter = __expf(m_n - Mt), em = __expf(-(bcL[t] + Mt));
    float qn = 0.f; bf16x8 qw[4];
#pragma unroll
    for (int ks = 0; ks < 4; ++ks) {
        const u32x4 raw = __builtin_bit_cast(u32x4, qf[ks]); float f[8]; unpack8(raw, f);
#pragma unroll
        for (int j = 0; j < 8; ++j) qn += f[j] * nnL[ks * 16 + h5 * 8 + j];
        qw[ks] = __builtin_bit_cast(bf16x8, (u32x4){pk2(f[0] * w_inter, f[1] * w_inter), pk2(f[2] * w_inter, f[3] * w_inter), pk2(f[4] * w_inter, f[5] * w_inter), pk2(f[6] * w_inter, f[7] * w_inter)});
    }
    qn += shfl_xor_(qn, 32);
    f32x16 x0, x1;
#pragma unroll
    for (int i = 0; i < 16; ++i) { x0[i] = 0.f; x1[i] = 0.f; }
#pragma unroll
    for (int ks = 0; ks < 4; ++ks) {
        x0 = MFMA32(kfa[ks], qf[ks], x0);
        if (th) x1 = MFMA32(kfb[ks], qf[ks], x1);
    }
    float ps = 0.f;
#pragma unroll
    for (int i = 0; i < 16; ++i) {
        const int s = (i & 3) + 8 * (i >> 2) + 4 * h5;
        const float w0 = (s <= t) ? __expf(csL[s] - Mt) * 0.125f : 0.f;
        x0[i] *= w0; ps += x0[i];
        if (th) { const float w1 = (s <= r) ? __expf(csL[32 + s] - Mt) * 0.125f : 0.f; x1[i] *= w1; ps += x1[i]; }
    }
    ps += shfl_xor_(ps, 32);
    const float den = w_inter * qn + ps;
    f32x16 o0, o1;
#pragma unroll
    for (int i = 0; i < 16; ++i) { o0[i] = 0.f; o1[i] = 0.f; }
    {
        const unsigned vb = (unsigned)(size_t)smem + (unsigned)((4 * h5 + q4) * 256 + dvh * 128 + 32 * blk + 8 * p);
#pragma unroll
        for (int st = 0; st < 2; ++st) {
            if (st == 0 || th) {
                s16x4 l00, h00, l01, h01, l10, h10, l11, h11;
                const unsigned va = vb + st * 8192;
                asm volatile("ds_read_b64_tr_b16 %0, %8\n\t"
                             "ds_read_b64_tr_b16 %1, %8 offset:2048\n\t"
                             "ds_read_b64_tr_b16 %2, %8 offset:64\n\t"
                             "ds_read_b64_tr_b16 %3, %8 offset:2112\n\t"
                             "ds_read_b64_tr_b16 %4, %8 offset:4096\n\t"
                             "ds_read_b64_tr_b16 %5, %8 offset:6144\n\t"
                             "ds_read_b64_tr_b16 %6, %8 offset:4160\n\t"
                             "ds_read_b64_tr_b16 %7, %8 offset:6208\n\t"
                             "s_waitcnt lgkmcnt(0)"
                             : "=&v"(l00), "=&v"(h00), "=&v"(l01), "=&v"(h01), "=&v"(l10), "=&v"(h10), "=&v"(l11), "=&v"(h11) : "v"(va) : "memory");
                const bf16x8 v00 = __builtin_shufflevector(l00, h00, 0, 1, 2, 3, 4, 5, 6, 7), v01 = __builtin_shufflevector(l01, h01, 0, 1, 2, 3, 4, 5, 6, 7);
                const bf16x8 v10 = __builtin_shufflevector(l10, h10, 0, 1, 2, 3, 4, 5, 6, 7), v11 = __builtin_shufflevector(l11, h11, 0, 1, 2, 3, 4, 5, 6, 7);
                const bf16x8 pb0 = (st == 0) ? pack_step<0>(x0) : pack_step<0>(x1);
                const bf16x8 pb1 = (st == 0) ? pack_step<1>(x0) : pack_step<1>(x1);
                o0 = MFMA32(v00, pb0, o0); o1 = MFMA32(v01, pb0, o1);
                o0 = MFMA32(v10, pb1, o0); o1 = MFMA32(v11, pb1, o1);
            }
        }
    }
    {
        const unsigned cb = (unsigned)(size_t)smem + 16384u + (unsigned)((8 * h5 + q4) * 256 + dvh * 128 + 32 * blk + 8 * p);
#pragma unroll
        for (int kp = 0; kp < 2; ++kp) {
            s16x4 l00, h00, l01, h01, l10, h10, l11, h11;
            const unsigned ca = cb + kp * 8192;
            asm volatile("ds_read_b64_tr_b16 %0, %8\n\t"
                         "ds_read_b64_tr_b16 %1, %8 offset:1024\n\t"
                         "ds_read_b64_tr_b16 %2, %8 offset:64\n\t"
                         "ds_read_b64_tr_b16 %3, %8 offset:1088\n\t"
                         "ds_read_b64_tr_b16 %4, %8 offset:4096\n\t"
                         "ds_read_b64_tr_b16 %5, %8 offset:5120\n\t"
                         "ds_read_b64_tr_b16 %6, %8 offset:4160\n\t"
                         "ds_read_b64_tr_b16 %7, %8 offset:5184\n\t"
                         "s_waitcnt lgkmcnt(0)"
                         : "=&v"(l00), "=&v"(h00), "=&v"(l01), "=&v"(h01), "=&v"(l10), "=&v"(h10), "=&v"(l11), "=&v"(h11) : "v"(ca) : "memory");
            const bf16x8 c00 = __builtin_shufflevector(l00, h00, 0, 1, 2, 3, 4, 5, 6, 7), c01 = __builtin_shufflevector(l01, h01, 0, 1, 2, 3, 4, 5, 6, 7);
            const bf16x8 c10 = __builtin_shufflevector(l10, h10, 0, 1, 2, 3, 4, 5, 6, 7), c11 = __builtin_shufflevector(l11, h11, 0, 1, 2, 3, 4, 5, 6, 7);
            o0 = MFMA32(c00, qw[2 * kp], o0); o1 = MFMA32(c01, qw[2 * kp], o1);
            o0 = MFMA32(c10, qw[2 * kp + 1], o0); o1 = MFMA32(c11, qw[2 * kp + 1], o1);
        }
    }
    const float inv = __builtin_amdgcn_rcpf(fmaxf(fabsf(den), em));
    float ss = 0.f;
#pragma unroll
    for (int i = 0; i < 16; ++i) { o0[i] *= inv; o1[i] *= inv; ss += o0[i] * o0[i] + o1[i] * o1[i]; }
    ss += shfl_xor_(ss, 32);
    if (h5 == 0) sqL[wid * 32 + r] = ss;
    __syncthreads();
    const float rr = rsqrtf((sqL[th * 32 + r] + sqL[(th + 2) * 32 + r]) * (1.f / 128.f) + 1e-6f);
    bf16_t* orow = MIXO + (t0 + t) * 1024 + h * 128 + dvh * 64 + 4 * h5;
#pragma unroll
    for (int d = 0; d < 2; ++d)
#pragma unroll
        for (int g = 0; g < 4; ++g) {
            const u32x2 zr = zrp[d][g];
            const f32x4 gv = gvp[d][g];
            const float z0 = bflo(zr.x), z1 = bfhi(zr.x), z2 = bflo(zr.y), z3 = bfhi(zr.y);
            const float y0 = (d ? o1[4 * g] : o0[4 * g]) * rr * gv[0] * sigmoidf_(z0), y1 = (d ? o1[4 * g + 1] : o0[4 * g + 1]) * rr * gv[1] * sigmoidf_(z1);
            const float y2 = (d ? o1[4 * g + 2] : o0[4 * g + 2]) * rr * gv[2] * sigmoidf_(z2), y3 = (d ? o1[4 * g + 3] : o0[4 * g + 3]) * rr * gv[3] * sigmoidf_(z3);
            *(u32x2*)(orow + d * 32 + 8 * g) = (u32x2){pk2(y0, y1), pk2(y2, y3)};
        }
}

constexpr size_t GD_WN = 0, GD_UU = GD_WN + (size_t)1024 * 16384, GD_KGT = GD_UU + (size_t)1024 * 16384, GD_QG = GD_KGT + (size_t)1024 * 16384,
                 GD_AT = GD_QG + (size_t)1024 * 16384, GD_GL = GD_AT + (size_t)1024 * 8192, GD_END = GD_GL + 4096;
static_assert(GD_END <= (size_t)MAXROWS * 256 * 2, "GDN chunk records must fit the HBUF region");

__device__ __forceinline__ void gdc_passA(int u, const bf16_t* GQ, const bf16_t* GK, const bf16_t* GV, const float* BETA, const float* GLOG, unsigned char* HB, const Ctx& c) {
    const int bh = u >> 5, b = bh >> 2, h = bh & 3;
    const size_t t0 = (size_t)b * SEQ + (u & 31) * 64;
    unsigned char* smem = c.smem;
    float* Lm = (float*)(smem + 49152);
    float* GA = (float*)(smem + 65536 + 64); float* BT = GA + 64; float* EG = BT + 64; float* EK = EG + 64;
    const int lane = c.lane, wid = __builtin_amdgcn_readfirstlane(c.wid);
    const int h5 = lane >> 5, r = lane & 31;
    if (wid == 0) {
        const float g = GLOG[(t0 + lane) * 4 + h];
        const float G = scan_add64(g, lane), Gl = shfl_c_(G, 63);
        GA[lane] = G; BT[lane] = BETA[(t0 + lane) * 4 + h]; EG[lane] = expf(G); EK[lane] = expf(Gl - G);
        if (lane == 0) ((float*)(HB + GD_GL))[u] = expf(Gl);
    }
    __syncthreads();
    if (wid < 3) {
        const int it = (wid + 1) >> 1, jt = wid >> 1;
        f32x16 dl, da;
#pragma unroll
        for (int i = 0; i < 16; ++i) { dl[i] = 0.f; da[i] = 0.f; }
#pragma unroll
        for (int ks = 0; ks < 8; ++ks) {
            const bf16x8 ki = *(const bf16x8*)(GK + (t0 + 32 * it + r) * 512 + h * 128 + ks * 16 + h5 * 8);
            const bf16x8 kj = *(const bf16x8*)(GK + (t0 + 32 * jt + r) * 512 + h * 128 + ks * 16 + h5 * 8);
            const bf16x8 qi = *(const bf16x8*)(GQ + (t0 + 32 * it + r) * 512 + h * 128 + ks * 16 + h5 * 8);
            dl = MFMA32(ki, kj, dl); da = MFMA32(qi, kj, da);
        }
        const int j = 32 * jt + r; const float Gj = GA[j];
        bf16_t* AT = (bf16_t*)(HB + GD_AT) + (size_t)u * 4096;
#pragma unroll
        for (int i = 0; i < 16; ++i) {
            const int ii = 32 * it + (i & 3) + 8 * (i >> 2) + 4 * h5;
            const float dec = __expf(GA[ii] - Gj);
            Lm[ii * 64 + j] = (j < ii) ? dl[i] * BT[ii] * dec : 0.f;
            AT[ii * 64 + j] = (bf16_t)f2bf((j <= ii) ? da[i] * dec : 0.f);
        }
        if (wid == 0) {
#pragma unroll
            for (int i = 0; i < 16; ++i) { const int ii = (i & 3) + 8 * (i >> 2) + 4 * h5; Lm[ii * 64 + 32 + r] = 0.f; AT[ii * 64 + 32 + r] = 0; }
        }
    }
    __syncthreads();
    if (wid == 0) {
        float Tc[64];
#pragma unroll
        for (int i = 0; i < 64; ++i) {
            float s = (i == lane) ? 1.f : 0.f;
#pragma unroll
            for (int k = 0; k < i; ++k) s -= Lm[i * 64 + k] * Tc[k];
            Tc[i] = s;
        }
        bf16_t* Tm = (bf16_t*)Lm;
#pragma unroll
        for (int i = 0; i < 64; ++i) Tm[i * 64 + lane] = (bf16_t)f2bf(Tc[i]);
    } else {
        const int t3 = c.tid - 64;
        for (int idx = t3; idx < 4096; idx += 192) {
            const int arr = idx >> 10, rem = idx & 1023, row = rem >> 4, chk = rem & 15;
            const bf16_t* sp = ((arr == 1) ? GV : (arr == 3) ? GQ : GK) + (t0 + row) * 512 + h * 128 + chk * 8;
            const u32x4 raw = *(const u32x4*)sp; float f[8]; unpack8(raw, f);
            const float sc = (arr == 0) ? BT[row] * EG[row] : (arr == 1) ? BT[row] : (arr == 2) ? EK[row] : EG[row];
            const u32x4 o = (u32x4){pk2(f[0] * sc, f[1] * sc), pk2(f[2] * sc, f[3] * sc), pk2(f[4] * sc, f[5] * sc), pk2(f[6] * sc, f[7] * sc)};
            if (arr < 3) *(u32x4*)(smem + arr * 16384 + row * 256 + chk * 16) = o;
            else *(u32x4*)((bf16_t*)(HB + GD_QG) + (size_t)u * 8192 + row * 128 + chk * 8) = o;
        }
    }
    __syncthreads();
    {
        const int i16 = lane & 15, q4 = i16 >> 2, p = i16 & 3, blk = (lane >> 4) & 1;
        const unsigned char* Tm = smem + 49152;
        f32x16 u0, u1, w0, w1;
#pragma unroll
        for (int i = 0; i < 16; ++i) { u0[i] = 0.f; u1[i] = 0.f; w0[i] = 0.f; w1[i] = 0.f; }
        const unsigned ib = (unsigned)(size_t)smem + (unsigned)((8 * h5 + q4) * 256 + wid * 64 + 32 * blk + 8 * p);
#pragma unroll
        for (int ks = 0; ks < 4; ++ks) {
            s16x4 kl, kh, vl, vh;
            const unsigned ia = ib + ks * 4096;
            asm volatile("ds_read_b64_tr_b16 %0, %4\n\t"
                         "ds_read_b64_tr_b16 %1, %4 offset:1024\n\t"
                         "ds_read_b64_tr_b16 %2, %4 offset:16384\n\t"
                         "ds_read_b64_tr_b16 %3, %4 offset:17408\n\t"
                         "s_waitcnt lgkmcnt(0)"
                         : "=&v"(kl), "=&v"(kh), "=&v"(vl), "=&v"(vh) : "v"(ia) : "memory");
            const bf16x8 kb = __builtin_shufflevector(kl, kh, 0, 1, 2, 3, 4, 5, 6, 7), vb = __builtin_shufflevector(vl, vh, 0, 1, 2, 3, 4, 5, 6, 7);
            const bf16x8 t1 = *(const bf16x8*)(Tm + (32 + r) * 128 + ks * 32 + h5 * 16);
            w1 = MFMA32(t1, kb, w1); u1 = MFMA32(t1, vb, u1);
            if (ks < 2) { const bf16x8 tt0 = *(const bf16x8*)(Tm + r * 128 + ks * 32 + h5 * 16); w0 = MFMA32(tt0, kb, w0); u0 = MFMA32(tt0, vb, u0); }
        }
        bf16_t* WN = (bf16_t*)(HB + GD_WN) + (size_t)u * 8192; bf16_t* UU = (bf16_t*)(HB + GD_UU) + (size_t)u * 8192;
#pragma unroll
        for (int i = 0; i < 16; ++i) {
            const int s = (i & 3) + 8 * (i >> 2) + 4 * h5;
            WN[s * 128 + wid * 32 + r] = (bf16_t)f2bf(-w0[i]); WN[(32 + s) * 128 + wid * 32 + r] = (bf16_t)f2bf(-w1[i]);
        }
        {
            u32x4* up = (u32x4*)(UU + (size_t)(wid * 64 + lane) * 32);
            up[0] = (u32x4){pk2(u0[0], u0[1]), pk2(u0[2], u0[3]), pk2(u0[4], u0[5]), pk2(u0[6], u0[7])};
            up[1] = (u32x4){pk2(u0[8], u0[9]), pk2(u0[10], u0[11]), pk2(u0[12], u0[13]), pk2(u0[14], u0[15])};
            up[2] = (u32x4){pk2(u1[0], u1[1]), pk2(u1[2], u1[3]), pk2(u1[4], u1[5]), pk2(u1[6], u1[7])};
            up[3] = (u32x4){pk2(u1[8], u1[9]), pk2(u1[10], u1[11]), pk2(u1[12], u1[13]), pk2(u1[14], u1[15])};
        }
        bf16_t* KGT = (bf16_t*)(HB + GD_KGT) + (size_t)u * 8192;
        const int gq = lane >> 4;
        const unsigned kb0 = (unsigned)(size_t)smem + 32768u + (unsigned)(q4 * 256 + gq * 32 + 8 * p);
#pragma unroll
        for (int it2 = 0; it2 < 8; ++it2) {
            const int job = wid * 8 + it2, s0 = (job & 15) * 4, dkb = (job >> 4) * 64;
            s16x4 v;
            const unsigned ad = kb0 + s0 * 256 + dkb * 2;
            asm volatile("ds_read_b64_tr_b16 %0, %1\n\ts_waitcnt lgkmcnt(0)" : "=&v"(v) : "v"(ad) : "memory");
            *(s16x4*)(KGT + (size_t)(dkb + gq * 16 + i16) * 64 + s0) = v;
        }
    }
}

constexpr size_t GC_ST = 0, GC_VT = (size_t)1024 * 32768;
__device__ __forceinline__ void gdc_passB(int bh, const unsigned char* HB, unsigned char* YB, const Ctx& c) {
    const int lane = c.lane, wid = __builtin_amdgcn_readfirstlane(c.wid);
    const int h5 = lane >> 5, r = lane & 31;
    unsigned char* smem = c.smem;
    f32x16 S0, S1, S2, S3;
#pragma unroll
    for (int i = 0; i < 16; ++i) { S0[i] = 0.f; S1[i] = 0.f; S2[i] = 0.f; S3[i] = 0.f; }
    const size_t u0 = (size_t)bh * 32;
#define GB_STAGE(n_, p_) do { const bf16_t* wn_ = (const bf16_t*)(HB + GD_WN) + (u0 + (n_)) * 8192; const bf16_t* kg_ = (const bf16_t*)(HB + GD_KGT) + (u0 + (n_)) * 8192; \
        unsigned char* bp_ = smem + (p_) * 32768; \
        _Pragma("unroll") for (int i = 0; i < 4; ++i) { const int jj = wid * 4 + i, row = 4 * jj + (lane >> 4), ch = (lane & 15) ^ (row & 15); \
            glds16(wn_ + row * 128 + ch * 8, bp_ + jj * 1024 + lane * 16); } \
        _Pragma("unroll") for (int i = 0; i < 4; ++i) { const int jj = wid * 4 + i, row = 8 * jj + (lane >> 3), ch = (lane & 7) ^ ((row >> 1) & 7); \
            glds16(kg_ + row * 64 + ch * 8, bp_ + 16384 + jj * 1024 + lane * 16); } } while (0)
#define LD128(base_, R_, ks_) __builtin_shufflevector(*(const s16x4*)((base_) + (R_) * 256 + (((2 * (ks_)) ^ (rl & 15)) << 4) + 8 * hl), \
                                                      *(const s16x4*)((base_) + (R_) * 256 + (((2 * (ks_) + 1) ^ (rl & 15)) << 4) + 8 * hl), 0, 1, 2, 3, 4, 5, 6, 7)
#define LD64(base_, R_, k2_) __builtin_shufflevector(*(const s16x4*)((base_) + (R_) * 128 + (((2 * (k2_)) ^ ((rl >> 1) & 7)) << 4) + 8 * hl), \
                                                     *(const s16x4*)((base_) + (R_) * 128 + (((2 * (k2_) + 1) ^ ((rl >> 1) & 7)) << 4) + 8 * hl), 0, 1, 2, 3, 4, 5, 6, 7)
    u32x4 uu[4];
#define GB_LOADU(n_) do { const u32x4* up_ = (const u32x4*)((const bf16_t*)(HB + GD_UU) + (u0 + (n_)) * 8192 + (size_t)(wid * 64 + lane) * 32); \
        uu[0] = up_[0]; uu[1] = up_[1]; uu[2] = up_[2]; uu[3] = up_[3]; } while (0)
    float* glL = (float*)(smem + 65536 + 64);
    __syncthreads();
    if (c.tid < 32) glL[c.tid] = ((const float*)(HB + GD_GL))[u0 + c.tid];
    GB_STAGE(0, 0);
    GB_LOADU(0);
#pragma unroll 1
    for (int n2 = 0; n2 < 16; ++n2) {
#pragma unroll
        for (int PBUF = 0; PBUF < 2; ++PBUF) {
        const int n = 2 * n2 + PBUF;
        const float gl = glL[n];
        if (n == 0) asm volatile("s_waitcnt vmcnt(0)" ::: "memory"); else asm volatile("s_waitcnt vmcnt(24)" ::: "memory");
        asm volatile("s_waitcnt lgkmcnt(0)" ::: "memory"); __builtin_amdgcn_s_barrier(); asm volatile("" ::: "memory");
        f32x16 v0, v1;
#pragma unroll
        for (int q = 0; q < 2; ++q) {
            const u32x4 a = uu[q], bq = uu[2 + q];
            v0[8 * q + 0] = bflo(a.x); v0[8 * q + 1] = bfhi(a.x); v0[8 * q + 2] = bflo(a.y); v0[8 * q + 3] = bfhi(a.y);
            v0[8 * q + 4] = bflo(a.z); v0[8 * q + 5] = bfhi(a.z); v0[8 * q + 6] = bflo(a.w); v0[8 * q + 7] = bfhi(a.w);
            v1[8 * q + 0] = bflo(bq.x); v1[8 * q + 1] = bfhi(bq.x); v1[8 * q + 2] = bflo(bq.y); v1[8 * q + 3] = bfhi(bq.y);
            v1[8 * q + 4] = bflo(bq.z); v1[8 * q + 5] = bfhi(bq.z); v1[8 * q + 6] = bflo(bq.w); v1[8 * q + 7] = bfhi(bq.w);
        }
        if (n + 1 < 32) { GB_STAGE(n + 1, (PBUF ^ 1)); GB_LOADU(n + 1); }
        int rl = r, hl = h5; asm volatile("" : "+v"(rl), "+v"(hl));
        const unsigned char* WNb = smem + PBUF * 32768; const unsigned char* KGb = WNb + 16384;
        {
            bf16_t* st = (bf16_t*)(YB + GC_ST) + (u0 + n) * 16384 + (size_t)h5 * 512 + (size_t)(wid * 32 + r) * 4;
#define ST_TILE(SX, dt_) do { _Pragma("unroll") for (int g = 0; g < 4; ++g) \
                *(u32x2*)(st + ((dt_) * 8 + 2 * g) * 512) = (u32x2){cvt_pk(SX[4 * g], SX[4 * g + 1]), cvt_pk(SX[4 * g + 2], SX[4 * g + 3])}; } while (0)
            ST_TILE(S0, 0); ST_TILE(S1, 1); ST_TILE(S2, 2); ST_TILE(S3, 3);
#undef ST_TILE
        }
        {
            bf16x8 fa0, fb0, fa1, fb1, fa2, fb2;
#define LDV(FA, FB, ks_) do { FA = LD128(WNb, rl, ks_); FB = LD128(WNb, 32 + rl, ks_); } while (0)
#define MMV(SX, HF, FA, FB) do { const bf16x8 sbk = pack_step<HF>(SX); v0 = MFMA32(FA, sbk, v0); v1 = MFMA32(FB, sbk, v1); } while (0)
            LDV(fa0, fb0, 0); LDV(fa1, fb1, 1); LDV(fa2, fb2, 2);
            MMV(S0, 0, fa0, fb0); LDV(fa0, fb0, 3);
            MMV(S0, 1, fa1, fb1); LDV(fa1, fb1, 4);
            MMV(S1, 0, fa2, fb2); LDV(fa2, fb2, 5);
            MMV(S1, 1, fa0, fb0); LDV(fa0, fb0, 6);
            MMV(S2, 0, fa1, fb1); LDV(fa1, fb1, 7);
            MMV(S2, 1, fa2, fb2);
            MMV(S3, 0, fa0, fb0);
            MMV(S3, 1, fa1, fb1);
#undef LDV
#undef MMV
        }
        const bf16x8 vb0 = pack_step_m<0>(v0), vb1 = pack_step_m<1>(v0), vb2 = pack_step_m<0>(v1), vb3 = pack_step_m<1>(v1);
        {
            bf16_t* vt = (bf16_t*)(YB + GC_VT) + (u0 + n) * 8192 + (size_t)h5 * 512 + (size_t)(wid * 32 + r) * 4;
            const u32x4 p0 = __builtin_bit_cast(u32x4, vb0), p1 = __builtin_bit_cast(u32x4, vb1), p2 = __builtin_bit_cast(u32x4, vb2), p3 = __builtin_bit_cast(u32x4, vb3);
            *(u32x2*)(vt + 0 * 512) = (u32x2){p0.x, p0.y};  *(u32x2*)(vt + 2 * 512) = (u32x2){p0.z, p0.w};
            *(u32x2*)(vt + 4 * 512) = (u32x2){p1.x, p1.y};  *(u32x2*)(vt + 6 * 512) = (u32x2){p1.z, p1.w};
            *(u32x2*)(vt + 8 * 512) = (u32x2){p2.x, p2.y};  *(u32x2*)(vt + 10 * 512) = (u32x2){p2.z, p2.w};
            *(u32x2*)(vt + 12 * 512) = (u32x2){p3.x, p3.y}; *(u32x2*)(vt + 14 * 512) = (u32x2){p3.z, p3.w};
        }
        asm volatile("" ::: "memory"); asm volatile("" : "+v"(rl), "+v"(hl));
        S0 *= gl; S1 *= gl; S2 *= gl; S3 *= gl;
        {
            bf16x8 g0, g1, g2;
            g0 = LD64(KGb, rl, 0); g1 = LD64(KGb, rl, 1); g2 = LD64(KGb, rl, 2);
            S0 = MFMA32(g0, vb0, S0); g0 = LD64(KGb, rl, 3);
            S0 = MFMA32(g1, vb1, S0); g1 = LD64(KGb, 32 + rl, 0);
            S0 = MFMA32(g2, vb2, S0); g2 = LD64(KGb, 32 + rl, 1);
            S0 = MFMA32(g0, vb3, S0); g0 = LD64(KGb, 32 + rl, 2);
            S1 = MFMA32(g1, vb0, S1); g1 = LD64(KGb, 32 + rl, 3);
            S1 = MFMA32(g2, vb1, S1); g2 = LD64(KGb, 64 + rl, 0);
            S1 = MFMA32(g0, vb2, S1); g0 = LD64(KGb, 64 + rl, 1);
            S1 = MFMA32(g1, vb3, S1); g1 = LD64(KGb, 64 + rl, 2);
            S2 = MFMA32(g2, vb0, S2); g2 = LD64(KGb, 64 + rl, 3);
            S2 = MFMA32(g0, vb1, S2); g0 = LD64(KGb, 96 + rl, 0);
            S2 = MFMA32(g1, vb2, S2); g1 = LD64(KGb, 96 + rl, 1);
            S2 = MFMA32(g2, vb3, S2); g2 = LD64(KGb, 96 + rl, 2);
            S3 = MFMA32(g0, vb0, S3); g0 = LD64(KGb, 96 + rl, 3);
            S3 = MFMA32(g1, vb1, S3);
            S3 = MFMA32(g2, vb2, S3);
            S3 = MFMA32(g0, vb3, S3);
        }
        }
    }
#undef GB_STAGE
#undef LD128
#undef LD64
#undef GB_LOADU
}

__device__ __forceinline__ void gdc_passB_idle() {
    __syncthreads();
    for (int n = 0; n < 32; ++n) { asm volatile("" ::: "memory"); __builtin_amdgcn_s_barrier(); asm volatile("" ::: "memory"); }
}

__device__ __forceinline__ void gdc_passC(int u, const unsigned char* HB, const unsigned char* YB, const bf16_t* PROJ, const float* gnorm, bf16_t* MIXO, const Ctx& c) {
    const int bh = u >> 5, b = bh >> 2, h = bh & 3;
    const size_t t0 = (size_t)b * SEQ + (u & 31) * 64;
    const int lane = c.lane, wid = __builtin_amdgcn_readfirstlane(c.wid);
    const int h5 = lane >> 5, r = lane & 31;
    float* sqL = (float*)c.smem;
    const bf16_t* ST = (const bf16_t*)(YB + GC_ST) + (size_t)u * 16384 + (size_t)(2 * h5) * 512 + (size_t)(wid * 32 + r) * 4;
    const bf16_t* VT = (const bf16_t*)(YB + GC_VT) + (size_t)u * 8192 + (size_t)(2 * h5) * 512 + (size_t)(wid * 32 + r) * 4;
    const bf16_t* QG = (const bf16_t*)(HB + GD_QG) + (size_t)u * 8192 + (size_t)r * 128 + 8 * h5;
    const bf16_t* AT = (const bf16_t*)(HB + GD_AT) + (size_t)u * 4096 + (size_t)r * 64 + 8 * h5;
    f32x16 o0, o1;
#pragma unroll
    for (int i = 0; i < 16; ++i) { o0[i] = 0.f; o1[i] = 0.f; }
#pragma unroll
    for (int ks = 0; ks < 8; ++ks) {
        const bf16x8 sa = __builtin_shufflevector(*(const s16x4*)(ST + (4 * ks) * 512), *(const s16x4*)(ST + (4 * ks + 1) * 512), 0, 1, 2, 3, 4, 5, 6, 7);
        const bf16x8 q0 = *(const bf16x8*)(QG + ks * 16), q1 = *(const bf16x8*)(QG + 32 * 128 + ks * 16);
        o0 = MFMA32(sa, q0, o0); o1 = MFMA32(sa, q1, o1);
        if (ks == 3) asm volatile("" ::: "memory");
    }
#pragma unroll
    for (int k2 = 0; k2 < 4; ++k2) {
        const bf16x8 va = __builtin_shufflevector(*(const s16x4*)(VT + (4 * k2) * 512), *(const s16x4*)(VT + (4 * k2 + 1) * 512), 0, 1, 2, 3, 4, 5, 6, 7);
        const bf16x8 a1 = *(const bf16x8*)(AT + 32 * 64 + k2 * 16);
        o1 = MFMA32(va, a1, o1);
        if (k2 < 2) { const bf16x8 a0 = *(const bf16x8*)(AT + k2 * 16); o0 = MFMA32(va, a0, o0); }
    }
    float s0 = 0.f, s1 = 0.f;
#pragma unroll
    for (int i = 0; i < 16; ++i) { s0 += o0[i] * o0[i]; s1 += o1[i] * o1[i]; }
    s0 += shfl_xor_(s0, 32); s1 += shfl_xor_(s1, 32);
    __syncthreads();
    if (h5 == 0) { sqL[wid * 64 + r] = s0; sqL[wid * 64 + 32 + r] = s1; }
    __syncthreads();
    const float rr0 = rsqrtf((sqL[r] + sqL[64 + r] + sqL[128 + r] + sqL[192 + r]) * (1.f / 128.f) + 1e-6f);
    const float rr1 = rsqrtf((sqL[32 + r] + sqL[96 + r] + sqL[160 + r] + sqL[224 + r]) * (1.f / 128.f) + 1e-6f);
#pragma unroll
    for (int tt = 0; tt < 2; ++tt) {
        const size_t t = t0 + tt * 32 + r;
        const bf16_t* zrow = PROJ + t * NPAD + 1960 + h * 128 + wid * 32 + 4 * h5;
        const float* gn = gnorm + wid * 32 + 4 * h5;
        bf16_t* orow = MIXO + t * 1024 + 512 + h * 128 + wid * 32 + 4 * h5;
        const float rr = tt ? rr1 : rr0;
#pragma unroll
        for (int g = 0; g < 4; ++g) {
            const u32x2 zr = *(const u32x2*)(zrow + 8 * g);
            const f32x4 gv = *(const f32x4*)(gn + 8 * g);
            const float z0 = bflo(zr.x), z1 = bfhi(zr.x), z2 = bflo(zr.y), z3 = bfhi(zr.y);
            const float y0 = (tt ? o1[4 * g] : o0[4 * g]) * rr * gv[0] * siluf_(z0), y1 = (tt ? o1[4 * g + 1] : o0[4 * g + 1]) * rr * gv[1] * siluf_(z1);
            const float y2 = (tt ? o1[4 * g + 2] : o0[4 * g + 2]) * rr * gv[2] * siluf_(z2), y3 = (tt ? o1[4 * g + 3] : o0[4 * g + 3]) * rr * gv[3] * siluf_(z3);
            *(u32x2*)(orow + 8 * g) = (u32x2){pk2(y0, y1), pk2(y2, y3)};
        }
    }
}

__device__ __forceinline__ void phase_post(const float* OG, const bf16_t* PROJ, const float* gain, bool odd, bf16_t* MIXO, const Ctx& c) {
    const int lane = c.lane;
    const int gcol = odd ? 1032 : 1960, ocol = odd ? 0 : 512;
    for (int t = c.bid * 4 + c.wid; t < T; t += c.nblk * 4) {
        const f32x4 a0 = *(const f32x4*)(OG + (size_t)t * 512 + lane * 8), a1 = *(const f32x4*)(OG + (size_t)t * 512 + lane * 8 + 4);
        float ss = (a0[0] * a0[0] + a0[1] * a0[1]) + (a0[2] * a0[2] + a0[3] * a0[3]) + (a1[0] * a1[0] + a1[1] * a1[1]) + (a1[2] * a1[2] + a1[3] * a1[3]);
        ss = red16(ss);
        const float rr = rsqrtf(ss * (1.f / 128.f) + 1e-6f);
        const u32x4 zr = *(const u32x4*)(PROJ + (size_t)t * NPAD + gcol + lane * 8);
        float z[8]; unpack8(zr, z);
        const int gi = odd ? lane * 8 : (lane & 15) * 8;
        const f32x4 g0 = *(const f32x4*)(gain + gi), g1 = *(const f32x4*)(gain + gi + 4);
        float y[8];
#pragma unroll
        for (int j = 0; j < 4; ++j) {
            const float ga = odd ? sigmoidf_(z[j]) : siluf_(z[j]), gb = odd ? sigmoidf_(z[4 + j]) : siluf_(z[4 + j]);
            y[j] = a0[j] * rr * g0[j] * ga; y[4 + j] = a1[j] * rr * g1[j] * gb;
        }
        *(u32x4*)(MIXO + (size_t)t * 1024 + ocol + lane * 8) = (u32x4){pk2(y[0], y[1]), pk2(y[2], y[3]), pk2(y[4], y[5]), pk2(y[6], y[7])};
    }
}

__global__ void __launch_bounds__(512, 2) fwd(Args a) {
    extern __shared__ __attribute__((aligned(16))) unsigned char smem[];
    Ctx c;
    const int wave_s = __builtin_amdgcn_readfirstlane((int)threadIdx.x >> 6);
#define SET_CTX(cx) do { int t_ = (wave_s << 6) | lane_id_v(); cx.tid0 = t_; cx.half = t_ >> 8; cx.tid = t_ & 255; cx.lane = t_ & 63; cx.wid = (t_ >> 6) & 3; \
        cx.wr = cx.wid >> 1; cx.wc = cx.wid & 1; cx.fr = cx.lane & 15; cx.fq = cx.lane >> 4; cx.bid = blockIdx.x * 2 + cx.half; cx.nblk = gridDim.x * 2; \
        cx.smem0 = smem; cx.smem = smem + cx.half * HALF_LDS; } while (0)
    SET_CTX(c);
#define PH_CTX() SET_CTX(c)
    unsigned char* const ws_base = a.ws;
    const void* const* const ain_base = (const void* const*)__builtin_amdgcn_kernarg_segment_ptr();
    unsigned* ctl = (unsigned*)(ws_base + WS_CTL);
    volatile LAS unsigned* xbw = (volatile LAS unsigned*)(smem + LDS_BLK);
    if (c.tid0 < 8) xbw[c.tid0] = 0u;
    __syncthreads();
    XcdBarrier bar; bar.bar = ctl; bar.x = 0; bar.st = xbw; bar.wave = wave_s;
    if (a.use_bar) bar = xcd_barrier_post(ctl, xbw, c.tid0);
#if ONE_LAUNCH
    const int hi = NPH;
#define IN(k) true
#else
    const int lo = a.ph_lo, hi = a.ph_hi;
#define IN(k) (lo <= (k) && (k) < hi)
#endif
#define PH(k) if (IN(k)) { PH_CTX(); unsigned char* ws = ws_base; const void* const* ain = ain_base; asm volatile("" : "+s"(ws), "+s"(ain));
#define UNIT_CTX() Ctx cu; SET_CTX(cu)
#define SEAM(k) do { if ((k) + 1 < hi) xcd_barrier(bar); } while (0)

#define XBF ((bf16_t*)(ws + WS_XBF))
#define X1 ((float*)(ws + WS_X1))
#define PROJ ((bf16_t*)(ws + U_PROJ))
#define GATES ((float*)(ws + U_GATES))
#define MIXO ((bf16_t*)(ws + U_MIXO))
#define YBUF ((float*)(ws + U_YBUF))
#define ROPEM ((const float*)(ws + WS_ROPEM))
#define ROPES ((const float*)(ws + WS_ROPES))
#define XRES ((layer == 0) ? (const float*)ain[0] : (const float*)a.out)
#define CNT (ctl + CW_CNT + layer * 128)
#define WIN ((const bf16_t*)(ws + WS_WIN) + (size_t)layer * WIN_ELEMS)
#define WOUT ((const bf16_t*)(ws + WS_WOUT) + (size_t)layer * WOUT_ELEMS)

    PH(0) for (int rep = 0; rep < REP_PRO; ++rep) phase_prologue(a, c); SEAM(0); }

    for (int layer = 0; layer < 4; ++layer) {
        const int pb = 1 + layer * PPL;
#if !ONE_LAUNCH
        if (pb >= hi || pb + PPL <= lo) continue;
#endif
        const int jj = layer >> 1;
        const bool odd = (layer & 1) != 0;

        PH(pb + 0) {
                DenseSched S{T / 256, NPAD / 256, 1024, (int)blockIdx.x, (int)gridDim.x};
                EpiIn E{PROJ, GATES, odd ? 1024 : 1952};
                g8::phase<1, false, false>(smem, (const char*)XBF, (const char*)WIN, 1024, S, E, c.tid0);
            }
            SEAM(pb + 0); }
        PH(pb + 1) for (int rp = 0; rp < ((REP_PHASE == 1) ? 2 : 1); ++rp) { if (rp) xcd_barrier(bar);
            if (!odd) phase_prep_even(PROJ, GATES, (const float*)ain[3] + jj * 256, (const float*)ain[5] + jj * 128, (const float*)ain[7] + jj * 4 * 1536,
                                      (const float*)ain[8] + jj * 4, (const float*)ain[9] + jj * 4, ROPEM,
                                      (bf16_t*)(ws + U_CQ), (bf16_t*)(ws + U_CKV), (bf16_t*)(ws + U_KROPE), (bf16_t*)(ws + U_GQ), (bf16_t*)(ws + U_GK), (bf16_t*)(ws + U_GV),
                                      (float*)(ws + U_BETA), (float*)(ws + U_GLOG), c);
            else {
                phase_prep_odd(PROJ, ROPES, (bf16_t*)(ws + U_QF), (bf16_t*)(ws + U_KN), c);
                unsigned* ctr = ctl + CW_WORK + pb + 1 + 64 * rp;
                for (;;) {
                    const int u = next_unit(ctr, c); UNIT_CTX();
                    if (u >= 1024) break;
                    mlc_passA(u, PROJ, GATES, (const float*)ain[13] + jj * 4, (const float*)ain[14] + jj * 4, (unsigned char*)YBUF, cu);
                }
            }
            }
            SEAM(pb + 1);
        }
        PH(pb + 2) for (int rp = 0; rp < ((REP_PHASE == 2) ? 2 : 1); ++rp) { if (rp) xcd_barrier(bar);
            unsigned* ctr = ctl + CW_WORK + pb + 2 + 64 * rp;
            if (!odd) {
                for (;;) {
                    const int u = next_unit(ctr, c); UNIT_CTX();
                    if (u >= 1024 + MLAUP_TILES) break;
                    if (u < 1024) gdc_passA(u, (const bf16_t*)(ws + U_GQ), (const bf16_t*)(ws + U_GK), (const bf16_t*)(ws + U_GV), (const float*)(ws + U_BETA),
                                            (const float*)(ws + U_GLOG), ws + WS_HBUF, cu);
                    else mla_up_tile(u - 1024, (const bf16_t*)(ws + U_CQ), (const bf16_t*)(ws + WS_WQB) + (size_t)jj * WQB_ELEMS, (const bf16_t*)(ws + U_CKV),
                                     (const bf16_t*)(ws + WS_WKVB) + (size_t)jj * WKVB_ELEMS, ROPEM, (bf16_t*)(ws + U_QF), (bf16_t*)(ws + U_KN), (bf16_t*)(ws + U_VV), cu);
                }
            } else {
                for (;;) {
                    const int u = next_unit(ctr, c); UNIT_CTX();
                    if (u >= 256 + 1024) break;
                    if (u < 256) mlc_passB(u, (unsigned char*)YBUF, cu);
                    else {
                        const int v = u - 256, hq = v & 7, n = (v >> 3) & 15, b = v >> 7, kvh = hq >> 2;
                        const size_t tb = (size_t)b * SEQ;
                        attn_unit<4, true>((const bf16_t*)(ws + U_QF) + tb * 512 + hq * 64, 512, (const bf16_t*)(ws + U_KN) + tb * 128 + kvh * 64, 128,
                                           (const bf16_t*)(ws + U_KN), 0, PROJ + tb * NPAD + 2184 + kvh * 64, NPAD,
                                           MIXO + tb * 1024 + 512 + hq * 64, 1024, n * 128, ((const float*)ain[16])[jj * 8 + hq] * 1.4426950408889634f, cu);
                    }
                }
            }
            }
            SEAM(pb + 2);
        }
        PH(pb + 3) for (int rp = 0; rp < ((REP_PHASE == 3) ? 2 : 1); ++rp) { if (rp) xcd_barrier(bar);
            unsigned* ctr = ctl + CW_WORK + pb + 3 + 64 * rp;
            if (!odd) {
                for (;;) {
                    const int u = next_unit(ctr, c); UNIT_CTX();
                    if (u >= 64 + 1024) break;
                    if (rp > 0 && ((REP_ONLY == 1 && u >= 64) || (REP_ONLY == 2 && u < 64))) continue;
                    if (u < 64) { if ((u & 1) == 0) gdc_passB(u >> 1, ws + WS_HBUF, (unsigned char*)YBUF, cu); else gdc_passB_idle(); }
                    else {
                        const int v = u - 64, qb = 15 - (v >> 6), bh = v & 63, b = bh >> 3, hh = bh & 7;
                        const size_t tb = (size_t)b * SEQ;
                        attn_unit<6, false>((const bf16_t*)(ws + U_QF) + tb * 768 + hh * 96, 768, (const bf16_t*)(ws + U_KN) + tb * 512 + hh * 64, 512,
                                            (const bf16_t*)(ws + U_KROPE) + tb * 32, 32, (const bf16_t*)(ws + U_VV) + tb * 512 + hh * 64, 512,
                                            MIXO + tb * 1024 + hh * 64, 1024, qb * 128, 0.f, cu);
                    }
                }
            } else {
                for (;;) {
                    const int u = next_unit(ctr, c); UNIT_CTX();
                    if (u >= 1024) break;
                    mlc_passC(u, PROJ, GATES, (const float*)ain[13] + jj * 4, (const float*)ain[14] + jj * 4, (const unsigned char*)YBUF, (const float*)ain[15] + jj * 512, MIXO, cu);
                }
            }
            }
            SEAM(pb + 3);
        }
        PH(pb + 4) for (int rp = 0; rp < ((REP_PHASE == 4) ? 2 : 1); ++rp) { if (rp) xcd_barrier(bar);
            if (!odd) {
                unsigned* ctr = ctl + CW_WORK + pb + 4 + 64 * rp;
                for (;;) {
                    const int u = next_unit(ctr, c); UNIT_CTX();
                    if (u >= 1024) break;
                    gdc_passC(u, ws + WS_HBUF, (const unsigned char*)YBUF, PROJ, (const float*)ain[10] + jj * 128, MIXO, cu);
                }
            }
            }
            if (!odd) SEAM(pb + 4);
        }
        PH(pb + 5) {
                DenseSched S{T / 256, 4, 1024, (int)blockIdx.x, (int)gridDim.x};
                EpiOut E{XBF, (bf16_t*)YBUF};
                g8::phase<1, false, false>(smem, (const char*)MIXO, (const char*)WOUT, 1024, S, E, c.tid0);
            }
            SEAM(pb + 5); }
#if FUSE_LNROUTE
        PH(pb + 6) phase_lnroute((const bf16_t*)YBUF, (const float*)ain[18] + layer * 1024, (const float*)ain[19] + layer * 1024, XBF, (const bf16_t*)(ws + WS_WRT) + (size_t)layer * WRT_ELEMS,
                                 (const float*)ain[21] + layer * 64, CNT, (int*)(ws + WS_LTOK), (float*)(ws + WS_LW), (int*)(ws + WS_ASG), (float*)(ws + WS_ASGW), c); SEAM(pb + 8); }
#else
        PH(pb + 6) for (int rep = 0; rep < REP_TOK; ++rep) phase_ln1((const bf16_t*)YBUF, (const float*)ain[18] + layer * 1024, (const float*)ain[19] + layer * 1024, XBF, c); SEAM(pb + 6); }
        PH(pb + 7) for (int rep = 0; rep < REP_GEMM; ++rep) phase_router(XBF, (const bf16_t*)(ws + WS_WRT) + (size_t)layer * WRT_ELEMS, (float*)(ws + WS_LOG), c); SEAM(pb + 7); }
        PH(pb + 8) phase_route((const float*)(ws + WS_LOG), (const float*)ain[21] + layer * 64, CNT, (int*)(ws + WS_LTOK), (float*)(ws + WS_LW), (int*)(ws + WS_ASG), (float*)(ws + WS_ASGW), c); SEAM(pb + 8); }
#endif
        PH(pb + 9) {
                int* bst8 = (int*)(smem + LDS_BLK + 64); int* eb8 = bst8 + 256;
                build_block_table(CNT, bst8, c);
                for (int rb = c.tid0; rb < bst8[65]; rb += NT) { int e = 0; for (int q = 1; q < 65; ++q) e += (bst8[q] <= rb) ? 1 : 0; eb8[rb] = e; }
                __syncthreads();
                MoeSchedG S{__builtin_amdgcn_readfirstlane(bst8[65]), (int)blockIdx.x, (int)gridDim.x, eb8, bst8, (const int*)(ws + WS_LTOK)};
#if MOE2_F8
                EpiMoe1F8 E{(unsigned char*)(ws + WS_HBUF)};
#else
                EpiMoe1 E{(bf16_t*)(ws + WS_HBUF)};
#endif
                g8::phase<0, true, false>(smem, (const char*)XBF, (const char*)((const bf16_t*)(ws + WS_WGU) + (size_t)layer * 65 * WGU_ELEMS), 1024, S, E, c.tid0);
            }
            SEAM(pb + 9); }
        PH(pb + 10)
#if MOE2_G8
            {
                int* bst8 = (int*)(smem + LDS_BLK + 64); int* eb8 = bst8 + 256;
                build_block_table(CNT, bst8, c);
                for (int rb = c.tid0; rb < bst8[65]; rb += NT) { int e = 0; for (int q = 1; q < 65; ++q) e += (bst8[q] <= rb) ? 1 : 0; eb8[rb] = e; }
                __syncthreads();
                MoeSched S{__builtin_amdgcn_readfirstlane(bst8[65]), 4, (int)blockIdx.x, (int)gridDim.x, eb8};
#if Y_FP8
                EpiMoe2F8 E{(unsigned char*)(ws + U_Y)};
#else
                EpiMoe2 E{(bf16_t*)(ws + U_Y)};
#endif
                #if MOE2_F8
                g8::phase<2, false, true>(smem, (const char*)(ws + WS_HBUF), (const char*)(ws + WS_WDN) + (size_t)layer * 65 * WDN_ELEMS, 128, S, E, c.tid0);
#else
                g8::phase<(Y_FP8 ? 2 : 1), false, false>(smem, (const char*)(ws + WS_HBUF), (const char*)((const bf16_t*)(ws + WS_WDN) + (size_t)layer * 65 * WDN_ELEMS), 256, S, E, c.tid0);
#endif
            }
#else
            phase_moe2((const bf16_t*)(ws + WS_HBUF), (const bf16_t*)(ws + WS_WDN) + (size_t)layer * 65 * WDN_ELEMS, CNT, (bf16_t*)(ws + U_Y), c);
#endif
            SEAM(pb + 10); }
        PH(pb + 11)
#if Y_FP8
            if (layer == 3) phase_combine8<true>((const unsigned char*)(ws + U_Y), (const int*)(ws + WS_ASG), (const float*)(ws + WS_ASGW), CNT, (const float*)ain[28] + layer * 1024, (const float*)ain[29] + layer * 1024, a.out, XBF, c);
            else phase_combine8<false>((const unsigned char*)(ws + U_Y), (const int*)(ws + WS_ASG), (const float*)(ws + WS_ASGW), CNT, (const float*)ain[28] + layer * 1024, (const float*)ain[29] + layer * 1024, a.out, XBF, c);
            SEAM(pb + 11); }
#else
            if (layer == 3) phase_combine<true>((const bf16_t*)(ws + U_Y), (const int*)(ws + WS_ASG), (const float*)(ws + WS_ASGW), CNT, (const float*)ain[28] + layer * 1024, (const float*)ain[29] + layer * 1024, a.out, XBF, c);
            else phase_combine<false>((const bf16_t*)(ws + U_Y), (const int*)(ws + WS_ASG), (const float*)(ws + WS_ASGW), CNT, (const float*)ain[28] + layer * 1024, (const float*)ain[29] + layer * 1024, a.out, XBF, c);
            SEAM(pb + 11); }
#endif
    }
#undef IN
#undef XBF
#undef X1
#undef PROJ
#undef GATES
#undef MIXO
#undef YBUF
#undef ROPEM
#undef ROPES
#undef XRES
#undef CNT
#undef WIN
#undef WOUT
#undef PH
#undef PH_CTX
#undef UNIT_CTX
#undef SEAM
}

extern "C" void kernel_launch(void* const* d_in, const int* in_sizes, int n_in, void* d_out, int out_size, void* d_ws, size_t ws_size, hipStream_t stream) {
    static int grid = 0;
    if (grid == 0) {
        if (n_in != 30 || out_size != T * 1024 || ws_size < WS_END) {
            fprintf(stderr, "kernel_launch: unexpected shapes (n_in %d, out %d, ws %zu < %zu)\n", n_in, out_size, ws_size, (size_t)WS_END);
            grid = -1; return;
        }
        int dev = 0, cus = 0, per_cu = 0;
        (void)hipGetDevice(&dev);
        (void)hipDeviceGetAttribute(&cus, hipDeviceAttributeMultiprocessorCount, dev);
        (void)hipFuncSetAttribute((const void*)fwd, hipFuncAttributeMaxDynamicSharedMemorySize, DYN_LDS);
        (void)hipOccupancyMaxActiveBlocksPerMultiprocessor(&per_cu, (const void*)fwd, NT, DYN_LDS);
        (void)hipGetLastError();
        if (per_cu < 1) per_cu = 1;
        grid = cus;
    }
    if (grid < 0) return;
    (void)hipMemsetAsync((char*)d_ws + WS_CTL, 0, CTL_BYTES, stream);
    Args a{};
    for (int i = 0; i < 30; ++i) a.in[i] = d_in[i];
    a.out = (float*)d_out; a.ws = (unsigned char*)d_ws; a.pad = 0;
#if ONE_LAUNCH
    a.ph_lo = 0; a.ph_hi = NPH; a.use_bar = 1;
    hipLaunchKernelGGL(fwd, dim3(grid), dim3(NT), DYN_LDS, stream, a);
#else
    for (int p = 0; p < NPH; ++p) {
        a.ph_lo = p; a.ph_hi = p + 1; a.use_bar = 0;
        hipLaunchKernelGGL(fwd, dim3(grid), dim3(NT), DYN_LDS, stream, a);
    }
#endif
}
```

```cpp
#include <hip/hip_runtime.h>
#include <stdint.h>
#include <stdio.h>

#define REP_GEMM 1
#define REP_PHASE 0
#define REP_G0 1
#define REP_G1 1
#define REP_G2 1
#define REP_G3 1
#define REP_MIX 1
#define REP_ONLY 0
#define REP_CMB 1
#define REP_PRO 1
#define REP_TOK 1
#define MOE2_G8 1
#ifndef G8_SPLIT
#define G8_SPLIT 0
#endif
#ifndef FUSE_LNROUTE
#define FUSE_LNROUTE 1
#endif
#ifndef Y_FP8
#define Y_FP8 1
#endif
#ifndef MOE2_F8
#define MOE2_F8 1
#endif
#ifndef MOE1_F8
#define MOE1_F8 1
#endif
#ifndef ONE_LAUNCH
#define ONE_LAUNCH 1
#endif

typedef unsigned short bf16_t;
typedef short bf16x8 __attribute__((ext_vector_type(8)));
typedef float f32x4 __attribute__((ext_vector_type(4)));
typedef float f32x2 __attribute__((ext_vector_type(2)));
typedef int i32x4 __attribute__((ext_vector_type(4)));
typedef int i32x8 __attribute__((ext_vector_type(8)));
typedef unsigned u32x4 __attribute__((ext_vector_type(4)));
typedef unsigned u32x2 __attribute__((ext_vector_type(2)));
#define LAS __attribute__((address_space(3)))
#define GAS __attribute__((address_space(1)))

constexpr int T = 16384, SEQ = 2048;
constexpr int NPAD = 2560;
constexpr int CAP = 16384;
constexpr int RBR = 256;
constexpr int MAXRB = 512 + 64 + 64;
constexpr int MAXROWS = MAXRB * RBR;
constexpr float ALPHA = 1.681792830507429f;
constexpr int PPL = 12;
constexpr int NPH = 1 + 4 * PPL;
constexpr int NT = 512, NW = 8;
constexpr int HALF_LDS = 65536 + 64 + 1024;
constexpr int LDS_BLK = 2 * HALF_LDS;
constexpr int DYN_LDS = LDS_BLK + 64 + 1024 + 2560;

constexpr size_t cmax(size_t a, size_t b) { return a > b ? a : b; }
constexpr size_t WS_CTL = 0;
constexpr size_t CTL_BYTES = 65536;
constexpr size_t WS_WIN = WS_CTL + CTL_BYTES;
constexpr size_t WIN_ELEMS = (size_t)NPAD * 1024;
constexpr size_t WS_WQB = WS_WIN + 4 * WIN_ELEMS * 2;
constexpr size_t WQB_ELEMS = 768 * 256;
constexpr size_t WS_WKVB = WS_WQB + 2 * WQB_ELEMS * 2;
constexpr size_t WKVB_ELEMS = 1024 * 128;
constexpr size_t WS_WOUT = WS_WKVB + 2 * WKVB_ELEMS * 2;
constexpr size_t WOUT_ELEMS = 1024 * 1024;
constexpr size_t WS_WRT = WS_WOUT + 4 * WOUT_ELEMS * 2;
constexpr size_t WRT_ELEMS = 128 * 1024;
constexpr size_t WS_WGU = WS_WRT + 4 * WRT_ELEMS * 2;
constexpr size_t WGU_ELEMS = 512 * 1024;
constexpr size_t WS_WDN = WS_WGU + 4 * 65 * WGU_ELEMS * 2;
constexpr size_t WDN_ELEMS = 1024 * 256;
constexpr size_t WS_ROPEM = WS_WDN + 4 * 65 * WDN_ELEMS * 2;
constexpr size_t WS_ROPES = WS_ROPEM + (size_t)T * 16 * 2 * 4;
constexpr size_t WS_X1 = WS_ROPES + (size_t)T * 32 * 2 * 4;
constexpr size_t WS_XBF = WS_X1 + (size_t)T * 1024 * 4;
constexpr size_t WS_HBUF = WS_XBF + (size_t)T * 1024 * 2;
constexpr size_t WS_LOG = WS_HBUF + (size_t)MAXROWS * 256 * 2;
constexpr size_t WS_ASG = WS_LOG + (size_t)T * 64 * 4;
constexpr size_t WS_ASGW = WS_ASG + (size_t)T * 8 * 4;
constexpr size_t WS_LTOK = WS_ASGW + (size_t)T * 8 * 4;
constexpr size_t WS_LW = WS_LTOK + (size_t)65 * CAP * 4;
constexpr size_t WS_U = WS_LW + (size_t)65 * CAP * 4;
constexpr size_t U_Y = WS_U;
constexpr size_t U_PROJ = WS_U;
constexpr size_t U_GATES = U_PROJ + (size_t)T * NPAD * 2;
constexpr size_t U_CQ = U_GATES + (size_t)T * 8 * 4;
constexpr size_t U_CKV = U_CQ + (size_t)T * 256 * 2;
constexpr size_t U_KROPE = U_CKV + (size_t)T * 128 * 2;
constexpr size_t U_QF = U_KROPE + (size_t)T * 32 * 2;
constexpr size_t U_KN = U_QF + (size_t)T * 768 * 2;
constexpr size_t U_VV = U_KN + (size_t)T * 512 * 2;
constexpr size_t U_GQ = U_VV + (size_t)T * 512 * 2;
constexpr size_t U_GK = U_GQ + (size_t)T * 512 * 2;
constexpr size_t U_GV = U_GK + (size_t)T * 512 * 2;
constexpr size_t U_BETA = U_GV + (size_t)T * 512 * 2;
constexpr size_t U_GLOG = U_BETA + (size_t)T * 4 * 4;
constexpr size_t U_MIXO = U_GLOG + (size_t)T * 4 * 4;
constexpr size_t U_YBUF = U_MIXO + (size_t)T * 1024 * 2;
constexpr size_t U_END1 = U_YBUF + (size_t)T * 1024 * 4;
constexpr size_t WS_END = WS_U + cmax((size_t)MAXROWS * 1024 * 2, U_END1 - WS_U);

constexpr int CW_CNT = 4096;
constexpr int CW_WORK = 8192;

#define XB_TMO      128
#define XB_XCNT(j)  (256  + 64 * (j))
#define XB_XSUB(j)  (1280 + 64 * (j))
#define XB_XGEN(j)  (2304 + 64 * (j))
#define XB_TOP      3328
#define XB_TOPGEN   3392
#define XCD_BAR_WORDS 3456
#define XB_SPIN_CAP (1u << 18)

__device__ __forceinline__ unsigned xb_ld(unsigned* p)              { return __hip_atomic_load(p, __ATOMIC_RELAXED, __HIP_MEMORY_SCOPE_AGENT); }
__device__ __forceinline__ int lane_id_v() { int l; asm volatile("v_mbcnt_lo_u32_b32 %0, -1, 0\n\tv_mbcnt_hi_u32_b32 %0, -1, %0" : "=v"(l)); return l; }
__device__ __forceinline__ unsigned xb_add(unsigned* p, unsigned v) { return __hip_atomic_fetch_add(p, v, __ATOMIC_RELAXED, __HIP_MEMORY_SCOPE_AGENT); }
__device__ __forceinline__ unsigned xb_xcc_id() { return (unsigned)__builtin_amdgcn_s_getreg((3 << 11) | 20) & 0xFu; }
#define XB_SPIN(cond, bar) do { unsigned _sp = 0; while (cond) { __builtin_amdgcn_s_sleep(1); \
    if ((++_sp & 255u) == 0u) { if (xb_ld(&(bar)[XB_TMO])) break; if (_sp > XB_SPIN_CAP) { atomicAdd(&(bar)[XB_TMO], 1u); break; } } } } while (0)

struct XcdBarrier { unsigned* bar; unsigned x; volatile LAS unsigned* st; int wave; };

__device__ __forceinline__ XcdBarrier xcd_barrier_post(unsigned* bar, volatile LAS unsigned* st, int tid0) {
    XcdBarrier b; b.bar = bar; b.x = xb_xcc_id(); b.st = st; b.wave = __builtin_amdgcn_readfirstlane(tid0 >> 6);
    if (tid0 == 0) (void)xb_add(&bar[XB_XCNT(b.x)], 1u);
    return b;
}
__device__ __forceinline__ void xcd_barrier_complete(unsigned* bar, unsigned x, unsigned& nloc, unsigned& nx) {
    const unsigned G = gridDim.x * gridDim.y * gridDim.z;
    unsigned sum, cnt, mine, sp = 0u;
    for (;;) {
        sum = 0u; cnt = 0u; mine = 0u;
#pragma unroll
        for (unsigned j = 0; j < 16; ++j) { const unsigned c = xb_ld(&bar[XB_XCNT(j)]); sum += c; cnt += (c > 0u) ? 1u : 0u; mine = (j == x) ? c : mine; }
        if (sum == G) break;
        __builtin_amdgcn_s_sleep(1);
        if ((++sp & 255u) == 0u) { if (xb_ld(&bar[XB_TMO])) break; if (sp > XB_SPIN_CAP) { atomicAdd(&bar[XB_TMO], 1u); break; } }
    }
    nloc = mine > 0u ? mine : 1u; nx = cnt > 0u ? cnt : 1u;
}
__device__ __forceinline__ void xcd_barrier(const XcdBarrier& b) {
    asm volatile("s_waitcnt vmcnt(0)" ::: "memory");
    __syncthreads();
    if (b.wave == 0 && lane_id_v() == 0) {
        unsigned* bar = b.bar; unsigned bx = __builtin_amdgcn_readfirstlane(b.x);
        asm volatile("" : "+s"(bar), "+s"(bx));
        __builtin_amdgcn_s_waitcnt(0);
        unsigned nloc = b.st[0], nx = b.st[1];
        if (nloc == 0u) { xcd_barrier_complete(bar, bx, nloc, nx); b.st[0] = nloc; b.st[1] = nx; }
        const unsigned old = xb_add(&bar[XB_XSUB(bx)], 1u);
        const unsigned gen = old / nloc;
        if (old + 1u == (gen + 1u) * nloc) {
            __builtin_amdgcn_fence(__ATOMIC_RELEASE, "agent");
            asm volatile("s_waitcnt vmcnt(0)" ::: "memory");
            const unsigned og = xb_add(&bar[XB_TOP], 1u);
            const unsigned tg = og / nx;
            if (og + 1u == (tg + 1u) * nx) xb_add(&bar[XB_TOPGEN], 1u);
            else XB_SPIN(xb_ld(&bar[XB_TOPGEN]) == tg, bar);
            __builtin_amdgcn_fence(__ATOMIC_ACQUIRE, "agent");
            xb_add(&bar[XB_XGEN(bx)], 1u);
            asm volatile("s_waitcnt vmcnt(0)" ::: "memory");
        } else {
            XB_SPIN(xb_ld(&bar[XB_XGEN(bx)]) == gen, bar);
            __builtin_amdgcn_fence(__ATOMIC_ACQUIRE, "agent");
            asm volatile("s_waitcnt vmcnt(0)" ::: "memory");
        }
    }
    __syncthreads();
}

__device__ __forceinline__ float bf2f(unsigned v) { return __uint_as_float(v << 16); }
__device__ __forceinline__ float bflo(unsigned w) { return __uint_as_float(w << 16); }
__device__ __forceinline__ float bfhi(unsigned w) { return __uint_as_float(w & 0xffff0000u); }
__device__ __forceinline__ unsigned f2bf(float f) { unsigned u = __float_as_uint(f); u += 0x7fffu + ((u >> 16) & 1u); return u >> 16; }
__device__ __forceinline__ unsigned pk2(float lo, float hi) { return f2bf(lo) | (f2bf(hi) << 16); }
__device__ __forceinline__ unsigned cvt_pk(float lo, float hi) { unsigned r; asm volatile("v_cvt_pk_bf16_f32 %0, %1, %2" : "=v"(r) : "v"(lo), "v"(hi)); return r; }
template <class T> __device__ __forceinline__ T shfl_xor_(T v, int o) { return __builtin_bit_cast(T, __builtin_amdgcn_ds_bpermute((lane_id_v() ^ o) << 2, __builtin_bit_cast(int, v))); }
template <class T> __device__ __forceinline__ T shfl_up_(T v, int o) { const int l = lane_id_v(), s = (l - o < 0) ? l : l - o; return __builtin_bit_cast(T, __builtin_amdgcn_ds_bpermute(s << 2, __builtin_bit_cast(int, v))); }
template <class T> __device__ __forceinline__ T shfl_c_(T v, int src  ) { return __builtin_bit_cast(T, __builtin_amdgcn_readlane(__builtin_bit_cast(int, v), src)); }
__device__ __forceinline__ float wave_dpp_(float v, int ctrl_sel) {
    int x = __builtin_bit_cast(int, v), r;
    if (ctrl_sel == 0) r = __builtin_amdgcn_update_dpp(0, x, 0xB1, 0xF, 0xF, true);
    else if (ctrl_sel == 1) r = __builtin_amdgcn_update_dpp(0, x, 0x4E, 0xF, 0xF, true);
    else if (ctrl_sel == 2) r = __builtin_amdgcn_update_dpp(0, x, 0x141, 0xF, 0xF, true);
    else r = __builtin_amdgcn_update_dpp(0, x, 0x140, 0xF, 0xF, true);
    return __builtin_bit_cast(float, r);
}
__device__ __forceinline__ float wave_sum_dpp(float v) {
    v += wave_dpp_(v, 0); v += wave_dpp_(v, 1); v += wave_dpp_(v, 2); v += wave_dpp_(v, 3);
    v += shfl_xor_(v, 16); v += shfl_xor_(v, 32);
    return v;
}
__device__ __forceinline__ float wave_sum(float v) { return wave_sum_dpp(v); }
__device__ __forceinline__ float grp8_max(float v) { v = fmaxf(v, wave_dpp_(v, 0)); v = fmaxf(v, wave_dpp_(v, 1)); v = fmaxf(v, wave_dpp_(v, 2)); return v; }
__device__ __forceinline__ int grp8_min(int v) {
    v = min(v, __builtin_amdgcn_update_dpp(0, v, 0xB1, 0xF, 0xF, true)); v = min(v, __builtin_amdgcn_update_dpp(0, v, 0x4E, 0xF, 0xF, true)); v = min(v, __builtin_amdgcn_update_dpp(0, v, 0x141, 0xF, 0xF, true));
    return v;
}
__device__ __forceinline__ float sigmoidf_(float x) { return 1.f / (1.f + expf(-x)); }
__device__ __forceinline__ float siluf_(float x) { return x / (1.f + expf(-x)); }
__device__ __forceinline__ float softplusf_(float x) { return x > 20.f ? x : log1pf(expf(x)); }
__device__ __forceinline__ void glds16(const void* g, void* l) {
    __builtin_amdgcn_global_load_lds((const GAS unsigned*)g, (LAS unsigned*)l, 16, 0, 0);
}
__device__ __forceinline__ void glds16s(const char* sbase, unsigned voff, unsigned lds_uniform) {
    asm volatile("s_mov_b32 m0, %2\n\ts_nop 0\n\tglobal_load_lds_dwordx4 %0, %1" :: "v"(voff), "s"(sbase), "s"(lds_uniform) : "memory", "m0");
}
__device__ __forceinline__ const char* uniform_ptr(const void* p) {
    const unsigned long long v = (unsigned long long)p;
    const unsigned lo = (unsigned)__builtin_amdgcn_readfirstlane((int)(unsigned)v), hi = (unsigned)__builtin_amdgcn_readfirstlane((int)(unsigned)(v >> 32));
    return (const char*)(((unsigned long long)hi << 32) | lo);
}
__device__ __forceinline__ void unpack8(const u32x4 r, float (&f)[8]) {
    f[0] = bflo(r.x); f[1] = bfhi(r.x); f[2] = bflo(r.y); f[3] = bfhi(r.y);
    f[4] = bflo(r.z); f[5] = bfhi(r.z); f[6] = bflo(r.w); f[7] = bfhi(r.w);
}

struct Args {
    const void* in[30];
    float* out;
    unsigned char* ws;
    int ph_lo, ph_hi, use_bar, pad;
};

struct Ctx { int tid, lane, wid, wr, wc, fr, fq, bid, nblk; unsigned char* smem; int half, tid0; unsigned char* smem0; };

#define WAIT_V(n) asm volatile("s_waitcnt vmcnt(" #n ")" ::: "memory")
__device__ __forceinline__ void gemm_tile(const bf16_t* a0, const bf16_t* a1, const bf16_t* b0, const bf16_t* b1,
                                          int nk, f32x4 (&acc)[4][4], const Ctx& c) {
#pragma unroll
    for (int m = 0; m < 4; ++m)
#pragma unroll
        for (int n = 0; n < 4; ++n) acc[m][n] = (f32x4){0.f, 0.f, 0.f, 0.f};
    unsigned char* smem = c.smem;
    const int sb = c.tid * 16;
    const int kofs = ((c.tid & 3) ^ ((c.tid >> 4) & 3)) * 8;
    a0 += kofs; a1 += kofs; b0 += kofs; b1 += kofs;
#define G_STAGE(kt_) do { unsigned char* sp_ = smem + ((kt_) & 3) * 16384 + sb; const int ko_ = (kt_) * 32; \
        glds16(a0 + ko_, sp_); glds16(a1 + ko_, sp_ + 4096); glds16(b0 + ko_, sp_ + 8192); glds16(b1 + ko_, sp_ + 12288); } while (0)
#define G_READ(kt_, AF, BF) do { const unsigned char* sa_ = smem + ((kt_) & 3) * 16384 + c.wr * 4096 + roff; const unsigned char* sb_ = smem + ((kt_) & 3) * 16384 + 8192 + c.wc * 4096 + roff; \
        _Pragma("unroll") for (int m = 0; m < 4; ++m) AF[m] = *(const bf16x8*)(sa_ + m * 1024); \
        _Pragma("unroll") for (int n = 0; n < 4; ++n) BF[n] = *(const bf16x8*)(sb_ + n * 1024); } while (0)
#define G_MMA(AF, BF) do { __builtin_amdgcn_s_setprio(1); \
        _Pragma("unroll") for (int m = 0; m < 4; ++m) _Pragma("unroll") for (int n = 0; n < 4; ++n) acc[m][n] = __builtin_amdgcn_mfma_f32_16x16x32_bf16(BF[n], AF[m], acc[m][n], 0, 0, 0); \
        __builtin_amdgcn_s_setprio(0); } while (0)
#define G_BAR() do { asm volatile("" ::: "memory"); __builtin_amdgcn_s_barrier(); asm volatile("" ::: "memory"); } while (0)
    const int roff = (c.fr * 64) + ((c.fq ^ ((c.fr >> 2) & 3)) * 16);
    WAIT_V(0);
    G_STAGE(0); G_STAGE(1); G_STAGE(2); G_STAGE(3);
    bf16x8 fa0[4], fb0[4], fa1[4], fb1[4];
    WAIT_V(12); G_BAR();
    G_READ(0, fa0, fb0);
#define G_LGK0() asm volatile("s_waitcnt lgkmcnt(0)" ::: "memory")
    int kt = 0;
    for (; kt < nk - 4; kt += 4) {
        G_LGK0(); WAIT_V(8); G_BAR(); G_STAGE(kt + 4); G_READ(1, fa1, fb1); G_MMA(fa0, fb0);
        G_LGK0(); WAIT_V(8); G_BAR(); G_STAGE(kt + 5); G_READ(2, fa0, fb0); G_MMA(fa1, fb1);
        G_LGK0(); WAIT_V(8); G_BAR(); G_STAGE(kt + 6); G_READ(3, fa1, fb1); G_MMA(fa0, fb0);
        G_LGK0(); WAIT_V(8); G_BAR(); G_STAGE(kt + 7); G_READ(0, fa0, fb0); G_MMA(fa1, fb1);
    }
    G_LGK0(); WAIT_V(8); G_BAR(); G_READ(1, fa1, fb1); G_MMA(fa0, fb0);
    G_LGK0(); WAIT_V(4); G_BAR(); G_READ(2, fa0, fb0); G_MMA(fa1, fb1);
    G_LGK0(); WAIT_V(0); G_BAR(); G_READ(3, fa1, fb1); G_MMA(fa0, fb0);
    G_MMA(fa1, fb1);
#undef G_LGK0
#undef G_STAGE
#undef G_READ
#undef G_MMA
#undef G_BAR
    __syncthreads();
}

namespace g8 {
constexpr int BM = 256, BK = 64, HALF = 128, HTB = HALF * BK * 2, STAGE_BYTES = 8 * HTB;
__device__ __forceinline__ int lds_byte(int r, int c) { const int st = (r >> 4) * 2 + (c >> 5), rr = r & 15, cc = c & 31, ob = rr * 64 + cc * 2; return st * 1024 + (ob ^ (((ob >> 9) & 1) << 5)); }
__device__ __forceinline__ void stage_rc(int b, int& R, int& C) { const int st = b / 1024, sb = b % 1024, swz = sb ^ (((sb >> 9) & 1) << 5); R = (st >> 1) * 16 + swz / 64; C = (st & 1) * 32 + (swz % 64) / 2; }
__device__ __forceinline__ int perm32(int rho) { const int n = rho >> 4, i = rho & 15; return 8 * (i >> 2) + 4 * n + (i & 3); }
struct Unit { int pm, pn, bt; };

template <int PERM, bool GATHER, bool F8, class Sched, class Epi>
__device__ __forceinline__ void phase(unsigned char* ldsp, const char* Abase, const char* Bbase, int K, const Sched& S, const Epi& E, int tid_in) {
    LAS unsigned char* lds = (LAS unsigned char*)ldsp;
    int tid = tid_in; asm volatile("" : "+v"(tid));
    const int wid = __builtin_amdgcn_readfirstlane(tid >> 6), lane = tid & 63, wr = wid >> 2, wc = wid & 3, fr = lane & 15, fq = lane >> 4;
    const int nt = K / BK;
    unsigned voffA[2], voffB[2];
#pragma unroll
    for (int i = 0; i < 2; ++i) { int R, C; stage_rc(tid * 16 + i * 8192, R, C); const int Rb = (PERM == 2) ? ((R >> 5) * 64 + ((R & 15) >> 2) * 16 + ((R >> 4) & 1) * 4 + (R & 3)) : (PERM == 1) ? ((R >> 5) * 64 + perm32(R & 31)) : (((R >> 5) * 2 + ((R & 15) >> 3)) * 32 + ((R >> 4) & 1) * 16 + (((R & 15) >> 2) & 1) * 8 + (R & 3));
        voffA[i] = (unsigned)(R * K + C) * 2u; voffB[i] = (unsigned)(Rb * K + C) * 2u; }
    const size_t kstep = (size_t)(BK * 2);
    const size_t hstep = (size_t)HALF * K * 2, tstep = 2 * hstep, bhstep = (PERM == 2) ? (size_t)8 * K * 2 : (PERM == 1) ? (size_t)32 * K * 2 : (size_t)4 * K * 2;
    const unsigned ldsw = (unsigned)wid * 1024u;
    const int aoff = F8 ? lds_byte(wr * 64 + fr, fq * 16) : lds_byte(wr * 64 + fr, fq * 8), boff = F8 ? lds_byte(wc * 32 + fr, fq * 16) : lds_byte(wc * 32 + fr, fq * 8);
    constexpr int KP = F8 ? 16 : 1024;
#define G8_SA(b, h) (((b) * 2 + (h)) * HTB)
#define G8_SB(b, h) ((4 + (b) * 2 + (h)) * HTB)
#define G8_DMA(gptr, voff32, ldsoff) do { const char* _gp = (gptr); const unsigned _lo = (unsigned)(size_t)(ldsp) + (unsigned)(ldsoff); \
        asm volatile("s_mov_b32 m0, %2\n\ts_nop 0\n\tglobal_load_lds_dwordx4 %0, %1" :: "v"(voff32), "s"(_gp), "s"(_lo) : "memory", "m0"); } while (0)
#define G8_STAGE(bufoff, gbase, voff) do { _Pragma("unroll") for (int _i = 0; _i < 2; ++_i) G8_DMA((const char*)(gbase), (voff)[_i], (bufoff) + ldsw + _i * 8192); } while (0)
#define G8_STAGEA(bufoff, gbase, h, kb) do { if constexpr (GATHER) { _Pragma("unroll") for (int _i = 0; _i < 2; ++_i) G8_DMA(Abase + (kb), vA[2 * (h) + _i], (bufoff) + ldsw + _i * 8192); } \
        else G8_STAGE(bufoff, (gbase) + (size_t)(h) * hstep + (kb), voffA); } while (0)
#define G8_LDA(dst, b, h) do { _Pragma("unroll") for (int m = 0; m < 4; ++m) _Pragma("unroll") for (int k = 0; k < 2; ++k) dst[m][k] = *(const LAS bf16x8*)(lds + G8_SA(b, h) + aoff + m * 2048 + k * KP); } while (0)
#define G8_LDB(dst, b, h) do { _Pragma("unroll") for (int n = 0; n < 2; ++n) _Pragma("unroll") for (int k = 0; k < 2; ++k) dst[n][k] = *(const LAS bf16x8*)(lds + G8_SB(b, h) + boff + n * 2048 + k * KP); } while (0)
#define G8_CAT(x, y) __builtin_shufflevector(__builtin_bit_cast(i32x4, (x)), __builtin_bit_cast(i32x4, (y)), 0, 1, 2, 3, 4, 5, 6, 7)
#define G8_MMA(ai, bj, At, Bt) do { __builtin_amdgcn_s_setprio(1); _Pragma("unroll") for (int m = 0; m < 4; ++m) _Pragma("unroll") for (int n = 0; n < 2; ++n) { \
        if constexpr (F8) acc[ai][bj][m][n] = __builtin_amdgcn_mfma_scale_f32_16x16x128_f8f6f4(G8_CAT(Bt[n][0], Bt[n][1]), G8_CAT(At[m][0], At[m][1]), acc[ai][bj][m][n], 0, 0, 0, 0, 0, 0); \
        else { _Pragma("unroll") for (int k = 0; k < 2; ++k) acc[ai][bj][m][n] = __builtin_amdgcn_mfma_f32_16x16x32_bf16(Bt[n][k], At[m][k], acc[ai][bj][m][n], 0, 0, 0); } } \
        __builtin_amdgcn_s_setprio(0); } while (0)
#define G8_WAIT_V(n) asm volatile("s_waitcnt vmcnt(" #n ")" ::: "memory")
#define G8_WAIT_L(n) asm volatile("s_waitcnt lgkmcnt(" #n ")" ::: "memory")
#define G8_BAR __builtin_amdgcn_s_barrier()
#define G8_SCHED __builtin_amdgcn_sched_barrier(0)
    Unit cur, nxt; int ui = 0;
    if (!S.next(0, cur)) return;
    f32x4 acc[2][2][4][2];
#pragma unroll
    for (int a = 0; a < 2; ++a)
#pragma unroll
        for (int b = 0; b < 2; ++b)
#pragma unroll
            for (int m = 0; m < 4; ++m)
#pragma unroll
                for (int n = 0; n < 2; ++n) acc[a][b][m][n] = (f32x4){0.f, 0.f, 0.f, 0.f};
    bf16x8 At[4][2], B0[2][2], B1[2][2];
    const char* cA = Abase + (size_t)cur.pm * tstep; const char* cB = Bbase + (size_t)cur.bt * tstep;
    unsigned vA[4] = {0u, 0u, 0u, 0u};
    if constexpr (GATHER) S.aoff(cur, tid, vA);
    asm volatile("s_waitcnt vmcnt(0)" ::: "memory");
    G8_STAGE(G8_SB(0, 0), cB, voffB); G8_STAGEA(G8_SA(0, 0), cA, 0, 0); G8_STAGE(G8_SB(0, 1), cB + bhstep, voffB); G8_STAGEA(G8_SA(0, 1), cA, 1, 0);
    if (wr == 1) G8_BAR;
    G8_WAIT_V(4); G8_BAR;
    G8_STAGE(G8_SB(1, 0), cB + kstep, voffB); G8_STAGEA(G8_SA(1, 0), cA, 0, kstep); G8_STAGE(G8_SB(1, 1), cB + bhstep + kstep, voffB);
    G8_WAIT_V(6); G8_BAR;
    G8_STAGEA(G8_SA(1, 1), cA, 1, kstep);
    for (;;) {
        const bool has_next = S.next(ui + 1, nxt);
        const char* nA = has_next ? Abase + (size_t)nxt.pm * tstep : cA; const char* nB = has_next ? Bbase + (size_t)nxt.bt * tstep : cB;
        for (int t = 0; t < nt; t += 2) {
            const bool last = (t == nt - 2);
            const int lastf = __builtin_amdgcn_readfirstlane(last ? 1 : 0);
            const size_t k2 = last ? 0 : (size_t)(t + 2) * kstep, k3 = k2 + kstep;
            const char* a2 = last ? nA : cA; const char* b2 = last ? nB : cB + (size_t)(t + 2) * kstep;
            const char* b3 = b2 + kstep;
            G8_LDB(B0, 0, 0); G8_SCHED; G8_LDA(At, 0, 0);
            if constexpr (GATHER) { if (last && has_next) S.aoff(nxt, tid, vA); }
            G8_WAIT_L(8); G8_BAR; G8_WAIT_L(0); G8_MMA(0, 0, At, B0); G8_BAR; G8_SCHED;
            G8_LDB(B1, 0, 1); G8_STAGE(G8_SB(0, 0), b2, voffB);
            G8_BAR; G8_WAIT_L(0); G8_MMA(0, 1, At, B1); G8_BAR;
            G8_LDA(At, 0, 1); G8_STAGEA(G8_SA(0, 0), a2, 0, k2);
            G8_BAR; G8_WAIT_L(0); G8_MMA(1, 0, At, B0); G8_BAR; G8_SCHED;
            G8_STAGE(G8_SB(0, 1), b2 + bhstep, voffB);
            const int pend = __builtin_amdgcn_readfirstlane((t == 0 && ui > 0) ? 1 : 0);
            asm volatile("s_cmp_lg_u32 %0, 0\n\ts_cbranch_scc1 1f\n\ts_waitcnt vmcnt(6)\n1:\n\ts_waitcnt vmcnt(%1)" :: "s"(pend), "n"(6 + (Epi::SPLIT ? Epi::NQ : Epi::NST)) : "memory", "scc");
            G8_BAR; G8_MMA(1, 1, At, B1); G8_BAR;
            G8_LDB(B0, 1, 0); G8_SCHED; G8_LDA(At, 1, 0); G8_STAGEA(G8_SA(0, 1), a2, 1, k2);
            G8_WAIT_L(8); G8_BAR; G8_WAIT_L(0); G8_MMA(0, 0, At, B0); G8_BAR; G8_SCHED;
            if constexpr (Epi::SPLIT) { E.template part_cond<0, 0>(acc, cur, wr, wc, fr, fq, lastf); G8_SCHED; }
            G8_LDB(B1, 1, 1); G8_STAGE(G8_SB(1, 0), b3, voffB);
            G8_BAR; G8_WAIT_L(0); G8_MMA(0, 1, At, B1); G8_BAR;
            if constexpr (Epi::SPLIT) { E.template part_cond<0, 1>(acc, cur, wr, wc, fr, fq, lastf); G8_SCHED; }
            G8_LDA(At, 1, 1); G8_STAGEA(G8_SA(1, 0), a2, 0, k3);
            G8_BAR; G8_WAIT_L(0); G8_MMA(1, 0, At, B0); G8_BAR; G8_SCHED;
            G8_STAGE(G8_SB(1, 1), b3 + bhstep, voffB);
            if constexpr (Epi::SPLIT) {
                asm volatile("s_cmp_lg_u32 %0, 0\n\ts_cbranch_scc1 1f\n\ts_waitcnt vmcnt(6)\n1:\n\ts_waitcnt vmcnt(%1)" :: "s"(lastf), "n"(6 + 2 * Epi::NQ) : "memory", "scc");
                G8_SCHED; E.template part_cond<1, 0>(acc, cur, wr, wc, fr, fq, lastf); G8_SCHED;
            } else G8_WAIT_V(6);
            G8_BAR; G8_MMA(1, 1, At, B1); G8_BAR;
            G8_STAGEA(G8_SA(1, 1), a2, 1, k3);
        }
        if constexpr (Epi::SPLIT) E.tail(acc, cur, wr, wc, fr, fq); else E(acc, cur, wr, wc, fr, fq);
        if (!has_next) break;
#pragma unroll
        for (int a = 0; a < 2; ++a)
#pragma unroll
            for (int b = 0; b < 2; ++b)
#pragma unroll
                for (int m = 0; m < 4; ++m)
#pragma unroll
                    for (int n = 0; n < 2; ++n) acc[a][b][m][n] = (f32x4){0.f, 0.f, 0.f, 0.f};
        cur = nxt; cA = nA; cB = nB; ++ui;
    }
    G8_WAIT_V(0);
    if (wr == 0) G8_BAR;
    G8_BAR;
#undef G8_SA
#undef G8_SB
#undef G8_STAGE
#undef G8_STAGEA
#undef G8_LDA
#undef G8_LDB
#undef G8_MMA
#undef G8_CAT
#undef G8_WAIT_V
#undef G8_WAIT_L
#undef G8_BAR
#undef G8_SCHED
}
}

__device__ __forceinline__ bool tile_map(int i, const Ctx& c, int ntm, int ntn, int& mt, int& nt) {
    const int vb = ((c.nblk & 15) == 0) ? ((c.bid >> 1) & 7) * (c.nblk >> 3) + (((c.bid >> 4) << 1) | (c.bid & 1)) : c.bid;
    const int L = i * c.nblk + vb;
    if (L >= ntm * ntn) return false;
    const int g = L / (8 * ntn), rem = L - g * 8 * ntn;
    const int gsz = (ntm - g * 8) < 8 ? (ntm - g * 8) : 8;
    mt = g * 8 + rem % gsz; nt = rem / gsz;
    return true;
}

__device__ __forceinline__ bool tile_map2(int i, const Ctx& c, int ntm, int ntn, int& mt, int& nt, bool& valid) {
    Ctx o = c; o.bid = c.bid ^ 1;
    int mo, no; const bool oko = tile_map(i, o, ntm, ntn, mo, no);
    valid = tile_map(i, c, ntm, ntn, mt, nt);
    if (!valid) { mt = 0; nt = 0; }
    return valid || oko;
}

struct DenseSched {
    int ntm, ntn, K, bid, nblk;
    __device__ __forceinline__ bool next(int i, g8::Unit& u) const {
        const int vb = ((nblk & 7) == 0) ? (bid & 7) * (nblk >> 3) + (bid >> 3) : bid;
        const int L = i * nblk + vb;
        if (L >= ntm * ntn) return false;
        const int g = L / (8 * ntn), rem = L - g * 8 * ntn;
        const int gsz = (ntm - g * 8) < 8 ? (ntm - g * 8) : 8;
        u.pm = g * 8 + rem % gsz; u.pn = rem / gsz; u.bt = u.pn;
        return true;
    }
};
struct MoeSched {
    int nrb, ntn, bid, nblk; const int* eb;
    __device__ __forceinline__ bool next(int i, g8::Unit& u) const {
        const int vb = ((nblk & 7) == 0) ? (bid & 7) * (nblk >> 3) + (bid >> 3) : bid;
        const int L = i * nblk + vb;
        if (L >= nrb * ntn) return false;
        const int g = L / (8 * ntn), rem = L - g * 8 * ntn;
        const int gsz = (nrb - g * 8) < 8 ? (nrb - g * 8) : 8;
        u.pm = g * 8 + rem % gsz; u.pn = rem / gsz;
        u.bt = __builtin_amdgcn_readfirstlane(eb[u.pm]) * ntn + u.pn;
        return true;
    }
};
struct MoeSchedG {
    int nrb, bid, nblk; const int* eb; const int* bst; const int* LTOK; unsigned rowb;
    __device__ __forceinline__ bool next(int i, g8::Unit& u) const {
        const int vb = ((nblk & 7) == 0) ? (bid & 7) * (nblk >> 3) + (bid >> 3) : bid;
        const int L = i * nblk + vb;
        if (L >= nrb * 2) return false;
        const int g = L >> 4, rem = L & 15;
        const int gsz = (nrb - g * 8) < 8 ? (nrb - g * 8) : 8;
        u.pm = g * 8 + rem % gsz; u.pn = rem / gsz;
        u.bt = __builtin_amdgcn_readfirstlane(eb[u.pm]) * 2 + u.pn;
        return true;
    }
    __device__ __forceinline__ void aoff(const g8::Unit& u, int tid, unsigned (&o)[4]) const {
        const int e = eb[u.pm], lb = u.pm - bst[e], cnt = bst[66 + e];
        int R0, C0, R1, C1; g8::stage_rc(tid * 16, R0, C0); g8::stage_rc(tid * 16 + 8192, R1, C1);
        const int* lt = LTOK + (size_t)e * CAP + lb * RBR;
        const int p00 = R0, p01 = R1, p10 = 128 + R0, p11 = 128 + R1;
        const int l00 = lt[p00], l01 = lt[p01], l10 = lt[p10], l11 = lt[p11];
        const int t00 = (lb * RBR + p00 < cnt) ? l00 : 0, t01 = (lb * RBR + p01 < cnt) ? l01 : 0;
        const int t10 = (lb * RBR + p10 < cnt) ? l10 : 0, t11 = (lb * RBR + p11 < cnt) ? l11 : 0;
        o[0] = (unsigned)t00 * rowb + (unsigned)C0 * 2u; o[1] = (unsigned)t01 * rowb + (unsigned)C1 * 2u;
        o[2] = (unsigned)t10 * rowb + (unsigned)C0 * 2u; o[3] = (unsigned)t11 * rowb + (unsigned)C1 * 2u;
    }
};
struct EpiMoe1 {
    static constexpr bool SPLIT = false; static constexpr int NQ = 2, NST = 8;
    bf16_t* H;
    __device__ __forceinline__ void operator()(const f32x4 (&acc)[2][2][4][2], const g8::Unit& u, int wr, int wc, int fr, int fq) const {
#pragma unroll
        for (int ai = 0; ai < 2; ++ai)
#pragma unroll
            for (int m = 0; m < 4; ++m) {
                const size_t row = (size_t)u.pm * RBR + ai * 128 + wr * 64 + m * 16 + fr;
                float h[8];
#pragma unroll
                for (int bj = 0; bj < 2; ++bj) {
                    const f32x4 g = acc[ai][bj][m][0], up = acc[ai][bj][m][1];
#pragma unroll
                    for (int j = 0; j < 4; ++j) h[bj * 4 + j] = g[j] * __builtin_amdgcn_rcpf(1.f + __expf(-g[j])) * up[j];
                }
                *(u32x4*)(H + row * 256 + u.pn * 128 + wc * 32 + fq * 8) = (u32x4){cvt_pk(h[0], h[1]), cvt_pk(h[2], h[3]), cvt_pk(h[4], h[5]), cvt_pk(h[6], h[7])};
            }
    }
    template <int ai, int bj> __device__ __forceinline__ void part_cond(const f32x4 (&acc)[2][2][4][2], const g8::Unit& u, int wr, int wc, int fr, int fq, int flag) const {}
    __device__ __forceinline__ void tail(const f32x4 (&acc)[2][2][4][2], const g8::Unit& u, int wr, int wc, int fr, int fq) const {}
};
struct EpiMoe1F8 {
    static constexpr bool SPLIT = false; static constexpr int NQ = 2, NST = 8;
    unsigned char* H;
    __device__ __forceinline__ void operator()(const f32x4 (&acc)[2][2][4][2], const g8::Unit& u, int wr, int wc, int fr, int fq) const {
#pragma unroll
        for (int ai = 0; ai < 2; ++ai)
#pragma unroll
            for (int m = 0; m < 4; ++m) {
                const size_t row = (size_t)u.pm * RBR + ai * 128 + wr * 64 + m * 16 + fr;
                u32x2 d;
#pragma unroll
                for (int bj = 0; bj < 2; ++bj) {
                    const f32x4 g = acc[ai][bj][m][0], up = acc[ai][bj][m][1];
                    float h[4];
#pragma unroll
#if MOE1_F8
                    for (int j = 0; j < 4; ++j) { const float gs = g[j] * (1.f / 512.f); h[j] = gs * __builtin_amdgcn_rcpf(1.f + __expf(-gs)) * up[j] * (2.f / 512.f); }
#else
                    for (int j = 0; j < 4; ++j) h[j] = g[j] * __builtin_amdgcn_rcpf(1.f + __expf(-g[j])) * up[j] * 2.f;
#endif
                    int w = __builtin_amdgcn_cvt_pk_fp8_f32(h[0], h[1], 0, false);
                    w = __builtin_amdgcn_cvt_pk_fp8_f32(h[2], h[3], w, true);
                    d[bj] = (unsigned)w;
                }
                *(u32x2*)(H + row * 256 + u.pn * 128 + wc * 32 + fq * 8) = d;
            }
    }
    template <int ai, int bj> __device__ __forceinline__ void part_cond(const f32x4 (&acc)[2][2][4][2], const g8::Unit& u, int wr, int wc, int fr, int fq, int flag) const {}
    __device__ __forceinline__ void tail(const f32x4 (&acc)[2][2][4][2], const g8::Unit& u, int wr, int wc, int fr, int fq) const {}
};
__device__ __forceinline__ u32x4 dpp_ror8(const u32x4 v) {
    u32x4 r;
#pragma unroll
    for (int i = 0; i < 4; ++i) r[i] = (unsigned)__builtin_amdgcn_update_dpp(0, (int)v[i], 0x128, 0xF, 0xF, true);
    return r;
}
template <bool NT = false>
__device__ __forceinline__ void perm_store(bf16_t* p  , size_t ld8  , const u32x4 p0, const u32x4 p1, int hi) {
    const u32x4 snd = hi ? p0 : p1, rcv = dpp_ror8(snd);
    if constexpr (NT) { __builtin_nontemporal_store(hi ? rcv : p0, (u32x4*)p); __builtin_nontemporal_store(hi ? p1 : rcv, (u32x4*)(p + ld8)); }
    else { *(u32x4*)p = hi ? rcv : p0; *(u32x4*)(p + ld8) = hi ? p1 : rcv; }
}
struct EpiIn {
    static constexpr bool SPLIT = false; static constexpr int NQ = 4, NST = 16;
    bf16_t* P; float* G; int gbase;
    template <int ai, int bj> __device__ __forceinline__ void part_cond(const f32x4 (&acc)[2][2][4][2], const g8::Unit& u, int wr, int wc, int fr, int fq, int flag) const {}
    __device__ __forceinline__ void tail(const f32x4 (&acc)[2][2][4][2], const g8::Unit& u, int wr, int wc, int fr, int fq) const {}
    __device__ __forceinline__ void operator()(const f32x4 (&acc)[2][2][4][2], const g8::Unit& u, int wr, int wc, int fr, int fq) const {
        const int hi = fr >> 3, r8 = fr & 7;
#pragma unroll
        for (int ai = 0; ai < 2; ++ai)
#pragma unroll
            for (int m = 0; m < 4; ++m) {
                const size_t rg = (size_t)u.pm * 256 + ai * 128 + wr * 64 + m * 16;
                u32x4 pk[2];
#pragma unroll
                for (int bj = 0; bj < 2; ++bj) {
                    const f32x4 v0 = acc[ai][bj][m][0], v1 = acc[ai][bj][m][1];
                    pk[bj] = (u32x4){cvt_pk(v0[0], v0[1]), cvt_pk(v0[2], v0[3]), cvt_pk(v1[0], v1[1]), cvt_pk(v1[2], v1[3])};
                    if (u.pn * 256 + wc * 64 + bj * 32 + fq * 8 == gbase) { *(f32x4*)(G + (rg + fr) * 8) = v0; *(f32x4*)(G + (rg + fr) * 8 + 4) = v1; }
                }
                perm_store(P + (rg + r8) * NPAD + u.pn * 256 + wc * 64 + hi * 32 + fq * 8, (size_t)8 * NPAD, pk[0], pk[1], hi);
            }
    }
};
struct EpiMoe2 {
    static constexpr bool SPLIT = false; static constexpr int NQ = 4, NST = 16;
    bf16_t* Y;
    template <int ai, int bj> __device__ __forceinline__ void part_cond(const f32x4 (&acc)[2][2][4][2], const g8::Unit& u, int wr, int wc, int fr, int fq, int flag) const {}
    __device__ __forceinline__ void tail(const f32x4 (&acc)[2][2][4][2], const g8::Unit& u, int wr, int wc, int fr, int fq) const {}
    __device__ __forceinline__ void operator()(const f32x4 (&acc)[2][2][4][2], const g8::Unit& u, int wr, int wc, int fr, int fq) const {
        const int hi = fr >> 3, r8 = fr & 7;
#pragma unroll
        for (int ai = 0; ai < 2; ++ai)
#pragma unroll
            for (int m = 0; m < 4; ++m) {
                const size_t rg = (size_t)u.pm * RBR + ai * 128 + wr * 64 + m * 16;
                u32x4 pk[2];
#pragma unroll
                for (int bj = 0; bj < 2; ++bj) {
                    const f32x4 v0 = acc[ai][bj][m][0], v1 = acc[ai][bj][m][1];
                    pk[bj] = (u32x4){cvt_pk(v0[0], v0[1]), cvt_pk(v0[2], v0[3]), cvt_pk(v1[0], v1[1]), cvt_pk(v1[2], v1[3])};
                }
                perm_store<true>(Y + (rg + r8) * 1024 + u.pn * 256 + wc * 64 + hi * 32 + fq * 8, (size_t)8 * 1024, pk[0], pk[1], hi);
            }
    }
};
struct EpiMoe2F8 {
    static constexpr bool SPLIT = false; static constexpr int NQ = 2, NST = 8;
    unsigned char* Y;
    template <int ai, int bj> __device__ __forceinline__ void part_cond(const f32x4 (&acc)[2][2][4][2], const g8::Unit& u, int wr, int wc, int fr, int fq, int flag) const {}
    __device__ __forceinline__ void tail(const f32x4 (&acc)[2][2][4][2], const g8::Unit& u, int wr, int wc, int fr, int fq) const {}
    __device__ __forceinline__ void operator()(const f32x4 (&acc)[2][2][4][2], const g8::Unit& u, int wr, int wc, int fr, int fq) const {
#pragma unroll
        for (int ai = 0; ai < 2; ++ai)
#pragma unroll
            for (int m = 0; m < 4; ++m) {
                const size_t row = (size_t)u.pm * RBR + ai * 128 + wr * 64 + m * 16 + fr;
                u32x4 d;
#pragma unroll
                for (int bj = 0; bj < 2; ++bj)
#pragma unroll
                    for (int n = 0; n < 2; ++n) {
#if MOE2_F8
                        const f32x4 v = acc[ai][bj][m][n];
#else
                        const f32x4 v = acc[ai][bj][m][n] * 16.f;
#endif
                        int w = __builtin_amdgcn_cvt_pk_fp8_f32(v[0], v[1], 0, false);
                        w = __builtin_amdgcn_cvt_pk_fp8_f32(v[2], v[3], w, true);
                        d[bj * 2 + n] = (unsigned)w;
                    }
                *(u32x4*)(Y + row * 1024 + u.pn * 256 + wc * 64 + fq * 16) = d;
            }
    }
};
struct EpiOut {
    static constexpr bool SPLIT = false; static constexpr int NQ = 8, NST = 32;
    template <int ai, int bj> __device__ __forceinline__ void part_cond(const f32x4 (&acc)[2][2][4][2], const g8::Unit& u, int wr, int wc, int fr, int fq, int flag) const {}
    __device__ __forceinline__ void tail(const f32x4 (&acc)[2][2][4][2], const g8::Unit& u, int wr, int wc, int fr, int fq) const {}
    const bf16_t* xres; bf16_t* Y;
    __device__ __forceinline__ void operator()(const f32x4 (&acc)[2][2][4][2], const g8::Unit& u, int wr, int wc, int fr, int fq) const {
        const int hi = fr >> 3, r8 = fr & 7;
#pragma unroll
        for (int ai = 0; ai < 2; ++ai)
#pragma unroll
            for (int m = 0; m < 4; ++m) {
                const size_t rg = (size_t)u.pm * 256 + ai * 128 + wr * 64 + m * 16;
                u32x4 pk[2];
#pragma unroll
                for (int bj = 0; bj < 2; ++bj) {
                    const u32x4 xr = *(const u32x4*)(xres + (rg + fr) * 1024 + u.pn * 256 + wc * 64 + bj * 32 + fq * 8);
                    float f[8]; unpack8(xr, f);
                    const f32x4 v0 = acc[ai][bj][m][0], v1 = acc[ai][bj][m][1];
                    pk[bj] = (u32x4){cvt_pk(f[0] * ALPHA + v0[0], f[1] * ALPHA + v0[1]), cvt_pk(f[2] * ALPHA + v0[2], f[3] * ALPHA + v0[3]),
                                     cvt_pk(f[4] * ALPHA + v1[0], f[5] * ALPHA + v1[1]), cvt_pk(f[6] * ALPHA + v1[2], f[7] * ALPHA + v1[3])};
                }
                perm_store(Y + (rg + r8) * 1024 + u.pn * 256 + wc * 64 + hi * 32 + fq * 8, (size_t)8 * 1024, pk[0], pk[1], hi);
                asm volatile("" ::: "memory");
            }
    }
};

constexpr int TS_RS = 272;
__device__ __forceinline__ void tile_put(const Ctx& c, int row_l, int col_l, const u32x2 v) { *(u32x2*)(c.smem + row_l * TS_RS + col_l * 2) = v; }
template <int NCOL>
__device__ __forceinline__ void tile_flush(const Ctx& c, bf16_t* out, size_t ld, bool valid) {
    __syncthreads();
    constexpr int CPR = NCOL / 8, PER = (128 * CPR) / 256;
#pragma unroll
    for (int i = 0; i < PER; ++i) {
        const int idx = c.tid + 256 * i, row = idx / CPR, ch = idx % CPR;
        const u32x4 v = *(const u32x4*)(c.smem + row * TS_RS + ch * 16);
        if (valid) *(u32x4*)(out + (size_t)row * ld + ch * 8) = v;
    }
    __syncthreads();
}

__device__ __forceinline__ void conv_family(const float* src, int nmat, size_t src_stride, int K, int N, int Nout,
                            bf16_t* dst, size_t dst_stride, int grp, int kind, const Ctx& c) {
    float* lds = (float*)c.smem;
    const int tk = K / 128, tn = Nout / 64, per = tk * tn, total = nmat * per;
    const int tx = c.tid & 15, ty = c.tid >> 4;
    f32x4 r[8];
#define CV_LOAD(u_) do { const int mat_ = (u_) / per, r_ = (u_) - mat_ * per, kt_ = r_ / tn, nt_ = r_ - kt_ * tn; \
        const float* s_ = src + (size_t)mat_ * src_stride + (size_t)(kt_ * 128 + ty) * N + nt_ * 64 + tx * 4; const bool in_ = (nt_ * 64 + tx * 4) < N; \
        _Pragma("unroll") for (int i = 0; i < 8; ++i) r[i] = in_ ? __builtin_nontemporal_load((const f32x4*)(s_ + (size_t)(16 * i) * N)) : (f32x4){0.f, 0.f, 0.f, 0.f}; } while (0)
    if (c.bid < total) CV_LOAD(c.bid);
    for (int base = 0; base < total; base += c.nblk) {
        const int u = base + c.bid; const bool valid = u < total;
#pragma unroll
        for (int i = 0; i < 8; ++i) *(f32x4*)(lds + (ty + 16 * i) * 68 + tx * 4) = r[i];
        if (u + c.nblk < total) CV_LOAD(u + c.nblk);
        __syncthreads();
        if (valid) {
        const int mat = u / per, rr = u - mat * per, kt = rr / tn, nt = rr - kt * tn;
        const int dmat = grp ? (mat / grp) * (grp + 1) + (mat % grp) : mat;
        bf16_t* d = dst + (size_t)dmat * dst_stride;
        const int nl = c.tid & 63, kq = (c.tid >> 6) * 32;
        if (kind >= 3) {
            unsigned char* d8 = (unsigned char*)dst + (size_t)dmat * dst_stride;
            const float sc8 = (kind == 3) ? 8.f : 32.f;
            unsigned w8[8];
#pragma unroll
            for (int j = 0; j < 8; ++j) {
                int w_ = __builtin_amdgcn_cvt_pk_fp8_f32(lds[(kq + 4 * j) * 68 + nl] * sc8, lds[(kq + 4 * j + 1) * 68 + nl] * sc8, 0, false);
                w_ = __builtin_amdgcn_cvt_pk_fp8_f32(lds[(kq + 4 * j + 2) * 68 + nl] * sc8, lds[(kq + 4 * j + 3) * 68 + nl] * sc8, w_, true);
                w8[j] = (unsigned)w_;
            }
            const int n8 = nt * 64 + nl;
            const int drow8 = (kind == 3) ? n8 : ((n8 >> 4) * 32 + (n8 & 15) + (kind == 5 ? 16 : 0));
            u32x4* dp8 = (u32x4*)(d8 + (size_t)drow8 * K + kt * 128 + kq);
            dp8[0] = (u32x4){w8[0], w8[1], w8[2], w8[3]}; dp8[1] = (u32x4){w8[4], w8[5], w8[6], w8[7]};
        } else {
        unsigned w[16];
#pragma unroll
        for (int j = 0; j < 16; ++j) w[j] = pk2(lds[(kq + 2 * j) * 68 + nl], lds[(kq + 2 * j + 1) * 68 + nl]);
        const int n = nt * 64 + nl;
        const int drow = (kind == 0) ? n : ((n >> 4) * 32 + (n & 15) + (kind == 2 ? 16 : 0));
        u32x4* dp = (u32x4*)(d + (size_t)drow * K + kt * 128 + kq);
        dp[0] = (u32x4){w[0], w[1], w[2], w[3]}; dp[1] = (u32x4){w[4], w[5], w[6], w[7]};
        dp[2] = (u32x4){w[8], w[9], w[10], w[11]}; dp[3] = (u32x4){w[12], w[13], w[14], w[15]};
        }
        }
        __syncthreads();
    }
#undef CV_LOAD
}

__device__ __forceinline__ void phase_prologue(const Args& a, const Ctx& c) {
    unsigned char* ws = a.ws;
    bf16_t* WIN = (bf16_t*)(ws + WS_WIN);
    conv_family((const float*)a.in[2], 2, (size_t)1024 * 2472, 1024, 2472, NPAD, WIN, 2 * WIN_ELEMS, 0, 0, c);
    conv_family((const float*)a.in[12], 2, (size_t)1024 * 2312, 1024, 2312, NPAD, WIN + WIN_ELEMS, 2 * WIN_ELEMS, 0, 0, c);
    conv_family((const float*)a.in[4], 2, (size_t)256 * 768, 256, 768, 768, (bf16_t*)(ws + WS_WQB), WQB_ELEMS, 0, 0, c);
    conv_family((const float*)a.in[6], 2, (size_t)128 * 1024, 128, 1024, 1024, (bf16_t*)(ws + WS_WKVB), WKVB_ELEMS, 0, 0, c);
    bf16_t* WOUT = (bf16_t*)(ws + WS_WOUT);
    conv_family((const float*)a.in[11], 2, (size_t)1024 * 1024, 1024, 1024, 1024, WOUT, 2 * WOUT_ELEMS, 0, 0, c);
    conv_family((const float*)a.in[17], 2, (size_t)1024 * 1024, 1024, 1024, 1024, WOUT + WOUT_ELEMS, 2 * WOUT_ELEMS, 0, 0, c);
    conv_family((const float*)a.in[20], 4, (size_t)1024 * 64, 1024, 64, 128, (bf16_t*)(ws + WS_WRT), WRT_ELEMS, 0, 0, c);
    bf16_t* WGU = (bf16_t*)(ws + WS_WGU);
#if MOE1_F8
    conv_family((const float*)a.in[22], 256, (size_t)1024 * 256, 1024, 256, 256, WGU, WGU_ELEMS, 64, 4, c);
    conv_family((const float*)a.in[23], 256, (size_t)1024 * 256, 1024, 256, 256, WGU, WGU_ELEMS, 64, 5, c);
    conv_family((const float*)a.in[25], 4, (size_t)1024 * 256, 1024, 256, 256, (bf16_t*)((unsigned char*)WGU + 64 * WGU_ELEMS), 65 * WGU_ELEMS, 0, 4, c);
    conv_family((const float*)a.in[26], 4, (size_t)1024 * 256, 1024, 256, 256, (bf16_t*)((unsigned char*)WGU + 64 * WGU_ELEMS), 65 * WGU_ELEMS, 0, 5, c);
#else
    conv_family((const float*)a.in[22], 256, (size_t)1024 * 256, 1024, 256, 256, WGU, WGU_ELEMS, 64, 1, c);
    conv_family((const float*)a.in[23], 256, (size_t)1024 * 256, 1024, 256, 256, WGU, WGU_ELEMS, 64, 2, c);
    conv_family((const float*)a.in[25], 4, (size_t)1024 * 256, 1024, 256, 256, WGU + 64 * WGU_ELEMS, 65 * WGU_ELEMS, 0, 1, c);
    conv_family((const float*)a.in[26], 4, (size_t)1024 * 256, 1024, 256, 256, WGU + 64 * WGU_ELEMS, 65 * WGU_ELEMS, 0, 2, c);
#endif
    bf16_t* WDN = (bf16_t*)(ws + WS_WDN);
#if MOE2_F8
    conv_family((const float*)a.in[24], 256, (size_t)256 * 1024, 256, 1024, 1024, WDN, WDN_ELEMS, 64, 3, c);
    conv_family((const float*)a.in[27], 4, (size_t)256 * 1024, 256, 1024, 1024, (bf16_t*)((unsigned char*)WDN + 64 * WDN_ELEMS), 65 * WDN_ELEMS, 0, 3, c);
#else
    conv_family((const float*)a.in[24], 256, (size_t)256 * 1024, 256, 1024, 1024, WDN, WDN_ELEMS, 64, 0, c);
    conv_family((const float*)a.in[27], 4, (size_t)256 * 1024, 256, 1024, 1024, WDN + 64 * WDN_ELEMS, 65 * WDN_ELEMS, 0, 0, c);
#endif
    {
        const float* x = (const float*)a.in[0]; bf16_t* xb = (bf16_t*)(ws + WS_XBF);
        const size_t n8 = (size_t)T * 1024 / 8;
        for (size_t i = (size_t)c.bid * 256 + c.tid; i < n8; i += (size_t)c.nblk * 256) {
            const f32x4 v0 = __builtin_nontemporal_load((const f32x4*)(x + i * 8)), v1 = __builtin_nontemporal_load((const f32x4*)(x + i * 8 + 4));
            *(u32x4*)(xb + i * 8) = (u32x4){pk2(v0[0], v0[1]), pk2(v0[2], v0[3]), pk2(v1[0], v1[1]), pk2(v1[2], v1[3])};
        }
    }
    {
        const int* pos = (const int*)a.in[1];
        float* rm = (float*)(ws + WS_ROPEM); float* rs = (float*)(ws + WS_ROPES);
        const float ln_theta = 9.210340371976184f;
        for (int i = c.bid * 256 + c.tid; i < T * 16; i += c.nblk * 256) {
            const int t = i >> 4, f = i & 15;
            const float inv = expf(-((float)(2 * f) / 32.f) * ln_theta);
            const float ang = (float)pos[t] * inv;
            rm[i * 2] = cosf(ang); rm[i * 2 + 1] = sinf(ang);
        }
        for (int i = c.bid * 256 + c.tid; i < T * 32; i += c.nblk * 256) {
            const int t = i >> 5, f = i & 31;
            const float inv = expf(-((float)(2 * f) / 64.f) * ln_theta);
            const float ang = (float)pos[t] * inv;
            rs[i * 2] = cosf(ang); rs[i * 2 + 1] = sinf(ang);
        }
    }
}

__device__ __forceinline__ void phase_inproj(const bf16_t* XBF, const bf16_t* W, bf16_t* PROJ, float* GATES, int gbase, const Ctx& c) {
    const int ntn = NPAD / 128;
    for (int i = 0;; ++i) {
        int mt, nt; bool valid; if (!tile_map2(i, c, T / 128, ntn, mt, nt, valid)) break;
        const bf16_t* a0 = XBF + (size_t)(mt * 128 + (c.tid >> 2)) * 1024;
        const bf16_t* b0 = W + (size_t)(nt * 128 + (c.tid >> 2)) * 1024;
        f32x4 acc[4][4];
        gemm_tile(a0, a0 + 64 * 1024, b0, b0 + 64 * 1024, 32, acc, c);
#pragma unroll
        for (int m = 0; m < 4; ++m) {
            const int rl = c.wr * 64 + m * 16 + c.fr, row = mt * 128 + rl;
#pragma unroll
            for (int n = 0; n < 4; ++n) {
                const int cl = c.wc * 64 + n * 16 + c.fq * 4, col = nt * 128 + cl;
                const f32x4 v = acc[m][n];
                tile_put(c, rl, cl, (u32x2){pk2(v[0], v[1]), pk2(v[2], v[3])});
                if (valid && col >= gbase && col < gbase + 8) *(f32x4*)(GATES + (size_t)row * 8 + (col - gbase)) = v;
            }
        }
        tile_flush<128>(c, PROJ + (size_t)mt * 128 * NPAD + nt * 128, NPAD, valid);
    }
}

constexpr int MLAUP_TILES = (T / 128) * 6 + (T / 128) * 8;
__device__ __forceinline__ void mla_up_tile(int u, const bf16_t* CQ, const bf16_t* WQB, const bf16_t* CKV, const bf16_t* WKVB,
                             const float* ROPEM, bf16_t* QF, bf16_t* KN, bf16_t* VV, const Ctx& c) {
    const int tq = (T / 128) * 6;
    const float qscale = 0.10206207261596577f * 1.4426950408889634f;
    {
        f32x4 acc[4][4];
        if (u < tq) {
            const int mt = u / 6, nt = u % 6;
            const bf16_t* a0 = CQ + (size_t)(mt * 128 + (c.tid >> 2)) * 256;
            const bf16_t* b0 = WQB + (size_t)(nt * 128 + (c.tid >> 2)) * 256;
            gemm_tile(a0, a0 + 64 * 256, b0, b0 + 64 * 256, 8, acc, c);
#pragma unroll
            for (int m = 0; m < 4; ++m) {
                const int row = mt * 128 + c.wr * 64 + m * 16 + c.fr;
#pragma unroll
                for (int np = 0; np < 2; ++np) {
                    const int cg = nt * 128 + c.wc * 64 + np * 32;
                    f32x4 v0 = acc[m][2 * np], v1 = acc[m][2 * np + 1];
                    if (((cg >> 5) % 3) == 2) {
#pragma unroll
                        for (int j = 0; j < 4; ++j) {
                            const int i = c.fq * 4 + j;
                            const float cs = ROPEM[((size_t)row * 16 + i) * 2], sn = ROPEM[((size_t)row * 16 + i) * 2 + 1];
                            const float x1 = v0[j], x2 = v1[j];
                            v0[j] = x1 * cs - x2 * sn; v1[j] = x2 * cs + x1 * sn;
                        }
                    }
                    v0 *= qscale; v1 *= qscale;
                    *(u32x2*)(QF + (size_t)row * 768 + cg + c.fq * 4) = (u32x2){pk2(v0[0], v0[1]), pk2(v0[2], v0[3])};
                    *(u32x2*)(QF + (size_t)row * 768 + cg + 16 + c.fq * 4) = (u32x2){pk2(v1[0], v1[1]), pk2(v1[2], v1[3])};
                }
            }
        } else {
            const int v = u - tq, mt = v / 8, nt = v % 8;
            const bf16_t* a0 = CKV + (size_t)(mt * 128 + (c.tid >> 2)) * 128;
            const bf16_t* b0 = WKVB + (size_t)(nt * 128 + (c.tid >> 2)) * 128;
            gemm_tile(a0, a0 + 64 * 128, b0, b0 + 64 * 128, 4, acc, c);
            bf16_t* dst = (c.wc == 0) ? KN : VV;
#pragma unroll
            for (int m = 0; m < 4; ++m) {
                const int row = mt * 128 + c.wr * 64 + m * 16 + c.fr;
#pragma unroll
                for (int n = 0; n < 4; ++n) {
                    const f32x4 x = acc[m][n];
                    *(u32x2*)(dst + (size_t)row * 512 + nt * 64 + n * 16 + c.fq * 4) = (u32x2){pk2(x[0], x[1]), pk2(x[2], x[3])};
                }
            }
        }
    }
}

__device__ __forceinline__ void phase_outproj(const bf16_t* MIXO, const bf16_t* W, const float* xres, float* YBUF, const Ctx& c) {
    for (int i = 0;; ++i) {
        int mt, nt; bool valid; if (!tile_map2(i, c, T / 128, 8, mt, nt, valid)) break;
        const bf16_t* a0 = MIXO + (size_t)(mt * 128 + (c.tid >> 2)) * 1024;
        const bf16_t* b0 = W + (size_t)(nt * 128 + (c.tid >> 2)) * 1024;
        f32x4 acc[4][4];
        gemm_tile(a0, a0 + 64 * 1024, b0, b0 + 64 * 1024, 32, acc, c);
#pragma unroll
        for (int m = 0; m < 4; ++m) {
            const int row = mt * 128 + c.wr * 64 + m * 16 + c.fr;
#pragma unroll
            for (int n = 0; n < 4; ++n) {
                const int col = nt * 128 + c.wc * 64 + n * 16 + c.fq * 4;
                const f32x4 xr = *(const f32x4*)(xres + (size_t)row * 1024 + col);
                if (valid) *(f32x4*)(YBUF + (size_t)row * 1024 + col) = xr * ALPHA + acc[m][n];
            }
        }
    }
}

__device__ __forceinline__ void phase_router(const bf16_t* XBF, const bf16_t* W, float* LOG, const Ctx& c) {
    for (int base = 0; base < T / 128; base += c.nblk) {
        const bool valid = (base + c.bid) < T / 128; const int mt = valid ? base + c.bid : 0;
        const bf16_t* a0 = XBF + (size_t)(mt * 128 + (c.tid >> 2)) * 1024;
        const bf16_t* b0 = W + (size_t)(c.tid >> 2) * 1024;
        f32x4 acc[4][4];
        gemm_tile(a0, a0 + 64 * 1024, b0, b0 + 64 * 1024, 32, acc, c);
        if (c.wc == 0 && valid) {
#pragma unroll
            for (int m = 0; m < 4; ++m) {
                const int row = mt * 128 + c.wr * 64 + m * 16 + c.fr;
#pragma unroll
                for (int n = 0; n < 4; ++n) *(f32x4*)(LOG + (size_t)row * 64 + n * 16 + c.fq * 4) = acc[m][n];
            }
        }
    }
}

__device__ __forceinline__ void build_block_table(const unsigned* CNT, int* bst, const Ctx& c) {
    __syncthreads();
    if (c.wid == 0) {
        const int cnt = (int)__hip_atomic_load(CNT + c.lane, __ATOMIC_RELAXED, __HIP_MEMORY_SCOPE_AGENT);
        const int nb = (cnt + RBR - 1) / RBR;
        int inc = nb;
#pragma unroll
        for (int o = 1; o < 64; o <<= 1) { const int x = shfl_up_(inc, o); if (c.lane >= o) inc += x; }
        bst[c.lane] = inc - nb; bst[66 + c.lane] = cnt;
        if (c.lane == 63) { bst[64] = inc; bst[65] = inc + T / RBR; bst[66 + 64] = T; }
    }
    __syncthreads();
}
__device__ __forceinline__ int find_expert(const int* bst, int rb, const Ctx& c) {
    return __popcll(__ballot(bst[1 + c.lane] <= rb));
}

__device__ __forceinline__ void phase_moe1(const bf16_t* XBF, const bf16_t* WGU, const unsigned* CNT, const int* LTOK, const float* LW, bf16_t* HBUF, const Ctx& c) {
    int* bst = (int*)(c.smem + 65536 + 64);
    build_block_table(CNT, bst, c);
    const int nsb = bst[65] * 2;
    for (int i = 0;; ++i) {
        int sbk, nt; bool valid; if (!tile_map2(i, c, nsb, 4, sbk, nt, valid)) break;
        const int rb = sbk >> 1, hb = sbk & 1;
        const int e = find_expert(bst, rb, c);
        const int lb = rb - bst[e], cnt = bst[66 + e];
        const int p0 = lb * RBR + hb * 128 + (c.tid >> 2), p1 = p0 + 64;
        const int t0 = (p0 < cnt) ? LTOK[(size_t)e * CAP + p0] : 0;
        const int t1 = (p1 < cnt) ? LTOK[(size_t)e * CAP + p1] : 0;
        const bf16_t* a0 = XBF + (size_t)t0 * 1024;
        const bf16_t* a1 = XBF + (size_t)t1 * 1024;
        const bf16_t* b0 = WGU + (size_t)e * WGU_ELEMS + (size_t)(nt * 128 + (c.tid >> 2)) * 1024;
        f32x4 acc[4][4];
        gemm_tile(a0, a1, b0, b0 + 64 * 1024, 32, acc, c);
#pragma unroll
        for (int m = 0; m < 4; ++m) {
            const int rl = c.wr * 64 + m * 16 + c.fr;
            const int pw = lb * RBR + hb * 128 + rl;
            const float wrow = (pw < cnt) ? LW[(size_t)e * CAP + pw] : 0.f;
#pragma unroll
            for (int n = 0; n < 2; ++n) {
                const f32x4 g = acc[m][n], up = acc[m][n + 2];
                float h[4];
#pragma unroll
                for (int j = 0; j < 4; ++j) h[j] = siluf_(g[j]) * up[j] * wrow;
                tile_put(c, rl, c.wc * 32 + n * 16 + c.fq * 4, (u32x2){pk2(h[0], h[1]), pk2(h[2], h[3])});
            }
        }
        tile_flush<64>(c, HBUF + ((size_t)rb * RBR + hb * 128) * 256 + nt * 64, 256, valid);
    }
}

__device__ __forceinline__ void phase_moe2(const bf16_t* HBUF, const bf16_t* WDN, const unsigned* CNT, bf16_t* Y, const Ctx& c) {
    int* bst = (int*)(c.smem + 65536 + 64);
    build_block_table(CNT, bst, c);
    const int nsb = bst[65] * 2;
    for (int i = 0;; ++i) {
        int sbk, nt; bool valid; if (!tile_map2(i, c, nsb, 8, sbk, nt, valid)) break;
        const int rb = sbk >> 1;
        const int e = find_expert(bst, rb, c);
        const bf16_t* a0 = HBUF + ((size_t)sbk * 128 + (c.tid >> 2)) * 256;
        const bf16_t* b0 = WDN + (size_t)e * WDN_ELEMS + (size_t)(nt * 128 + (c.tid >> 2)) * 256;
        f32x4 acc[4][4];
        gemm_tile(a0, a0 + 64 * 256, b0, b0 + 64 * 256, 8, acc, c);
#pragma unroll
        for (int m = 0; m < 4; ++m) {
            const int lr = c.wr * 64 + m * 16 + c.fr;
#pragma unroll
            for (int n = 0; n < 4; ++n) {
                const f32x4 v = acc[m][n];
                tile_put(c, lr, c.wc * 64 + n * 16 + c.fq * 4, (u32x2){pk2(v[0], v[1]), pk2(v[2], v[3])});
            }
        }
        tile_flush<128>(c, Y + (size_t)sbk * 128 * 1024 + nt * 128, 1024, valid);
    }
}

__device__ __forceinline__ float dppf(float v, int ctrl_sel) {
    int x = __builtin_bit_cast(int, v), r;
    if (ctrl_sel == 0) r = __builtin_amdgcn_update_dpp(0, x, 0xB1, 0xF, 0xF, true);
    else if (ctrl_sel == 1) r = __builtin_amdgcn_update_dpp(0, x, 0x4E, 0xF, 0xF, true);
    else if (ctrl_sel == 2) r = __builtin_amdgcn_update_dpp(0, x, 0x141, 0xF, 0xF, true);
    else r = __builtin_amdgcn_update_dpp(0, x, 0x140, 0xF, 0xF, true);
    return __builtin_bit_cast(float, r);
}
__device__ __forceinline__ float red16(float v) { v += dppf(v, 0); v += dppf(v, 1); v += dppf(v, 2); v += dppf(v, 3); return v; }

template <bool F32OUT>
__device__ __forceinline__ void ln_row_store(float (&v)[16], const float* g, const float* b, float* of32, bf16_t* obf, int lane) {
    float s = 0.f;
#pragma unroll
    for (int i = 0; i < 16; ++i) s += v[i];
    const float mean = wave_sum(s) * (1.f / 1024.f);
    float q = 0.f;
#pragma unroll
    for (int i = 0; i < 16; ++i) { v[i] -= mean; q += v[i] * v[i]; }
    const float rstd = rsqrtf(wave_sum(q) * (1.f / 1024.f) + 1e-5f);
#pragma unroll
    for (int hf = 0; hf < 2; ++hf) {
        const int col = hf * 512 + lane * 8;
        const f32x4 g0 = *(const f32x4*)(g + col), g1 = *(const f32x4*)(g + col + 4);
        const f32x4 b0 = *(const f32x4*)(b + col), b1 = *(const f32x4*)(b + col + 4);
        f32x4 y0, y1;
#pragma unroll
        for (int j = 0; j < 4; ++j) { y0[j] = v[hf * 8 + j] * rstd * g0[j] + b0[j]; y1[j] = v[hf * 8 + 4 + j] * rstd * g1[j] + b1[j]; }
        if constexpr (F32OUT) { *(f32x4*)(of32 + col) = y0; *(f32x4*)(of32 + col + 4) = y1; }
        *(u32x4*)(obf + col) = (u32x4){pk2(y0[0], y0[1]), pk2(y0[2], y0[3]), pk2(y1[0], y1[1]), pk2(y1[2], y1[3])};
    }
}

__device__ __forceinline__ void phase_ln1(const bf16_t* YBUF, const float* g, const float* b, bf16_t* XBF, const Ctx& c) {
    for (int t = c.bid * 4 + c.wid; t < T; t += c.nblk * 4) {
        float v[16];
#pragma unroll
        for (int hf = 0; hf < 2; ++hf) {
            const u32x4 r = *(const u32x4*)(YBUF + (size_t)t * 1024 + hf * 512 + c.lane * 8);
            float f[8]; unpack8(r, f);
#pragma unroll
            for (int j = 0; j < 8; ++j) v[hf * 8 + j] = f[j];
        }
        ln_row_store<false>(v, g, b, nullptr, XBF + (size_t)t * 1024, c.lane);
    }
}

template <bool LASTL>
__device__ __forceinline__ void phase_combine8(const unsigned char* Y, const int* ASG, const float* ASGW, const unsigned* CNT, const float* g, const float* b,
                                               float* XOUT, bf16_t* XBF, const Ctx& c) {
    int* bst = (int*)(c.smem + 65536 + 64);
    build_block_table(CNT, bst, c);
    const int lane = c.lane;
    for (int t = c.bid * 4 + c.wid; t < T; t += c.nblk * 4) {
        float v[16];
        {
            const u32x4 r0 = *(const u32x4*)(XBF + (size_t)t * 1024 + lane * 16), r1 = *(const u32x4*)(XBF + (size_t)t * 1024 + lane * 16 + 8);
            float f[8]; unpack8(r0, f);
#pragma unroll
            for (int j = 0; j < 8; ++j) v[j] = f[j] * ALPHA;
            unpack8(r1, f);
#pragma unroll
            for (int j = 0; j < 8; ++j) v[8 + j] = f[j] * ALPHA;
        }
        u32x4 yr[9]; float wk[9];
#pragma unroll
        for (int k = 0; k < 9; ++k) {
            size_t crow; wk[k] = 1.f / 16.f;
            if (k < 8) { const int asg = ASG[(size_t)t * 8 + k]; crow = (size_t)bst[asg >> 16] * RBR + (asg & 0xffff); wk[k] = ASGW[(size_t)t * 8 + k] * (1.f / 16.f); }
            else crow = (size_t)bst[64] * RBR + t;
            yr[k] = *(const u32x4*)(Y + crow * 1024 + lane * 16);
        }
#pragma unroll
        for (int k = 0; k < 9; ++k)
#pragma unroll
            for (int q = 0; q < 4; ++q) {
                const f32x2 lo = __builtin_amdgcn_cvt_pk_f32_fp8((int)yr[k][q], false), hi = __builtin_amdgcn_cvt_pk_f32_fp8((int)yr[k][q], true);
                v[q * 4 + 0] += lo[0] * wk[k]; v[q * 4 + 1] += lo[1] * wk[k]; v[q * 4 + 2] += hi[0] * wk[k]; v[q * 4 + 3] += hi[1] * wk[k];
            }
        float s = 0.f;
#pragma unroll
        for (int i = 0; i < 16; ++i) s += v[i];
        const float mean = wave_sum_dpp(s) * (1.f / 1024.f);
        float q2 = 0.f;
#pragma unroll
        for (int i = 0; i < 16; ++i) { v[i] -= mean; q2 += v[i] * v[i]; }
        const float rstd = rsqrtf(wave_sum_dpp(q2) * (1.f / 1024.f) + 1e-5f);
        float y[16];
#pragma unroll
        for (int q = 0; q < 4; ++q) {
            const f32x4 gg = *(const f32x4*)(g + lane * 16 + q * 4), bb = *(const f32x4*)(b + lane * 16 + q * 4);
#pragma unroll
            for (int j = 0; j < 4; ++j) y[q * 4 + j] = v[q * 4 + j] * rstd * gg[j] + bb[j];
            if constexpr (LASTL) *(f32x4*)(XOUT + (size_t)t * 1024 + lane * 16 + q * 4) = (f32x4){y[q * 4], y[q * 4 + 1], y[q * 4 + 2], y[q * 4 + 3]};
        }
        *(u32x4*)(XBF + (size_t)t * 1024 + lane * 16) = (u32x4){pk2(y[0], y[1]), pk2(y[2], y[3]), pk2(y[4], y[5]), pk2(y[6], y[7])};
        *(u32x4*)(XBF + (size_t)t * 1024 + lane * 16 + 8) = (u32x4){pk2(y[8], y[9]), pk2(y[10], y[11]), pk2(y[12], y[13]), pk2(y[14], y[15])};
    }
}

template <bool LASTL>
__device__ __forceinline__ void phase_combine(const bf16_t* Y, const int* ASG, const float* ASGW, const unsigned* CNT, const float* g, const float* b,
                              float* XOUT, bf16_t* XBF, const Ctx& c) {
    int* bst = (int*)(c.smem + 65536 + 64);
    build_block_table(CNT, bst, c);
    for (int t = c.bid * 4 + c.wid; t < T; t += c.nblk * 4) {
        float v[16];
#pragma unroll
        for (int hf = 0; hf < 2; ++hf) {
            const u32x4 r = *(const u32x4*)(XBF + (size_t)t * 1024 + hf * 512 + c.lane * 8);
            float f[8]; unpack8(r, f);
#pragma unroll
            for (int j = 0; j < 8; ++j) v[hf * 8 + j] = f[j] * ALPHA;
        }
#pragma unroll
        for (int k = 0; k < 9; ++k) {
            size_t crow; float wk = 1.f;
            if (k < 8) { const int asg = ASG[(size_t)t * 8 + k]; crow = (size_t)bst[asg >> 16] * RBR + (asg & 0xffff); wk = ASGW[(size_t)t * 8 + k]; }
            else crow = (size_t)bst[64] * RBR + t;
#pragma unroll
            for (int hf = 0; hf < 2; ++hf) {
                const u32x4 r = *(const u32x4*)(Y + crow * 1024 + hf * 512 + c.lane * 8);
                float f[8]; unpack8(r, f);
#pragma unroll
                for (int j = 0; j < 8; ++j) v[hf * 8 + j] += f[j] * wk;
            }
        }
        ln_row_store<LASTL>(v, g, b, XOUT + (size_t)t * 1024, XBF + (size_t)t * 1024, c.lane);
    }
}

__device__ __forceinline__ void phase_route(const float* LOG, const float* rb, unsigned* CNT, int* LTOK, float* LW, int* ASG, float* ASGW, const Ctx& c) {
    int* lcnt = (int*)c.smem;
    int* lbase = lcnt + 64;
    int* sel_e = lbase + 64;
    int* sel_p = sel_e + 256;
    float* sel_w = (float*)(sel_p + 256);
    const float rbias = rb[c.lane];
    for (int base = 0; base < T / 32; base += c.nblk) {
        const int ch = base + c.bid; const bool valid = ch < T / 32;
        __syncthreads();
        if (c.tid < 64) lcnt[c.tid] = 0;
        __syncthreads();
        if (valid) for (int tl = c.wid; tl < 32; tl += 4) {
            const int t = ch * 32 + tl;
            const float lg = LOG[(size_t)t * 64 + c.lane];
            const float sc = 1.f / (1.f + expf(-lg));
            const float v = sc + rbias;
            float m1 = v;
            m1 = grp8_max(m1);
            int cand = (v == m1) ? c.lane : 999;
            cand = grp8_min(cand);
            float m2 = (c.lane == cand) ? -INFINITY : v;
            m2 = grp8_max(m2);
            const float gs = m1 + m2;
            const int g = c.lane >> 3;
            int grank = 0;
#pragma unroll
            for (int gg = 0; gg < 8; ++gg) { const float o = shfl_c_(gs, gg * 8); grank += ((o > gs) || (o == gs && gg < g)) ? 1 : 0; }
            const bool gsel = grank < 4;
            const float mv = gsel ? v : -INFINITY;
            int rank = 0;
#pragma unroll 8
            for (int jj = 0; jj < 64; ++jj) { const float o = shfl_c_(mv, jj); rank += ((o > mv) || (o == mv && jj < c.lane)) ? 1 : 0; }
            const bool sel = gsel && rank < 8;
            const float ssum = wave_sum(sel ? sc : 0.f);
            const float w = sc / ssum * 2.5f;
            const unsigned long long bal = __ballot(sel);
            const int slot = __popcll(bal & ((1ull << c.lane) - 1ull));
            if (sel) {
                const int p = atomicAdd(&lcnt[c.lane], 1);
                sel_e[tl * 8 + slot] = c.lane; sel_p[tl * 8 + slot] = p; sel_w[tl * 8 + slot] = w;
            }
        }
        __syncthreads();
        if (valid && c.tid < 64) { const int n = lcnt[c.tid]; lbase[c.tid] = n ? (int)atomicAdd(CNT + c.tid, (unsigned)n) : 0; }
        __syncthreads();
        if (valid) {
            const int tl = c.tid >> 3, t = ch * 32 + tl;
            const int e = sel_e[c.tid], pos = lbase[e] + sel_p[c.tid];
            LTOK[(size_t)e * CAP + pos] = t; LW[(size_t)e * CAP + pos] = sel_w[c.tid];
            ASG[(size_t)t * 8 + (c.tid & 7)] = (e << 16) | pos; ASGW[(size_t)t * 8 + (c.tid & 7)] = sel_w[c.tid];
            if (c.tid < 32) { const int ts = ch * 32 + c.tid; LTOK[(size_t)64 * CAP + ts] = ts; LW[(size_t)64 * CAP + ts] = 1.f; }
        }
    }
}

__device__ __forceinline__ void phase_lnroute(const bf16_t* YBUF, const float* g, const float* b, bf16_t* XBF, unsigned char* XB8, const bf16_t* W, const float* rb,
                                              unsigned* CNT, int* LTOK, float* LW, int* ASG, float* ASGW, const Ctx& c) {
    unsigned char* xa = c.smem;
    int* lcnt = (int*)(c.smem + 65536 + 64);
    int* lbase = lcnt + 64;
    float* lgt = (float*)c.smem;
    int* sel_e = (int*)(c.smem + 8192);
    int* sel_p = sel_e + 256;
    float* sel_w = (float*)(sel_p + 256);
    const int lane = c.lane;
    const float rbias = rb[lane];
    for (int base = 0; base < T / 32; base += c.nblk) {
        const int ch = base + c.bid; const bool valid = ch < T / 32;
        __syncthreads();
        if (c.tid < 64) lcnt[c.tid] = 0;
        u32x4 raw[8][2];
#pragma unroll
        for (int i = 0; i < 8; ++i)
#pragma unroll
            for (int hf = 0; hf < 2; ++hf) raw[i][hf] = valid ? *(const u32x4*)(YBUF + (size_t)(ch * 32 + c.wid + 4 * i) * 1024 + hf * 512 + lane * 8) : (u32x4){0u, 0u, 0u, 0u};
        if (valid)
#pragma unroll
        for (int i = 0; i < 8; ++i) {
            const int tl = c.wid + 4 * i;
            const int t = ch * 32 + tl;
            float v[16];
#pragma unroll
            for (int hf = 0; hf < 2; ++hf) {
                float f[8]; unpack8(raw[i][hf], f);
#pragma unroll
                for (int j = 0; j < 8; ++j) v[hf * 8 + j] = f[j];
            }
            float s = 0.f;
#pragma unroll
            for (int i = 0; i < 16; ++i) s += v[i];
            const float mean = wave_sum(s) * (1.f / 1024.f);
            float q = 0.f;
#pragma unroll
            for (int i = 0; i < 16; ++i) { v[i] -= mean; q += v[i] * v[i]; }
            const float rstd = rsqrtf(wave_sum(q) * (1.f / 1024.f) + 1e-5f);
#pragma unroll
            for (int hf = 0; hf < 2; ++hf) {
                const int col = hf * 512 + lane * 8;
                const f32x4 g0 = *(const f32x4*)(g + col), g1 = *(const f32x4*)(g + col + 4);
                const f32x4 b0 = *(const f32x4*)(b + col), b1 = *(const f32x4*)(b + col + 4);
                f32x4 y0, y1;
#pragma unroll
                for (int j = 0; j < 4; ++j) { y0[j] = v[hf * 8 + j] * rstd * g0[j] + b0[j]; y1[j] = v[hf * 8 + 4 + j] * rstd * g1[j] + b1[j]; }
                const u32x4 pk = (u32x4){pk2(y0[0], y0[1]), pk2(y0[2], y0[3]), pk2(y1[0], y1[1]), pk2(y1[2], y1[3])};
                *(u32x4*)(XBF + (size_t)t * 1024 + col) = pk;
                *(u32x4*)(xa + tl * 2048 + (((hf * 64 + lane) ^ (tl & 15)) * 16)) = pk;
#if MOE1_F8
                {
                    int w0 = __builtin_amdgcn_cvt_pk_fp8_f32(y0[0] * 16.f, y0[1] * 16.f, 0, false); w0 = __builtin_amdgcn_cvt_pk_fp8_f32(y0[2] * 16.f, y0[3] * 16.f, w0, true);
                    int w1 = __builtin_amdgcn_cvt_pk_fp8_f32(y1[0] * 16.f, y1[1] * 16.f, 0, false); w1 = __builtin_amdgcn_cvt_pk_fp8_f32(y1[2] * 16.f, y1[3] * 16.f, w1, true);
                    *(u32x2*)(XB8 + (size_t)t * 1024 + col) = (u32x2){(unsigned)w0, (unsigned)w1};
                }
#endif
            }
        }
        __syncthreads();
        f32x4 acc0 = (f32x4){0.f, 0.f, 0.f, 0.f}, acc1 = (f32x4){0.f, 0.f, 0.f, 0.f};
        {
            const int r = lane & 15, kq = lane >> 4;
            const bf16_t* wrow = W + (size_t)(c.wid * 16 + r) * 1024 + kq * 8;
#pragma unroll 1
            for (int kb = 0; kb < 32; kb += 8) {
                bf16x8 bfr[8];
#pragma unroll
                for (int j = 0; j < 8; ++j) bfr[j] = *(const bf16x8*)(wrow + (kb + j) * 32);
#pragma unroll
                for (int j = 0; j < 8; ++j) {
                    const int chunk = ((kb + j) * 4 + kq) ^ r;
                    const bf16x8 a0 = *(const bf16x8*)(xa + r * 2048 + chunk * 16), a1 = *(const bf16x8*)(xa + (16 + r) * 2048 + chunk * 16);
                    acc0 = __builtin_amdgcn_mfma_f32_16x16x32_bf16(a0, bfr[j], acc0, 0, 0, 0);
                    acc1 = __builtin_amdgcn_mfma_f32_16x16x32_bf16(a1, bfr[j], acc1, 0, 0, 0);
                }
            }
        }
        __syncthreads();
        {
            const int e = c.wid * 16 + (lane & 15), r0 = 4 * (lane >> 4);
#pragma unroll
            for (int j = 0; j < 4; ++j) { lgt[(r0 + j) * 64 + e] = acc0[j]; lgt[(16 + r0 + j) * 64 + e] = acc1[j]; }
        }
        __syncthreads();
        if (valid) for (int tl = c.wid; tl < 32; tl += 4) {
            const float lg = lgt[tl * 64 + lane];
            const float sc = 1.f / (1.f + expf(-lg));
            const float v = sc + rbias;
            float m1 = v;
            m1 = grp8_max(m1);
            int cand = (v == m1) ? lane : 999;
            cand = grp8_min(cand);
            float m2 = (lane == cand) ? -INFINITY : v;
            m2 = grp8_max(m2);
            const float gs = m1 + m2;
            const int gi = lane >> 3;
            int grank = 0;
#pragma unroll
            for (int gg = 0; gg < 8; ++gg) { const float o = shfl_c_(gs, gg * 8); grank += ((o > gs) || (o == gs && gg < gi)) ? 1 : 0; }
            const bool gsel = grank < 4;
            const float mv = gsel ? v : -INFINITY;
            int rank = 0;
#pragma unroll 8
            for (int jj = 0; jj < 64; ++jj) { const float o = shfl_c_(mv, jj); rank += ((o > mv) || (o == mv && jj < lane)) ? 1 : 0; }
            const bool sel = gsel && rank < 8;
            const float ssum = wave_sum(sel ? sc : 0.f);
            const float w = sc / ssum * 2.5f;
            const unsigned long long bal = __ballot(sel);
            const int slot = __popcll(bal & ((1ull << lane) - 1ull));
            if (sel) {
                const int p = atomicAdd(&lcnt[lane], 1);
                sel_e[tl * 8 + slot] = lane; sel_p[tl * 8 + slot] = p; sel_w[tl * 8 + slot] = w;
            }
        }
        __syncthreads();
        if (valid && c.tid < 64) { const int n = lcnt[c.tid]; lbase[c.tid] = n ? (int)atomicAdd(CNT + c.tid, (unsigned)n) : 0; }
        __syncthreads();
        if (valid) {
            const int tl = c.tid >> 3, t = ch * 32 + tl;
            const int e = sel_e[c.tid], pos = lbase[e] + sel_p[c.tid];
            LTOK[(size_t)e * CAP + pos] = t; LW[(size_t)e * CAP + pos] = sel_w[c.tid];
            ASG[(size_t)t * 8 + (c.tid & 7)] = (e << 16) | pos; ASGW[(size_t)t * 8 + (c.tid & 7)] = sel_w[c.tid];
            if (c.tid < 32) { const int ts = ch * 32 + c.tid; LTOK[(size_t)64 * CAP + ts] = ts; LW[(size_t)64 * CAP + ts] = 1.f; }
        }
    }
}

__device__ __forceinline__ void phase_prep_even(const bf16_t* PROJ, const float* GATES, const float* qn, const float* kvn, const float* cw,
                                const float* a_log, const float* dt_bias, const float* ROPEM,
                                bf16_t* CQ, bf16_t* CKV, bf16_t* KROPE, bf16_t* GQ, bf16_t* GK, bf16_t* GV, float* BETA, float* GLOG, const Ctx& c) {
    const int lane = c.lane;
    float* cwL = (float*)c.smem;
    __syncthreads();
    for (int i = c.tid; i < 4 * 1536 / 4; i += 256) *(f32x4*)(cwL + i * 4) = *(const f32x4*)(cw + i * 4);
    __syncthreads();
    for (int tb = (c.bid * 4 + c.wid) * 8; tb < T; tb += c.nblk * 4 * 8) {
        const int s0 = tb & (SEQ - 1);
        u32x4 xr[3][4];
#pragma unroll
        for (int arr = 0; arr < 3; ++arr)
#pragma unroll
            for (int w = 0; w < 3; ++w)
                xr[arr][w] = (s0 - 3 + w >= 0) ? *(const u32x4*)(PROJ + (size_t)(tb - 3 + w) * NPAD + 416 + arr * 512 + lane * 8) : (u32x4){0u, 0u, 0u, 0u};
        u32x4 nx[3]; u32x2 ncq; unsigned nckv; float nk1 = 0.f, nk2 = 0.f, ncs = 0.f, nsn = 0.f, ngate = 0.f;
#define PE_LOAD(t_) do { const bf16_t* pr_ = PROJ + (size_t)(t_) * NPAD; \
            _Pragma("unroll") for (int arr = 0; arr < 3; ++arr) nx[arr] = *(const u32x4*)(pr_ + 416 + arr * 512 + lane * 8); \
            ncq = *(const u32x2*)(pr_ + lane * 4); nckv = *(const unsigned*)(pr_ + 256 + lane * 2); \
            if (lane < 16) { nk1 = bf2f(pr_[384 + lane]); nk2 = bf2f(pr_[400 + lane]); ncs = ROPEM[((size_t)(t_) * 16 + lane) * 2]; nsn = ROPEM[((size_t)(t_) * 16 + lane) * 2 + 1]; } \
            if (lane < 8) ngate = GATES[(size_t)(t_) * 8 + lane]; } while (0)
        PE_LOAD(tb);
#pragma unroll
        for (int k = 0; k < 8; ++k) {
            const int t = tb + k;
#pragma unroll
            for (int arr = 0; arr < 3; ++arr) xr[arr][3] = nx[arr];
            const u32x2 r = ncq; const unsigned rkv = nckv; const float x1 = nk1, x2 = nk2, cs = ncs, sn = nsn, gate = ngate;
            if (k < 7) PE_LOAD(t + 1);
            {
                float v[4] = {bflo(r.x), bfhi(r.x), bflo(r.y), bfhi(r.y)};
                const float ss = wave_sum(v[0] * v[0] + v[1] * v[1] + v[2] * v[2] + v[3] * v[3]);
                const float rr = rsqrtf(ss * (1.f / 256.f) + 1e-6f);
                const f32x4 gq = *(const f32x4*)(qn + lane * 4);
                *(u32x2*)(CQ + (size_t)t * 256 + lane * 4) = (u32x2){pk2(v[0] * rr * gq[0], v[1] * rr * gq[1]), pk2(v[2] * rr * gq[2], v[3] * rr * gq[3])};
            }
            {
                const float v0 = bflo(rkv), v1 = bfhi(rkv);
                const float ss = wave_sum(v0 * v0 + v1 * v1);
                const float rr = rsqrtf(ss * (1.f / 128.f) + 1e-6f);
                *(unsigned*)(CKV + (size_t)t * 128 + lane * 2) = pk2(v0 * rr * kvn[lane * 2], v1 * rr * kvn[lane * 2 + 1]);
            }
            if (lane < 16) {
                KROPE[(size_t)t * 32 + lane] = (bf16_t)f2bf(x1 * cs - x2 * sn);
                KROPE[(size_t)t * 32 + 16 + lane] = (bf16_t)f2bf(x2 * cs + x1 * sn);
            }
#pragma unroll
            for (int arr = 0; arr < 3; ++arr) {
                float y[8];
#pragma unroll
                for (int j = 0; j < 8; ++j) y[j] = 0.f;
#pragma unroll
                for (int w = 0; w < 4; ++w) {
                    float f[8]; unpack8(xr[arr][w], f);
                    const f32x4 c0 = *(const f32x4*)(cwL + w * 1536 + arr * 512 + lane * 8), c1 = *(const f32x4*)(cwL + w * 1536 + arr * 512 + lane * 8 + 4);
#pragma unroll
                    for (int j = 0; j < 4; ++j) { y[j] += c0[j] * f[j]; y[4 + j] += c1[j] * f[4 + j]; }
                }
                float ss = 0.f;
#pragma unroll
                for (int j = 0; j < 8; ++j) { y[j] = siluf_(y[j]); ss += y[j] * y[j]; }
                if (arr < 2) {
                    float rr = rsqrtf(red16(ss) + 1e-6f);
                    if (arr == 0) rr *= 0.08838834764831845f;
#pragma unroll
                    for (int j = 0; j < 8; ++j) y[j] *= rr;
                }
                bf16_t* dst = (arr == 0) ? GQ : (arr == 1) ? GK : GV;
                *(u32x4*)(dst + (size_t)t * 512 + lane * 8) = (u32x4){pk2(y[0], y[1]), pk2(y[2], y[3]), pk2(y[4], y[5]), pk2(y[6], y[7])};
                xr[arr][0] = xr[arr][1]; xr[arr][1] = xr[arr][2]; xr[arr][2] = xr[arr][3];
            }
            if (lane < 4) BETA[(size_t)t * 4 + lane] = sigmoidf_(gate);
            else if (lane < 8) { const int h = lane - 4; GLOG[(size_t)t * 4 + h] = -expf(a_log[h]) * softplusf_(gate + dt_bias[h]); }
        }
#undef PE_LOAD
    }
}

__device__ __forceinline__ void phase_prep_odd(const bf16_t* PROJ, const float* ROPES, bf16_t* SQ, bf16_t* SK, const Ctx& c) {
    const int lane = c.lane;
    const int hh = lane >> 2, j = lane & 3;
    const bool isq = lane < 32, act = lane < 40;
    const int scol = isq ? 1544 + hh * 64 + j * 8 : 2056 + (hh - 8) * 64 + j * 8;
    const float sc = isq ? 0.18033688011112042f : 1.f;
    for (int t = c.bid * 4 + c.wid; t < T; t += c.nblk * 4) {
        if (act) {
            const bf16_t* pr = PROJ + (size_t)t * NPAD + scol;
            const u32x4 r1 = *(const u32x4*)pr, r2 = *(const u32x4*)(pr + 32);
            const float* rp = ROPES + ((size_t)t * 32 + j * 8) * 2;
            const f32x4 t0 = *(const f32x4*)rp, t1 = *(const f32x4*)(rp + 4), t2 = *(const f32x4*)(rp + 8), t3 = *(const f32x4*)(rp + 12);
            const float cs[8] = {t0[0], t0[2], t1[0], t1[2], t2[0], t2[2], t3[0], t3[2]}, sn[8] = {t0[1], t0[3], t1[1], t1[3], t2[1], t2[3], t3[1], t3[3]};
            float x1[8], x2[8], o1[8], o2[8]; unpack8(r1, x1); unpack8(r2, x2);
#pragma unroll
            for (int k = 0; k < 8; ++k) { o1[k] = (x1[k] * cs[k] - x2[k] * sn[k]) * sc; o2[k] = (x2[k] * cs[k] + x1[k] * sn[k]) * sc; }
            bf16_t* d = isq ? SQ + (size_t)t * 512 + hh * 64 + j * 8 : SK + (size_t)t * 128 + (hh - 8) * 64 + j * 8;
            *(u32x4*)d = (u32x4){pk2(o1[0], o1[1]), pk2(o1[2], o1[3]), pk2(o1[4], o1[5]), pk2(o1[6], o1[7])};
            *(u32x4*)(d + 32) = (u32x4){pk2(o2[0], o2[1]), pk2(o2[2], o2[3]), pk2(o2[4], o2[5]), pk2(o2[6], o2[7])};
        }
    }
}

__device__ __forceinline__ int next_unit(unsigned* ctr, const Ctx& c) {
    volatile int* su = (volatile int*)(c.smem0 + LDS_BLK + 16);
    __syncthreads();
    if (c.tid0 == 0) *su = (int)atomicAdd(ctr, 1u);
    __syncthreads();
    return *su * 2 + c.half;
}

typedef float f32x16 __attribute__((ext_vector_type(16)));
typedef short s16x4 __attribute__((ext_vector_type(4)));
#define MFMA32(a, b, c) __builtin_amdgcn_mfma_f32_32x32x16_bf16((a), (b), (c), 0, 0, 0)
template <int S_> __device__ __forceinline__ bf16x8 pack_step(const f32x16& x) {
    u32x4 p;
    asm volatile("v_cvt_pk_bf16_f32 %0, %4, %5\n\tv_cvt_pk_bf16_f32 %1, %6, %7\n\tv_cvt_pk_bf16_f32 %2, %8, %9\n\tv_cvt_pk_bf16_f32 %3, %10, %11\n\ts_nop 1"
                 : "=&v"(p[0]), "=&v"(p[1]), "=&v"(p[2]), "=&v"(p[3])
                 : "v"(x[8 * S_]), "v"(x[8 * S_ + 1]), "v"(x[8 * S_ + 2]), "v"(x[8 * S_ + 3]), "v"(x[8 * S_ + 4]), "v"(x[8 * S_ + 5]), "v"(x[8 * S_ + 6]), "v"(x[8 * S_ + 7]));
    return __builtin_bit_cast(bf16x8, p);
}
template <int S_> __device__ __forceinline__ bf16x8 pack_step_m(const f32x16& x) {
    u32x4 p;
    asm volatile("s_nop 15\n\tv_cvt_pk_bf16_f32 %0, %4, %5\n\tv_cvt_pk_bf16_f32 %1, %6, %7\n\tv_cvt_pk_bf16_f32 %2, %8, %9\n\tv_cvt_pk_bf16_f32 %3, %10, %11\n\ts_nop 1"
                 : "=&v"(p[0]), "=&v"(p[1]), "=&v"(p[2]), "=&v"(p[3])
                 : "v"(x[8 * S_]), "v"(x[8 * S_ + 1]), "v"(x[8 * S_ + 2]), "v"(x[8 * S_ + 3]), "v"(x[8 * S_ + 4]), "v"(x[8 * S_ + 5]), "v"(x[8 * S_ + 6]), "v"(x[8 * S_ + 7]));
    return __builtin_bit_cast(bf16x8, p);
}
constexpr int ATT_VB = 64 * 128;

template <int NKS, bool WIN>
__device__ __forceinline__ void attn_unit(const bf16_t* Qp, int q_ld, const bf16_t* K1, int k1_ld, const bf16_t* K2, int k2_ld, const bf16_t* Vp, int v_ld,
                          bf16_t* Op, int o_ld, int Q0_in, float sink_l2, const Ctx& c) {
    constexpr int KB = NKS * 2 * 1024, BUF = KB + ATT_VB;
    const int Q0 = __builtin_amdgcn_readfirstlane(Q0_in);
    const int lane = c.lane, r = lane & 31, h = lane >> 5;
    const int wid = __builtin_amdgcn_readfirstlane(c.wid);
    const int q0w = Q0 + wid * 32;
    unsigned char* smem = c.smem;
    bf16x8 qf[NKS];
#pragma unroll
    for (int ks = 0; ks < NKS; ++ks) qf[ks] = *(const bf16x8*)(Qp + (size_t)(q0w + r) * q_ld + ks * 16 + h * 8);
    f32x16 o0, o1;
#pragma unroll
    for (int i = 0; i < 16; ++i) { o0[i] = 0.f; o1[i] = 0.f; }
    float m = WIN ? sink_l2 : -1e30f, l = (WIN && h == 0) ? 1.f : 0.f;
    const int kt_lo = WIN ? ((Q0 >> 6) - 2 < 0 ? 0 : (Q0 >> 6) - 2) : 0, kt_hi = (Q0 >> 6) + 1;
    const char* K1u = uniform_ptr(K1); const char* K2u = uniform_ptr(K2); const char* Vu = uniform_ptr(Vp);
    const unsigned lds0 = (unsigned)__builtin_amdgcn_readfirstlane((int)(unsigned)(size_t)smem);
    const unsigned voK1 = (unsigned)(lane * k1_ld * 2), voK2 = (unsigned)(lane * k2_ld * 2), voV = (unsigned)(((lane >> 3) * v_ld + (lane & 7) * 8) * 2);
#define ATT_STAGE(kt_, buf_) do { const unsigned bp = lds0 + (unsigned)((buf_) * BUF); const size_t kb = (size_t)(kt_) * 64; \
        _Pragma("unroll") for (int i = 0; i < (NKS * 2) / 4; ++i) { const int ch = wid + 4 * i; \
            if (ch < 8) glds16s(K1u + (kb * k1_ld + ch * 8) * 2, voK1, bp + ch * 1024); \
            else glds16s(K2u + (kb * k2_ld + (ch - 8) * 8) * 2, voK2, bp + ch * 1024); } \
        _Pragma("unroll") for (int i = 0; i < 2; ++i) { const int j = wid + 4 * i; \
            glds16s(Vu + ((kb + 8 * j) * v_ld) * 2, voV, bp + KB + j * 1024); } } while (0)
    ATT_STAGE(kt_lo, 0);
    const int i16 = lane & 15;
    const unsigned vlane = (unsigned)((4 * h + (i16 >> 2)) * 128 + 32 * ((lane >> 4) & 1) + 8 * (i16 & 3));
    for (int kt = kt_lo; kt <= kt_hi; ++kt) {
        const int cur = (kt - kt_lo) & 1;
        asm volatile("s_waitcnt vmcnt(0)" ::: "memory");
        __syncthreads();
        if (kt < kt_hi) ATT_STAGE(kt + 1, cur ^ 1);
        const int k0 = kt * 64;
        const bool active = (k0 <= q0w + 31) && (!WIN || (k0 + 63 > q0w - 128));
        if (active) {
            const LAS unsigned char* Kt = (const LAS unsigned char*)smem + cur * BUF + h * 1024 + r * 16;
            f32x16 x0, x1;
            const f32x16 zero16 = (f32x16){0.f, 0.f, 0.f, 0.f, 0.f, 0.f, 0.f, 0.f, 0.f, 0.f, 0.f, 0.f, 0.f, 0.f, 0.f, 0.f};
#pragma unroll
            for (int ks = 0; ks < NKS; ++ks) {
                const bf16x8 kf0 = *(const LAS bf16x8*)(Kt + ks * 2048);
                const bf16x8 kf1 = *(const LAS bf16x8*)(Kt + ks * 2048 + 512);
                x0 = MFMA32(kf0, qf[ks], ks == 0 ? zero16 : x0); x1 = MFMA32(kf1, qf[ks], ks == 0 ? zero16 : x1);
            }
            const bool need_mask = (k0 + 63 > q0w) || (WIN && (k0 <= q0w + 31 - 128));
            if (need_mask) {
                const int q = q0w + r;
#pragma unroll
                for (int i = 0; i < 16; ++i) {
                    const int key = k0 + (i & 3) + 8 * (i >> 2) + 4 * h;
                    const bool v0 = (key <= q) && (!WIN || key > q - 128);
                    const bool v1 = (key + 32 <= q) && (!WIN || key + 32 > q - 128);
                    x0[i] = v0 ? x0[i] : -INFINITY; x1[i] = v1 ? x1[i] : -INFINITY;
                }
            }
            float mx = fmaxf(x0[0], x1[0]);
#pragma unroll
            for (int i = 1; i < 16; ++i) mx = fmaxf(mx, fmaxf(x0[i], x1[i]));
            mx = fmaxf(mx, shfl_xor_(mx, 32));
            const float mn = fmaxf(m, mx);
            const float alpha = __builtin_amdgcn_exp2f(m - mn);
            m = mn;
            float ps = 0.f;
#pragma unroll
            for (int i = 0; i < 16; ++i) { x0[i] = __builtin_amdgcn_exp2f(x0[i] - mn); x1[i] = __builtin_amdgcn_exp2f(x1[i] - mn); ps += x0[i] + x1[i]; }
            l = l * alpha + ps;
            o0 *= alpha; o1 *= alpha;
            const unsigned vbase = (unsigned)(size_t)(smem + cur * BUF + KB) + vlane;
#pragma unroll
            for (int t = 0; t < 2; ++t) {
                s16x4 l00, h00, l01, h01, l10, h10, l11, h11;
                const unsigned va = vbase + t * 4096;
                asm volatile("ds_read_b64_tr_b16 %0, %8\n\t"
                             "ds_read_b64_tr_b16 %1, %8 offset:1024\n\t"
                             "ds_read_b64_tr_b16 %2, %8 offset:64\n\t"
                             "ds_read_b64_tr_b16 %3, %8 offset:1088\n\t"
                             "ds_read_b64_tr_b16 %4, %8 offset:2048\n\t"
                             "ds_read_b64_tr_b16 %5, %8 offset:3072\n\t"
                             "ds_read_b64_tr_b16 %6, %8 offset:2112\n\t"
                             "ds_read_b64_tr_b16 %7, %8 offset:3136\n\t"
                             "s_waitcnt lgkmcnt(0)"
                             : "=&v"(l00), "=&v"(h00), "=&v"(l01), "=&v"(h01), "=&v"(l10), "=&v"(h10), "=&v"(l11), "=&v"(h11) : "v"(va) : "memory");
                const bf16x8 v00 = __builtin_shufflevector(l00, h00, 0, 1, 2, 3, 4, 5, 6, 7), v01 = __builtin_shufflevector(l01, h01, 0, 1, 2, 3, 4, 5, 6, 7);
                const bf16x8 v10 = __builtin_shufflevector(l10, h10, 0, 1, 2, 3, 4, 5, 6, 7), v11 = __builtin_shufflevector(l11, h11, 0, 1, 2, 3, 4, 5, 6, 7);
                const bf16x8 pb0 = (t == 0) ? pack_step<0>(x0) : pack_step<0>(x1);
                const bf16x8 pb1 = (t == 0) ? pack_step<1>(x0) : pack_step<1>(x1);
                o0 = MFMA32(v00, pb0, o0); o1 = MFMA32(v01, pb0, o1);
                o0 = MFMA32(v10, pb1, o0); o1 = MFMA32(v11, pb1, o1);
            }
        }
    }
#undef ATT_STAGE
    l += shfl_xor_(l, 32);
    const float inv = 1.f / l;
    bf16_t* orow = Op + (size_t)(q0w + r) * o_ld + 4 * h;
#pragma unroll
    for (int g = 0; g < 4; ++g) {
        *(u32x2*)(orow + 8 * g) = (u32x2){pk2(o0[4 * g] * inv, o0[4 * g + 1] * inv), pk2(o0[4 * g + 2] * inv, o0[4 * g + 3] * inv)};
        *(u32x2*)(orow + 32 + 8 * g) = (u32x2){pk2(o1[4 * g] * inv, o1[4 * g + 1] * inv), pk2(o1[4 * g + 2] * inv, o1[4 * g + 3] * inv)};
    }
}

constexpr size_t MLC_DC = 0, MLC_CS = 33554432, MLC_DN = MLC_CS + 16777216, MLC_NS = MLC_DN + 262144, MLC_ML = MLC_NS + 262144, MLC_BE = MLC_ML + 4096, MLC_MS = MLC_BE + 4096;

__device__ __forceinline__ float scan_add64(float v, int lane) {
#pragma unroll
    for (int o = 1; o < 64; o <<= 1) { const float x = shfl_up_(v, o); if (lane >= o) v += x; }
    return v;
}
__device__ __forceinline__ float scan_max64(float v, int lane) {
#pragma unroll
    for (int o = 1; o < 64; o <<= 1) { const float x = shfl_up_(v, o); if (lane >= o) v = fmaxf(v, x); }
    return v;
}
__device__ __forceinline__ float wave_max(float v) {
#pragma unroll
    for (int o = 32; o > 0; o >>= 1) v = fmaxf(v, shfl_xor_(v, o));
    return v;
}

__device__ __forceinline__ void mlc_passA(int u, const bf16_t* PROJ, const float* GATES, const float* b_i, const float* b_f, unsigned char* YB, const Ctx& c) {
    const int bh = u >> 5, b = bh >> 2, h = bh & 3;
    const size_t t0 = (size_t)b * SEQ + (u & 31) * 64;
    unsigned char* smem = c.smem;
    float* saL = (float*)(smem + 24576);
    const int lane = c.lane, wid = __builtin_amdgcn_readfirstlane(c.wid);
#pragma unroll
    for (int i = 0; i < 4; ++i) { const int j = wid * 4 + i;
        glds16(PROJ + (t0 + 4 * j + (lane >> 4)) * NPAD + 512 + h * 128 + (lane & 15) * 8, smem + 8192 + j * 1024 + lane * 16); }
    if (wid == 0) {
        const float ip = GATES[(t0 + lane) * 8 + h] + b_i[h], lf = -softplusf_(-(GATES[(t0 + lane) * 8 + 4 + h] + b_f[h]));
        const float bc = scan_add64(lf, lane), bend = shfl_c_(bc, 63);
        const float a = bend - bc + ip, mloc = wave_max(a);
        saL[lane] = expf(a - mloc) * 0.125f;
        if (lane == 0) { ((float*)(YB + MLC_ML))[u] = mloc; ((float*)(YB + MLC_BE))[u] = bend; }
    }
    __syncthreads();
#pragma unroll
    for (int i = 0; i < 2; ++i) {
        const int idx = c.tid + 256 * i, row = idx >> 3, chk = idx & 7;
        const u32x4 r = *(const u32x4*)(PROJ + (t0 + row) * NPAD + 256 + h * 64 + chk * 8);
        float f[8]; unpack8(r, f);
        const float s = saL[row];
        *(u32x4*)(smem + row * 128 + chk * 16) = (u32x4){pk2(f[0] * s, f[1] * s), pk2(f[2] * s, f[3] * s), pk2(f[4] * s, f[5] * s), pk2(f[6] * s, f[7] * s)};
    }
    asm volatile("s_waitcnt vmcnt(0)" ::: "memory");
    __syncthreads();
    const int h5 = lane >> 5, r = lane & 31, i16 = lane & 15, q4 = i16 >> 2, p = i16 & 3, blk = (lane >> 4) & 1;
    const int dkt = wid & 1, dvp = wid >> 1;
    const unsigned kaddr = (unsigned)(size_t)smem + (unsigned)((8 * h5 + q4) * 128 + dkt * 64 + 32 * blk + 8 * p);
    const unsigned vaddr = (unsigned)(size_t)smem + 8192u + (unsigned)((8 * h5 + q4) * 256 + dvp * 128 + 32 * blk + 8 * p);
    f32x16 a0, a1;
#pragma unroll
    for (int i = 0; i < 16; ++i) { a0[i] = 0.f; a1[i] = 0.f; }
#pragma unroll
    for (int st = 0; st < 4; ++st) {
        s16x4 kl, kh, v0l, v0h, v1l, v1h;
        const unsigned ka = kaddr + st * 2048, va = vaddr + st * 4096;
        asm volatile("ds_read_b64_tr_b16 %0, %6\n\t"
                     "ds_read_b64_tr_b16 %1, %6 offset:512\n\t"
                     "ds_read_b64_tr_b16 %2, %7\n\t"
                     "ds_read_b64_tr_b16 %3, %7 offset:1024\n\t"
                     "ds_read_b64_tr_b16 %4, %7 offset:64\n\t"
                     "ds_read_b64_tr_b16 %5, %7 offset:1088\n\t"
                     "s_waitcnt lgkmcnt(0)"
                     : "=&v"(kl), "=&v"(kh), "=&v"(v0l), "=&v"(v0h), "=&v"(v1l), "=&v"(v1h) : "v"(ka), "v"(va) : "memory");
        const bf16x8 kf = __builtin_shufflevector(kl, kh, 0, 1, 2, 3, 4, 5, 6, 7);
        const bf16x8 vf0 = __builtin_shufflevector(v0l, v0h, 0, 1, 2, 3, 4, 5, 6, 7), vf1 = __builtin_shufflevector(v1l, v1h, 0, 1, 2, 3, 4, 5, 6, 7);
        a0 = MFMA32(kf, vf0, a0); a1 = MFMA32(kf, vf1, a1);
    }
    float* DC = (float*)(YB + MLC_DC) + (size_t)u * 8192;
#pragma unroll
    for (int i = 0; i < 16; ++i) {
        const int dk = dkt * 32 + (i & 3) + 8 * (i >> 2) + 4 * h5;
        DC[dk * 128 + dvp * 64 + r] = a0[i]; DC[dk * 128 + dvp * 64 + 32 + r] = a1[i];
    }
    if (c.tid < 64) {
        float s = 0.f;
#pragma unroll 8
        for (int t = 0; t < 64; ++t) s += bf2f(((const bf16_t*)smem)[t * 64 + c.tid]);
        ((float*)(YB + MLC_DN))[(size_t)u * 64 + c.tid] = s;
    }
}

__device__ __forceinline__ void mlc_passB(int u, unsigned char* YB, const Ctx& c) {
    const int bh = u >> 3, sl = u & 7;
    const float* ML = (const float*)(YB + MLC_ML) + bh * 32; const float* BE = (const float*)(YB + MLC_BE) + bh * 32;
    const float* DC = (const float*)(YB + MLC_DC) + (size_t)bh * 32 * 8192 + sl * 1024 + c.tid * 4;
    bf16_t* CS = (bf16_t*)(YB + MLC_CS) + (size_t)bh * 32 * 8192 + sl * 1024 + c.tid * 4;
    const float* DN = (const float*)(YB + MLC_DN) + (size_t)bh * 32 * 64; float* NS = (float*)(YB + MLC_NS) + (size_t)bh * 32 * 64; float* MS = (float*)(YB + MLC_MS) + bh * 32;
    f32x4 C4 = (f32x4){0.f, 0.f, 0.f, 0.f}; float nv = 0.f, m = 0.f;
    const bool do_n = (sl == 0) && (c.tid < 64);
#pragma unroll 1
    for (int nb = 0; nb < 32; nb += 16) {
        f32x4 d[16]; float be[16], ml[16], dn[16];
#pragma unroll
        for (int i = 0; i < 16; ++i) { d[i] = *(const f32x4*)(DC + (size_t)(nb + i) * 8192); be[i] = BE[nb + i]; ml[i] = ML[nb + i]; dn[i] = do_n ? DN[(nb + i) * 64 + c.tid] : 0.f; }
#pragma unroll
        for (int i = 0; i < 16; ++i) {
            const int n = nb + i;
            *(u32x2*)(CS + (size_t)n * 8192) = (u32x2){pk2(C4[0], C4[1]), pk2(C4[2], C4[3])};
            if (do_n) NS[n * 64 + c.tid] = nv;
            if (sl == 0 && c.tid == 0) MS[n] = m;
            const float mn = fmaxf(be[i] + m, ml[i]), keep = expf(be[i] + m - mn), g = expf(ml[i] - mn);
            m = mn;
            C4 = C4 * keep + d[i] * g;
            nv = nv * keep + dn[i] * g;
        }
    }
}

__device__ __forceinline__ void mlc_passC(int u, const bf16_t* PROJ, const float* GATES, const float* b_i, const float* b_f, const unsigned char* YB,
                                          const float* gain  , bf16_t* MIXO, const Ctx& c) {
    const int bh = u >> 5, b = bh >> 2, h = bh & 3;
    const size_t t0 = (size_t)b * SEQ + (u & 31) * 64;
    unsigned char* smem = c.smem;
    float* csL = (float*)(smem + 32768); float* pmL = (float*)(smem + 33024); float* bcL = (float*)(smem + 33280); float* nnL = (float*)(smem + 33536); float* sqL = (float*)(smem + 33792);
    const int lane = c.lane, wid = __builtin_amdgcn_readfirstlane(c.wid);
    const bf16_t* CS = (const bf16_t*)(YB + MLC_CS) + (size_t)u * 8192;
#pragma unroll
    for (int i = 0; i < 4; ++i) { const int j = wid * 4 + i;
        glds16(PROJ + (t0 + 4 * j + (lane >> 4)) * NPAD + 512 + h * 128 + (lane & 15) * 8, smem + j * 1024 + lane * 16);
        glds16(CS + (4 * j + (lane >> 4)) * 128 + (lane & 15) * 8, smem + 16384 + j * 1024 + lane * 16); }
    const int h5 = lane >> 5, r = lane & 31, i16 = lane & 15, q4 = i16 >> 2, p = i16 & 3, blk = (lane >> 4) & 1;
    const int th = wid & 1, dvh = wid >> 1;
    const int t = th * 32 + r;
    const float m_n = ((const float*)(YB + MLC_MS))[u];
    bf16x8 qf[4], kfa[4], kfb[4];
#pragma unroll
    for (int ks = 0; ks < 4; ++ks) {
        qf[ks] = *(const bf16x8*)(PROJ + (t0 + t) * NPAD + h * 64 + ks * 16 + h5 * 8);
        kfa[ks] = *(const bf16x8*)(PROJ + (t0 + r) * NPAD + 256 + h * 64 + ks * 16 + h5 * 8);
        kfb[ks] = *(const bf16x8*)(PROJ + (t0 + 32 + r) * NPAD + 256 + h * 64 + ks * 16 + h5 * 8);
    }
    const bf16_t* grow = PROJ + (t0 + t) * NPAD + 1032 + h * 128 + dvh * 64 + 4 * h5;
    const float* gn = gain + h * 128 + dvh * 64 + 4 * h5;
    u32x2 zrp[2][4]; f32x4 gvp[2][4];
#pragma unroll
    for (int d = 0; d < 2; ++d)
#pragma unroll
        for (int g = 0; g < 4; ++g) { zrp[d][g] = *(const u32x2*)(grow + d * 32 + 8 * g); gvp[d][g] = *(const f32x4*)(gn + d * 32 + 8 * g); }
    float bcl = 0.f;
    if (wid == 0) {
        const float ip = GATES[(t0 + lane) * 8 + h] + b_i[h], lf = -softplusf_(-(GATES[(t0 + lane) * 8 + 4 + h] + b_f[h]));
        bcl = scan_add64(lf, lane);
        const float cs = ip - bcl;
        csL[lane] = cs; pmL[lane] = scan_max64(cs, lane);
        nnL[lane] = ((const float*)(YB + MLC_NS))[(size_t)u * 64 + lane];
        bcL[lane] = bcl;
    }
    asm volatile("s_waitcnt vmcnt(0)" ::: "memory");
    __syncthreads();
    const float Mt = fmaxf(m_n, pmL[t]), w_inter = __expf(m_n - Mt), em = __expf(-(bcL[t] + Mt));
    float qn = 0.f; bf16x8 qw[4];
#pragma unroll
    for (int ks = 0; ks < 4; ++ks) {
        const u32x4 raw = __builtin_bit_cast(u32x4, qf[ks]); float f[8]; unpack8(raw, f);
#pragma unroll
        for (int j = 0; j < 8; ++j) qn += f[j] * nnL[ks * 16 + h5 * 8 + j];
        qw[ks] = __builtin_bit_cast(bf16x8, (u32x4){pk2(f[0] * w_inter, f[1] * w_inter), pk2(f[2] * w_inter, f[3] * w_inter), pk2(f[4] * w_inter, f[5] * w_inter), pk2(f[6] * w_inter, f[7] * w_inter)});
    }
    qn += shfl_xor_(qn, 32);
    f32x16 x0, x1;
#pragma unroll
    for (int i = 0; i < 16; ++i) { x0[i] = 0.f; x1[i] = 0.f; }
#pragma unroll
    for (int ks = 0; ks < 4; ++ks) {
        x0 = MFMA32(kfa[ks], qf[ks], x0);
        if (th) x1 = MFMA32(kfb[ks], qf[ks], x1);
    }
    float ps = 0.f;
#pragma unroll
    for (int i = 0; i < 16; ++i) {
        const int s = (i & 3) + 8 * (i >> 2) + 4 * h5;
        const float w0 = (s <= t) ? __expf(csL[s] - Mt) * 0.125f : 0.f;
        x0[i] *= w0; ps += x0[i];
        if (th) { const float w1 = (s <= r) ? __expf(csL[32 + s] - Mt) * 0.125f : 0.f; x1[i] *= w1; ps += x1[i]; }
    }
    ps += shfl_xor_(ps, 32);
    const float den = w_inter * qn + ps;
    f32x16 o0, o1;
#pragma unroll
    for (int i = 0; i < 16; ++i) { o0[i] = 0.f; o1[i] = 0.f; }
    {
        const unsigned vb = (unsigned)(size_t)smem + (unsigned)((4 * h5 + q4) * 256 + dvh * 128 + 32 * blk + 8 * p);
#pragma unroll
        for (int st = 0; st < 2; ++st) {
            if (st == 0 || th) {
                s16x4 l00, h00, l01, h01, l10, h10, l11, h11;
                const unsigned va = vb + st * 8192;
                asm volatile("ds_read_b64_tr_b16 %0, %8\n\t"
                             "ds_read_b64_tr_b16 %1, %8 offset:2048\n\t"
                             "ds_read_b64_tr_b16 %2, %8 offset:64\n\t"
                             "ds_read_b64_tr_b16 %3, %8 offset:2112\n\t"
                             "ds_read_b64_tr_b16 %4, %8 offset:4096\n\t"
                             "ds_read_b64_tr_b16 %5, %8 offset:6144\n\t"
                             "ds_read_b64_tr_b16 %6, %8 offset:4160\n\t"
                             "ds_read_b64_tr_b16 %7, %8 offset:6208\n\t"
                             "s_waitcnt lgkmcnt(0)"
                             : "=&v"(l00), "=&v"(h00), "=&v"(l01), "=&v"(h01), "=&v"(l10), "=&v"(h10), "=&v"(l11), "=&v"(h11) : "v"(va) : "memory");
                const bf16x8 v00 = __builtin_shufflevector(l00, h00, 0, 1, 2, 3, 4, 5, 6, 7), v01 = __builtin_shufflevector(l01, h01, 0, 1, 2, 3, 4, 5, 6, 7);
                const bf16x8 v10 = __builtin_shufflevector(l10, h10, 0, 1, 2, 3, 4, 5, 6, 7), v11 = __builtin_shufflevector(l11, h11, 0, 1, 2, 3, 4, 5, 6, 7);
                const bf16x8 pb0 = (st == 0) ? pack_step<0>(x0) : pack_step<0>(x1);
                const bf16x8 pb1 = (st == 0) ? pack_step<1>(x0) : pack_step<1>(x1);
                o0 = MFMA32(v00, pb0, o0); o1 = MFMA32(v01, pb0, o1);
                o0 = MFMA32(v10, pb1, o0); o1 = MFMA32(v11, pb1, o1);
            }
        }
    }
    {
        const unsigned cb = (unsigned)(size_t)smem + 16384u + (unsigned)((8 * h5 + q4) * 256 + dvh * 128 + 32 * blk + 8 * p);
#pragma unroll
        for (int kp = 0; kp < 2; ++kp) {
            s16x4 l00, h00, l01, h01, l10, h10, l11, h11;
            const unsigned ca = cb + kp * 8192;
            asm volatile("ds_read_b64_tr_b16 %0, %8\n\t"
                         "ds_read_b64_tr_b16 %1, %8 offset:1024\n\t"
                         "ds_read_b64_tr_b16 %2, %8 offset:64\n\t"
                         "ds_read_b64_tr_b16 %3, %8 offset:1088\n\t"
                         "ds_read_b64_tr_b16 %4, %8 offset:4096\n\t"
                         "ds_read_b64_tr_b16 %5, %8 offset:5120\n\t"
                         "ds_read_b64_tr_b16 %6, %8 offset:4160\n\t"
                         "ds_read_b64_tr_b16 %7, %8 offset:5184\n\t"
                         "s_waitcnt lgkmcnt(0)"
                         : "=&v"(l00), "=&v"(h00), "=&v"(l01), "=&v"(h01), "=&v"(l10), "=&v"(h10), "=&v"(l11), "=&v"(h11) : "v"(ca) : "memory");
            const bf16x8 c00 = __builtin_shufflevector(l00, h00, 0, 1, 2, 3, 4, 5, 6, 7), c01 = __builtin_shufflevector(l01, h01, 0, 1, 2, 3, 4, 5, 6, 7);
            const bf16x8 c10 = __builtin_shufflevector(l10, h10, 0, 1, 2, 3, 4, 5, 6, 7), c11 = __builtin_shufflevector(l11, h11, 0, 1, 2, 3, 4, 5, 6, 7);
            o0 = MFMA32(c00, qw[2 * kp], o0); o1 = MFMA32(c01, qw[2 * kp], o1);
            o0 = MFMA32(c10, qw[2 * kp + 1], o0); o1 = MFMA32(c11, qw[2 * kp + 1], o1);
        }
    }
    const float inv = __builtin_amdgcn_rcpf(fmaxf(fabsf(den), em));
    float ss = 0.f;
#pragma unroll
    for (int i = 0; i < 16; ++i) { o0[i] *= inv; o1[i] *= inv; ss += o0[i] * o0[i] + o1[i] * o1[i]; }
    ss += shfl_xor_(ss, 32);
    if (h5 == 0) sqL[wid * 32 + r] = ss;
    __syncthreads();
    const float rr = rsqrtf((sqL[th * 32 + r] + sqL[(th + 2) * 32 + r]) * (1.f / 128.f) + 1e-6f);
    bf16_t* orow = MIXO + (t0 + t) * 1024 + h * 128 + dvh * 64 + 4 * h5;
#pragma unroll
    for (int d = 0; d < 2; ++d)
#pragma unroll
        for (int g = 0; g < 4; ++g) {
            const u32x2 zr = zrp[d][g];
            const f32x4 gv = gvp[d][g];
            const float z0 = bflo(zr.x), z1 = bfhi(zr.x), z2 = bflo(zr.y), z3 = bfhi(zr.y);
            const float y0 = (d ? o1[4 * g] : o0[4 * g]) * rr * gv[0] * sigmoidf_(z0), y1 = (d ? o1[4 * g + 1] : o0[4 * g + 1]) * rr * gv[1] * sigmoidf_(z1);
            const float y2 = (d ? o1[4 * g + 2] : o0[4 * g + 2]) * rr * gv[2] * sigmoidf_(z2), y3 = (d ? o1[4 * g + 3] : o0[4 * g + 3]) * rr * gv[3] * sigmoidf_(z3);
            *(u32x2*)(orow + d * 32 + 8 * g) = (u32x2){pk2(y0, y1), pk2(y2, y3)};
        }
}

constexpr size_t GD_WN = 0, GD_UU = GD_WN + (size_t)1024 * 16384, GD_KGT = GD_UU + (size_t)1024 * 16384, GD_QG = GD_KGT + (size_t)1024 * 16384,
                 GD_AT = GD_QG + (size_t)1024 * 16384, GD_GL = GD_AT + (size_t)1024 * 8192, GD_END = GD_GL + 4096;
static_assert(GD_END <= (size_t)MAXROWS * 256 * 2, "GDN chunk records must fit the HBUF region");

__device__ __forceinline__ void gdc_passA(int u, const bf16_t* GQ, const bf16_t* GK, const bf16_t* GV, const float* BETA, const float* GLOG, unsigned char* HB, const Ctx& c) {
    const int bh = u >> 5, b = bh >> 2, h = bh & 3;
    const size_t t0 = (size_t)b * SEQ + (u & 31) * 64;
    unsigned char* smem = c.smem;
    float* Lm = (float*)(smem + 49152);
    float* GA = (float*)(smem + 65536 + 64); float* BT = GA + 64; float* EG = BT + 64; float* EK = EG + 64;
    const int lane = c.lane, wid = __builtin_amdgcn_readfirstlane(c.wid);
    const int h5 = lane >> 5, r = lane & 31;
    if (wid == 0) {
        const float g = GLOG[(t0 + lane) * 4 + h];
        const float G = scan_add64(g, lane), Gl = shfl_c_(G, 63);
        GA[lane] = G; BT[lane] = BETA[(t0 + lane) * 4 + h]; EG[lane] = expf(G); EK[lane] = expf(Gl - G);
        if (lane == 0) ((float*)(HB + GD_GL))[u] = expf(Gl);
    }
    __syncthreads();
    if (wid < 3) {
        const int it = (wid + 1) >> 1, jt = wid >> 1;
        f32x16 dl, da;
#pragma unroll
        for (int i = 0; i < 16; ++i) { dl[i] = 0.f; da[i] = 0.f; }
#pragma unroll
        for (int ks = 0; ks < 8; ++ks) {
            const bf16x8 ki = *(const bf16x8*)(GK + (t0 + 32 * it + r) * 512 + h * 128 + ks * 16 + h5 * 8);
            const bf16x8 kj = *(const bf16x8*)(GK + (t0 + 32 * jt + r) * 512 + h * 128 + ks * 16 + h5 * 8);
            const bf16x8 qi = *(const bf16x8*)(GQ + (t0 + 32 * it + r) * 512 + h * 128 + ks * 16 + h5 * 8);
            dl = MFMA32(ki, kj, dl); da = MFMA32(qi, kj, da);
        }
        const int j = 32 * jt + r; const float Gj = GA[j];
        bf16_t* AT = (bf16_t*)(HB + GD_AT) + (size_t)u * 4096;
#pragma unroll
        for (int i = 0; i < 16; ++i) {
            const int ii = 32 * it + (i & 3) + 8 * (i >> 2) + 4 * h5;
            const float dec = __expf(GA[ii] - Gj);
            Lm[ii * 64 + j] = (j < ii) ? dl[i] * BT[ii] * dec : 0.f;
            AT[ii * 64 + j] = (bf16_t)f2bf((j <= ii) ? da[i] * dec : 0.f);
        }
        if (wid == 0) {
#pragma unroll
            for (int i = 0; i < 16; ++i) { const int ii = (i & 3) + 8 * (i >> 2) + 4 * h5; Lm[ii * 64 + 32 + r] = 0.f; AT[ii * 64 + 32 + r] = 0; }
        }
    }
    __syncthreads();
    if (wid == 0) {
        float Tc[64];
#pragma unroll
        for (int i = 0; i < 64; ++i) {
            float s = (i == lane) ? 1.f : 0.f;
#pragma unroll
            for (int k = 0; k < i; ++k) s -= Lm[i * 64 + k] * Tc[k];
            Tc[i] = s;
        }
        bf16_t* Tm = (bf16_t*)Lm;
#pragma unroll
        for (int i = 0; i < 64; ++i) Tm[i * 64 + lane] = (bf16_t)f2bf(Tc[i]);
    } else {
        const int t3 = c.tid - 64;
        for (int idx = t3; idx < 4096; idx += 192) {
            const int arr = idx >> 10, rem = idx & 1023, row = rem >> 4, chk = rem & 15;
            const bf16_t* sp = ((arr == 1) ? GV : (arr == 3) ? GQ : GK) + (t0 + row) * 512 + h * 128 + chk * 8;
            const u32x4 raw = *(const u32x4*)sp; float f[8]; unpack8(raw, f);
            const float sc = (arr == 0) ? BT[row] * EG[row] : (arr == 1) ? BT[row] : (arr == 2) ? EK[row] : EG[row];
            const u32x4 o = (u32x4){pk2(f[0] * sc, f[1] * sc), pk2(f[2] * sc, f[3] * sc), pk2(f[4] * sc, f[5] * sc), pk2(f[6] * sc, f[7] * sc)};
            if (arr < 3) *(u32x4*)(smem + arr * 16384 + row * 256 + chk * 16) = o;
            else *(u32x4*)((bf16_t*)(HB + GD_QG) + (size_t)u * 8192 + row * 128 + chk * 8) = o;
        }
    }
    __syncthreads();
    {
        const int i16 = lane & 15, q4 = i16 >> 2, p = i16 & 3, blk = (lane >> 4) & 1;
        const unsigned char* Tm = smem + 49152;
        f32x16 u0, u1, w0, w1;
#pragma unroll
        for (int i = 0; i < 16; ++i) { u0[i] = 0.f; u1[i] = 0.f; w0[i] = 0.f; w1[i] = 0.f; }
        const unsigned ib = (unsigned)(size_t)smem + (unsigned)((8 * h5 + q4) * 256 + wid * 64 + 32 * blk + 8 * p);
#pragma unroll
        for (int ks = 0; ks < 4; ++ks) {
            s16x4 kl, kh, vl, vh;
            const unsigned ia = ib + ks * 4096;
            asm volatile("ds_read_b64_tr_b16 %0, %4\n\t"
                         "ds_read_b64_tr_b16 %1, %4 offset:1024\n\t"
                         "ds_read_b64_tr_b16 %2, %4 offset:16384\n\t"
                         "ds_read_b64_tr_b16 %3, %4 offset:17408\n\t"
                         "s_waitcnt lgkmcnt(0)"
                         : "=&v"(kl), "=&v"(kh), "=&v"(vl), "=&v"(vh) : "v"(ia) : "memory");
            const bf16x8 kb = __builtin_shufflevector(kl, kh, 0, 1, 2, 3, 4, 5, 6, 7), vb = __builtin_shufflevector(vl, vh, 0, 1, 2, 3, 4, 5, 6, 7);
            const bf16x8 t1 = *(const bf16x8*)(Tm + (32 + r) * 128 + ks * 32 + h5 * 16);
            w1 = MFMA32(t1, kb, w1); u1 = MFMA32(t1, vb, u1);
            if (ks < 2) { const bf16x8 tt0 = *(const bf16x8*)(Tm + r * 128 + ks * 32 + h5 * 16); w0 = MFMA32(tt0, kb, w0); u0 = MFMA32(tt0, vb, u0); }
        }
        bf16_t* WN = (bf16_t*)(HB + GD_WN) + (size_t)u * 8192; bf16_t* UU = (bf16_t*)(HB + GD_UU) + (size_t)u * 8192;
#pragma unroll
        for (int i = 0; i < 16; ++i) {
            const int s = (i & 3) + 8 * (i >> 2) + 4 * h5;
            WN[s * 128 + wid * 32 + r] = (bf16_t)f2bf(-w0[i]); WN[(32 + s) * 128 + wid * 32 + r] = (bf16_t)f2bf(-w1[i]);
        }
        {
            u32x4* up = (u32x4*)(UU + (size_t)(wid * 64 + lane) * 32);
            up[0] = (u32x4){pk2(u0[0], u0[1]), pk2(u0[2], u0[3]), pk2(u0[4], u0[5]), pk2(u0[6], u0[7])};
            up[1] = (u32x4){pk2(u0[8], u0[9]), pk2(u0[10], u0[11]), pk2(u0[12], u0[13]), pk2(u0[14], u0[15])};
            up[2] = (u32x4){pk2(u1[0], u1[1]), pk2(u1[2], u1[3]), pk2(u1[4], u1[5]), pk2(u1[6], u1[7])};
            up[3] = (u32x4){pk2(u1[8], u1[9]), pk2(u1[10], u1[11]), pk2(u1[12], u1[13]), pk2(u1[14], u1[15])};
        }
        bf16_t* KGT = (bf16_t*)(HB + GD_KGT) + (size_t)u * 8192;
        const int gq = lane >> 4;
        const unsigned kb0 = (unsigned)(size_t)smem + 32768u + (unsigned)(q4 * 256 + gq * 32 + 8 * p);
#pragma unroll
        for (int it2 = 0; it2 < 8; ++it2) {
            const int job = wid * 8 + it2, s0 = (job & 15) * 4, dkb = (job >> 4) * 64;
            s16x4 v;
            const unsigned ad = kb0 + s0 * 256 + dkb * 2;
            asm volatile("ds_read_b64_tr_b16 %0, %1\n\ts_waitcnt lgkmcnt(0)" : "=&v"(v) : "v"(ad) : "memory");
            *(s16x4*)(KGT + (size_t)(dkb + gq * 16 + i16) * 64 + s0) = v;
        }
    }
}

constexpr size_t GC_ST = 0, GC_VT = (size_t)1024 * 32768;
__device__ __forceinline__ void gdc_passB(int bh, const unsigned char* HB, unsigned char* YB, const Ctx& c) {
    const int lane = c.lane, wid = __builtin_amdgcn_readfirstlane(c.wid);
    const int h5 = lane >> 5, r = lane & 31;
    unsigned char* smem = c.smem;
    f32x16 S0, S1, S2, S3;
#pragma unroll
    for (int i = 0; i < 16; ++i) { S0[i] = 0.f; S1[i] = 0.f; S2[i] = 0.f; S3[i] = 0.f; }
    const size_t u0 = (size_t)bh * 32;
#define GB_STAGE(n_, p_) do { const bf16_t* wn_ = (const bf16_t*)(HB + GD_WN) + (u0 + (n_)) * 8192; const bf16_t* kg_ = (const bf16_t*)(HB + GD_KGT) + (u0 + (n_)) * 8192; \
        unsigned char* bp_ = smem + (p_) * 32768; \
        _Pragma("unroll") for (int i = 0; i < 4; ++i) { const int jj = wid * 4 + i, row = 4 * jj + (lane >> 4), ch = (lane & 15) ^ (row & 15); \
            glds16(wn_ + row * 128 + ch * 8, bp_ + jj * 1024 + lane * 16); } \
        _Pragma("unroll") for (int i = 0; i < 4; ++i) { const int jj = wid * 4 + i, row = 8 * jj + (lane >> 3), ch = (lane & 7) ^ ((row >> 1) & 7); \
            glds16(kg_ + row * 64 + ch * 8, bp_ + 16384 + jj * 1024 + lane * 16); } } while (0)
#define LD128(base_, R_, ks_) __builtin_shufflevector(*(const s16x4*)((base_) + (R_) * 256 + (((2 * (ks_)) ^ (rl & 15)) << 4) + 8 * hl), \
                                                      *(const s16x4*)((base_) + (R_) * 256 + (((2 * (ks_) + 1) ^ (rl & 15)) << 4) + 8 * hl), 0, 1, 2, 3, 4, 5, 6, 7)
#define LD64(base_, R_, k2_) __builtin_shufflevector(*(const s16x4*)((base_) + (R_) * 128 + (((2 * (k2_)) ^ ((rl >> 1) & 7)) << 4) + 8 * hl), \
                                                     *(const s16x4*)((base_) + (R_) * 128 + (((2 * (k2_) + 1) ^ ((rl >> 1) & 7)) << 4) + 8 * hl), 0, 1, 2, 3, 4, 5, 6, 7)
    u32x4 uu[4];
#define GB_LOADU(n_) do { const u32x4* up_ = (const u32x4*)((const bf16_t*)(HB + GD_UU) + (u0 + (n_)) * 8192 + (size_t)(wid * 64 + lane) * 32); \
        uu[0] = up_[0]; uu[1] = up_[1]; uu[2] = up_[2]; uu[3] = up_[3]; } while (0)
    float* glL = (float*)(smem + 65536 + 64);
    __syncthreads();
    if (c.tid < 32) glL[c.tid] = ((const float*)(HB + GD_GL))[u0 + c.tid];
    GB_STAGE(0, 0);
    GB_LOADU(0);
#pragma unroll 1
    for (int n2 = 0; n2 < 16; ++n2) {
#pragma unroll
        for (int PBUF = 0; PBUF < 2; ++PBUF) {
        const int n = 2 * n2 + PBUF;
        const float gl = glL[n];
        if (n == 0) asm volatile("s_waitcnt vmcnt(0)" ::: "memory"); else asm volatile("s_waitcnt vmcnt(24)" ::: "memory");
        asm volatile("s_waitcnt lgkmcnt(0)" ::: "memory"); __builtin_amdgcn_s_barrier(); asm volatile("" ::: "memory");
        f32x16 v0, v1;
#pragma unroll
        for (int q = 0; q < 2; ++q) {
            const u32x4 a = uu[q], bq = uu[2 + q];
            v0[8 * q + 0] = bflo(a.x); v0[8 * q + 1] = bfhi(a.x); v0[8 * q + 2] = bflo(a.y); v0[8 * q + 3] = bfhi(a.y);
            v0[8 * q + 4] = bflo(a.z); v0[8 * q + 5] = bfhi(a.z); v0[8 * q + 6] = bflo(a.w); v0[8 * q + 7] = bfhi(a.w);
            v1[8 * q + 0] = bflo(bq.x); v1[8 * q + 1] = bfhi(bq.x); v1[8 * q + 2] = bflo(bq.y); v1[8 * q + 3] = bfhi(bq.y);
            v1[8 * q + 4] = bflo(bq.z); v1[8 * q + 5] = bfhi(bq.z); v1[8 * q + 6] = bflo(bq.w); v1[8 * q + 7] = bfhi(bq.w);
        }
        if (n + 1 < 32) { GB_STAGE(n + 1, (PBUF ^ 1)); GB_LOADU(n + 1); }
        int rl = r, hl = h5; asm volatile("" : "+v"(rl), "+v"(hl));
        const unsigned char* WNb = smem + PBUF * 32768; const unsigned char* KGb = WNb + 16384;
        {
            bf16_t* st = (bf16_t*)(YB + GC_ST) + (u0 + n) * 16384 + (size_t)h5 * 512 + (size_t)(wid * 32 + r) * 4;
#define ST_TILE(SX, dt_) do { _Pragma("unroll") for (int g = 0; g < 4; ++g) \
                *(u32x2*)(st + ((dt_) * 8 + 2 * g) * 512) = (u32x2){cvt_pk(SX[4 * g], SX[4 * g + 1]), cvt_pk(SX[4 * g + 2], SX[4 * g + 3])}; } while (0)
            ST_TILE(S0, 0); ST_TILE(S1, 1); ST_TILE(S2, 2); ST_TILE(S3, 3);
#undef ST_TILE
        }
        {
            bf16x8 fa0, fb0, fa1, fb1, fa2, fb2;
#define LDV(FA, FB, ks_) do { FA = LD128(WNb, rl, ks_); FB = LD128(WNb, 32 + rl, ks_); } while (0)
#define MMV(SX, HF, FA, FB) do { const bf16x8 sbk = pack_step<HF>(SX); v0 = MFMA32(FA, sbk, v0); v1 = MFMA32(FB, sbk, v1); } while (0)
            LDV(fa0, fb0, 0); LDV(fa1, fb1, 1); LDV(fa2, fb2, 2);
            MMV(S0, 0, fa0, fb0); LDV(fa0, fb0, 3);
            MMV(S0, 1, fa1, fb1); LDV(fa1, fb1, 4);
            MMV(S1, 0, fa2, fb2); LDV(fa2, fb2, 5);
            MMV(S1, 1, fa0, fb0); LDV(fa0, fb0, 6);
            MMV(S2, 0, fa1, fb1); LDV(fa1, fb1, 7);
            MMV(S2, 1, fa2, fb2);
            MMV(S3, 0, fa0, fb0);
            MMV(S3, 1, fa1, fb1);
#undef LDV
#undef MMV
        }
        const bf16x8 vb0 = pack_step_m<0>(v0), vb1 = pack_step_m<1>(v0), vb2 = pack_step_m<0>(v1), vb3 = pack_step_m<1>(v1);
        {
            bf16_t* vt = (bf16_t*)(YB + GC_VT) + (u0 + n) * 8192 + (size_t)h5 * 512 + (size_t)(wid * 32 + r) * 4;
            const u32x4 p0 = __builtin_bit_cast(u32x4, vb0), p1 = __builtin_bit_cast(u32x4, vb1), p2 = __builtin_bit_cast(u32x4, vb2), p3 = __builtin_bit_cast(u32x4, vb3);
            *(u32x2*)(vt + 0 * 512) = (u32x2){p0.x, p0.y};  *(u32x2*)(vt + 2 * 512) = (u32x2){p0.z, p0.w};
            *(u32x2*)(vt + 4 * 512) = (u32x2){p1.x, p1.y};  *(u32x2*)(vt + 6 * 512) = (u32x2){p1.z, p1.w};
            *(u32x2*)(vt + 8 * 512) = (u32x2){p2.x, p2.y};  *(u32x2*)(vt + 10 * 512) = (u32x2){p2.z, p2.w};
            *(u32x2*)(vt + 12 * 512) = (u32x2){p3.x, p3.y}; *(u32x2*)(vt + 14 * 512) = (u32x2){p3.z, p3.w};
        }
        asm volatile("" ::: "memory"); asm volatile("" : "+v"(rl), "+v"(hl));
        S0 *= gl; S1 *= gl; S2 *= gl; S3 *= gl;
        {
            bf16x8 g0, g1, g2;
            g0 = LD64(KGb, rl, 0); g1 = LD64(KGb, rl, 1); g2 = LD64(KGb, rl, 2);
            S0 = MFMA32(g0, vb0, S0); g0 = LD64(KGb, rl, 3);
            S0 = MFMA32(g1, vb1, S0); g1 = LD64(KGb, 32 + rl, 0);
            S0 = MFMA32(g2, vb2, S0); g2 = LD64(KGb, 32 + rl, 1);
            S0 = MFMA32(g0, vb3, S0); g0 = LD64(KGb, 32 + rl, 2);
            S1 = MFMA32(g1, vb0, S1); g1 = LD64(KGb, 32 + rl, 3);
            S1 = MFMA32(g2, vb1, S1); g2 = LD64(KGb, 64 + rl, 0);
            S1 = MFMA32(g0, vb2, S1); g0 = LD64(KGb, 64 + rl, 1);
            S1 = MFMA32(g1, vb3, S1); g1 = LD64(KGb, 64 + rl, 2);
            S2 = MFMA32(g2, vb0, S2); g2 = LD64(KGb, 64 + rl, 3);
            S2 = MFMA32(g0, vb1, S2); g0 = LD64(KGb, 96 + rl, 0);
            S2 = MFMA32(g1, vb2, S2); g1 = LD64(KGb, 96 + rl, 1);
            S2 = MFMA32(g2, vb3, S2); g2 = LD64(KGb, 96 + rl, 2);
            S3 = MFMA32(g0, vb0, S3); g0 = LD64(KGb, 96 + rl, 3);
            S3 = MFMA32(g1, vb1, S3);
            S3 = MFMA32(g2, vb2, S3);
            S3 = MFMA32(g0, vb3, S3);
        }
        }
    }
#undef GB_STAGE
#undef LD128
#undef LD64
#undef GB_LOADU
}

__device__ __forceinline__ void gdc_passB_idle() {
    __syncthreads();
    for (int n = 0; n < 32; ++n) { asm volatile("" ::: "memory"); __builtin_amdgcn_s_barrier(); asm volatile("" ::: "memory"); }
}

__device__ __forceinline__ void gdc_passC(int u, const unsigned char* HB, const unsigned char* YB, const bf16_t* PROJ, const float* gnorm, bf16_t* MIXO, const Ctx& c) {
    const int bh = u >> 5, b = bh >> 2, h = bh & 3;
    const size_t t0 = (size_t)b * SEQ + (u & 31) * 64;
    const int lane = c.lane, wid = __builtin_amdgcn_readfirstlane(c.wid);
    const int h5 = lane >> 5, r = lane & 31;
    float* sqL = (float*)c.smem;
    const bf16_t* ST = (const bf16_t*)(YB + GC_ST) + (size_t)u * 16384 + (size_t)(2 * h5) * 512 + (size_t)(wid * 32 + r) * 4;
    const bf16_t* VT = (const bf16_t*)(YB + GC_VT) + (size_t)u * 8192 + (size_t)(2 * h5) * 512 + (size_t)(wid * 32 + r) * 4;
    const bf16_t* QG = (const bf16_t*)(HB + GD_QG) + (size_t)u * 8192 + (size_t)r * 128 + 8 * h5;
    const bf16_t* AT = (const bf16_t*)(HB + GD_AT) + (size_t)u * 4096 + (size_t)r * 64 + 8 * h5;
    f32x16 o0, o1;
#pragma unroll
    for (int i = 0; i < 16; ++i) { o0[i] = 0.f; o1[i] = 0.f; }
#pragma unroll
    for (int ks = 0; ks < 8; ++ks) {
        const bf16x8 sa = __builtin_shufflevector(*(const s16x4*)(ST + (4 * ks) * 512), *(const s16x4*)(ST + (4 * ks + 1) * 512), 0, 1, 2, 3, 4, 5, 6, 7);
        const bf16x8 q0 = *(const bf16x8*)(QG + ks * 16), q1 = *(const bf16x8*)(QG + 32 * 128 + ks * 16);
        o0 = MFMA32(sa, q0, o0); o1 = MFMA32(sa, q1, o1);
        if (ks == 3) asm volatile("" ::: "memory");
    }
#pragma unroll
    for (int k2 = 0; k2 < 4; ++k2) {
        const bf16x8 va = __builtin_shufflevector(*(const s16x4*)(VT + (4 * k2) * 512), *(const s16x4*)(VT + (4 * k2 + 1) * 512), 0, 1, 2, 3, 4, 5, 6, 7);
        const bf16x8 a1 = *(const bf16x8*)(AT + 32 * 64 + k2 * 16);
        o1 = MFMA32(va, a1, o1);
        if (k2 < 2) { const bf16x8 a0 = *(const bf16x8*)(AT + k2 * 16); o0 = MFMA32(va, a0, o0); }
    }
    float s0 = 0.f, s1 = 0.f;
#pragma unroll
    for (int i = 0; i < 16; ++i) { s0 += o0[i] * o0[i]; s1 += o1[i] * o1[i]; }
    s0 += shfl_xor_(s0, 32); s1 += shfl_xor_(s1, 32);
    __syncthreads();
    if (h5 == 0) { sqL[wid * 64 + r] = s0; sqL[wid * 64 + 32 + r] = s1; }
    __syncthreads();
    const float rr0 = rsqrtf((sqL[r] + sqL[64 + r] + sqL[128 + r] + sqL[192 + r]) * (1.f / 128.f) + 1e-6f);
    const float rr1 = rsqrtf((sqL[32 + r] + sqL[96 + r] + sqL[160 + r] + sqL[224 + r]) * (1.f / 128.f) + 1e-6f);
#pragma unroll
    for (int tt = 0; tt < 2; ++tt) {
        const size_t t = t0 + tt * 32 + r;
        const bf16_t* zrow = PROJ + t * NPAD + 1960 + h * 128 + wid * 32 + 4 * h5;
        const float* gn = gnorm + wid * 32 + 4 * h5;
        bf16_t* orow = MIXO + t * 1024 + 512 + h * 128 + wid * 32 + 4 * h5;
        const float rr = tt ? rr1 : rr0;
#pragma unroll
        for (int g = 0; g < 4; ++g) {
            const u32x2 zr = *(const u32x2*)(zrow + 8 * g);
            const f32x4 gv = *(const f32x4*)(gn + 8 * g);
            const float z0 = bflo(zr.x), z1 = bfhi(zr.x), z2 = bflo(zr.y), z3 = bfhi(zr.y);
            const float y0 = (tt ? o1[4 * g] : o0[4 * g]) * rr * gv[0] * siluf_(z0), y1 = (tt ? o1[4 * g + 1] : o0[4 * g + 1]) * rr * gv[1] * siluf_(z1);
            const float y2 = (tt ? o1[4 * g + 2] : o0[4 * g + 2]) * rr * gv[2] * siluf_(z2), y3 = (tt ? o1[4 * g + 3] : o0[4 * g + 3]) * rr * gv[3] * siluf_(z3);
            *(u32x2*)(orow + 8 * g) = (u32x2){pk2(y0, y1), pk2(y2, y3)};
        }
    }
}

__device__ __forceinline__ void phase_post(const float* OG, const bf16_t* PROJ, const float* gain, bool odd, bf16_t* MIXO, const Ctx& c) {
    const int lane = c.lane;
    const int gcol = odd ? 1032 : 1960, ocol = odd ? 0 : 512;
    for (int t = c.bid * 4 + c.wid; t < T; t += c.nblk * 4) {
        const f32x4 a0 = *(const f32x4*)(OG + (size_t)t * 512 + lane * 8), a1 = *(const f32x4*)(OG + (size_t)t * 512 + lane * 8 + 4);
        float ss = (a0[0] * a0[0] + a0[1] * a0[1]) + (a0[2] * a0[2] + a0[3] * a0[3]) + (a1[0] * a1[0] + a1[1] * a1[1]) + (a1[2] * a1[2] + a1[3] * a1[3]);
        ss = red16(ss);
        const float rr = rsqrtf(ss * (1.f / 128.f) + 1e-6f);
        const u32x4 zr = *(const u32x4*)(PROJ + (size_t)t * NPAD + gcol + lane * 8);
        float z[8]; unpack8(zr, z);
        const int gi = odd ? lane * 8 : (lane & 15) * 8;
        const f32x4 g0 = *(const f32x4*)(gain + gi), g1 = *(const f32x4*)(gain + gi + 4);
        float y[8];
#pragma unroll
        for (int j = 0; j < 4; ++j) {
            const float ga = odd ? sigmoidf_(z[j]) : siluf_(z[j]), gb = odd ? sigmoidf_(z[4 + j]) : siluf_(z[4 + j]);
            y[j] = a0[j] * rr * g0[j] * ga; y[4 + j] = a1[j] * rr * g1[j] * gb;
        }
        *(u32x4*)(MIXO + (size_t)t * 1024 + ocol + lane * 8) = (u32x4){pk2(y[0], y[1]), pk2(y[2], y[3]), pk2(y[4], y[5]), pk2(y[6], y[7])};
    }
}

__global__ void __launch_bounds__(512, 2) fwd(Args a) {
    extern __shared__ __attribute__((aligned(16))) unsigned char smem[];
    Ctx c;
    const int wave_s = __builtin_amdgcn_readfirstlane((int)threadIdx.x >> 6);
#define SET_CTX(cx) do { int t_ = (wave_s << 6) | lane_id_v(); cx.tid0 = t_; cx.half = t_ >> 8; cx.tid = t_ & 255; cx.lane = t_ & 63; cx.wid = (t_ >> 6) & 3; \
        cx.wr = cx.wid >> 1; cx.wc = cx.wid & 1; cx.fr = cx.lane & 15; cx.fq = cx.lane >> 4; cx.bid = blockIdx.x * 2 + cx.half; cx.nblk = gridDim.x * 2; \
        cx.smem0 = smem; cx.smem = smem + cx.half * HALF_LDS; } while (0)
    SET_CTX(c);
#define PH_CTX() SET_CTX(c)
    unsigned char* const ws_base = a.ws;
    const void* const* const ain_base = (const void* const*)__builtin_amdgcn_kernarg_segment_ptr();
    unsigned* ctl = (unsigned*)(ws_base + WS_CTL);
    volatile LAS unsigned* xbw = (volatile LAS unsigned*)(smem + LDS_BLK);
    if (c.tid0 < 8) xbw[c.tid0] = 0u;
    __syncthreads();
    XcdBarrier bar; bar.bar = ctl; bar.x = 0; bar.st = xbw; bar.wave = wave_s;
    if (a.use_bar) bar = xcd_barrier_post(ctl, xbw, c.tid0);
#if ONE_LAUNCH
    const int hi = NPH;
#define IN(k) true
#else
    const int lo = a.ph_lo, hi = a.ph_hi;
#define IN(k) (lo <= (k) && (k) < hi)
#endif
#define PH(k) if (IN(k)) { PH_CTX(); unsigned char* ws = ws_base; const void* const* ain = ain_base; asm volatile("" : "+s"(ws), "+s"(ain));
#define UNIT_CTX() Ctx cu; SET_CTX(cu)
#define SEAM(k) do { if ((k) + 1 < hi) xcd_barrier(bar); } while (0)

#define XBF ((bf16_t*)(ws + WS_XBF))
#define X1 ((float*)(ws + WS_X1))
#define PROJ ((bf16_t*)(ws + U_PROJ))
#define GATES ((float*)(ws + U_GATES))
#define MIXO ((bf16_t*)(ws + U_MIXO))
#define YBUF ((float*)(ws + U_YBUF))
#define ROPEM ((const float*)(ws + WS_ROPEM))
#define ROPES ((const float*)(ws + WS_ROPES))
#define XRES ((layer == 0) ? (const float*)ain[0] : (const float*)a.out)
#define CNT (ctl + CW_CNT + layer * 128)
#define WIN ((const bf16_t*)(ws + WS_WIN) + (size_t)layer * WIN_ELEMS)
#define WOUT ((const bf16_t*)(ws + WS_WOUT) + (size_t)layer * WOUT_ELEMS)

    PH(0) for (int rep = 0; rep < REP_PRO; ++rep) phase_prologue(a, c); SEAM(0); }

    for (int layer = 0; layer < 4; ++layer) {
        const int pb = 1 + layer * PPL;
#if !ONE_LAUNCH
        if (pb >= hi || pb + PPL <= lo) continue;
#endif
        const int jj = layer >> 1;
        const bool odd = (layer & 1) != 0;

        PH(pb + 0) {
                DenseSched S{T / 256, NPAD / 256, 1024, (int)blockIdx.x, (int)gridDim.x};
                EpiIn E{PROJ, GATES, odd ? 1024 : 1952};
                g8::phase<1, false, false>(smem, (const char*)XBF, (const char*)WIN, 1024, S, E, c.tid0);
            }
            SEAM(pb + 0); }
        PH(pb + 1) for (int rp = 0; rp < ((REP_PHASE == 1) ? 2 : 1); ++rp) { if (rp) xcd_barrier(bar);
            if (!odd) phase_prep_even(PROJ, GATES, (const float*)ain[3] + jj * 256, (const float*)ain[5] + jj * 128, (const float*)ain[7] + jj * 4 * 1536,
                                      (const float*)ain[8] + jj * 4, (const float*)ain[9] + jj * 4, ROPEM,
                                      (bf16_t*)(ws + U_CQ), (bf16_t*)(ws + U_CKV), (bf16_t*)(ws + U_KROPE), (bf16_t*)(ws + U_GQ), (bf16_t*)(ws + U_GK), (bf16_t*)(ws + U_GV),
                                      (float*)(ws + U_BETA), (float*)(ws + U_GLOG), c);
            else {
                phase_prep_odd(PROJ, ROPES, (bf16_t*)(ws + U_QF), (bf16_t*)(ws + U_KN), c);
                unsigned* ctr = ctl + CW_WORK + pb + 1 + 64 * rp;
                for (;;) {
                    const int u = next_unit(ctr, c); UNIT_CTX();
                    if (u >= 1024) break;
                    mlc_passA(u, PROJ, GATES, (const float*)ain[13] + jj * 4, (const float*)ain[14] + jj * 4, (unsigned char*)YBUF, cu);
                }
            }
            }
            SEAM(pb + 1);
        }
        PH(pb + 2) for (int rp = 0; rp < ((REP_PHASE == 2) ? 2 : 1); ++rp) { if (rp) xcd_barrier(bar);
            unsigned* ctr = ctl + CW_WORK + pb + 2 + 64 * rp;
            if (!odd) {
                for (;;) {
                    const int u = next_unit(ctr, c); UNIT_CTX();
                    if (u >= 1024 + MLAUP_TILES) break;
                    if (u < 1024) gdc_passA(u, (const bf16_t*)(ws + U_GQ), (const bf16_t*)(ws + U_GK), (const bf16_t*)(ws + U_GV), (const float*)(ws + U_BETA),
                                            (const float*)(ws + U_GLOG), ws + WS_HBUF, cu);
                    else mla_up_tile(u - 1024, (const bf16_t*)(ws + U_CQ), (const bf16_t*)(ws + WS_WQB) + (size_t)jj * WQB_ELEMS, (const bf16_t*)(ws + U_CKV),
                                     (const bf16_t*)(ws + WS_WKVB) + (size_t)jj * WKVB_ELEMS, ROPEM, (bf16_t*)(ws + U_QF), (bf16_t*)(ws + U_KN), (bf16_t*)(ws + U_VV), cu);
                }
            } else {
                for (;;) {
                    const int u = next_unit(ctr, c); UNIT_CTX();
                    if (u >= 256 + 1024) break;
                    if (u < 256) mlc_passB(u, (unsigned char*)YBUF, cu);
                    else {
                        const int v = u - 256, hq = v & 7, n = (v >> 3) & 15, b = v >> 7, kvh = hq >> 2;
                        const size_t tb = (size_t)b * SEQ;
                        attn_unit<4, true>((const bf16_t*)(ws + U_QF) + tb * 512 + hq * 64, 512, (const bf16_t*)(ws + U_KN) + tb * 128 + kvh * 64, 128,
                                           (const bf16_t*)(ws + U_KN), 0, PROJ + tb * NPAD + 2184 + kvh * 64, NPAD,
                                           MIXO + tb * 1024 + 512 + hq * 64, 1024, n * 128, ((const float*)ain[16])[jj * 8 + hq] * 1.4426950408889634f, cu);
                    }
                }
            }
            }
            SEAM(pb + 2);
        }
        PH(pb + 3) for (int rp = 0; rp < ((REP_PHASE == 3) ? 2 : 1); ++rp) { if (rp) xcd_barrier(bar);
            unsigned* ctr = ctl + CW_WORK + pb + 3 + 64 * rp;
            if (!odd) {
                for (;;) {
                    const int u = next_unit(ctr, c); UNIT_CTX();
                    if (u >= 64 + 1024) break;
                    if (rp > 0 && ((REP_ONLY == 1 && u >= 64) || (REP_ONLY == 2 && u < 64))) continue;
                    if (u < 64) { if ((u & 1) == 0) gdc_passB(u >> 1, ws + WS_HBUF, (unsigned char*)YBUF, cu); else gdc_passB_idle(); }
                    else {
                        const int v = u - 64, qb = 15 - (v >> 6), bh = v & 63, b = bh >> 3, hh = bh & 7;
                        const size_t tb = (size_t)b * SEQ;
                        attn_unit<6, false>((const bf16_t*)(ws + U_QF) + tb * 768 + hh * 96, 768, (const bf16_t*)(ws + U_KN) + tb * 512 + hh * 64, 512,
                                            (const bf16_t*)(ws + U_KROPE) + tb * 32, 32, (const bf16_t*)(ws + U_VV) + tb * 512 + hh * 64, 512,
                                            MIXO + tb * 1024 + hh * 64, 1024, qb * 128, 0.f, cu);
                    }
                }
            } else {
                for (;;) {
                    const int u = next_unit(ctr, c); UNIT_CTX();
                    if (u >= 1024) break;
                    mlc_passC(u, PROJ, GATES, (const float*)ain[13] + jj * 4, (const float*)ain[14] + jj * 4, (const unsigned char*)YBUF, (const float*)ain[15] + jj * 512, MIXO, cu);
                }
            }
            }
            SEAM(pb + 3);
        }
        PH(pb + 4) for (int rp = 0; rp < ((REP_PHASE == 4) ? 2 : 1); ++rp) { if (rp) xcd_barrier(bar);
            if (!odd) {
                unsigned* ctr = ctl + CW_WORK + pb + 4 + 64 * rp;
                for (;;) {
                    const int u = next_unit(ctr, c); UNIT_CTX();
                    if (u >= 1024) break;
                    gdc_passC(u, ws + WS_HBUF, (const unsigned char*)YBUF, PROJ, (const float*)ain[10] + jj * 128, MIXO, cu);
                }
            }
            }
            if (!odd) SEAM(pb + 4);
        }
        PH(pb + 5) {
                DenseSched S{T / 256, 4, 1024, (int)blockIdx.x, (int)gridDim.x};
                EpiOut E{XBF, (bf16_t*)YBUF};
                g8::phase<1, false, false>(smem, (const char*)MIXO, (const char*)WOUT, 1024, S, E, c.tid0);
            }
            SEAM(pb + 5); }
#if FUSE_LNROUTE
        PH(pb + 6) phase_lnroute((const bf16_t*)YBUF, (const float*)ain[18] + layer * 1024, (const float*)ain[19] + layer * 1024, XBF, (unsigned char*)(ws + WS_X1), (const bf16_t*)(ws + WS_WRT) + (size_t)layer * WRT_ELEMS,
                                 (const float*)ain[21] + layer * 64, CNT, (int*)(ws + WS_LTOK), (float*)(ws + WS_LW), (int*)(ws + WS_ASG), (float*)(ws + WS_ASGW), c); SEAM(pb + 8); }
#else
        PH(pb + 6) for (int rep = 0; rep < REP_TOK; ++rep) phase_ln1((const bf16_t*)YBUF, (const float*)ain[18] + layer * 1024, (const float*)ain[19] + layer * 1024, XBF, c); SEAM(pb + 6); }
        PH(pb + 7) for (int rep = 0; rep < REP_GEMM; ++rep) phase_router(XBF, (const bf16_t*)(ws + WS_WRT) + (size_t)layer * WRT_ELEMS, (float*)(ws + WS_LOG), c); SEAM(pb + 7); }
        PH(pb + 8) phase_route((const float*)(ws + WS_LOG), (const float*)ain[21] + layer * 64, CNT, (int*)(ws + WS_LTOK), (float*)(ws + WS_LW), (int*)(ws + WS_ASG), (float*)(ws + WS_ASGW), c); SEAM(pb + 8); }
#endif
        PH(pb + 9) {
                int* bst8 = (int*)(smem + LDS_BLK + 64); int* eb8 = bst8 + 256;
                build_block_table(CNT, bst8, c);
                for (int rb = c.tid0; rb < bst8[65]; rb += NT) { int e = 0; for (int q = 1; q < 65; ++q) e += (bst8[q] <= rb) ? 1 : 0; eb8[rb] = e; }
                __syncthreads();
                MoeSchedG S{__builtin_amdgcn_readfirstlane(bst8[65]), (int)blockIdx.x, (int)gridDim.x, eb8, bst8, (const int*)(ws + WS_LTOK), MOE1_F8 ? 1024u : 2048u};
#if MOE2_F8
                EpiMoe1F8 E{(unsigned char*)(ws + WS_HBUF)};
#else
                EpiMoe1 E{(bf16_t*)(ws + WS_HBUF)};
#endif
#if MOE1_F8
                g8::phase<0, true, true>(smem, (const char*)(ws + WS_X1), (const char*)(ws + WS_WGU) + (size_t)layer * 65 * WGU_ELEMS, 512, S, E, c.tid0);
#else
                g8::phase<0, true, false>(smem, (const char*)XBF, (const char*)((const bf16_t*)(ws + WS_WGU) + (size_t)layer * 65 * WGU_ELEMS), 1024, S, E, c.tid0);
#endif
            }
            SEAM(pb + 9); }
        PH(pb + 10)
#if MOE2_G8
            {
                int* bst8 = (int*)(smem + LDS_BLK + 64); int* eb8 = bst8 + 256;
                build_block_table(CNT, bst8, c);
                for (int rb = c.tid0; rb < bst8[65]; rb += NT) { int e = 0; for (int q = 1; q < 65; ++q) e += (bst8[q] <= rb) ? 1 : 0; eb8[rb] = e; }
                __syncthreads();
                MoeSched S{__builtin_amdgcn_readfirstlane(bst8[65]), 4, (int)blockIdx.x, (int)gridDim.x, eb8};
#if Y_FP8
                EpiMoe2F8 E{(unsigned char*)(ws + U_Y)};
#else
                EpiMoe2 E{(bf16_t*)(ws + U_Y)};
#endif
                #if MOE2_F8
                g8::phase<2, false, true>(smem, (const char*)(ws + WS_HBUF), (const char*)(ws + WS_WDN) + (size_t)layer * 65 * WDN_ELEMS, 128, S, E, c.tid0);
#else
                g8::phase<(Y_FP8 ? 2 : 1), false, false>(smem, (const char*)(ws + WS_HBUF), (const char*)((const bf16_t*)(ws + WS_WDN) + (size_t)layer * 65 * WDN_ELEMS), 256, S, E, c.tid0);
#endif
            }
#else
            phase_moe2((const bf16_t*)(ws + WS_HBUF), (const bf16_t*)(ws + WS_WDN) + (size_t)layer * 65 * WDN_ELEMS, CNT, (bf16_t*)(ws + U_Y), c);
#endif
            SEAM(pb + 10); }
        PH(pb + 11)
#if Y_FP8
            if (layer == 3) phase_combine8<true>((const unsigned char*)(ws + U_Y), (const int*)(ws + WS_ASG), (const float*)(ws + WS_ASGW), CNT, (const float*)ain[28] + layer * 1024, (const float*)ain[29] + layer * 1024, a.out, XBF, c);
            else phase_combine8<false>((const unsigned char*)(ws + U_Y), (const int*)(ws + WS_ASG), (const float*)(ws + WS_ASGW), CNT, (const float*)ain[28] + layer * 1024, (const float*)ain[29] + layer * 1024, a.out, XBF, c);
            SEAM(pb + 11); }
#else
            if (layer == 3) phase_combine<true>((const bf16_t*)(ws + U_Y), (const int*)(ws + WS_ASG), (const float*)(ws + WS_ASGW), CNT, (const float*)ain[28] + layer * 1024, (const float*)ain[29] + layer * 1024, a.out, XBF, c);
            else phase_combine<false>((const bf16_t*)(ws + U_Y), (const int*)(ws + WS_ASG), (const float*)(ws + WS_ASGW), CNT, (const float*)ain[28] + layer * 1024, (const float*)ain[29] + layer * 1024, a.out, XBF, c);
            SEAM(pb + 11); }
#endif
    }
#undef IN
#undef XBF
#undef X1
#undef PROJ
#undef GATES
#undef MIXO
#undef YBUF
#undef ROPEM
#undef ROPES
#undef XRES
#undef CNT
#undef WIN
#undef WOUT
#undef PH
#undef PH_CTX
#undef UNIT_CTX
#undef SEAM
}

extern "C" void kernel_launch(void* const* d_in, const int* in_sizes, int n_in, void* d_out, int out_size, void* d_ws, size_t ws_size, hipStream_t stream) {
    static int grid = 0;
    if (grid == 0) {
        if (n_in != 30 || out_size != T * 1024 || ws_size < WS_END) {
            fprintf(stderr, "kernel_launch: unexpected shapes (n_in %d, out %d, ws %zu < %zu)\n", n_in, out_size, ws_size, (size_t)WS_END);
            grid = -1; return;
        }
        int dev = 0, cus = 0, per_cu = 0;
        (void)hipGetDevice(&dev);
        (void)hipDeviceGetAttribute(&cus, hipDeviceAttributeMultiprocessorCount, dev);
        (void)hipFuncSetAttribute((const void*)fwd, hipFuncAttributeMaxDynamicSharedMemorySize, DYN_LDS);
        (void)hipOccupancyMaxActiveBlocksPerMultiprocessor(&per_cu, (const void*)fwd, NT, DYN_LDS);
        (void)hipGetLastError();
        if (per_cu < 1) per_cu = 1;
        grid = cus;
    }
    if (grid < 0) return;
    (void)hipMemsetAsync((char*)d_ws + WS_CTL, 0, CTL_BYTES, stream);
    Args a{};
    for (int i = 0; i < 30; ++i) a.in[i] = d_in[i];
    a.out = (float*)d_out; a.ws = (unsigned char*)d_ws; a.pad = 0;
#if ONE_LAUNCH
    a.ph_lo = 0; a.ph_hi = NPH; a.use_bar = 1;
    hipLaunchKernelGGL(fwd, dim3(grid), dim3(NT), DYN_LDS, stream, a);
#else
    for (int p = 0; p < NPH; ++p) {
        a.ph_lo = p; a.ph_hi = p + 1; a.use_bar = 0;
        hipLaunchKernelGGL(fwd, dim3(grid), dim3(NT), DYN_LDS, stream, a);
    }
#endif
}
```

```cpp
#include <hip/hip_runtime.h>
#include <stdint.h>
#include <stdio.h>

#define REP_GEMM 1
#define REP_PHASE 0
#define REP_G0 1
#define REP_G1 1
#define REP_G2 1
#define REP_G3 1
#define REP_MIX 1
#define REP_ONLY 0
#define REP_CMB 1
#define REP_PRO 1
#define REP_TOK 1
#define MOE2_G8 1
#ifndef G8_SPLIT
#define G8_SPLIT 0
#endif
#ifndef FUSE_LNROUTE
#define FUSE_LNROUTE 1
#endif
#ifndef STATIC_UNIFORM
#define STATIC_UNIFORM 1
#endif
#ifndef DEFER_CONV
#define DEFER_CONV 1
#endif
#ifndef Y_FP8
#define Y_FP8 1
#endif
#ifndef MOE2_F8
#define MOE2_F8 1
#endif
#ifndef MOE1_F8
#define MOE1_F8 1
#endif
#ifndef INP_F8
#define INP_F8 1
#endif
#ifndef ONE_LAUNCH
#define ONE_LAUNCH 1
#endif

typedef unsigned short bf16_t;
typedef short bf16x8 __attribute__((ext_vector_type(8)));
typedef float f32x4 __attribute__((ext_vector_type(4)));
typedef float f32x2 __attribute__((ext_vector_type(2)));
typedef int i32x4 __attribute__((ext_vector_type(4)));
typedef int i32x8 __attribute__((ext_vector_type(8)));
typedef unsigned u32x4 __attribute__((ext_vector_type(4)));
typedef unsigned u32x2 __attribute__((ext_vector_type(2)));
#define LAS __attribute__((address_space(3)))
#define GAS __attribute__((address_space(1)))

constexpr int T = 16384, SEQ = 2048;
constexpr int NPAD = 2560;
constexpr int CAP = 16384;
constexpr int RBR = 256;
constexpr int MAXRB = 512 + 64 + 64;
constexpr int MAXROWS = MAXRB * RBR;
constexpr float ALPHA = 1.681792830507429f;
constexpr int PPL = 12;
constexpr int NPH = 1 + 4 * PPL;
constexpr int NT = 512, NW = 8;
constexpr int HALF_LDS = 65536 + 64 + 1024;
constexpr int LDS_BLK = 2 * HALF_LDS;
constexpr int DYN_LDS = LDS_BLK + 64 + 1024 + 2560;

constexpr size_t cmax(size_t a, size_t b) { return a > b ? a : b; }
constexpr size_t WS_CTL = 0;
constexpr size_t CTL_BYTES = 65536;
constexpr size_t WS_WIN = WS_CTL + CTL_BYTES;
constexpr size_t WIN_ELEMS = (size_t)NPAD * 1024;
constexpr size_t WS_WQB = WS_WIN + 4 * WIN_ELEMS * 2;
constexpr size_t WQB_ELEMS = 768 * 256;
constexpr size_t WS_WKVB = WS_WQB + 2 * WQB_ELEMS * 2;
constexpr size_t WKVB_ELEMS = 1024 * 128;
constexpr size_t WS_WOUT = WS_WKVB + 2 * WKVB_ELEMS * 2;
constexpr size_t WOUT_ELEMS = 1024 * 1024;
constexpr size_t WS_WRT = WS_WOUT + 4 * WOUT_ELEMS * 2;
constexpr size_t WRT_ELEMS = 128 * 1024;
constexpr size_t WS_WGU = WS_WRT + 4 * WRT_ELEMS * 2;
constexpr size_t WGU_ELEMS = 512 * 1024;
constexpr size_t WS_WDN = WS_WGU + 4 * 65 * WGU_ELEMS * 2;
constexpr size_t WDN_ELEMS = 1024 * 256;
constexpr size_t WS_ROPEM = WS_WDN + 4 * 65 * WDN_ELEMS * 2;
constexpr size_t WS_ROPES = WS_ROPEM + (size_t)T * 16 * 2 * 4;
constexpr size_t WS_X1 = WS_ROPES + (size_t)T * 32 * 2 * 4;
constexpr size_t WS_XBF = WS_X1 + (size_t)T * 1024 * 4;
constexpr size_t XB8I_OFF = (size_t)T * 1024;
constexpr size_t WS_HBUF = WS_XBF + (size_t)T * 1024 * 2;
constexpr size_t WS_LOG = WS_HBUF + (size_t)MAXROWS * 256 * 2;
constexpr size_t WS_ASG = WS_LOG + (size_t)T * 64 * 4;
constexpr size_t WS_ASGW = WS_ASG + (size_t)T * 8 * 4;
constexpr size_t WS_LTOK = WS_ASGW + (size_t)T * 8 * 4;
constexpr size_t WS_LW = WS_LTOK + (size_t)65 * CAP * 4;
constexpr size_t WS_U = WS_LW + (size_t)65 * CAP * 4;
constexpr size_t U_Y = WS_U;
constexpr size_t U_PROJ = WS_U;
constexpr size_t U_GATES = U_PROJ + (size_t)T * NPAD * 2;
constexpr size_t U_CQ = U_GATES + (size_t)T * 8 * 4;
constexpr size_t U_CKV = U_CQ + (size_t)T * 256 * 2;
constexpr size_t U_KROPE = U_CKV + (size_t)T * 128 * 2;
constexpr size_t U_QF = U_KROPE + (size_t)T * 32 * 2;
constexpr size_t U_KN = U_QF + (size_t)T * 768 * 2;
constexpr size_t U_VV = U_KN + (size_t)T * 512 * 2;
constexpr size_t U_GQ = U_VV + (size_t)T * 512 * 2;
constexpr size_t U_GK = U_GQ + (size_t)T * 512 * 2;
constexpr size_t U_GV = U_GK + (size_t)T * 512 * 2;
constexpr size_t U_BETA = U_GV + (size_t)T * 512 * 2;
constexpr size_t U_GLOG = U_BETA + (size_t)T * 4 * 4;
constexpr size_t U_MIXO = U_GLOG + (size_t)T * 4 * 4;
constexpr size_t U_YBUF = U_MIXO + (size_t)T * 1024 * 2;
constexpr size_t U_END1 = U_YBUF + (size_t)T * 1024 * 4;
constexpr size_t WS_END = WS_U + cmax((size_t)MAXROWS * 1024 * 2, U_END1 - WS_U);

constexpr int CW_CNT = 4096;
constexpr int CW_WORK = 8192;

#define XB_TMO      128
#define XB_XCNT(j)  (256  + 64 * (j))
#define XB_XSUB(j)  (1280 + 64 * (j))
#define XB_XGEN(j)  (2304 + 64 * (j))
#define XB_TOP      3328
#define XB_TOPGEN   3392
#define XCD_BAR_WORDS 3456
#define XB_SPIN_CAP (1u << 18)

__device__ __forceinline__ unsigned xb_ld(unsigned* p)              { return __hip_atomic_load(p, __ATOMIC_RELAXED, __HIP_MEMORY_SCOPE_AGENT); }
__device__ __forceinline__ int lane_id_v() { int l; asm volatile("v_mbcnt_lo_u32_b32 %0, -1, 0\n\tv_mbcnt_hi_u32_b32 %0, -1, %0" : "=v"(l)); return l; }
__device__ __forceinline__ unsigned xb_add(unsigned* p, unsigned v) { return __hip_atomic_fetch_add(p, v, __ATOMIC_RELAXED, __HIP_MEMORY_SCOPE_AGENT); }
__device__ __forceinline__ unsigned xb_xcc_id() { return (unsigned)__builtin_amdgcn_s_getreg((3 << 11) | 20) & 0xFu; }
#define XB_SPIN(cond, bar) do { unsigned _sp = 0; while (cond) { __builtin_amdgcn_s_sleep(1); \
    if ((++_sp & 255u) == 0u) { if (xb_ld(&(bar)[XB_TMO])) break; if (_sp > XB_SPIN_CAP) { atomicAdd(&(bar)[XB_TMO], 1u); break; } } } } while (0)

struct XcdBarrier { unsigned* bar; unsigned x; volatile LAS unsigned* st; int wave; };

__device__ __forceinline__ XcdBarrier xcd_barrier_post(unsigned* bar, volatile LAS unsigned* st, int tid0) {
    XcdBarrier b; b.bar = bar; b.x = xb_xcc_id(); b.st = st; b.wave = __builtin_amdgcn_readfirstlane(tid0 >> 6);
    if (tid0 == 0) (void)xb_add(&bar[XB_XCNT(b.x)], 1u);
    return b;
}
__device__ __forceinline__ void xcd_barrier_complete(unsigned* bar, unsigned x, unsigned& nloc, unsigned& nx) {
    const unsigned G = gridDim.x * gridDim.y * gridDim.z;
    unsigned sum, cnt, mine, sp = 0u;
    for (;;) {
        sum = 0u; cnt = 0u; mine = 0u;
#pragma unroll
        for (unsigned j = 0; j < 16; ++j) { const unsigned c = xb_ld(&bar[XB_XCNT(j)]); sum += c; cnt += (c > 0u) ? 1u : 0u; mine = (j == x) ? c : mine; }
        if (sum == G) break;
        __builtin_amdgcn_s_sleep(1);
        if ((++sp & 255u) == 0u) { if (xb_ld(&bar[XB_TMO])) break; if (sp > XB_SPIN_CAP) { atomicAdd(&bar[XB_TMO], 1u); break; } }
    }
    nloc = mine > 0u ? mine : 1u; nx = cnt > 0u ? cnt : 1u;
}
__device__ __forceinline__ void xcd_barrier(const XcdBarrier& b) {
    asm volatile("s_waitcnt vmcnt(0)" ::: "memory");
    __syncthreads();
    if (b.wave == 0 && b.st[0] == 0u) {
        unsigned* bar0 = b.bar; const unsigned x0 = __builtin_amdgcn_readfirstlane(b.x);
        const int l0 = lane_id_v();
        const unsigned G = gridDim.x * gridDim.y * gridDim.z;
        unsigned sum, cnt, mine, sp = 0u;
        for (;;) {
            const unsigned cj = (l0 < 16) ? xb_ld(&bar0[XB_XCNT(l0)]) : 0u;
            sum = 0u; cnt = 0u;
#pragma unroll
            for (int j = 0; j < 16; ++j) { const unsigned v = (unsigned)__builtin_amdgcn_readlane((int)cj, j); sum += v; cnt += (v > 0u) ? 1u : 0u; }
            mine = (unsigned)__builtin_amdgcn_readlane((int)cj, (int)x0);
            if (sum == G) break;
            __builtin_amdgcn_s_sleep(1);
            if ((++sp & 255u) == 0u) { if (xb_ld(&bar0[XB_TMO])) break; if (sp > XB_SPIN_CAP) { if (l0 == 0) atomicAdd(&bar0[XB_TMO], 1u); break; } }
        }
        if (l0 == 0) { b.st[0] = mine > 0u ? mine : 1u; b.st[1] = cnt > 0u ? cnt : 1u; }
        __builtin_amdgcn_s_waitcnt(0);
    }
    if (b.wave == 0 && lane_id_v() == 0) {
        unsigned* bar = b.bar; unsigned bx = __builtin_amdgcn_readfirstlane(b.x);
        asm volatile("" : "+s"(bar), "+s"(bx));
        __builtin_amdgcn_s_waitcnt(0);
        unsigned nloc = b.st[0], nx = b.st[1];
        if (nloc == 0u) { xcd_barrier_complete(bar, bx, nloc, nx); b.st[0] = nloc; b.st[1] = nx; }
        const unsigned old = xb_add(&bar[XB_XSUB(bx)], 1u);
        const unsigned gen = old / nloc;
        if (old + 1u == (gen + 1u) * nloc) {
            __builtin_amdgcn_fence(__ATOMIC_RELEASE, "agent");
            asm volatile("s_waitcnt vmcnt(0)" ::: "memory");
            const unsigned og = xb_add(&bar[XB_TOP], 1u);
            const unsigned tg = og / nx;
            if (og + 1u == (tg + 1u) * nx) xb_add(&bar[XB_TOPGEN], 1u);
            else XB_SPIN(xb_ld(&bar[XB_TOPGEN]) == tg, bar);
            __builtin_amdgcn_fence(__ATOMIC_ACQUIRE, "agent");
            xb_add(&bar[XB_XGEN(bx)], 1u);
            asm volatile("s_waitcnt vmcnt(0)" ::: "memory");
        } else {
            __builtin_amdgcn_fence(__ATOMIC_ACQUIRE, "agent");
            asm volatile("s_waitcnt vmcnt(0)" ::: "memory");
            XB_SPIN(xb_ld(&bar[XB_XGEN(bx)]) == gen, bar);
            asm volatile("" ::: "memory");
        }
    }
    __syncthreads();
}

__device__ __forceinline__ float bf2f(unsigned v) { return __uint_as_float(v << 16); }
__device__ __forceinline__ float bflo(unsigned w) { return __uint_as_float(w << 16); }
__device__ __forceinline__ float bfhi(unsigned w) { return __uint_as_float(w & 0xffff0000u); }
__device__ __forceinline__ unsigned f2bf(float f) { unsigned u = __float_as_uint(f); u += 0x7fffu + ((u >> 16) & 1u); return u >> 16; }
__device__ __forceinline__ unsigned pk2(float lo, float hi) { return f2bf(lo) | (f2bf(hi) << 16); }
__device__ __forceinline__ unsigned cvt_pk(float lo, float hi) { unsigned r; asm volatile("v_cvt_pk_bf16_f32 %0, %1, %2" : "=v"(r) : "v"(lo), "v"(hi)); return r; }
template <class T> __device__ __forceinline__ T shfl_xor_(T v, int o) { return __builtin_bit_cast(T, __builtin_amdgcn_ds_bpermute((lane_id_v() ^ o) << 2, __builtin_bit_cast(int, v))); }
template <class T> __device__ __forceinline__ T shfl_up_(T v, int o) { const int l = lane_id_v(), s = (l - o < 0) ? l : l - o; return __builtin_bit_cast(T, __builtin_amdgcn_ds_bpermute(s << 2, __builtin_bit_cast(int, v))); }
template <class T> __device__ __forceinline__ T shfl_c_(T v, int src  ) { return __builtin_bit_cast(T, __builtin_amdgcn_readlane(__builtin_bit_cast(int, v), src)); }
__device__ __forceinline__ float wave_dpp_(float v, int ctrl_sel) {
    int x = __builtin_bit_cast(int, v), r;
    if (ctrl_sel == 0) r = __builtin_amdgcn_update_dpp(0, x, 0xB1, 0xF, 0xF, true);
    else if (ctrl_sel == 1) r = __builtin_amdgcn_update_dpp(0, x, 0x4E, 0xF, 0xF, true);
    else if (ctrl_sel == 2) r = __builtin_amdgcn_update_dpp(0, x, 0x141, 0xF, 0xF, true);
    else r = __builtin_amdgcn_update_dpp(0, x, 0x140, 0xF, 0xF, true);
    return __builtin_bit_cast(float, r);
}
__device__ __forceinline__ float wave_sum_dpp(float v) {
    v += wave_dpp_(v, 0); v += wave_dpp_(v, 1); v += wave_dpp_(v, 2); v += wave_dpp_(v, 3);
    v += shfl_xor_(v, 16); v += shfl_xor_(v, 32);
    return v;
}
__device__ __forceinline__ float wave_sum(float v) { return wave_sum_dpp(v); }
__device__ __forceinline__ float grp8_max(float v) { v = fmaxf(v, wave_dpp_(v, 0)); v = fmaxf(v, wave_dpp_(v, 1)); v = fmaxf(v, wave_dpp_(v, 2)); return v; }
__device__ __forceinline__ int grp8_min(int v) {
    v = min(v, __builtin_amdgcn_update_dpp(0, v, 0xB1, 0xF, 0xF, true)); v = min(v, __builtin_amdgcn_update_dpp(0, v, 0x4E, 0xF, 0xF, true)); v = min(v, __builtin_amdgcn_update_dpp(0, v, 0x141, 0xF, 0xF, true));
    return v;
}
__device__ __forceinline__ float sigmoidf_(float x) { return 1.f / (1.f + expf(-x)); }
__device__ __forceinline__ float siluf_(float x) { return x / (1.f + expf(-x)); }
__device__ __forceinline__ float softplusf_(float x) { return fmaxf(x, 0.f) + __logf(1.f + __expf(-fabsf(x))); }
__device__ __forceinline__ void glds16(const void* g, void* l) {
    __builtin_amdgcn_global_load_lds((const GAS unsigned*)g, (LAS unsigned*)l, 16, 0, 0);
}
__device__ __forceinline__ void glds16s(const char* sbase, unsigned voff, unsigned lds_uniform) {
    asm volatile("s_mov_b32 m0, %2\n\ts_nop 0\n\tglobal_load_lds_dwordx4 %0, %1" :: "v"(voff), "s"(sbase), "s"(lds_uniform) : "memory", "m0");
}
__device__ __forceinline__ const char* uniform_ptr(const void* p) {
    const unsigned long long v = (unsigned long long)p;
    const unsigned lo = (unsigned)__builtin_amdgcn_readfirstlane((int)(unsigned)v), hi = (unsigned)__builtin_amdgcn_readfirstlane((int)(unsigned)(v >> 32));
    return (const char*)(((unsigned long long)hi << 32) | lo);
}
__device__ __forceinline__ void unpack8(const u32x4 r, float (&f)[8]) {
    f[0] = bflo(r.x); f[1] = bfhi(r.x); f[2] = bflo(r.y); f[3] = bfhi(r.y);
    f[4] = bflo(r.z); f[5] = bfhi(r.z); f[6] = bflo(r.w); f[7] = bfhi(r.w);
}

struct Args {
    const void* in[30];
    float* out;
    unsigned char* ws;
    int ph_lo, ph_hi, use_bar, pad;
};

struct Ctx { int tid, lane, wid, wr, wc, fr, fq, bid, nblk; unsigned char* smem; int half, tid0; unsigned char* smem0; };

#define WAIT_V(n) asm volatile("s_waitcnt vmcnt(" #n ")" ::: "memory")
__device__ __forceinline__ void gemm_tile(const bf16_t* a0, const bf16_t* a1, const bf16_t* b0, const bf16_t* b1,
                                          int nk, f32x4 (&acc)[4][4], const Ctx& c) {
#pragma unroll
    for (int m = 0; m < 4; ++m)
#pragma unroll
        for (int n = 0; n < 4; ++n) acc[m][n] = (f32x4){0.f, 0.f, 0.f, 0.f};
    unsigned char* smem = c.smem;
    const int sb = c.tid * 16;
    const int kofs = ((c.tid & 3) ^ ((c.tid >> 4) & 3)) * 8;
    a0 += kofs; a1 += kofs; b0 += kofs; b1 += kofs;
#define G_STAGE(kt_) do { unsigned char* sp_ = smem + ((kt_) & 3) * 16384 + sb; const int ko_ = (kt_) * 32; \
        glds16(a0 + ko_, sp_); glds16(a1 + ko_, sp_ + 4096); glds16(b0 + ko_, sp_ + 8192); glds16(b1 + ko_, sp_ + 12288); } while (0)
#define G_READ(kt_, AF, BF) do { const unsigned char* sa_ = smem + ((kt_) & 3) * 16384 + c.wr * 4096 + roff; const unsigned char* sb_ = smem + ((kt_) & 3) * 16384 + 8192 + c.wc * 4096 + roff; \
        _Pragma("unroll") for (int m = 0; m < 4; ++m) AF[m] = *(const bf16x8*)(sa_ + m * 1024); \
        _Pragma("unroll") for (int n = 0; n < 4; ++n) BF[n] = *(const bf16x8*)(sb_ + n * 1024); } while (0)
#define G_MMA(AF, BF) do { __builtin_amdgcn_s_setprio(1); \
        _Pragma("unroll") for (int m = 0; m < 4; ++m) _Pragma("unroll") for (int n = 0; n < 4; ++n) acc[m][n] = __builtin_amdgcn_mfma_f32_16x16x32_bf16(BF[n], AF[m], acc[m][n], 0, 0, 0); \
        __builtin_amdgcn_s_setprio(0); } while (0)
#define G_BAR() do { asm volatile("" ::: "memory"); __builtin_amdgcn_s_barrier(); asm volatile("" ::: "memory"); } while (0)
    const int roff = (c.fr * 64) + ((c.fq ^ ((c.fr >> 2) & 3)) * 16);
    WAIT_V(0);
    G_STAGE(0); G_STAGE(1); G_STAGE(2); G_STAGE(3);
    bf16x8 fa0[4], fb0[4], fa1[4], fb1[4];
    WAIT_V(12); G_BAR();
    G_READ(0, fa0, fb0);
#define G_LGK0() asm volatile("s_waitcnt lgkmcnt(0)" ::: "memory")
    int kt = 0;
    for (; kt < nk - 4; kt += 4) {
        G_LGK0(); WAIT_V(8); G_BAR(); G_STAGE(kt + 4); G_READ(1, fa1, fb1); G_MMA(fa0, fb0);
        G_LGK0(); WAIT_V(8); G_BAR(); G_STAGE(kt + 5); G_READ(2, fa0, fb0); G_MMA(fa1, fb1);
        G_LGK0(); WAIT_V(8); G_BAR(); G_STAGE(kt + 6); G_READ(3, fa1, fb1); G_MMA(fa0, fb0);
        G_LGK0(); WAIT_V(8); G_BAR(); G_STAGE(kt + 7); G_READ(0, fa0, fb0); G_MMA(fa1, fb1);
    }
    G_LGK0(); WAIT_V(8); G_BAR(); G_READ(1, fa1, fb1); G_MMA(fa0, fb0);
    G_LGK0(); WAIT_V(4); G_BAR(); G_READ(2, fa0, fb0); G_MMA(fa1, fb1);
    G_LGK0(); WAIT_V(0); G_BAR(); G_READ(3, fa1, fb1); G_MMA(fa0, fb0);
    G_MMA(fa1, fb1);
#undef G_LGK0
#undef G_STAGE
#undef G_READ
#undef G_MMA
#undef G_BAR
    __syncthreads();
}

namespace g8 {
constexpr int BM = 256, BK = 64, HALF = 128, HTB = HALF * BK * 2, STAGE_BYTES = 8 * HTB;
__device__ __forceinline__ int lds_byte(int r, int c) { const int st = (r >> 4) * 2 + (c >> 5), rr = r & 15, cc = c & 31, ob = rr * 64 + cc * 2; return st * 1024 + (ob ^ (((ob >> 9) & 1) << 5)); }
__device__ __forceinline__ void stage_rc(int b, int& R, int& C) { const int st = b / 1024, sb = b % 1024, swz = sb ^ (((sb >> 9) & 1) << 5); R = (st >> 1) * 16 + swz / 64; C = (st & 1) * 32 + (swz % 64) / 2; }
__device__ __forceinline__ int perm32(int rho) { const int n = rho >> 4, i = rho & 15; return 8 * (i >> 2) + 4 * n + (i & 3); }
struct Unit { int pm, pn, bt; };

template <int PERM, bool GATHER, bool F8, class Sched, class Epi, bool ONETRIP = false>
__device__ __forceinline__ void phase(unsigned char* ldsp, const char* Abase, const char* Bbase, int K, const Sched& S, const Epi& E, int tid_in) {
    LAS unsigned char* lds = (LAS unsigned char*)ldsp;
    int tid = tid_in; asm volatile("" : "+v"(tid));
    const int wid = __builtin_amdgcn_readfirstlane(tid >> 6), lane = tid & 63, wr = wid >> 2, wc = wid & 3, fr = lane & 15, fq = lane >> 4;
    const int nt = K / BK;
    unsigned voffA[2], voffB[2];
#pragma unroll
    for (int i = 0; i < 2; ++i) { int R, C; stage_rc(tid * 16 + i * 8192, R, C); const int Rb = (PERM == 2) ? ((R >> 5) * 64 + ((R & 15) >> 2) * 16 + ((R >> 4) & 1) * 4 + (R & 3)) : (PERM == 1) ? ((R >> 5) * 64 + perm32(R & 31)) : (((R >> 5) * 2 + ((R & 15) >> 3)) * 32 + ((R >> 4) & 1) * 16 + (((R & 15) >> 2) & 1) * 8 + (R & 3));
        voffA[i] = (unsigned)(R * K + C) * 2u; voffB[i] = (unsigned)(Rb * K + C) * 2u; }
    const size_t kstep = (size_t)(BK * 2);
    const size_t hstep = (size_t)HALF * K * 2, tstep = 2 * hstep, bhstep = (PERM == 2) ? (size_t)8 * K * 2 : (PERM == 1) ? (size_t)32 * K * 2 : (size_t)4 * K * 2;
    const unsigned ldsw = (unsigned)wid * 1024u;
    const int aoff = F8 ? lds_byte(wr * 64 + fr, fq * 16) : lds_byte(wr * 64 + fr, fq * 8), boff = F8 ? lds_byte(wc * 32 + fr, fq * 16) : lds_byte(wc * 32 + fr, fq * 8);
    constexpr int KP = F8 ? 16 : 1024;
#define G8_SA(b, h) (((b) * 2 + (h)) * HTB)
#define G8_SB(b, h) ((4 + (b) * 2 + (h)) * HTB)
#define G8_DMA(gptr, voff32, ldsoff) do { const char* _gp = (gptr); const unsigned _lo = (unsigned)(size_t)(ldsp) + (unsigned)(ldsoff); \
        asm volatile("s_mov_b32 m0, %2\n\ts_nop 0\n\tglobal_load_lds_dwordx4 %0, %1" :: "v"(voff32), "s"(_gp), "s"(_lo) : "memory", "m0"); } while (0)
#define G8_STAGE(bufoff, gbase, voff) do { _Pragma("unroll") for (int _i = 0; _i < 2; ++_i) G8_DMA((const char*)(gbase), (voff)[_i], (bufoff) + ldsw + _i * 8192); } while (0)
#define G8_STAGEA(bufoff, gbase, h, kb) do { if constexpr (GATHER) { _Pragma("unroll") for (int _i = 0; _i < 2; ++_i) G8_DMA(Abase + (kb), vA[2 * (h) + _i], (bufoff) + ldsw + _i * 8192); } \
        else G8_STAGE(bufoff, (gbase) + (size_t)(h) * hstep + (kb), voffA); } while (0)
#define G8_LDA(dst, b, h) do { _Pragma("unroll") for (int m = 0; m < 4; ++m) _Pragma("unroll") for (int k = 0; k < 2; ++k) dst[m][k] = *(const LAS bf16x8*)(lds + G8_SA(b, h) + aoff + m * 2048 + k * KP); } while (0)
#define G8_LDB(dst, b, h) do { _Pragma("unroll") for (int n = 0; n < 2; ++n) _Pragma("unroll") for (int k = 0; k < 2; ++k) dst[n][k] = *(const LAS bf16x8*)(lds + G8_SB(b, h) + boff + n * 2048 + k * KP); } while (0)
#define G8_CAT(x, y) __builtin_shufflevector(__builtin_bit_cast(i32x4, (x)), __builtin_bit_cast(i32x4, (y)), 0, 1, 2, 3, 4, 5, 6, 7)
#define G8_MMA(ai, bj, At, Bt, Z) do { __builtin_amdgcn_s_setprio(1); _Pragma("unroll") for (int m = 0; m < 4; ++m) _Pragma("unroll") for (int n = 0; n < 2; ++n) { \
        if constexpr (F8) acc[ai][bj][m][n] = __builtin_amdgcn_mfma_scale_f32_16x16x128_f8f6f4(G8_CAT(Bt[n][0], Bt[n][1]), G8_CAT(At[m][0], At[m][1]), \
                                                  ((Z) && ONETRIP) ? (f32x4){0.f, 0.f, 0.f, 0.f} : acc[ai][bj][m][n], 0, 0, 0, 0, 0, 0); \
        else { _Pragma("unroll") for (int k = 0; k < 2; ++k) acc[ai][bj][m][n] = __builtin_amdgcn_mfma_f32_16x16x32_bf16(Bt[n][k], At[m][k], acc[ai][bj][m][n], 0, 0, 0); } } \
        __builtin_amdgcn_s_setprio(0); } while (0)
#define G8_WAIT_V(n) asm volatile("s_waitcnt vmcnt(" #n ")" ::: "memory")
#define G8_WAIT_L(n) asm volatile("s_waitcnt lgkmcnt(" #n ")" ::: "memory")
#define G8_BAR __builtin_amdgcn_s_barrier()
#define G8_SCHED __builtin_amdgcn_sched_barrier(0)
    Unit cur, nxt; int ui = 0;
    if (!S.next(0, cur)) return;
    f32x4 acc[2][2][4][2];
#pragma unroll
    for (int a = 0; a < 2; ++a)
#pragma unroll
        for (int b = 0; b < 2; ++b)
#pragma unroll
            for (int m = 0; m < 4; ++m)
#pragma unroll
                for (int n = 0; n < 2; ++n) acc[a][b][m][n] = (f32x4){0.f, 0.f, 0.f, 0.f};
    bf16x8 At[4][2], B0[2][2], B1[2][2];
    const char* cA = Abase + (size_t)cur.pm * tstep; const char* cB = Bbase + (size_t)cur.bt * tstep;
    unsigned vA[4] = {0u, 0u, 0u, 0u};
    if constexpr (GATHER) S.aoff(cur, tid, vA);
    asm volatile("s_waitcnt vmcnt(0)" ::: "memory");
    G8_STAGE(G8_SB(0, 0), cB, voffB); G8_STAGEA(G8_SA(0, 0), cA, 0, 0); G8_STAGE(G8_SB(0, 1), cB + bhstep, voffB); G8_STAGEA(G8_SA(0, 1), cA, 1, 0);
    if (wr == 1) G8_BAR;
    G8_WAIT_V(4); G8_BAR;
    G8_STAGE(G8_SB(1, 0), cB + kstep, voffB); G8_STAGEA(G8_SA(1, 0), cA, 0, kstep); G8_STAGE(G8_SB(1, 1), cB + bhstep + kstep, voffB);
    G8_WAIT_V(6); G8_BAR;
    G8_STAGEA(G8_SA(1, 1), cA, 1, kstep);
    for (;;) {
        const bool has_next = S.next(ui + 1, nxt);
        const char* nA = has_next ? Abase + (size_t)nxt.pm * tstep : cA; const char* nB = has_next ? Bbase + (size_t)nxt.bt * tstep : cB;
        for (int t = 0; t < nt; t += 2) {
            const bool last = (t == nt - 2);
            const int lastf = __builtin_amdgcn_readfirstlane(last ? 1 : 0);
            const size_t k2 = last ? 0 : (size_t)(t + 2) * kstep, k3 = k2 + kstep;
            const char* a2 = last ? nA : cA; const char* b2 = last ? nB : cB + (size_t)(t + 2) * kstep;
            const char* b3 = b2 + kstep;
            G8_LDB(B0, 0, 0); G8_SCHED; G8_LDA(At, 0, 0);
            if constexpr (GATHER) { if (last && has_next) S.aoff(nxt, tid, vA); }
            G8_WAIT_L(8); G8_BAR; G8_WAIT_L(0); G8_MMA(0, 0, At, B0, 1); G8_BAR; G8_SCHED;
            G8_LDB(B1, 0, 1); G8_STAGE(G8_SB(0, 0), b2, voffB);
            G8_BAR; G8_WAIT_L(0); G8_MMA(0, 1, At, B1, 1); G8_BAR;
            G8_LDA(At, 0, 1); G8_STAGEA(G8_SA(0, 0), a2, 0, k2);
            G8_BAR; G8_WAIT_L(0); G8_MMA(1, 0, At, B0, 1); G8_BAR; G8_SCHED;
            G8_STAGE(G8_SB(0, 1), b2 + bhstep, voffB);
            const int pend = __builtin_amdgcn_readfirstlane((t == 0 && ui > 0) ? 1 : 0);
            asm volatile("s_cmp_lg_u32 %0, 0\n\ts_cbranch_scc1 1f\n\ts_waitcnt vmcnt(6)\n1:\n\ts_waitcnt vmcnt(%1)" :: "s"(pend), "n"(6 + (Epi::SPLIT ? Epi::NQ : Epi::NST)) : "memory", "scc");
            G8_BAR; G8_MMA(1, 1, At, B1, 1); G8_BAR;
            G8_LDB(B0, 1, 0); G8_SCHED; G8_LDA(At, 1, 0); G8_STAGEA(G8_SA(0, 1), a2, 1, k2);
            G8_WAIT_L(8); G8_BAR; G8_WAIT_L(0); G8_MMA(0, 0, At, B0, 0); G8_BAR; G8_SCHED;
            if constexpr (Epi::SPLIT) { E.template part_cond<0, 0>(acc, cur, wr, wc, fr, fq, lastf); G8_SCHED; }
            G8_LDB(B1, 1, 1); G8_STAGE(G8_SB(1, 0), b3, voffB);
            G8_BAR; G8_WAIT_L(0); G8_MMA(0, 1, At, B1, 0); G8_BAR;
            if constexpr (Epi::SPLIT) { E.template part_cond<0, 1>(acc, cur, wr, wc, fr, fq, lastf); G8_SCHED; }
            G8_LDA(At, 1, 1); G8_STAGEA(G8_SA(1, 0), a2, 0, k3);
            G8_BAR; G8_WAIT_L(0); G8_MMA(1, 0, At, B0, 0); G8_BAR; G8_SCHED;
            G8_STAGE(G8_SB(1, 1), b3 + bhstep, voffB);
            if constexpr (Epi::SPLIT) {
                asm volatile("s_cmp_lg_u32 %0, 0\n\ts_cbranch_scc1 1f\n\ts_waitcnt vmcnt(6)\n1:\n\ts_waitcnt vmcnt(%1)" :: "s"(lastf), "n"(6 + 2 * Epi::NQ) : "memory", "scc");
                G8_SCHED; E.template part_cond<1, 0>(acc, cur, wr, wc, fr, fq, lastf); G8_SCHED;
            } else G8_WAIT_V(6);
            G8_BAR; G8_MMA(1, 1, At, B1, 0); G8_BAR;
            G8_STAGEA(G8_SA(1, 1), a2, 1, k3);
        }
        if constexpr (Epi::SPLIT) E.tail(acc, cur, wr, wc, fr, fq);
        else { const int l_ = lane_id_v();
               E(acc, cur, wr, wc, l_ & 15, l_ >> 4); }
        if (!has_next) break;
        if constexpr (!ONETRIP)
#pragma unroll
        for (int a = 0; a < 2; ++a)
#pragma unroll
            for (int b = 0; b < 2; ++b)
#pragma unroll
                for (int m = 0; m < 4; ++m)
#pragma unroll
                    for (int n = 0; n < 2; ++n) acc[a][b][m][n] = (f32x4){0.f, 0.f, 0.f, 0.f};
        cur = nxt; cA = nA; cB = nB; ++ui;
    }
    G8_WAIT_V(0);
    if (wr == 0) G8_BAR;
    G8_BAR;
#undef G8_SA
#undef G8_SB
#undef G8_STAGE
#undef G8_STAGEA
#undef G8_LDA
#undef G8_LDB
#undef G8_MMA
#undef G8_CAT
#undef G8_WAIT_V
#undef G8_WAIT_L
#undef G8_BAR
#undef G8_SCHED
}
}

__device__ __forceinline__ bool tile_map(int i, const Ctx& c, int ntm, int ntn, int& mt, int& nt) {
    const int vb = ((c.nblk & 15) == 0) ? ((c.bid >> 1) & 7) * (c.nblk >> 3) + (((c.bid >> 4) << 1) | (c.bid & 1)) : c.bid;
    const int L = i * c.nblk + vb;
    if (L >= ntm * ntn) return false;
    const int g = L / (8 * ntn), rem = L - g * 8 * ntn;
    const int gsz = (ntm - g * 8) < 8 ? (ntm - g * 8) : 8;
    mt = g * 8 + rem % gsz; nt = rem / gsz;
    return true;
}

__device__ __forceinline__ bool tile_map2(int i, const Ctx& c, int ntm, int ntn, int& mt, int& nt, bool& valid) {
    Ctx o = c; o.bid = c.bid ^ 1;
    int mo, no; const bool oko = tile_map(i, o, ntm, ntn, mo, no);
    valid = tile_map(i, c, ntm, ntn, mt, nt);
    if (!valid) { mt = 0; nt = 0; }
    return valid || oko;
}

struct DenseSched {
    int ntm, ntn, K, bid, nblk;
    __device__ __forceinline__ bool next(int i, g8::Unit& u) const {
        const int vb = ((nblk & 7) == 0) ? (bid & 7) * (nblk >> 3) + (bid >> 3) : bid;
        const int L = i * nblk + vb;
        if (L >= ntm * ntn) return false;
        const int g = L / (8 * ntn), rem = L - g * 8 * ntn;
        const int gsz = (ntm - g * 8) < 8 ? (ntm - g * 8) : 8;
        u.pm = g * 8 + rem % gsz; u.pn = rem / gsz; u.bt = u.pn;
        return true;
    }
};
struct MoeSched {
    int nrb, ntn, bid, nblk; const int* eb;
    __device__ __forceinline__ bool next(int i, g8::Unit& u) const {
        const int vb = ((nblk & 7) == 0) ? (bid & 7) * (nblk >> 3) + (bid >> 3) : bid;
        const int L = i * nblk + vb;
        if (L >= nrb * ntn) return false;
        const int g = L / (8 * ntn), rem = L - g * 8 * ntn;
        const int gsz = (nrb - g * 8) < 8 ? (nrb - g * 8) : 8;
        u.pm = g * 8 + rem % gsz; u.pn = rem / gsz;
        u.bt = __builtin_amdgcn_readfirstlane(eb[u.pm]) * ntn + u.pn;
        return true;
    }
};
struct MoeSchedG {
    int nrb, bid, nblk; const int* eb; const int* bst; const int* LTOK; unsigned rowb;
    __device__ __forceinline__ bool next(int i, g8::Unit& u) const {
        const int vb = ((nblk & 7) == 0) ? (bid & 7) * (nblk >> 3) + (bid >> 3) : bid;
        const int L = i * nblk + vb;
        if (L >= nrb * 2) return false;
        const int g = L >> 4, rem = L & 15;
        const int gsz = (nrb - g * 8) < 8 ? (nrb - g * 8) : 8;
        u.pm = g * 8 + rem % gsz; u.pn = rem / gsz;
        u.bt = __builtin_amdgcn_readfirstlane(eb[u.pm]) * 2 + u.pn;
        return true;
    }
    __device__ __forceinline__ void aoff(const g8::Unit& u, int tid, unsigned (&o)[4]) const {
        const int e = eb[u.pm], lb = u.pm - bst[e], cnt = bst[66 + e];
        int R0, C0, R1, C1; g8::stage_rc(tid * 16, R0, C0); g8::stage_rc(tid * 16 + 8192, R1, C1);
        const int* lt = LTOK + (size_t)e * CAP + lb * RBR;
        const int p00 = R0, p01 = R1, p10 = 128 + R0, p11 = 128 + R1;
        const int l00 = lt[p00], l01 = lt[p01], l10 = lt[p10], l11 = lt[p11];
        const int t00 = (lb * RBR + p00 < cnt) ? l00 : 0, t01 = (lb * RBR + p01 < cnt) ? l01 : 0;
        const int t10 = (lb * RBR + p10 < cnt) ? l10 : 0, t11 = (lb * RBR + p11 < cnt) ? l11 : 0;
        o[0] = (unsigned)t00 * rowb + (unsigned)C0 * 2u; o[1] = (unsigned)t01 * rowb + (unsigned)C1 * 2u;
        o[2] = (unsigned)t10 * rowb + (unsigned)C0 * 2u; o[3] = (unsigned)t11 * rowb + (unsigned)C1 * 2u;
    }
};
struct EpiMoe1 {
    static constexpr bool SPLIT = false; static constexpr int NQ = 2, NST = 8;
    bf16_t* H;
    __device__ __forceinline__ void operator()(const f32x4 (&acc)[2][2][4][2], const g8::Unit& u, int wr, int wc, int fr, int fq) const {
#pragma unroll
        for (int ai = 0; ai < 2; ++ai)
#pragma unroll
            for (int m = 0; m < 4; ++m) {
                const size_t row = (size_t)u.pm * RBR + ai * 128 + wr * 64 + m * 16 + fr;
                float h[8];
#pragma unroll
                for (int bj = 0; bj < 2; ++bj) {
                    const f32x4 g = acc[ai][bj][m][0], up = acc[ai][bj][m][1];
#pragma unroll
                    for (int j = 0; j < 4; ++j) h[bj * 4 + j] = g[j] * __builtin_amdgcn_rcpf(1.f + __expf(-g[j])) * up[j];
                }
                *(u32x4*)(H + row * 256 + u.pn * 128 + wc * 32 + fq * 8) = (u32x4){cvt_pk(h[0], h[1]), cvt_pk(h[2], h[3]), cvt_pk(h[4], h[5]), cvt_pk(h[6], h[7])};
            }
    }
    template <int ai, int bj> __device__ __forceinline__ void part_cond(const f32x4 (&acc)[2][2][4][2], const g8::Unit& u, int wr, int wc, int fr, int fq, int flag) const {}
    __device__ __forceinline__ void tail(const f32x4 (&acc)[2][2][4][2], const g8::Unit& u, int wr, int wc, int fr, int fq) const {}
};
struct EpiMoe1F8 {
    static constexpr bool SPLIT = false; static constexpr int NQ = 2, NST = 8;
    unsigned char* H;
    __device__ __forceinline__ void operator()(const f32x4 (&acc)[2][2][4][2], const g8::Unit& u, int wr, int wc, int fr, int fq) const {
#pragma unroll
        for (int ai = 0; ai < 2; ++ai)
#pragma unroll
            for (int m = 0; m < 4; ++m) {
                const size_t row = (size_t)u.pm * RBR + ai * 128 + wr * 64 + m * 16 + fr;
                u32x2 d;
#pragma unroll
                for (int bj = 0; bj < 2; ++bj) {
                    const f32x4 g = acc[ai][bj][m][0], up = acc[ai][bj][m][1];
                    float h[4];
#pragma unroll
#if MOE1_F8
                    for (int j = 0; j < 4; ++j) { const float gs = g[j] * (1.f / 512.f); h[j] = gs * __builtin_amdgcn_rcpf(1.f + __expf(-gs)) * up[j] * (2.f / 512.f); }
#else
                    for (int j = 0; j < 4; ++j) h[j] = g[j] * __builtin_amdgcn_rcpf(1.f + __expf(-g[j])) * up[j] * 2.f;
#endif
                    int w = __builtin_amdgcn_cvt_pk_fp8_f32(h[0], h[1], 0, false);
                    w = __builtin_amdgcn_cvt_pk_fp8_f32(h[2], h[3], w, true);
                    d[bj] = (unsigned)w;
                }
                *(u32x2*)(H + row * 256 + u.pn * 128 + wc * 32 + fq * 8) = d;
            }
    }
    template <int ai, int bj> __device__ __forceinline__ void part_cond(const f32x4 (&acc)[2][2][4][2], const g8::Unit& u, int wr, int wc, int fr, int fq, int flag) const {}
    __device__ __forceinline__ void tail(const f32x4 (&acc)[2][2][4][2], const g8::Unit& u, int wr, int wc, int fr, int fq) const {}
};
__device__ __forceinline__ u32x4 dpp_ror8(const u32x4 v) {
    u32x4 r;
#pragma unroll
    for (int i = 0; i < 4; ++i) r[i] = (unsigned)__builtin_amdgcn_update_dpp(0, (int)v[i], 0x128, 0xF, 0xF, true);
    return r;
}
template <bool NT = false>
__device__ __forceinline__ void perm_store(bf16_t* p  , size_t ld8  , const u32x4 p0, const u32x4 p1, int hi) {
    const u32x4 snd = hi ? p0 : p1, rcv = dpp_ror8(snd);
    if constexpr (NT) { __builtin_nontemporal_store(hi ? rcv : p0, (u32x4*)p); __builtin_nontemporal_store(hi ? p1 : rcv, (u32x4*)(p + ld8)); }
    else { *(u32x4*)p = hi ? rcv : p0; *(u32x4*)(p + ld8) = hi ? p1 : rcv; }
}
template <bool F8IN>
struct EpiIn {
    static constexpr bool SPLIT = false; static constexpr int NQ = 4, NST = 16;
    bf16_t* P; float* G; int gbase;
    template <int ai, int bj> __device__ __forceinline__ void part_cond(const f32x4 (&acc)[2][2][4][2], const g8::Unit& u, int wr, int wc, int fr, int fq, int flag) const {}
    __device__ __forceinline__ void tail(const f32x4 (&acc)[2][2][4][2], const g8::Unit& u, int wr, int wc, int fr, int fq) const {}
    __device__ __forceinline__ void operator()(const f32x4 (&acc)[2][2][4][2], const g8::Unit& u, int wr, int wc, int fr, int fq) const {
        const int hi = fr >> 3, r8 = fr & 7;
#pragma unroll
        for (int ai = 0; ai < 2; ++ai)
#pragma unroll
            for (int m = 0; m < 4; ++m) {
                const size_t rg = (size_t)u.pm * 256 + ai * 128 + wr * 64 + m * 16;
                u32x4 pk[2];
#pragma unroll
                for (int bj = 0; bj < 2; ++bj) {
                    f32x4 v0 = acc[ai][bj][m][0], v1 = acc[ai][bj][m][1];
                    if constexpr (F8IN) {
#pragma unroll
                        for (int j = 0; j < 4; ++j) { v0[j] *= (1.f / 512.f); v1[j] *= (1.f / 512.f); }
                    }
                    pk[bj] = (u32x4){cvt_pk(v0[0], v0[1]), cvt_pk(v0[2], v0[3]), cvt_pk(v1[0], v1[1]), cvt_pk(v1[2], v1[3])};
                    if (u.pn * 256 + wc * 64 + bj * 32 + fq * 8 == gbase) { *(f32x4*)(G + (rg + fr) * 8) = v0; *(f32x4*)(G + (rg + fr) * 8 + 4) = v1; }
                }
                perm_store(P + (rg + r8) * NPAD + u.pn * 256 + wc * 64 + hi * 32 + fq * 8, (size_t)8 * NPAD, pk[0], pk[1], hi);
            }
    }
};
struct EpiMoe2 {
    static constexpr bool SPLIT = false; static constexpr int NQ = 4, NST = 16;
    bf16_t* Y;
    template <int ai, int bj> __device__ __forceinline__ void part_cond(const f32x4 (&acc)[2][2][4][2], const g8::Unit& u, int wr, int wc, int fr, int fq, int flag) const {}
    __device__ __forceinline__ void tail(const f32x4 (&acc)[2][2][4][2], const g8::Unit& u, int wr, int wc, int fr, int fq) const {}
    __device__ __forceinline__ void operator()(const f32x4 (&acc)[2][2][4][2], const g8::Unit& u, int wr, int wc, int fr, int fq) const {
        const int hi = fr >> 3, r8 = fr & 7;
#pragma unroll
        for (int ai = 0; ai < 2; ++ai)
#pragma unroll
            for (int m = 0; m < 4; ++m) {
                const size_t rg = (size_t)u.pm * RBR + ai * 128 + wr * 64 + m * 16;
                u32x4 pk[2];
#pragma unroll
                for (int bj = 0; bj < 2; ++bj) {
                    const f32x4 v0 = acc[ai][bj][m][0], v1 = acc[ai][bj][m][1];
                    pk[bj] = (u32x4){cvt_pk(v0[0], v0[1]), cvt_pk(v0[2], v0[3]), cvt_pk(v1[0], v1[1]), cvt_pk(v1[2], v1[3])};
                }
                perm_store<true>(Y + (rg + r8) * 1024 + u.pn * 256 + wc * 64 + hi * 32 + fq * 8, (size_t)8 * 1024, pk[0], pk[1], hi);
            }
    }
};
struct EpiMoe2F8 {
    static constexpr bool SPLIT = false; static constexpr int NQ = 2, NST = 8;
    unsigned char* Y;
    template <int ai, int bj> __device__ __forceinline__ void part_cond(const f32x4 (&acc)[2][2][4][2], const g8::Unit& u, int wr, int wc, int fr, int fq, int flag) const {}
    __device__ __forceinline__ void tail(const f32x4 (&acc)[2][2][4][2], const g8::Unit& u, int wr, int wc, int fr, int fq) const {}
    __device__ __forceinline__ void operator()(const f32x4 (&acc)[2][2][4][2], const g8::Unit& u, int wr, int wc, int fr, int fq) const {
#pragma unroll
        for (int ai = 0; ai < 2; ++ai)
#pragma unroll
            for (int m = 0; m < 4; ++m) {
                const size_t row = (size_t)u.pm * RBR + ai * 128 + wr * 64 + m * 16 + fr;
                u32x4 d;
#pragma unroll
                for (int bj = 0; bj < 2; ++bj)
#pragma unroll
                    for (int n = 0; n < 2; ++n) {
#if MOE2_F8
                        const f32x4 v = acc[ai][bj][m][n];
#else
                        const f32x4 v = acc[ai][bj][m][n] * 16.f;
#endif
                        int w = __builtin_amdgcn_cvt_pk_fp8_f32(v[0], v[1], 0, false);
                        w = __builtin_amdgcn_cvt_pk_fp8_f32(v[2], v[3], w, true);
                        d[bj * 2 + n] = (unsigned)w;
                    }
                *(u32x4*)(Y + row * 1024 + u.pn * 256 + wc * 64 + fq * 16) = d;
            }
    }
};
struct EpiOut {
    static constexpr bool SPLIT = false; static constexpr int NQ = 8, NST = 32;
    template <int ai, int bj> __device__ __forceinline__ void part_cond(const f32x4 (&acc)[2][2][4][2], const g8::Unit& u, int wr, int wc, int fr, int fq, int flag) const {}
    __device__ __forceinline__ void tail(const f32x4 (&acc)[2][2][4][2], const g8::Unit& u, int wr, int wc, int fr, int fq) const {}
    const bf16_t* xres; bf16_t* Y;
    __device__ __forceinline__ void operator()(const f32x4 (&acc)[2][2][4][2], const g8::Unit& u, int wr, int wc, int fr, int fq) const {
        const int hi = fr >> 3, r8 = fr & 7;
        u32x4 xrv[2][4][2];
#pragma unroll
        for (int ai = 0; ai < 2; ++ai)
#pragma unroll
            for (int m = 0; m < 4; ++m)
#pragma unroll
                for (int bj = 0; bj < 2; ++bj)
                    xrv[ai][m][bj] = *(const u32x4*)(xres + ((size_t)u.pm * 256 + ai * 128 + wr * 64 + m * 16 + fr) * 1024 + u.pn * 256 + wc * 64 + bj * 32 + fq * 8);
        asm volatile("" ::: "memory");
#pragma unroll
        for (int ai = 0; ai < 2; ++ai)
#pragma unroll
            for (int m = 0; m < 4; ++m) {
                const size_t rg = (size_t)u.pm * 256 + ai * 128 + wr * 64 + m * 16;
                u32x4 pk[2];
#pragma unroll
                for (int bj = 0; bj < 2; ++bj) {
                    const u32x4 xr = xrv[ai][m][bj];
                    float f[8]; unpack8(xr, f);
                    const f32x4 v0 = acc[ai][bj][m][0], v1 = acc[ai][bj][m][1];
                    pk[bj] = (u32x4){cvt_pk(f[0] * ALPHA + v0[0], f[1] * ALPHA + v0[1]), cvt_pk(f[2] * ALPHA + v0[2], f[3] * ALPHA + v0[3]),
                                     cvt_pk(f[4] * ALPHA + v1[0], f[5] * ALPHA + v1[1]), cvt_pk(f[6] * ALPHA + v1[2], f[7] * ALPHA + v1[3])};
                }
                perm_store(Y + (rg + r8) * 1024 + u.pn * 256 + wc * 64 + hi * 32 + fq * 8, (size_t)8 * 1024, pk[0], pk[1], hi);
                asm volatile("" ::: "memory");
            }
    }
};

constexpr int TS_RS = 272;
__device__ __forceinline__ void tile_put(const Ctx& c, int row_l, int col_l, const u32x2 v) { *(u32x2*)(c.smem + row_l * TS_RS + col_l * 2) = v; }
template <int NCOL>
__device__ __forceinline__ void tile_flush(const Ctx& c, bf16_t* out, size_t ld, bool valid) {
    __syncthreads();
    constexpr int CPR = NCOL / 8, PER = (128 * CPR) / 256;
#pragma unroll
    for (int i = 0; i < PER; ++i) {
        const int idx = c.tid + 256 * i, row = idx / CPR, ch = idx % CPR;
        const u32x4 v = *(const u32x4*)(c.smem + row * TS_RS + ch * 16);
        if (valid) *(u32x4*)(out + (size_t)row * ld + ch * 8) = v;
    }
    __syncthreads();
}

__device__ __forceinline__ void conv_family(const float* src, int nmat, size_t src_stride, int K, int N, int Nout,
                            bf16_t* dst, size_t dst_stride, int grp, int kind, const Ctx& c, int rot4 = 0) {
    float* lds = (float*)c.smem;
    const int tk = K / 128, tn = Nout / 64, per = tk * tn, total = nmat * per;
    const int tx = c.tid & 15, ty = c.tid >> 4;
    int vbid = c.bid + (c.nblk >> 2) * rot4; if (vbid >= c.nblk) vbid -= c.nblk;
    f32x4 r[8];
#define CV_LOAD(u_) do { const int mat_ = (u_) / per, r_ = (u_) - mat_ * per, kt_ = r_ / tn, nt_ = r_ - kt_ * tn; \
        const float* s_ = src + (size_t)mat_ * src_stride + (size_t)(kt_ * 128 + ty) * N + nt_ * 64 + tx * 4; const bool in_ = (nt_ * 64 + tx * 4) < N; \
        _Pragma("unroll") for (int i = 0; i < 8; ++i) r[i] = in_ ? __builtin_nontemporal_load((const f32x4*)(s_ + (size_t)(16 * i) * N)) : (f32x4){0.f, 0.f, 0.f, 0.f}; } while (0)
    if (vbid < total) CV_LOAD(vbid);
    for (int base = 0; base < total; base += c.nblk) {
        const int u = base + vbid; const bool valid = u < total;
#pragma unroll
        for (int i = 0; i < 8; ++i) *(f32x4*)(lds + (ty + 16 * i) * 68 + tx * 4) = r[i];
        if (u + c.nblk < total) CV_LOAD(u + c.nblk);
        __syncthreads();
        if (valid) {
        const int mat = u / per, rr = u - mat * per, kt = rr / tn, nt = rr - kt * tn;
        const int dmat = grp ? (mat / grp) * (grp + 1) + (mat % grp) : mat;
        bf16_t* d = dst + (size_t)dmat * dst_stride;
        const int nl = c.tid & 63, kq = (c.tid >> 6) * 32;
        if (kind >= 3) {
            unsigned char* d8 = (unsigned char*)dst + (size_t)dmat * dst_stride;
            const float sc8 = (kind == 3) ? 8.f : 32.f;
            unsigned w8[8];
#pragma unroll
            for (int j = 0; j < 8; ++j) {
                int w_ = __builtin_amdgcn_cvt_pk_fp8_f32(lds[(kq + 4 * j) * 68 + nl] * sc8, lds[(kq + 4 * j + 1) * 68 + nl] * sc8, 0, false);
                w_ = __builtin_amdgcn_cvt_pk_fp8_f32(lds[(kq + 4 * j + 2) * 68 + nl] * sc8, lds[(kq + 4 * j + 3) * 68 + nl] * sc8, w_, true);
                w8[j] = (unsigned)w_;
            }
            const int n8 = nt * 64 + nl;
            const int drow8 = (kind == 3 || kind == 6) ? n8 : ((n8 >> 4) * 32 + (n8 & 15) + (kind == 5 ? 16 : 0));
            u32x4* dp8 = (u32x4*)(d8 + (size_t)drow8 * K + kt * 128 + kq);
            dp8[0] = (u32x4){w8[0], w8[1], w8[2], w8[3]}; dp8[1] = (u32x4){w8[4], w8[5], w8[6], w8[7]};
        } else {
        unsigned w[16];
#pragma unroll
        for (int j = 0; j < 16; ++j) w[j] = pk2(lds[(kq + 2 * j) * 68 + nl], lds[(kq + 2 * j + 1) * 68 + nl]);
        const int n = nt * 64 + nl;
        const int drow = (kind == 0) ? n : ((n >> 4) * 32 + (n & 15) + (kind == 2 ? 16 : 0));
        u32x4* dp = (u32x4*)(d + (size_t)drow * K + kt * 128 + kq);
        dp[0] = (u32x4){w[0], w[1], w[2], w[3]}; dp[1] = (u32x4){w[4], w[5], w[6], w[7]};
        dp[2] = (u32x4){w[8], w[9], w[10], w[11]}; dp[3] = (u32x4){w[12], w[13], w[14], w[15]};
        }
        }
        __syncthreads();
    }
#undef CV_LOAD
}

constexpr int CVU_PER_LAYER = 195 * 4;
__device__ __forceinline__ void conv_unit(int cvu_, int lc_, const void* const* ain, unsigned char* ws, const Ctx& c) {
    const int cvu = __builtin_amdgcn_readfirstlane(cvu_), lc = __builtin_amdgcn_readfirstlane(lc_);
    const int sl = cvu >> 2, part = cvu & 3;
    const float* src; unsigned char* d8; int kind;
    if (sl < 130) {
        const bool rt = sl < 128, up = rt ? (sl >= 64) : (sl == 129);
        const int e = rt ? (sl & 63) : 64;
        const float* base = (const float*)(rt ? (up ? ain[23] : ain[22]) : (up ? ain[26] : ain[25]));
        src = base + (size_t)(rt ? (lc * 64 + e) : lc) * (1024 * 256);
        d8 = ws + WS_WGU + (size_t)(lc * 65 + e) * WGU_ELEMS; kind = up ? 5 : 4;
    } else {
        const int e = sl - 130;
        src = (const float*)((e < 64) ? ain[24] : ain[27]) + (size_t)((e < 64) ? (lc * 64 + e) : lc) * (256 * 1024);
        d8 = ws + WS_WDN + (size_t)(lc * 65 + e) * WDN_ELEMS; kind = 3;
    }
    const int K = (kind == 3) ? 256 : 1024, N = (kind == 3) ? 1024 : 256, tnsh = (kind == 3) ? 4 : 2;
    float* lds = (float*)c.smem;
    const int tx = c.tid & 15, ty = c.tid >> 4, kp = c.tid & 7, n0 = c.tid >> 3;
    const float sc8 = (kind == 3) ? 8.f : 32.f;
    f32x4 ra[8], rb[8];
#define CU_LOAD(R, i_) do { const int r_ = part * 8 + (i_), kt_ = r_ >> tnsh, nt_ = r_ & ((1 << tnsh) - 1); \
        const float* s_ = src + (size_t)(kt_ * 128 + ty) * N + nt_ * 64 + tx * 4; \
        _Pragma("unroll") for (int q = 0; q < 8; ++q) R[q] = __builtin_nontemporal_load((const f32x4*)(s_ + (size_t)(16 * q) * N)); } while (0)
#define CU_TILE(R, i_, NEXT) do { \
        _Pragma("unroll") for (int q = 0; q < 8; ++q) *(f32x4*)(lds + (ty + 16 * q) * 68 + 4 * q + tx * 4) = R[q]; \
        NEXT; \
        __syncthreads(); \
        { const int r_ = part * 8 + (i_), kt_ = r_ >> tnsh, nt_ = r_ & ((1 << tnsh) - 1); \
          _Pragma("unroll") for (int rr = 0; rr < 2; ++rr) { const int nn = rr * 32 + n0; unsigned w4[4]; \
              _Pragma("unroll") for (int j = 0; j < 4; ++j) { const float* lp_ = lds + (16 * kp + 4 * j) * 68 + 4 * kp + nn; \
                  int w_ = __builtin_amdgcn_cvt_pk_fp8_f32(lp_[0] * sc8, lp_[68] * sc8, 0, false); \
                  w_ = __builtin_amdgcn_cvt_pk_fp8_f32(lp_[136] * sc8, lp_[204] * sc8, w_, true); w4[j] = (unsigned)w_; } \
              const int n8 = nt_ * 64 + nn; const int drow8 = (kind == 3) ? n8 : ((n8 >> 4) * 32 + (n8 & 15) + (kind == 5 ? 16 : 0)); \
              __builtin_nontemporal_store((u32x4){w4[0], w4[1], w4[2], w4[3]}, (u32x4*)(d8 + (size_t)drow8 * K + kt_ * 128 + 16 * kp)); } } \
        __syncthreads(); } while (0)
    __syncthreads();
    CU_LOAD(ra, 0); CU_LOAD(rb, 1);
#pragma unroll 1
    for (int i = 0; i < 8; i += 2) {
        CU_TILE(ra, i, if (i + 2 < 8) CU_LOAD(ra, i + 2));
        CU_TILE(rb, i + 1, if (i + 3 < 8) CU_LOAD(rb, i + 3));
    }
#undef CU_LOAD
#undef CU_TILE
}

__device__ __forceinline__ void phase_prologue(const Args& a, const Ctx& c) {
    unsigned char* ws = a.ws;
    bf16_t* WIN = (bf16_t*)(ws + WS_WIN);
#if INP_F8
    if (INP_F8 == 2) conv_family((const float*)a.in[2], 2, (size_t)1024 * 2472, 1024, 2472, NPAD, WIN, 2 * WIN_ELEMS, 0, 0, c);
    else conv_family((const float*)a.in[2], 2, (size_t)1024 * 2472, 1024, 2472, NPAD, WIN, 4 * WIN_ELEMS, 0, 6, c);
    if (INP_F8 == 3) conv_family((const float*)a.in[12], 2, (size_t)1024 * 2312, 1024, 2312, NPAD, WIN + WIN_ELEMS, 2 * WIN_ELEMS, 0, 0, c);
    else conv_family((const float*)a.in[12], 2, (size_t)1024 * 2312, 1024, 2312, NPAD, WIN + WIN_ELEMS, 4 * WIN_ELEMS, 0, 6, c, 3);
#else
    conv_family((const float*)a.in[2], 2, (size_t)1024 * 2472, 1024, 2472, NPAD, WIN, 2 * WIN_ELEMS, 0, 0, c);
    conv_family((const float*)a.in[12], 2, (size_t)1024 * 2312, 1024, 2312, NPAD, WIN + WIN_ELEMS, 2 * WIN_ELEMS, 0, 0, c);
#endif
    conv_family((const float*)a.in[4], 2, (size_t)256 * 768, 256, 768, 768, (bf16_t*)(ws + WS_WQB), WQB_ELEMS, 0, 0, c, 2);
    conv_family((const float*)a.in[6], 2, (size_t)128 * 1024, 128, 1024, 1024, (bf16_t*)(ws + WS_WKVB), WKVB_ELEMS, 0, 0, c, 1);
    bf16_t* WOUT = (bf16_t*)(ws + WS_WOUT);
    conv_family((const float*)a.in[11], 2, (size_t)1024 * 1024, 1024, 1024, 1024, WOUT, 2 * WOUT_ELEMS, 0, 0, c, 2);
    conv_family((const float*)a.in[17], 2, (size_t)1024 * 1024, 1024, 1024, 1024, WOUT + WOUT_ELEMS, 2 * WOUT_ELEMS, 0, 0, c, 0);
    conv_family((const float*)a.in[20], 4, (size_t)1024 * 64, 1024, 64, 128, (bf16_t*)(ws + WS_WRT), WRT_ELEMS, 0, 0, c, 1);
    bf16_t* WGU = (bf16_t*)(ws + WS_WGU);
#if MOE1_F8
    if (!DEFER_CONV) {
    conv_family((const float*)a.in[22], 256, (size_t)1024 * 256, 1024, 256, 256, WGU, WGU_ELEMS, 64, 4, c);
    conv_family((const float*)a.in[23], 256, (size_t)1024 * 256, 1024, 256, 256, WGU, WGU_ELEMS, 64, 5, c);
    conv_family((const float*)a.in[25], 4, (size_t)1024 * 256, 1024, 256, 256, (bf16_t*)((unsigned char*)WGU + 64 * WGU_ELEMS), 65 * WGU_ELEMS, 0, 4, c);
    conv_family((const float*)a.in[26], 4, (size_t)1024 * 256, 1024, 256, 256, (bf16_t*)((unsigned char*)WGU + 64 * WGU_ELEMS), 65 * WGU_ELEMS, 0, 5, c);
    }
#else
    conv_family((const float*)a.in[22], 256, (size_t)1024 * 256, 1024, 256, 256, WGU, WGU_ELEMS, 64, 1, c);
    conv_family((const float*)a.in[23], 256, (size_t)1024 * 256, 1024, 256, 256, WGU, WGU_ELEMS, 64, 2, c);
    conv_family((const float*)a.in[25], 4, (size_t)1024 * 256, 1024, 256, 256, WGU + 64 * WGU_ELEMS, 65 * WGU_ELEMS, 0, 1, c);
    conv_family((const float*)a.in[26], 4, (size_t)1024 * 256, 1024, 256, 256, WGU + 64 * WGU_ELEMS, 65 * WGU_ELEMS, 0, 2, c);
#endif
    bf16_t* WDN = (bf16_t*)(ws + WS_WDN);
#if MOE2_F8
    if (!DEFER_CONV) {
    conv_family((const float*)a.in[24], 256, (size_t)256 * 1024, 256, 1024, 1024, WDN, WDN_ELEMS, 64, 3, c);
    conv_family((const float*)a.in[27], 4, (size_t)256 * 1024, 256, 1024, 1024, (bf16_t*)((unsigned char*)WDN + 64 * WDN_ELEMS), 65 * WDN_ELEMS, 0, 3, c);
    }
#else
    conv_family((const float*)a.in[24], 256, (size_t)256 * 1024, 256, 1024, 1024, WDN, WDN_ELEMS, 64, 0, c);
    conv_family((const float*)a.in[27], 4, (size_t)256 * 1024, 256, 1024, 1024, WDN + 64 * WDN_ELEMS, 65 * WDN_ELEMS, 0, 0, c);
#endif
    {
        const float* x = (const float*)a.in[0]; bf16_t* xb = (bf16_t*)(ws + WS_XBF);
        const size_t n8 = (size_t)T * 1024 / 8;
        for (size_t i = (size_t)c.bid * 256 + c.tid; i < n8; i += (size_t)c.nblk * 256) {
            const f32x4 v0 = __builtin_nontemporal_load((const f32x4*)(x + i * 8)), v1 = __builtin_nontemporal_load((const f32x4*)(x + i * 8 + 4));
            *(u32x4*)(xb + i * 8) = (u32x4){pk2(v0[0], v0[1]), pk2(v0[2], v0[3]), pk2(v1[0], v1[1]), pk2(v1[2], v1[3])};
#if INP_F8
            {   int w0 = __builtin_amdgcn_cvt_pk_fp8_f32(v0[0] * 16.f, v0[1] * 16.f, 0, false); w0 = __builtin_amdgcn_cvt_pk_fp8_f32(v0[2] * 16.f, v0[3] * 16.f, w0, true);
                int w1 = __builtin_amdgcn_cvt_pk_fp8_f32(v1[0] * 16.f, v1[1] * 16.f, 0, false); w1 = __builtin_amdgcn_cvt_pk_fp8_f32(v1[2] * 16.f, v1[3] * 16.f, w1, true);
                *(u32x2*)(ws + WS_X1 + XB8I_OFF + i * 8) = (u32x2){(unsigned)w0, (unsigned)w1}; }
#endif
        }
    }
    {
        const int* pos = (const int*)a.in[1];
        float* rm = (float*)(ws + WS_ROPEM); float* rs = (float*)(ws + WS_ROPES);
        const float ln_theta = 9.210340371976184f;
        for (int i = c.bid * 256 + c.tid; i < T * 16; i += c.nblk * 256) {
            const int t = i >> 4, f = i & 15;
            const float inv = expf(-((float)(2 * f) / 32.f) * ln_theta);
            const float ang = (float)pos[t] * inv;
            rm[i * 2] = cosf(ang); rm[i * 2 + 1] = sinf(ang);
        }
        for (int i = c.bid * 256 + c.tid; i < T * 32; i += c.nblk * 256) {
            const int t = i >> 5, f = i & 31;
            const float inv = expf(-((float)(2 * f) / 64.f) * ln_theta);
            const float ang = (float)pos[t] * inv;
            rs[i * 2] = cosf(ang); rs[i * 2 + 1] = sinf(ang);
        }
    }
}

__device__ __forceinline__ void phase_inproj(const bf16_t* XBF, const bf16_t* W, bf16_t* PROJ, float* GATES, int gbase, const Ctx& c) {
    const int ntn = NPAD / 128;
    for (int i = 0;; ++i) {
        int mt, nt; bool valid; if (!tile_map2(i, c, T / 128, ntn, mt, nt, valid)) break;
        const bf16_t* a0 = XBF + (size_t)(mt * 128 + (c.tid >> 2)) * 1024;
        const bf16_t* b0 = W + (size_t)(nt * 128 + (c.tid >> 2)) * 1024;
        f32x4 acc[4][4];
        gemm_tile(a0, a0 + 64 * 1024, b0, b0 + 64 * 1024, 32, acc, c);
#pragma unroll
        for (int m = 0; m < 4; ++m) {
            const int rl = c.wr * 64 + m * 16 + c.fr, row = mt * 128 + rl;
#pragma unroll
            for (int n = 0; n < 4; ++n) {
                const int cl = c.wc * 64 + n * 16 + c.fq * 4, col = nt * 128 + cl;
                const f32x4 v = acc[m][n];
                tile_put(c, rl, cl, (u32x2){pk2(v[0], v[1]), pk2(v[2], v[3])});
                if (valid && col >= gbase && col < gbase + 8) *(f32x4*)(GATES + (size_t)row * 8 + (col - gbase)) = v;
            }
        }
        tile_flush<128>(c, PROJ + (size_t)mt * 128 * NPAD + nt * 128, NPAD, valid);
    }
}

constexpr int MLAUP_TILES = (T / 128) * 6 + (T / 128) * 8;
__device__ __forceinline__ void mla_up_tile(int u, const bf16_t* CQ, const bf16_t* WQB, const bf16_t* CKV, const bf16_t* WKVB,
                             const float* ROPEM, bf16_t* QF, bf16_t* KN, bf16_t* VV, const Ctx& c) {
    const int tq = (T / 128) * 6;
    const float qscale = 0.10206207261596577f * 1.4426950408889634f;
    {
        f32x4 acc[4][4];
        if (u < tq) {
            const int mt = u / 6, nt = u % 6;
            const bf16_t* a0 = CQ + (size_t)(mt * 128 + (c.tid >> 2)) * 256;
            const bf16_t* b0 = WQB + (size_t)(nt * 128 + (c.tid >> 2)) * 256;
            gemm_tile(a0, a0 + 64 * 256, b0, b0 + 64 * 256, 8, acc, c);
#pragma unroll
            for (int m = 0; m < 4; ++m) {
                const int row = mt * 128 + c.wr * 64 + m * 16 + c.fr;
#pragma unroll
                for (int np = 0; np < 2; ++np) {
                    const int cg = nt * 128 + c.wc * 64 + np * 32;
                    f32x4 v0 = acc[m][2 * np], v1 = acc[m][2 * np + 1];
                    if (((cg >> 5) % 3) == 2) {
#pragma unroll
                        for (int j = 0; j < 4; ++j) {
                            const int i = c.fq * 4 + j;
                            const float cs = ROPEM[((size_t)row * 16 + i) * 2], sn = ROPEM[((size_t)row * 16 + i) * 2 + 1];
                            const float x1 = v0[j], x2 = v1[j];
                            v0[j] = x1 * cs - x2 * sn; v1[j] = x2 * cs + x1 * sn;
                        }
                    }
                    v0 *= qscale; v1 *= qscale;
                    *(u32x2*)(QF + (size_t)row * 768 + cg + c.fq * 4) = (u32x2){pk2(v0[0], v0[1]), pk2(v0[2], v0[3])};
                    *(u32x2*)(QF + (size_t)row * 768 + cg + 16 + c.fq * 4) = (u32x2){pk2(v1[0], v1[1]), pk2(v1[2], v1[3])};
                }
            }
        } else {
            const int v = u - tq, mt = v / 8, nt = v % 8;
            const bf16_t* a0 = CKV + (size_t)(mt * 128 + (c.tid >> 2)) * 128;
            const bf16_t* b0 = WKVB + (size_t)(nt * 128 + (c.tid >> 2)) * 128;
            gemm_tile(a0, a0 + 64 * 128, b0, b0 + 64 * 128, 4, acc, c);
            bf16_t* dst = (c.wc == 0) ? KN : VV;
#pragma unroll
            for (int m = 0; m < 4; ++m) {
                const int row = mt * 128 + c.wr * 64 + m * 16 + c.fr;
#pragma unroll
                for (int n = 0; n < 4; ++n) {
                    const f32x4 x = acc[m][n];
                    *(u32x2*)(dst + (size_t)row * 512 + nt * 64 + n * 16 + c.fq * 4) = (u32x2){pk2(x[0], x[1]), pk2(x[2], x[3])};
                }
            }
        }
    }
}

__device__ __forceinline__ void phase_outproj(const bf16_t* MIXO, const bf16_t* W, const float* xres, float* YBUF, const Ctx& c) {
    for (int i = 0;; ++i) {
        int mt, nt; bool valid; if (!tile_map2(i, c, T / 128, 8, mt, nt, valid)) break;
        const bf16_t* a0 = MIXO + (size_t)(mt * 128 + (c.tid >> 2)) * 1024;
        const bf16_t* b0 = W + (size_t)(nt * 128 + (c.tid >> 2)) * 1024;
        f32x4 acc[4][4];
        gemm_tile(a0, a0 + 64 * 1024, b0, b0 + 64 * 1024, 32, acc, c);
#pragma unroll
        for (int m = 0; m < 4; ++m) {
            const int row = mt * 128 + c.wr * 64 + m * 16 + c.fr;
#pragma unroll
            for (int n = 0; n < 4; ++n) {
                const int col = nt * 128 + c.wc * 64 + n * 16 + c.fq * 4;
                const f32x4 xr = *(const f32x4*)(xres + (size_t)row * 1024 + col);
                if (valid) *(f32x4*)(YBUF + (size_t)row * 1024 + col) = xr * ALPHA + acc[m][n];
            }
        }
    }
}

__device__ __forceinline__ void phase_router(const bf16_t* XBF, const bf16_t* W, float* LOG, const Ctx& c) {
    for (int base = 0; base < T / 128; base += c.nblk) {
        const bool valid = (base + c.bid) < T / 128; const int mt = valid ? base + c.bid : 0;
        const bf16_t* a0 = XBF + (size_t)(mt * 128 + (c.tid >> 2)) * 1024;
        const bf16_t* b0 = W + (size_t)(c.tid >> 2) * 1024;
        f32x4 acc[4][4];
        gemm_tile(a0, a0 + 64 * 1024, b0, b0 + 64 * 1024, 32, acc, c);
        if (c.wc == 0 && valid) {
#pragma unroll
            for (int m = 0; m < 4; ++m) {
                const int row = mt * 128 + c.wr * 64 + m * 16 + c.fr;
#pragma unroll
                for (int n = 0; n < 4; ++n) *(f32x4*)(LOG + (size_t)row * 64 + n * 16 + c.fq * 4) = acc[m][n];
            }
        }
    }
}

__device__ __forceinline__ void build_block_table(const unsigned* CNT, int* bst, const Ctx& c) {
    __syncthreads();
    if (c.wid == 0) {
        const int cnt = (int)__hip_atomic_load(CNT + c.lane, __ATOMIC_RELAXED, __HIP_MEMORY_SCOPE_AGENT);
        const int nb = (cnt + RBR - 1) / RBR;
        int inc = nb;
#pragma unroll
        for (int o = 1; o < 64; o <<= 1) { const int x = shfl_up_(inc, o); if (c.lane >= o) inc += x; }
        bst[c.lane] = inc - nb; bst[66 + c.lane] = cnt;
        if (c.lane == 63) { bst[64] = inc; bst[65] = inc + T / RBR; bst[66 + 64] = T; }
    }
    __syncthreads();
}
__device__ __forceinline__ int find_expert(const int* bst, int rb, const Ctx& c) {
    return __popcll(__ballot(bst[1 + c.lane] <= rb));
}

__device__ __forceinline__ void phase_moe1(const bf16_t* XBF, const bf16_t* WGU, const unsigned* CNT, const int* LTOK, const float* LW, bf16_t* HBUF, const Ctx& c) {
    int* bst = (int*)(c.smem + 65536 + 64);
    build_block_table(CNT, bst, c);
    const int nsb = bst[65] * 2;
    for (int i = 0;; ++i) {
        int sbk, nt; bool valid; if (!tile_map2(i, c, nsb, 4, sbk, nt, valid)) break;
        const int rb = sbk >> 1, hb = sbk & 1;
        const int e = find_expert(bst, rb, c);
        const int lb = rb - bst[e], cnt = bst[66 + e];
        const int p0 = lb * RBR + hb * 128 + (c.tid >> 2), p1 = p0 + 64;
        const int t0 = (p0 < cnt) ? LTOK[(size_t)e * CAP + p0] : 0;
        const int t1 = (p1 < cnt) ? LTOK[(size_t)e * CAP + p1] : 0;
        const bf16_t* a0 = XBF + (size_t)t0 * 1024;
        const bf16_t* a1 = XBF + (size_t)t1 * 1024;
        const bf16_t* b0 = WGU + (size_t)e * WGU_ELEMS + (size_t)(nt * 128 + (c.tid >> 2)) * 1024;
        f32x4 acc[4][4];
        gemm_tile(a0, a1, b0, b0 + 64 * 1024, 32, acc, c);
#pragma unroll
        for (int m = 0; m < 4; ++m) {
            const int rl = c.wr * 64 + m * 16 + c.fr;
            const int pw = lb * RBR + hb * 128 + rl;
            const float wrow = (pw < cnt) ? LW[(size_t)e * CAP + pw] : 0.f;
#pragma unroll
            for (int n = 0; n < 2; ++n) {
                const f32x4 g = acc[m][n], up = acc[m][n + 2];
                float h[4];
#pragma unroll
                for (int j = 0; j < 4; ++j) h[j] = siluf_(g[j]) * up[j] * wrow;
                tile_put(c, rl, c.wc * 32 + n * 16 + c.fq * 4, (u32x2){pk2(h[0], h[1]), pk2(h[2], h[3])});
            }
        }
        tile_flush<64>(c, HBUF + ((size_t)rb * RBR + hb * 128) * 256 + nt * 64, 256, valid);
    }
}

__device__ __forceinline__ void phase_moe2(const bf16_t* HBUF, const bf16_t* WDN, const unsigned* CNT, bf16_t* Y, const Ctx& c) {
    int* bst = (int*)(c.smem + 65536 + 64);
    build_block_table(CNT, bst, c);
    const int nsb = bst[65] * 2;
    for (int i = 0;; ++i) {
        int sbk, nt; bool valid; if (!tile_map2(i, c, nsb, 8, sbk, nt, valid)) break;
        const int rb = sbk >> 1;
        const int e = find_expert(bst, rb, c);
        const bf16_t* a0 = HBUF + ((size_t)sbk * 128 + (c.tid >> 2)) * 256;
        const bf16_t* b0 = WDN + (size_t)e * WDN_ELEMS + (size_t)(nt * 128 + (c.tid >> 2)) * 256;
        f32x4 acc[4][4];
        gemm_tile(a0, a0 + 64 * 256, b0, b0 + 64 * 256, 8, acc, c);
#pragma unroll
        for (int m = 0; m < 4; ++m) {
            const int lr = c.wr * 64 + m * 16 + c.fr;
#pragma unroll
            for (int n = 0; n < 4; ++n) {
                const f32x4 v = acc[m][n];
                tile_put(c, lr, c.wc * 64 + n * 16 + c.fq * 4, (u32x2){pk2(v[0], v[1]), pk2(v[2], v[3])});
            }
        }
        tile_flush<128>(c, Y + (size_t)sbk * 128 * 1024 + nt * 128, 1024, valid);
    }
}

__device__ __forceinline__ float dppf(float v, int ctrl_sel) {
    int x = __builtin_bit_cast(int, v), r;
    if (ctrl_sel == 0) r = __builtin_amdgcn_update_dpp(0, x, 0xB1, 0xF, 0xF, true);
    else if (ctrl_sel == 1) r = __builtin_amdgcn_update_dpp(0, x, 0x4E, 0xF, 0xF, true);
    else if (ctrl_sel == 2) r = __builtin_amdgcn_update_dpp(0, x, 0x141, 0xF, 0xF, true);
    else r = __builtin_amdgcn_update_dpp(0, x, 0x140, 0xF, 0xF, true);
    return __builtin_bit_cast(float, r);
}
__device__ __forceinline__ float red16(float v) { v += dppf(v, 0); v += dppf(v, 1); v += dppf(v, 2); v += dppf(v, 3); return v; }

template <bool F32OUT>
__device__ __forceinline__ void ln_row_store(float (&v)[16], const float* g, const float* b, float* of32, bf16_t* obf, int lane) {
    float s = 0.f;
#pragma unroll
    for (int i = 0; i < 16; ++i) s += v[i];
    const float mean = wave_sum(s) * (1.f / 1024.f);
    float q = 0.f;
#pragma unroll
    for (int i = 0; i < 16; ++i) { v[i] -= mean; q += v[i] * v[i]; }
    const float rstd = rsqrtf(wave_sum(q) * (1.f / 1024.f) + 1e-5f);
#pragma unroll
    for (int hf = 0; hf < 2; ++hf) {
        const int col = hf * 512 + lane * 8;
        const f32x4 g0 = *(const f32x4*)(g + col), g1 = *(const f32x4*)(g + col + 4);
        const f32x4 b0 = *(const f32x4*)(b + col), b1 = *(const f32x4*)(b + col + 4);
        f32x4 y0, y1;
#pragma unroll
        for (int j = 0; j < 4; ++j) { y0[j] = v[hf * 8 + j] * rstd * g0[j] + b0[j]; y1[j] = v[hf * 8 + 4 + j] * rstd * g1[j] + b1[j]; }
        if constexpr (F32OUT) { *(f32x4*)(of32 + col) = y0; *(f32x4*)(of32 + col + 4) = y1; }
        *(u32x4*)(obf + col) = (u32x4){pk2(y0[0], y0[1]), pk2(y0[2], y0[3]), pk2(y1[0], y1[1]), pk2(y1[2], y1[3])};
    }
}

__device__ __forceinline__ void phase_ln1(const bf16_t* YBUF, const float* g, const float* b, bf16_t* XBF, const Ctx& c) {
    for (int t = c.bid * 4 + c.wid; t < T; t += c.nblk * 4) {
        float v[16];
#pragma unroll
        for (int hf = 0; hf < 2; ++hf) {
            const u32x4 r = *(const u32x4*)(YBUF + (size_t)t * 1024 + hf * 512 + c.lane * 8);
            float f[8]; unpack8(r, f);
#pragma unroll
            for (int j = 0; j < 8; ++j) v[hf * 8 + j] = f[j];
        }
        ln_row_store<false>(v, g, b, nullptr, XBF + (size_t)t * 1024, c.lane);
    }
}

template <bool LASTL>
__device__ __forceinline__ void phase_combine8(const unsigned char* Y, const int* ASG, const float* ASGW, const unsigned* CNT, const float* g, const float* b,
                                               float* XOUT, bf16_t* XBF, unsigned char* XB8I, const Ctx& c) {
    const int* bst = (const int*)(c.smem0 + LDS_BLK + 64);
    const int lane = c.lane;
    struct CmbA { u32x4 a0, a1; f32x4 w0, w1; };
    struct CmbY { u32x4 r0, r1; u32x4 yr[9]; float wk[9]; };
    auto ldA = [&](int t) {
        CmbA k;
        k.a0 = *(const u32x4*)(ASG + (size_t)t * 8); k.a1 = *(const u32x4*)(ASG + (size_t)t * 8 + 4);
        k.w0 = *(const f32x4*)(ASGW + (size_t)t * 8); k.w1 = *(const f32x4*)(ASGW + (size_t)t * 8 + 4);
        return k;
    };
    auto ldY = [&](int t, const CmbA& a) {
        CmbY k;
        k.r0 = *(const u32x4*)(XBF + (size_t)t * 1024 + lane * 16); k.r1 = *(const u32x4*)(XBF + (size_t)t * 1024 + lane * 16 + 8);
#pragma unroll
        for (int q = 0; q < 9; ++q) {
            size_t crow;
            if (q < 8) { const int asg = (int)((q < 4) ? a.a0[q & 3] : a.a1[q & 3]); crow = (size_t)bst[asg >> 16] * RBR + (asg & 0xffff); k.wk[q] = ((q < 4) ? a.w0[q & 3] : a.w1[q & 3]) * (1.f / 16.f); }
            else { crow = (size_t)bst[64] * RBR + t; k.wk[q] = 1.f / 16.f; }
            k.yr[q] = *(const u32x4*)(Y + crow * 1024 + lane * 16);
        }
        return k;
    };
    float* gL = (float*)(c.smem + 24576); float* bL = gL + 1024;
    __syncthreads();
    *(f32x4*)(gL + c.tid * 4) = *(const f32x4*)(g + c.tid * 4); *(f32x4*)(bL + c.tid * 4) = *(const f32x4*)(b + c.tid * 4);
    __syncthreads();
    const int tstep = c.nblk * 4;
    int t = c.bid * 4 + c.wid;
    const int tfirst = t < T ? t : 0;
    CmbA an = ldA(tfirst);
    CmbY cy = ldY(tfirst, an);
    an = ldA((tfirst + tstep < T) ? tfirst + tstep : tfirst);
    for (; t < T; t += tstep) {
        const int tn = (t + tstep < T) ? t + tstep : t, tnn = (tn + tstep < T) ? tn + tstep : tn;
        const CmbY ny = ldY(tn, an);
        const CmbA na = ldA(tnn);
        asm volatile("" ::: "memory");
        float v[16];
        {
            float f[8]; unpack8(cy.r0, f);
#pragma unroll
            for (int j = 0; j < 8; ++j) v[j] = f[j] * ALPHA;
            unpack8(cy.r1, f);
#pragma unroll
            for (int j = 0; j < 8; ++j) v[8 + j] = f[j] * ALPHA;
        }
#pragma unroll
        for (int k = 0; k < 9; ++k)
#pragma unroll
            for (int q = 0; q < 4; ++q) {
                const f32x2 lo = __builtin_amdgcn_cvt_pk_f32_fp8((int)cy.yr[k][q], false), hi = __builtin_amdgcn_cvt_pk_f32_fp8((int)cy.yr[k][q], true);
                v[q * 4 + 0] += lo[0] * cy.wk[k]; v[q * 4 + 1] += lo[1] * cy.wk[k]; v[q * 4 + 2] += hi[0] * cy.wk[k]; v[q * 4 + 3] += hi[1] * cy.wk[k];
            }
        float s = 0.f;
#pragma unroll
        for (int i = 0; i < 16; ++i) s += v[i];
        const float mean = wave_sum_dpp(s) * (1.f / 1024.f);
        float q2 = 0.f;
#pragma unroll
        for (int i = 0; i < 16; ++i) { v[i] -= mean; q2 += v[i] * v[i]; }
        const float rstd = rsqrtf(wave_sum_dpp(q2) * (1.f / 1024.f) + 1e-5f);
        float y[16];
#pragma unroll
        for (int q = 0; q < 4; ++q) {
            const f32x4 gg = *(const f32x4*)(gL + lane * 16 + q * 4), bb = *(const f32x4*)(bL + lane * 16 + q * 4);
#pragma unroll
            for (int j = 0; j < 4; ++j) y[q * 4 + j] = v[q * 4 + j] * rstd * gg[j] + bb[j];
            if constexpr (LASTL) *(f32x4*)(c.smem + 8192 + c.wid * 4096 + lane * 64 + q * 16) = (f32x4){y[q * 4], y[q * 4 + 1], y[q * 4 + 2], y[q * 4 + 3]};
        }
        if constexpr (LASTL) {
            asm volatile("s_waitcnt lgkmcnt(0)" ::: "memory");
            const unsigned char* wo_ = c.smem + 8192 + c.wid * 4096;
            unsigned char* orow_ = (unsigned char*)(XOUT + (size_t)t * 1024);
#pragma unroll
            for (int q = 0; q < 4; ++q) __builtin_nontemporal_store(*(const f32x4*)(wo_ + q * 1024 + lane * 16), (f32x4*)(orow_ + q * 1024 + lane * 16));
        }
        {
            unsigned char* wr_ = c.smem + c.wid * 2048;
            *(u32x4*)(wr_ + lane * 32) = (u32x4){pk2(y[0], y[1]), pk2(y[2], y[3]), pk2(y[4], y[5]), pk2(y[6], y[7])};
            *(u32x4*)(wr_ + lane * 32 + 16) = (u32x4){pk2(y[8], y[9]), pk2(y[10], y[11]), pk2(y[12], y[13]), pk2(y[14], y[15])};
            asm volatile("s_waitcnt lgkmcnt(0)" ::: "memory");
            const u32x4 ra_ = *(const u32x4*)(wr_ + lane * 16), rb_ = *(const u32x4*)(wr_ + 1024 + lane * 16);
            unsigned char* xrow_ = (unsigned char*)(XBF + (size_t)t * 1024);
            __builtin_nontemporal_store(ra_, (u32x4*)(xrow_ + lane * 16));
            __builtin_nontemporal_store(rb_, (u32x4*)(xrow_ + 1024 + lane * 16));
        }
#if INP_F8
        if constexpr (!LASTL) {
            u32x4 d8;
#pragma unroll
            for (int q = 0; q < 4; ++q) { int w_ = __builtin_amdgcn_cvt_pk_fp8_f32(y[4 * q] * 16.f, y[4 * q + 1] * 16.f, 0, false); w_ = __builtin_amdgcn_cvt_pk_fp8_f32(y[4 * q + 2] * 16.f, y[4 * q + 3] * 16.f, w_, true); d8[q] = (unsigned)w_; }
            *(u32x4*)(XB8I + (size_t)t * 1024 + lane * 16) = d8;
        }
#endif
        cy = ny; an = na;
    }
}

template <bool LASTL>
__device__ __forceinline__ void phase_combine(const bf16_t* Y, const int* ASG, const float* ASGW, const unsigned* CNT, const float* g, const float* b,
                              float* XOUT, bf16_t* XBF, const Ctx& c) {
    int* bst = (int*)(c.smem + 65536 + 64);
    build_block_table(CNT, bst, c);
    for (int t = c.bid * 4 + c.wid; t < T; t += c.nblk * 4) {
        float v[16];
#pragma unroll
        for (int hf = 0; hf < 2; ++hf) {
            const u32x4 r = *(const u32x4*)(XBF + (size_t)t * 1024 + hf * 512 + c.lane * 8);
            float f[8]; unpack8(r, f);
#pragma unroll
            for (int j = 0; j < 8; ++j) v[hf * 8 + j] = f[j] * ALPHA;
        }
#pragma unroll
        for (int k = 0; k < 9; ++k) {
            size_t crow; float wk = 1.f;
            if (k < 8) { const int asg = ASG[(size_t)t * 8 + k]; crow = (size_t)bst[asg >> 16] * RBR + (asg & 0xffff); wk = ASGW[(size_t)t * 8 + k]; }
            else crow = (size_t)bst[64] * RBR + t;
#pragma unroll
            for (int hf = 0; hf < 2; ++hf) {
                const u32x4 r = *(const u32x4*)(Y + crow * 1024 + hf * 512 + c.lane * 8);
                float f[8]; unpack8(r, f);
#pragma unroll
                for (int j = 0; j < 8; ++j) v[hf * 8 + j] += f[j] * wk;
            }
        }
        ln_row_store<LASTL>(v, g, b, XOUT + (size_t)t * 1024, XBF + (size_t)t * 1024, c.lane);
    }
}

__device__ __forceinline__ void phase_route(const float* LOG, const float* rb, unsigned* CNT, int* LTOK, float* LW, int* ASG, float* ASGW, const Ctx& c) {
    int* lcnt = (int*)c.smem;
    int* lbase = lcnt + 64;
    int* sel_e = lbase + 64;
    int* sel_p = sel_e + 256;
    float* sel_w = (float*)(sel_p + 256);
    const float rbias = rb[c.lane];
    for (int base = 0; base < T / 32; base += c.nblk) {
        const int ch = base + c.bid; const bool valid = ch < T / 32;
        __syncthreads();
        if (c.tid < 64) lcnt[c.tid] = 0;
        __syncthreads();
        if (valid) for (int tl = c.wid; tl < 32; tl += 4) {
            const int t = ch * 32 + tl;
            const float lg = LOG[(size_t)t * 64 + c.lane];
            const float sc = 1.f / (1.f + expf(-lg));
            const float v = sc + rbias;
            float m1 = v;
            m1 = grp8_max(m1);
            int cand = (v == m1) ? c.lane : 999;
            cand = grp8_min(cand);
            float m2 = (c.lane == cand) ? -INFINITY : v;
            m2 = grp8_max(m2);
            const float gs = m1 + m2;
            const int g = c.lane >> 3;
            int grank = 0;
#pragma unroll
            for (int gg = 0; gg < 8; ++gg) { const float o = shfl_c_(gs, gg * 8); grank += ((o > gs) || (o == gs && gg < g)) ? 1 : 0; }
            const bool gsel = grank < 4;
            const float mv = gsel ? v : -INFINITY;
            int rank = 0;
#pragma unroll 8
            for (int jj = 0; jj < 64; ++jj) { const float o = shfl_c_(mv, jj); rank += ((o > mv) || (o == mv && jj < c.lane)) ? 1 : 0; }
            const bool sel = gsel && rank < 8;
            const float ssum = wave_sum(sel ? sc : 0.f);
            const float w = sc / ssum * 2.5f;
            const unsigned long long bal = __ballot(sel);
            const int slot = __popcll(bal & ((1ull << c.lane) - 1ull));
            if (sel) {
                const int p = atomicAdd(&lcnt[c.lane], 1);
                sel_e[tl * 8 + slot] = c.lane; sel_p[tl * 8 + slot] = p; sel_w[tl * 8 + slot] = w;
            }
        }
        __syncthreads();
        if (valid && c.tid < 64) { const int n = lcnt[c.tid]; lbase[c.tid] = n ? (int)atomicAdd(CNT + c.tid, (unsigned)n) : 0; }
        __syncthreads();
        if (valid) {
            const int tl = c.tid >> 3, t = ch * 32 + tl;
            const int e = sel_e[c.tid], pos = lbase[e] + sel_p[c.tid];
            LTOK[(size_t)e * CAP + pos] = t; LW[(size_t)e * CAP + pos] = sel_w[c.tid];
            ASG[(size_t)t * 8 + (c.tid & 7)] = (e << 16) | pos; ASGW[(size_t)t * 8 + (c.tid & 7)] = sel_w[c.tid];
            if (c.tid < 32) { const int ts = ch * 32 + c.tid; LTOK[(size_t)64 * CAP + ts] = ts; LW[(size_t)64 * CAP + ts] = 1.f; }
        }
    }
}

__device__ __forceinline__ void phase_lnroute(const bf16_t* YBUF, const float* g, const float* b, bf16_t* XBF, unsigned char* XB8, const bf16_t* W, const float* rb,
                                              unsigned* CNT, int* LTOK, float* LW, int* ASG, float* ASGW, const Ctx& c) {
    unsigned char* xa = c.smem;
    int* lcnt = (int*)(c.smem + 65536 + 64);
    int* lbase = lcnt + 64;
    float* lgt = (float*)c.smem;
    int* sel_e = (int*)(c.smem + 8192);
    int* sel_p = sel_e + 256;
    float* sel_w = (float*)(sel_p + 256);
    const int lane = c.lane;
    const float rbias = rb[lane];
    f32x4 gv_[2][2], bv_[2][2];
#pragma unroll
    for (int hf = 0; hf < 2; ++hf) { const int col = hf * 512 + lane * 8;
        gv_[hf][0] = *(const f32x4*)(g + col); gv_[hf][1] = *(const f32x4*)(g + col + 4); bv_[hf][0] = *(const f32x4*)(b + col); bv_[hf][1] = *(const f32x4*)(b + col + 4); }
    for (int base = 0; base < T / 32; base += c.nblk) {
        const int ch = base + c.bid; const bool valid = ch < T / 32;
        __syncthreads();
        if (c.tid < 64) lcnt[c.tid] = 0;
        bf16x8 bfr[8], bfn[8];
        const bf16_t* wrow = W + (size_t)(c.wid * 16 + (lane & 15)) * 1024 + (lane >> 4) * 8;
#pragma unroll
        for (int j = 0; j < 8; ++j) bfr[j] = *(const bf16x8*)(wrow + j * 32);
        u32x4 raw[8][2];
#pragma unroll
        for (int i = 0; i < 8; ++i)
#pragma unroll
            for (int hf = 0; hf < 2; ++hf) raw[i][hf] = valid ? *(const u32x4*)(YBUF + (size_t)(ch * 32 + c.wid + 4 * i) * 1024 + hf * 512 + lane * 8) : (u32x4){0u, 0u, 0u, 0u};
        if (valid)
#pragma unroll
        for (int i = 0; i < 8; ++i) {
            const int tl = c.wid + 4 * i;
            const int t = ch * 32 + tl;
            float v[16];
#pragma unroll
            for (int hf = 0; hf < 2; ++hf) {
                float f[8]; unpack8(raw[i][hf], f);
#pragma unroll
                for (int j = 0; j < 8; ++j) v[hf * 8 + j] = f[j];
            }
            float s = 0.f;
#pragma unroll
            for (int i = 0; i < 16; ++i) s += v[i];
            const float mean = wave_sum(s) * (1.f / 1024.f);
            float q = 0.f;
#pragma unroll
            for (int i = 0; i < 16; ++i) { v[i] -= mean; q += v[i] * v[i]; }
            const float rstd = rsqrtf(wave_sum(q) * (1.f / 1024.f) + 1e-5f);
#pragma unroll
            for (int hf = 0; hf < 2; ++hf) {
                const int col = hf * 512 + lane * 8;
                const f32x4 g0 = gv_[hf][0], g1 = gv_[hf][1];
                const f32x4 b0 = bv_[hf][0], b1 = bv_[hf][1];
                f32x4 y0, y1;
#pragma unroll
                for (int j = 0; j < 4; ++j) { y0[j] = v[hf * 8 + j] * rstd * g0[j] + b0[j]; y1[j] = v[hf * 8 + 4 + j] * rstd * g1[j] + b1[j]; }
                const u32x4 pk = (u32x4){pk2(y0[0], y0[1]), pk2(y0[2], y0[3]), pk2(y1[0], y1[1]), pk2(y1[2], y1[3])};
                __builtin_nontemporal_store(pk, (u32x4*)(XBF + (size_t)t * 1024 + col));
                *(u32x4*)(xa + tl * 2048 + (((hf * 64 + lane) ^ (tl & 15)) * 16)) = pk;
#if MOE1_F8
                {
                    int w0 = __builtin_amdgcn_cvt_pk_fp8_f32(y0[0] * 16.f, y0[1] * 16.f, 0, false); w0 = __builtin_amdgcn_cvt_pk_fp8_f32(y0[2] * 16.f, y0[3] * 16.f, w0, true);
                    int w1 = __builtin_amdgcn_cvt_pk_fp8_f32(y1[0] * 16.f, y1[1] * 16.f, 0, false); w1 = __builtin_amdgcn_cvt_pk_fp8_f32(y1[2] * 16.f, y1[3] * 16.f, w1, true);
                    *(u32x2*)(XB8 + (size_t)t * 1024 + col) = (u32x2){(unsigned)w0, (unsigned)w1};
                }
#endif
            }
        }
        __syncthreads();
        f32x4 acc0 = (f32x4){0.f, 0.f, 0.f, 0.f}, acc1 = (f32x4){0.f, 0.f, 0.f, 0.f};
        {
            const int r = lane & 15, kq = lane >> 4;
#pragma unroll
            for (int kb = 0; kb < 32; kb += 8) {
                if (kb + 8 < 32) {
#pragma unroll
                    for (int j = 0; j < 8; ++j) bfn[j] = *(const bf16x8*)(wrow + (kb + 8 + j) * 32);
                }
#pragma unroll
                for (int j = 0; j < 8; ++j) {
                    const int chunk = ((kb + j) * 4 + kq) ^ r;
                    const bf16x8 a0 = *(const bf16x8*)(xa + r * 2048 + chunk * 16), a1 = *(const bf16x8*)(xa + (16 + r) * 2048 + chunk * 16);
                    acc0 = __builtin_amdgcn_mfma_f32_16x16x32_bf16(a0, bfr[j], acc0, 0, 0, 0);
                    acc1 = __builtin_amdgcn_mfma_f32_16x16x32_bf16(a1, bfr[j], acc1, 0, 0, 0);
                }
#pragma unroll
                for (int j = 0; j < 8; ++j) bfr[j] = bfn[j];
            }
        }
        __syncthreads();
        {
            const int e = c.wid * 16 + (lane & 15), r0 = 4 * (lane >> 4);
#pragma unroll
            for (int j = 0; j < 4; ++j) { lgt[(r0 + j) * 64 + e] = acc0[j]; lgt[(16 + r0 + j) * 64 + e] = acc1[j]; }
        }
        __syncthreads();
        if (valid) for (int tl = c.wid; tl < 32; tl += 4) {
            const float lg = lgt[tl * 64 + lane];
            const float sc = 1.f / (1.f + expf(-lg));
            const float v = sc + rbias;
            float m1 = v;
            m1 = grp8_max(m1);
            int cand = (v == m1) ? lane : 999;
            cand = grp8_min(cand);
            float m2 = (lane == cand) ? -INFINITY : v;
            m2 = grp8_max(m2);
            const float gs = m1 + m2;
            const int gi = lane >> 3;
            int grank = 0;
#pragma unroll
            for (int gg = 0; gg < 8; ++gg) { const float o = shfl_c_(gs, gg * 8); grank += ((o > gs) || (o == gs && gg < gi)) ? 1 : 0; }
            const bool gsel = grank < 4;
            const float mv = gsel ? v : -INFINITY;
            int rank = 0;
#pragma unroll 8
            for (int jj = 0; jj < 64; ++jj) { const float o = shfl_c_(mv, jj); rank += ((o > mv) || (o == mv && jj < lane)) ? 1 : 0; }
            const bool sel = gsel && rank < 8;
            const float ssum = wave_sum(sel ? sc : 0.f);
            const float w = sc / ssum * 2.5f;
            const unsigned long long bal = __ballot(sel);
            const int slot = __popcll(bal & ((1ull << lane) - 1ull));
            if (sel) {
                const int p = atomicAdd(&lcnt[lane], 1);
                sel_e[tl * 8 + slot] = lane; sel_p[tl * 8 + slot] = p; sel_w[tl * 8 + slot] = w;
            }
        }
        __syncthreads();
        if (valid && c.tid < 64) { const int n = lcnt[c.tid]; lbase[c.tid] = n ? (int)atomicAdd(CNT + c.tid, (unsigned)n) : 0; }
        __syncthreads();
        if (valid) {
            const int tl = c.tid >> 3, t = ch * 32 + tl;
            const int e = sel_e[c.tid], pos = lbase[e] + sel_p[c.tid];
            LTOK[(size_t)e * CAP + pos] = t; LW[(size_t)e * CAP + pos] = sel_w[c.tid];
            ASG[(size_t)t * 8 + (c.tid & 7)] = (e << 16) | pos; ASGW[(size_t)t * 8 + (c.tid & 7)] = sel_w[c.tid];
            if (c.tid < 32) { const int ts = ch * 32 + c.tid; LTOK[(size_t)64 * CAP + ts] = ts; LW[(size_t)64 * CAP + ts] = 1.f; }
        }
    }
}

__device__ __forceinline__ void phase_prep_even(const bf16_t* PROJ, const float* GATES, const float* qn, const float* kvn, const float* cw,
                                const float* a_log, const float* dt_bias, const float* ROPEM,
                                bf16_t* CQ, bf16_t* CKV, bf16_t* KROPE, bf16_t* GQ, bf16_t* GK, bf16_t* GV, float* BETA, float* GLOG, const Ctx& c) {
    const int lane = c.lane;
    float* cwL = (float*)c.smem;
    __syncthreads();
    for (int i = c.tid; i < 4 * 1536 / 4; i += 256) *(f32x4*)(cwL + i * 4) = *(const f32x4*)(cw + i * 4);
    __syncthreads();
    const f32x4 gq = *(const f32x4*)(qn + lane * 4);
    const float kvg0 = kvn[lane * 2], kvg1 = kvn[lane * 2 + 1];
    const int l16 = lane & 15, hg = (lane >> 2) == 1 ? lane - 4 : 0;
    const float nalog = -expf(a_log[hg]), dtb = dt_bias[hg];
    struct PrepTok { u32x2 rq; unsigned rk; unsigned kx1, kx2; f32x2 rcs; float gt; u32x4 xr[3][4]; };
    auto ldtok = [&](int t) {
        PrepTok k;
        const bf16_t* pr = PROJ + (size_t)t * NPAD;
        const int s = t & (SEQ - 1);
        k.rq = *(const u32x2*)(pr + lane * 4);
        k.rk = *(const unsigned*)(pr + 256 + lane * 2);
        k.kx1 = pr[384 + l16]; k.kx2 = pr[400 + l16];
        k.rcs = *(const f32x2*)(ROPEM + ((size_t)t * 16 + l16) * 2);
        k.gt = GATES[(size_t)t * 8 + (lane & 7)];
#pragma unroll
        for (int arr = 0; arr < 3; ++arr)
#pragma unroll
            for (int w = 0; w < 4; ++w) {
                const int tw = (s - 3 + w >= 0) ? t - 3 + w : t;
                k.xr[arr][w] = *(const u32x4*)(PROJ + (size_t)tw * NPAD + 416 + arr * 512 + lane * 8);
            }
        return k;
    };
    const int tstep = c.nblk * 4;
    int t = c.bid * 4 + c.wid;
    PrepTok cur = ldtok(t < T ? t : 0);
    for (; t < T; t += tstep) {
        const PrepTok nxt = ldtok((t + tstep < T) ? t + tstep : t);
        asm volatile("" ::: "memory");
        {
            const u32x2 r = cur.rq;
            float v[4] = {bflo(r.x), bfhi(r.x), bflo(r.y), bfhi(r.y)};
            const float ss = wave_sum(v[0] * v[0] + v[1] * v[1] + v[2] * v[2] + v[3] * v[3]);
            const float rr = rsqrtf(ss * (1.f / 256.f) + 1e-6f);
            *(u32x2*)(CQ + (size_t)t * 256 + lane * 4) = (u32x2){pk2(v[0] * rr * gq[0], v[1] * rr * gq[1]), pk2(v[2] * rr * gq[2], v[3] * rr * gq[3])};
        }
        {
            const unsigned r = cur.rk;
            const float v0 = bflo(r), v1 = bfhi(r);
            const float ss = wave_sum(v0 * v0 + v1 * v1);
            const float rr = rsqrtf(ss * (1.f / 128.f) + 1e-6f);
            *(unsigned*)(CKV + (size_t)t * 128 + lane * 2) = pk2(v0 * rr * kvg0, v1 * rr * kvg1);
        }
        if (lane < 16) {
            const float x1 = bf2f(cur.kx1), x2 = bf2f(cur.kx2);
            const float cs = cur.rcs[0], sn = cur.rcs[1];
            KROPE[(size_t)t * 32 + lane] = (bf16_t)f2bf(x1 * cs - x2 * sn);
            KROPE[(size_t)t * 32 + 16 + lane] = (bf16_t)f2bf(x2 * cs + x1 * sn);
        }
        const int s = t & (SEQ - 1);
#pragma unroll
        for (int arr = 0; arr < 3; ++arr) {
            float y[8];
#pragma unroll
            for (int j = 0; j < 8; ++j) y[j] = 0.f;
#pragma unroll
            for (int w = 0; w < 4; ++w) {
                float f[8]; unpack8(cur.xr[arr][w], f);
                const float keep = (s - 3 + w >= 0) ? 1.f : 0.f;
                const f32x4 c0 = *(const f32x4*)(cwL + w * 1536 + arr * 512 + lane * 8) * keep, c1 = *(const f32x4*)(cwL + w * 1536 + arr * 512 + lane * 8 + 4) * keep;
#pragma unroll
                for (int j = 0; j < 4; ++j) { y[j] += c0[j] * f[j]; y[4 + j] += c1[j] * f[4 + j]; }
            }
            float ss = 0.f;
#pragma unroll
            for (int j = 0; j < 8; ++j) { y[j] = siluf_(y[j]); ss += y[j] * y[j]; }
            if (arr < 2) {
                float rr = rsqrtf(red16(ss) + 1e-6f);
                if (arr == 0) rr *= 0.08838834764831845f;
#pragma unroll
                for (int j = 0; j < 8; ++j) y[j] *= rr;
            }
            bf16_t* dst = (arr == 0) ? GQ : (arr == 1) ? GK : GV;
            *(u32x4*)(dst + (size_t)t * 512 + lane * 8) = (u32x4){pk2(y[0], y[1]), pk2(y[2], y[3]), pk2(y[4], y[5]), pk2(y[6], y[7])};
        }
        if (lane < 4) BETA[(size_t)t * 4 + lane] = sigmoidf_(cur.gt);
        else if (lane < 8) GLOG[(size_t)t * 4 + hg] = nalog * softplusf_(cur.gt + dtb);
        cur = nxt;
    }
}

__device__ __forceinline__ void phase_prep_odd(const bf16_t* PROJ, const float* ROPES, bf16_t* SQ, bf16_t* SK, const Ctx& c) {
    const int lane = c.lane;
    const int hh = lane >> 2, j = lane & 3;
    const bool isq = lane < 32, act = lane < 40;
    const int scol = isq ? 1544 + hh * 64 + j * 8 : 2056 + (hh - 8) * 64 + j * 8;
    const float sc = isq ? 0.18033688011112042f : 1.f;
    struct OddTok { u32x4 r1, r2; f32x4 t0, t1, t2, t3; };
    auto ldtok = [&](int t) {
        OddTok k;
        const bf16_t* pr = PROJ + (size_t)t * NPAD + scol;
        k.r1 = *(const u32x4*)pr; k.r2 = *(const u32x4*)(pr + 32);
        const float* rp = ROPES + ((size_t)t * 32 + j * 8) * 2;
        k.t0 = *(const f32x4*)rp; k.t1 = *(const f32x4*)(rp + 4); k.t2 = *(const f32x4*)(rp + 8); k.t3 = *(const f32x4*)(rp + 12);
        return k;
    };
    const int tstep = c.nblk * 4;
    int t = c.bid * 4 + c.wid;
    if (!act) return;
    OddTok cur = ldtok(t < T ? t : 0);
    for (; t < T; t += tstep) {
        const OddTok nxt = ldtok((t + tstep < T) ? t + tstep : t);
        asm volatile("" ::: "memory");
        {
            const u32x4 r1 = cur.r1, r2 = cur.r2;
            const f32x4 t0 = cur.t0, t1 = cur.t1, t2 = cur.t2, t3 = cur.t3;
            const float cs[8] = {t0[0], t0[2], t1[0], t1[2], t2[0], t2[2], t3[0], t3[2]}, sn[8] = {t0[1], t0[3], t1[1], t1[3], t2[1], t2[3], t3[1], t3[3]};
            float x1[8], x2[8], o1[8], o2[8]; unpack8(r1, x1); unpack8(r2, x2);
#pragma unroll
            for (int k = 0; k < 8; ++k) { o1[k] = (x1[k] * cs[k] - x2[k] * sn[k]) * sc; o2[k] = (x2[k] * cs[k] + x1[k] * sn[k]) * sc; }
            bf16_t* d = isq ? SQ + (size_t)t * 512 + hh * 64 + j * 8 : SK + (size_t)t * 128 + (hh - 8) * 64 + j * 8;
            *(u32x4*)d = (u32x4){pk2(o1[0], o1[1]), pk2(o1[2], o1[3]), pk2(o1[4], o1[5]), pk2(o1[6], o1[7])};
            *(u32x4*)(d + 32) = (u32x4){pk2(o2[0], o2[1]), pk2(o2[2], o2[3]), pk2(o2[4], o2[5]), pk2(o2[6], o2[7])};
        }
        cur = nxt;
    }
}

__device__ __forceinline__ int next_unit(unsigned* ctr, const Ctx& c) {
    volatile int* su = (volatile int*)(c.smem0 + LDS_BLK + 16);
    __syncthreads();
    if (c.tid0 == 0) *su = (int)atomicAdd(ctr, 1u);
    __syncthreads();
    return *su * 2 + c.half;
}

typedef float f32x16 __attribute__((ext_vector_type(16)));
typedef short s16x4 __attribute__((ext_vector_type(4)));
#define MFMA32(a, b, c) __builtin_amdgcn_mfma_f32_32x32x16_bf16((a), (b), (c), 0, 0, 0)
template <int S_> __device__ __forceinline__ bf16x8 pack_step(const f32x16& x) {
    u32x4 p;
    asm volatile("v_cvt_pk_bf16_f32 %0, %4, %5\n\tv_cvt_pk_bf16_f32 %1, %6, %7\n\tv_cvt_pk_bf16_f32 %2, %8, %9\n\tv_cvt_pk_bf16_f32 %3, %10, %11\n\ts_nop 1"
                 : "=&v"(p[0]), "=&v"(p[1]), "=&v"(p[2]), "=&v"(p[3])
                 : "v"(x[8 * S_]), "v"(x[8 * S_ + 1]), "v"(x[8 * S_ + 2]), "v"(x[8 * S_ + 3]), "v"(x[8 * S_ + 4]), "v"(x[8 * S_ + 5]), "v"(x[8 * S_ + 6]), "v"(x[8 * S_ + 7]));
    return __builtin_bit_cast(bf16x8, p);
}
template <int S_> __device__ __forceinline__ bf16x8 pack_step_m(const f32x16& x) {
    u32x4 p;
    asm volatile("s_nop 15\n\tv_cvt_pk_bf16_f32 %0, %4, %5\n\tv_cvt_pk_bf16_f32 %1, %6, %7\n\tv_cvt_pk_bf16_f32 %2, %8, %9\n\tv_cvt_pk_bf16_f32 %3, %10, %11\n\ts_nop 1"
                 : "=&v"(p[0]), "=&v"(p[1]), "=&v"(p[2]), "=&v"(p[3])
                 : "v"(x[8 * S_]), "v"(x[8 * S_ + 1]), "v"(x[8 * S_ + 2]), "v"(x[8 * S_ + 3]), "v"(x[8 * S_ + 4]), "v"(x[8 * S_ + 5]), "v"(x[8 * S_ + 6]), "v"(x[8 * S_ + 7]));
    return __builtin_bit_cast(bf16x8, p);
}
constexpr int ATT_VB = 64 * 128;

template <int NKS, bool WIN>
__device__ __forceinline__ void attn_unit(const bf16_t* Qp, int q_ld, const bf16_t* K1, int k1_ld, const bf16_t* K2, int k2_ld, const bf16_t* Vp, int v_ld,
                          bf16_t* Op, int o_ld, int Q0_in, float sink_l2, const Ctx& c) {
    constexpr int KB = NKS * 2 * 1024, BUF = KB + ATT_VB;
    const int Q0 = __builtin_amdgcn_readfirstlane(Q0_in);
    const int lane = c.lane, r = lane & 31, h = lane >> 5;
    const int wid = __builtin_amdgcn_readfirstlane(c.wid);
    const int q0w = Q0 + wid * 32;
    unsigned char* smem = c.smem;
    bf16x8 qf[NKS];
#pragma unroll
    for (int ks = 0; ks < NKS; ++ks) qf[ks] = *(const bf16x8*)(Qp + (size_t)(q0w + r) * q_ld + ks * 16 + h * 8);
    f32x16 o0, o1;
#pragma unroll
    for (int i = 0; i < 16; ++i) { o0[i] = 0.f; o1[i] = 0.f; }
    float m = WIN ? sink_l2 : -1e30f, l = (WIN && h == 0) ? 1.f : 0.f;
    const int kt_lo = WIN ? ((Q0 >> 6) - 2 < 0 ? 0 : (Q0 >> 6) - 2) : 0, kt_hi = (Q0 >> 6) + 1;
    const char* K1u = uniform_ptr(K1); const char* K2u = uniform_ptr(K2); const char* Vu = uniform_ptr(Vp);
    const unsigned lds0 = (unsigned)__builtin_amdgcn_readfirstlane((int)(unsigned)(size_t)smem);
    const unsigned voK1 = (unsigned)(lane * k1_ld * 2), voK2 = (unsigned)(lane * k2_ld * 2), voV = (unsigned)(((lane >> 3) * v_ld + (lane & 7) * 8) * 2);
#define ATT_STAGE(kt_, buf_) do { const unsigned bp = lds0 + (unsigned)((buf_) * BUF); const size_t kb = (size_t)(kt_) * 64; \
        _Pragma("unroll") for (int i = 0; i < (NKS * 2) / 4; ++i) { const int ch = wid + 4 * i; \
            if (ch < 8) glds16s(K1u + (kb * k1_ld + ch * 8) * 2, voK1, bp + ch * 1024); \
            else glds16s(K2u + (kb * k2_ld + (ch - 8) * 8) * 2, voK2, bp + ch * 1024); } \
        _Pragma("unroll") for (int i = 0; i < 2; ++i) { const int j = wid + 4 * i; \
            glds16s(Vu + ((kb + 8 * j) * v_ld) * 2, voV, bp + KB + j * 1024); } } while (0)
    ATT_STAGE(kt_lo, 0);
    const int i16 = lane & 15;
    const unsigned vlane = (unsigned)((4 * h + (i16 >> 2)) * 128 + 32 * ((lane >> 4) & 1) + 8 * (i16 & 3));
    for (int kt = kt_lo; kt <= kt_hi; ++kt) {
        const int cur = (kt - kt_lo) & 1;
        asm volatile("s_waitcnt vmcnt(0)" ::: "memory");
        __syncthreads();
        if (kt < kt_hi) ATT_STAGE(kt + 1, cur ^ 1);
        const int k0 = kt * 64;
        const bool active = (k0 <= q0w + 31) && (!WIN || (k0 + 63 > q0w - 128));
        if (active) {
            const LAS unsigned char* Kt = (const LAS unsigned char*)smem + cur * BUF + h * 1024 + r * 16;
            f32x16 x0, x1;
            const f32x16 zero16 = (f32x16){0.f, 0.f, 0.f, 0.f, 0.f, 0.f, 0.f, 0.f, 0.f, 0.f, 0.f, 0.f, 0.f, 0.f, 0.f, 0.f};
#pragma unroll
            for (int ks = 0; ks < NKS; ++ks) {
                const bf16x8 kf0 = *(const LAS bf16x8*)(Kt + ks * 2048);
                const bf16x8 kf1 = *(const LAS bf16x8*)(Kt + ks * 2048 + 512);
                x0 = MFMA32(kf0, qf[ks], ks == 0 ? zero16 : x0); x1 = MFMA32(kf1, qf[ks], ks == 0 ? zero16 : x1);
            }
            const bool need_mask = (k0 + 63 > q0w) || (WIN && (k0 <= q0w + 31 - 128));
            if (need_mask) {
                const int q = q0w + r;
#pragma unroll
                for (int i = 0; i < 16; ++i) {
                    const int key = k0 + (i & 3) + 8 * (i >> 2) + 4 * h;
                    const bool v0 = (key <= q) && (!WIN || key > q - 128);
                    const bool v1 = (key + 32 <= q) && (!WIN || key + 32 > q - 128);
                    x0[i] = v0 ? x0[i] : -INFINITY; x1[i] = v1 ? x1[i] : -INFINITY;
                }
            }
            float mx = fmaxf(x0[0], x1[0]);
#pragma unroll
            for (int i = 1; i < 16; ++i) mx = fmaxf(mx, fmaxf(x0[i], x1[i]));
            mx = fmaxf(mx, shfl_xor_(mx, 32));
            const float mn = fmaxf(m, mx);
            const float alpha = __builtin_amdgcn_exp2f(m - mn);
            m = mn;
            float ps = 0.f;
#pragma unroll
            for (int i = 0; i < 16; ++i) { x0[i] = __builtin_amdgcn_exp2f(x0[i] - mn); x1[i] = __builtin_amdgcn_exp2f(x1[i] - mn); ps += x0[i] + x1[i]; }
            l = l * alpha + ps;
            o0 *= alpha; o1 *= alpha;
            const unsigned vbase = (unsigned)(size_t)(smem + cur * BUF + KB) + vlane;
#pragma unroll
            for (int t = 0; t < 2; ++t) {
                s16x4 l00, h00, l01, h01, l10, h10, l11, h11;
                const unsigned va = vbase + t * 4096;
                asm volatile("ds_read_b64_tr_b16 %0, %8\n\t"
                             "ds_read_b64_tr_b16 %1, %8 offset:1024\n\t"
                             "ds_read_b64_tr_b16 %2, %8 offset:64\n\t"
                             "ds_read_b64_tr_b16 %3, %8 offset:1088\n\t"
                             "ds_read_b64_tr_b16 %4, %8 offset:2048\n\t"
                             "ds_read_b64_tr_b16 %5, %8 offset:3072\n\t"
                             "ds_read_b64_tr_b16 %6, %8 offset:2112\n\t"
                             "ds_read_b64_tr_b16 %7, %8 offset:3136\n\t"
                             "s_waitcnt lgkmcnt(0)"
                             : "=&v"(l00), "=&v"(h00), "=&v"(l01), "=&v"(h01), "=&v"(l10), "=&v"(h10), "=&v"(l11), "=&v"(h11) : "v"(va) : "memory");
                const bf16x8 v00 = __builtin_shufflevector(l00, h00, 0, 1, 2, 3, 4, 5, 6, 7), v01 = __builtin_shufflevector(l01, h01, 0, 1, 2, 3, 4, 5, 6, 7);
                const bf16x8 v10 = __builtin_shufflevector(l10, h10, 0, 1, 2, 3, 4, 5, 6, 7), v11 = __builtin_shufflevector(l11, h11, 0, 1, 2, 3, 4, 5, 6, 7);
                const bf16x8 pb0 = (t == 0) ? pack_step<0>(x0) : pack_step<0>(x1);
                const bf16x8 pb1 = (t == 0) ? pack_step<1>(x0) : pack_step<1>(x1);
                o0 = MFMA32(v00, pb0, o0); o1 = MFMA32(v01, pb0, o1);
                o0 = MFMA32(v10, pb1, o0); o1 = MFMA32(v11, pb1, o1);
            }
        }
    }
#undef ATT_STAGE
    l += shfl_xor_(l, 32);
    const float inv = 1.f / l;
    bf16_t* orow = Op + (size_t)(q0w + r) * o_ld + 4 * h;
#pragma unroll
    for (int g = 0; g < 4; ++g) {
        *(u32x2*)(orow + 8 * g) = (u32x2){pk2(o0[4 * g] * inv, o0[4 * g + 1] * inv), pk2(o0[4 * g + 2] * inv, o0[4 * g + 3] * inv)};
        *(u32x2*)(orow + 32 + 8 * g) = (u32x2){pk2(o1[4 * g] * inv, o1[4 * g + 1] * inv), pk2(o1[4 * g + 2] * inv, o1[4 * g + 3] * inv)};
    }
}

constexpr size_t MLC_DC = 0, MLC_CS = 33554432, MLC_DN = MLC_CS + 16777216, MLC_NS = MLC_DN + 262144, MLC_ML = MLC_NS + 262144, MLC_BE = MLC_ML + 4096, MLC_MS = MLC_BE + 4096;

__device__ __forceinline__ float scan_add64(float v, int lane) {
#pragma unroll
    for (int o = 1; o < 64; o <<= 1) { const float x = shfl_up_(v, o); if (lane >= o) v += x; }
    return v;
}
__device__ __forceinline__ float scan_max64(float v, int lane) {
#pragma unroll
    for (int o = 1; o < 64; o <<= 1) { const float x = shfl_up_(v, o); if (lane >= o) v = fmaxf(v, x); }
    return v;
}
__device__ __forceinline__ float wave_max(float v) {
#pragma unroll
    for (int o = 32; o > 0; o >>= 1) v = fmaxf(v, shfl_xor_(v, o));
    return v;
}

__device__ __forceinline__ void mlc_passA(int u, const bf16_t* PROJ, const float* GATES, const float* b_i, const float* b_f, unsigned char* YB, const Ctx& c) {
    const int bh = u >> 5, b = bh >> 2, h = bh & 3;
    const size_t t0 = (size_t)b * SEQ + (u & 31) * 64;
    unsigned char* smem = c.smem;
    float* saL = (float*)(smem + 24576);
    const int lane = c.lane, wid = __builtin_amdgcn_readfirstlane(c.wid);
#pragma unroll
    for (int i = 0; i < 4; ++i) { const int j = wid * 4 + i;
        glds16(PROJ + (t0 + 4 * j + (lane >> 4)) * NPAD + 512 + h * 128 + (lane & 15) * 8, smem + 8192 + j * 1024 + lane * 16); }
    if (wid == 0) {
        const float ip = GATES[(t0 + lane) * 8 + h] + b_i[h], lf = -softplusf_(-(GATES[(t0 + lane) * 8 + 4 + h] + b_f[h]));
        const float bc = scan_add64(lf, lane), bend = shfl_c_(bc, 63);
        const float a = bend - bc + ip, mloc = wave_max(a);
        saL[lane] = expf(a - mloc) * 0.125f;
        if (lane == 0) { ((float*)(YB + MLC_ML))[u] = mloc; ((float*)(YB + MLC_BE))[u] = bend; }
    }
    __syncthreads();
#pragma unroll
    for (int i = 0; i < 2; ++i) {
        const int idx = c.tid + 256 * i, row = idx >> 3, chk = idx & 7;
        const u32x4 r = *(const u32x4*)(PROJ + (t0 + row) * NPAD + 256 + h * 64 + chk * 8);
        float f[8]; unpack8(r, f);
        const float s = saL[row];
        *(u32x4*)(smem + row * 128 + chk * 16) = (u32x4){pk2(f[0] * s, f[1] * s), pk2(f[2] * s, f[3] * s), pk2(f[4] * s, f[5] * s), pk2(f[6] * s, f[7] * s)};
    }
    asm volatile("s_waitcnt vmcnt(0)" ::: "memory");
    __syncthreads();
    const int h5 = lane >> 5, r = lane & 31, i16 = lane & 15, q4 = i16 >> 2, p = i16 & 3, blk = (lane >> 4) & 1;
    const int dkt = wid & 1, dvp = wid >> 1;
    const unsigned kaddr = (unsigned)(size_t)smem + (unsigned)((8 * h5 + q4) * 128 + dkt * 64 + 32 * blk + 8 * p);
    const unsigned vaddr = (unsigned)(size_t)smem + 8192u + (unsigned)((8 * h5 + q4) * 256 + dvp * 128 + 32 * blk + 8 * p);
    f32x16 a0, a1;
#pragma unroll
    for (int i = 0; i < 16; ++i) { a0[i] = 0.f; a1[i] = 0.f; }
#pragma unroll
    for (int st = 0; st < 4; ++st) {
        s16x4 kl, kh, v0l, v0h, v1l, v1h;
        const unsigned ka = kaddr + st * 2048, va = vaddr + st * 4096;
        asm volatile("ds_read_b64_tr_b16 %0, %6\n\t"
                     "ds_read_b64_tr_b16 %1, %6 offset:512\n\t"
                     "ds_read_b64_tr_b16 %2, %7\n\t"
                     "ds_read_b64_tr_b16 %3, %7 offset:1024\n\t"
                     "ds_read_b64_tr_b16 %4, %7 offset:64\n\t"
                     "ds_read_b64_tr_b16 %5, %7 offset:1088\n\t"
                     "s_waitcnt lgkmcnt(0)"
                     : "=&v"(kl), "=&v"(kh), "=&v"(v0l), "=&v"(v0h), "=&v"(v1l), "=&v"(v1h) : "v"(ka), "v"(va) : "memory");
        const bf16x8 kf = __builtin_shufflevector(kl, kh, 0, 1, 2, 3, 4, 5, 6, 7);
        const bf16x8 vf0 = __builtin_shufflevector(v0l, v0h, 0, 1, 2, 3, 4, 5, 6, 7), vf1 = __builtin_shufflevector(v1l, v1h, 0, 1, 2, 3, 4, 5, 6, 7);
        a0 = MFMA32(kf, vf0, a0); a1 = MFMA32(kf, vf1, a1);
    }
    float* DC = (float*)(YB + MLC_DC) + (size_t)u * 8192;
#pragma unroll
    for (int i = 0; i < 16; ++i) {
        const int dk = dkt * 32 + (i & 3) + 8 * (i >> 2) + 4 * h5;
        DC[dk * 128 + dvp * 64 + r] = a0[i]; DC[dk * 128 + dvp * 64 + 32 + r] = a1[i];
    }
    if (c.tid < 64) {
        float s = 0.f;
#pragma unroll 8
        for (int t = 0; t < 64; ++t) s += bf2f(((const bf16_t*)smem)[t * 64 + c.tid]);
        ((float*)(YB + MLC_DN))[(size_t)u * 64 + c.tid] = s;
    }
}

__device__ __forceinline__ void mlc_passB(int u, unsigned char* YB, const Ctx& c) {
    const int bh = u >> 3, sl = u & 7;
    const float* ML = (const float*)(YB + MLC_ML) + bh * 32; const float* BE = (const float*)(YB + MLC_BE) + bh * 32;
    const float* DC = (const float*)(YB + MLC_DC) + (size_t)bh * 32 * 8192 + sl * 1024 + c.tid * 4;
    bf16_t* CS = (bf16_t*)(YB + MLC_CS) + (size_t)bh * 32 * 8192 + sl * 1024 + c.tid * 4;
    const float* DN = (const float*)(YB + MLC_DN) + (size_t)bh * 32 * 64; float* NS = (float*)(YB + MLC_NS) + (size_t)bh * 32 * 64; float* MS = (float*)(YB + MLC_MS) + bh * 32;
    f32x4 C4 = (f32x4){0.f, 0.f, 0.f, 0.f}; float nv = 0.f, m = 0.f;
    const bool do_n = (sl == 0) && (c.tid < 64);
#pragma unroll 1
    for (int nb = 0; nb < 32; nb += 16) {
        f32x4 d[16]; float be[16], ml[16], dn[16];
#pragma unroll
        for (int i = 0; i < 16; ++i) { d[i] = *(const f32x4*)(DC + (size_t)(nb + i) * 8192); be[i] = BE[nb + i]; ml[i] = ML[nb + i]; dn[i] = do_n ? DN[(nb + i) * 64 + c.tid] : 0.f; }
#pragma unroll
        for (int i = 0; i < 16; ++i) {
            const int n = nb + i;
            *(u32x2*)(CS + (size_t)n * 8192) = (u32x2){pk2(C4[0], C4[1]), pk2(C4[2], C4[3])};
            if (do_n) NS[n * 64 + c.tid] = nv;
            if (sl == 0 && c.tid == 0) MS[n] = m;
            const float mn = fmaxf(be[i] + m, ml[i]), keep = expf(be[i] + m - mn), g = expf(ml[i] - mn);
            m = mn;
            C4 = C4 * keep + d[i] * g;
            nv = nv * keep + dn[i] * g;
        }
    }
}

__device__ __forceinline__ void mlc_passC(int u, const bf16_t* PROJ, const float* GATES, const float* b_i, const float* b_f, const unsigned char* YB,
                                          const float* gain  , bf16_t* MIXO, const Ctx& c) {
    const int bh = u >> 5, b = bh >> 2, h = bh & 3;
    const size_t t0 = (size_t)b * SEQ + (u & 31) * 64;
    unsigned char* smem = c.smem;
    float* csL = (float*)(smem + 32768); float* pmL = (float*)(smem + 33024); float* bcL = (float*)(smem + 33280); float* nnL = (float*)(smem + 33536); float* sqL = (float*)(smem + 33792);
    const int lane = c.lane, wid = __builtin_amdgcn_readfirstlane(c.wid);
    const bf16_t* CS = (const bf16_t*)(YB + MLC_CS) + (size_t)u * 8192;
#pragma unroll
    for (int i = 0; i < 4; ++i) { const int j = wid * 4 + i;
        glds16(PROJ + (t0 + 4 * j + (lane >> 4)) * NPAD + 512 + h * 128 + (lane & 15) * 8, smem + j * 1024 + lane * 16);
        glds16(CS + (4 * j + (lane >> 4)) * 128 + (lane & 15) * 8, smem + 16384 + j * 1024 + lane * 16); }
    const int h5 = lane >> 5, r = lane & 31, i16 = lane & 15, q4 = i16 >> 2, p = i16 & 3, blk = (lane >> 4) & 1;
    const int th = wid & 1, dvh = wid >> 1;
    const int t = th * 32 + r;
    const float m_n = ((const float*)(YB + MLC_MS))[u];
    bf16x8 qf[4], kfa[4], kfb[4];
#pragma unroll
    for (int ks = 0; ks < 4; ++ks) {
        qf[ks] = *(const bf16x8*)(PROJ + (t0 + t) * NPAD + h * 64 + ks * 16 + h5 * 8);
        kfa[ks] = *(const bf16x8*)(PROJ + (t0 + r) * NPAD + 256 + h * 64 + ks * 16 + h5 * 8);
        kfb[ks] = *(const bf16x8*)(PROJ + (t0 + 32 + r) * NPAD + 256 + h * 64 + ks * 16 + h5 * 8);
    }
    const bf16_t* grow = PROJ + (t0 + t) * NPAD + 1032 + h * 128 + dvh * 64 + 4 * h5;
    const float* gn = gain + h * 128 + dvh * 64 + 4 * h5;
    u32x2 zrp[2][4]; f32x4 gvp[2][4];
#pragma unroll
    for (int d = 0; d < 2; ++d)
#pragma unroll
        for (int g = 0; g < 4; ++g) { zrp[d][g] = *(const u32x2*)(grow + d * 32 + 8 * g); gvp[d][g] = *(const f32x4*)(gn + d * 32 + 8 * g); }
    float bcl = 0.f;
    if (wid == 0) {
        const float ip = GATES[(t0 + lane) * 8 + h] + b_i[h], lf = -softplusf_(-(GATES[(t0 + lane) * 8 + 4 + h] + b_f[h]));
        bcl = scan_add64(lf, lane);
        const float cs = ip - bcl;
        csL[lane] = cs; pmL[lane] = scan_max64(cs, lane);
        nnL[lane] = ((const float*)(YB + MLC_NS))[(size_t)u * 64 + lane];
        bcL[lane] = bcl;
    }
    asm volatile("s_waitcnt vmcnt(0)" ::: "memory");
    __syncthreads();
    const float Mt = fmaxf(m_n, pmL[t]), w_inter = __expf(m_n - Mt), em = __expf(-(bcL[t] + Mt));
    float qn = 0.f; bf16x8 qw[4];
#pragma unroll
    for (int ks = 0; ks < 4; ++ks) {
        const u32x4 raw = __builtin_bit_cast(u32x4, qf[ks]); float f[8]; unpack8(raw, f);
#pragma unroll
        for (int j = 0; j < 8; ++j) qn += f[j] * nnL[ks * 16 + h5 * 8 + j];
        qw[ks] = __builtin_bit_cast(bf16x8, (u32x4){pk2(f[0] * w_inter, f[1] * w_inter), pk2(f[2] * w_inter, f[3] * w_inter), pk2(f[4] * w_inter, f[5] * w_inter), pk2(f[6] * w_inter, f[7] * w_inter)});
    }
    qn += shfl_xor_(qn, 32);
    f32x16 x0, x1;
#pragma unroll
    for (int i = 0; i < 16; ++i) { x0[i] = 0.f; x1[i] = 0.f; }
#pragma unroll
    for (int ks = 0; ks < 4; ++ks) {
        x0 = MFMA32(kfa[ks], qf[ks], x0);
        if (th) x1 = MFMA32(kfb[ks], qf[ks], x1);
    }
    float ps = 0.f;
#pragma unroll
    for (int i = 0; i < 16; ++i) {
        const int s = (i & 3) + 8 * (i >> 2) + 4 * h5;
        const float e0 = __expf(csL[s] - Mt) * 0.125f, e1 = __expf(csL[32 + s] - Mt) * 0.125f;
        const float w0 = (s <= t) ? e0 : 0.f;
        x0[i] *= w0; ps += x0[i];
        if (th) { const float w1 = (s <= r) ? e1 : 0.f; x1[i] *= w1; ps += x1[i]; }
    }
    ps += shfl_xor_(ps, 32);
    const float den = w_inter * qn + ps;
    f32x16 o0, o1;
#pragma unroll
    for (int i = 0; i < 16; ++i) { o0[i] = 0.f; o1[i] = 0.f; }
    {
        const unsigned vb = (unsigned)(size_t)smem + (unsigned)((4 * h5 + q4) * 256 + dvh * 128 + 32 * blk + 8 * p);
#pragma unroll
        for (int st = 0; st < 2; ++st) {
            if (st == 0 || th) {
                s16x4 l00, h00, l01, h01, l10, h10, l11, h11;
                const unsigned va = vb + st * 8192;
                asm volatile("ds_read_b64_tr_b16 %0, %8\n\t"
                             "ds_read_b64_tr_b16 %1, %8 offset:2048\n\t"
                             "ds_read_b64_tr_b16 %2, %8 offset:64\n\t"
                             "ds_read_b64_tr_b16 %3, %8 offset:2112\n\t"
                             "ds_read_b64_tr_b16 %4, %8 offset:4096\n\t"
                             "ds_read_b64_tr_b16 %5, %8 offset:6144\n\t"
                             "ds_read_b64_tr_b16 %6, %8 offset:4160\n\t"
                             "ds_read_b64_tr_b16 %7, %8 offset:6208\n\t"
                             "s_waitcnt lgkmcnt(0)"
                             : "=&v"(l00), "=&v"(h00), "=&v"(l01), "=&v"(h01), "=&v"(l10), "=&v"(h10), "=&v"(l11), "=&v"(h11) : "v"(va) : "memory");
                const bf16x8 v00 = __builtin_shufflevector(l00, h00, 0, 1, 2, 3, 4, 5, 6, 7), v01 = __builtin_shufflevector(l01, h01, 0, 1, 2, 3, 4, 5, 6, 7);
                const bf16x8 v10 = __builtin_shufflevector(l10, h10, 0, 1, 2, 3, 4, 5, 6, 7), v11 = __builtin_shufflevector(l11, h11, 0, 1, 2, 3, 4, 5, 6, 7);
                const bf16x8 pb0 = (st == 0) ? pack_step<0>(x0) : pack_step<0>(x1);
                const bf16x8 pb1 = (st == 0) ? pack_step<1>(x0) : pack_step<1>(x1);
                o0 = MFMA32(v00, pb0, o0); o1 = MFMA32(v01, pb0, o1);
                o0 = MFMA32(v10, pb1, o0); o1 = MFMA32(v11, pb1, o1);
            }
        }
    }
    {
        const unsigned cb = (unsigned)(size_t)smem + 16384u + (unsigned)((8 * h5 + q4) * 256 + dvh * 128 + 32 * blk + 8 * p);
#pragma unroll
        for (int kp = 0; kp < 2; ++kp) {
            s16x4 l00, h00, l01, h01, l10, h10, l11, h11;
            const unsigned ca = cb + kp * 8192;
            asm volatile("ds_read_b64_tr_b16 %0, %8\n\t"
                         "ds_read_b64_tr_b16 %1, %8 offset:1024\n\t"
                         "ds_read_b64_tr_b16 %2, %8 offset:64\n\t"
                         "ds_read_b64_tr_b16 %3, %8 offset:1088\n\t"
                         "ds_read_b64_tr_b16 %4, %8 offset:4096\n\t"
                         "ds_read_b64_tr_b16 %5, %8 offset:5120\n\t"
                         "ds_read_b64_tr_b16 %6, %8 offset:4160\n\t"
                         "ds_read_b64_tr_b16 %7, %8 offset:5184\n\t"
                         "s_waitcnt lgkmcnt(0)"
                         : "=&v"(l00), "=&v"(h00), "=&v"(l01), "=&v"(h01), "=&v"(l10), "=&v"(h10), "=&v"(l11), "=&v"(h11) : "v"(ca) : "memory");
            const bf16x8 c00 = __builtin_shufflevector(l00, h00, 0, 1, 2, 3, 4, 5, 6, 7), c01 = __builtin_shufflevector(l01, h01, 0, 1, 2, 3, 4, 5, 6, 7);
            const bf16x8 c10 = __builtin_shufflevector(l10, h10, 0, 1, 2, 3, 4, 5, 6, 7), c11 = __builtin_shufflevector(l11, h11, 0, 1, 2, 3, 4, 5, 6, 7);
            o0 = MFMA32(c00, qw[2 * kp], o0); o1 = MFMA32(c01, qw[2 * kp], o1);
            o0 = MFMA32(c10, qw[2 * kp + 1], o0); o1 = MFMA32(c11, qw[2 * kp + 1], o1);
        }
    }
    const float inv = __builtin_amdgcn_rcpf(fmaxf(fabsf(den), em));
    float ss = 0.f;
#pragma unroll
    for (int i = 0; i < 16; ++i) { o0[i] *= inv; o1[i] *= inv; ss += o0[i] * o0[i] + o1[i] * o1[i]; }
    ss += shfl_xor_(ss, 32);
    if (h5 == 0) sqL[wid * 32 + r] = ss;
    __syncthreads();
    const float rr = rsqrtf((sqL[th * 32 + r] + sqL[(th + 2) * 32 + r]) * (1.f / 128.f) + 1e-6f);
    bf16_t* orow = MIXO + (t0 + t) * 1024 + h * 128 + dvh * 64 + 4 * h5;
#pragma unroll
    for (int d = 0; d < 2; ++d)
#pragma unroll
        for (int g = 0; g < 4; ++g) {
            const u32x2 zr = zrp[d][g];
            const f32x4 gv = gvp[d][g];
            const float z0 = bflo(zr.x), z1 = bfhi(zr.x), z2 = bflo(zr.y), z3 = bfhi(zr.y);
            const float y0 = (d ? o1[4 * g] : o0[4 * g]) * rr * gv[0] * sigmoidf_(z0), y1 = (d ? o1[4 * g + 1] : o0[4 * g + 1]) * rr * gv[1] * sigmoidf_(z1);
            const float y2 = (d ? o1[4 * g + 2] : o0[4 * g + 2]) * rr * gv[2] * sigmoidf_(z2), y3 = (d ? o1[4 * g + 3] : o0[4 * g + 3]) * rr * gv[3] * sigmoidf_(z3);
            *(u32x2*)(orow + d * 32 + 8 * g) = (u32x2){pk2(y0, y1), pk2(y2, y3)};
        }
}

constexpr size_t GD_WN = 0, GD_UU = GD_WN + (size_t)1024 * 16384, GD_KGT = GD_UU + (size_t)1024 * 16384, GD_QG = GD_KGT + (size_t)1024 * 16384,
                 GD_AT = GD_QG + (size_t)1024 * 16384, GD_GL = GD_AT + (size_t)1024 * 8192, GD_END = GD_GL + 4096;
static_assert(GD_END <= (size_t)MAXROWS * 256 * 2, "GDN chunk records must fit the HBUF region");

__device__ __forceinline__ void gdc_passA(int u, const bf16_t* GQ, const bf16_t* GK, const bf16_t* GV, const float* BETA, const float* GLOG, unsigned char* HB, const Ctx& c) {
    const int bh = u >> 5, b = bh >> 2, h = bh & 3;
    const size_t t0 = (size_t)b * SEQ + (u & 31) * 64;
    unsigned char* smem = c.smem;
    float* Lm = (float*)(smem + 49152);
    float* GA = (float*)(smem + 65536 + 64); float* BT = GA + 64; float* EG = BT + 64; float* EK = EG + 64;
    const int lane = c.lane, wid = __builtin_amdgcn_readfirstlane(c.wid);
    const int h5 = lane >> 5, r = lane & 31;
    if (wid == 0) {
        const float g = GLOG[(t0 + lane) * 4 + h];
        const float G = scan_add64(g, lane), Gl = shfl_c_(G, 63);
        GA[lane] = G; BT[lane] = BETA[(t0 + lane) * 4 + h]; EG[lane] = expf(G); EK[lane] = expf(Gl - G);
        if (lane == 0) ((float*)(HB + GD_GL))[u] = expf(Gl);
    }
    __syncthreads();
    if (wid < 3) {
        const int it = (wid + 1) >> 1, jt = wid >> 1;
        f32x16 dl, da;
#pragma unroll
        for (int i = 0; i < 16; ++i) { dl[i] = 0.f; da[i] = 0.f; }
        {
            bf16x8 kiv[8], kjv[8], qiv[8];
#pragma unroll
            for (int ks = 0; ks < 8; ++ks) {
                kiv[ks] = *(const bf16x8*)(GK + (t0 + 32 * it + r) * 512 + h * 128 + ks * 16 + h5 * 8);
                kjv[ks] = *(const bf16x8*)(GK + (t0 + 32 * jt + r) * 512 + h * 128 + ks * 16 + h5 * 8);
                qiv[ks] = *(const bf16x8*)(GQ + (t0 + 32 * it + r) * 512 + h * 128 + ks * 16 + h5 * 8);
            }
            asm volatile("" ::: "memory");
#pragma unroll
            for (int ks = 0; ks < 8; ++ks) { dl = MFMA32(kiv[ks], kjv[ks], dl); da = MFMA32(qiv[ks], kjv[ks], da); }
        }
        const int j = 32 * jt + r; const float Gj = GA[j];
        bf16_t* AT = (bf16_t*)(HB + GD_AT) + (size_t)u * 4096;
        float gav[16], btv[16];
#pragma unroll
        for (int i = 0; i < 16; ++i) { const int ii = 32 * it + (i & 3) + 8 * (i >> 2) + 4 * h5; gav[i] = GA[ii]; btv[i] = BT[ii]; }
        asm volatile("" ::: "memory");
#pragma unroll
        for (int i = 0; i < 16; ++i) {
            const int ii = 32 * it + (i & 3) + 8 * (i >> 2) + 4 * h5;
            const float dec = __expf(gav[i] - Gj);
            const float lv = dl[i] * btv[i] * dec, av = da[i] * dec;
            Lm[ii * 64 + j] = (j < ii) ? lv : 0.f;
            AT[ii * 64 + j] = (bf16_t)f2bf((j <= ii) ? av : 0.f);
        }
        if (wid == 0) {
#pragma unroll
            for (int i = 0; i < 16; ++i) { const int ii = (i & 3) + 8 * (i >> 2) + 4 * h5; Lm[ii * 64 + 32 + r] = 0.f; AT[ii * 64 + 32 + r] = 0; }
        }
    }
    __syncthreads();
    if (wid == 0) {
        float Tc[64];
        const LAS float* Ll = (const LAS float*)Lm;
        Tc[0] = (lane == 0) ? 1.f : 0.f;
#pragma unroll
        for (int i = 1; i < 64; ++i) {
            f32x4 rowv[16];
#pragma unroll
            for (int q = 0; q < 16; ++q) if (q * 4 < i) rowv[q] = *(const LAS f32x4*)(Ll + i * 64 + q * 4);
            asm volatile("" ::: "memory");
            float s = (i == lane) ? 1.f : 0.f;
#pragma unroll
            for (int k = 0; k < i; ++k) s -= rowv[k >> 2][k & 3] * Tc[k];
            Tc[i] = s;
        }
        bf16_t* Tm = (bf16_t*)Lm;
#pragma unroll
        for (int i = 0; i < 64; ++i) Tm[i * 64 + lane] = (bf16_t)f2bf(Tc[i]);
    } else {
        const int t3 = c.tid - 64;
        for (int idx = t3; idx < 4096; idx += 192) {
            const int arr = idx >> 10, rem = idx & 1023, row = rem >> 4, chk = rem & 15;
            const bf16_t* sp = ((arr == 1) ? GV : (arr == 3) ? GQ : GK) + (t0 + row) * 512 + h * 128 + chk * 8;
            const u32x4 raw = *(const u32x4*)sp; float f[8]; unpack8(raw, f);
            const float sc = (arr == 0) ? BT[row] * EG[row] : (arr == 1) ? BT[row] : (arr == 2) ? EK[row] : EG[row];
            const u32x4 o = (u32x4){pk2(f[0] * sc, f[1] * sc), pk2(f[2] * sc, f[3] * sc), pk2(f[4] * sc, f[5] * sc), pk2(f[6] * sc, f[7] * sc)};
            if (arr < 3) *(u32x4*)(smem + arr * 16384 + row * 256 + chk * 16) = o;
            else *(u32x4*)((bf16_t*)(HB + GD_QG) + (size_t)u * 8192 + row * 128 + chk * 8) = o;
        }
    }
    __syncthreads();
    {
        const int i16 = lane & 15, q4 = i16 >> 2, p = i16 & 3, blk = (lane >> 4) & 1;
        const unsigned char* Tm = smem + 49152;
        f32x16 u0, u1, w0, w1;
#pragma unroll
        for (int i = 0; i < 16; ++i) { u0[i] = 0.f; u1[i] = 0.f; w0[i] = 0.f; w1[i] = 0.f; }
        const unsigned ib = (unsigned)(size_t)smem + (unsigned)((8 * h5 + q4) * 256 + wid * 64 + 32 * blk + 8 * p);
#pragma unroll
        for (int ks = 0; ks < 4; ++ks) {
            s16x4 kl, kh, vl, vh;
            const unsigned ia = ib + ks * 4096;
            asm volatile("ds_read_b64_tr_b16 %0, %4\n\t"
                         "ds_read_b64_tr_b16 %1, %4 offset:1024\n\t"
                         "ds_read_b64_tr_b16 %2, %4 offset:16384\n\t"
                         "ds_read_b64_tr_b16 %3, %4 offset:17408\n\t"
                         "s_waitcnt lgkmcnt(0)"
                         : "=&v"(kl), "=&v"(kh), "=&v"(vl), "=&v"(vh) : "v"(ia) : "memory");
            const bf16x8 kb = __builtin_shufflevector(kl, kh, 0, 1, 2, 3, 4, 5, 6, 7), vb = __builtin_shufflevector(vl, vh, 0, 1, 2, 3, 4, 5, 6, 7);
            const bf16x8 t1 = *(const bf16x8*)(Tm + (32 + r) * 128 + ks * 32 + h5 * 16);
            w1 = MFMA32(t1, kb, w1); u1 = MFMA32(t1, vb, u1);
            if (ks < 2) { const bf16x8 tt0 = *(const bf16x8*)(Tm + r * 128 + ks * 32 + h5 * 16); w0 = MFMA32(tt0, kb, w0); u0 = MFMA32(tt0, vb, u0); }
        }
        bf16_t* WN = (bf16_t*)(HB + GD_WN) + (size_t)u * 8192; bf16_t* UU = (bf16_t*)(HB + GD_UU) + (size_t)u * 8192;
#pragma unroll
        for (int i = 0; i < 16; ++i) {
            const int s = (i & 3) + 8 * (i >> 2) + 4 * h5;
            WN[s * 128 + wid * 32 + r] = (bf16_t)f2bf(-w0[i]); WN[(32 + s) * 128 + wid * 32 + r] = (bf16_t)f2bf(-w1[i]);
        }
        {
            u32x4* up = (u32x4*)(UU + (size_t)(wid * 64 + lane) * 32);
            up[0] = (u32x4){pk2(u0[0], u0[1]), pk2(u0[2], u0[3]), pk2(u0[4], u0[5]), pk2(u0[6], u0[7])};
            up[1] = (u32x4){pk2(u0[8], u0[9]), pk2(u0[10], u0[11]), pk2(u0[12], u0[13]), pk2(u0[14], u0[15])};
            up[2] = (u32x4){pk2(u1[0], u1[1]), pk2(u1[2], u1[3]), pk2(u1[4], u1[5]), pk2(u1[6], u1[7])};
            up[3] = (u32x4){pk2(u1[8], u1[9]), pk2(u1[10], u1[11]), pk2(u1[12], u1[13]), pk2(u1[14], u1[15])};
        }
        bf16_t* KGT = (bf16_t*)(HB + GD_KGT) + (size_t)u * 8192;
        const int gq = lane >> 4;
        const unsigned kb0 = (unsigned)(size_t)smem + 32768u + (unsigned)(q4 * 256 + gq * 32 + 8 * p);
        {
            s16x4 kv[8];
#pragma unroll
            for (int it2 = 0; it2 < 8; ++it2) {
                const int job = wid * 8 + it2, s0 = (job & 15) * 4, dkb = (job >> 4) * 64;
                const unsigned ad = kb0 + s0 * 256 + dkb * 2;
                asm volatile("ds_read_b64_tr_b16 %0, %1" : "=&v"(kv[it2]) : "v"(ad) : "memory");
            }
            asm volatile("s_waitcnt lgkmcnt(0)" : "+v"(kv[0]), "+v"(kv[1]), "+v"(kv[2]), "+v"(kv[3]), "+v"(kv[4]), "+v"(kv[5]), "+v"(kv[6]), "+v"(kv[7]) :: "memory");
#pragma unroll
            for (int it2 = 0; it2 < 8; ++it2) {
                const int job = wid * 8 + it2, s0 = (job & 15) * 4, dkb = (job >> 4) * 64;
                *(s16x4*)(KGT + (size_t)(dkb + gq * 16 + i16) * 64 + s0) = kv[it2];
            }
        }
    }
}

constexpr size_t GC_ST = 0, GC_VT = (size_t)1024 * 32768;
__device__ __forceinline__ void gdc_passB(int bh, const unsigned char* HB, unsigned char* YB, const Ctx& c) {
    const int lane = c.lane, wid = __builtin_amdgcn_readfirstlane(c.wid);
    const int h5 = lane >> 5, r = lane & 31;
    unsigned char* smem = c.smem;
    f32x16 S0, S1, S2, S3;
#pragma unroll
    for (int i = 0; i < 16; ++i) { S0[i] = 0.f; S1[i] = 0.f; S2[i] = 0.f; S3[i] = 0.f; }
    const size_t u0 = (size_t)bh * 32;
#define GB_STAGE(n_, p_) do { const bf16_t* wn_ = (const bf16_t*)(HB + GD_WN) + (u0 + (n_)) * 8192; const bf16_t* kg_ = (const bf16_t*)(HB + GD_KGT) + (u0 + (n_)) * 8192; \
        unsigned char* bp_ = smem + (p_) * 32768; \
        _Pragma("unroll") for (int i = 0; i < 4; ++i) { const int jj = wid * 4 + i, row = 4 * jj + (lane >> 4), ch = (lane & 15) ^ (row & 15); \
            glds16(wn_ + row * 128 + ch * 8, bp_ + jj * 1024 + lane * 16); } \
        _Pragma("unroll") for (int i = 0; i < 4; ++i) { const int jj = wid * 4 + i, row = 8 * jj + (lane >> 3), ch = (lane & 7) ^ ((row >> 1) & 7); \
            glds16(kg_ + row * 64 + ch * 8, bp_ + 16384 + jj * 1024 + lane * 16); } } while (0)
#define LD128(base_, R_, ks_) __builtin_shufflevector(*(const s16x4*)((base_) + (R_) * 256 + (((2 * (ks_)) ^ (rl & 15)) << 4) + 8 * hl), \
                                                      *(const s16x4*)((base_) + (R_) * 256 + (((2 * (ks_) + 1) ^ (rl & 15)) << 4) + 8 * hl), 0, 1, 2, 3, 4, 5, 6, 7)
#define LD64(base_, R_, k2_) __builtin_shufflevector(*(const s16x4*)((base_) + (R_) * 128 + (((2 * (k2_)) ^ ((rl >> 1) & 7)) << 4) + 8 * hl), \
                                                     *(const s16x4*)((base_) + (R_) * 128 + (((2 * (k2_) + 1) ^ ((rl >> 1) & 7)) << 4) + 8 * hl), 0, 1, 2, 3, 4, 5, 6, 7)
    u32x4 uu[4];
#define GB_LOADU(n_) do { const u32x4* up_ = (const u32x4*)((const bf16_t*)(HB + GD_UU) + (u0 + (n_)) * 8192 + (size_t)(wid * 64 + lane) * 32); \
        uu[0] = up_[0]; uu[1] = up_[1]; uu[2] = up_[2]; uu[3] = up_[3]; } while (0)
    float* glL = (float*)(smem + 65536 + 64);
    __syncthreads();
    if (c.tid < 32) glL[c.tid] = ((const float*)(HB + GD_GL))[u0 + c.tid];
    GB_STAGE(0, 0);
    GB_LOADU(0);
#pragma unroll 1
    for (int n2 = 0; n2 < 16; ++n2) {
#pragma unroll
        for (int PBUF = 0; PBUF < 2; ++PBUF) {
        const int n = 2 * n2 + PBUF;
        const float gl = glL[n];
        if (n == 0) asm volatile("s_waitcnt vmcnt(0)" ::: "memory"); else asm volatile("s_waitcnt vmcnt(24)" ::: "memory");
        asm volatile("s_waitcnt lgkmcnt(0)" ::: "memory"); __builtin_amdgcn_s_barrier(); asm volatile("" ::: "memory");
        f32x16 v0, v1;
#pragma unroll
        for (int q = 0; q < 2; ++q) {
            const u32x4 a = uu[q], bq = uu[2 + q];
            v0[8 * q + 0] = bflo(a.x); v0[8 * q + 1] = bfhi(a.x); v0[8 * q + 2] = bflo(a.y); v0[8 * q + 3] = bfhi(a.y);
            v0[8 * q + 4] = bflo(a.z); v0[8 * q + 5] = bfhi(a.z); v0[8 * q + 6] = bflo(a.w); v0[8 * q + 7] = bfhi(a.w);
            v1[8 * q + 0] = bflo(bq.x); v1[8 * q + 1] = bfhi(bq.x); v1[8 * q + 2] = bflo(bq.y); v1[8 * q + 3] = bfhi(bq.y);
            v1[8 * q + 4] = bflo(bq.z); v1[8 * q + 5] = bfhi(bq.z); v1[8 * q + 6] = bflo(bq.w); v1[8 * q + 7] = bfhi(bq.w);
        }
        if (n + 1 < 32) { GB_STAGE(n + 1, (PBUF ^ 1)); GB_LOADU(n + 1); }
        int rl = r, hl = h5; asm volatile("" : "+v"(rl), "+v"(hl));
        const unsigned char* WNb = smem + PBUF * 32768; const unsigned char* KGb = WNb + 16384;
        {
            bf16_t* st = (bf16_t*)(YB + GC_ST) + (u0 + n) * 16384 + (size_t)h5 * 512 + (size_t)(wid * 32 + r) * 4;
#define ST_TILE(SX, dt_) do { _Pragma("unroll") for (int g = 0; g < 4; ++g) \
                *(u32x2*)(st + ((dt_) * 8 + 2 * g) * 512) = (u32x2){cvt_pk(SX[4 * g], SX[4 * g + 1]), cvt_pk(SX[4 * g + 2], SX[4 * g + 3])}; } while (0)
            ST_TILE(S0, 0); ST_TILE(S1, 1); ST_TILE(S2, 2); ST_TILE(S3, 3);
#undef ST_TILE
        }
        {
            bf16x8 fa0, fb0, fa1, fb1, fa2, fb2;
#define LDV(FA, FB, ks_) do { FA = LD128(WNb, rl, ks_); FB = LD128(WNb, 32 + rl, ks_); } while (0)
#define MMV(SX, HF, FA, FB) do { const bf16x8 sbk = pack_step<HF>(SX); v0 = MFMA32(FA, sbk, v0); v1 = MFMA32(FB, sbk, v1); } while (0)
            LDV(fa0, fb0, 0); LDV(fa1, fb1, 1); LDV(fa2, fb2, 2);
            MMV(S0, 0, fa0, fb0); LDV(fa0, fb0, 3);
            MMV(S0, 1, fa1, fb1); LDV(fa1, fb1, 4);
            MMV(S1, 0, fa2, fb2); LDV(fa2, fb2, 5);
            MMV(S1, 1, fa0, fb0); LDV(fa0, fb0, 6);
            MMV(S2, 0, fa1, fb1); LDV(fa1, fb1, 7);
            MMV(S2, 1, fa2, fb2);
            MMV(S3, 0, fa0, fb0);
            MMV(S3, 1, fa1, fb1);
#undef LDV
#undef MMV
        }
        const bf16x8 vb0 = pack_step_m<0>(v0), vb1 = pack_step_m<1>(v0), vb2 = pack_step_m<0>(v1), vb3 = pack_step_m<1>(v1);
        {
            bf16_t* vt = (bf16_t*)(YB + GC_VT) + (u0 + n) * 8192 + (size_t)h5 * 512 + (size_t)(wid * 32 + r) * 4;
            const u32x4 p0 = __builtin_bit_cast(u32x4, vb0), p1 = __builtin_bit_cast(u32x4, vb1), p2 = __builtin_bit_cast(u32x4, vb2), p3 = __builtin_bit_cast(u32x4, vb3);
            *(u32x2*)(vt + 0 * 512) = (u32x2){p0.x, p0.y};  *(u32x2*)(vt + 2 * 512) = (u32x2){p0.z, p0.w};
            *(u32x2*)(vt + 4 * 512) = (u32x2){p1.x, p1.y};  *(u32x2*)(vt + 6 * 512) = (u32x2){p1.z, p1.w};
            *(u32x2*)(vt + 8 * 512) = (u32x2){p2.x, p2.y};  *(u32x2*)(vt + 10 * 512) = (u32x2){p2.z, p2.w};
            *(u32x2*)(vt + 12 * 512) = (u32x2){p3.x, p3.y}; *(u32x2*)(vt + 14 * 512) = (u32x2){p3.z, p3.w};
        }
        asm volatile("" ::: "memory"); asm volatile("" : "+v"(rl), "+v"(hl));
        S0 *= gl; S1 *= gl; S2 *= gl; S3 *= gl;
        {
            bf16x8 g0, g1, g2;
            g0 = LD64(KGb, rl, 0); g1 = LD64(KGb, rl, 1); g2 = LD64(KGb, rl, 2);
            S0 = MFMA32(g0, vb0, S0); g0 = LD64(KGb, rl, 3);
            S0 = MFMA32(g1, vb1, S0); g1 = LD64(KGb, 32 + rl, 0);
            S0 = MFMA32(g2, vb2, S0); g2 = LD64(KGb, 32 + rl, 1);
            S0 = MFMA32(g0, vb3, S0); g0 = LD64(KGb, 32 + rl, 2);
            S1 = MFMA32(g1, vb0, S1); g1 = LD64(KGb, 32 + rl, 3);
            S1 = MFMA32(g2, vb1, S1); g2 = LD64(KGb, 64 + rl, 0);
            S1 = MFMA32(g0, vb2, S1); g0 = LD64(KGb, 64 + rl, 1);
            S1 = MFMA32(g1, vb3, S1); g1 = LD64(KGb, 64 + rl, 2);
            S2 = MFMA32(g2, vb0, S2); g2 = LD64(KGb, 64 + rl, 3);
            S2 = MFMA32(g0, vb1, S2); g0 = LD64(KGb, 96 + rl, 0);
            S2 = MFMA32(g1, vb2, S2); g1 = LD64(KGb, 96 + rl, 1);
            S2 = MFMA32(g2, vb3, S2); g2 = LD64(KGb, 96 + rl, 2);
            S3 = MFMA32(g0, vb0, S3); g0 = LD64(KGb, 96 + rl, 3);
            S3 = MFMA32(g1, vb1, S3);
            S3 = MFMA32(g2, vb2, S3);
            S3 = MFMA32(g0, vb3, S3);
        }
        }
    }
#undef GB_STAGE
#undef LD128
#undef LD64
#undef GB_LOADU
}

__device__ __forceinline__ void gdc_passB_idle() {
    __syncthreads();
    for (int n = 0; n < 32; ++n) { asm volatile("" ::: "memory"); __builtin_amdgcn_s_barrier(); asm volatile("" ::: "memory"); }
}

__device__ __forceinline__ void gdc_passC(int u, const unsigned char* HB, const unsigned char* YB, const bf16_t* PROJ, const float* gnorm, bf16_t* MIXO, const Ctx& c) {
    const int bh = u >> 5, b = bh >> 2, h = bh & 3;
    const size_t t0 = (size_t)b * SEQ + (u & 31) * 64;
    const int lane = c.lane, wid = __builtin_amdgcn_readfirstlane(c.wid);
    const int h5 = lane >> 5, r = lane & 31;
    float* sqL = (float*)c.smem;
    const bf16_t* ST = (const bf16_t*)(YB + GC_ST) + (size_t)u * 16384 + (size_t)(2 * h5) * 512 + (size_t)(wid * 32 + r) * 4;
    const bf16_t* VT = (const bf16_t*)(YB + GC_VT) + (size_t)u * 8192 + (size_t)(2 * h5) * 512 + (size_t)(wid * 32 + r) * 4;
    const bf16_t* QG = (const bf16_t*)(HB + GD_QG) + (size_t)u * 8192 + (size_t)r * 128 + 8 * h5;
    const bf16_t* AT = (const bf16_t*)(HB + GD_AT) + (size_t)u * 4096 + (size_t)r * 64 + 8 * h5;
    u32x2 zrv[2][4]; f32x4 gvv[4];
#pragma unroll
    for (int tt = 0; tt < 2; ++tt)
#pragma unroll
        for (int g = 0; g < 4; ++g) zrv[tt][g] = *(const u32x2*)(PROJ + (t0 + tt * 32 + r) * NPAD + 1960 + h * 128 + wid * 32 + 4 * h5 + 8 * g);
#pragma unroll
    for (int g = 0; g < 4; ++g) gvv[g] = *(const f32x4*)(gnorm + wid * 32 + 4 * h5 + 8 * g);
    f32x16 o0, o1;
#pragma unroll
    for (int i = 0; i < 16; ++i) { o0[i] = 0.f; o1[i] = 0.f; }
    {
        s16x4 sal[8], sah[8], val[4], vah[4]; bf16x8 q0v[8], q1v[8], a1v[4], a0v[2];
#pragma unroll
        for (int ks = 0; ks < 8; ++ks) { sal[ks] = *(const s16x4*)(ST + (4 * ks) * 512); sah[ks] = *(const s16x4*)(ST + (4 * ks + 1) * 512);
                                         q0v[ks] = *(const bf16x8*)(QG + ks * 16); q1v[ks] = *(const bf16x8*)(QG + 32 * 128 + ks * 16); }
#pragma unroll
        for (int k2 = 0; k2 < 4; ++k2) { val[k2] = *(const s16x4*)(VT + (4 * k2) * 512); vah[k2] = *(const s16x4*)(VT + (4 * k2 + 1) * 512); a1v[k2] = *(const bf16x8*)(AT + 32 * 64 + k2 * 16); }
        a0v[0] = *(const bf16x8*)(AT); a0v[1] = *(const bf16x8*)(AT + 16);
        asm volatile("" ::: "memory");
#pragma unroll
        for (int ks = 0; ks < 8; ++ks) {
            const bf16x8 sa = __builtin_shufflevector(sal[ks], sah[ks], 0, 1, 2, 3, 4, 5, 6, 7);
            o0 = MFMA32(sa, q0v[ks], o0); o1 = MFMA32(sa, q1v[ks], o1);
        }
#pragma unroll
        for (int k2 = 0; k2 < 4; ++k2) {
            const bf16x8 va = __builtin_shufflevector(val[k2], vah[k2], 0, 1, 2, 3, 4, 5, 6, 7);
            o1 = MFMA32(va, a1v[k2], o1);
            if (k2 < 2) o0 = MFMA32(va, a0v[k2], o0);
        }
    }
    float s0 = 0.f, s1 = 0.f;
#pragma unroll
    for (int i = 0; i < 16; ++i) { s0 += o0[i] * o0[i]; s1 += o1[i] * o1[i]; }
    s0 += shfl_xor_(s0, 32); s1 += shfl_xor_(s1, 32);
    __syncthreads();
    if (h5 == 0) { sqL[wid * 64 + r] = s0; sqL[wid * 64 + 32 + r] = s1; }
    __syncthreads();
    const float rr0 = rsqrtf((sqL[r] + sqL[64 + r] + sqL[128 + r] + sqL[192 + r]) * (1.f / 128.f) + 1e-6f);
    const float rr1 = rsqrtf((sqL[32 + r] + sqL[96 + r] + sqL[160 + r] + sqL[224 + r]) * (1.f / 128.f) + 1e-6f);
#pragma unroll
    for (int tt = 0; tt < 2; ++tt) {
        const size_t t = t0 + tt * 32 + r;
        const bf16_t* zrow = PROJ + t * NPAD + 1960 + h * 128 + wid * 32 + 4 * h5;
        const float* gn = gnorm + wid * 32 + 4 * h5;
        bf16_t* orow = MIXO + t * 1024 + 512 + h * 128 + wid * 32 + 4 * h5;
        const float rr = tt ? rr1 : rr0;
#pragma unroll
        for (int g = 0; g < 4; ++g) {
            const u32x2 zr = zrv[tt][g];
            const f32x4 gv = gvv[g];
            const float z0 = bflo(zr.x), z1 = bfhi(zr.x), z2 = bflo(zr.y), z3 = bfhi(zr.y);
            const float y0 = (tt ? o1[4 * g] : o0[4 * g]) * rr * gv[0] * siluf_(z0), y1 = (tt ? o1[4 * g + 1] : o0[4 * g + 1]) * rr * gv[1] * siluf_(z1);
            const float y2 = (tt ? o1[4 * g + 2] : o0[4 * g + 2]) * rr * gv[2] * siluf_(z2), y3 = (tt ? o1[4 * g + 3] : o0[4 * g + 3]) * rr * gv[3] * siluf_(z3);
            *(u32x2*)(orow + 8 * g) = (u32x2){pk2(y0, y1), pk2(y2, y3)};
        }
    }
}

__device__ __forceinline__ void phase_post(const float* OG, const bf16_t* PROJ, const float* gain, bool odd, bf16_t* MIXO, const Ctx& c) {
    const int lane = c.lane;
    const int gcol = odd ? 1032 : 1960, ocol = odd ? 0 : 512;
    for (int t = c.bid * 4 + c.wid; t < T; t += c.nblk * 4) {
        const f32x4 a0 = *(const f32x4*)(OG + (size_t)t * 512 + lane * 8), a1 = *(const f32x4*)(OG + (size_t)t * 512 + lane * 8 + 4);
        float ss = (a0[0] * a0[0] + a0[1] * a0[1]) + (a0[2] * a0[2] + a0[3] * a0[3]) + (a1[0] * a1[0] + a1[1] * a1[1]) + (a1[2] * a1[2] + a1[3] * a1[3]);
        ss = red16(ss);
        const float rr = rsqrtf(ss * (1.f / 128.f) + 1e-6f);
        const u32x4 zr = *(const u32x4*)(PROJ + (size_t)t * NPAD + gcol + lane * 8);
        float z[8]; unpack8(zr, z);
        const int gi = odd ? lane * 8 : (lane & 15) * 8;
        const f32x4 g0 = *(const f32x4*)(gain + gi), g1 = *(const f32x4*)(gain + gi + 4);
        float y[8];
#pragma unroll
        for (int j = 0; j < 4; ++j) {
            const float ga = odd ? sigmoidf_(z[j]) : siluf_(z[j]), gb = odd ? sigmoidf_(z[4 + j]) : siluf_(z[4 + j]);
            y[j] = a0[j] * rr * g0[j] * ga; y[4 + j] = a1[j] * rr * g1[j] * gb;
        }
        *(u32x4*)(MIXO + (size_t)t * 1024 + ocol + lane * 8) = (u32x4){pk2(y[0], y[1]), pk2(y[2], y[3]), pk2(y[4], y[5]), pk2(y[6], y[7])};
    }
}

__global__ void __launch_bounds__(512, 2) fwd(Args a) {
    extern __shared__ __attribute__((aligned(16))) unsigned char smem[];
    Ctx c;
    const int wave_s = __builtin_amdgcn_readfirstlane((int)threadIdx.x >> 6);
#define SET_CTX(cx) do { int t_ = (wave_s << 6) | lane_id_v(); cx.tid0 = t_; cx.half = t_ >> 8; cx.tid = t_ & 255; cx.lane = t_ & 63; cx.wid = (t_ >> 6) & 3; \
        cx.wr = cx.wid >> 1; cx.wc = cx.wid & 1; cx.fr = cx.lane & 15; cx.fq = cx.lane >> 4; cx.bid = blockIdx.x * 2 + cx.half; cx.nblk = gridDim.x * 2; \
        cx.smem0 = smem; cx.smem = smem + cx.half * HALF_LDS; } while (0)
    SET_CTX(c);
#define PH_CTX() SET_CTX(c)
    unsigned char* const ws_base = a.ws;
    const void* const* const ain_base = (const void* const*)__builtin_amdgcn_kernarg_segment_ptr();
    unsigned* ctl = (unsigned*)(ws_base + WS_CTL);
    volatile LAS unsigned* xbw = (volatile LAS unsigned*)(smem + LDS_BLK);
    if (c.tid0 < 8) xbw[c.tid0] = 0u;
    __syncthreads();
    XcdBarrier bar; bar.bar = ctl; bar.x = 0; bar.st = xbw; bar.wave = wave_s;
    if (a.use_bar) bar = xcd_barrier_post(ctl, xbw, c.tid0);
#if ONE_LAUNCH
    const int hi = NPH;
#define IN(k) true
#else
    const int lo = a.ph_lo, hi = a.ph_hi;
#define IN(k) (lo <= (k) && (k) < hi)
#endif
#define PH(k) if (IN(k)) { PH_CTX(); unsigned char* ws = ws_base; const void* const* ain = ain_base; int gdx = (int)gridDim.x; asm volatile("" : "+s"(ws), "+s"(ain), "+s"(gdx));
#define UNIT_CTX() Ctx cu; SET_CTX(cu)
#define SEAM(k) do { if ((k) + 1 < hi) xcd_barrier(bar); } while (0)

#define XBF ((bf16_t*)(ws + WS_XBF))
#define X1 ((float*)(ws + WS_X1))
#define PROJ ((bf16_t*)(ws + U_PROJ))
#define GATES ((float*)(ws + U_GATES))
#define MIXO ((bf16_t*)(ws + U_MIXO))
#define YBUF ((float*)(ws + U_YBUF))
#define ROPEM ((const float*)(ws + WS_ROPEM))
#define ROPES ((const float*)(ws + WS_ROPES))
#define XRES ((layer == 0) ? (const float*)ain[0] : (const float*)a.out)
#define CNT (ctl + CW_CNT + layer * 128)
#define WIN ((const bf16_t*)(ws + WS_WIN) + (size_t)layer * WIN_ELEMS)
#define WOUT ((const bf16_t*)(ws + WS_WOUT) + (size_t)layer * WOUT_ELEMS)

    PH(0) for (int rep = 0; rep < REP_PRO; ++rep) phase_prologue(a, c); SEAM(0); }

    for (int layer = 0; layer < 4; ++layer) {
        const int pb = 1 + layer * PPL;
#if !ONE_LAUNCH
        if (pb >= hi || pb + PPL <= lo) continue;
#endif
        const int jj = layer >> 1;
        const bool odd = (layer & 1) != 0;

        PH(pb + 0) {
                DenseSched S{T / 256, NPAD / 256, 1024, (int)blockIdx.x, gdx};
                if ((INP_F8 == 1) || (INP_F8 == 2 && odd) || (INP_F8 == 3 && !odd)) {
                    EpiIn<true> E{PROJ, GATES, odd ? 1024 : 1952};
                    g8::phase<1, false, true>(smem, (const char*)(ws + WS_X1 + XB8I_OFF), (const char*)(ws + WS_WIN) + (size_t)layer * 2 * WIN_ELEMS, 512, S, E, (wave_s << 6) | lane_id_v());
                } else {
                    EpiIn<false> E{PROJ, GATES, odd ? 1024 : 1952};
                    g8::phase<1, false, false>(smem, (const char*)XBF, (const char*)WIN, 1024, S, E, (wave_s << 6) | lane_id_v());
                }
            }
            SEAM(pb + 0); }
        PH(pb + 1) for (int rp = 0; rp < ((REP_PHASE == 1) ? 2 : 1); ++rp) { if (rp) xcd_barrier(bar);
            if (!odd) phase_prep_even(PROJ, GATES, (const float*)ain[3] + jj * 256, (const float*)ain[5] + jj * 128, (const float*)ain[7] + jj * 4 * 1536,
                                      (const float*)ain[8] + jj * 4, (const float*)ain[9] + jj * 4, ROPEM,
                                      (bf16_t*)(ws + U_CQ), (bf16_t*)(ws + U_CKV), (bf16_t*)(ws + U_KROPE), (bf16_t*)(ws + U_GQ), (bf16_t*)(ws + U_GK), (bf16_t*)(ws + U_GV),
                                      (float*)(ws + U_BETA), (float*)(ws + U_GLOG), c);
            else {
                phase_prep_odd(PROJ, ROPES, (bf16_t*)(ws + U_QF), (bf16_t*)(ws + U_KN), c);
                unsigned* ctr = ctl + CW_WORK + pb + 1 + 64 * rp;
#if STATIC_UNIFORM
                (void)ctr;
                for (int p_ = (int)blockIdx.x; p_ < 512; p_ += gdx) {
                    UNIT_CTX(); const int u = p_ * 2 + cu.half;
                    __syncthreads();
                    mlc_passA(u, PROJ, GATES, (const float*)ain[13] + jj * 4, (const float*)ain[14] + jj * 4, (unsigned char*)YBUF, cu);
                }
#else
                for (;;) {
                    const int u = next_unit(ctr, c); UNIT_CTX();
                    if (u >= 1024) break;
                    mlc_passA(u, PROJ, GATES, (const float*)ain[13] + jj * 4, (const float*)ain[14] + jj * 4, (unsigned char*)YBUF, cu);
                }
#endif
            }
            }
            SEAM(pb + 1);
        }
        PH(pb + 2) for (int rp = 0; rp < ((REP_PHASE == 2) ? 2 : 1); ++rp) { if (rp) xcd_barrier(bar);
            unsigned* ctr = ctl + CW_WORK + pb + 2 + 64 * rp;
            if (!odd) {
                const int ncp = DEFER_CONV ? CVU_PER_LAYER : 0, tpairs = (1024 + MLAUP_TILES) / 2 + ncp;
                for (;;) {
                    const int uq = next_unit(ctr, c); UNIT_CTX();
                    if (uq >= 2 * tpairs) break;
                    const int pj = uq >> 1, tsp = tpairs - 192, pa = pj < tsp ? pj : tsp, pb_ = pj + 1 < tsp ? pj + 1 : tsp;
                    const int cb0 = (pa * ncp) / tsp, cb1 = (pb_ * ncp) / tsp;
                    if (cb1 > cb0) { const int cvu = cb0 * 2 + (uq & 1); conv_unit(cvu % CVU_PER_LAYER, layer + cvu / CVU_PER_LAYER, ain, ws, cu); continue; }
                    const int u = (pj - cb0) * 2 + (uq & 1);
                    if (u < 1024) gdc_passA(u, (const bf16_t*)(ws + U_GQ), (const bf16_t*)(ws + U_GK), (const bf16_t*)(ws + U_GV), (const float*)(ws + U_BETA),
                                            (const float*)(ws + U_GLOG), ws + WS_HBUF, cu);
                    else mla_up_tile(u - 1024, (const bf16_t*)(ws + U_CQ), (const bf16_t*)(ws + WS_WQB) + (size_t)jj * WQB_ELEMS, (const bf16_t*)(ws + U_CKV),
                                     (const bf16_t*)(ws + WS_WKVB) + (size_t)jj * WKVB_ELEMS, ROPEM, (bf16_t*)(ws + U_QF), (bf16_t*)(ws + U_KN), (bf16_t*)(ws + U_VV), cu);
                }
            } else {
                for (;;) {
                    const int u = next_unit(ctr, c); UNIT_CTX();
                    if (u >= 256 + 1024) break;
                    if (u < 256) mlc_passB(u, (unsigned char*)YBUF, cu);
                    else {
                        const int v = u - 256, hq = v & 7, n = (v >> 3) & 15, b = v >> 7, kvh = hq >> 2;
                        const size_t tb = (size_t)b * SEQ;
                        attn_unit<4, true>((const bf16_t*)(ws + U_QF) + tb * 512 + hq * 64, 512, (const bf16_t*)(ws + U_KN) + tb * 128 + kvh * 64, 128,
                                           (const bf16_t*)(ws + U_KN), 0, PROJ + tb * NPAD + 2184 + kvh * 64, NPAD,
                                           MIXO + tb * 1024 + 512 + hq * 64, 1024, n * 128, ((const float*)ain[16])[jj * 8 + hq] * 1.4426950408889634f, cu);
                    }
                }
            }
            }
            SEAM(pb + 2);
        }
        PH(pb + 3) for (int rp = 0; rp < ((REP_PHASE == 3) ? 2 : 1); ++rp) { if (rp) xcd_barrier(bar);
            unsigned* ctr = ctl + CW_WORK + pb + 3 + 64 * rp;
            if (!odd) {
                const int ncp = 0, tpairs = 512 + ncp;
                for (;;) {
                    const int u = next_unit(ctr, c); UNIT_CTX();
                    if (u >= 64 + 2 * tpairs) break;
                    if (rp > 0 && ((REP_ONLY == 1 && u >= 64) || (REP_ONLY == 2 && u < 64))) continue;
                    if (u < 64) { if ((u & 1) == 0) gdc_passB(u >> 1, ws + WS_HBUF, (unsigned char*)YBUF, cu); else gdc_passB_idle(); }
                    else {
                        const int j_ = u - 64, pj = j_ >> 1, cb0 = (pj * ncp) / tpairs, cb1 = ((pj + 1) * ncp) / tpairs;
                        if (cb1 > cb0) { const int cvu = cb0 * 2 + (j_ & 1); conv_unit(cvu, layer + 1, ain, ws, cu); continue; }
                        const int v = (pj - cb0) * 2 + (j_ & 1), qb = 15 - (v >> 6), bh = v & 63, b = bh >> 3, hh = bh & 7;
                        const size_t tb = (size_t)b * SEQ;
                        attn_unit<6, false>((const bf16_t*)(ws + U_QF) + tb * 768 + hh * 96, 768, (const bf16_t*)(ws + U_KN) + tb * 512 + hh * 64, 512,
                                            (const bf16_t*)(ws + U_KROPE) + tb * 32, 32, (const bf16_t*)(ws + U_VV) + tb * 512 + hh * 64, 512,
                                            MIXO + tb * 1024 + hh * 64, 1024, qb * 128, 0.f, cu);
                    }
                }
            } else {
#if STATIC_UNIFORM
                for (int p_ = (int)blockIdx.x; p_ < 512; p_ += gdx) {
                    UNIT_CTX(); const int u = p_ * 2 + cu.half;
                    __syncthreads();
                    mlc_passC(u, PROJ, GATES, (const float*)ain[13] + jj * 4, (const float*)ain[14] + jj * 4, (const unsigned char*)YBUF, (const float*)ain[15] + jj * 512, MIXO, cu);
                }
#else
                for (;;) {
                    const int u = next_unit(ctr, c); UNIT_CTX();
                    if (u >= 1024) break;
                    mlc_passC(u, PROJ, GATES, (const float*)ain[13] + jj * 4, (const float*)ain[14] + jj * 4, (const unsigned char*)YBUF, (const float*)ain[15] + jj * 512, MIXO, cu);
                }
#endif
            }
            }
            SEAM(pb + 3);
        }
        PH(pb + 4) for (int rp = 0; rp < ((REP_PHASE == 4) ? 2 : 1); ++rp) { if (rp) xcd_barrier(bar);
            if (!odd) {
                unsigned* ctr = ctl + CW_WORK + pb + 4 + 64 * rp;
#if STATIC_UNIFORM
                (void)ctr;
                for (int p_ = (int)blockIdx.x; p_ < 512; p_ += gdx) {
                    UNIT_CTX(); const int u = p_ * 2 + cu.half;
                    __syncthreads();
                    gdc_passC(u, ws + WS_HBUF, (const unsigned char*)YBUF, PROJ, (const float*)ain[10] + jj * 128, MIXO, cu);
                }
#else
                for (;;) {
                    const int u = next_unit(ctr, c); UNIT_CTX();
                    if (u >= 1024) break;
                    gdc_passC(u, ws + WS_HBUF, (const unsigned char*)YBUF, PROJ, (const float*)ain[10] + jj * 128, MIXO, cu);
                }
#endif
            }
            }
            if (!odd) SEAM(pb + 4);
        }
        PH(pb + 5) {
                DenseSched S{T / 256, 4, 1024, (int)blockIdx.x, gdx};
                EpiOut E{XBF, (bf16_t*)YBUF};
                g8::phase<1, false, false>(smem, (const char*)MIXO, (const char*)WOUT, 1024, S, E, c.tid0);
            }
            SEAM(pb + 5); }
#if FUSE_LNROUTE
        PH(pb + 6) phase_lnroute((const bf16_t*)YBUF, (const float*)ain[18] + layer * 1024, (const float*)ain[19] + layer * 1024, XBF, (unsigned char*)(ws + WS_X1), (const bf16_t*)(ws + WS_WRT) + (size_t)layer * WRT_ELEMS,
                                 (const float*)ain[21] + layer * 64, CNT, (int*)(ws + WS_LTOK), (float*)(ws + WS_LW), (int*)(ws + WS_ASG), (float*)(ws + WS_ASGW), c); SEAM(pb + 8); }
#else
        PH(pb + 6) for (int rep = 0; rep < REP_TOK; ++rep) phase_ln1((const bf16_t*)YBUF, (const float*)ain[18] + layer * 1024, (const float*)ain[19] + layer * 1024, XBF, c); SEAM(pb + 6); }
        PH(pb + 7) for (int rep = 0; rep < REP_GEMM; ++rep) phase_router(XBF, (const bf16_t*)(ws + WS_WRT) + (size_t)layer * WRT_ELEMS, (float*)(ws + WS_LOG), c); SEAM(pb + 7); }
        PH(pb + 8) phase_route((const float*)(ws + WS_LOG), (const float*)ain[21] + layer * 64, CNT, (int*)(ws + WS_LTOK), (float*)(ws + WS_LW), (int*)(ws + WS_ASG), (float*)(ws + WS_ASGW), c); SEAM(pb + 8); }
#endif
        PH(pb + 9) {
                int* bst8 = (int*)(smem + LDS_BLK + 64); int* eb8 = bst8 + 256;
                build_block_table(CNT, bst8, c);
                if (c.tid0 < 65) { const int e_ = c.tid0; for (int rb = bst8[e_]; rb < bst8[e_ + 1]; ++rb) eb8[rb] = e_; }
                __syncthreads();
                MoeSchedG S{__builtin_amdgcn_readfirstlane(bst8[65]), (int)blockIdx.x, gdx, eb8, bst8, (const int*)(ws + WS_LTOK), MOE1_F8 ? 1024u : 2048u};
#if MOE2_F8
                EpiMoe1F8 E{(unsigned char*)(ws + WS_HBUF)};
#else
                EpiMoe1 E{(bf16_t*)(ws + WS_HBUF)};
#endif
#if MOE1_F8
                g8::phase<0, true, true>(smem, (const char*)(ws + WS_X1), (const char*)(ws + WS_WGU) + (size_t)layer * 65 * WGU_ELEMS, 512, S, E, c.tid0);
#else
                g8::phase<0, true, false>(smem, (const char*)XBF, (const char*)((const bf16_t*)(ws + WS_WGU) + (size_t)layer * 65 * WGU_ELEMS), 1024, S, E, c.tid0);
#endif
            }
            SEAM(pb + 9); }
        PH(pb + 10)
#if MOE2_G8
            {
                int* bst8 = (int*)(smem + LDS_BLK + 64); int* eb8 = bst8 + 256;
                MoeSched S{__builtin_amdgcn_readfirstlane(bst8[65]), 4, (int)blockIdx.x, gdx, eb8};
#if Y_FP8
                EpiMoe2F8 E{(unsigned char*)(ws + U_Y)};
#else
                EpiMoe2 E{(bf16_t*)(ws + U_Y)};
#endif
                #if MOE2_F8
                g8::phase<2, false, true, MoeSched, EpiMoe2F8, true>(smem, (const char*)(ws + WS_HBUF), (const char*)(ws + WS_WDN) + (size_t)layer * 65 * WDN_ELEMS, 128, S, E, c.tid0);
#else
                g8::phase<(Y_FP8 ? 2 : 1), false, false>(smem, (const char*)(ws + WS_HBUF), (const char*)((const bf16_t*)(ws + WS_WDN) + (size_t)layer * 65 * WDN_ELEMS), 256, S, E, c.tid0);
#endif
            }
#else
            phase_moe2((const bf16_t*)(ws + WS_HBUF), (const bf16_t*)(ws + WS_WDN) + (size_t)layer * 65 * WDN_ELEMS, CNT, (bf16_t*)(ws + U_Y), c);
#endif
            SEAM(pb + 10); }
        PH(pb + 11)
#if Y_FP8
            if (layer == 3) phase_combine8<true>((const unsigned char*)(ws + U_Y), (const int*)(ws + WS_ASG), (const float*)(ws + WS_ASGW), CNT, (const float*)ain[28] + layer * 1024, (const float*)ain[29] + layer * 1024, a.out, XBF, ws + WS_X1 + XB8I_OFF, c);
            else phase_combine8<false>((const unsigned char*)(ws + U_Y), (const int*)(ws + WS_ASG), (const float*)(ws + WS_ASGW), CNT, (const float*)ain[28] + layer * 1024, (const float*)ain[29] + layer * 1024, a.out, XBF, ws + WS_X1 + XB8I_OFF, c);
            SEAM(pb + 11); }
#else
            if (layer == 3) phase_combine<true>((const bf16_t*)(ws + U_Y), (const int*)(ws + WS_ASG), (const float*)(ws + WS_ASGW), CNT, (const float*)ain[28] + layer * 1024, (const float*)ain[29] + layer * 1024, a.out, XBF, c);
            else phase_combine<false>((const bf16_t*)(ws + U_Y), (const int*)(ws + WS_ASG), (const float*)(ws + WS_ASGW), CNT, (const float*)ain[28] + layer * 1024, (const float*)ain[29] + layer * 1024, a.out, XBF, c);
            SEAM(pb + 11); }
#endif
    }
#undef IN
#undef XBF
#undef X1
#undef PROJ
#undef GATES
#undef MIXO
#undef YBUF
#undef ROPEM
#undef ROPES
#undef XRES
#undef CNT
#undef WIN
#undef WOUT
#undef PH
#undef PH_CTX
#undef UNIT_CTX
#undef SEAM
}

extern "C" void kernel_launch(void* const* d_in, const int* in_sizes, int n_in, void* d_out, int out_size, void* d_ws, size_t ws_size, hipStream_t stream) {
    static int grid = 0;
    if (grid == 0) {
        if (n_in != 30 || out_size != T * 1024 || ws_size < WS_END) {
            fprintf(stderr, "kernel_launch: unexpected shapes (n_in %d, out %d, ws %zu < %zu)\n", n_in, out_size, ws_size, (size_t)WS_END);
            grid = -1; return;
        }
        int dev = 0, cus = 0, per_cu = 0;
        (void)hipGetDevice(&dev);
        (void)hipDeviceGetAttribute(&cus, hipDeviceAttributeMultiprocessorCount, dev);
        (void)hipFuncSetAttribute((const void*)fwd, hipFuncAttributeMaxDynamicSharedMemorySize, DYN_LDS);
        (void)hipOccupancyMaxActiveBlocksPerMultiprocessor(&per_cu, (const void*)fwd, NT, DYN_LDS);
        (void)hipGetLastError();
        if (per_cu < 1) per_cu = 1;
        grid = cus;
    }
    if (grid < 0) return;
    (void)hipMemsetAsync((char*)d_ws + WS_CTL, 0, CTL_BYTES, stream);
    Args a{};
    for (int i = 0; i < 30; ++i) a.in[i] = d_in[i];
    a.out = (float*)d_out; a.ws = (unsigned char*)d_ws; a.pad = 0;
#if ONE_LAUNCH
    a.ph_lo = 0; a.ph_hi = NPH; a.use_bar = 1;
    hipLaunchKernelGGL(fwd, dim3(grid), dim3(NT), DYN_LDS, stream, a);
#else
    for (int p = 0; p < NPH; ++p) {
        a.ph_lo = p; a.ph_hi = p + 1; a.use_bar = 0;
        hipLaunchKernelGGL(fwd, dim3(grid), dim3(NT), DYN_LDS, stream, a);
    }
#endif
}
```
